# Optimizing an MI355X kernel written in HIP

```python
import jax
import jax.numpy as jnp
from jax import lax
import numpy as np

D_MODEL = 1024
BATCH = 2
SEQ = 16384
DEPTH = 2

GRID_W = 64
CTX_LEN = 256
HEAD_DIM = 64
ROPE_THETA = 10000.0
RMS_EPS = 1e-6
A_Q_HEADS = 8
A_KV_HEADS = 2
B_Q_HEADS = 8
B_KV_HEADS = 2
WINDOW = 128
Q_BLOCK = 128
ATTN_IN_DIM = (A_Q_HEADS + 2 * A_KV_HEADS + B_Q_HEADS + 2 * B_KV_HEADS) * HEAD_DIM
ATTN_OUT_DIM = (A_Q_HEADS + B_Q_HEADS) * HEAD_DIM
RWKV_HEADS = D_MODEL // HEAD_DIM
DECAY_LORA = 64
ICLR_LORA = 64
GATE_LORA = 160
GN_EPS = 64e-5
N_EXPERTS = 16
N_GROUPS = 4
EXPERTS_PER_GROUP = N_EXPERTS // N_GROUPS
TOP_K = 2
D_EXPERT = 1024
MOE_BLOCK = 256
N_ATTN_LAYERS = (DEPTH + 1) // 2
N_RWKV_LAYERS = DEPTH // 2

kernel_name = 'hybrid_dit_swa_axial_rwkv7_groupmoe'


def rmsnorm(x, g):
    xf = x.astype(jnp.float32)
    y = xf * lax.rsqrt(jnp.mean(xf * xf, axis=-1, keepdims=True) + RMS_EPS)
    return (y * g.astype(jnp.float32)).astype(x.dtype)


def modulate(h, shift, scale):
    return h * (1 + scale) + shift


def axial_rope_tables(n_tokens):
    rows = n_tokens // GRID_W
    row = jnp.repeat(jnp.arange(rows, dtype=jnp.float32), GRID_W)
    col = (jnp.arange(rows * GRID_W) % GRID_W).astype(jnp.float32)
    n_freq = HEAD_DIM // 4
    inv = ROPE_THETA ** (-jnp.arange(n_freq, dtype=jnp.float32) / n_freq)
    ang = jnp.stack([row, col], axis=-1)[..., None] * inv
    ang = ang[:, None, :, None, :]
    return jnp.cos(ang), jnp.sin(ang)


def apply_rope(x, cos, sin):
    xs = x.reshape(*x.shape[:-1], 2, 2, HEAD_DIM // 4).astype(jnp.float32)
    rot = jnp.stack([-xs[..., 1, :], xs[..., 0, :]], axis=-2)
    return (xs * cos + rot * sin).reshape(x.shape).astype(x.dtype)


def attend(q, k, v, sink=None, mask=None):
    s = jnp.einsum('bqhgd,bshd->bhgqs', q, k, preferred_element_type=jnp.float32)
    if mask is not None:
        s = jnp.where(mask, s, -jnp.inf)
    if sink is not None:
        sk = jnp.broadcast_to(sink.astype(jnp.float32)[None, :, :, None, None], s.shape[:-1] + (1,))
        p = jax.nn.softmax(jnp.concatenate([sk, s], axis=-1), axis=-1)[..., 1:]
    else:
        p = jax.nn.softmax(s, axis=-1)
    return jnp.einsum('bhgqs,bshd->bqhgd', p.astype(v.dtype), v)


def window_attention(q, k, v, kc, vc, sink):
    B, S = q.shape[:2]
    L = kc.shape[1]
    nb = S // Q_BLOCK
    span = Q_BLOCK + 2 * WINDOW
    pad = ((0, 0), (WINDOW, WINDOW), (0, 0), (0, 0))
    kp, vp = jnp.pad(k, pad), jnp.pad(v, pad)
    qb = jnp.swapaxes(q.reshape(B, nb, Q_BLOCK, *q.shape[2:]), 0, 1)
    ctx_ok = jnp.ones((Q_BLOCK, L), dtype=bool)

    def one_block(args):
        q_blk, i = args
        start = i * Q_BLOCK
        qpos = start + jnp.arange(Q_BLOCK)
        kpos = start - WINDOW + jnp.arange(span)
        band = (jnp.abs(qpos[:, None] - kpos[None, :]) <= WINDOW) & (kpos >= 0)[None, :] & (kpos < S)[None, :]
        k_blk = jnp.concatenate([kc, lax.dynamic_slice_in_dim(kp, start, span, axis=1)], axis=1)
        v_blk = jnp.concatenate([vc, lax.dynamic_slice_in_dim(vp, start, span, axis=1)], axis=1)
        return attend(q_blk, k_blk, v_blk, sink=sink, mask=jnp.concatenate([ctx_ok, band], axis=1))

    o = lax.map(one_block, (qb, jnp.arange(nb)))
    return jnp.swapaxes(o, 0, 1).reshape(q.shape)


def block_attention(q, k, v):
    B, S = q.shape[:2]
    nb = S // Q_BLOCK
    qb = jnp.swapaxes(q.reshape(B, nb, Q_BLOCK, *q.shape[2:]), 0, 1)
    o = lax.map(lambda q_blk: attend(q_blk, k, v), qb)
    return jnp.swapaxes(o, 0, 1).reshape(q.shape)


def attn_mixer(hc, hl, w_in, w_out, sink, q_norm_g, k_norm_g, cos, sin, with_ctx):
    B, S, _ = hl.shape
    qscale = HEAD_DIM ** -0.5
    sizes = [A_Q_HEADS, A_KV_HEADS, A_KV_HEADS, B_Q_HEADS, B_KV_HEADS, B_KV_HEADS]
    cuts = [int(n) * HEAD_DIM for n in np.cumsum(sizes)[:-1]]

    def project(h):
        T = h.shape[1]
        parts = jnp.split(h @ w_in, cuts, axis=-1)
        qa, ka, va, qb, kb, vb = [p.reshape(B, T, -1, HEAD_DIM) for p in parts]
        return qa, ka, va, rmsnorm(qb, q_norm_g), rmsnorm(kb, k_norm_g), vb

    def group(q, n_kv):
        return (q * qscale).reshape(q.shape[0], q.shape[1], n_kv, -1, HEAD_DIM)

    sink_g = sink.reshape(A_KV_HEADS, -1)
    cqa, cka, cva, cqb, ckb, cvb = project(hc)
    qa, ka, va, qb, kb, vb = project(hl)
    qa, ka, qb, kb = (apply_rope(t, cos, sin) for t in (qa, ka, qb, kb))
    oa = window_attention(group(qa, A_KV_HEADS), ka, va, cka, cva, sink_g)
    ob = block_attention(group(qb, B_KV_HEADS), jnp.concatenate([ckb, kb], axis=1), jnp.concatenate([cvb, vb], axis=1))
    yl = jnp.concatenate([oa.reshape(B, S, -1), ob.reshape(B, S, -1)], axis=-1) @ w_out
    yc = None
    if with_ctx:
        L = hc.shape[1]
        oca = attend(group(cqa, A_KV_HEADS), cka, cva, sink=sink_g)
        ocb = attend(group(cqb, B_KV_HEADS), ckb, cvb)
        yc = jnp.concatenate([oca.reshape(B, L, -1), ocb.reshape(B, L, -1)], axis=-1) @ w_out
    return yc, yl


def centred_shift(h):
    hp = jnp.pad(h, ((0, 0), (1, 1), (0, 0)))
    return 0.5 * (hp[:, :-2] + hp[:, 2:])


def wkv_scan(state, r, decay, k, v, a, b, reverse):
    def step(s, inp):
        r_t, w_t, k_t, v_t, a_t, b_t = inp
        sa = jnp.einsum('bhvk,bhk->bhv', s, a_t)
        s = s * w_t[:, :, None, :] + sa[..., None] * b_t[:, :, None, :] + v_t[..., None] * k_t[:, :, None, :]
        return s, jnp.einsum('bhvk,bhk->bhv', s, r_t)
    xs = tuple(jnp.swapaxes(t, 0, 1) for t in (r, decay, k, v, a, b))
    state, y = lax.scan(step, state, xs, reverse=reverse)
    return state, jnp.swapaxes(y, 0, 1)


def rwkv_mixer(hc, hl, x_mix, w_r, w_k, w_v, w_o, w0, w1, w2, a0, a1, a2, g1, g2, k_k, k_a, r_k, ln_g, ln_b, with_ctx):
    B, L, D = hc.shape
    f32 = jnp.float32
    h = jnp.concatenate([hc, hl], axis=1)
    T = h.shape[1]
    xx = jnp.concatenate([centred_shift(hc), centred_shift(hl)], axis=1) - h
    mix = lambda j: h + xx * x_mix[j]
    heads = lambda t: t.reshape(*t.shape[:-1], RWKV_HEADS, HEAD_DIM).astype(f32)
    r = heads(mix(0) @ w_r)
    k = heads(mix(2) @ w_k)
    v = heads(mix(3) @ w_v)
    g = jax.nn.sigmoid(mix(5) @ g1) @ g2
    kk = k * heads(k_k)
    kk = kk * lax.rsqrt(jnp.maximum(jnp.sum(kk * kk, axis=-1, keepdims=True), 1e-24))
    y = jnp.zeros_like(v)
    bonus = jnp.zeros(v.shape[:-1] + (1,), f32)
    for d in range(2):
        reverse = d == 1
        w_log = -jax.nn.softplus(-heads(w0[d] + jnp.tanh(mix(1) @ w1[d]) @ w2[d])) - 0.5
        decay = jnp.exp(-jnp.exp(w_log))
        iclr = jax.nn.sigmoid(heads(a0[d] + (mix(4) @ a1[d]) @ a2[d]))
        k_d = k * (1.0 + (iclr - 1.0) * heads(k_a))
        ins = (r, decay, k_d, v, -kk, kk * iclr)
        zero = jnp.zeros((B, RWKV_HEADS, HEAD_DIM, HEAD_DIM), f32)
        s_ctx, y_c = wkv_scan(zero, *(t[:, :L] for t in ins), reverse=reverse)
        _, y_l = wkv_scan(s_ctx, *(t[:, L:] for t in ins), reverse=reverse)
        y = y + jnp.concatenate([y_c, y_l], axis=1)
        bonus = bonus + jnp.sum(r * k_d * r_k.astype(f32), axis=-1, keepdims=True)
    mu = jnp.mean(y, axis=-1, keepdims=True)
    yn = (y - mu) * lax.rsqrt(jnp.mean(jnp.square(y - mu), axis=-1, keepdims=True) + GN_EPS)
    o = yn.reshape(B, T, D) * ln_g.astype(f32) + ln_b.astype(f32) + (bonus * v).reshape(B, T, D)
    o = o.astype(h.dtype) * g
    yl = o[:, L:] @ w_o
    yc = o[:, :L] @ w_o if with_ctx else None
    return yc, yl


def route(h, router_w, router_bias):
    n = h.shape[0]
    probs = jax.nn.softmax((h @ router_w).astype(jnp.float32), axis=-1)
    sel = (probs + router_bias.astype(jnp.float32)).reshape(n, N_GROUPS, EXPERTS_PER_GROUP)
    group_score = jnp.sum(lax.top_k(sel, TOP_K)[0], axis=-1)
    g_idx = jnp.argmax(group_score, axis=-1)
    in_group = jnp.take_along_axis(sel, g_idx[:, None, None], axis=1)[:, 0]
    local = lax.top_k(in_group, TOP_K)[1]
    expert_idx = g_idx[:, None] * EXPERTS_PER_GROUP + local
    w = jnp.take_along_axis(probs, expert_idx, axis=1)
    return expert_idx, w / jnp.sum(w, axis=-1, keepdims=True)


def moe_ffn(h, expert_idx, gate_w, w1, w3, w2):
    N, D = h.shape
    NK = N * TOP_K
    flat_e = expert_idx.reshape(NK)
    flat_tok = jnp.repeat(jnp.arange(N, dtype=jnp.int32), TOP_K)
    flat_w = gate_w.reshape(NK)
    order = jnp.argsort(flat_e)
    e_sorted = flat_e[order]
    counts = jnp.bincount(flat_e, length=N_EXPERTS)
    padded = (counts + MOE_BLOCK - 1) // MOE_BLOCK * MOE_BLOCK
    pad_end = jnp.cumsum(padded)
    pad_start = pad_end - padded
    start = jnp.cumsum(counts) - counts
    dest = pad_start[e_sorted] + jnp.arange(NK) - start[e_sorted]
    n_blocks = -(-NK // MOE_BLOCK) + N_EXPERTS
    n_slots = n_blocks * MOE_BLOCK
    slot_tok = jnp.full((n_slots,), N, dtype=jnp.int32).at[dest].set(flat_tok[order])
    slot_w = jnp.zeros((n_slots,), gate_w.dtype).at[dest].set(flat_w[order])
    block_expert = jnp.minimum(jnp.searchsorted(pad_end, jnp.arange(n_blocks) * MOE_BLOCK, side='right'), N_EXPERTS - 1)
    h_pad = jnp.concatenate([h, jnp.zeros((1, D), h.dtype)], axis=0)
    xb = h_pad[slot_tok].reshape(n_blocks, MOE_BLOCK, D)

    def expert_block(args):
        x_blk, e = args
        return (jax.nn.silu(x_blk @ w1[e]) * (x_blk @ w3[e])) @ w2[e]

    yb = lax.map(expert_block, (xb, block_expert)).reshape(n_slots, D)
    out = jnp.zeros((N + 1, D), h.dtype).at[slot_tok].add(yb * slot_w[:, None].astype(h.dtype))
    return out[:N]


def setup_inputs(seed: int = 0) -> dict:
    key = jax.random.key(seed)
    ks = iter(jax.random.split(key, 64))
    nrm = lambda shape, scale: jax.random.normal(next(ks), shape, jnp.float32) * scale
    D = D_MODEL
    NA, NR = N_ATTN_LAYERS, N_RWKV_LAYERS
    H, N = RWKV_HEADS, HEAD_DIM
    E, F = N_EXPERTS, D_EXPERT
    return {
        'x': nrm((BATCH, SEQ, D), 1.0),
        'c': nrm((BATCH, D), 1.0),
        'ctx': nrm((BATCH, CTX_LEN, D), 1.0),
        'c_ctx': nrm((D,), 1.0),
        'ada_w': nrm((DEPTH, D, 6 * D), 0.5 * D ** -0.5),
        'ada_b': nrm((DEPTH, 6 * D), 0.02),
        'norm_mix_g': 1.0 + nrm((DEPTH, D), 0.02),
        'norm_ffn_g': 1.0 + nrm((DEPTH, D), 0.02),
        'attn_w_in': nrm((NA, D, ATTN_IN_DIM), D ** -0.5),
        'attn_w_out': nrm((NA, ATTN_OUT_DIM, D), ATTN_OUT_DIM ** -0.5),
        'attn_sink': nrm((NA, A_Q_HEADS), 1.0),
        'attn_q_norm_g': 1.0 + nrm((NA, HEAD_DIM), 0.02),
        'attn_k_norm_g': 1.0 + nrm((NA, HEAD_DIM), 0.02),
        'rwkv_x_mix': jax.random.uniform(next(ks), (NR, 6, D), jnp.float32),
        'rwkv_w_r': nrm((NR, D, D), D ** -0.5),
        'rwkv_w_k': nrm((NR, D, D), D ** -0.5),
        'rwkv_w_v': nrm((NR, D, D), D ** -0.5),
        'rwkv_w_o': nrm((NR, D, D), D ** -0.5),
        'rwkv_decay_w0': jax.random.uniform(next(ks), (NR, 2, D), jnp.float32, minval=-6.0, maxval=-1.0),
        'rwkv_decay_w1': nrm((NR, 2, D, DECAY_LORA), 0.5 * D ** -0.5),
        'rwkv_decay_w2': nrm((NR, 2, DECAY_LORA, D), 0.5 * DECAY_LORA ** -0.5),
        'rwkv_iclr_a0': nrm((NR, 2, D), 0.1),
        'rwkv_iclr_a1': nrm((NR, 2, D, ICLR_LORA), 0.5 * D ** -0.5),
        'rwkv_iclr_a2': nrm((NR, 2, ICLR_LORA, D), 0.5 * ICLR_LORA ** -0.5),
        'rwkv_gate_g1': nrm((NR, D, GATE_LORA), D ** -0.5),
        'rwkv_gate_g2': nrm((NR, GATE_LORA, D), GATE_LORA ** -0.5),
        'rwkv_k_k': 0.85 + nrm((NR, D), 0.02),
        'rwkv_k_a': 1.0 + nrm((NR, D), 0.02),
        'rwkv_r_k': nrm((NR, H, N), 0.1),
        'rwkv_ln_g': 1.0 + nrm((NR, D), 0.02),
        'rwkv_ln_b': nrm((NR, D), 0.02),
        'router_w': nrm((D, E), D ** -0.5),
        'router_bias': nrm((E,), 0.01),
        'moe_w1': nrm((DEPTH, E, D, F), D ** -0.5),
        'moe_w3': nrm((DEPTH, E, D, F), D ** -0.5),
        'moe_w2': nrm((DEPTH, E, F, D), F ** -0.5),
        'final_norm_g': 1.0 + nrm((D,), 0.02),
    }


def reference(x, c, ctx, c_ctx, ada_w, ada_b, norm_mix_g, norm_ffn_g, attn_w_in, attn_w_out, attn_sink,
              attn_q_norm_g, attn_k_norm_g, rwkv_x_mix, rwkv_w_r, rwkv_w_k, rwkv_w_v, rwkv_w_o,
              rwkv_decay_w0, rwkv_decay_w1, rwkv_decay_w2, rwkv_iclr_a0, rwkv_iclr_a1, rwkv_iclr_a2,
              rwkv_gate_g1, rwkv_gate_g2, rwkv_k_k, rwkv_k_a, rwkv_r_k, rwkv_ln_g, rwkv_ln_b,
              router_w, router_bias, moe_w1, moe_w3, moe_w2, final_norm_g):
    B, S, D = x.shape
    L = ctx.shape[1]
    cos, sin = axial_rope_tables(S)
    xl, xc = x, ctx
    for i in range(DEPTH):
        with_ctx = i < DEPTH - 1
        j = i // 2
        ml = jnp.moveaxis((jax.nn.silu(c) @ ada_w[i] + ada_b[i]).reshape(B, 6, D), 1, 0)[:, :, None, :]
        mc = (jax.nn.silu(c_ctx) @ ada_w[i] + ada_b[i]).reshape(6, D)
        hl = modulate(rmsnorm(xl, norm_mix_g[i]), ml[0], ml[1])
        hc = modulate(rmsnorm(xc, norm_mix_g[i]), mc[0], mc[1])
        if i % 2 == 0:
            yc, yl = attn_mixer(hc, hl, attn_w_in[j], attn_w_out[j], attn_sink[j], attn_q_norm_g[j],
                                attn_k_norm_g[j], cos, sin, with_ctx)
        else:
            yc, yl = rwkv_mixer(hc, hl, rwkv_x_mix[j], rwkv_w_r[j], rwkv_w_k[j], rwkv_w_v[j], rwkv_w_o[j],
                                rwkv_decay_w0[j], rwkv_decay_w1[j], rwkv_decay_w2[j],
                                rwkv_iclr_a0[j], rwkv_iclr_a1[j], rwkv_iclr_a2[j],
                                rwkv_gate_g1[j], rwkv_gate_g2[j], rwkv_k_k[j], rwkv_k_a[j], rwkv_r_k[j],
                                rwkv_ln_g[j], rwkv_ln_b[j], with_ctx)
        xl = xl + ml[2] * yl
        hl = modulate(rmsnorm(xl, norm_ffn_g[i]), ml[3], ml[4]).reshape(B * S, D)
        if with_ctx:
            xc = xc + mc[2] * yc
            hc = modulate(rmsnorm(xc, norm_ffn_g[i]), mc[3], mc[4]).reshape(B * L, D)
            tokens = jnp.concatenate([hc, hl], axis=0)
        else:
            tokens = hl
        expert_idx, gate_w = route(tokens, router_w, router_bias)
        f = moe_ffn(tokens, expert_idx, gate_w, moe_w1[i], moe_w3[i], moe_w2[i])
        if with_ctx:
            xc = xc + mc[5] * f[:B * L].reshape(B, L, D)
            f = f[B * L:]
        xl = xl + ml[5] * f.reshape(B, S, D)
    return rmsnorm(xl, final_norm_g)
```

```cpp
#include <hip/hip_runtime.h>
#include <stdint.h>
#include <stdio.h>

#ifndef MEGA
#define MEGA 1
#endif

typedef unsigned short bf16_t;
typedef short bf16x8 __attribute__((ext_vector_type(8)));
typedef short s16x4 __attribute__((ext_vector_type(4)));
typedef float f32x2 __attribute__((ext_vector_type(2)));
typedef float f32x4 __attribute__((ext_vector_type(4)));
typedef float f32x16 __attribute__((ext_vector_type(16)));
typedef unsigned u32x2 __attribute__((ext_vector_type(2)));
typedef unsigned u32x4 __attribute__((ext_vector_type(4)));
typedef __bf16 bf16x2_t __attribute__((ext_vector_type(2)));
#define DI __device__ __forceinline__

constexpr int DM = 1024, NBATCH = 2, SEQ = 16384, LCTX = 256, PTOT = SEQ + LCTX, TTOT = NBATCH * PTOT;
constexpr int NTH = 512, NWAVE = 8;
constexpr int QKV_N = 1536;
constexpr int NEXP = 16, CAP = TTOT * 2;
constexpr float RMS_EPS = 1e-6f, GN_EPS = 64e-5f;
constexpr float LOG2E = 1.4426950408889634f;

constexpr size_t MBy = 1u << 20;
constexpr size_t OFF_BAR   = 0;
constexpr size_t OFF_CNT   = 16384;
constexpr size_t OFF_MOD   = 32768;
constexpr size_t OFF_ROPE  = OFF_MOD + 2 * 3 * 6144 * 4;
constexpr size_t OFF_BONUS = 1 * MBy;
constexpr size_t OFF_STOK  = 6 * MBy;
constexpr size_t OFF_SW    = 11 * MBy;
constexpr size_t OFF_XC    = 16 * MBy;
constexpr size_t OFF_WS    = 18 * MBy;
constexpr size_t OFF_MOEW  = 33 * MBy;
constexpr size_t OFF_H     = 129 * MBy;
constexpr size_t OFF_SCR   = 194 * MBy;
constexpr size_t SCR_SIZE  = 290 * MBy;
constexpr size_t WS_NEED   = OFF_SCR + SCR_SIZE;
constexpr size_t W_IN = 0, W_OUT = W_IN + 1536 * 1024, W_R = W_OUT + 1024 * 1024, W_K = W_R + 1024 * 1024, W_V = W_K + 1024 * 1024,
                 W_O = W_V + 1024 * 1024, W_W1 = W_O + 1024 * 1024, W_A1 = W_W1 + 128 * 1024, W_G1 = W_A1 + 128 * 1024,
                 W_W2 = W_G1 + 256 * 1024, W_A2 = W_W2 + 2 * 1024 * 64, W_G2 = W_A2 + 2 * 1024 * 64, W_END = W_G2 + 1024 * 192;
static_assert(W_END * 2 <= 15 * MBy, "small weights region");
constexpr size_t ROWB = (size_t)TTOT * 2048;
constexpr size_t S_Q = 0, S_K = S_Q + ROWB, S_VT = S_K + ROWB / 4, S_O = S_VT + ROWB / 4;
constexpr size_t S_HID = 0, S_Y = 140 * MBy;
constexpr size_t S_R = 0, S_KK = S_R + ROWB, S_V = S_KK + ROWB, S_LW = S_V + ROWB, S_LA = S_LW + ROWB / 8, S_LG = S_LA + ROWB / 8,
                 S_Y1 = 224 * MBy, S_XX = S_Y1, S_OR = S_R;
static_assert(S_O + ROWB <= SCR_SIZE, "scr");
static_assert(S_LG + (size_t)TTOT * 384 <= S_Y1, "scr2");
static_assert(S_Y1 + ROWB <= SCR_SIZE, "scr3");
static_assert(S_Y + 2 * ROWB <= SCR_SIZE, "scr4");
static_assert((size_t)(CAP / 256 + 16) * 256 * 2048 <= S_Y, "hid");
static_assert(OFF_H + ROWB <= OFF_SCR, "h");

struct Params {
    const float *x, *c, *ctx, *c_ctx, *ada_w, *ada_b, *norm_mix_g, *norm_ffn_g, *attn_w_in, *attn_w_out, *attn_sink, *attn_q_norm_g, *attn_k_norm_g,
        *rwkv_x_mix, *rwkv_w_r, *rwkv_w_k, *rwkv_w_v, *rwkv_w_o, *rwkv_decay_w0, *rwkv_decay_w1, *rwkv_decay_w2, *rwkv_iclr_a0, *rwkv_iclr_a1,
        *rwkv_iclr_a2, *rwkv_gate_g1, *rwkv_gate_g2, *rwkv_k_k, *rwkv_k_a, *rwkv_r_k, *rwkv_ln_g, *rwkv_ln_b, *router_w, *router_bias, *moe_w1,
        *moe_w3, *moe_w2, *final_norm_g;
    float* out;
    char* ws;
};

DI unsigned pk_bf16(float a, float b) { f32x2 v = {a, b}; bf16x2_t r = __builtin_convertvector(v, bf16x2_t); return __builtin_bit_cast(unsigned, r); }
DI float bf_lo(unsigned u) { return __uint_as_float(u << 16); }
DI float bf_hi(unsigned u) { return __uint_as_float(u & 0xffff0000u); }
DI float bf2f(bf16_t u) { return __uint_as_float(((unsigned)u) << 16); }
DI float wave_sum(float v) {
#pragma unroll
    for (int o = 32; o >= 1; o >>= 1) v += __shfl_xor(v, o);
    return v;
}
DI float sigmoidf_(float x) { return 1.0f / (1.0f + __expf(-x)); }
DI float siluf_(float x) { return x / (1.0f + __expf(-x)); }
DI float* xrow_ptr(const Params& p, int tok) {
    const int b = tok >= PTOT ? 1 : 0, pos = tok - b * PTOT;
    return pos < LCTX ? (float*)(p.ws + OFF_XC) + (size_t)(b * LCTX + pos) * DM : p.out + (size_t)(b * SEQ + pos - LCTX) * DM;
}
DI const float* xin_ptr(const Params& p, int tok) {
    const int b = tok >= PTOT ? 1 : 0, pos = tok - b * PTOT;
    return pos < LCTX ? p.ctx + (size_t)(b * LCTX + pos) * DM : p.x + (size_t)(b * SEQ + pos - LCTX) * DM;
}
DI const float* mod_ptr(const Params& p, int layer, int tok, int which) {
    const int b = tok >= PTOT ? 1 : 0, pos = tok - b * PTOT;
    const int w = pos < LCTX ? 2 : b;
    return (const float*)(p.ws + OFF_MOD) + (size_t)((layer * 3 + w) * 6 + which) * DM;
}

#define XB_TMO      128
#define XB_XCNT(j)  (256  + 64 * (j))
#define XB_XSUB(j)  (1280 + 64 * (j))
#define XB_XGEN(j)  (2304 + 64 * (j))
#define XB_TOP      3328
#define XB_TOPGEN   3392
#define XCD_BAR_WORDS 3456
#define XB_SPIN_CAP (1u << 18)
#define LAS __attribute__((address_space(3)))
DI unsigned xb_ld(unsigned* p)              { return __hip_atomic_load(p, __ATOMIC_RELAXED, __HIP_MEMORY_SCOPE_AGENT); }
DI unsigned xb_add(unsigned* p, unsigned v) { return __hip_atomic_fetch_add(p, v, __ATOMIC_RELAXED, __HIP_MEMORY_SCOPE_AGENT); }
DI unsigned xb_xcc_id() { return (unsigned)__builtin_amdgcn_s_getreg((3 << 11) | 20) & 0xFu; }
#define XB_SPIN(cond, bar) do { unsigned _sp = 0; while (cond) { __builtin_amdgcn_s_sleep(1); \
    if ((++_sp & 255u) == 0u) { if (xb_ld(&(bar)[XB_TMO])) break; if (_sp > XB_SPIN_CAP) { atomicAdd(&(bar)[XB_TMO], 1u); break; } } } } while (0)
struct XcdBarrier { unsigned* bar; unsigned x; volatile LAS unsigned* st; };
DI XcdBarrier xcd_barrier_post(unsigned* bar, volatile LAS unsigned* st) {
    XcdBarrier b; b.bar = bar; b.x = xb_xcc_id(); b.st = st;
    if (threadIdx.x == 0) (void)xb_add(&bar[XB_XCNT(b.x)], 1u);
    return b;
}
DI void xcd_barrier_complete(unsigned* bar, unsigned x, unsigned& nloc, unsigned& nx) {
    const unsigned G = gridDim.x * gridDim.y * gridDim.z;
    unsigned sum, cnt, mine, sp = 0u;
    for (;;) {
        sum = 0u; cnt = 0u; mine = 0u;
#pragma unroll
        for (unsigned j = 0; j < 16; ++j) { const unsigned c = xb_ld(&bar[XB_XCNT(j)]); sum += c; cnt += (c > 0u) ? 1u : 0u; mine = (j == x) ? c : mine; }
        if (sum == G) break;
        __builtin_amdgcn_s_sleep(1);
        if ((++sp & 255u) == 0u) { if (xb_ld(&bar[XB_TMO])) break; if (sp > XB_SPIN_CAP) { atomicAdd(&bar[XB_TMO], 1u); break; } }
    }
    nloc = mine > 0u ? mine : 1u; nx = cnt > 0u ? cnt : 1u;
}
DI void xcd_barrier(const XcdBarrier& b) {
    asm volatile("s_waitcnt vmcnt(0)" ::: "memory");
    __syncthreads();
    if (threadIdx.x == 0) {
        unsigned* bar = b.bar;
        __builtin_amdgcn_s_waitcnt(0);
        unsigned nloc = b.st[0], nx = b.st[1];
        if (nloc == 0u) { xcd_barrier_complete(bar, b.x, nloc, nx); b.st[0] = nloc; b.st[1] = nx; }
        const unsigned old = xb_add(&bar[XB_XSUB(b.x)], 1u);
        const unsigned gen = old / nloc;
        if (old + 1u == (gen + 1u) * nloc) {
            __builtin_amdgcn_fence(__ATOMIC_RELEASE, "agent");
            asm volatile("s_waitcnt vmcnt(0)" ::: "memory");
            const unsigned og = xb_add(&bar[XB_TOP], 1u);
            const unsigned tg = og / nx;
            if (og + 1u == (tg + 1u) * nx) xb_add(&bar[XB_TOPGEN], 1u);
            else XB_SPIN(xb_ld(&bar[XB_TOPGEN]) == tg, bar);
            __builtin_amdgcn_fence(__ATOMIC_ACQUIRE, "agent");
            xb_add(&bar[XB_XGEN(b.x)], 1u);
            asm volatile("s_waitcnt vmcnt(0)" ::: "memory");
        } else {
            XB_SPIN(xb_ld(&bar[XB_XGEN(b.x)]) == gen, bar);
            __builtin_amdgcn_fence(__ATOMIC_ACQUIRE, "agent");
            asm volatile("s_waitcnt vmcnt(0)" ::: "memory");
        }
    }
    __syncthreads();
}

DI void cvt_tile(const float* src, int ld, int kvalid, bool colvalid, bf16_t* dst, int dld, float* tile  ) {
    const int t = threadIdx.x;
    {
        const int k = t >> 3, c4 = (t & 7) * 4;
        f32x4 v = {0.f, 0.f, 0.f, 0.f};
        if (colvalid && k < kvalid) v = *(const f32x4*)(src + (size_t)k * ld + c4);
        tile[k * 33 + c4 + 0] = v[0]; tile[k * 33 + c4 + 1] = v[1]; tile[k * 33 + c4 + 2] = v[2]; tile[k * 33 + c4 + 3] = v[3];
    }
    __syncthreads();
    {
        const int n = t >> 4, kc = (t & 15) * 4;
        u32x2 w;
        w[0] = pk_bf16(tile[(kc + 0) * 33 + n], tile[(kc + 1) * 33 + n]);
        w[1] = pk_bf16(tile[(kc + 2) * 33 + n], tile[(kc + 3) * 33 + n]);
        *(u32x2*)(dst + (size_t)n * dld + kc) = w;
    }
    __syncthreads();
}
constexpr int CV_SMALL_UNITS = 768 + 512 * 5 + 64 + 64 + 128 + 64 + 64 + 96;
DI void cvt_small_unit(const Params& p, int u, float* tile) {
    bf16_t* wsm = (bf16_t*)(p.ws + OFF_WS);
    if (u < 768) { const int run = u >> 4, kt = u & 15; cvt_tile(p.attn_w_in + (size_t)kt * 64 * 1536 + run * 32, 1536, 64, true, wsm + W_IN + (size_t)run * 32 * 1024 + kt * 64, 1024, tile); return; }
    u -= 768;
    if (u < 512 * 5) {
        const int j = u >> 9, v = u & 511, run = v >> 4, kt = v & 15;
        const float* src = j == 0 ? p.attn_w_out : j == 1 ? p.rwkv_w_r : j == 2 ? p.rwkv_w_k : j == 3 ? p.rwkv_w_v : p.rwkv_w_o;
        const size_t dofs = j == 0 ? W_OUT : j == 1 ? W_R : j == 2 ? W_K : j == 3 ? W_V : W_O;
        cvt_tile(src + (size_t)kt * 64 * 1024 + run * 32, 1024, 64, true, wsm + dofs + (size_t)run * 32 * 1024 + kt * 64, 1024, tile); return;
    }
    u -= 512 * 5;
    if (u < 128) {
        const int j = u >> 6, v = u & 63, run = v >> 4, kt = v & 15, d = run >> 1, co = (run & 1) * 32;
        const float* src = (j == 0 ? p.rwkv_decay_w1 : p.rwkv_iclr_a1) + (size_t)d * 1024 * 64;
        cvt_tile(src + (size_t)kt * 64 * 64 + co, 64, 64, true, wsm + (j == 0 ? W_W1 : W_A1) + (size_t)run * 32 * 1024 + kt * 64, 1024, tile); return;
    }
    u -= 128;
    if (u < 128) {
        const int run = u >> 4, kt = u & 15;
        cvt_tile(p.rwkv_gate_g1 + (size_t)kt * 64 * 160 + run * 32, 160, 64, run < 5, wsm + W_G1 + (size_t)run * 32 * 1024 + kt * 64, 1024, tile); return;
    }
    u -= 128;
    if (u < 128) {
        const int j = u >> 6, v = u & 63, d = v >> 5, run = v & 31;
        const float* src = (j == 0 ? p.rwkv_decay_w2 : p.rwkv_iclr_a2) + (size_t)d * 64 * 1024;
        cvt_tile(src + run * 32, 1024, 64, true, wsm + (j == 0 ? W_W2 : W_A2) + (size_t)d * 1024 * 64 + (size_t)run * 32 * 64, 64, tile); return;
    }
    u -= 128;
    {
        const int run = u / 3, kt = u % 3;
        const int kvalid = 160 - kt * 64 > 64 ? 64 : (160 - kt * 64 < 0 ? 0 : 160 - kt * 64);
        cvt_tile(p.rwkv_gate_g2 + (size_t)kt * 64 * 1024 + run * 32, 1024, kvalid, true, wsm + W_G2 + (size_t)run * 32 * 192 + kt * 64, 192, tile);
    }
}
constexpr int CV_MOE_UNITS = 16 * (1024 + 512);
DI void cvt_moe_unit(const Params& p, int layer, int u, float* tile) {
    bf16_t* w13 = (bf16_t*)(p.ws + OFF_MOEW);
    bf16_t* w2t = w13 + (size_t)16 * 2048 * 1024;
    const int e = u / 1536, v = u % 1536;
    const size_t eo = (size_t)(layer * 16 + e) * 1024 * 1024;
    if (v < 1024) {
        const int run = v >> 4, kt = v & 15, g = run >> 1;
        const float* src = ((run & 1) ? p.moe_w3 : p.moe_w1) + eo;
        cvt_tile(src + (size_t)kt * 64 * 1024 + g * 32, 1024, 64, true, w13 + (size_t)e * 2048 * 1024 + (size_t)run * 32 * 1024 + kt * 64, 1024, tile);
    } else {
        const int w = v - 1024, run = w >> 4, kt = w & 15;
        cvt_tile(p.moe_w2 + eo + (size_t)kt * 64 * 1024 + run * 32, 1024, 64, true, w2t + (size_t)e * 1024 * 1024 + (size_t)run * 32 * 1024 + kt * 64, 1024, tile);
    }
}
DI void adaln_unit(const Params& p, int u, float* sm) {
    const int l = u / 96, n0 = (u % 96) * 64, t = threadIdx.x;
    float* sv = sm;
    float* red = sm + 3 * 1024;
    for (int i = t; i < 3 * 1024; i += NTH) { const int w = i >> 10, k = i & 1023; const float c = w < 2 ? p.c[w * 1024 + k] : p.c_ctx[k]; sv[i] = siluf_(c); }
    __syncthreads();
    const int kg = t >> 4, cl = t & 15;
    f32x4 a0 = {0, 0, 0, 0}, a1 = a0, a2 = a0;
    const float* W = p.ada_w + (size_t)l * 1024 * 6144 + n0 + cl * 4;
#pragma unroll 8
    for (int i = 0; i < 32; ++i) {
        const int k = kg + 32 * i;
        const f32x4 w = *(const f32x4*)(W + (size_t)k * 6144);
        a0 += w * sv[k]; a1 += w * sv[1024 + k]; a2 += w * sv[2048 + k];
    }
#pragma unroll
    for (int j = 0; j < 4; ++j) { red[kg * 192 + 0 * 64 + cl * 4 + j] = a0[j]; red[kg * 192 + 1 * 64 + cl * 4 + j] = a1[j]; red[kg * 192 + 2 * 64 + cl * 4 + j] = a2[j]; }
    __syncthreads();
    if (t < 192) {
        float s = 0.f;
        for (int g = 0; g < 32; ++g) s += red[g * 192 + t];
        const int w = t >> 6, n = n0 + (t & 63);
        ((float*)(p.ws + OFF_MOD))[(size_t)(l * 3 + w) * 6144 + n] = s + p.ada_b[l * 6144 + n];
    }
    __syncthreads();
}
DI void rope_unit(const Params& p, int u) {
    const int id = u * NTH + threadIdx.x;
    if (id < 320 * 16) {
        const int pi = id >> 4, f = id & 15;
        const float inv = exp2f(-(float)f * (13.287712379549449f / 16.0f));
        const float val = pi < 256 ? (float)pi : (float)(pi - 256);
        const float ang = val * inv;
        const double a = (double)ang;
        const double k = __builtin_rint(a * 0.15915494309189535);
        const float r = (float)(a - k * 6.283185307179586);
        f32x2 cs = {__cosf(r), __sinf(r)};
        ((f32x2*)(p.ws + OFF_ROPE))[id] = cs;
    }
}
DI void phase_prologue(const Params& p, char* smem) {
    float* sm = (float*)smem;
    const int nconv = CV_SMALL_UNITS + CV_MOE_UNITS;
    const int total = nconv + 192 + 10;
    for (int u = blockIdx.x; u < total; u += gridDim.x) {
        if (u < CV_SMALL_UNITS) cvt_small_unit(p, u, sm);
        else if (u < nconv) cvt_moe_unit(p, 0, u - CV_SMALL_UNITS, sm);
        else if (u < nconv + 192) adaln_unit(p, u - nconv, sm);
        else rope_unit(p, u - nconv - 192);
    }
}

DI void row_load(const float* src, f32x4 (&v)[4], int lane) {
#pragma unroll
    for (int i = 0; i < 4; ++i) v[i] = ((const f32x4*)src)[lane + 64 * i];
}
DI float row_rstd(const f32x4 (&v)[4]) {
    float ss = 0.f;
#pragma unroll
    for (int i = 0; i < 4; ++i) ss += v[i][0] * v[i][0] + v[i][1] * v[i][1] + v[i][2] * v[i][2] + v[i][3] * v[i][3];
    ss = wave_sum(ss);
    return rsqrtf(ss * (1.0f / DM) + RMS_EPS);
}
DI void row_norm_mod(const f32x4 (&v)[4], float rstd, const float* g, const float* shift, const float* scale, f32x4 (&h)[4], int lane) {
#pragma unroll
    for (int i = 0; i < 4; ++i) {
        const int c = (lane + 64 * i) * 4;
        const f32x4 g4 = *(const f32x4*)(g + c), sh = *(const f32x4*)(shift + c), sc = *(const f32x4*)(scale + c);
        h[i] = (v[i] * rstd * g4) * (1.0f + sc) + sh;
    }
}
DI void row_store_bf16(bf16_t* dst, const f32x4 (&h)[4], int lane) {
#pragma unroll
    for (int i = 0; i < 4; ++i) { u32x2 w; w[0] = pk_bf16(h[i][0], h[i][1]); w[1] = pk_bf16(h[i][2], h[i][3]); *(u32x2*)(dst + (lane + 64 * i) * 4) = w; }
}
DI void row_load_bf16(const bf16_t* src, f32x4 (&v)[4], int lane) {
#pragma unroll
    for (int i = 0; i < 4; ++i) { const u32x2 w = *(const u32x2*)(src + (lane + 64 * i) * 4); v[i][0] = bf_lo(w[0]); v[i][1] = bf_hi(w[0]); v[i][2] = bf_lo(w[1]); v[i][3] = bf_hi(w[1]); }
}

DI void phase_norm0(const Params& p) {
    const int lane = threadIdx.x & 63, gw = blockIdx.x * NWAVE + (threadIdx.x >> 6), nw = gridDim.x * NWAVE;
    bf16_t* H = (bf16_t*)(p.ws + OFF_H);
    for (int tok = gw; tok < TTOT; tok += nw) {
        f32x4 v[4], h[4];
        row_load(xin_ptr(p, tok), v, lane);
        const float rstd = row_rstd(v);
        row_norm_mod(v, rstd, p.norm_mix_g, mod_ptr(p, 0, tok, 0), mod_ptr(p, 0, tok, 1), h, lane);
        row_store_bf16(H + (size_t)tok * DM, h, lane);
    }
}

DI void route_row(const Params& p, int layer, int tok, const float (&lg)[16], int lane) {
    float mx = lg[0];
#pragma unroll
    for (int e = 1; e < 16; ++e) mx = fmaxf(mx, lg[e]);
    float pr[16], sum = 0.f;
#pragma unroll
    for (int e = 0; e < 16; ++e) { pr[e] = __expf(lg[e] - mx); sum += pr[e]; }
    const float inv = 1.0f / sum;
    float sel[16];
#pragma unroll
    for (int e = 0; e < 16; ++e) { pr[e] *= inv; sel[e] = pr[e] + p.router_bias[e]; }
    float best = -1e30f; int gi = 0;
#pragma unroll
    for (int g = 0; g < 4; ++g) {
        float m1 = -1e30f, m2 = -1e30f;
#pragma unroll
        for (int j = 0; j < 4; ++j) { const float s = sel[g * 4 + j]; if (s > m1) { m2 = m1; m1 = s; } else if (s > m2) m2 = s; }
        const float gs = m1 + m2;
        if (gs > best) { best = gs; gi = g; }
    }
    float s4[4], p4[4];
#pragma unroll
    for (int j = 0; j < 4; ++j) {
        s4[j] = gi == 0 ? sel[j] : gi == 1 ? sel[4 + j] : gi == 2 ? sel[8 + j] : sel[12 + j];
        p4[j] = gi == 0 ? pr[j] : gi == 1 ? pr[4 + j] : gi == 2 ? pr[8 + j] : pr[12 + j];
    }
    int i1 = 0; float b1 = s4[0];
#pragma unroll
    for (int j = 1; j < 4; ++j) if (s4[j] > b1) { b1 = s4[j]; i1 = j; }
    int i2 = i1 == 0 ? 1 : 0; float b2 = -3e38f;
#pragma unroll
    for (int j = 0; j < 4; ++j) if (j != i1 && s4[j] > b2) { b2 = s4[j]; i2 = j; }
    const float w1 = i1 == 0 ? p4[0] : i1 == 1 ? p4[1] : i1 == 2 ? p4[2] : p4[3];
    const float w2 = i2 == 0 ? p4[0] : i2 == 1 ? p4[1] : i2 == 2 ? p4[2] : p4[3];
    const float ws = 1.0f / (w1 + w2);
    if (lane == 0) {
        int* cnt = (int*)(p.ws + OFF_CNT) + layer * 16;
        int* stok = (int*)(p.ws + OFF_STOK);
        float* sw = (float*)(p.ws + OFF_SW);
        const int e1 = gi * 4 + i1, e2 = gi * 4 + i2;
        const int r1 = atomicAdd(&cnt[e1], 1), r2 = atomicAdd(&cnt[e2], 1);
        stok[(size_t)e1 * CAP + r1] = tok * 2 + 0; sw[(size_t)e1 * CAP + r1] = w1 * ws;
        stok[(size_t)e2 * CAP + r2] = tok * 2 + 1; sw[(size_t)e2 * CAP + r2] = w2 * ws;
    }
}
DI void phase_ffn_norm_route(const Params& p, int layer, char* smem) {
    const int lane = threadIdx.x & 63, gw = blockIdx.x * NWAVE + (threadIdx.x >> 6), nw = gridDim.x * NWAVE;
    float* rw = (float*)smem;
    for (int i = threadIdx.x; i < 1024 * 16; i += NTH) rw[(i & 15) * 1024 + (i >> 4)] = p.router_w[i];
    __syncthreads();
    bf16_t* H = (bf16_t*)(p.ws + OFF_H);
    for (int tok = gw; tok < TTOT; tok += nw) {
        const int pos = tok >= PTOT ? tok - PTOT : tok;
        if (layer == 1 && pos < LCTX) continue;
        f32x4 v[4], h[4];
        row_load(xrow_ptr(p, tok), v, lane);
        const float rstd = row_rstd(v);
        row_norm_mod(v, rstd, p.norm_ffn_g + layer * DM, mod_ptr(p, layer, tok, 3), mod_ptr(p, layer, tok, 4), h, lane);
        row_store_bf16(H + (size_t)tok * DM, h, lane);
        float lg[16];
#pragma unroll
        for (int e = 0; e < 16; ++e) lg[e] = 0.f;
#pragma unroll
        for (int i = 0; i < 4; ++i)
#pragma unroll
            for (int e = 0; e < 16; ++e) {
                const f32x4 w = *(const f32x4*)(rw + e * 1024 + (lane + 64 * i) * 4);
                lg[e] += h[i][0] * w[0] + h[i][1] * w[1] + h[i][2] * w[2] + h[i][3] * w[3];
                if ((e & 3) == 3) asm volatile("" ::: "memory");
            }
#pragma unroll
        for (int e = 0; e < 16; ++e) lg[e] = wave_sum(lg[e]);
        route_row(p, layer, tok, lg, lane);
    }
    __syncthreads();
}

DI void combine_row(const Params& p, int layer, int tok, f32x4 (&v)[4], int lane) {
    const bf16_t* Y = (const bf16_t*)(p.ws + OFF_SCR + S_Y) + (size_t)tok * 2 * DM;
    const float* g5 = mod_ptr(p, layer, tok, 5);
    f32x4 y0[4], y1[4];
    row_load(xrow_ptr(p, tok), v, lane);
    row_load_bf16(Y, y0, lane); row_load_bf16(Y + DM, y1, lane);
#pragma unroll
    for (int i = 0; i < 4; ++i) { const f32x4 g = *(const f32x4*)(g5 + (lane + 64 * i) * 4); v[i] += g * (y0[i] + y1[i]); }
}
DI void phase_combine_l0(const Params& p, char* smem) {
    const int lane = threadIdx.x & 63, gw = blockIdx.x * NWAVE + (threadIdx.x >> 6), nw = gridDim.x * NWAVE;
    bf16_t* H = (bf16_t*)(p.ws + OFF_H);
    for (int tok = gw; tok < TTOT; tok += nw) {
        f32x4 v[4], h[4];
        combine_row(p, 0, tok, v, lane);
        float* X = xrow_ptr(p, tok);
#pragma unroll
        for (int i = 0; i < 4; ++i) ((f32x4*)X)[lane + 64 * i] = v[i];
        const float rstd = row_rstd(v);
        row_norm_mod(v, rstd, p.norm_mix_g + DM, mod_ptr(p, 1, tok, 0), mod_ptr(p, 1, tok, 1), h, lane);
        row_store_bf16(H + (size_t)tok * DM, h, lane);
    }
    __syncthreads();
    for (int u = blockIdx.x; u < CV_MOE_UNITS; u += gridDim.x) cvt_moe_unit(p, 1, u, (float*)smem);
}
DI void phase_xx(const Params& p) {
    const int lane = threadIdx.x & 63, gw = blockIdx.x * NWAVE + (threadIdx.x >> 6), nw = gridDim.x * NWAVE;
    const bf16_t* H = (const bf16_t*)(p.ws + OFF_H);
    bf16_t* XX = (bf16_t*)(p.ws + OFF_SCR + S_XX);
    for (int tok = gw; tok < TTOT; tok += nw) {
        const int pos = tok >= PTOT ? tok - PTOT : tok;
        const bool first = pos == 0 || pos == LCTX, last = pos == LCTX - 1 || pos == PTOT - 1;
        f32x4 hc[4], hp[4], hn[4], xx[4];
        row_load_bf16(H + (size_t)tok * DM, hc, lane);
        row_load_bf16(H + (size_t)(first ? tok : tok - 1) * DM, hp, lane);
        row_load_bf16(H + (size_t)(last ? tok : tok + 1) * DM, hn, lane);
#pragma unroll
        for (int i = 0; i < 4; ++i) {
            const f32x4 a = first ? (f32x4){0, 0, 0, 0} : hp[i], b = last ? (f32x4){0, 0, 0, 0} : hn[i];
            xx[i] = 0.5f * (a + b) - hc[i];
        }
        row_store_bf16(XX + (size_t)tok * DM, xx, lane);
    }
}
DI void phase_final(const Params& p) {
    const int lane = threadIdx.x & 63, gw = blockIdx.x * NWAVE + (threadIdx.x >> 6), nw = gridDim.x * NWAVE;
    for (int r = gw; r < NBATCH * SEQ; r += nw) {
        const int b = r / SEQ, tok = b * PTOT + LCTX + (r - b * SEQ);
        f32x4 v[4];
        combine_row(p, 1, tok, v, lane);
        const float rstd = row_rstd(v);
        float* O = p.out + (size_t)r * DM;
#pragma unroll
        for (int i = 0; i < 4; ++i) { const f32x4 g = *(const f32x4*)(p.final_norm_g + (lane + 64 * i) * 4); ((f32x4*)O)[lane + 64 * i] = v[i] * rstd * g; }
    }
}

constexpr int LDSROW = 72;
constexpr int GEMM_SMEM = 2 * (256 + 128) * LDSROW * 2;
template <class AL, class EPI>
DI void gemm_tile(AL& al, const bf16_t* __restrict__ Bt, int ldb, int nk, EPI& epi, char* smem) {
    const int t = threadIdx.x, lane = t & 63, wid = t >> 6, wr = wid >> 1, wc = wid & 1, fr = lane & 15, fq = lane >> 4;
    bf16_t* sA = (bf16_t*)smem;
    bf16_t* sB = sA + 2 * 256 * LDSROW;
    f32x4 acc[4][4];
#pragma unroll
    for (int m = 0; m < 4; ++m)
#pragma unroll
        for (int n = 0; n < 4; ++n) acc[m][n] = (f32x4){0.f, 0.f, 0.f, 0.f};
    const int lr = t >> 3, lc = (t & 7) * 8;
    u32x4 ra[4], rb[2];
#pragma unroll
    for (int i = 0; i < 4; ++i) ra[i] = al.load(lr + 64 * i, lc, i);
#pragma unroll
    for (int i = 0; i < 2; ++i) rb[i] = *(const u32x4*)(Bt + (size_t)(lr + 64 * i) * ldb + lc);
#pragma unroll
    for (int i = 0; i < 4; ++i) *(u32x4*)(sA + (lr + 64 * i) * LDSROW + lc) = ra[i];
#pragma unroll
    for (int i = 0; i < 2; ++i) *(u32x4*)(sB + (lr + 64 * i) * LDSROW + lc) = rb[i];
    __syncthreads();
    for (int kt = 0; kt < nk; ++kt) {
        const int cur = kt & 1;
        const bool more = kt + 1 < nk;
        if (more) {
#pragma unroll
            for (int i = 0; i < 4; ++i) ra[i] = al.load(lr + 64 * i, (kt + 1) * 64 + lc, i);
#pragma unroll
            for (int i = 0; i < 2; ++i) rb[i] = *(const u32x4*)(Bt + (size_t)(lr + 64 * i) * ldb + (kt + 1) * 64 + lc);
        }
        const bf16_t* cA = sA + cur * 256 * LDSROW + (wr * 64 + fr) * LDSROW + fq * 8;
        const bf16_t* cB = sB + cur * 128 * LDSROW + (wc * 64 + fr) * LDSROW + fq * 8;
#pragma unroll
        for (int kk = 0; kk < 2; ++kk) {
            bf16x8 af[4], bfr[4];
#pragma unroll
            for (int m = 0; m < 4; ++m) af[m] = *(const bf16x8*)(cA + m * 16 * LDSROW + kk * 32);
#pragma unroll
            for (int n = 0; n < 4; ++n) bfr[n] = *(const bf16x8*)(cB + n * 16 * LDSROW + kk * 32);
#pragma unroll
            for (int m = 0; m < 4; ++m)
#pragma unroll
                for (int n = 0; n < 4; ++n) acc[m][n] = __builtin_amdgcn_mfma_f32_16x16x32_bf16(bfr[n], af[m], acc[m][n], 0, 0, 0);
        }
        if (more) {
            bf16_t* nA = sA + (cur ^ 1) * 256 * LDSROW;
            bf16_t* nB = sB + (cur ^ 1) * 128 * LDSROW;
#pragma unroll
            for (int i = 0; i < 4; ++i) *(u32x4*)(nA + (lr + 64 * i) * LDSROW + lc) = ra[i];
#pragma unroll
            for (int i = 0; i < 2; ++i) *(u32x4*)(nB + (lr + 64 * i) * LDSROW + lc) = rb[i];
        }
        __syncthreads();
    }
    epi(acc, wr * 64, wc * 64, fr, fq);
}
struct ALPlain {
    const bf16_t* A; int lda;
    DI u32x4 load(int r, int k, int) const { return *(const u32x4*)(A + (size_t)r * lda + k); }
};
struct ALGather {
    const bf16_t* rowp[4];
    DI u32x4 load(int, int k, int i) const { return *(const u32x4*)(rowp[i] + k); }
};
struct ALMix {
    const bf16_t* H; const bf16_t* XX; const float* xm;
    DI u32x4 load(int r, int k, int) const {
        const u32x4 h = *(const u32x4*)(H + (size_t)r * DM + k), x = *(const u32x4*)(XX + (size_t)r * DM + k);
        const f32x4 m0 = *(const f32x4*)(xm + k), m1 = *(const f32x4*)(xm + k + 4);
        u32x4 o;
        o[0] = pk_bf16(bf_lo(h[0]) + bf_lo(x[0]) * m0[0], bf_hi(h[0]) + bf_hi(x[0]) * m0[1]);
        o[1] = pk_bf16(bf_lo(h[1]) + bf_lo(x[1]) * m0[2], bf_hi(h[1]) + bf_hi(x[1]) * m0[3]);
        o[2] = pk_bf16(bf_lo(h[2]) + bf_lo(x[2]) * m1[0], bf_hi(h[2]) + bf_hi(x[2]) * m1[1]);
        o[3] = pk_bf16(bf_lo(h[3]) + bf_lo(x[3]) * m1[2], bf_hi(h[3]) + bf_hi(x[3]) * m1[3]);
        return o;
    }
};

struct EpiQKV {
    const Params* p; int m0, n0;
    DI void operator()(const f32x4 (&acc)[4][4], int rb, int cb, int fr, int fq) const {
        const int hs = (n0 + cb) >> 6;
        const bool isq = hs < 8 || (hs >= 12 && hs < 20), isv = (hs >= 10 && hs < 12) || hs >= 22, normed = hs >= 12 && hs < 22;
        const float* gam = hs < 20 ? p->attn_q_norm_g : p->attn_k_norm_g;
        const f32x2* rope = (const f32x2*)(p->ws + OFF_ROPE);
        bf16_t* Q = (bf16_t*)(p->ws + OFF_SCR + S_Q);
        bf16_t* K = (bf16_t*)(p->ws + OFF_SCR + S_K);
        bf16_t* VT = (bf16_t*)(p->ws + OFF_SCR + S_VT);
#pragma unroll
        for (int m = 0; m < 4; ++m) {
            const int tok = m0 + rb + m * 16 + fr, b = tok >= PTOT ? 1 : 0, pos = tok - b * PTOT;
            f32x4 v[4];
#pragma unroll
            for (int n = 0; n < 4; ++n) v[n] = acc[m][n];
            if (normed) {
                float ss = 0.f;
#pragma unroll
                for (int n = 0; n < 4; ++n) ss += v[n][0] * v[n][0] + v[n][1] * v[n][1] + v[n][2] * v[n][2] + v[n][3] * v[n][3];
                ss += __shfl_xor(ss, 16); ss += __shfl_xor(ss, 32);
                const float rstd = rsqrtf(ss * (1.0f / 64.0f) + RMS_EPS);
#pragma unroll
                for (int n = 0; n < 4; ++n) { const f32x4 g = *(const f32x4*)(gam + n * 16 + fq * 4); v[n] = v[n] * rstd * g; }
            }
            if (!isv && pos >= LCTX) {
                const int t = pos - LCTX, prow = t >> 6, pcol = t & 63;
#pragma unroll
                for (int a = 0; a < 2; ++a) {
                    const f32x2* tb = rope + (a == 0 ? prow : 256 + pcol) * 16 + fq * 4;
#pragma unroll
                    for (int j = 0; j < 4; ++j) {
                        const f32x2 cs = tb[j];
                        const float x0 = v[2 * a][j], x1 = v[2 * a + 1][j];
                        v[2 * a][j] = x0 * cs[0] - x1 * cs[1];
                        v[2 * a + 1][j] = x1 * cs[0] + x0 * cs[1];
                    }
                }
            }
            if (isq) {
                const int hq = hs < 8 ? hs : hs - 4;
                bf16_t* dst = Q + ((size_t)(b * 16 + hq) * PTOT + pos) * 64 + fq * 4;
#pragma unroll
                for (int n = 0; n < 4; ++n) { const f32x4 w = v[n] * (0.125f * LOG2E); u32x2 o; o[0] = pk_bf16(w[0], w[1]); o[1] = pk_bf16(w[2], w[3]); *(u32x2*)(dst + n * 16) = o; }
            } else if (!isv) {
                const int kh = hs < 12 ? hs - 8 : hs - 18;
                bf16_t* dst = K + ((size_t)(b * 4 + kh) * PTOT + pos) * 64 + fq * 4;
#pragma unroll
                for (int n = 0; n < 4; ++n) { u32x2 o; o[0] = pk_bf16(v[n][0], v[n][1]); o[1] = pk_bf16(v[n][2], v[n][3]); *(u32x2*)(dst + n * 16) = o; }
            } else {
                const int vh = hs < 12 ? hs - 10 : hs - 20;
                bf16_t* dst = VT + (size_t)(b * 4 + vh) * 64 * PTOT + pos;
#pragma unroll
                for (int n = 0; n < 4; ++n)
#pragma unroll
                    for (int j = 0; j < 4; ++j) dst[(size_t)(n * 16 + fq * 4 + j) * PTOT] = (bf16_t)(pk_bf16(v[n][j], 0.f) & 0xffffu);
            }
        }
    }
};
DI void phase_qkv(const Params& p, char* smem) {
    const bf16_t* H = (const bf16_t*)(p.ws + OFF_H);
    const bf16_t* W = (const bf16_t*)(p.ws + OFF_WS) + W_IN;
    constexpr int NT = QKV_N / 128, MT = TTOT / 256;
    for (int u = blockIdx.x; u < MT * NT; u += gridDim.x) {
        const int mt = u / NT, nt = u % NT;
        ALPlain al{H + (size_t)mt * 256 * DM, DM};
        EpiQKV epi{&p, mt * 256, nt * 128};
        gemm_tile(al, W + (size_t)nt * 128 * DM, DM, DM / 64, epi, smem);
    }
}

struct EpiResid {
    const Params* p; int m0, n0, layer; bool from_input;
    DI void operator()(const f32x4 (&acc)[4][4], int rb, int cb, int fr, int fq) const {
#pragma unroll
        for (int m = 0; m < 4; ++m) {
            const int tok = m0 + rb + m * 16 + fr;
            const float* xin = from_input ? xin_ptr(*p, tok) : xrow_ptr(*p, tok);
            float* xo = xrow_ptr(*p, tok);
            const float* gate = mod_ptr(*p, layer, tok, 2);
#pragma unroll
            for (int n = 0; n < 4; ++n) {
                const int c = n0 + cb + n * 16 + fq * 4;
                const f32x4 xi = *(const f32x4*)(xin + c), g = *(const f32x4*)(gate + c);
                *(f32x4*)(xo + c) = xi + g * acc[m][n];
            }
        }
    }
};
DI void phase_wout(const Params& p, char* smem) {
    const bf16_t* O = (const bf16_t*)(p.ws + OFF_SCR + S_O);
    const bf16_t* W = (const bf16_t*)(p.ws + OFF_WS) + W_OUT;
    constexpr int NT = 8, MT = TTOT / 256;
    for (int u = blockIdx.x; u < MT * NT; u += gridDim.x) {
        const int mt = u / NT, nt = u % NT;
        ALPlain al{O + (size_t)mt * 256 * DM, DM};
        EpiResid epi{&p, mt * 256, nt * 128, 0, true};
        gemm_tile(al, W + (size_t)nt * 128 * DM, DM, DM / 64, epi, smem);
    }
}
DI void phase_wo(const Params& p, char* smem) {
    const bf16_t* O = (const bf16_t*)(p.ws + OFF_SCR + S_OR);
    const bf16_t* W = (const bf16_t*)(p.ws + OFF_WS) + W_O;
    constexpr int NT = 8, MTL = SEQ / 256;
    for (int u = blockIdx.x; u < NBATCH * MTL * NT; u += gridDim.x) {
        const int mi = u / NT, nt = u % NT, b = mi / MTL, mt = b * (PTOT / 256) + 1 + (mi % MTL);
        ALPlain al{O + (size_t)mt * 256 * DM, DM};
        EpiResid epi{&p, mt * 256, nt * 128, 1, false};
        gemm_tile(al, W + (size_t)nt * 128 * DM, DM, DM / 64, epi, smem);
    }
}

struct MoeSched { int nt[16], base[17]; };
DI void moe_sched(const Params& p, int layer, MoeSched& s, int (&cnt)[16]) {
    const int* c = (const int*)(p.ws + OFF_CNT) + layer * 16;
    int acc = 0;
#pragma unroll
    for (int e = 0; e < 16; ++e) { cnt[e] = c[e]; s.nt[e] = (cnt[e] + 255) >> 8; s.base[e] = acc; acc += s.nt[e]; }
    s.base[16] = acc;
}
struct EpiMoe1 {
    bf16_t* hid;   int n0;
    DI void operator()(const f32x4 (&acc)[4][4], int rb, int cb, int fr, int fq) const {
        const int g = (n0 + cb) >> 6;
#pragma unroll
        for (int m = 0; m < 4; ++m) {
            bf16_t* dst = hid + (size_t)(rb + m * 16 + fr) * 1024 + g * 32 + fq * 4;
#pragma unroll
            for (int n = 0; n < 2; ++n) {
                const f32x4 a = acc[m][n], b = acc[m][n + 2];
                u32x2 o;
                o[0] = pk_bf16(siluf_(a[0]) * b[0], siluf_(a[1]) * b[1]);
                o[1] = pk_bf16(siluf_(a[2]) * b[2], siluf_(a[3]) * b[3]);
                *(u32x2*)(dst + n * 16) = o;
            }
        }
    }
};
DI void phase_moe1(const Params& p, int layer, char* smem) {
    MoeSched s; int cnt[16];
    moe_sched(p, layer, s, cnt);
    const bf16_t* H = (const bf16_t*)(p.ws + OFF_H);
    const bf16_t* W13 = (const bf16_t*)(p.ws + OFF_MOEW);
    const int* stok = (const int*)(p.ws + OFF_STOK);
    bf16_t* hid = (bf16_t*)(p.ws + OFF_SCR + S_HID);
    constexpr int NT = 16;
    const int total = s.base[16] * NT;
    const int lr = threadIdx.x >> 3;
    for (int u = blockIdx.x; u < total; u += gridDim.x) {
        const int mg = u / NT, nt = u % NT;
        int e = 0;
#pragma unroll
        for (int i = 1; i < 16; ++i) if (mg >= s.base[i]) e = i;
        int ce = 0;
#pragma unroll
        for (int i = 0; i < 16; ++i) if (i == e) ce = cnt[i];
        int be = 0;
#pragma unroll
        for (int i = 0; i < 16; ++i) if (i == e) be = s.base[i];
        const int ml = mg - be;
        ALGather al;
#pragma unroll
        for (int i = 0; i < 4; ++i) {
            const int r = ml * 256 + lr + 64 * i;
            const int tk = r < ce ? (stok[(size_t)e * CAP + r] >> 1) : 0;
            al.rowp[i] = H + (size_t)tk * DM;
        }
        EpiMoe1 epi{hid + (size_t)mg * 256 * 1024, nt * 128};
        gemm_tile(al, W13 + (size_t)e * 2048 * 1024 + (size_t)nt * 128 * 1024, 1024, 16, epi, smem);
    }
}
struct EpiMoe2 {
    bf16_t* Y; const int* stok; const float* sw; int nvalid, n0;
    DI void operator()(const f32x4 (&acc)[4][4], int rb, int cb, int fr, int fq) const {
#pragma unroll
        for (int m = 0; m < 4; ++m) {
            const int r = rb + m * 16 + fr;
            if (r < nvalid) {
                const int tk = stok[r]; const float w = sw[r];
                bf16_t* dst = Y + (size_t)tk * 1024 + n0 + cb + fq * 4;
#pragma unroll
                for (int n = 0; n < 4; ++n) { const f32x4 a = acc[m][n] * w; u32x2 o; o[0] = pk_bf16(a[0], a[1]); o[1] = pk_bf16(a[2], a[3]); *(u32x2*)(dst + n * 16) = o; }
            }
        }
    }
};
DI void phase_moe2(const Params& p, int layer, char* smem) {
    MoeSched s; int cnt[16];
    moe_sched(p, layer, s, cnt);
    const bf16_t* hid = (const bf16_t*)(p.ws + OFF_SCR + S_HID);
    const bf16_t* W2 = (const bf16_t*)(p.ws + OFF_MOEW) + (size_t)16 * 2048 * 1024;
    const int* stok = (const int*)(p.ws + OFF_STOK);
    const float* sw = (const float*)(p.ws + OFF_SW);
    bf16_t* Y = (bf16_t*)(p.ws + OFF_SCR + S_Y);
    constexpr int NT = 8;
    const int total = s.base[16] * NT;
    for (int u = blockIdx.x; u < total; u += gridDim.x) {
        const int mg = u / NT, nt = u % NT;
        int e = 0;
#pragma unroll
        for (int i = 1; i < 16; ++i) if (mg >= s.base[i]) e = i;
        int ce = 0, be = 0;
#pragma unroll
        for (int i = 0; i < 16; ++i) if (i == e) { ce = cnt[i]; be = s.base[i]; }
        const int ml = mg - be;
        ALPlain al{hid + (size_t)mg * 256 * 1024, 1024};
        EpiMoe2 epi{Y, stok + (size_t)e * CAP + ml * 256, sw + (size_t)e * CAP + ml * 256, ce - ml * 256, nt * 128};
        gemm_tile(al, W2 + (size_t)e * 1024 * 1024 + (size_t)nt * 128 * 1024, 1024, 16, epi, smem);
    }
}

struct EpiRwkv {
    bf16_t* dst; int ld, m0, n0, act, nstore;
    DI void operator()(const f32x4 (&acc)[4][4], int rb, int cb, int fr, int fq) const {
#pragma unroll
        for (int m = 0; m < 4; ++m) {
            bf16_t* d = dst + (size_t)(m0 + rb + m * 16 + fr) * ld + n0 + cb + fq * 4;
#pragma unroll
            for (int n = 0; n < 4; ++n) {
                const int c = n0 + cb + n * 16 + fq * 4;
                if (c >= ld) continue;
                f32x4 a = acc[m][n];
                if (act == 1) {
#pragma unroll
                    for (int j = 0; j < 4; ++j) { const float e = __expf(2.0f * a[j]); a[j] = 1.0f - 2.0f / (e + 1.0f); }
                }
                if (act == 2) {
#pragma unroll
                    for (int j = 0; j < 4; ++j) a[j] = sigmoidf_(a[j]);
                }
                if (c >= nstore) a = (f32x4){0.f, 0.f, 0.f, 0.f};
                u32x2 o; o[0] = pk_bf16(a[0], a[1]); o[1] = pk_bf16(a[2], a[3]);
                *(u32x2*)(d + n * 16) = o;
            }
        }
    }
};
DI void phase_rwkv_proj(const Params& p, char* smem) {
    const bf16_t* H = (const bf16_t*)(p.ws + OFF_H);
    const bf16_t* XX = (const bf16_t*)(p.ws + OFF_SCR + S_XX);
    const bf16_t* wsm = (const bf16_t*)(p.ws + OFF_WS);
    constexpr int MT = TTOT / 256, NTT = 8 + 8 + 8 + 1 + 1 + 2;
    for (int u = blockIdx.x; u < MT * NTT; u += gridDim.x) {
        const int mt = u / NTT, q = u % NTT;
        int job, nt;
        if (q < 8) { job = 0; nt = q; } else if (q < 16) { job = 1; nt = q - 8; } else if (q < 24) { job = 2; nt = q - 16; }
        else if (q == 24) { job = 3; nt = 0; } else if (q == 25) { job = 4; nt = 0; } else { job = 5; nt = q - 26; }
        const int mixj = job == 0 ? 0 : job == 1 ? 2 : job == 2 ? 3 : job == 3 ? 1 : job == 4 ? 4 : 5;
        const size_t wofs = job == 0 ? W_R : job == 1 ? W_K : job == 2 ? W_V : job == 3 ? W_W1 : job == 4 ? W_A1 : W_G1;
        const size_t dofs = job == 0 ? S_R : job == 1 ? S_KK : job == 2 ? S_V : job == 3 ? S_LW : job == 4 ? S_LA : S_LG;
        const int ld = job < 3 ? 1024 : job < 5 ? 128 : 192;
        ALMix al{H + (size_t)mt * 256 * DM, XX + (size_t)mt * 256 * DM, p.rwkv_x_mix + mixj * DM};
        EpiRwkv epi{(bf16_t*)(p.ws + OFF_SCR + dofs), ld, mt * 256, nt * 128, job == 3 ? 1 : job == 5 ? 2 : 0, job == 5 ? 160 : 4096};
        gemm_tile(al, wsm + wofs + (size_t)nt * 128 * DM, DM, DM / 64, epi, smem);
    }
}

struct EpiGate {
    const Params* p; int m0, n0;
    DI void operator()(const f32x4 (&acc)[4][4], int rb, int cb, int fr, int fq) const {
        const bf16_t* Y0 = (const bf16_t*)(p->ws + OFF_H);
        const bf16_t* Y1 = (const bf16_t*)(p->ws + OFF_SCR + S_Y1);
        const bf16_t* V = (const bf16_t*)(p->ws + OFF_SCR + S_V);
        const float* bonus = (const float*)(p->ws + OFF_BONUS);
        bf16_t* O = (bf16_t*)(p->ws + OFF_SCR + S_OR);
        const int c0 = n0 + cb, hd = c0 >> 6;
#pragma unroll
        for (int m = 0; m < 4; ++m) {
            const int tok = m0 + rb + m * 16 + fr;
            const size_t ro = (size_t)tok * DM + c0 + fq * 4;
            f32x4 y[4];
            float s = 0.f;
#pragma unroll
            for (int n = 0; n < 4; ++n) {
                const u32x2 a = *(const u32x2*)(Y0 + ro + n * 16), b = *(const u32x2*)(Y1 + ro + n * 16);
                y[n][0] = bf_lo(a[0]) + bf_lo(b[0]); y[n][1] = bf_hi(a[0]) + bf_hi(b[0]); y[n][2] = bf_lo(a[1]) + bf_lo(b[1]); y[n][3] = bf_hi(a[1]) + bf_hi(b[1]);
                s += y[n][0] + y[n][1] + y[n][2] + y[n][3];
            }
            s += __shfl_xor(s, 16); s += __shfl_xor(s, 32);
            const float mu = s * (1.0f / 64.0f);
            float q = 0.f;
#pragma unroll
            for (int n = 0; n < 4; ++n) { const f32x4 d = y[n] - mu; q += d[0] * d[0] + d[1] * d[1] + d[2] * d[2] + d[3] * d[3]; }
            q += __shfl_xor(q, 16); q += __shfl_xor(q, 32);
            const float rs = rsqrtf(q * (1.0f / 64.0f) + GN_EPS);
            const float bon = bonus[(size_t)tok * 16 + hd] + bonus[(size_t)(TTOT + tok) * 16 + hd];
#pragma unroll
            for (int n = 0; n < 4; ++n) {
                const int c = c0 + n * 16 + fq * 4;
                const f32x4 g = *(const f32x4*)(p->rwkv_ln_g + c), bb = *(const f32x4*)(p->rwkv_ln_b + c);
                const u32x2 vv = *(const u32x2*)(V + ro + n * 16);
                const f32x4 v4 = {bf_lo(vv[0]), bf_hi(vv[0]), bf_lo(vv[1]), bf_hi(vv[1])};
                const f32x4 o = ((y[n] - mu) * rs * g + bb + bon * v4) * acc[m][n];
                u32x2 w; w[0] = pk_bf16(o[0], o[1]); w[1] = pk_bf16(o[2], o[3]);
                *(u32x2*)(O + ro + n * 16) = w;
            }
        }
    }
};
DI void phase_gate(const Params& p, char* smem) {
    const bf16_t* LG = (const bf16_t*)(p.ws + OFF_SCR + S_LG);
    const bf16_t* W = (const bf16_t*)(p.ws + OFF_WS) + W_G2;
    constexpr int NT = 8, MT = TTOT / 256;
    for (int u = blockIdx.x; u < MT * NT; u += gridDim.x) {
        const int mt = u / NT, nt = u % NT;
        ALPlain al{LG + (size_t)mt * 256 * 192, 192};
        EpiGate epi{&p, mt * 256, nt * 128};
        gemm_tile(al, W + (size_t)nt * 128 * 192, 192, 3, epi, smem);
    }
}

constexpr int KROW = 72, VROW = 68;
constexpr int ATT_SMEM = 2 * 64 * KROW * 2 + 2 * 64 * VROW * 2;
DI int crow_(int i, int h) { return (i & 3) + 8 * (i >> 2) + 4 * h; }
#define MFMA32(a, b, c) __builtin_amdgcn_mfma_f32_32x32x16_bf16((a), (b), (c), 0, 0, 0)
template <int MODE>
DI void attn_unit(const Params& p, const bf16_t* Qg  , int nq_valid, const bf16_t* Kg  , const bf16_t* Vg  ,
                  int ta0, int ta1, int tb0, int tb1  , bool band, int q_lat0  ,
                  float init_m, float init_l0, bf16_t* Og  , char* smem) {
    const int t = threadIdx.x, lane = t & 63, wid = t >> 6, r = lane & 31, h = lane >> 5;
    bf16_t* sK = (bf16_t*)smem;
    bf16_t* sV = sK + 2 * 64 * KROW;
    const int qi = wid * 32 + r;
    bf16x8 qf[4];
    {
        const bf16_t* qp = Qg + (size_t)(qi < nq_valid ? qi : 0) * 64 + 8 * h;
#pragma unroll
        for (int ks = 0; ks < 4; ++ks) qf[ks] = *(const bf16x8*)(qp + ks * 16);
    }
    f32x16 o0, o1;
#pragma unroll
    for (int i = 0; i < 16; ++i) { o0[i] = 0.f; o1[i] = 0.f; }
    float mrun = init_m, lrun = (MODE == 1 && h == 0) ? init_l0 : 0.f;
    const int ntile = ((ta1 - ta0) + (tb1 - tb0)) >> 6;
    const int lrow = t >> 3, lch = (t & 7) * 8;
    u32x4 rk, rv;
    auto tile_pos = [&](int i) { const int a = (ta1 - ta0) >> 6; return i < a ? ta0 + i * 64 : tb0 + (i - a) * 64; };
    {
        const int kp = tile_pos(0);
        rk = *(const u32x4*)(Kg + (size_t)(kp + lrow) * 64 + lch);
        rv = *(const u32x4*)(Vg + (size_t)lrow * PTOT + kp + lch);
        *(u32x4*)(sK + lrow * KROW + lch) = rk;
        *(u32x2*)(sV + lrow * VROW + lch) = (u32x2){rv[0], rv[1]};
        *(u32x2*)(sV + lrow * VROW + lch + 4) = (u32x2){rv[2], rv[3]};
    }
    __syncthreads();
    for (int it = 0; it < ntile; ++it) {
        const int cur = it & 1;
        const bool more = it + 1 < ntile;
        const int kp = tile_pos(it);
        if (more) {
            const int kn = tile_pos(it + 1);
            rk = *(const u32x4*)(Kg + (size_t)(kn + lrow) * 64 + lch);
            rv = *(const u32x4*)(Vg + (size_t)lrow * PTOT + kn + lch);
        }
        const bf16_t* cK = sK + cur * 64 * KROW;
        const bf16_t* cV = sV + cur * 64 * VROW;
        f32x16 s0, s1;
#pragma unroll
        for (int i = 0; i < 16; ++i) { s0[i] = MODE == 0 ? init_m : 0.f; s1[i] = s0[i]; }
#pragma unroll
        for (int ks = 0; ks < 4; ++ks) {
            const bf16x8 k0 = *(const bf16x8*)(cK + r * KROW + ks * 16 + 8 * h);
            const bf16x8 k1 = *(const bf16x8*)(cK + (32 + r) * KROW + ks * 16 + 8 * h);
            s0 = MFMA32(k0, qf[ks], s0);
            s1 = MFMA32(k1, qf[ks], s1);
        }
        if (MODE == 1) {
            if (band && kp >= LCTX) {
                const int qlat = q_lat0 + qi, kl0 = kp - LCTX;
#pragma unroll
                for (int i = 0; i < 16; ++i) {
                    const int d0 = qlat - (kl0 + crow_(i, h)), d1 = d0 - 32;
                    if (d0 > 128 || d0 < -128) s0[i] = -1e30f;
                    if (d1 > 128 || d1 < -128) s1[i] = -1e30f;
                }
            }
            float mt = s0[0];
#pragma unroll
            for (int i = 1; i < 16; ++i) mt = fmaxf(mt, s0[i]);
#pragma unroll
            for (int i = 0; i < 16; ++i) mt = fmaxf(mt, s1[i]);
            mt = fmaxf(mt, __shfl_xor(mt, 32));
            const float mnew = fmaxf(mrun, mt);
            const float alpha = exp2f(mrun - mnew);
            mrun = mnew; lrun *= alpha;
#pragma unroll
            for (int i = 0; i < 16; ++i) { o0[i] *= alpha; o1[i] *= alpha; }
#pragma unroll
            for (int i = 0; i < 16; ++i) { s0[i] -= mnew; s1[i] -= mnew; }
        }
        float ls = 0.f;
#pragma unroll
        for (int i = 0; i < 16; ++i) { s0[i] = exp2f(s0[i]); s1[i] = exp2f(s1[i]); ls += s0[i] + s1[i]; }
        lrun += ls;
#pragma unroll
        for (int sub = 0; sub < 2; ++sub)
#pragma unroll
            for (int st = 0; st < 2; ++st) {
                u32x4 pw;
#pragma unroll
                for (int j = 0; j < 4; ++j) {
                    const float a = sub == 0 ? s0[8 * st + 2 * j] : s1[8 * st + 2 * j], b = sub == 0 ? s0[8 * st + 2 * j + 1] : s1[8 * st + 2 * j + 1];
                    pw[j] = pk_bf16(a, b);
                }
                const bf16x8 pf = __builtin_bit_cast(bf16x8, pw);
                const int kb = sub * 32 + 16 * st + 4 * h;
#pragma unroll
                for (int dt = 0; dt < 2; ++dt) {
                    const s16x4 lo = *(const s16x4*)(cV + (dt * 32 + r) * VROW + kb), hi = *(const s16x4*)(cV + (dt * 32 + r) * VROW + kb + 8);
                    const bf16x8 vf = __builtin_shufflevector(lo, hi, 0, 1, 2, 3, 4, 5, 6, 7);
                    if (dt == 0) o0 = MFMA32(vf, pf, o0); else o1 = MFMA32(vf, pf, o1);
                }
            }
        if (more) {
            bf16_t* nK = sK + (cur ^ 1) * 64 * KROW;
            bf16_t* nV = sV + (cur ^ 1) * 64 * VROW;
            *(u32x4*)(nK + lrow * KROW + lch) = rk;
            *(u32x2*)(nV + lrow * VROW + lch) = (u32x2){rv[0], rv[1]};
            *(u32x2*)(nV + lrow * VROW + lch + 4) = (u32x2){rv[2], rv[3]};
        }
        __syncthreads();
    }
    lrun += __shfl_xor(lrun, 32);
    const float invl = 1.0f / lrun;
    if (qi < nq_valid) {
        bf16_t* op = Og + (size_t)qi * DM;
#pragma unroll
        for (int g = 0; g < 4; ++g) {
            u32x2 w0, w1;
            w0[0] = pk_bf16(o0[4 * g] * invl, o0[4 * g + 1] * invl); w0[1] = pk_bf16(o0[4 * g + 2] * invl, o0[4 * g + 3] * invl);
            w1[0] = pk_bf16(o1[4 * g] * invl, o1[4 * g + 1] * invl); w1[1] = pk_bf16(o1[4 * g + 2] * invl, o1[4 * g + 3] * invl);
            *(u32x2*)(op + 8 * g + 4 * h) = w0;
            *(u32x2*)(op + 32 + 8 * g + 4 * h) = w1;
        }
    }
}
DI void phase_attn(const Params& p, char* smem) {
    const bf16_t* Q = (const bf16_t*)(p.ws + OFF_SCR + S_Q);
    const bf16_t* K = (const bf16_t*)(p.ws + OFF_SCR + S_K);
    const bf16_t* VT = (const bf16_t*)(p.ws + OFF_SCR + S_VT);
    bf16_t* O = (bf16_t*)(p.ws + OFF_SCR + S_O);
    float gq = 0.f, gk = 0.f;
    for (int i = 0; i < 64; ++i) { gq = fmaxf(gq, fabsf(p.attn_q_norm_g[i])); gk = fmaxf(gk, fabsf(p.attn_k_norm_g[i])); }
    const float M2 = 8.25f * gq * gk * LOG2E;
    constexpr int NQB = SEQ / 256;
    const int G = gridDim.x;
    for (int u = blockIdx.x; u < NBATCH * 8 * NQB; u += G) {
        int combo, within;
        if ((G & 7) == 0 && NBATCH * 8 * NQB % G == 0) {
            const int xcd = blockIdx.x & 7, idx = (blockIdx.x >> 3) + (G >> 3) * (u / G);
            combo = xcd & 3; within = (xcd >> 2) * (NBATCH * 8 * NQB / 8) + idx;
        } else { combo = u / (4 * NQB); within = u % (4 * NQB); }
        const int b = combo >> 1, kvh = combo & 1, hq = kvh * 4 + (within & 3), qb = within >> 2;
        const bf16_t* Qg = Q + ((size_t)(b * 16 + 8 + hq) * PTOT + LCTX + qb * 256) * 64;
        attn_unit<0>(p, Qg, 256, K + (size_t)(b * 4 + 2 + kvh) * PTOT * 64, VT + (size_t)(b * 4 + 2 + kvh) * 64 * PTOT, 0, PTOT, 0, 0, false, 0, -M2, 0.f,
                     O + (size_t)(b * PTOT + LCTX + qb * 256) * DM + (8 + hq) * 64, smem);
    }
    for (int u = blockIdx.x; u < NBATCH * 8 * NQB; u += G) {
        const int b = u / (8 * NQB), rem = u % (8 * NQB), qb = rem >> 3, hq = rem & 7, kvh = hq >> 2;
        const int i0 = qb * 256;
        const int lo = i0 - 128 < 0 ? 0 : i0 - 128, hi = i0 + 384 > SEQ ? SEQ : i0 + 384;
        const bf16_t* Qg = Q + ((size_t)(b * 16 + hq) * PTOT + LCTX + i0) * 64;
        attn_unit<1>(p, Qg, 256, K + (size_t)(b * 4 + kvh) * PTOT * 64, VT + (size_t)(b * 4 + kvh) * 64 * PTOT, 0, LCTX, LCTX + lo, LCTX + hi, true, i0,
                     p.attn_sink[hq] * LOG2E, 1.0f, O + (size_t)(b * PTOT + LCTX + i0) * DM + hq * 64, smem);
    }
    for (int u = blockIdx.x; u < NBATCH * 16; u += G) {
        const int b = u >> 4, hh = u & 15, isb = hh >> 3, hq = hh & 7, kvh = isb * 2 + (hq >> 2);
        const bf16_t* Qg = Q + ((size_t)(b * 16 + hh) * PTOT) * 64;
        attn_unit<1>(p, Qg, 256, K + (size_t)(b * 4 + kvh) * PTOT * 64, VT + (size_t)(b * 4 + kvh) * 64 * PTOT, 0, LCTX, 0, 0, false, 0,
                     isb ? -1e30f : p.attn_sink[hq] * LOG2E, isb ? 0.f : 1.0f, O + (size_t)(b * PTOT) * DM + hh * 64, smem);
    }
}

constexpr int TB = 32;
constexpr int SC_REC = 5 * 64;
constexpr int SC_OPS = TB * SC_REC * 4;
constexpr int SC_SMEM = 2 * SC_OPS + 2 * TB * 16 * 4 + 2 * TB * 16 * 4;
DI int scan_pos(int n, int dir) {
    if (n < LCTX) return dir ? LCTX - 1 - n : n;
    const int m = n - LCTX;
    return LCTX + (dir ? SEQ - 1 - m : m);
}
template <int CTRL> DI float dpp_add(float v) { return v + __builtin_bit_cast(float, __builtin_amdgcn_update_dpp(0, __builtin_bit_cast(int, v), CTRL, 0xf, 0xf, false)); }
DI float row16_sum(float v) { v = dpp_add<0x128>(v); v = dpp_add<0x124>(v); v = dpp_add<0x122>(v); v = dpp_add<0x121>(v); return v; }
DI void scan_unit(const Params& p, int u, char* smem) {
    const int t = threadIdx.x, lane = t & 63, wid = __builtin_amdgcn_readfirstlane(t >> 6);
    const unsigned rg = u & 3, dir = (u >> 2) & 1, hd = (u >> 3) & 15, b = u >> 7;
    float* ops = (float*)smem;
    float* vbuf = (float*)(smem + 2 * SC_OPS);
    float* ybuf = vbuf + 2 * TB * 16;
    const bf16_t* R = (const bf16_t*)(p.ws + OFF_SCR + S_R);
    const bf16_t* Kk = (const bf16_t*)(p.ws + OFF_SCR + S_KK);
    const bf16_t* V = (const bf16_t*)(p.ws + OFF_SCR + S_V);
    const bf16_t* LW = (const bf16_t*)(p.ws + OFF_SCR + S_LW);
    const bf16_t* LA = (const bf16_t*)(p.ws + OFF_SCR + S_LA);
    bf16_t* Yo = dir ? (bf16_t*)(p.ws + OFF_SCR + S_Y1) : (bf16_t*)(p.ws + OFF_H);
    float* bonus = (float*)(p.ws + OFF_BONUS);
    const unsigned tokb = b * PTOT, hc = hd * 64;
    constexpr int NBLK = PTOT / TB;
    const unsigned fr = lane & 15, fq = lane >> 4;

    auto prep45 = [&](int blk, int buf) {
        const unsigned st = (wid & 1) * 16 + fr;
        const unsigned tok = tokb + scan_pos(blk * TB + st, dir);
        const unsigned lo = tok * 128u + dir * 64u + fq * 8u;
        const unsigned ro = tok * 1024u + hc + fq * 4u;
        const unsigned wo = W_W2 + dir * 65536u + (hc + fr) * 64u + fq * 8u;
        const unsigned ao = W_A2 + dir * 65536u + (hc + fr) * 64u + fq * 8u;
        const unsigned po = hc + fq * 4u;
        const bf16_t* wsm = (const bf16_t*)(p.ws + OFF_WS);
        bf16x8 lwf[2], laf[2];
#pragma unroll
        for (int kk = 0; kk < 2; ++kk) { lwf[kk] = *(const bf16x8*)(LW + lo + kk * 32); laf[kk] = *(const bf16x8*)(LA + lo + kk * 32); }
        float ssq = 0.f, bsum = 0.f;
        f32x4 wv[4], icv[4];
#pragma unroll
        for (int nt = 0; nt < 4; ++nt) {
            f32x4 aw = {0.f, 0.f, 0.f, 0.f}, aa = aw;
#pragma unroll
            for (int kk = 0; kk < 2; ++kk) {
                const bf16x8 w2f = *(const bf16x8*)(wsm + wo + nt * 1024 + kk * 32), a2f = *(const bf16x8*)(wsm + ao + nt * 1024 + kk * 32);
                aw = __builtin_amdgcn_mfma_f32_16x16x32_bf16(w2f, lwf[kk], aw, 0, 0, 0);
                aa = __builtin_amdgcn_mfma_f32_16x16x32_bf16(a2f, laf[kk], aa, 0, 0, 0);
            }
            const f32x4 w0v = *(const f32x4*)(p.rwkv_decay_w0 + dir * 1024u + po + nt * 16), a0v = *(const f32x4*)(p.rwkv_iclr_a0 + dir * 1024u + po + nt * 16);
            const f32x4 kkv = *(const f32x4*)(p.rwkv_k_k + po + nt * 16);
            const u32x2 c = *(const u32x2*)(Kk + ro + nt * 16);
            const f32x4 kr = {bf_lo(c[0]), bf_hi(c[0]), bf_lo(c[1]), bf_hi(c[1])};
#pragma unroll
            for (int j = 0; j < 4; ++j) {
                const float e = 0.6065306597126334f * sigmoidf_(w0v[j] + aw[j]);
                wv[nt][j] = __expf(-e);
                icv[nt][j] = sigmoidf_(a0v[j] + aa[j]);
                const float q = kr[j] * kkv[j];
                ssq += q * q;
            }
        }
        ssq += __shfl_xor(ssq, 16); ssq += __shfl_xor(ssq, 32);
        const float kn = rsqrtf(fmaxf(ssq, 1e-24f));
        float* rec = ops + (unsigned)buf * (TB * SC_REC) + st * SC_REC + fq * 4;
#pragma unroll
        for (int nt = 0; nt < 4; ++nt) {
            f32x4 kd, bb, aa;
            const f32x4 kkv = *(const f32x4*)(p.rwkv_k_k + po + nt * 16);
            const f32x4 kav = *(const f32x4*)(p.rwkv_k_a + po + nt * 16), rkv = *(const f32x4*)(p.rwkv_r_k + po + nt * 16);
            const u32x2 a = *(const u32x2*)(R + ro + nt * 16), c = *(const u32x2*)(Kk + ro + nt * 16);
            const f32x4 rr = {bf_lo(a[0]), bf_hi(a[0]), bf_lo(a[1]), bf_hi(a[1])};
            const f32x4 kr = {bf_lo(c[0]), bf_hi(c[0]), bf_lo(c[1]), bf_hi(c[1])};
#pragma unroll
            for (int j = 0; j < 4; ++j) {
                const float kkn = kr[j] * kkv[j] * kn;
                kd[j] = kr[j] * (1.0f + (icv[nt][j] - 1.0f) * kav[j]);
                bb[j] = kkn * icv[nt][j];
                aa[j] = -kkn;
                bsum += rr[j] * kd[j] * rkv[j];
            }
            *(f32x4*)(rec + 0 * 64 + nt * 16) = wv[nt];
            *(f32x4*)(rec + 1 * 64 + nt * 16) = kd;
            *(f32x4*)(rec + 2 * 64 + nt * 16) = bb;
            *(f32x4*)(rec + 3 * 64 + nt * 16) = aa;
            *(f32x4*)(rec + 4 * 64 + nt * 16) = rr;
        }
        bsum += __shfl_xor(bsum, 16); bsum += __shfl_xor(bsum, 32);
        if (rg == 0 && fq == 0) bonus[(dir * TTOT + tok) * 16u + hd] = bsum;
    };
    auto prepv = [&](int blk, int buf) {
#pragma unroll
        for (int i = 0; i < TB * 16 / 64; ++i) {
            const unsigned id = i * 64 + lane, st = id >> 4, rw = id & 15;
            const unsigned tok = tokb + scan_pos(blk * TB + st, dir);
            vbuf[(unsigned)buf * (TB * 16) + id] = bf2f(V[tok * 1024u + hc + rg * 16 + rw]);
        }
    };
    auto yflush = [&](int blk, int buf) {
#pragma unroll
        for (int i = 0; i < TB * 16 / 64; ++i) {
            const unsigned id = i * 64 + lane, st = id >> 4, rw = id & 15;
            const unsigned tok = tokb + scan_pos(blk * TB + st, dir);
            Yo[tok * 1024u + hc + rg * 16 + rw] = (bf16_t)(pk_bf16(ybuf[(unsigned)buf * (TB * 16) + id], 0.f) & 0xffffu);
        }
    };
    float s0 = 0.f, s1 = 0.f, s2 = 0.f, s3 = 0.f;
    const unsigned g = lane >> 4, c4 = (lane & 15) * 4, myrow = (wid & 3) * 4 + g;
    if (wid == 4 || wid == 5) prep45(0, 0);
    else if (wid == 6) prepv(0, 0);
    __syncthreads();
    for (int blk = 0; blk < NBLK; ++blk) {
        const int buf = blk & 1;
        if (wid < 4) {
            const float* rec = ops + (unsigned)buf * (TB * SC_REC) + c4;
            const float* vb = vbuf + (unsigned)buf * (TB * 16) + myrow;
            float* yb = ybuf + (unsigned)buf * (TB * 16) + myrow;
#pragma unroll 2
            for (int st = 0; st < TB; ++st) {
                const f32x4 w = *(const f32x4*)(rec + st * SC_REC), kd = *(const f32x4*)(rec + st * SC_REC + 64), bb = *(const f32x4*)(rec + st * SC_REC + 128),
                            aa = *(const f32x4*)(rec + st * SC_REC + 192), rr = *(const f32x4*)(rec + st * SC_REC + 256);
                const float vv = vb[st * 16];
                float sa = s0 * aa[0] + s1 * aa[1] + s2 * aa[2] + s3 * aa[3];
                sa = row16_sum(sa);
                s0 = s0 * w[0] + sa * bb[0] + vv * kd[0];
                s1 = s1 * w[1] + sa * bb[1] + vv * kd[1];
                s2 = s2 * w[2] + sa * bb[2] + vv * kd[2];
                s3 = s3 * w[3] + sa * bb[3] + vv * kd[3];
                float y = s0 * rr[0] + s1 * rr[1] + s2 * rr[2] + s3 * rr[3];
                y = row16_sum(y);
                if ((lane & 15) == 0) yb[st * 16] = y;
            }
        } else if (wid < 6) {
            if (blk + 1 < NBLK) prep45(blk + 1, buf ^ 1);
        } else if (wid == 6) {
            if (blk + 1 < NBLK) prepv(blk + 1, buf ^ 1);
        } else {
            if (blk > 0) yflush(blk - 1, buf ^ 1);
        }
        __syncthreads();
    }
    if (wid == 7) yflush(NBLK - 1, (NBLK - 1) & 1);
    __syncthreads();
}
DI void phase_scan(const Params& p, char* smem) {
    for (int u = blockIdx.x; u < NBATCH * 16 * 2 * 4; u += gridDim.x) scan_unit(p, u, smem);
}

constexpr int NPHASE = 18;
constexpr int SMEM_BYTES = GEMM_SMEM + 64;
template <int PH> DI void run_phase(const Params& p, char* smem) {
    if constexpr (PH == 0) phase_prologue(p, smem);
    else if constexpr (PH == 1) phase_norm0(p);
    else if constexpr (PH == 2) phase_qkv(p, smem);
    else if constexpr (PH == 3) phase_attn(p, smem);
    else if constexpr (PH == 4) phase_wout(p, smem);
    else if constexpr (PH == 5) phase_ffn_norm_route(p, 0, smem);
    else if constexpr (PH == 6) phase_moe1(p, 0, smem);
    else if constexpr (PH == 7) phase_moe2(p, 0, smem);
    else if constexpr (PH == 8) phase_combine_l0(p, smem);
    else if constexpr (PH == 9) phase_xx(p);
    else if constexpr (PH == 10) phase_rwkv_proj(p, smem);
    else if constexpr (PH == 11) phase_scan(p, smem);
    else if constexpr (PH == 12) phase_gate(p, smem);
    else if constexpr (PH == 13) phase_wo(p, smem);
    else if constexpr (PH == 14) phase_ffn_norm_route(p, 1, smem);
    else if constexpr (PH == 15) phase_moe1(p, 1, smem);
    else if constexpr (PH == 16) phase_moe2(p, 1, smem);
    else if constexpr (PH == 17) phase_final(p);
}
template <int PH, int END> struct PhaseSeq {
    static DI void run(const Params& p, char* smem, const XcdBarrier& bar) {
        run_phase<PH>(p, smem);
        if constexpr (PH + 1 < END) { xcd_barrier(bar); PhaseSeq<PH + 1, END>::run(p, smem, bar); }
    }
};
template <int BEG, int END>
__global__ void __launch_bounds__(NTH, 2) fwd_kernel(Params p) {
    extern __shared__ __attribute__((aligned(16))) char smem_raw[];
    char* smem = smem_raw + 16;
    if constexpr (END - BEG > 1) {
        if (threadIdx.x == 0) *(uint4*)smem_raw = make_uint4(0u, 0u, 0u, 0u);
        __syncthreads();
        XcdBarrier bar = xcd_barrier_post((unsigned*)(p.ws + OFF_BAR), (volatile LAS unsigned*)smem_raw);
        PhaseSeq<BEG, END>::run(p, smem, bar);
    } else {
        run_phase<BEG>(p, smem);
    }
}

template <int BEG, int END> static void launch_range(const Params& p, int grid, hipStream_t stream) {
    (void)hipFuncSetAttribute((const void*)fwd_kernel<BEG, END>, hipFuncAttributeMaxDynamicSharedMemorySize, SMEM_BYTES + 16);
    hipLaunchKernelGGL((fwd_kernel<BEG, END>), dim3(grid), dim3(NTH), SMEM_BYTES + 16, stream, p);
}
#ifndef RUN_PHASES
#define RUN_PHASES NPHASE
#endif
template <int PH> static void launch_each(const Params& p, int grid, hipStream_t stream) {
    launch_range<PH, PH + 1>(p, grid, stream);
    if constexpr (PH + 1 < RUN_PHASES) launch_each<PH + 1>(p, grid, stream);
}

extern "C" void kernel_launch(void* const* d_in, const int* in_sizes, int n_in, void* d_out, int out_size, void* d_ws, size_t ws_size, hipStream_t stream) {
    Params p{};
    const float** f = (const float**)&p;
    for (int i = 0; i < 37; ++i) f[i] = (const float*)d_in[i];
    p.out = (float*)d_out;
    p.ws = (char*)d_ws;
    if (ws_size < WS_NEED || n_in < 37) return;
    static int grid = 0;
    if (!grid) {
        int dev = 0, cus = 0;
        (void)hipGetDevice(&dev);
        (void)hipDeviceGetAttribute(&cus, hipDeviceAttributeMultiprocessorCount, dev);
        grid = cus > 0 ? cus : 256;
    }
    (void)hipMemsetAsync(d_ws, 0, 32768, stream);
#if MEGA
    launch_range<0, NPHASE>(p, grid, stream);
#else
    launch_each<0>(p, grid, stream);
#endif
}
```

```cpp
#include <hip/hip_runtime.h>
#include <stdint.h>
#include <stdio.h>

#ifndef MEGA
#define MEGA 1
#endif

typedef unsigned short bf16_t;
typedef short bf16x8 __attribute__((ext_vector_type(8)));
typedef short s16x4 __attribute__((ext_vector_type(4)));
typedef float f32x2 __attribute__((ext_vector_type(2)));
typedef float f32x4 __attribute__((ext_vector_type(4)));
typedef float f32x16 __attribute__((ext_vector_type(16)));
typedef unsigned u32x2 __attribute__((ext_vector_type(2)));
typedef unsigned u32x4 __attribute__((ext_vector_type(4)));
typedef __bf16 bf16x2_t __attribute__((ext_vector_type(2)));
#define DI __device__ __forceinline__

constexpr int DM = 1024, NBATCH = 2, SEQ = 16384, LCTX = 256, PTOT = SEQ + LCTX, TTOT = NBATCH * PTOT;
constexpr int NTH = 512, NWAVE = 8;
constexpr int QKV_N = 1536;
constexpr int NEXP = 16, CAP = TTOT * 2;
constexpr float RMS_EPS = 1e-6f, GN_EPS = 64e-5f;
constexpr float LOG2E = 1.4426950408889634f;

constexpr size_t MBy = 1u << 20;
constexpr size_t OFF_BAR   = 0;
constexpr size_t OFF_CNT   = 16384;
constexpr size_t OFF_MOD   = 32768;
constexpr size_t OFF_ROPE  = OFF_MOD + 2 * 3 * 6144 * 4;
constexpr size_t OFF_BONUS = 1 * MBy;
constexpr size_t OFF_BONUS2 = 6 * MBy;
constexpr size_t OFF_STOK  = 6 * MBy;
constexpr size_t OFF_SW    = 11 * MBy;
constexpr size_t OFF_XC    = 16 * MBy;
constexpr size_t OFF_WS    = 18 * MBy;
constexpr size_t OFF_MOEW  = 33 * MBy;
constexpr size_t OFF_H     = 129 * MBy;
constexpr size_t OFF_SCR   = 194 * MBy;
constexpr size_t SCR_SIZE  = 290 * MBy;
constexpr size_t WS_NEED   = OFF_SCR + SCR_SIZE;
constexpr size_t W_IN = 0, W_OUT = W_IN + 1536 * 1024, W_R = W_OUT + 1024 * 1024, W_K = W_R + 1024 * 1024, W_V = W_K + 1024 * 1024,
                 W_O = W_V + 1024 * 1024, W_W1 = W_O + 1024 * 1024, W_A1 = W_W1 + 128 * 1024, W_G1 = W_A1 + 128 * 1024,
                 W_W2 = W_G1 + 256 * 1024, W_A2 = W_W2 + 2 * 1024 * 64, W_G2 = W_A2 + 2 * 1024 * 64, W_END = W_G2 + 1024 * 192;
static_assert(W_END * 2 <= 15 * MBy, "small weights region");
constexpr size_t ROWB = (size_t)TTOT * 2048;
constexpr size_t S_Q = 0, S_K = S_Q + ROWB, S_VT = S_K + ROWB / 4, S_O = S_VT + ROWB / 4;
constexpr size_t S_HID = 0, S_Y = 140 * MBy;
constexpr size_t S_R = 0, S_KK = S_R + ROWB, S_V = S_KK + ROWB, S_LW = S_V + ROWB, S_LA = S_LW + ROWB / 8, S_LG = S_LA + ROWB / 8,
                 S_Y1 = 224 * MBy, S_XX = S_Y1, S_OR = S_R;
static_assert(S_O + ROWB <= SCR_SIZE, "scr");
static_assert(S_LG + (size_t)TTOT * 384 <= S_Y1, "scr2");
static_assert(S_Y1 + ROWB <= SCR_SIZE, "scr3");
static_assert(S_Y + 2 * ROWB <= SCR_SIZE, "scr4");
static_assert((size_t)(CAP / 256 + 16) * 256 * 2048 <= S_Y, "hid");
static_assert(OFF_H + ROWB <= OFF_SCR, "h");

struct Params {
    const float *x, *c, *ctx, *c_ctx, *ada_w, *ada_b, *norm_mix_g, *norm_ffn_g, *attn_w_in, *attn_w_out, *attn_sink, *attn_q_norm_g, *attn_k_norm_g,
        *rwkv_x_mix, *rwkv_w_r, *rwkv_w_k, *rwkv_w_v, *rwkv_w_o, *rwkv_decay_w0, *rwkv_decay_w1, *rwkv_decay_w2, *rwkv_iclr_a0, *rwkv_iclr_a1,
        *rwkv_iclr_a2, *rwkv_gate_g1, *rwkv_gate_g2, *rwkv_k_k, *rwkv_k_a, *rwkv_r_k, *rwkv_ln_g, *rwkv_ln_b, *router_w, *router_bias, *moe_w1,
        *moe_w3, *moe_w2, *final_norm_g;
    float* out;
    char* ws;
};

DI unsigned pk_bf16(float a, float b) { f32x2 v = {a, b}; bf16x2_t r = __builtin_convertvector(v, bf16x2_t); return __builtin_bit_cast(unsigned, r); }
DI float bf_lo(unsigned u) { return __uint_as_float(u << 16); }
DI float bf_hi(unsigned u) { return __uint_as_float(u & 0xffff0000u); }
DI float bf2f(bf16_t u) { return __uint_as_float(((unsigned)u) << 16); }
DI float wave_sum(float v) {
#pragma unroll
    for (int o = 32; o >= 1; o >>= 1) v += __shfl_xor(v, o);
    return v;
}
DI float sigmoidf_(float x) { return 1.0f / (1.0f + __expf(-x)); }
DI float siluf_(float x) { return x / (1.0f + __expf(-x)); }
DI float* xrow_ptr(const Params& p, int tok) {
    const int b = tok >= PTOT ? 1 : 0, pos = tok - b * PTOT;
    return pos < LCTX ? (float*)(p.ws + OFF_XC) + (size_t)(b * LCTX + pos) * DM : p.out + (size_t)(b * SEQ + pos - LCTX) * DM;
}
DI const float* xin_ptr(const Params& p, int tok) {
    const int b = tok >= PTOT ? 1 : 0, pos = tok - b * PTOT;
    return pos < LCTX ? p.ctx + (size_t)(b * LCTX + pos) * DM : p.x + (size_t)(b * SEQ + pos - LCTX) * DM;
}
DI const float* mod_ptr(const Params& p, int layer, int tok, int which) {
    const int b = tok >= PTOT ? 1 : 0, pos = tok - b * PTOT;
    const int w = pos < LCTX ? 2 : b;
    return (const float*)(p.ws + OFF_MOD) + (size_t)((layer * 3 + w) * 6 + which) * DM;
}

#define XB_TMO      128
#define XB_XCNT(j)  (256  + 64 * (j))
#define XB_XSUB(j)  (1280 + 64 * (j))
#define XB_XGEN(j)  (2304 + 64 * (j))
#define XB_TOP      3328
#define XB_TOPGEN   3392
#define XCD_BAR_WORDS 3456
#define XB_SPIN_CAP (1u << 18)
#define LAS __attribute__((address_space(3)))
DI unsigned xb_ld(unsigned* p)              { return __hip_atomic_load(p, __ATOMIC_RELAXED, __HIP_MEMORY_SCOPE_AGENT); }
DI unsigned xb_add(unsigned* p, unsigned v) { return __hip_atomic_fetch_add(p, v, __ATOMIC_RELAXED, __HIP_MEMORY_SCOPE_AGENT); }
DI unsigned xb_xcc_id() { return (unsigned)__builtin_amdgcn_s_getreg((3 << 11) | 20) & 0xFu; }
#define XB_SPIN(cond, bar) do { unsigned _sp = 0; while (cond) { __builtin_amdgcn_s_sleep(1); \
    if ((++_sp & 255u) == 0u) { if (xb_ld(&(bar)[XB_TMO])) break; if (_sp > XB_SPIN_CAP) { atomicAdd(&(bar)[XB_TMO], 1u); break; } } } } while (0)
struct XcdBarrier { unsigned* bar; unsigned x; volatile LAS unsigned* st; };
DI XcdBarrier xcd_barrier_post(unsigned* bar, volatile LAS unsigned* st) {
    XcdBarrier b; b.bar = bar; b.x = xb_xcc_id(); b.st = st;
    if (threadIdx.x == 0) (void)xb_add(&bar[XB_XCNT(b.x)], 1u);
    return b;
}
DI void xcd_barrier_complete(unsigned* bar, unsigned x, unsigned& nloc, unsigned& nx) {
    const unsigned G = gridDim.x * gridDim.y * gridDim.z;
    unsigned sum, cnt, mine, sp = 0u;
    for (;;) {
        sum = 0u; cnt = 0u; mine = 0u;
#pragma unroll
        for (unsigned j = 0; j < 16; ++j) { const unsigned c = xb_ld(&bar[XB_XCNT(j)]); sum += c; cnt += (c > 0u) ? 1u : 0u; mine = (j == x) ? c : mine; }
        if (sum == G) break;
        __builtin_amdgcn_s_sleep(1);
        if ((++sp & 255u) == 0u) { if (xb_ld(&bar[XB_TMO])) break; if (sp > XB_SPIN_CAP) { atomicAdd(&bar[XB_TMO], 1u); break; } }
    }
    nloc = mine > 0u ? mine : 1u; nx = cnt > 0u ? cnt : 1u;
}
DI void xcd_barrier(const XcdBarrier& b) {
    asm volatile("s_waitcnt vmcnt(0)" ::: "memory");
    __syncthreads();
    if (threadIdx.x == 0) {
        unsigned* bar = b.bar;
        __builtin_amdgcn_s_waitcnt(0);
        unsigned nloc = b.st[0], nx = b.st[1];
        if (nloc == 0u) { xcd_barrier_complete(bar, b.x, nloc, nx); b.st[0] = nloc; b.st[1] = nx; }
        const unsigned old = xb_add(&bar[XB_XSUB(b.x)], 1u);
        const unsigned gen = old / nloc;
        if (old + 1u == (gen + 1u) * nloc) {
            __builtin_amdgcn_fence(__ATOMIC_RELEASE, "agent");
            asm volatile("s_waitcnt vmcnt(0)" ::: "memory");
            const unsigned og = xb_add(&bar[XB_TOP], 1u);
            const unsigned tg = og / nx;
            if (og + 1u == (tg + 1u) * nx) xb_add(&bar[XB_TOPGEN], 1u);
            else XB_SPIN(xb_ld(&bar[XB_TOPGEN]) == tg, bar);
            __builtin_amdgcn_fence(__ATOMIC_ACQUIRE, "agent");
            xb_add(&bar[XB_XGEN(b.x)], 1u);
            asm volatile("s_waitcnt vmcnt(0)" ::: "memory");
        } else {
            XB_SPIN(xb_ld(&bar[XB_XGEN(b.x)]) == gen, bar);
            __builtin_amdgcn_fence(__ATOMIC_ACQUIRE, "agent");
            asm volatile("s_waitcnt vmcnt(0)" ::: "memory");
        }
    }
    __syncthreads();
}

DI void cvt_tile(const float* src, int ld, int kvalid, bool colvalid, bf16_t* dst, int dld, float* tile  ) {
    const int t = threadIdx.x;
    {
        const int k = t >> 3, c4 = (t & 7) * 4;
        f32x4 v = {0.f, 0.f, 0.f, 0.f};
        if (colvalid && k < kvalid) v = *(const f32x4*)(src + (size_t)k * ld + c4);
        tile[k * 33 + c4 + 0] = v[0]; tile[k * 33 + c4 + 1] = v[1]; tile[k * 33 + c4 + 2] = v[2]; tile[k * 33 + c4 + 3] = v[3];
    }
    __syncthreads();
    {
        const int n = t >> 4, kc = (t & 15) * 4;
        u32x2 w;
        w[0] = pk_bf16(tile[(kc + 0) * 33 + n], tile[(kc + 1) * 33 + n]);
        w[1] = pk_bf16(tile[(kc + 2) * 33 + n], tile[(kc + 3) * 33 + n]);
        *(u32x2*)(dst + (size_t)n * dld + kc) = w;
    }
    __syncthreads();
}
constexpr int CV_SMALL_UNITS = 768 + 512 * 5 + 64 + 64 + 128 + 64 + 64 + 96;
DI void cvt_small_unit(const Params& p, int u, float* tile) {
    bf16_t* wsm = (bf16_t*)(p.ws + OFF_WS);
    if (u < 768) { const int run = u >> 4, kt = u & 15; cvt_tile(p.attn_w_in + (size_t)kt * 64 * 1536 + run * 32, 1536, 64, true, wsm + W_IN + (size_t)run * 32 * 1024 + kt * 64, 1024, tile); return; }
    u -= 768;
    if (u < 512 * 5) {
        const int j = u >> 9, v = u & 511, run = v >> 4, kt = v & 15;
        const float* src = j == 0 ? p.attn_w_out : j == 1 ? p.rwkv_w_r : j == 2 ? p.rwkv_w_k : j == 3 ? p.rwkv_w_v : p.rwkv_w_o;
        const size_t dofs = j == 0 ? W_OUT : j == 1 ? W_R : j == 2 ? W_K : j == 3 ? W_V : W_O;
        cvt_tile(src + (size_t)kt * 64 * 1024 + run * 32, 1024, 64, true, wsm + dofs + (size_t)run * 32 * 1024 + kt * 64, 1024, tile); return;
    }
    u -= 512 * 5;
    if (u < 128) {
        const int j = u >> 6, v = u & 63, run = v >> 4, kt = v & 15, d = run >> 1, co = (run & 1) * 32;
        const float* src = (j == 0 ? p.rwkv_decay_w1 : p.rwkv_iclr_a1) + (size_t)d * 1024 * 64;
        cvt_tile(src + (size_t)kt * 64 * 64 + co, 64, 64, true, wsm + (j == 0 ? W_W1 : W_A1) + (size_t)run * 32 * 1024 + kt * 64, 1024, tile); return;
    }
    u -= 128;
    if (u < 128) {
        const int run = u >> 4, kt = u & 15;
        cvt_tile(p.rwkv_gate_g1 + (size_t)kt * 64 * 160 + run * 32, 160, 64, run < 5, wsm + W_G1 + (size_t)run * 32 * 1024 + kt * 64, 1024, tile); return;
    }
    u -= 128;
    if (u < 128) {
        const int j = u >> 6, v = u & 63, d = v >> 5, run = v & 31;
        const float* src = (j == 0 ? p.rwkv_decay_w2 : p.rwkv_iclr_a2) + (size_t)d * 64 * 1024;
        cvt_tile(src + run * 32, 1024, 64, true, wsm + (j == 0 ? W_W2 : W_A2) + (size_t)d * 1024 * 64 + (size_t)run * 32 * 64, 64, tile); return;
    }
    u -= 128;
    {
        const int run = u / 3, kt = u % 3;
        const int kvalid = 160 - kt * 64 > 64 ? 64 : (160 - kt * 64 < 0 ? 0 : 160 - kt * 64);
        cvt_tile(p.rwkv_gate_g2 + (size_t)kt * 64 * 1024 + run * 32, 1024, kvalid, true, wsm + W_G2 + (size_t)run * 32 * 192 + kt * 64, 192, tile);
    }
}
constexpr int CV_MOE_UNITS = 16 * (1024 + 512);
DI void cvt_moe_unit(const Params& p, int layer, int u, float* tile) {
    bf16_t* w13 = (bf16_t*)(p.ws + OFF_MOEW);
    bf16_t* w2t = w13 + (size_t)16 * 2048 * 1024;
    const int e = u / 1536, v = u % 1536;
    const size_t eo = (size_t)(layer * 16 + e) * 1024 * 1024;
    if (v < 1024) {
        const int run = v >> 4, kt = v & 15, g = run >> 1;
        const float* src = ((run & 1) ? p.moe_w3 : p.moe_w1) + eo;
        cvt_tile(src + (size_t)kt * 64 * 1024 + g * 32, 1024, 64, true, w13 + (size_t)e * 2048 * 1024 + (size_t)run * 32 * 1024 + kt * 64, 1024, tile);
    } else {
        const int w = v - 1024, run = w >> 4, kt = w & 15;
        cvt_tile(p.moe_w2 + eo + (size_t)kt * 64 * 1024 + run * 32, 1024, 64, true, w2t + (size_t)e * 1024 * 1024 + (size_t)run * 32 * 1024 + kt * 64, 1024, tile);
    }
}
DI void adaln_unit(const Params& p, int u, float* sm) {
    const int l = u / 96, n0 = (u % 96) * 64, t = threadIdx.x;
    float* sv = sm;
    float* red = sm + 3 * 1024;
    for (int i = t; i < 3 * 1024; i += NTH) { const int w = i >> 10, k = i & 1023; const float c = w < 2 ? p.c[w * 1024 + k] : p.c_ctx[k]; sv[i] = siluf_(c); }
    __syncthreads();
    const int kg = t >> 4, cl = t & 15;
    f32x4 a0 = {0, 0, 0, 0}, a1 = a0, a2 = a0;
    const float* W = p.ada_w + (size_t)l * 1024 * 6144 + n0 + cl * 4;
#pragma unroll 8
    for (int i = 0; i < 32; ++i) {
        const int k = kg + 32 * i;
        const f32x4 w = *(const f32x4*)(W + (size_t)k * 6144);
        a0 += w * sv[k]; a1 += w * sv[1024 + k]; a2 += w * sv[2048 + k];
    }
#pragma unroll
    for (int j = 0; j < 4; ++j) { red[kg * 192 + 0 * 64 + cl * 4 + j] = a0[j]; red[kg * 192 + 1 * 64 + cl * 4 + j] = a1[j]; red[kg * 192 + 2 * 64 + cl * 4 + j] = a2[j]; }
    __syncthreads();
    if (t < 192) {
        float s = 0.f;
        for (int g = 0; g < 32; ++g) s += red[g * 192 + t];
        const int w = t >> 6, n = n0 + (t & 63);
        ((float*)(p.ws + OFF_MOD))[(size_t)(l * 3 + w) * 6144 + n] = s + p.ada_b[l * 6144 + n];
    }
    __syncthreads();
}
DI void rope_unit(const Params& p, int u) {
    const int id = u * NTH + threadIdx.x;
    if (id < 320 * 16) {
        const int pi = id >> 4, f = id & 15;
        const float inv = exp2f(-(float)f * (13.287712379549449f / 16.0f));
        const float val = pi < 256 ? (float)pi : (float)(pi - 256);
        const float ang = val * inv;
        const double a = (double)ang;
        const double k = __builtin_rint(a * 0.15915494309189535);
        const float r = (float)(a - k * 6.283185307179586);
        f32x2 cs = {__cosf(r), __sinf(r)};
        ((f32x2*)(p.ws + OFF_ROPE))[id] = cs;
    }
}
DI void phase_prologue(const Params& p, char* smem) {
    float* sm = (float*)smem;
    const int nconv = CV_SMALL_UNITS + CV_MOE_UNITS;
    const int total = nconv + 192 + 10;
    for (int u = blockIdx.x; u < total; u += gridDim.x) {
        if (u < CV_SMALL_UNITS) cvt_small_unit(p, u, sm);
        else if (u < nconv) cvt_moe_unit(p, 0, u - CV_SMALL_UNITS, sm);
        else if (u < nconv + 192) adaln_unit(p, u - nconv, sm);
        else rope_unit(p, u - nconv - 192);
    }
}

DI void row_load(const float* src, f32x4 (&v)[4], int lane) {
#pragma unroll
    for (int i = 0; i < 4; ++i) v[i] = ((const f32x4*)src)[lane + 64 * i];
}
DI float row_rstd(const f32x4 (&v)[4]) {
    float ss = 0.f;
#pragma unroll
    for (int i = 0; i < 4; ++i) ss += v[i][0] * v[i][0] + v[i][1] * v[i][1] + v[i][2] * v[i][2] + v[i][3] * v[i][3];
    ss = wave_sum(ss);
    return rsqrtf(ss * (1.0f / DM) + RMS_EPS);
}
DI void row_norm_mod(const f32x4 (&v)[4], float rstd, const float* g, const float* shift, const float* scale, f32x4 (&h)[4], int lane) {
#pragma unroll
    for (int i = 0; i < 4; ++i) {
        const int c = (lane + 64 * i) * 4;
        const f32x4 g4 = *(const f32x4*)(g + c), sh = *(const f32x4*)(shift + c), sc = *(const f32x4*)(scale + c);
        h[i] = (v[i] * rstd * g4) * (1.0f + sc) + sh;
    }
}
DI void row_store_bf16(bf16_t* dst, const f32x4 (&h)[4], int lane) {
#pragma unroll
    for (int i = 0; i < 4; ++i) { u32x2 w; w[0] = pk_bf16(h[i][0], h[i][1]); w[1] = pk_bf16(h[i][2], h[i][3]); *(u32x2*)(dst + (lane + 64 * i) * 4) = w; }
}
DI void row_load_bf16(const bf16_t* src, f32x4 (&v)[4], int lane) {
#pragma unroll
    for (int i = 0; i < 4; ++i) { const u32x2 w = *(const u32x2*)(src + (lane + 64 * i) * 4); v[i][0] = bf_lo(w[0]); v[i][1] = bf_hi(w[0]); v[i][2] = bf_lo(w[1]); v[i][3] = bf_hi(w[1]); }
}

DI void phase_norm0(const Params& p) {
    const int lane = threadIdx.x & 63, gw = blockIdx.x * NWAVE + (threadIdx.x >> 6), nw = gridDim.x * NWAVE;
    bf16_t* H = (bf16_t*)(p.ws + OFF_H);
    for (int tok = gw; tok < TTOT; tok += nw) {
        f32x4 v[4], h[4];
        row_load(xin_ptr(p, tok), v, lane);
        const float rstd = row_rstd(v);
        row_norm_mod(v, rstd, p.norm_mix_g, mod_ptr(p, 0, tok, 0), mod_ptr(p, 0, tok, 1), h, lane);
        row_store_bf16(H + (size_t)tok * DM, h, lane);
    }
}

DI void route_row(const Params& p, int layer, int tok, const float (&lg)[16], int lane) {
    float mx = lg[0];
#pragma unroll
    for (int e = 1; e < 16; ++e) mx = fmaxf(mx, lg[e]);
    float pr[16], sum = 0.f;
#pragma unroll
    for (int e = 0; e < 16; ++e) { pr[e] = __expf(lg[e] - mx); sum += pr[e]; }
    const float inv = 1.0f / sum;
    float sel[16];
#pragma unroll
    for (int e = 0; e < 16; ++e) { pr[e] *= inv; sel[e] = pr[e] + p.router_bias[e]; }
    float best = -1e30f; int gi = 0;
#pragma unroll
    for (int g = 0; g < 4; ++g) {
        float m1 = -1e30f, m2 = -1e30f;
#pragma unroll
        for (int j = 0; j < 4; ++j) { const float s = sel[g * 4 + j]; if (s > m1) { m2 = m1; m1 = s; } else if (s > m2) m2 = s; }
        const float gs = m1 + m2;
        if (gs > best) { best = gs; gi = g; }
    }
    float s4[4], p4[4];
#pragma unroll
    for (int j = 0; j < 4; ++j) {
        s4[j] = gi == 0 ? sel[j] : gi == 1 ? sel[4 + j] : gi == 2 ? sel[8 + j] : sel[12 + j];
        p4[j] = gi == 0 ? pr[j] : gi == 1 ? pr[4 + j] : gi == 2 ? pr[8 + j] : pr[12 + j];
    }
    int i1 = 0; float b1 = s4[0];
#pragma unroll
    for (int j = 1; j < 4; ++j) if (s4[j] > b1) { b1 = s4[j]; i1 = j; }
    int i2 = i1 == 0 ? 1 : 0; float b2 = -3e38f;
#pragma unroll
    for (int j = 0; j < 4; ++j) if (j != i1 && s4[j] > b2) { b2 = s4[j]; i2 = j; }
    const float w1 = i1 == 0 ? p4[0] : i1 == 1 ? p4[1] : i1 == 2 ? p4[2] : p4[3];
    const float w2 = i2 == 0 ? p4[0] : i2 == 1 ? p4[1] : i2 == 2 ? p4[2] : p4[3];
    const float ws = 1.0f / (w1 + w2);
    if (lane == 0) {
        int* cnt = (int*)(p.ws + OFF_CNT) + layer * 16;
        int* stok = (int*)(p.ws + OFF_STOK);
        float* sw = (float*)(p.ws + OFF_SW);
        const int e1 = gi * 4 + i1, e2 = gi * 4 + i2;
        const int r1 = atomicAdd(&cnt[e1], 1), r2 = atomicAdd(&cnt[e2], 1);
        stok[(size_t)e1 * CAP + r1] = tok * 2 + 0; sw[(size_t)e1 * CAP + r1] = w1 * ws;
        stok[(size_t)e2 * CAP + r2] = tok * 2 + 1; sw[(size_t)e2 * CAP + r2] = w2 * ws;
    }
}
DI void phase_ffn_norm_route(const Params& p, int layer, char* smem) {
    const int lane = threadIdx.x & 63, gw = blockIdx.x * NWAVE + (threadIdx.x >> 6), nw = gridDim.x * NWAVE;
    float* rw = (float*)smem;
    for (int i = threadIdx.x; i < 1024 * 16; i += NTH) rw[(i & 15) * 1024 + (i >> 4)] = p.router_w[i];
    __syncthreads();
    bf16_t* H = (bf16_t*)(p.ws + OFF_H);
    for (int tok = gw; tok < TTOT; tok += nw) {
        const int pos = tok >= PTOT ? tok - PTOT : tok;
        if (layer == 1 && pos < LCTX) continue;
        f32x4 v[4], h[4];
        row_load(xrow_ptr(p, tok), v, lane);
        const float rstd = row_rstd(v);
        row_norm_mod(v, rstd, p.norm_ffn_g + layer * DM, mod_ptr(p, layer, tok, 3), mod_ptr(p, layer, tok, 4), h, lane);
        row_store_bf16(H + (size_t)tok * DM, h, lane);
        float lg[16];
#pragma unroll
        for (int e = 0; e < 16; ++e) lg[e] = 0.f;
#pragma unroll
        for (int i = 0; i < 4; ++i)
#pragma unroll
            for (int e = 0; e < 16; ++e) {
                const f32x4 w = *(const f32x4*)(rw + e * 1024 + (lane + 64 * i) * 4);
                lg[e] += h[i][0] * w[0] + h[i][1] * w[1] + h[i][2] * w[2] + h[i][3] * w[3];
                if ((e & 3) == 3) asm volatile("" ::: "memory");
            }
#pragma unroll
        for (int e = 0; e < 16; ++e) lg[e] = wave_sum(lg[e]);
        route_row(p, layer, tok, lg, lane);
    }
    __syncthreads();
}

DI void combine_row(const Params& p, int layer, int tok, f32x4 (&v)[4], int lane) {
    const bf16_t* Y = (const bf16_t*)(p.ws + OFF_SCR + S_Y) + (size_t)tok * 2 * DM;
    const float* g5 = mod_ptr(p, layer, tok, 5);
    f32x4 y0[4], y1[4];
    row_load(xrow_ptr(p, tok), v, lane);
    row_load_bf16(Y, y0, lane); row_load_bf16(Y + DM, y1, lane);
#pragma unroll
    for (int i = 0; i < 4; ++i) { const f32x4 g = *(const f32x4*)(g5 + (lane + 64 * i) * 4); v[i] += g * (y0[i] + y1[i]); }
}
DI void phase_combine_l0(const Params& p, char* smem) {
    const int lane = threadIdx.x & 63, gw = blockIdx.x * NWAVE + (threadIdx.x >> 6), nw = gridDim.x * NWAVE;
    bf16_t* H = (bf16_t*)(p.ws + OFF_H);
    for (int tok = gw; tok < TTOT; tok += nw) {
        f32x4 v[4], h[4];
        combine_row(p, 0, tok, v, lane);
        float* X = xrow_ptr(p, tok);
#pragma unroll
        for (int i = 0; i < 4; ++i) ((f32x4*)X)[lane + 64 * i] = v[i];
        const float rstd = row_rstd(v);
        row_norm_mod(v, rstd, p.norm_mix_g + DM, mod_ptr(p, 1, tok, 0), mod_ptr(p, 1, tok, 1), h, lane);
        row_store_bf16(H + (size_t)tok * DM, h, lane);
    }
    __syncthreads();
    for (int u = blockIdx.x; u < CV_MOE_UNITS; u += gridDim.x) cvt_moe_unit(p, 1, u, (float*)smem);
}
DI void phase_xx(const Params& p) {
    const int lane = threadIdx.x & 63, gw = blockIdx.x * NWAVE + (threadIdx.x >> 6), nw = gridDim.x * NWAVE;
    const bf16_t* H = (const bf16_t*)(p.ws + OFF_H);
    bf16_t* XX = (bf16_t*)(p.ws + OFF_SCR + S_XX);
    for (int tok = gw; tok < TTOT; tok += nw) {
        const int pos = tok >= PTOT ? tok - PTOT : tok;
        const bool first = pos == 0 || pos == LCTX, last = pos == LCTX - 1 || pos == PTOT - 1;
        f32x4 hc[4], hp[4], hn[4], xx[4];
        row_load_bf16(H + (size_t)tok * DM, hc, lane);
        row_load_bf16(H + (size_t)(first ? tok : tok - 1) * DM, hp, lane);
        row_load_bf16(H + (size_t)(last ? tok : tok + 1) * DM, hn, lane);
#pragma unroll
        for (int i = 0; i < 4; ++i) {
            const f32x4 a = first ? (f32x4){0, 0, 0, 0} : hp[i], b = last ? (f32x4){0, 0, 0, 0} : hn[i];
            xx[i] = 0.5f * (a + b) - hc[i];
        }
        row_store_bf16(XX + (size_t)tok * DM, xx, lane);
    }
}
DI void phase_final(const Params& p) {
    const int lane = threadIdx.x & 63, gw = blockIdx.x * NWAVE + (threadIdx.x >> 6), nw = gridDim.x * NWAVE;
    for (int r = gw; r < NBATCH * SEQ; r += nw) {
        const int b = r / SEQ, tok = b * PTOT + LCTX + (r - b * SEQ);
        f32x4 v[4];
        combine_row(p, 1, tok, v, lane);
        const float rstd = row_rstd(v);
        float* O = p.out + (size_t)r * DM;
#pragma unroll
        for (int i = 0; i < 4; ++i) { const f32x4 g = *(const f32x4*)(p.final_norm_g + (lane + 64 * i) * 4); ((f32x4*)O)[lane + 64 * i] = v[i] * rstd * g; }
    }
}

constexpr int LDSROW = 72;
constexpr int GEMM_SMEM = 2 * (256 + 128) * LDSROW * 2;
template <class AL, class EPI>
DI void gemm_tile(AL& al, const bf16_t* __restrict__ Bt, int ldb, int nk, EPI& epi, char* smem) {
    const int t = threadIdx.x, lane = t & 63, wid = t >> 6, wr = wid >> 1, wc = wid & 1, fr = lane & 15, fq = lane >> 4;
    bf16_t* sA = (bf16_t*)smem;
    bf16_t* sB = sA + 2 * 256 * LDSROW;
    f32x4 acc[4][4];
#pragma unroll
    for (int m = 0; m < 4; ++m)
#pragma unroll
        for (int n = 0; n < 4; ++n) acc[m][n] = (f32x4){0.f, 0.f, 0.f, 0.f};
    const int lr = t >> 3, lc = (t & 7) * 8;
    u32x4 ra[4], rb[2];
#pragma unroll
    for (int i = 0; i < 4; ++i) ra[i] = al.load(lr + 64 * i, lc, i);
#pragma unroll
    for (int i = 0; i < 2; ++i) rb[i] = *(const u32x4*)(Bt + (size_t)(lr + 64 * i) * ldb + lc);
#pragma unroll
    for (int i = 0; i < 4; ++i) *(u32x4*)(sA + (lr + 64 * i) * LDSROW + lc) = ra[i];
#pragma unroll
    for (int i = 0; i < 2; ++i) *(u32x4*)(sB + (lr + 64 * i) * LDSROW + lc) = rb[i];
    __syncthreads();
    for (int kt = 0; kt < nk; ++kt) {
        const int cur = kt & 1;
        const bool more = kt + 1 < nk;
        if (more) {
#pragma unroll
            for (int i = 0; i < 4; ++i) ra[i] = al.load(lr + 64 * i, (kt + 1) * 64 + lc, i);
#pragma unroll
            for (int i = 0; i < 2; ++i) rb[i] = *(const u32x4*)(Bt + (size_t)(lr + 64 * i) * ldb + (kt + 1) * 64 + lc);
        }
        const bf16_t* cA = sA + cur * 256 * LDSROW + (wr * 64 + fr) * LDSROW + fq * 8;
        const bf16_t* cB = sB + cur * 128 * LDSROW + (wc * 64 + fr) * LDSROW + fq * 8;
#pragma unroll
        for (int kk = 0; kk < 2; ++kk) {
            bf16x8 af[4], bfr[4];
#pragma unroll
            for (int m = 0; m < 4; ++m) af[m] = *(const bf16x8*)(cA + m * 16 * LDSROW + kk * 32);
#pragma unroll
            for (int n = 0; n < 4; ++n) bfr[n] = *(const bf16x8*)(cB + n * 16 * LDSROW + kk * 32);
#pragma unroll
            for (int m = 0; m < 4; ++m)
#pragma unroll
                for (int n = 0; n < 4; ++n) acc[m][n] = __builtin_amdgcn_mfma_f32_16x16x32_bf16(bfr[n], af[m], acc[m][n], 0, 0, 0);
        }
        if (more) {
            bf16_t* nA = sA + (cur ^ 1) * 256 * LDSROW;
            bf16_t* nB = sB + (cur ^ 1) * 128 * LDSROW;
#pragma unroll
            for (int i = 0; i < 4; ++i) *(u32x4*)(nA + (lr + 64 * i) * LDSROW + lc) = ra[i];
#pragma unroll
            for (int i = 0; i < 2; ++i) *(u32x4*)(nB + (lr + 64 * i) * LDSROW + lc) = rb[i];
        }
        __syncthreads();
    }
    epi(acc, wr * 64, wc * 64, fr, fq);
}
struct ALPlain {
    const bf16_t* A; int lda;
    DI u32x4 load(int r, int k, int) const { return *(const u32x4*)(A + (size_t)r * lda + k); }
};
struct ALGather {
    const bf16_t* rowp[4];
    DI u32x4 load(int, int k, int i) const { return *(const u32x4*)(rowp[i] + k); }
};
struct ALMix {
    const bf16_t* H; const bf16_t* XX; const float* xm;
    DI u32x4 load(int r, int k, int) const {
        const u32x4 h = *(const u32x4*)(H + (size_t)r * DM + k), x = *(const u32x4*)(XX + (size_t)r * DM + k);
        const f32x4 m0 = *(const f32x4*)(xm + k), m1 = *(const f32x4*)(xm + k + 4);
        u32x4 o;
        o[0] = pk_bf16(bf_lo(h[0]) + bf_lo(x[0]) * m0[0], bf_hi(h[0]) + bf_hi(x[0]) * m0[1]);
        o[1] = pk_bf16(bf_lo(h[1]) + bf_lo(x[1]) * m0[2], bf_hi(h[1]) + bf_hi(x[1]) * m0[3]);
        o[2] = pk_bf16(bf_lo(h[2]) + bf_lo(x[2]) * m1[0], bf_hi(h[2]) + bf_hi(x[2]) * m1[1]);
        o[3] = pk_bf16(bf_lo(h[3]) + bf_lo(x[3]) * m1[2], bf_hi(h[3]) + bf_hi(x[3]) * m1[3]);
        return o;
    }
};

struct EpiQKV {
    const Params* p; int m0, n0;
    DI void operator()(const f32x4 (&acc)[4][4], int rb, int cb, int fr, int fq) const {
        const int hs = (n0 + cb) >> 6;
        const bool isq = hs < 8 || (hs >= 12 && hs < 20), isv = (hs >= 10 && hs < 12) || hs >= 22, normed = hs >= 12 && hs < 22;
        const float* gam = hs < 20 ? p->attn_q_norm_g : p->attn_k_norm_g;
        const f32x2* rope = (const f32x2*)(p->ws + OFF_ROPE);
        bf16_t* Q = (bf16_t*)(p->ws + OFF_SCR + S_Q);
        bf16_t* K = (bf16_t*)(p->ws + OFF_SCR + S_K);
        bf16_t* VT = (bf16_t*)(p->ws + OFF_SCR + S_VT);
#pragma unroll
        for (int m = 0; m < 4; ++m) {
            const int tok = m0 + rb + m * 16 + fr, b = tok >= PTOT ? 1 : 0, pos = tok - b * PTOT;
            f32x4 v[4];
#pragma unroll
            for (int n = 0; n < 4; ++n) v[n] = acc[m][n];
            if (normed) {
                float ss = 0.f;
#pragma unroll
                for (int n = 0; n < 4; ++n) ss += v[n][0] * v[n][0] + v[n][1] * v[n][1] + v[n][2] * v[n][2] + v[n][3] * v[n][3];
                ss += __shfl_xor(ss, 16); ss += __shfl_xor(ss, 32);
                const float rstd = rsqrtf(ss * (1.0f / 64.0f) + RMS_EPS);
#pragma unroll
                for (int n = 0; n < 4; ++n) { const f32x4 g = *(const f32x4*)(gam + n * 16 + fq * 4); v[n] = v[n] * rstd * g; }
            }
            if (!isv && pos >= LCTX) {
                const int t = pos - LCTX, prow = t >> 6, pcol = t & 63;
#pragma unroll
                for (int a = 0; a < 2; ++a) {
                    const f32x2* tb = rope + (a == 0 ? prow : 256 + pcol) * 16 + fq * 4;
#pragma unroll
                    for (int j = 0; j < 4; ++j) {
                        const f32x2 cs = tb[j];
                        const float x0 = v[2 * a][j], x1 = v[2 * a + 1][j];
                        v[2 * a][j] = x0 * cs[0] - x1 * cs[1];
                        v[2 * a + 1][j] = x1 * cs[0] + x0 * cs[1];
                    }
                }
            }
            if (isq) {
                const int hq = hs < 8 ? hs : hs - 4;
                bf16_t* dst = Q + ((size_t)(b * 16 + hq) * PTOT + pos) * 64 + fq * 4;
#pragma unroll
                for (int n = 0; n < 4; ++n) { const f32x4 w = v[n] * (0.125f * LOG2E); u32x2 o; o[0] = pk_bf16(w[0], w[1]); o[1] = pk_bf16(w[2], w[3]); *(u32x2*)(dst + n * 16) = o; }
            } else if (!isv) {
                const int kh = hs < 12 ? hs - 8 : hs - 18;
                bf16_t* dst = K + ((size_t)(b * 4 + kh) * PTOT + pos) * 64 + fq * 4;
#pragma unroll
                for (int n = 0; n < 4; ++n) { u32x2 o; o[0] = pk_bf16(v[n][0], v[n][1]); o[1] = pk_bf16(v[n][2], v[n][3]); *(u32x2*)(dst + n * 16) = o; }
            } else {
                const int vh = hs < 12 ? hs - 10 : hs - 20;
                bf16_t* dst = VT + (size_t)(b * 4 + vh) * 64 * PTOT + pos;
#pragma unroll
                for (int n = 0; n < 4; ++n)
#pragma unroll
                    for (int j = 0; j < 4; ++j) dst[(size_t)(n * 16 + fq * 4 + j) * PTOT] = (bf16_t)(pk_bf16(v[n][j], 0.f) & 0xffffu);
            }
        }
    }
};
DI void phase_qkv(const Params& p, char* smem) {
    const bf16_t* H = (const bf16_t*)(p.ws + OFF_H);
    const bf16_t* W = (const bf16_t*)(p.ws + OFF_WS) + W_IN;
    constexpr int NT = QKV_N / 128, MT = TTOT / 256;
    for (int u = blockIdx.x; u < MT * NT; u += gridDim.x) {
        const int mt = u / NT, nt = u % NT;
        ALPlain al{H + (size_t)mt * 256 * DM, DM};
        EpiQKV epi{&p, mt * 256, nt * 128};
        gemm_tile(al, W + (size_t)nt * 128 * DM, DM, DM / 64, epi, smem);
    }
}

struct EpiResid {
    const Params* p; int m0, n0, layer; bool from_input;
    DI void operator()(const f32x4 (&acc)[4][4], int rb, int cb, int fr, int fq) const {
#pragma unroll
        for (int m = 0; m < 4; ++m) {
            const int tok = m0 + rb + m * 16 + fr;
            const float* xin = from_input ? xin_ptr(*p, tok) : xrow_ptr(*p, tok);
            float* xo = xrow_ptr(*p, tok);
            const float* gate = mod_ptr(*p, layer, tok, 2);
#pragma unroll
            for (int n = 0; n < 4; ++n) {
                const int c = n0 + cb + n * 16 + fq * 4;
                const f32x4 xi = *(const f32x4*)(xin + c), g = *(const f32x4*)(gate + c);
                *(f32x4*)(xo + c) = xi + g * acc[m][n];
            }
        }
    }
};
DI void phase_wout(const Params& p, char* smem) {
    const bf16_t* O = (const bf16_t*)(p.ws + OFF_SCR + S_O);
    const bf16_t* W = (const bf16_t*)(p.ws + OFF_WS) + W_OUT;
    constexpr int NT = 8, MT = TTOT / 256;
    for (int u = blockIdx.x; u < MT * NT; u += gridDim.x) {
        const int mt = u / NT, nt = u % NT;
        ALPlain al{O + (size_t)mt * 256 * DM, DM};
        EpiResid epi{&p, mt * 256, nt * 128, 0, true};
        gemm_tile(al, W + (size_t)nt * 128 * DM, DM, DM / 64, epi, smem);
    }
}
DI void phase_wo(const Params& p, char* smem) {
    const bf16_t* O = (const bf16_t*)(p.ws + OFF_SCR + S_OR);
    const bf16_t* W = (const bf16_t*)(p.ws + OFF_WS) + W_O;
    constexpr int NT = 8, MTL = SEQ / 256;
    for (int u = blockIdx.x; u < NBATCH * MTL * NT; u += gridDim.x) {
        const int mi = u / NT, nt = u % NT, b = mi / MTL, mt = b * (PTOT / 256) + 1 + (mi % MTL);
        ALPlain al{O + (size_t)mt * 256 * DM, DM};
        EpiResid epi{&p, mt * 256, nt * 128, 1, false};
        gemm_tile(al, W + (size_t)nt * 128 * DM, DM, DM / 64, epi, smem);
    }
}

struct MoeSched { int nt[16], base[17]; };
DI void moe_sched(const Params& p, int layer, MoeSched& s, int (&cnt)[16]) {
    const int* c = (const int*)(p.ws + OFF_CNT) + layer * 16;
    int acc = 0;
#pragma unroll
    for (int e = 0; e < 16; ++e) { cnt[e] = c[e]; s.nt[e] = (cnt[e] + 255) >> 8; s.base[e] = acc; acc += s.nt[e]; }
    s.base[16] = acc;
}
struct EpiMoe1 {
    bf16_t* hid;   int n0;
    DI void operator()(const f32x4 (&acc)[4][4], int rb, int cb, int fr, int fq) const {
        const int g = (n0 + cb) >> 6;
#pragma unroll
        for (int m = 0; m < 4; ++m) {
            bf16_t* dst = hid + (size_t)(rb + m * 16 + fr) * 1024 + g * 32 + fq * 4;
#pragma unroll
            for (int n = 0; n < 2; ++n) {
                const f32x4 a = acc[m][n], b = acc[m][n + 2];
                u32x2 o;
                o[0] = pk_bf16(siluf_(a[0]) * b[0], siluf_(a[1]) * b[1]);
                o[1] = pk_bf16(siluf_(a[2]) * b[2], siluf_(a[3]) * b[3]);
                *(u32x2*)(dst + n * 16) = o;
            }
        }
    }
};
DI void phase_moe1(const Params& p, int layer, char* smem) {
    MoeSched s; int cnt[16];
    moe_sched(p, layer, s, cnt);
    const bf16_t* H = (const bf16_t*)(p.ws + OFF_H);
    const bf16_t* W13 = (const bf16_t*)(p.ws + OFF_MOEW);
    const int* stok = (const int*)(p.ws + OFF_STOK);
    bf16_t* hid = (bf16_t*)(p.ws + OFF_SCR + S_HID);
    constexpr int NT = 16;
    const int total = s.base[16] * NT;
    const int lr = threadIdx.x >> 3;
    for (int u = blockIdx.x; u < total; u += gridDim.x) {
        const int mg = u / NT, nt = u % NT;
        int e = 0;
#pragma unroll
        for (int i = 1; i < 16; ++i) if (mg >= s.base[i]) e = i;
        int ce = 0;
#pragma unroll
        for (int i = 0; i < 16; ++i) if (i == e) ce = cnt[i];
        int be = 0;
#pragma unroll
        for (int i = 0; i < 16; ++i) if (i == e) be = s.base[i];
        const int ml = mg - be;
        ALGather al;
#pragma unroll
        for (int i = 0; i < 4; ++i) {
            const int r = ml * 256 + lr + 64 * i;
            const int tk = r < ce ? (stok[(size_t)e * CAP + r] >> 1) : 0;
            al.rowp[i] = H + (size_t)tk * DM;
        }
        EpiMoe1 epi{hid + (size_t)mg * 256 * 1024, nt * 128};
        gemm_tile(al, W13 + (size_t)e * 2048 * 1024 + (size_t)nt * 128 * 1024, 1024, 16, epi, smem);
    }
}
struct EpiMoe2 {
    bf16_t* Y; const int* stok; const float* sw; int nvalid, n0;
    DI void operator()(const f32x4 (&acc)[4][4], int rb, int cb, int fr, int fq) const {
#pragma unroll
        for (int m = 0; m < 4; ++m) {
            const int r = rb + m * 16 + fr;
            if (r < nvalid) {
                const int tk = stok[r]; const float w = sw[r];
                bf16_t* dst = Y + (size_t)tk * 1024 + n0 + cb + fq * 4;
#pragma unroll
                for (int n = 0; n < 4; ++n) { const f32x4 a = acc[m][n] * w; u32x2 o; o[0] = pk_bf16(a[0], a[1]); o[1] = pk_bf16(a[2], a[3]); *(u32x2*)(dst + n * 16) = o; }
            }
        }
    }
};
DI void phase_moe2(const Params& p, int layer, char* smem) {
    MoeSched s; int cnt[16];
    moe_sched(p, layer, s, cnt);
    const bf16_t* hid = (const bf16_t*)(p.ws + OFF_SCR + S_HID);
    const bf16_t* W2 = (const bf16_t*)(p.ws + OFF_MOEW) + (size_t)16 * 2048 * 1024;
    const int* stok = (const int*)(p.ws + OFF_STOK);
    const float* sw = (const float*)(p.ws + OFF_SW);
    bf16_t* Y = (bf16_t*)(p.ws + OFF_SCR + S_Y);
    constexpr int NT = 8;
    const int total = s.base[16] * NT;
    for (int u = blockIdx.x; u < total; u += gridDim.x) {
        const int mg = u / NT, nt = u % NT;
        int e = 0;
#pragma unroll
        for (int i = 1; i < 16; ++i) if (mg >= s.base[i]) e = i;
        int ce = 0, be = 0;
#pragma unroll
        for (int i = 0; i < 16; ++i) if (i == e) { ce = cnt[i]; be = s.base[i]; }
        const int ml = mg - be;
        ALPlain al{hid + (size_t)mg * 256 * 1024, 1024};
        EpiMoe2 epi{Y, stok + (size_t)e * CAP + ml * 256, sw + (size_t)e * CAP + ml * 256, ce - ml * 256, nt * 128};
        gemm_tile(al, W2 + (size_t)e * 1024 * 1024 + (size_t)nt * 128 * 1024, 1024, 16, epi, smem);
    }
}

struct EpiRwkv {
    bf16_t* dst; int ld, m0, n0, act, nstore;
    DI void operator()(const f32x4 (&acc)[4][4], int rb, int cb, int fr, int fq) const {
#pragma unroll
        for (int m = 0; m < 4; ++m) {
            bf16_t* d = dst + (size_t)(m0 + rb + m * 16 + fr) * ld + n0 + cb + fq * 4;
#pragma unroll
            for (int n = 0; n < 4; ++n) {
                const int c = n0 + cb + n * 16 + fq * 4;
                if (c >= ld) continue;
                f32x4 a = acc[m][n];
                if (act == 1) {
#pragma unroll
                    for (int j = 0; j < 4; ++j) { const float e = __expf(2.0f * a[j]); a[j] = 1.0f - 2.0f / (e + 1.0f); }
                }
                if (act == 2) {
#pragma unroll
                    for (int j = 0; j < 4; ++j) a[j] = sigmoidf_(a[j]);
                }
                if (c >= nstore) a = (f32x4){0.f, 0.f, 0.f, 0.f};
                u32x2 o; o[0] = pk_bf16(a[0], a[1]); o[1] = pk_bf16(a[2], a[3]);
                *(u32x2*)(d + n * 16) = o;
            }
        }
    }
};
DI void phase_rwkv_proj(const Params& p, char* smem) {
    const bf16_t* H = (const bf16_t*)(p.ws + OFF_H);
    const bf16_t* XX = (const bf16_t*)(p.ws + OFF_SCR + S_XX);
    const bf16_t* wsm = (const bf16_t*)(p.ws + OFF_WS);
    constexpr int MT = TTOT / 256, NTT = 8 + 8 + 8 + 1 + 1 + 2;
    for (int u = blockIdx.x; u < MT * NTT; u += gridDim.x) {
        const int mt = u / NTT, q = u % NTT;
        int job, nt;
        if (q < 8) { job = 0; nt = q; } else if (q < 16) { job = 1; nt = q - 8; } else if (q < 24) { job = 2; nt = q - 16; }
        else if (q == 24) { job = 3; nt = 0; } else if (q == 25) { job = 4; nt = 0; } else { job = 5; nt = q - 26; }
        const int mixj = job == 0 ? 0 : job == 1 ? 2 : job == 2 ? 3 : job == 3 ? 1 : job == 4 ? 4 : 5;
        const size_t wofs = job == 0 ? W_R : job == 1 ? W_K : job == 2 ? W_V : job == 3 ? W_W1 : job == 4 ? W_A1 : W_G1;
        const size_t dofs = job == 0 ? S_R : job == 1 ? S_KK : job == 2 ? S_V : job == 3 ? S_LW : job == 4 ? S_LA : S_LG;
        const int ld = job < 3 ? 1024 : job < 5 ? 128 : 192;
        ALMix al{H + (size_t)mt * 256 * DM, XX + (size_t)mt * 256 * DM, p.rwkv_x_mix + mixj * DM};
        EpiRwkv epi{(bf16_t*)(p.ws + OFF_SCR + dofs), ld, mt * 256, nt * 128, job == 3 ? 1 : job == 5 ? 2 : 0, job == 5 ? 160 : 4096};
        gemm_tile(al, wsm + wofs + (size_t)nt * 128 * DM, DM, DM / 64, epi, smem);
    }
}

struct EpiGate {
    const Params* p; int m0, n0;
    DI void operator()(const f32x4 (&acc)[4][4], int rb, int cb, int fr, int fq) const {
        const bf16_t* Y0 = (const bf16_t*)(p->ws + OFF_H);
        const bf16_t* Y1 = (const bf16_t*)(p->ws + OFF_SCR + S_Y1);
        const bf16_t* V = (const bf16_t*)(p->ws + OFF_SCR + S_V);
        const float* bonus = (const float*)(p->ws + OFF_BONUS2);
        bf16_t* O = (bf16_t*)(p->ws + OFF_SCR + S_OR);
        const int c0 = n0 + cb, hd = c0 >> 6;
#pragma unroll
        for (int m = 0; m < 4; ++m) {
            const int tok = m0 + rb + m * 16 + fr;
            const size_t ro = (size_t)tok * DM + c0 + fq * 4;
            f32x4 y[4];
            float s = 0.f;
#pragma unroll
            for (int n = 0; n < 4; ++n) {
                const u32x2 a = *(const u32x2*)(Y0 + ro + n * 16), b = *(const u32x2*)(Y1 + ro + n * 16);
                y[n][0] = bf_lo(a[0]) + bf_lo(b[0]); y[n][1] = bf_hi(a[0]) + bf_hi(b[0]); y[n][2] = bf_lo(a[1]) + bf_lo(b[1]); y[n][3] = bf_hi(a[1]) + bf_hi(b[1]);
                s += y[n][0] + y[n][1] + y[n][2] + y[n][3];
            }
            s += __shfl_xor(s, 16); s += __shfl_xor(s, 32);
            const float mu = s * (1.0f / 64.0f);
            float q = 0.f;
#pragma unroll
            for (int n = 0; n < 4; ++n) { const f32x4 d = y[n] - mu; q += d[0] * d[0] + d[1] * d[1] + d[2] * d[2] + d[3] * d[3]; }
            q += __shfl_xor(q, 16); q += __shfl_xor(q, 32);
            const float rs = rsqrtf(q * (1.0f / 64.0f) + GN_EPS);
            const float bon = (bonus[(size_t)tok * 16 + hd] + bonus[(size_t)(TTOT + tok) * 16 + hd]) + (bonus[(size_t)(2 * TTOT + tok) * 16 + hd] + bonus[(size_t)(3 * TTOT + tok) * 16 + hd]);
#pragma unroll
            for (int n = 0; n < 4; ++n) {
                const int c = c0 + n * 16 + fq * 4;
                const f32x4 g = *(const f32x4*)(p->rwkv_ln_g + c), bb = *(const f32x4*)(p->rwkv_ln_b + c);
                const u32x2 vv = *(const u32x2*)(V + ro + n * 16);
                const f32x4 v4 = {bf_lo(vv[0]), bf_hi(vv[0]), bf_lo(vv[1]), bf_hi(vv[1])};
                const f32x4 o = ((y[n] - mu) * rs * g + bb + bon * v4) * acc[m][n];
                u32x2 w; w[0] = pk_bf16(o[0], o[1]); w[1] = pk_bf16(o[2], o[3]);
                *(u32x2*)(O + ro + n * 16) = w;
            }
        }
    }
};
DI void phase_gate(const Params& p, char* smem) {
    const bf16_t* LG = (const bf16_t*)(p.ws + OFF_SCR + S_LG);
    const bf16_t* W = (const bf16_t*)(p.ws + OFF_WS) + W_G2;
    constexpr int NT = 8, MT = TTOT / 256;
    for (int u = blockIdx.x; u < MT * NT; u += gridDim.x) {
        const int mt = u / NT, nt = u % NT;
        ALPlain al{LG + (size_t)mt * 256 * 192, 192};
        EpiGate epi{&p, mt * 256, nt * 128};
        gemm_tile(al, W + (size_t)nt * 128 * 192, 192, 3, epi, smem);
    }
}

constexpr int KROW = 72, VROW = 68;
constexpr int ATT_SMEM = 2 * 64 * KROW * 2 + 2 * 64 * VROW * 2;
DI int crow_(int i, int h) { return (i & 3) + 8 * (i >> 2) + 4 * h; }
#define MFMA32(a, b, c) __builtin_amdgcn_mfma_f32_32x32x16_bf16((a), (b), (c), 0, 0, 0)
template <int MODE>
DI void attn_unit(const Params& p, const bf16_t* Qg  , int nq_valid, const bf16_t* Kg  , const bf16_t* Vg  ,
                  int ta0, int ta1, int tb0, int tb1  , bool band, int q_lat0  ,
                  float init_m, float init_l0, bf16_t* Og  , char* smem) {
    const int t = threadIdx.x, lane = t & 63, wid = t >> 6, r = lane & 31, h = lane >> 5;
    bf16_t* sK = (bf16_t*)smem;
    bf16_t* sV = sK + 2 * 64 * KROW;
    const int qi = wid * 32 + r;
    bf16x8 qf[4];
    {
        const bf16_t* qp = Qg + (size_t)(qi < nq_valid ? qi : 0) * 64 + 8 * h;
#pragma unroll
        for (int ks = 0; ks < 4; ++ks) qf[ks] = *(const bf16x8*)(qp + ks * 16);
    }
    f32x16 o0, o1;
#pragma unroll
    for (int i = 0; i < 16; ++i) { o0[i] = 0.f; o1[i] = 0.f; }
    float mrun = init_m, lrun = (MODE == 1 && h == 0) ? init_l0 : 0.f;
    const int ntile = ((ta1 - ta0) + (tb1 - tb0)) >> 6;
    const int lrow = t >> 3, lch = (t & 7) * 8;
    u32x4 rk, rv;
    auto tile_pos = [&](int i) { const int a = (ta1 - ta0) >> 6; return i < a ? ta0 + i * 64 : tb0 + (i - a) * 64; };
    {
        const int kp = tile_pos(0);
        rk = *(const u32x4*)(Kg + (size_t)(kp + lrow) * 64 + lch);
        rv = *(const u32x4*)(Vg + (size_t)lrow * PTOT + kp + lch);
        *(u32x4*)(sK + lrow * KROW + lch) = rk;
        *(u32x2*)(sV + lrow * VROW + lch) = (u32x2){rv[0], rv[1]};
        *(u32x2*)(sV + lrow * VROW + lch + 4) = (u32x2){rv[2], rv[3]};
    }
    __syncthreads();
    for (int it = 0; it < ntile; ++it) {
        const int cur = it & 1;
        const bool more = it + 1 < ntile;
        const int kp = tile_pos(it);
        if (more) {
            const int kn = tile_pos(it + 1);
            rk = *(const u32x4*)(Kg + (size_t)(kn + lrow) * 64 + lch);
            rv = *(const u32x4*)(Vg + (size_t)lrow * PTOT + kn + lch);
        }
        const bf16_t* cK = sK + cur * 64 * KROW;
        const bf16_t* cV = sV + cur * 64 * VROW;
        f32x16 s0, s1;
#pragma unroll
        for (int i = 0; i < 16; ++i) { s0[i] = MODE == 0 ? init_m : 0.f; s1[i] = s0[i]; }
#pragma unroll
        for (int ks = 0; ks < 4; ++ks) {
            const bf16x8 k0 = *(const bf16x8*)(cK + r * KROW + ks * 16 + 8 * h);
            const bf16x8 k1 = *(const bf16x8*)(cK + (32 + r) * KROW + ks * 16 + 8 * h);
            s0 = MFMA32(k0, qf[ks], s0);
            s1 = MFMA32(k1, qf[ks], s1);
        }
        if (MODE == 1) {
            if (band && kp >= LCTX) {
                const int qlat = q_lat0 + qi, kl0 = kp - LCTX;
#pragma unroll
                for (int i = 0; i < 16; ++i) {
                    const int d0 = qlat - (kl0 + crow_(i, h)), d1 = d0 - 32;
                    if (d0 > 128 || d0 < -128) s0[i] = -1e30f;
                    if (d1 > 128 || d1 < -128) s1[i] = -1e30f;
                }
            }
            float mt = s0[0];
#pragma unroll
            for (int i = 1; i < 16; ++i) mt = fmaxf(mt, s0[i]);
#pragma unroll
            for (int i = 0; i < 16; ++i) mt = fmaxf(mt, s1[i]);
            mt = fmaxf(mt, __shfl_xor(mt, 32));
            const float mnew = fmaxf(mrun, mt);
            const float alpha = exp2f(mrun - mnew);
            mrun = mnew; lrun *= alpha;
#pragma unroll
            for (int i = 0; i < 16; ++i) { o0[i] *= alpha; o1[i] *= alpha; }
#pragma unroll
            for (int i = 0; i < 16; ++i) { s0[i] -= mnew; s1[i] -= mnew; }
        }
        float ls = 0.f;
#pragma unroll
        for (int i = 0; i < 16; ++i) { s0[i] = exp2f(s0[i]); s1[i] = exp2f(s1[i]); ls += s0[i] + s1[i]; }
        lrun += ls;
#pragma unroll
        for (int sub = 0; sub < 2; ++sub)
#pragma unroll
            for (int st = 0; st < 2; ++st) {
                u32x4 pw;
#pragma unroll
                for (int j = 0; j < 4; ++j) {
                    const float a = sub == 0 ? s0[8 * st + 2 * j] : s1[8 * st + 2 * j], b = sub == 0 ? s0[8 * st + 2 * j + 1] : s1[8 * st + 2 * j + 1];
                    pw[j] = pk_bf16(a, b);
                }
                const bf16x8 pf = __builtin_bit_cast(bf16x8, pw);
                const int kb = sub * 32 + 16 * st + 4 * h;
#pragma unroll
                for (int dt = 0; dt < 2; ++dt) {
                    const s16x4 lo = *(const s16x4*)(cV + (dt * 32 + r) * VROW + kb), hi = *(const s16x4*)(cV + (dt * 32 + r) * VROW + kb + 8);
                    const bf16x8 vf = __builtin_shufflevector(lo, hi, 0, 1, 2, 3, 4, 5, 6, 7);
                    if (dt == 0) o0 = MFMA32(vf, pf, o0); else o1 = MFMA32(vf, pf, o1);
                }
            }
        if (more) {
            bf16_t* nK = sK + (cur ^ 1) * 64 * KROW;
            bf16_t* nV = sV + (cur ^ 1) * 64 * VROW;
            *(u32x4*)(nK + lrow * KROW + lch) = rk;
            *(u32x2*)(nV + lrow * VROW + lch) = (u32x2){rv[0], rv[1]};
            *(u32x2*)(nV + lrow * VROW + lch + 4) = (u32x2){rv[2], rv[3]};
        }
        __syncthreads();
    }
    lrun += __shfl_xor(lrun, 32);
    const float invl = 1.0f / lrun;
    if (qi < nq_valid) {
        bf16_t* op = Og + (size_t)qi * DM;
#pragma unroll
        for (int g = 0; g < 4; ++g) {
            u32x2 w0, w1;
            w0[0] = pk_bf16(o0[4 * g] * invl, o0[4 * g + 1] * invl); w0[1] = pk_bf16(o0[4 * g + 2] * invl, o0[4 * g + 3] * invl);
            w1[0] = pk_bf16(o1[4 * g] * invl, o1[4 * g + 1] * invl); w1[1] = pk_bf16(o1[4 * g + 2] * invl, o1[4 * g + 3] * invl);
            *(u32x2*)(op + 8 * g + 4 * h) = w0;
            *(u32x2*)(op + 32 + 8 * g + 4 * h) = w1;
        }
    }
}
DI void phase_attn(const Params& p, char* smem) {
    const bf16_t* Q = (const bf16_t*)(p.ws + OFF_SCR + S_Q);
    const bf16_t* K = (const bf16_t*)(p.ws + OFF_SCR + S_K);
    const bf16_t* VT = (const bf16_t*)(p.ws + OFF_SCR + S_VT);
    bf16_t* O = (bf16_t*)(p.ws + OFF_SCR + S_O);
    float gq = 0.f, gk = 0.f;
    for (int i = 0; i < 64; ++i) { gq = fmaxf(gq, fabsf(p.attn_q_norm_g[i])); gk = fmaxf(gk, fabsf(p.attn_k_norm_g[i])); }
    const float M2 = 8.25f * gq * gk * LOG2E;
    constexpr int NQB = SEQ / 256;
    const int G = gridDim.x;
    for (int u = blockIdx.x; u < NBATCH * 8 * NQB; u += G) {
        int combo, within;
        if ((G & 7) == 0 && NBATCH * 8 * NQB % G == 0) {
            const int xcd = blockIdx.x & 7, idx = (blockIdx.x >> 3) + (G >> 3) * (u / G);
            combo = xcd & 3; within = (xcd >> 2) * (NBATCH * 8 * NQB / 8) + idx;
        } else { combo = u / (4 * NQB); within = u % (4 * NQB); }
        const int b = combo >> 1, kvh = combo & 1, hq = kvh * 4 + (within & 3), qb = within >> 2;
        const bf16_t* Qg = Q + ((size_t)(b * 16 + 8 + hq) * PTOT + LCTX + qb * 256) * 64;
        attn_unit<0>(p, Qg, 256, K + (size_t)(b * 4 + 2 + kvh) * PTOT * 64, VT + (size_t)(b * 4 + 2 + kvh) * 64 * PTOT, 0, PTOT, 0, 0, false, 0, -M2, 0.f,
                     O + (size_t)(b * PTOT + LCTX + qb * 256) * DM + (8 + hq) * 64, smem);
    }
    for (int u = blockIdx.x; u < NBATCH * 8 * NQB; u += G) {
        const int b = u / (8 * NQB), rem = u % (8 * NQB), qb = rem >> 3, hq = rem & 7, kvh = hq >> 2;
        const int i0 = qb * 256;
        const int lo = i0 - 128 < 0 ? 0 : i0 - 128, hi = i0 + 384 > SEQ ? SEQ : i0 + 384;
        const bf16_t* Qg = Q + ((size_t)(b * 16 + hq) * PTOT + LCTX + i0) * 64;
        attn_unit<1>(p, Qg, 256, K + (size_t)(b * 4 + kvh) * PTOT * 64, VT + (size_t)(b * 4 + kvh) * 64 * PTOT, 0, LCTX, LCTX + lo, LCTX + hi, true, i0,
                     p.attn_sink[hq] * LOG2E, 1.0f, O + (size_t)(b * PTOT + LCTX + i0) * DM + hq * 64, smem);
    }
    for (int u = blockIdx.x; u < NBATCH * 16; u += G) {
        const int b = u >> 4, hh = u & 15, isb = hh >> 3, hq = hh & 7, kvh = isb * 2 + (hq >> 2);
        const bf16_t* Qg = Q + ((size_t)(b * 16 + hh) * PTOT) * 64;
        attn_unit<1>(p, Qg, 256, K + (size_t)(b * 4 + kvh) * PTOT * 64, VT + (size_t)(b * 4 + kvh) * 64 * PTOT, 0, LCTX, 0, 0, false, 0,
                     isb ? -1e30f : p.attn_sink[hq] * LOG2E, isb ? 0.f : 1.0f, O + (size_t)(b * PTOT) * DM + hh * 64, smem);
    }
}

constexpr int TB = 32, NBUF = 3;
constexpr int SC_REC = 5 * 64;
constexpr int SC_OPS = TB * SC_REC * 4;
constexpr int SC_SMEM = NBUF * SC_OPS + NBUF * TB * 16 * 4 + NBUF * TB * 16 * 4 + 64;
DI int scan_pos(int n, int dir) {
    if (n < LCTX) return dir ? LCTX - 1 - n : n;
    const int m = n - LCTX;
    return LCTX + (dir ? SEQ - 1 - m : m);
}
template <int CTRL> DI float dpp_add(float v) { return v + __builtin_bit_cast(float, __builtin_amdgcn_update_dpp(0, __builtin_bit_cast(int, v), CTRL, 0xf, 0xf, false)); }
DI float row16_sum(float v) { v = dpp_add<0x128>(v); v = dpp_add<0x124>(v); v = dpp_add<0x122>(v); v = dpp_add<0x121>(v); return v; }
DI int lds_min4(int* c) { const volatile LAS int* q = (const volatile LAS int*)c; const int a = q[0], b = q[1], d = q[2], e = q[3]; return min(min(a, b), min(d, e)); }
DI void lds_publish(int* c, int v) { *(volatile LAS int*)c = v; }
DI void scan_unit(const Params& p, int u, char* smem) {
    const int t = threadIdx.x, lane = t & 63, wid = __builtin_amdgcn_readfirstlane(t >> 6);
    const unsigned rg = u & 3, dir = (u >> 2) & 1, hd = (u >> 3) & 15, b = u >> 7;
    float* ops = (float*)smem;
    float* vbuf = (float*)(smem + NBUF * SC_OPS);
    float* ybuf = vbuf + NBUF * TB * 16;
    int* cnts = (int*)(ybuf + NBUF * TB * 16);
    const bf16_t* R = (const bf16_t*)(p.ws + OFF_SCR + S_R);
    const bf16_t* Kk = (const bf16_t*)(p.ws + OFF_SCR + S_KK);
    const bf16_t* V = (const bf16_t*)(p.ws + OFF_SCR + S_V);
    const bf16_t* LW = (const bf16_t*)(p.ws + OFF_SCR + S_LW);
    const bf16_t* LA = (const bf16_t*)(p.ws + OFF_SCR + S_LA);
    bf16_t* Yo = dir ? (bf16_t*)(p.ws + OFF_SCR + S_Y1) : (bf16_t*)(p.ws + OFF_H);
    float* bonus = (float*)(p.ws + OFF_BONUS2);
    const unsigned tokb = b * PTOT, hc = hd * 64;
    constexpr int NBLK = PTOT / TB;
    const unsigned fr = lane & 15, fq = lane >> 4;
    if (t < 8) cnts[t] = 0;
    __syncthreads();

    if (wid < 4) {
        __builtin_amdgcn_s_setprio(3);
        float s0 = 0.f, s1 = 0.f, s2 = 0.f, s3 = 0.f;
        const unsigned g = lane >> 4, c4 = (lane & 15) * 4, myrow = wid * 4 + g;
        for (int blk = 0; blk < NBLK; ++blk) {
            const unsigned buf = (unsigned)blk % NBUF;
            while (lds_min4(cnts) < blk + 1) __builtin_amdgcn_s_sleep(1);
            asm volatile("" ::: "memory");
            const float* rec = ops + buf * (TB * SC_REC) + c4;
            const float* vb = vbuf + buf * (TB * 16) + myrow;
            float* yb = ybuf + buf * (TB * 16) + myrow;
            f32x4 w0_ = *(const f32x4*)(rec), kd0_ = *(const f32x4*)(rec + 64), bb0_ = *(const f32x4*)(rec + 128), aa0_ = *(const f32x4*)(rec + 192), rr0_ = *(const f32x4*)(rec + 256);
            float vv0_ = vb[0];
#define SCAN_STEP(W, KD, BB, AA, RR, VV, ST) { \
                float sa = s0 * AA[0] + s1 * AA[1] + s2 * AA[2] + s3 * AA[3]; \
                sa = row16_sum(sa); \
                s0 = s0 * W[0] + sa * BB[0] + VV * KD[0]; \
                s1 = s1 * W[1] + sa * BB[1] + VV * KD[1]; \
                s2 = s2 * W[2] + sa * BB[2] + VV * KD[2]; \
                s3 = s3 * W[3] + sa * BB[3] + VV * KD[3]; \
                float y = s0 * RR[0] + s1 * RR[1] + s2 * RR[2] + s3 * RR[3]; \
                y = row16_sum(y); \
                if ((lane & 15) == 0) yb[(ST) * 16] = y; }
#pragma unroll 1
            for (int st = 0; st < TB; st += 2) {
                const float* r1 = rec + (st + 1) * SC_REC;
                const f32x4 w1_ = *(const f32x4*)(r1), kd1_ = *(const f32x4*)(r1 + 64), bb1_ = *(const f32x4*)(r1 + 128), aa1_ = *(const f32x4*)(r1 + 192), rr1_ = *(const f32x4*)(r1 + 256);
                const float vv1_ = vb[(st + 1) * 16];
                SCAN_STEP(w0_, kd0_, bb0_, aa0_, rr0_, vv0_, st)
                const int st2 = st + 2 < TB ? st + 2 : st;
                const float* r2 = rec + st2 * SC_REC;
                w0_ = *(const f32x4*)(r2); kd0_ = *(const f32x4*)(r2 + 64); bb0_ = *(const f32x4*)(r2 + 128); aa0_ = *(const f32x4*)(r2 + 192); rr0_ = *(const f32x4*)(r2 + 256);
                vv0_ = vb[st2 * 16];
                SCAN_STEP(w1_, kd1_, bb1_, aa1_, rr1_, vv1_, st + 1)
            }
#undef SCAN_STEP
            asm volatile("s_waitcnt lgkmcnt(0)" ::: "memory");
            if (lane == 0) lds_publish(cnts + 4 + wid, blk + 1);
        }
        __builtin_amdgcn_s_setprio(0);
    } else {
        const unsigned wt = wid & 1, chh = (wid >> 1) & 1;
        const bf16_t* wsm = (const bf16_t*)(p.ws + OFF_WS);
        const unsigned wo = W_W2 + dir * 65536u + (hc + fr) * 64u + fq * 8u;
        const unsigned ao = W_A2 + dir * 65536u + (hc + fr) * 64u + fq * 8u;
        const unsigned po = hc + fq * 4u;
        for (int blk = 0; blk < NBLK + NBUF; ++blk) {
            const unsigned buf = (unsigned)blk % NBUF;
            const int need = blk - NBUF + 1 < NBLK ? blk - NBUF + 1 : NBLK;
            while (lds_min4(cnts + 4) < need) __builtin_amdgcn_s_sleep(1);
            asm volatile("" ::: "memory");
            if (wid == 7 && blk >= NBUF) {
#pragma unroll
                for (int i = 0; i < TB * 16 / 64; ++i) {
                    const unsigned id = i * 64 + lane, st = id >> 4, rw = id & 15;
                    const unsigned tok = tokb + scan_pos((blk - NBUF) * TB + st, dir);
                    Yo[tok * 1024u + hc + rg * 16 + rw] = (bf16_t)(pk_bf16(ybuf[buf * (TB * 16) + id], 0.f) & 0xffffu);
                }
            }
            if (blk >= NBLK) continue;
            const unsigned st = wt * 16 + fr;
            const unsigned tok = tokb + scan_pos(blk * TB + st, dir);
            const unsigned lo = tok * 128u + dir * 64u + fq * 8u;
            const unsigned ro = tok * 1024u + hc + fq * 4u;
            bf16x8 lwf[2], laf[2];
#pragma unroll
            for (int kk = 0; kk < 2; ++kk) { lwf[kk] = *(const bf16x8*)(LW + lo + kk * 32); laf[kk] = *(const bf16x8*)(LA + lo + kk * 32); }
            float ssq = 0.f;
#pragma unroll
            for (int nt = 0; nt < 4; ++nt) {
                const f32x4 kkv = *(const f32x4*)(p.rwkv_k_k + po + nt * 16);
                const u32x2 c = *(const u32x2*)(Kk + ro + nt * 16);
                const float q0 = bf_lo(c[0]) * kkv[0], q1 = bf_hi(c[0]) * kkv[1], q2 = bf_lo(c[1]) * kkv[2], q3 = bf_hi(c[1]) * kkv[3];
                ssq += q0 * q0 + q1 * q1 + q2 * q2 + q3 * q3;
            }
            ssq += __shfl_xor(ssq, 16); ssq += __shfl_xor(ssq, 32);
            const float kn = __builtin_amdgcn_rsqf(fmaxf(ssq, 1e-24f));
            float* rec = ops + buf * (TB * SC_REC) + st * SC_REC + fq * 4;
            float bsum = 0.f;
#pragma unroll
            for (int n2 = 0; n2 < 2; ++n2) {
                const unsigned nt = chh * 2 + n2;
                f32x4 aw = {0.f, 0.f, 0.f, 0.f}, ai = aw;
#pragma unroll
                for (int kk = 0; kk < 2; ++kk) {
                    const bf16x8 w2f = *(const bf16x8*)(wsm + wo + nt * 1024 + kk * 32), a2f = *(const bf16x8*)(wsm + ao + nt * 1024 + kk * 32);
                    aw = __builtin_amdgcn_mfma_f32_16x16x32_bf16(w2f, lwf[kk], aw, 0, 0, 0);
                    ai = __builtin_amdgcn_mfma_f32_16x16x32_bf16(a2f, laf[kk], ai, 0, 0, 0);
                }
                const f32x4 w0v = *(const f32x4*)(p.rwkv_decay_w0 + dir * 1024u + po + nt * 16), a0v = *(const f32x4*)(p.rwkv_iclr_a0 + dir * 1024u + po + nt * 16);
                const f32x4 kkv = *(const f32x4*)(p.rwkv_k_k + po + nt * 16);
                const f32x4 kav = *(const f32x4*)(p.rwkv_k_a + po + nt * 16), rkv = *(const f32x4*)(p.rwkv_r_k + po + nt * 16);
                const u32x2 a = *(const u32x2*)(R + ro + nt * 16), c = *(const u32x2*)(Kk + ro + nt * 16);
                const f32x4 rr = {bf_lo(a[0]), bf_hi(a[0]), bf_lo(a[1]), bf_hi(a[1])};
                const f32x4 kr = {bf_lo(c[0]), bf_hi(c[0]), bf_lo(c[1]), bf_hi(c[1])};
                f32x4 wv, kd, bb, aa;
#pragma unroll
                for (int j = 0; j < 4; ++j) {
                    const float sg = __builtin_amdgcn_rcpf(1.0f + __builtin_amdgcn_exp2f(-(w0v[j] + aw[j]) * LOG2E));
                    wv[j] = __builtin_amdgcn_exp2f(sg * (-0.6065306597126334f * LOG2E));
                    const float ic = __builtin_amdgcn_rcpf(1.0f + __builtin_amdgcn_exp2f(-(a0v[j] + ai[j]) * LOG2E));
                    const float kkn = kr[j] * kkv[j] * kn;
                    kd[j] = kr[j] * (1.0f + (ic - 1.0f) * kav[j]);
                    bb[j] = kkn * ic;
                    aa[j] = -kkn;
                    bsum += rr[j] * kd[j] * rkv[j];
                }
                *(f32x4*)(rec + 0 * 64 + nt * 16) = wv;
                *(f32x4*)(rec + 1 * 64 + nt * 16) = kd;
                *(f32x4*)(rec + 2 * 64 + nt * 16) = bb;
                *(f32x4*)(rec + 3 * 64 + nt * 16) = aa;
                *(f32x4*)(rec + 4 * 64 + nt * 16) = rr;
            }
            bsum += __shfl_xor(bsum, 16); bsum += __shfl_xor(bsum, 32);
            if (rg == 0 && fq == 0) bonus[((chh * 2 + dir) * TTOT + tok) * 16u + hd] = bsum;
            if (wid == 6) {
                bf16_t vr[TB * 16 / 64];
#pragma unroll
                for (int i = 0; i < TB * 16 / 64; ++i) {
                    const unsigned id = i * 64 + lane, s2 = id >> 4, rw = id & 15;
                    const unsigned tk = tokb + scan_pos(blk * TB + s2, dir);
                    vr[i] = V[tk * 1024u + hc + rg * 16 + rw];
                }
#pragma unroll
                for (int i = 0; i < TB * 16 / 64; ++i) vbuf[buf * (TB * 16) + i * 64 + lane] = bf2f(vr[i]);
            }
            asm volatile("s_waitcnt lgkmcnt(0)" ::: "memory");
            if (lane == 0) lds_publish(cnts + (wid - 4), blk + 1);
        }
    }
    __syncthreads();
}
DI void phase_scan(const Params& p, char* smem) {
    for (int u = blockIdx.x; u < NBATCH * 16 * 2 * 4; u += gridDim.x) scan_unit(p, u, smem);
}

constexpr int NPHASE = 18;
constexpr int SMEM_BYTES = (GEMM_SMEM > SC_SMEM ? GEMM_SMEM : SC_SMEM) + 64;
template <int PH> DI void run_phase(const Params& p, char* smem) {
    if constexpr (PH == 0) phase_prologue(p, smem);
    else if constexpr (PH == 1) phase_norm0(p);
    else if constexpr (PH == 2) phase_qkv(p, smem);
    else if constexpr (PH == 3) phase_attn(p, smem);
    else if constexpr (PH == 4) phase_wout(p, smem);
    else if constexpr (PH == 5) phase_ffn_norm_route(p, 0, smem);
    else if constexpr (PH == 6) phase_moe1(p, 0, smem);
    else if constexpr (PH == 7) phase_moe2(p, 0, smem);
    else if constexpr (PH == 8) phase_combine_l0(p, smem);
    else if constexpr (PH == 9) phase_xx(p);
    else if constexpr (PH == 10) phase_rwkv_proj(p, smem);
    else if constexpr (PH == 11) phase_scan(p, smem);
    else if constexpr (PH == 12) phase_gate(p, smem);
    else if constexpr (PH == 13) phase_wo(p, smem);
    else if constexpr (PH == 14) phase_ffn_norm_route(p, 1, smem);
    else if constexpr (PH == 15) phase_moe1(p, 1, smem);
    else if constexpr (PH == 16) phase_moe2(p, 1, smem);
    else if constexpr (PH == 17) phase_final(p);
}
template <int PH, int END> struct PhaseSeq {
    static DI void run(const Params& p, char* smem, const XcdBarrier& bar) {
        run_phase<PH>(p, smem);
        if constexpr (PH + 1 < END) { xcd_barrier(bar); PhaseSeq<PH + 1, END>::run(p, smem, bar); }
    }
};
template <int BEG, int END>
__global__ void __launch_bounds__(NTH, 2) fwd_kernel(Params p) {
    extern __shared__ __attribute__((aligned(16))) char smem_raw[];
    char* smem = smem_raw + 16;
    if constexpr (END - BEG > 1) {
        if (threadIdx.x == 0) *(uint4*)smem_raw = make_uint4(0u, 0u, 0u, 0u);
        __syncthreads();
        XcdBarrier bar = xcd_barrier_post((unsigned*)(p.ws + OFF_BAR), (volatile LAS unsigned*)smem_raw);
        PhaseSeq<BEG, END>::run(p, smem, bar);
    } else {
        run_phase<BEG>(p, smem);
    }
}

template <int BEG, int END> static void launch_range(const Params& p, int grid, hipStream_t stream) {
    (void)hipFuncSetAttribute((const void*)fwd_kernel<BEG, END>, hipFuncAttributeMaxDynamicSharedMemorySize, SMEM_BYTES + 16);
    hipLaunchKernelGGL((fwd_kernel<BEG, END>), dim3(grid), dim3(NTH), SMEM_BYTES + 16, stream, p);
}
#ifndef RUN_PHASES
#define RUN_PHASES NPHASE
#endif
#ifndef REPEAT_PHASE
#define REPEAT_PHASE 10-1
#endif
template <int PH> static void launch_each(const Params& p, int grid, hipStream_t stream) {
    launch_range<PH, PH + 1>(p, grid, stream);
    if (PH == REPEAT_PHASE) launch_range<PH, PH + 1>(p, grid, stream);
    if constexpr (PH + 1 < RUN_PHASES) launch_each<PH + 1>(p, grid, stream);
}

extern "C" void kernel_launch(void* const* d_in, const int* in_sizes, int n_in, void* d_out, int out_size, void* d_ws, size_t ws_size, hipStream_t stream) {
    Params p{};
    const float** f = (const float**)&p;
    for (int i = 0; i < 37; ++i) f[i] = (const float*)d_in[i];
    p.out = (float*)d_out;
    p.ws = (char*)d_ws;
    if (ws_size < WS_NEED || n_in < 37) return;
    static int grid = 0;
    if (!grid) {
        int dev = 0, cus = 0;
        (void)hipGetDevice(&dev);
        (void)hipDeviceGetAttribute(&cus, hipDeviceAttributeMultiprocessorCount, dev);
        grid = cus > 0 ? cus : 256;
    }
    (void)hipMemsetAsync(d_ws, 0, 32768, stream);
#if MEGA
    launch_range<0, NPHASE>(p, grid, stream);
#else
    launch_each<0>(p, grid, stream);
#endif
}
```

```cpp
#include <hip/hip_runtime.h>
#include <stdint.h>
#include <stdio.h>

#ifndef MEGA
#define MEGA 1
#endif

typedef unsigned short bf16_t;
typedef short bf16x8 __attribute__((ext_vector_type(8)));
typedef short s16x4 __attribute__((ext_vector_type(4)));
typedef float f32x2 __attribute__((ext_vector_type(2)));
typedef float f32x4 __attribute__((ext_vector_type(4)));
typedef float f32x16 __attribute__((ext_vector_type(16)));
typedef unsigned u32x2 __attribute__((ext_vector_type(2)));
typedef unsigned u32x4 __attribute__((ext_vector_type(4)));
typedef __bf16 bf16x2_t __attribute__((ext_vector_type(2)));
#define DI __device__ __forceinline__

constexpr int DM = 1024, NBATCH = 2, SEQ = 16384, LCTX = 256, PTOT = SEQ + LCTX, TTOT = NBATCH * PTOT;
constexpr int NTH = 512, NWAVE = 8;
constexpr int QKV_N = 1536;
constexpr int NEXP = 16, CAP = TTOT * 2;
constexpr float RMS_EPS = 1e-6f, GN_EPS = 64e-5f;
constexpr float LOG2E = 1.4426950408889634f;

constexpr size_t MBy = 1u << 20;
constexpr size_t OFF_BAR   = 0;
constexpr size_t OFF_CNT   = 16384;
constexpr size_t OFF_MOD   = 32768;
constexpr size_t OFF_ROPE  = OFF_MOD + 2 * 3 * 6144 * 4;
constexpr size_t OFF_BONUS = 1 * MBy;
constexpr size_t OFF_BONUS2 = 6 * MBy;
constexpr size_t OFF_STOK  = 6 * MBy;
constexpr size_t OFF_SW    = 11 * MBy;
constexpr size_t OFF_XC    = 16 * MBy;
constexpr size_t OFF_WS    = 18 * MBy;
constexpr size_t OFF_MOEW  = 33 * MBy;
constexpr size_t OFF_H     = 129 * MBy;
constexpr size_t OFF_SCR   = 194 * MBy;
constexpr size_t SCR_SIZE  = 290 * MBy;
constexpr size_t WS_NEED   = OFF_SCR + SCR_SIZE;
constexpr size_t W_IN = 0, W_OUT = W_IN + 1536 * 1024, W_R = W_OUT + 1024 * 1024, W_K = W_R + 1024 * 1024, W_V = W_K + 1024 * 1024,
                 W_O = W_V + 1024 * 1024, W_W1 = W_O + 1024 * 1024, W_A1 = W_W1 + 128 * 1024, W_G1 = W_A1 + 128 * 1024,
                 W_W2 = W_G1 + 256 * 1024, W_A2 = W_W2 + 2 * 1024 * 64, W_G2 = W_A2 + 2 * 1024 * 64, W_END = W_G2 + 1024 * 192;
static_assert(W_END * 2 <= 15 * MBy, "small weights region");
constexpr size_t ROWB = (size_t)TTOT * 2048;
constexpr size_t S_Q = 0, S_K = S_Q + ROWB, S_VT = S_K + ROWB / 4, S_O = S_VT + ROWB / 4;
constexpr size_t S_HID = 0, S_Y = 140 * MBy;
constexpr size_t S_R = 0, S_KK = S_R + ROWB, S_V = S_KK + ROWB, S_LW = S_V + ROWB, S_LA = S_LW + ROWB / 8, S_LG = S_LA + ROWB / 8,
                 S_Y1 = 224 * MBy, S_XX = S_Y1, S_OR = S_R;
static_assert(S_O + ROWB <= SCR_SIZE, "scr");
static_assert(S_LG + (size_t)TTOT * 384 <= S_Y1, "scr2");
static_assert(S_Y1 + ROWB <= SCR_SIZE, "scr3");
static_assert(S_Y + 2 * ROWB <= SCR_SIZE, "scr4");
static_assert((size_t)(CAP / 256 + 16) * 256 * 2048 <= S_Y, "hid");
static_assert(OFF_H + ROWB <= OFF_SCR, "h");

struct Params {
    const float *x, *c, *ctx, *c_ctx, *ada_w, *ada_b, *norm_mix_g, *norm_ffn_g, *attn_w_in, *attn_w_out, *attn_sink, *attn_q_norm_g, *attn_k_norm_g,
        *rwkv_x_mix, *rwkv_w_r, *rwkv_w_k, *rwkv_w_v, *rwkv_w_o, *rwkv_decay_w0, *rwkv_decay_w1, *rwkv_decay_w2, *rwkv_iclr_a0, *rwkv_iclr_a1,
        *rwkv_iclr_a2, *rwkv_gate_g1, *rwkv_gate_g2, *rwkv_k_k, *rwkv_k_a, *rwkv_r_k, *rwkv_ln_g, *rwkv_ln_b, *router_w, *router_bias, *moe_w1,
        *moe_w3, *moe_w2, *final_norm_g;
    float* out;
    char* ws;
};

DI unsigned pk_bf16(float a, float b) { f32x2 v = {a, b}; bf16x2_t r = __builtin_convertvector(v, bf16x2_t); return __builtin_bit_cast(unsigned, r); }
DI float bf_lo(unsigned u) { return __uint_as_float(u << 16); }
DI float bf_hi(unsigned u) { return __uint_as_float(u & 0xffff0000u); }
DI float bf2f(bf16_t u) { return __uint_as_float(((unsigned)u) << 16); }
DI float wave_sum(float v) {
#pragma unroll
    for (int o = 32; o >= 1; o >>= 1) v += __shfl_xor(v, o);
    return v;
}
DI float sigmoidf_(float x) { return 1.0f / (1.0f + __expf(-x)); }
DI float siluf_(float x) { return x / (1.0f + __expf(-x)); }
DI float* xrow_ptr(const Params& p, int tok) {
    const int b = tok >= PTOT ? 1 : 0, pos = tok - b * PTOT;
    return pos < LCTX ? (float*)(p.ws + OFF_XC) + (size_t)(b * LCTX + pos) * DM : p.out + (size_t)(b * SEQ + pos - LCTX) * DM;
}
DI const float* xin_ptr(const Params& p, int tok) {
    const int b = tok >= PTOT ? 1 : 0, pos = tok - b * PTOT;
    return pos < LCTX ? p.ctx + (size_t)(b * LCTX + pos) * DM : p.x + (size_t)(b * SEQ + pos - LCTX) * DM;
}
DI const float* mod_ptr(const Params& p, int layer, int tok, int which) {
    const int b = tok >= PTOT ? 1 : 0, pos = tok - b * PTOT;
    const int w = pos < LCTX ? 2 : b;
    return (const float*)(p.ws + OFF_MOD) + (size_t)((layer * 3 + w) * 6 + which) * DM;
}

#define XB_TMO      128
#define XB_XCNT(j)  (256  + 64 * (j))
#define XB_XSUB(j)  (1280 + 64 * (j))
#define XB_XGEN(j)  (2304 + 64 * (j))
#define XB_TOP      3328
#define XB_TOPGEN   3392
#define XCD_BAR_WORDS 3456
#define XB_SPIN_CAP (1u << 18)
#define LAS __attribute__((address_space(3)))
DI unsigned xb_ld(unsigned* p)              { return __hip_atomic_load(p, __ATOMIC_RELAXED, __HIP_MEMORY_SCOPE_AGENT); }
DI unsigned xb_add(unsigned* p, unsigned v) { return __hip_atomic_fetch_add(p, v, __ATOMIC_RELAXED, __HIP_MEMORY_SCOPE_AGENT); }
DI unsigned xb_xcc_id() { return (unsigned)__builtin_amdgcn_s_getreg((3 << 11) | 20) & 0xFu; }
#define XB_SPIN(cond, bar) do { unsigned _sp = 0; while (cond) { __builtin_amdgcn_s_sleep(1); \
    if ((++_sp & 255u) == 0u) { if (xb_ld(&(bar)[XB_TMO])) break; if (_sp > XB_SPIN_CAP) { atomicAdd(&(bar)[XB_TMO], 1u); break; } } } } while (0)
struct XcdBarrier { unsigned* bar; unsigned x; volatile LAS unsigned* st; };
DI XcdBarrier xcd_barrier_post(unsigned* bar, volatile LAS unsigned* st) {
    XcdBarrier b; b.bar = bar; b.x = xb_xcc_id(); b.st = st;
    if (threadIdx.x == 0) (void)xb_add(&bar[XB_XCNT(b.x)], 1u);
    return b;
}
DI void xcd_barrier_complete(unsigned* bar, unsigned x, unsigned& nloc, unsigned& nx) {
    const unsigned G = gridDim.x * gridDim.y * gridDim.z;
    unsigned sum, cnt, mine, sp = 0u;
    for (;;) {
        sum = 0u; cnt = 0u; mine = 0u;
#pragma unroll
        for (unsigned j = 0; j < 16; ++j) { const unsigned c = xb_ld(&bar[XB_XCNT(j)]); sum += c; cnt += (c > 0u) ? 1u : 0u; mine = (j == x) ? c : mine; }
        if (sum == G) break;
        __builtin_amdgcn_s_sleep(1);
        if ((++sp & 255u) == 0u) { if (xb_ld(&bar[XB_TMO])) break; if (sp > XB_SPIN_CAP) { atomicAdd(&bar[XB_TMO], 1u); break; } }
    }
    nloc = mine > 0u ? mine : 1u; nx = cnt > 0u ? cnt : 1u;
}
DI void xcd_barrier(const XcdBarrier& b) {
    asm volatile("s_waitcnt vmcnt(0)" ::: "memory");
    __syncthreads();
    if (threadIdx.x == 0) {
        unsigned* bar = b.bar;
        __builtin_amdgcn_s_waitcnt(0);
        unsigned nloc = b.st[0], nx = b.st[1];
        if (nloc == 0u) { xcd_barrier_complete(bar, b.x, nloc, nx); b.st[0] = nloc; b.st[1] = nx; }
        const unsigned old = xb_add(&bar[XB_XSUB(b.x)], 1u);
        const unsigned gen = old / nloc;
        if (old + 1u == (gen + 1u) * nloc) {
            __builtin_amdgcn_fence(__ATOMIC_RELEASE, "agent");
            asm volatile("s_waitcnt vmcnt(0)" ::: "memory");
            const unsigned og = xb_add(&bar[XB_TOP], 1u);
            const unsigned tg = og / nx;
            if (og + 1u == (tg + 1u) * nx) xb_add(&bar[XB_TOPGEN], 1u);
            else XB_SPIN(xb_ld(&bar[XB_TOPGEN]) == tg, bar);
            __builtin_amdgcn_fence(__ATOMIC_ACQUIRE, "agent");
            xb_add(&bar[XB_XGEN(b.x)], 1u);
            asm volatile("s_waitcnt vmcnt(0)" ::: "memory");
        } else {
            XB_SPIN(xb_ld(&bar[XB_XGEN(b.x)]) == gen, bar);
            __builtin_amdgcn_fence(__ATOMIC_ACQUIRE, "agent");
            asm volatile("s_waitcnt vmcnt(0)" ::: "memory");
        }
    }
    __syncthreads();
}

DI void cvt_tile(const float* src, int ld, int kvalid, bool colvalid, bf16_t* dst, int dld, float* tile  ) {
    const int t = threadIdx.x;
    {
        const int k = t >> 3, c4 = (t & 7) * 4;
        f32x4 v = {0.f, 0.f, 0.f, 0.f};
        if (colvalid && k < kvalid) v = *(const f32x4*)(src + (size_t)k * ld + c4);
        tile[k * 33 + c4 + 0] = v[0]; tile[k * 33 + c4 + 1] = v[1]; tile[k * 33 + c4 + 2] = v[2]; tile[k * 33 + c4 + 3] = v[3];
    }
    __syncthreads();
    {
        const int n = t >> 4, kc = (t & 15) * 4;
        u32x2 w;
        w[0] = pk_bf16(tile[(kc + 0) * 33 + n], tile[(kc + 1) * 33 + n]);
        w[1] = pk_bf16(tile[(kc + 2) * 33 + n], tile[(kc + 3) * 33 + n]);
        *(u32x2*)(dst + (size_t)n * dld + kc) = w;
    }
    __syncthreads();
}
constexpr int CV_SMALL_UNITS = 768 + 512 * 5 + 64 + 64 + 128 + 64 + 64 + 96;
DI void cvt_small_unit(const Params& p, int u, float* tile) {
    bf16_t* wsm = (bf16_t*)(p.ws + OFF_WS);
    if (u < 768) { const int run = u >> 4, kt = u & 15; cvt_tile(p.attn_w_in + (size_t)kt * 64 * 1536 + run * 32, 1536, 64, true, wsm + W_IN + (size_t)run * 32 * 1024 + kt * 64, 1024, tile); return; }
    u -= 768;
    if (u < 512 * 5) {
        const int j = u >> 9, v = u & 511, run = v >> 4, kt = v & 15;
        const float* src = j == 0 ? p.attn_w_out : j == 1 ? p.rwkv_w_r : j == 2 ? p.rwkv_w_k : j == 3 ? p.rwkv_w_v : p.rwkv_w_o;
        const size_t dofs = j == 0 ? W_OUT : j == 1 ? W_R : j == 2 ? W_K : j == 3 ? W_V : W_O;
        cvt_tile(src + (size_t)kt * 64 * 1024 + run * 32, 1024, 64, true, wsm + dofs + (size_t)run * 32 * 1024 + kt * 64, 1024, tile); return;
    }
    u -= 512 * 5;
    if (u < 128) {
        const int j = u >> 6, v = u & 63, run = v >> 4, kt = v & 15, d = run >> 1, co = (run & 1) * 32;
        const float* src = (j == 0 ? p.rwkv_decay_w1 : p.rwkv_iclr_a1) + (size_t)d * 1024 * 64;
        cvt_tile(src + (size_t)kt * 64 * 64 + co, 64, 64, true, wsm + (j == 0 ? W_W1 : W_A1) + (size_t)run * 32 * 1024 + kt * 64, 1024, tile); return;
    }
    u -= 128;
    if (u < 128) {
        const int run = u >> 4, kt = u & 15;
        cvt_tile(p.rwkv_gate_g1 + (size_t)kt * 64 * 160 + run * 32, 160, 64, run < 5, wsm + W_G1 + (size_t)run * 32 * 1024 + kt * 64, 1024, tile); return;
    }
    u -= 128;
    if (u < 128) {
        const int j = u >> 6, v = u & 63, d = v >> 5, run = v & 31;
        const float* src = (j == 0 ? p.rwkv_decay_w2 : p.rwkv_iclr_a2) + (size_t)d * 64 * 1024;
        cvt_tile(src + run * 32, 1024, 64, true, wsm + (j == 0 ? W_W2 : W_A2) + (size_t)d * 1024 * 64 + (size_t)run * 32 * 64, 64, tile); return;
    }
    u -= 128;
    {
        const int run = u / 3, kt = u % 3;
        const int kvalid = 160 - kt * 64 > 64 ? 64 : (160 - kt * 64 < 0 ? 0 : 160 - kt * 64);
        cvt_tile(p.rwkv_gate_g2 + (size_t)kt * 64 * 1024 + run * 32, 1024, kvalid, true, wsm + W_G2 + (size_t)run * 32 * 192 + kt * 64, 192, tile);
    }
}
constexpr int CV_MOE_UNITS = 16 * (1024 + 512);
DI void cvt_moe_unit(const Params& p, int layer, int u, float* tile) {
    bf16_t* w13 = (bf16_t*)(p.ws + OFF_MOEW);
    bf16_t* w2t = w13 + (size_t)16 * 2048 * 1024;
    const int e = u / 1536, v = u % 1536;
    const size_t eo = (size_t)(layer * 16 + e) * 1024 * 1024;
    if (v < 1024) {
        const int run = v >> 4, kt = v & 15, g = run >> 1;
        const float* src = ((run & 1) ? p.moe_w3 : p.moe_w1) + eo;
        cvt_tile(src + (size_t)kt * 64 * 1024 + g * 32, 1024, 64, true, w13 + (size_t)e * 2048 * 1024 + (size_t)run * 32 * 1024 + kt * 64, 1024, tile);
    } else {
        const int w = v - 1024, run = w >> 4, kt = w & 15;
        cvt_tile(p.moe_w2 + eo + (size_t)kt * 64 * 1024 + run * 32, 1024, 64, true, w2t + (size_t)e * 1024 * 1024 + (size_t)run * 32 * 1024 + kt * 64, 1024, tile);
    }
}
DI void adaln_unit(const Params& p, int u, float* sm) {
    const int l = u / 96, n0 = (u % 96) * 64, t = threadIdx.x;
    float* sv = sm;
    float* red = sm + 3 * 1024;
    for (int i = t; i < 3 * 1024; i += NTH) { const int w = i >> 10, k = i & 1023; const float c = w < 2 ? p.c[w * 1024 + k] : p.c_ctx[k]; sv[i] = siluf_(c); }
    __syncthreads();
    const int kg = t >> 4, cl = t & 15;
    f32x4 a0 = {0, 0, 0, 0}, a1 = a0, a2 = a0;
    const float* W = p.ada_w + (size_t)l * 1024 * 6144 + n0 + cl * 4;
#pragma unroll 8
    for (int i = 0; i < 32; ++i) {
        const int k = kg + 32 * i;
        const f32x4 w = *(const f32x4*)(W + (size_t)k * 6144);
        a0 += w * sv[k]; a1 += w * sv[1024 + k]; a2 += w * sv[2048 + k];
    }
#pragma unroll
    for (int j = 0; j < 4; ++j) { red[kg * 192 + 0 * 64 + cl * 4 + j] = a0[j]; red[kg * 192 + 1 * 64 + cl * 4 + j] = a1[j]; red[kg * 192 + 2 * 64 + cl * 4 + j] = a2[j]; }
    __syncthreads();
    if (t < 192) {
        float s = 0.f;
        for (int g = 0; g < 32; ++g) s += red[g * 192 + t];
        const int w = t >> 6, n = n0 + (t & 63);
        ((float*)(p.ws + OFF_MOD))[(size_t)(l * 3 + w) * 6144 + n] = s + p.ada_b[l * 6144 + n];
    }
    __syncthreads();
}
DI void rope_unit(const Params& p, int u) {
    const int id = u * NTH + threadIdx.x;
    if (id < 320 * 16) {
        const int pi = id >> 4, f = id & 15;
        const float inv = exp2f(-(float)f * (13.287712379549449f / 16.0f));
        const float val = pi < 256 ? (float)pi : (float)(pi - 256);
        const float ang = val * inv;
        const double a = (double)ang;
        const double k = __builtin_rint(a * 0.15915494309189535);
        const float r = (float)(a - k * 6.283185307179586);
        f32x2 cs = {__cosf(r), __sinf(r)};
        ((f32x2*)(p.ws + OFF_ROPE))[id] = cs;
    }
}
DI void phase_prologue(const Params& p, char* smem) {
    float* sm = (float*)smem;
    const int nconv = CV_SMALL_UNITS + CV_MOE_UNITS;
    const int total = nconv + 192 + 10;
    for (int u = blockIdx.x; u < total; u += gridDim.x) {
        if (u < CV_SMALL_UNITS) cvt_small_unit(p, u, sm);
        else if (u < nconv) cvt_moe_unit(p, 0, u - CV_SMALL_UNITS, sm);
        else if (u < nconv + 192) adaln_unit(p, u - nconv, sm);
        else rope_unit(p, u - nconv - 192);
    }
}

DI void row_load(const float* src, f32x4 (&v)[4], int lane) {
#pragma unroll
    for (int i = 0; i < 4; ++i) v[i] = ((const f32x4*)src)[lane + 64 * i];
}
DI float row_rstd(const f32x4 (&v)[4]) {
    float ss = 0.f;
#pragma unroll
    for (int i = 0; i < 4; ++i) ss += v[i][0] * v[i][0] + v[i][1] * v[i][1] + v[i][2] * v[i][2] + v[i][3] * v[i][3];
    ss = wave_sum(ss);
    return rsqrtf(ss * (1.0f / DM) + RMS_EPS);
}
DI void row_norm_mod(const f32x4 (&v)[4], float rstd, const float* g, const float* shift, const float* scale, f32x4 (&h)[4], int lane) {
#pragma unroll
    for (int i = 0; i < 4; ++i) {
        const int c = (lane + 64 * i) * 4;
        const f32x4 g4 = *(const f32x4*)(g + c), sh = *(const f32x4*)(shift + c), sc = *(const f32x4*)(scale + c);
        h[i] = (v[i] * rstd * g4) * (1.0f + sc) + sh;
    }
}
DI void row_store_bf16(bf16_t* dst, const f32x4 (&h)[4], int lane) {
#pragma unroll
    for (int i = 0; i < 4; ++i) { u32x2 w; w[0] = pk_bf16(h[i][0], h[i][1]); w[1] = pk_bf16(h[i][2], h[i][3]); *(u32x2*)(dst + (lane + 64 * i) * 4) = w; }
}
DI void row_load_bf16(const bf16_t* src, f32x4 (&v)[4], int lane) {
#pragma unroll
    for (int i = 0; i < 4; ++i) { const u32x2 w = *(const u32x2*)(src + (lane + 64 * i) * 4); v[i][0] = bf_lo(w[0]); v[i][1] = bf_hi(w[0]); v[i][2] = bf_lo(w[1]); v[i][3] = bf_hi(w[1]); }
}

DI void phase_norm0(const Params& p) {
    const int lane = threadIdx.x & 63, gw = blockIdx.x * NWAVE + (threadIdx.x >> 6), nw = gridDim.x * NWAVE;
    bf16_t* H = (bf16_t*)(p.ws + OFF_H);
    for (int tok = gw; tok < TTOT; tok += nw) {
        f32x4 v[4], h[4];
        row_load(xin_ptr(p, tok), v, lane);
        const float rstd = row_rstd(v);
        row_norm_mod(v, rstd, p.norm_mix_g, mod_ptr(p, 0, tok, 0), mod_ptr(p, 0, tok, 1), h, lane);
        row_store_bf16(H + (size_t)tok * DM, h, lane);
    }
}

DI void route_row(const Params& p, const float (&lg)[16], int& e1, int& e2, float& g1, float& g2) {
    float mx = lg[0];
#pragma unroll
    for (int e = 1; e < 16; ++e) mx = fmaxf(mx, lg[e]);
    float pr[16], sum = 0.f;
#pragma unroll
    for (int e = 0; e < 16; ++e) { pr[e] = __expf(lg[e] - mx); sum += pr[e]; }
    const float inv = 1.0f / sum;
    float sel[16];
#pragma unroll
    for (int e = 0; e < 16; ++e) { pr[e] *= inv; sel[e] = pr[e] + p.router_bias[e]; }
    float best = -1e30f; int gi = 0;
#pragma unroll
    for (int g = 0; g < 4; ++g) {
        float m1 = -1e30f, m2 = -1e30f;
#pragma unroll
        for (int j = 0; j < 4; ++j) { const float s = sel[g * 4 + j]; if (s > m1) { m2 = m1; m1 = s; } else if (s > m2) m2 = s; }
        const float gs = m1 + m2;
        if (gs > best) { best = gs; gi = g; }
    }
    float s4[4], p4[4];
#pragma unroll
    for (int j = 0; j < 4; ++j) {
        s4[j] = gi == 0 ? sel[j] : gi == 1 ? sel[4 + j] : gi == 2 ? sel[8 + j] : sel[12 + j];
        p4[j] = gi == 0 ? pr[j] : gi == 1 ? pr[4 + j] : gi == 2 ? pr[8 + j] : pr[12 + j];
    }
    int i1 = 0; float b1 = s4[0];
#pragma unroll
    for (int j = 1; j < 4; ++j) if (s4[j] > b1) { b1 = s4[j]; i1 = j; }
    int i2 = i1 == 0 ? 1 : 0; float b2 = -3e38f;
#pragma unroll
    for (int j = 0; j < 4; ++j) if (j != i1 && s4[j] > b2) { b2 = s4[j]; i2 = j; }
    const float w1 = i1 == 0 ? p4[0] : i1 == 1 ? p4[1] : i1 == 2 ? p4[2] : p4[3];
    const float w2 = i2 == 0 ? p4[0] : i2 == 1 ? p4[1] : i2 == 2 ? p4[2] : p4[3];
    const float ws = 1.0f / (w1 + w2);
    e1 = gi * 4 + i1; e2 = gi * 4 + i2; g1 = w1 * ws; g2 = w2 * ws;
}
DI void phase_ffn_norm_route(const Params& p, int layer, char* smem) {
    const int lane = threadIdx.x & 63, gw = blockIdx.x * NWAVE + (threadIdx.x >> 6), nw = gridDim.x * NWAVE;
    float* rw = (float*)smem;
    for (int i = threadIdx.x; i < 1024 * 16; i += NTH) rw[(i & 15) * 1024 + (i >> 4)] = p.router_w[i];
    __syncthreads();
    bf16_t* H = (bf16_t*)(p.ws + OFF_H);
    int* lcnt = (int*)(smem + 65536);
    if (threadIdx.x < 32) lcnt[threadIdx.x] = 0;
    int my_tok = -1, my_e1 = 0, my_e2 = 0, it = 0; float my_g1 = 0.f, my_g2 = 0.f;
    for (int tok = gw; tok < TTOT; tok += nw) {
        const int pos = tok >= PTOT ? tok - PTOT : tok;
        if (layer == 1 && pos < LCTX) continue;
        f32x4 v[4], h[4];
        row_load(xrow_ptr(p, tok), v, lane);
        const float rstd = row_rstd(v);
        row_norm_mod(v, rstd, p.norm_ffn_g + layer * DM, mod_ptr(p, layer, tok, 3), mod_ptr(p, layer, tok, 4), h, lane);
        row_store_bf16(H + (size_t)tok * DM, h, lane);
        float lg[16];
#pragma unroll
        for (int e = 0; e < 16; ++e) lg[e] = 0.f;
#pragma unroll
        for (int i = 0; i < 4; ++i)
#pragma unroll
            for (int e = 0; e < 16; ++e) {
                const f32x4 w = *(const f32x4*)(rw + e * 1024 + (lane + 64 * i) * 4);
                lg[e] += h[i][0] * w[0] + h[i][1] * w[1] + h[i][2] * w[2] + h[i][3] * w[3];
                if ((e & 3) == 3) asm volatile("" ::: "memory");
            }
#pragma unroll
        for (int e = 0; e < 16; ++e) lg[e] = wave_sum(lg[e]);
        int e1, e2; float g1, g2;
        route_row(p, lg, e1, e2, g1, g2);
        if (lane == it) { my_tok = tok; my_e1 = e1; my_e2 = e2; my_g1 = g1; my_g2 = g2; }
        ++it;
    }
    __syncthreads();
    int r1 = 0, r2 = 0;
    if (my_tok >= 0) { r1 = atomicAdd(&lcnt[my_e1], 1); r2 = atomicAdd(&lcnt[my_e2], 1); }
    __syncthreads();
    if (threadIdx.x < 16) { const int n = lcnt[threadIdx.x]; lcnt[16 + threadIdx.x] = n ? atomicAdd((int*)(p.ws + OFF_CNT) + layer * 16 + threadIdx.x, n) : 0; }
    __syncthreads();
    if (my_tok >= 0) {
        int* stok = (int*)(p.ws + OFF_STOK);
        float* sw = (float*)(p.ws + OFF_SW);
        const size_t s1 = (size_t)my_e1 * CAP + lcnt[16 + my_e1] + r1, s2 = (size_t)my_e2 * CAP + lcnt[16 + my_e2] + r2;
        stok[s1] = my_tok * 2 + 0; sw[s1] = my_g1;
        stok[s2] = my_tok * 2 + 1; sw[s2] = my_g2;
    }
    __syncthreads();
}

DI void combine_row(const Params& p, int layer, int tok, f32x4 (&v)[4], int lane) {
    const bf16_t* Y = (const bf16_t*)(p.ws + OFF_SCR + S_Y) + (size_t)tok * 2 * DM;
    const float* g5 = mod_ptr(p, layer, tok, 5);
    f32x4 y0[4], y1[4];
    row_load(xrow_ptr(p, tok), v, lane);
    row_load_bf16(Y, y0, lane); row_load_bf16(Y + DM, y1, lane);
#pragma unroll
    for (int i = 0; i < 4; ++i) { const f32x4 g = *(const f32x4*)(g5 + (lane + 64 * i) * 4); v[i] += g * (y0[i] + y1[i]); }
}
DI void phase_combine_l0(const Params& p, char* smem) {
    const int lane = threadIdx.x & 63, gw = blockIdx.x * NWAVE + (threadIdx.x >> 6), nw = gridDim.x * NWAVE;
    bf16_t* H = (bf16_t*)(p.ws + OFF_H);
    for (int tok = gw; tok < TTOT; tok += nw) {
        f32x4 v[4], h[4];
        combine_row(p, 0, tok, v, lane);
        float* X = xrow_ptr(p, tok);
#pragma unroll
        for (int i = 0; i < 4; ++i) ((f32x4*)X)[lane + 64 * i] = v[i];
        const float rstd = row_rstd(v);
        row_norm_mod(v, rstd, p.norm_mix_g + DM, mod_ptr(p, 1, tok, 0), mod_ptr(p, 1, tok, 1), h, lane);
        row_store_bf16(H + (size_t)tok * DM, h, lane);
    }
    __syncthreads();
    for (int u = blockIdx.x; u < CV_MOE_UNITS; u += gridDim.x) cvt_moe_unit(p, 1, u, (float*)smem);
}
DI void phase_xx(const Params& p) {
    const int lane = threadIdx.x & 63, gw = blockIdx.x * NWAVE + (threadIdx.x >> 6), nw = gridDim.x * NWAVE;
    const bf16_t* H = (const bf16_t*)(p.ws + OFF_H);
    bf16_t* XX = (bf16_t*)(p.ws + OFF_SCR + S_XX);
    for (int tok = gw; tok < TTOT; tok += nw) {
        const int pos = tok >= PTOT ? tok - PTOT : tok;
        const bool first = pos == 0 || pos == LCTX, last = pos == LCTX - 1 || pos == PTOT - 1;
        f32x4 hc[4], hp[4], hn[4], xx[4];
        row_load_bf16(H + (size_t)tok * DM, hc, lane);
        row_load_bf16(H + (size_t)(first ? tok : tok - 1) * DM, hp, lane);
        row_load_bf16(H + (size_t)(last ? tok : tok + 1) * DM, hn, lane);
#pragma unroll
        for (int i = 0; i < 4; ++i) {
            const f32x4 a = first ? (f32x4){0, 0, 0, 0} : hp[i], b = last ? (f32x4){0, 0, 0, 0} : hn[i];
            xx[i] = 0.5f * (a + b) - hc[i];
        }
        row_store_bf16(XX + (size_t)tok * DM, xx, lane);
    }
}
DI void phase_final(const Params& p) {
    const int lane = threadIdx.x & 63, gw = blockIdx.x * NWAVE + (threadIdx.x >> 6), nw = gridDim.x * NWAVE;
    for (int r = gw; r < NBATCH * SEQ; r += nw) {
        const int b = r / SEQ, tok = b * PTOT + LCTX + (r - b * SEQ);
        f32x4 v[4];
        combine_row(p, 1, tok, v, lane);
        const float rstd = row_rstd(v);
        float* O = p.out + (size_t)r * DM;
#pragma unroll
        for (int i = 0; i < 4; ++i) { const f32x4 g = *(const f32x4*)(p.final_norm_g + (lane + 64 * i) * 4); ((f32x4*)O)[lane + 64 * i] = v[i] * rstd * g; }
    }
}

constexpr int LDSROW = 72;
constexpr int GEMM_SMEM = 2 * (256 + 128) * LDSROW * 2;
template <class AL, class EPI>
DI void gemm_tile(AL& al, const bf16_t* __restrict__ Bt, int ldb, int nk, EPI& epi, char* smem) {
    const int t = threadIdx.x, lane = t & 63, wid = t >> 6, wr = wid >> 1, wc = wid & 1, fr = lane & 15, fq = lane >> 4;
    bf16_t* sA = (bf16_t*)smem;
    bf16_t* sB = sA + 2 * 256 * LDSROW;
    f32x4 acc[4][4];
#pragma unroll
    for (int m = 0; m < 4; ++m)
#pragma unroll
        for (int n = 0; n < 4; ++n) acc[m][n] = (f32x4){0.f, 0.f, 0.f, 0.f};
    const int lr = t >> 3, lc = (t & 7) * 8;
    u32x4 ra[4], rb[2];
#pragma unroll
    for (int i = 0; i < 4; ++i) ra[i] = al.load(lr + 64 * i, lc, i);
#pragma unroll
    for (int i = 0; i < 2; ++i) rb[i] = *(const u32x4*)(Bt + (size_t)(lr + 64 * i) * ldb + lc);
#pragma unroll
    for (int i = 0; i < 4; ++i) *(u32x4*)(sA + (lr + 64 * i) * LDSROW + lc) = ra[i];
#pragma unroll
    for (int i = 0; i < 2; ++i) *(u32x4*)(sB + (lr + 64 * i) * LDSROW + lc) = rb[i];
    __syncthreads();
    for (int kt = 0; kt < nk; ++kt) {
        const int cur = kt & 1;
        const bool more = kt + 1 < nk;
        if (more) {
#pragma unroll
            for (int i = 0; i < 4; ++i) ra[i] = al.load(lr + 64 * i, (kt + 1) * 64 + lc, i);
#pragma unroll
            for (int i = 0; i < 2; ++i) rb[i] = *(const u32x4*)(Bt + (size_t)(lr + 64 * i) * ldb + (kt + 1) * 64 + lc);
        }
        const bf16_t* cA = sA + cur * 256 * LDSROW + (wr * 64 + fr) * LDSROW + fq * 8;
        const bf16_t* cB = sB + cur * 128 * LDSROW + (wc * 64 + fr) * LDSROW + fq * 8;
#pragma unroll
        for (int kk = 0; kk < 2; ++kk) {
            bf16x8 af[4], bfr[4];
#pragma unroll
            for (int m = 0; m < 4; ++m) af[m] = *(const bf16x8*)(cA + m * 16 * LDSROW + kk * 32);
#pragma unroll
            for (int n = 0; n < 4; ++n) bfr[n] = *(const bf16x8*)(cB + n * 16 * LDSROW + kk * 32);
#pragma unroll
            for (int m = 0; m < 4; ++m)
#pragma unroll
                for (int n = 0; n < 4; ++n) acc[m][n] = __builtin_amdgcn_mfma_f32_16x16x32_bf16(bfr[n], af[m], acc[m][n], 0, 0, 0);
        }
        if (more) {
            bf16_t* nA = sA + (cur ^ 1) * 256 * LDSROW;
            bf16_t* nB = sB + (cur ^ 1) * 128 * LDSROW;
#pragma unroll
            for (int i = 0; i < 4; ++i) *(u32x4*)(nA + (lr + 64 * i) * LDSROW + lc) = ra[i];
#pragma unroll
            for (int i = 0; i < 2; ++i) *(u32x4*)(nB + (lr + 64 * i) * LDSROW + lc) = rb[i];
        }
        __syncthreads();
    }
    epi(acc, wr * 64, wc * 64, fr, fq);
}
struct ALPlain {
    const bf16_t* A; int lda;
    DI u32x4 load(int r, int k, int) const { return *(const u32x4*)(A + (size_t)r * lda + k); }
};
struct ALGather {
    const bf16_t* rowp[4];
    DI u32x4 load(int, int k, int i) const { return *(const u32x4*)(rowp[i] + k); }
};
struct ALMix {
    const bf16_t* H; const bf16_t* XX; const float* xm;
    DI u32x4 load(int r, int k, int) const {
        const u32x4 h = *(const u32x4*)(H + (size_t)r * DM + k), x = *(const u32x4*)(XX + (size_t)r * DM + k);
        const f32x4 m0 = *(const f32x4*)(xm + k), m1 = *(const f32x4*)(xm + k + 4);
        u32x4 o;
        o[0] = pk_bf16(bf_lo(h[0]) + bf_lo(x[0]) * m0[0], bf_hi(h[0]) + bf_hi(x[0]) * m0[1]);
        o[1] = pk_bf16(bf_lo(h[1]) + bf_lo(x[1]) * m0[2], bf_hi(h[1]) + bf_hi(x[1]) * m0[3]);
        o[2] = pk_bf16(bf_lo(h[2]) + bf_lo(x[2]) * m1[0], bf_hi(h[2]) + bf_hi(x[2]) * m1[1]);
        o[3] = pk_bf16(bf_lo(h[3]) + bf_lo(x[3]) * m1[2], bf_hi(h[3]) + bf_hi(x[3]) * m1[3]);
        return o;
    }
};

struct EpiQKV {
    const Params* p; int m0, n0;
    DI void operator()(const f32x4 (&acc)[4][4], int rb, int cb, int fr, int fq) const {
        const int hs = (n0 + cb) >> 6;
        const bool isq = hs < 8 || (hs >= 12 && hs < 20), isv = (hs >= 10 && hs < 12) || hs >= 22, normed = hs >= 12 && hs < 22;
        const float* gam = hs < 20 ? p->attn_q_norm_g : p->attn_k_norm_g;
        const f32x2* rope = (const f32x2*)(p->ws + OFF_ROPE);
        bf16_t* Q = (bf16_t*)(p->ws + OFF_SCR + S_Q);
        bf16_t* K = (bf16_t*)(p->ws + OFF_SCR + S_K);
        bf16_t* VT = (bf16_t*)(p->ws + OFF_SCR + S_VT);
#pragma unroll
        for (int m = 0; m < 4; ++m) {
            const int tok = m0 + rb + m * 16 + fr, b = tok >= PTOT ? 1 : 0, pos = tok - b * PTOT;
            f32x4 v[4];
#pragma unroll
            for (int n = 0; n < 4; ++n) v[n] = acc[m][n];
            if (normed) {
                float ss = 0.f;
#pragma unroll
                for (int n = 0; n < 4; ++n) ss += v[n][0] * v[n][0] + v[n][1] * v[n][1] + v[n][2] * v[n][2] + v[n][3] * v[n][3];
                ss += __shfl_xor(ss, 16); ss += __shfl_xor(ss, 32);
                const float rstd = rsqrtf(ss * (1.0f / 64.0f) + RMS_EPS);
#pragma unroll
                for (int n = 0; n < 4; ++n) { const f32x4 g = *(const f32x4*)(gam + n * 16 + fq * 4); v[n] = v[n] * rstd * g; }
            }
            if (!isv && pos >= LCTX) {
                const int t = pos - LCTX, prow = t >> 6, pcol = t & 63;
#pragma unroll
                for (int a = 0; a < 2; ++a) {
                    const f32x2* tb = rope + (a == 0 ? prow : 256 + pcol) * 16 + fq * 4;
#pragma unroll
                    for (int j = 0; j < 4; ++j) {
                        const f32x2 cs = tb[j];
                        const float x0 = v[2 * a][j], x1 = v[2 * a + 1][j];
                        v[2 * a][j] = x0 * cs[0] - x1 * cs[1];
                        v[2 * a + 1][j] = x1 * cs[0] + x0 * cs[1];
                    }
                }
            }
            if (isq) {
                const int hq = hs < 8 ? hs : hs - 4;
                bf16_t* dst = Q + ((size_t)(b * 16 + hq) * PTOT + pos) * 64 + fq * 4;
#pragma unroll
                for (int n = 0; n < 4; ++n) { const f32x4 w = v[n] * (0.125f * LOG2E); u32x2 o; o[0] = pk_bf16(w[0], w[1]); o[1] = pk_bf16(w[2], w[3]); *(u32x2*)(dst + n * 16) = o; }
            } else if (!isv) {
                const int kh = hs < 12 ? hs - 8 : hs - 18;
                bf16_t* dst = K + ((size_t)(b * 4 + kh) * PTOT + pos) * 64 + fq * 4;
#pragma unroll
                for (int n = 0; n < 4; ++n) { u32x2 o; o[0] = pk_bf16(v[n][0], v[n][1]); o[1] = pk_bf16(v[n][2], v[n][3]); *(u32x2*)(dst + n * 16) = o; }
            } else {
                const int vh = hs < 12 ? hs - 10 : hs - 20;
                bf16_t* dst = VT + (size_t)(b * 4 + vh) * 64 * PTOT + pos;
#pragma unroll
                for (int n = 0; n < 4; ++n)
#pragma unroll
                    for (int j = 0; j < 4; ++j) dst[(size_t)(n * 16 + fq * 4 + j) * PTOT] = (bf16_t)(pk_bf16(v[n][j], 0.f) & 0xffffu);
            }
        }
    }
};
DI void phase_qkv(const Params& p, char* smem) {
    const bf16_t* H = (const bf16_t*)(p.ws + OFF_H);
    const bf16_t* W = (const bf16_t*)(p.ws + OFF_WS) + W_IN;
    constexpr int NT = QKV_N / 128, MT = TTOT / 256;
    for (int u = blockIdx.x; u < MT * NT; u += gridDim.x) {
        const int mt = u / NT, nt = u % NT;
        ALPlain al{H + (size_t)mt * 256 * DM, DM};
        EpiQKV epi{&p, mt * 256, nt * 128};
        gemm_tile(al, W + (size_t)nt * 128 * DM, DM, DM / 64, epi, smem);
    }
}

struct EpiResid {
    const Params* p; int m0, n0, layer; bool from_input;
    DI void operator()(const f32x4 (&acc)[4][4], int rb, int cb, int fr, int fq) const {
#pragma unroll
        for (int m = 0; m < 4; ++m) {
            const int tok = m0 + rb + m * 16 + fr;
            const float* xin = from_input ? xin_ptr(*p, tok) : xrow_ptr(*p, tok);
            float* xo = xrow_ptr(*p, tok);
            const float* gate = mod_ptr(*p, layer, tok, 2);
#pragma unroll
            for (int n = 0; n < 4; ++n) {
                const int c = n0 + cb + n * 16 + fq * 4;
                const f32x4 xi = *(const f32x4*)(xin + c), g = *(const f32x4*)(gate + c);
                *(f32x4*)(xo + c) = xi + g * acc[m][n];
            }
        }
    }
};
DI void phase_wout(const Params& p, char* smem) {
    const bf16_t* O = (const bf16_t*)(p.ws + OFF_SCR + S_O);
    const bf16_t* W = (const bf16_t*)(p.ws + OFF_WS) + W_OUT;
    constexpr int NT = 8, MT = TTOT / 256;
    for (int u = blockIdx.x; u < MT * NT; u += gridDim.x) {
        const int mt = u / NT, nt = u % NT;
        ALPlain al{O + (size_t)mt * 256 * DM, DM};
        EpiResid epi{&p, mt * 256, nt * 128, 0, true};
        gemm_tile(al, W + (size_t)nt * 128 * DM, DM, DM / 64, epi, smem);
    }
}
DI void phase_wo(const Params& p, char* smem) {
    const bf16_t* O = (const bf16_t*)(p.ws + OFF_SCR + S_OR);
    const bf16_t* W = (const bf16_t*)(p.ws + OFF_WS) + W_O;
    constexpr int NT = 8, MTL = SEQ / 256;
    for (int u = blockIdx.x; u < NBATCH * MTL * NT; u += gridDim.x) {
        const int mi = u / NT, nt = u % NT, b = mi / MTL, mt = b * (PTOT / 256) + 1 + (mi % MTL);
        ALPlain al{O + (size_t)mt * 256 * DM, DM};
        EpiResid epi{&p, mt * 256, nt * 128, 1, false};
        gemm_tile(al, W + (size_t)nt * 128 * DM, DM, DM / 64, epi, smem);
    }
}

struct MoeSched { int nt[16], base[17]; };
DI void moe_sched(const Params& p, int layer, MoeSched& s, int (&cnt)[16]) {
    const int* c = (const int*)(p.ws + OFF_CNT) + layer * 16;
    int acc = 0;
#pragma unroll
    for (int e = 0; e < 16; ++e) { cnt[e] = c[e]; s.nt[e] = (cnt[e] + 255) >> 8; s.base[e] = acc; acc += s.nt[e]; }
    s.base[16] = acc;
}
struct EpiMoe1 {
    bf16_t* hid;   int n0;
    DI void operator()(const f32x4 (&acc)[4][4], int rb, int cb, int fr, int fq) const {
        const int g = (n0 + cb) >> 6;
#pragma unroll
        for (int m = 0; m < 4; ++m) {
            bf16_t* dst = hid + (size_t)(rb + m * 16 + fr) * 1024 + g * 32 + fq * 4;
#pragma unroll
            for (int n = 0; n < 2; ++n) {
                const f32x4 a = acc[m][n], b = acc[m][n + 2];
                u32x2 o;
                o[0] = pk_bf16(siluf_(a[0]) * b[0], siluf_(a[1]) * b[1]);
                o[1] = pk_bf16(siluf_(a[2]) * b[2], siluf_(a[3]) * b[3]);
                *(u32x2*)(dst + n * 16) = o;
            }
        }
    }
};
DI void phase_moe1(const Params& p, int layer, char* smem) {
    MoeSched s; int cnt[16];
    moe_sched(p, layer, s, cnt);
    const bf16_t* H = (const bf16_t*)(p.ws + OFF_H);
    const bf16_t* W13 = (const bf16_t*)(p.ws + OFF_MOEW);
    const int* stok = (const int*)(p.ws + OFF_STOK);
    bf16_t* hid = (bf16_t*)(p.ws + OFF_SCR + S_HID);
    constexpr int NT = 16;
    const int total = s.base[16] * NT;
    const int lr = threadIdx.x >> 3;
    for (int u = blockIdx.x; u < total; u += gridDim.x) {
        const int mg = u / NT, nt = u % NT;
        int e = 0;
#pragma unroll
        for (int i = 1; i < 16; ++i) if (mg >= s.base[i]) e = i;
        int ce = 0;
#pragma unroll
        for (int i = 0; i < 16; ++i) if (i == e) ce = cnt[i];
        int be = 0;
#pragma unroll
        for (int i = 0; i < 16; ++i) if (i == e) be = s.base[i];
        const int ml = mg - be;
        ALGather al;
#pragma unroll
        for (int i = 0; i < 4; ++i) {
            const int r = ml * 256 + lr + 64 * i;
            const int tk = r < ce ? (stok[(size_t)e * CAP + r] >> 1) : 0;
            al.rowp[i] = H + (size_t)tk * DM;
        }
        EpiMoe1 epi{hid + (size_t)mg * 256 * 1024, nt * 128};
        gemm_tile(al, W13 + (size_t)e * 2048 * 1024 + (size_t)nt * 128 * 1024, 1024, 16, epi, smem);
    }
}
struct EpiMoe2 {
    bf16_t* Y; const int* stok; const float* sw; int nvalid, n0;
    DI void operator()(const f32x4 (&acc)[4][4], int rb, int cb, int fr, int fq) const {
#pragma unroll
        for (int m = 0; m < 4; ++m) {
            const int r = rb + m * 16 + fr;
            if (r < nvalid) {
                const int tk = stok[r]; const float w = sw[r];
                bf16_t* dst = Y + (size_t)tk * 1024 + n0 + cb + fq * 4;
#pragma unroll
                for (int n = 0; n < 4; ++n) { const f32x4 a = acc[m][n] * w; u32x2 o; o[0] = pk_bf16(a[0], a[1]); o[1] = pk_bf16(a[2], a[3]); *(u32x2*)(dst + n * 16) = o; }
            }
        }
    }
};
DI void phase_moe2(const Params& p, int layer, char* smem) {
    MoeSched s; int cnt[16];
    moe_sched(p, layer, s, cnt);
    const bf16_t* hid = (const bf16_t*)(p.ws + OFF_SCR + S_HID);
    const bf16_t* W2 = (const bf16_t*)(p.ws + OFF_MOEW) + (size_t)16 * 2048 * 1024;
    const int* stok = (const int*)(p.ws + OFF_STOK);
    const float* sw = (const float*)(p.ws + OFF_SW);
    bf16_t* Y = (bf16_t*)(p.ws + OFF_SCR + S_Y);
    constexpr int NT = 8;
    const int total = s.base[16] * NT;
    for (int u = blockIdx.x; u < total; u += gridDim.x) {
        const int mg = u / NT, nt = u % NT;
        int e = 0;
#pragma unroll
        for (int i = 1; i < 16; ++i) if (mg >= s.base[i]) e = i;
        int ce = 0, be = 0;
#pragma unroll
        for (int i = 0; i < 16; ++i) if (i == e) { ce = cnt[i]; be = s.base[i]; }
        const int ml = mg - be;
        ALPlain al{hid + (size_t)mg * 256 * 1024, 1024};
        EpiMoe2 epi{Y, stok + (size_t)e * CAP + ml * 256, sw + (size_t)e * CAP + ml * 256, ce - ml * 256, nt * 128};
        gemm_tile(al, W2 + (size_t)e * 1024 * 1024 + (size_t)nt * 128 * 1024, 1024, 16, epi, smem);
    }
}

struct EpiRwkv {
    bf16_t* dst; int ld, m0, n0, act, nstore;
    DI void operator()(const f32x4 (&acc)[4][4], int rb, int cb, int fr, int fq) const {
#pragma unroll
        for (int m = 0; m < 4; ++m) {
            bf16_t* d = dst + (size_t)(m0 + rb + m * 16 + fr) * ld + n0 + cb + fq * 4;
#pragma unroll
            for (int n = 0; n < 4; ++n) {
                const int c = n0 + cb + n * 16 + fq * 4;
                if (c >= ld) continue;
                f32x4 a = acc[m][n];
                if (act == 1) {
#pragma unroll
                    for (int j = 0; j < 4; ++j) { const float e = __expf(2.0f * a[j]); a[j] = 1.0f - 2.0f / (e + 1.0f); }
                }
                if (act == 2) {
#pragma unroll
                    for (int j = 0; j < 4; ++j) a[j] = sigmoidf_(a[j]);
                }
                if (c >= nstore) a = (f32x4){0.f, 0.f, 0.f, 0.f};
                u32x2 o; o[0] = pk_bf16(a[0], a[1]); o[1] = pk_bf16(a[2], a[3]);
                *(u32x2*)(d + n * 16) = o;
            }
        }
    }
};
DI void phase_rwkv_proj(const Params& p, char* smem) {
    const bf16_t* H = (const bf16_t*)(p.ws + OFF_H);
    const bf16_t* XX = (const bf16_t*)(p.ws + OFF_SCR + S_XX);
    const bf16_t* wsm = (const bf16_t*)(p.ws + OFF_WS);
    constexpr int MT = TTOT / 256, NTT = 8 + 8 + 8 + 1 + 1 + 2;
    for (int u = blockIdx.x; u < MT * NTT; u += gridDim.x) {
        const int mt = u / NTT, q = u % NTT;
        int job, nt;
        if (q < 8) { job = 0; nt = q; } else if (q < 16) { job = 1; nt = q - 8; } else if (q < 24) { job = 2; nt = q - 16; }
        else if (q == 24) { job = 3; nt = 0; } else if (q == 25) { job = 4; nt = 0; } else { job = 5; nt = q - 26; }
        const int mixj = job == 0 ? 0 : job == 1 ? 2 : job == 2 ? 3 : job == 3 ? 1 : job == 4 ? 4 : 5;
        const size_t wofs = job == 0 ? W_R : job == 1 ? W_K : job == 2 ? W_V : job == 3 ? W_W1 : job == 4 ? W_A1 : W_G1;
        const size_t dofs = job == 0 ? S_R : job == 1 ? S_KK : job == 2 ? S_V : job == 3 ? S_LW : job == 4 ? S_LA : S_LG;
        const int ld = job < 3 ? 1024 : job < 5 ? 128 : 192;
        ALMix al{H + (size_t)mt * 256 * DM, XX + (size_t)mt * 256 * DM, p.rwkv_x_mix + mixj * DM};
        EpiRwkv epi{(bf16_t*)(p.ws + OFF_SCR + dofs), ld, mt * 256, nt * 128, job == 3 ? 1 : job == 5 ? 2 : 0, job == 5 ? 160 : 4096};
        gemm_tile(al, wsm + wofs + (size_t)nt * 128 * DM, DM, DM / 64, epi, smem);
    }
}

struct EpiGate {
    const Params* p; int m0, n0;
    DI void operator()(const f32x4 (&acc)[4][4], int rb, int cb, int fr, int fq) const {
        const bf16_t* Y0 = (const bf16_t*)(p->ws + OFF_H);
        const bf16_t* Y1 = (const bf16_t*)(p->ws + OFF_SCR + S_Y1);
        const bf16_t* V = (const bf16_t*)(p->ws + OFF_SCR + S_V);
        const float* bonus = (const float*)(p->ws + OFF_BONUS2);
        bf16_t* O = (bf16_t*)(p->ws + OFF_SCR + S_OR);
        const int c0 = n0 + cb, hd = c0 >> 6;
#pragma unroll
        for (int m = 0; m < 4; ++m) {
            const int tok = m0 + rb + m * 16 + fr;
            const size_t ro = (size_t)tok * DM + c0 + fq * 4;
            f32x4 y[4];
            float s = 0.f;
#pragma unroll
            for (int n = 0; n < 4; ++n) {
                const u32x2 a = *(const u32x2*)(Y0 + ro + n * 16), b = *(const u32x2*)(Y1 + ro + n * 16);
                y[n][0] = bf_lo(a[0]) + bf_lo(b[0]); y[n][1] = bf_hi(a[0]) + bf_hi(b[0]); y[n][2] = bf_lo(a[1]) + bf_lo(b[1]); y[n][3] = bf_hi(a[1]) + bf_hi(b[1]);
                s += y[n][0] + y[n][1] + y[n][2] + y[n][3];
            }
            s += __shfl_xor(s, 16); s += __shfl_xor(s, 32);
            const float mu = s * (1.0f / 64.0f);
            float q = 0.f;
#pragma unroll
            for (int n = 0; n < 4; ++n) { const f32x4 d = y[n] - mu; q += d[0] * d[0] + d[1] * d[1] + d[2] * d[2] + d[3] * d[3]; }
            q += __shfl_xor(q, 16); q += __shfl_xor(q, 32);
            const float rs = rsqrtf(q * (1.0f / 64.0f) + GN_EPS);
            const float bon = (bonus[(size_t)tok * 16 + hd] + bonus[(size_t)(TTOT + tok) * 16 + hd]) + (bonus[(size_t)(2 * TTOT + tok) * 16 + hd] + bonus[(size_t)(3 * TTOT + tok) * 16 + hd]);
#pragma unroll
            for (int n = 0; n < 4; ++n) {
                const int c = c0 + n * 16 + fq * 4;
                const f32x4 g = *(const f32x4*)(p->rwkv_ln_g + c), bb = *(const f32x4*)(p->rwkv_ln_b + c);
                const u32x2 vv = *(const u32x2*)(V + ro + n * 16);
                const f32x4 v4 = {bf_lo(vv[0]), bf_hi(vv[0]), bf_lo(vv[1]), bf_hi(vv[1])};
                const f32x4 o = ((y[n] - mu) * rs * g + bb + bon * v4) * acc[m][n];
                u32x2 w; w[0] = pk_bf16(o[0], o[1]); w[1] = pk_bf16(o[2], o[3]);
                *(u32x2*)(O + ro + n * 16) = w;
            }
        }
    }
};
DI void phase_gate(const Params& p, char* smem) {
    const bf16_t* LG = (const bf16_t*)(p.ws + OFF_SCR + S_LG);
    const bf16_t* W = (const bf16_t*)(p.ws + OFF_WS) + W_G2;
    constexpr int NT = 8, MT = TTOT / 256;
    for (int u = blockIdx.x; u < MT * NT; u += gridDim.x) {
        const int mt = u / NT, nt = u % NT;
        ALPlain al{LG + (size_t)mt * 256 * 192, 192};
        EpiGate epi{&p, mt * 256, nt * 128};
        gemm_tile(al, W + (size_t)nt * 128 * 192, 192, 3, epi, smem);
    }
}

constexpr int KROW = 72, VROW = 68;
constexpr int ATT_SMEM = 2 * 64 * KROW * 2 + 2 * 64 * VROW * 2;
DI int crow_(int i, int h) { return (i & 3) + 8 * (i >> 2) + 4 * h; }
#define MFMA32(a, b, c) __builtin_amdgcn_mfma_f32_32x32x16_bf16((a), (b), (c), 0, 0, 0)
template <int MODE>
DI void attn_unit(const Params& p, const bf16_t* Qg  , int nq_valid, const bf16_t* Kg  , const bf16_t* Vg  ,
                  int ta0, int ta1, int tb0, int tb1  , bool band, int q_lat0  ,
                  float init_m, float init_l0, bf16_t* Og  , char* smem) {
    const int t = threadIdx.x, lane = t & 63, wid = t >> 6, r = lane & 31, h = lane >> 5;
    bf16_t* sK = (bf16_t*)smem;
    bf16_t* sV = sK + 2 * 64 * KROW;
    bf16x8 qf[2][4];
#pragma unroll
    for (int qs = 0; qs < 2; ++qs) {
        const int qi = wid * 64 + qs * 32 + r;
        const bf16_t* qp = Qg + (size_t)(qi < nq_valid ? qi : 0) * 64 + 8 * h;
#pragma unroll
        for (int ks = 0; ks < 4; ++ks) qf[qs][ks] = *(const bf16x8*)(qp + ks * 16);
    }
    f32x16 o[2][2];
#pragma unroll
    for (int qs = 0; qs < 2; ++qs)
#pragma unroll
        for (int dt = 0; dt < 2; ++dt)
#pragma unroll
            for (int i = 0; i < 16; ++i) o[qs][dt][i] = 0.f;
    float mrun[2], lrun[2];
#pragma unroll
    for (int qs = 0; qs < 2; ++qs) { mrun[qs] = init_m; lrun[qs] = (MODE == 1 && h == 0) ? init_l0 : 0.f; }
    const int ntile = ((ta1 - ta0) + (tb1 - tb0)) >> 6;
    const int lrow = t >> 3, lch = (t & 7) * 8;
    u32x4 rk, rv;
    auto tile_pos = [&](int i) { const int a = (ta1 - ta0) >> 6; return i < a ? ta0 + i * 64 : tb0 + (i - a) * 64; };
    {
        const int kp = tile_pos(0);
        rk = *(const u32x4*)(Kg + (size_t)(kp + lrow) * 64 + lch);
        rv = *(const u32x4*)(Vg + (size_t)lrow * PTOT + kp + lch);
        *(u32x4*)(sK + lrow * KROW + lch) = rk;
        *(u32x2*)(sV + lrow * VROW + lch) = (u32x2){rv[0], rv[1]};
        *(u32x2*)(sV + lrow * VROW + lch + 4) = (u32x2){rv[2], rv[3]};
    }
    __syncthreads();
    for (int it = 0; it < ntile; ++it) {
        const int cur = it & 1;
        const bool more = it + 1 < ntile;
        const int kp = tile_pos(it);
        if (more) {
            const int kn = tile_pos(it + 1);
            rk = *(const u32x4*)(Kg + (size_t)(kn + lrow) * 64 + lch);
            rv = *(const u32x4*)(Vg + (size_t)lrow * PTOT + kn + lch);
        }
        const bf16_t* cK = sK + cur * 64 * KROW;
        const bf16_t* cV = sV + cur * 64 * VROW;
#pragma unroll 1
        for (int ksub = 0; ksub < 2; ++ksub) {
            f32x16 sc[2];
#pragma unroll
            for (int qs = 0; qs < 2; ++qs)
#pragma unroll
                for (int i = 0; i < 16; ++i) sc[qs][i] = MODE == 0 ? init_m : 0.f;
#pragma unroll
            for (int ks = 0; ks < 4; ++ks) {
                const bf16x8 kf = *(const bf16x8*)(cK + (ksub * 32 + r) * KROW + ks * 16 + 8 * h);
#pragma unroll
                for (int qs = 0; qs < 2; ++qs) sc[qs] = MFMA32(kf, qf[qs][ks], sc[qs]);
            }
#pragma unroll
            for (int qs = 0; qs < 2; ++qs) {
                if (MODE == 1) {
                    if (band && kp >= LCTX) {
                        const int qlat = q_lat0 + wid * 64 + qs * 32 + r, kl0 = kp - LCTX + ksub * 32;
#pragma unroll
                        for (int i = 0; i < 16; ++i) {
                            const int d0 = qlat - (kl0 + crow_(i, h));
                            if (d0 > 128 || d0 < -128) sc[qs][i] = -1e30f;
                        }
                    }
                    float mt = sc[qs][0];
#pragma unroll
                    for (int i = 1; i < 16; ++i) mt = fmaxf(mt, sc[qs][i]);
                    mt = fmaxf(mt, __shfl_xor(mt, 32));
                    const float mnew = fmaxf(mrun[qs], mt);
                    const float alpha = __builtin_amdgcn_exp2f(mrun[qs] - mnew);
                    mrun[qs] = mnew; lrun[qs] *= alpha;
#pragma unroll
                    for (int i = 0; i < 16; ++i) { o[qs][0][i] *= alpha; o[qs][1][i] *= alpha; }
#pragma unroll
                    for (int i = 0; i < 16; ++i) sc[qs][i] -= mnew;
                }
                float ls = 0.f;
#pragma unroll
                for (int i = 0; i < 16; ++i) { sc[qs][i] = __builtin_amdgcn_exp2f(sc[qs][i]); ls += sc[qs][i]; }
                lrun[qs] += ls;
            }
#pragma unroll
            for (int st = 0; st < 2; ++st) {
                bf16x8 pf[2];
#pragma unroll
                for (int qs = 0; qs < 2; ++qs) {
                    u32x4 pw;
#pragma unroll
                    for (int j = 0; j < 4; ++j) pw[j] = pk_bf16(sc[qs][8 * st + 2 * j], sc[qs][8 * st + 2 * j + 1]);
                    pf[qs] = __builtin_bit_cast(bf16x8, pw);
                }
                const int kb = ksub * 32 + 16 * st + 4 * h;
#pragma unroll
                for (int dt = 0; dt < 2; ++dt) {
                    const s16x4 lo = *(const s16x4*)(cV + (dt * 32 + r) * VROW + kb), hi = *(const s16x4*)(cV + (dt * 32 + r) * VROW + kb + 8);
                    const bf16x8 vf = __builtin_shufflevector(lo, hi, 0, 1, 2, 3, 4, 5, 6, 7);
#pragma unroll
                    for (int qs = 0; qs < 2; ++qs) o[qs][dt] = MFMA32(vf, pf[qs], o[qs][dt]);
                }
            }
        }
        if (more) {
            bf16_t* nK = sK + (cur ^ 1) * 64 * KROW;
            bf16_t* nV = sV + (cur ^ 1) * 64 * VROW;
            *(u32x4*)(nK + lrow * KROW + lch) = rk;
            *(u32x2*)(nV + lrow * VROW + lch) = (u32x2){rv[0], rv[1]};
            *(u32x2*)(nV + lrow * VROW + lch + 4) = (u32x2){rv[2], rv[3]};
        }
        __syncthreads();
    }
#pragma unroll
    for (int qs = 0; qs < 2; ++qs) {
        const int qi = wid * 64 + qs * 32 + r;
        const float lt = lrun[qs] + __shfl_xor(lrun[qs], 32);
        const float invl = 1.0f / lt;
        if (qi < nq_valid) {
            bf16_t* op = Og + (size_t)qi * DM;
#pragma unroll
            for (int g = 0; g < 4; ++g) {
                u32x2 w0, w1;
                w0[0] = pk_bf16(o[qs][0][4 * g] * invl, o[qs][0][4 * g + 1] * invl); w0[1] = pk_bf16(o[qs][0][4 * g + 2] * invl, o[qs][0][4 * g + 3] * invl);
                w1[0] = pk_bf16(o[qs][1][4 * g] * invl, o[qs][1][4 * g + 1] * invl); w1[1] = pk_bf16(o[qs][1][4 * g + 2] * invl, o[qs][1][4 * g + 3] * invl);
                *(u32x2*)(op + 8 * g + 4 * h) = w0;
                *(u32x2*)(op + 32 + 8 * g + 4 * h) = w1;
            }
        }
    }
}
DI void phase_attn(const Params& p, char* smem) {
    const bf16_t* Q = (const bf16_t*)(p.ws + OFF_SCR + S_Q);
    const bf16_t* K = (const bf16_t*)(p.ws + OFF_SCR + S_K);
    const bf16_t* VT = (const bf16_t*)(p.ws + OFF_SCR + S_VT);
    bf16_t* O = (bf16_t*)(p.ws + OFF_SCR + S_O);
    float gq = 0.f, gk = 0.f;
    for (int i = 0; i < 64; ++i) { gq = fmaxf(gq, fabsf(p.attn_q_norm_g[i])); gk = fmaxf(gk, fabsf(p.attn_k_norm_g[i])); }
    const float M2 = 8.25f * gq * gk * LOG2E;
    constexpr int QB = 512, NQB = SEQ / QB;
    const int G = gridDim.x;
    constexpr int NDENSE = NBATCH * 8 * NQB;
    for (int u = blockIdx.x; u < NDENSE; u += G) {
        int combo, within;
        if ((G & 7) == 0 && NDENSE % G == 0) {
            const int xcd = blockIdx.x & 7, idx = (blockIdx.x >> 3) + (G >> 3) * (u / G);
            combo = xcd & 3; within = (xcd >> 2) * (NDENSE / 8) + idx;
        } else { combo = u / (4 * NQB); within = u % (4 * NQB); }
        const int b = combo >> 1, kvh = combo & 1, hq = kvh * 4 + (within & 3), qb = within >> 2;
        const bf16_t* Qg = Q + ((size_t)(b * 16 + 8 + hq) * PTOT + LCTX + qb * QB) * 64;
        attn_unit<0>(p, Qg, QB, K + (size_t)(b * 4 + 2 + kvh) * PTOT * 64, VT + (size_t)(b * 4 + 2 + kvh) * 64 * PTOT, 0, PTOT, 0, 0, false, 0, -M2, 0.f,
                     O + (size_t)(b * PTOT + LCTX + qb * QB) * DM + (8 + hq) * 64, smem);
    }
    for (int u = blockIdx.x; u < NDENSE; u += G) {
        const int b = u / (8 * NQB), rem = u % (8 * NQB), qb = rem >> 3, hq = rem & 7, kvh = hq >> 2;
        const int i0 = qb * QB;
        const int lo = i0 - 128 < 0 ? 0 : i0 - 128, hi = i0 + QB + 128 > SEQ ? SEQ : i0 + QB + 128;
        const bf16_t* Qg = Q + ((size_t)(b * 16 + hq) * PTOT + LCTX + i0) * 64;
        attn_unit<1>(p, Qg, QB, K + (size_t)(b * 4 + kvh) * PTOT * 64, VT + (size_t)(b * 4 + kvh) * 64 * PTOT, 0, LCTX, LCTX + lo, LCTX + hi, true, i0,
                     p.attn_sink[hq] * LOG2E, 1.0f, O + (size_t)(b * PTOT + LCTX + i0) * DM + hq * 64, smem);
    }
    for (int u = blockIdx.x; u < NBATCH * 16; u += G) {
        const int b = u >> 4, hh = u & 15, isb = hh >> 3, hq = hh & 7, kvh = isb * 2 + (hq >> 2);
        const bf16_t* Qg = Q + ((size_t)(b * 16 + hh) * PTOT) * 64;
        attn_unit<1>(p, Qg, LCTX, K + (size_t)(b * 4 + kvh) * PTOT * 64, VT + (size_t)(b * 4 + kvh) * 64 * PTOT, 0, LCTX, 0, 0, false, 0,
                     isb ? -1e30f : p.attn_sink[hq] * LOG2E, isb ? 0.f : 1.0f, O + (size_t)(b * PTOT) * DM + hh * 64, smem);
    }
}

constexpr int TB = 32, NBUF = 3;
constexpr int SC_REC = 5 * 64;
constexpr int SC_OPS = TB * SC_REC * 4;
constexpr int SC_SMEM = NBUF * SC_OPS + NBUF * TB * 16 * 4 + NBUF * TB * 16 * 4 + 64;
DI int scan_pos(int n, int dir) {
    if (n < LCTX) return dir ? LCTX - 1 - n : n;
    const int m = n - LCTX;
    return LCTX + (dir ? SEQ - 1 - m : m);
}
template <int CTRL> DI float dpp_add(float v) { return v + __builtin_bit_cast(float, __builtin_amdgcn_update_dpp(0, __builtin_bit_cast(int, v), CTRL, 0xf, 0xf, false)); }
DI float row16_sum(float v) { v = dpp_add<0x128>(v); v = dpp_add<0x124>(v); v = dpp_add<0x122>(v); v = dpp_add<0x121>(v); return v; }
DI int lds_min4(int* c) { const volatile LAS int* q = (const volatile LAS int*)c; const int a = q[0], b = q[1], d = q[2], e = q[3]; return min(min(a, b), min(d, e)); }
DI void lds_publish(int* c, int v) { *(volatile LAS int*)c = v; }
DI void scan_unit(const Params& p, int u, char* smem) {
    const int t = threadIdx.x, lane = t & 63, wid = __builtin_amdgcn_readfirstlane(t >> 6);
    const unsigned rg = u & 3, dir = (u >> 2) & 1, hd = (u >> 3) & 15, b = u >> 7;
    float* ops = (float*)smem;
    float* vbuf = (float*)(smem + NBUF * SC_OPS);
    float* ybuf = vbuf + NBUF * TB * 16;
    int* cnts = (int*)(ybuf + NBUF * TB * 16);
    const bf16_t* R = (const bf16_t*)(p.ws + OFF_SCR + S_R);
    const bf16_t* Kk = (const bf16_t*)(p.ws + OFF_SCR + S_KK);
    const bf16_t* V = (const bf16_t*)(p.ws + OFF_SCR + S_V);
    const bf16_t* LW = (const bf16_t*)(p.ws + OFF_SCR + S_LW);
    const bf16_t* LA = (const bf16_t*)(p.ws + OFF_SCR + S_LA);
    bf16_t* Yo = dir ? (bf16_t*)(p.ws + OFF_SCR + S_Y1) : (bf16_t*)(p.ws + OFF_H);
    float* bonus = (float*)(p.ws + OFF_BONUS2);
    const unsigned tokb = b * PTOT, hc = hd * 64;
    constexpr int NBLK = PTOT / TB;
    const unsigned fr = lane & 15, fq = lane >> 4;
    if (t < 8) cnts[t] = 0;
    __syncthreads();

    if (wid < 4) {
        __builtin_amdgcn_s_setprio(3);
        float s0 = 0.f, s1 = 0.f, s2 = 0.f, s3 = 0.f;
        const unsigned g = lane >> 4, c4 = (lane & 15) * 4, myrow = wid * 4 + g;
        for (int blk = 0; blk < NBLK; ++blk) {
            const unsigned buf = (unsigned)blk % NBUF;
            while (lds_min4(cnts) < blk + 1) __builtin_amdgcn_s_sleep(1);
            asm volatile("" ::: "memory");
            const float* rec = ops + buf * (TB * SC_REC) + c4;
            const float* vb = vbuf + buf * (TB * 16) + myrow;
            float* yb = ybuf + buf * (TB * 16) + myrow;
            f32x4 w0_ = *(const f32x4*)(rec), kd0_ = *(const f32x4*)(rec + 64), bb0_ = *(const f32x4*)(rec + 128), aa0_ = *(const f32x4*)(rec + 192), rr0_ = *(const f32x4*)(rec + 256);
            float vv0_ = vb[0];
#define SCAN_STEP(W, KD, BB, AA, RR, VV, ST) { \
                float sa = s0 * AA[0] + s1 * AA[1] + s2 * AA[2] + s3 * AA[3]; \
                sa = row16_sum(sa); \
                s0 = s0 * W[0] + sa * BB[0] + VV * KD[0]; \
                s1 = s1 * W[1] + sa * BB[1] + VV * KD[1]; \
                s2 = s2 * W[2] + sa * BB[2] + VV * KD[2]; \
                s3 = s3 * W[3] + sa * BB[3] + VV * KD[3]; \
                float y = s0 * RR[0] + s1 * RR[1] + s2 * RR[2] + s3 * RR[3]; \
                y = row16_sum(y); \
                if ((lane & 15) == 0) yb[(ST) * 16] = y; }
#pragma unroll 1
            for (int st = 0; st < TB; st += 2) {
                const float* r1 = rec + (st + 1) * SC_REC;
                const f32x4 w1_ = *(const f32x4*)(r1), kd1_ = *(const f32x4*)(r1 + 64), bb1_ = *(const f32x4*)(r1 + 128), aa1_ = *(const f32x4*)(r1 + 192), rr1_ = *(const f32x4*)(r1 + 256);
                const float vv1_ = vb[(st + 1) * 16];
                SCAN_STEP(w0_, kd0_, bb0_, aa0_, rr0_, vv0_, st)
                const int st2 = st + 2 < TB ? st + 2 : st;
                const float* r2 = rec + st2 * SC_REC;
                w0_ = *(const f32x4*)(r2); kd0_ = *(const f32x4*)(r2 + 64); bb0_ = *(const f32x4*)(r2 + 128); aa0_ = *(const f32x4*)(r2 + 192); rr0_ = *(const f32x4*)(r2 + 256);
                vv0_ = vb[st2 * 16];
                SCAN_STEP(w1_, kd1_, bb1_, aa1_, rr1_, vv1_, st + 1)
            }
#undef SCAN_STEP
            asm volatile("s_waitcnt lgkmcnt(0)" ::: "memory");
            if (lane == 0) lds_publish(cnts + 4 + wid, blk + 1);
        }
        __builtin_amdgcn_s_setprio(0);
    } else {
        const unsigned wt = wid & 1, chh = (wid >> 1) & 1;
        const bf16_t* wsm = (const bf16_t*)(p.ws + OFF_WS);
        const unsigned wo = W_W2 + dir * 65536u + (hc + fr) * 64u + fq * 8u;
        const unsigned ao = W_A2 + dir * 65536u + (hc + fr) * 64u + fq * 8u;
        const unsigned po = hc + fq * 4u;
        for (int blk = 0; blk < NBLK + NBUF; ++blk) {
            const unsigned buf = (unsigned)blk % NBUF;
            const int need = blk - NBUF + 1 < NBLK ? blk - NBUF + 1 : NBLK;
            while (lds_min4(cnts + 4) < need) __builtin_amdgcn_s_sleep(1);
            asm volatile("" ::: "memory");
            if (wid == 7 && blk >= NBUF) {
#pragma unroll
                for (int i = 0; i < TB * 16 / 64; ++i) {
                    const unsigned id = i * 64 + lane, st = id >> 4, rw = id & 15;
                    const unsigned tok = tokb + scan_pos((blk - NBUF) * TB + st, dir);
                    Yo[tok * 1024u + hc + rg * 16 + rw] = (bf16_t)(pk_bf16(ybuf[buf * (TB * 16) + id], 0.f) & 0xffffu);
                }
            }
            if (blk >= NBLK) continue;
            const unsigned st = wt * 16 + fr;
            const unsigned tok = tokb + scan_pos(blk * TB + st, dir);
            const unsigned lo = tok * 128u + dir * 64u + fq * 8u;
            const unsigned ro = tok * 1024u + hc + fq * 4u;
            bf16x8 lwf[2], laf[2];
#pragma unroll
            for (int kk = 0; kk < 2; ++kk) { lwf[kk] = *(const bf16x8*)(LW + lo + kk * 32); laf[kk] = *(const bf16x8*)(LA + lo + kk * 32); }
            float ssq = 0.f;
#pragma unroll
            for (int nt = 0; nt < 4; ++nt) {
                const f32x4 kkv = *(const f32x4*)(p.rwkv_k_k + po + nt * 16);
                const u32x2 c = *(const u32x2*)(Kk + ro + nt * 16);
                const float q0 = bf_lo(c[0]) * kkv[0], q1 = bf_hi(c[0]) * kkv[1], q2 = bf_lo(c[1]) * kkv[2], q3 = bf_hi(c[1]) * kkv[3];
                ssq += q0 * q0 + q1 * q1 + q2 * q2 + q3 * q3;
            }
            ssq += __shfl_xor(ssq, 16); ssq += __shfl_xor(ssq, 32);
            const float kn = __builtin_amdgcn_rsqf(fmaxf(ssq, 1e-24f));
            float* rec = ops + buf * (TB * SC_REC) + st * SC_REC + fq * 4;
            float bsum = 0.f;
#pragma unroll
            for (int n2 = 0; n2 < 2; ++n2) {
                const unsigned nt = chh * 2 + n2;
                f32x4 aw = {0.f, 0.f, 0.f, 0.f}, ai = aw;
#pragma unroll
                for (int kk = 0; kk < 2; ++kk) {
                    const bf16x8 w2f = *(const bf16x8*)(wsm + wo + nt * 1024 + kk * 32), a2f = *(const bf16x8*)(wsm + ao + nt * 1024 + kk * 32);
                    aw = __builtin_amdgcn_mfma_f32_16x16x32_bf16(w2f, lwf[kk], aw, 0, 0, 0);
                    ai = __builtin_amdgcn_mfma_f32_16x16x32_bf16(a2f, laf[kk], ai, 0, 0, 0);
                }
                const f32x4 w0v = *(const f32x4*)(p.rwkv_decay_w0 + dir * 1024u + po + nt * 16), a0v = *(const f32x4*)(p.rwkv_iclr_a0 + dir * 1024u + po + nt * 16);
                const f32x4 kkv = *(const f32x4*)(p.rwkv_k_k + po + nt * 16);
                const f32x4 kav = *(const f32x4*)(p.rwkv_k_a + po + nt * 16), rkv = *(const f32x4*)(p.rwkv_r_k + po + nt * 16);
                const u32x2 a = *(const u32x2*)(R + ro + nt * 16), c = *(const u32x2*)(Kk + ro + nt * 16);
                const f32x4 rr = {bf_lo(a[0]), bf_hi(a[0]), bf_lo(a[1]), bf_hi(a[1])};
                const f32x4 kr = {bf_lo(c[0]), bf_hi(c[0]), bf_lo(c[1]), bf_hi(c[1])};
                f32x4 wv, kd, bb, aa;
#pragma unroll
                for (int j = 0; j < 4; ++j) {
                    const float sg = __builtin_amdgcn_rcpf(1.0f + __builtin_amdgcn_exp2f(-(w0v[j] + aw[j]) * LOG2E));
                    wv[j] = __builtin_amdgcn_exp2f(sg * (-0.6065306597126334f * LOG2E));
                    const float ic = __builtin_amdgcn_rcpf(1.0f + __builtin_amdgcn_exp2f(-(a0v[j] + ai[j]) * LOG2E));
                    const float kkn = kr[j] * kkv[j] * kn;
                    kd[j] = kr[j] * (1.0f + (ic - 1.0f) * kav[j]);
                    bb[j] = kkn * ic;
                    aa[j] = -kkn;
                    bsum += rr[j] * kd[j] * rkv[j];
                }
                *(f32x4*)(rec + 0 * 64 + nt * 16) = wv;
                *(f32x4*)(rec + 1 * 64 + nt * 16) = kd;
                *(f32x4*)(rec + 2 * 64 + nt * 16) = bb;
                *(f32x4*)(rec + 3 * 64 + nt * 16) = aa;
                *(f32x4*)(rec + 4 * 64 + nt * 16) = rr;
            }
            bsum += __shfl_xor(bsum, 16); bsum += __shfl_xor(bsum, 32);
            if (rg == 0 && fq == 0) bonus[((chh * 2 + dir) * TTOT + tok) * 16u + hd] = bsum;
            if (wid == 6) {
                bf16_t vr[TB * 16 / 64];
#pragma unroll
                for (int i = 0; i < TB * 16 / 64; ++i) {
                    const unsigned id = i * 64 + lane, s2 = id >> 4, rw = id & 15;
                    const unsigned tk = tokb + scan_pos(blk * TB + s2, dir);
                    vr[i] = V[tk * 1024u + hc + rg * 16 + rw];
                }
#pragma unroll
                for (int i = 0; i < TB * 16 / 64; ++i) vbuf[buf * (TB * 16) + i * 64 + lane] = bf2f(vr[i]);
            }
            asm volatile("s_waitcnt lgkmcnt(0)" ::: "memory");
            if (lane == 0) lds_publish(cnts + (wid - 4), blk + 1);
        }
    }
    __syncthreads();
}
DI void phase_scan(const Params& p, char* smem) {
    for (int u = blockIdx.x; u < NBATCH * 16 * 2 * 4; u += gridDim.x) scan_unit(p, u, smem);
}

constexpr int NPHASE = 18;
constexpr int SMEM_BYTES = (GEMM_SMEM > SC_SMEM ? GEMM_SMEM : SC_SMEM) + 64;
template <int PH> DI void run_phase(const Params& p, char* smem) {
    if constexpr (PH == 0) phase_prologue(p, smem);
    else if constexpr (PH == 1) phase_norm0(p);
    else if constexpr (PH == 2) phase_qkv(p, smem);
    else if constexpr (PH == 3) phase_attn(p, smem);
    else if constexpr (PH == 4) phase_wout(p, smem);
    else if constexpr (PH == 5) phase_ffn_norm_route(p, 0, smem);
    else if constexpr (PH == 6) phase_moe1(p, 0, smem);
    else if constexpr (PH == 7) phase_moe2(p, 0, smem);
    else if constexpr (PH == 8) phase_combine_l0(p, smem);
    else if constexpr (PH == 9) phase_xx(p);
    else if constexpr (PH == 10) phase_rwkv_proj(p, smem);
    else if constexpr (PH == 11) phase_scan(p, smem);
    else if constexpr (PH == 12) phase_gate(p, smem);
    else if constexpr (PH == 13) phase_wo(p, smem);
    else if constexpr (PH == 14) phase_ffn_norm_route(p, 1, smem);
    else if constexpr (PH == 15) phase_moe1(p, 1, smem);
    else if constexpr (PH == 16) phase_moe2(p, 1, smem);
    else if constexpr (PH == 17) phase_final(p);
}
template <int PH, int END> struct PhaseSeq {
    static DI void run(const Params& p, char* smem, const XcdBarrier& bar) {
        run_phase<PH>(p, smem);
        if constexpr (PH + 1 < END) { xcd_barrier(bar); PhaseSeq<PH + 1, END>::run(p, smem, bar); }
    }
};
template <int BEG, int END>
__global__ void __launch_bounds__(NTH, 2) fwd_kernel(Params p) {
    extern __shared__ __attribute__((aligned(16))) char smem_raw[];
    char* smem = smem_raw + 16;
    if constexpr (END - BEG > 1) {
        if (threadIdx.x == 0) *(uint4*)smem_raw = make_uint4(0u, 0u, 0u, 0u);
        __syncthreads();
        XcdBarrier bar = xcd_barrier_post((unsigned*)(p.ws + OFF_BAR), (volatile LAS unsigned*)smem_raw);
        PhaseSeq<BEG, END>::run(p, smem, bar);
    } else {
        run_phase<BEG>(p, smem);
    }
}

template <int BEG, int END> static void launch_range(const Params& p, int grid, hipStream_t stream) {
    (void)hipFuncSetAttribute((const void*)fwd_kernel<BEG, END>, hipFuncAttributeMaxDynamicSharedMemorySize, SMEM_BYTES + 16);
    hipLaunchKernelGGL((fwd_kernel<BEG, END>), dim3(grid), dim3(NTH), SMEM_BYTES + 16, stream, p);
}
#ifndef RUN_PHASES
#define RUN_PHASES NPHASE
#endif
#ifndef REPEAT_PHASE
#define REPEAT_PHASE -1
#endif
template <int PH> static void launch_each(const Params& p, int grid, hipStream_t stream) {
    launch_range<PH, PH + 1>(p, grid, stream);
    if (PH == REPEAT_PHASE) launch_range<PH, PH + 1>(p, grid, stream);
    if constexpr (PH + 1 < RUN_PHASES) launch_each<PH + 1>(p, grid, stream);
}

extern "C" void kernel_launch(void* const* d_in, const int* in_sizes, int n_in, void* d_out, int out_size, void* d_ws, size_t ws_size, hipStream_t stream) {
    Params p{};
    const float** f = (const float**)&p;
    for (int i = 0; i < 37; ++i) f[i] = (const float*)d_in[i];
    p.out = (float*)d_out;
    p.ws = (char*)d_ws;
    if (ws_size < WS_NEED || n_in < 37) return;
    static int grid = 0;
    if (!grid) {
        int dev = 0, cus = 0;
        (void)hipGetDevice(&dev);
        (void)hipDeviceGetAttribute(&cus, hipDeviceAttributeMultiprocessorCount, dev);
        grid = cus > 0 ? cus : 256;
    }
    (void)hipMemsetAsync(d_ws, 0, 32768, stream);
#if MEGA
    launch_range<0, NPHASE>(p, grid, stream);
#else
    launch_each<0>(p, grid, stream);
#endif
}
```

```cpp
#include <hip/hip_runtime.h>
#include <stdint.h>
#include <stdio.h>

#ifndef MEGA
#define MEGA 1
#endif

typedef unsigned short bf16_t;
typedef short bf16x8 __attribute__((ext_vector_type(8)));
typedef short s16x4 __attribute__((ext_vector_type(4)));
typedef float f32x2 __attribute__((ext_vector_type(2)));
typedef float f32x4 __attribute__((ext_vector_type(4)));
typedef float f32x16 __attribute__((ext_vector_type(16)));
typedef unsigned u32x2 __attribute__((ext_vector_type(2)));
typedef unsigned u32x4 __attribute__((ext_vector_type(4)));
typedef __bf16 bf16x2_t __attribute__((ext_vector_type(2)));
#define DI __device__ __forceinline__

constexpr int DM = 1024, NBATCH = 2, SEQ = 16384, LCTX = 256, PTOT = SEQ + LCTX, TTOT = NBATCH * PTOT;
constexpr int NTH = 512, NWAVE = 8;
constexpr int QKV_N = 1536;
constexpr int NEXP = 16, CAP = TTOT * 2;
constexpr float RMS_EPS = 1e-6f, GN_EPS = 64e-5f;
constexpr float LOG2E = 1.4426950408889634f;

constexpr size_t MBy = 1u << 20;
constexpr size_t OFF_BAR   = 0;
constexpr size_t OFF_CNT   = 16384;
constexpr size_t OFF_MOD   = 32768;
constexpr size_t OFF_ROPE  = OFF_MOD + 2 * 3 * 6144 * 4;
constexpr size_t OFF_BONUS = 1 * MBy;
constexpr size_t OFF_BONUS2 = 6 * MBy;
constexpr size_t OFF_STOK  = 6 * MBy;
constexpr size_t OFF_SW    = 11 * MBy;
constexpr size_t OFF_XC    = 16 * MBy;
constexpr size_t OFF_WS    = 18 * MBy;
constexpr size_t OFF_MOEW  = 33 * MBy;
constexpr size_t OFF_H     = 129 * MBy;
constexpr size_t OFF_SCR   = 194 * MBy;
constexpr size_t SCR_SIZE  = 290 * MBy;
constexpr size_t WS_NEED   = OFF_SCR + SCR_SIZE;
constexpr size_t W_IN = 0, W_OUT = W_IN + 1536 * 1024, W_R = W_OUT + 1024 * 1024, W_K = W_R + 1024 * 1024, W_V = W_K + 1024 * 1024,
                 W_O = W_V + 1024 * 1024, W_W1 = W_O + 1024 * 1024, W_A1 = W_W1 + 128 * 1024, W_G1 = W_A1 + 128 * 1024,
                 W_W2 = W_G1 + 256 * 1024, W_A2 = W_W2 + 2 * 1024 * 64, W_G2 = W_A2 + 2 * 1024 * 64, W_END = W_G2 + 1024 * 192;
static_assert(W_END * 2 <= 15 * MBy, "small weights region");
constexpr size_t ROWB = (size_t)TTOT * 2048;
constexpr size_t S_Q = 0, S_K = S_Q + ROWB, S_VT = S_K + ROWB / 4, S_O = S_VT + ROWB / 4;
constexpr size_t S_HID = 0, S_Y = 140 * MBy;
constexpr size_t S_R = 0, S_KK = S_R + ROWB, S_V = S_KK + ROWB, S_LW = S_V + ROWB, S_LA = S_LW + ROWB / 8, S_LG = S_LA + ROWB / 8,
                 S_Y1 = 224 * MBy, S_XX = S_Y1, S_OR = S_R;
static_assert(S_O + ROWB <= SCR_SIZE, "scr");
static_assert(S_LG + (size_t)TTOT * 384 <= S_Y1, "scr2");
static_assert(S_Y1 + ROWB <= SCR_SIZE, "scr3");
static_assert(S_Y + 2 * ROWB <= SCR_SIZE, "scr4");
static_assert((size_t)(CAP / 256 + 16) * 256 * 2048 <= S_Y, "hid");
static_assert(OFF_H + ROWB <= OFF_SCR, "h");

struct Params {
    const float *x, *c, *ctx, *c_ctx, *ada_w, *ada_b, *norm_mix_g, *norm_ffn_g, *attn_w_in, *attn_w_out, *attn_sink, *attn_q_norm_g, *attn_k_norm_g,
        *rwkv_x_mix, *rwkv_w_r, *rwkv_w_k, *rwkv_w_v, *rwkv_w_o, *rwkv_decay_w0, *rwkv_decay_w1, *rwkv_decay_w2, *rwkv_iclr_a0, *rwkv_iclr_a1,
        *rwkv_iclr_a2, *rwkv_gate_g1, *rwkv_gate_g2, *rwkv_k_k, *rwkv_k_a, *rwkv_r_k, *rwkv_ln_g, *rwkv_ln_b, *router_w, *router_bias, *moe_w1,
        *moe_w3, *moe_w2, *final_norm_g;
    float* out;
    char* ws;
};

DI unsigned pk_bf16(float a, float b) { f32x2 v = {a, b}; bf16x2_t r = __builtin_convertvector(v, bf16x2_t); return __builtin_bit_cast(unsigned, r); }
DI float bf_lo(unsigned u) { return __uint_as_float(u << 16); }
DI float bf_hi(unsigned u) { return __uint_as_float(u & 0xffff0000u); }
DI float bf2f(bf16_t u) { return __uint_as_float(((unsigned)u) << 16); }
DI float wave_sum(float v) {
#pragma unroll
    for (int o = 32; o >= 1; o >>= 1) v += __shfl_xor(v, o);
    return v;
}
DI float sigmoidf_(float x) { return 1.0f / (1.0f + __expf(-x)); }
DI float siluf_(float x) { return x / (1.0f + __expf(-x)); }
DI float* xrow_ptr(const Params& p, int tok) {
    const int b = tok >= PTOT ? 1 : 0, pos = tok - b * PTOT;
    return pos < LCTX ? (float*)(p.ws + OFF_XC) + (size_t)(b * LCTX + pos) * DM : p.out + (size_t)(b * SEQ + pos - LCTX) * DM;
}
DI const float* xin_ptr(const Params& p, int tok) {
    const int b = tok >= PTOT ? 1 : 0, pos = tok - b * PTOT;
    return pos < LCTX ? p.ctx + (size_t)(b * LCTX + pos) * DM : p.x + (size_t)(b * SEQ + pos - LCTX) * DM;
}
DI const float* mod_ptr(const Params& p, int layer, int tok, int which) {
    const int b = tok >= PTOT ? 1 : 0, pos = tok - b * PTOT;
    const int w = pos < LCTX ? 2 : b;
    return (const float*)(p.ws + OFF_MOD) + (size_t)((layer * 3 + w) * 6 + which) * DM;
}

#define XB_TMO      128
#define XB_XCNT(j)  (256  + 64 * (j))
#define XB_XSUB(j)  (1280 + 64 * (j))
#define XB_XGEN(j)  (2304 + 64 * (j))
#define XB_TOP      3328
#define XB_TOPGEN   3392
#define XCD_BAR_WORDS 3456
#define XB_SPIN_CAP (1u << 18)
#define LAS __attribute__((address_space(3)))
DI unsigned xb_ld(unsigned* p)              { return __hip_atomic_load(p, __ATOMIC_RELAXED, __HIP_MEMORY_SCOPE_AGENT); }
DI unsigned xb_add(unsigned* p, unsigned v) { return __hip_atomic_fetch_add(p, v, __ATOMIC_RELAXED, __HIP_MEMORY_SCOPE_AGENT); }
DI unsigned xb_xcc_id() { return (unsigned)__builtin_amdgcn_s_getreg((3 << 11) | 20) & 0xFu; }
#define XB_SPIN(cond, bar) do { unsigned _sp = 0; while (cond) { __builtin_amdgcn_s_sleep(1); \
    if ((++_sp & 255u) == 0u) { if (xb_ld(&(bar)[XB_TMO])) break; if (_sp > XB_SPIN_CAP) { atomicAdd(&(bar)[XB_TMO], 1u); break; } } } } while (0)
struct XcdBarrier { unsigned* bar; unsigned x; volatile LAS unsigned* st; };
DI XcdBarrier xcd_barrier_post(unsigned* bar, volatile LAS unsigned* st) {
    XcdBarrier b; b.bar = bar; b.x = xb_xcc_id(); b.st = st;
    if (threadIdx.x == 0) (void)xb_add(&bar[XB_XCNT(b.x)], 1u);
    return b;
}
DI void xcd_barrier_complete(unsigned* bar, unsigned x, unsigned& nloc, unsigned& nx) {
    const unsigned G = gridDim.x * gridDim.y * gridDim.z;
    unsigned sum, cnt, mine, sp = 0u;
    for (;;) {
        sum = 0u; cnt = 0u; mine = 0u;
#pragma unroll
        for (unsigned j = 0; j < 16; ++j) { const unsigned c = xb_ld(&bar[XB_XCNT(j)]); sum += c; cnt += (c > 0u) ? 1u : 0u; mine = (j == x) ? c : mine; }
        if (sum == G) break;
        __builtin_amdgcn_s_sleep(1);
        if ((++sp & 255u) == 0u) { if (xb_ld(&bar[XB_TMO])) break; if (sp > XB_SPIN_CAP) { atomicAdd(&bar[XB_TMO], 1u); break; } }
    }
    nloc = mine > 0u ? mine : 1u; nx = cnt > 0u ? cnt : 1u;
}
DI void xcd_barrier(const XcdBarrier& b) {
    asm volatile("s_waitcnt vmcnt(0)" ::: "memory");
    __syncthreads();
    if (threadIdx.x == 0) {
        unsigned* bar = b.bar;
        __builtin_amdgcn_s_waitcnt(0);
        unsigned nloc = b.st[0], nx = b.st[1];
        if (nloc == 0u) { xcd_barrier_complete(bar, b.x, nloc, nx); b.st[0] = nloc; b.st[1] = nx; }
        const unsigned old = xb_add(&bar[XB_XSUB(b.x)], 1u);
        const unsigned gen = old / nloc;
        if (old + 1u == (gen + 1u) * nloc) {
            __builtin_amdgcn_fence(__ATOMIC_RELEASE, "agent");
            asm volatile("s_waitcnt vmcnt(0)" ::: "memory");
            const unsigned og = xb_add(&bar[XB_TOP], 1u);
            const unsigned tg = og / nx;
            if (og + 1u == (tg + 1u) * nx) xb_add(&bar[XB_TOPGEN], 1u);
            else XB_SPIN(xb_ld(&bar[XB_TOPGEN]) == tg, bar);
            __builtin_amdgcn_fence(__ATOMIC_ACQUIRE, "agent");
            xb_add(&bar[XB_XGEN(b.x)], 1u);
            asm volatile("s_waitcnt vmcnt(0)" ::: "memory");
        } else {
            XB_SPIN(xb_ld(&bar[XB_XGEN(b.x)]) == gen, bar);
            __builtin_amdgcn_fence(__ATOMIC_ACQUIRE, "agent");
            asm volatile("s_waitcnt vmcnt(0)" ::: "memory");
        }
    }
    __syncthreads();
}

DI void cvt_tile(const float* src, int ld, int kvalid, bool colvalid, bf16_t* dst, int dld, float* tile  ) {
    const int t = threadIdx.x;
    {
        const int k = t >> 3, c4 = (t & 7) * 4;
        f32x4 v = {0.f, 0.f, 0.f, 0.f};
        if (colvalid && k < kvalid) v = *(const f32x4*)(src + (size_t)k * ld + c4);
        tile[k * 33 + c4 + 0] = v[0]; tile[k * 33 + c4 + 1] = v[1]; tile[k * 33 + c4 + 2] = v[2]; tile[k * 33 + c4 + 3] = v[3];
    }
    __syncthreads();
    {
        const int n = t >> 4, kc = (t & 15) * 4;
        u32x2 w;
        w[0] = pk_bf16(tile[(kc + 0) * 33 + n], tile[(kc + 1) * 33 + n]);
        w[1] = pk_bf16(tile[(kc + 2) * 33 + n], tile[(kc + 3) * 33 + n]);
        *(u32x2*)(dst + (size_t)n * dld + kc) = w;
    }
    __syncthreads();
}
constexpr int CV_SMALL_UNITS = 768 + 512 * 5 + 64 + 64 + 128 + 64 + 64 + 96;
DI void cvt_small_unit(const Params& p, int u, float* tile) {
    bf16_t* wsm = (bf16_t*)(p.ws + OFF_WS);
    if (u < 768) { const int run = u >> 4, kt = u & 15; cvt_tile(p.attn_w_in + (size_t)kt * 64 * 1536 + run * 32, 1536, 64, true, wsm + W_IN + (size_t)run * 32 * 1024 + kt * 64, 1024, tile); return; }
    u -= 768;
    if (u < 512 * 5) {
        const int j = u >> 9, v = u & 511, run = v >> 4, kt = v & 15;
        const float* src = j == 0 ? p.attn_w_out : j == 1 ? p.rwkv_w_r : j == 2 ? p.rwkv_w_k : j == 3 ? p.rwkv_w_v : p.rwkv_w_o;
        const size_t dofs = j == 0 ? W_OUT : j == 1 ? W_R : j == 2 ? W_K : j == 3 ? W_V : W_O;
        cvt_tile(src + (size_t)kt * 64 * 1024 + run * 32, 1024, 64, true, wsm + dofs + (size_t)run * 32 * 1024 + kt * 64, 1024, tile); return;
    }
    u -= 512 * 5;
    if (u < 128) {
        const int j = u >> 6, v = u & 63, run = v >> 4, kt = v & 15, d = run >> 1, co = (run & 1) * 32;
        const float* src = (j == 0 ? p.rwkv_decay_w1 : p.rwkv_iclr_a1) + (size_t)d * 1024 * 64;
        cvt_tile(src + (size_t)kt * 64 * 64 + co, 64, 64, true, wsm + (j == 0 ? W_W1 : W_A1) + (size_t)run * 32 * 1024 + kt * 64, 1024, tile); return;
    }
    u -= 128;
    if (u < 128) {
        const int run = u >> 4, kt = u & 15;
        cvt_tile(p.rwkv_gate_g1 + (size_t)kt * 64 * 160 + run * 32, 160, 64, run < 5, wsm + W_G1 + (size_t)run * 32 * 1024 + kt * 64, 1024, tile); return;
    }
    u -= 128;
    if (u < 128) {
        const int j = u >> 6, v = u & 63, d = v >> 5, run = v & 31;
        const float* src = (j == 0 ? p.rwkv_decay_w2 : p.rwkv_iclr_a2) + (size_t)d * 64 * 1024;
        cvt_tile(src + run * 32, 1024, 64, true, wsm + (j == 0 ? W_W2 : W_A2) + (size_t)d * 1024 * 64 + (size_t)run * 32 * 64, 64, tile); return;
    }
    u -= 128;
    {
        const int run = u / 3, kt = u % 3;
        const int kvalid = 160 - kt * 64 > 64 ? 64 : (160 - kt * 64 < 0 ? 0 : 160 - kt * 64);
        cvt_tile(p.rwkv_gate_g2 + (size_t)kt * 64 * 1024 + run * 32, 1024, kvalid, true, wsm + W_G2 + (size_t)run * 32 * 192 + kt * 64, 192, tile);
    }
}
constexpr int CV_MOE_UNITS = 16 * (1024 + 512);
DI void cvt_moe_unit(const Params& p, int layer, int u, float* tile) {
    bf16_t* w13 = (bf16_t*)(p.ws + OFF_MOEW);
    bf16_t* w2t = w13 + (size_t)16 * 2048 * 1024;
    const int e = u / 1536, v = u % 1536;
    const size_t eo = (size_t)(layer * 16 + e) * 1024 * 1024;
    if (v < 1024) {
        const int run = v >> 4, kt = v & 15, g = run >> 1;
        const float* src = ((run & 1) ? p.moe_w3 : p.moe_w1) + eo;
        cvt_tile(src + (size_t)kt * 64 * 1024 + g * 32, 1024, 64, true, w13 + (size_t)e * 2048 * 1024 + (size_t)run * 32 * 1024 + kt * 64, 1024, tile);
    } else {
        const int w = v - 1024, run = w >> 4, kt = w & 15;
        cvt_tile(p.moe_w2 + eo + (size_t)kt * 64 * 1024 + run * 32, 1024, 64, true, w2t + (size_t)e * 1024 * 1024 + (size_t)run * 32 * 1024 + kt * 64, 1024, tile);
    }
}
DI void adaln_unit(const Params& p, int u, float* sm) {
    const int l = u / 96, n0 = (u % 96) * 64, t = threadIdx.x;
    float* sv = sm;
    float* red = sm + 3 * 1024;
    for (int i = t; i < 3 * 1024; i += NTH) { const int w = i >> 10, k = i & 1023; const float c = w < 2 ? p.c[w * 1024 + k] : p.c_ctx[k]; sv[i] = siluf_(c); }
    __syncthreads();
    const int kg = t >> 4, cl = t & 15;
    f32x4 a0 = {0, 0, 0, 0}, a1 = a0, a2 = a0;
    const float* W = p.ada_w + (size_t)l * 1024 * 6144 + n0 + cl * 4;
#pragma unroll 8
    for (int i = 0; i < 32; ++i) {
        const int k = kg + 32 * i;
        const f32x4 w = *(const f32x4*)(W + (size_t)k * 6144);
        a0 += w * sv[k]; a1 += w * sv[1024 + k]; a2 += w * sv[2048 + k];
    }
#pragma unroll
    for (int j = 0; j < 4; ++j) { red[kg * 192 + 0 * 64 + cl * 4 + j] = a0[j]; red[kg * 192 + 1 * 64 + cl * 4 + j] = a1[j]; red[kg * 192 + 2 * 64 + cl * 4 + j] = a2[j]; }
    __syncthreads();
    if (t < 192) {
        float s = 0.f;
        for (int g = 0; g < 32; ++g) s += red[g * 192 + t];
        const int w = t >> 6, n = n0 + (t & 63);
        ((float*)(p.ws + OFF_MOD))[(size_t)(l * 3 + w) * 6144 + n] = s + p.ada_b[l * 6144 + n];
    }
    __syncthreads();
}
DI void rope_unit(const Params& p, int u) {
    const int id = u * NTH + threadIdx.x;
    if (id < 320 * 16) {
        const int pi = id >> 4, f = id & 15;
        const float inv = exp2f(-(float)f * (13.287712379549449f / 16.0f));
        const float val = pi < 256 ? (float)pi : (float)(pi - 256);
        const float ang = val * inv;
        const double a = (double)ang;
        const double k = __builtin_rint(a * 0.15915494309189535);
        const float r = (float)(a - k * 6.283185307179586);
        f32x2 cs = {__cosf(r), __sinf(r)};
        ((f32x2*)(p.ws + OFF_ROPE))[id] = cs;
    }
}
DI void phase_prologue(const Params& p, char* smem) {
    float* sm = (float*)smem;
    const int nconv = CV_SMALL_UNITS + CV_MOE_UNITS;
    const int total = nconv + 192 + 10;
    for (int u = blockIdx.x; u < total; u += gridDim.x) {
        if (u < CV_SMALL_UNITS) cvt_small_unit(p, u, sm);
        else if (u < nconv) cvt_moe_unit(p, 0, u - CV_SMALL_UNITS, sm);
        else if (u < nconv + 192) adaln_unit(p, u - nconv, sm);
        else rope_unit(p, u - nconv - 192);
    }
}

DI void row_load(const float* src, f32x4 (&v)[4], int lane) {
#pragma unroll
    for (int i = 0; i < 4; ++i) v[i] = ((const f32x4*)src)[lane + 64 * i];
}
DI float row_rstd(const f32x4 (&v)[4]) {
    float ss = 0.f;
#pragma unroll
    for (int i = 0; i < 4; ++i) ss += v[i][0] * v[i][0] + v[i][1] * v[i][1] + v[i][2] * v[i][2] + v[i][3] * v[i][3];
    ss = wave_sum(ss);
    return rsqrtf(ss * (1.0f / DM) + RMS_EPS);
}
DI void row_norm_mod(const f32x4 (&v)[4], float rstd, const float* g, const float* shift, const float* scale, f32x4 (&h)[4], int lane) {
#pragma unroll
    for (int i = 0; i < 4; ++i) {
        const int c = (lane + 64 * i) * 4;
        const f32x4 g4 = *(const f32x4*)(g + c), sh = *(const f32x4*)(shift + c), sc = *(const f32x4*)(scale + c);
        h[i] = (v[i] * rstd * g4) * (1.0f + sc) + sh;
    }
}
DI void row_store_bf16(bf16_t* dst, const f32x4 (&h)[4], int lane) {
#pragma unroll
    for (int i = 0; i < 4; ++i) { u32x2 w; w[0] = pk_bf16(h[i][0], h[i][1]); w[1] = pk_bf16(h[i][2], h[i][3]); *(u32x2*)(dst + (lane + 64 * i) * 4) = w; }
}
DI void row_load_bf16(const bf16_t* src, f32x4 (&v)[4], int lane) {
#pragma unroll
    for (int i = 0; i < 4; ++i) { const u32x2 w = *(const u32x2*)(src + (lane + 64 * i) * 4); v[i][0] = bf_lo(w[0]); v[i][1] = bf_hi(w[0]); v[i][2] = bf_lo(w[1]); v[i][3] = bf_hi(w[1]); }
}

DI void phase_norm0(const Params& p) {
    const int lane = threadIdx.x & 63, gw = blockIdx.x * NWAVE + (threadIdx.x >> 6), nw = gridDim.x * NWAVE;
    bf16_t* H = (bf16_t*)(p.ws + OFF_H);
    for (int tok = gw; tok < TTOT; tok += nw) {
        f32x4 v[4], h[4];
        row_load(xin_ptr(p, tok), v, lane);
        const float rstd = row_rstd(v);
        row_norm_mod(v, rstd, p.norm_mix_g, mod_ptr(p, 0, tok, 0), mod_ptr(p, 0, tok, 1), h, lane);
        row_store_bf16(H + (size_t)tok * DM, h, lane);
    }
}

DI void route_row(const Params& p, const float (&lg)[16], int& e1, int& e2, float& g1, float& g2) {
    float mx = lg[0];
#pragma unroll
    for (int e = 1; e < 16; ++e) mx = fmaxf(mx, lg[e]);
    float pr[16], sum = 0.f;
#pragma unroll
    for (int e = 0; e < 16; ++e) { pr[e] = __expf(lg[e] - mx); sum += pr[e]; }
    const float inv = 1.0f / sum;
    float sel[16];
#pragma unroll
    for (int e = 0; e < 16; ++e) { pr[e] *= inv; sel[e] = pr[e] + p.router_bias[e]; }
    float best = -1e30f; int gi = 0;
#pragma unroll
    for (int g = 0; g < 4; ++g) {
        float m1 = -1e30f, m2 = -1e30f;
#pragma unroll
        for (int j = 0; j < 4; ++j) { const float s = sel[g * 4 + j]; if (s > m1) { m2 = m1; m1 = s; } else if (s > m2) m2 = s; }
        const float gs = m1 + m2;
        if (gs > best) { best = gs; gi = g; }
    }
    float s4[4], p4[4];
#pragma unroll
    for (int j = 0; j < 4; ++j) {
        s4[j] = gi == 0 ? sel[j] : gi == 1 ? sel[4 + j] : gi == 2 ? sel[8 + j] : sel[12 + j];
        p4[j] = gi == 0 ? pr[j] : gi == 1 ? pr[4 + j] : gi == 2 ? pr[8 + j] : pr[12 + j];
    }
    int i1 = 0; float b1 = s4[0];
#pragma unroll
    for (int j = 1; j < 4; ++j) if (s4[j] > b1) { b1 = s4[j]; i1 = j; }
    int i2 = i1 == 0 ? 1 : 0; float b2 = -3e38f;
#pragma unroll
    for (int j = 0; j < 4; ++j) if (j != i1 && s4[j] > b2) { b2 = s4[j]; i2 = j; }
    const float w1 = i1 == 0 ? p4[0] : i1 == 1 ? p4[1] : i1 == 2 ? p4[2] : p4[3];
    const float w2 = i2 == 0 ? p4[0] : i2 == 1 ? p4[1] : i2 == 2 ? p4[2] : p4[3];
    const float ws = 1.0f / (w1 + w2);
    e1 = gi * 4 + i1; e2 = gi * 4 + i2; g1 = w1 * ws; g2 = w2 * ws;
}
DI void phase_ffn_norm_route(const Params& p, int layer, char* smem) {
    const int lane = threadIdx.x & 63, gw = blockIdx.x * NWAVE + (threadIdx.x >> 6), nw = gridDim.x * NWAVE;
    float* rw = (float*)smem;
    for (int i = threadIdx.x; i < 1024 * 16; i += NTH) rw[(i & 15) * 1024 + (i >> 4)] = p.router_w[i];
    __syncthreads();
    bf16_t* H = (bf16_t*)(p.ws + OFF_H);
    int* lcnt = (int*)(smem + 65536);
    if (threadIdx.x < 32) lcnt[threadIdx.x] = 0;
    int my_tok = -1, my_e1 = 0, my_e2 = 0, it = 0; float my_g1 = 0.f, my_g2 = 0.f;
    for (int tok = gw; tok < TTOT; tok += nw) {
        const int pos = tok >= PTOT ? tok - PTOT : tok;
        if (layer == 1 && pos < LCTX) continue;
        f32x4 v[4], h[4];
        row_load(xrow_ptr(p, tok), v, lane);
        const float rstd = row_rstd(v);
        row_norm_mod(v, rstd, p.norm_ffn_g + layer * DM, mod_ptr(p, layer, tok, 3), mod_ptr(p, layer, tok, 4), h, lane);
        row_store_bf16(H + (size_t)tok * DM, h, lane);
        float lg[16];
#pragma unroll
        for (int e = 0; e < 16; ++e) lg[e] = 0.f;
#pragma unroll
        for (int i = 0; i < 4; ++i)
#pragma unroll
            for (int e = 0; e < 16; ++e) {
                const f32x4 w = *(const f32x4*)(rw + e * 1024 + (lane + 64 * i) * 4);
                lg[e] += h[i][0] * w[0] + h[i][1] * w[1] + h[i][2] * w[2] + h[i][3] * w[3];
                if ((e & 3) == 3) asm volatile("" ::: "memory");
            }
#pragma unroll
        for (int e = 0; e < 16; ++e) lg[e] = wave_sum(lg[e]);
        int e1, e2; float g1, g2;
        route_row(p, lg, e1, e2, g1, g2);
        if (lane == it) { my_tok = tok; my_e1 = e1; my_e2 = e2; my_g1 = g1; my_g2 = g2; }
        ++it;
    }
    __syncthreads();
    int r1 = 0, r2 = 0;
    if (my_tok >= 0) { r1 = atomicAdd(&lcnt[my_e1], 1); r2 = atomicAdd(&lcnt[my_e2], 1); }
    __syncthreads();
    if (threadIdx.x < 16) { const int n = lcnt[threadIdx.x]; lcnt[16 + threadIdx.x] = n ? atomicAdd((int*)(p.ws + OFF_CNT) + layer * 16 + threadIdx.x, n) : 0; }
    __syncthreads();
    if (my_tok >= 0) {
        int* stok = (int*)(p.ws + OFF_STOK);
        float* sw = (float*)(p.ws + OFF_SW);
        const size_t s1 = (size_t)my_e1 * CAP + lcnt[16 + my_e1] + r1, s2 = (size_t)my_e2 * CAP + lcnt[16 + my_e2] + r2;
        stok[s1] = my_tok * 2 + 0; sw[s1] = my_g1;
        stok[s2] = my_tok * 2 + 1; sw[s2] = my_g2;
    }
    __syncthreads();
}

DI void combine_row(const Params& p, int layer, int tok, f32x4 (&v)[4], int lane) {
    const bf16_t* Y = (const bf16_t*)(p.ws + OFF_SCR + S_Y) + (size_t)tok * 2 * DM;
    const float* g5 = mod_ptr(p, layer, tok, 5);
    f32x4 y0[4], y1[4];
    row_load(xrow_ptr(p, tok), v, lane);
    row_load_bf16(Y, y0, lane); row_load_bf16(Y + DM, y1, lane);
#pragma unroll
    for (int i = 0; i < 4; ++i) { const f32x4 g = *(const f32x4*)(g5 + (lane + 64 * i) * 4); v[i] += g * (y0[i] + y1[i]); }
}
DI void phase_combine_l0(const Params& p, char* smem) {
    const int lane = threadIdx.x & 63, gw = blockIdx.x * NWAVE + (threadIdx.x >> 6), nw = gridDim.x * NWAVE;
    bf16_t* H = (bf16_t*)(p.ws + OFF_H);
    for (int tok = gw; tok < TTOT; tok += nw) {
        f32x4 v[4], h[4];
        combine_row(p, 0, tok, v, lane);
        float* X = xrow_ptr(p, tok);
#pragma unroll
        for (int i = 0; i < 4; ++i) ((f32x4*)X)[lane + 64 * i] = v[i];
        const float rstd = row_rstd(v);
        row_norm_mod(v, rstd, p.norm_mix_g + DM, mod_ptr(p, 1, tok, 0), mod_ptr(p, 1, tok, 1), h, lane);
        row_store_bf16(H + (size_t)tok * DM, h, lane);
    }
    __syncthreads();
    for (int u = blockIdx.x; u < CV_MOE_UNITS; u += gridDim.x) cvt_moe_unit(p, 1, u, (float*)smem);
}
DI void phase_xx(const Params& p) {
    const int lane = threadIdx.x & 63, gw = blockIdx.x * NWAVE + (threadIdx.x >> 6), nw = gridDim.x * NWAVE;
    const bf16_t* H = (const bf16_t*)(p.ws + OFF_H);
    bf16_t* XX = (bf16_t*)(p.ws + OFF_SCR + S_XX);
    for (int tok = gw; tok < TTOT; tok += nw) {
        const int pos = tok >= PTOT ? tok - PTOT : tok;
        const bool first = pos == 0 || pos == LCTX, last = pos == LCTX - 1 || pos == PTOT - 1;
        f32x4 hc[4], hp[4], hn[4], xx[4];
        row_load_bf16(H + (size_t)tok * DM, hc, lane);
        row_load_bf16(H + (size_t)(first ? tok : tok - 1) * DM, hp, lane);
        row_load_bf16(H + (size_t)(last ? tok : tok + 1) * DM, hn, lane);
#pragma unroll
        for (int i = 0; i < 4; ++i) {
            const f32x4 a = first ? (f32x4){0, 0, 0, 0} : hp[i], b = last ? (f32x4){0, 0, 0, 0} : hn[i];
            xx[i] = 0.5f * (a + b) - hc[i];
        }
        row_store_bf16(XX + (size_t)tok * DM, xx, lane);
    }
}
DI void phase_final(const Params& p) {
    const int lane = threadIdx.x & 63, gw = blockIdx.x * NWAVE + (threadIdx.x >> 6), nw = gridDim.x * NWAVE;
    for (int r = gw; r < NBATCH * SEQ; r += nw) {
        const int b = r / SEQ, tok = b * PTOT + LCTX + (r - b * SEQ);
        f32x4 v[4];
        combine_row(p, 1, tok, v, lane);
        const float rstd = row_rstd(v);
        float* O = p.out + (size_t)r * DM;
#pragma unroll
        for (int i = 0; i < 4; ++i) { const f32x4 g = *(const f32x4*)(p.final_norm_g + (lane + 64 * i) * 4); ((f32x4*)O)[lane + 64 * i] = v[i] * rstd * g; }
    }
}

constexpr int LDSROW = 72;
constexpr int GEMM_SMEM = 2 * (256 + 128) * LDSROW * 2;
template <class AL, class EPI>
DI void gemm_tile(AL& al, const bf16_t* __restrict__ Bt, int ldb, int nk, EPI& epi, char* smem) {
    const int t = threadIdx.x, lane = t & 63, wid = t >> 6, wr = wid >> 1, wc = wid & 1, fr = lane & 15, fq = lane >> 4;
    bf16_t* sA = (bf16_t*)smem;
    bf16_t* sB = sA + 2 * 256 * LDSROW;
    f32x4 acc[4][4];
#pragma unroll
    for (int m = 0; m < 4; ++m)
#pragma unroll
        for (int n = 0; n < 4; ++n) acc[m][n] = (f32x4){0.f, 0.f, 0.f, 0.f};
    const int lr = t >> 3, lc = (t & 7) * 8;
    u32x4 ra[4], rb[2];
#pragma unroll
    for (int i = 0; i < 4; ++i) ra[i] = al.load(lr + 64 * i, lc, i);
#pragma unroll
    for (int i = 0; i < 2; ++i) rb[i] = *(const u32x4*)(Bt + (size_t)(lr + 64 * i) * ldb + lc);
#pragma unroll
    for (int i = 0; i < 4; ++i) *(u32x4*)(sA + (lr + 64 * i) * LDSROW + lc) = ra[i];
#pragma unroll
    for (int i = 0; i < 2; ++i) *(u32x4*)(sB + (lr + 64 * i) * LDSROW + lc) = rb[i];
    __syncthreads();
    bf16x8 af[2][4], bfr[2][4];
    {
        const bf16_t* cA = sA + (wr * 64 + fr) * LDSROW + fq * 8;
        const bf16_t* cB = sB + (wc * 64 + fr) * LDSROW + fq * 8;
#pragma unroll
        for (int m = 0; m < 4; ++m) af[0][m] = *(const bf16x8*)(cA + m * 16 * LDSROW);
#pragma unroll
        for (int n = 0; n < 4; ++n) bfr[0][n] = *(const bf16x8*)(cB + n * 16 * LDSROW);
    }
    for (int kt = 0; kt < nk; ++kt) {
        const int cur = kt & 1;
        const bool more = kt + 1 < nk;
        if (more) {
#pragma unroll
            for (int i = 0; i < 4; ++i) ra[i] = al.load(lr + 64 * i, (kt + 1) * 64 + lc, i);
#pragma unroll
            for (int i = 0; i < 2; ++i) rb[i] = *(const u32x4*)(Bt + (size_t)(lr + 64 * i) * ldb + (kt + 1) * 64 + lc);
        }
        const bf16_t* cA = sA + cur * 256 * LDSROW + (wr * 64 + fr) * LDSROW + fq * 8;
        const bf16_t* cB = sB + cur * 128 * LDSROW + (wc * 64 + fr) * LDSROW + fq * 8;
#pragma unroll
        for (int m = 0; m < 4; ++m) af[1][m] = *(const bf16x8*)(cA + m * 16 * LDSROW + 32);
#pragma unroll
        for (int n = 0; n < 4; ++n) bfr[1][n] = *(const bf16x8*)(cB + n * 16 * LDSROW + 32);
#pragma unroll
        for (int m = 0; m < 4; ++m)
#pragma unroll
            for (int n = 0; n < 4; ++n) acc[m][n] = __builtin_amdgcn_mfma_f32_16x16x32_bf16(bfr[0][n], af[0][m], acc[m][n], 0, 0, 0);
        if (more) {
            bf16_t* nA = sA + (cur ^ 1) * 256 * LDSROW;
            bf16_t* nB = sB + (cur ^ 1) * 128 * LDSROW;
#pragma unroll
            for (int i = 0; i < 4; ++i) *(u32x4*)(nA + (lr + 64 * i) * LDSROW + lc) = ra[i];
#pragma unroll
            for (int i = 0; i < 2; ++i) *(u32x4*)(nB + (lr + 64 * i) * LDSROW + lc) = rb[i];
        }
#pragma unroll
        for (int m = 0; m < 4; ++m)
#pragma unroll
            for (int n = 0; n < 4; ++n) acc[m][n] = __builtin_amdgcn_mfma_f32_16x16x32_bf16(bfr[1][n], af[1][m], acc[m][n], 0, 0, 0);
        __syncthreads();
        if (more) {
            const bf16_t* dA = sA + (cur ^ 1) * 256 * LDSROW + (wr * 64 + fr) * LDSROW + fq * 8;
            const bf16_t* dB = sB + (cur ^ 1) * 128 * LDSROW + (wc * 64 + fr) * LDSROW + fq * 8;
#pragma unroll
            for (int m = 0; m < 4; ++m) af[0][m] = *(const bf16x8*)(dA + m * 16 * LDSROW);
#pragma unroll
            for (int n = 0; n < 4; ++n) bfr[0][n] = *(const bf16x8*)(dB + n * 16 * LDSROW);
        }
    }
    epi(acc, wr * 64, wc * 64, fr, fq);
}
struct ALPlain {
    const bf16_t* A; int lda;
    DI u32x4 load(int r, int k, int) const { return *(const u32x4*)(A + (size_t)r * lda + k); }
};
struct ALGather {
    const bf16_t* rowp[4];
    DI u32x4 load(int, int k, int i) const { return *(const u32x4*)(rowp[i] + k); }
};
struct ALMix {
    const bf16_t* H; const bf16_t* XX; const float* xm;
    DI u32x4 load(int r, int k, int) const {
        const u32x4 h = *(const u32x4*)(H + (size_t)r * DM + k), x = *(const u32x4*)(XX + (size_t)r * DM + k);
        const f32x4 m0 = *(const f32x4*)(xm + k), m1 = *(const f32x4*)(xm + k + 4);
        u32x4 o;
        o[0] = pk_bf16(bf_lo(h[0]) + bf_lo(x[0]) * m0[0], bf_hi(h[0]) + bf_hi(x[0]) * m0[1]);
        o[1] = pk_bf16(bf_lo(h[1]) + bf_lo(x[1]) * m0[2], bf_hi(h[1]) + bf_hi(x[1]) * m0[3]);
        o[2] = pk_bf16(bf_lo(h[2]) + bf_lo(x[2]) * m1[0], bf_hi(h[2]) + bf_hi(x[2]) * m1[1]);
        o[3] = pk_bf16(bf_lo(h[3]) + bf_lo(x[3]) * m1[2], bf_hi(h[3]) + bf_hi(x[3]) * m1[3]);
        return o;
    }
};

struct EpiQKV {
    const Params* p; int m0, n0;
    DI void operator()(const f32x4 (&acc)[4][4], int rb, int cb, int fr, int fq) const {
        const int hs = (n0 + cb) >> 6;
        const bool isq = hs < 8 || (hs >= 12 && hs < 20), isv = (hs >= 10 && hs < 12) || hs >= 22, normed = hs >= 12 && hs < 22;
        const float* gam = hs < 20 ? p->attn_q_norm_g : p->attn_k_norm_g;
        const f32x2* rope = (const f32x2*)(p->ws + OFF_ROPE);
        bf16_t* Q = (bf16_t*)(p->ws + OFF_SCR + S_Q);
        bf16_t* K = (bf16_t*)(p->ws + OFF_SCR + S_K);
        bf16_t* VT = (bf16_t*)(p->ws + OFF_SCR + S_VT);
#pragma unroll
        for (int m = 0; m < 4; ++m) {
            const int tok = m0 + rb + m * 16 + fr, b = tok >= PTOT ? 1 : 0, pos = tok - b * PTOT;
            f32x4 v[4];
#pragma unroll
            for (int n = 0; n < 4; ++n) v[n] = acc[m][n];
            if (normed) {
                float ss = 0.f;
#pragma unroll
                for (int n = 0; n < 4; ++n) ss += v[n][0] * v[n][0] + v[n][1] * v[n][1] + v[n][2] * v[n][2] + v[n][3] * v[n][3];
                ss += __shfl_xor(ss, 16); ss += __shfl_xor(ss, 32);
                const float rstd = rsqrtf(ss * (1.0f / 64.0f) + RMS_EPS);
#pragma unroll
                for (int n = 0; n < 4; ++n) { const f32x4 g = *(const f32x4*)(gam + n * 16 + fq * 4); v[n] = v[n] * rstd * g; }
            }
            if (!isv && pos >= LCTX) {
                const int t = pos - LCTX, prow = t >> 6, pcol = t & 63;
#pragma unroll
                for (int a = 0; a < 2; ++a) {
                    const f32x2* tb = rope + (a == 0 ? prow : 256 + pcol) * 16 + fq * 4;
#pragma unroll
                    for (int j = 0; j < 4; ++j) {
                        const f32x2 cs = tb[j];
                        const float x0 = v[2 * a][j], x1 = v[2 * a + 1][j];
                        v[2 * a][j] = x0 * cs[0] - x1 * cs[1];
                        v[2 * a + 1][j] = x1 * cs[0] + x0 * cs[1];
                    }
                }
            }
            if (isq) {
                const int hq = hs < 8 ? hs : hs - 4;
                bf16_t* dst = Q + ((size_t)(b * 16 + hq) * PTOT + pos) * 64 + fq * 4;
#pragma unroll
                for (int n = 0; n < 4; ++n) { const f32x4 w = v[n] * (0.125f * LOG2E); u32x2 o; o[0] = pk_bf16(w[0], w[1]); o[1] = pk_bf16(w[2], w[3]); *(u32x2*)(dst + n * 16) = o; }
            } else if (!isv) {
                const int kh = hs < 12 ? hs - 8 : hs - 18;
                bf16_t* dst = K + ((size_t)(b * 4 + kh) * PTOT + pos) * 64 + fq * 4;
#pragma unroll
                for (int n = 0; n < 4; ++n) { u32x2 o; o[0] = pk_bf16(v[n][0], v[n][1]); o[1] = pk_bf16(v[n][2], v[n][3]); *(u32x2*)(dst + n * 16) = o; }
            } else {
                const int vh = hs < 12 ? hs - 10 : hs - 20;
                bf16_t* dst = VT + (size_t)(b * 4 + vh) * 64 * PTOT + pos;
#pragma unroll
                for (int n = 0; n < 4; ++n)
#pragma unroll
                    for (int j = 0; j < 4; ++j) dst[(size_t)(n * 16 + fq * 4 + j) * PTOT] = (bf16_t)(pk_bf16(v[n][j], 0.f) & 0xffffu);
            }
        }
    }
};
DI void phase_qkv(const Params& p, char* smem) {
    const bf16_t* H = (const bf16_t*)(p.ws + OFF_H);
    const bf16_t* W = (const bf16_t*)(p.ws + OFF_WS) + W_IN;
    constexpr int NT = QKV_N / 128, MT = TTOT / 256;
    for (int u = blockIdx.x; u < MT * NT; u += gridDim.x) {
        const int mt = u / NT, nt = u % NT;
        ALPlain al{H + (size_t)mt * 256 * DM, DM};
        EpiQKV epi{&p, mt * 256, nt * 128};
        gemm_tile(al, W + (size_t)nt * 128 * DM, DM, DM / 64, epi, smem);
    }
}

struct EpiResid {
    const Params* p; int m0, n0, layer; bool from_input;
    DI void operator()(const f32x4 (&acc)[4][4], int rb, int cb, int fr, int fq) const {
#pragma unroll
        for (int m = 0; m < 4; ++m) {
            const int tok = m0 + rb + m * 16 + fr;
            const float* xin = from_input ? xin_ptr(*p, tok) : xrow_ptr(*p, tok);
            float* xo = xrow_ptr(*p, tok);
            const float* gate = mod_ptr(*p, layer, tok, 2);
#pragma unroll
            for (int n = 0; n < 4; ++n) {
                const int c = n0 + cb + n * 16 + fq * 4;
                const f32x4 xi = *(const f32x4*)(xin + c), g = *(const f32x4*)(gate + c);
                *(f32x4*)(xo + c) = xi + g * acc[m][n];
            }
        }
    }
};
DI void phase_wout(const Params& p, char* smem) {
    const bf16_t* O = (const bf16_t*)(p.ws + OFF_SCR + S_O);
    const bf16_t* W = (const bf16_t*)(p.ws + OFF_WS) + W_OUT;
    constexpr int NT = 8, MT = TTOT / 256;
    for (int u = blockIdx.x; u < MT * NT; u += gridDim.x) {
        const int mt = u / NT, nt = u % NT;
        ALPlain al{O + (size_t)mt * 256 * DM, DM};
        EpiResid epi{&p, mt * 256, nt * 128, 0, true};
        gemm_tile(al, W + (size_t)nt * 128 * DM, DM, DM / 64, epi, smem);
    }
}
DI void phase_wo(const Params& p, char* smem) {
    const bf16_t* O = (const bf16_t*)(p.ws + OFF_SCR + S_OR);
    const bf16_t* W = (const bf16_t*)(p.ws + OFF_WS) + W_O;
    constexpr int NT = 8, MTL = SEQ / 256;
    for (int u = blockIdx.x; u < NBATCH * MTL * NT; u += gridDim.x) {
        const int mi = u / NT, nt = u % NT, b = mi / MTL, mt = b * (PTOT / 256) + 1 + (mi % MTL);
        ALPlain al{O + (size_t)mt * 256 * DM, DM};
        EpiResid epi{&p, mt * 256, nt * 128, 1, false};
        gemm_tile(al, W + (size_t)nt * 128 * DM, DM, DM / 64, epi, smem);
    }
}

struct MoeSched { int nt[16], base[17]; };
DI void moe_sched(const Params& p, int layer, MoeSched& s, int (&cnt)[16]) {
    const int* c = (const int*)(p.ws + OFF_CNT) + layer * 16;
    int acc = 0;
#pragma unroll
    for (int e = 0; e < 16; ++e) { cnt[e] = c[e]; s.nt[e] = (cnt[e] + 255) >> 8; s.base[e] = acc; acc += s.nt[e]; }
    s.base[16] = acc;
}
struct EpiMoe1 {
    bf16_t* hid;   int n0;
    DI void operator()(const f32x4 (&acc)[4][4], int rb, int cb, int fr, int fq) const {
        const int g = (n0 + cb) >> 6;
#pragma unroll
        for (int m = 0; m < 4; ++m) {
            bf16_t* dst = hid + (size_t)(rb + m * 16 + fr) * 1024 + g * 32 + fq * 4;
#pragma unroll
            for (int n = 0; n < 2; ++n) {
                const f32x4 a = acc[m][n], b = acc[m][n + 2];
                u32x2 o;
                o[0] = pk_bf16(siluf_(a[0]) * b[0], siluf_(a[1]) * b[1]);
                o[1] = pk_bf16(siluf_(a[2]) * b[2], siluf_(a[3]) * b[3]);
                *(u32x2*)(dst + n * 16) = o;
            }
        }
    }
};
DI void phase_moe1(const Params& p, int layer, char* smem) {
    MoeSched s; int cnt[16];
    moe_sched(p, layer, s, cnt);
    const bf16_t* H = (const bf16_t*)(p.ws + OFF_H);
    const bf16_t* W13 = (const bf16_t*)(p.ws + OFF_MOEW);
    const int* stok = (const int*)(p.ws + OFF_STOK);
    bf16_t* hid = (bf16_t*)(p.ws + OFF_SCR + S_HID);
    constexpr int NT = 16;
    const int total = s.base[16] * NT;
    const int lr = threadIdx.x >> 3;
    for (int u = blockIdx.x; u < total; u += gridDim.x) {
        const int mg = u / NT, nt = u % NT;
        int e = 0;
#pragma unroll
        for (int i = 1; i < 16; ++i) if (mg >= s.base[i]) e = i;
        int ce = 0;
#pragma unroll
        for (int i = 0; i < 16; ++i) if (i == e) ce = cnt[i];
        int be = 0;
#pragma unroll
        for (int i = 0; i < 16; ++i) if (i == e) be = s.base[i];
        const int ml = mg - be;
        ALGather al;
#pragma unroll
        for (int i = 0; i < 4; ++i) {
            const int r = ml * 256 + lr + 64 * i;
            const int tk = r < ce ? (stok[(size_t)e * CAP + r] >> 1) : 0;
            al.rowp[i] = H + (size_t)tk * DM;
        }
        EpiMoe1 epi{hid + (size_t)mg * 256 * 1024, nt * 128};
        gemm_tile(al, W13 + (size_t)e * 2048 * 1024 + (size_t)nt * 128 * 1024, 1024, 16, epi, smem);
    }
}
struct EpiMoe2 {
    bf16_t* Y; const int* stok; const float* sw; int nvalid, n0;
    DI void operator()(const f32x4 (&acc)[4][4], int rb, int cb, int fr, int fq) const {
#pragma unroll
        for (int m = 0; m < 4; ++m) {
            const int r = rb + m * 16 + fr;
            if (r < nvalid) {
                const int tk = stok[r]; const float w = sw[r];
                bf16_t* dst = Y + (size_t)tk * 1024 + n0 + cb + fq * 4;
#pragma unroll
                for (int n = 0; n < 4; ++n) { const f32x4 a = acc[m][n] * w; u32x2 o; o[0] = pk_bf16(a[0], a[1]); o[1] = pk_bf16(a[2], a[3]); *(u32x2*)(dst + n * 16) = o; }
            }
        }
    }
};
DI void phase_moe2(const Params& p, int layer, char* smem) {
    MoeSched s; int cnt[16];
    moe_sched(p, layer, s, cnt);
    const bf16_t* hid = (const bf16_t*)(p.ws + OFF_SCR + S_HID);
    const bf16_t* W2 = (const bf16_t*)(p.ws + OFF_MOEW) + (size_t)16 * 2048 * 1024;
    const int* stok = (const int*)(p.ws + OFF_STOK);
    const float* sw = (const float*)(p.ws + OFF_SW);
    bf16_t* Y = (bf16_t*)(p.ws + OFF_SCR + S_Y);
    constexpr int NT = 8;
    const int total = s.base[16] * NT;
    for (int u = blockIdx.x; u < total; u += gridDim.x) {
        const int mg = u / NT, nt = u % NT;
        int e = 0;
#pragma unroll
        for (int i = 1; i < 16; ++i) if (mg >= s.base[i]) e = i;
        int ce = 0, be = 0;
#pragma unroll
        for (int i = 0; i < 16; ++i) if (i == e) { ce = cnt[i]; be = s.base[i]; }
        const int ml = mg - be;
        ALPlain al{hid + (size_t)mg * 256 * 1024, 1024};
        EpiMoe2 epi{Y, stok + (size_t)e * CAP + ml * 256, sw + (size_t)e * CAP + ml * 256, ce - ml * 256, nt * 128};
        gemm_tile(al, W2 + (size_t)e * 1024 * 1024 + (size_t)nt * 128 * 1024, 1024, 16, epi, smem);
    }
}

struct EpiRwkv {
    bf16_t* dst; int ld, m0, n0, act, nstore;
    DI void operator()(const f32x4 (&acc)[4][4], int rb, int cb, int fr, int fq) const {
#pragma unroll
        for (int m = 0; m < 4; ++m) {
            bf16_t* d = dst + (size_t)(m0 + rb + m * 16 + fr) * ld + n0 + cb + fq * 4;
#pragma unroll
            for (int n = 0; n < 4; ++n) {
                const int c = n0 + cb + n * 16 + fq * 4;
                if (c >= ld) continue;
                f32x4 a = acc[m][n];
                if (act == 1) {
#pragma unroll
                    for (int j = 0; j < 4; ++j) { const float e = __expf(2.0f * a[j]); a[j] = 1.0f - 2.0f / (e + 1.0f); }
                }
                if (act == 2) {
#pragma unroll
                    for (int j = 0; j < 4; ++j) a[j] = sigmoidf_(a[j]);
                }
                if (c >= nstore) a = (f32x4){0.f, 0.f, 0.f, 0.f};
                u32x2 o; o[0] = pk_bf16(a[0], a[1]); o[1] = pk_bf16(a[2], a[3]);
                *(u32x2*)(d + n * 16) = o;
            }
        }
    }
};
DI void phase_rwkv_proj(const Params& p, char* smem) {
    const bf16_t* H = (const bf16_t*)(p.ws + OFF_H);
    const bf16_t* XX = (const bf16_t*)(p.ws + OFF_SCR + S_XX);
    const bf16_t* wsm = (const bf16_t*)(p.ws + OFF_WS);
    constexpr int MT = TTOT / 256, NTT = 8 + 8 + 8 + 1 + 1 + 2;
    for (int u = blockIdx.x; u < MT * NTT; u += gridDim.x) {
        const int mt = u / NTT, q = u % NTT;
        int job, nt;
        if (q < 8) { job = 0; nt = q; } else if (q < 16) { job = 1; nt = q - 8; } else if (q < 24) { job = 2; nt = q - 16; }
        else if (q == 24) { job = 3; nt = 0; } else if (q == 25) { job = 4; nt = 0; } else { job = 5; nt = q - 26; }
        const int mixj = job == 0 ? 0 : job == 1 ? 2 : job == 2 ? 3 : job == 3 ? 1 : job == 4 ? 4 : 5;
        const size_t wofs = job == 0 ? W_R : job == 1 ? W_K : job == 2 ? W_V : job == 3 ? W_W1 : job == 4 ? W_A1 : W_G1;
        const size_t dofs = job == 0 ? S_R : job == 1 ? S_KK : job == 2 ? S_V : job == 3 ? S_LW : job == 4 ? S_LA : S_LG;
        const int ld = job < 3 ? 1024 : job < 5 ? 128 : 192;
        ALMix al{H + (size_t)mt * 256 * DM, XX + (size_t)mt * 256 * DM, p.rwkv_x_mix + mixj * DM};
        EpiRwkv epi{(bf16_t*)(p.ws + OFF_SCR + dofs), ld, mt * 256, nt * 128, job == 3 ? 1 : job == 5 ? 2 : 0, job == 5 ? 160 : 4096};
        gemm_tile(al, wsm + wofs + (size_t)nt * 128 * DM, DM, DM / 64, epi, smem);
    }
}

struct EpiGate {
    const Params* p; int m0, n0;
    DI void operator()(const f32x4 (&acc)[4][4], int rb, int cb, int fr, int fq) const {
        const bf16_t* Y0 = (const bf16_t*)(p->ws + OFF_H);
        const bf16_t* Y1 = (const bf16_t*)(p->ws + OFF_SCR + S_Y1);
        const bf16_t* V = (const bf16_t*)(p->ws + OFF_SCR + S_V);
        const float* bonus = (const float*)(p->ws + OFF_BONUS2);
        bf16_t* O = (bf16_t*)(p->ws + OFF_SCR + S_OR);
        const int c0 = n0 + cb, hd = c0 >> 6;
#pragma unroll
        for (int m = 0; m < 4; ++m) {
            const int tok = m0 + rb + m * 16 + fr;
            const size_t ro = (size_t)tok * DM + c0 + fq * 4;
            f32x4 y[4];
            float s = 0.f;
#pragma unroll
            for (int n = 0; n < 4; ++n) {
                const u32x2 a = *(const u32x2*)(Y0 + ro + n * 16), b = *(const u32x2*)(Y1 + ro + n * 16);
                y[n][0] = bf_lo(a[0]) + bf_lo(b[0]); y[n][1] = bf_hi(a[0]) + bf_hi(b[0]); y[n][2] = bf_lo(a[1]) + bf_lo(b[1]); y[n][3] = bf_hi(a[1]) + bf_hi(b[1]);
                s += y[n][0] + y[n][1] + y[n][2] + y[n][3];
            }
            s += __shfl_xor(s, 16); s += __shfl_xor(s, 32);
            const float mu = s * (1.0f / 64.0f);
            float q = 0.f;
#pragma unroll
            for (int n = 0; n < 4; ++n) { const f32x4 d = y[n] - mu; q += d[0] * d[0] + d[1] * d[1] + d[2] * d[2] + d[3] * d[3]; }
            q += __shfl_xor(q, 16); q += __shfl_xor(q, 32);
            const float rs = rsqrtf(q * (1.0f / 64.0f) + GN_EPS);
            const float bon = (bonus[(size_t)tok * 16 + hd] + bonus[(size_t)(TTOT + tok) * 16 + hd]) + (bonus[(size_t)(2 * TTOT + tok) * 16 + hd] + bonus[(size_t)(3 * TTOT + tok) * 16 + hd]);
#pragma unroll
            for (int n = 0; n < 4; ++n) {
                const int c = c0 + n * 16 + fq * 4;
                const f32x4 g = *(const f32x4*)(p->rwkv_ln_g + c), bb = *(const f32x4*)(p->rwkv_ln_b + c);
                const u32x2 vv = *(const u32x2*)(V + ro + n * 16);
                const f32x4 v4 = {bf_lo(vv[0]), bf_hi(vv[0]), bf_lo(vv[1]), bf_hi(vv[1])};
                const f32x4 o = ((y[n] - mu) * rs * g + bb + bon * v4) * acc[m][n];
                u32x2 w; w[0] = pk_bf16(o[0], o[1]); w[1] = pk_bf16(o[2], o[3]);
                *(u32x2*)(O + ro + n * 16) = w;
            }
        }
    }
};
DI void phase_gate(const Params& p, char* smem) {
    const bf16_t* LG = (const bf16_t*)(p.ws + OFF_SCR + S_LG);
    const bf16_t* W = (const bf16_t*)(p.ws + OFF_WS) + W_G2;
    constexpr int NT = 8, MT = TTOT / 256;
    for (int u = blockIdx.x; u < MT * NT; u += gridDim.x) {
        const int mt = u / NT, nt = u % NT;
        ALPlain al{LG + (size_t)mt * 256 * 192, 192};
        EpiGate epi{&p, mt * 256, nt * 128};
        gemm_tile(al, W + (size_t)nt * 128 * 192, 192, 3, epi, smem);
    }
}

constexpr int KROW = 72, VROW = 68;
constexpr int ATT_SMEM = 2 * 64 * KROW * 2 + 2 * 64 * VROW * 2;
DI int crow_(int i, int h) { return (i & 3) + 8 * (i >> 2) + 4 * h; }
#define MFMA32(a, b, c) __builtin_amdgcn_mfma_f32_32x32x16_bf16((a), (b), (c), 0, 0, 0)
template <int MODE>
DI void attn_unit(const Params& p, const bf16_t* Qg  , int nq_valid, const bf16_t* Kg  , const bf16_t* Vg  ,
                  int ta0, int ta1, int tb0, int tb1  , bool band, int q_lat0  ,
                  float init_m, float init_l0, bf16_t* Og  , char* smem) {
    const int t = threadIdx.x, lane = t & 63, wid = t >> 6, r = lane & 31, h = lane >> 5;
    bf16_t* sK = (bf16_t*)smem;
    bf16_t* sV = sK + 2 * 64 * KROW;
    bf16x8 qf[2][4];
#pragma unroll
    for (int qs = 0; qs < 2; ++qs) {
        const int qi = wid * 64 + qs * 32 + r;
        const bf16_t* qp = Qg + (size_t)(qi < nq_valid ? qi : 0) * 64 + 8 * h;
#pragma unroll
        for (int ks = 0; ks < 4; ++ks) qf[qs][ks] = *(const bf16x8*)(qp + ks * 16);
    }
    f32x16 o[2][2];
#pragma unroll
    for (int qs = 0; qs < 2; ++qs)
#pragma unroll
        for (int dt = 0; dt < 2; ++dt)
#pragma unroll
            for (int i = 0; i < 16; ++i) o[qs][dt][i] = 0.f;
    float mrun[2], lrun[2];
#pragma unroll
    for (int qs = 0; qs < 2; ++qs) { mrun[qs] = init_m; lrun[qs] = (MODE == 1 && h == 0) ? init_l0 : 0.f; }
    const int ntile = ((ta1 - ta0) + (tb1 - tb0)) >> 6;
    const int lrow = t >> 3, lch = (t & 7) * 8;
    u32x4 rk, rv;
    auto tile_pos = [&](int i) { const int a = (ta1 - ta0) >> 6; return i < a ? ta0 + i * 64 : tb0 + (i - a) * 64; };
    {
        const int kp = tile_pos(0);
        rk = *(const u32x4*)(Kg + (size_t)(kp + lrow) * 64 + lch);
        rv = *(const u32x4*)(Vg + (size_t)lrow * PTOT + kp + lch);
        *(u32x4*)(sK + lrow * KROW + lch) = rk;
        *(u32x2*)(sV + lrow * VROW + lch) = (u32x2){rv[0], rv[1]};
        *(u32x2*)(sV + lrow * VROW + lch + 4) = (u32x2){rv[2], rv[3]};
    }
    __syncthreads();
    for (int it = 0; it < ntile; ++it) {
        const int cur = it & 1;
        const bool more = it + 1 < ntile;
        const int kp = tile_pos(it);
        if (more) {
            const int kn = tile_pos(it + 1);
            rk = *(const u32x4*)(Kg + (size_t)(kn + lrow) * 64 + lch);
            rv = *(const u32x4*)(Vg + (size_t)lrow * PTOT + kn + lch);
        }
        const bf16_t* cK = sK + cur * 64 * KROW;
        const bf16_t* cV = sV + cur * 64 * VROW;
#pragma unroll 1
        for (int ksub = 0; ksub < 2; ++ksub) {
            f32x16 sc[2];
#pragma unroll
            for (int qs = 0; qs < 2; ++qs)
#pragma unroll
                for (int i = 0; i < 16; ++i) sc[qs][i] = MODE == 0 ? init_m : 0.f;
#pragma unroll
            for (int ks = 0; ks < 4; ++ks) {
                const bf16x8 kf = *(const bf16x8*)(cK + (ksub * 32 + r) * KROW + ks * 16 + 8 * h);
#pragma unroll
                for (int qs = 0; qs < 2; ++qs) sc[qs] = MFMA32(kf, qf[qs][ks], sc[qs]);
            }
#pragma unroll
            for (int qs = 0; qs < 2; ++qs) {
                if (MODE == 1) {
                    if (band && kp >= LCTX) {
                        const int qlat = q_lat0 + wid * 64 + qs * 32 + r, kl0 = kp - LCTX + ksub * 32;
#pragma unroll
                        for (int i = 0; i < 16; ++i) {
                            const int d0 = qlat - (kl0 + crow_(i, h));
                            if (d0 > 128 || d0 < -128) sc[qs][i] = -1e30f;
                        }
                    }
                    float mt = sc[qs][0];
#pragma unroll
                    for (int i = 1; i < 16; ++i) mt = fmaxf(mt, sc[qs][i]);
                    mt = fmaxf(mt, __shfl_xor(mt, 32));
                    const float mnew = fmaxf(mrun[qs], mt);
                    const float alpha = __builtin_amdgcn_exp2f(mrun[qs] - mnew);
                    mrun[qs] = mnew; lrun[qs] *= alpha;
#pragma unroll
                    for (int i = 0; i < 16; ++i) { o[qs][0][i] *= alpha; o[qs][1][i] *= alpha; }
#pragma unroll
                    for (int i = 0; i < 16; ++i) sc[qs][i] -= mnew;
                }
                float ls = 0.f;
#pragma unroll
                for (int i = 0; i < 16; ++i) { sc[qs][i] = __builtin_amdgcn_exp2f(sc[qs][i]); ls += sc[qs][i]; }
                lrun[qs] += ls;
            }
#pragma unroll
            for (int st = 0; st < 2; ++st) {
                bf16x8 pf[2];
#pragma unroll
                for (int qs = 0; qs < 2; ++qs) {
                    u32x4 pw;
#pragma unroll
                    for (int j = 0; j < 4; ++j) pw[j] = pk_bf16(sc[qs][8 * st + 2 * j], sc[qs][8 * st + 2 * j + 1]);
                    pf[qs] = __builtin_bit_cast(bf16x8, pw);
                }
                const int kb = ksub * 32 + 16 * st + 4 * h;
#pragma unroll
                for (int dt = 0; dt < 2; ++dt) {
                    const s16x4 lo = *(const s16x4*)(cV + (dt * 32 + r) * VROW + kb), hi = *(const s16x4*)(cV + (dt * 32 + r) * VROW + kb + 8);
                    const bf16x8 vf = __builtin_shufflevector(lo, hi, 0, 1, 2, 3, 4, 5, 6, 7);
#pragma unroll
                    for (int qs = 0; qs < 2; ++qs) o[qs][dt] = MFMA32(vf, pf[qs], o[qs][dt]);
                }
            }
        }
        if (more) {
            bf16_t* nK = sK + (cur ^ 1) * 64 * KROW;
            bf16_t* nV = sV + (cur ^ 1) * 64 * VROW;
            *(u32x4*)(nK + lrow * KROW + lch) = rk;
            *(u32x2*)(nV + lrow * VROW + lch) = (u32x2){rv[0], rv[1]};
            *(u32x2*)(nV + lrow * VROW + lch + 4) = (u32x2){rv[2], rv[3]};
        }
        __syncthreads();
    }
#pragma unroll
    for (int qs = 0; qs < 2; ++qs) {
        const int qi = wid * 64 + qs * 32 + r;
        const float lt = lrun[qs] + __shfl_xor(lrun[qs], 32);
        const float invl = 1.0f / lt;
        if (qi < nq_valid) {
            bf16_t* op = Og + (size_t)qi * DM;
#pragma unroll
            for (int g = 0; g < 4; ++g) {
                u32x2 w0, w1;
                w0[0] = pk_bf16(o[qs][0][4 * g] * invl, o[qs][0][4 * g + 1] * invl); w0[1] = pk_bf16(o[qs][0][4 * g + 2] * invl, o[qs][0][4 * g + 3] * invl);
                w1[0] = pk_bf16(o[qs][1][4 * g] * invl, o[qs][1][4 * g + 1] * invl); w1[1] = pk_bf16(o[qs][1][4 * g + 2] * invl, o[qs][1][4 * g + 3] * invl);
                *(u32x2*)(op + 8 * g + 4 * h) = w0;
                *(u32x2*)(op + 32 + 8 * g + 4 * h) = w1;
            }
        }
    }
}
DI void phase_attn(const Params& p, char* smem) {
    const bf16_t* Q = (const bf16_t*)(p.ws + OFF_SCR + S_Q);
    const bf16_t* K = (const bf16_t*)(p.ws + OFF_SCR + S_K);
    const bf16_t* VT = (const bf16_t*)(p.ws + OFF_SCR + S_VT);
    bf16_t* O = (bf16_t*)(p.ws + OFF_SCR + S_O);
    float gq = 0.f, gk = 0.f;
    for (int i = 0; i < 64; ++i) { gq = fmaxf(gq, fabsf(p.attn_q_norm_g[i])); gk = fmaxf(gk, fabsf(p.attn_k_norm_g[i])); }
    const float M2 = 8.25f * gq * gk * LOG2E;
    constexpr int QB = 512, NQB = SEQ / QB;
    const int G = gridDim.x;
    constexpr int NDENSE = NBATCH * 8 * NQB;
    for (int u = blockIdx.x; u < NDENSE; u += G) {
        int combo, within;
        if ((G & 7) == 0 && NDENSE % G == 0) {
            const int xcd = blockIdx.x & 7, idx = (blockIdx.x >> 3) + (G >> 3) * (u / G);
            combo = xcd & 3; within = (xcd >> 2) * (NDENSE / 8) + idx;
        } else { combo = u / (4 * NQB); within = u % (4 * NQB); }
        const int b = combo >> 1, kvh = combo & 1, hq = kvh * 4 + (within & 3), qb = within >> 2;
        const bf16_t* Qg = Q + ((size_t)(b * 16 + 8 + hq) * PTOT + LCTX + qb * QB) * 64;
        attn_unit<0>(p, Qg, QB, K + (size_t)(b * 4 + 2 + kvh) * PTOT * 64, VT + (size_t)(b * 4 + 2 + kvh) * 64 * PTOT, 0, PTOT, 0, 0, false, 0, -M2, 0.f,
                     O + (size_t)(b * PTOT + LCTX + qb * QB) * DM + (8 + hq) * 64, smem);
    }
    for (int u = blockIdx.x; u < NDENSE; u += G) {
        const int b = u / (8 * NQB), rem = u % (8 * NQB), qb = rem >> 3, hq = rem & 7, kvh = hq >> 2;
        const int i0 = qb * QB;
        const int lo = i0 - 128 < 0 ? 0 : i0 - 128, hi = i0 + QB + 128 > SEQ ? SEQ : i0 + QB + 128;
        const bf16_t* Qg = Q + ((size_t)(b * 16 + hq) * PTOT + LCTX + i0) * 64;
        attn_unit<1>(p, Qg, QB, K + (size_t)(b * 4 + kvh) * PTOT * 64, VT + (size_t)(b * 4 + kvh) * 64 * PTOT, 0, LCTX, LCTX + lo, LCTX + hi, true, i0,
                     p.attn_sink[hq] * LOG2E, 1.0f, O + (size_t)(b * PTOT + LCTX + i0) * DM + hq * 64, smem);
    }
    for (int u = blockIdx.x; u < NBATCH * 16; u += G) {
        const int b = u >> 4, hh = u & 15, isb = hh >> 3, hq = hh & 7, kvh = isb * 2 + (hq >> 2);
        const bf16_t* Qg = Q + ((size_t)(b * 16 + hh) * PTOT) * 64;
        attn_unit<1>(p, Qg, LCTX, K + (size_t)(b * 4 + kvh) * PTOT * 64, VT + (size_t)(b * 4 + kvh) * 64 * PTOT, 0, LCTX, 0, 0, false, 0,
                     isb ? -1e30f : p.attn_sink[hq] * LOG2E, isb ? 0.f : 1.0f, O + (size_t)(b * PTOT) * DM + hh * 64, smem);
    }
}

constexpr int TB = 32, NBUF = 3;
constexpr int SC_REC = 5 * 64;
constexpr int SC_OPS = TB * SC_REC * 4;
constexpr int SC_SMEM = NBUF * SC_OPS + NBUF * TB * 16 * 4 + NBUF * TB * 16 * 4 + 64;
DI int scan_pos(int n, int dir) {
    if (n < LCTX) return dir ? LCTX - 1 - n : n;
    const int m = n - LCTX;
    return LCTX + (dir ? SEQ - 1 - m : m);
}
template <int CTRL> DI float dpp_add(float v) { return v + __builtin_bit_cast(float, __builtin_amdgcn_update_dpp(0, __builtin_bit_cast(int, v), CTRL, 0xf, 0xf, false)); }
DI float row16_sum(float v) { v = dpp_add<0x128>(v); v = dpp_add<0x124>(v); v = dpp_add<0x122>(v); v = dpp_add<0x121>(v); return v; }
DI int lds_min4(int* c) { const volatile LAS int* q = (const volatile LAS int*)c; const int a = q[0], b = q[1], d = q[2], e = q[3]; return min(min(a, b), min(d, e)); }
DI void lds_publish(int* c, int v) { *(volatile LAS int*)c = v; }
DI void scan_unit(const Params& p, int u, char* smem) {
    const int t = threadIdx.x, lane = t & 63, wid = __builtin_amdgcn_readfirstlane(t >> 6);
    const unsigned rg = u & 3, dir = (u >> 2) & 1, hd = (u >> 3) & 15, b = u >> 7;
    float* ops = (float*)smem;
    float* vbuf = (float*)(smem + NBUF * SC_OPS);
    float* ybuf = vbuf + NBUF * TB * 16;
    int* cnts = (int*)(ybuf + NBUF * TB * 16);
    const bf16_t* R = (const bf16_t*)(p.ws + OFF_SCR + S_R);
    const bf16_t* Kk = (const bf16_t*)(p.ws + OFF_SCR + S_KK);
    const bf16_t* V = (const bf16_t*)(p.ws + OFF_SCR + S_V);
    const bf16_t* LW = (const bf16_t*)(p.ws + OFF_SCR + S_LW);
    const bf16_t* LA = (const bf16_t*)(p.ws + OFF_SCR + S_LA);
    bf16_t* Yo = dir ? (bf16_t*)(p.ws + OFF_SCR + S_Y1) : (bf16_t*)(p.ws + OFF_H);
    float* bonus = (float*)(p.ws + OFF_BONUS2);
    const unsigned tokb = b * PTOT, hc = hd * 64;
    constexpr int NBLK = PTOT / TB;
    const unsigned fr = lane & 15, fq = lane >> 4;
    if (t < 8) cnts[t] = 0;
    __syncthreads();

    if (wid < 4) {
        __builtin_amdgcn_s_setprio(3);
        float s0 = 0.f, s1 = 0.f, s2 = 0.f, s3 = 0.f;
        const unsigned g = lane >> 4, c4 = (lane & 15) * 4, myrow = wid * 4 + g;
        for (int blk = 0; blk < NBLK; ++blk) {
            const unsigned buf = (unsigned)blk % NBUF;
            while (lds_min4(cnts) < blk + 1) __builtin_amdgcn_s_sleep(1);
            asm volatile("" ::: "memory");
            const float* rec = ops + buf * (TB * SC_REC) + c4;
            const float* vb = vbuf + buf * (TB * 16) + myrow;
            float* yb = ybuf + buf * (TB * 16) + myrow;
            f32x4 w0_ = *(const f32x4*)(rec), kd0_ = *(const f32x4*)(rec + 64), bb0_ = *(const f32x4*)(rec + 128), aa0_ = *(const f32x4*)(rec + 192), rr0_ = *(const f32x4*)(rec + 256);
            float vv0_ = vb[0];
#define SCAN_STEP(W, KD, BB, AA, RR, VV, ST) { \
                float sa = s0 * AA[0] + s1 * AA[1] + s2 * AA[2] + s3 * AA[3]; \
                sa = row16_sum(sa); \
                s0 = s0 * W[0] + sa * BB[0] + VV * KD[0]; \
                s1 = s1 * W[1] + sa * BB[1] + VV * KD[1]; \
                s2 = s2 * W[2] + sa * BB[2] + VV * KD[2]; \
                s3 = s3 * W[3] + sa * BB[3] + VV * KD[3]; \
                float y = s0 * RR[0] + s1 * RR[1] + s2 * RR[2] + s3 * RR[3]; \
                y = row16_sum(y); \
                if ((lane & 15) == 0) yb[(ST) * 16] = y; }
#pragma unroll 1
            for (int st = 0; st < TB; st += 2) {
                const float* r1 = rec + (st + 1) * SC_REC;
                const f32x4 w1_ = *(const f32x4*)(r1), kd1_ = *(const f32x4*)(r1 + 64), bb1_ = *(const f32x4*)(r1 + 128), aa1_ = *(const f32x4*)(r1 + 192), rr1_ = *(const f32x4*)(r1 + 256);
                const float vv1_ = vb[(st + 1) * 16];
                SCAN_STEP(w0_, kd0_, bb0_, aa0_, rr0_, vv0_, st)
                const int st2 = st + 2 < TB ? st + 2 : st;
                const float* r2 = rec + st2 * SC_REC;
                w0_ = *(const f32x4*)(r2); kd0_ = *(const f32x4*)(r2 + 64); bb0_ = *(const f32x4*)(r2 + 128); aa0_ = *(const f32x4*)(r2 + 192); rr0_ = *(const f32x4*)(r2 + 256);
                vv0_ = vb[st2 * 16];
                SCAN_STEP(w1_, kd1_, bb1_, aa1_, rr1_, vv1_, st + 1)
            }
#undef SCAN_STEP
            asm volatile("s_waitcnt lgkmcnt(0)" ::: "memory");
            if (lane == 0) lds_publish(cnts + 4 + wid, blk + 1);
        }
        __builtin_amdgcn_s_setprio(0);
    } else {
        const unsigned wt = wid & 1, chh = (wid >> 1) & 1;
        const bf16_t* wsm = (const bf16_t*)(p.ws + OFF_WS);
        const unsigned wo = W_W2 + dir * 65536u + (hc + fr) * 64u + fq * 8u;
        const unsigned ao = W_A2 + dir * 65536u + (hc + fr) * 64u + fq * 8u;
        const unsigned po = hc + fq * 4u;
        for (int blk = 0; blk < NBLK + NBUF; ++blk) {
            const unsigned buf = (unsigned)blk % NBUF;
            const int need = blk - NBUF + 1 < NBLK ? blk - NBUF + 1 : NBLK;
            while (lds_min4(cnts + 4) < need) __builtin_amdgcn_s_sleep(1);
            asm volatile("" ::: "memory");
            if (wid == 7 && blk >= NBUF) {
#pragma unroll
                for (int i = 0; i < TB * 16 / 64; ++i) {
                    const unsigned id = i * 64 + lane, st = id >> 4, rw = id & 15;
                    const unsigned tok = tokb + scan_pos((blk - NBUF) * TB + st, dir);
                    Yo[tok * 1024u + hc + rg * 16 + rw] = (bf16_t)(pk_bf16(ybuf[buf * (TB * 16) + id], 0.f) & 0xffffu);
                }
            }
            if (blk >= NBLK) continue;
            const unsigned st = wt * 16 + fr;
            const unsigned tok = tokb + scan_pos(blk * TB + st, dir);
            const unsigned lo = tok * 128u + dir * 64u + fq * 8u;
            const unsigned ro = tok * 1024u + hc + fq * 4u;
            bf16x8 lwf[2], laf[2];
#pragma unroll
            for (int kk = 0; kk < 2; ++kk) { lwf[kk] = *(const bf16x8*)(LW + lo + kk * 32); laf[kk] = *(const bf16x8*)(LA + lo + kk * 32); }
            float ssq = 0.f;
#pragma unroll
            for (int nt = 0; nt < 4; ++nt) {
                const f32x4 kkv = *(const f32x4*)(p.rwkv_k_k + po + nt * 16);
                const u32x2 c = *(const u32x2*)(Kk + ro + nt * 16);
                const float q0 = bf_lo(c[0]) * kkv[0], q1 = bf_hi(c[0]) * kkv[1], q2 = bf_lo(c[1]) * kkv[2], q3 = bf_hi(c[1]) * kkv[3];
                ssq += q0 * q0 + q1 * q1 + q2 * q2 + q3 * q3;
            }
            ssq += __shfl_xor(ssq, 16); ssq += __shfl_xor(ssq, 32);
            const float kn = __builtin_amdgcn_rsqf(fmaxf(ssq, 1e-24f));
            float* rec = ops + buf * (TB * SC_REC) + st * SC_REC + fq * 4;
            float bsum = 0.f;
#pragma unroll
            for (int n2 = 0; n2 < 2; ++n2) {
                const unsigned nt = chh * 2 + n2;
                f32x4 aw = {0.f, 0.f, 0.f, 0.f}, ai = aw;
#pragma unroll
                for (int kk = 0; kk < 2; ++kk) {
                    const bf16x8 w2f = *(const bf16x8*)(wsm + wo + nt * 1024 + kk * 32), a2f = *(const bf16x8*)(wsm + ao + nt * 1024 + kk * 32);
                    aw = __builtin_amdgcn_mfma_f32_16x16x32_bf16(w2f, lwf[kk], aw, 0, 0, 0);
                    ai = __builtin_amdgcn_mfma_f32_16x16x32_bf16(a2f, laf[kk], ai, 0, 0, 0);
                }
                const f32x4 w0v = *(const f32x4*)(p.rwkv_decay_w0 + dir * 1024u + po + nt * 16), a0v = *(const f32x4*)(p.rwkv_iclr_a0 + dir * 1024u + po + nt * 16);
                const f32x4 kkv = *(const f32x4*)(p.rwkv_k_k + po + nt * 16);
                const f32x4 kav = *(const f32x4*)(p.rwkv_k_a + po + nt * 16), rkv = *(const f32x4*)(p.rwkv_r_k + po + nt * 16);
                const u32x2 a = *(const u32x2*)(R + ro + nt * 16), c = *(const u32x2*)(Kk + ro + nt * 16);
                const f32x4 rr = {bf_lo(a[0]), bf_hi(a[0]), bf_lo(a[1]), bf_hi(a[1])};
                const f32x4 kr = {bf_lo(c[0]), bf_hi(c[0]), bf_lo(c[1]), bf_hi(c[1])};
                f32x4 wv, kd, bb, aa;
#pragma unroll
                for (int j = 0; j < 4; ++j) {
                    const float sg = __builtin_amdgcn_rcpf(1.0f + __builtin_amdgcn_exp2f(-(w0v[j] + aw[j]) * LOG2E));
                    wv[j] = __builtin_amdgcn_exp2f(sg * (-0.6065306597126334f * LOG2E));
                    const float ic = __builtin_amdgcn_rcpf(1.0f + __builtin_amdgcn_exp2f(-(a0v[j] + ai[j]) * LOG2E));
                    const float kkn = kr[j] * kkv[j] * kn;
                    kd[j] = kr[j] * (1.0f + (ic - 1.0f) * kav[j]);
                    bb[j] = kkn * ic;
                    aa[j] = -kkn;
                    bsum += rr[j] * kd[j] * rkv[j];
                }
                *(f32x4*)(rec + 0 * 64 + nt * 16) = wv;
                *(f32x4*)(rec + 1 * 64 + nt * 16) = kd;
                *(f32x4*)(rec + 2 * 64 + nt * 16) = bb;
                *(f32x4*)(rec + 3 * 64 + nt * 16) = aa;
                *(f32x4*)(rec + 4 * 64 + nt * 16) = rr;
            }
            bsum += __shfl_xor(bsum, 16); bsum += __shfl_xor(bsum, 32);
            if (rg == 0 && fq == 0) bonus[((chh * 2 + dir) * TTOT + tok) * 16u + hd] = bsum;
            if (wid == 6) {
                bf16_t vr[TB * 16 / 64];
#pragma unroll
                for (int i = 0; i < TB * 16 / 64; ++i) {
                    const unsigned id = i * 64 + lane, s2 = id >> 4, rw = id & 15;
                    const unsigned tk = tokb + scan_pos(blk * TB + s2, dir);
                    vr[i] = V[tk * 1024u + hc + rg * 16 + rw];
                }
#pragma unroll
                for (int i = 0; i < TB * 16 / 64; ++i) vbuf[buf * (TB * 16) + i * 64 + lane] = bf2f(vr[i]);
            }
            asm volatile("s_waitcnt lgkmcnt(0)" ::: "memory");
            if (lane == 0) lds_publish(cnts + (wid - 4), blk + 1);
        }
    }
    __syncthreads();
}
DI void phase_scan(const Params& p, char* smem) {
    for (int u = blockIdx.x; u < NBATCH * 16 * 2 * 4; u += gridDim.x) scan_unit(p, u, smem);
}

constexpr int NPHASE = 18;
constexpr int SMEM_BYTES = (GEMM_SMEM > SC_SMEM ? GEMM_SMEM : SC_SMEM) + 64;
template <int PH> DI void run_phase(const Params& p, char* smem) {
    if constexpr (PH == 0) phase_prologue(p, smem);
    else if constexpr (PH == 1) phase_norm0(p);
    else if constexpr (PH == 2) phase_qkv(p, smem);
    else if constexpr (PH == 3) phase_attn(p, smem);
    else if constexpr (PH == 4) phase_wout(p, smem);
    else if constexpr (PH == 5) phase_ffn_norm_route(p, 0, smem);
    else if constexpr (PH == 6) phase_moe1(p, 0, smem);
    else if constexpr (PH == 7) phase_moe2(p, 0, smem);
    else if constexpr (PH == 8) phase_combine_l0(p, smem);
    else if constexpr (PH == 9) phase_xx(p);
    else if constexpr (PH == 10) phase_rwkv_proj(p, smem);
    else if constexpr (PH == 11) phase_scan(p, smem);
    else if constexpr (PH == 12) phase_gate(p, smem);
    else if constexpr (PH == 13) phase_wo(p, smem);
    else if constexpr (PH == 14) phase_ffn_norm_route(p, 1, smem);
    else if constexpr (PH == 15) phase_moe1(p, 1, smem);
    else if constexpr (PH == 16) phase_moe2(p, 1, smem);
    else if constexpr (PH == 17) phase_final(p);
}
template <int PH, int END> struct PhaseSeq {
    static DI void run(const Params& p, char* smem, const XcdBarrier& bar) {
        run_phase<PH>(p, smem);
        if constexpr (PH + 1 < END) { xcd_barrier(bar); PhaseSeq<PH + 1, END>::run(p, smem, bar); }
    }
};
template <int BEG, int END>
__global__ void __launch_bounds__(NTH, 2) fwd_kernel(Params p) {
    extern __shared__ __attribute__((aligned(16))) char smem_raw[];
    char* smem = smem_raw + 16;
    if constexpr (END - BEG > 1) {
        if (threadIdx.x == 0) *(uint4*)smem_raw = make_uint4(0u, 0u, 0u, 0u);
        __syncthreads();
        XcdBarrier bar = xcd_barrier_post((unsigned*)(p.ws + OFF_BAR), (volatile LAS unsigned*)smem_raw);
        PhaseSeq<BEG, END>::run(p, smem, bar);
    } else {
        run_phase<BEG>(p, smem);
    }
}

template <int BEG, int END> static void launch_range(const Params& p, int grid, hipStream_t stream) {
    (void)hipFuncSetAttribute((const void*)fwd_kernel<BEG, END>, hipFuncAttributeMaxDynamicSharedMemorySize, SMEM_BYTES + 16);
    hipLaunchKernelGGL((fwd_kernel<BEG, END>), dim3(grid), dim3(NTH), SMEM_BYTES + 16, stream, p);
}
#ifndef RUN_PHASES
#define RUN_PHASES NPHASE
#endif
#ifndef REPEAT_PHASE
#define REPEAT_PHASE -1
#endif
template <int PH> static void launch_each(const Params& p, int grid, hipStream_t stream) {
    launch_range<PH, PH + 1>(p, grid, stream);
    if (PH == REPEAT_PHASE) launch_range<PH, PH + 1>(p, grid, stream);
    if constexpr (PH + 1 < RUN_PHASES) launch_each<PH + 1>(p, grid, stream);
}

extern "C" void kernel_launch(void* const* d_in, const int* in_sizes, int n_in, void* d_out, int out_size, void* d_ws, size_t ws_size, hipStream_t stream) {
    Params p{};
    const float** f = (const float**)&p;
    for (int i = 0; i < 37; ++i) f[i] = (const float*)d_in[i];
    p.out = (float*)d_out;
    p.ws = (char*)d_ws;
    if (ws_size < WS_NEED || n_in < 37) return;
    static int grid = 0;
    if (!grid) {
        int dev = 0, cus = 0;
        (void)hipGetDevice(&dev);
        (void)hipDeviceGetAttribute(&cus, hipDeviceAttributeMultiprocessorCount, dev);
        grid = cus > 0 ? cus : 256;
    }
    (void)hipMemsetAsync(d_ws, 0, 32768, stream);
#if MEGA
    launch_range<0, NPHASE>(p, grid, stream);
#else
    launch_each<0>(p, grid, stream);
#endif
}
```

```cpp
#include <hip/hip_runtime.h>
#include <stdint.h>
#include <stdio.h>

#ifndef MEGA
#define MEGA 1
#endif

typedef unsigned short bf16_t;
typedef short bf16x8 __attribute__((ext_vector_type(8)));
typedef short s16x4 __attribute__((ext_vector_type(4)));
typedef float f32x2 __attribute__((ext_vector_type(2)));
typedef float f32x4 __attribute__((ext_vector_type(4)));
typedef float f32x16 __attribute__((ext_vector_type(16)));
typedef unsigned u32x2 __attribute__((ext_vector_type(2)));
typedef unsigned u32x4 __attribute__((ext_vector_type(4)));
typedef __bf16 bf16x2_t __attribute__((ext_vector_type(2)));
#define DI __device__ __forceinline__

constexpr int DM = 1024, NBATCH = 2, SEQ = 16384, LCTX = 256, PTOT = SEQ + LCTX, TTOT = NBATCH * PTOT;
constexpr int NTH = 512, NWAVE = 8;
constexpr int QKV_N = 1536;
constexpr int NEXP = 16, CAP = TTOT * 2;
constexpr float RMS_EPS = 1e-6f, GN_EPS = 64e-5f;
constexpr float LOG2E = 1.4426950408889634f;

constexpr size_t MBy = 1u << 20;
constexpr size_t OFF_BAR   = 0;
constexpr size_t OFF_CNT   = 16384;
constexpr size_t OFF_MOD   = 32768;
constexpr size_t OFF_ROPE  = OFF_MOD + 2 * 3 * 6144 * 4;
constexpr size_t OFF_BONUS = 1 * MBy;
constexpr size_t OFF_BONUS2 = 6 * MBy;
constexpr size_t OFF_STOK  = 6 * MBy;
constexpr size_t OFF_SW    = 11 * MBy;
constexpr size_t OFF_XC    = 16 * MBy;
constexpr size_t OFF_WS    = 18 * MBy;
constexpr size_t OFF_MOEW  = 33 * MBy;
constexpr size_t OFF_H     = 129 * MBy;
constexpr size_t OFF_SCR   = 194 * MBy;
constexpr size_t SCR_SIZE  = 290 * MBy;
constexpr size_t WS_NEED   = OFF_SCR + SCR_SIZE;
constexpr size_t W_IN = 0, W_OUT = W_IN + 1536 * 1024, W_R = W_OUT + 1024 * 1024, W_K = W_R + 1024 * 1024, W_V = W_K + 1024 * 1024,
                 W_O = W_V + 1024 * 1024, W_W1 = W_O + 1024 * 1024, W_A1 = W_W1 + 128 * 1024, W_G1 = W_A1 + 128 * 1024,
                 W_W2 = W_G1 + 256 * 1024, W_A2 = W_W2 + 2 * 1024 * 64, W_G2 = W_A2 + 2 * 1024 * 64, W_END = W_G2 + 1024 * 192;
static_assert(W_END * 2 <= 15 * MBy, "small weights region");
constexpr size_t ROWB = (size_t)TTOT * 2048;
constexpr size_t S_Q = 0, S_K = S_Q + ROWB, S_VT = S_K + ROWB / 4, S_O = S_VT + ROWB / 4;
constexpr size_t S_HID = 0, S_Y = 140 * MBy;
constexpr size_t S_R = 0, S_KK = S_R + ROWB, S_V = S_KK + ROWB, S_LW = S_V + ROWB, S_LA = S_LW + ROWB / 8, S_LG = S_LA + ROWB / 8,
                 S_Y1 = 224 * MBy, S_XX = S_Y1, S_OR = S_R;
static_assert(S_O + ROWB <= SCR_SIZE, "scr");
static_assert(S_LG + (size_t)TTOT * 384 <= S_Y1, "scr2");
static_assert(S_Y1 + ROWB <= SCR_SIZE, "scr3");
static_assert(S_Y + 2 * ROWB <= SCR_SIZE, "scr4");
static_assert((size_t)(CAP / 256 + 16) * 256 * 2048 <= S_Y, "hid");
static_assert(OFF_H + ROWB <= OFF_SCR, "h");

struct Params {
    const float *x, *c, *ctx, *c_ctx, *ada_w, *ada_b, *norm_mix_g, *norm_ffn_g, *attn_w_in, *attn_w_out, *attn_sink, *attn_q_norm_g, *attn_k_norm_g,
        *rwkv_x_mix, *rwkv_w_r, *rwkv_w_k, *rwkv_w_v, *rwkv_w_o, *rwkv_decay_w0, *rwkv_decay_w1, *rwkv_decay_w2, *rwkv_iclr_a0, *rwkv_iclr_a1,
        *rwkv_iclr_a2, *rwkv_gate_g1, *rwkv_gate_g2, *rwkv_k_k, *rwkv_k_a, *rwkv_r_k, *rwkv_ln_g, *rwkv_ln_b, *router_w, *router_bias, *moe_w1,
        *moe_w3, *moe_w2, *final_norm_g;
    float* out;
    char* ws;
};

DI unsigned pk_bf16(float a, float b) { f32x2 v = {a, b}; bf16x2_t r = __builtin_convertvector(v, bf16x2_t); return __builtin_bit_cast(unsigned, r); }
DI float bf_lo(unsigned u) { return __uint_as_float(u << 16); }
DI float bf_hi(unsigned u) { return __uint_as_float(u & 0xffff0000u); }
DI float bf2f(bf16_t u) { return __uint_as_float(((unsigned)u) << 16); }
DI float wave_sum(float v) {
#pragma unroll
    for (int o = 32; o >= 1; o >>= 1) v += __shfl_xor(v, o);
    return v;
}
DI float sigmoidf_(float x) { return 1.0f / (1.0f + __expf(-x)); }
DI float siluf_(float x) { return x / (1.0f + __expf(-x)); }
DI float* xrow_ptr(const Params& p, int tok) {
    const int b = tok >= PTOT ? 1 : 0, pos = tok - b * PTOT;
    return pos < LCTX ? (float*)(p.ws + OFF_XC) + (size_t)(b * LCTX + pos) * DM : p.out + (size_t)(b * SEQ + pos - LCTX) * DM;
}
DI const float* xin_ptr(const Params& p, int tok) {
    const int b = tok >= PTOT ? 1 : 0, pos = tok - b * PTOT;
    return pos < LCTX ? p.ctx + (size_t)(b * LCTX + pos) * DM : p.x + (size_t)(b * SEQ + pos - LCTX) * DM;
}
DI const float* mod_ptr(const Params& p, int layer, int tok, int which) {
    const int b = tok >= PTOT ? 1 : 0, pos = tok - b * PTOT;
    const int w = pos < LCTX ? 2 : b;
    return (const float*)(p.ws + OFF_MOD) + (size_t)((layer * 3 + w) * 6 + which) * DM;
}

#define XB_TMO      128
#define XB_XCNT(j)  (256  + 64 * (j))
#define XB_XSUB(j)  (1280 + 64 * (j))
#define XB_XGEN(j)  (2304 + 64 * (j))
#define XB_TOP      3328
#define XB_TOPGEN   3392
#define XCD_BAR_WORDS 3456
#define XB_SPIN_CAP (1u << 18)
#define LAS __attribute__((address_space(3)))
DI unsigned xb_ld(unsigned* p)              { return __hip_atomic_load(p, __ATOMIC_RELAXED, __HIP_MEMORY_SCOPE_AGENT); }
DI unsigned xb_add(unsigned* p, unsigned v) { return __hip_atomic_fetch_add(p, v, __ATOMIC_RELAXED, __HIP_MEMORY_SCOPE_AGENT); }
DI unsigned xb_xcc_id() { return (unsigned)__builtin_amdgcn_s_getreg((3 << 11) | 20) & 0xFu; }
#define XB_SPIN(cond, bar) do { unsigned _sp = 0; while (cond) { __builtin_amdgcn_s_sleep(1); \
    if ((++_sp & 255u) == 0u) { if (xb_ld(&(bar)[XB_TMO])) break; if (_sp > XB_SPIN_CAP) { atomicAdd(&(bar)[XB_TMO], 1u); break; } } } } while (0)
struct XcdBarrier { unsigned* bar; unsigned x; volatile LAS unsigned* st; };
DI XcdBarrier xcd_barrier_post(unsigned* bar, volatile LAS unsigned* st) {
    XcdBarrier b; b.bar = bar; b.x = xb_xcc_id(); b.st = st;
    if (threadIdx.x == 0) (void)xb_add(&bar[XB_XCNT(b.x)], 1u);
    return b;
}
DI void xcd_barrier_complete(unsigned* bar, unsigned x, unsigned& nloc, unsigned& nx) {
    const unsigned G = gridDim.x * gridDim.y * gridDim.z;
    unsigned sum, cnt, mine, sp = 0u;
    for (;;) {
        sum = 0u; cnt = 0u; mine = 0u;
#pragma unroll
        for (unsigned j = 0; j < 16; ++j) { const unsigned c = xb_ld(&bar[XB_XCNT(j)]); sum += c; cnt += (c > 0u) ? 1u : 0u; mine = (j == x) ? c : mine; }
        if (sum == G) break;
        __builtin_amdgcn_s_sleep(1);
        if ((++sp & 255u) == 0u) { if (xb_ld(&bar[XB_TMO])) break; if (sp > XB_SPIN_CAP) { atomicAdd(&bar[XB_TMO], 1u); break; } }
    }
    nloc = mine > 0u ? mine : 1u; nx = cnt > 0u ? cnt : 1u;
}
DI void xcd_barrier(const XcdBarrier& b) {
    asm volatile("s_waitcnt vmcnt(0)" ::: "memory");
    __syncthreads();
    if (threadIdx.x == 0) {
        unsigned* bar = b.bar;
        __builtin_amdgcn_s_waitcnt(0);
        unsigned nloc = b.st[0], nx = b.st[1];
        if (nloc == 0u) { xcd_barrier_complete(bar, b.x, nloc, nx); b.st[0] = nloc; b.st[1] = nx; }
        const unsigned old = xb_add(&bar[XB_XSUB(b.x)], 1u);
        const unsigned gen = old / nloc;
        if (old + 1u == (gen + 1u) * nloc) {
            __builtin_amdgcn_fence(__ATOMIC_RELEASE, "agent");
            asm volatile("s_waitcnt vmcnt(0)" ::: "memory");
            const unsigned og = xb_add(&bar[XB_TOP], 1u);
            const unsigned tg = og / nx;
            if (og + 1u == (tg + 1u) * nx) xb_add(&bar[XB_TOPGEN], 1u);
            else XB_SPIN(xb_ld(&bar[XB_TOPGEN]) == tg, bar);
            __builtin_amdgcn_fence(__ATOMIC_ACQUIRE, "agent");
            xb_add(&bar[XB_XGEN(b.x)], 1u);
            asm volatile("s_waitcnt vmcnt(0)" ::: "memory");
        } else {
            XB_SPIN(xb_ld(&bar[XB_XGEN(b.x)]) == gen, bar);
            __builtin_amdgcn_fence(__ATOMIC_ACQUIRE, "agent");
            asm volatile("s_waitcnt vmcnt(0)" ::: "memory");
        }
    }
    __syncthreads();
}

DI void cvt_tile(const float* src, int ld, int kvalid, bool colvalid, bf16_t* dst, int dld, float* tile  ) {
    const int t = threadIdx.x;
    {
        const int k = t >> 3, c4 = (t & 7) * 4;
        f32x4 v = {0.f, 0.f, 0.f, 0.f};
        if (colvalid && k < kvalid) v = *(const f32x4*)(src + (size_t)k * ld + c4);
        tile[k * 33 + c4 + 0] = v[0]; tile[k * 33 + c4 + 1] = v[1]; tile[k * 33 + c4 + 2] = v[2]; tile[k * 33 + c4 + 3] = v[3];
    }
    __syncthreads();
    {
        const int n = t >> 4, kc = (t & 15) * 4;
        u32x2 w;
        w[0] = pk_bf16(tile[(kc + 0) * 33 + n], tile[(kc + 1) * 33 + n]);
        w[1] = pk_bf16(tile[(kc + 2) * 33 + n], tile[(kc + 3) * 33 + n]);
        *(u32x2*)(dst + (size_t)n * dld + kc) = w;
    }
    __syncthreads();
}
constexpr int CV_SMALL_UNITS = 768 + 512 * 5 + 64 + 64 + 128 + 64 + 64 + 96;
DI void cvt_small_unit(const Params& p, int u, float* tile) {
    bf16_t* wsm = (bf16_t*)(p.ws + OFF_WS);
    if (u < 768) { const int run = u >> 4, kt = u & 15; cvt_tile(p.attn_w_in + (size_t)kt * 64 * 1536 + run * 32, 1536, 64, true, wsm + W_IN + (size_t)run * 32 * 1024 + kt * 64, 1024, tile); return; }
    u -= 768;
    if (u < 512 * 5) {
        const int j = u >> 9, v = u & 511, run = v >> 4, kt = v & 15;
        const float* src = j == 0 ? p.attn_w_out : j == 1 ? p.rwkv_w_r : j == 2 ? p.rwkv_w_k : j == 3 ? p.rwkv_w_v : p.rwkv_w_o;
        const size_t dofs = j == 0 ? W_OUT : j == 1 ? W_R : j == 2 ? W_K : j == 3 ? W_V : W_O;
        cvt_tile(src + (size_t)kt * 64 * 1024 + run * 32, 1024, 64, true, wsm + dofs + (size_t)run * 32 * 1024 + kt * 64, 1024, tile); return;
    }
    u -= 512 * 5;
    if (u < 128) {
        const int j = u >> 6, v = u & 63, run = v >> 4, kt = v & 15, d = run >> 1, co = (run & 1) * 32;
        const float* src = (j == 0 ? p.rwkv_decay_w1 : p.rwkv_iclr_a1) + (size_t)d * 1024 * 64;
        cvt_tile(src + (size_t)kt * 64 * 64 + co, 64, 64, true, wsm + (j == 0 ? W_W1 : W_A1) + (size_t)run * 32 * 1024 + kt * 64, 1024, tile); return;
    }
    u -= 128;
    if (u < 128) {
        const int run = u >> 4, kt = u & 15;
        cvt_tile(p.rwkv_gate_g1 + (size_t)kt * 64 * 160 + run * 32, 160, 64, run < 5, wsm + W_G1 + (size_t)run * 32 * 1024 + kt * 64, 1024, tile); return;
    }
    u -= 128;
    if (u < 128) {
        const int j = u >> 6, v = u & 63, d = v >> 5, run = v & 31;
        const float* src = (j == 0 ? p.rwkv_decay_w2 : p.rwkv_iclr_a2) + (size_t)d * 64 * 1024;
        cvt_tile(src + run * 32, 1024, 64, true, wsm + (j == 0 ? W_W2 : W_A2) + (size_t)d * 1024 * 64 + (size_t)run * 32 * 64, 64, tile); return;
    }
    u -= 128;
    {
        const int run = u / 3, kt = u % 3;
        const int kvalid = 160 - kt * 64 > 64 ? 64 : (160 - kt * 64 < 0 ? 0 : 160 - kt * 64);
        cvt_tile(p.rwkv_gate_g2 + (size_t)kt * 64 * 1024 + run * 32, 1024, kvalid, true, wsm + W_G2 + (size_t)run * 32 * 192 + kt * 64, 192, tile);
    }
}
constexpr int CV_MOE_UNITS = 16 * (1024 + 512);
DI void cvt_moe_unit(const Params& p, int layer, int u, float* tile) {
    bf16_t* w13 = (bf16_t*)(p.ws + OFF_MOEW);
    bf16_t* w2t = w13 + (size_t)16 * 2048 * 1024;
    const int e = u / 1536, v = u % 1536;
    const size_t eo = (size_t)(layer * 16 + e) * 1024 * 1024;
    if (v < 1024) {
        const int run = v >> 4, kt = v & 15, g = run >> 1;
        const float* src = ((run & 1) ? p.moe_w3 : p.moe_w1) + eo;
        cvt_tile(src + (size_t)kt * 64 * 1024 + g * 32, 1024, 64, true, w13 + (size_t)e * 2048 * 1024 + (size_t)run * 32 * 1024 + kt * 64, 1024, tile);
    } else {
        const int w = v - 1024, run = w >> 4, kt = w & 15;
        cvt_tile(p.moe_w2 + eo + (size_t)kt * 64 * 1024 + run * 32, 1024, 64, true, w2t + (size_t)e * 1024 * 1024 + (size_t)run * 32 * 1024 + kt * 64, 1024, tile);
    }
}
DI void adaln_unit(const Params& p, int u, float* sm) {
    const int l = u / 96, n0 = (u % 96) * 64, t = threadIdx.x;
    float* sv = sm;
    float* red = sm + 3 * 1024;
    for (int i = t; i < 3 * 1024; i += NTH) { const int w = i >> 10, k = i & 1023; const float c = w < 2 ? p.c[w * 1024 + k] : p.c_ctx[k]; sv[i] = siluf_(c); }
    __syncthreads();
    const int kg = t >> 4, cl = t & 15;
    f32x4 a0 = {0, 0, 0, 0}, a1 = a0, a2 = a0;
    const float* W = p.ada_w + (size_t)l * 1024 * 6144 + n0 + cl * 4;
#pragma unroll 8
    for (int i = 0; i < 32; ++i) {
        const int k = kg + 32 * i;
        const f32x4 w = *(const f32x4*)(W + (size_t)k * 6144);
        a0 += w * sv[k]; a1 += w * sv[1024 + k]; a2 += w * sv[2048 + k];
    }
#pragma unroll
    for (int j = 0; j < 4; ++j) { red[kg * 192 + 0 * 64 + cl * 4 + j] = a0[j]; red[kg * 192 + 1 * 64 + cl * 4 + j] = a1[j]; red[kg * 192 + 2 * 64 + cl * 4 + j] = a2[j]; }
    __syncthreads();
    if (t < 192) {
        float s = 0.f;
        for (int g = 0; g < 32; ++g) s += red[g * 192 + t];
        const int w = t >> 6, n = n0 + (t & 63);
        ((float*)(p.ws + OFF_MOD))[(size_t)(l * 3 + w) * 6144 + n] = s + p.ada_b[l * 6144 + n];
    }
    __syncthreads();
}
DI void rope_unit(const Params& p, int u) {
    const int id = u * NTH + threadIdx.x;
    if (id < 320 * 16) {
        const int pi = id >> 4, f = id & 15;
        const float inv = exp2f(-(float)f * (13.287712379549449f / 16.0f));
        const float val = pi < 256 ? (float)pi : (float)(pi - 256);
        const float ang = val * inv;
        const double a = (double)ang;
        const double k = __builtin_rint(a * 0.15915494309189535);
        const float r = (float)(a - k * 6.283185307179586);
        f32x2 cs = {__cosf(r), __sinf(r)};
        ((f32x2*)(p.ws + OFF_ROPE))[id] = cs;
    }
}
DI void phase_prologue(const Params& p, char* smem) {
    float* sm = (float*)smem;
    const int nconv = CV_SMALL_UNITS + CV_MOE_UNITS;
    const int total = nconv + 192 + 10;
    for (int u = blockIdx.x; u < total; u += gridDim.x) {
        if (u < CV_SMALL_UNITS) cvt_small_unit(p, u, sm);
        else if (u < nconv) cvt_moe_unit(p, 0, u - CV_SMALL_UNITS, sm);
        else if (u < nconv + 192) adaln_unit(p, u - nconv, sm);
        else rope_unit(p, u - nconv - 192);
    }
}

DI void row_load(const float* src, f32x4 (&v)[4], int lane) {
#pragma unroll
    for (int i = 0; i < 4; ++i) v[i] = ((const f32x4*)src)[lane + 64 * i];
}
DI float row_rstd(const f32x4 (&v)[4]) {
    float ss = 0.f;
#pragma unroll
    for (int i = 0; i < 4; ++i) ss += v[i][0] * v[i][0] + v[i][1] * v[i][1] + v[i][2] * v[i][2] + v[i][3] * v[i][3];
    ss = wave_sum(ss);
    return rsqrtf(ss * (1.0f / DM) + RMS_EPS);
}
DI void row_norm_mod(const f32x4 (&v)[4], float rstd, const float* g, const float* shift, const float* scale, f32x4 (&h)[4], int lane) {
#pragma unroll
    for (int i = 0; i < 4; ++i) {
        const int c = (lane + 64 * i) * 4;
        const f32x4 g4 = *(const f32x4*)(g + c), sh = *(const f32x4*)(shift + c), sc = *(const f32x4*)(scale + c);
        h[i] = (v[i] * rstd * g4) * (1.0f + sc) + sh;
    }
}
DI void row_store_bf16(bf16_t* dst, const f32x4 (&h)[4], int lane) {
#pragma unroll
    for (int i = 0; i < 4; ++i) { u32x2 w; w[0] = pk_bf16(h[i][0], h[i][1]); w[1] = pk_bf16(h[i][2], h[i][3]); *(u32x2*)(dst + (lane + 64 * i) * 4) = w; }
}
DI void row_load_bf16(const bf16_t* src, f32x4 (&v)[4], int lane) {
#pragma unroll
    for (int i = 0; i < 4; ++i) { const u32x2 w = *(const u32x2*)(src + (lane + 64 * i) * 4); v[i][0] = bf_lo(w[0]); v[i][1] = bf_hi(w[0]); v[i][2] = bf_lo(w[1]); v[i][3] = bf_hi(w[1]); }
}

DI void phase_norm0(const Params& p) {
    const int lane = threadIdx.x & 63, gw = blockIdx.x * NWAVE + (threadIdx.x >> 6), nw = gridDim.x * NWAVE;
    bf16_t* H = (bf16_t*)(p.ws + OFF_H);
    for (int tok = gw; tok < TTOT; tok += nw) {
        f32x4 v[4], h[4];
        row_load(xin_ptr(p, tok), v, lane);
        const float rstd = row_rstd(v);
        row_norm_mod(v, rstd, p.norm_mix_g, mod_ptr(p, 0, tok, 0), mod_ptr(p, 0, tok, 1), h, lane);
        row_store_bf16(H + (size_t)tok * DM, h, lane);
    }
}

DI void route_row(const Params& p, const float (&lg)[16], int& e1, int& e2, float& g1, float& g2) {
    float mx = lg[0];
#pragma unroll
    for (int e = 1; e < 16; ++e) mx = fmaxf(mx, lg[e]);
    float pr[16], sum = 0.f;
#pragma unroll
    for (int e = 0; e < 16; ++e) { pr[e] = __expf(lg[e] - mx); sum += pr[e]; }
    const float inv = 1.0f / sum;
    float sel[16];
#pragma unroll
    for (int e = 0; e < 16; ++e) { pr[e] *= inv; sel[e] = pr[e] + p.router_bias[e]; }
    float best = -1e30f; int gi = 0;
#pragma unroll
    for (int g = 0; g < 4; ++g) {
        float m1 = -1e30f, m2 = -1e30f;
#pragma unroll
        for (int j = 0; j < 4; ++j) { const float s = sel[g * 4 + j]; if (s > m1) { m2 = m1; m1 = s; } else if (s > m2) m2 = s; }
        const float gs = m1 + m2;
        if (gs > best) { best = gs; gi = g; }
    }
    float s4[4], p4[4];
#pragma unroll
    for (int j = 0; j < 4; ++j) {
        s4[j] = gi == 0 ? sel[j] : gi == 1 ? sel[4 + j] : gi == 2 ? sel[8 + j] : sel[12 + j];
        p4[j] = gi == 0 ? pr[j] : gi == 1 ? pr[4 + j] : gi == 2 ? pr[8 + j] : pr[12 + j];
    }
    int i1 = 0; float b1 = s4[0];
#pragma unroll
    for (int j = 1; j < 4; ++j) if (s4[j] > b1) { b1 = s4[j]; i1 = j; }
    int i2 = i1 == 0 ? 1 : 0; float b2 = -3e38f;
#pragma unroll
    for (int j = 0; j < 4; ++j) if (j != i1 && s4[j] > b2) { b2 = s4[j]; i2 = j; }
    const float w1 = i1 == 0 ? p4[0] : i1 == 1 ? p4[1] : i1 == 2 ? p4[2] : p4[3];
    const float w2 = i2 == 0 ? p4[0] : i2 == 1 ? p4[1] : i2 == 2 ? p4[2] : p4[3];
    const float ws = 1.0f / (w1 + w2);
    e1 = gi * 4 + i1; e2 = gi * 4 + i2; g1 = w1 * ws; g2 = w2 * ws;
}
DI void phase_ffn_norm_route(const Params& p, int layer, char* smem) {
    const int lane = threadIdx.x & 63, gw = blockIdx.x * NWAVE + (threadIdx.x >> 6), nw = gridDim.x * NWAVE;
    float* rw = (float*)smem;
    for (int i = threadIdx.x; i < 1024 * 16; i += NTH) rw[(i & 15) * 1024 + (i >> 4)] = p.router_w[i];
    __syncthreads();
    bf16_t* H = (bf16_t*)(p.ws + OFF_H);
    int* lcnt = (int*)(smem + 65536);
    if (threadIdx.x < 32) lcnt[threadIdx.x] = 0;
    int my_tok = -1, my_e1 = 0, my_e2 = 0, it = 0; float my_g1 = 0.f, my_g2 = 0.f;
    for (int tok = gw; tok < TTOT; tok += nw) {
        const int pos = tok >= PTOT ? tok - PTOT : tok;
        if (layer == 1 && pos < LCTX) continue;
        f32x4 v[4], h[4];
        row_load(xrow_ptr(p, tok), v, lane);
        const float rstd = row_rstd(v);
        row_norm_mod(v, rstd, p.norm_ffn_g + layer * DM, mod_ptr(p, layer, tok, 3), mod_ptr(p, layer, tok, 4), h, lane);
        row_store_bf16(H + (size_t)tok * DM, h, lane);
        float lg[16];
#pragma unroll
        for (int e = 0; e < 16; ++e) lg[e] = 0.f;
#pragma unroll
        for (int i = 0; i < 4; ++i)
#pragma unroll
            for (int e = 0; e < 16; ++e) {
                const f32x4 w = *(const f32x4*)(rw + e * 1024 + (lane + 64 * i) * 4);
                lg[e] += h[i][0] * w[0] + h[i][1] * w[1] + h[i][2] * w[2] + h[i][3] * w[3];
                if ((e & 3) == 3) asm volatile("" ::: "memory");
            }
#pragma unroll
        for (int e = 0; e < 16; ++e) lg[e] = wave_sum(lg[e]);
        int e1, e2; float g1, g2;
        route_row(p, lg, e1, e2, g1, g2);
        if (lane == it) { my_tok = tok; my_e1 = e1; my_e2 = e2; my_g1 = g1; my_g2 = g2; }
        ++it;
    }
    __syncthreads();
    int r1 = 0, r2 = 0;
    if (my_tok >= 0) { r1 = atomicAdd(&lcnt[my_e1], 1); r2 = atomicAdd(&lcnt[my_e2], 1); }
    __syncthreads();
    if (threadIdx.x < 16) { const int n = lcnt[threadIdx.x]; lcnt[16 + threadIdx.x] = n ? atomicAdd((int*)(p.ws + OFF_CNT) + layer * 16 + threadIdx.x, n) : 0; }
    __syncthreads();
    if (my_tok >= 0) {
        int* stok = (int*)(p.ws + OFF_STOK);
        float* sw = (float*)(p.ws + OFF_SW);
        const size_t s1 = (size_t)my_e1 * CAP + lcnt[16 + my_e1] + r1, s2 = (size_t)my_e2 * CAP + lcnt[16 + my_e2] + r2;
        stok[s1] = my_tok * 2 + 0; sw[s1] = my_g1;
        stok[s2] = my_tok * 2 + 1; sw[s2] = my_g2;
    }
    __syncthreads();
}

DI void combine_row(const Params& p, int layer, int tok, f32x4 (&v)[4], int lane) {
    const bf16_t* Y = (const bf16_t*)(p.ws + OFF_SCR + S_Y) + (size_t)tok * 2 * DM;
    const float* g5 = mod_ptr(p, layer, tok, 5);
    f32x4 y0[4], y1[4];
    row_load(xrow_ptr(p, tok), v, lane);
    row_load_bf16(Y, y0, lane); row_load_bf16(Y + DM, y1, lane);
#pragma unroll
    for (int i = 0; i < 4; ++i) { const f32x4 g = *(const f32x4*)(g5 + (lane + 64 * i) * 4); v[i] += g * (y0[i] + y1[i]); }
}
DI void phase_combine_l0(const Params& p, char* smem) {
    const int lane = threadIdx.x & 63, gw = blockIdx.x * NWAVE + (threadIdx.x >> 6), nw = gridDim.x * NWAVE;
    bf16_t* H = (bf16_t*)(p.ws + OFF_H);
    for (int tok = gw; tok < TTOT; tok += nw) {
        f32x4 v[4], h[4];
        combine_row(p, 0, tok, v, lane);
        float* X = xrow_ptr(p, tok);
#pragma unroll
        for (int i = 0; i < 4; ++i) ((f32x4*)X)[lane + 64 * i] = v[i];
        const float rstd = row_rstd(v);
        row_norm_mod(v, rstd, p.norm_mix_g + DM, mod_ptr(p, 1, tok, 0), mod_ptr(p, 1, tok, 1), h, lane);
        row_store_bf16(H + (size_t)tok * DM, h, lane);
    }
    __syncthreads();
    for (int u = blockIdx.x; u < CV_MOE_UNITS; u += gridDim.x) cvt_moe_unit(p, 1, u, (float*)smem);
}
DI void phase_xx(const Params& p) {
    const int lane = threadIdx.x & 63, gw = blockIdx.x * NWAVE + (threadIdx.x >> 6), nw = gridDim.x * NWAVE;
    const bf16_t* H = (const bf16_t*)(p.ws + OFF_H);
    bf16_t* XX = (bf16_t*)(p.ws + OFF_SCR + S_XX);
    for (int tok = gw; tok < TTOT; tok += nw) {
        const int pos = tok >= PTOT ? tok - PTOT : tok;
        const bool first = pos == 0 || pos == LCTX, last = pos == LCTX - 1 || pos == PTOT - 1;
        f32x4 hc[4], hp[4], hn[4], xx[4];
        row_load_bf16(H + (size_t)tok * DM, hc, lane);
        row_load_bf16(H + (size_t)(first ? tok : tok - 1) * DM, hp, lane);
        row_load_bf16(H + (size_t)(last ? tok : tok + 1) * DM, hn, lane);
#pragma unroll
        for (int i = 0; i < 4; ++i) {
            const f32x4 a = first ? (f32x4){0, 0, 0, 0} : hp[i], b = last ? (f32x4){0, 0, 0, 0} : hn[i];
            xx[i] = 0.5f * (a + b) - hc[i];
        }
        row_store_bf16(XX + (size_t)tok * DM, xx, lane);
    }
}
DI void phase_final(const Params& p) {
    const int lane = threadIdx.x & 63, gw = blockIdx.x * NWAVE + (threadIdx.x >> 6), nw = gridDim.x * NWAVE;
    for (int r = gw; r < NBATCH * SEQ; r += nw) {
        const int b = r / SEQ, tok = b * PTOT + LCTX + (r - b * SEQ);
        f32x4 v[4];
        combine_row(p, 1, tok, v, lane);
        const float rstd = row_rstd(v);
        float* O = p.out + (size_t)r * DM;
#pragma unroll
        for (int i = 0; i < 4; ++i) { const f32x4 g = *(const f32x4*)(p.final_norm_g + (lane + 64 * i) * 4); ((f32x4*)O)[lane + 64 * i] = v[i] * rstd * g; }
    }
}

constexpr int LDSROW = 72;
constexpr int GEMM_SMEM = 2 * (256 + 128) * LDSROW * 2;
template <class AL, class EPI>
DI void gemm_tile(AL& al, const bf16_t* __restrict__ Bt, int ldb, int nk, EPI& epi, char* smem) {
    const int t = threadIdx.x, lane = t & 63, wid = t >> 6, wr = wid >> 1, wc = wid & 1, fr = lane & 15, fq = lane >> 4;
    bf16_t* sA = (bf16_t*)smem;
    bf16_t* sB = sA + 2 * 256 * LDSROW;
    f32x4 acc[4][4];
#pragma unroll
    for (int m = 0; m < 4; ++m)
#pragma unroll
        for (int n = 0; n < 4; ++n) acc[m][n] = (f32x4){0.f, 0.f, 0.f, 0.f};
    const int lr = t >> 3, lc = (t & 7) * 8;
    u32x4 ra[4], rb[2];
#pragma unroll
    for (int i = 0; i < 4; ++i) ra[i] = al.load(lr + 64 * i, lc, i);
#pragma unroll
    for (int i = 0; i < 2; ++i) rb[i] = *(const u32x4*)(Bt + (size_t)(lr + 64 * i) * ldb + lc);
#pragma unroll
    for (int i = 0; i < 4; ++i) *(u32x4*)(sA + (lr + 64 * i) * LDSROW + lc) = ra[i];
#pragma unroll
    for (int i = 0; i < 2; ++i) *(u32x4*)(sB + (lr + 64 * i) * LDSROW + lc) = rb[i];
    __syncthreads();
    bf16x8 af[2][4], bfr[2][4];
    {
        const bf16_t* cA = sA + (wr * 64 + fr) * LDSROW + fq * 8;
        const bf16_t* cB = sB + (wc * 64 + fr) * LDSROW + fq * 8;
#pragma unroll
        for (int m = 0; m < 4; ++m) af[0][m] = *(const bf16x8*)(cA + m * 16 * LDSROW);
#pragma unroll
        for (int n = 0; n < 4; ++n) bfr[0][n] = *(const bf16x8*)(cB + n * 16 * LDSROW);
    }
    for (int kt = 0; kt < nk; ++kt) {
        const int cur = kt & 1;
        const bool more = kt + 1 < nk;
        if (more) {
#pragma unroll
            for (int i = 0; i < 4; ++i) ra[i] = al.load(lr + 64 * i, (kt + 1) * 64 + lc, i);
#pragma unroll
            for (int i = 0; i < 2; ++i) rb[i] = *(const u32x4*)(Bt + (size_t)(lr + 64 * i) * ldb + (kt + 1) * 64 + lc);
        }
        const bf16_t* cA = sA + cur * 256 * LDSROW + (wr * 64 + fr) * LDSROW + fq * 8;
        const bf16_t* cB = sB + cur * 128 * LDSROW + (wc * 64 + fr) * LDSROW + fq * 8;
#pragma unroll
        for (int m = 0; m < 4; ++m) af[1][m] = *(const bf16x8*)(cA + m * 16 * LDSROW + 32);
#pragma unroll
        for (int n = 0; n < 4; ++n) bfr[1][n] = *(const bf16x8*)(cB + n * 16 * LDSROW + 32);
#pragma unroll
        for (int m = 0; m < 4; ++m)
#pragma unroll
            for (int n = 0; n < 4; ++n) acc[m][n] = __builtin_amdgcn_mfma_f32_16x16x32_bf16(bfr[0][n], af[0][m], acc[m][n], 0, 0, 0);
        if (more) {
            bf16_t* nA = sA + (cur ^ 1) * 256 * LDSROW;
            bf16_t* nB = sB + (cur ^ 1) * 128 * LDSROW;
#pragma unroll
            for (int i = 0; i < 4; ++i) *(u32x4*)(nA + (lr + 64 * i) * LDSROW + lc) = ra[i];
#pragma unroll
            for (int i = 0; i < 2; ++i) *(u32x4*)(nB + (lr + 64 * i) * LDSROW + lc) = rb[i];
        }
#pragma unroll
        for (int m = 0; m < 4; ++m)
#pragma unroll
            for (int n = 0; n < 4; ++n) acc[m][n] = __builtin_amdgcn_mfma_f32_16x16x32_bf16(bfr[1][n], af[1][m], acc[m][n], 0, 0, 0);
        __syncthreads();
        if (more) {
            const bf16_t* dA = sA + (cur ^ 1) * 256 * LDSROW + (wr * 64 + fr) * LDSROW + fq * 8;
            const bf16_t* dB = sB + (cur ^ 1) * 128 * LDSROW + (wc * 64 + fr) * LDSROW + fq * 8;
#pragma unroll
            for (int m = 0; m < 4; ++m) af[0][m] = *(const bf16x8*)(dA + m * 16 * LDSROW);
#pragma unroll
            for (int n = 0; n < 4; ++n) bfr[0][n] = *(const bf16x8*)(dB + n * 16 * LDSROW);
        }
    }
    epi(acc, wr * 64, wc * 64, fr, fq);
}
struct ALPlain {
    const bf16_t* A; int lda;
    DI u32x4 load(int r, int k, int) const { return *(const u32x4*)(A + (size_t)r * lda + k); }
};
struct ALGather {
    const bf16_t* rowp[4];
    DI u32x4 load(int, int k, int i) const { return *(const u32x4*)(rowp[i] + k); }
};
struct ALMix {
    const bf16_t* H; const bf16_t* XX; const float* xm;
    DI u32x4 load(int r, int k, int) const {
        const u32x4 h = *(const u32x4*)(H + (size_t)r * DM + k), x = *(const u32x4*)(XX + (size_t)r * DM + k);
        const f32x4 m0 = *(const f32x4*)(xm + k), m1 = *(const f32x4*)(xm + k + 4);
        u32x4 o;
        o[0] = pk_bf16(bf_lo(h[0]) + bf_lo(x[0]) * m0[0], bf_hi(h[0]) + bf_hi(x[0]) * m0[1]);
        o[1] = pk_bf16(bf_lo(h[1]) + bf_lo(x[1]) * m0[2], bf_hi(h[1]) + bf_hi(x[1]) * m0[3]);
        o[2] = pk_bf16(bf_lo(h[2]) + bf_lo(x[2]) * m1[0], bf_hi(h[2]) + bf_hi(x[2]) * m1[1]);
        o[3] = pk_bf16(bf_lo(h[3]) + bf_lo(x[3]) * m1[2], bf_hi(h[3]) + bf_hi(x[3]) * m1[3]);
        return o;
    }
};

struct EpiQKV {
    const Params* p; int m0, n0;
    DI void operator()(const f32x4 (&acc)[4][4], int rb, int cb, int fr, int fq) const {
        const int hs = (n0 + cb) >> 6;
        const bool isq = hs < 8 || (hs >= 12 && hs < 20), isv = (hs >= 10 && hs < 12) || hs >= 22, normed = hs >= 12 && hs < 22;
        const float* gam = hs < 20 ? p->attn_q_norm_g : p->attn_k_norm_g;
        const f32x2* rope = (const f32x2*)(p->ws + OFF_ROPE);
        bf16_t* Q = (bf16_t*)(p->ws + OFF_SCR + S_Q);
        bf16_t* K = (bf16_t*)(p->ws + OFF_SCR + S_K);
        bf16_t* VT = (bf16_t*)(p->ws + OFF_SCR + S_VT);
#pragma unroll
        for (int m = 0; m < 4; ++m) {
            const int tok = m0 + rb + m * 16 + fr, b = tok >= PTOT ? 1 : 0, pos = tok - b * PTOT;
            f32x4 v[4];
#pragma unroll
            for (int n = 0; n < 4; ++n) v[n] = acc[m][n];
            if (normed) {
                float ss = 0.f;
#pragma unroll
                for (int n = 0; n < 4; ++n) ss += v[n][0] * v[n][0] + v[n][1] * v[n][1] + v[n][2] * v[n][2] + v[n][3] * v[n][3];
                ss += __shfl_xor(ss, 16); ss += __shfl_xor(ss, 32);
                const float rstd = rsqrtf(ss * (1.0f / 64.0f) + RMS_EPS);
#pragma unroll
                for (int n = 0; n < 4; ++n) { const f32x4 g = *(const f32x4*)(gam + n * 16 + fq * 4); v[n] = v[n] * rstd * g; }
            }
            if (!isv && pos >= LCTX) {
                const int t = pos - LCTX, prow = t >> 6, pcol = t & 63;
#pragma unroll
                for (int a = 0; a < 2; ++a) {
                    const f32x2* tb = rope + (a == 0 ? prow : 256 + pcol) * 16 + fq * 4;
#pragma unroll
                    for (int j = 0; j < 4; ++j) {
                        const f32x2 cs = tb[j];
                        const float x0 = v[2 * a][j], x1 = v[2 * a + 1][j];
                        v[2 * a][j] = x0 * cs[0] - x1 * cs[1];
                        v[2 * a + 1][j] = x1 * cs[0] + x0 * cs[1];
                    }
                }
            }
            if (isq) {
                const int hq = hs < 8 ? hs : hs - 4;
                bf16_t* dst = Q + ((size_t)(b * 16 + hq) * PTOT + pos) * 64 + fq * 4;
#pragma unroll
                for (int n = 0; n < 4; ++n) { const f32x4 w = v[n] * (0.125f * LOG2E); u32x2 o; o[0] = pk_bf16(w[0], w[1]); o[1] = pk_bf16(w[2], w[3]); *(u32x2*)(dst + n * 16) = o; }
            } else if (!isv) {
                const int kh = hs < 12 ? hs - 8 : hs - 18;
                bf16_t* dst = K + ((size_t)(b * 4 + kh) * PTOT + pos) * 64 + fq * 4;
#pragma unroll
                for (int n = 0; n < 4; ++n) { u32x2 o; o[0] = pk_bf16(v[n][0], v[n][1]); o[1] = pk_bf16(v[n][2], v[n][3]); *(u32x2*)(dst + n * 16) = o; }
            } else {
                const int vh = hs < 12 ? hs - 10 : hs - 20;
                bf16_t* dst = VT + (size_t)(b * 4 + vh) * 64 * PTOT + pos;
#pragma unroll
                for (int n = 0; n < 4; ++n)
#pragma unroll
                    for (int j = 0; j < 4; ++j) dst[(size_t)(n * 16 + fq * 4 + j) * PTOT] = (bf16_t)(pk_bf16(v[n][j], 0.f) & 0xffffu);
            }
        }
    }
};
DI void phase_qkv(const Params& p, char* smem) {
    const bf16_t* H = (const bf16_t*)(p.ws + OFF_H);
    const bf16_t* W = (const bf16_t*)(p.ws + OFF_WS) + W_IN;
    constexpr int NT = QKV_N / 128, MT = TTOT / 256;
    for (int u = blockIdx.x; u < MT * NT; u += gridDim.x) {
        const int mt = u / NT, nt = u % NT;
        ALPlain al{H + (size_t)mt * 256 * DM, DM};
        EpiQKV epi{&p, mt * 256, nt * 128};
        gemm_tile(al, W + (size_t)nt * 128 * DM, DM, DM / 64, epi, smem);
    }
}

struct EpiResid {
    const Params* p; int m0, n0, layer; bool from_input;
    DI void operator()(const f32x4 (&acc)[4][4], int rb, int cb, int fr, int fq) const {
#pragma unroll
        for (int m = 0; m < 4; ++m) {
            const int tok = m0 + rb + m * 16 + fr;
            const float* xin = from_input ? xin_ptr(*p, tok) : xrow_ptr(*p, tok);
            float* xo = xrow_ptr(*p, tok);
            const float* gate = mod_ptr(*p, layer, tok, 2);
#pragma unroll
            for (int n = 0; n < 4; ++n) {
                const int c = n0 + cb + n * 16 + fq * 4;
                const f32x4 xi = *(const f32x4*)(xin + c), g = *(const f32x4*)(gate + c);
                *(f32x4*)(xo + c) = xi + g * acc[m][n];
            }
        }
    }
};
DI void phase_wout(const Params& p, char* smem) {
    const bf16_t* O = (const bf16_t*)(p.ws + OFF_SCR + S_O);
    const bf16_t* W = (const bf16_t*)(p.ws + OFF_WS) + W_OUT;
    constexpr int NT = 8, MT = TTOT / 256;
    for (int u = blockIdx.x; u < MT * NT; u += gridDim.x) {
        const int mt = u / NT, nt = u % NT;
        ALPlain al{O + (size_t)mt * 256 * DM, DM};
        EpiResid epi{&p, mt * 256, nt * 128, 0, true};
        gemm_tile(al, W + (size_t)nt * 128 * DM, DM, DM / 64, epi, smem);
    }
}
DI void phase_wo(const Params& p, char* smem) {
    const bf16_t* O = (const bf16_t*)(p.ws + OFF_SCR + S_OR);
    const bf16_t* W = (const bf16_t*)(p.ws + OFF_WS) + W_O;
    constexpr int NT = 8, MTL = SEQ / 256;
    for (int u = blockIdx.x; u < NBATCH * MTL * NT; u += gridDim.x) {
        const int mi = u / NT, nt = u % NT, b = mi / MTL, mt = b * (PTOT / 256) + 1 + (mi % MTL);
        ALPlain al{O + (size_t)mt * 256 * DM, DM};
        EpiResid epi{&p, mt * 256, nt * 128, 1, false};
        gemm_tile(al, W + (size_t)nt * 128 * DM, DM, DM / 64, epi, smem);
    }
}

struct MoeSched { int nt[16], base[17]; };
DI void moe_sched(const Params& p, int layer, MoeSched& s, int (&cnt)[16]) {
    const int* c = (const int*)(p.ws + OFF_CNT) + layer * 16;
    int acc = 0;
#pragma unroll
    for (int e = 0; e < 16; ++e) { cnt[e] = c[e]; s.nt[e] = (cnt[e] + 255) >> 8; s.base[e] = acc; acc += s.nt[e]; }
    s.base[16] = acc;
}
struct EpiMoe1 {
    bf16_t* hid;   int n0;
    DI void operator()(const f32x4 (&acc)[4][4], int rb, int cb, int fr, int fq) const {
        const int g = (n0 + cb) >> 6;
#pragma unroll
        for (int m = 0; m < 4; ++m) {
            bf16_t* dst = hid + (size_t)(rb + m * 16 + fr) * 1024 + g * 32 + fq * 4;
#pragma unroll
            for (int n = 0; n < 2; ++n) {
                const f32x4 a = acc[m][n], b = acc[m][n + 2];
                u32x2 o;
                o[0] = pk_bf16(siluf_(a[0]) * b[0], siluf_(a[1]) * b[1]);
                o[1] = pk_bf16(siluf_(a[2]) * b[2], siluf_(a[3]) * b[3]);
                *(u32x2*)(dst + n * 16) = o;
            }
        }
    }
};
DI void phase_moe1(const Params& p, int layer, char* smem) {
    MoeSched s; int cnt[16];
    moe_sched(p, layer, s, cnt);
    const bf16_t* H = (const bf16_t*)(p.ws + OFF_H);
    const bf16_t* W13 = (const bf16_t*)(p.ws + OFF_MOEW);
    const int* stok = (const int*)(p.ws + OFF_STOK);
    bf16_t* hid = (bf16_t*)(p.ws + OFF_SCR + S_HID);
    constexpr int NT = 16;
    const int total = s.base[16] * NT;
    const int lr = threadIdx.x >> 3;
    for (int u = blockIdx.x; u < total; u += gridDim.x) {
        const int mg = u / NT, nt = u % NT;
        int e = 0;
#pragma unroll
        for (int i = 1; i < 16; ++i) if (mg >= s.base[i]) e = i;
        int ce = 0;
#pragma unroll
        for (int i = 0; i < 16; ++i) if (i == e) ce = cnt[i];
        int be = 0;
#pragma unroll
        for (int i = 0; i < 16; ++i) if (i == e) be = s.base[i];
        const int ml = mg - be;
        ALGather al;
#pragma unroll
        for (int i = 0; i < 4; ++i) {
            const int r = ml * 256 + lr + 64 * i;
            const int tk = r < ce ? (stok[(size_t)e * CAP + r] >> 1) : 0;
            al.rowp[i] = H + (size_t)tk * DM;
        }
        EpiMoe1 epi{hid + (size_t)mg * 256 * 1024, nt * 128};
        gemm_tile(al, W13 + (size_t)e * 2048 * 1024 + (size_t)nt * 128 * 1024, 1024, 16, epi, smem);
    }
}
struct EpiMoe2 {
    bf16_t* Y; const int* stok; const float* sw; int nvalid, n0;
    DI void operator()(const f32x4 (&acc)[4][4], int rb, int cb, int fr, int fq) const {
#pragma unroll
        for (int m = 0; m < 4; ++m) {
            const int r = rb + m * 16 + fr;
            if (r < nvalid) {
                const int tk = stok[r]; const float w = sw[r];
                bf16_t* dst = Y + (size_t)tk * 1024 + n0 + cb + fq * 4;
#pragma unroll
                for (int n = 0; n < 4; ++n) { const f32x4 a = acc[m][n] * w; u32x2 o; o[0] = pk_bf16(a[0], a[1]); o[1] = pk_bf16(a[2], a[3]); *(u32x2*)(dst + n * 16) = o; }
            }
        }
    }
};
DI void phase_moe2(const Params& p, int layer, char* smem) {
    MoeSched s; int cnt[16];
    moe_sched(p, layer, s, cnt);
    const bf16_t* hid = (const bf16_t*)(p.ws + OFF_SCR + S_HID);
    const bf16_t* W2 = (const bf16_t*)(p.ws + OFF_MOEW) + (size_t)16 * 2048 * 1024;
    const int* stok = (const int*)(p.ws + OFF_STOK);
    const float* sw = (const float*)(p.ws + OFF_SW);
    bf16_t* Y = (bf16_t*)(p.ws + OFF_SCR + S_Y);
    constexpr int NT = 8;
    const int total = s.base[16] * NT;
    for (int u = blockIdx.x; u < total; u += gridDim.x) {
        const int mg = u / NT, nt = u % NT;
        int e = 0;
#pragma unroll
        for (int i = 1; i < 16; ++i) if (mg >= s.base[i]) e = i;
        int ce = 0, be = 0;
#pragma unroll
        for (int i = 0; i < 16; ++i) if (i == e) { ce = cnt[i]; be = s.base[i]; }
        const int ml = mg - be;
        ALPlain al{hid + (size_t)mg * 256 * 1024, 1024};
        EpiMoe2 epi{Y, stok + (size_t)e * CAP + ml * 256, sw + (size_t)e * CAP + ml * 256, ce - ml * 256, nt * 128};
        gemm_tile(al, W2 + (size_t)e * 1024 * 1024 + (size_t)nt * 128 * 1024, 1024, 16, epi, smem);
    }
}

struct EpiRwkv {
    bf16_t* dst; int ld, m0, n0, act, nstore;
    DI void operator()(const f32x4 (&acc)[4][4], int rb, int cb, int fr, int fq) const {
#pragma unroll
        for (int m = 0; m < 4; ++m) {
            bf16_t* d = dst + (size_t)(m0 + rb + m * 16 + fr) * ld + n0 + cb + fq * 4;
#pragma unroll
            for (int n = 0; n < 4; ++n) {
                const int c = n0 + cb + n * 16 + fq * 4;
                if (c >= ld) continue;
                f32x4 a = acc[m][n];
                if (act == 1) {
#pragma unroll
                    for (int j = 0; j < 4; ++j) { const float e = __expf(2.0f * a[j]); a[j] = 1.0f - 2.0f / (e + 1.0f); }
                }
                if (act == 2) {
#pragma unroll
                    for (int j = 0; j < 4; ++j) a[j] = sigmoidf_(a[j]);
                }
                if (c >= nstore) a = (f32x4){0.f, 0.f, 0.f, 0.f};
                u32x2 o; o[0] = pk_bf16(a[0], a[1]); o[1] = pk_bf16(a[2], a[3]);
                *(u32x2*)(d + n * 16) = o;
            }
        }
    }
};
DI void phase_rwkv_proj(const Params& p, char* smem) {
    const bf16_t* H = (const bf16_t*)(p.ws + OFF_H);
    const bf16_t* XX = (const bf16_t*)(p.ws + OFF_SCR + S_XX);
    const bf16_t* wsm = (const bf16_t*)(p.ws + OFF_WS);
    constexpr int MT = TTOT / 256, NTT = 8 + 8 + 8 + 1 + 1 + 2;
    for (int u = blockIdx.x; u < MT * NTT; u += gridDim.x) {
        const int mt = u / NTT, q = u % NTT;
        int job, nt;
        if (q < 8) { job = 0; nt = q; } else if (q < 16) { job = 1; nt = q - 8; } else if (q < 24) { job = 2; nt = q - 16; }
        else if (q == 24) { job = 3; nt = 0; } else if (q == 25) { job = 4; nt = 0; } else { job = 5; nt = q - 26; }
        const int mixj = job == 0 ? 0 : job == 1 ? 2 : job == 2 ? 3 : job == 3 ? 1 : job == 4 ? 4 : 5;
        const size_t wofs = job == 0 ? W_R : job == 1 ? W_K : job == 2 ? W_V : job == 3 ? W_W1 : job == 4 ? W_A1 : W_G1;
        const size_t dofs = job == 0 ? S_R : job == 1 ? S_KK : job == 2 ? S_V : job == 3 ? S_LW : job == 4 ? S_LA : S_LG;
        const int ld = job < 3 ? 1024 : job < 5 ? 128 : 192;
        ALMix al{H + (size_t)mt * 256 * DM, XX + (size_t)mt * 256 * DM, p.rwkv_x_mix + mixj * DM};
        EpiRwkv epi{(bf16_t*)(p.ws + OFF_SCR + dofs), ld, mt * 256, nt * 128, job == 3 ? 1 : job == 5 ? 2 : 0, job == 5 ? 160 : 4096};
        gemm_tile(al, wsm + wofs + (size_t)nt * 128 * DM, DM, DM / 64, epi, smem);
    }
}

struct EpiGate {
    const Params* p; int m0, n0;
    DI void operator()(const f32x4 (&acc)[4][4], int rb, int cb, int fr, int fq) const {
        const bf16_t* Y0 = (const bf16_t*)(p->ws + OFF_H);
        const bf16_t* Y1 = (const bf16_t*)(p->ws + OFF_SCR + S_Y1);
        const bf16_t* V = (const bf16_t*)(p->ws + OFF_SCR + S_V);
        const float* bonus = (const float*)(p->ws + OFF_BONUS2);
        bf16_t* O = (bf16_t*)(p->ws + OFF_SCR + S_OR);
        const int c0 = n0 + cb, hd = c0 >> 6;
#pragma unroll
        for (int m = 0; m < 4; ++m) {
            const int tok = m0 + rb + m * 16 + fr;
            const size_t ro = (size_t)tok * DM + c0 + fq * 4;
            f32x4 y[4];
            float s = 0.f;
#pragma unroll
            for (int n = 0; n < 4; ++n) {
                const u32x2 a = *(const u32x2*)(Y0 + ro + n * 16), b = *(const u32x2*)(Y1 + ro + n * 16);
                y[n][0] = bf_lo(a[0]) + bf_lo(b[0]); y[n][1] = bf_hi(a[0]) + bf_hi(b[0]); y[n][2] = bf_lo(a[1]) + bf_lo(b[1]); y[n][3] = bf_hi(a[1]) + bf_hi(b[1]);
                s += y[n][0] + y[n][1] + y[n][2] + y[n][3];
            }
            s += __shfl_xor(s, 16); s += __shfl_xor(s, 32);
            const float mu = s * (1.0f / 64.0f);
            float q = 0.f;
#pragma unroll
            for (int n = 0; n < 4; ++n) { const f32x4 d = y[n] - mu; q += d[0] * d[0] + d[1] * d[1] + d[2] * d[2] + d[3] * d[3]; }
            q += __shfl_xor(q, 16); q += __shfl_xor(q, 32);
            const float rs = rsqrtf(q * (1.0f / 64.0f) + GN_EPS);
            const float bon = (bonus[(size_t)tok * 16 + hd] + bonus[(size_t)(TTOT + tok) * 16 + hd]) + (bonus[(size_t)(2 * TTOT + tok) * 16 + hd] + bonus[(size_t)(3 * TTOT + tok) * 16 + hd]);
#pragma unroll
            for (int n = 0; n < 4; ++n) {
                const int c = c0 + n * 16 + fq * 4;
                const f32x4 g = *(const f32x4*)(p->rwkv_ln_g + c), bb = *(const f32x4*)(p->rwkv_ln_b + c);
                const u32x2 vv = *(const u32x2*)(V + ro + n * 16);
                const f32x4 v4 = {bf_lo(vv[0]), bf_hi(vv[0]), bf_lo(vv[1]), bf_hi(vv[1])};
                const f32x4 o = ((y[n] - mu) * rs * g + bb + bon * v4) * acc[m][n];
                u32x2 w; w[0] = pk_bf16(o[0], o[1]); w[1] = pk_bf16(o[2], o[3]);
                *(u32x2*)(O + ro + n * 16) = w;
            }
        }
    }
};
DI void phase_gate(const Params& p, char* smem) {
    const bf16_t* LG = (const bf16_t*)(p.ws + OFF_SCR + S_LG);
    const bf16_t* W = (const bf16_t*)(p.ws + OFF_WS) + W_G2;
    constexpr int NT = 8, MT = TTOT / 256;
    for (int u = blockIdx.x; u < MT * NT; u += gridDim.x) {
        const int mt = u / NT, nt = u % NT;
        ALPlain al{LG + (size_t)mt * 256 * 192, 192};
        EpiGate epi{&p, mt * 256, nt * 128};
        gemm_tile(al, W + (size_t)nt * 128 * 192, 192, 3, epi, smem);
    }
}

constexpr int KROW = 72, VROW = 68;
constexpr int ATT_SMEM = 2 * 64 * KROW * 2 + 2 * 64 * VROW * 2;
DI int crow_(int i, int h) { return (i & 3) + 8 * (i >> 2) + 4 * h; }
#define MFMA32(a, b, c) __builtin_amdgcn_mfma_f32_32x32x16_bf16((a), (b), (c), 0, 0, 0)
template <int MODE>
DI void attn_unit(const Params& p, const bf16_t* Qg  , int nq_valid, const bf16_t* Kg  , const bf16_t* Vg  ,
                  int ta0, int ta1, int tb0, int tb1  , bool band, int q_lat0  ,
                  float init_m, float init_l0, bf16_t* Og  , char* smem) {
    const int t = threadIdx.x, lane = t & 63, wid = t >> 6, r = lane & 31, h = lane >> 5;
    bf16_t* sK = (bf16_t*)smem;
    bf16_t* sV = sK + 2 * 64 * KROW;
    bf16x8 qf[2][4];
#pragma unroll
    for (int qs = 0; qs < 2; ++qs) {
        const int qi = wid * 64 + qs * 32 + r;
        const bf16_t* qp = Qg + (size_t)(qi < nq_valid ? qi : 0) * 64 + 8 * h;
#pragma unroll
        for (int ks = 0; ks < 4; ++ks) qf[qs][ks] = *(const bf16x8*)(qp + ks * 16);
    }
    f32x16 o[2][2];
#pragma unroll
    for (int qs = 0; qs < 2; ++qs)
#pragma unroll
        for (int dt = 0; dt < 2; ++dt)
#pragma unroll
            for (int i = 0; i < 16; ++i) o[qs][dt][i] = 0.f;
    float mrun[2], lrun[2];
#pragma unroll
    for (int qs = 0; qs < 2; ++qs) { mrun[qs] = init_m; lrun[qs] = (MODE == 1 && h == 0) ? init_l0 : 0.f; }
    const int ntile = ((ta1 - ta0) + (tb1 - tb0)) >> 6;
    const int lrow = t >> 3, lch = (t & 7) * 8;
    u32x4 rk, rv;
    auto tile_pos = [&](int i) { const int a = (ta1 - ta0) >> 6; return i < a ? ta0 + i * 64 : tb0 + (i - a) * 64; };
    {
        const int kp = tile_pos(0);
        rk = *(const u32x4*)(Kg + (size_t)(kp + lrow) * 64 + lch);
        rv = *(const u32x4*)(Vg + (size_t)lrow * PTOT + kp + lch);
        *(u32x4*)(sK + lrow * KROW + lch) = rk;
        *(u32x2*)(sV + lrow * VROW + lch) = (u32x2){rv[0], rv[1]};
        *(u32x2*)(sV + lrow * VROW + lch + 4) = (u32x2){rv[2], rv[3]};
    }
    __syncthreads();
    for (int it = 0; it < ntile; ++it) {
        const int cur = it & 1;
        const bool more = it + 1 < ntile;
        const int kp = tile_pos(it);
        if (more) {
            const int kn = tile_pos(it + 1);
            rk = *(const u32x4*)(Kg + (size_t)(kn + lrow) * 64 + lch);
            rv = *(const u32x4*)(Vg + (size_t)lrow * PTOT + kn + lch);
        }
        const bf16_t* cK = sK + cur * 64 * KROW;
        const bf16_t* cV = sV + cur * 64 * VROW;
#pragma unroll 1
        for (int ksub = 0; ksub < 2; ++ksub) {
            f32x16 sc[2];
#pragma unroll
            for (int qs = 0; qs < 2; ++qs)
#pragma unroll
                for (int i = 0; i < 16; ++i) sc[qs][i] = MODE == 0 ? init_m : 0.f;
#pragma unroll
            for (int ks = 0; ks < 4; ++ks) {
                const bf16x8 kf = *(const bf16x8*)(cK + (ksub * 32 + r) * KROW + ks * 16 + 8 * h);
#pragma unroll
                for (int qs = 0; qs < 2; ++qs) sc[qs] = MFMA32(kf, qf[qs][ks], sc[qs]);
            }
#pragma unroll
            for (int qs = 0; qs < 2; ++qs) {
                if (MODE == 1) {
                    if (band && kp >= LCTX) {
                        const int qlat = q_lat0 + wid * 64 + qs * 32 + r, kl0 = kp - LCTX + ksub * 32;
#pragma unroll
                        for (int i = 0; i < 16; ++i) {
                            const int d0 = qlat - (kl0 + crow_(i, h));
                            if (d0 > 128 || d0 < -128) sc[qs][i] = -1e30f;
                        }
                    }
                    float mt = sc[qs][0];
#pragma unroll
                    for (int i = 1; i < 16; ++i) mt = fmaxf(mt, sc[qs][i]);
                    mt = fmaxf(mt, __shfl_xor(mt, 32));
                    const float mnew = fmaxf(mrun[qs], mt);
                    const float alpha = __builtin_amdgcn_exp2f(mrun[qs] - mnew);
                    mrun[qs] = mnew; lrun[qs] *= alpha;
#pragma unroll
                    for (int i = 0; i < 16; ++i) { o[qs][0][i] *= alpha; o[qs][1][i] *= alpha; }
#pragma unroll
                    for (int i = 0; i < 16; ++i) sc[qs][i] -= mnew;
                }
                float ls = 0.f;
#pragma unroll
                for (int i = 0; i < 16; ++i) { sc[qs][i] = __builtin_amdgcn_exp2f(sc[qs][i]); ls += sc[qs][i]; }
                lrun[qs] += ls;
            }
#pragma unroll
            for (int st = 0; st < 2; ++st) {
                bf16x8 pf[2];
#pragma unroll
                for (int qs = 0; qs < 2; ++qs) {
                    u32x4 pw;
#pragma unroll
                    for (int j = 0; j < 4; ++j) pw[j] = pk_bf16(sc[qs][8 * st + 2 * j], sc[qs][8 * st + 2 * j + 1]);
                    pf[qs] = __builtin_bit_cast(bf16x8, pw);
                }
                const int kb = ksub * 32 + 16 * st + 4 * h;
#pragma unroll
                for (int dt = 0; dt < 2; ++dt) {
                    const s16x4 lo = *(const s16x4*)(cV + (dt * 32 + r) * VROW + kb), hi = *(const s16x4*)(cV + (dt * 32 + r) * VROW + kb + 8);
                    const bf16x8 vf = __builtin_shufflevector(lo, hi, 0, 1, 2, 3, 4, 5, 6, 7);
#pragma unroll
                    for (int qs = 0; qs < 2; ++qs) o[qs][dt] = MFMA32(vf, pf[qs], o[qs][dt]);
                }
            }
        }
        if (more) {
            bf16_t* nK = sK + (cur ^ 1) * 64 * KROW;
            bf16_t* nV = sV + (cur ^ 1) * 64 * VROW;
            *(u32x4*)(nK + lrow * KROW + lch) = rk;
            *(u32x2*)(nV + lrow * VROW + lch) = (u32x2){rv[0], rv[1]};
            *(u32x2*)(nV + lrow * VROW + lch + 4) = (u32x2){rv[2], rv[3]};
        }
        __syncthreads();
    }
#pragma unroll
    for (int qs = 0; qs < 2; ++qs) {
        const int qi = wid * 64 + qs * 32 + r;
        const float lt = lrun[qs] + __shfl_xor(lrun[qs], 32);
        const float invl = 1.0f / lt;
        if (qi < nq_valid) {
            bf16_t* op = Og + (size_t)qi * DM;
#pragma unroll
            for (int g = 0; g < 4; ++g) {
                u32x2 w0, w1;
                w0[0] = pk_bf16(o[qs][0][4 * g] * invl, o[qs][0][4 * g + 1] * invl); w0[1] = pk_bf16(o[qs][0][4 * g + 2] * invl, o[qs][0][4 * g + 3] * invl);
                w1[0] = pk_bf16(o[qs][1][4 * g] * invl, o[qs][1][4 * g + 1] * invl); w1[1] = pk_bf16(o[qs][1][4 * g + 2] * invl, o[qs][1][4 * g + 3] * invl);
                *(u32x2*)(op + 8 * g + 4 * h) = w0;
                *(u32x2*)(op + 32 + 8 * g + 4 * h) = w1;
            }
        }
    }
}
DI void phase_attn(const Params& p, char* smem) {
    const bf16_t* Q = (const bf16_t*)(p.ws + OFF_SCR + S_Q);
    const bf16_t* K = (const bf16_t*)(p.ws + OFF_SCR + S_K);
    const bf16_t* VT = (const bf16_t*)(p.ws + OFF_SCR + S_VT);
    bf16_t* O = (bf16_t*)(p.ws + OFF_SCR + S_O);
    float gq = 0.f, gk = 0.f;
    for (int i = 0; i < 64; ++i) { gq = fmaxf(gq, fabsf(p.attn_q_norm_g[i])); gk = fmaxf(gk, fabsf(p.attn_k_norm_g[i])); }
    const float M2 = 8.25f * gq * gk * LOG2E;
    constexpr int QB = 512, NQB = SEQ / QB;
    const int G = gridDim.x;
    constexpr int NDENSE = NBATCH * 8 * NQB;
    for (int u = blockIdx.x; u < NDENSE; u += G) {
        int combo, within;
        if ((G & 7) == 0 && NDENSE % G == 0) {
            const int xcd = blockIdx.x & 7, idx = (blockIdx.x >> 3) + (G >> 3) * (u / G);
            combo = xcd & 3; within = (xcd >> 2) * (NDENSE / 8) + idx;
        } else { combo = u / (4 * NQB); within = u % (4 * NQB); }
        const int b = combo >> 1, kvh = combo & 1, hq = kvh * 4 + (within & 3), qb = within >> 2;
        const bf16_t* Qg = Q + ((size_t)(b * 16 + 8 + hq) * PTOT + LCTX + qb * QB) * 64;
        attn_unit<0>(p, Qg, QB, K + (size_t)(b * 4 + 2 + kvh) * PTOT * 64, VT + (size_t)(b * 4 + 2 + kvh) * 64 * PTOT, 0, PTOT, 0, 0, false, 0, -M2, 0.f,
                     O + (size_t)(b * PTOT + LCTX + qb * QB) * DM + (8 + hq) * 64, smem);
    }
    for (int u = blockIdx.x; u < NDENSE; u += G) {
        const int b = u / (8 * NQB), rem = u % (8 * NQB), qb = rem >> 3, hq = rem & 7, kvh = hq >> 2;
        const int i0 = qb * QB;
        const int lo = i0 - 128 < 0 ? 0 : i0 - 128, hi = i0 + QB + 128 > SEQ ? SEQ : i0 + QB + 128;
        const bf16_t* Qg = Q + ((size_t)(b * 16 + hq) * PTOT + LCTX + i0) * 64;
        attn_unit<1>(p, Qg, QB, K + (size_t)(b * 4 + kvh) * PTOT * 64, VT + (size_t)(b * 4 + kvh) * 64 * PTOT, 0, LCTX, LCTX + lo, LCTX + hi, true, i0,
                     p.attn_sink[hq] * LOG2E, 1.0f, O + (size_t)(b * PTOT + LCTX + i0) * DM + hq * 64, smem);
    }
    for (int u = blockIdx.x; u < NBATCH * 16; u += G) {
        const int b = u >> 4, hh = u & 15, isb = hh >> 3, hq = hh & 7, kvh = isb * 2 + (hq >> 2);
        const bf16_t* Qg = Q + ((size_t)(b * 16 + hh) * PTOT) * 64;
        attn_unit<1>(p, Qg, LCTX, K + (size_t)(b * 4 + kvh) * PTOT * 64, VT + (size_t)(b * 4 + kvh) * 64 * PTOT, 0, LCTX, 0, 0, false, 0,
                     isb ? -1e30f : p.attn_sink[hq] * LOG2E, isb ? 0.f : 1.0f, O + (size_t)(b * PTOT) * DM + hh * 64, smem);
    }
}

constexpr int TB = 32, NBUF = 3;
constexpr int SC_REC = 5 * 64;
constexpr int SC_OPS = TB * SC_REC * 4;
constexpr int SC_SMEM = NBUF * SC_OPS + NBUF * TB * 16 * 4 + NBUF * TB * 16 * 4 + 64;
DI int scan_pos(int n, int dir) {
    if (n < LCTX) return dir ? LCTX - 1 - n : n;
    const int m = n - LCTX;
    return LCTX + (dir ? SEQ - 1 - m : m);
}
template <int CTRL> DI float dpp_add(float v) { return v + __builtin_bit_cast(float, __builtin_amdgcn_update_dpp(0, __builtin_bit_cast(int, v), CTRL, 0xf, 0xf, false)); }
DI float row16_sum(float v) { v = dpp_add<0x128>(v); v = dpp_add<0x124>(v); v = dpp_add<0x122>(v); v = dpp_add<0x121>(v); return v; }
DI int lds_min4(int* c) { const volatile LAS int* q = (const volatile LAS int*)c; const int a = q[0], b = q[1], d = q[2], e = q[3]; return min(min(a, b), min(d, e)); }
DI void lds_publish(int* c, int v) { *(volatile LAS int*)c = v; }
DI void scan_unit(const Params& p, int u, char* smem) {
    const int t = threadIdx.x, lane = t & 63, wid = __builtin_amdgcn_readfirstlane(t >> 6);
    const unsigned rg = u & 3, dir = (u >> 2) & 1, hd = (u >> 3) & 15, b = u >> 7;
    float* ops = (float*)smem;
    float* vbuf = (float*)(smem + NBUF * SC_OPS);
    float* ybuf = vbuf + NBUF * TB * 16;
    int* cnts = (int*)(ybuf + NBUF * TB * 16);
    const bf16_t* R = (const bf16_t*)(p.ws + OFF_SCR + S_R);
    const bf16_t* Kk = (const bf16_t*)(p.ws + OFF_SCR + S_KK);
    const bf16_t* V = (const bf16_t*)(p.ws + OFF_SCR + S_V);
    const bf16_t* LW = (const bf16_t*)(p.ws + OFF_SCR + S_LW);
    const bf16_t* LA = (const bf16_t*)(p.ws + OFF_SCR + S_LA);
    bf16_t* Yo = dir ? (bf16_t*)(p.ws + OFF_SCR + S_Y1) : (bf16_t*)(p.ws + OFF_H);
    float* bonus = (float*)(p.ws + OFF_BONUS2);
    const unsigned tokb = b * PTOT, hc = hd * 64;
    constexpr int NBLK = PTOT / TB;
    const unsigned fr = lane & 15, fq = lane >> 4;
    if (t < 8) cnts[t] = 0;
    __syncthreads();

    if (wid < 4) {
        __builtin_amdgcn_s_setprio(3);
        float s0 = 0.f, s1 = 0.f, s2 = 0.f, s3 = 0.f;
        const unsigned g = lane >> 4, c4 = (lane & 15) * 4, myrow = wid * 4 + g;
        for (int blk = 0; blk < NBLK; ++blk) {
            const unsigned buf = (unsigned)blk % NBUF;
            while (lds_min4(cnts) < blk + 1) __builtin_amdgcn_s_sleep(1);
            asm volatile("" ::: "memory");
            const float* rec = ops + buf * (TB * SC_REC) + c4;
            const float* vb = vbuf + buf * (TB * 16) + myrow;
            float* yb = ybuf + buf * (TB * 16) + myrow;
            f32x4 w0_ = *(const f32x4*)(rec), kd0_ = *(const f32x4*)(rec + 64), bb0_ = *(const f32x4*)(rec + 128), aa0_ = *(const f32x4*)(rec + 192), rr0_ = *(const f32x4*)(rec + 256);
            float vv0_ = vb[0];
#define SCAN_STEP(W, KD, BB, AA, RR, VV, ST) { \
                float sa = s0 * AA[0] + s1 * AA[1] + s2 * AA[2] + s3 * AA[3]; \
                sa = row16_sum(sa); \
                s0 = s0 * W[0] + sa * BB[0] + VV * KD[0]; \
                s1 = s1 * W[1] + sa * BB[1] + VV * KD[1]; \
                s2 = s2 * W[2] + sa * BB[2] + VV * KD[2]; \
                s3 = s3 * W[3] + sa * BB[3] + VV * KD[3]; \
                float y = s0 * RR[0] + s1 * RR[1] + s2 * RR[2] + s3 * RR[3]; \
                y = row16_sum(y); \
                if ((lane & 15) == 0) yb[(ST) * 16] = y; }
#pragma unroll 1
            for (int st = 0; st < TB; st += 2) {
                const float* r1 = rec + (st + 1) * SC_REC;
                const f32x4 w1_ = *(const f32x4*)(r1), kd1_ = *(const f32x4*)(r1 + 64), bb1_ = *(const f32x4*)(r1 + 128), aa1_ = *(const f32x4*)(r1 + 192), rr1_ = *(const f32x4*)(r1 + 256);
                const float vv1_ = vb[(st + 1) * 16];
                SCAN_STEP(w0_, kd0_, bb0_, aa0_, rr0_, vv0_, st)
                const int st2 = st + 2 < TB ? st + 2 : st;
                const float* r2 = rec + st2 * SC_REC;
                w0_ = *(const f32x4*)(r2); kd0_ = *(const f32x4*)(r2 + 64); bb0_ = *(const f32x4*)(r2 + 128); aa0_ = *(const f32x4*)(r2 + 192); rr0_ = *(const f32x4*)(r2 + 256);
                vv0_ = vb[st2 * 16];
                SCAN_STEP(w1_, kd1_, bb1_, aa1_, rr1_, vv1_, st + 1)
            }
#undef SCAN_STEP
            asm volatile("s_waitcnt lgkmcnt(0)" ::: "memory");
            if (lane == 0) lds_publish(cnts + 4 + wid, blk + 1);
        }
        __builtin_amdgcn_s_setprio(0);
    } else {
        const unsigned wt = wid & 1, chh = (wid >> 1) & 1;
        const bf16_t* wsm = (const bf16_t*)(p.ws + OFF_WS);
        const unsigned wo = W_W2 + dir * 65536u + (hc + fr) * 64u + fq * 8u;
        const unsigned ao = W_A2 + dir * 65536u + (hc + fr) * 64u + fq * 8u;
        const unsigned po = hc + fq * 4u;
        for (int blk = 0; blk < NBLK + NBUF; ++blk) {
            const unsigned buf = (unsigned)blk % NBUF;
            const int need = blk - NBUF + 1 < NBLK ? blk - NBUF + 1 : NBLK;
            while (lds_min4(cnts + 4) < need) __builtin_amdgcn_s_sleep(1);
            asm volatile("" ::: "memory");
            if (wid == 7 && blk >= NBUF) {
#pragma unroll
                for (int i = 0; i < TB * 16 / 64; ++i) {
                    const unsigned id = i * 64 + lane, st = id >> 4, rw = id & 15;
                    const unsigned tok = tokb + scan_pos((blk - NBUF) * TB + st, dir);
                    Yo[tok * 1024u + hc + rg * 16 + rw] = (bf16_t)(pk_bf16(ybuf[buf * (TB * 16) + id], 0.f) & 0xffffu);
                }
            }
            if (blk >= NBLK) continue;
            const unsigned st = wt * 16 + fr;
            const unsigned tok = tokb + scan_pos(blk * TB + st, dir);
            const unsigned lo = tok * 128u + dir * 64u + fq * 8u;
            const unsigned ro = tok * 1024u + hc + fq * 4u;
            bf16x8 lwf[2], laf[2];
#pragma unroll
            for (int kk = 0; kk < 2; ++kk) { lwf[kk] = *(const bf16x8*)(LW + lo + kk * 32); laf[kk] = *(const bf16x8*)(LA + lo + kk * 32); }
            float ssq = 0.f;
#pragma unroll
            for (int nt = 0; nt < 4; ++nt) {
                const f32x4 kkv = *(const f32x4*)(p.rwkv_k_k + po + nt * 16);
                const u32x2 c = *(const u32x2*)(Kk + ro + nt * 16);
                const float q0 = bf_lo(c[0]) * kkv[0], q1 = bf_hi(c[0]) * kkv[1], q2 = bf_lo(c[1]) * kkv[2], q3 = bf_hi(c[1]) * kkv[3];
                ssq += q0 * q0 + q1 * q1 + q2 * q2 + q3 * q3;
            }
            ssq += __shfl_xor(ssq, 16); ssq += __shfl_xor(ssq, 32);
            const float kn = __builtin_amdgcn_rsqf(fmaxf(ssq, 1e-24f));
            float* rec = ops + buf * (TB * SC_REC) + st * SC_REC + fq * 4;
            float bsum = 0.f;
#pragma unroll
            for (int n2 = 0; n2 < 2; ++n2) {
                const unsigned nt = chh * 2 + n2;
                f32x4 aw = {0.f, 0.f, 0.f, 0.f}, ai = aw;
#pragma unroll
                for (int kk = 0; kk < 2; ++kk) {
                    const bf16x8 w2f = *(const bf16x8*)(wsm + wo + nt * 1024 + kk * 32), a2f = *(const bf16x8*)(wsm + ao + nt * 1024 + kk * 32);
                    aw = __builtin_amdgcn_mfma_f32_16x16x32_bf16(w2f, lwf[kk], aw, 0, 0, 0);
                    ai = __builtin_amdgcn_mfma_f32_16x16x32_bf16(a2f, laf[kk], ai, 0, 0, 0);
                }
                const f32x4 w0v = *(const f32x4*)(p.rwkv_decay_w0 + dir * 1024u + po + nt * 16), a0v = *(const f32x4*)(p.rwkv_iclr_a0 + dir * 1024u + po + nt * 16);
                const f32x4 kkv = *(const f32x4*)(p.rwkv_k_k + po + nt * 16);
                const f32x4 kav = *(const f32x4*)(p.rwkv_k_a + po + nt * 16), rkv = *(const f32x4*)(p.rwkv_r_k + po + nt * 16);
                const u32x2 a = *(const u32x2*)(R + ro + nt * 16), c = *(const u32x2*)(Kk + ro + nt * 16);
                const f32x4 rr = {bf_lo(a[0]), bf_hi(a[0]), bf_lo(a[1]), bf_hi(a[1])};
                const f32x4 kr = {bf_lo(c[0]), bf_hi(c[0]), bf_lo(c[1]), bf_hi(c[1])};
                f32x4 wv, kd, bb, aa;
#pragma unroll
                for (int j = 0; j < 4; ++j) {
                    const float sg = __builtin_amdgcn_rcpf(1.0f + __builtin_amdgcn_exp2f(-(w0v[j] + aw[j]) * LOG2E));
                    wv[j] = __builtin_amdgcn_exp2f(sg * (-0.6065306597126334f * LOG2E));
                    const float ic = __builtin_amdgcn_rcpf(1.0f + __builtin_amdgcn_exp2f(-(a0v[j] + ai[j]) * LOG2E));
                    const float kkn = kr[j] * kkv[j] * kn;
                    kd[j] = kr[j] * (1.0f + (ic - 1.0f) * kav[j]);
                    bb[j] = kkn * ic;
                    aa[j] = -kkn;
                    bsum += rr[j] * kd[j] * rkv[j];
                }
                *(f32x4*)(rec + 0 * 64 + nt * 16) = wv;
                *(f32x4*)(rec + 1 * 64 + nt * 16) = kd;
                *(f32x4*)(rec + 2 * 64 + nt * 16) = bb;
                *(f32x4*)(rec + 3 * 64 + nt * 16) = aa;
                *(f32x4*)(rec + 4 * 64 + nt * 16) = rr;
            }
            bsum += __shfl_xor(bsum, 16); bsum += __shfl_xor(bsum, 32);
            if (rg == 0 && fq == 0) bonus[((chh * 2 + dir) * TTOT + tok) * 16u + hd] = bsum;
            if (wid == 6) {
                bf16_t vr[TB * 16 / 64];
#pragma unroll
                for (int i = 0; i < TB * 16 / 64; ++i) {
                    const unsigned id = i * 64 + lane, s2 = id >> 4, rw = id & 15;
                    const unsigned tk = tokb + scan_pos(blk * TB + s2, dir);
                    vr[i] = V[tk * 1024u + hc + rg * 16 + rw];
                }
#pragma unroll
                for (int i = 0; i < TB * 16 / 64; ++i) vbuf[buf * (TB * 16) + i * 64 + lane] = bf2f(vr[i]);
            }
            asm volatile("s_waitcnt lgkmcnt(0)" ::: "memory");
            if (lane == 0) lds_publish(cnts + (wid - 4), blk + 1);
        }
    }
    __syncthreads();
}

constexpr int CH = 16, NCHK = PTOT / CH;
constexpr int NPREP = 4, NSLOT = 3;
constexpr int TKS = 72, KTS = 20, SMS = 20;
constexpr int SL_PT = 0, SL_QM = SL_PT + 64 * TKS * 2, SL_RT = SL_QM + 64 * KTS * 2, SL_G2 = SL_RT + 16 * TKS * 2, SL_VT = SL_G2 + 16 * SMS * 2, SL_WC = SL_VT + 16 * SMS * 2,
              SLOT_BYTES = SL_WC + 64 * 4;
constexpr int XTK_B = 16 * TKS * 2, XKT_B = 64 * KTS * 2, SM_B = 16 * SMS * 2;
constexpr int PR_XA = 0, PR_XB = PR_XA + XTK_B, PR_XK = PR_XB + XTK_B, PR_XR = PR_XK + XTK_B, PR_TA = PR_XR + XTK_B, PR_TB = PR_TA + XKT_B, PR_TK = PR_TB + XKT_B,
              PR_AT = PR_TK + XKT_B, PR_SM = PR_AT + XKT_B, PREP_BYTES = PR_SM + 12 * SM_B;
constexpr int SC2_SMEM = NSLOT * SLOT_BYTES + NPREP * PREP_BYTES + 64;
typedef short s16x4v __attribute__((ext_vector_type(4)));
DI f32x4 mfma16(s16x4v a, s16x4v b, f32x4 c) { return __builtin_amdgcn_mfma_f32_16x16x16bf16_1k(a, b, c, 0, 0, 0); }
DI f32x4 mfma32(bf16x8 a, bf16x8 b, f32x4 c) { return __builtin_amdgcn_mfma_f32_16x16x32_bf16(a, b, c, 0, 0, 0); }
DI s16x4v ld4(const bf16_t* q) { return *(const s16x4v*)q; }
DI f32x4 up4(u32x2 w) { return (f32x4){bf_lo(w[0]), bf_hi(w[0]), bf_lo(w[1]), bf_hi(w[1])}; }
DI f32x4 ld4f(const bf16_t* q) { return up4(*(const u32x2*)q); }
DI void st4(bf16_t* q, f32x4 v) { u32x2 w; w[0] = pk_bf16(v[0], v[1]); w[1] = pk_bf16(v[2], v[3]); *(u32x2*)q = w; }
#define LDS_WAIT() asm volatile("s_waitcnt lgkmcnt(0)" ::: "memory")
template <int CTRL> DI float dpp_shr_add(float v) { return v + __builtin_bit_cast(float, __builtin_amdgcn_update_dpp(0, __builtin_bit_cast(int, v), CTRL, 0xf, 0xf, true)); }
DI float row16_prefix(float v) { v = dpp_shr_add<0x111>(v); v = dpp_shr_add<0x112>(v); v = dpp_shr_add<0x114>(v); v = dpp_shr_add<0x118>(v); return v; }
DI f32x4 mm16(const bf16_t* A, const bf16_t* Bt, int fr, int fq) {
    const s16x4v a = ld4(A + fr * SMS + fq * 4), b = ld4(Bt + fr * SMS + fq * 4);
    LDS_WAIT();
    return mfma16(a, b, (f32x4){0.f, 0.f, 0.f, 0.f});
}
DI f32x4 mm16p(const bf16_t* A, const bf16_t* Bt, const bf16_t* Add, int fr, int fq) {
    const s16x4v a = ld4(A + fr * SMS + fq * 4), b = ld4(Bt + fr * SMS + fq * 4);
    const u32x2 c = *(const u32x2*)(Add + fr * SMS + fq * 4);
    LDS_WAIT();
    return mfma16(a, b, up4(c));
}

DI void scan_unit_chunked(const Params& p, int u, char* smem) {
    const int t = threadIdx.x, lane = t & 63, wid = __builtin_amdgcn_readfirstlane(t >> 6);
    const unsigned rg = u & 3, dir = (u >> 2) & 1, hd = (u >> 3) & 15, b = u >> 7;
    const unsigned tokb = b * PTOT, hc = hd * 64;
    const unsigned fr = lane & 15, fq = lane >> 4;
    char* slots = smem;
    char* prep0 = smem + NSLOT * SLOT_BYTES;
    int* cnts = (int*)(smem + NSLOT * SLOT_BYTES + NPREP * PREP_BYTES);
    const bf16_t* R = (const bf16_t*)(p.ws + OFF_SCR + S_R);
    const bf16_t* Kk = (const bf16_t*)(p.ws + OFF_SCR + S_KK);
    const bf16_t* V = (const bf16_t*)(p.ws + OFF_SCR + S_V);
    const bf16_t* LW = (const bf16_t*)(p.ws + OFF_SCR + S_LW);
    const bf16_t* LA = (const bf16_t*)(p.ws + OFF_SCR + S_LA);
    bf16_t* Yo = dir ? (bf16_t*)(p.ws + OFF_SCR + S_Y1) : (bf16_t*)(p.ws + OFF_H);
    float* bonus = (float*)(p.ws + OFF_BONUS2);
    if (t < 16) cnts[t] = 0;
    __syncthreads();

    if (wid == 0) {
        __builtin_amdgcn_s_setprio(3);
        f32x4 st[4];
#pragma unroll
        for (int m = 0; m < 4; ++m) st[m] = (f32x4){0.f, 0.f, 0.f, 0.f};
        for (int c = 0; c < NCHK; ++c) {
            const unsigned sl = (unsigned)c % NSLOT;
            const char* S = slots + sl * SLOT_BYTES;
            while (*(volatile LAS int*)(cnts + sl) < c + 1) __builtin_amdgcn_s_sleep(1);
            LDS_WAIT();
            const s16x4v vt = ld4((const bf16_t*)(S + SL_VT) + fr * SMS + fq * 4);
            const s16x4v g2 = ld4((const bf16_t*)(S + SL_G2) + fr * SMS + fq * 4);
            s16x4v rtl[2], rth[2], ptl[4][2], pth[4][2], qm[4];
            f32x4 wc[4];
#pragma unroll
            for (int i = 0; i < 2; ++i) { const bf16_t* q = (const bf16_t*)(S + SL_RT) + fr * TKS + 32 * i + fq * 4; rtl[i] = ld4(q); rth[i] = ld4(q + 16); }
#pragma unroll
            for (int m = 0; m < 4; ++m) {
                wc[m] = *(const f32x4*)((const float*)(S + SL_WC) + 16 * m + fq * 4);
                qm[m] = ld4((const bf16_t*)(S + SL_QM) + (16 * m + fr) * KTS + fq * 4);
#pragma unroll
                for (int i = 0; i < 2; ++i) { const bf16_t* q = (const bf16_t*)(S + SL_PT) + (16 * m + fr) * TKS + 32 * i + fq * 4; ptl[m][i] = ld4(q); pth[m][i] = ld4(q + 16); }
            }
            LDS_WAIT();
            if (lane == 0) *(volatile LAS int*)(cnts + 8) = c + 1;
            bf16x8 sb[2];
#pragma unroll
            for (int i = 0; i < 2; ++i) {
                u32x4 w; w[0] = pk_bf16(st[2 * i][0], st[2 * i][1]); w[1] = pk_bf16(st[2 * i][2], st[2 * i][3]); w[2] = pk_bf16(st[2 * i + 1][0], st[2 * i + 1][1]); w[3] = pk_bf16(st[2 * i + 1][2], st[2 * i + 1][3]);
                sb[i] = __builtin_bit_cast(bf16x8, w);
            }
            f32x4 y = {0.f, 0.f, 0.f, 0.f};
#pragma unroll
            for (int i = 0; i < 2; ++i) y = mfma32(__builtin_shufflevector(rtl[i], rth[i], 0, 1, 2, 3, 4, 5, 6, 7), sb[i], y);
            y = mfma16(g2, vt, y);
#pragma unroll
            for (int m = 0; m < 4; ++m) {
                f32x4 acc = st[m] * wc[m];
#pragma unroll
                for (int i = 0; i < 2; ++i) acc = mfma32(__builtin_shufflevector(ptl[m][i], pth[m][i], 0, 1, 2, 3, 4, 5, 6, 7), sb[i], acc);
                st[m] = mfma16(qm[m], vt, acc);
            }

#pragma unroll
            for (int j = 0; j < 4; ++j) {
                const unsigned tok = tokb + scan_pos(c * CH + fq * 4 + j, dir);
                Yo[tok * 1024u + hc + rg * 16 + fr] = (bf16_t)(pk_bf16(y[j], 0.f) & 0xffffu);
            }
        }
        __builtin_amdgcn_s_setprio(0);
    } else if (wid == 4 || wid > 5) {
    } else {
        const unsigned pid = wid < 4 ? wid - 1 : 3;
        unsigned pso = pid * PREP_BYTES; asm volatile("" : "+v"(pso));
        char* PS = prep0 + pso;
        bf16_t* XA = (bf16_t*)(PS + PR_XA); bf16_t* XB = (bf16_t*)(PS + PR_XB); bf16_t* XK = (bf16_t*)(PS + PR_XK); bf16_t* XR = (bf16_t*)(PS + PR_XR);
        bf16_t* TA = (bf16_t*)(PS + PR_TA); bf16_t* TB_ = (bf16_t*)(PS + PR_TB); bf16_t* TK = (bf16_t*)(PS + PR_TK); bf16_t* AT = (bf16_t*)(PS + PR_AT);
        bf16_t* SMb = (bf16_t*)(PS + PR_SM);
        bf16_t *M = SMb, *NABR = SMb + 1 * 16 * SMS, *M2 = SMb + 2 * 16 * SMS, *M2T = SMb + 3 * 16 * SMS, *M4 = SMb + 4 * 16 * SMS, *M4T = SMb + 5 * 16 * SMS, *IM = SMb + 6 * 16 * SMS,
                *X1 = SMb + 7 * 16 * SMS, *NAKR = SMb + 8 * 16 * SMS, *NRBT = SMb + 9 * 16 * SMS, *NRKT = SMb + 10 * 16 * SMS, *G1 = SMb + 11 * 16 * SMS;
        bf16_t *M8T = M2, *X2 = M2T, *TT = M4;
        const bf16_t* wsm = (const bf16_t*)(p.ws + OFF_WS);
        const unsigned wo = W_W2 + dir * 65536u + (hc + fr) * 64u + fq * 8u;
        const unsigned ao = W_A2 + dir * 65536u + (hc + fr) * 64u + fq * 8u;
        const unsigned po = hc + fq * 4u;
        const f32x4 z4 = {0.f, 0.f, 0.f, 0.f};
        for (int c = pid; c < NCHK; c += NPREP) {
            const unsigned tok = tokb + scan_pos(c * CH + fr, dir);
            const unsigned lo = tok * 128u + dir * 64u + fq * 8u;
            const unsigned ro = tok * 1024u + hc + fq * 4u;
            bf16x8 lwf[2], laf[2];
#pragma unroll
            for (int kk = 0; kk < 2; ++kk) { lwf[kk] = *(const bf16x8*)(LW + lo + kk * 32); laf[kk] = *(const bf16x8*)(LA + lo + kk * 32); }
            float ssq = 0.f;
            f32x4 kr[4];
#pragma unroll
            for (int nt = 0; nt < 4; ++nt) {
                const f32x4 kkv = *(const f32x4*)(p.rwkv_k_k + po + nt * 16);
                kr[nt] = ld4f(Kk + ro + nt * 16);
                const f32x4 q = kr[nt] * kkv;
                ssq += q[0] * q[0] + q[1] * q[1] + q[2] * q[2] + q[3] * q[3];
            }
            ssq += __shfl_xor(ssq, 16); ssq += __shfl_xor(ssq, 32);
            const float kn = __builtin_amdgcn_rsqf(fmaxf(ssq, 1e-24f));
            float bsum = 0.f;
#pragma unroll
            for (int nt = 0; nt < 4; ++nt) {
                f32x4 aw = z4, ai = z4;
#pragma unroll
                for (int kk = 0; kk < 2; ++kk) {
                    const bf16x8 w2f = *(const bf16x8*)(wsm + wo + nt * 1024 + kk * 32), a2f = *(const bf16x8*)(wsm + ao + nt * 1024 + kk * 32);
                    aw = mfma32(w2f, lwf[kk], aw);
                    ai = mfma32(a2f, laf[kk], ai);
                }
                const f32x4 w0v = *(const f32x4*)(p.rwkv_decay_w0 + dir * 1024u + po + nt * 16), a0v = *(const f32x4*)(p.rwkv_iclr_a0 + dir * 1024u + po + nt * 16);
                const f32x4 kkv = *(const f32x4*)(p.rwkv_k_k + po + nt * 16);
                const f32x4 kav = *(const f32x4*)(p.rwkv_k_a + po + nt * 16), rkv = *(const f32x4*)(p.rwkv_r_k + po + nt * 16);
                const f32x4 rr = ld4f(R + ro + nt * 16);
                f32x4 at, rt, bt, kt;
#pragma unroll
                for (int j = 0; j < 4; ++j) {
                    const float e = 0.6065306597126334f * __builtin_amdgcn_rcpf(1.0f + __builtin_amdgcn_exp2f(-(w0v[j] + aw[j]) * LOG2E));
                    const float ic = __builtin_amdgcn_rcpf(1.0f + __builtin_amdgcn_exp2f(-(a0v[j] + ai[j]) * LOG2E));
                    const float kkn = kr[nt][j] * kkv[j] * kn;
                    const float kd = kr[nt][j] * (1.0f + (ic - 1.0f) * kav[j]);
                    bsum += rr[j] * kd * rkv[j];
                    const float ec = row16_prefix(e);
                    const float wt = __builtin_amdgcn_exp2f(-ec * LOG2E);
                    const float wi = __builtin_amdgcn_exp2f(ec * LOG2E);
                    const float wp = __builtin_amdgcn_exp2f((e - ec) * LOG2E);
                    at[j] = -kkn * wp; rt[j] = rr[j] * wt; bt[j] = kkn * ic * wi; kt[j] = kd * wi;
                    TA[(nt * 16 + fq * 4 + j) * KTS + fr] = (bf16_t)(pk_bf16(at[j], 0.f) & 0xffffu);
                    TB_[(nt * 16 + fq * 4 + j) * KTS + fr] = (bf16_t)(pk_bf16(bt[j], 0.f) & 0xffffu);
                    TK[(nt * 16 + fq * 4 + j) * KTS + fr] = (bf16_t)(pk_bf16(kt[j], 0.f) & 0xffffu);
                    if (fr == 15) ((float*)AT)[nt * 16 + fq * 4 + j] = wt;
                }
                st4(XA + fr * TKS + nt * 16 + fq * 4, at); st4(XR + fr * TKS + nt * 16 + fq * 4, rt);
                st4(XB + fr * TKS + nt * 16 + fq * 4, bt); st4(XK + fr * TKS + nt * 16 + fq * 4, kt);
            }
            bsum += __shfl_xor(bsum, 16); bsum += __shfl_xor(bsum, 32);
            if (rg == 0 && fq == 0) { bonus[((0 * 2 + dir) * TTOT + tok) * 16u + hd] = bsum; bonus[((1 * 2 + dir) * TTOT + tok) * 16u + hd] = 0.f; }
            LDS_WAIT();
            float wcr[4];
#pragma unroll
            for (int n = 0; n < 4; ++n) wcr[n] = ((const float*)AT)[16 * n + fr];
            LDS_WAIT();
            LDS_WAIT();
            bf16x8 fa[2], fb[2], fk[2], frr[2];
#pragma unroll
            for (int kk = 0; kk < 2; ++kk) {
                fa[kk] = *(const bf16x8*)(XA + fr * TKS + kk * 32 + fq * 8); fb[kk] = *(const bf16x8*)(XB + fr * TKS + kk * 32 + fq * 8);
                fk[kk] = *(const bf16x8*)(XK + fr * TKS + kk * 32 + fq * 8); frr[kk] = *(const bf16x8*)(XR + fr * TKS + kk * 32 + fq * 8);
            }
            LDS_WAIT();
            f32x4 d1 = z4, d2 = z4, d3 = z4, d4 = z4, d5 = z4;
#pragma unroll
            for (int kk = 0; kk < 2; ++kk) {
                d1 = mfma32(fb[kk], fa[kk], d1);
                d2 = mfma32(fa[kk], fb[kk], d2);
                d3 = mfma32(fa[kk], fk[kk], d3);
                d4 = mfma32(fb[kk], frr[kk], d4);
                d5 = mfma32(fk[kk], frr[kk], d5);
            }
            f32x4 im;
#pragma unroll
            for (int j = 0; j < 4; ++j) {
                const unsigned ij = fq * 4 + j;
                d1[j] = ij < fr ? d1[j] : 0.f;
                d2[j] = fr < ij ? d2[j] : 0.f;
                d3[j] = fr < ij ? d3[j] : 0.f;
                d4[j] = ij <= fr ? d4[j] : 0.f;
                d5[j] = ij <= fr ? d5[j] : 0.f;
                im[j] = d1[j] + (ij == fr ? 1.0f : 0.f);
            }
            st4(M + fr * SMS + fq * 4, d1);
            st4(IM + fr * SMS + fq * 4, im);
            st4(NABR + fr * SMS + fq * 4, d2);
            st4(NAKR + fr * SMS + fq * 4, d3);
            st4(NRBT + fr * SMS + fq * 4, d4);
            st4(NRKT + fr * SMS + fq * 4, d5);
            LDS_WAIT();
            st4(M2T + fr * SMS + fq * 4, mm16(M, NABR, fr, fq));
            LDS_WAIT();
            st4(M2 + fr * SMS + fq * 4, mm16(NABR, M, fr, fq));
            LDS_WAIT();
            st4(M4T + fr * SMS + fq * 4, mm16(M2, M2T, fr, fq));
            LDS_WAIT();
            st4(M4 + fr * SMS + fq * 4, mm16(M2T, M2, fr, fq));
            LDS_WAIT();
            st4(X1 + fr * SMS + fq * 4, mm16p(M2T, IM, IM, fr, fq));
            LDS_WAIT();
            st4(M8T + fr * SMS + fq * 4, mm16(M4, M4T, fr, fq));
            LDS_WAIT();
            st4(X2 + fr * SMS + fq * 4, mm16p(M4T, X1, X1, fr, fq));
            LDS_WAIT();
            st4(TT + fr * SMS + fq * 4, mm16p(M8T, X2, X2, fr, fq));
            LDS_WAIT();
            {
                const s16x4v ta = ld4(TT + fr * SMS + fq * 4), nk = ld4(NAKR + fr * SMS + fq * 4);
                s16x4v xa[4];
#pragma unroll
                for (int n = 0; n < 4; ++n) xa[n] = ld4(TA + (16 * n + fr) * KTS + fq * 4);
                LDS_WAIT();
                st4(G1 + fr * SMS + fq * 4, mfma16(ta, nk, z4));
#pragma unroll
                for (int n = 0; n < 4; ++n) st4(AT + (16 * n + fr) * KTS + fq * 4, mfma16(ta, xa[n], z4));
            }
            LDS_WAIT();
            const unsigned sl = (unsigned)c % NSLOT;
            char* S = slots + sl * SLOT_BYTES;
            while (*(volatile LAS int*)(cnts + 8) < c - NSLOT + 1) __builtin_amdgcn_s_sleep(1);
            LDS_WAIT();
            {
                unsigned vv[2][2];
#pragma unroll
                for (int i = 0; i < 2; ++i) {
                    const unsigned q = i * 64 + lane, vrow = q & 15, sp = q >> 4;
                    const unsigned tk0 = tokb + scan_pos(c * CH + 2 * sp, dir), tk1 = tokb + scan_pos(c * CH + 2 * sp + 1, dir);
                    vv[i][0] = V[tk0 * 1024u + hc + rg * 16 + vrow]; vv[i][1] = V[tk1 * 1024u + hc + rg * 16 + vrow];
                }
                const s16x4v nrb = ld4(NRBT + fr * SMS + fq * 4), g1 = ld4(G1 + fr * SMS + fq * 4);
                const u32x2 nrk = *(const u32x2*)(NRKT + fr * SMS + fq * 4);
                s16x4v atm[4], tb[4]; u32x2 xr[4], tk[4];
#pragma unroll
                for (int m = 0; m < 4; ++m) {
                    atm[m] = ld4(AT + (16 * m + fr) * KTS + fq * 4); tb[m] = ld4(TB_ + (16 * m + fr) * KTS + fq * 4);
                    xr[m] = *(const u32x2*)(XR + fr * TKS + 16 * m + fq * 4); tk[m] = *(const u32x2*)(TK + (16 * m + fr) * KTS + fq * 4);
                }
                LDS_WAIT();
                st4((bf16_t*)(S + SL_G2) + fr * SMS + fq * 4, mfma16(g1, nrb, up4(nrk)));
#pragma unroll
                for (int m = 0; m < 4; ++m) {
                    st4((bf16_t*)(S + SL_RT) + fr * TKS + 16 * m + fq * 4, mfma16(atm[m], nrb, up4(xr[m])));
#pragma unroll
                    for (int n = 0; n < 4; ++n) st4((bf16_t*)(S + SL_PT) + (16 * n + fr) * TKS + 16 * m + fq * 4, mfma16(atm[m], tb[n], z4) * wcr[n]);
                }
#pragma unroll
                for (int n = 0; n < 4; ++n) st4((bf16_t*)(S + SL_QM) + (16 * n + fr) * KTS + fq * 4, mfma16(g1, tb[n], up4(tk[n])) * wcr[n]);
                ((float*)(S + SL_WC))[lane] = (fq == 0) ? wcr[0] : (fq == 1) ? wcr[1] : (fq == 2) ? wcr[2] : wcr[3];
#pragma unroll
                for (int i = 0; i < 2; ++i) {
                    const unsigned q = i * 64 + lane, vrow = q & 15, sp = q >> 4;
                    *(unsigned*)((bf16_t*)(S + SL_VT) + vrow * SMS + 2 * sp) = vv[i][0] | (vv[i][1] << 16);
                }
            }
            LDS_WAIT();
            if (lane == 0) *(volatile LAS int*)(cnts + sl) = c + 1;
        }
    }
    __syncthreads();
}

DI void phase_scan(const Params& p, char* smem) {
    for (int u = blockIdx.x; u < NBATCH * 16 * 2 * 4; u += gridDim.x) scan_unit_chunked(p, u, smem);
}

constexpr int NPHASE = 18;
constexpr int SMEM_BYTES = (SC2_SMEM > SC_SMEM ? SC2_SMEM : SC_SMEM) + 64;
static_assert(SMEM_BYTES >= GEMM_SMEM + 64 && SMEM_BYTES + 16 <= 163840, "LDS");
template <int PH> DI void run_phase(const Params& p, char* smem) {
    if constexpr (PH == 0) phase_prologue(p, smem);
    else if constexpr (PH == 1) phase_norm0(p);
    else if constexpr (PH == 2) phase_qkv(p, smem);
    else if constexpr (PH == 3) phase_attn(p, smem);
    else if constexpr (PH == 4) phase_wout(p, smem);
    else if constexpr (PH == 5) phase_ffn_norm_route(p, 0, smem);
    else if constexpr (PH == 6) phase_moe1(p, 0, smem);
    else if constexpr (PH == 7) phase_moe2(p, 0, smem);
    else if constexpr (PH == 8) phase_combine_l0(p, smem);
    else if constexpr (PH == 9) phase_xx(p);
    else if constexpr (PH == 10) phase_rwkv_proj(p, smem);
    else if constexpr (PH == 11) phase_scan(p, smem);
    else if constexpr (PH == 12) phase_gate(p, smem);
    else if constexpr (PH == 13) phase_wo(p, smem);
    else if constexpr (PH == 14) phase_ffn_norm_route(p, 1, smem);
    else if constexpr (PH == 15) phase_moe1(p, 1, smem);
    else if constexpr (PH == 16) phase_moe2(p, 1, smem);
    else if constexpr (PH == 17) phase_final(p);
}
template <int PH, int END> struct PhaseSeq {
    static DI void run(const Params& p, char* smem, const XcdBarrier& bar) {
        run_phase<PH>(p, smem);
        if constexpr (PH + 1 < END) { xcd_barrier(bar); PhaseSeq<PH + 1, END>::run(p, smem, bar); }
    }
};
template <int BEG, int END>
__global__ void __launch_bounds__(NTH, 2) fwd_kernel(Params p) {
    extern __shared__ __attribute__((aligned(16))) char smem_raw[];
    char* smem = smem_raw + 16;
    if constexpr (END - BEG > 1) {
        if (threadIdx.x == 0) *(uint4*)smem_raw = make_uint4(0u, 0u, 0u, 0u);
        __syncthreads();
        XcdBarrier bar = xcd_barrier_post((unsigned*)(p.ws + OFF_BAR), (volatile LAS unsigned*)smem_raw);
        PhaseSeq<BEG, END>::run(p, smem, bar);
    } else {
        run_phase<BEG>(p, smem);
    }
}

template <int BEG, int END> static void launch_range(const Params& p, int grid, hipStream_t stream) {
    (void)hipFuncSetAttribute((const void*)fwd_kernel<BEG, END>, hipFuncAttributeMaxDynamicSharedMemorySize, SMEM_BYTES + 16);
    hipLaunchKernelGGL((fwd_kernel<BEG, END>), dim3(grid), dim3(NTH), SMEM_BYTES + 16, stream, p);
}
#ifndef RUN_PHASES
#define RUN_PHASES NPHASE
#endif
#ifndef REPEAT_PHASE
#define REPEAT_PHASE -1
#endif
template <int PH> static void launch_each(const Params& p, int grid, hipStream_t stream) {
    launch_range<PH, PH + 1>(p, grid, stream);
    if (PH == REPEAT_PHASE) launch_range<PH, PH + 1>(p, grid, stream);
    if constexpr (PH + 1 < RUN_PHASES) launch_each<PH + 1>(p, grid, stream);
}

extern "C" void kernel_launch(void* const* d_in, const int* in_sizes, int n_in, void* d_out, int out_size, void* d_ws, size_t ws_size, hipStream_t stream) {
    Params p{};
    const float** f = (const float**)&p;
    for (int i = 0; i < 37; ++i) f[i] = (const float*)d_in[i];
    p.out = (float*)d_out;
    p.ws = (char*)d_ws;
    if (ws_size < WS_NEED || n_in < 37) return;
    static int grid = 0;
    if (!grid) {
        int dev = 0, cus = 0;
        (void)hipGetDevice(&dev);
        (void)hipDeviceGetAttribute(&cus, hipDeviceAttributeMultiprocessorCount, dev);
        grid = cus > 0 ? cus : 256;
    }
    (void)hipMemsetAsync(d_ws, 0, 32768, stream);
#if MEGA
    launch_range<0, NPHASE>(p, grid, stream);
#else
    launch_each<0>(p, grid, stream);
#endif
}
```

```cpp
#include <hip/hip_runtime.h>
#include <stdint.h>
#include <stdio.h>

#ifndef MEGA
#define MEGA 1
#endif

typedef unsigned short bf16_t;
typedef short bf16x8 __attribute__((ext_vector_type(8)));
typedef short s16x4 __attribute__((ext_vector_type(4)));
typedef float f32x2 __attribute__((ext_vector_type(2)));
typedef float f32x4 __attribute__((ext_vector_type(4)));
typedef float f32x16 __attribute__((ext_vector_type(16)));
typedef unsigned u32x2 __attribute__((ext_vector_type(2)));
typedef unsigned u32x4 __attribute__((ext_vector_type(4)));
typedef __bf16 bf16x2_t __attribute__((ext_vector_type(2)));
#define DI __device__ __forceinline__

constexpr int DM = 1024, NBATCH = 2, SEQ = 16384, LCTX = 256, PTOT = SEQ + LCTX, TTOT = NBATCH * PTOT;
constexpr int NTH = 512, NWAVE = 8;
constexpr int QKV_N = 1536;
constexpr int NEXP = 16, CAP = TTOT * 2;
constexpr float RMS_EPS = 1e-6f, GN_EPS = 64e-5f;
constexpr float LOG2E = 1.4426950408889634f;

constexpr size_t MBy = 1u << 20;
constexpr size_t OFF_BAR   = 0;
constexpr size_t OFF_CNT   = 16384;
constexpr size_t OFF_MOD   = 32768;
constexpr size_t OFF_ROPE  = OFF_MOD + 2 * 3 * 6144 * 4;
constexpr size_t OFF_BONUS = 1 * MBy;
constexpr size_t OFF_BONUS2 = 6 * MBy;
constexpr size_t OFF_STOK  = 6 * MBy;
constexpr size_t OFF_SW    = 11 * MBy;
constexpr size_t OFF_XC    = 16 * MBy;
constexpr size_t OFF_WS    = 18 * MBy;
constexpr size_t OFF_MOEW  = 33 * MBy;
constexpr size_t OFF_H     = 129 * MBy;
constexpr size_t OFF_SCR   = 194 * MBy;
constexpr size_t SCR_SIZE  = 290 * MBy;
constexpr size_t WS_NEED   = OFF_SCR + SCR_SIZE;
constexpr size_t W_IN = 0, W_OUT = W_IN + 1536 * 1024, W_R = W_OUT + 1024 * 1024, W_K = W_R + 1024 * 1024, W_V = W_K + 1024 * 1024,
                 W_O = W_V + 1024 * 1024, W_W1 = W_O + 1024 * 1024, W_A1 = W_W1 + 128 * 1024, W_G1 = W_A1 + 128 * 1024,
                 W_W2 = W_G1 + 256 * 1024, W_A2 = W_W2 + 2 * 1024 * 64, W_G2 = W_A2 + 2 * 1024 * 64, W_END = W_G2 + 1024 * 192;
static_assert(W_END * 2 <= 15 * MBy, "small weights region");
constexpr size_t ROWB = (size_t)TTOT * 2048;
constexpr size_t S_Q = 0, S_K = S_Q + ROWB, S_VT = S_K + ROWB / 4, S_O = S_VT + ROWB / 4;
constexpr size_t S_HID = 0, S_Y = 140 * MBy;
constexpr size_t S_R = 0, S_KK = S_R + ROWB, S_V = S_KK + ROWB, S_LW = S_V + ROWB, S_LA = S_LW + ROWB / 8, S_LG = S_LA + ROWB / 8,
                 S_Y1 = 224 * MBy, S_XX = S_Y1, S_OR = S_R;
static_assert(S_O + ROWB <= SCR_SIZE, "scr");
static_assert(S_LG + (size_t)TTOT * 384 <= S_Y1, "scr2");
static_assert(S_Y1 + ROWB <= SCR_SIZE, "scr3");
static_assert(S_Y + 2 * ROWB <= SCR_SIZE, "scr4");
static_assert((size_t)(CAP / 256 + 16) * 256 * 2048 <= S_Y, "hid");
static_assert(OFF_H + ROWB <= OFF_SCR, "h");

struct Params {
    const float *x, *c, *ctx, *c_ctx, *ada_w, *ada_b, *norm_mix_g, *norm_ffn_g, *attn_w_in, *attn_w_out, *attn_sink, *attn_q_norm_g, *attn_k_norm_g,
        *rwkv_x_mix, *rwkv_w_r, *rwkv_w_k, *rwkv_w_v, *rwkv_w_o, *rwkv_decay_w0, *rwkv_decay_w1, *rwkv_decay_w2, *rwkv_iclr_a0, *rwkv_iclr_a1,
        *rwkv_iclr_a2, *rwkv_gate_g1, *rwkv_gate_g2, *rwkv_k_k, *rwkv_k_a, *rwkv_r_k, *rwkv_ln_g, *rwkv_ln_b, *router_w, *router_bias, *moe_w1,
        *moe_w3, *moe_w2, *final_norm_g;
    float* out;
    char* ws;
};

DI unsigned pk_bf16(float a, float b) { f32x2 v = {a, b}; bf16x2_t r = __builtin_convertvector(v, bf16x2_t); return __builtin_bit_cast(unsigned, r); }
DI float bf_lo(unsigned u) { return __uint_as_float(u << 16); }
DI float bf_hi(unsigned u) { return __uint_as_float(u & 0xffff0000u); }
DI float bf2f(bf16_t u) { return __uint_as_float(((unsigned)u) << 16); }
DI float wave_sum(float v) {
#pragma unroll
    for (int o = 32; o >= 1; o >>= 1) v += __shfl_xor(v, o);
    return v;
}
DI float sigmoidf_(float x) { return 1.0f / (1.0f + __expf(-x)); }
DI float siluf_(float x) { return x / (1.0f + __expf(-x)); }
DI float* xrow_ptr(const Params& p, int tok) {
    const int b = tok >= PTOT ? 1 : 0, pos = tok - b * PTOT;
    return pos < LCTX ? (float*)(p.ws + OFF_XC) + (size_t)(b * LCTX + pos) * DM : p.out + (size_t)(b * SEQ + pos - LCTX) * DM;
}
DI const float* xin_ptr(const Params& p, int tok) {
    const int b = tok >= PTOT ? 1 : 0, pos = tok - b * PTOT;
    return pos < LCTX ? p.ctx + (size_t)(b * LCTX + pos) * DM : p.x + (size_t)(b * SEQ + pos - LCTX) * DM;
}
DI const float* mod_ptr(const Params& p, int layer, int tok, int which) {
    const int b = tok >= PTOT ? 1 : 0, pos = tok - b * PTOT;
    const int w = pos < LCTX ? 2 : b;
    return (const float*)(p.ws + OFF_MOD) + (size_t)((layer * 3 + w) * 6 + which) * DM;
}

#define XB_TMO      128
#define XB_XCNT(j)  (256  + 64 * (j))
#define XB_XSUB(j)  (1280 + 64 * (j))
#define XB_XGEN(j)  (2304 + 64 * (j))
#define XB_TOP      3328
#define XB_TOPGEN   3392
#define XCD_BAR_WORDS 3456
#define XB_SPIN_CAP (1u << 18)
#define LAS __attribute__((address_space(3)))
DI unsigned xb_ld(unsigned* p)              { return __hip_atomic_load(p, __ATOMIC_RELAXED, __HIP_MEMORY_SCOPE_AGENT); }
DI unsigned xb_add(unsigned* p, unsigned v) { return __hip_atomic_fetch_add(p, v, __ATOMIC_RELAXED, __HIP_MEMORY_SCOPE_AGENT); }
DI unsigned xb_xcc_id() { return (unsigned)__builtin_amdgcn_s_getreg((3 << 11) | 20) & 0xFu; }
#define XB_SPIN(cond, bar) do { unsigned _sp = 0; while (cond) { __builtin_amdgcn_s_sleep(1); \
    if ((++_sp & 255u) == 0u) { if (xb_ld(&(bar)[XB_TMO])) break; if (_sp > XB_SPIN_CAP) { atomicAdd(&(bar)[XB_TMO], 1u); break; } } } } while (0)
struct XcdBarrier { unsigned* bar; unsigned x; volatile LAS unsigned* st; };
DI XcdBarrier xcd_barrier_post(unsigned* bar, volatile LAS unsigned* st) {
    XcdBarrier b; b.bar = bar; b.x = xb_xcc_id(); b.st = st;
    if (threadIdx.x == 0) (void)xb_add(&bar[XB_XCNT(b.x)], 1u);
    return b;
}
DI void xcd_barrier_complete(unsigned* bar, unsigned x, unsigned& nloc, unsigned& nx) {
    const unsigned G = gridDim.x * gridDim.y * gridDim.z;
    unsigned sum, cnt, mine, sp = 0u;
    for (;;) {
        sum = 0u; cnt = 0u; mine = 0u;
#pragma unroll
        for (unsigned j = 0; j < 16; ++j) { const unsigned c = xb_ld(&bar[XB_XCNT(j)]); sum += c; cnt += (c > 0u) ? 1u : 0u; mine = (j == x) ? c : mine; }
        if (sum == G) break;
        __builtin_amdgcn_s_sleep(1);
        if ((++sp & 255u) == 0u) { if (xb_ld(&bar[XB_TMO])) break; if (sp > XB_SPIN_CAP) { atomicAdd(&bar[XB_TMO], 1u); break; } }
    }
    nloc = mine > 0u ? mine : 1u; nx = cnt > 0u ? cnt : 1u;
}
DI void xcd_barrier(const XcdBarrier& b) {
    asm volatile("s_waitcnt vmcnt(0)" ::: "memory");
    __syncthreads();
    if (threadIdx.x == 0) {
        unsigned* bar = b.bar;
        __builtin_amdgcn_s_waitcnt(0);
        unsigned nloc = b.st[0], nx = b.st[1];
        if (nloc == 0u) { xcd_barrier_complete(bar, b.x, nloc, nx); b.st[0] = nloc; b.st[1] = nx; }
        const unsigned old = xb_add(&bar[XB_XSUB(b.x)], 1u);
        const unsigned gen = old / nloc;
        if (old + 1u == (gen + 1u) * nloc) {
            __builtin_amdgcn_fence(__ATOMIC_RELEASE, "agent");
            asm volatile("s_waitcnt vmcnt(0)" ::: "memory");
            const unsigned og = xb_add(&bar[XB_TOP], 1u);
            const unsigned tg = og / nx;
            if (og + 1u == (tg + 1u) * nx) xb_add(&bar[XB_TOPGEN], 1u);
            else XB_SPIN(xb_ld(&bar[XB_TOPGEN]) == tg, bar);
            __builtin_amdgcn_fence(__ATOMIC_ACQUIRE, "agent");
            xb_add(&bar[XB_XGEN(b.x)], 1u);
            asm volatile("s_waitcnt vmcnt(0)" ::: "memory");
        } else {
            XB_SPIN(xb_ld(&bar[XB_XGEN(b.x)]) == gen, bar);
            __builtin_amdgcn_fence(__ATOMIC_ACQUIRE, "agent");
            asm volatile("s_waitcnt vmcnt(0)" ::: "memory");
        }
    }
    __syncthreads();
}

DI void cvt_tile(const float* src, int ld, int kvalid, bool colvalid, bf16_t* dst, int dld, float* tile  ) {
    const int t = threadIdx.x;
    {
        const int k = t >> 3, c4 = (t & 7) * 4;
        f32x4 v = {0.f, 0.f, 0.f, 0.f};
        if (colvalid && k < kvalid) v = *(const f32x4*)(src + (size_t)k * ld + c4);
        tile[k * 33 + c4 + 0] = v[0]; tile[k * 33 + c4 + 1] = v[1]; tile[k * 33 + c4 + 2] = v[2]; tile[k * 33 + c4 + 3] = v[3];
    }
    __syncthreads();
    {
        const int n = t >> 4, kc = (t & 15) * 4;
        u32x2 w;
        w[0] = pk_bf16(tile[(kc + 0) * 33 + n], tile[(kc + 1) * 33 + n]);
        w[1] = pk_bf16(tile[(kc + 2) * 33 + n], tile[(kc + 3) * 33 + n]);
        *(u32x2*)(dst + (size_t)n * dld + kc) = w;
    }
    __syncthreads();
}
constexpr int CV_SMALL_UNITS = 768 + 512 * 5 + 64 + 64 + 128 + 64 + 64 + 96;
DI void cvt_small_unit(const Params& p, int u, float* tile) {
    bf16_t* wsm = (bf16_t*)(p.ws + OFF_WS);
    if (u < 768) { const int run = u >> 4, kt = u & 15; cvt_tile(p.attn_w_in + (size_t)kt * 64 * 1536 + run * 32, 1536, 64, true, wsm + W_IN + (size_t)run * 32 * 1024 + kt * 64, 1024, tile); return; }
    u -= 768;
    if (u < 512 * 5) {
        const int j = u >> 9, v = u & 511, run = v >> 4, kt = v & 15;
        const float* src = j == 0 ? p.attn_w_out : j == 1 ? p.rwkv_w_r : j == 2 ? p.rwkv_w_k : j == 3 ? p.rwkv_w_v : p.rwkv_w_o;
        const size_t dofs = j == 0 ? W_OUT : j == 1 ? W_R : j == 2 ? W_K : j == 3 ? W_V : W_O;
        cvt_tile(src + (size_t)kt * 64 * 1024 + run * 32, 1024, 64, true, wsm + dofs + (size_t)run * 32 * 1024 + kt * 64, 1024, tile); return;
    }
    u -= 512 * 5;
    if (u < 128) {
        const int j = u >> 6, v = u & 63, run = v >> 4, kt = v & 15, d = run >> 1, co = (run & 1) * 32;
        const float* src = (j == 0 ? p.rwkv_decay_w1 : p.rwkv_iclr_a1) + (size_t)d * 1024 * 64;
        cvt_tile(src + (size_t)kt * 64 * 64 + co, 64, 64, true, wsm + (j == 0 ? W_W1 : W_A1) + (size_t)run * 32 * 1024 + kt * 64, 1024, tile); return;
    }
    u -= 128;
    if (u < 128) {
        const int run = u >> 4, kt = u & 15;
        cvt_tile(p.rwkv_gate_g1 + (size_t)kt * 64 * 160 + run * 32, 160, 64, run < 5, wsm + W_G1 + (size_t)run * 32 * 1024 + kt * 64, 1024, tile); return;
    }
    u -= 128;
    if (u < 128) {
        const int j = u >> 6, v = u & 63, d = v >> 5, run = v & 31;
        const float* src = (j == 0 ? p.rwkv_decay_w2 : p.rwkv_iclr_a2) + (size_t)d * 64 * 1024;
        cvt_tile(src + run * 32, 1024, 64, true, wsm + (j == 0 ? W_W2 : W_A2) + (size_t)d * 1024 * 64 + (size_t)run * 32 * 64, 64, tile); return;
    }
    u -= 128;
    {
        const int run = u / 3, kt = u % 3;
        const int kvalid = 160 - kt * 64 > 64 ? 64 : (160 - kt * 64 < 0 ? 0 : 160 - kt * 64);
        cvt_tile(p.rwkv_gate_g2 + (size_t)kt * 64 * 1024 + run * 32, 1024, kvalid, true, wsm + W_G2 + (size_t)run * 32 * 192 + kt * 64, 192, tile);
    }
}
constexpr int CV_MOE_UNITS = 16 * (1024 + 512);
DI void cvt_moe_unit(const Params& p, int layer, int u, float* tile) {
    bf16_t* w13 = (bf16_t*)(p.ws + OFF_MOEW);
    bf16_t* w2t = w13 + (size_t)16 * 2048 * 1024;
    const int e = u / 1536, v = u % 1536;
    const size_t eo = (size_t)(layer * 16 + e) * 1024 * 1024;
    if (v < 1024) {
        const int run = v >> 4, kt = v & 15, g = run >> 1;
        const float* src = ((run & 1) ? p.moe_w3 : p.moe_w1) + eo;
        cvt_tile(src + (size_t)kt * 64 * 1024 + g * 32, 1024, 64, true, w13 + (size_t)e * 2048 * 1024 + (size_t)run * 32 * 1024 + kt * 64, 1024, tile);
    } else {
        const int w = v - 1024, run = w >> 4, kt = w & 15;
        cvt_tile(p.moe_w2 + eo + (size_t)kt * 64 * 1024 + run * 32, 1024, 64, true, w2t + (size_t)e * 1024 * 1024 + (size_t)run * 32 * 1024 + kt * 64, 1024, tile);
    }
}
DI void adaln_unit(const Params& p, int u, float* sm) {
    const int l = u / 96, n0 = (u % 96) * 64, t = threadIdx.x;
    float* sv = sm;
    float* red = sm + 3 * 1024;
    for (int i = t; i < 3 * 1024; i += NTH) { const int w = i >> 10, k = i & 1023; const float c = w < 2 ? p.c[w * 1024 + k] : p.c_ctx[k]; sv[i] = siluf_(c); }
    __syncthreads();
    const int kg = t >> 4, cl = t & 15;
    f32x4 a0 = {0, 0, 0, 0}, a1 = a0, a2 = a0;
    const float* W = p.ada_w + (size_t)l * 1024 * 6144 + n0 + cl * 4;
#pragma unroll 8
    for (int i = 0; i < 32; ++i) {
        const int k = kg + 32 * i;
        const f32x4 w = *(const f32x4*)(W + (size_t)k * 6144);
        a0 += w * sv[k]; a1 += w * sv[1024 + k]; a2 += w * sv[2048 + k];
    }
#pragma unroll
    for (int j = 0; j < 4; ++j) { red[kg * 192 + 0 * 64 + cl * 4 + j] = a0[j]; red[kg * 192 + 1 * 64 + cl * 4 + j] = a1[j]; red[kg * 192 + 2 * 64 + cl * 4 + j] = a2[j]; }
    __syncthreads();
    if (t < 192) {
        float s = 0.f;
        for (int g = 0; g < 32; ++g) s += red[g * 192 + t];
        const int w = t >> 6, n = n0 + (t & 63);
        ((float*)(p.ws + OFF_MOD))[(size_t)(l * 3 + w) * 6144 + n] = s + p.ada_b[l * 6144 + n];
    }
    __syncthreads();
}
DI void rope_unit(const Params& p, int u) {
    const int id = u * NTH + threadIdx.x;
    if (id < 320 * 16) {
        const int pi = id >> 4, f = id & 15;
        const float inv = exp2f(-(float)f * (13.287712379549449f / 16.0f));
        const float val = pi < 256 ? (float)pi : (float)(pi - 256);
        const float ang = val * inv;
        const double a = (double)ang;
        const double k = __builtin_rint(a * 0.15915494309189535);
        const float r = (float)(a - k * 6.283185307179586);
        f32x2 cs = {__cosf(r), __sinf(r)};
        ((f32x2*)(p.ws + OFF_ROPE))[id] = cs;
    }
}
DI void phase_prologue(const Params& p, char* smem) {
    float* sm = (float*)smem;
    const int nconv = CV_SMALL_UNITS + CV_MOE_UNITS;
    const int total = nconv + 192 + 10;
    for (int u = blockIdx.x; u < total; u += gridDim.x) {
        if (u < CV_SMALL_UNITS) cvt_small_unit(p, u, sm);
        else if (u < nconv) cvt_moe_unit(p, 0, u - CV_SMALL_UNITS, sm);
        else if (u < nconv + 192) adaln_unit(p, u - nconv, sm);
        else rope_unit(p, u - nconv - 192);
    }
}

DI void row_load(const float* src, f32x4 (&v)[4], int lane) {
#pragma unroll
    for (int i = 0; i < 4; ++i) v[i] = ((const f32x4*)src)[lane + 64 * i];
}
DI float row_rstd(const f32x4 (&v)[4]) {
    float ss = 0.f;
#pragma unroll
    for (int i = 0; i < 4; ++i) ss += v[i][0] * v[i][0] + v[i][1] * v[i][1] + v[i][2] * v[i][2] + v[i][3] * v[i][3];
    ss = wave_sum(ss);
    return rsqrtf(ss * (1.0f / DM) + RMS_EPS);
}
DI void row_norm_mod(const f32x4 (&v)[4], float rstd, const float* g, const float* shift, const float* scale, f32x4 (&h)[4], int lane) {
#pragma unroll
    for (int i = 0; i < 4; ++i) {
        const int c = (lane + 64 * i) * 4;
        const f32x4 g4 = *(const f32x4*)(g + c), sh = *(const f32x4*)(shift + c), sc = *(const f32x4*)(scale + c);
        h[i] = (v[i] * rstd * g4) * (1.0f + sc) + sh;
    }
}
DI void row_store_bf16(bf16_t* dst, const f32x4 (&h)[4], int lane) {
#pragma unroll
    for (int i = 0; i < 4; ++i) { u32x2 w; w[0] = pk_bf16(h[i][0], h[i][1]); w[1] = pk_bf16(h[i][2], h[i][3]); *(u32x2*)(dst + (lane + 64 * i) * 4) = w; }
}
DI void row_load_bf16(const bf16_t* src, f32x4 (&v)[4], int lane) {
#pragma unroll
    for (int i = 0; i < 4; ++i) { const u32x2 w = *(const u32x2*)(src + (lane + 64 * i) * 4); v[i][0] = bf_lo(w[0]); v[i][1] = bf_hi(w[0]); v[i][2] = bf_lo(w[1]); v[i][3] = bf_hi(w[1]); }
}

DI void phase_norm0(const Params& p) {
    const int lane = threadIdx.x & 63, gw = blockIdx.x * NWAVE + (threadIdx.x >> 6), nw = gridDim.x * NWAVE;
    bf16_t* H = (bf16_t*)(p.ws + OFF_H);
    for (int tok = gw; tok < TTOT; tok += nw) {
        f32x4 v[4], h[4];
        row_load(xin_ptr(p, tok), v, lane);
        const float rstd = row_rstd(v);
        row_norm_mod(v, rstd, p.norm_mix_g, mod_ptr(p, 0, tok, 0), mod_ptr(p, 0, tok, 1), h, lane);
        row_store_bf16(H + (size_t)tok * DM, h, lane);
    }
}

DI void route_row(const Params& p, const float (&lg)[16], int& e1, int& e2, float& g1, float& g2) {
    float mx = lg[0];
#pragma unroll
    for (int e = 1; e < 16; ++e) mx = fmaxf(mx, lg[e]);
    float pr[16], sum = 0.f;
#pragma unroll
    for (int e = 0; e < 16; ++e) { pr[e] = __expf(lg[e] - mx); sum += pr[e]; }
    const float inv = 1.0f / sum;
    float sel[16];
#pragma unroll
    for (int e = 0; e < 16; ++e) { pr[e] *= inv; sel[e] = pr[e] + p.router_bias[e]; }
    float best = -1e30f; int gi = 0;
#pragma unroll
    for (int g = 0; g < 4; ++g) {
        float m1 = -1e30f, m2 = -1e30f;
#pragma unroll
        for (int j = 0; j < 4; ++j) { const float s = sel[g * 4 + j]; if (s > m1) { m2 = m1; m1 = s; } else if (s > m2) m2 = s; }
        const float gs = m1 + m2;
        if (gs > best) { best = gs; gi = g; }
    }
    float s4[4], p4[4];
#pragma unroll
    for (int j = 0; j < 4; ++j) {
        s4[j] = gi == 0 ? sel[j] : gi == 1 ? sel[4 + j] : gi == 2 ? sel[8 + j] : sel[12 + j];
        p4[j] = gi == 0 ? pr[j] : gi == 1 ? pr[4 + j] : gi == 2 ? pr[8 + j] : pr[12 + j];
    }
    int i1 = 0; float b1 = s4[0];
#pragma unroll
    for (int j = 1; j < 4; ++j) if (s4[j] > b1) { b1 = s4[j]; i1 = j; }
    int i2 = i1 == 0 ? 1 : 0; float b2 = -3e38f;
#pragma unroll
    for (int j = 0; j < 4; ++j) if (j != i1 && s4[j] > b2) { b2 = s4[j]; i2 = j; }
    const float w1 = i1 == 0 ? p4[0] : i1 == 1 ? p4[1] : i1 == 2 ? p4[2] : p4[3];
    const float w2 = i2 == 0 ? p4[0] : i2 == 1 ? p4[1] : i2 == 2 ? p4[2] : p4[3];
    const float ws = 1.0f / (w1 + w2);
    e1 = gi * 4 + i1; e2 = gi * 4 + i2; g1 = w1 * ws; g2 = w2 * ws;
}
DI void phase_ffn_norm_route(const Params& p, int layer, char* smem) {
    const int lane = threadIdx.x & 63, gw = blockIdx.x * NWAVE + (threadIdx.x >> 6), nw = gridDim.x * NWAVE;
    float* rw = (float*)smem;
    for (int i = threadIdx.x; i < 1024 * 16; i += NTH) rw[(i & 15) * 1024 + (i >> 4)] = p.router_w[i];
    __syncthreads();
    bf16_t* H = (bf16_t*)(p.ws + OFF_H);
    int* lcnt = (int*)(smem + 65536);
    if (threadIdx.x < 32) lcnt[threadIdx.x] = 0;
    int my_tok = -1, my_e1 = 0, my_e2 = 0, it = 0; float my_g1 = 0.f, my_g2 = 0.f;
    for (int tok = gw; tok < TTOT; tok += nw) {
        const int pos = tok >= PTOT ? tok - PTOT : tok;
        if (layer == 1 && pos < LCTX) continue;
        f32x4 v[4], h[4];
        row_load(xrow_ptr(p, tok), v, lane);
        const float rstd = row_rstd(v);
        row_norm_mod(v, rstd, p.norm_ffn_g + layer * DM, mod_ptr(p, layer, tok, 3), mod_ptr(p, layer, tok, 4), h, lane);
        row_store_bf16(H + (size_t)tok * DM, h, lane);
        float lg[16];
#pragma unroll
        for (int e = 0; e < 16; ++e) lg[e] = 0.f;
#pragma unroll
        for (int i = 0; i < 4; ++i)
#pragma unroll
            for (int e = 0; e < 16; ++e) {
                const f32x4 w = *(const f32x4*)(rw + e * 1024 + (lane + 64 * i) * 4);
                lg[e] += h[i][0] * w[0] + h[i][1] * w[1] + h[i][2] * w[2] + h[i][3] * w[3];
                if ((e & 3) == 3) asm volatile("" ::: "memory");
            }
#pragma unroll
        for (int e = 0; e < 16; ++e) lg[e] = wave_sum(lg[e]);
        int e1, e2; float g1, g2;
        route_row(p, lg, e1, e2, g1, g2);
        if (lane == it) { my_tok = tok; my_e1 = e1; my_e2 = e2; my_g1 = g1; my_g2 = g2; }
        ++it;
    }
    __syncthreads();
    int r1 = 0, r2 = 0;
    if (my_tok >= 0) { r1 = atomicAdd(&lcnt[my_e1], 1); r2 = atomicAdd(&lcnt[my_e2], 1); }
    __syncthreads();
    if (threadIdx.x < 16) { const int n = lcnt[threadIdx.x]; lcnt[16 + threadIdx.x] = n ? atomicAdd((int*)(p.ws + OFF_CNT) + layer * 16 + threadIdx.x, n) : 0; }
    __syncthreads();
    if (my_tok >= 0) {
        int* stok = (int*)(p.ws + OFF_STOK);
        float* sw = (float*)(p.ws + OFF_SW);
        const size_t s1 = (size_t)my_e1 * CAP + lcnt[16 + my_e1] + r1, s2 = (size_t)my_e2 * CAP + lcnt[16 + my_e2] + r2;
        stok[s1] = my_tok * 2 + 0; sw[s1] = my_g1;
        stok[s2] = my_tok * 2 + 1; sw[s2] = my_g2;
    }
    __syncthreads();
}

DI void combine_row(const Params& p, int layer, int tok, f32x4 (&v)[4], int lane) {
    const bf16_t* Y = (const bf16_t*)(p.ws + OFF_SCR + S_Y) + (size_t)tok * 2 * DM;
    const float* g5 = mod_ptr(p, layer, tok, 5);
    f32x4 y0[4], y1[4];
    row_load(xrow_ptr(p, tok), v, lane);
    row_load_bf16(Y, y0, lane); row_load_bf16(Y + DM, y1, lane);
#pragma unroll
    for (int i = 0; i < 4; ++i) { const f32x4 g = *(const f32x4*)(g5 + (lane + 64 * i) * 4); v[i] += g * (y0[i] + y1[i]); }
}
DI void phase_combine_l0(const Params& p, char* smem) {
    const int lane = threadIdx.x & 63, gw = blockIdx.x * NWAVE + (threadIdx.x >> 6), nw = gridDim.x * NWAVE;
    bf16_t* H = (bf16_t*)(p.ws + OFF_H);
    for (int tok = gw; tok < TTOT; tok += nw) {
        f32x4 v[4], h[4];
        combine_row(p, 0, tok, v, lane);
        float* X = xrow_ptr(p, tok);
#pragma unroll
        for (int i = 0; i < 4; ++i) ((f32x4*)X)[lane + 64 * i] = v[i];
        const float rstd = row_rstd(v);
        row_norm_mod(v, rstd, p.norm_mix_g + DM, mod_ptr(p, 1, tok, 0), mod_ptr(p, 1, tok, 1), h, lane);
        row_store_bf16(H + (size_t)tok * DM, h, lane);
    }
    __syncthreads();
    for (int u = blockIdx.x; u < CV_MOE_UNITS; u += gridDim.x) cvt_moe_unit(p, 1, u, (float*)smem);
}
DI void phase_xx(const Params& p) {
    const int lane = threadIdx.x & 63, gw = blockIdx.x * NWAVE + (threadIdx.x >> 6), nw = gridDim.x * NWAVE;
    const bf16_t* H = (const bf16_t*)(p.ws + OFF_H);
    bf16_t* XX = (bf16_t*)(p.ws + OFF_SCR + S_XX);
    for (int tok = gw; tok < TTOT; tok += nw) {
        const int pos = tok >= PTOT ? tok - PTOT : tok;
        const bool first = pos == 0 || pos == LCTX, last = pos == LCTX - 1 || pos == PTOT - 1;
        f32x4 hc[4], hp[4], hn[4], xx[4];
        row_load_bf16(H + (size_t)tok * DM, hc, lane);
        row_load_bf16(H + (size_t)(first ? tok : tok - 1) * DM, hp, lane);
        row_load_bf16(H + (size_t)(last ? tok : tok + 1) * DM, hn, lane);
#pragma unroll
        for (int i = 0; i < 4; ++i) {
            const f32x4 a = first ? (f32x4){0, 0, 0, 0} : hp[i], b = last ? (f32x4){0, 0, 0, 0} : hn[i];
            xx[i] = 0.5f * (a + b) - hc[i];
        }
        row_store_bf16(XX + (size_t)tok * DM, xx, lane);
    }
}
DI void phase_final(const Params& p) {
    const int lane = threadIdx.x & 63, gw = blockIdx.x * NWAVE + (threadIdx.x >> 6), nw = gridDim.x * NWAVE;
    for (int r = gw; r < NBATCH * SEQ; r += nw) {
        const int b = r / SEQ, tok = b * PTOT + LCTX + (r - b * SEQ);
        f32x4 v[4];
        combine_row(p, 1, tok, v, lane);
        const float rstd = row_rstd(v);
        float* O = p.out + (size_t)r * DM;
#pragma unroll
        for (int i = 0; i < 4; ++i) { const f32x4 g = *(const f32x4*)(p.final_norm_g + (lane + 64 * i) * 4); ((f32x4*)O)[lane + 64 * i] = v[i] * rstd * g; }
    }
}

constexpr int LDSROW = 72;
constexpr int GEMM_SMEM = 2 * (256 + 128) * LDSROW * 2;
template <class AL, class EPI>
DI void gemm_tile(AL& al, const bf16_t* __restrict__ Bt, int ldb, int nk, EPI& epi, char* smem) {
    const int t = threadIdx.x, lane = t & 63, wid = t >> 6, wr = wid >> 1, wc = wid & 1, fr = lane & 15, fq = lane >> 4;
    bf16_t* sA = (bf16_t*)smem;
    bf16_t* sB = sA + 2 * 256 * LDSROW;
    f32x4 acc[4][4];
#pragma unroll
    for (int m = 0; m < 4; ++m)
#pragma unroll
        for (int n = 0; n < 4; ++n) acc[m][n] = (f32x4){0.f, 0.f, 0.f, 0.f};
    const int lr = t >> 3, lc = (t & 7) * 8;
    u32x4 ra[4], rb[2];
#pragma unroll
    for (int i = 0; i < 4; ++i) ra[i] = al.load(lr + 64 * i, lc, i);
#pragma unroll
    for (int i = 0; i < 2; ++i) rb[i] = *(const u32x4*)(Bt + (size_t)(lr + 64 * i) * ldb + lc);
#pragma unroll
    for (int i = 0; i < 4; ++i) *(u32x4*)(sA + (lr + 64 * i) * LDSROW + lc) = ra[i];
#pragma unroll
    for (int i = 0; i < 2; ++i) *(u32x4*)(sB + (lr + 64 * i) * LDSROW + lc) = rb[i];
    __syncthreads();
    bf16x8 af[2][4], bfr[2][4];
    {
        const bf16_t* cA = sA + (wr * 64 + fr) * LDSROW + fq * 8;
        const bf16_t* cB = sB + (wc * 64 + fr) * LDSROW + fq * 8;
#pragma unroll
        for (int m = 0; m < 4; ++m) af[0][m] = *(const bf16x8*)(cA + m * 16 * LDSROW);
#pragma unroll
        for (int n = 0; n < 4; ++n) bfr[0][n] = *(const bf16x8*)(cB + n * 16 * LDSROW);
    }
    for (int kt = 0; kt < nk; ++kt) {
        const int cur = kt & 1;
        const bool more = kt + 1 < nk;
        if (more) {
#pragma unroll
            for (int i = 0; i < 4; ++i) ra[i] = al.load(lr + 64 * i, (kt + 1) * 64 + lc, i);
#pragma unroll
            for (int i = 0; i < 2; ++i) rb[i] = *(const u32x4*)(Bt + (size_t)(lr + 64 * i) * ldb + (kt + 1) * 64 + lc);
        }
        const bf16_t* cA = sA + cur * 256 * LDSROW + (wr * 64 + fr) * LDSROW + fq * 8;
        const bf16_t* cB = sB + cur * 128 * LDSROW + (wc * 64 + fr) * LDSROW + fq * 8;
#pragma unroll
        for (int m = 0; m < 4; ++m) af[1][m] = *(const bf16x8*)(cA + m * 16 * LDSROW + 32);
#pragma unroll
        for (int n = 0; n < 4; ++n) bfr[1][n] = *(const bf16x8*)(cB + n * 16 * LDSROW + 32);
#pragma unroll
        for (int m = 0; m < 4; ++m)
#pragma unroll
            for (int n = 0; n < 4; ++n) acc[m][n] = __builtin_amdgcn_mfma_f32_16x16x32_bf16(bfr[0][n], af[0][m], acc[m][n], 0, 0, 0);
        if (more) {
            bf16_t* nA = sA + (cur ^ 1) * 256 * LDSROW;
            bf16_t* nB = sB + (cur ^ 1) * 128 * LDSROW;
#pragma unroll
            for (int i = 0; i < 4; ++i) *(u32x4*)(nA + (lr + 64 * i) * LDSROW + lc) = ra[i];
#pragma unroll
            for (int i = 0; i < 2; ++i) *(u32x4*)(nB + (lr + 64 * i) * LDSROW + lc) = rb[i];
        }
#pragma unroll
        for (int m = 0; m < 4; ++m)
#pragma unroll
            for (int n = 0; n < 4; ++n) acc[m][n] = __builtin_amdgcn_mfma_f32_16x16x32_bf16(bfr[1][n], af[1][m], acc[m][n], 0, 0, 0);
        __syncthreads();
        if (more) {
            const bf16_t* dA = sA + (cur ^ 1) * 256 * LDSROW + (wr * 64 + fr) * LDSROW + fq * 8;
            const bf16_t* dB = sB + (cur ^ 1) * 128 * LDSROW + (wc * 64 + fr) * LDSROW + fq * 8;
#pragma unroll
            for (int m = 0; m < 4; ++m) af[0][m] = *(const bf16x8*)(dA + m * 16 * LDSROW);
#pragma unroll
            for (int n = 0; n < 4; ++n) bfr[0][n] = *(const bf16x8*)(dB + n * 16 * LDSROW);
        }
    }
    epi(acc, wr * 64, wc * 64, fr, fq);
}
struct ALPlain {
    const bf16_t* A; int lda;
    DI u32x4 load(int r, int k, int) const { return *(const u32x4*)(A + (size_t)r * lda + k); }
};
struct ALGather {
    const bf16_t* rowp[4];
    DI u32x4 load(int, int k, int i) const { return *(const u32x4*)(rowp[i] + k); }
};
struct ALMix {
    const bf16_t* H; const bf16_t* XX; const float* xm;
    DI u32x4 load(int r, int k, int) const {
        const u32x4 h = *(const u32x4*)(H + (size_t)r * DM + k), x = *(const u32x4*)(XX + (size_t)r * DM + k);
        const f32x4 m0 = *(const f32x4*)(xm + k), m1 = *(const f32x4*)(xm + k + 4);
        u32x4 o;
        o[0] = pk_bf16(bf_lo(h[0]) + bf_lo(x[0]) * m0[0], bf_hi(h[0]) + bf_hi(x[0]) * m0[1]);
        o[1] = pk_bf16(bf_lo(h[1]) + bf_lo(x[1]) * m0[2], bf_hi(h[1]) + bf_hi(x[1]) * m0[3]);
        o[2] = pk_bf16(bf_lo(h[2]) + bf_lo(x[2]) * m1[0], bf_hi(h[2]) + bf_hi(x[2]) * m1[1]);
        o[3] = pk_bf16(bf_lo(h[3]) + bf_lo(x[3]) * m1[2], bf_hi(h[3]) + bf_hi(x[3]) * m1[3]);
        return o;
    }
};

struct EpiQKV {
    const Params* p; int m0, n0;
    DI void operator()(const f32x4 (&acc)[4][4], int rb, int cb, int fr, int fq) const {
        const int hs = (n0 + cb) >> 6;
        const bool isq = hs < 8 || (hs >= 12 && hs < 20), isv = (hs >= 10 && hs < 12) || hs >= 22, normed = hs >= 12 && hs < 22;
        const float* gam = hs < 20 ? p->attn_q_norm_g : p->attn_k_norm_g;
        const f32x2* rope = (const f32x2*)(p->ws + OFF_ROPE);
        bf16_t* Q = (bf16_t*)(p->ws + OFF_SCR + S_Q);
        bf16_t* K = (bf16_t*)(p->ws + OFF_SCR + S_K);
        bf16_t* VT = (bf16_t*)(p->ws + OFF_SCR + S_VT);
#pragma unroll
        for (int m = 0; m < 4; ++m) {
            const int tok = m0 + rb + m * 16 + fr, b = tok >= PTOT ? 1 : 0, pos = tok - b * PTOT;
            f32x4 v[4];
#pragma unroll
            for (int n = 0; n < 4; ++n) v[n] = acc[m][n];
            if (normed) {
                float ss = 0.f;
#pragma unroll
                for (int n = 0; n < 4; ++n) ss += v[n][0] * v[n][0] + v[n][1] * v[n][1] + v[n][2] * v[n][2] + v[n][3] * v[n][3];
                ss += __shfl_xor(ss, 16); ss += __shfl_xor(ss, 32);
                const float rstd = rsqrtf(ss * (1.0f / 64.0f) + RMS_EPS);
#pragma unroll
                for (int n = 0; n < 4; ++n) { const f32x4 g = *(const f32x4*)(gam + n * 16 + fq * 4); v[n] = v[n] * rstd * g; }
            }
            if (!isv && pos >= LCTX) {
                const int t = pos - LCTX, prow = t >> 6, pcol = t & 63;
#pragma unroll
                for (int a = 0; a < 2; ++a) {
                    const f32x2* tb = rope + (a == 0 ? prow : 256 + pcol) * 16 + fq * 4;
#pragma unroll
                    for (int j = 0; j < 4; ++j) {
                        const f32x2 cs = tb[j];
                        const float x0 = v[2 * a][j], x1 = v[2 * a + 1][j];
                        v[2 * a][j] = x0 * cs[0] - x1 * cs[1];
                        v[2 * a + 1][j] = x1 * cs[0] + x0 * cs[1];
                    }
                }
            }
            if (isq) {
                const int hq = hs < 8 ? hs : hs - 4;
                bf16_t* dst = Q + ((size_t)(b * 16 + hq) * PTOT + pos) * 64 + fq * 4;
#pragma unroll
                for (int n = 0; n < 4; ++n) { const f32x4 w = v[n] * (0.125f * LOG2E); u32x2 o; o[0] = pk_bf16(w[0], w[1]); o[1] = pk_bf16(w[2], w[3]); *(u32x2*)(dst + n * 16) = o; }
            } else if (!isv) {
                const int kh = hs < 12 ? hs - 8 : hs - 18;
                bf16_t* dst = K + ((size_t)(b * 4 + kh) * PTOT + pos) * 64 + fq * 4;
#pragma unroll
                for (int n = 0; n < 4; ++n) { u32x2 o; o[0] = pk_bf16(v[n][0], v[n][1]); o[1] = pk_bf16(v[n][2], v[n][3]); *(u32x2*)(dst + n * 16) = o; }
            } else {
                const int vh = hs < 12 ? hs - 10 : hs - 20;
                bf16_t* dst = VT + (size_t)(b * 4 + vh) * 64 * PTOT + pos;
#pragma unroll
                for (int n = 0; n < 4; ++n)
#pragma unroll
                    for (int j = 0; j < 4; ++j) dst[(size_t)(n * 16 + fq * 4 + j) * PTOT] = (bf16_t)(pk_bf16(v[n][j], 0.f) & 0xffffu);
            }
        }
    }
};
DI void phase_qkv(const Params& p, char* smem) {
    const bf16_t* H = (const bf16_t*)(p.ws + OFF_H);
    const bf16_t* W = (const bf16_t*)(p.ws + OFF_WS) + W_IN;
    constexpr int NT = QKV_N / 128, MT = TTOT / 256;
    for (int u = blockIdx.x; u < MT * NT; u += gridDim.x) {
        const int mt = u / NT, nt = u % NT;
        ALPlain al{H + (size_t)mt * 256 * DM, DM};
        EpiQKV epi{&p, mt * 256, nt * 128};
        gemm_tile(al, W + (size_t)nt * 128 * DM, DM, DM / 64, epi, smem);
    }
}

struct EpiResid {
    const Params* p; int m0, n0, layer; bool from_input;
    DI void operator()(const f32x4 (&acc)[4][4], int rb, int cb, int fr, int fq) const {
#pragma unroll
        for (int m = 0; m < 4; ++m) {
            const int tok = m0 + rb + m * 16 + fr;
            const float* xin = from_input ? xin_ptr(*p, tok) : xrow_ptr(*p, tok);
            float* xo = xrow_ptr(*p, tok);
            const float* gate = mod_ptr(*p, layer, tok, 2);
#pragma unroll
            for (int n = 0; n < 4; ++n) {
                const int c = n0 + cb + n * 16 + fq * 4;
                const f32x4 xi = *(const f32x4*)(xin + c), g = *(const f32x4*)(gate + c);
                *(f32x4*)(xo + c) = xi + g * acc[m][n];
            }
        }
    }
};
DI void phase_wout(const Params& p, char* smem) {
    const bf16_t* O = (const bf16_t*)(p.ws + OFF_SCR + S_O);
    const bf16_t* W = (const bf16_t*)(p.ws + OFF_WS) + W_OUT;
    constexpr int NT = 8, MT = TTOT / 256;
    for (int u = blockIdx.x; u < MT * NT; u += gridDim.x) {
        const int mt = u / NT, nt = u % NT;
        ALPlain al{O + (size_t)mt * 256 * DM, DM};
        EpiResid epi{&p, mt * 256, nt * 128, 0, true};
        gemm_tile(al, W + (size_t)nt * 128 * DM, DM, DM / 64, epi, smem);
    }
}
DI void phase_wo(const Params& p, char* smem) {
    const bf16_t* O = (const bf16_t*)(p.ws + OFF_SCR + S_OR);
    const bf16_t* W = (const bf16_t*)(p.ws + OFF_WS) + W_O;
    constexpr int NT = 8, MTL = SEQ / 256;
    for (int u = blockIdx.x; u < NBATCH * MTL * NT; u += gridDim.x) {
        const int mi = u / NT, nt = u % NT, b = mi / MTL, mt = b * (PTOT / 256) + 1 + (mi % MTL);
        ALPlain al{O + (size_t)mt * 256 * DM, DM};
        EpiResid epi{&p, mt * 256, nt * 128, 1, false};
        gemm_tile(al, W + (size_t)nt * 128 * DM, DM, DM / 64, epi, smem);
    }
}

struct MoeSched { int nt[16], base[17]; };
DI void moe_sched(const Params& p, int layer, MoeSched& s, int (&cnt)[16]) {
    const int* c = (const int*)(p.ws + OFF_CNT) + layer * 16;
    int acc = 0;
#pragma unroll
    for (int e = 0; e < 16; ++e) { cnt[e] = c[e]; s.nt[e] = (cnt[e] + 255) >> 8; s.base[e] = acc; acc += s.nt[e]; }
    s.base[16] = acc;
}
struct EpiMoe1 {
    bf16_t* hid;   int n0;
    DI void operator()(const f32x4 (&acc)[4][4], int rb, int cb, int fr, int fq) const {
        const int g = (n0 + cb) >> 6;
#pragma unroll
        for (int m = 0; m < 4; ++m) {
            bf16_t* dst = hid + (size_t)(rb + m * 16 + fr) * 1024 + g * 32 + fq * 4;
#pragma unroll
            for (int n = 0; n < 2; ++n) {
                const f32x4 a = acc[m][n], b = acc[m][n + 2];
                u32x2 o;
                o[0] = pk_bf16(siluf_(a[0]) * b[0], siluf_(a[1]) * b[1]);
                o[1] = pk_bf16(siluf_(a[2]) * b[2], siluf_(a[3]) * b[3]);
                *(u32x2*)(dst + n * 16) = o;
            }
        }
    }
};
DI void phase_moe1(const Params& p, int layer, char* smem) {
    MoeSched s; int cnt[16];
    moe_sched(p, layer, s, cnt);
    const bf16_t* H = (const bf16_t*)(p.ws + OFF_H);
    const bf16_t* W13 = (const bf16_t*)(p.ws + OFF_MOEW);
    const int* stok = (const int*)(p.ws + OFF_STOK);
    bf16_t* hid = (bf16_t*)(p.ws + OFF_SCR + S_HID);
    constexpr int NT = 16;
    const int total = s.base[16] * NT;
    const int lr = threadIdx.x >> 3;
    for (int u = blockIdx.x; u < total; u += gridDim.x) {
        const int mg = u / NT, nt = u % NT;
        int e = 0;
#pragma unroll
        for (int i = 1; i < 16; ++i) if (mg >= s.base[i]) e = i;
        int ce = 0;
#pragma unroll
        for (int i = 0; i < 16; ++i) if (i == e) ce = cnt[i];
        int be = 0;
#pragma unroll
        for (int i = 0; i < 16; ++i) if (i == e) be = s.base[i];
        const int ml = mg - be;
        ALGather al;
#pragma unroll
        for (int i = 0; i < 4; ++i) {
            const int r = ml * 256 + lr + 64 * i;
            const int tk = r < ce ? (stok[(size_t)e * CAP + r] >> 1) : 0;
            al.rowp[i] = H + (size_t)tk * DM;
        }
        EpiMoe1 epi{hid + (size_t)mg * 256 * 1024, nt * 128};
        gemm_tile(al, W13 + (size_t)e * 2048 * 1024 + (size_t)nt * 128 * 1024, 1024, 16, epi, smem);
    }
}
struct EpiMoe2 {
    bf16_t* Y; const int* stok; const float* sw; int nvalid, n0;
    DI void operator()(const f32x4 (&acc)[4][4], int rb, int cb, int fr, int fq) const {
#pragma unroll
        for (int m = 0; m < 4; ++m) {
            const int r = rb + m * 16 + fr;
            if (r < nvalid) {
                const int tk = stok[r]; const float w = sw[r];
                bf16_t* dst = Y + (size_t)tk * 1024 + n0 + cb + fq * 4;
#pragma unroll
                for (int n = 0; n < 4; ++n) { const f32x4 a = acc[m][n] * w; u32x2 o; o[0] = pk_bf16(a[0], a[1]); o[1] = pk_bf16(a[2], a[3]); *(u32x2*)(dst + n * 16) = o; }
            }
        }
    }
};
DI void phase_moe2(const Params& p, int layer, char* smem) {
    MoeSched s; int cnt[16];
    moe_sched(p, layer, s, cnt);
    const bf16_t* hid = (const bf16_t*)(p.ws + OFF_SCR + S_HID);
    const bf16_t* W2 = (const bf16_t*)(p.ws + OFF_MOEW) + (size_t)16 * 2048 * 1024;
    const int* stok = (const int*)(p.ws + OFF_STOK);
    const float* sw = (const float*)(p.ws + OFF_SW);
    bf16_t* Y = (bf16_t*)(p.ws + OFF_SCR + S_Y);
    constexpr int NT = 8;
    const int total = s.base[16] * NT;
    for (int u = blockIdx.x; u < total; u += gridDim.x) {
        const int mg = u / NT, nt = u % NT;
        int e = 0;
#pragma unroll
        for (int i = 1; i < 16; ++i) if (mg >= s.base[i]) e = i;
        int ce = 0, be = 0;
#pragma unroll
        for (int i = 0; i < 16; ++i) if (i == e) { ce = cnt[i]; be = s.base[i]; }
        const int ml = mg - be;
        ALPlain al{hid + (size_t)mg * 256 * 1024, 1024};
        EpiMoe2 epi{Y, stok + (size_t)e * CAP + ml * 256, sw + (size_t)e * CAP + ml * 256, ce - ml * 256, nt * 128};
        gemm_tile(al, W2 + (size_t)e * 1024 * 1024 + (size_t)nt * 128 * 1024, 1024, 16, epi, smem);
    }
}

struct EpiRwkv {
    bf16_t* dst; int ld, m0, n0, act, nstore;
    DI void operator()(const f32x4 (&acc)[4][4], int rb, int cb, int fr, int fq) const {
#pragma unroll
        for (int m = 0; m < 4; ++m) {
            bf16_t* d = dst + (size_t)(m0 + rb + m * 16 + fr) * ld + n0 + cb + fq * 4;
#pragma unroll
            for (int n = 0; n < 4; ++n) {
                const int c = n0 + cb + n * 16 + fq * 4;
                if (c >= ld) continue;
                f32x4 a = acc[m][n];
                if (act == 1) {
#pragma unroll
                    for (int j = 0; j < 4; ++j) { const float e = __expf(2.0f * a[j]); a[j] = 1.0f - 2.0f / (e + 1.0f); }
                }
                if (act == 2) {
#pragma unroll
                    for (int j = 0; j < 4; ++j) a[j] = sigmoidf_(a[j]);
                }
                if (c >= nstore) a = (f32x4){0.f, 0.f, 0.f, 0.f};
                u32x2 o; o[0] = pk_bf16(a[0], a[1]); o[1] = pk_bf16(a[2], a[3]);
                *(u32x2*)(d + n * 16) = o;
            }
        }
    }
};
DI void phase_rwkv_proj(const Params& p, char* smem) {
    const bf16_t* H = (const bf16_t*)(p.ws + OFF_H);
    const bf16_t* XX = (const bf16_t*)(p.ws + OFF_SCR + S_XX);
    const bf16_t* wsm = (const bf16_t*)(p.ws + OFF_WS);
    constexpr int MT = TTOT / 256, NTT = 8 + 8 + 8 + 1 + 1 + 2;
    for (int u = blockIdx.x; u < MT * NTT; u += gridDim.x) {
        const int mt = u / NTT, q = u % NTT;
        int job, nt;
        if (q < 8) { job = 0; nt = q; } else if (q < 16) { job = 1; nt = q - 8; } else if (q < 24) { job = 2; nt = q - 16; }
        else if (q == 24) { job = 3; nt = 0; } else if (q == 25) { job = 4; nt = 0; } else { job = 5; nt = q - 26; }
        const int mixj = job == 0 ? 0 : job == 1 ? 2 : job == 2 ? 3 : job == 3 ? 1 : job == 4 ? 4 : 5;
        const size_t wofs = job == 0 ? W_R : job == 1 ? W_K : job == 2 ? W_V : job == 3 ? W_W1 : job == 4 ? W_A1 : W_G1;
        const size_t dofs = job == 0 ? S_R : job == 1 ? S_KK : job == 2 ? S_V : job == 3 ? S_LW : job == 4 ? S_LA : S_LG;
        const int ld = job < 3 ? 1024 : job < 5 ? 128 : 192;
        ALMix al{H + (size_t)mt * 256 * DM, XX + (size_t)mt * 256 * DM, p.rwkv_x_mix + mixj * DM};
        EpiRwkv epi{(bf16_t*)(p.ws + OFF_SCR + dofs), ld, mt * 256, nt * 128, job == 3 ? 1 : job == 5 ? 2 : 0, job == 5 ? 160 : 4096};
        gemm_tile(al, wsm + wofs + (size_t)nt * 128 * DM, DM, DM / 64, epi, smem);
    }
}

struct EpiGate {
    const Params* p; int m0, n0;
    DI void operator()(const f32x4 (&acc)[4][4], int rb, int cb, int fr, int fq) const {
        const bf16_t* Y0 = (const bf16_t*)(p->ws + OFF_H);
        const bf16_t* Y1 = (const bf16_t*)(p->ws + OFF_SCR + S_Y1);
        const bf16_t* V = (const bf16_t*)(p->ws + OFF_SCR + S_V);
        const float* bonus = (const float*)(p->ws + OFF_BONUS2);
        bf16_t* O = (bf16_t*)(p->ws + OFF_SCR + S_OR);
        const int c0 = n0 + cb, hd = c0 >> 6;
#pragma unroll
        for (int m = 0; m < 4; ++m) {
            const int tok = m0 + rb + m * 16 + fr;
            const size_t ro = (size_t)tok * DM + c0 + fq * 4;
            f32x4 y[4];
            float s = 0.f;
#pragma unroll
            for (int n = 0; n < 4; ++n) {
                const u32x2 a = *(const u32x2*)(Y0 + ro + n * 16), b = *(const u32x2*)(Y1 + ro + n * 16);
                y[n][0] = bf_lo(a[0]) + bf_lo(b[0]); y[n][1] = bf_hi(a[0]) + bf_hi(b[0]); y[n][2] = bf_lo(a[1]) + bf_lo(b[1]); y[n][3] = bf_hi(a[1]) + bf_hi(b[1]);
                s += y[n][0] + y[n][1] + y[n][2] + y[n][3];
            }
            s += __shfl_xor(s, 16); s += __shfl_xor(s, 32);
            const float mu = s * (1.0f / 64.0f);
            float q = 0.f;
#pragma unroll
            for (int n = 0; n < 4; ++n) { const f32x4 d = y[n] - mu; q += d[0] * d[0] + d[1] * d[1] + d[2] * d[2] + d[3] * d[3]; }
            q += __shfl_xor(q, 16); q += __shfl_xor(q, 32);
            const float rs = rsqrtf(q * (1.0f / 64.0f) + GN_EPS);
            const float bon = (bonus[(size_t)tok * 16 + hd] + bonus[(size_t)(TTOT + tok) * 16 + hd]) + (bonus[(size_t)(2 * TTOT + tok) * 16 + hd] + bonus[(size_t)(3 * TTOT + tok) * 16 + hd]);
#pragma unroll
            for (int n = 0; n < 4; ++n) {
                const int c = c0 + n * 16 + fq * 4;
                const f32x4 g = *(const f32x4*)(p->rwkv_ln_g + c), bb = *(const f32x4*)(p->rwkv_ln_b + c);
                const u32x2 vv = *(const u32x2*)(V + ro + n * 16);
                const f32x4 v4 = {bf_lo(vv[0]), bf_hi(vv[0]), bf_lo(vv[1]), bf_hi(vv[1])};
                const f32x4 o = ((y[n] - mu) * rs * g + bb + bon * v4) * acc[m][n];
                u32x2 w; w[0] = pk_bf16(o[0], o[1]); w[1] = pk_bf16(o[2], o[3]);
                *(u32x2*)(O + ro + n * 16) = w;
            }
        }
    }
};
DI void phase_gate(const Params& p, char* smem) {
    const bf16_t* LG = (const bf16_t*)(p.ws + OFF_SCR + S_LG);
    const bf16_t* W = (const bf16_t*)(p.ws + OFF_WS) + W_G2;
    constexpr int NT = 8, MT = TTOT / 256;
    for (int u = blockIdx.x; u < MT * NT; u += gridDim.x) {
        const int mt = u / NT, nt = u % NT;
        ALPlain al{LG + (size_t)mt * 256 * 192, 192};
        EpiGate epi{&p, mt * 256, nt * 128};
        gemm_tile(al, W + (size_t)nt * 128 * 192, 192, 3, epi, smem);
    }
}

constexpr int KROW = 72, VROW = 68;
constexpr int ATT_SMEM = 2 * 64 * KROW * 2 + 2 * 64 * VROW * 2;
DI int crow_(int i, int h) { return (i & 3) + 8 * (i >> 2) + 4 * h; }
#define MFMA32(a, b, c) __builtin_amdgcn_mfma_f32_32x32x16_bf16((a), (b), (c), 0, 0, 0)
template <int MODE>
DI void attn_unit(const Params& p, const bf16_t* Qg  , int nq_valid, const bf16_t* Kg  , const bf16_t* Vg  ,
                  int ta0, int ta1, int tb0, int tb1  , bool band, int q_lat0  ,
                  float init_m, float init_l0, bf16_t* Og  , char* smem) {
    const int t = threadIdx.x, lane = t & 63, wid = t >> 6, r = lane & 31, h = lane >> 5;
    bf16_t* sK = (bf16_t*)smem;
    bf16_t* sV = sK + 2 * 64 * KROW;
    bf16x8 qf[2][4];
#pragma unroll
    for (int qs = 0; qs < 2; ++qs) {
        const int qi = wid * 64 + qs * 32 + r;
        const bf16_t* qp = Qg + (size_t)(qi < nq_valid ? qi : 0) * 64 + 8 * h;
#pragma unroll
        for (int ks = 0; ks < 4; ++ks) qf[qs][ks] = *(const bf16x8*)(qp + ks * 16);
    }
    f32x16 o[2][2];
#pragma unroll
    for (int qs = 0; qs < 2; ++qs)
#pragma unroll
        for (int dt = 0; dt < 2; ++dt)
#pragma unroll
            for (int i = 0; i < 16; ++i) o[qs][dt][i] = 0.f;
    float mrun[2], lrun[2];
#pragma unroll
    for (int qs = 0; qs < 2; ++qs) { mrun[qs] = init_m; lrun[qs] = (MODE == 1 && h == 0) ? init_l0 : 0.f; }
    const int ntile = ((ta1 - ta0) + (tb1 - tb0)) >> 6;
    const int lrow = t >> 3, lch = (t & 7) * 8;
    u32x4 rk, rv;
    auto tile_pos = [&](int i) { const int a = (ta1 - ta0) >> 6; return i < a ? ta0 + i * 64 : tb0 + (i - a) * 64; };
    {
        const int kp = tile_pos(0);
        rk = *(const u32x4*)(Kg + (size_t)(kp + lrow) * 64 + lch);
        rv = *(const u32x4*)(Vg + (size_t)lrow * PTOT + kp + lch);
        *(u32x4*)(sK + lrow * KROW + lch) = rk;
        *(u32x2*)(sV + lrow * VROW + lch) = (u32x2){rv[0], rv[1]};
        *(u32x2*)(sV + lrow * VROW + lch + 4) = (u32x2){rv[2], rv[3]};
    }
    __syncthreads();
    for (int it = 0; it < ntile; ++it) {
        const int cur = it & 1;
        const bool more = it + 1 < ntile;
        const int kp = tile_pos(it);
        if (more) {
            const int kn = tile_pos(it + 1);
            rk = *(const u32x4*)(Kg + (size_t)(kn + lrow) * 64 + lch);
            rv = *(const u32x4*)(Vg + (size_t)lrow * PTOT + kn + lch);
        }
        const bf16_t* cK = sK + cur * 64 * KROW;
        const bf16_t* cV = sV + cur * 64 * VROW;
#pragma unroll 1
        for (int ksub = 0; ksub < 2; ++ksub) {
            f32x16 sc[2];
#pragma unroll
            for (int qs = 0; qs < 2; ++qs)
#pragma unroll
                for (int i = 0; i < 16; ++i) sc[qs][i] = MODE == 0 ? init_m : 0.f;
#pragma unroll
            for (int ks = 0; ks < 4; ++ks) {
                const bf16x8 kf = *(const bf16x8*)(cK + (ksub * 32 + r) * KROW + ks * 16 + 8 * h);
#pragma unroll
                for (int qs = 0; qs < 2; ++qs) sc[qs] = MFMA32(kf, qf[qs][ks], sc[qs]);
            }
#pragma unroll
            for (int qs = 0; qs < 2; ++qs) {
                if (MODE == 1) {
                    if (band && kp >= LCTX) {
                        const int qlat = q_lat0 + wid * 64 + qs * 32 + r, kl0 = kp - LCTX + ksub * 32;
#pragma unroll
                        for (int i = 0; i < 16; ++i) {
                            const int d0 = qlat - (kl0 + crow_(i, h));
                            if (d0 > 128 || d0 < -128) sc[qs][i] = -1e30f;
                        }
                    }
                    float mt = sc[qs][0];
#pragma unroll
                    for (int i = 1; i < 16; ++i) mt = fmaxf(mt, sc[qs][i]);
                    mt = fmaxf(mt, __shfl_xor(mt, 32));
                    const float mnew = fmaxf(mrun[qs], mt);
                    const float alpha = __builtin_amdgcn_exp2f(mrun[qs] - mnew);
                    mrun[qs] = mnew; lrun[qs] *= alpha;
#pragma unroll
                    for (int i = 0; i < 16; ++i) { o[qs][0][i] *= alpha; o[qs][1][i] *= alpha; }
#pragma unroll
                    for (int i = 0; i < 16; ++i) sc[qs][i] -= mnew;
                }
                float ls = 0.f;
#pragma unroll
                for (int i = 0; i < 16; ++i) { sc[qs][i] = __builtin_amdgcn_exp2f(sc[qs][i]); ls += sc[qs][i]; }
                lrun[qs] += ls;
            }
#pragma unroll
            for (int st = 0; st < 2; ++st) {
                bf16x8 pf[2];
#pragma unroll
                for (int qs = 0; qs < 2; ++qs) {
                    u32x4 pw;
#pragma unroll
                    for (int j = 0; j < 4; ++j) pw[j] = pk_bf16(sc[qs][8 * st + 2 * j], sc[qs][8 * st + 2 * j + 1]);
                    pf[qs] = __builtin_bit_cast(bf16x8, pw);
                }
                const int kb = ksub * 32 + 16 * st + 4 * h;
#pragma unroll
                for (int dt = 0; dt < 2; ++dt) {
                    const s16x4 lo = *(const s16x4*)(cV + (dt * 32 + r) * VROW + kb), hi = *(const s16x4*)(cV + (dt * 32 + r) * VROW + kb + 8);
                    const bf16x8 vf = __builtin_shufflevector(lo, hi, 0, 1, 2, 3, 4, 5, 6, 7);
#pragma unroll
                    for (int qs = 0; qs < 2; ++qs) o[qs][dt] = MFMA32(vf, pf[qs], o[qs][dt]);
                }
            }
        }
        if (more) {
            bf16_t* nK = sK + (cur ^ 1) * 64 * KROW;
            bf16_t* nV = sV + (cur ^ 1) * 64 * VROW;
            *(u32x4*)(nK + lrow * KROW + lch) = rk;
            *(u32x2*)(nV + lrow * VROW + lch) = (u32x2){rv[0], rv[1]};
            *(u32x2*)(nV + lrow * VROW + lch + 4) = (u32x2){rv[2], rv[3]};
        }
        __syncthreads();
    }
#pragma unroll
    for (int qs = 0; qs < 2; ++qs) {
        const int qi = wid * 64 + qs * 32 + r;
        const float lt = lrun[qs] + __shfl_xor(lrun[qs], 32);
        const float invl = 1.0f / lt;
        if (qi < nq_valid) {
            bf16_t* op = Og + (size_t)qi * DM;
#pragma unroll
            for (int g = 0; g < 4; ++g) {
                u32x2 w0, w1;
                w0[0] = pk_bf16(o[qs][0][4 * g] * invl, o[qs][0][4 * g + 1] * invl); w0[1] = pk_bf16(o[qs][0][4 * g + 2] * invl, o[qs][0][4 * g + 3] * invl);
                w1[0] = pk_bf16(o[qs][1][4 * g] * invl, o[qs][1][4 * g + 1] * invl); w1[1] = pk_bf16(o[qs][1][4 * g + 2] * invl, o[qs][1][4 * g + 3] * invl);
                *(u32x2*)(op + 8 * g + 4 * h) = w0;
                *(u32x2*)(op + 32 + 8 * g + 4 * h) = w1;
            }
        }
    }
}
DI void phase_attn(const Params& p, char* smem) {
    const bf16_t* Q = (const bf16_t*)(p.ws + OFF_SCR + S_Q);
    const bf16_t* K = (const bf16_t*)(p.ws + OFF_SCR + S_K);
    const bf16_t* VT = (const bf16_t*)(p.ws + OFF_SCR + S_VT);
    bf16_t* O = (bf16_t*)(p.ws + OFF_SCR + S_O);
    float gq = 0.f, gk = 0.f;
    for (int i = 0; i < 64; ++i) { gq = fmaxf(gq, fabsf(p.attn_q_norm_g[i])); gk = fmaxf(gk, fabsf(p.attn_k_norm_g[i])); }
    const float M2 = 8.25f * gq * gk * LOG2E;
    constexpr int QB = 512, NQB = SEQ / QB;
    const int G = gridDim.x;
    constexpr int NDENSE = NBATCH * 8 * NQB;
    for (int u = blockIdx.x; u < NDENSE; u += G) {
        int combo, within;
        if ((G & 7) == 0 && NDENSE % G == 0) {
            const int xcd = blockIdx.x & 7, idx = (blockIdx.x >> 3) + (G >> 3) * (u / G);
            combo = xcd & 3; within = (xcd >> 2) * (NDENSE / 8) + idx;
        } else { combo = u / (4 * NQB); within = u % (4 * NQB); }
        const int b = combo >> 1, kvh = combo & 1, hq = kvh * 4 + (within & 3), qb = within >> 2;
        const bf16_t* Qg = Q + ((size_t)(b * 16 + 8 + hq) * PTOT + LCTX + qb * QB) * 64;
        attn_unit<0>(p, Qg, QB, K + (size_t)(b * 4 + 2 + kvh) * PTOT * 64, VT + (size_t)(b * 4 + 2 + kvh) * 64 * PTOT, 0, PTOT, 0, 0, false, 0, -M2, 0.f,
                     O + (size_t)(b * PTOT + LCTX + qb * QB) * DM + (8 + hq) * 64, smem);
    }
    for (int u = blockIdx.x; u < NDENSE; u += G) {
        const int b = u / (8 * NQB), rem = u % (8 * NQB), qb = rem >> 3, hq = rem & 7, kvh = hq >> 2;
        const int i0 = qb * QB;
        const int lo = i0 - 128 < 0 ? 0 : i0 - 128, hi = i0 + QB + 128 > SEQ ? SEQ : i0 + QB + 128;
        const bf16_t* Qg = Q + ((size_t)(b * 16 + hq) * PTOT + LCTX + i0) * 64;
        attn_unit<1>(p, Qg, QB, K + (size_t)(b * 4 + kvh) * PTOT * 64, VT + (size_t)(b * 4 + kvh) * 64 * PTOT, 0, LCTX, LCTX + lo, LCTX + hi, true, i0,
                     p.attn_sink[hq] * LOG2E, 1.0f, O + (size_t)(b * PTOT + LCTX + i0) * DM + hq * 64, smem);
    }
    for (int u = blockIdx.x; u < NBATCH * 16; u += G) {
        const int b = u >> 4, hh = u & 15, isb = hh >> 3, hq = hh & 7, kvh = isb * 2 + (hq >> 2);
        const bf16_t* Qg = Q + ((size_t)(b * 16 + hh) * PTOT) * 64;
        attn_unit<1>(p, Qg, LCTX, K + (size_t)(b * 4 + kvh) * PTOT * 64, VT + (size_t)(b * 4 + kvh) * 64 * PTOT, 0, LCTX, 0, 0, false, 0,
                     isb ? -1e30f : p.attn_sink[hq] * LOG2E, isb ? 0.f : 1.0f, O + (size_t)(b * PTOT) * DM + hh * 64, smem);
    }
}

constexpr int TB = 32, NBUF = 3;
constexpr int SC_REC = 5 * 64;
constexpr int SC_OPS = TB * SC_REC * 4;
constexpr int SC_SMEM = NBUF * SC_OPS + NBUF * TB * 16 * 4 + NBUF * TB * 16 * 4 + 64;
DI int scan_pos(int n, int dir) {
    if (n < LCTX) return dir ? LCTX - 1 - n : n;
    const int m = n - LCTX;
    return LCTX + (dir ? SEQ - 1 - m : m);
}
template <int CTRL> DI float dpp_add(float v) { return v + __builtin_bit_cast(float, __builtin_amdgcn_update_dpp(0, __builtin_bit_cast(int, v), CTRL, 0xf, 0xf, false)); }
DI float row16_sum(float v) { v = dpp_add<0x128>(v); v = dpp_add<0x124>(v); v = dpp_add<0x122>(v); v = dpp_add<0x121>(v); return v; }
DI int lds_min4(int* c) { const volatile LAS int* q = (const volatile LAS int*)c; const int a = q[0], b = q[1], d = q[2], e = q[3]; return min(min(a, b), min(d, e)); }
DI void lds_publish(int* c, int v) { *(volatile LAS int*)c = v; }
DI void scan_unit(const Params& p, int u, char* smem) {
    const int t = threadIdx.x, lane = t & 63, wid = __builtin_amdgcn_readfirstlane(t >> 6);
    const unsigned rg = u & 3, dir = (u >> 2) & 1, hd = (u >> 3) & 15, b = u >> 7;
    float* ops = (float*)smem;
    float* vbuf = (float*)(smem + NBUF * SC_OPS);
    float* ybuf = vbuf + NBUF * TB * 16;
    int* cnts = (int*)(ybuf + NBUF * TB * 16);
    const bf16_t* R = (const bf16_t*)(p.ws + OFF_SCR + S_R);
    const bf16_t* Kk = (const bf16_t*)(p.ws + OFF_SCR + S_KK);
    const bf16_t* V = (const bf16_t*)(p.ws + OFF_SCR + S_V);
    const bf16_t* LW = (const bf16_t*)(p.ws + OFF_SCR + S_LW);
    const bf16_t* LA = (const bf16_t*)(p.ws + OFF_SCR + S_LA);
    bf16_t* Yo = dir ? (bf16_t*)(p.ws + OFF_SCR + S_Y1) : (bf16_t*)(p.ws + OFF_H);
    float* bonus = (float*)(p.ws + OFF_BONUS2);
    const unsigned tokb = b * PTOT, hc = hd * 64;
    constexpr int NBLK = PTOT / TB;
    const unsigned fr = lane & 15, fq = lane >> 4;
    if (t < 8) cnts[t] = 0;
    __syncthreads();

    if (wid < 4) {
        __builtin_amdgcn_s_setprio(3);
        float s0 = 0.f, s1 = 0.f, s2 = 0.f, s3 = 0.f;
        const unsigned g = lane >> 4, c4 = (lane & 15) * 4, myrow = wid * 4 + g;
        for (int blk = 0; blk < NBLK; ++blk) {
            const unsigned buf = (unsigned)blk % NBUF;
            while (lds_min4(cnts) < blk + 1) __builtin_amdgcn_s_sleep(1);
            asm volatile("" ::: "memory");
            const float* rec = ops + buf * (TB * SC_REC) + c4;
            const float* vb = vbuf + buf * (TB * 16) + myrow;
            float* yb = ybuf + buf * (TB * 16) + myrow;
            f32x4 w0_ = *(const f32x4*)(rec), kd0_ = *(const f32x4*)(rec + 64), bb0_ = *(const f32x4*)(rec + 128), aa0_ = *(const f32x4*)(rec + 192), rr0_ = *(const f32x4*)(rec + 256);
            float vv0_ = vb[0];
#define SCAN_STEP(W, KD, BB, AA, RR, VV, ST) { \
                float sa = s0 * AA[0] + s1 * AA[1] + s2 * AA[2] + s3 * AA[3]; \
                sa = row16_sum(sa); \
                s0 = s0 * W[0] + sa * BB[0] + VV * KD[0]; \
                s1 = s1 * W[1] + sa * BB[1] + VV * KD[1]; \
                s2 = s2 * W[2] + sa * BB[2] + VV * KD[2]; \
                s3 = s3 * W[3] + sa * BB[3] + VV * KD[3]; \
                float y = s0 * RR[0] + s1 * RR[1] + s2 * RR[2] + s3 * RR[3]; \
                y = row16_sum(y); \
                if ((lane & 15) == 0) yb[(ST) * 16] = y; }
#pragma unroll 1
            for (int st = 0; st < TB; st += 2) {
                const float* r1 = rec + (st + 1) * SC_REC;
                const f32x4 w1_ = *(const f32x4*)(r1), kd1_ = *(const f32x4*)(r1 + 64), bb1_ = *(const f32x4*)(r1 + 128), aa1_ = *(const f32x4*)(r1 + 192), rr1_ = *(const f32x4*)(r1 + 256);
                const float vv1_ = vb[(st + 1) * 16];
                SCAN_STEP(w0_, kd0_, bb0_, aa0_, rr0_, vv0_, st)
                const int st2 = st + 2 < TB ? st + 2 : st;
                const float* r2 = rec + st2 * SC_REC;
                w0_ = *(const f32x4*)(r2); kd0_ = *(const f32x4*)(r2 + 64); bb0_ = *(const f32x4*)(r2 + 128); aa0_ = *(const f32x4*)(r2 + 192); rr0_ = *(const f32x4*)(r2 + 256);
                vv0_ = vb[st2 * 16];
                SCAN_STEP(w1_, kd1_, bb1_, aa1_, rr1_, vv1_, st + 1)
            }
#undef SCAN_STEP
            asm volatile("s_waitcnt lgkmcnt(0)" ::: "memory");
            if (lane == 0) lds_publish(cnts + 4 + wid, blk + 1);
        }
        __builtin_amdgcn_s_setprio(0);
    } else {
        const unsigned wt = wid & 1, chh = (wid >> 1) & 1;
        const bf16_t* wsm = (const bf16_t*)(p.ws + OFF_WS);
        const unsigned wo = W_W2 + dir * 65536u + (hc + fr) * 64u + fq * 8u;
        const unsigned ao = W_A2 + dir * 65536u + (hc + fr) * 64u + fq * 8u;
        const unsigned po = hc + fq * 4u;
        for (int blk = 0; blk < NBLK + NBUF; ++blk) {
            const unsigned buf = (unsigned)blk % NBUF;
            const int need = blk - NBUF + 1 < NBLK ? blk - NBUF + 1 : NBLK;
            while (lds_min4(cnts + 4) < need) __builtin_amdgcn_s_sleep(1);
            asm volatile("" ::: "memory");
            if (wid == 7 && blk >= NBUF) {
#pragma unroll
                for (int i = 0; i < TB * 16 / 64; ++i) {
                    const unsigned id = i * 64 + lane, st = id >> 4, rw = id & 15;
                    const unsigned tok = tokb + scan_pos((blk - NBUF) * TB + st, dir);
                    Yo[tok * 1024u + hc + rg * 16 + rw] = (bf16_t)(pk_bf16(ybuf[buf * (TB * 16) + id], 0.f) & 0xffffu);
                }
            }
            if (blk >= NBLK) continue;
            const unsigned st = wt * 16 + fr;
            const unsigned tok = tokb + scan_pos(blk * TB + st, dir);
            const unsigned lo = tok * 128u + dir * 64u + fq * 8u;
            const unsigned ro = tok * 1024u + hc + fq * 4u;
            bf16x8 lwf[2], laf[2];
#pragma unroll
            for (int kk = 0; kk < 2; ++kk) { lwf[kk] = *(const bf16x8*)(LW + lo + kk * 32); laf[kk] = *(const bf16x8*)(LA + lo + kk * 32); }
            float ssq = 0.f;
#pragma unroll
            for (int nt = 0; nt < 4; ++nt) {
                const f32x4 kkv = *(const f32x4*)(p.rwkv_k_k + po + nt * 16);
                const u32x2 c = *(const u32x2*)(Kk + ro + nt * 16);
                const float q0 = bf_lo(c[0]) * kkv[0], q1 = bf_hi(c[0]) * kkv[1], q2 = bf_lo(c[1]) * kkv[2], q3 = bf_hi(c[1]) * kkv[3];
                ssq += q0 * q0 + q1 * q1 + q2 * q2 + q3 * q3;
            }
            ssq += __shfl_xor(ssq, 16); ssq += __shfl_xor(ssq, 32);
            const float kn = __builtin_amdgcn_rsqf(fmaxf(ssq, 1e-24f));
            float* rec = ops + buf * (TB * SC_REC) + st * SC_REC + fq * 4;
            float bsum = 0.f;
#pragma unroll
            for (int n2 = 0; n2 < 2; ++n2) {
                const unsigned nt = chh * 2 + n2;
                f32x4 aw = {0.f, 0.f, 0.f, 0.f}, ai = aw;
#pragma unroll
                for (int kk = 0; kk < 2; ++kk) {
                    const bf16x8 w2f = *(const bf16x8*)(wsm + wo + nt * 1024 + kk * 32), a2f = *(const bf16x8*)(wsm + ao + nt * 1024 + kk * 32);
                    aw = __builtin_amdgcn_mfma_f32_16x16x32_bf16(w2f, lwf[kk], aw, 0, 0, 0);
                    ai = __builtin_amdgcn_mfma_f32_16x16x32_bf16(a2f, laf[kk], ai, 0, 0, 0);
                }
                const f32x4 w0v = *(const f32x4*)(p.rwkv_decay_w0 + dir * 1024u + po + nt * 16), a0v = *(const f32x4*)(p.rwkv_iclr_a0 + dir * 1024u + po + nt * 16);
                const f32x4 kkv = *(const f32x4*)(p.rwkv_k_k + po + nt * 16);
                const f32x4 kav = *(const f32x4*)(p.rwkv_k_a + po + nt * 16), rkv = *(const f32x4*)(p.rwkv_r_k + po + nt * 16);
                const u32x2 a = *(const u32x2*)(R + ro + nt * 16), c = *(const u32x2*)(Kk + ro + nt * 16);
                const f32x4 rr = {bf_lo(a[0]), bf_hi(a[0]), bf_lo(a[1]), bf_hi(a[1])};
                const f32x4 kr = {bf_lo(c[0]), bf_hi(c[0]), bf_lo(c[1]), bf_hi(c[1])};
                f32x4 wv, kd, bb, aa;
#pragma unroll
                for (int j = 0; j < 4; ++j) {
                    const float sg = __builtin_amdgcn_rcpf(1.0f + __builtin_amdgcn_exp2f(-(w0v[j] + aw[j]) * LOG2E));
                    wv[j] = __builtin_amdgcn_exp2f(sg * (-0.6065306597126334f * LOG2E));
                    const float ic = __builtin_amdgcn_rcpf(1.0f + __builtin_amdgcn_exp2f(-(a0v[j] + ai[j]) * LOG2E));
                    const float kkn = kr[j] * kkv[j] * kn;
                    kd[j] = kr[j] * (1.0f + (ic - 1.0f) * kav[j]);
                    bb[j] = kkn * ic;
                    aa[j] = -kkn;
                    bsum += rr[j] * kd[j] * rkv[j];
                }
                *(f32x4*)(rec + 0 * 64 + nt * 16) = wv;
                *(f32x4*)(rec + 1 * 64 + nt * 16) = kd;
                *(f32x4*)(rec + 2 * 64 + nt * 16) = bb;
                *(f32x4*)(rec + 3 * 64 + nt * 16) = aa;
                *(f32x4*)(rec + 4 * 64 + nt * 16) = rr;
            }
            bsum += __shfl_xor(bsum, 16); bsum += __shfl_xor(bsum, 32);
            if (rg == 0 && fq == 0) bonus[((chh * 2 + dir) * TTOT + tok) * 16u + hd] = bsum;
            if (wid == 6) {
                bf16_t vr[TB * 16 / 64];
#pragma unroll
                for (int i = 0; i < TB * 16 / 64; ++i) {
                    const unsigned id = i * 64 + lane, s2 = id >> 4, rw = id & 15;
                    const unsigned tk = tokb + scan_pos(blk * TB + s2, dir);
                    vr[i] = V[tk * 1024u + hc + rg * 16 + rw];
                }
#pragma unroll
                for (int i = 0; i < TB * 16 / 64; ++i) vbuf[buf * (TB * 16) + i * 64 + lane] = bf2f(vr[i]);
            }
            asm volatile("s_waitcnt lgkmcnt(0)" ::: "memory");
            if (lane == 0) lds_publish(cnts + (wid - 4), blk + 1);
        }
    }
    __syncthreads();
}

constexpr int CH = 16, NCHK = PTOT / CH;
constexpr int NPREP = 6, NSLOT = 2;
constexpr int TKS = 72, KTS = 20, SMS = 20;
constexpr int SL_PT = 0, SL_QM = SL_PT + 64 * TKS * 2, SL_RT = SL_QM + 64 * KTS * 2, SL_G2 = SL_RT + 16 * TKS * 2, SL_VT = SL_G2 + 16 * SMS * 2, SL_WC = SL_VT + 16 * SMS * 2,
              SLOT_BYTES = SL_WC + 64 * 4;
constexpr int XTK_B = 16 * TKS * 2, XKT_B = 64 * KTS * 2, SM_B = 16 * SMS * 2;
constexpr int PR_XA = 0, PR_XB = PR_XA + XTK_B, PR_XK = PR_XB + XTK_B, PR_XR = PR_XK + XTK_B, PR_TA = PR_XR + XTK_B, PR_TB = PR_TA + XKT_B, PR_TK = PR_TB + XKT_B,
              PR_SN = PR_TK + XKT_B, PREP_BYTES = PR_SN + 6 * SM_B;
static_assert(9 * SM_B <= 3 * XTK_B, "T/G matrices fit in XA..XK");
constexpr int SC2_SMEM = NSLOT * SLOT_BYTES + NPREP * PREP_BYTES + 64;
typedef short s16x4v __attribute__((ext_vector_type(4)));
DI f32x4 mfma16(s16x4v a, s16x4v b, f32x4 c) { return __builtin_amdgcn_mfma_f32_16x16x16bf16_1k(a, b, c, 0, 0, 0); }
DI f32x4 mfma32(bf16x8 a, bf16x8 b, f32x4 c) { return __builtin_amdgcn_mfma_f32_16x16x32_bf16(a, b, c, 0, 0, 0); }
DI s16x4v ld4(const bf16_t* q) { return *(const s16x4v*)q; }
DI f32x4 up4(u32x2 w) { return (f32x4){bf_lo(w[0]), bf_hi(w[0]), bf_lo(w[1]), bf_hi(w[1])}; }
DI f32x4 ld4f(const bf16_t* q) { return up4(*(const u32x2*)q); }
DI void st4(bf16_t* q, f32x4 v) { u32x2 w; w[0] = pk_bf16(v[0], v[1]); w[1] = pk_bf16(v[2], v[3]); *(u32x2*)q = w; }
#define LDS_WAIT() asm volatile("s_waitcnt lgkmcnt(0)" ::: "memory")
template <int CTRL> DI float dpp_shr_add(float v) { return v + __builtin_bit_cast(float, __builtin_amdgcn_update_dpp(0, __builtin_bit_cast(int, v), CTRL, 0xf, 0xf, true)); }
DI float row16_prefix(float v) { v = dpp_shr_add<0x111>(v); v = dpp_shr_add<0x112>(v); v = dpp_shr_add<0x114>(v); v = dpp_shr_add<0x118>(v); return v; }
DI f32x4 mm16(const bf16_t* A, const bf16_t* Bt, int fr, int fq) {
    const s16x4v a = ld4(A + fr * SMS + fq * 4), b = ld4(Bt + fr * SMS + fq * 4);
    LDS_WAIT();
    return mfma16(a, b, (f32x4){0.f, 0.f, 0.f, 0.f});
}
DI f32x4 mm16p(const bf16_t* A, const bf16_t* Bt, const bf16_t* Add, int fr, int fq) {
    const s16x4v a = ld4(A + fr * SMS + fq * 4), b = ld4(Bt + fr * SMS + fq * 4);
    const u32x2 c = *(const u32x2*)(Add + fr * SMS + fq * 4);
    LDS_WAIT();
    return mfma16(a, b, up4(c));
}

DI void scan_unit_chunked(const Params& p, int u, char* smem) {
    const int t = threadIdx.x, lane = t & 63, wid = __builtin_amdgcn_readfirstlane(t >> 6);
    const unsigned rg = u & 3, dir = (u >> 2) & 1, hd = (u >> 3) & 15, b = u >> 7;
    const unsigned tokb = b * PTOT, hc = hd * 64;
    const unsigned fr = lane & 15, fq = lane >> 4;
    char* slots = smem;
    char* prep0 = smem + NSLOT * SLOT_BYTES;
    int* cnts = (int*)(smem + NSLOT * SLOT_BYTES + NPREP * PREP_BYTES);
    const bf16_t* R = (const bf16_t*)(p.ws + OFF_SCR + S_R);
    const bf16_t* Kk = (const bf16_t*)(p.ws + OFF_SCR + S_KK);
    const bf16_t* V = (const bf16_t*)(p.ws + OFF_SCR + S_V);
    const bf16_t* LW = (const bf16_t*)(p.ws + OFF_SCR + S_LW);
    const bf16_t* LA = (const bf16_t*)(p.ws + OFF_SCR + S_LA);
    bf16_t* Yo = dir ? (bf16_t*)(p.ws + OFF_SCR + S_Y1) : (bf16_t*)(p.ws + OFF_H);
    float* bonus = (float*)(p.ws + OFF_BONUS2);
    if (t < 16) cnts[t] = 0;
    __syncthreads();

    if (wid == 0) {
        __builtin_amdgcn_s_setprio(3);
        f32x4 st[4];
#pragma unroll
        for (int m = 0; m < 4; ++m) st[m] = (f32x4){0.f, 0.f, 0.f, 0.f};
        for (int c = 0; c < NCHK; ++c) {
            const unsigned sl = (unsigned)c % NSLOT;
            const char* S = slots + sl * SLOT_BYTES;
            while (*(volatile LAS int*)(cnts + sl) < c + 1) __builtin_amdgcn_s_sleep(1);
            LDS_WAIT();
            const s16x4v vt = ld4((const bf16_t*)(S + SL_VT) + fr * SMS + fq * 4);
            const s16x4v g2 = ld4((const bf16_t*)(S + SL_G2) + fr * SMS + fq * 4);
            s16x4v rtl[2], rth[2], ptl[4][2], pth[4][2], qm[4];
            f32x4 wc[4];
#pragma unroll
            for (int i = 0; i < 2; ++i) { const bf16_t* q = (const bf16_t*)(S + SL_RT) + fr * TKS + 32 * i + fq * 4; rtl[i] = ld4(q); rth[i] = ld4(q + 16); }
#pragma unroll
            for (int m = 0; m < 4; ++m) {
                wc[m] = *(const f32x4*)((const float*)(S + SL_WC) + 16 * m + fq * 4);
                qm[m] = ld4((const bf16_t*)(S + SL_QM) + (16 * m + fr) * KTS + fq * 4);
#pragma unroll
                for (int i = 0; i < 2; ++i) { const bf16_t* q = (const bf16_t*)(S + SL_PT) + (16 * m + fr) * TKS + 32 * i + fq * 4; ptl[m][i] = ld4(q); pth[m][i] = ld4(q + 16); }
            }
            LDS_WAIT();
            if (lane == 0) *(volatile LAS int*)(cnts + 8) = c + 1;
            bf16x8 sb[2];
#pragma unroll
            for (int i = 0; i < 2; ++i) {
                u32x4 w; w[0] = pk_bf16(st[2 * i][0], st[2 * i][1]); w[1] = pk_bf16(st[2 * i][2], st[2 * i][3]); w[2] = pk_bf16(st[2 * i + 1][0], st[2 * i + 1][1]); w[3] = pk_bf16(st[2 * i + 1][2], st[2 * i + 1][3]);
                sb[i] = __builtin_bit_cast(bf16x8, w);
            }
            f32x4 y = {0.f, 0.f, 0.f, 0.f};
#pragma unroll
            for (int i = 0; i < 2; ++i) y = mfma32(__builtin_shufflevector(rtl[i], rth[i], 0, 1, 2, 3, 4, 5, 6, 7), sb[i], y);
            y = mfma16(g2, vt, y);
#pragma unroll
            for (int m = 0; m < 4; ++m) {
                f32x4 acc = st[m] * wc[m];
#pragma unroll
                for (int i = 0; i < 2; ++i) acc = mfma32(__builtin_shufflevector(ptl[m][i], pth[m][i], 0, 1, 2, 3, 4, 5, 6, 7), sb[i], acc);
                st[m] = mfma16(qm[m], vt, acc);
            }

#pragma unroll
            for (int j = 0; j < 4; ++j) {
                const unsigned tok = tokb + scan_pos(c * CH + fq * 4 + j, dir);
                Yo[tok * 1024u + hc + rg * 16 + fr] = (bf16_t)(pk_bf16(y[j], 0.f) & 0xffffu);
            }
        }
        __builtin_amdgcn_s_setprio(0);
    } else if (wid == 4) {
    } else {
        const unsigned pid = wid < 4 ? wid - 1 : wid - 2;
        char* PS = prep0 + pid * PREP_BYTES;
        bf16_t* XA = (bf16_t*)(PS + PR_XA); bf16_t* XB = (bf16_t*)(PS + PR_XB); bf16_t* XK = (bf16_t*)(PS + PR_XK); bf16_t* XR = (bf16_t*)(PS + PR_XR);
        bf16_t* TA = (bf16_t*)(PS + PR_TA); bf16_t* TB_ = (bf16_t*)(PS + PR_TB); bf16_t* TK = (bf16_t*)(PS + PR_TK); bf16_t* AT = TA;
        bf16_t* SN = (bf16_t*)(PS + PR_SN);
        bf16_t *M = SN, *NABR = SN + 1 * 16 * SMS, *IM = SN + 2 * 16 * SMS, *NAKR = SN + 3 * 16 * SMS, *NRBT = SN + 4 * 16 * SMS, *NRKT = SN + 5 * 16 * SMS;
        bf16_t *M2 = XA, *M2T = XA + 1 * 16 * SMS, *M4 = XA + 2 * 16 * SMS, *M4T = XA + 3 * 16 * SMS, *X1 = XA + 4 * 16 * SMS, *M8T = XA + 5 * 16 * SMS, *X2 = XA + 6 * 16 * SMS,
                *TT = XA + 7 * 16 * SMS, *G1 = XA + 8 * 16 * SMS;
        float* WCP = (float*)SN;
        const bf16_t* wsm = (const bf16_t*)(p.ws + OFF_WS);
        const unsigned wo = W_W2 + dir * 65536u + (hc + fr) * 64u + fq * 8u;
        const unsigned ao = W_A2 + dir * 65536u + (hc + fr) * 64u + fq * 8u;
        const unsigned po = hc + fq * 4u;
        const f32x4 z4 = {0.f, 0.f, 0.f, 0.f};
        bf16x8 lwf[2], laf[2], lwn[2], lan[2];
        u32x2 krw[4], rrw[4], krn[4], rrn[4];
        unsigned tok_cur = 0, tok_nxt = 0;
        auto issue = [&](int c, bf16x8 (&lw)[2], bf16x8 (&la)[2], u32x2 (&kw)[4], u32x2 (&rw)[4], unsigned& tk) {
            tk = tokb + scan_pos(c * CH + fr, dir);
            const unsigned lo = tk * 128u + dir * 64u + fq * 8u, ro = tk * 1024u + hc + fq * 4u;
#pragma unroll
            for (int kk = 0; kk < 2; ++kk) { lw[kk] = *(const bf16x8*)(LW + lo + kk * 32); la[kk] = *(const bf16x8*)(LA + lo + kk * 32); }
#pragma unroll
            for (int nt = 0; nt < 4; ++nt) { kw[nt] = *(const u32x2*)(Kk + ro + nt * 16); rw[nt] = *(const u32x2*)(R + ro + nt * 16); }
        };
        if ((int)pid < NCHK) issue(pid, lwf, laf, krw, rrw, tok_cur);
        for (int c = pid; c < NCHK; c += NPREP) {
            if (c + NPREP < NCHK) issue(c + NPREP, lwn, lan, krn, rrn, tok_nxt);
            const unsigned tok = tok_cur;
            float ssq = 0.f;
            f32x4 kr[4];
#pragma unroll
            for (int nt = 0; nt < 4; ++nt) {
                const f32x4 kkv = *(const f32x4*)(p.rwkv_k_k + po + nt * 16);
                kr[nt] = up4(krw[nt]);
                const f32x4 q = kr[nt] * kkv;
                ssq += q[0] * q[0] + q[1] * q[1] + q[2] * q[2] + q[3] * q[3];
            }
            ssq += __shfl_xor(ssq, 16); ssq += __shfl_xor(ssq, 32);
            const float kn = __builtin_amdgcn_rsqf(fmaxf(ssq, 1e-24f));
            float bsum = 0.f;
#pragma unroll
            for (int nt = 0; nt < 4; ++nt) {
                f32x4 aw = z4, ai = z4;
#pragma unroll
                for (int kk = 0; kk < 2; ++kk) {
                    const bf16x8 w2f = *(const bf16x8*)(wsm + wo + nt * 1024 + kk * 32), a2f = *(const bf16x8*)(wsm + ao + nt * 1024 + kk * 32);
                    aw = mfma32(w2f, lwf[kk], aw);
                    ai = mfma32(a2f, laf[kk], ai);
                }
                const f32x4 w0v = *(const f32x4*)(p.rwkv_decay_w0 + dir * 1024u + po + nt * 16), a0v = *(const f32x4*)(p.rwkv_iclr_a0 + dir * 1024u + po + nt * 16);
                const f32x4 kkv = *(const f32x4*)(p.rwkv_k_k + po + nt * 16);
                const f32x4 kav = *(const f32x4*)(p.rwkv_k_a + po + nt * 16), rkv = *(const f32x4*)(p.rwkv_r_k + po + nt * 16);
                const f32x4 rr = up4(rrw[nt]);
                f32x4 at, rt, bt, kt;
#pragma unroll
                for (int j = 0; j < 4; ++j) {
                    const float e = 0.6065306597126334f * __builtin_amdgcn_rcpf(1.0f + __builtin_amdgcn_exp2f(-(w0v[j] + aw[j]) * LOG2E));
                    const float ic = __builtin_amdgcn_rcpf(1.0f + __builtin_amdgcn_exp2f(-(a0v[j] + ai[j]) * LOG2E));
                    const float kkn = kr[nt][j] * kkv[j] * kn;
                    const float kd = kr[nt][j] * (1.0f + (ic - 1.0f) * kav[j]);
                    bsum += rr[j] * kd * rkv[j];
                    const float ec = row16_prefix(e);
                    const float wt = __builtin_amdgcn_exp2f(-ec * LOG2E);
                    const float wi = __builtin_amdgcn_exp2f(ec * LOG2E);
                    const float wp = __builtin_amdgcn_exp2f((e - ec) * LOG2E);
                    at[j] = -kkn * wp; rt[j] = rr[j] * wt; bt[j] = kkn * ic * wi; kt[j] = kd * wi;
                    TA[(nt * 16 + fq * 4 + j) * KTS + fr] = (bf16_t)(pk_bf16(at[j], 0.f) & 0xffffu);
                    TB_[(nt * 16 + fq * 4 + j) * KTS + fr] = (bf16_t)(pk_bf16(bt[j], 0.f) & 0xffffu);
                    TK[(nt * 16 + fq * 4 + j) * KTS + fr] = (bf16_t)(pk_bf16(kt[j], 0.f) & 0xffffu);
                    if (fr == 15) WCP[nt * 16 + fq * 4 + j] = wt;
                }
                st4(XA + fr * TKS + nt * 16 + fq * 4, at); st4(XR + fr * TKS + nt * 16 + fq * 4, rt);
                st4(XB + fr * TKS + nt * 16 + fq * 4, bt); st4(XK + fr * TKS + nt * 16 + fq * 4, kt);
            }
            bsum += __shfl_xor(bsum, 16); bsum += __shfl_xor(bsum, 32);
            if (rg == 0 && fq == 0) { bonus[((0 * 2 + dir) * TTOT + tok) * 16u + hd] = bsum; bonus[((1 * 2 + dir) * TTOT + tok) * 16u + hd] = 0.f; }
            LDS_WAIT();
            float wcr[4];
#pragma unroll
            for (int n = 0; n < 4; ++n) wcr[n] = WCP[16 * n + fr];
            bf16x8 fa[2], fb[2], fk[2], frr[2];
#pragma unroll
            for (int kk = 0; kk < 2; ++kk) {
                fa[kk] = *(const bf16x8*)(XA + fr * TKS + kk * 32 + fq * 8); fb[kk] = *(const bf16x8*)(XB + fr * TKS + kk * 32 + fq * 8);
                fk[kk] = *(const bf16x8*)(XK + fr * TKS + kk * 32 + fq * 8); frr[kk] = *(const bf16x8*)(XR + fr * TKS + kk * 32 + fq * 8);
            }
            LDS_WAIT();
            f32x4 d1 = z4, d2 = z4, d3 = z4, d4 = z4, d5 = z4;
#pragma unroll
            for (int kk = 0; kk < 2; ++kk) {
                d1 = mfma32(fb[kk], fa[kk], d1);
                d2 = mfma32(fa[kk], fb[kk], d2);
                d3 = mfma32(fa[kk], fk[kk], d3);
                d4 = mfma32(fb[kk], frr[kk], d4);
                d5 = mfma32(fk[kk], frr[kk], d5);
            }
            f32x4 im;
#pragma unroll
            for (int j = 0; j < 4; ++j) {
                const unsigned ij = fq * 4 + j;
                d1[j] = ij < fr ? d1[j] : 0.f;
                d2[j] = fr < ij ? d2[j] : 0.f;
                d3[j] = fr < ij ? d3[j] : 0.f;
                d4[j] = ij <= fr ? d4[j] : 0.f;
                d5[j] = ij <= fr ? d5[j] : 0.f;
                im[j] = d1[j] + (ij == fr ? 1.0f : 0.f);
            }
            st4(M + fr * SMS + fq * 4, d1);
            st4(IM + fr * SMS + fq * 4, im);
            st4(NABR + fr * SMS + fq * 4, d2);
            st4(NAKR + fr * SMS + fq * 4, d3);
            st4(NRBT + fr * SMS + fq * 4, d4);
            st4(NRKT + fr * SMS + fq * 4, d5);
            LDS_WAIT();
            const int so = fr * SMS + fq * 4;
            {
                const s16x4v m = ld4(M + so), mt = ld4(NABR + so);
                LDS_WAIT();
                st4(M2T + so, mfma16(m, mt, z4)); st4(M2 + so, mfma16(mt, m, z4));
                LDS_WAIT();
            }
            {
                const s16x4v m2 = ld4(M2 + so), m2t = ld4(M2T + so); const u32x2 imr = *(const u32x2*)(IM + so);
                LDS_WAIT();
                st4(M4T + so, mfma16(m2, m2t, z4)); st4(M4 + so, mfma16(m2t, m2, z4));
                st4(X1 + so, mfma16(m2t, __builtin_bit_cast(s16x4v, imr), up4(imr)));
                LDS_WAIT();
            }
            {
                const s16x4v m4 = ld4(M4 + so), m4t = ld4(M4T + so); const u32x2 x1r = *(const u32x2*)(X1 + so);
                LDS_WAIT();
                st4(M8T + so, mfma16(m4, m4t, z4));
                st4(X2 + so, mfma16(m4t, __builtin_bit_cast(s16x4v, x1r), up4(x1r)));
                LDS_WAIT();
            }
            {
                const s16x4v m8t = ld4(M8T + so); const u32x2 x2r = *(const u32x2*)(X2 + so);
                LDS_WAIT();
                st4(TT + so, mfma16(m8t, __builtin_bit_cast(s16x4v, x2r), up4(x2r)));
                LDS_WAIT();
            }
            {
                const s16x4v ta = ld4(TT + so), nk = ld4(NAKR + so);
                s16x4v xa[4];
#pragma unroll
                for (int n = 0; n < 4; ++n) xa[n] = ld4(TA + (16 * n + fr) * KTS + fq * 4);
                LDS_WAIT();
                st4(G1 + so, mfma16(ta, nk, z4));
#pragma unroll
                for (int n = 0; n < 4; ++n) st4(AT + (16 * n + fr) * KTS + fq * 4, mfma16(ta, xa[n], z4));
                LDS_WAIT();
            }
            const unsigned sl = (unsigned)c % NSLOT;
            char* S = slots + sl * SLOT_BYTES;
            {
                unsigned vv[2][2];
#pragma unroll
                for (int i = 0; i < 2; ++i) {
                    const unsigned q = i * 64 + lane, vrow = q & 15, sp = q >> 4;
                    const unsigned tk0 = tokb + scan_pos(c * CH + 2 * sp, dir), tk1 = tokb + scan_pos(c * CH + 2 * sp + 1, dir);
                    vv[i][0] = V[tk0 * 1024u + hc + rg * 16 + vrow]; vv[i][1] = V[tk1 * 1024u + hc + rg * 16 + vrow];
                }
                const s16x4v nrb = ld4(NRBT + so), g1 = ld4(G1 + so);
                const u32x2 nrk = *(const u32x2*)(NRKT + so);
                s16x4v atm[4], tb[4]; u32x2 xr[4], tk[4];
#pragma unroll
                for (int m = 0; m < 4; ++m) {
                    atm[m] = ld4(AT + (16 * m + fr) * KTS + fq * 4); tb[m] = ld4(TB_ + (16 * m + fr) * KTS + fq * 4);
                    xr[m] = *(const u32x2*)(XR + fr * TKS + 16 * m + fq * 4); tk[m] = *(const u32x2*)(TK + (16 * m + fr) * KTS + fq * 4);
                }
                LDS_WAIT();
                while (*(volatile LAS int*)(cnts + 8) < c - NSLOT + 1) __builtin_amdgcn_s_sleep(1);
                asm volatile("" ::: "memory");
                st4((bf16_t*)(S + SL_G2) + so, mfma16(g1, nrb, up4(nrk)));
#pragma unroll
                for (int m = 0; m < 4; ++m) {
                    st4((bf16_t*)(S + SL_RT) + fr * TKS + 16 * m + fq * 4, mfma16(atm[m], nrb, up4(xr[m])));
#pragma unroll
                    for (int n = 0; n < 4; ++n) st4((bf16_t*)(S + SL_PT) + (16 * n + fr) * TKS + 16 * m + fq * 4, mfma16(atm[m], tb[n], z4) * wcr[n]);
                }
#pragma unroll
                for (int n = 0; n < 4; ++n) st4((bf16_t*)(S + SL_QM) + (16 * n + fr) * KTS + fq * 4, mfma16(g1, tb[n], up4(tk[n])) * wcr[n]);
                ((float*)(S + SL_WC))[lane] = (fq == 0) ? wcr[0] : (fq == 1) ? wcr[1] : (fq == 2) ? wcr[2] : wcr[3];
#pragma unroll
                for (int i = 0; i < 2; ++i) {
                    const unsigned q = i * 64 + lane, vrow = q & 15, sp = q >> 4;
                    *(unsigned*)((bf16_t*)(S + SL_VT) + vrow * SMS + 2 * sp) = vv[i][0] | (vv[i][1] << 16);
                }
            }
            LDS_WAIT();
            if (lane == 0) *(volatile LAS int*)(cnts + sl) = c + 1;
#pragma unroll
            for (int kk = 0; kk < 2; ++kk) { lwf[kk] = lwn[kk]; laf[kk] = lan[kk]; }
#pragma unroll
            for (int nt = 0; nt < 4; ++nt) { krw[nt] = krn[nt]; rrw[nt] = rrn[nt]; }
            tok_cur = tok_nxt;
        }
    }
    __syncthreads();
}

DI void phase_scan(const Params& p, char* smem) {
    for (int u = blockIdx.x; u < NBATCH * 16 * 2 * 4; u += gridDim.x) scan_unit_chunked(p, u, smem);
}

constexpr int NPHASE = 18;
constexpr int SMEM_BYTES = (SC2_SMEM > SC_SMEM ? SC2_SMEM : SC_SMEM) + 64;
static_assert(SMEM_BYTES >= GEMM_SMEM + 64 && SMEM_BYTES + 16 <= 163840, "LDS");
template <int PH> DI void run_phase(const Params& p, char* smem) {
    if constexpr (PH == 0) phase_prologue(p, smem);
    else if constexpr (PH == 1) phase_norm0(p);
    else if constexpr (PH == 2) phase_qkv(p, smem);
    else if constexpr (PH == 3) phase_attn(p, smem);
    else if constexpr (PH == 4) phase_wout(p, smem);
    else if constexpr (PH == 5) phase_ffn_norm_route(p, 0, smem);
    else if constexpr (PH == 6) phase_moe1(p, 0, smem);
    else if constexpr (PH == 7) phase_moe2(p, 0, smem);
    else if constexpr (PH == 8) phase_combine_l0(p, smem);
    else if constexpr (PH == 9) phase_xx(p);
    else if constexpr (PH == 10) phase_rwkv_proj(p, smem);
    else if constexpr (PH == 11) phase_scan(p, smem);
    else if constexpr (PH == 12) phase_gate(p, smem);
    else if constexpr (PH == 13) phase_wo(p, smem);
    else if constexpr (PH == 14) phase_ffn_norm_route(p, 1, smem);
    else if constexpr (PH == 15) phase_moe1(p, 1, smem);
    else if constexpr (PH == 16) phase_moe2(p, 1, smem);
    else if constexpr (PH == 17) phase_final(p);
}
template <int PH, int END> struct PhaseSeq {
    static DI void run(const Params& p, char* smem, const XcdBarrier& bar) {
        run_phase<PH>(p, smem);
        if constexpr (PH + 1 < END) { xcd_barrier(bar); PhaseSeq<PH + 1, END>::run(p, smem, bar); }
    }
};
template <int BEG, int END>
__global__ void __launch_bounds__(NTH, 2) fwd_kernel(Params p) {
    extern __shared__ __attribute__((aligned(16))) char smem_raw[];
    char* smem = smem_raw + 16;
    if constexpr (END - BEG > 1) {
        if (threadIdx.x == 0) *(uint4*)smem_raw = make_uint4(0u, 0u, 0u, 0u);
        __syncthreads();
        XcdBarrier bar = xcd_barrier_post((unsigned*)(p.ws + OFF_BAR), (volatile LAS unsigned*)smem_raw);
        PhaseSeq<BEG, END>::run(p, smem, bar);
    } else {
        run_phase<BEG>(p, smem);
    }
}

template <int BEG, int END> static void launch_range(const Params& p, int grid, hipStream_t stream) {
    (void)hipFuncSetAttribute((const void*)fwd_kernel<BEG, END>, hipFuncAttributeMaxDynamicSharedMemorySize, SMEM_BYTES + 16);
    hipLaunchKernelGGL((fwd_kernel<BEG, END>), dim3(grid), dim3(NTH), SMEM_BYTES + 16, stream, p);
}
#ifndef RUN_PHASES
#define RUN_PHASES NPHASE
#endif
#ifndef REPEAT_PHASE
#define REPEAT_PHASE -1
#endif
template <int PH> static void launch_each(const Params& p, int grid, hipStream_t stream) {
    launch_range<PH, PH + 1>(p, grid, stream);
    if (PH == REPEAT_PHASE) launch_range<PH, PH + 1>(p, grid, stream);
    if constexpr (PH + 1 < RUN_PHASES) launch_each<PH + 1>(p, grid, stream);
}

extern "C" void kernel_launch(void* const* d_in, const int* in_sizes, int n_in, void* d_out, int out_size, void* d_ws, size_t ws_size, hipStream_t stream) {
    Params p{};
    const float** f = (const float**)&p;
    for (int i = 0; i < 37; ++i) f[i] = (const float*)d_in[i];
    p.out = (float*)d_out;
    p.ws = (char*)d_ws;
    if (ws_size < WS_NEED || n_in < 37) return;
    static int grid = 0;
    if (!grid) {
        int dev = 0, cus = 0;
        (void)hipGetDevice(&dev);
        (void)hipDeviceGetAttribute(&cus, hipDeviceAttributeMultiprocessorCount, dev);
        grid = cus > 0 ? cus : 256;
    }
    (void)hipMemsetAsync(d_ws, 0, 32768, stream);
#if MEGA
    launch_range<0, NPHASE>(p, grid, stream);
#else
    launch_each<0>(p, grid, stream);
#endif
}
```

```cpp
#include <hip/hip_runtime.h>
#include <stdint.h>
#include <stdio.h>

#ifndef MEGA
#define MEGA 1
#endif

typedef unsigned short bf16_t;
typedef short bf16x8 __attribute__((ext_vector_type(8)));
typedef short s16x4 __attribute__((ext_vector_type(4)));
typedef float f32x2 __attribute__((ext_vector_type(2)));
typedef float f32x4 __attribute__((ext_vector_type(4)));
typedef float f32x16 __attribute__((ext_vector_type(16)));
typedef unsigned u32x2 __attribute__((ext_vector_type(2)));
typedef unsigned u32x4 __attribute__((ext_vector_type(4)));
typedef __bf16 bf16x2_t __attribute__((ext_vector_type(2)));
#define DI __device__ __forceinline__
__device__ __forceinline__ unsigned tidx() { unsigned t = threadIdx.x; asm volatile("" : "+v"(t)); return t; }

constexpr int DM = 1024, NBATCH = 2, SEQ = 16384, LCTX = 256, PTOT = SEQ + LCTX, TTOT = NBATCH * PTOT;
constexpr int NTH = 512, NWAVE = 8;
constexpr int QKV_N = 1536;
constexpr int NEXP = 16, CAP = TTOT * 2;
constexpr float RMS_EPS = 1e-6f, GN_EPS = 64e-5f;
constexpr float LOG2E = 1.4426950408889634f;

constexpr size_t MBy = 1u << 20;
constexpr size_t OFF_BAR   = 0;
constexpr size_t OFF_CNT   = 16384;
constexpr size_t OFF_MOD   = 32768;
constexpr size_t OFF_ROPE  = OFF_MOD + 2 * 3 * 6144 * 4;
constexpr size_t OFF_BONUS = 1 * MBy;
constexpr size_t OFF_BONUS2 = 6 * MBy;
constexpr size_t OFF_STOK  = 6 * MBy;
constexpr size_t OFF_SW    = 11 * MBy;
constexpr size_t OFF_XC    = 16 * MBy;
constexpr size_t OFF_WS    = 18 * MBy;
constexpr size_t OFF_MOEW  = 33 * MBy;
constexpr size_t OFF_H     = 129 * MBy;
constexpr size_t OFF_SCR   = 194 * MBy;
constexpr size_t SCR_SIZE  = 290 * MBy;
constexpr size_t WS_NEED   = OFF_SCR + SCR_SIZE;
constexpr size_t W_IN = 0, W_OUT = W_IN + 1536 * 1024, W_R = W_OUT + 1024 * 1024, W_K = W_R + 1024 * 1024, W_V = W_K + 1024 * 1024,
                 W_O = W_V + 1024 * 1024, W_W1 = W_O + 1024 * 1024, W_A1 = W_W1 + 128 * 1024, W_G1 = W_A1 + 128 * 1024,
                 W_W2 = W_G1 + 256 * 1024, W_A2 = W_W2 + 2 * 1024 * 64, W_G2 = W_A2 + 2 * 1024 * 64, W_END = W_G2 + 1024 * 192;
static_assert(W_END * 2 <= 15 * MBy, "small weights region");
constexpr size_t ROWB = (size_t)TTOT * 2048;
constexpr size_t S_Q = 0, S_K = S_Q + ROWB, S_VT = S_K + ROWB / 4, S_O = S_VT + ROWB / 4;
constexpr size_t S_HID = 0, S_Y = 140 * MBy;
constexpr size_t S_R = 0, S_KK = S_R + ROWB, S_V = S_KK + ROWB, S_LW = S_V + ROWB, S_LA = S_LW + ROWB / 8, S_LG = S_LA + ROWB / 8,
                 S_Y1 = 224 * MBy, S_XX = S_Y1, S_OR = S_R;
static_assert(S_O + ROWB <= SCR_SIZE, "scr");
static_assert(S_LG + (size_t)TTOT * 384 <= S_Y1, "scr2");
static_assert(S_Y1 + ROWB <= SCR_SIZE, "scr3");
static_assert(S_Y + 2 * ROWB <= SCR_SIZE, "scr4");
static_assert((size_t)(CAP / 256 + 16) * 256 * 2048 <= S_Y, "hid");
static_assert(OFF_H + ROWB <= OFF_SCR, "h");

struct Params {
    const float *x, *c, *ctx, *c_ctx, *ada_w, *ada_b, *norm_mix_g, *norm_ffn_g, *attn_w_in, *attn_w_out, *attn_sink, *attn_q_norm_g, *attn_k_norm_g,
        *rwkv_x_mix, *rwkv_w_r, *rwkv_w_k, *rwkv_w_v, *rwkv_w_o, *rwkv_decay_w0, *rwkv_decay_w1, *rwkv_decay_w2, *rwkv_iclr_a0, *rwkv_iclr_a1,
        *rwkv_iclr_a2, *rwkv_gate_g1, *rwkv_gate_g2, *rwkv_k_k, *rwkv_k_a, *rwkv_r_k, *rwkv_ln_g, *rwkv_ln_b, *router_w, *router_bias, *moe_w1,
        *moe_w3, *moe_w2, *final_norm_g;
    float* out;
    char* ws;
};

DI unsigned pk_bf16(float a, float b) { f32x2 v = {a, b}; bf16x2_t r = __builtin_convertvector(v, bf16x2_t); return __builtin_bit_cast(unsigned, r); }
DI float bf_lo(unsigned u) { return __uint_as_float(u << 16); }
DI float bf_hi(unsigned u) { return __uint_as_float(u & 0xffff0000u); }
DI float bf2f(bf16_t u) { return __uint_as_float(((unsigned)u) << 16); }
DI float wave_sum(float v) {
#pragma unroll
    for (int o = 32; o >= 1; o >>= 1) v += __shfl_xor(v, o);
    return v;
}
DI float sigmoidf_(float x) { return 1.0f / (1.0f + __expf(-x)); }
DI float siluf_(float x) { return x / (1.0f + __expf(-x)); }
DI float* xrow_ptr(const Params& p, int tok) {
    const int b = tok >= PTOT ? 1 : 0, pos = tok - b * PTOT;
    return pos < LCTX ? (float*)(p.ws + OFF_XC) + (size_t)(b * LCTX + pos) * DM : p.out + (size_t)(b * SEQ + pos - LCTX) * DM;
}
DI const float* xin_ptr(const Params& p, int tok) {
    const int b = tok >= PTOT ? 1 : 0, pos = tok - b * PTOT;
    return pos < LCTX ? p.ctx + (size_t)(b * LCTX + pos) * DM : p.x + (size_t)(b * SEQ + pos - LCTX) * DM;
}
DI const float* mod_ptr(const Params& p, int layer, int tok, int which) {
    const int b = tok >= PTOT ? 1 : 0, pos = tok - b * PTOT;
    const int w = pos < LCTX ? 2 : b;
    return (const float*)(p.ws + OFF_MOD) + (size_t)((layer * 3 + w) * 6 + which) * DM;
}

#define XB_TMO      128
#define XB_XCNT(j)  (256  + 64 * (j))
#define XB_XSUB(j)  (1280 + 64 * (j))
#define XB_XGEN(j)  (2304 + 64 * (j))
#define XB_TOP      3328
#define XB_TOPGEN   3392
#define XCD_BAR_WORDS 3456
#define XB_SPIN_CAP (1u << 18)
#define LAS __attribute__((address_space(3)))
DI unsigned xb_ld(unsigned* p)              { return __hip_atomic_load(p, __ATOMIC_RELAXED, __HIP_MEMORY_SCOPE_AGENT); }
DI unsigned xb_add(unsigned* p, unsigned v) { return __hip_atomic_fetch_add(p, v, __ATOMIC_RELAXED, __HIP_MEMORY_SCOPE_AGENT); }
DI unsigned xb_xcc_id() { return (unsigned)__builtin_amdgcn_s_getreg((3 << 11) | 20) & 0xFu; }
#define XB_SPIN(cond, bar) do { unsigned _sp = 0; while (cond) { __builtin_amdgcn_s_sleep(1); \
    if ((++_sp & 255u) == 0u) { if (xb_ld(&(bar)[XB_TMO])) break; if (_sp > XB_SPIN_CAP) { atomicAdd(&(bar)[XB_TMO], 1u); break; } } } } while (0)
struct XcdBarrier { unsigned* bar; unsigned x; volatile LAS unsigned* st; };
DI XcdBarrier xcd_barrier_post(unsigned* bar, volatile LAS unsigned* st) {
    XcdBarrier b; b.bar = bar; b.x = xb_xcc_id(); b.st = st;
    if (tidx() == 0) (void)xb_add(&bar[XB_XCNT(b.x)], 1u);
    return b;
}
DI void xcd_barrier_complete(unsigned* bar, unsigned x, unsigned& nloc, unsigned& nx) {
    const unsigned G = gridDim.x * gridDim.y * gridDim.z;
    unsigned sum, cnt, mine, sp = 0u;
    for (;;) {
        sum = 0u; cnt = 0u; mine = 0u;
#pragma unroll
        for (unsigned j = 0; j < 16; ++j) { const unsigned c = xb_ld(&bar[XB_XCNT(j)]); sum += c; cnt += (c > 0u) ? 1u : 0u; mine = (j == x) ? c : mine; }
        if (sum == G) break;
        __builtin_amdgcn_s_sleep(1);
        if ((++sp & 255u) == 0u) { if (xb_ld(&bar[XB_TMO])) break; if (sp > XB_SPIN_CAP) { atomicAdd(&bar[XB_TMO], 1u); break; } }
    }
    nloc = mine > 0u ? mine : 1u; nx = cnt > 0u ? cnt : 1u;
}
DI void xcd_barrier(const XcdBarrier& b) {
    asm volatile("s_waitcnt vmcnt(0)" ::: "memory");
    __syncthreads();
    if (tidx() == 0) {
        unsigned* bar = b.bar;
        __builtin_amdgcn_s_waitcnt(0);
        unsigned nloc = b.st[0], nx = b.st[1];
        if (nloc == 0u) { xcd_barrier_complete(bar, b.x, nloc, nx); b.st[0] = nloc; b.st[1] = nx; }
        const unsigned old = xb_add(&bar[XB_XSUB(b.x)], 1u);
        const unsigned gen = old / nloc;
        if (old + 1u == (gen + 1u) * nloc) {
            __builtin_amdgcn_fence(__ATOMIC_RELEASE, "agent");
            asm volatile("s_waitcnt vmcnt(0)" ::: "memory");
            const unsigned og = xb_add(&bar[XB_TOP], 1u);
            const unsigned tg = og / nx;
            if (og + 1u == (tg + 1u) * nx) xb_add(&bar[XB_TOPGEN], 1u);
            else XB_SPIN(xb_ld(&bar[XB_TOPGEN]) == tg, bar);
            __builtin_amdgcn_fence(__ATOMIC_ACQUIRE, "agent");
            xb_add(&bar[XB_XGEN(b.x)], 1u);
            asm volatile("s_waitcnt vmcnt(0)" ::: "memory");
        } else {
            XB_SPIN(xb_ld(&bar[XB_XGEN(b.x)]) == gen, bar);
            __builtin_amdgcn_fence(__ATOMIC_ACQUIRE, "agent");
            asm volatile("s_waitcnt vmcnt(0)" ::: "memory");
        }
    }
    __syncthreads();
}

DI void cvt_tile(const float* src, int ld, int kvalid, bool colvalid, bf16_t* dst, int dld, float* tile  ) {
    const int t = tidx();
    {
        const int k = t >> 3, c4 = (t & 7) * 4;
        f32x4 v = {0.f, 0.f, 0.f, 0.f};
        if (colvalid && k < kvalid) v = *(const f32x4*)(src + (size_t)k * ld + c4);
        tile[k * 33 + c4 + 0] = v[0]; tile[k * 33 + c4 + 1] = v[1]; tile[k * 33 + c4 + 2] = v[2]; tile[k * 33 + c4 + 3] = v[3];
    }
    __syncthreads();
    {
        const int n = t >> 4, kc = (t & 15) * 4;
        u32x2 w;
        w[0] = pk_bf16(tile[(kc + 0) * 33 + n], tile[(kc + 1) * 33 + n]);
        w[1] = pk_bf16(tile[(kc + 2) * 33 + n], tile[(kc + 3) * 33 + n]);
        *(u32x2*)(dst + (size_t)n * dld + kc) = w;
    }
    __syncthreads();
}
constexpr int CV_SMALL_UNITS = 768 + 512 * 5 + 64 + 64 + 128 + 64 + 64 + 96;
DI void cvt_small_unit(const Params& p, int u, float* tile) {
    bf16_t* wsm = (bf16_t*)(p.ws + OFF_WS);
    if (u < 768) { const int run = u >> 4, kt = u & 15; cvt_tile(p.attn_w_in + (size_t)kt * 64 * 1536 + run * 32, 1536, 64, true, wsm + W_IN + (size_t)run * 32 * 1024 + kt * 64, 1024, tile); return; }
    u -= 768;
    if (u < 512 * 5) {
        const int j = u >> 9, v = u & 511, run = v >> 4, kt = v & 15;
        const float* src = j == 0 ? p.attn_w_out : j == 1 ? p.rwkv_w_r : j == 2 ? p.rwkv_w_k : j == 3 ? p.rwkv_w_v : p.rwkv_w_o;
        const size_t dofs = j == 0 ? W_OUT : j == 1 ? W_R : j == 2 ? W_K : j == 3 ? W_V : W_O;
        cvt_tile(src + (size_t)kt * 64 * 1024 + run * 32, 1024, 64, true, wsm + dofs + (size_t)run * 32 * 1024 + kt * 64, 1024, tile); return;
    }
    u -= 512 * 5;
    if (u < 128) {
        const int j = u >> 6, v = u & 63, run = v >> 4, kt = v & 15, d = run >> 1, co = (run & 1) * 32;
        const float* src = (j == 0 ? p.rwkv_decay_w1 : p.rwkv_iclr_a1) + (size_t)d * 1024 * 64;
        cvt_tile(src + (size_t)kt * 64 * 64 + co, 64, 64, true, wsm + (j == 0 ? W_W1 : W_A1) + (size_t)run * 32 * 1024 + kt * 64, 1024, tile); return;
    }
    u -= 128;
    if (u < 128) {
        const int run = u >> 4, kt = u & 15;
        cvt_tile(p.rwkv_gate_g1 + (size_t)kt * 64 * 160 + run * 32, 160, 64, run < 5, wsm + W_G1 + (size_t)run * 32 * 1024 + kt * 64, 1024, tile); return;
    }
    u -= 128;
    if (u < 128) {
        const int j = u >> 6, v = u & 63, d = v >> 5, run = v & 31;
        const float* src = (j == 0 ? p.rwkv_decay_w2 : p.rwkv_iclr_a2) + (size_t)d * 64 * 1024;
        cvt_tile(src + run * 32, 1024, 64, true, wsm + (j == 0 ? W_W2 : W_A2) + (size_t)d * 1024 * 64 + (size_t)run * 32 * 64, 64, tile); return;
    }
    u -= 128;
    {
        const int run = u / 3, kt = u % 3;
        const int kvalid = 160 - kt * 64 > 64 ? 64 : (160 - kt * 64 < 0 ? 0 : 160 - kt * 64);
        cvt_tile(p.rwkv_gate_g2 + (size_t)kt * 64 * 1024 + run * 32, 1024, kvalid, true, wsm + W_G2 + (size_t)run * 32 * 192 + kt * 64, 192, tile);
    }
}
constexpr int CV_MOE_UNITS = 16 * (1024 + 512);
DI void cvt_moe_unit(const Params& p, int layer, int u, float* tile) {
    bf16_t* w13 = (bf16_t*)(p.ws + OFF_MOEW);
    bf16_t* w2t = w13 + (size_t)16 * 2048 * 1024;
    const int e = u / 1536, v = u % 1536;
    const size_t eo = (size_t)(layer * 16 + e) * 1024 * 1024;
    if (v < 1024) {
        const int run = v >> 4, kt = v & 15, g = run >> 1;
        const float* src = ((run & 1) ? p.moe_w3 : p.moe_w1) + eo;
        cvt_tile(src + (size_t)kt * 64 * 1024 + g * 32, 1024, 64, true, w13 + (size_t)e * 2048 * 1024 + (size_t)run * 32 * 1024 + kt * 64, 1024, tile);
    } else {
        const int w = v - 1024, run = w >> 4, kt = w & 15;
        cvt_tile(p.moe_w2 + eo + (size_t)kt * 64 * 1024 + run * 32, 1024, 64, true, w2t + (size_t)e * 1024 * 1024 + (size_t)run * 32 * 1024 + kt * 64, 1024, tile);
    }
}
DI void adaln_unit(const Params& p, int u, float* sm) {
    const int l = u / 96, n0 = (u % 96) * 64, t = tidx();
    float* sv = sm;
    float* red = sm + 3 * 1024;
    for (int i = t; i < 3 * 1024; i += NTH) { const int w = i >> 10, k = i & 1023; const float c = w < 2 ? p.c[w * 1024 + k] : p.c_ctx[k]; sv[i] = siluf_(c); }
    __syncthreads();
    const int kg = t >> 4, cl = t & 15;
    f32x4 a0 = {0, 0, 0, 0}, a1 = a0, a2 = a0;
    const float* W = p.ada_w + (size_t)l * 1024 * 6144 + n0 + cl * 4;
#pragma unroll 8
    for (int i = 0; i < 32; ++i) {
        const int k = kg + 32 * i;
        const f32x4 w = *(const f32x4*)(W + (size_t)k * 6144);
        a0 += w * sv[k]; a1 += w * sv[1024 + k]; a2 += w * sv[2048 + k];
    }
#pragma unroll
    for (int j = 0; j < 4; ++j) { red[kg * 192 + 0 * 64 + cl * 4 + j] = a0[j]; red[kg * 192 + 1 * 64 + cl * 4 + j] = a1[j]; red[kg * 192 + 2 * 64 + cl * 4 + j] = a2[j]; }
    __syncthreads();
    if (t < 192) {
        float s = 0.f;
        for (int g = 0; g < 32; ++g) s += red[g * 192 + t];
        const int w = t >> 6, n = n0 + (t & 63);
        ((float*)(p.ws + OFF_MOD))[(size_t)(l * 3 + w) * 6144 + n] = s + p.ada_b[l * 6144 + n];
    }
    __syncthreads();
}
DI void rope_unit(const Params& p, int u) {
    const int id = u * NTH + tidx();
    if (id < 320 * 16) {
        const int pi = id >> 4, f = id & 15;
        const float inv = exp2f(-(float)f * (13.287712379549449f / 16.0f));
        const float val = pi < 256 ? (float)pi : (float)(pi - 256);
        const float ang = val * inv;
        const double a = (double)ang;
        const double k = __builtin_rint(a * 0.15915494309189535);
        const float r = (float)(a - k * 6.283185307179586);
        f32x2 cs = {__cosf(r), __sinf(r)};
        ((f32x2*)(p.ws + OFF_ROPE))[id] = cs;
    }
}
DI void phase_prologue(const Params& p, char* smem) {
    float* sm = (float*)smem;
    const int nconv = CV_SMALL_UNITS + CV_MOE_UNITS;
    const int total = nconv + 192 + 10;
    for (int u = blockIdx.x; u < total; u += gridDim.x) {
        if (u < CV_SMALL_UNITS) cvt_small_unit(p, u, sm);
        else if (u < nconv) cvt_moe_unit(p, 0, u - CV_SMALL_UNITS, sm);
        else if (u < nconv + 192) adaln_unit(p, u - nconv, sm);
        else rope_unit(p, u - nconv - 192);
    }
}

DI void row_load(const float* src, f32x4 (&v)[4], int lane) {
#pragma unroll
    for (int i = 0; i < 4; ++i) v[i] = ((const f32x4*)src)[lane + 64 * i];
}
DI float row_rstd(const f32x4 (&v)[4]) {
    float ss = 0.f;
#pragma unroll
    for (int i = 0; i < 4; ++i) ss += v[i][0] * v[i][0] + v[i][1] * v[i][1] + v[i][2] * v[i][2] + v[i][3] * v[i][3];
    ss = wave_sum(ss);
    return rsqrtf(ss * (1.0f / DM) + RMS_EPS);
}
DI void row_norm_mod(const f32x4 (&v)[4], float rstd, const float* g, const float* shift, const float* scale, f32x4 (&h)[4], int lane) {
#pragma unroll
    for (int i = 0; i < 4; ++i) {
        const int c = (lane + 64 * i) * 4;
        const f32x4 g4 = *(const f32x4*)(g + c), sh = *(const f32x4*)(shift + c), sc = *(const f32x4*)(scale + c);
        h[i] = (v[i] * rstd * g4) * (1.0f + sc) + sh;
    }
}
DI void row_store_bf16(bf16_t* dst, const f32x4 (&h)[4], int lane) {
#pragma unroll
    for (int i = 0; i < 4; ++i) { u32x2 w; w[0] = pk_bf16(h[i][0], h[i][1]); w[1] = pk_bf16(h[i][2], h[i][3]); *(u32x2*)(dst + (lane + 64 * i) * 4) = w; }
}
DI void row_load_bf16(const bf16_t* src, f32x4 (&v)[4], int lane) {
#pragma unroll
    for (int i = 0; i < 4; ++i) { const u32x2 w = *(const u32x2*)(src + (lane + 64 * i) * 4); v[i][0] = bf_lo(w[0]); v[i][1] = bf_hi(w[0]); v[i][2] = bf_lo(w[1]); v[i][3] = bf_hi(w[1]); }
}

DI void phase_norm0(const Params& p) {
    const int lane = tidx() & 63, gw = blockIdx.x * NWAVE + (tidx() >> 6), nw = gridDim.x * NWAVE;
    bf16_t* H = (bf16_t*)(p.ws + OFF_H);
    for (int tok = gw; tok < TTOT; tok += nw) {
        f32x4 v[4], h[4];
        row_load(xin_ptr(p, tok), v, lane);
        const float rstd = row_rstd(v);
        row_norm_mod(v, rstd, p.norm_mix_g, mod_ptr(p, 0, tok, 0), mod_ptr(p, 0, tok, 1), h, lane);
        row_store_bf16(H + (size_t)tok * DM, h, lane);
    }
}

DI void route_row(const Params& p, const float (&lg)[16], int& e1, int& e2, float& g1, float& g2) {
    float mx = lg[0];
#pragma unroll
    for (int e = 1; e < 16; ++e) mx = fmaxf(mx, lg[e]);
    float pr[16], sum = 0.f;
#pragma unroll
    for (int e = 0; e < 16; ++e) { pr[e] = __expf(lg[e] - mx); sum += pr[e]; }
    const float inv = 1.0f / sum;
    float sel[16];
#pragma unroll
    for (int e = 0; e < 16; ++e) { pr[e] *= inv; sel[e] = pr[e] + p.router_bias[e]; }
    float best = -1e30f; int gi = 0;
#pragma unroll
    for (int g = 0; g < 4; ++g) {
        float m1 = -1e30f, m2 = -1e30f;
#pragma unroll
        for (int j = 0; j < 4; ++j) { const float s = sel[g * 4 + j]; if (s > m1) { m2 = m1; m1 = s; } else if (s > m2) m2 = s; }
        const float gs = m1 + m2;
        if (gs > best) { best = gs; gi = g; }
    }
    float s4[4], p4[4];
#pragma unroll
    for (int j = 0; j < 4; ++j) {
        s4[j] = gi == 0 ? sel[j] : gi == 1 ? sel[4 + j] : gi == 2 ? sel[8 + j] : sel[12 + j];
        p4[j] = gi == 0 ? pr[j] : gi == 1 ? pr[4 + j] : gi == 2 ? pr[8 + j] : pr[12 + j];
    }
    int i1 = 0; float b1 = s4[0];
#pragma unroll
    for (int j = 1; j < 4; ++j) if (s4[j] > b1) { b1 = s4[j]; i1 = j; }
    int i2 = i1 == 0 ? 1 : 0; float b2 = -3e38f;
#pragma unroll
    for (int j = 0; j < 4; ++j) if (j != i1 && s4[j] > b2) { b2 = s4[j]; i2 = j; }
    const float w1 = i1 == 0 ? p4[0] : i1 == 1 ? p4[1] : i1 == 2 ? p4[2] : p4[3];
    const float w2 = i2 == 0 ? p4[0] : i2 == 1 ? p4[1] : i2 == 2 ? p4[2] : p4[3];
    const float ws = 1.0f / (w1 + w2);
    e1 = gi * 4 + i1; e2 = gi * 4 + i2; g1 = w1 * ws; g2 = w2 * ws;
}
DI void phase_ffn_norm_route(const Params& p, int layer, char* smem) {
    const int lane = tidx() & 63, gw = blockIdx.x * NWAVE + (tidx() >> 6), nw = gridDim.x * NWAVE;
    float* rw = (float*)smem;
    for (int i = tidx(); i < 1024 * 16; i += NTH) rw[(i & 15) * 1024 + (i >> 4)] = p.router_w[i];
    __syncthreads();
    bf16_t* H = (bf16_t*)(p.ws + OFF_H);
    int* lcnt = (int*)(smem + 65536);
    if (tidx() < 32) lcnt[tidx()] = 0;
    int my_tok = -1, my_e1 = 0, my_e2 = 0, it = 0; float my_g1 = 0.f, my_g2 = 0.f;
    for (int tok = gw; tok < TTOT; tok += nw) {
        const int pos = tok >= PTOT ? tok - PTOT : tok;
        if (layer == 1 && pos < LCTX) continue;
        f32x4 v[4], h[4];
        row_load(xrow_ptr(p, tok), v, lane);
        const float rstd = row_rstd(v);
        row_norm_mod(v, rstd, p.norm_ffn_g + layer * DM, mod_ptr(p, layer, tok, 3), mod_ptr(p, layer, tok, 4), h, lane);
        row_store_bf16(H + (size_t)tok * DM, h, lane);
        float lg[16];
#pragma unroll
        for (int e = 0; e < 16; ++e) lg[e] = 0.f;
#pragma unroll
        for (int i = 0; i < 4; ++i)
#pragma unroll
            for (int e = 0; e < 16; ++e) {
                const f32x4 w = *(const f32x4*)(rw + e * 1024 + (lane + 64 * i) * 4);
                lg[e] += h[i][0] * w[0] + h[i][1] * w[1] + h[i][2] * w[2] + h[i][3] * w[3];
                if ((e & 3) == 3) asm volatile("" ::: "memory");
            }
#pragma unroll
        for (int e = 0; e < 16; ++e) lg[e] = wave_sum(lg[e]);
        int e1, e2; float g1, g2;
        route_row(p, lg, e1, e2, g1, g2);
        if (lane == it) { my_tok = tok; my_e1 = e1; my_e2 = e2; my_g1 = g1; my_g2 = g2; }
        ++it;
    }
    __syncthreads();
    int r1 = 0, r2 = 0;
    if (my_tok >= 0) { r1 = atomicAdd(&lcnt[my_e1], 1); r2 = atomicAdd(&lcnt[my_e2], 1); }
    __syncthreads();
    if (tidx() < 16) { const int n = lcnt[tidx()]; lcnt[16 + tidx()] = n ? atomicAdd((int*)(p.ws + OFF_CNT) + layer * 16 + tidx(), n) : 0; }
    __syncthreads();
    if (my_tok >= 0) {
        int* stok = (int*)(p.ws + OFF_STOK);
        float* sw = (float*)(p.ws + OFF_SW);
        const size_t s1 = (size_t)my_e1 * CAP + lcnt[16 + my_e1] + r1, s2 = (size_t)my_e2 * CAP + lcnt[16 + my_e2] + r2;
        stok[s1] = my_tok * 2 + 0; sw[s1] = my_g1;
        stok[s2] = my_tok * 2 + 1; sw[s2] = my_g2;
    }
    __syncthreads();
}

DI void combine_row(const Params& p, int layer, int tok, f32x4 (&v)[4], int lane) {
    const bf16_t* Y = (const bf16_t*)(p.ws + OFF_SCR + S_Y) + (size_t)tok * 2 * DM;
    const float* g5 = mod_ptr(p, layer, tok, 5);
    f32x4 y0[4], y1[4];
    row_load(xrow_ptr(p, tok), v, lane);
    row_load_bf16(Y, y0, lane); row_load_bf16(Y + DM, y1, lane);
#pragma unroll
    for (int i = 0; i < 4; ++i) { const f32x4 g = *(const f32x4*)(g5 + (lane + 64 * i) * 4); v[i] += g * (y0[i] + y1[i]); }
}
DI void phase_combine_l0(const Params& p, char* smem) {
    const int lane = tidx() & 63, gw = blockIdx.x * NWAVE + (tidx() >> 6), nw = gridDim.x * NWAVE;
    bf16_t* H = (bf16_t*)(p.ws + OFF_H);
    for (int tok = gw; tok < TTOT; tok += nw) {
        f32x4 v[4], h[4];
        combine_row(p, 0, tok, v, lane);
        float* X = xrow_ptr(p, tok);
#pragma unroll
        for (int i = 0; i < 4; ++i) ((f32x4*)X)[lane + 64 * i] = v[i];
        const float rstd = row_rstd(v);
        row_norm_mod(v, rstd, p.norm_mix_g + DM, mod_ptr(p, 1, tok, 0), mod_ptr(p, 1, tok, 1), h, lane);
        row_store_bf16(H + (size_t)tok * DM, h, lane);
    }
    __syncthreads();
    for (int u = blockIdx.x; u < CV_MOE_UNITS; u += gridDim.x) cvt_moe_unit(p, 1, u, (float*)smem);
}
DI void phase_xx(const Params& p) {
    const int lane = tidx() & 63, gw = blockIdx.x * NWAVE + (tidx() >> 6), nw = gridDim.x * NWAVE;
    const bf16_t* H = (const bf16_t*)(p.ws + OFF_H);
    bf16_t* XX = (bf16_t*)(p.ws + OFF_SCR + S_XX);
    for (int tok = gw; tok < TTOT; tok += nw) {
        const int pos = tok >= PTOT ? tok - PTOT : tok;
        const bool first = pos == 0 || pos == LCTX, last = pos == LCTX - 1 || pos == PTOT - 1;
        f32x4 hc[4], hp[4], hn[4], xx[4];
        row_load_bf16(H + (size_t)tok * DM, hc, lane);
        row_load_bf16(H + (size_t)(first ? tok : tok - 1) * DM, hp, lane);
        row_load_bf16(H + (size_t)(last ? tok : tok + 1) * DM, hn, lane);
#pragma unroll
        for (int i = 0; i < 4; ++i) {
            const f32x4 a = first ? (f32x4){0, 0, 0, 0} : hp[i], b = last ? (f32x4){0, 0, 0, 0} : hn[i];
            xx[i] = 0.5f * (a + b) - hc[i];
        }
        row_store_bf16(XX + (size_t)tok * DM, xx, lane);
    }
}
DI void phase_final(const Params& p) {
    const int lane = tidx() & 63, gw = blockIdx.x * NWAVE + (tidx() >> 6), nw = gridDim.x * NWAVE;
    for (int r = gw; r < NBATCH * SEQ; r += nw) {
        const int b = r / SEQ, tok = b * PTOT + LCTX + (r - b * SEQ);
        f32x4 v[4];
        combine_row(p, 1, tok, v, lane);
        const float rstd = row_rstd(v);
        float* O = p.out + (size_t)r * DM;
#pragma unroll
        for (int i = 0; i < 4; ++i) { const f32x4 g = *(const f32x4*)(p.final_norm_g + (lane + 64 * i) * 4); ((f32x4*)O)[lane + 64 * i] = v[i] * rstd * g; }
    }
}

constexpr int LDSROW = 72;
constexpr int GEMM_SMEM = 2 * (256 + 256) * LDSROW * 2;
template <int NH, class AL, class EPI>
DI void gemm_tile(AL& al, const bf16_t* __restrict__ Bt, int ldb, int nk, EPI& epi, char* smem) {
    const int t = tidx(), lane = t & 63, wid = t >> 6, wr = wid >> 1, wc = wid & 1, fr = lane & 15, fq = lane >> 4;
    constexpr int BR = 128 * NH;
    bf16_t* sA = (bf16_t*)smem;
    bf16_t* sB = sA + 2 * 256 * LDSROW;
    f32x4 acc[NH][4][4];
#pragma unroll
    for (int h = 0; h < NH; ++h)
#pragma unroll
        for (int m = 0; m < 4; ++m)
#pragma unroll
            for (int n = 0; n < 4; ++n) acc[h][m][n] = (f32x4){0.f, 0.f, 0.f, 0.f};
    const int lr = t >> 3, lc = (t & 7) * 8;
    u32x4 ra[4], rb[2 * NH];
#pragma unroll
    for (int i = 0; i < 4; ++i) ra[i] = al.load(lr + 64 * i, lc, i);
#pragma unroll
    for (int i = 0; i < 2 * NH; ++i) rb[i] = *(const u32x4*)(Bt + (size_t)(lr + 64 * i) * ldb + lc);
#pragma unroll
    for (int i = 0; i < 4; ++i) *(u32x4*)(sA + (lr + 64 * i) * LDSROW + lc) = ra[i];
#pragma unroll
    for (int i = 0; i < 2 * NH; ++i) *(u32x4*)(sB + (lr + 64 * i) * LDSROW + lc) = rb[i];
    __syncthreads();
    for (int kt = 0; kt < nk; ++kt) {
        const int cur = kt & 1;
        const bool more = kt + 1 < nk;
        if (more) {
#pragma unroll
            for (int i = 0; i < 4; ++i) ra[i] = al.load(lr + 64 * i, (kt + 1) * 64 + lc, i);
#pragma unroll
            for (int i = 0; i < 2 * NH; ++i) rb[i] = *(const u32x4*)(Bt + (size_t)(lr + 64 * i) * ldb + (kt + 1) * 64 + lc);
        }
        const bf16_t* cA = sA + cur * 256 * LDSROW + (wr * 64 + fr) * LDSROW + fq * 8;
        const bf16_t* cB = sB + cur * BR * LDSROW + (wc * 64 + fr) * LDSROW + fq * 8;
#pragma unroll
        for (int kk = 0; kk < 2; ++kk) {
            bf16x8 af[4];
#pragma unroll
            for (int m = 0; m < 4; ++m) af[m] = *(const bf16x8*)(cA + m * 16 * LDSROW + kk * 32);
#pragma unroll
            for (int h = 0; h < NH; ++h) {
                bf16x8 bfr[4];
#pragma unroll
                for (int n = 0; n < 4; ++n) bfr[n] = *(const bf16x8*)(cB + (h * 128 + n * 16) * LDSROW + kk * 32);
#pragma unroll
                for (int m = 0; m < 4; ++m)
#pragma unroll
                    for (int n = 0; n < 4; ++n) acc[h][m][n] = __builtin_amdgcn_mfma_f32_16x16x32_bf16(bfr[n], af[m], acc[h][m][n], 0, 0, 0);
            }
            if (kk == 0 && more) {
                bf16_t* nA = sA + (cur ^ 1) * 256 * LDSROW;
                bf16_t* nB = sB + (cur ^ 1) * BR * LDSROW;
#pragma unroll
                for (int i = 0; i < 4; ++i) *(u32x4*)(nA + (lr + 64 * i) * LDSROW + lc) = ra[i];
#pragma unroll
                for (int i = 0; i < 2 * NH; ++i) *(u32x4*)(nB + (lr + 64 * i) * LDSROW + lc) = rb[i];
            }
        }
        __syncthreads();
    }
#pragma unroll
    for (int h = 0; h < NH; ++h) epi(acc[h], wr * 64, h * 128 + wc * 64, fr, fq);
}
DI bool xcd_tile(int k, int nM, int NT, int& mt, int& nt) {
    const bool swz = (gridDim.x & 7) == 0;
    const int j = (swz ? (int)(blockIdx.x >> 3) : (int)blockIdx.x) + (swz ? (int)(gridDim.x >> 3) : (int)gridDim.x) * k, mi = j / NT;
    nt = j - mi * NT; mt = swz ? (int)(blockIdx.x & 7) + 8 * mi : mi;
    return mt < nM;
}
struct ALPlain {
    const bf16_t* A; int lda;
    DI u32x4 load(int r, int k, int) const { return *(const u32x4*)(A + (size_t)r * lda + k); }
};
struct ALGather {
    const bf16_t* rowp[4];
    DI u32x4 load(int, int k, int i) const { return *(const u32x4*)(rowp[i] + k); }
};
struct ALMix {
    const bf16_t* H; const bf16_t* XX; const float* xm;
    DI u32x4 load(int r, int k, int) const {
        const u32x4 h = *(const u32x4*)(H + (size_t)r * DM + k), x = *(const u32x4*)(XX + (size_t)r * DM + k);
        const f32x4 m0 = *(const f32x4*)(xm + k), m1 = *(const f32x4*)(xm + k + 4);
        u32x4 o;
        o[0] = pk_bf16(bf_lo(h[0]) + bf_lo(x[0]) * m0[0], bf_hi(h[0]) + bf_hi(x[0]) * m0[1]);
        o[1] = pk_bf16(bf_lo(h[1]) + bf_lo(x[1]) * m0[2], bf_hi(h[1]) + bf_hi(x[1]) * m0[3]);
        o[2] = pk_bf16(bf_lo(h[2]) + bf_lo(x[2]) * m1[0], bf_hi(h[2]) + bf_hi(x[2]) * m1[1]);
        o[3] = pk_bf16(bf_lo(h[3]) + bf_lo(x[3]) * m1[2], bf_hi(h[3]) + bf_hi(x[3]) * m1[3]);
        return o;
    }
};

struct EpiQKV {
    const Params* p; int m0, n0;
    DI void operator()(const f32x4 (&acc)[4][4], int rb, int cb, int fr, int fq) const {
        const int hs = (n0 + cb) >> 6;
        const bool isq = hs < 8 || (hs >= 12 && hs < 20), isv = (hs >= 10 && hs < 12) || hs >= 22, normed = hs >= 12 && hs < 22;
        const float* gam = hs < 20 ? p->attn_q_norm_g : p->attn_k_norm_g;
        const f32x2* rope = (const f32x2*)(p->ws + OFF_ROPE);
        bf16_t* Q = (bf16_t*)(p->ws + OFF_SCR + S_Q);
        bf16_t* K = (bf16_t*)(p->ws + OFF_SCR + S_K);
        bf16_t* VT = (bf16_t*)(p->ws + OFF_SCR + S_VT);
#pragma unroll
        for (int m = 0; m < 4; ++m) {
            const int tok = m0 + rb + m * 16 + fr, b = tok >= PTOT ? 1 : 0, pos = tok - b * PTOT;
            f32x4 v[4];
#pragma unroll
            for (int n = 0; n < 4; ++n) v[n] = acc[m][n];
            if (normed) {
                float ss = 0.f;
#pragma unroll
                for (int n = 0; n < 4; ++n) ss += v[n][0] * v[n][0] + v[n][1] * v[n][1] + v[n][2] * v[n][2] + v[n][3] * v[n][3];
                ss += __shfl_xor(ss, 16); ss += __shfl_xor(ss, 32);
                const float rstd = rsqrtf(ss * (1.0f / 64.0f) + RMS_EPS);
#pragma unroll
                for (int n = 0; n < 4; ++n) { const f32x4 g = *(const f32x4*)(gam + n * 16 + fq * 4); v[n] = v[n] * rstd * g; }
            }
            if (!isv && pos >= LCTX) {
                const int t = pos - LCTX, prow = t >> 6, pcol = t & 63;
#pragma unroll
                for (int a = 0; a < 2; ++a) {
                    const f32x2* tb = rope + (a == 0 ? prow : 256 + pcol) * 16 + fq * 4;
#pragma unroll
                    for (int j = 0; j < 4; ++j) {
                        const f32x2 cs = tb[j];
                        const float x0 = v[2 * a][j], x1 = v[2 * a + 1][j];
                        v[2 * a][j] = x0 * cs[0] - x1 * cs[1];
                        v[2 * a + 1][j] = x1 * cs[0] + x0 * cs[1];
                    }
                }
            }
            if (isq) {
                const int hq = hs < 8 ? hs : hs - 4;
                bf16_t* dst = Q + ((size_t)(b * 16 + hq) * PTOT + pos) * 64 + fq * 4;
#pragma unroll
                for (int n = 0; n < 4; ++n) { const f32x4 w = v[n] * (0.125f * LOG2E); u32x2 o; o[0] = pk_bf16(w[0], w[1]); o[1] = pk_bf16(w[2], w[3]); *(u32x2*)(dst + n * 16) = o; }
            } else if (!isv) {
                const int kh = hs < 12 ? hs - 8 : hs - 18;
                bf16_t* dst = K + ((size_t)(b * 4 + kh) * PTOT + pos) * 64 + fq * 4;
#pragma unroll
                for (int n = 0; n < 4; ++n) { u32x2 o; o[0] = pk_bf16(v[n][0], v[n][1]); o[1] = pk_bf16(v[n][2], v[n][3]); *(u32x2*)(dst + n * 16) = o; }
            } else {
                const int vh = hs < 12 ? hs - 10 : hs - 20;
                bf16_t* dst = VT + (size_t)(b * 4 + vh) * 64 * PTOT + pos;
#pragma unroll
                for (int n = 0; n < 4; ++n)
#pragma unroll
                    for (int j = 0; j < 4; ++j) dst[(size_t)(n * 16 + fq * 4 + j) * PTOT] = (bf16_t)(pk_bf16(v[n][j], 0.f) & 0xffffu);
            }
        }
    }
};
DI void phase_qkv(const Params& p, char* smem) {
    const bf16_t* H = (const bf16_t*)(p.ws + OFF_H);
    const bf16_t* W = (const bf16_t*)(p.ws + OFF_WS) + W_IN;
    constexpr int NT = QKV_N / 128, MT = TTOT / 256;
    for (int k = 0;; ++k) {
        int mt, nt; if (!xcd_tile(k, MT, NT, mt, nt)) break;
        ALPlain al{H + (size_t)mt * 256 * DM, DM};
        EpiQKV epi{&p, mt * 256, nt * 128};
        gemm_tile<1>(al, W + (size_t)nt * 128 * DM, DM, DM / 64, epi, smem);
    }
}

struct EpiResid {
    const Params* p; int m0, n0, layer; bool from_input;
    DI void operator()(const f32x4 (&acc)[4][4], int rb, int cb, int fr, int fq) const {
#pragma unroll
        for (int m = 0; m < 4; ++m) {
            const int tok = m0 + rb + m * 16 + fr;
            const float* xin = from_input ? xin_ptr(*p, tok) : xrow_ptr(*p, tok);
            float* xo = xrow_ptr(*p, tok);
            const float* gate = mod_ptr(*p, layer, tok, 2);
#pragma unroll
            for (int n = 0; n < 4; ++n) {
                const int c = n0 + cb + n * 16 + fq * 4;
                const f32x4 xi = *(const f32x4*)(xin + c), g = *(const f32x4*)(gate + c);
                *(f32x4*)(xo + c) = xi + g * acc[m][n];
            }
        }
    }
};
DI void phase_wout(const Params& p, char* smem) {
    const bf16_t* O = (const bf16_t*)(p.ws + OFF_SCR + S_O);
    const bf16_t* W = (const bf16_t*)(p.ws + OFF_WS) + W_OUT;
    constexpr int NT = 8, MT = TTOT / 256;
    for (int k = 0;; ++k) {
        int mt, nt; if (!xcd_tile(k, MT, NT, mt, nt)) break;
        ALPlain al{O + (size_t)mt * 256 * DM, DM};
        EpiResid epi{&p, mt * 256, nt * 128, 0, true};
        gemm_tile<1>(al, W + (size_t)nt * 128 * DM, DM, DM / 64, epi, smem);
    }
}
DI void phase_wo(const Params& p, char* smem) {
    const bf16_t* O = (const bf16_t*)(p.ws + OFF_SCR + S_OR);
    const bf16_t* W = (const bf16_t*)(p.ws + OFF_WS) + W_O;
    constexpr int NT = 8, MTL = SEQ / 256;
    for (int k = 0;; ++k) {
        int mi, nt; if (!xcd_tile(k, NBATCH * MTL, NT, mi, nt)) break;
        const int b = mi / MTL, mt = b * (PTOT / 256) + 1 + (mi % MTL);
        ALPlain al{O + (size_t)mt * 256 * DM, DM};
        EpiResid epi{&p, mt * 256, nt * 128, 1, false};
        gemm_tile<1>(al, W + (size_t)nt * 128 * DM, DM, DM / 64, epi, smem);
    }
}

struct MoeSched { int nt[16], base[17]; };
DI void moe_sched(const Params& p, int layer, MoeSched& s, int (&cnt)[16]) {
    const int* c = (const int*)(p.ws + OFF_CNT) + layer * 16;
    int acc = 0;
#pragma unroll
    for (int e = 0; e < 16; ++e) { cnt[e] = c[e]; s.nt[e] = (cnt[e] + 255) >> 8; s.base[e] = acc; acc += s.nt[e]; }
    s.base[16] = acc;
}
struct EpiMoe1 {
    bf16_t* hid;   int n0;
    DI void operator()(const f32x4 (&acc)[4][4], int rb, int cb, int fr, int fq) const {
        const int g = (n0 + cb) >> 6;
#pragma unroll
        for (int m = 0; m < 4; ++m) {
            bf16_t* dst = hid + (size_t)(rb + m * 16 + fr) * 1024 + g * 32 + fq * 4;
#pragma unroll
            for (int n = 0; n < 2; ++n) {
                const f32x4 a = acc[m][n], b = acc[m][n + 2];
                u32x2 o;
                o[0] = pk_bf16(siluf_(a[0]) * b[0], siluf_(a[1]) * b[1]);
                o[1] = pk_bf16(siluf_(a[2]) * b[2], siluf_(a[3]) * b[3]);
                *(u32x2*)(dst + n * 16) = o;
            }
        }
    }
};
DI void phase_moe1(const Params& p, int layer, char* smem) {
    MoeSched s; int cnt[16];
    moe_sched(p, layer, s, cnt);
    const bf16_t* H = (const bf16_t*)(p.ws + OFF_H);
    const bf16_t* W13 = (const bf16_t*)(p.ws + OFF_MOEW);
    const int* stok = (const int*)(p.ws + OFF_STOK);
    bf16_t* hid = (bf16_t*)(p.ws + OFF_SCR + S_HID);
    constexpr int NT = 8;
    const int total = s.base[16] * NT;
    const int lr = tidx() >> 3;
    for (int k = 0;; ++k) {
        int mg, nt; if (!xcd_tile(k, s.base[16], NT, mg, nt)) break;
        int e = 0;
#pragma unroll
        for (int i = 1; i < 16; ++i) if (mg >= s.base[i]) e = i;
        int ce = 0;
#pragma unroll
        for (int i = 0; i < 16; ++i) if (i == e) ce = cnt[i];
        int be = 0;
#pragma unroll
        for (int i = 0; i < 16; ++i) if (i == e) be = s.base[i];
        const int ml = mg - be;
        ALGather al;
#pragma unroll
        for (int i = 0; i < 4; ++i) {
            const int r = ml * 256 + lr + 64 * i;
            const int tk = r < ce ? (stok[(size_t)e * CAP + r] >> 1) : 0;
            al.rowp[i] = H + (size_t)tk * DM;
        }
        EpiMoe1 epi{hid + (size_t)mg * 256 * 1024, nt * 256};
        gemm_tile<2>(al, W13 + (size_t)e * 2048 * 1024 + (size_t)nt * 256 * 1024, 1024, 16, epi, smem);
    }
}
struct EpiMoe2 {
    bf16_t* Y; const int* stok; const float* sw; int nvalid, n0;
    DI void operator()(const f32x4 (&acc)[4][4], int rb, int cb, int fr, int fq) const {
#pragma unroll
        for (int m = 0; m < 4; ++m) {
            const int r = rb + m * 16 + fr;
            if (r < nvalid) {
                const int tk = stok[r]; const float w = sw[r];
                bf16_t* dst = Y + (size_t)tk * 1024 + n0 + cb + fq * 4;
#pragma unroll
                for (int n = 0; n < 4; ++n) { const f32x4 a = acc[m][n] * w; u32x2 o; o[0] = pk_bf16(a[0], a[1]); o[1] = pk_bf16(a[2], a[3]); *(u32x2*)(dst + n * 16) = o; }
            }
        }
    }
};
DI void phase_moe2(const Params& p, int layer, char* smem) {
    MoeSched s; int cnt[16];
    moe_sched(p, layer, s, cnt);
    const bf16_t* hid = (const bf16_t*)(p.ws + OFF_SCR + S_HID);
    const bf16_t* W2 = (const bf16_t*)(p.ws + OFF_MOEW) + (size_t)16 * 2048 * 1024;
    const int* stok = (const int*)(p.ws + OFF_STOK);
    const float* sw = (const float*)(p.ws + OFF_SW);
    bf16_t* Y = (bf16_t*)(p.ws + OFF_SCR + S_Y);
    constexpr int NT = 4;
    const int total = s.base[16] * NT;
    for (int k = 0;; ++k) {
        int mg, nt; if (!xcd_tile(k, s.base[16], NT, mg, nt)) break;
        int e = 0;
#pragma unroll
        for (int i = 1; i < 16; ++i) if (mg >= s.base[i]) e = i;
        int ce = 0, be = 0;
#pragma unroll
        for (int i = 0; i < 16; ++i) if (i == e) { ce = cnt[i]; be = s.base[i]; }
        const int ml = mg - be;
        ALPlain al{hid + (size_t)mg * 256 * 1024, 1024};
        EpiMoe2 epi{Y, stok + (size_t)e * CAP + ml * 256, sw + (size_t)e * CAP + ml * 256, ce - ml * 256, nt * 256};
        gemm_tile<2>(al, W2 + (size_t)e * 1024 * 1024 + (size_t)nt * 256 * 1024, 1024, 16, epi, smem);
    }
}

struct EpiRwkv {
    bf16_t* dst; int ld, m0, n0, act, nstore;
    DI void operator()(const f32x4 (&acc)[4][4], int rb, int cb, int fr, int fq) const {
#pragma unroll
        for (int m = 0; m < 4; ++m) {
            bf16_t* d = dst + (size_t)(m0 + rb + m * 16 + fr) * ld + n0 + cb + fq * 4;
#pragma unroll
            for (int n = 0; n < 4; ++n) {
                const int c = n0 + cb + n * 16 + fq * 4;
                if (c >= ld) continue;
                f32x4 a = acc[m][n];
                if (act == 1) {
#pragma unroll
                    for (int j = 0; j < 4; ++j) { const float e = __expf(2.0f * a[j]); a[j] = 1.0f - 2.0f / (e + 1.0f); }
                }
                if (act == 2) {
#pragma unroll
                    for (int j = 0; j < 4; ++j) a[j] = sigmoidf_(a[j]);
                }
                if (c >= nstore) a = (f32x4){0.f, 0.f, 0.f, 0.f};
                u32x2 o; o[0] = pk_bf16(a[0], a[1]); o[1] = pk_bf16(a[2], a[3]);
                *(u32x2*)(d + n * 16) = o;
            }
        }
    }
};
DI void phase_rwkv_proj(const Params& p, char* smem) {
    const bf16_t* H = (const bf16_t*)(p.ws + OFF_H);
    const bf16_t* XX = (const bf16_t*)(p.ws + OFF_SCR + S_XX);
    const bf16_t* wsm = (const bf16_t*)(p.ws + OFF_WS);
    constexpr int MT = TTOT / 256, NTT = 8 + 8 + 8 + 1 + 1 + 2;
    for (int k = 0;; ++k) {
        int mt, q; if (!xcd_tile(k, MT, NTT, mt, q)) break;
        int job, nt;
        if (q < 8) { job = 0; nt = q; } else if (q < 16) { job = 1; nt = q - 8; } else if (q < 24) { job = 2; nt = q - 16; }
        else if (q == 24) { job = 3; nt = 0; } else if (q == 25) { job = 4; nt = 0; } else { job = 5; nt = q - 26; }
        const int mixj = job == 0 ? 0 : job == 1 ? 2 : job == 2 ? 3 : job == 3 ? 1 : job == 4 ? 4 : 5;
        const size_t wofs = job == 0 ? W_R : job == 1 ? W_K : job == 2 ? W_V : job == 3 ? W_W1 : job == 4 ? W_A1 : W_G1;
        const size_t dofs = job == 0 ? S_R : job == 1 ? S_KK : job == 2 ? S_V : job == 3 ? S_LW : job == 4 ? S_LA : S_LG;
        const int ld = job < 3 ? 1024 : job < 5 ? 128 : 192;
        ALMix al{H + (size_t)mt * 256 * DM, XX + (size_t)mt * 256 * DM, p.rwkv_x_mix + mixj * DM};
        EpiRwkv epi{(bf16_t*)(p.ws + OFF_SCR + dofs), ld, mt * 256, nt * 128, job == 3 ? 1 : job == 5 ? 2 : 0, job == 5 ? 160 : 4096};
        gemm_tile<1>(al, wsm + wofs + (size_t)nt * 128 * DM, DM, DM / 64, epi, smem);
    }
}

struct EpiGate {
    const Params* p; int m0, n0;
    DI void operator()(const f32x4 (&acc)[4][4], int rb, int cb, int fr, int fq) const {
        const bf16_t* Y0 = (const bf16_t*)(p->ws + OFF_H);
        const bf16_t* Y1 = (const bf16_t*)(p->ws + OFF_SCR + S_Y1);
        const bf16_t* V = (const bf16_t*)(p->ws + OFF_SCR + S_V);
        const float* bonus = (const float*)(p->ws + OFF_BONUS2);
        bf16_t* O = (bf16_t*)(p->ws + OFF_SCR + S_OR);
        const int c0 = n0 + cb, hd = c0 >> 6;
#pragma unroll
        for (int m = 0; m < 4; ++m) {
            const int tok = m0 + rb + m * 16 + fr;
            const size_t ro = (size_t)tok * DM + c0 + fq * 4;
            f32x4 y[4];
            float s = 0.f;
#pragma unroll
            for (int n = 0; n < 4; ++n) {
                const u32x2 a = *(const u32x2*)(Y0 + ro + n * 16), b = *(const u32x2*)(Y1 + ro + n * 16);
                y[n][0] = bf_lo(a[0]) + bf_lo(b[0]); y[n][1] = bf_hi(a[0]) + bf_hi(b[0]); y[n][2] = bf_lo(a[1]) + bf_lo(b[1]); y[n][3] = bf_hi(a[1]) + bf_hi(b[1]);
                s += y[n][0] + y[n][1] + y[n][2] + y[n][3];
            }
            s += __shfl_xor(s, 16); s += __shfl_xor(s, 32);
            const float mu = s * (1.0f / 64.0f);
            float q = 0.f;
#pragma unroll
            for (int n = 0; n < 4; ++n) { const f32x4 d = y[n] - mu; q += d[0] * d[0] + d[1] * d[1] + d[2] * d[2] + d[3] * d[3]; }
            q += __shfl_xor(q, 16); q += __shfl_xor(q, 32);
            const float rs = rsqrtf(q * (1.0f / 64.0f) + GN_EPS);
            const float bon = (bonus[(size_t)tok * 16 + hd] + bonus[(size_t)(TTOT + tok) * 16 + hd]) + (bonus[(size_t)(2 * TTOT + tok) * 16 + hd] + bonus[(size_t)(3 * TTOT + tok) * 16 + hd]);
#pragma unroll
            for (int n = 0; n < 4; ++n) {
                const int c = c0 + n * 16 + fq * 4;
                const f32x4 g = *(const f32x4*)(p->rwkv_ln_g + c), bb = *(const f32x4*)(p->rwkv_ln_b + c);
                const u32x2 vv = *(const u32x2*)(V + ro + n * 16);
                const f32x4 v4 = {bf_lo(vv[0]), bf_hi(vv[0]), bf_lo(vv[1]), bf_hi(vv[1])};
                const f32x4 o = ((y[n] - mu) * rs * g + bb + bon * v4) * acc[m][n];
                u32x2 w; w[0] = pk_bf16(o[0], o[1]); w[1] = pk_bf16(o[2], o[3]);
                *(u32x2*)(O + ro + n * 16) = w;
            }
        }
    }
};
DI void phase_gate(const Params& p, char* smem) {
    const bf16_t* LG = (const bf16_t*)(p.ws + OFF_SCR + S_LG);
    const bf16_t* W = (const bf16_t*)(p.ws + OFF_WS) + W_G2;
    constexpr int NT = 8, MT = TTOT / 256;
    for (int k = 0;; ++k) {
        int mt, nt; if (!xcd_tile(k, MT, NT, mt, nt)) break;
        ALPlain al{LG + (size_t)mt * 256 * 192, 192};
        EpiGate epi{&p, mt * 256, nt * 128};
        gemm_tile<1>(al, W + (size_t)nt * 128 * 192, 192, 3, epi, smem);
    }
}

constexpr int KROW = 72, VROW = 68;
constexpr int ATT_SMEM = 2 * 64 * KROW * 2 + 2 * 64 * VROW * 2;
DI int crow_(int i, int h) { return (i & 3) + 8 * (i >> 2) + 4 * h; }
#define MFMA32(a, b, c) __builtin_amdgcn_mfma_f32_32x32x16_bf16((a), (b), (c), 0, 0, 0)
template <int MODE>
DI void attn_unit(const Params& p, const bf16_t* Qg  , int nq_valid, const bf16_t* Kg  , const bf16_t* Vg  ,
                  int ta0, int ta1, int tb0, int tb1  , bool band, int q_lat0  ,
                  float init_m, float init_l0, bf16_t* Og  , char* smem) {
    const int t = tidx(), lane = t & 63, wid = t >> 6, r = lane & 31, h = lane >> 5;
    bf16_t* sK = (bf16_t*)smem;
    bf16_t* sV = sK + 2 * 64 * KROW;
    bf16x8 qf[2][4];
#pragma unroll
    for (int qs = 0; qs < 2; ++qs) {
        const int qi = wid * 64 + qs * 32 + r;
        const bf16_t* qp = Qg + (size_t)(qi < nq_valid ? qi : 0) * 64 + 8 * h;
#pragma unroll
        for (int ks = 0; ks < 4; ++ks) qf[qs][ks] = *(const bf16x8*)(qp + ks * 16);
    }
    f32x16 o[2][2];
#pragma unroll
    for (int qs = 0; qs < 2; ++qs)
#pragma unroll
        for (int dt = 0; dt < 2; ++dt)
#pragma unroll
            for (int i = 0; i < 16; ++i) o[qs][dt][i] = 0.f;
    float mrun[2], lrun[2];
#pragma unroll
    for (int qs = 0; qs < 2; ++qs) { mrun[qs] = init_m; lrun[qs] = (MODE == 1 && h == 0) ? init_l0 : 0.f; }
    const int ntile = ((ta1 - ta0) + (tb1 - tb0)) >> 6;
    const int lrow = t >> 3, lch = (t & 7) * 8;
    u32x4 rk, rv;
    auto tile_pos = [&](int i) { const int a = (ta1 - ta0) >> 6; return i < a ? ta0 + i * 64 : tb0 + (i - a) * 64; };
    {
        const int kp = tile_pos(0);
        rk = *(const u32x4*)(Kg + (size_t)(kp + lrow) * 64 + lch);
        rv = *(const u32x4*)(Vg + (size_t)lrow * PTOT + kp + lch);
        *(u32x4*)(sK + lrow * KROW + lch) = rk;
        *(u32x2*)(sV + lrow * VROW + lch) = (u32x2){rv[0], rv[1]};
        *(u32x2*)(sV + lrow * VROW + lch + 4) = (u32x2){rv[2], rv[3]};
    }
    __syncthreads();
    for (int it = 0; it < ntile; ++it) {
        const int cur = it & 1;
        const bool more = it + 1 < ntile;
        const int kp = tile_pos(it);
        if (more) {
            const int kn = tile_pos(it + 1);
            rk = *(const u32x4*)(Kg + (size_t)(kn + lrow) * 64 + lch);
            rv = *(const u32x4*)(Vg + (size_t)lrow * PTOT + kn + lch);
        }
        const bf16_t* cK = sK + cur * 64 * KROW;
        const bf16_t* cV = sV + cur * 64 * VROW;
#pragma unroll 1
        for (int ksub = 0; ksub < 2; ++ksub) {
            f32x16 sc[2];
#pragma unroll
            for (int qs = 0; qs < 2; ++qs)
#pragma unroll
                for (int i = 0; i < 16; ++i) sc[qs][i] = MODE == 0 ? init_m : 0.f;
            {
                bf16x8 kf[4];
#pragma unroll
                for (int ks = 0; ks < 4; ++ks) kf[ks] = *(const bf16x8*)(cK + (ksub * 32 + r) * KROW + ks * 16 + 8 * h);
                __builtin_amdgcn_s_setprio(1);
#pragma unroll
                for (int ks = 0; ks < 4; ++ks)
#pragma unroll
                    for (int qs = 0; qs < 2; ++qs) sc[qs] = MFMA32(kf[ks], qf[qs][ks], sc[qs]);
                __builtin_amdgcn_s_setprio(0);
            }
#pragma unroll
            for (int qs = 0; qs < 2; ++qs) {
                if (MODE == 1) {
                    if (band && kp >= LCTX) {
                        const int qlat = q_lat0 + wid * 64 + qs * 32 + r, kl0 = kp - LCTX + ksub * 32;
#pragma unroll
                        for (int i = 0; i < 16; ++i) {
                            const int d0 = qlat - (kl0 + crow_(i, h));
                            if (d0 > 128 || d0 < -128) sc[qs][i] = -1e30f;
                        }
                    }
                    float mt = sc[qs][0];
#pragma unroll
                    for (int i = 1; i < 16; ++i) mt = fmaxf(mt, sc[qs][i]);
                    mt = fmaxf(mt, __shfl_xor(mt, 32));
                    const float mnew = fmaxf(mrun[qs], mt);
                    const float alpha = __builtin_amdgcn_exp2f(mrun[qs] - mnew);
                    mrun[qs] = mnew; lrun[qs] *= alpha;
#pragma unroll
                    for (int i = 0; i < 16; ++i) { o[qs][0][i] *= alpha; o[qs][1][i] *= alpha; }
#pragma unroll
                    for (int i = 0; i < 16; ++i) sc[qs][i] -= mnew;
                }
                float ls = 0.f;
#pragma unroll
                for (int i = 0; i < 16; ++i) { sc[qs][i] = __builtin_amdgcn_exp2f(sc[qs][i]); ls += sc[qs][i]; }
                lrun[qs] += ls;
            }
#pragma unroll
            for (int st = 0; st < 2; ++st) {
                bf16x8 pf[2];
#pragma unroll
                for (int qs = 0; qs < 2; ++qs) {
                    u32x4 pw;
#pragma unroll
                    for (int j = 0; j < 4; ++j) pw[j] = pk_bf16(sc[qs][8 * st + 2 * j], sc[qs][8 * st + 2 * j + 1]);
                    pf[qs] = __builtin_bit_cast(bf16x8, pw);
                }
                const int kb = ksub * 32 + 16 * st + 4 * h;
#pragma unroll
                for (int dt = 0; dt < 2; ++dt) {
                    const s16x4 lo = *(const s16x4*)(cV + (dt * 32 + r) * VROW + kb), hi = *(const s16x4*)(cV + (dt * 32 + r) * VROW + kb + 8);
                    const bf16x8 vf = __builtin_shufflevector(lo, hi, 0, 1, 2, 3, 4, 5, 6, 7);
#pragma unroll
                    for (int qs = 0; qs < 2; ++qs) o[qs][dt] = MFMA32(vf, pf[qs], o[qs][dt]);
                }
            }
        }
        if (more) {
            bf16_t* nK = sK + (cur ^ 1) * 64 * KROW;
            bf16_t* nV = sV + (cur ^ 1) * 64 * VROW;
            *(u32x4*)(nK + lrow * KROW + lch) = rk;
            *(u32x2*)(nV + lrow * VROW + lch) = (u32x2){rv[0], rv[1]};
            *(u32x2*)(nV + lrow * VROW + lch + 4) = (u32x2){rv[2], rv[3]};
        }
        __syncthreads();
    }
#pragma unroll
    for (int qs = 0; qs < 2; ++qs) {
        const int qi = wid * 64 + qs * 32 + r;
        const float lt = lrun[qs] + __shfl_xor(lrun[qs], 32);
        const float invl = 1.0f / lt;
        if (qi < nq_valid) {
            bf16_t* op = Og + (size_t)qi * DM;
#pragma unroll
            for (int g = 0; g < 4; ++g) {
                u32x2 w0, w1;
                w0[0] = pk_bf16(o[qs][0][4 * g] * invl, o[qs][0][4 * g + 1] * invl); w0[1] = pk_bf16(o[qs][0][4 * g + 2] * invl, o[qs][0][4 * g + 3] * invl);
                w1[0] = pk_bf16(o[qs][1][4 * g] * invl, o[qs][1][4 * g + 1] * invl); w1[1] = pk_bf16(o[qs][1][4 * g + 2] * invl, o[qs][1][4 * g + 3] * invl);
                *(u32x2*)(op + 8 * g + 4 * h) = w0;
                *(u32x2*)(op + 32 + 8 * g + 4 * h) = w1;
            }
        }
    }
}
DI void phase_attn(const Params& p, char* smem) {
    const bf16_t* Q = (const bf16_t*)(p.ws + OFF_SCR + S_Q);
    const bf16_t* K = (const bf16_t*)(p.ws + OFF_SCR + S_K);
    const bf16_t* VT = (const bf16_t*)(p.ws + OFF_SCR + S_VT);
    bf16_t* O = (bf16_t*)(p.ws + OFF_SCR + S_O);
    float gq = 0.f, gk = 0.f;
    for (int i = 0; i < 64; ++i) { gq = fmaxf(gq, fabsf(p.attn_q_norm_g[i])); gk = fmaxf(gk, fabsf(p.attn_k_norm_g[i])); }
    const float M2 = 8.25f * gq * gk * LOG2E;
    constexpr int QB = 512, NQB = SEQ / QB;
    const int G = gridDim.x;
    constexpr int NDENSE = NBATCH * 8 * NQB;
    for (int u = blockIdx.x; u < NDENSE; u += G) {
        int combo, within;
        if ((G & 7) == 0 && NDENSE % G == 0) {
            const int xcd = blockIdx.x & 7, idx = (blockIdx.x >> 3) + (G >> 3) * (u / G);
            combo = xcd & 3; within = (xcd >> 2) * (NDENSE / 8) + idx;
        } else { combo = u / (4 * NQB); within = u % (4 * NQB); }
        const int b = combo >> 1, kvh = combo & 1, hq = kvh * 4 + (within & 3), qb = within >> 2;
        const bf16_t* Qg = Q + ((size_t)(b * 16 + 8 + hq) * PTOT + LCTX + qb * QB) * 64;
        attn_unit<0>(p, Qg, QB, K + (size_t)(b * 4 + 2 + kvh) * PTOT * 64, VT + (size_t)(b * 4 + 2 + kvh) * 64 * PTOT, 0, PTOT, 0, 0, false, 0, -M2, 0.f,
                     O + (size_t)(b * PTOT + LCTX + qb * QB) * DM + (8 + hq) * 64, smem);
    }
    for (int u = blockIdx.x; u < NDENSE; u += G) {
        const int b = u / (8 * NQB), rem = u % (8 * NQB), qb = rem >> 3, hq = rem & 7, kvh = hq >> 2;
        const int i0 = qb * QB;
        const int lo = i0 - 128 < 0 ? 0 : i0 - 128, hi = i0 + QB + 128 > SEQ ? SEQ : i0 + QB + 128;
        const bf16_t* Qg = Q + ((size_t)(b * 16 + hq) * PTOT + LCTX + i0) * 64;
        attn_unit<1>(p, Qg, QB, K + (size_t)(b * 4 + kvh) * PTOT * 64, VT + (size_t)(b * 4 + kvh) * 64 * PTOT, 0, LCTX, LCTX + lo, LCTX + hi, true, i0,
                     p.attn_sink[hq] * LOG2E, 1.0f, O + (size_t)(b * PTOT + LCTX + i0) * DM + hq * 64, smem);
    }
    for (int u = blockIdx.x; u < NBATCH * 16; u += G) {
        const int b = u >> 4, hh = u & 15, isb = hh >> 3, hq = hh & 7, kvh = isb * 2 + (hq >> 2);
        const bf16_t* Qg = Q + ((size_t)(b * 16 + hh) * PTOT) * 64;
        attn_unit<1>(p, Qg, LCTX, K + (size_t)(b * 4 + kvh) * PTOT * 64, VT + (size_t)(b * 4 + kvh) * 64 * PTOT, 0, LCTX, 0, 0, false, 0,
                     isb ? -1e30f : p.attn_sink[hq] * LOG2E, isb ? 0.f : 1.0f, O + (size_t)(b * PTOT) * DM + hh * 64, smem);
    }
}

constexpr int TB = 32, NBUF = 3;
constexpr int SC_REC = 5 * 64;
constexpr int SC_OPS = TB * SC_REC * 4;
constexpr int SC_SMEM = NBUF * SC_OPS + NBUF * TB * 16 * 4 + NBUF * TB * 16 * 4 + 64;
DI int scan_pos(int n, int dir) {
    if (n < LCTX) return dir ? LCTX - 1 - n : n;
    const int m = n - LCTX;
    return LCTX + (dir ? SEQ - 1 - m : m);
}
template <int CTRL> DI float dpp_add(float v) { return v + __builtin_bit_cast(float, __builtin_amdgcn_update_dpp(0, __builtin_bit_cast(int, v), CTRL, 0xf, 0xf, false)); }
DI float row16_sum(float v) { v = dpp_add<0x128>(v); v = dpp_add<0x124>(v); v = dpp_add<0x122>(v); v = dpp_add<0x121>(v); return v; }
DI int lds_min4(int* c) { const volatile LAS int* q = (const volatile LAS int*)c; const int a = q[0], b = q[1], d = q[2], e = q[3]; return min(min(a, b), min(d, e)); }
DI void lds_publish(int* c, int v) { *(volatile LAS int*)c = v; }
DI void scan_unit(const Params& p, int u, char* smem) {
    const int t = tidx(), lane = t & 63, wid = __builtin_amdgcn_readfirstlane(t >> 6);
    const unsigned rg = u & 3, dir = (u >> 2) & 1, hd = (u >> 3) & 15, b = u >> 7;
    float* ops = (float*)smem;
    float* vbuf = (float*)(smem + NBUF * SC_OPS);
    float* ybuf = vbuf + NBUF * TB * 16;
    int* cnts = (int*)(ybuf + NBUF * TB * 16);
    const bf16_t* R = (const bf16_t*)(p.ws + OFF_SCR + S_R);
    const bf16_t* Kk = (const bf16_t*)(p.ws + OFF_SCR + S_KK);
    const bf16_t* V = (const bf16_t*)(p.ws + OFF_SCR + S_V);
    const bf16_t* LW = (const bf16_t*)(p.ws + OFF_SCR + S_LW);
    const bf16_t* LA = (const bf16_t*)(p.ws + OFF_SCR + S_LA);
    bf16_t* Yo = dir ? (bf16_t*)(p.ws + OFF_SCR + S_Y1) : (bf16_t*)(p.ws + OFF_H);
    float* bonus = (float*)(p.ws + OFF_BONUS2);
    const unsigned tokb = b * PTOT, hc = hd * 64;
    constexpr int NBLK = PTOT / TB;
    const unsigned fr = lane & 15, fq = lane >> 4;
    if (t < 8) cnts[t] = 0;
    __syncthreads();

    if (wid < 4) {
        __builtin_amdgcn_s_setprio(3);
        float s0 = 0.f, s1 = 0.f, s2 = 0.f, s3 = 0.f;
        const unsigned g = lane >> 4, c4 = (lane & 15) * 4, myrow = wid * 4 + g;
        for (int blk = 0; blk < NBLK; ++blk) {
            const unsigned buf = (unsigned)blk % NBUF;
            while (lds_min4(cnts) < blk + 1) __builtin_amdgcn_s_sleep(1);
            asm volatile("" ::: "memory");
            const float* rec = ops + buf * (TB * SC_REC) + c4;
            const float* vb = vbuf + buf * (TB * 16) + myrow;
            float* yb = ybuf + buf * (TB * 16) + myrow;
            f32x4 w0_ = *(const f32x4*)(rec), kd0_ = *(const f32x4*)(rec + 64), bb0_ = *(const f32x4*)(rec + 128), aa0_ = *(const f32x4*)(rec + 192), rr0_ = *(const f32x4*)(rec + 256);
            float vv0_ = vb[0];
#define SCAN_STEP(W, KD, BB, AA, RR, VV, ST) { \
                float sa = s0 * AA[0] + s1 * AA[1] + s2 * AA[2] + s3 * AA[3]; \
                sa = row16_sum(sa); \
                s0 = s0 * W[0] + sa * BB[0] + VV * KD[0]; \
                s1 = s1 * W[1] + sa * BB[1] + VV * KD[1]; \
                s2 = s2 * W[2] + sa * BB[2] + VV * KD[2]; \
                s3 = s3 * W[3] + sa * BB[3] + VV * KD[3]; \
                float y = s0 * RR[0] + s1 * RR[1] + s2 * RR[2] + s3 * RR[3]; \
                y = row16_sum(y); \
                if ((lane & 15) == 0) yb[(ST) * 16] = y; }
#pragma unroll 1
            for (int st = 0; st < TB; st += 2) {
                const float* r1 = rec + (st + 1) * SC_REC;
                const f32x4 w1_ = *(const f32x4*)(r1), kd1_ = *(const f32x4*)(r1 + 64), bb1_ = *(const f32x4*)(r1 + 128), aa1_ = *(const f32x4*)(r1 + 192), rr1_ = *(const f32x4*)(r1 + 256);
                const float vv1_ = vb[(st + 1) * 16];
                SCAN_STEP(w0_, kd0_, bb0_, aa0_, rr0_, vv0_, st)
                const int st2 = st + 2 < TB ? st + 2 : st;
                const float* r2 = rec + st2 * SC_REC;
                w0_ = *(const f32x4*)(r2); kd0_ = *(const f32x4*)(r2 + 64); bb0_ = *(const f32x4*)(r2 + 128); aa0_ = *(const f32x4*)(r2 + 192); rr0_ = *(const f32x4*)(r2 + 256);
                vv0_ = vb[st2 * 16];
                SCAN_STEP(w1_, kd1_, bb1_, aa1_, rr1_, vv1_, st + 1)
            }
#undef SCAN_STEP
            asm volatile("s_waitcnt lgkmcnt(0)" ::: "memory");
            if (lane == 0) lds_publish(cnts + 4 + wid, blk + 1);
        }
        __builtin_amdgcn_s_setprio(0);
    } else {
        const unsigned wt = wid & 1, chh = (wid >> 1) & 1;
        const bf16_t* wsm = (const bf16_t*)(p.ws + OFF_WS);
        const unsigned wo = W_W2 + dir * 65536u + (hc + fr) * 64u + fq * 8u;
        const unsigned ao = W_A2 + dir * 65536u + (hc + fr) * 64u + fq * 8u;
        const unsigned po = hc + fq * 4u;
        for (int blk = 0; blk < NBLK + NBUF; ++blk) {
            const unsigned buf = (unsigned)blk % NBUF;
            const int need = blk - NBUF + 1 < NBLK ? blk - NBUF + 1 : NBLK;
            while (lds_min4(cnts + 4) < need) __builtin_amdgcn_s_sleep(1);
            asm volatile("" ::: "memory");
            if (wid == 7 && blk >= NBUF) {
#pragma unroll
                for (int i = 0; i < TB * 16 / 64; ++i) {
                    const unsigned id = i * 64 + lane, st = id >> 4, rw = id & 15;
                    const unsigned tok = tokb + scan_pos((blk - NBUF) * TB + st, dir);
                    Yo[tok * 1024u + hc + rg * 16 + rw] = (bf16_t)(pk_bf16(ybuf[buf * (TB * 16) + id], 0.f) & 0xffffu);
                }
            }
            if (blk >= NBLK) continue;
            const unsigned st = wt * 16 + fr;
            const unsigned tok = tokb + scan_pos(blk * TB + st, dir);
            const unsigned lo = tok * 128u + dir * 64u + fq * 8u;
            const unsigned ro = tok * 1024u + hc + fq * 4u;
            bf16x8 lwf[2], laf[2];
#pragma unroll
            for (int kk = 0; kk < 2; ++kk) { lwf[kk] = *(const bf16x8*)(LW + lo + kk * 32); laf[kk] = *(const bf16x8*)(LA + lo + kk * 32); }
            float ssq = 0.f;
#pragma unroll
            for (int nt = 0; nt < 4; ++nt) {
                const f32x4 kkv = *(const f32x4*)(p.rwkv_k_k + po + nt * 16);
                const u32x2 c = *(const u32x2*)(Kk + ro + nt * 16);
                const float q0 = bf_lo(c[0]) * kkv[0], q1 = bf_hi(c[0]) * kkv[1], q2 = bf_lo(c[1]) * kkv[2], q3 = bf_hi(c[1]) * kkv[3];
                ssq += q0 * q0 + q1 * q1 + q2 * q2 + q3 * q3;
            }
            ssq += __shfl_xor(ssq, 16); ssq += __shfl_xor(ssq, 32);
            const float kn = __builtin_amdgcn_rsqf(fmaxf(ssq, 1e-24f));
            float* rec = ops + buf * (TB * SC_REC) + st * SC_REC + fq * 4;
            float bsum = 0.f;
#pragma unroll
            for (int n2 = 0; n2 < 2; ++n2) {
                const unsigned nt = chh * 2 + n2;
                f32x4 aw = {0.f, 0.f, 0.f, 0.f}, ai = aw;
#pragma unroll
                for (int kk = 0; kk < 2; ++kk) {
                    const bf16x8 w2f = *(const bf16x8*)(wsm + wo + nt * 1024 + kk * 32), a2f = *(const bf16x8*)(wsm + ao + nt * 1024 + kk * 32);
                    aw = __builtin_amdgcn_mfma_f32_16x16x32_bf16(w2f, lwf[kk], aw, 0, 0, 0);
                    ai = __builtin_amdgcn_mfma_f32_16x16x32_bf16(a2f, laf[kk], ai, 0, 0, 0);
                }
                const f32x4 w0v = *(const f32x4*)(p.rwkv_decay_w0 + dir * 1024u + po + nt * 16), a0v = *(const f32x4*)(p.rwkv_iclr_a0 + dir * 1024u + po + nt * 16);
                const f32x4 kkv = *(const f32x4*)(p.rwkv_k_k + po + nt * 16);
                const f32x4 kav = *(const f32x4*)(p.rwkv_k_a + po + nt * 16), rkv = *(const f32x4*)(p.rwkv_r_k + po + nt * 16);
                const u32x2 a = *(const u32x2*)(R + ro + nt * 16), c = *(const u32x2*)(Kk + ro + nt * 16);
                const f32x4 rr = {bf_lo(a[0]), bf_hi(a[0]), bf_lo(a[1]), bf_hi(a[1])};
                const f32x4 kr = {bf_lo(c[0]), bf_hi(c[0]), bf_lo(c[1]), bf_hi(c[1])};
                f32x4 wv, kd, bb, aa;
#pragma unroll
                for (int j = 0; j < 4; ++j) {
                    const float sg = __builtin_amdgcn_rcpf(1.0f + __builtin_amdgcn_exp2f(-(w0v[j] + aw[j]) * LOG2E));
                    wv[j] = __builtin_amdgcn_exp2f(sg * (-0.6065306597126334f * LOG2E));
                    const float ic = __builtin_amdgcn_rcpf(1.0f + __builtin_amdgcn_exp2f(-(a0v[j] + ai[j]) * LOG2E));
                    const float kkn = kr[j] * kkv[j] * kn;
                    kd[j] = kr[j] * (1.0f + (ic - 1.0f) * kav[j]);
                    bb[j] = kkn * ic;
                    aa[j] = -kkn;
                    bsum += rr[j] * kd[j] * rkv[j];
                }
                *(f32x4*)(rec + 0 * 64 + nt * 16) = wv;
                *(f32x4*)(rec + 1 * 64 + nt * 16) = kd;
                *(f32x4*)(rec + 2 * 64 + nt * 16) = bb;
                *(f32x4*)(rec + 3 * 64 + nt * 16) = aa;
                *(f32x4*)(rec + 4 * 64 + nt * 16) = rr;
            }
            bsum += __shfl_xor(bsum, 16); bsum += __shfl_xor(bsum, 32);
            if (rg == 0 && fq == 0) bonus[((chh * 2 + dir) * TTOT + tok) * 16u + hd] = bsum;
            if (wid == 6) {
                bf16_t vr[TB * 16 / 64];
#pragma unroll
                for (int i = 0; i < TB * 16 / 64; ++i) {
                    const unsigned id = i * 64 + lane, s2 = id >> 4, rw = id & 15;
                    const unsigned tk = tokb + scan_pos(blk * TB + s2, dir);
                    vr[i] = V[tk * 1024u + hc + rg * 16 + rw];
                }
#pragma unroll
                for (int i = 0; i < TB * 16 / 64; ++i) vbuf[buf * (TB * 16) + i * 64 + lane] = bf2f(vr[i]);
            }
            asm volatile("s_waitcnt lgkmcnt(0)" ::: "memory");
            if (lane == 0) lds_publish(cnts + (wid - 4), blk + 1);
        }
    }
    __syncthreads();
}

constexpr int CH = 16, NCHK = PTOT / CH;
constexpr int NPREP = 7, NSLOT = 2;
constexpr int TKS = 72, KTS = 20, SMS = 20;
constexpr int SL_PT = 0, SL_QM = SL_PT + 64 * TKS * 2, SL_RT = SL_QM + 64 * KTS * 2, SL_G2 = SL_RT + 16 * TKS * 2, SL_VT = SL_G2 + 16 * SMS * 2, SL_WC = SL_VT + 16 * SMS * 2,
              SLOT_BYTES = SL_WC + 64 * 4;
constexpr int XTK_B = 16 * TKS * 2, XKT_B = 64 * KTS * 2, SM_B = 16 * SMS * 2;
constexpr int PR_XA = 0, PR_XB = PR_XA + XTK_B, PR_XK = PR_XB + XTK_B, PR_XR = PR_XK + XTK_B, PR_TA = PR_XR + XTK_B, PR_TB = PR_TA + XKT_B, PR_TK = PR_TB + XKT_B,
              PR_SN = PR_TK + XKT_B, PREP_BYTES = PR_SN + 2 * SM_B;
static_assert(10 * SM_B <= 3 * XTK_B, "matrices fit in XA..XK");
constexpr int SC2_SMEM = NSLOT * SLOT_BYTES + NPREP * PREP_BYTES + 64 + 5 * 64 * 4;
typedef short s16x4v __attribute__((ext_vector_type(4)));
DI f32x4 mfma16(s16x4v a, s16x4v b, f32x4 c) { return __builtin_amdgcn_mfma_f32_16x16x16bf16_1k(a, b, c, 0, 0, 0); }
DI f32x4 mfma32(bf16x8 a, bf16x8 b, f32x4 c) { return __builtin_amdgcn_mfma_f32_16x16x32_bf16(a, b, c, 0, 0, 0); }
DI s16x4v ld4(const bf16_t* q) { return *(const s16x4v*)q; }
DI f32x4 up4(u32x2 w) { return (f32x4){bf_lo(w[0]), bf_hi(w[0]), bf_lo(w[1]), bf_hi(w[1])}; }
DI f32x4 ld4f(const bf16_t* q) { return up4(*(const u32x2*)q); }
DI void st4(bf16_t* q, f32x4 v) { u32x2 w; w[0] = pk_bf16(v[0], v[1]); w[1] = pk_bf16(v[2], v[3]); *(u32x2*)q = w; }
#define LDS_WAIT() asm volatile("s_waitcnt lgkmcnt(0)" ::: "memory")
template <int CTRL> DI float dpp_shr_add(float v) { return v + __builtin_bit_cast(float, __builtin_amdgcn_update_dpp(0, __builtin_bit_cast(int, v), CTRL, 0xf, 0xf, true)); }
DI float row16_prefix(float v) { v = dpp_shr_add<0x111>(v); v = dpp_shr_add<0x112>(v); v = dpp_shr_add<0x114>(v); v = dpp_shr_add<0x118>(v); return v; }
DI f32x4 mm16(const bf16_t* A, const bf16_t* Bt, int fr, int fq) {
    const s16x4v a = ld4(A + fr * SMS + fq * 4), b = ld4(Bt + fr * SMS + fq * 4);
    LDS_WAIT();
    return mfma16(a, b, (f32x4){0.f, 0.f, 0.f, 0.f});
}
DI f32x4 mm16p(const bf16_t* A, const bf16_t* Bt, const bf16_t* Add, int fr, int fq) {
    const s16x4v a = ld4(A + fr * SMS + fq * 4), b = ld4(Bt + fr * SMS + fq * 4);
    const u32x2 c = *(const u32x2*)(Add + fr * SMS + fq * 4);
    LDS_WAIT();
    return mfma16(a, b, up4(c));
}

DI void scan_unit_chunked(const Params& p, int u, char* smem) {
    const int t = tidx(), lane = t & 63, wid = __builtin_amdgcn_readfirstlane(t >> 6);
    const unsigned rg = u & 3, dir = (u >> 2) & 1, hd = (u >> 3) & 15, b = u >> 7;
    const unsigned tokb = b * PTOT, hc = hd * 64;
    const unsigned fr = lane & 15, fq = lane >> 4;
    char* slots = smem;
    char* prep0 = smem + NSLOT * SLOT_BYTES;
    int* cnts = (int*)(smem + NSLOT * SLOT_BYTES + NPREP * PREP_BYTES);
    const bf16_t* R = (const bf16_t*)(p.ws + OFF_SCR + S_R);
    const bf16_t* Kk = (const bf16_t*)(p.ws + OFF_SCR + S_KK);
    const bf16_t* V = (const bf16_t*)(p.ws + OFF_SCR + S_V);
    const bf16_t* LW = (const bf16_t*)(p.ws + OFF_SCR + S_LW);
    const bf16_t* LA = (const bf16_t*)(p.ws + OFF_SCR + S_LA);
    bf16_t* Yo = dir ? (bf16_t*)(p.ws + OFF_SCR + S_Y1) : (bf16_t*)(p.ws + OFF_H);
    float* bonus = (float*)(p.ws + OFF_BONUS2);
    float* prm = (float*)(cnts + 16);
    if (t < 16) cnts[t] = 0;
    if (t < 64) {
        prm[t] = p.rwkv_decay_w0[dir * 1024u + hc + t]; prm[64 + t] = p.rwkv_iclr_a0[dir * 1024u + hc + t];
        prm[128 + t] = p.rwkv_k_k[hc + t]; prm[192 + t] = p.rwkv_k_a[hc + t]; prm[256 + t] = p.rwkv_r_k[hc + t];
    }
    __syncthreads();

    if (wid == 0) {
        __builtin_amdgcn_s_setprio(3);
        f32x4 st[4];
#pragma unroll
        for (int m = 0; m < 4; ++m) st[m] = (f32x4){0.f, 0.f, 0.f, 0.f};
        for (int c = 0; c < NCHK; ++c) {
            const unsigned sl = (unsigned)c % NSLOT;
            const char* S = slots + sl * SLOT_BYTES;
            while (*(volatile LAS int*)(cnts + sl) < c + 1) __builtin_amdgcn_s_sleep(1);
            LDS_WAIT();
            const s16x4v vt = ld4((const bf16_t*)(S + SL_VT) + fr * SMS + fq * 4);
            const s16x4v g2 = ld4((const bf16_t*)(S + SL_G2) + fr * SMS + fq * 4);
            s16x4v rtl[2], rth[2], ptl[4][2], pth[4][2], qm[4];
            f32x4 wc[4];
#pragma unroll
            for (int i = 0; i < 2; ++i) { const bf16_t* q = (const bf16_t*)(S + SL_RT) + fr * TKS + 32 * i + fq * 4; rtl[i] = ld4(q); rth[i] = ld4(q + 16); }
#pragma unroll
            for (int m = 0; m < 4; ++m) {
                wc[m] = *(const f32x4*)((const float*)(S + SL_WC) + 16 * m + fq * 4);
                qm[m] = ld4((const bf16_t*)(S + SL_QM) + (16 * m + fr) * KTS + fq * 4);
#pragma unroll
                for (int i = 0; i < 2; ++i) { const bf16_t* q = (const bf16_t*)(S + SL_PT) + (16 * m + fr) * TKS + 32 * i + fq * 4; ptl[m][i] = ld4(q); pth[m][i] = ld4(q + 16); }
            }
            LDS_WAIT();
            if (lane == 0) *(volatile LAS int*)(cnts + 8) = c + 1;
            bf16x8 sb[2];
#pragma unroll
            for (int i = 0; i < 2; ++i) {
                u32x4 w; w[0] = pk_bf16(st[2 * i][0], st[2 * i][1]); w[1] = pk_bf16(st[2 * i][2], st[2 * i][3]); w[2] = pk_bf16(st[2 * i + 1][0], st[2 * i + 1][1]); w[3] = pk_bf16(st[2 * i + 1][2], st[2 * i + 1][3]);
                sb[i] = __builtin_bit_cast(bf16x8, w);
            }
            f32x4 y = {0.f, 0.f, 0.f, 0.f};
#pragma unroll
            for (int i = 0; i < 2; ++i) y = mfma32(__builtin_shufflevector(rtl[i], rth[i], 0, 1, 2, 3, 4, 5, 6, 7), sb[i], y);
            y = mfma16(g2, vt, y);
#pragma unroll
            for (int m = 0; m < 4; ++m) {
                f32x4 acc = st[m] * wc[m];
#pragma unroll
                for (int i = 0; i < 2; ++i) acc = mfma32(__builtin_shufflevector(ptl[m][i], pth[m][i], 0, 1, 2, 3, 4, 5, 6, 7), sb[i], acc);
                st[m] = mfma16(qm[m], vt, acc);
            }

#pragma unroll
            for (int j = 0; j < 4; ++j) {
                const unsigned tok = tokb + scan_pos(c * CH + fq * 4 + j, dir);
                Yo[tok * 1024u + hc + rg * 16 + fr] = (bf16_t)(pk_bf16(y[j], 0.f) & 0xffffu);
            }
        }
        __builtin_amdgcn_s_setprio(0);
    } else {
        const unsigned pid = wid - 1;
        char* PS = prep0 + pid * PREP_BYTES;
        bf16_t* XA = (bf16_t*)(PS + PR_XA); bf16_t* XB = (bf16_t*)(PS + PR_XB); bf16_t* XK = (bf16_t*)(PS + PR_XK); bf16_t* XR = (bf16_t*)(PS + PR_XR);
        bf16_t* TA = (bf16_t*)(PS + PR_TA); bf16_t* TB_ = (bf16_t*)(PS + PR_TB); bf16_t* TK = (bf16_t*)(PS + PR_TK); bf16_t* AT = TA;
        bf16_t* SN = (bf16_t*)(PS + PR_SN);
        bf16_t *M = SN, *NABR = SN + 1 * 16 * SMS;
        bf16_t *M2 = XA, *M2T = XA + 1 * 16 * SMS, *M4 = XA + 2 * 16 * SMS, *M4T = XA + 3 * 16 * SMS, *X1 = XA + 4 * 16 * SMS, *G1 = XA + 5 * 16 * SMS, *NAKR = XA + 6 * 16 * SMS,
                *NRBT = XA + 7 * 16 * SMS, *NRKT = XA + 8 * 16 * SMS, *IM = XA + 9 * 16 * SMS;
        bf16_t *M8T = M2, *X2 = M2T, *TT = M4;
        float* WCP = (float*)SN;
        const bf16_t* wsm = (const bf16_t*)(p.ws + OFF_WS);
        const unsigned wo = W_W2 + dir * 65536u + (hc + fr) * 64u + fq * 8u;
        const unsigned ao = W_A2 + dir * 65536u + (hc + fr) * 64u + fq * 8u;
        const unsigned po = hc + fq * 4u;
        const f32x4 z4 = {0.f, 0.f, 0.f, 0.f};
        bf16x8 lwf[2], laf[2], lwn[2], lan[2];
        u32x2 krw[4], rrw[4], krn[4], rrn[4];
        unsigned tok_cur = 0, tok_nxt = 0;
        auto issue = [&](int c, bf16x8 (&lw)[2], bf16x8 (&la)[2], u32x2 (&kw)[4], u32x2 (&rw)[4], unsigned& tk) {
            tk = tokb + scan_pos(c * CH + fr, dir);
            const unsigned lo = tk * 128u + dir * 64u + fq * 8u, ro = tk * 1024u + hc + fq * 4u;
#pragma unroll
            for (int kk = 0; kk < 2; ++kk) { lw[kk] = *(const bf16x8*)(LW + lo + kk * 32); la[kk] = *(const bf16x8*)(LA + lo + kk * 32); }
#pragma unroll
            for (int nt = 0; nt < 4; ++nt) { kw[nt] = *(const u32x2*)(Kk + ro + nt * 16); rw[nt] = *(const u32x2*)(R + ro + nt * 16); }
        };
        if ((int)pid < NCHK) issue(pid, lwf, laf, krw, rrw, tok_cur);
        for (int c = pid; c < NCHK; c += NPREP) {
            if (c + NPREP < NCHK) issue(c + NPREP, lwn, lan, krn, rrn, tok_nxt);
            const unsigned tok = tok_cur;
            float ssq = 0.f;
#pragma unroll
            for (int nt = 0; nt < 4; ++nt) {
                const f32x4 kkv = *(const f32x4*)(prm + 128 + fq * 4 + nt * 16);
                const f32x4 q = up4(krw[nt]) * kkv;
                ssq += q[0] * q[0] + q[1] * q[1] + q[2] * q[2] + q[3] * q[3];
            }
            ssq += __shfl_xor(ssq, 16); ssq += __shfl_xor(ssq, 32);
            const float kn = __builtin_amdgcn_rsqf(fmaxf(ssq, 1e-24f));
            float bsum = 0.f;
#pragma unroll
            for (int nt = 0; nt < 4; ++nt) {
                f32x4 aw = z4, ai = z4;
#pragma unroll
                for (int kk = 0; kk < 2; ++kk) {
                    const bf16x8 w2f = *(const bf16x8*)(wsm + wo + nt * 1024 + kk * 32), a2f = *(const bf16x8*)(wsm + ao + nt * 1024 + kk * 32);
                    aw = mfma32(w2f, lwf[kk], aw);
                    ai = mfma32(a2f, laf[kk], ai);
                }
                const f32x4 w0v = *(const f32x4*)(prm + fq * 4 + nt * 16), a0v = *(const f32x4*)(prm + 64 + fq * 4 + nt * 16);
                const f32x4 kkv = *(const f32x4*)(prm + 128 + fq * 4 + nt * 16);
                const f32x4 kav = *(const f32x4*)(prm + 192 + fq * 4 + nt * 16), rkv = *(const f32x4*)(prm + 256 + fq * 4 + nt * 16);
                const f32x4 rr = up4(rrw[nt]), krn4 = up4(krw[nt]);
                f32x4 at, rt, bt, kt;
#pragma unroll
                for (int j = 0; j < 4; ++j) {
                    const float e = 0.6065306597126334f * __builtin_amdgcn_rcpf(1.0f + __builtin_amdgcn_exp2f(-(w0v[j] + aw[j]) * LOG2E));
                    const float ic = __builtin_amdgcn_rcpf(1.0f + __builtin_amdgcn_exp2f(-(a0v[j] + ai[j]) * LOG2E));
                    const float kkn = krn4[j] * kkv[j] * kn;
                    const float kd = krn4[j] * (1.0f + (ic - 1.0f) * kav[j]);
                    bsum += rr[j] * kd * rkv[j];
                    const float ec = row16_prefix(e);
                    const float wt = __builtin_amdgcn_exp2f(-ec * LOG2E);
                    const float wi = __builtin_amdgcn_exp2f(ec * LOG2E);
                    const float wp = __builtin_bit_cast(float, __builtin_amdgcn_update_dpp(0x3f800000, __builtin_bit_cast(int, wt), 0x111, 0xf, 0xf, false));
                    at[j] = -kkn * wp; rt[j] = rr[j] * wt; bt[j] = kkn * ic * wi; kt[j] = kd * wi;
                    TA[(nt * 16 + fq * 4 + j) * KTS + fr] = (bf16_t)(pk_bf16(at[j], 0.f) & 0xffffu);
                    TB_[(nt * 16 + fq * 4 + j) * KTS + fr] = (bf16_t)(pk_bf16(bt[j], 0.f) & 0xffffu);
                    TK[(nt * 16 + fq * 4 + j) * KTS + fr] = (bf16_t)(pk_bf16(kt[j], 0.f) & 0xffffu);
                    if (fr == 15) WCP[nt * 16 + fq * 4 + j] = wt;
                }
                st4(XA + fr * TKS + nt * 16 + fq * 4, at); st4(XR + fr * TKS + nt * 16 + fq * 4, rt);
                st4(XB + fr * TKS + nt * 16 + fq * 4, bt); st4(XK + fr * TKS + nt * 16 + fq * 4, kt);
            }
            bsum += __shfl_xor(bsum, 16); bsum += __shfl_xor(bsum, 32);
            if (rg == 0 && fq == 0) { bonus[((0 * 2 + dir) * TTOT + tok) * 16u + hd] = bsum; bonus[((1 * 2 + dir) * TTOT + tok) * 16u + hd] = 0.f; }
            LDS_WAIT();
            float wcr[4];
#pragma unroll
            for (int n = 0; n < 4; ++n) wcr[n] = WCP[16 * n + fr];
            bf16x8 fa[2], fb[2], fk[2], frr[2];
#pragma unroll
            for (int kk = 0; kk < 2; ++kk) {
                fa[kk] = *(const bf16x8*)(XA + fr * TKS + kk * 32 + fq * 8); fb[kk] = *(const bf16x8*)(XB + fr * TKS + kk * 32 + fq * 8);
                fk[kk] = *(const bf16x8*)(XK + fr * TKS + kk * 32 + fq * 8); frr[kk] = *(const bf16x8*)(XR + fr * TKS + kk * 32 + fq * 8);
            }
            LDS_WAIT();
            f32x4 d1 = z4, d2 = z4, d3 = z4, d4 = z4, d5 = z4;
#pragma unroll
            for (int kk = 0; kk < 2; ++kk) {
                d1 = mfma32(fb[kk], fa[kk], d1);
                d2 = mfma32(fa[kk], fb[kk], d2);
                d3 = mfma32(fa[kk], fk[kk], d3);
                d4 = mfma32(fb[kk], frr[kk], d4);
                d5 = mfma32(fk[kk], frr[kk], d5);
            }
            f32x4 im;
#pragma unroll
            for (int j = 0; j < 4; ++j) {
                const unsigned ij = fq * 4 + j;
                d1[j] = ij < fr ? d1[j] : 0.f;
                d2[j] = fr < ij ? d2[j] : 0.f;
                d3[j] = fr < ij ? d3[j] : 0.f;
                d4[j] = ij <= fr ? d4[j] : 0.f;
                d5[j] = ij <= fr ? d5[j] : 0.f;
                im[j] = d1[j] + (ij == fr ? 1.0f : 0.f);
            }
            st4(M + fr * SMS + fq * 4, d1);
            st4(IM + fr * SMS + fq * 4, im);
            st4(NABR + fr * SMS + fq * 4, d2);
            st4(NAKR + fr * SMS + fq * 4, d3);
            st4(NRBT + fr * SMS + fq * 4, d4);
            st4(NRKT + fr * SMS + fq * 4, d5);
            LDS_WAIT();
            const int so = fr * SMS + fq * 4;
            {
                const s16x4v m = ld4(M + so), mt = ld4(NABR + so);
                LDS_WAIT();
                st4(M2T + so, mfma16(m, mt, z4)); st4(M2 + so, mfma16(mt, m, z4));
                LDS_WAIT();
            }
            {
                const s16x4v m2 = ld4(M2 + so), m2t = ld4(M2T + so); const u32x2 imr = *(const u32x2*)(IM + so);
                LDS_WAIT();
                st4(M4T + so, mfma16(m2, m2t, z4)); st4(M4 + so, mfma16(m2t, m2, z4));
                st4(X1 + so, mfma16(m2t, __builtin_bit_cast(s16x4v, imr), up4(imr)));
                LDS_WAIT();
            }
            {
                const s16x4v m4 = ld4(M4 + so), m4t = ld4(M4T + so); const u32x2 x1r = *(const u32x2*)(X1 + so);
                LDS_WAIT();
                st4(M8T + so, mfma16(m4, m4t, z4));
                st4(X2 + so, mfma16(m4t, __builtin_bit_cast(s16x4v, x1r), up4(x1r)));
                LDS_WAIT();
            }
            {
                const s16x4v m8t = ld4(M8T + so); const u32x2 x2r = *(const u32x2*)(X2 + so);
                LDS_WAIT();
                st4(TT + so, mfma16(m8t, __builtin_bit_cast(s16x4v, x2r), up4(x2r)));
                LDS_WAIT();
            }
            {
                const s16x4v ta = ld4(TT + so), nk = ld4(NAKR + so);
                s16x4v xa[4];
#pragma unroll
                for (int n = 0; n < 4; ++n) xa[n] = ld4(TA + (16 * n + fr) * KTS + fq * 4);
                LDS_WAIT();
                st4(G1 + so, mfma16(ta, nk, z4));
#pragma unroll
                for (int n = 0; n < 4; ++n) st4(AT + (16 * n + fr) * KTS + fq * 4, mfma16(ta, xa[n], z4));
                LDS_WAIT();
            }
            const unsigned sl = (unsigned)c % NSLOT;
            char* S = slots + sl * SLOT_BYTES;
            {
                unsigned vv[2][2];
#pragma unroll
                for (int i = 0; i < 2; ++i) {
                    const unsigned q = i * 64 + lane, vrow = q & 15, sp = q >> 4;
                    const unsigned tk0 = tokb + scan_pos(c * CH + 2 * sp, dir), tk1 = tokb + scan_pos(c * CH + 2 * sp + 1, dir);
                    vv[i][0] = V[tk0 * 1024u + hc + rg * 16 + vrow]; vv[i][1] = V[tk1 * 1024u + hc + rg * 16 + vrow];
                }
                const s16x4v nrb = ld4(NRBT + so), g1 = ld4(G1 + so);
                const u32x2 nrk = *(const u32x2*)(NRKT + so);
                s16x4v atm[4], tb[4]; u32x2 xr[4], tk[4];
#pragma unroll
                for (int m = 0; m < 4; ++m) {
                    atm[m] = ld4(AT + (16 * m + fr) * KTS + fq * 4); tb[m] = ld4(TB_ + (16 * m + fr) * KTS + fq * 4);
                    xr[m] = *(const u32x2*)(XR + fr * TKS + 16 * m + fq * 4); tk[m] = *(const u32x2*)(TK + (16 * m + fr) * KTS + fq * 4);
                }
                LDS_WAIT();
                while (*(volatile LAS int*)(cnts + 8) < c - NSLOT + 1) __builtin_amdgcn_s_sleep(1);
                asm volatile("" ::: "memory");
                st4((bf16_t*)(S + SL_G2) + so, mfma16(g1, nrb, up4(nrk)));
#pragma unroll
                for (int m = 0; m < 4; ++m) {
                    st4((bf16_t*)(S + SL_RT) + fr * TKS + 16 * m + fq * 4, mfma16(atm[m], nrb, up4(xr[m])));
#pragma unroll
                    for (int n = 0; n < 4; ++n) st4((bf16_t*)(S + SL_PT) + (16 * n + fr) * TKS + 16 * m + fq * 4, mfma16(atm[m], tb[n], z4) * wcr[n]);
                    asm volatile("" ::: "memory");
                }
#pragma unroll
                for (int n = 0; n < 4; ++n) st4((bf16_t*)(S + SL_QM) + (16 * n + fr) * KTS + fq * 4, mfma16(g1, tb[n], up4(tk[n])) * wcr[n]);
                ((float*)(S + SL_WC))[lane] = (fq == 0) ? wcr[0] : (fq == 1) ? wcr[1] : (fq == 2) ? wcr[2] : wcr[3];
#pragma unroll
                for (int i = 0; i < 2; ++i) {
                    const unsigned q = i * 64 + lane, vrow = q & 15, sp = q >> 4;
                    *(unsigned*)((bf16_t*)(S + SL_VT) + vrow * SMS + 2 * sp) = vv[i][0] | (vv[i][1] << 16);
                }
            }
            LDS_WAIT();
            if (lane == 0) *(volatile LAS int*)(cnts + sl) = c + 1;
#pragma unroll
            for (int kk = 0; kk < 2; ++kk) { lwf[kk] = lwn[kk]; laf[kk] = lan[kk]; }
#pragma unroll
            for (int nt = 0; nt < 4; ++nt) { krw[nt] = krn[nt]; rrw[nt] = rrn[nt]; }
            tok_cur = tok_nxt;
        }
    }
    __syncthreads();
}

DI void phase_scan(const Params& p, char* smem) {
    for (int u = blockIdx.x; u < NBATCH * 16 * 2 * 4; u += gridDim.x) scan_unit_chunked(p, u, smem);
}

constexpr int NPHASE = 18;
constexpr int SMEM_BYTES = (SC2_SMEM > SC_SMEM ? SC2_SMEM : SC_SMEM) + 64;
static_assert(SMEM_BYTES >= GEMM_SMEM + 64 && SMEM_BYTES + 16 <= 163840, "LDS");
template <int PH> DI void run_phase(const Params& p, char* smem) {
    if constexpr (PH == 0) phase_prologue(p, smem);
    else if constexpr (PH == 1) phase_norm0(p);
    else if constexpr (PH == 2) phase_qkv(p, smem);
    else if constexpr (PH == 3) phase_attn(p, smem);
    else if constexpr (PH == 4) phase_wout(p, smem);
    else if constexpr (PH == 5) phase_ffn_norm_route(p, 0, smem);
    else if constexpr (PH == 6) phase_moe1(p, 0, smem);
    else if constexpr (PH == 7) phase_moe2(p, 0, smem);
    else if constexpr (PH == 8) phase_combine_l0(p, smem);
    else if constexpr (PH == 9) phase_xx(p);
    else if constexpr (PH == 10) phase_rwkv_proj(p, smem);
    else if constexpr (PH == 11) phase_scan(p, smem);
    else if constexpr (PH == 12) phase_gate(p, smem);
    else if constexpr (PH == 13) phase_wo(p, smem);
    else if constexpr (PH == 14) phase_ffn_norm_route(p, 1, smem);
    else if constexpr (PH == 15) phase_moe1(p, 1, smem);
    else if constexpr (PH == 16) phase_moe2(p, 1, smem);
    else if constexpr (PH == 17) phase_final(p);
}
template <int PH, int END> struct PhaseSeq {
    static DI void run(const Params& p, char* smem, const XcdBarrier& bar) {
        run_phase<PH>(p, smem);
        if constexpr (PH + 1 < END) { xcd_barrier(bar); PhaseSeq<PH + 1, END>::run(p, smem, bar); }
    }
};
template <int BEG, int END>
__global__ void __launch_bounds__(NTH, 2) fwd_kernel(Params p) {
    extern __shared__ __attribute__((aligned(16))) char smem_raw[];
    char* smem = smem_raw + 16;
    if constexpr (END - BEG > 1) {
        if (tidx() == 0) *(uint4*)smem_raw = make_uint4(0u, 0u, 0u, 0u);
        __syncthreads();
        XcdBarrier bar = xcd_barrier_post((unsigned*)(p.ws + OFF_BAR), (volatile LAS unsigned*)smem_raw);
        PhaseSeq<BEG, END>::run(p, smem, bar);
    } else {
        run_phase<BEG>(p, smem);
    }
}

template <int BEG, int END> static void launch_range(const Params& p, int grid, hipStream_t stream) {
    (void)hipFuncSetAttribute((const void*)fwd_kernel<BEG, END>, hipFuncAttributeMaxDynamicSharedMemorySize, SMEM_BYTES + 16);
    hipLaunchKernelGGL((fwd_kernel<BEG, END>), dim3(grid), dim3(NTH), SMEM_BYTES + 16, stream, p);
}
#ifndef RUN_PHASES
#define RUN_PHASES NPHASE
#endif
#ifndef REPEAT_PHASE
#define REPEAT_PHASE -1
#endif
template <int PH> static void launch_each(const Params& p, int grid, hipStream_t stream) {
    launch_range<PH, PH + 1>(p, grid, stream);
    if (PH == REPEAT_PHASE) launch_range<PH, PH + 1>(p, grid, stream);
    if constexpr (PH + 1 < RUN_PHASES) launch_each<PH + 1>(p, grid, stream);
}

extern "C" void kernel_launch(void* const* d_in, const int* in_sizes, int n_in, void* d_out, int out_size, void* d_ws, size_t ws_size, hipStream_t stream) {
    Params p{};
    const float** f = (const float**)&p;
    for (int i = 0; i < 37; ++i) f[i] = (const float*)d_in[i];
    p.out = (float*)d_out;
    p.ws = (char*)d_ws;
    if (ws_size < WS_NEED || n_in < 37) return;
    static int grid = 0;
    if (!grid) {
        int dev = 0, cus = 0;
        (void)hipGetDevice(&dev);
        (void)hipDeviceGetAttribute(&cus, hipDeviceAttributeMultiprocessorCount, dev);
        grid = cus > 0 ? cus : 256;
    }
    (void)hipMemsetAsync(d_ws, 0, 32768, stream);
#if MEGA
    launch_range<0, NPHASE>(p, grid, stream);
#else
    launch_each<0>(p, grid, stream);
#endif
}
```

```cpp
#include <hip/hip_runtime.h>
#include <stdint.h>
#include <stdio.h>

#ifndef MEGA
#define MEGA 1
#endif

typedef unsigned short bf16_t;
typedef short bf16x8 __attribute__((ext_vector_type(8)));
typedef short s16x4 __attribute__((ext_vector_type(4)));
typedef float f32x2 __attribute__((ext_vector_type(2)));
typedef float f32x4 __attribute__((ext_vector_type(4)));
typedef float f32x16 __attribute__((ext_vector_type(16)));
typedef unsigned u32x2 __attribute__((ext_vector_type(2)));
typedef unsigned u32x4 __attribute__((ext_vector_type(4)));
typedef __bf16 bf16x2_t __attribute__((ext_vector_type(2)));
#define DI __device__ __forceinline__
__device__ __forceinline__ unsigned tidx() { unsigned t = threadIdx.x; asm volatile("" : "+v"(t)); return t; }

constexpr int DM = 1024, NBATCH = 2, SEQ = 16384, LCTX = 256, PTOT = SEQ + LCTX, TTOT = NBATCH * PTOT;
constexpr int NTH = 512, NWAVE = 8;
constexpr int QKV_N = 1536;
constexpr int NEXP = 16, CAP = TTOT * 2;
constexpr float RMS_EPS = 1e-6f, GN_EPS = 64e-5f;
constexpr float LOG2E = 1.4426950408889634f;

constexpr size_t MBy = 1u << 20;
constexpr size_t OFF_BAR   = 0;
constexpr size_t OFF_CNT   = 16384;
constexpr size_t OFF_MOD   = 32768;
constexpr size_t OFF_ROPE  = OFF_MOD + 2 * 3 * 6144 * 4;
constexpr size_t OFF_BONUS = 1 * MBy;
constexpr size_t OFF_BONUS2 = 6 * MBy;
constexpr size_t OFF_STOK  = 6 * MBy;
constexpr size_t OFF_SW    = 11 * MBy;
constexpr size_t OFF_XC    = 16 * MBy;
constexpr size_t OFF_WS    = 18 * MBy;
constexpr size_t OFF_MOEW  = 33 * MBy;
constexpr size_t OFF_H     = 129 * MBy;
constexpr size_t OFF_SCR   = 194 * MBy;
constexpr size_t SCR_SIZE  = 290 * MBy;
constexpr size_t WS_NEED   = OFF_SCR + SCR_SIZE;
constexpr size_t W_IN = 0, W_OUT = W_IN + 1536 * 1024, W_R = W_OUT + 1024 * 1024, W_K = W_R + 1024 * 1024, W_V = W_K + 1024 * 1024,
                 W_O = W_V + 1024 * 1024, W_W1 = W_O + 1024 * 1024, W_A1 = W_W1 + 128 * 1024, W_G1 = W_A1 + 128 * 1024,
                 W_W2 = W_G1 + 256 * 1024, W_A2 = W_W2 + 2 * 1024 * 64, W_G2 = W_A2 + 2 * 1024 * 64, W_END = W_G2 + 1024 * 192;
static_assert(W_END * 2 <= 15 * MBy, "small weights region");
constexpr size_t ROWB = (size_t)TTOT * 2048;
constexpr size_t S_Q = 0, S_K = S_Q + ROWB, S_VT = S_K + ROWB / 4, S_O = S_VT + ROWB / 4;
constexpr size_t S_HID = 0, S_Y = 140 * MBy;
constexpr size_t S_R = 0, S_KK = S_R + ROWB, S_V = S_KK + ROWB, S_LW = S_V + ROWB, S_LA = S_LW + ROWB / 8, S_LG = S_LA + ROWB / 8,
                 S_Y1 = 224 * MBy, S_XX = S_Y1, S_OR = S_R;
static_assert(S_O + ROWB <= SCR_SIZE, "scr");
static_assert(S_LG + (size_t)TTOT * 384 <= S_Y1, "scr2");
static_assert(S_Y1 + ROWB <= SCR_SIZE, "scr3");
static_assert(S_Y + 2 * ROWB <= SCR_SIZE, "scr4");
static_assert((size_t)(CAP / 256 + 16) * 256 * 2048 <= S_Y, "hid");
static_assert(OFF_H + ROWB <= OFF_SCR, "h");

struct Params {
    const float *x, *c, *ctx, *c_ctx, *ada_w, *ada_b, *norm_mix_g, *norm_ffn_g, *attn_w_in, *attn_w_out, *attn_sink, *attn_q_norm_g, *attn_k_norm_g,
        *rwkv_x_mix, *rwkv_w_r, *rwkv_w_k, *rwkv_w_v, *rwkv_w_o, *rwkv_decay_w0, *rwkv_decay_w1, *rwkv_decay_w2, *rwkv_iclr_a0, *rwkv_iclr_a1,
        *rwkv_iclr_a2, *rwkv_gate_g1, *rwkv_gate_g2, *rwkv_k_k, *rwkv_k_a, *rwkv_r_k, *rwkv_ln_g, *rwkv_ln_b, *router_w, *router_bias, *moe_w1,
        *moe_w3, *moe_w2, *final_norm_g;
    float* out;
    char* ws;
};

DI unsigned pk_bf16(float a, float b) { f32x2 v = {a, b}; bf16x2_t r = __builtin_convertvector(v, bf16x2_t); return __builtin_bit_cast(unsigned, r); }
DI float bf_lo(unsigned u) { return __uint_as_float(u << 16); }
DI float bf_hi(unsigned u) { return __uint_as_float(u & 0xffff0000u); }
DI float bf2f(bf16_t u) { return __uint_as_float(((unsigned)u) << 16); }
DI float wave_sum(float v) {
#pragma unroll
    for (int o = 32; o >= 1; o >>= 1) v += __shfl_xor(v, o);
    return v;
}
DI float sigmoidf_(float x) { return 1.0f / (1.0f + __expf(-x)); }
DI float siluf_(float x) { return x / (1.0f + __expf(-x)); }
DI float* xrow_ptr(const Params& p, int tok) {
    const int b = tok >= PTOT ? 1 : 0, pos = tok - b * PTOT;
    return pos < LCTX ? (float*)(p.ws + OFF_XC) + (size_t)(b * LCTX + pos) * DM : p.out + (size_t)(b * SEQ + pos - LCTX) * DM;
}
DI const float* xin_ptr(const Params& p, int tok) {
    const int b = tok >= PTOT ? 1 : 0, pos = tok - b * PTOT;
    return pos < LCTX ? p.ctx + (size_t)(b * LCTX + pos) * DM : p.x + (size_t)(b * SEQ + pos - LCTX) * DM;
}
DI const float* mod_ptr(const Params& p, int layer, int tok, int which) {
    const int b = tok >= PTOT ? 1 : 0, pos = tok - b * PTOT;
    const int w = pos < LCTX ? 2 : b;
    return (const float*)(p.ws + OFF_MOD) + (size_t)((layer * 3 + w) * 6 + which) * DM;
}

#define XB_TMO      128
#define XB_XCNT(j)  (256  + 64 * (j))
#define XB_XSUB(j)  (1280 + 64 * (j))
#define XB_XGEN(j)  (2304 + 64 * (j))
#define XB_TOP      3328
#define XB_TOPGEN   3392
#define XCD_BAR_WORDS 3456
#define XB_SPIN_CAP (1u << 18)
#define LAS __attribute__((address_space(3)))
DI unsigned xb_ld(unsigned* p)              { return __hip_atomic_load(p, __ATOMIC_RELAXED, __HIP_MEMORY_SCOPE_AGENT); }
DI unsigned xb_add(unsigned* p, unsigned v) { return __hip_atomic_fetch_add(p, v, __ATOMIC_RELAXED, __HIP_MEMORY_SCOPE_AGENT); }
DI unsigned xb_xcc_id() { return (unsigned)__builtin_amdgcn_s_getreg((3 << 11) | 20) & 0xFu; }
#define XB_SPIN(cond, bar) do { unsigned _sp = 0; while (cond) { __builtin_amdgcn_s_sleep(1); \
    if ((++_sp & 255u) == 0u) { if (xb_ld(&(bar)[XB_TMO])) break; if (_sp > XB_SPIN_CAP) { atomicAdd(&(bar)[XB_TMO], 1u); break; } } } } while (0)
struct XcdBarrier { unsigned* bar; unsigned x; volatile LAS unsigned* st; };
DI XcdBarrier xcd_barrier_post(unsigned* bar, volatile LAS unsigned* st) {
    XcdBarrier b; b.bar = bar; b.x = xb_xcc_id(); b.st = st;
    if (tidx() == 0) (void)xb_add(&bar[XB_XCNT(b.x)], 1u);
    return b;
}
DI void xcd_barrier_complete(unsigned* bar, unsigned x, unsigned& nloc, unsigned& nx) {
    const unsigned G = gridDim.x * gridDim.y * gridDim.z;
    unsigned sum, cnt, mine, sp = 0u;
    for (;;) {
        sum = 0u; cnt = 0u; mine = 0u;
#pragma unroll
        for (unsigned j = 0; j < 16; ++j) { const unsigned c = xb_ld(&bar[XB_XCNT(j)]); sum += c; cnt += (c > 0u) ? 1u : 0u; mine = (j == x) ? c : mine; }
        if (sum == G) break;
        __builtin_amdgcn_s_sleep(1);
        if ((++sp & 255u) == 0u) { if (xb_ld(&bar[XB_TMO])) break; if (sp > XB_SPIN_CAP) { atomicAdd(&bar[XB_TMO], 1u); break; } }
    }
    nloc = mine > 0u ? mine : 1u; nx = cnt > 0u ? cnt : 1u;
}
DI void xcd_barrier(const XcdBarrier& b) {
    asm volatile("s_waitcnt vmcnt(0)" ::: "memory");
    __syncthreads();
    if (tidx() == 0) {
        unsigned* bar = b.bar;
        __builtin_amdgcn_s_waitcnt(0);
        unsigned nloc = b.st[0], nx = b.st[1];
        if (nloc == 0u) { xcd_barrier_complete(bar, b.x, nloc, nx); b.st[0] = nloc; b.st[1] = nx; }
        const unsigned old = xb_add(&bar[XB_XSUB(b.x)], 1u);
        const unsigned gen = old / nloc;
        if (old + 1u == (gen + 1u) * nloc) {
            __builtin_amdgcn_fence(__ATOMIC_RELEASE, "agent");
            asm volatile("s_waitcnt vmcnt(0)" ::: "memory");
            const unsigned og = xb_add(&bar[XB_TOP], 1u);
            const unsigned tg = og / nx;
            if (og + 1u == (tg + 1u) * nx) xb_add(&bar[XB_TOPGEN], 1u);
            else XB_SPIN(xb_ld(&bar[XB_TOPGEN]) == tg, bar);
            __builtin_amdgcn_fence(__ATOMIC_ACQUIRE, "agent");
            xb_add(&bar[XB_XGEN(b.x)], 1u);
            asm volatile("s_waitcnt vmcnt(0)" ::: "memory");
        } else {
            XB_SPIN(xb_ld(&bar[XB_XGEN(b.x)]) == gen, bar);
            __builtin_amdgcn_fence(__ATOMIC_ACQUIRE, "agent");
            asm volatile("s_waitcnt vmcnt(0)" ::: "memory");
        }
    }
    __syncthreads();
}

DI void cvt_tile(const float* src, int ld, int kvalid, bool colvalid, bf16_t* dst, int dld, float* tile  ) {
    const int t = tidx();
    {
        const int k = t >> 3, c4 = (t & 7) * 4;
        f32x4 v = {0.f, 0.f, 0.f, 0.f};
        if (colvalid && k < kvalid) v = *(const f32x4*)(src + (size_t)k * ld + c4);
        tile[k * 33 + c4 + 0] = v[0]; tile[k * 33 + c4 + 1] = v[1]; tile[k * 33 + c4 + 2] = v[2]; tile[k * 33 + c4 + 3] = v[3];
    }
    __syncthreads();
    {
        const int n = t >> 4, kc = (t & 15) * 4;
        u32x2 w;
        w[0] = pk_bf16(tile[(kc + 0) * 33 + n], tile[(kc + 1) * 33 + n]);
        w[1] = pk_bf16(tile[(kc + 2) * 33 + n], tile[(kc + 3) * 33 + n]);
        *(u32x2*)(dst + (size_t)n * dld + kc) = w;
    }
    __syncthreads();
}
constexpr int CV_SMALL_UNITS = 768 + 512 * 5 + 64 + 64 + 128 + 64 + 64 + 96;
DI void cvt_small_unit(const Params& p, int u, float* tile) {
    bf16_t* wsm = (bf16_t*)(p.ws + OFF_WS);
    if (u < 768) { const int run = u >> 4, kt = u & 15; cvt_tile(p.attn_w_in + (size_t)kt * 64 * 1536 + run * 32, 1536, 64, true, wsm + W_IN + (size_t)run * 32 * 1024 + kt * 64, 1024, tile); return; }
    u -= 768;
    if (u < 512 * 5) {
        const int j = u >> 9, v = u & 511, run = v >> 4, kt = v & 15;
        const float* src = j == 0 ? p.attn_w_out : j == 1 ? p.rwkv_w_r : j == 2 ? p.rwkv_w_k : j == 3 ? p.rwkv_w_v : p.rwkv_w_o;
        const size_t dofs = j == 0 ? W_OUT : j == 1 ? W_R : j == 2 ? W_K : j == 3 ? W_V : W_O;
        cvt_tile(src + (size_t)kt * 64 * 1024 + run * 32, 1024, 64, true, wsm + dofs + (size_t)run * 32 * 1024 + kt * 64, 1024, tile); return;
    }
    u -= 512 * 5;
    if (u < 128) {
        const int j = u >> 6, v = u & 63, run = v >> 4, kt = v & 15, d = run >> 1, co = (run & 1) * 32;
        const float* src = (j == 0 ? p.rwkv_decay_w1 : p.rwkv_iclr_a1) + (size_t)d * 1024 * 64;
        cvt_tile(src + (size_t)kt * 64 * 64 + co, 64, 64, true, wsm + (j == 0 ? W_W1 : W_A1) + (size_t)run * 32 * 1024 + kt * 64, 1024, tile); return;
    }
    u -= 128;
    if (u < 128) {
        const int run = u >> 4, kt = u & 15;
        cvt_tile(p.rwkv_gate_g1 + (size_t)kt * 64 * 160 + run * 32, 160, 64, run < 5, wsm + W_G1 + (size_t)run * 32 * 1024 + kt * 64, 1024, tile); return;
    }
    u -= 128;
    if (u < 128) {
        const int j = u >> 6, v = u & 63, d = v >> 5, run = v & 31;
        const float* src = (j == 0 ? p.rwkv_decay_w2 : p.rwkv_iclr_a2) + (size_t)d * 64 * 1024;
        cvt_tile(src + run * 32, 1024, 64, true, wsm + (j == 0 ? W_W2 : W_A2) + (size_t)d * 1024 * 64 + (size_t)run * 32 * 64, 64, tile); return;
    }
    u -= 128;
    {
        const int run = u / 3, kt = u % 3;
        const int kvalid = 160 - kt * 64 > 64 ? 64 : (160 - kt * 64 < 0 ? 0 : 160 - kt * 64);
        cvt_tile(p.rwkv_gate_g2 + (size_t)kt * 64 * 1024 + run * 32, 1024, kvalid, true, wsm + W_G2 + (size_t)run * 32 * 192 + kt * 64, 192, tile);
    }
}
constexpr int CV_MOE_UNITS = 16 * (1024 + 512);
DI void cvt_moe_unit(const Params& p, int layer, int u, float* tile) {
    bf16_t* w13 = (bf16_t*)(p.ws + OFF_MOEW);
    bf16_t* w2t = w13 + (size_t)16 * 2048 * 1024;
    const int e = u / 1536, v = u % 1536;
    const size_t eo = (size_t)(layer * 16 + e) * 1024 * 1024;
    if (v < 1024) {
        const int run = v >> 4, kt = v & 15, g = run >> 1;
        const float* src = ((run & 1) ? p.moe_w3 : p.moe_w1) + eo;
        cvt_tile(src + (size_t)kt * 64 * 1024 + g * 32, 1024, 64, true, w13 + (size_t)e * 2048 * 1024 + (size_t)run * 32 * 1024 + kt * 64, 1024, tile);
    } else {
        const int w = v - 1024, run = w >> 4, kt = w & 15;
        cvt_tile(p.moe_w2 + eo + (size_t)kt * 64 * 1024 + run * 32, 1024, 64, true, w2t + (size_t)e * 1024 * 1024 + (size_t)run * 32 * 1024 + kt * 64, 1024, tile);
    }
}
DI void adaln_unit(const Params& p, int u, float* sm) {
    const int l = u / 96, n0 = (u % 96) * 64, t = tidx();
    float* sv = sm;
    float* red = sm + 3 * 1024;
    for (int i = t; i < 3 * 1024; i += NTH) { const int w = i >> 10, k = i & 1023; const float c = w < 2 ? p.c[w * 1024 + k] : p.c_ctx[k]; sv[i] = siluf_(c); }
    __syncthreads();
    const int kg = t >> 4, cl = t & 15;
    f32x4 a0 = {0, 0, 0, 0}, a1 = a0, a2 = a0;
    const float* W = p.ada_w + (size_t)l * 1024 * 6144 + n0 + cl * 4;
#pragma unroll 8
    for (int i = 0; i < 32; ++i) {
        const int k = kg + 32 * i;
        const f32x4 w = *(const f32x4*)(W + (size_t)k * 6144);
        a0 += w * sv[k]; a1 += w * sv[1024 + k]; a2 += w * sv[2048 + k];
    }
#pragma unroll
    for (int j = 0; j < 4; ++j) { red[kg * 192 + 0 * 64 + cl * 4 + j] = a0[j]; red[kg * 192 + 1 * 64 + cl * 4 + j] = a1[j]; red[kg * 192 + 2 * 64 + cl * 4 + j] = a2[j]; }
    __syncthreads();
    if (t < 192) {
        float s = 0.f;
        for (int g = 0; g < 32; ++g) s += red[g * 192 + t];
        const int w = t >> 6, n = n0 + (t & 63);
        ((float*)(p.ws + OFF_MOD))[(size_t)(l * 3 + w) * 6144 + n] = s + p.ada_b[l * 6144 + n];
    }
    __syncthreads();
}
DI void rope_unit(const Params& p, int u) {
    const int id = u * NTH + tidx();
    if (id < 320 * 16) {
        const int pi = id >> 4, f = id & 15;
        const float inv = exp2f(-(float)f * (13.287712379549449f / 16.0f));
        const float val = pi < 256 ? (float)pi : (float)(pi - 256);
        const float ang = val * inv;
        const double a = (double)ang;
        const double k = __builtin_rint(a * 0.15915494309189535);
        const float r = (float)(a - k * 6.283185307179586);
        f32x2 cs = {__cosf(r), __sinf(r)};
        ((f32x2*)(p.ws + OFF_ROPE))[id] = cs;
    }
}
DI void phase_prologue(const Params& p, char* smem) {
    float* sm = (float*)smem;
    const int nconv = CV_SMALL_UNITS + CV_MOE_UNITS;
    const int total = nconv + 192 + 10;
    for (int u = blockIdx.x; u < total; u += gridDim.x) {
        if (u < CV_SMALL_UNITS) cvt_small_unit(p, u, sm);
        else if (u < nconv) cvt_moe_unit(p, 0, u - CV_SMALL_UNITS, sm);
        else if (u < nconv + 192) adaln_unit(p, u - nconv, sm);
        else rope_unit(p, u - nconv - 192);
    }
}

DI void row_load(const float* src, f32x4 (&v)[4], int lane) {
#pragma unroll
    for (int i = 0; i < 4; ++i) v[i] = ((const f32x4*)src)[lane + 64 * i];
}
DI float row_rstd(const f32x4 (&v)[4]) {
    float ss = 0.f;
#pragma unroll
    for (int i = 0; i < 4; ++i) ss += v[i][0] * v[i][0] + v[i][1] * v[i][1] + v[i][2] * v[i][2] + v[i][3] * v[i][3];
    ss = wave_sum(ss);
    return rsqrtf(ss * (1.0f / DM) + RMS_EPS);
}
DI void row_norm_mod(const f32x4 (&v)[4], float rstd, const float* g, const float* shift, const float* scale, f32x4 (&h)[4], int lane) {
#pragma unroll
    for (int i = 0; i < 4; ++i) {
        const int c = (lane + 64 * i) * 4;
        const f32x4 g4 = *(const f32x4*)(g + c), sh = *(const f32x4*)(shift + c), sc = *(const f32x4*)(scale + c);
        h[i] = (v[i] * rstd * g4) * (1.0f + sc) + sh;
    }
}
DI void row_store_bf16(bf16_t* dst, const f32x4 (&h)[4], int lane) {
#pragma unroll
    for (int i = 0; i < 4; ++i) { u32x2 w; w[0] = pk_bf16(h[i][0], h[i][1]); w[1] = pk_bf16(h[i][2], h[i][3]); *(u32x2*)(dst + (lane + 64 * i) * 4) = w; }
}
DI void row_load_bf16(const bf16_t* src, f32x4 (&v)[4], int lane) {
#pragma unroll
    for (int i = 0; i < 4; ++i) { const u32x2 w = *(const u32x2*)(src + (lane + 64 * i) * 4); v[i][0] = bf_lo(w[0]); v[i][1] = bf_hi(w[0]); v[i][2] = bf_lo(w[1]); v[i][3] = bf_hi(w[1]); }
}

DI void phase_norm0(const Params& p) {
    const int lane = tidx() & 63, gw = blockIdx.x * NWAVE + (tidx() >> 6), nw = gridDim.x * NWAVE;
    bf16_t* H = (bf16_t*)(p.ws + OFF_H);
    for (int tok = gw; tok < TTOT; tok += nw) {
        f32x4 v[4], h[4];
        row_load(xin_ptr(p, tok), v, lane);
        const float rstd = row_rstd(v);
        row_norm_mod(v, rstd, p.norm_mix_g, mod_ptr(p, 0, tok, 0), mod_ptr(p, 0, tok, 1), h, lane);
        row_store_bf16(H + (size_t)tok * DM, h, lane);
    }
}

DI void route_row(const Params& p, const float (&lg)[16], int& e1, int& e2, float& g1, float& g2) {
    float mx = lg[0];
#pragma unroll
    for (int e = 1; e < 16; ++e) mx = fmaxf(mx, lg[e]);
    float pr[16], sum = 0.f;
#pragma unroll
    for (int e = 0; e < 16; ++e) { pr[e] = __expf(lg[e] - mx); sum += pr[e]; }
    const float inv = 1.0f / sum;
    float sel[16];
#pragma unroll
    for (int e = 0; e < 16; ++e) { pr[e] *= inv; sel[e] = pr[e] + p.router_bias[e]; }
    float best = -1e30f; int gi = 0;
#pragma unroll
    for (int g = 0; g < 4; ++g) {
        float m1 = -1e30f, m2 = -1e30f;
#pragma unroll
        for (int j = 0; j < 4; ++j) { const float s = sel[g * 4 + j]; if (s > m1) { m2 = m1; m1 = s; } else if (s > m2) m2 = s; }
        const float gs = m1 + m2;
        if (gs > best) { best = gs; gi = g; }
    }
    float s4[4], p4[4];
#pragma unroll
    for (int j = 0; j < 4; ++j) {
        s4[j] = gi == 0 ? sel[j] : gi == 1 ? sel[4 + j] : gi == 2 ? sel[8 + j] : sel[12 + j];
        p4[j] = gi == 0 ? pr[j] : gi == 1 ? pr[4 + j] : gi == 2 ? pr[8 + j] : pr[12 + j];
    }
    int i1 = 0; float b1 = s4[0];
#pragma unroll
    for (int j = 1; j < 4; ++j) if (s4[j] > b1) { b1 = s4[j]; i1 = j; }
    int i2 = i1 == 0 ? 1 : 0; float b2 = -3e38f;
#pragma unroll
    for (int j = 0; j < 4; ++j) if (j != i1 && s4[j] > b2) { b2 = s4[j]; i2 = j; }
    const float w1 = i1 == 0 ? p4[0] : i1 == 1 ? p4[1] : i1 == 2 ? p4[2] : p4[3];
    const float w2 = i2 == 0 ? p4[0] : i2 == 1 ? p4[1] : i2 == 2 ? p4[2] : p4[3];
    const float ws = 1.0f / (w1 + w2);
    e1 = gi * 4 + i1; e2 = gi * 4 + i2; g1 = w1 * ws; g2 = w2 * ws;
}
DI void phase_ffn_norm_route(const Params& p, int layer, char* smem) {
    const int lane = tidx() & 63, gw = blockIdx.x * NWAVE + (tidx() >> 6), nw = gridDim.x * NWAVE;
    float* rw = (float*)smem;
    for (int i = tidx(); i < 1024 * 16; i += NTH) rw[(i & 15) * 1024 + (i >> 4)] = p.router_w[i];
    __syncthreads();
    bf16_t* H = (bf16_t*)(p.ws + OFF_H);
    int* lcnt = (int*)(smem + 65536);
    if (tidx() < 32) lcnt[tidx()] = 0;
    int my_tok = -1, my_e1 = 0, my_e2 = 0, it = 0; float my_g1 = 0.f, my_g2 = 0.f;
    for (int tok = gw; tok < TTOT; tok += nw) {
        const int pos = tok >= PTOT ? tok - PTOT : tok;
        if (layer == 1 && pos < LCTX) continue;
        f32x4 v[4], h[4];
        row_load(xrow_ptr(p, tok), v, lane);
        const float rstd = row_rstd(v);
        row_norm_mod(v, rstd, p.norm_ffn_g + layer * DM, mod_ptr(p, layer, tok, 3), mod_ptr(p, layer, tok, 4), h, lane);
        row_store_bf16(H + (size_t)tok * DM, h, lane);
        float lg[16];
#pragma unroll
        for (int e = 0; e < 16; ++e) lg[e] = 0.f;
#pragma unroll
        for (int i = 0; i < 4; ++i)
#pragma unroll
            for (int e = 0; e < 16; ++e) {
                const f32x4 w = *(const f32x4*)(rw + e * 1024 + (lane + 64 * i) * 4);
                lg[e] += h[i][0] * w[0] + h[i][1] * w[1] + h[i][2] * w[2] + h[i][3] * w[3];
                if ((e & 3) == 3) asm volatile("" ::: "memory");
            }
#pragma unroll
        for (int e = 0; e < 16; ++e) lg[e] = wave_sum(lg[e]);
        int e1, e2; float g1, g2;
        route_row(p, lg, e1, e2, g1, g2);
        if (lane == it) { my_tok = tok; my_e1 = e1; my_e2 = e2; my_g1 = g1; my_g2 = g2; }
        ++it;
    }
    __syncthreads();
    int r1 = 0, r2 = 0;
    if (my_tok >= 0) { r1 = atomicAdd(&lcnt[my_e1], 1); r2 = atomicAdd(&lcnt[my_e2], 1); }
    __syncthreads();
    if (tidx() < 16) { const int n = lcnt[tidx()]; lcnt[16 + tidx()] = n ? atomicAdd((int*)(p.ws + OFF_CNT) + layer * 16 + tidx(), n) : 0; }
    __syncthreads();
    if (my_tok >= 0) {
        int* stok = (int*)(p.ws + OFF_STOK);
        float* sw = (float*)(p.ws + OFF_SW);
        const size_t s1 = (size_t)my_e1 * CAP + lcnt[16 + my_e1] + r1, s2 = (size_t)my_e2 * CAP + lcnt[16 + my_e2] + r2;
        stok[s1] = my_tok * 2 + 0; sw[s1] = my_g1;
        stok[s2] = my_tok * 2 + 1; sw[s2] = my_g2;
    }
    __syncthreads();
}

DI void combine_row(const Params& p, int layer, int tok, f32x4 (&v)[4], int lane) {
    const bf16_t* Y = (const bf16_t*)(p.ws + OFF_SCR + S_Y) + (size_t)tok * 2 * DM;
    const float* g5 = mod_ptr(p, layer, tok, 5);
    f32x4 y0[4], y1[4];
    row_load(xrow_ptr(p, tok), v, lane);
    row_load_bf16(Y, y0, lane); row_load_bf16(Y + DM, y1, lane);
#pragma unroll
    for (int i = 0; i < 4; ++i) { const f32x4 g = *(const f32x4*)(g5 + (lane + 64 * i) * 4); v[i] += g * (y0[i] + y1[i]); }
}
DI void phase_combine_l0(const Params& p, char* smem) {
    const int lane = tidx() & 63, gw = blockIdx.x * NWAVE + (tidx() >> 6), nw = gridDim.x * NWAVE;
    bf16_t* H = (bf16_t*)(p.ws + OFF_H);
    for (int tok = gw; tok < TTOT; tok += nw) {
        f32x4 v[4], h[4];
        combine_row(p, 0, tok, v, lane);
        float* X = xrow_ptr(p, tok);
#pragma unroll
        for (int i = 0; i < 4; ++i) ((f32x4*)X)[lane + 64 * i] = v[i];
        const float rstd = row_rstd(v);
        row_norm_mod(v, rstd, p.norm_mix_g + DM, mod_ptr(p, 1, tok, 0), mod_ptr(p, 1, tok, 1), h, lane);
        row_store_bf16(H + (size_t)tok * DM, h, lane);
    }
    __syncthreads();
    for (int u = blockIdx.x; u < CV_MOE_UNITS; u += gridDim.x) cvt_moe_unit(p, 1, u, (float*)smem);
}
DI void phase_xx(const Params& p) {
    const int lane = tidx() & 63, gw = blockIdx.x * NWAVE + (tidx() >> 6), nw = gridDim.x * NWAVE;
    const bf16_t* H = (const bf16_t*)(p.ws + OFF_H);
    bf16_t* XX = (bf16_t*)(p.ws + OFF_SCR + S_XX);
    for (int tok = gw; tok < TTOT; tok += nw) {
        const int pos = tok >= PTOT ? tok - PTOT : tok;
        const bool first = pos == 0 || pos == LCTX, last = pos == LCTX - 1 || pos == PTOT - 1;
        f32x4 hc[4], hp[4], hn[4], xx[4];
        row_load_bf16(H + (size_t)tok * DM, hc, lane);
        row_load_bf16(H + (size_t)(first ? tok : tok - 1) * DM, hp, lane);
        row_load_bf16(H + (size_t)(last ? tok : tok + 1) * DM, hn, lane);
#pragma unroll
        for (int i = 0; i < 4; ++i) {
            const f32x4 a = first ? (f32x4){0, 0, 0, 0} : hp[i], b = last ? (f32x4){0, 0, 0, 0} : hn[i];
            xx[i] = 0.5f * (a + b) - hc[i];
        }
        row_store_bf16(XX + (size_t)tok * DM, xx, lane);
    }
}
DI void phase_final(const Params& p) {
    const int lane = tidx() & 63, gw = blockIdx.x * NWAVE + (tidx() >> 6), nw = gridDim.x * NWAVE;
    for (int r = gw; r < NBATCH * SEQ; r += nw) {
        const int b = r / SEQ, tok = b * PTOT + LCTX + (r - b * SEQ);
        f32x4 v[4];
        combine_row(p, 1, tok, v, lane);
        const float rstd = row_rstd(v);
        float* O = p.out + (size_t)r * DM;
#pragma unroll
        for (int i = 0; i < 4; ++i) { const f32x4 g = *(const f32x4*)(p.final_norm_g + (lane + 64 * i) * 4); ((f32x4*)O)[lane + 64 * i] = v[i] * rstd * g; }
    }
}

constexpr int LDSROW = 72;
constexpr int GEMM_SMEM = 2 * (256 + 256) * LDSROW * 2;
template <int NH, class AL, class EPI>
DI void gemm_tile(AL& al, const bf16_t* __restrict__ Bt, int ldb, int nk, EPI& epi, char* smem) {
    const int t = tidx(), lane = t & 63, wid = t >> 6, wr = wid >> 1, wc = wid & 1, fr = lane & 15, fq = lane >> 4;
    constexpr int BR = 128 * NH;
    bf16_t* sA = (bf16_t*)smem;
    bf16_t* sB = sA + 2 * 256 * LDSROW;
    f32x4 acc[NH][4][4];
#pragma unroll
    for (int h = 0; h < NH; ++h)
#pragma unroll
        for (int m = 0; m < 4; ++m)
#pragma unroll
            for (int n = 0; n < 4; ++n) acc[h][m][n] = (f32x4){0.f, 0.f, 0.f, 0.f};
    const int lr = t >> 3, lc = (t & 7) * 8;
    u32x4 ra[4], rb[2 * NH];
#pragma unroll
    for (int i = 0; i < 4; ++i) ra[i] = al.load(lr + 64 * i, lc, i);
#pragma unroll
    for (int i = 0; i < 2 * NH; ++i) rb[i] = *(const u32x4*)(Bt + (size_t)(lr + 64 * i) * ldb + lc);
#pragma unroll
    for (int i = 0; i < 4; ++i) *(u32x4*)(sA + (lr + 64 * i) * LDSROW + lc) = ra[i];
#pragma unroll
    for (int i = 0; i < 2 * NH; ++i) *(u32x4*)(sB + (lr + 64 * i) * LDSROW + lc) = rb[i];
    __syncthreads();
    for (int kt = 0; kt < nk; ++kt) {
        const int cur = kt & 1;
        const bool more = kt + 1 < nk;
        if (more) {
#pragma unroll
            for (int i = 0; i < 4; ++i) ra[i] = al.load(lr + 64 * i, (kt + 1) * 64 + lc, i);
#pragma unroll
            for (int i = 0; i < 2 * NH; ++i) rb[i] = *(const u32x4*)(Bt + (size_t)(lr + 64 * i) * ldb + (kt + 1) * 64 + lc);
        }
        __builtin_amdgcn_sched_barrier(0);
        const bf16_t* cA = sA + cur * 256 * LDSROW + (wr * 64 + fr) * LDSROW + fq * 8;
        const bf16_t* cB = sB + cur * BR * LDSROW + (wc * 64 + fr) * LDSROW + fq * 8;
#pragma unroll
        for (int kk = 0; kk < 2; ++kk) {
            bf16x8 af[4];
#pragma unroll
            for (int m = 0; m < 4; ++m) af[m] = *(const bf16x8*)(cA + m * 16 * LDSROW + kk * 32);
#pragma unroll
            for (int h = 0; h < NH; ++h) {
                bf16x8 bfr[4];
#pragma unroll
                for (int n = 0; n < 4; ++n) bfr[n] = *(const bf16x8*)(cB + (h * 128 + n * 16) * LDSROW + kk * 32);
#pragma unroll
                for (int m = 0; m < 4; ++m)
#pragma unroll
                    for (int n = 0; n < 4; ++n) acc[h][m][n] = __builtin_amdgcn_mfma_f32_16x16x32_bf16(bfr[n], af[m], acc[h][m][n], 0, 0, 0);
            }
            if (kk == 0 && more) {
                bf16_t* nA = sA + (cur ^ 1) * 256 * LDSROW;
                bf16_t* nB = sB + (cur ^ 1) * BR * LDSROW;
#pragma unroll
                for (int i = 0; i < 4; ++i) *(u32x4*)(nA + (lr + 64 * i) * LDSROW + lc) = ra[i];
#pragma unroll
                for (int i = 0; i < 2 * NH; ++i) *(u32x4*)(nB + (lr + 64 * i) * LDSROW + lc) = rb[i];
            }
        }
        __syncthreads();
    }
#pragma unroll
    for (int h = 0; h < NH; ++h) epi(acc[h], wr * 64, h * 128 + wc * 64, fr, fq);
}
DI bool xcd_tile(int k, int nM, int NT, int& mt, int& nt) {
    const bool swz = (gridDim.x & 7) == 0;
    const int j = (swz ? (int)(blockIdx.x >> 3) : (int)blockIdx.x) + (swz ? (int)(gridDim.x >> 3) : (int)gridDim.x) * k, mi = j / NT;
    nt = j - mi * NT; mt = swz ? (int)(blockIdx.x & 7) + 8 * mi : mi;
    return mt < nM;
}
struct ALPlain {
    const bf16_t* A; int lda;
    DI u32x4 load(int r, int k, int) const { return *(const u32x4*)(A + (size_t)r * lda + k); }
};
struct ALGather {
    const bf16_t* rowp[4];
    DI u32x4 load(int, int k, int i) const { return *(const u32x4*)(rowp[i] + k); }
};
struct ALMix {
    const bf16_t* H; const bf16_t* XX; const float* xm;
    DI u32x4 load(int r, int k, int) const {
        const u32x4 h = *(const u32x4*)(H + (size_t)r * DM + k), x = *(const u32x4*)(XX + (size_t)r * DM + k);
        const f32x4 m0 = *(const f32x4*)(xm + k), m1 = *(const f32x4*)(xm + k + 4);
        u32x4 o;
        o[0] = pk_bf16(bf_lo(h[0]) + bf_lo(x[0]) * m0[0], bf_hi(h[0]) + bf_hi(x[0]) * m0[1]);
        o[1] = pk_bf16(bf_lo(h[1]) + bf_lo(x[1]) * m0[2], bf_hi(h[1]) + bf_hi(x[1]) * m0[3]);
        o[2] = pk_bf16(bf_lo(h[2]) + bf_lo(x[2]) * m1[0], bf_hi(h[2]) + bf_hi(x[2]) * m1[1]);
        o[3] = pk_bf16(bf_lo(h[3]) + bf_lo(x[3]) * m1[2], bf_hi(h[3]) + bf_hi(x[3]) * m1[3]);
        return o;
    }
};

struct EpiQKV {
    const Params* p; int m0, n0;
    DI void operator()(const f32x4 (&acc)[4][4], int rb, int cb, int fr, int fq) const {
        const int hs = (n0 + cb) >> 6;
        const bool isq = hs < 8 || (hs >= 12 && hs < 20), isv = (hs >= 10 && hs < 12) || hs >= 22, normed = hs >= 12 && hs < 22;
        const float* gam = hs < 20 ? p->attn_q_norm_g : p->attn_k_norm_g;
        const f32x2* rope = (const f32x2*)(p->ws + OFF_ROPE);
        bf16_t* Q = (bf16_t*)(p->ws + OFF_SCR + S_Q);
        bf16_t* K = (bf16_t*)(p->ws + OFF_SCR + S_K);
        bf16_t* VT = (bf16_t*)(p->ws + OFF_SCR + S_VT);
#pragma unroll
        for (int m = 0; m < 4; ++m) {
            const int tok = m0 + rb + m * 16 + fr, b = tok >= PTOT ? 1 : 0, pos = tok - b * PTOT;
            f32x4 v[4];
#pragma unroll
            for (int n = 0; n < 4; ++n) v[n] = acc[m][n];
            if (normed) {
                float ss = 0.f;
#pragma unroll
                for (int n = 0; n < 4; ++n) ss += v[n][0] * v[n][0] + v[n][1] * v[n][1] + v[n][2] * v[n][2] + v[n][3] * v[n][3];
                ss += __shfl_xor(ss, 16); ss += __shfl_xor(ss, 32);
                const float rstd = rsqrtf(ss * (1.0f / 64.0f) + RMS_EPS);
#pragma unroll
                for (int n = 0; n < 4; ++n) { const f32x4 g = *(const f32x4*)(gam + n * 16 + fq * 4); v[n] = v[n] * rstd * g; }
            }
            if (!isv && pos >= LCTX) {
                const int t = pos - LCTX, prow = t >> 6, pcol = t & 63;
#pragma unroll
                for (int a = 0; a < 2; ++a) {
                    const f32x2* tb = rope + (a == 0 ? prow : 256 + pcol) * 16 + fq * 4;
#pragma unroll
                    for (int j = 0; j < 4; ++j) {
                        const f32x2 cs = tb[j];
                        const float x0 = v[2 * a][j], x1 = v[2 * a + 1][j];
                        v[2 * a][j] = x0 * cs[0] - x1 * cs[1];
                        v[2 * a + 1][j] = x1 * cs[0] + x0 * cs[1];
                    }
                }
            }
            if (isq) {
                const int hq = hs < 8 ? hs : hs - 4;
                bf16_t* dst = Q + ((size_t)(b * 16 + hq) * PTOT + pos) * 64 + fq * 4;
#pragma unroll
                for (int n = 0; n < 4; ++n) { const f32x4 w = v[n] * (0.125f * LOG2E); u32x2 o; o[0] = pk_bf16(w[0], w[1]); o[1] = pk_bf16(w[2], w[3]); *(u32x2*)(dst + n * 16) = o; }
            } else if (!isv) {
                const int kh = hs < 12 ? hs - 8 : hs - 18;
                bf16_t* dst = K + ((size_t)(b * 4 + kh) * PTOT + pos) * 64 + fq * 4;
#pragma unroll
                for (int n = 0; n < 4; ++n) { u32x2 o; o[0] = pk_bf16(v[n][0], v[n][1]); o[1] = pk_bf16(v[n][2], v[n][3]); *(u32x2*)(dst + n * 16) = o; }
            } else {
                const int vh = hs < 12 ? hs - 10 : hs - 20;
                bf16_t* dst = VT + (size_t)(b * 4 + vh) * 64 * PTOT + pos;
#pragma unroll
                for (int n = 0; n < 4; ++n)
#pragma unroll
                    for (int j = 0; j < 4; ++j) dst[(size_t)(n * 16 + fq * 4 + j) * PTOT] = (bf16_t)(pk_bf16(v[n][j], 0.f) & 0xffffu);
            }
        }
    }
};
DI void phase_qkv(const Params& p, char* smem) {
    const bf16_t* H = (const bf16_t*)(p.ws + OFF_H);
    const bf16_t* W = (const bf16_t*)(p.ws + OFF_WS) + W_IN;
    constexpr int NT = QKV_N / 128, MT = TTOT / 256;
    for (int k = 0;; ++k) {
        int mt, nt; if (!xcd_tile(k, MT, NT, mt, nt)) break;
        ALPlain al{H + (size_t)mt * 256 * DM, DM};
        EpiQKV epi{&p, mt * 256, nt * 128};
        gemm_tile<1>(al, W + (size_t)nt * 128 * DM, DM, DM / 64, epi, smem);
    }
}

struct EpiResid {
    const Params* p; int m0, n0, layer; bool from_input;
    DI void operator()(const f32x4 (&acc)[4][4], int rb, int cb, int fr, int fq) const {
#pragma unroll
        for (int m = 0; m < 4; ++m) {
            const int tok = m0 + rb + m * 16 + fr;
            const float* xin = from_input ? xin_ptr(*p, tok) : xrow_ptr(*p, tok);
            float* xo = xrow_ptr(*p, tok);
            const float* gate = mod_ptr(*p, layer, tok, 2);
#pragma unroll
            for (int n = 0; n < 4; ++n) {
                const int c = n0 + cb + n * 16 + fq * 4;
                const f32x4 xi = *(const f32x4*)(xin + c), g = *(const f32x4*)(gate + c);
                *(f32x4*)(xo + c) = xi + g * acc[m][n];
            }
        }
    }
};
DI void phase_wout(const Params& p, char* smem) {
    const bf16_t* O = (const bf16_t*)(p.ws + OFF_SCR + S_O);
    const bf16_t* W = (const bf16_t*)(p.ws + OFF_WS) + W_OUT;
    constexpr int NT = 8, MT = TTOT / 256;
    for (int k = 0;; ++k) {
        int mt, nt; if (!xcd_tile(k, MT, NT, mt, nt)) break;
        ALPlain al{O + (size_t)mt * 256 * DM, DM};
        EpiResid epi{&p, mt * 256, nt * 128, 0, true};
        gemm_tile<1>(al, W + (size_t)nt * 128 * DM, DM, DM / 64, epi, smem);
    }
}
DI void phase_wo(const Params& p, char* smem) {
    const bf16_t* O = (const bf16_t*)(p.ws + OFF_SCR + S_OR);
    const bf16_t* W = (const bf16_t*)(p.ws + OFF_WS) + W_O;
    constexpr int NT = 8, MTL = SEQ / 256;
    for (int k = 0;; ++k) {
        int mi, nt; if (!xcd_tile(k, NBATCH * MTL, NT, mi, nt)) break;
        const int b = mi / MTL, mt = b * (PTOT / 256) + 1 + (mi % MTL);
        ALPlain al{O + (size_t)mt * 256 * DM, DM};
        EpiResid epi{&p, mt * 256, nt * 128, 1, false};
        gemm_tile<1>(al, W + (size_t)nt * 128 * DM, DM, DM / 64, epi, smem);
    }
}

struct MoeSched { int nt[16], base[17]; };
DI void moe_sched(const Params& p, int layer, MoeSched& s, int (&cnt)[16]) {
    const int* c = (const int*)(p.ws + OFF_CNT) + layer * 16;
    int acc = 0;
#pragma unroll
    for (int e = 0; e < 16; ++e) { cnt[e] = c[e]; s.nt[e] = (cnt[e] + 255) >> 8; s.base[e] = acc; acc += s.nt[e]; }
    s.base[16] = acc;
}
struct EpiMoe1 {
    bf16_t* hid;   int n0;
    DI void operator()(const f32x4 (&acc)[4][4], int rb, int cb, int fr, int fq) const {
        const int g = (n0 + cb) >> 6;
#pragma unroll
        for (int m = 0; m < 4; ++m) {
            bf16_t* dst = hid + (size_t)(rb + m * 16 + fr) * 1024 + g * 32 + fq * 4;
#pragma unroll
            for (int n = 0; n < 2; ++n) {
                const f32x4 a = acc[m][n], b = acc[m][n + 2];
                u32x2 o;
                o[0] = pk_bf16(siluf_(a[0]) * b[0], siluf_(a[1]) * b[1]);
                o[1] = pk_bf16(siluf_(a[2]) * b[2], siluf_(a[3]) * b[3]);
                *(u32x2*)(dst + n * 16) = o;
            }
        }
    }
};
DI void phase_moe1(const Params& p, int layer, char* smem) {
    MoeSched s; int cnt[16];
    moe_sched(p, layer, s, cnt);
    const bf16_t* H = (const bf16_t*)(p.ws + OFF_H);
    const bf16_t* W13 = (const bf16_t*)(p.ws + OFF_MOEW);
    const int* stok = (const int*)(p.ws + OFF_STOK);
    bf16_t* hid = (bf16_t*)(p.ws + OFF_SCR + S_HID);
    constexpr int NT = 8;
    const int total = s.base[16] * NT;
    const int lr = tidx() >> 3;
    for (int k = 0;; ++k) {
        int mg, nt; if (!xcd_tile(k, s.base[16], NT, mg, nt)) break;
        int e = 0;
#pragma unroll
        for (int i = 1; i < 16; ++i) if (mg >= s.base[i]) e = i;
        int ce = 0;
#pragma unroll
        for (int i = 0; i < 16; ++i) if (i == e) ce = cnt[i];
        int be = 0;
#pragma unroll
        for (int i = 0; i < 16; ++i) if (i == e) be = s.base[i];
        const int ml = mg - be;
        ALGather al;
#pragma unroll
        for (int i = 0; i < 4; ++i) {
            const int r = ml * 256 + lr + 64 * i;
            const int tk = r < ce ? (stok[(size_t)e * CAP + r] >> 1) : 0;
            al.rowp[i] = H + (size_t)tk * DM;
        }
        EpiMoe1 epi{hid + (size_t)mg * 256 * 1024, nt * 256};
        gemm_tile<2>(al, W13 + (size_t)e * 2048 * 1024 + (size_t)nt * 256 * 1024, 1024, 16, epi, smem);
    }
}
struct EpiMoe2 {
    bf16_t* Y; const int* stok; const float* sw; int nvalid, n0;
    DI void operator()(const f32x4 (&acc)[4][4], int rb, int cb, int fr, int fq) const {
#pragma unroll
        for (int m = 0; m < 4; ++m) {
            const int r = rb + m * 16 + fr;
            if (r < nvalid) {
                const int tk = stok[r]; const float w = sw[r];
                bf16_t* dst = Y + (size_t)tk * 1024 + n0 + cb + fq * 4;
#pragma unroll
                for (int n = 0; n < 4; ++n) { const f32x4 a = acc[m][n] * w; u32x2 o; o[0] = pk_bf16(a[0], a[1]); o[1] = pk_bf16(a[2], a[3]); *(u32x2*)(dst + n * 16) = o; }
            }
        }
    }
};
DI void phase_moe2(const Params& p, int layer, char* smem) {
    MoeSched s; int cnt[16];
    moe_sched(p, layer, s, cnt);
    const bf16_t* hid = (const bf16_t*)(p.ws + OFF_SCR + S_HID);
    const bf16_t* W2 = (const bf16_t*)(p.ws + OFF_MOEW) + (size_t)16 * 2048 * 1024;
    const int* stok = (const int*)(p.ws + OFF_STOK);
    const float* sw = (const float*)(p.ws + OFF_SW);
    bf16_t* Y = (bf16_t*)(p.ws + OFF_SCR + S_Y);
    constexpr int NT = 4;
    const int total = s.base[16] * NT;
    for (int k = 0;; ++k) {
        int mg, nt; if (!xcd_tile(k, s.base[16], NT, mg, nt)) break;
        int e = 0;
#pragma unroll
        for (int i = 1; i < 16; ++i) if (mg >= s.base[i]) e = i;
        int ce = 0, be = 0;
#pragma unroll
        for (int i = 0; i < 16; ++i) if (i == e) { ce = cnt[i]; be = s.base[i]; }
        const int ml = mg - be;
        ALPlain al{hid + (size_t)mg * 256 * 1024, 1024};
        EpiMoe2 epi{Y, stok + (size_t)e * CAP + ml * 256, sw + (size_t)e * CAP + ml * 256, ce - ml * 256, nt * 256};
        gemm_tile<2>(al, W2 + (size_t)e * 1024 * 1024 + (size_t)nt * 256 * 1024, 1024, 16, epi, smem);
    }
}

struct EpiRwkv {
    bf16_t* dst; int ld, m0, n0, act, nstore;
    DI void operator()(const f32x4 (&acc)[4][4], int rb, int cb, int fr, int fq) const {
#pragma unroll
        for (int m = 0; m < 4; ++m) {
            bf16_t* d = dst + (size_t)(m0 + rb + m * 16 + fr) * ld + n0 + cb + fq * 4;
#pragma unroll
            for (int n = 0; n < 4; ++n) {
                const int c = n0 + cb + n * 16 + fq * 4;
                if (c >= ld) continue;
                f32x4 a = acc[m][n];
                if (act == 1) {
#pragma unroll
                    for (int j = 0; j < 4; ++j) { const float e = __expf(2.0f * a[j]); a[j] = 1.0f - 2.0f / (e + 1.0f); }
                }
                if (act == 2) {
#pragma unroll
                    for (int j = 0; j < 4; ++j) a[j] = sigmoidf_(a[j]);
                }
                if (c >= nstore) a = (f32x4){0.f, 0.f, 0.f, 0.f};
                u32x2 o; o[0] = pk_bf16(a[0], a[1]); o[1] = pk_bf16(a[2], a[3]);
                *(u32x2*)(d + n * 16) = o;
            }
        }
    }
};
DI void phase_rwkv_proj(const Params& p, char* smem) {
    const bf16_t* H = (const bf16_t*)(p.ws + OFF_H);
    const bf16_t* XX = (const bf16_t*)(p.ws + OFF_SCR + S_XX);
    const bf16_t* wsm = (const bf16_t*)(p.ws + OFF_WS);
    constexpr int MT = TTOT / 256, NU = 14;
    for (int u = blockIdx.x; u < MT * NU; u += gridDim.x) {
        const int mt = u / NU, q = u % NU;
        ALMix al{H + (size_t)mt * 256 * DM, XX + (size_t)mt * 256 * DM, nullptr};
        if (q < 13) {
            const int job = q < 4 ? 0 : q < 8 ? 1 : q < 12 ? 2 : 5, nt = q < 12 ? (q & 3) : 0;
            const int mixj = job == 0 ? 0 : job == 1 ? 2 : job == 2 ? 3 : 5;
            const size_t wofs = job == 0 ? W_R : job == 1 ? W_K : job == 2 ? W_V : W_G1;
            const size_t dofs = job == 0 ? S_R : job == 1 ? S_KK : job == 2 ? S_V : S_LG;
            al.xm = p.rwkv_x_mix + mixj * DM;
            EpiRwkv epi{(bf16_t*)(p.ws + OFF_SCR + dofs), job == 5 ? 192 : 1024, mt * 256, nt * 256, job == 5 ? 2 : 0, job == 5 ? 160 : 4096};
            gemm_tile<2>(al, wsm + wofs + (size_t)nt * 256 * DM, DM, DM / 64, epi, smem);
        } else {
#pragma unroll 1
            for (int j = 0; j < 2; ++j) {
                al.xm = p.rwkv_x_mix + (j == 0 ? 1 : 4) * DM;
                EpiRwkv epi{(bf16_t*)(p.ws + OFF_SCR + (j == 0 ? S_LW : S_LA)), 128, mt * 256, 0, j == 0 ? 1 : 0, 4096};
                gemm_tile<1>(al, wsm + (j == 0 ? W_W1 : W_A1), DM, DM / 64, epi, smem);
            }
        }
    }
}

struct EpiGate {
    const Params* p; int m0, n0;
    DI void operator()(const f32x4 (&acc)[4][4], int rb, int cb, int fr, int fq) const {
        const bf16_t* Y0 = (const bf16_t*)(p->ws + OFF_H);
        const bf16_t* Y1 = (const bf16_t*)(p->ws + OFF_SCR + S_Y1);
        const bf16_t* V = (const bf16_t*)(p->ws + OFF_SCR + S_V);
        const float* bonus = (const float*)(p->ws + OFF_BONUS2);
        bf16_t* O = (bf16_t*)(p->ws + OFF_SCR + S_OR);
        const int c0 = n0 + cb, hd = c0 >> 6;
#pragma unroll
        for (int m = 0; m < 4; ++m) {
            const int tok = m0 + rb + m * 16 + fr;
            const size_t ro = (size_t)tok * DM + c0 + fq * 4;
            f32x4 y[4];
            float s = 0.f;
#pragma unroll
            for (int n = 0; n < 4; ++n) {
                const u32x2 a = *(const u32x2*)(Y0 + ro + n * 16), b = *(const u32x2*)(Y1 + ro + n * 16);
                y[n][0] = bf_lo(a[0]) + bf_lo(b[0]); y[n][1] = bf_hi(a[0]) + bf_hi(b[0]); y[n][2] = bf_lo(a[1]) + bf_lo(b[1]); y[n][3] = bf_hi(a[1]) + bf_hi(b[1]);
                s += y[n][0] + y[n][1] + y[n][2] + y[n][3];
            }
            s += __shfl_xor(s, 16); s += __shfl_xor(s, 32);
            const float mu = s * (1.0f / 64.0f);
            float q = 0.f;
#pragma unroll
            for (int n = 0; n < 4; ++n) { const f32x4 d = y[n] - mu; q += d[0] * d[0] + d[1] * d[1] + d[2] * d[2] + d[3] * d[3]; }
            q += __shfl_xor(q, 16); q += __shfl_xor(q, 32);
            const float rs = rsqrtf(q * (1.0f / 64.0f) + GN_EPS);
            const float bon = (bonus[(size_t)tok * 16 + hd] + bonus[(size_t)(TTOT + tok) * 16 + hd]) + (bonus[(size_t)(2 * TTOT + tok) * 16 + hd] + bonus[(size_t)(3 * TTOT + tok) * 16 + hd]);
#pragma unroll
            for (int n = 0; n < 4; ++n) {
                const int c = c0 + n * 16 + fq * 4;
                const f32x4 g = *(const f32x4*)(p->rwkv_ln_g + c), bb = *(const f32x4*)(p->rwkv_ln_b + c);
                const u32x2 vv = *(const u32x2*)(V + ro + n * 16);
                const f32x4 v4 = {bf_lo(vv[0]), bf_hi(vv[0]), bf_lo(vv[1]), bf_hi(vv[1])};
                const f32x4 o = ((y[n] - mu) * rs * g + bb + bon * v4) * acc[m][n];
                u32x2 w; w[0] = pk_bf16(o[0], o[1]); w[1] = pk_bf16(o[2], o[3]);
                *(u32x2*)(O + ro + n * 16) = w;
            }
        }
    }
};
DI void phase_gate(const Params& p, char* smem) {
    const bf16_t* LG = (const bf16_t*)(p.ws + OFF_SCR + S_LG);
    const bf16_t* W = (const bf16_t*)(p.ws + OFF_WS) + W_G2;
    constexpr int NT = 8, MT = TTOT / 256;
    for (int k = 0;; ++k) {
        int mt, nt; if (!xcd_tile(k, MT, NT, mt, nt)) break;
        ALPlain al{LG + (size_t)mt * 256 * 192, 192};
        EpiGate epi{&p, mt * 256, nt * 128};
        gemm_tile<1>(al, W + (size_t)nt * 128 * 192, 192, 3, epi, smem);
    }
}

constexpr int KROW = 72, VROW = 68;
constexpr int ATT_SMEM = 2 * 64 * KROW * 2 + 2 * 64 * VROW * 2;
DI int crow_(int i, int h) { return (i & 3) + 8 * (i >> 2) + 4 * h; }
#define MFMA32(a, b, c) __builtin_amdgcn_mfma_f32_32x32x16_bf16((a), (b), (c), 0, 0, 0)
template <int MODE>
DI void attn_unit(const Params& p, const bf16_t* Qg  , int nq_valid, const bf16_t* Kg  , const bf16_t* Vg  ,
                  int ta0, int ta1, int tb0, int tb1  , bool band, int q_lat0  ,
                  float init_m, float init_l0, bf16_t* Og  , char* smem) {
    const int t = tidx(), lane = t & 63, wid = t >> 6, r = lane & 31, h = lane >> 5;
    bf16_t* sK = (bf16_t*)smem;
    bf16_t* sV = sK + 2 * 64 * KROW;
    bf16x8 qf[2][4];
#pragma unroll
    for (int qs = 0; qs < 2; ++qs) {
        const int qi = wid * 64 + qs * 32 + r;
        const bf16_t* qp = Qg + (size_t)(qi < nq_valid ? qi : 0) * 64 + 8 * h;
#pragma unroll
        for (int ks = 0; ks < 4; ++ks) qf[qs][ks] = *(const bf16x8*)(qp + ks * 16);
    }
#pragma unroll
    for (int qs = 0; qs < 2; ++qs)
#pragma unroll
        for (int ks = 0; ks < 4; ++ks) asm volatile("" : "+v"(qf[qs][ks]));
    f32x16 o[2][2];
#pragma unroll
    for (int qs = 0; qs < 2; ++qs)
#pragma unroll
        for (int dt = 0; dt < 2; ++dt)
#pragma unroll
            for (int i = 0; i < 16; ++i) o[qs][dt][i] = 0.f;
    float mrun[2], lrun[2];
#pragma unroll
    for (int qs = 0; qs < 2; ++qs) { mrun[qs] = init_m; lrun[qs] = (MODE == 1 && h == 0) ? init_l0 : 0.f; }
    const int ntile = ((ta1 - ta0) + (tb1 - tb0)) >> 6;
    const int lrow = t >> 3, lch = (t & 7) * 8;
    u32x4 rk, rv;
    auto tile_pos = [&](int i) { const int a = (ta1 - ta0) >> 6; return i < a ? ta0 + i * 64 : tb0 + (i - a) * 64; };
    {
        const int kp = tile_pos(0);
        rk = *(const u32x4*)(Kg + (size_t)(kp + lrow) * 64 + lch);
        rv = *(const u32x4*)(Vg + (size_t)lrow * PTOT + kp + lch);
        *(u32x4*)(sK + lrow * KROW + lch) = rk;
        *(u32x2*)(sV + lrow * VROW + lch) = (u32x2){rv[0], rv[1]};
        *(u32x2*)(sV + lrow * VROW + lch + 4) = (u32x2){rv[2], rv[3]};
    }
    __syncthreads();
    for (int it = 0; it < ntile; ++it) {
        const int cur = it & 1;
        const bool more = it + 1 < ntile;
        const int kp = tile_pos(it);
        if (more) {
            const int kn = tile_pos(it + 1);
            rk = *(const u32x4*)(Kg + (size_t)(kn + lrow) * 64 + lch);
            rv = *(const u32x4*)(Vg + (size_t)lrow * PTOT + kn + lch);
        }
        __builtin_amdgcn_sched_barrier(0);
        const bf16_t* cK = sK + cur * 64 * KROW;
        const bf16_t* cV = sV + cur * 64 * VROW;
#pragma unroll 1
        for (int ksub = 0; ksub < 2; ++ksub) {
            f32x16 sc[2];
#pragma unroll
            for (int qs = 0; qs < 2; ++qs)
#pragma unroll
                for (int i = 0; i < 16; ++i) sc[qs][i] = MODE == 0 ? init_m : 0.f;
            {
                bf16x8 kf[4];
#pragma unroll
                for (int ks = 0; ks < 4; ++ks) kf[ks] = *(const bf16x8*)(cK + (ksub * 32 + r) * KROW + ks * 16 + 8 * h);
                __builtin_amdgcn_s_setprio(1);
#pragma unroll
                for (int ks = 0; ks < 4; ++ks)
#pragma unroll
                    for (int qs = 0; qs < 2; ++qs) sc[qs] = MFMA32(kf[ks], qf[qs][ks], sc[qs]);
                __builtin_amdgcn_s_setprio(0);
            }
#pragma unroll
            for (int qs = 0; qs < 2; ++qs) {
                if (MODE == 1) {
                    if (band && kp >= LCTX) {
                        const int qlat = q_lat0 + wid * 64 + qs * 32 + r, kl0 = kp - LCTX + ksub * 32;
#pragma unroll
                        for (int i = 0; i < 16; ++i) {
                            const int d0 = qlat - (kl0 + crow_(i, h));
                            if (d0 > 128 || d0 < -128) sc[qs][i] = -1e30f;
                        }
                    }
                    float mt = sc[qs][0];
#pragma unroll
                    for (int i = 1; i < 16; ++i) mt = fmaxf(mt, sc[qs][i]);
                    mt = fmaxf(mt, __shfl_xor(mt, 32));
                    const float mnew = fmaxf(mrun[qs], mt);
                    const float alpha = __builtin_amdgcn_exp2f(mrun[qs] - mnew);
                    mrun[qs] = mnew; lrun[qs] *= alpha;
#pragma unroll
                    for (int i = 0; i < 16; ++i) { o[qs][0][i] *= alpha; o[qs][1][i] *= alpha; }
#pragma unroll
                    for (int i = 0; i < 16; ++i) sc[qs][i] -= mnew;
                }
                float ls = 0.f;
#pragma unroll
                for (int i = 0; i < 16; ++i) { sc[qs][i] = __builtin_amdgcn_exp2f(sc[qs][i]); ls += sc[qs][i]; }
                lrun[qs] += ls;
            }
#pragma unroll
            for (int st = 0; st < 2; ++st) {
                bf16x8 pf[2];
#pragma unroll
                for (int qs = 0; qs < 2; ++qs) {
                    u32x4 pw;
#pragma unroll
                    for (int j = 0; j < 4; ++j) pw[j] = pk_bf16(sc[qs][8 * st + 2 * j], sc[qs][8 * st + 2 * j + 1]);
                    pf[qs] = __builtin_bit_cast(bf16x8, pw);
                }
                const int kb = ksub * 32 + 16 * st + 4 * h;
#pragma unroll
                for (int dt = 0; dt < 2; ++dt) {
                    const s16x4 lo = *(const s16x4*)(cV + (dt * 32 + r) * VROW + kb), hi = *(const s16x4*)(cV + (dt * 32 + r) * VROW + kb + 8);
                    const bf16x8 vf = __builtin_shufflevector(lo, hi, 0, 1, 2, 3, 4, 5, 6, 7);
#pragma unroll
                    for (int qs = 0; qs < 2; ++qs) o[qs][dt] = MFMA32(vf, pf[qs], o[qs][dt]);
                }
            }
        }
        if (more) {
            bf16_t* nK = sK + (cur ^ 1) * 64 * KROW;
            bf16_t* nV = sV + (cur ^ 1) * 64 * VROW;
            *(u32x4*)(nK + lrow * KROW + lch) = rk;
            *(u32x2*)(nV + lrow * VROW + lch) = (u32x2){rv[0], rv[1]};
            *(u32x2*)(nV + lrow * VROW + lch + 4) = (u32x2){rv[2], rv[3]};
        }
        __syncthreads();
    }
#pragma unroll
    for (int qs = 0; qs < 2; ++qs) {
        const int qi = wid * 64 + qs * 32 + r;
        const float lt = lrun[qs] + __shfl_xor(lrun[qs], 32);
        const float invl = 1.0f / lt;
        if (qi < nq_valid) {
            bf16_t* op = Og + (size_t)qi * DM;
#pragma unroll
            for (int g = 0; g < 4; ++g) {
                u32x2 w0, w1;
                w0[0] = pk_bf16(o[qs][0][4 * g] * invl, o[qs][0][4 * g + 1] * invl); w0[1] = pk_bf16(o[qs][0][4 * g + 2] * invl, o[qs][0][4 * g + 3] * invl);
                w1[0] = pk_bf16(o[qs][1][4 * g] * invl, o[qs][1][4 * g + 1] * invl); w1[1] = pk_bf16(o[qs][1][4 * g + 2] * invl, o[qs][1][4 * g + 3] * invl);
                *(u32x2*)(op + 8 * g + 4 * h) = w0;
                *(u32x2*)(op + 32 + 8 * g + 4 * h) = w1;
            }
        }
    }
}
DI void phase_attn(const Params& p, char* smem) {
    const bf16_t* Q = (const bf16_t*)(p.ws + OFF_SCR + S_Q);
    const bf16_t* K = (const bf16_t*)(p.ws + OFF_SCR + S_K);
    const bf16_t* VT = (const bf16_t*)(p.ws + OFF_SCR + S_VT);
    bf16_t* O = (bf16_t*)(p.ws + OFF_SCR + S_O);
    float gq = 0.f, gk = 0.f;
    for (int i = 0; i < 64; ++i) { gq = fmaxf(gq, fabsf(p.attn_q_norm_g[i])); gk = fmaxf(gk, fabsf(p.attn_k_norm_g[i])); }
    const float M2 = 8.25f * gq * gk * LOG2E;
    constexpr int QB = 512, NQB = SEQ / QB;
    const int G = gridDim.x;
    constexpr int NDENSE = NBATCH * 8 * NQB;
    for (int u = blockIdx.x; u < NDENSE; u += G) {
        int combo, within;
        if ((G & 7) == 0 && NDENSE % G == 0) {
            const int xcd = blockIdx.x & 7, idx = (blockIdx.x >> 3) + (G >> 3) * (u / G);
            combo = xcd & 3; within = (xcd >> 2) * (NDENSE / 8) + idx;
        } else { combo = u / (4 * NQB); within = u % (4 * NQB); }
        const int b = combo >> 1, kvh = combo & 1, hq = kvh * 4 + (within & 3), qb = within >> 2;
        const bf16_t* Qg = Q + ((size_t)(b * 16 + 8 + hq) * PTOT + LCTX + qb * QB) * 64;
        attn_unit<0>(p, Qg, QB, K + (size_t)(b * 4 + 2 + kvh) * PTOT * 64, VT + (size_t)(b * 4 + 2 + kvh) * 64 * PTOT, 0, PTOT, 0, 0, false, 0, -M2, 0.f,
                     O + (size_t)(b * PTOT + LCTX + qb * QB) * DM + (8 + hq) * 64, smem);
    }
    for (int u = blockIdx.x; u < NDENSE; u += G) {
        const int b = u / (8 * NQB), rem = u % (8 * NQB), qb = rem >> 3, hq = rem & 7, kvh = hq >> 2;
        const int i0 = qb * QB;
        const int lo = i0 - 128 < 0 ? 0 : i0 - 128, hi = i0 + QB + 128 > SEQ ? SEQ : i0 + QB + 128;
        const bf16_t* Qg = Q + ((size_t)(b * 16 + hq) * PTOT + LCTX + i0) * 64;
        attn_unit<1>(p, Qg, QB, K + (size_t)(b * 4 + kvh) * PTOT * 64, VT + (size_t)(b * 4 + kvh) * 64 * PTOT, 0, LCTX, LCTX + lo, LCTX + hi, true, i0,
                     p.attn_sink[hq] * LOG2E, 1.0f, O + (size_t)(b * PTOT + LCTX + i0) * DM + hq * 64, smem);
    }
    for (int u = blockIdx.x; u < NBATCH * 16; u += G) {
        const int b = u >> 4, hh = u & 15, isb = hh >> 3, hq = hh & 7, kvh = isb * 2 + (hq >> 2);
        const bf16_t* Qg = Q + ((size_t)(b * 16 + hh) * PTOT) * 64;
        attn_unit<1>(p, Qg, LCTX, K + (size_t)(b * 4 + kvh) * PTOT * 64, VT + (size_t)(b * 4 + kvh) * 64 * PTOT, 0, LCTX, 0, 0, false, 0,
                     isb ? -1e30f : p.attn_sink[hq] * LOG2E, isb ? 0.f : 1.0f, O + (size_t)(b * PTOT) * DM + hh * 64, smem);
    }
}

constexpr int TB = 32, NBUF = 3;
constexpr int SC_REC = 5 * 64;
constexpr int SC_OPS = TB * SC_REC * 4;
constexpr int SC_SMEM = NBUF * SC_OPS + NBUF * TB * 16 * 4 + NBUF * TB * 16 * 4 + 64;
DI int scan_pos(int n, int dir) {
    if (n < LCTX) return dir ? LCTX - 1 - n : n;
    const int m = n - LCTX;
    return LCTX + (dir ? SEQ - 1 - m : m);
}
template <int CTRL> DI float dpp_add(float v) { return v + __builtin_bit_cast(float, __builtin_amdgcn_update_dpp(0, __builtin_bit_cast(int, v), CTRL, 0xf, 0xf, false)); }
DI float row16_sum(float v) { v = dpp_add<0x128>(v); v = dpp_add<0x124>(v); v = dpp_add<0x122>(v); v = dpp_add<0x121>(v); return v; }
DI int lds_min4(int* c) { const volatile LAS int* q = (const volatile LAS int*)c; const int a = q[0], b = q[1], d = q[2], e = q[3]; return min(min(a, b), min(d, e)); }
DI void lds_publish(int* c, int v) { *(volatile LAS int*)c = v; }
DI void scan_unit(const Params& p, int u, char* smem) {
    const int t = tidx(), lane = t & 63, wid = __builtin_amdgcn_readfirstlane(t >> 6);
    const unsigned rg = u & 3, dir = (u >> 2) & 1, hd = (u >> 3) & 15, b = u >> 7;
    float* ops = (float*)smem;
    float* vbuf = (float*)(smem + NBUF * SC_OPS);
    float* ybuf = vbuf + NBUF * TB * 16;
    int* cnts = (int*)(ybuf + NBUF * TB * 16);
    const bf16_t* R = (const bf16_t*)(p.ws + OFF_SCR + S_R);
    const bf16_t* Kk = (const bf16_t*)(p.ws + OFF_SCR + S_KK);
    const bf16_t* V = (const bf16_t*)(p.ws + OFF_SCR + S_V);
    const bf16_t* LW = (const bf16_t*)(p.ws + OFF_SCR + S_LW);
    const bf16_t* LA = (const bf16_t*)(p.ws + OFF_SCR + S_LA);
    bf16_t* Yo = dir ? (bf16_t*)(p.ws + OFF_SCR + S_Y1) : (bf16_t*)(p.ws + OFF_H);
    float* bonus = (float*)(p.ws + OFF_BONUS2);
    const unsigned tokb = b * PTOT, hc = hd * 64;
    constexpr int NBLK = PTOT / TB;
    const unsigned fr = lane & 15, fq = lane >> 4;
    if (t < 8) cnts[t] = 0;
    __syncthreads();

    if (wid < 4) {
        __builtin_amdgcn_s_setprio(3);
        float s0 = 0.f, s1 = 0.f, s2 = 0.f, s3 = 0.f;
        const unsigned g = lane >> 4, c4 = (lane & 15) * 4, myrow = wid * 4 + g;
        for (int blk = 0; blk < NBLK; ++blk) {
            const unsigned buf = (unsigned)blk % NBUF;
            while (lds_min4(cnts) < blk + 1) __builtin_amdgcn_s_sleep(1);
            asm volatile("" ::: "memory");
            const float* rec = ops + buf * (TB * SC_REC) + c4;
            const float* vb = vbuf + buf * (TB * 16) + myrow;
            float* yb = ybuf + buf * (TB * 16) + myrow;
            f32x4 w0_ = *(const f32x4*)(rec), kd0_ = *(const f32x4*)(rec + 64), bb0_ = *(const f32x4*)(rec + 128), aa0_ = *(const f32x4*)(rec + 192), rr0_ = *(const f32x4*)(rec + 256);
            float vv0_ = vb[0];
#define SCAN_STEP(W, KD, BB, AA, RR, VV, ST) { \
                float sa = s0 * AA[0] + s1 * AA[1] + s2 * AA[2] + s3 * AA[3]; \
                sa = row16_sum(sa); \
                s0 = s0 * W[0] + sa * BB[0] + VV * KD[0]; \
                s1 = s1 * W[1] + sa * BB[1] + VV * KD[1]; \
                s2 = s2 * W[2] + sa * BB[2] + VV * KD[2]; \
                s3 = s3 * W[3] + sa * BB[3] + VV * KD[3]; \
                float y = s0 * RR[0] + s1 * RR[1] + s2 * RR[2] + s3 * RR[3]; \
                y = row16_sum(y); \
                if ((lane & 15) == 0) yb[(ST) * 16] = y; }
#pragma unroll 1
            for (int st = 0; st < TB; st += 2) {
                const float* r1 = rec + (st + 1) * SC_REC;
                const f32x4 w1_ = *(const f32x4*)(r1), kd1_ = *(const f32x4*)(r1 + 64), bb1_ = *(const f32x4*)(r1 + 128), aa1_ = *(const f32x4*)(r1 + 192), rr1_ = *(const f32x4*)(r1 + 256);
                const float vv1_ = vb[(st + 1) * 16];
                SCAN_STEP(w0_, kd0_, bb0_, aa0_, rr0_, vv0_, st)
                const int st2 = st + 2 < TB ? st + 2 : st;
                const float* r2 = rec + st2 * SC_REC;
                w0_ = *(const f32x4*)(r2); kd0_ = *(const f32x4*)(r2 + 64); bb0_ = *(const f32x4*)(r2 + 128); aa0_ = *(const f32x4*)(r2 + 192); rr0_ = *(const f32x4*)(r2 + 256);
                vv0_ = vb[st2 * 16];
                SCAN_STEP(w1_, kd1_, bb1_, aa1_, rr1_, vv1_, st + 1)
            }
#undef SCAN_STEP
            asm volatile("s_waitcnt lgkmcnt(0)" ::: "memory");
            if (lane == 0) lds_publish(cnts + 4 + wid, blk + 1);
        }
        __builtin_amdgcn_s_setprio(0);
    } else {
        const unsigned wt = wid & 1, chh = (wid >> 1) & 1;
        const bf16_t* wsm = (const bf16_t*)(p.ws + OFF_WS);
        const unsigned wo = W_W2 + dir * 65536u + (hc + fr) * 64u + fq * 8u;
        const unsigned ao = W_A2 + dir * 65536u + (hc + fr) * 64u + fq * 8u;
        const unsigned po = hc + fq * 4u;
        for (int blk = 0; blk < NBLK + NBUF; ++blk) {
            const unsigned buf = (unsigned)blk % NBUF;
            const int need = blk - NBUF + 1 < NBLK ? blk - NBUF + 1 : NBLK;
            while (lds_min4(cnts + 4) < need) __builtin_amdgcn_s_sleep(1);
            asm volatile("" ::: "memory");
            if (wid == 7 && blk >= NBUF) {
#pragma unroll
                for (int i = 0; i < TB * 16 / 64; ++i) {
                    const unsigned id = i * 64 + lane, st = id >> 4, rw = id & 15;
                    const unsigned tok = tokb + scan_pos((blk - NBUF) * TB + st, dir);
                    Yo[tok * 1024u + hc + rg * 16 + rw] = (bf16_t)(pk_bf16(ybuf[buf * (TB * 16) + id], 0.f) & 0xffffu);
                }
            }
            if (blk >= NBLK) continue;
            const unsigned st = wt * 16 + fr;
            const unsigned tok = tokb + scan_pos(blk * TB + st, dir);
            const unsigned lo = tok * 128u + dir * 64u + fq * 8u;
            const unsigned ro = tok * 1024u + hc + fq * 4u;
            bf16x8 lwf[2], laf[2];
#pragma unroll
            for (int kk = 0; kk < 2; ++kk) { lwf[kk] = *(const bf16x8*)(LW + lo + kk * 32); laf[kk] = *(const bf16x8*)(LA + lo + kk * 32); }
            float ssq = 0.f;
#pragma unroll
            for (int nt = 0; nt < 4; ++nt) {
                const f32x4 kkv = *(const f32x4*)(p.rwkv_k_k + po + nt * 16);
                const u32x2 c = *(const u32x2*)(Kk + ro + nt * 16);
                const float q0 = bf_lo(c[0]) * kkv[0], q1 = bf_hi(c[0]) * kkv[1], q2 = bf_lo(c[1]) * kkv[2], q3 = bf_hi(c[1]) * kkv[3];
                ssq += q0 * q0 + q1 * q1 + q2 * q2 + q3 * q3;
            }
            ssq += __shfl_xor(ssq, 16); ssq += __shfl_xor(ssq, 32);
            const float kn = __builtin_amdgcn_rsqf(fmaxf(ssq, 1e-24f));
            float* rec = ops + buf * (TB * SC_REC) + st * SC_REC + fq * 4;
            float bsum = 0.f;
#pragma unroll
            for (int n2 = 0; n2 < 2; ++n2) {
                const unsigned nt = chh * 2 + n2;
                f32x4 aw = {0.f, 0.f, 0.f, 0.f}, ai = aw;
#pragma unroll
                for (int kk = 0; kk < 2; ++kk) {
                    const bf16x8 w2f = *(const bf16x8*)(wsm + wo + nt * 1024 + kk * 32), a2f = *(const bf16x8*)(wsm + ao + nt * 1024 + kk * 32);
                    aw = __builtin_amdgcn_mfma_f32_16x16x32_bf16(w2f, lwf[kk], aw, 0, 0, 0);
                    ai = __builtin_amdgcn_mfma_f32_16x16x32_bf16(a2f, laf[kk], ai, 0, 0, 0);
                }
                const f32x4 w0v = *(const f32x4*)(p.rwkv_decay_w0 + dir * 1024u + po + nt * 16), a0v = *(const f32x4*)(p.rwkv_iclr_a0 + dir * 1024u + po + nt * 16);
                const f32x4 kkv = *(const f32x4*)(p.rwkv_k_k + po + nt * 16);
                const f32x4 kav = *(const f32x4*)(p.rwkv_k_a + po + nt * 16), rkv = *(const f32x4*)(p.rwkv_r_k + po + nt * 16);
                const u32x2 a = *(const u32x2*)(R + ro + nt * 16), c = *(const u32x2*)(Kk + ro + nt * 16);
                const f32x4 rr = {bf_lo(a[0]), bf_hi(a[0]), bf_lo(a[1]), bf_hi(a[1])};
                const f32x4 kr = {bf_lo(c[0]), bf_hi(c[0]), bf_lo(c[1]), bf_hi(c[1])};
                f32x4 wv, kd, bb, aa;
#pragma unroll
                for (int j = 0; j < 4; ++j) {
                    const float sg = __builtin_amdgcn_rcpf(1.0f + __builtin_amdgcn_exp2f(-(w0v[j] + aw[j]) * LOG2E));
                    wv[j] = __builtin_amdgcn_exp2f(sg * (-0.6065306597126334f * LOG2E));
                    const float ic = __builtin_amdgcn_rcpf(1.0f + __builtin_amdgcn_exp2f(-(a0v[j] + ai[j]) * LOG2E));
                    const float kkn = kr[j] * kkv[j] * kn;
                    kd[j] = kr[j] * (1.0f + (ic - 1.0f) * kav[j]);
                    bb[j] = kkn * ic;
                    aa[j] = -kkn;
                    bsum += rr[j] * kd[j] * rkv[j];
                }
                *(f32x4*)(rec + 0 * 64 + nt * 16) = wv;
                *(f32x4*)(rec + 1 * 64 + nt * 16) = kd;
                *(f32x4*)(rec + 2 * 64 + nt * 16) = bb;
                *(f32x4*)(rec + 3 * 64 + nt * 16) = aa;
                *(f32x4*)(rec + 4 * 64 + nt * 16) = rr;
            }
            bsum += __shfl_xor(bsum, 16); bsum += __shfl_xor(bsum, 32);
            if (rg == 0 && fq == 0) bonus[((chh * 2 + dir) * TTOT + tok) * 16u + hd] = bsum;
            if (wid == 6) {
                bf16_t vr[TB * 16 / 64];
#pragma unroll
                for (int i = 0; i < TB * 16 / 64; ++i) {
                    const unsigned id = i * 64 + lane, s2 = id >> 4, rw = id & 15;
                    const unsigned tk = tokb + scan_pos(blk * TB + s2, dir);
                    vr[i] = V[tk * 1024u + hc + rg * 16 + rw];
                }
#pragma unroll
                for (int i = 0; i < TB * 16 / 64; ++i) vbuf[buf * (TB * 16) + i * 64 + lane] = bf2f(vr[i]);
            }
            asm volatile("s_waitcnt lgkmcnt(0)" ::: "memory");
            if (lane == 0) lds_publish(cnts + (wid - 4), blk + 1);
        }
    }
    __syncthreads();
}

constexpr int CH = 16, NCHK = PTOT / CH;
constexpr int NPREP = 7, NSLOT = 2;
constexpr int TKS = 72, KTS = 20, SMS = 20;
constexpr int SL_PT = 0, SL_QM = SL_PT + 64 * TKS * 2, SL_RT = SL_QM + 64 * KTS * 2, SL_G2 = SL_RT + 16 * TKS * 2, SL_VT = SL_G2 + 16 * SMS * 2, SL_WC = SL_VT + 16 * SMS * 2,
              SLOT_BYTES = SL_WC + 64 * 4;
constexpr int XTK_B = 16 * TKS * 2, XKT_B = 64 * KTS * 2, SM_B = 16 * SMS * 2;
constexpr int PR_XA = 0, PR_XB = PR_XA + XTK_B, PR_XK = PR_XB + XTK_B, PR_XR = PR_XK + XTK_B, PR_TA = PR_XR + XTK_B, PR_TB = PR_TA + XKT_B, PR_TK = PR_TB + XKT_B,
              PR_SN = PR_TK + XKT_B, PREP_BYTES = PR_SN + 2 * SM_B;
static_assert(10 * SM_B <= 3 * XTK_B, "matrices fit in XA..XK");
constexpr int SC2_SMEM = NSLOT * SLOT_BYTES + NPREP * PREP_BYTES + 64 + 5 * 64 * 4;
typedef short s16x4v __attribute__((ext_vector_type(4)));
DI f32x4 mfma16(s16x4v a, s16x4v b, f32x4 c) { return __builtin_amdgcn_mfma_f32_16x16x16bf16_1k(a, b, c, 0, 0, 0); }
DI f32x4 mfma32(bf16x8 a, bf16x8 b, f32x4 c) { return __builtin_amdgcn_mfma_f32_16x16x32_bf16(a, b, c, 0, 0, 0); }
DI s16x4v ld4(const bf16_t* q) { return *(const s16x4v*)q; }
DI f32x4 up4(u32x2 w) { return (f32x4){bf_lo(w[0]), bf_hi(w[0]), bf_lo(w[1]), bf_hi(w[1])}; }
DI f32x4 ld4f(const bf16_t* q) { return up4(*(const u32x2*)q); }
DI void st4(bf16_t* q, f32x4 v) { u32x2 w; w[0] = pk_bf16(v[0], v[1]); w[1] = pk_bf16(v[2], v[3]); *(u32x2*)q = w; }
#define LDS_WAIT() asm volatile("s_waitcnt lgkmcnt(0)" ::: "memory")
template <int CTRL> DI float dpp_shr_add(float v) { return v + __builtin_bit_cast(float, __builtin_amdgcn_update_dpp(0, __builtin_bit_cast(int, v), CTRL, 0xf, 0xf, true)); }
DI float row16_prefix(float v) { v = dpp_shr_add<0x111>(v); v = dpp_shr_add<0x112>(v); v = dpp_shr_add<0x114>(v); v = dpp_shr_add<0x118>(v); return v; }
DI f32x4 mm16(const bf16_t* A, const bf16_t* Bt, int fr, int fq) {
    const s16x4v a = ld4(A + fr * SMS + fq * 4), b = ld4(Bt + fr * SMS + fq * 4);
    LDS_WAIT();
    return mfma16(a, b, (f32x4){0.f, 0.f, 0.f, 0.f});
}
DI f32x4 mm16p(const bf16_t* A, const bf16_t* Bt, const bf16_t* Add, int fr, int fq) {
    const s16x4v a = ld4(A + fr * SMS + fq * 4), b = ld4(Bt + fr * SMS + fq * 4);
    const u32x2 c = *(const u32x2*)(Add + fr * SMS + fq * 4);
    LDS_WAIT();
    return mfma16(a, b, up4(c));
}

DI void scan_unit_chunked(const Params& p, int u, char* smem) {
    const int t = tidx(), lane = t & 63, wid = __builtin_amdgcn_readfirstlane(t >> 6);
    const unsigned rg = u & 3, dir = (u >> 2) & 1, hd = (u >> 3) & 15, b = u >> 7;
    const unsigned tokb = b * PTOT, hc = hd * 64;
    const unsigned fr = lane & 15, fq = lane >> 4;
    char* slots = smem;
    char* prep0 = smem + NSLOT * SLOT_BYTES;
    int* cnts = (int*)(smem + NSLOT * SLOT_BYTES + NPREP * PREP_BYTES);
    const bf16_t* R = (const bf16_t*)(p.ws + OFF_SCR + S_R);
    const bf16_t* Kk = (const bf16_t*)(p.ws + OFF_SCR + S_KK);
    const bf16_t* V = (const bf16_t*)(p.ws + OFF_SCR + S_V);
    const bf16_t* LW = (const bf16_t*)(p.ws + OFF_SCR + S_LW);
    const bf16_t* LA = (const bf16_t*)(p.ws + OFF_SCR + S_LA);
    bf16_t* Yo = dir ? (bf16_t*)(p.ws + OFF_SCR + S_Y1) : (bf16_t*)(p.ws + OFF_H);
    float* bonus = (float*)(p.ws + OFF_BONUS2);
    float* prm = (float*)(cnts + 16);
    if (t < 16) cnts[t] = 0;
    if (t < 64) {
        prm[t] = p.rwkv_decay_w0[dir * 1024u + hc + t]; prm[64 + t] = p.rwkv_iclr_a0[dir * 1024u + hc + t];
        prm[128 + t] = p.rwkv_k_k[hc + t]; prm[192 + t] = p.rwkv_k_a[hc + t]; prm[256 + t] = p.rwkv_r_k[hc + t];
    }
    __syncthreads();

    if (wid == 0) {
        __builtin_amdgcn_s_setprio(3);
        f32x4 st[4];
#pragma unroll
        for (int m = 0; m < 4; ++m) st[m] = (f32x4){0.f, 0.f, 0.f, 0.f};
        for (int c = 0; c < NCHK; ++c) {
            const unsigned sl = (unsigned)c % NSLOT;
            const char* S = slots + sl * SLOT_BYTES;
            while (*(volatile LAS int*)(cnts + sl) < c + 1) __builtin_amdgcn_s_sleep(1);
            LDS_WAIT();
            const s16x4v vt = ld4((const bf16_t*)(S + SL_VT) + fr * SMS + fq * 4);
            const s16x4v g2 = ld4((const bf16_t*)(S + SL_G2) + fr * SMS + fq * 4);
            s16x4v rtl[2], rth[2], ptl[4][2], pth[4][2], qm[4];
            f32x4 wc[4];
#pragma unroll
            for (int i = 0; i < 2; ++i) { const bf16_t* q = (const bf16_t*)(S + SL_RT) + fr * TKS + 32 * i + fq * 4; rtl[i] = ld4(q); rth[i] = ld4(q + 16); }
#pragma unroll
            for (int m = 0; m < 4; ++m) {
                wc[m] = *(const f32x4*)((const float*)(S + SL_WC) + 16 * m + fq * 4);
                qm[m] = ld4((const bf16_t*)(S + SL_QM) + (16 * m + fr) * KTS + fq * 4);
#pragma unroll
                for (int i = 0; i < 2; ++i) { const bf16_t* q = (const bf16_t*)(S + SL_PT) + (16 * m + fr) * TKS + 32 * i + fq * 4; ptl[m][i] = ld4(q); pth[m][i] = ld4(q + 16); }
            }
            LDS_WAIT();
            if (lane == 0) *(volatile LAS int*)(cnts + 8) = c + 1;
            bf16x8 sb[2];
#pragma unroll
            for (int i = 0; i < 2; ++i) {
                u32x4 w; w[0] = pk_bf16(st[2 * i][0], st[2 * i][1]); w[1] = pk_bf16(st[2 * i][2], st[2 * i][3]); w[2] = pk_bf16(st[2 * i + 1][0], st[2 * i + 1][1]); w[3] = pk_bf16(st[2 * i + 1][2], st[2 * i + 1][3]);
                sb[i] = __builtin_bit_cast(bf16x8, w);
            }
            f32x4 y = {0.f, 0.f, 0.f, 0.f};
#pragma unroll
            for (int i = 0; i < 2; ++i) y = mfma32(__builtin_shufflevector(rtl[i], rth[i], 0, 1, 2, 3, 4, 5, 6, 7), sb[i], y);
            y = mfma16(g2, vt, y);
#pragma unroll
            for (int m = 0; m < 4; ++m) {
                f32x4 acc = st[m] * wc[m];
#pragma unroll
                for (int i = 0; i < 2; ++i) acc = mfma32(__builtin_shufflevector(ptl[m][i], pth[m][i], 0, 1, 2, 3, 4, 5, 6, 7), sb[i], acc);
                st[m] = mfma16(qm[m], vt, acc);
            }

#pragma unroll
            for (int j = 0; j < 4; ++j) {
                const unsigned tok = tokb + scan_pos(c * CH + fq * 4 + j, dir);
                Yo[tok * 1024u + hc + rg * 16 + fr] = (bf16_t)(pk_bf16(y[j], 0.f) & 0xffffu);
            }
        }
        __builtin_amdgcn_s_setprio(0);
    } else {
        const unsigned pid = wid - 1;
        char* PS = prep0 + pid * PREP_BYTES;
        bf16_t* XA = (bf16_t*)(PS + PR_XA); bf16_t* XB = (bf16_t*)(PS + PR_XB); bf16_t* XK = (bf16_t*)(PS + PR_XK); bf16_t* XR = (bf16_t*)(PS + PR_XR);
        bf16_t* TA = (bf16_t*)(PS + PR_TA); bf16_t* TB_ = (bf16_t*)(PS + PR_TB); bf16_t* TK = (bf16_t*)(PS + PR_TK); bf16_t* AT = TA;
        bf16_t* SN = (bf16_t*)(PS + PR_SN);
        bf16_t *M = SN, *NABR = SN + 1 * 16 * SMS;
        bf16_t *M2 = XA, *M2T = XA + 1 * 16 * SMS, *M4 = XA + 2 * 16 * SMS, *M4T = XA + 3 * 16 * SMS, *X1 = XA + 4 * 16 * SMS, *G1 = XA + 5 * 16 * SMS, *NAKR = XA + 6 * 16 * SMS,
                *NRBT = XA + 7 * 16 * SMS, *NRKT = XA + 8 * 16 * SMS, *IM = XA + 9 * 16 * SMS;
        bf16_t *M8T = M2, *X2 = M2T, *TT = M4;
        float* WCP = (float*)SN;
        const bf16_t* wsm = (const bf16_t*)(p.ws + OFF_WS);
        const unsigned wo = W_W2 + dir * 65536u + (hc + fr) * 64u + fq * 8u;
        const unsigned ao = W_A2 + dir * 65536u + (hc + fr) * 64u + fq * 8u;
        const unsigned po = hc + fq * 4u;
        const f32x4 z4 = {0.f, 0.f, 0.f, 0.f};
        bf16x8 lwf[2], laf[2], lwn[2], lan[2];
        u32x2 krw[4], rrw[4], krn[4], rrn[4];
        unsigned tok_cur = 0, tok_nxt = 0;
        auto issue = [&](int c, bf16x8 (&lw)[2], bf16x8 (&la)[2], u32x2 (&kw)[4], u32x2 (&rw)[4], unsigned& tk) {
            tk = tokb + scan_pos(c * CH + fr, dir);
            const unsigned lo = tk * 128u + dir * 64u + fq * 8u, ro = tk * 1024u + hc + fq * 4u;
#pragma unroll
            for (int kk = 0; kk < 2; ++kk) { lw[kk] = *(const bf16x8*)(LW + lo + kk * 32); la[kk] = *(const bf16x8*)(LA + lo + kk * 32); }
#pragma unroll
            for (int nt = 0; nt < 4; ++nt) { kw[nt] = *(const u32x2*)(Kk + ro + nt * 16); rw[nt] = *(const u32x2*)(R + ro + nt * 16); }
        };
        if ((int)pid < NCHK) issue(pid, lwf, laf, krw, rrw, tok_cur);
        for (int c = pid; c < NCHK; c += NPREP) {
            if (c + NPREP < NCHK) issue(c + NPREP, lwn, lan, krn, rrn, tok_nxt);
            const unsigned tok = tok_cur;
            float ssq = 0.f;
#pragma unroll
            for (int nt = 0; nt < 4; ++nt) {
                const f32x4 kkv = *(const f32x4*)(prm + 128 + fq * 4 + nt * 16);
                const f32x4 q = up4(krw[nt]) * kkv;
                ssq += q[0] * q[0] + q[1] * q[1] + q[2] * q[2] + q[3] * q[3];
            }
            ssq += __shfl_xor(ssq, 16); ssq += __shfl_xor(ssq, 32);
            const float kn = __builtin_amdgcn_rsqf(fmaxf(ssq, 1e-24f));
            float bsum = 0.f;
#pragma unroll
            for (int nt = 0; nt < 4; ++nt) {
                f32x4 aw = z4, ai = z4;
#pragma unroll
                for (int kk = 0; kk < 2; ++kk) {
                    const bf16x8 w2f = *(const bf16x8*)(wsm + wo + nt * 1024 + kk * 32), a2f = *(const bf16x8*)(wsm + ao + nt * 1024 + kk * 32);
                    aw = mfma32(w2f, lwf[kk], aw);
                    ai = mfma32(a2f, laf[kk], ai);
                }
                const f32x4 w0v = *(const f32x4*)(prm + fq * 4 + nt * 16), a0v = *(const f32x4*)(prm + 64 + fq * 4 + nt * 16);
                const f32x4 kkv = *(const f32x4*)(prm + 128 + fq * 4 + nt * 16);
                const f32x4 kav = *(const f32x4*)(prm + 192 + fq * 4 + nt * 16), rkv = *(const f32x4*)(prm + 256 + fq * 4 + nt * 16);
                LDS_WAIT();
                const f32x4 rr = up4(rrw[nt]), krn4 = up4(krw[nt]);
                const f32x4 x1 = (w0v + aw) * (-LOG2E), x2 = (a0v + ai) * (-LOG2E);
                f32x4 ex1, ex2;
#pragma unroll
                for (int j = 0; j < 4; ++j) { ex1[j] = __builtin_amdgcn_exp2f(x1[j]); ex2[j] = __builtin_amdgcn_exp2f(x2[j]); }
                ex1 = ex1 + 1.0f; ex2 = ex2 + 1.0f;
                f32x4 sg, ic;
#pragma unroll
                for (int j = 0; j < 4; ++j) { sg[j] = __builtin_amdgcn_rcpf(ex1[j]); ic[j] = __builtin_amdgcn_rcpf(ex2[j]); }
                const f32x4 e2 = sg * (0.6065306597126334f * LOG2E);
                const f32x4 kkn = krn4 * kkv * kn;
                const f32x4 kd = krn4 * ((ic - 1.0f) * kav + 1.0f);
                { const f32x4 bq = rr * kd * rkv; bsum += (bq[0] + bq[1]) + (bq[2] + bq[3]); }
                f32x4 wt, wi, wp;
#pragma unroll
                for (int j = 0; j < 4; ++j) {
                    const float ec = row16_prefix(e2[j]);
                    wt[j] = __builtin_amdgcn_exp2f(-ec);
                    wi[j] = __builtin_amdgcn_exp2f(ec);
                    wp[j] = __builtin_amdgcn_exp2f(e2[j] - ec);
                }
                const f32x4 at = -(kkn * wp), rt = rr * wt, bt = kkn * ic * wi, kt = kd * wi;
                {
                    u32x2 wa, wb, wk;
                    wa[0] = pk_bf16(at[0], at[1]); wa[1] = pk_bf16(at[2], at[3]); wb[0] = pk_bf16(bt[0], bt[1]); wb[1] = pk_bf16(bt[2], bt[3]);
                    wk[0] = pk_bf16(kt[0], kt[1]); wk[1] = pk_bf16(kt[2], kt[3]);
                    *(u32x2*)(XA + fr * TKS + nt * 16 + fq * 4) = wa; *(u32x2*)(XB + fr * TKS + nt * 16 + fq * 4) = wb; *(u32x2*)(XK + fr * TKS + nt * 16 + fq * 4) = wk;
                    const unsigned o = (nt * 16 + fq * 4) * KTS + fr;
#pragma unroll
                    for (int j = 0; j < 4; ++j) {
                        TA[o + j * KTS] = (bf16_t)((j & 1) ? (wa[j >> 1] >> 16) : (wa[j >> 1] & 0xffffu));
                        TB_[o + j * KTS] = (bf16_t)((j & 1) ? (wb[j >> 1] >> 16) : (wb[j >> 1] & 0xffffu));
                        TK[o + j * KTS] = (bf16_t)((j & 1) ? (wk[j >> 1] >> 16) : (wk[j >> 1] & 0xffffu));
                    }
                }
                if (fr == 15) *(f32x4*)(WCP + nt * 16 + fq * 4) = wt;
                st4(XR + fr * TKS + nt * 16 + fq * 4, rt);
            }
            bsum += __shfl_xor(bsum, 16); bsum += __shfl_xor(bsum, 32);
            if (rg == 0 && fq == 0) { bonus[((0 * 2 + dir) * TTOT + tok) * 16u + hd] = bsum; bonus[((1 * 2 + dir) * TTOT + tok) * 16u + hd] = 0.f; }
            LDS_WAIT();
            float wcr[4];
#pragma unroll
            for (int n = 0; n < 4; ++n) wcr[n] = WCP[16 * n + fr];
            bf16x8 fa[2], fb[2], fk[2], frr[2];
#pragma unroll
            for (int kk = 0; kk < 2; ++kk) {
                fa[kk] = *(const bf16x8*)(XA + fr * TKS + kk * 32 + fq * 8); fb[kk] = *(const bf16x8*)(XB + fr * TKS + kk * 32 + fq * 8);
                fk[kk] = *(const bf16x8*)(XK + fr * TKS + kk * 32 + fq * 8); frr[kk] = *(const bf16x8*)(XR + fr * TKS + kk * 32 + fq * 8);
            }
            LDS_WAIT();
            f32x4 d1 = z4, d2 = z4, d3 = z4, d4 = z4, d5 = z4;
#pragma unroll
            for (int kk = 0; kk < 2; ++kk) {
                d1 = mfma32(fb[kk], fa[kk], d1);
                d2 = mfma32(fa[kk], fb[kk], d2);
                d3 = mfma32(fa[kk], fk[kk], d3);
                d4 = mfma32(fb[kk], frr[kk], d4);
                d5 = mfma32(fk[kk], frr[kk], d5);
            }
            f32x4 im;
#pragma unroll
            for (int j = 0; j < 4; ++j) {
                const unsigned ij = fq * 4 + j;
                d1[j] = ij < fr ? d1[j] : 0.f;
                d2[j] = fr < ij ? d2[j] : 0.f;
                d3[j] = fr < ij ? d3[j] : 0.f;
                d4[j] = ij <= fr ? d4[j] : 0.f;
                d5[j] = ij <= fr ? d5[j] : 0.f;
                im[j] = d1[j] + (ij == fr ? 1.0f : 0.f);
            }
            st4(M + fr * SMS + fq * 4, d1);
            st4(IM + fr * SMS + fq * 4, im);
            st4(NABR + fr * SMS + fq * 4, d2);
            st4(NAKR + fr * SMS + fq * 4, d3);
            st4(NRBT + fr * SMS + fq * 4, d4);
            st4(NRKT + fr * SMS + fq * 4, d5);
            LDS_WAIT();
            const int so = fr * SMS + fq * 4;
            {
                const s16x4v m = ld4(M + so), mt = ld4(NABR + so);
                LDS_WAIT();
                st4(M2T + so, mfma16(m, mt, z4)); st4(M2 + so, mfma16(mt, m, z4));
                LDS_WAIT();
            }
            {
                const s16x4v m2 = ld4(M2 + so), m2t = ld4(M2T + so); const u32x2 imr = *(const u32x2*)(IM + so);
                LDS_WAIT();
                st4(M4T + so, mfma16(m2, m2t, z4)); st4(M4 + so, mfma16(m2t, m2, z4));
                st4(X1 + so, mfma16(m2t, __builtin_bit_cast(s16x4v, imr), up4(imr)));
                LDS_WAIT();
            }
            {
                const s16x4v m4 = ld4(M4 + so), m4t = ld4(M4T + so); const u32x2 x1r = *(const u32x2*)(X1 + so);
                LDS_WAIT();
                st4(M8T + so, mfma16(m4, m4t, z4));
                st4(X2 + so, mfma16(m4t, __builtin_bit_cast(s16x4v, x1r), up4(x1r)));
                LDS_WAIT();
            }
            {
                const s16x4v m8t = ld4(M8T + so); const u32x2 x2r = *(const u32x2*)(X2 + so);
                LDS_WAIT();
                st4(TT + so, mfma16(m8t, __builtin_bit_cast(s16x4v, x2r), up4(x2r)));
                LDS_WAIT();
            }
            {
                const s16x4v ta = ld4(TT + so), nk = ld4(NAKR + so);
                s16x4v xa[4];
#pragma unroll
                for (int n = 0; n < 4; ++n) xa[n] = ld4(TA + (16 * n + fr) * KTS + fq * 4);
                LDS_WAIT();
                st4(G1 + so, mfma16(ta, nk, z4));
#pragma unroll
                for (int n = 0; n < 4; ++n) st4(AT + (16 * n + fr) * KTS + fq * 4, mfma16(ta, xa[n], z4));
                LDS_WAIT();
            }
            const unsigned sl = (unsigned)c % NSLOT;
            char* S = slots + sl * SLOT_BYTES;
            {
                unsigned vv[2][2];
#pragma unroll
                for (int i = 0; i < 2; ++i) {
                    const unsigned q = i * 64 + lane, vrow = q & 15, sp = q >> 4;
                    const unsigned tk0 = tokb + scan_pos(c * CH + 2 * sp, dir), tk1 = tokb + scan_pos(c * CH + 2 * sp + 1, dir);
                    vv[i][0] = V[tk0 * 1024u + hc + rg * 16 + vrow]; vv[i][1] = V[tk1 * 1024u + hc + rg * 16 + vrow];
                }
                const s16x4v nrb = ld4(NRBT + so), g1 = ld4(G1 + so);
                const u32x2 nrk = *(const u32x2*)(NRKT + so);
                s16x4v atm[4], tb[4]; u32x2 xr[4], tk[4];
#pragma unroll
                for (int m = 0; m < 4; ++m) {
                    atm[m] = ld4(AT + (16 * m + fr) * KTS + fq * 4); tb[m] = ld4(TB_ + (16 * m + fr) * KTS + fq * 4);
                    xr[m] = *(const u32x2*)(XR + fr * TKS + 16 * m + fq * 4); tk[m] = *(const u32x2*)(TK + (16 * m + fr) * KTS + fq * 4);
                }
                LDS_WAIT();
                while (*(volatile LAS int*)(cnts + 8) < c - NSLOT + 1) __builtin_amdgcn_s_sleep(1);
                asm volatile("" ::: "memory");
                st4((bf16_t*)(S + SL_G2) + so, mfma16(g1, nrb, up4(nrk)));
#pragma unroll
                for (int m = 0; m < 4; ++m) {
                    st4((bf16_t*)(S + SL_RT) + fr * TKS + 16 * m + fq * 4, mfma16(atm[m], nrb, up4(xr[m])));
#pragma unroll
                    for (int n = 0; n < 4; ++n) st4((bf16_t*)(S + SL_PT) + (16 * n + fr) * TKS + 16 * m + fq * 4, mfma16(atm[m], tb[n], z4) * wcr[n]);
                    asm volatile("" ::: "memory");
                }
#pragma unroll
                for (int n = 0; n < 4; ++n) st4((bf16_t*)(S + SL_QM) + (16 * n + fr) * KTS + fq * 4, mfma16(g1, tb[n], up4(tk[n])) * wcr[n]);
                ((float*)(S + SL_WC))[lane] = (fq == 0) ? wcr[0] : (fq == 1) ? wcr[1] : (fq == 2) ? wcr[2] : wcr[3];
#pragma unroll
                for (int i = 0; i < 2; ++i) {
                    const unsigned q = i * 64 + lane, vrow = q & 15, sp = q >> 4;
                    *(unsigned*)((bf16_t*)(S + SL_VT) + vrow * SMS + 2 * sp) = vv[i][0] | (vv[i][1] << 16);
                }
            }
            LDS_WAIT();
            if (lane == 0) *(volatile LAS int*)(cnts + sl) = c + 1;
#pragma unroll
            for (int kk = 0; kk < 2; ++kk) { lwf[kk] = lwn[kk]; laf[kk] = lan[kk]; }
#pragma unroll
            for (int nt = 0; nt < 4; ++nt) { krw[nt] = krn[nt]; rrw[nt] = rrn[nt]; }
            tok_cur = tok_nxt;
        }
    }
    __syncthreads();
}

DI void phase_scan(const Params& p, char* smem) {
    for (int u = blockIdx.x; u < NBATCH * 16 * 2 * 4; u += gridDim.x) scan_unit_chunked(p, u, smem);
}

constexpr int NPHASE = 18;
constexpr int SMEM_BYTES = (SC2_SMEM > SC_SMEM ? SC2_SMEM : SC_SMEM) + 64;
static_assert(SMEM_BYTES >= GEMM_SMEM + 64 && SMEM_BYTES + 16 <= 163840, "LDS");
template <int PH> DI void run_phase(const Params& p, char* smem) {
    if constexpr (PH == 0) phase_prologue(p, smem);
    else if constexpr (PH == 1) phase_norm0(p);
    else if constexpr (PH == 2) phase_qkv(p, smem);
    else if constexpr (PH == 3) phase_attn(p, smem);
    else if constexpr (PH == 4) phase_wout(p, smem);
    else if constexpr (PH == 5) phase_ffn_norm_route(p, 0, smem);
    else if constexpr (PH == 6) phase_moe1(p, 0, smem);
    else if constexpr (PH == 7) phase_moe2(p, 0, smem);
    else if constexpr (PH == 8) phase_combine_l0(p, smem);
    else if constexpr (PH == 9) phase_xx(p);
    else if constexpr (PH == 10) phase_rwkv_proj(p, smem);
    else if constexpr (PH == 11) phase_scan(p, smem);
    else if constexpr (PH == 12) phase_gate(p, smem);
    else if constexpr (PH == 13) phase_wo(p, smem);
    else if constexpr (PH == 14) phase_ffn_norm_route(p, 1, smem);
    else if constexpr (PH == 15) phase_moe1(p, 1, smem);
    else if constexpr (PH == 16) phase_moe2(p, 1, smem);
    else if constexpr (PH == 17) phase_final(p);
}
template <int PH, int END> struct PhaseSeq {
    static DI void run(const Params& p, char* smem, const XcdBarrier& bar) {
        run_phase<PH>(p, smem);
        if constexpr (PH + 1 < END) { xcd_barrier(bar); PhaseSeq<PH + 1, END>::run(p, smem, bar); }
    }
};
template <int BEG, int END>
__global__ void __launch_bounds__(NTH, 2) fwd_kernel(Params p) {
    extern __shared__ __attribute__((aligned(16))) char smem_raw[];
    char* smem = smem_raw + 16;
    if constexpr (END - BEG > 1) {
        if (tidx() == 0) *(uint4*)smem_raw = make_uint4(0u, 0u, 0u, 0u);
        __syncthreads();
        XcdBarrier bar = xcd_barrier_post((unsigned*)(p.ws + OFF_BAR), (volatile LAS unsigned*)smem_raw);
        PhaseSeq<BEG, END>::run(p, smem, bar);
    } else {
        run_phase<BEG>(p, smem);
    }
}

template <int BEG, int END> static void launch_range(const Params& p, int grid, hipStream_t stream) {
    (void)hipFuncSetAttribute((const void*)fwd_kernel<BEG, END>, hipFuncAttributeMaxDynamicSharedMemorySize, SMEM_BYTES + 16);
    hipLaunchKernelGGL((fwd_kernel<BEG, END>), dim3(grid), dim3(NTH), SMEM_BYTES + 16, stream, p);
}
#ifndef RUN_PHASES
#define RUN_PHASES NPHASE
#endif
#ifndef REPEAT_PHASE
#define REPEAT_PHASE -1
#endif
template <int PH> static void launch_each(const Params& p, int grid, hipStream_t stream) {
    launch_range<PH, PH + 1>(p, grid, stream);
    if (PH == REPEAT_PHASE) launch_range<PH, PH + 1>(p, grid, stream);
    if constexpr (PH + 1 < RUN_PHASES) launch_each<PH + 1>(p, grid, stream);
}

extern "C" void kernel_launch(void* const* d_in, const int* in_sizes, int n_in, void* d_out, int out_size, void* d_ws, size_t ws_size, hipStream_t stream) {
    Params p{};
    const float** f = (const float**)&p;
    for (int i = 0; i < 37; ++i) f[i] = (const float*)d_in[i];
    p.out = (float*)d_out;
    p.ws = (char*)d_ws;
    if (ws_size < WS_NEED || n_in < 37) return;
    static int grid = 0;
    if (!grid) {
        int dev = 0, cus = 0;
        (void)hipGetDevice(&dev);
        (void)hipDeviceGetAttribute(&cus, hipDeviceAttributeMultiprocessorCount, dev);
        grid = cus > 0 ? cus : 256;
    }
    (void)hipMemsetAsync(d_ws, 0, 32768, stream);
#if MEGA
    launch_range<0, NPHASE>(p, grid, stream);
#else
    launch_each<0>(p, grid, stream);
#endif
}
```

```cpp
#include <hip/hip_runtime.h>
#include <stdint.h>
#include <stdio.h>

#ifndef MEGA
#define MEGA 1
#endif

typedef unsigned short bf16_t;
typedef short bf16x8 __attribute__((ext_vector_type(8)));
typedef short s16x4 __attribute__((ext_vector_type(4)));
typedef float f32x2 __attribute__((ext_vector_type(2)));
typedef float f32x4 __attribute__((ext_vector_type(4)));
typedef float f32x16 __attribute__((ext_vector_type(16)));
typedef unsigned u32x2 __attribute__((ext_vector_type(2)));
typedef unsigned u32x4 __attribute__((ext_vector_type(4)));
typedef __bf16 bf16x2_t __attribute__((ext_vector_type(2)));
#define DI __device__ __forceinline__
__device__ __forceinline__ unsigned tidx() { unsigned t = threadIdx.x; asm volatile("" : "+v"(t)); return t; }

constexpr int DM = 1024, NBATCH = 2, SEQ = 16384, LCTX = 256, PTOT = SEQ + LCTX, TTOT = NBATCH * PTOT;
constexpr int NTH = 512, NWAVE = 8;
constexpr int QKV_N = 1536;
constexpr int NEXP = 16, CAP = TTOT * 2;
constexpr float RMS_EPS = 1e-6f, GN_EPS = 64e-5f;
constexpr float LOG2E = 1.4426950408889634f;

constexpr size_t MBy = 1u << 20;
constexpr size_t OFF_BAR   = 0;
constexpr size_t OFF_CNT   = 16384;
constexpr size_t OFF_MOD   = 32768;
constexpr size_t OFF_ROPE  = OFF_MOD + 2 * 3 * 6144 * 4;
constexpr size_t OFF_BONUS = 1 * MBy;
constexpr size_t OFF_BONUS2 = 6 * MBy;
constexpr size_t OFF_STOK  = 6 * MBy;
constexpr size_t OFF_SW    = 11 * MBy;
constexpr size_t OFF_XC    = 16 * MBy;
constexpr size_t OFF_WS    = 18 * MBy;
constexpr size_t OFF_MOEW  = 33 * MBy;
constexpr size_t OFF_H     = 129 * MBy;
constexpr size_t OFF_SCR   = 194 * MBy;
constexpr size_t SCR_SIZE  = 290 * MBy;
constexpr size_t WS_NEED   = OFF_SCR + SCR_SIZE;
constexpr size_t W_IN = 0, W_OUT = W_IN + 1536 * 1024, W_R = W_OUT + 1024 * 1024, W_K = W_R + 1024 * 1024, W_V = W_K + 1024 * 1024,
                 W_O = W_V + 1024 * 1024, W_W1 = W_O + 1024 * 1024, W_A1 = W_W1 + 128 * 1024, W_G1 = W_A1 + 128 * 1024,
                 W_W2 = W_G1 + 256 * 1024, W_A2 = W_W2 + 2 * 1024 * 64, W_G2 = W_A2 + 2 * 1024 * 64, W_END = W_G2 + 1024 * 192;
static_assert(W_END * 2 <= 15 * MBy, "small weights region");
constexpr size_t ROWB = (size_t)TTOT * 2048;
constexpr size_t S_Q = 0, S_K = S_Q + ROWB, S_VT = S_K + ROWB / 4, S_O = S_VT + ROWB / 4;
constexpr size_t S_HID = 0, S_Y = 140 * MBy;
constexpr size_t S_R = 0, S_KK = S_R + ROWB, S_V = S_KK + ROWB, S_LW = S_V + ROWB, S_LA = S_LW + ROWB / 8, S_LG = S_LA + ROWB / 8,
                 S_Y1 = 224 * MBy, S_XX = S_Y1, S_OR = S_R;
static_assert(S_O + ROWB <= SCR_SIZE, "scr");
static_assert(S_LG + (size_t)TTOT * 384 <= S_Y1, "scr2");
static_assert(S_Y1 + ROWB <= SCR_SIZE, "scr3");
static_assert(S_Y + 2 * ROWB <= SCR_SIZE, "scr4");
static_assert((size_t)(CAP / 256 + 16) * 256 * 2048 <= S_Y, "hid");
static_assert(OFF_H + ROWB <= OFF_SCR, "h");

struct Params {
    const float *x, *c, *ctx, *c_ctx, *ada_w, *ada_b, *norm_mix_g, *norm_ffn_g, *attn_w_in, *attn_w_out, *attn_sink, *attn_q_norm_g, *attn_k_norm_g,
        *rwkv_x_mix, *rwkv_w_r, *rwkv_w_k, *rwkv_w_v, *rwkv_w_o, *rwkv_decay_w0, *rwkv_decay_w1, *rwkv_decay_w2, *rwkv_iclr_a0, *rwkv_iclr_a1,
        *rwkv_iclr_a2, *rwkv_gate_g1, *rwkv_gate_g2, *rwkv_k_k, *rwkv_k_a, *rwkv_r_k, *rwkv_ln_g, *rwkv_ln_b, *router_w, *router_bias, *moe_w1,
        *moe_w3, *moe_w2, *final_norm_g;
    float* out;
    char* ws;
};

DI unsigned pk_bf16(float a, float b) { f32x2 v = {a, b}; bf16x2_t r = __builtin_convertvector(v, bf16x2_t); return __builtin_bit_cast(unsigned, r); }
DI float bf_lo(unsigned u) { return __uint_as_float(u << 16); }
DI float bf_hi(unsigned u) { return __uint_as_float(u & 0xffff0000u); }
DI float bf2f(bf16_t u) { return __uint_as_float(((unsigned)u) << 16); }
DI float wave_sum(float v) {
#pragma unroll
    for (int o = 32; o >= 1; o >>= 1) v += __shfl_xor(v, o);
    return v;
}
DI float sigmoidf_(float x) { return 1.0f / (1.0f + __expf(-x)); }
DI float siluf_(float x) { return x / (1.0f + __expf(-x)); }
DI float* xrow_ptr(const Params& p, int tok) {
    const int b = tok >= PTOT ? 1 : 0, pos = tok - b * PTOT;
    return pos < LCTX ? (float*)(p.ws + OFF_XC) + (size_t)(b * LCTX + pos) * DM : p.out + (size_t)(b * SEQ + pos - LCTX) * DM;
}
DI const float* xin_ptr(const Params& p, int tok) {
    const int b = tok >= PTOT ? 1 : 0, pos = tok - b * PTOT;
    return pos < LCTX ? p.ctx + (size_t)(b * LCTX + pos) * DM : p.x + (size_t)(b * SEQ + pos - LCTX) * DM;
}
DI const float* mod_ptr(const Params& p, int layer, int tok, int which) {
    const int b = tok >= PTOT ? 1 : 0, pos = tok - b * PTOT;
    const int w = pos < LCTX ? 2 : b;
    return (const float*)(p.ws + OFF_MOD) + (size_t)((layer * 3 + w) * 6 + which) * DM;
}

#define XB_TMO      128
#define XB_XCNT(j)  (256  + 64 * (j))
#define XB_XSUB(j)  (1280 + 64 * (j))
#define XB_XGEN(j)  (2304 + 64 * (j))
#define XB_TOP      3328
#define XB_TOPGEN   3392
#define XCD_BAR_WORDS 3456
#define XB_SPIN_CAP (1u << 18)
#define LAS __attribute__((address_space(3)))
DI unsigned xb_ld(unsigned* p)              { return __hip_atomic_load(p, __ATOMIC_RELAXED, __HIP_MEMORY_SCOPE_AGENT); }
DI unsigned xb_add(unsigned* p, unsigned v) { return __hip_atomic_fetch_add(p, v, __ATOMIC_RELAXED, __HIP_MEMORY_SCOPE_AGENT); }
DI unsigned xb_xcc_id() { return (unsigned)__builtin_amdgcn_s_getreg((3 << 11) | 20) & 0xFu; }
#define XB_SPIN(cond, bar) do { unsigned _sp = 0; while (cond) { __builtin_amdgcn_s_sleep(1); \
    if ((++_sp & 255u) == 0u) { if (xb_ld(&(bar)[XB_TMO])) break; if (_sp > XB_SPIN_CAP) { atomicAdd(&(bar)[XB_TMO], 1u); break; } } } } while (0)
struct XcdBarrier { unsigned* bar; unsigned x; volatile LAS unsigned* st; };
DI XcdBarrier xcd_barrier_post(unsigned* bar, volatile LAS unsigned* st) {
    XcdBarrier b; b.bar = bar; b.x = xb_xcc_id(); b.st = st;
    if (tidx() == 0) (void)xb_add(&bar[XB_XCNT(b.x)], 1u);
    return b;
}
DI void xcd_barrier_complete(unsigned* bar, unsigned x, unsigned& nloc, unsigned& nx) {
    const unsigned G = gridDim.x * gridDim.y * gridDim.z;
    unsigned sum, cnt, mine, sp = 0u;
    for (;;) {
        sum = 0u; cnt = 0u; mine = 0u;
#pragma unroll
        for (unsigned j = 0; j < 16; ++j) { const unsigned c = xb_ld(&bar[XB_XCNT(j)]); sum += c; cnt += (c > 0u) ? 1u : 0u; mine = (j == x) ? c : mine; }
        if (sum == G) break;
        __builtin_amdgcn_s_sleep(1);
        if ((++sp & 255u) == 0u) { if (xb_ld(&bar[XB_TMO])) break; if (sp > XB_SPIN_CAP) { atomicAdd(&bar[XB_TMO], 1u); break; } }
    }
    nloc = mine > 0u ? mine : 1u; nx = cnt > 0u ? cnt : 1u;
}
DI void xcd_barrier(const XcdBarrier& b) {
    asm volatile("s_waitcnt vmcnt(0)" ::: "memory");
    __syncthreads();
    if (tidx() == 0) {
        unsigned* bar = b.bar;
        __builtin_amdgcn_s_waitcnt(0);
        unsigned nloc = b.st[0], nx = b.st[1];
        if (nloc == 0u) { xcd_barrier_complete(bar, b.x, nloc, nx); b.st[0] = nloc; b.st[1] = nx; }
        const unsigned old = xb_add(&bar[XB_XSUB(b.x)], 1u);
        const unsigned gen = old / nloc;
        if (old + 1u == (gen + 1u) * nloc) {
            __builtin_amdgcn_fence(__ATOMIC_RELEASE, "agent");
            asm volatile("s_waitcnt vmcnt(0)" ::: "memory");
            const unsigned og = xb_add(&bar[XB_TOP], 1u);
            const unsigned tg = og / nx;
            if (og + 1u == (tg + 1u) * nx) xb_add(&bar[XB_TOPGEN], 1u);
            else XB_SPIN(xb_ld(&bar[XB_TOPGEN]) == tg, bar);
            __builtin_amdgcn_fence(__ATOMIC_ACQUIRE, "agent");
            xb_add(&bar[XB_XGEN(b.x)], 1u);
            asm volatile("s_waitcnt vmcnt(0)" ::: "memory");
        } else {
            XB_SPIN(xb_ld(&bar[XB_XGEN(b.x)]) == gen, bar);
            __builtin_amdgcn_fence(__ATOMIC_ACQUIRE, "agent");
            asm volatile("s_waitcnt vmcnt(0)" ::: "memory");
        }
    }
    __syncthreads();
}

DI void cvt_tile(const float* src, int ld, int kvalid, bool colvalid, bf16_t* dst, int dld, float* tile  ) {
    const int t = tidx();
    {
        const int k = t >> 3, c4 = (t & 7) * 4;
        f32x4 v = {0.f, 0.f, 0.f, 0.f};
        if (colvalid && k < kvalid) v = *(const f32x4*)(src + (size_t)k * ld + c4);
        tile[k * 33 + c4 + 0] = v[0]; tile[k * 33 + c4 + 1] = v[1]; tile[k * 33 + c4 + 2] = v[2]; tile[k * 33 + c4 + 3] = v[3];
    }
    __syncthreads();
    {
        const int n = t >> 4, kc = (t & 15) * 4;
        u32x2 w;
        w[0] = pk_bf16(tile[(kc + 0) * 33 + n], tile[(kc + 1) * 33 + n]);
        w[1] = pk_bf16(tile[(kc + 2) * 33 + n], tile[(kc + 3) * 33 + n]);
        *(u32x2*)(dst + (size_t)n * dld + kc) = w;
    }
    __syncthreads();
}
constexpr int CV_SMALL_UNITS = 768 + 512 * 5 + 64 + 64 + 128 + 64 + 64 + 96;
DI void cvt_small_unit(const Params& p, int u, float* tile) {
    bf16_t* wsm = (bf16_t*)(p.ws + OFF_WS);
    if (u < 768) { const int run = u >> 4, kt = u & 15; cvt_tile(p.attn_w_in + (size_t)kt * 64 * 1536 + run * 32, 1536, 64, true, wsm + W_IN + (size_t)run * 32 * 1024 + kt * 64, 1024, tile); return; }
    u -= 768;
    if (u < 512 * 5) {
        const int j = u >> 9, v = u & 511, run = v >> 4, kt = v & 15;
        const float* src = j == 0 ? p.attn_w_out : j == 1 ? p.rwkv_w_r : j == 2 ? p.rwkv_w_k : j == 3 ? p.rwkv_w_v : p.rwkv_w_o;
        const size_t dofs = j == 0 ? W_OUT : j == 1 ? W_R : j == 2 ? W_K : j == 3 ? W_V : W_O;
        cvt_tile(src + (size_t)kt * 64 * 1024 + run * 32, 1024, 64, true, wsm + dofs + (size_t)run * 32 * 1024 + kt * 64, 1024, tile); return;
    }
    u -= 512 * 5;
    if (u < 128) {
        const int j = u >> 6, v = u & 63, run = v >> 4, kt = v & 15, d = run >> 1, co = (run & 1) * 32;
        const float* src = (j == 0 ? p.rwkv_decay_w1 : p.rwkv_iclr_a1) + (size_t)d * 1024 * 64;
        cvt_tile(src + (size_t)kt * 64 * 64 + co, 64, 64, true, wsm + (j == 0 ? W_W1 : W_A1) + (size_t)run * 32 * 1024 + kt * 64, 1024, tile); return;
    }
    u -= 128;
    if (u < 128) {
        const int run = u >> 4, kt = u & 15;
        cvt_tile(p.rwkv_gate_g1 + (size_t)kt * 64 * 160 + run * 32, 160, 64, run < 5, wsm + W_G1 + (size_t)run * 32 * 1024 + kt * 64, 1024, tile); return;
    }
    u -= 128;
    if (u < 128) {
        const int j = u >> 6, v = u & 63, d = v >> 5, run = v & 31;
        const float* src = (j == 0 ? p.rwkv_decay_w2 : p.rwkv_iclr_a2) + (size_t)d * 64 * 1024;
        cvt_tile(src + run * 32, 1024, 64, true, wsm + (j == 0 ? W_W2 : W_A2) + (size_t)d * 1024 * 64 + (size_t)run * 32 * 64, 64, tile); return;
    }
    u -= 128;
    {
        const int run = u / 3, kt = u % 3;
        const int kvalid = 160 - kt * 64 > 64 ? 64 : (160 - kt * 64 < 0 ? 0 : 160 - kt * 64);
        cvt_tile(p.rwkv_gate_g2 + (size_t)kt * 64 * 1024 + run * 32, 1024, kvalid, true, wsm + W_G2 + (size_t)run * 32 * 192 + kt * 64, 192, tile);
    }
}
constexpr int CV_MOE_UNITS = 16 * (1024 + 512);
DI void cvt_moe_unit(const Params& p, int layer, int u, float* tile) {
    bf16_t* w13 = (bf16_t*)(p.ws + OFF_MOEW);
    bf16_t* w2t = w13 + (size_t)16 * 2048 * 1024;
    const int e = u / 1536, v = u % 1536;
    const size_t eo = (size_t)(layer * 16 + e) * 1024 * 1024;
    if (v < 1024) {
        const int run = v >> 4, kt = v & 15, g = run >> 1;
        const float* src = ((run & 1) ? p.moe_w3 : p.moe_w1) + eo;
        cvt_tile(src + (size_t)kt * 64 * 1024 + g * 32, 1024, 64, true, w13 + (size_t)e * 2048 * 1024 + (size_t)run * 32 * 1024 + kt * 64, 1024, tile);
    } else {
        const int w = v - 1024, run = w >> 4, kt = w & 15;
        cvt_tile(p.moe_w2 + eo + (size_t)kt * 64 * 1024 + run * 32, 1024, 64, true, w2t + (size_t)e * 1024 * 1024 + (size_t)run * 32 * 1024 + kt * 64, 1024, tile);
    }
}
DI void adaln_unit(const Params& p, int u, float* sm) {
    const int l = u / 96, n0 = (u % 96) * 64, t = tidx();
    float* sv = sm;
    float* red = sm + 3 * 1024;
    for (int i = t; i < 3 * 1024; i += NTH) { const int w = i >> 10, k = i & 1023; const float c = w < 2 ? p.c[w * 1024 + k] : p.c_ctx[k]; sv[i] = siluf_(c); }
    __syncthreads();
    const int kg = t >> 4, cl = t & 15;
    f32x4 a0 = {0, 0, 0, 0}, a1 = a0, a2 = a0;
    const float* W = p.ada_w + (size_t)l * 1024 * 6144 + n0 + cl * 4;
#pragma unroll 8
    for (int i = 0; i < 32; ++i) {
        const int k = kg + 32 * i;
        const f32x4 w = *(const f32x4*)(W + (size_t)k * 6144);
        a0 += w * sv[k]; a1 += w * sv[1024 + k]; a2 += w * sv[2048 + k];
    }
#pragma unroll
    for (int j = 0; j < 4; ++j) { red[kg * 192 + 0 * 64 + cl * 4 + j] = a0[j]; red[kg * 192 + 1 * 64 + cl * 4 + j] = a1[j]; red[kg * 192 + 2 * 64 + cl * 4 + j] = a2[j]; }
    __syncthreads();
    if (t < 192) {
        float s = 0.f;
        for (int g = 0; g < 32; ++g) s += red[g * 192 + t];
        const int w = t >> 6, n = n0 + (t & 63);
        ((float*)(p.ws + OFF_MOD))[(size_t)(l * 3 + w) * 6144 + n] = s + p.ada_b[l * 6144 + n];
    }
    __syncthreads();
}
DI void rope_unit(const Params& p, int u) {
    const int id = u * NTH + tidx();
    if (id < 320 * 16) {
        const int pi = id >> 4, f = id & 15;
        const float inv = exp2f(-(float)f * (13.287712379549449f / 16.0f));
        const float val = pi < 256 ? (float)pi : (float)(pi - 256);
        const float ang = val * inv;
        const double a = (double)ang;
        const double k = __builtin_rint(a * 0.15915494309189535);
        const float r = (float)(a - k * 6.283185307179586);
        f32x2 cs = {__cosf(r), __sinf(r)};
        ((f32x2*)(p.ws + OFF_ROPE))[id] = cs;
    }
}
DI void phase_prologue(const Params& p, char* smem) {
    float* sm = (float*)smem;
    const int nconv = CV_SMALL_UNITS + CV_MOE_UNITS;
    const int total = nconv + 192 + 10;
    for (int u = blockIdx.x; u < total; u += gridDim.x) {
        if (u < CV_SMALL_UNITS) cvt_small_unit(p, u, sm);
        else if (u < nconv) cvt_moe_unit(p, 0, u - CV_SMALL_UNITS, sm);
        else if (u < nconv + 192) adaln_unit(p, u - nconv, sm);
        else rope_unit(p, u - nconv - 192);
    }
}

DI void row_load(const float* src, f32x4 (&v)[4], int lane) {
#pragma unroll
    for (int i = 0; i < 4; ++i) v[i] = ((const f32x4*)src)[lane + 64 * i];
}
DI float row_rstd(const f32x4 (&v)[4]) {
    float ss = 0.f;
#pragma unroll
    for (int i = 0; i < 4; ++i) ss += v[i][0] * v[i][0] + v[i][1] * v[i][1] + v[i][2] * v[i][2] + v[i][3] * v[i][3];
    ss = wave_sum(ss);
    return rsqrtf(ss * (1.0f / DM) + RMS_EPS);
}
DI void row_norm_mod(const f32x4 (&v)[4], float rstd, const float* g, const float* shift, const float* scale, f32x4 (&h)[4], int lane) {
#pragma unroll
    for (int i = 0; i < 4; ++i) {
        const int c = (lane + 64 * i) * 4;
        const f32x4 g4 = *(const f32x4*)(g + c), sh = *(const f32x4*)(shift + c), sc = *(const f32x4*)(scale + c);
        h[i] = (v[i] * rstd * g4) * (1.0f + sc) + sh;
    }
}
DI void row_store_bf16(bf16_t* dst, const f32x4 (&h)[4], int lane) {
#pragma unroll
    for (int i = 0; i < 4; ++i) { u32x2 w; w[0] = pk_bf16(h[i][0], h[i][1]); w[1] = pk_bf16(h[i][2], h[i][3]); *(u32x2*)(dst + (lane + 64 * i) * 4) = w; }
}
DI void row_load_bf16(const bf16_t* src, f32x4 (&v)[4], int lane) {
#pragma unroll
    for (int i = 0; i < 4; ++i) { const u32x2 w = *(const u32x2*)(src + (lane + 64 * i) * 4); v[i][0] = bf_lo(w[0]); v[i][1] = bf_hi(w[0]); v[i][2] = bf_lo(w[1]); v[i][3] = bf_hi(w[1]); }
}

DI void phase_norm0(const Params& p) {
    const int lane = tidx() & 63, gw = blockIdx.x * NWAVE + (tidx() >> 6), nw = gridDim.x * NWAVE;
    bf16_t* H = (bf16_t*)(p.ws + OFF_H);
    for (int tok = gw; tok < TTOT; tok += nw) {
        f32x4 v[4], h[4];
        row_load(xin_ptr(p, tok), v, lane);
        const float rstd = row_rstd(v);
        row_norm_mod(v, rstd, p.norm_mix_g, mod_ptr(p, 0, tok, 0), mod_ptr(p, 0, tok, 1), h, lane);
        row_store_bf16(H + (size_t)tok * DM, h, lane);
    }
}

DI void route_row(const Params& p, const float (&lg)[16], int& e1, int& e2, float& g1, float& g2) {
    float mx = lg[0];
#pragma unroll
    for (int e = 1; e < 16; ++e) mx = fmaxf(mx, lg[e]);
    float pr[16], sum = 0.f;
#pragma unroll
    for (int e = 0; e < 16; ++e) { pr[e] = __expf(lg[e] - mx); sum += pr[e]; }
    const float inv = 1.0f / sum;
    float sel[16];
#pragma unroll
    for (int e = 0; e < 16; ++e) { pr[e] *= inv; sel[e] = pr[e] + p.router_bias[e]; }
    float best = -1e30f; int gi = 0;
#pragma unroll
    for (int g = 0; g < 4; ++g) {
        float m1 = -1e30f, m2 = -1e30f;
#pragma unroll
        for (int j = 0; j < 4; ++j) { const float s = sel[g * 4 + j]; if (s > m1) { m2 = m1; m1 = s; } else if (s > m2) m2 = s; }
        const float gs = m1 + m2;
        if (gs > best) { best = gs; gi = g; }
    }
    float s4[4], p4[4];
#pragma unroll
    for (int j = 0; j < 4; ++j) {
        s4[j] = gi == 0 ? sel[j] : gi == 1 ? sel[4 + j] : gi == 2 ? sel[8 + j] : sel[12 + j];
        p4[j] = gi == 0 ? pr[j] : gi == 1 ? pr[4 + j] : gi == 2 ? pr[8 + j] : pr[12 + j];
    }
    int i1 = 0; float b1 = s4[0];
#pragma unroll
    for (int j = 1; j < 4; ++j) if (s4[j] > b1) { b1 = s4[j]; i1 = j; }
    int i2 = i1 == 0 ? 1 : 0; float b2 = -3e38f;
#pragma unroll
    for (int j = 0; j < 4; ++j) if (j != i1 && s4[j] > b2) { b2 = s4[j]; i2 = j; }
    const float w1 = i1 == 0 ? p4[0] : i1 == 1 ? p4[1] : i1 == 2 ? p4[2] : p4[3];
    const float w2 = i2 == 0 ? p4[0] : i2 == 1 ? p4[1] : i2 == 2 ? p4[2] : p4[3];
    const float ws = 1.0f / (w1 + w2);
    e1 = gi * 4 + i1; e2 = gi * 4 + i2; g1 = w1 * ws; g2 = w2 * ws;
}
DI void phase_ffn_norm_route(const Params& p, int layer, char* smem) {
    const int lane = tidx() & 63, gw = blockIdx.x * NWAVE + (tidx() >> 6), nw = gridDim.x * NWAVE;
    float* rw = (float*)smem;
    for (int i = tidx(); i < 1024 * 16; i += NTH) rw[(i & 15) * 1024 + (i >> 4)] = p.router_w[i];
    __syncthreads();
    bf16_t* H = (bf16_t*)(p.ws + OFF_H);
    int* lcnt = (int*)(smem + 65536);
    if (tidx() < 32) lcnt[tidx()] = 0;
    int my_tok = -1, my_e1 = 0, my_e2 = 0, it = 0; float my_g1 = 0.f, my_g2 = 0.f;
    for (int tok = gw; tok < TTOT; tok += nw) {
        const int pos = tok >= PTOT ? tok - PTOT : tok;
        if (layer == 1 && pos < LCTX) continue;
        f32x4 v[4], h[4];
        row_load(xrow_ptr(p, tok), v, lane);
        const float rstd = row_rstd(v);
        row_norm_mod(v, rstd, p.norm_ffn_g + layer * DM, mod_ptr(p, layer, tok, 3), mod_ptr(p, layer, tok, 4), h, lane);
        row_store_bf16(H + (size_t)tok * DM, h, lane);
        float lg[16];
#pragma unroll
        for (int e = 0; e < 16; ++e) lg[e] = 0.f;
#pragma unroll
        for (int i = 0; i < 4; ++i)
#pragma unroll
            for (int e = 0; e < 16; ++e) {
                const f32x4 w = *(const f32x4*)(rw + e * 1024 + (lane + 64 * i) * 4);
                lg[e] += h[i][0] * w[0] + h[i][1] * w[1] + h[i][2] * w[2] + h[i][3] * w[3];
                if ((e & 3) == 3) asm volatile("" ::: "memory");
            }
#pragma unroll
        for (int e = 0; e < 16; ++e) lg[e] = wave_sum(lg[e]);
        int e1, e2; float g1, g2;
        route_row(p, lg, e1, e2, g1, g2);
        if (lane == it) { my_tok = tok; my_e1 = e1; my_e2 = e2; my_g1 = g1; my_g2 = g2; }
        ++it;
    }
    __syncthreads();
    int r1 = 0, r2 = 0;
    if (my_tok >= 0) { r1 = atomicAdd(&lcnt[my_e1], 1); r2 = atomicAdd(&lcnt[my_e2], 1); }
    __syncthreads();
    if (tidx() < 16) { const int n = lcnt[tidx()]; lcnt[16 + tidx()] = n ? atomicAdd((int*)(p.ws + OFF_CNT) + layer * 16 + tidx(), n) : 0; }
    __syncthreads();
    if (my_tok >= 0) {
        int* stok = (int*)(p.ws + OFF_STOK);
        float* sw = (float*)(p.ws + OFF_SW);
        const size_t s1 = (size_t)my_e1 * CAP + lcnt[16 + my_e1] + r1, s2 = (size_t)my_e2 * CAP + lcnt[16 + my_e2] + r2;
        stok[s1] = my_tok * 2 + 0; sw[s1] = my_g1;
        stok[s2] = my_tok * 2 + 1; sw[s2] = my_g2;
    }
    __syncthreads();
}

DI void combine_row(const Params& p, int layer, int tok, f32x4 (&v)[4], int lane) {
    const bf16_t* Y = (const bf16_t*)(p.ws + OFF_SCR + S_Y) + (size_t)tok * 2 * DM;
    const float* g5 = mod_ptr(p, layer, tok, 5);
    f32x4 y0[4], y1[4];
    row_load(xrow_ptr(p, tok), v, lane);
    row_load_bf16(Y, y0, lane); row_load_bf16(Y + DM, y1, lane);
#pragma unroll
    for (int i = 0; i < 4; ++i) { const f32x4 g = *(const f32x4*)(g5 + (lane + 64 * i) * 4); v[i] += g * (y0[i] + y1[i]); }
}
DI void phase_combine_l0(const Params& p, char* smem) {
    const int lane = tidx() & 63, gw = blockIdx.x * NWAVE + (tidx() >> 6), nw = gridDim.x * NWAVE;
    bf16_t* H = (bf16_t*)(p.ws + OFF_H);
    for (int tok = gw; tok < TTOT; tok += nw) {
        f32x4 v[4], h[4];
        combine_row(p, 0, tok, v, lane);
        float* X = xrow_ptr(p, tok);
#pragma unroll
        for (int i = 0; i < 4; ++i) ((f32x4*)X)[lane + 64 * i] = v[i];
        const float rstd = row_rstd(v);
        row_norm_mod(v, rstd, p.norm_mix_g + DM, mod_ptr(p, 1, tok, 0), mod_ptr(p, 1, tok, 1), h, lane);
        row_store_bf16(H + (size_t)tok * DM, h, lane);
    }
    __syncthreads();
    for (int u = blockIdx.x; u < CV_MOE_UNITS; u += gridDim.x) cvt_moe_unit(p, 1, u, (float*)smem);
}
DI void phase_xx(const Params& p) {
    const int lane = tidx() & 63, gw = blockIdx.x * NWAVE + (tidx() >> 6), nw = gridDim.x * NWAVE;
    const bf16_t* H = (const bf16_t*)(p.ws + OFF_H);
    bf16_t* XX = (bf16_t*)(p.ws + OFF_SCR + S_XX);
    for (int tok = gw; tok < TTOT; tok += nw) {
        const int pos = tok >= PTOT ? tok - PTOT : tok;
        const bool first = pos == 0 || pos == LCTX, last = pos == LCTX - 1 || pos == PTOT - 1;
        f32x4 hc[4], hp[4], hn[4], xx[4];
        row_load_bf16(H + (size_t)tok * DM, hc, lane);
        row_load_bf16(H + (size_t)(first ? tok : tok - 1) * DM, hp, lane);
        row_load_bf16(H + (size_t)(last ? tok : tok + 1) * DM, hn, lane);
#pragma unroll
        for (int i = 0; i < 4; ++i) {
            const f32x4 a = first ? (f32x4){0, 0, 0, 0} : hp[i], b = last ? (f32x4){0, 0, 0, 0} : hn[i];
            xx[i] = 0.5f * (a + b) - hc[i];
        }
        row_store_bf16(XX + (size_t)tok * DM, xx, lane);
    }
}
DI void phase_final(const Params& p) {
    const int lane = tidx() & 63, gw = blockIdx.x * NWAVE + (tidx() >> 6), nw = gridDim.x * NWAVE;
    for (int r = gw; r < NBATCH * SEQ; r += nw) {
        const int b = r / SEQ, tok = b * PTOT + LCTX + (r - b * SEQ);
        f32x4 v[4];
        combine_row(p, 1, tok, v, lane);
        const float rstd = row_rstd(v);
        float* O = p.out + (size_t)r * DM;
#pragma unroll
        for (int i = 0; i < 4; ++i) { const f32x4 g = *(const f32x4*)(p.final_norm_g + (lane + 64 * i) * 4); ((f32x4*)O)[lane + 64 * i] = v[i] * rstd * g; }
    }
}

constexpr int LDSROW = 72;
constexpr int GEMM_SMEM = 2 * (256 + 256) * LDSROW * 2;
template <int NH, class AL, class EPI>
DI void gemm_tile(AL& al, const bf16_t* __restrict__ Bt, int ldb, int nk, EPI& epi, char* smem) {
    const int t = tidx(), lane = t & 63, wid = t >> 6, wr = wid >> 1, wc = wid & 1, fr = lane & 15, fq = lane >> 4;
    constexpr int BR = 128 * NH;
    bf16_t* sA = (bf16_t*)smem;
    bf16_t* sB = sA + 2 * 256 * LDSROW;
    f32x4 acc[NH][4][4];
#pragma unroll
    for (int h = 0; h < NH; ++h)
#pragma unroll
        for (int m = 0; m < 4; ++m)
#pragma unroll
            for (int n = 0; n < 4; ++n) acc[h][m][n] = (f32x4){0.f, 0.f, 0.f, 0.f};
    const int lr = t >> 3, lc = (t & 7) * 8;
    u32x4 ra[4], rb[2 * NH];
#pragma unroll
    for (int i = 0; i < 4; ++i) ra[i] = al.load(lr + 64 * i, lc, i);
#pragma unroll
    for (int i = 0; i < 2 * NH; ++i) rb[i] = *(const u32x4*)(Bt + (size_t)(lr + 64 * i) * ldb + lc);
#pragma unroll
    for (int i = 0; i < 4; ++i) *(u32x4*)(sA + (lr + 64 * i) * LDSROW + lc) = ra[i];
#pragma unroll
    for (int i = 0; i < 2 * NH; ++i) *(u32x4*)(sB + (lr + 64 * i) * LDSROW + lc) = rb[i];
    __syncthreads();
    for (int kt = 0; kt < nk; ++kt) {
        const int cur = kt & 1;
        const bool more = kt + 1 < nk;
        if (more) {
#pragma unroll
            for (int i = 0; i < 4; ++i) ra[i] = al.load(lr + 64 * i, (kt + 1) * 64 + lc, i);
#pragma unroll
            for (int i = 0; i < 2 * NH; ++i) rb[i] = *(const u32x4*)(Bt + (size_t)(lr + 64 * i) * ldb + (kt + 1) * 64 + lc);
        }
        __builtin_amdgcn_sched_barrier(0);
        const bf16_t* cA = sA + cur * 256 * LDSROW + (wr * 64 + fr) * LDSROW + fq * 8;
        const bf16_t* cB = sB + cur * BR * LDSROW + (wc * 64 + fr) * LDSROW + fq * 8;
#pragma unroll
        for (int kk = 0; kk < 2; ++kk) {
            bf16x8 af[4];
#pragma unroll
            for (int m = 0; m < 4; ++m) af[m] = *(const bf16x8*)(cA + m * 16 * LDSROW + kk * 32);
#pragma unroll
            for (int h = 0; h < NH; ++h) {
                bf16x8 bfr[4];
#pragma unroll
                for (int n = 0; n < 4; ++n) bfr[n] = *(const bf16x8*)(cB + (h * 128 + n * 16) * LDSROW + kk * 32);
#pragma unroll
                for (int m = 0; m < 4; ++m)
#pragma unroll
                    for (int n = 0; n < 4; ++n) acc[h][m][n] = __builtin_amdgcn_mfma_f32_16x16x32_bf16(bfr[n], af[m], acc[h][m][n], 0, 0, 0);
            }
            if (kk == 0 && more) {
                bf16_t* nA = sA + (cur ^ 1) * 256 * LDSROW;
                bf16_t* nB = sB + (cur ^ 1) * BR * LDSROW;
#pragma unroll
                for (int i = 0; i < 4; ++i) *(u32x4*)(nA + (lr + 64 * i) * LDSROW + lc) = ra[i];
#pragma unroll
                for (int i = 0; i < 2 * NH; ++i) *(u32x4*)(nB + (lr + 64 * i) * LDSROW + lc) = rb[i];
            }
        }
        __syncthreads();
    }
#pragma unroll
    for (int h = 0; h < NH; ++h) epi(acc[h], wr * 64, h * 128 + wc * 64, fr, fq);
}
constexpr int G8_HB = 128 * 64 * 2;
constexpr int G8_SMEM = 8 * G8_HB;
DI void g8_rc(int& R0, int& C0) {
    const int tz = tidx(), st = tz >> 6, sb = (tz & 63) * 16, swz = sb ^ (((sb >> 9) & 1) << 5);
    R0 = (st >> 1) * 16 + (swz >> 6); C0 = (st & 1) * 32 + ((swz & 63) >> 1);
}
DI int g8_bcol(int h, int rho) { return (rho >> 5) * 64 + h * 32 + (rho & 31); }
struct G8Rows {
    const bf16_t* base; unsigned o0, d1, d2;
    DI const bf16_t* ptr(int h, int i, int kt) const { return (base + (size_t)(h * d2 + i * d1 + kt * 64)) + o0; }
};
struct G8Gather {
    const bf16_t* base; unsigned o[4];
    DI const bf16_t* ptr(int h, int i, int kt) const { return (base + kt * 64) + o[h * 2 + i]; }
};
DI G8Rows g8_arows(const bf16_t* A, int lda) { int R0, C0; g8_rc(R0, C0); return G8Rows{A, (unsigned)(R0 * lda + C0), (unsigned)(64 * lda), (unsigned)(128 * lda)}; }
DI G8Rows g8_brows(const bf16_t* Bt, int ldb) { int R0, C0; g8_rc(R0, C0); return G8Rows{Bt, (unsigned)(g8_bcol(0, R0) * ldb + C0), (unsigned)(128 * ldb), (unsigned)(32 * ldb)}; }
template <class AS, class BS, class EPI>
DI void gemm8_tile(const AS& as, const BS& bs, int nt  , EPI& epi, char* smem) {
    int tz = tidx();
    int wid = tz >> 6, lane = tz & 63, wr = wid >> 2, wc = wid & 3, fr = lane & 15, fq = lane >> 4;
    int loff = ((fr * 64 + fq * 16) ^ ((fr >> 3) << 5));
#define G8_SA(b, h) (smem + ((b) * 2 + (h)) * G8_HB)
#define G8_SB(b, h) (smem + (4 + (b) * 2 + (h)) * G8_HB)
#define G8_STAGE(P, src, h, kt) do { \
        __builtin_amdgcn_global_load_lds((const unsigned*)(src).ptr(h, 0, kt), (LAS unsigned*)((P) + tz * 16), 16, 0, 0); \
        __builtin_amdgcn_global_load_lds((const unsigned*)(src).ptr(h, 1, kt), (LAS unsigned*)((P) + tz * 16 + 8192), 16, 0, 0); } while (0)
#define G8_STA(b, h, kt) G8_STAGE(G8_SA(b, h), as, h, kt)
#define G8_STB(b, h, kt) G8_STAGE(G8_SB(b, h), bs, h, kt)
#define G8_LDA(dst, b, h) _Pragma("unroll") for (int m = 0; m < 4; ++m) _Pragma("unroll") for (int k = 0; k < 2; ++k) \
        dst[m][k] = *(const bf16x8*)(G8_SA(b, h) + (wr * 8 + m * 2 + k) * 1024 + loff)
#define G8_LDB(dst, b, h) _Pragma("unroll") for (int n = 0; n < 2; ++n) _Pragma("unroll") for (int k = 0; k < 2; ++k) \
        dst[n][k] = *(const bf16x8*)(G8_SB(b, h) + (wc * 4 + n * 2 + k) * 1024 + loff)
#define G8_MMA(ai, bj, Bx) do { __builtin_amdgcn_s_setprio(1); \
        _Pragma("unroll") for (int m = 0; m < 4; ++m) _Pragma("unroll") for (int n = 0; n < 2; ++n) _Pragma("unroll") for (int k = 0; k < 2; ++k) \
            acc[ai][bj][m][n] = __builtin_amdgcn_mfma_f32_16x16x32_bf16(Bx[n][k], At[m][k], acc[ai][bj][m][n], 0, 0, 0); \
        __builtin_amdgcn_s_setprio(0); } while (0)
#define G8_WV(n) asm volatile("s_waitcnt vmcnt(" #n ")" ::: "memory")
#define G8_WL(n) asm volatile("s_waitcnt lgkmcnt(" #n ")" ::: "memory")
#define G8_BAR __builtin_amdgcn_s_barrier()
#define G8_SCHED __builtin_amdgcn_sched_barrier(0)
    f32x4 acc[2][2][4][2];
#pragma unroll
    for (int a = 0; a < 2; ++a)
#pragma unroll
        for (int b = 0; b < 2; ++b)
#pragma unroll
            for (int m = 0; m < 4; ++m)
#pragma unroll
                for (int n = 0; n < 2; ++n) acc[a][b][m][n] = (f32x4){0.f, 0.f, 0.f, 0.f};
    bf16x8 At[4][2], B0[2][2], B1[2][2];
    G8_STB(0, 0, 0); G8_STA(0, 0, 0); G8_STB(0, 1, 0); G8_STA(0, 1, 0);
    if (wr == 1) G8_BAR;
    G8_WV(4); G8_BAR;
    G8_STB(1, 0, 1); G8_STA(1, 0, 1); G8_STB(1, 1, 1);
    G8_WV(6); G8_BAR;
    for (int t = 0; t < nt - 2; t += 2) {
        G8_LDB(B0, 0, 0); G8_SCHED; G8_LDA(At, 0, 0); G8_STA(1, 1, t + 1);
        G8_WL(8); G8_BAR; G8_WL(0); G8_MMA(0, 0, B0); G8_BAR; G8_SCHED;
        G8_LDB(B1, 0, 1); G8_STB(0, 0, t + 2);
        G8_BAR; G8_WL(0); G8_MMA(0, 1, B1); G8_BAR;
        G8_LDA(At, 0, 1); G8_STA(0, 0, t + 2);
        G8_BAR; G8_WL(0); G8_MMA(1, 0, B0); G8_BAR; G8_SCHED;
        G8_STB(0, 1, t + 2);
        G8_WV(6); G8_BAR; G8_MMA(1, 1, B1); G8_BAR;
        G8_LDB(B0, 1, 0); G8_SCHED; G8_LDA(At, 1, 0); G8_STA(0, 1, t + 2);
        G8_WL(8); G8_BAR; G8_WL(0); G8_MMA(0, 0, B0); G8_BAR; G8_SCHED;
        G8_LDB(B1, 1, 1); G8_STB(1, 0, t + 3);
        G8_BAR; G8_WL(0); G8_MMA(0, 1, B1); G8_BAR;
        G8_LDA(At, 1, 1); G8_STA(1, 0, t + 3);
        G8_BAR; G8_WL(0); G8_MMA(1, 0, B0); G8_BAR; G8_SCHED;
        G8_STB(1, 1, t + 3);
        G8_WV(6); G8_BAR; G8_MMA(1, 1, B1); G8_BAR;
    }
    tz = tidx(); wid = tz >> 6; lane = tz & 63; wr = wid >> 2; wc = wid & 3; fr = lane & 15; fq = lane >> 4;
    loff = ((fr * 64 + fq * 16) ^ ((fr >> 3) << 5));
    {
        G8_LDB(B0, 0, 0); G8_WV(0); G8_LDA(At, 0, 0); G8_STA(1, 1, nt - 1);
        G8_BAR; G8_WL(0); G8_MMA(0, 0, B0); G8_BAR;
        G8_LDB(B1, 0, 1); G8_BAR; G8_WL(0); G8_MMA(0, 1, B1); G8_BAR;
        G8_LDA(At, 0, 1); G8_WV(4); G8_BAR; G8_WL(0); G8_MMA(1, 0, B0); G8_MMA(1, 1, B1); G8_BAR;
    }
    {
        G8_LDB(B0, 1, 0); G8_LDA(At, 1, 0); G8_WV(2); G8_BAR; G8_WL(0); G8_MMA(0, 0, B0); G8_BAR;
        G8_LDB(B1, 1, 1); G8_WV(0); G8_BAR; G8_WL(0); G8_MMA(0, 1, B1); G8_BAR;
        G8_LDA(At, 1, 1); G8_BAR; G8_WL(0); G8_MMA(1, 0, B0); G8_MMA(1, 1, B1); G8_BAR;
    }
    if (wr == 0) G8_BAR;
#pragma unroll
    for (int ai = 0; ai < 2; ++ai) {
        f32x4 a4[4][4];
#pragma unroll
        for (int m = 0; m < 4; ++m)
#pragma unroll
            for (int n = 0; n < 4; ++n) a4[m][n] = acc[ai][n >> 1][m][n & 1];
        epi(a4, ai * 128 + wr * 64, wc * 64, fr, fq);
    }
}
DI bool xcd_tile(int k, int nM, int NT, int& mt, int& nt) {
    const bool swz = (gridDim.x & 7) == 0;
    const int j = (swz ? (int)(blockIdx.x >> 3) : (int)blockIdx.x) + (swz ? (int)(gridDim.x >> 3) : (int)gridDim.x) * k, mi = j / NT;
    nt = j - mi * NT; mt = swz ? (int)(blockIdx.x & 7) + 8 * mi : mi;
    return mt < nM;
}
struct ALPlain {
    const bf16_t* A; int lda;
    DI u32x4 load(int r, int k, int) const { return *(const u32x4*)(A + (size_t)r * lda + k); }
};
struct ALGather {
    const bf16_t* rowp[4];
    DI u32x4 load(int, int k, int i) const { return *(const u32x4*)(rowp[i] + k); }
};
struct ALMix {
    const bf16_t* H; const bf16_t* XX; const float* xm;
    DI u32x4 load(int r, int k, int) const {
        const u32x4 h = *(const u32x4*)(H + (size_t)r * DM + k), x = *(const u32x4*)(XX + (size_t)r * DM + k);
        const f32x4 m0 = *(const f32x4*)(xm + k), m1 = *(const f32x4*)(xm + k + 4);
        u32x4 o;
        o[0] = pk_bf16(bf_lo(h[0]) + bf_lo(x[0]) * m0[0], bf_hi(h[0]) + bf_hi(x[0]) * m0[1]);
        o[1] = pk_bf16(bf_lo(h[1]) + bf_lo(x[1]) * m0[2], bf_hi(h[1]) + bf_hi(x[1]) * m0[3]);
        o[2] = pk_bf16(bf_lo(h[2]) + bf_lo(x[2]) * m1[0], bf_hi(h[2]) + bf_hi(x[2]) * m1[1]);
        o[3] = pk_bf16(bf_lo(h[3]) + bf_lo(x[3]) * m1[2], bf_hi(h[3]) + bf_hi(x[3]) * m1[3]);
        return o;
    }
};

struct EpiQKV {
    const Params* p; int m0, n0;
    DI void operator()(const f32x4 (&acc)[4][4], int rb, int cb, int fr, int fq) const {
        const int hs = (n0 + cb) >> 6;
        const bool isq = hs < 8 || (hs >= 12 && hs < 20), isv = (hs >= 10 && hs < 12) || hs >= 22, normed = hs >= 12 && hs < 22;
        const float* gam = hs < 20 ? p->attn_q_norm_g : p->attn_k_norm_g;
        const f32x2* rope = (const f32x2*)(p->ws + OFF_ROPE);
        bf16_t* Q = (bf16_t*)(p->ws + OFF_SCR + S_Q);
        bf16_t* K = (bf16_t*)(p->ws + OFF_SCR + S_K);
        bf16_t* VT = (bf16_t*)(p->ws + OFF_SCR + S_VT);
#pragma unroll
        for (int m = 0; m < 4; ++m) {
            const int tok = m0 + rb + m * 16 + fr, b = tok >= PTOT ? 1 : 0, pos = tok - b * PTOT;
            f32x4 v[4];
#pragma unroll
            for (int n = 0; n < 4; ++n) v[n] = acc[m][n];
            if (normed) {
                float ss = 0.f;
#pragma unroll
                for (int n = 0; n < 4; ++n) ss += v[n][0] * v[n][0] + v[n][1] * v[n][1] + v[n][2] * v[n][2] + v[n][3] * v[n][3];
                ss += __shfl_xor(ss, 16); ss += __shfl_xor(ss, 32);
                const float rstd = rsqrtf(ss * (1.0f / 64.0f) + RMS_EPS);
#pragma unroll
                for (int n = 0; n < 4; ++n) { const f32x4 g = *(const f32x4*)(gam + n * 16 + fq * 4); v[n] = v[n] * rstd * g; }
            }
            if (!isv && pos >= LCTX) {
                const int t = pos - LCTX, prow = t >> 6, pcol = t & 63;
#pragma unroll
                for (int a = 0; a < 2; ++a) {
                    const f32x2* tb = rope + (a == 0 ? prow : 256 + pcol) * 16 + fq * 4;
#pragma unroll
                    for (int j = 0; j < 4; ++j) {
                        const f32x2 cs = tb[j];
                        const float x0 = v[2 * a][j], x1 = v[2 * a + 1][j];
                        v[2 * a][j] = x0 * cs[0] - x1 * cs[1];
                        v[2 * a + 1][j] = x1 * cs[0] + x0 * cs[1];
                    }
                }
            }
            if (isq) {
                const int hq = hs < 8 ? hs : hs - 4;
                bf16_t* dst = Q + ((size_t)(b * 16 + hq) * PTOT + pos) * 64 + fq * 4;
#pragma unroll
                for (int n = 0; n < 4; ++n) { const f32x4 w = v[n] * (0.125f * LOG2E); u32x2 o; o[0] = pk_bf16(w[0], w[1]); o[1] = pk_bf16(w[2], w[3]); *(u32x2*)(dst + n * 16) = o; }
            } else if (!isv) {
                const int kh = hs < 12 ? hs - 8 : hs - 18;
                bf16_t* dst = K + ((size_t)(b * 4 + kh) * PTOT + pos) * 64 + fq * 4;
#pragma unroll
                for (int n = 0; n < 4; ++n) { u32x2 o; o[0] = pk_bf16(v[n][0], v[n][1]); o[1] = pk_bf16(v[n][2], v[n][3]); *(u32x2*)(dst + n * 16) = o; }
            } else {
                const int vh = hs < 12 ? hs - 10 : hs - 20;
                bf16_t* dst = VT + (size_t)(b * 4 + vh) * 64 * PTOT + pos;
#pragma unroll
                for (int n = 0; n < 4; ++n)
#pragma unroll
                    for (int j = 0; j < 4; ++j) dst[(size_t)(n * 16 + fq * 4 + j) * PTOT] = (bf16_t)(pk_bf16(v[n][j], 0.f) & 0xffffu);
            }
        }
    }
};
DI void phase_qkv(const Params& p, char* smem) {
    const bf16_t* H = (const bf16_t*)(p.ws + OFF_H);
    const bf16_t* W = (const bf16_t*)(p.ws + OFF_WS) + W_IN;
    constexpr int NT = QKV_N / 256, MT = TTOT / 256;
    for (int k = 0;; ++k) {
        int mt, nt; if (!xcd_tile(k, MT, NT, mt, nt)) break;
        EpiQKV epi{&p, mt * 256, nt * 256};
        gemm8_tile(g8_arows(H + (size_t)mt * 256 * DM, DM), g8_brows(W + (size_t)nt * 256 * DM, DM), DM / 64, epi, smem);
    }
}

struct EpiResid {
    const Params* p; int m0, n0, layer; bool from_input;
    DI void operator()(const f32x4 (&acc)[4][4], int rb, int cb, int fr, int fq) const {
#pragma unroll
        for (int m = 0; m < 4; ++m) {
            const int tok = m0 + rb + m * 16 + fr;
            const float* xin = from_input ? xin_ptr(*p, tok) : xrow_ptr(*p, tok);
            float* xo = xrow_ptr(*p, tok);
            const float* gate = mod_ptr(*p, layer, tok, 2);
#pragma unroll
            for (int n = 0; n < 4; ++n) {
                const int c = n0 + cb + n * 16 + fq * 4;
                const f32x4 xi = *(const f32x4*)(xin + c), g = *(const f32x4*)(gate + c);
                *(f32x4*)(xo + c) = xi + g * acc[m][n];
            }
        }
    }
};
DI void phase_wout(const Params& p, char* smem) {
    const bf16_t* O = (const bf16_t*)(p.ws + OFF_SCR + S_O);
    const bf16_t* W = (const bf16_t*)(p.ws + OFF_WS) + W_OUT;
    constexpr int NT = 4, MT = TTOT / 256;
    for (int k = 0;; ++k) {
        int mt, nt; if (!xcd_tile(k, MT, NT, mt, nt)) break;
        EpiResid epi{&p, mt * 256, nt * 256, 0, true};
        gemm8_tile(g8_arows(O + (size_t)mt * 256 * DM, DM), g8_brows(W + (size_t)nt * 256 * DM, DM), DM / 64, epi, smem);
    }
}
DI void phase_wo(const Params& p, char* smem) {
    const bf16_t* O = (const bf16_t*)(p.ws + OFF_SCR + S_OR);
    const bf16_t* W = (const bf16_t*)(p.ws + OFF_WS) + W_O;
    constexpr int NT = 4, MTL = SEQ / 256;
    for (int k = 0;; ++k) {
        int mi, nt; if (!xcd_tile(k, NBATCH * MTL, NT, mi, nt)) break;
        const int b = mi / MTL, mt = b * (PTOT / 256) + 1 + (mi % MTL);
        EpiResid epi{&p, mt * 256, nt * 256, 1, false};
        gemm8_tile(g8_arows(O + (size_t)mt * 256 * DM, DM), g8_brows(W + (size_t)nt * 256 * DM, DM), DM / 64, epi, smem);
    }
}

struct MoeSched { int nt[16], base[17]; };
DI void moe_sched(const Params& p, int layer, MoeSched& s, int (&cnt)[16]) {
    const int* c = (const int*)(p.ws + OFF_CNT) + layer * 16;
    int acc = 0;
#pragma unroll
    for (int e = 0; e < 16; ++e) { cnt[e] = c[e]; s.nt[e] = (cnt[e] + 255) >> 8; s.base[e] = acc; acc += s.nt[e]; }
    s.base[16] = acc;
}
struct EpiMoe1 {
    bf16_t* hid;   int n0;
    DI void operator()(const f32x4 (&acc)[4][4], int rb, int cb, int fr, int fq) const {
        const int g = (n0 + cb) >> 6;
#pragma unroll
        for (int m = 0; m < 4; ++m) {
            bf16_t* dst = hid + (size_t)(rb + m * 16 + fr) * 1024 + g * 32 + fq * 4;
#pragma unroll
            for (int n = 0; n < 2; ++n) {
                const f32x4 a = acc[m][n], b = acc[m][n + 2];
                u32x2 o;
                o[0] = pk_bf16(siluf_(a[0]) * b[0], siluf_(a[1]) * b[1]);
                o[1] = pk_bf16(siluf_(a[2]) * b[2], siluf_(a[3]) * b[3]);
                *(u32x2*)(dst + n * 16) = o;
            }
        }
    }
};
DI void phase_moe1(const Params& p, int layer, char* smem) {
    MoeSched s; int cnt[16];
    moe_sched(p, layer, s, cnt);
    const bf16_t* H = (const bf16_t*)(p.ws + OFF_H);
    const bf16_t* W13 = (const bf16_t*)(p.ws + OFF_MOEW);
    const int* stok = (const int*)(p.ws + OFF_STOK);
    bf16_t* hid = (bf16_t*)(p.ws + OFF_SCR + S_HID);
    constexpr int NT = 8;
    const int total = s.base[16] * NT;
    for (int k = 0;; ++k) {
        int mg, nt; if (!xcd_tile(k, s.base[16], NT, mg, nt)) break;
        int e = 0;
#pragma unroll
        for (int i = 1; i < 16; ++i) if (mg >= s.base[i]) e = i;
        int ce = 0;
#pragma unroll
        for (int i = 0; i < 16; ++i) if (i == e) ce = cnt[i];
        int be = 0;
#pragma unroll
        for (int i = 0; i < 16; ++i) if (i == e) be = s.base[i];
        const int ml = mg - be;
        int R0, C0; g8_rc(R0, C0);
        G8Gather ag; ag.base = H;
#pragma unroll
        for (int q = 0; q < 4; ++q) {
            const int r = ml * 256 + R0 + 64 * (q & 1) + 128 * (q >> 1);
            const int tk = r < ce ? (stok[(size_t)e * CAP + r] >> 1) : 0;
            ag.o[q] = (unsigned)tk * 1024u + C0;
        }
        EpiMoe1 epi{hid + (size_t)mg * 256 * 1024, nt * 256};
        gemm8_tile(ag, g8_brows(W13 + (size_t)e * 2048 * 1024 + (size_t)nt * 256 * 1024, 1024), 16, epi, smem);
    }
}
struct EpiMoe2 {
    bf16_t* Y; const int* stok; const float* sw; int nvalid, n0;
    DI void operator()(const f32x4 (&acc)[4][4], int rb, int cb, int fr, int fq) const {
#pragma unroll
        for (int m = 0; m < 4; ++m) {
            const int r = rb + m * 16 + fr;
            if (r < nvalid) {
                const int tk = stok[r]; const float w = sw[r];
                bf16_t* dst = Y + (size_t)tk * 1024 + n0 + cb + fq * 4;
#pragma unroll
                for (int n = 0; n < 4; ++n) { const f32x4 a = acc[m][n] * w; u32x2 o; o[0] = pk_bf16(a[0], a[1]); o[1] = pk_bf16(a[2], a[3]); *(u32x2*)(dst + n * 16) = o; }
            }
        }
    }
};
DI void phase_moe2(const Params& p, int layer, char* smem) {
    MoeSched s; int cnt[16];
    moe_sched(p, layer, s, cnt);
    const bf16_t* hid = (const bf16_t*)(p.ws + OFF_SCR + S_HID);
    const bf16_t* W2 = (const bf16_t*)(p.ws + OFF_MOEW) + (size_t)16 * 2048 * 1024;
    const int* stok = (const int*)(p.ws + OFF_STOK);
    const float* sw = (const float*)(p.ws + OFF_SW);
    bf16_t* Y = (bf16_t*)(p.ws + OFF_SCR + S_Y);
    constexpr int NT = 4;
    const int total = s.base[16] * NT;
    for (int k = 0;; ++k) {
        int mg, nt; if (!xcd_tile(k, s.base[16], NT, mg, nt)) break;
        int e = 0;
#pragma unroll
        for (int i = 1; i < 16; ++i) if (mg >= s.base[i]) e = i;
        int ce = 0, be = 0;
#pragma unroll
        for (int i = 0; i < 16; ++i) if (i == e) { ce = cnt[i]; be = s.base[i]; }
        const int ml = mg - be;
        EpiMoe2 epi{Y, stok + (size_t)e * CAP + ml * 256, sw + (size_t)e * CAP + ml * 256, ce - ml * 256, nt * 256};
        gemm8_tile(g8_arows(hid + (size_t)mg * 256 * 1024, 1024), g8_brows(W2 + (size_t)e * 1024 * 1024 + (size_t)nt * 256 * 1024, 1024), 16, epi, smem);
    }
}

struct EpiRwkv {
    bf16_t* dst; int ld, m0, n0, act, nstore;
    DI void operator()(const f32x4 (&acc)[4][4], int rb, int cb, int fr, int fq) const {
#pragma unroll
        for (int m = 0; m < 4; ++m) {
            bf16_t* d = dst + (size_t)(m0 + rb + m * 16 + fr) * ld + n0 + cb + fq * 4;
#pragma unroll
            for (int n = 0; n < 4; ++n) {
                const int c = n0 + cb + n * 16 + fq * 4;
                if (c >= ld) continue;
                f32x4 a = acc[m][n];
                if (act == 1) {
#pragma unroll
                    for (int j = 0; j < 4; ++j) { const float e = __expf(2.0f * a[j]); a[j] = 1.0f - 2.0f / (e + 1.0f); }
                }
                if (act == 2) {
#pragma unroll
                    for (int j = 0; j < 4; ++j) a[j] = sigmoidf_(a[j]);
                }
                if (c >= nstore) a = (f32x4){0.f, 0.f, 0.f, 0.f};
                u32x2 o; o[0] = pk_bf16(a[0], a[1]); o[1] = pk_bf16(a[2], a[3]);
                *(u32x2*)(d + n * 16) = o;
            }
        }
    }
};
DI void phase_rwkv_proj(const Params& p, char* smem) {
    const bf16_t* H = (const bf16_t*)(p.ws + OFF_H);
    const bf16_t* XX = (const bf16_t*)(p.ws + OFF_SCR + S_XX);
    const bf16_t* wsm = (const bf16_t*)(p.ws + OFF_WS);
    constexpr int MT = TTOT / 256, NU = 14;
    for (int u = blockIdx.x; u < MT * NU; u += gridDim.x) {
        const int mt = u / NU, q = u % NU;
        ALMix al{H + (size_t)mt * 256 * DM, XX + (size_t)mt * 256 * DM, nullptr};
        if (q < 13) {
            const int job = q < 4 ? 0 : q < 8 ? 1 : q < 12 ? 2 : 5, nt = q < 12 ? (q & 3) : 0;
            const int mixj = job == 0 ? 0 : job == 1 ? 2 : job == 2 ? 3 : 5;
            const size_t wofs = job == 0 ? W_R : job == 1 ? W_K : job == 2 ? W_V : W_G1;
            const size_t dofs = job == 0 ? S_R : job == 1 ? S_KK : job == 2 ? S_V : S_LG;
            al.xm = p.rwkv_x_mix + mixj * DM;
            EpiRwkv epi{(bf16_t*)(p.ws + OFF_SCR + dofs), job == 5 ? 192 : 1024, mt * 256, nt * 256, job == 5 ? 2 : 0, job == 5 ? 160 : 4096};
            gemm_tile<2>(al, wsm + wofs + (size_t)nt * 256 * DM, DM, DM / 64, epi, smem);
        } else {
#pragma unroll 1
            for (int j = 0; j < 2; ++j) {
                al.xm = p.rwkv_x_mix + (j == 0 ? 1 : 4) * DM;
                EpiRwkv epi{(bf16_t*)(p.ws + OFF_SCR + (j == 0 ? S_LW : S_LA)), 128, mt * 256, 0, j == 0 ? 1 : 0, 4096};
                gemm_tile<1>(al, wsm + (j == 0 ? W_W1 : W_A1), DM, DM / 64, epi, smem);
            }
        }
    }
}

struct EpiGate {
    const Params* p; int m0, n0;
    DI void operator()(const f32x4 (&acc)[4][4], int rb, int cb, int fr, int fq) const {
        const bf16_t* Y0 = (const bf16_t*)(p->ws + OFF_H);
        const bf16_t* Y1 = (const bf16_t*)(p->ws + OFF_SCR + S_Y1);
        const bf16_t* V = (const bf16_t*)(p->ws + OFF_SCR + S_V);
        const float* bonus = (const float*)(p->ws + OFF_BONUS2);
        bf16_t* O = (bf16_t*)(p->ws + OFF_SCR + S_OR);
        const int c0 = n0 + cb, hd = c0 >> 6;
#pragma unroll
        for (int m = 0; m < 4; ++m) {
            const int tok = m0 + rb + m * 16 + fr;
            const size_t ro = (size_t)tok * DM + c0 + fq * 4;
            f32x4 y[4];
            float s = 0.f;
#pragma unroll
            for (int n = 0; n < 4; ++n) {
                const u32x2 a = *(const u32x2*)(Y0 + ro + n * 16), b = *(const u32x2*)(Y1 + ro + n * 16);
                y[n][0] = bf_lo(a[0]) + bf_lo(b[0]); y[n][1] = bf_hi(a[0]) + bf_hi(b[0]); y[n][2] = bf_lo(a[1]) + bf_lo(b[1]); y[n][3] = bf_hi(a[1]) + bf_hi(b[1]);
                s += y[n][0] + y[n][1] + y[n][2] + y[n][3];
            }
            s += __shfl_xor(s, 16); s += __shfl_xor(s, 32);
            const float mu = s * (1.0f / 64.0f);
            float q = 0.f;
#pragma unroll
            for (int n = 0; n < 4; ++n) { const f32x4 d = y[n] - mu; q += d[0] * d[0] + d[1] * d[1] + d[2] * d[2] + d[3] * d[3]; }
            q += __shfl_xor(q, 16); q += __shfl_xor(q, 32);
            const float rs = rsqrtf(q * (1.0f / 64.0f) + GN_EPS);
            const float bon = (bonus[(size_t)tok * 16 + hd] + bonus[(size_t)(TTOT + tok) * 16 + hd]) + (bonus[(size_t)(2 * TTOT + tok) * 16 + hd] + bonus[(size_t)(3 * TTOT + tok) * 16 + hd]);
#pragma unroll
            for (int n = 0; n < 4; ++n) {
                const int c = c0 + n * 16 + fq * 4;
                const f32x4 g = *(const f32x4*)(p->rwkv_ln_g + c), bb = *(const f32x4*)(p->rwkv_ln_b + c);
                const u32x2 vv = *(const u32x2*)(V + ro + n * 16);
                const f32x4 v4 = {bf_lo(vv[0]), bf_hi(vv[0]), bf_lo(vv[1]), bf_hi(vv[1])};
                const f32x4 o = ((y[n] - mu) * rs * g + bb + bon * v4) * acc[m][n];
                u32x2 w; w[0] = pk_bf16(o[0], o[1]); w[1] = pk_bf16(o[2], o[3]);
                *(u32x2*)(O + ro + n * 16) = w;
            }
        }
    }
};
DI void phase_gate(const Params& p, char* smem) {
    const bf16_t* LG = (const bf16_t*)(p.ws + OFF_SCR + S_LG);
    const bf16_t* W = (const bf16_t*)(p.ws + OFF_WS) + W_G2;
    constexpr int NT = 8, MT = TTOT / 256;
    for (int k = 0;; ++k) {
        int mt, nt; if (!xcd_tile(k, MT, NT, mt, nt)) break;
        ALPlain al{LG + (size_t)mt * 256 * 192, 192};
        EpiGate epi{&p, mt * 256, nt * 128};
        gemm_tile<1>(al, W + (size_t)nt * 128 * 192, 192, 3, epi, smem);
    }
}

constexpr int KROW = 72, VROW = 68;
constexpr int ATT_SMEM = 2 * 64 * KROW * 2 + 2 * 64 * VROW * 2;
DI int crow_(int i, int h) { return (i & 3) + 8 * (i >> 2) + 4 * h; }
#define MFMA32(a, b, c) __builtin_amdgcn_mfma_f32_32x32x16_bf16((a), (b), (c), 0, 0, 0)
template <int MODE>
DI void attn_unit(const Params& p, const bf16_t* Qg  , int nq_valid, const bf16_t* Kg  , const bf16_t* Vg  ,
                  int ta0, int ta1, int tb0, int tb1  , bool band, int q_lat0  ,
                  float init_m, float init_l0, bf16_t* Og  , char* smem) {
    const int t = tidx(), lane = t & 63, wid = t >> 6, r = lane & 31, h = lane >> 5;
    bf16_t* sK = (bf16_t*)smem;
    bf16_t* sV = sK + 2 * 64 * KROW;
    bf16x8 qf[2][4];
#pragma unroll
    for (int qs = 0; qs < 2; ++qs) {
        const int qi = wid * 64 + qs * 32 + r;
        const bf16_t* qp = Qg + (size_t)(qi < nq_valid ? qi : 0) * 64 + 8 * h;
#pragma unroll
        for (int ks = 0; ks < 4; ++ks) qf[qs][ks] = *(const bf16x8*)(qp + ks * 16);
    }
#pragma unroll
    for (int qs = 0; qs < 2; ++qs)
#pragma unroll
        for (int ks = 0; ks < 4; ++ks) asm volatile("" : "+v"(qf[qs][ks]));
    f32x16 o[2][2];
#pragma unroll
    for (int qs = 0; qs < 2; ++qs)
#pragma unroll
        for (int dt = 0; dt < 2; ++dt)
#pragma unroll
            for (int i = 0; i < 16; ++i) o[qs][dt][i] = 0.f;
    float mrun[2], lrun[2];
#pragma unroll
    for (int qs = 0; qs < 2; ++qs) { mrun[qs] = init_m; lrun[qs] = (MODE == 1 && h == 0) ? init_l0 : 0.f; }
    const int ntile = ((ta1 - ta0) + (tb1 - tb0)) >> 6;
    const int lrow = t >> 3, lch = (t & 7) * 8;
    u32x4 rk, rv;
    auto tile_pos = [&](int i) { const int a = (ta1 - ta0) >> 6; return i < a ? ta0 + i * 64 : tb0 + (i - a) * 64; };
    {
        const int kp = tile_pos(0);
        rk = *(const u32x4*)(Kg + (size_t)(kp + lrow) * 64 + lch);
        rv = *(const u32x4*)(Vg + (size_t)lrow * PTOT + kp + lch);
        *(u32x4*)(sK + lrow * KROW + lch) = rk;
        *(u32x2*)(sV + lrow * VROW + lch) = (u32x2){rv[0], rv[1]};
        *(u32x2*)(sV + lrow * VROW + lch + 4) = (u32x2){rv[2], rv[3]};
    }
    __syncthreads();
    for (int it = 0; it < ntile; ++it) {
        const int cur = it & 1;
        const bool more = it + 1 < ntile;
        const int kp = tile_pos(it);
        if (more) {
            const int kn = tile_pos(it + 1);
            rk = *(const u32x4*)(Kg + (size_t)(kn + lrow) * 64 + lch);
            rv = *(const u32x4*)(Vg + (size_t)lrow * PTOT + kn + lch);
        }
        __builtin_amdgcn_sched_barrier(0);
        const bf16_t* cK = sK + cur * 64 * KROW;
        const bf16_t* cV = sV + cur * 64 * VROW;
#pragma unroll 1
        for (int ksub = 0; ksub < 2; ++ksub) {
            f32x16 sc[2];
#pragma unroll
            for (int qs = 0; qs < 2; ++qs)
#pragma unroll
                for (int i = 0; i < 16; ++i) sc[qs][i] = MODE == 0 ? init_m : 0.f;
            {
                bf16x8 kf[4];
#pragma unroll
                for (int ks = 0; ks < 4; ++ks) kf[ks] = *(const bf16x8*)(cK + (ksub * 32 + r) * KROW + ks * 16 + 8 * h);
                __builtin_amdgcn_s_setprio(1);
#pragma unroll
                for (int ks = 0; ks < 4; ++ks)
#pragma unroll
                    for (int qs = 0; qs < 2; ++qs) sc[qs] = MFMA32(kf[ks], qf[qs][ks], sc[qs]);
                __builtin_amdgcn_s_setprio(0);
            }
#pragma unroll
            for (int qs = 0; qs < 2; ++qs) {
                if (MODE == 1) {
                    if (band && kp >= LCTX) {
                        const int qlat = q_lat0 + wid * 64 + qs * 32 + r, kl0 = kp - LCTX + ksub * 32;
#pragma unroll
                        for (int i = 0; i < 16; ++i) {
                            const int d0 = qlat - (kl0 + crow_(i, h));
                            if (d0 > 128 || d0 < -128) sc[qs][i] = -1e30f;
                        }
                    }
                    float mt = sc[qs][0];
#pragma unroll
                    for (int i = 1; i < 16; ++i) mt = fmaxf(mt, sc[qs][i]);
                    mt = fmaxf(mt, __shfl_xor(mt, 32));
                    const float mnew = fmaxf(mrun[qs], mt);
                    const float alpha = __builtin_amdgcn_exp2f(mrun[qs] - mnew);
                    mrun[qs] = mnew; lrun[qs] *= alpha;
#pragma unroll
                    for (int i = 0; i < 16; ++i) { o[qs][0][i] *= alpha; o[qs][1][i] *= alpha; }
#pragma unroll
                    for (int i = 0; i < 16; ++i) sc[qs][i] -= mnew;
                }
                float ls = 0.f;
#pragma unroll
                for (int i = 0; i < 16; ++i) { sc[qs][i] = __builtin_amdgcn_exp2f(sc[qs][i]); ls += sc[qs][i]; }
                lrun[qs] += ls;
            }
#pragma unroll
            for (int st = 0; st < 2; ++st) {
                bf16x8 pf[2];
#pragma unroll
                for (int qs = 0; qs < 2; ++qs) {
                    u32x4 pw;
#pragma unroll
                    for (int j = 0; j < 4; ++j) pw[j] = pk_bf16(sc[qs][8 * st + 2 * j], sc[qs][8 * st + 2 * j + 1]);
                    pf[qs] = __builtin_bit_cast(bf16x8, pw);
                }
                const int kb = ksub * 32 + 16 * st + 4 * h;
#pragma unroll
                for (int dt = 0; dt < 2; ++dt) {
                    const s16x4 lo = *(const s16x4*)(cV + (dt * 32 + r) * VROW + kb), hi = *(const s16x4*)(cV + (dt * 32 + r) * VROW + kb + 8);
                    const bf16x8 vf = __builtin_shufflevector(lo, hi, 0, 1, 2, 3, 4, 5, 6, 7);
#pragma unroll
                    for (int qs = 0; qs < 2; ++qs) o[qs][dt] = MFMA32(vf, pf[qs], o[qs][dt]);
                }
            }
        }
        if (more) {
            bf16_t* nK = sK + (cur ^ 1) * 64 * KROW;
            bf16_t* nV = sV + (cur ^ 1) * 64 * VROW;
            *(u32x4*)(nK + lrow * KROW + lch) = rk;
            *(u32x2*)(nV + lrow * VROW + lch) = (u32x2){rv[0], rv[1]};
            *(u32x2*)(nV + lrow * VROW + lch + 4) = (u32x2){rv[2], rv[3]};
        }
        __syncthreads();
    }
#pragma unroll
    for (int qs = 0; qs < 2; ++qs) {
        const int qi = wid * 64 + qs * 32 + r;
        const float lt = lrun[qs] + __shfl_xor(lrun[qs], 32);
        const float invl = 1.0f / lt;
        if (qi < nq_valid) {
            bf16_t* op = Og + (size_t)qi * DM;
#pragma unroll
            for (int g = 0; g < 4; ++g) {
                u32x2 w0, w1;
                w0[0] = pk_bf16(o[qs][0][4 * g] * invl, o[qs][0][4 * g + 1] * invl); w0[1] = pk_bf16(o[qs][0][4 * g + 2] * invl, o[qs][0][4 * g + 3] * invl);
                w1[0] = pk_bf16(o[qs][1][4 * g] * invl, o[qs][1][4 * g + 1] * invl); w1[1] = pk_bf16(o[qs][1][4 * g + 2] * invl, o[qs][1][4 * g + 3] * invl);
                *(u32x2*)(op + 8 * g + 4 * h) = w0;
                *(u32x2*)(op + 32 + 8 * g + 4 * h) = w1;
            }
        }
    }
}
DI void phase_attn(const Params& p, char* smem) {
    const bf16_t* Q = (const bf16_t*)(p.ws + OFF_SCR + S_Q);
    const bf16_t* K = (const bf16_t*)(p.ws + OFF_SCR + S_K);
    const bf16_t* VT = (const bf16_t*)(p.ws + OFF_SCR + S_VT);
    bf16_t* O = (bf16_t*)(p.ws + OFF_SCR + S_O);
    float gq = 0.f, gk = 0.f;
    for (int i = 0; i < 64; ++i) { gq = fmaxf(gq, fabsf(p.attn_q_norm_g[i])); gk = fmaxf(gk, fabsf(p.attn_k_norm_g[i])); }
    const float M2 = 8.25f * gq * gk * LOG2E;
    constexpr int QB = 512, NQB = SEQ / QB;
    const int G = gridDim.x;
    constexpr int NDENSE = NBATCH * 8 * NQB;
    for (int u = blockIdx.x; u < NDENSE; u += G) {
        int combo, within;
        if ((G & 7) == 0 && NDENSE % G == 0) {
            const int xcd = blockIdx.x & 7, idx = (blockIdx.x >> 3) + (G >> 3) * (u / G);
            combo = xcd & 3; within = (xcd >> 2) * (NDENSE / 8) + idx;
        } else { combo = u / (4 * NQB); within = u % (4 * NQB); }
        const int b = combo >> 1, kvh = combo & 1, hq = kvh * 4 + (within & 3), qb = within >> 2;
        const bf16_t* Qg = Q + ((size_t)(b * 16 + 8 + hq) * PTOT + LCTX + qb * QB) * 64;
        attn_unit<0>(p, Qg, QB, K + (size_t)(b * 4 + 2 + kvh) * PTOT * 64, VT + (size_t)(b * 4 + 2 + kvh) * 64 * PTOT, 0, PTOT, 0, 0, false, 0, -M2, 0.f,
                     O + (size_t)(b * PTOT + LCTX + qb * QB) * DM + (8 + hq) * 64, smem);
    }
    for (int u = blockIdx.x; u < NDENSE; u += G) {
        const int b = u / (8 * NQB), rem = u % (8 * NQB), qb = rem >> 3, hq = rem & 7, kvh = hq >> 2;
        const int i0 = qb * QB;
        const int lo = i0 - 128 < 0 ? 0 : i0 - 128, hi = i0 + QB + 128 > SEQ ? SEQ : i0 + QB + 128;
        const bf16_t* Qg = Q + ((size_t)(b * 16 + hq) * PTOT + LCTX + i0) * 64;
        attn_unit<1>(p, Qg, QB, K + (size_t)(b * 4 + kvh) * PTOT * 64, VT + (size_t)(b * 4 + kvh) * 64 * PTOT, 0, LCTX, LCTX + lo, LCTX + hi, true, i0,
                     p.attn_sink[hq] * LOG2E, 1.0f, O + (size_t)(b * PTOT + LCTX + i0) * DM + hq * 64, smem);
    }
    for (int u = blockIdx.x; u < NBATCH * 16; u += G) {
        const int b = u >> 4, hh = u & 15, isb = hh >> 3, hq = hh & 7, kvh = isb * 2 + (hq >> 2);
        const bf16_t* Qg = Q + ((size_t)(b * 16 + hh) * PTOT) * 64;
        attn_unit<1>(p, Qg, LCTX, K + (size_t)(b * 4 + kvh) * PTOT * 64, VT + (size_t)(b * 4 + kvh) * 64 * PTOT, 0, LCTX, 0, 0, false, 0,
                     isb ? -1e30f : p.attn_sink[hq] * LOG2E, isb ? 0.f : 1.0f, O + (size_t)(b * PTOT) * DM + hh * 64, smem);
    }
}

constexpr int TB = 32, NBUF = 3;
constexpr int SC_REC = 5 * 64;
constexpr int SC_OPS = TB * SC_REC * 4;
constexpr int SC_SMEM = NBUF * SC_OPS + NBUF * TB * 16 * 4 + NBUF * TB * 16 * 4 + 64;
DI int scan_pos(int n, int dir) {
    if (n < LCTX) return dir ? LCTX - 1 - n : n;
    const int m = n - LCTX;
    return LCTX + (dir ? SEQ - 1 - m : m);
}
template <int CTRL> DI float dpp_add(float v) { return v + __builtin_bit_cast(float, __builtin_amdgcn_update_dpp(0, __builtin_bit_cast(int, v), CTRL, 0xf, 0xf, false)); }
DI float row16_sum(float v) { v = dpp_add<0x128>(v); v = dpp_add<0x124>(v); v = dpp_add<0x122>(v); v = dpp_add<0x121>(v); return v; }
DI int lds_min4(int* c) { const volatile LAS int* q = (const volatile LAS int*)c; const int a = q[0], b = q[1], d = q[2], e = q[3]; return min(min(a, b), min(d, e)); }
DI void lds_publish(int* c, int v) { *(volatile LAS int*)c = v; }
DI void scan_unit(const Params& p, int u, char* smem) {
    const int t = tidx(), lane = t & 63, wid = __builtin_amdgcn_readfirstlane(t >> 6);
    const unsigned rg = u & 3, dir = (u >> 2) & 1, hd = (u >> 3) & 15, b = u >> 7;
    float* ops = (float*)smem;
    float* vbuf = (float*)(smem + NBUF * SC_OPS);
    float* ybuf = vbuf + NBUF * TB * 16;
    int* cnts = (int*)(ybuf + NBUF * TB * 16);
    const bf16_t* R = (const bf16_t*)(p.ws + OFF_SCR + S_R);
    const bf16_t* Kk = (const bf16_t*)(p.ws + OFF_SCR + S_KK);
    const bf16_t* V = (const bf16_t*)(p.ws + OFF_SCR + S_V);
    const bf16_t* LW = (const bf16_t*)(p.ws + OFF_SCR + S_LW);
    const bf16_t* LA = (const bf16_t*)(p.ws + OFF_SCR + S_LA);
    bf16_t* Yo = dir ? (bf16_t*)(p.ws + OFF_SCR + S_Y1) : (bf16_t*)(p.ws + OFF_H);
    float* bonus = (float*)(p.ws + OFF_BONUS2);
    const unsigned tokb = b * PTOT, hc = hd * 64;
    constexpr int NBLK = PTOT / TB;
    const unsigned fr = lane & 15, fq = lane >> 4;
    if (t < 8) cnts[t] = 0;
    __syncthreads();

    if (wid < 4) {
        __builtin_amdgcn_s_setprio(3);
        float s0 = 0.f, s1 = 0.f, s2 = 0.f, s3 = 0.f;
        const unsigned g = lane >> 4, c4 = (lane & 15) * 4, myrow = wid * 4 + g;
        for (int blk = 0; blk < NBLK; ++blk) {
            const unsigned buf = (unsigned)blk % NBUF;
            while (lds_min4(cnts) < blk + 1) __builtin_amdgcn_s_sleep(1);
            asm volatile("" ::: "memory");
            const float* rec = ops + buf * (TB * SC_REC) + c4;
            const float* vb = vbuf + buf * (TB * 16) + myrow;
            float* yb = ybuf + buf * (TB * 16) + myrow;
            f32x4 w0_ = *(const f32x4*)(rec), kd0_ = *(const f32x4*)(rec + 64), bb0_ = *(const f32x4*)(rec + 128), aa0_ = *(const f32x4*)(rec + 192), rr0_ = *(const f32x4*)(rec + 256);
            float vv0_ = vb[0];
#define SCAN_STEP(W, KD, BB, AA, RR, VV, ST) { \
                float sa = s0 * AA[0] + s1 * AA[1] + s2 * AA[2] + s3 * AA[3]; \
                sa = row16_sum(sa); \
                s0 = s0 * W[0] + sa * BB[0] + VV * KD[0]; \
                s1 = s1 * W[1] + sa * BB[1] + VV * KD[1]; \
                s2 = s2 * W[2] + sa * BB[2] + VV * KD[2]; \
                s3 = s3 * W[3] + sa * BB[3] + VV * KD[3]; \
                float y = s0 * RR[0] + s1 * RR[1] + s2 * RR[2] + s3 * RR[3]; \
                y = row16_sum(y); \
                if ((lane & 15) == 0) yb[(ST) * 16] = y; }
#pragma unroll 1
            for (int st = 0; st < TB; st += 2) {
                const float* r1 = rec + (st + 1) * SC_REC;
                const f32x4 w1_ = *(const f32x4*)(r1), kd1_ = *(const f32x4*)(r1 + 64), bb1_ = *(const f32x4*)(r1 + 128), aa1_ = *(const f32x4*)(r1 + 192), rr1_ = *(const f32x4*)(r1 + 256);
                const float vv1_ = vb[(st + 1) * 16];
                SCAN_STEP(w0_, kd0_, bb0_, aa0_, rr0_, vv0_, st)
                const int st2 = st + 2 < TB ? st + 2 : st;
                const float* r2 = rec + st2 * SC_REC;
                w0_ = *(const f32x4*)(r2); kd0_ = *(const f32x4*)(r2 + 64); bb0_ = *(const f32x4*)(r2 + 128); aa0_ = *(const f32x4*)(r2 + 192); rr0_ = *(const f32x4*)(r2 + 256);
                vv0_ = vb[st2 * 16];
                SCAN_STEP(w1_, kd1_, bb1_, aa1_, rr1_, vv1_, st + 1)
            }
#undef SCAN_STEP
            asm volatile("s_waitcnt lgkmcnt(0)" ::: "memory");
            if (lane == 0) lds_publish(cnts + 4 + wid, blk + 1);
        }
        __builtin_amdgcn_s_setprio(0);
    } else {
        const unsigned wt = wid & 1, chh = (wid >> 1) & 1;
        const bf16_t* wsm = (const bf16_t*)(p.ws + OFF_WS);
        const unsigned wo = W_W2 + dir * 65536u + (hc + fr) * 64u + fq * 8u;
        const unsigned ao = W_A2 + dir * 65536u + (hc + fr) * 64u + fq * 8u;
        const unsigned po = hc + fq * 4u;
        for (int blk = 0; blk < NBLK + NBUF; ++blk) {
            const unsigned buf = (unsigned)blk % NBUF;
            const int need = blk - NBUF + 1 < NBLK ? blk - NBUF + 1 : NBLK;
            while (lds_min4(cnts + 4) < need) __builtin_amdgcn_s_sleep(1);
            asm volatile("" ::: "memory");
            if (wid == 7 && blk >= NBUF) {
#pragma unroll
                for (int i = 0; i < TB * 16 / 64; ++i) {
                    const unsigned id = i * 64 + lane, st = id >> 4, rw = id & 15;
                    const unsigned tok = tokb + scan_pos((blk - NBUF) * TB + st, dir);
                    Yo[tok * 1024u + hc + rg * 16 + rw] = (bf16_t)(pk_bf16(ybuf[buf * (TB * 16) + id], 0.f) & 0xffffu);
                }
            }
            if (blk >= NBLK) continue;
            const unsigned st = wt * 16 + fr;
            const unsigned tok = tokb + scan_pos(blk * TB + st, dir);
            const unsigned lo = tok * 128u + dir * 64u + fq * 8u;
            const unsigned ro = tok * 1024u + hc + fq * 4u;
            bf16x8 lwf[2], laf[2];
#pragma unroll
            for (int kk = 0; kk < 2; ++kk) { lwf[kk] = *(const bf16x8*)(LW + lo + kk * 32); laf[kk] = *(const bf16x8*)(LA + lo + kk * 32); }
            float ssq = 0.f;
#pragma unroll
            for (int nt = 0; nt < 4; ++nt) {
                const f32x4 kkv = *(const f32x4*)(p.rwkv_k_k + po + nt * 16);
                const u32x2 c = *(const u32x2*)(Kk + ro + nt * 16);
                const float q0 = bf_lo(c[0]) * kkv[0], q1 = bf_hi(c[0]) * kkv[1], q2 = bf_lo(c[1]) * kkv[2], q3 = bf_hi(c[1]) * kkv[3];
                ssq += q0 * q0 + q1 * q1 + q2 * q2 + q3 * q3;
            }
            ssq += __shfl_xor(ssq, 16); ssq += __shfl_xor(ssq, 32);
            const float kn = __builtin_amdgcn_rsqf(fmaxf(ssq, 1e-24f));
            float* rec = ops + buf * (TB * SC_REC) + st * SC_REC + fq * 4;
            float bsum = 0.f;
#pragma unroll
            for (int n2 = 0; n2 < 2; ++n2) {
                const unsigned nt = chh * 2 + n2;
                f32x4 aw = {0.f, 0.f, 0.f, 0.f}, ai = aw;
#pragma unroll
                for (int kk = 0; kk < 2; ++kk) {
                    const bf16x8 w2f = *(const bf16x8*)(wsm + wo + nt * 1024 + kk * 32), a2f = *(const bf16x8*)(wsm + ao + nt * 1024 + kk * 32);
                    aw = __builtin_amdgcn_mfma_f32_16x16x32_bf16(w2f, lwf[kk], aw, 0, 0, 0);
                    ai = __builtin_amdgcn_mfma_f32_16x16x32_bf16(a2f, laf[kk], ai, 0, 0, 0);
                }
                const f32x4 w0v = *(const f32x4*)(p.rwkv_decay_w0 + dir * 1024u + po + nt * 16), a0v = *(const f32x4*)(p.rwkv_iclr_a0 + dir * 1024u + po + nt * 16);
                const f32x4 kkv = *(const f32x4*)(p.rwkv_k_k + po + nt * 16);
                const f32x4 kav = *(const f32x4*)(p.rwkv_k_a + po + nt * 16), rkv = *(const f32x4*)(p.rwkv_r_k + po + nt * 16);
                const u32x2 a = *(const u32x2*)(R + ro + nt * 16), c = *(const u32x2*)(Kk + ro + nt * 16);
                const f32x4 rr = {bf_lo(a[0]), bf_hi(a[0]), bf_lo(a[1]), bf_hi(a[1])};
                const f32x4 kr = {bf_lo(c[0]), bf_hi(c[0]), bf_lo(c[1]), bf_hi(c[1])};
                f32x4 wv, kd, bb, aa;
#pragma unroll
                for (int j = 0; j < 4; ++j) {
                    const float sg = __builtin_amdgcn_rcpf(1.0f + __builtin_amdgcn_exp2f(-(w0v[j] + aw[j]) * LOG2E));
                    wv[j] = __builtin_amdgcn_exp2f(sg * (-0.6065306597126334f * LOG2E));
                    const float ic = __builtin_amdgcn_rcpf(1.0f + __builtin_amdgcn_exp2f(-(a0v[j] + ai[j]) * LOG2E));
                    const float kkn = kr[j] * kkv[j] * kn;
                    kd[j] = kr[j] * (1.0f + (ic - 1.0f) * kav[j]);
                    bb[j] = kkn * ic;
                    aa[j] = -kkn;
                    bsum += rr[j] * kd[j] * rkv[j];
                }
                *(f32x4*)(rec + 0 * 64 + nt * 16) = wv;
                *(f32x4*)(rec + 1 * 64 + nt * 16) = kd;
                *(f32x4*)(rec + 2 * 64 + nt * 16) = bb;
                *(f32x4*)(rec + 3 * 64 + nt * 16) = aa;
                *(f32x4*)(rec + 4 * 64 + nt * 16) = rr;
            }
            bsum += __shfl_xor(bsum, 16); bsum += __shfl_xor(bsum, 32);
            if (rg == 0 && fq == 0) bonus[((chh * 2 + dir) * TTOT + tok) * 16u + hd] = bsum;
            if (wid == 6) {
                bf16_t vr[TB * 16 / 64];
#pragma unroll
                for (int i = 0; i < TB * 16 / 64; ++i) {
                    const unsigned id = i * 64 + lane, s2 = id >> 4, rw = id & 15;
                    const unsigned tk = tokb + scan_pos(blk * TB + s2, dir);
                    vr[i] = V[tk * 1024u + hc + rg * 16 + rw];
                }
#pragma unroll
                for (int i = 0; i < TB * 16 / 64; ++i) vbuf[buf * (TB * 16) + i * 64 + lane] = bf2f(vr[i]);
            }
            asm volatile("s_waitcnt lgkmcnt(0)" ::: "memory");
            if (lane == 0) lds_publish(cnts + (wid - 4), blk + 1);
        }
    }
    __syncthreads();
}

constexpr int CH = 16, NCHK = PTOT / CH;
constexpr int NPREP = 7, NSLOT = 2;
constexpr int TKS = 72, KTS = 20, SMS = 20;
constexpr int SL_PT = 0, SL_QM = SL_PT + 64 * TKS * 2, SL_RT = SL_QM + 64 * KTS * 2, SL_G2 = SL_RT + 16 * TKS * 2, SL_VT = SL_G2 + 16 * SMS * 2, SL_WC = SL_VT + 16 * SMS * 2,
              SLOT_BYTES = SL_WC + 64 * 4;
constexpr int XTK_B = 16 * TKS * 2, XKT_B = 64 * KTS * 2, SM_B = 16 * SMS * 2;
constexpr int PR_XA = 0, PR_XB = PR_XA + XTK_B, PR_XK = PR_XB + XTK_B, PR_XR = PR_XK + XTK_B, PR_TA = PR_XR + XTK_B, PR_TB = PR_TA + XKT_B, PR_TK = PR_TB + XKT_B,
              PR_SN = PR_TK + XKT_B, PREP_BYTES = PR_SN + 2 * SM_B;
static_assert(10 * SM_B <= 3 * XTK_B, "matrices fit in XA..XK");
constexpr int SC2_SMEM = NSLOT * SLOT_BYTES + NPREP * PREP_BYTES + 64 + 5 * 64 * 4;
typedef short s16x4v __attribute__((ext_vector_type(4)));
DI f32x4 mfma16(s16x4v a, s16x4v b, f32x4 c) { return __builtin_amdgcn_mfma_f32_16x16x16bf16_1k(a, b, c, 0, 0, 0); }
DI f32x4 mfma32(bf16x8 a, bf16x8 b, f32x4 c) { return __builtin_amdgcn_mfma_f32_16x16x32_bf16(a, b, c, 0, 0, 0); }
DI s16x4v ld4(const bf16_t* q) { return *(const s16x4v*)q; }
DI f32x4 up4(u32x2 w) { return (f32x4){bf_lo(w[0]), bf_hi(w[0]), bf_lo(w[1]), bf_hi(w[1])}; }
DI f32x4 ld4f(const bf16_t* q) { return up4(*(const u32x2*)q); }
DI void st4(bf16_t* q, f32x4 v) { u32x2 w; w[0] = pk_bf16(v[0], v[1]); w[1] = pk_bf16(v[2], v[3]); *(u32x2*)q = w; }
#define LDS_WAIT() asm volatile("s_waitcnt lgkmcnt(0)" ::: "memory")
template <int CTRL> DI float dpp_shr_add(float v) { return v + __builtin_bit_cast(float, __builtin_amdgcn_update_dpp(0, __builtin_bit_cast(int, v), CTRL, 0xf, 0xf, true)); }
DI float row16_prefix(float v) { v = dpp_shr_add<0x111>(v); v = dpp_shr_add<0x112>(v); v = dpp_shr_add<0x114>(v); v = dpp_shr_add<0x118>(v); return v; }
DI f32x4 mm16(const bf16_t* A, const bf16_t* Bt, int fr, int fq) {
    const s16x4v a = ld4(A + fr * SMS + fq * 4), b = ld4(Bt + fr * SMS + fq * 4);
    LDS_WAIT();
    return mfma16(a, b, (f32x4){0.f, 0.f, 0.f, 0.f});
}
DI f32x4 mm16p(const bf16_t* A, const bf16_t* Bt, const bf16_t* Add, int fr, int fq) {
    const s16x4v a = ld4(A + fr * SMS + fq * 4), b = ld4(Bt + fr * SMS + fq * 4);
    const u32x2 c = *(const u32x2*)(Add + fr * SMS + fq * 4);
    LDS_WAIT();
    return mfma16(a, b, up4(c));
}

DI void scan_unit_chunked(const Params& p, int u, char* smem) {
    const int t = tidx(), lane = t & 63, wid = __builtin_amdgcn_readfirstlane(t >> 6);
    const unsigned rg = u & 3, dir = (u >> 2) & 1, hd = (u >> 3) & 15, b = u >> 7;
    const unsigned tokb = b * PTOT, hc = hd * 64;
    const unsigned fr = lane & 15, fq = lane >> 4;
    char* slots = smem;
    char* prep0 = smem + NSLOT * SLOT_BYTES;
    int* cnts = (int*)(smem + NSLOT * SLOT_BYTES + NPREP * PREP_BYTES);
    const bf16_t* R = (const bf16_t*)(p.ws + OFF_SCR + S_R);
    const bf16_t* Kk = (const bf16_t*)(p.ws + OFF_SCR + S_KK);
    const bf16_t* V = (const bf16_t*)(p.ws + OFF_SCR + S_V);
    const bf16_t* LW = (const bf16_t*)(p.ws + OFF_SCR + S_LW);
    const bf16_t* LA = (const bf16_t*)(p.ws + OFF_SCR + S_LA);
    bf16_t* Yo = dir ? (bf16_t*)(p.ws + OFF_SCR + S_Y1) : (bf16_t*)(p.ws + OFF_H);
    float* bonus = (float*)(p.ws + OFF_BONUS2);
    float* prm = (float*)(cnts + 16);
    if (t < 16) cnts[t] = 0;
    if (t < 64) {
        prm[t] = p.rwkv_decay_w0[dir * 1024u + hc + t]; prm[64 + t] = p.rwkv_iclr_a0[dir * 1024u + hc + t];
        prm[128 + t] = p.rwkv_k_k[hc + t]; prm[192 + t] = p.rwkv_k_a[hc + t]; prm[256 + t] = p.rwkv_r_k[hc + t];
    }
    __syncthreads();

    if (wid == 0) {
        __builtin_amdgcn_s_setprio(3);
        f32x4 st[4];
#pragma unroll
        for (int m = 0; m < 4; ++m) st[m] = (f32x4){0.f, 0.f, 0.f, 0.f};
        for (int c = 0; c < NCHK; ++c) {
            const unsigned sl = (unsigned)c % NSLOT;
            const char* S = slots + sl * SLOT_BYTES;
            while (*(volatile LAS int*)(cnts + sl) < c + 1) __builtin_amdgcn_s_sleep(1);
            LDS_WAIT();
            const s16x4v vt = ld4((const bf16_t*)(S + SL_VT) + fr * SMS + fq * 4);
            const s16x4v g2 = ld4((const bf16_t*)(S + SL_G2) + fr * SMS + fq * 4);
            s16x4v rtl[2], rth[2], ptl[4][2], pth[4][2], qm[4];
            f32x4 wc[4];
#pragma unroll
            for (int i = 0; i < 2; ++i) { const bf16_t* q = (const bf16_t*)(S + SL_RT) + fr * TKS + 32 * i + fq * 4; rtl[i] = ld4(q); rth[i] = ld4(q + 16); }
#pragma unroll
            for (int m = 0; m < 4; ++m) {
                wc[m] = *(const f32x4*)((const float*)(S + SL_WC) + 16 * m + fq * 4);
                qm[m] = ld4((const bf16_t*)(S + SL_QM) + (16 * m + fr) * KTS + fq * 4);
#pragma unroll
                for (int i = 0; i < 2; ++i) { const bf16_t* q = (const bf16_t*)(S + SL_PT) + (16 * m + fr) * TKS + 32 * i + fq * 4; ptl[m][i] = ld4(q); pth[m][i] = ld4(q + 16); }
            }
            LDS_WAIT();
            if (lane == 0) *(volatile LAS int*)(cnts + 8) = c + 1;
            bf16x8 sb[2];
#pragma unroll
            for (int i = 0; i < 2; ++i) {
                u32x4 w; w[0] = pk_bf16(st[2 * i][0], st[2 * i][1]); w[1] = pk_bf16(st[2 * i][2], st[2 * i][3]); w[2] = pk_bf16(st[2 * i + 1][0], st[2 * i + 1][1]); w[3] = pk_bf16(st[2 * i + 1][2], st[2 * i + 1][3]);
                sb[i] = __builtin_bit_cast(bf16x8, w);
            }
            f32x4 y = {0.f, 0.f, 0.f, 0.f};
#pragma unroll
            for (int i = 0; i < 2; ++i) y = mfma32(__builtin_shufflevector(rtl[i], rth[i], 0, 1, 2, 3, 4, 5, 6, 7), sb[i], y);
            y = mfma16(g2, vt, y);
#pragma unroll
            for (int m = 0; m < 4; ++m) {
                f32x4 acc = st[m] * wc[m];
#pragma unroll
                for (int i = 0; i < 2; ++i) acc = mfma32(__builtin_shufflevector(ptl[m][i], pth[m][i], 0, 1, 2, 3, 4, 5, 6, 7), sb[i], acc);
                st[m] = mfma16(qm[m], vt, acc);
            }

#pragma unroll
            for (int j = 0; j < 4; ++j) {
                const unsigned tok = tokb + scan_pos(c * CH + fq * 4 + j, dir);
                Yo[tok * 1024u + hc + rg * 16 + fr] = (bf16_t)(pk_bf16(y[j], 0.f) & 0xffffu);
            }
        }
        __builtin_amdgcn_s_setprio(0);
    } else {
        const unsigned pid = wid - 1;
        char* PS = prep0 + pid * PREP_BYTES;
        bf16_t* XA = (bf16_t*)(PS + PR_XA); bf16_t* XB = (bf16_t*)(PS + PR_XB); bf16_t* XK = (bf16_t*)(PS + PR_XK); bf16_t* XR = (bf16_t*)(PS + PR_XR);
        bf16_t* TA = (bf16_t*)(PS + PR_TA); bf16_t* TB_ = (bf16_t*)(PS + PR_TB); bf16_t* TK = (bf16_t*)(PS + PR_TK); bf16_t* AT = TA;
        bf16_t* SN = (bf16_t*)(PS + PR_SN);
        bf16_t *M = SN, *NABR = SN + 1 * 16 * SMS;
        bf16_t *M2 = XA, *M2T = XA + 1 * 16 * SMS, *M4 = XA + 2 * 16 * SMS, *M4T = XA + 3 * 16 * SMS, *X1 = XA + 4 * 16 * SMS, *G1 = XA + 5 * 16 * SMS, *NAKR = XA + 6 * 16 * SMS,
                *NRBT = XA + 7 * 16 * SMS, *NRKT = XA + 8 * 16 * SMS, *IM = XA + 9 * 16 * SMS;
        bf16_t *M8T = M2, *X2 = M2T, *TT = M4;
        float* WCP = (float*)SN;
        const bf16_t* wsm = (const bf16_t*)(p.ws + OFF_WS);
        const unsigned wo = W_W2 + dir * 65536u + (hc + fr) * 64u + fq * 8u;
        const unsigned ao = W_A2 + dir * 65536u + (hc + fr) * 64u + fq * 8u;
        const unsigned po = hc + fq * 4u;
        const f32x4 z4 = {0.f, 0.f, 0.f, 0.f};
        bf16x8 lwf[2], laf[2], lwn[2], lan[2];
        u32x2 krw[4], rrw[4], krn[4], rrn[4];
        unsigned tok_cur = 0, tok_nxt = 0;
        auto issue = [&](int c, bf16x8 (&lw)[2], bf16x8 (&la)[2], u32x2 (&kw)[4], u32x2 (&rw)[4], unsigned& tk) {
            tk = tokb + scan_pos(c * CH + fr, dir);
            const unsigned lo = tk * 128u + dir * 64u + fq * 8u, ro = tk * 1024u + hc + fq * 4u;
#pragma unroll
            for (int kk = 0; kk < 2; ++kk) { lw[kk] = *(const bf16x8*)(LW + lo + kk * 32); la[kk] = *(const bf16x8*)(LA + lo + kk * 32); }
#pragma unroll
            for (int nt = 0; nt < 4; ++nt) { kw[nt] = *(const u32x2*)(Kk + ro + nt * 16); rw[nt] = *(const u32x2*)(R + ro + nt * 16); }
        };
        if ((int)pid < NCHK) issue(pid, lwf, laf, krw, rrw, tok_cur);
        for (int c = pid; c < NCHK; c += NPREP) {
            if (c + NPREP < NCHK) issue(c + NPREP, lwn, lan, krn, rrn, tok_nxt);
            const unsigned tok = tok_cur;
            float ssq = 0.f;
#pragma unroll
            for (int nt = 0; nt < 4; ++nt) {
                const f32x4 kkv = *(const f32x4*)(prm + 128 + fq * 4 + nt * 16);
                const f32x4 q = up4(krw[nt]) * kkv;
                ssq += q[0] * q[0] + q[1] * q[1] + q[2] * q[2] + q[3] * q[3];
            }
            ssq += __shfl_xor(ssq, 16); ssq += __shfl_xor(ssq, 32);
            const float kn = __builtin_amdgcn_rsqf(fmaxf(ssq, 1e-24f));
            float bsum = 0.f;
#pragma unroll
            for (int nt = 0; nt < 4; ++nt) {
                f32x4 aw = z4, ai = z4;
#pragma unroll
                for (int kk = 0; kk < 2; ++kk) {
                    const bf16x8 w2f = *(const bf16x8*)(wsm + wo + nt * 1024 + kk * 32), a2f = *(const bf16x8*)(wsm + ao + nt * 1024 + kk * 32);
                    aw = mfma32(w2f, lwf[kk], aw);
                    ai = mfma32(a2f, laf[kk], ai);
                }
                const f32x4 w0v = *(const f32x4*)(prm + fq * 4 + nt * 16), a0v = *(const f32x4*)(prm + 64 + fq * 4 + nt * 16);
                const f32x4 kkv = *(const f32x4*)(prm + 128 + fq * 4 + nt * 16);
                const f32x4 kav = *(const f32x4*)(prm + 192 + fq * 4 + nt * 16), rkv = *(const f32x4*)(prm + 256 + fq * 4 + nt * 16);
                LDS_WAIT();
                const f32x4 rr = up4(rrw[nt]), krn4 = up4(krw[nt]);
                const f32x4 x1 = (w0v + aw) * (-LOG2E), x2 = (a0v + ai) * (-LOG2E);
                f32x4 ex1, ex2;
#pragma unroll
                for (int j = 0; j < 4; ++j) { ex1[j] = __builtin_amdgcn_exp2f(x1[j]); ex2[j] = __builtin_amdgcn_exp2f(x2[j]); }
                ex1 = ex1 + 1.0f; ex2 = ex2 + 1.0f;
                f32x4 sg, ic;
#pragma unroll
                for (int j = 0; j < 4; ++j) { sg[j] = __builtin_amdgcn_rcpf(ex1[j]); ic[j] = __builtin_amdgcn_rcpf(ex2[j]); }
                const f32x4 e2 = sg * (0.6065306597126334f * LOG2E);
                const f32x4 kkn = krn4 * kkv * kn;
                const f32x4 kd = krn4 * ((ic - 1.0f) * kav + 1.0f);
                { const f32x4 bq = rr * kd * rkv; bsum += (bq[0] + bq[1]) + (bq[2] + bq[3]); }
                f32x4 wt, wi, wp;
#pragma unroll
                for (int j = 0; j < 4; ++j) {
                    const float ec = row16_prefix(e2[j]);
                    wt[j] = __builtin_amdgcn_exp2f(-ec);
                    wi[j] = __builtin_amdgcn_exp2f(ec);
                    wp[j] = __builtin_amdgcn_exp2f(e2[j] - ec);
                }
                const f32x4 at = -(kkn * wp), rt = rr * wt, bt = kkn * ic * wi, kt = kd * wi;
                {
                    u32x2 wa, wb, wk;
                    wa[0] = pk_bf16(at[0], at[1]); wa[1] = pk_bf16(at[2], at[3]); wb[0] = pk_bf16(bt[0], bt[1]); wb[1] = pk_bf16(bt[2], bt[3]);
                    wk[0] = pk_bf16(kt[0], kt[1]); wk[1] = pk_bf16(kt[2], kt[3]);
                    *(u32x2*)(XA + fr * TKS + nt * 16 + fq * 4) = wa; *(u32x2*)(XB + fr * TKS + nt * 16 + fq * 4) = wb; *(u32x2*)(XK + fr * TKS + nt * 16 + fq * 4) = wk;
                    const unsigned o = (nt * 16 + fq * 4) * KTS + fr;
#pragma unroll
                    for (int j = 0; j < 4; ++j) {
                        TA[o + j * KTS] = (bf16_t)((j & 1) ? (wa[j >> 1] >> 16) : (wa[j >> 1] & 0xffffu));
                        TB_[o + j * KTS] = (bf16_t)((j & 1) ? (wb[j >> 1] >> 16) : (wb[j >> 1] & 0xffffu));
                        TK[o + j * KTS] = (bf16_t)((j & 1) ? (wk[j >> 1] >> 16) : (wk[j >> 1] & 0xffffu));
                    }
                }
                if (fr == 15) *(f32x4*)(WCP + nt * 16 + fq * 4) = wt;
                st4(XR + fr * TKS + nt * 16 + fq * 4, rt);
            }
            bsum += __shfl_xor(bsum, 16); bsum += __shfl_xor(bsum, 32);
            if (rg == 0 && fq == 0) { bonus[((0 * 2 + dir) * TTOT + tok) * 16u + hd] = bsum; bonus[((1 * 2 + dir) * TTOT + tok) * 16u + hd] = 0.f; }
            LDS_WAIT();
            float wcr[4];
#pragma unroll
            for (int n = 0; n < 4; ++n) wcr[n] = WCP[16 * n + fr];
            bf16x8 fa[2], fb[2], fk[2], frr[2];
#pragma unroll
            for (int kk = 0; kk < 2; ++kk) {
                fa[kk] = *(const bf16x8*)(XA + fr * TKS + kk * 32 + fq * 8); fb[kk] = *(const bf16x8*)(XB + fr * TKS + kk * 32 + fq * 8);
                fk[kk] = *(const bf16x8*)(XK + fr * TKS + kk * 32 + fq * 8); frr[kk] = *(const bf16x8*)(XR + fr * TKS + kk * 32 + fq * 8);
            }
            LDS_WAIT();
            f32x4 d1 = z4, d2 = z4, d3 = z4, d4 = z4, d5 = z4;
#pragma unroll
            for (int kk = 0; kk < 2; ++kk) {
                d1 = mfma32(fb[kk], fa[kk], d1);
                d2 = mfma32(fa[kk], fb[kk], d2);
                d3 = mfma32(fa[kk], fk[kk], d3);
                d4 = mfma32(fb[kk], frr[kk], d4);
                d5 = mfma32(fk[kk], frr[kk], d5);
            }
            f32x4 im;
#pragma unroll
            for (int j = 0; j < 4; ++j) {
                const unsigned ij = fq * 4 + j;
                d1[j] = ij < fr ? d1[j] : 0.f;
                d2[j] = fr < ij ? d2[j] : 0.f;
                d3[j] = fr < ij ? d3[j] : 0.f;
                d4[j] = ij <= fr ? d4[j] : 0.f;
                d5[j] = ij <= fr ? d5[j] : 0.f;
                im[j] = d1[j] + (ij == fr ? 1.0f : 0.f);
            }
            st4(M + fr * SMS + fq * 4, d1);
            st4(IM + fr * SMS + fq * 4, im);
            st4(NABR + fr * SMS + fq * 4, d2);
            st4(NAKR + fr * SMS + fq * 4, d3);
            st4(NRBT + fr * SMS + fq * 4, d4);
            st4(NRKT + fr * SMS + fq * 4, d5);
            LDS_WAIT();
            const int so = fr * SMS + fq * 4;
            {
                const s16x4v m = ld4(M + so), mt = ld4(NABR + so);
                LDS_WAIT();
                st4(M2T + so, mfma16(m, mt, z4)); st4(M2 + so, mfma16(mt, m, z4));
                LDS_WAIT();
            }
            {
                const s16x4v m2 = ld4(M2 + so), m2t = ld4(M2T + so); const u32x2 imr = *(const u32x2*)(IM + so);
                LDS_WAIT();
                st4(M4T + so, mfma16(m2, m2t, z4)); st4(M4 + so, mfma16(m2t, m2, z4));
                st4(X1 + so, mfma16(m2t, __builtin_bit_cast(s16x4v, imr), up4(imr)));
                LDS_WAIT();
            }
            {
                const s16x4v m4 = ld4(M4 + so), m4t = ld4(M4T + so); const u32x2 x1r = *(const u32x2*)(X1 + so);
                LDS_WAIT();
                st4(M8T + so, mfma16(m4, m4t, z4));
                st4(X2 + so, mfma16(m4t, __builtin_bit_cast(s16x4v, x1r), up4(x1r)));
                LDS_WAIT();
            }
            {
                const s16x4v m8t = ld4(M8T + so); const u32x2 x2r = *(const u32x2*)(X2 + so);
                LDS_WAIT();
                st4(TT + so, mfma16(m8t, __builtin_bit_cast(s16x4v, x2r), up4(x2r)));
                LDS_WAIT();
            }
            {
                const s16x4v ta = ld4(TT + so), nk = ld4(NAKR + so);
                s16x4v xa[4];
#pragma unroll
                for (int n = 0; n < 4; ++n) xa[n] = ld4(TA + (16 * n + fr) * KTS + fq * 4);
                LDS_WAIT();
                st4(G1 + so, mfma16(ta, nk, z4));
#pragma unroll
                for (int n = 0; n < 4; ++n) st4(AT + (16 * n + fr) * KTS + fq * 4, mfma16(ta, xa[n], z4));
                LDS_WAIT();
            }
            const unsigned sl = (unsigned)c % NSLOT;
            char* S = slots + sl * SLOT_BYTES;
            {
                unsigned vv[2][2];
#pragma unroll
                for (int i = 0; i < 2; ++i) {
                    const unsigned q = i * 64 + lane, vrow = q & 15, sp = q >> 4;
                    const unsigned tk0 = tokb + scan_pos(c * CH + 2 * sp, dir), tk1 = tokb + scan_pos(c * CH + 2 * sp + 1, dir);
                    vv[i][0] = V[tk0 * 1024u + hc + rg * 16 + vrow]; vv[i][1] = V[tk1 * 1024u + hc + rg * 16 + vrow];
                }
                const s16x4v nrb = ld4(NRBT + so), g1 = ld4(G1 + so);
                const u32x2 nrk = *(const u32x2*)(NRKT + so);
                s16x4v atm[4], tb[4]; u32x2 xr[4], tk[4];
#pragma unroll
                for (int m = 0; m < 4; ++m) {
                    atm[m] = ld4(AT + (16 * m + fr) * KTS + fq * 4); tb[m] = ld4(TB_ + (16 * m + fr) * KTS + fq * 4);
                    xr[m] = *(const u32x2*)(XR + fr * TKS + 16 * m + fq * 4); tk[m] = *(const u32x2*)(TK + (16 * m + fr) * KTS + fq * 4);
                }
                LDS_WAIT();
                while (*(volatile LAS int*)(cnts + 8) < c - NSLOT + 1) __builtin_amdgcn_s_sleep(1);
                asm volatile("" ::: "memory");
                st4((bf16_t*)(S + SL_G2) + so, mfma16(g1, nrb, up4(nrk)));
#pragma unroll
                for (int m = 0; m < 4; ++m) {
                    st4((bf16_t*)(S + SL_RT) + fr * TKS + 16 * m + fq * 4, mfma16(atm[m], nrb, up4(xr[m])));
#pragma unroll
                    for (int n = 0; n < 4; ++n) st4((bf16_t*)(S + SL_PT) + (16 * n + fr) * TKS + 16 * m + fq * 4, mfma16(atm[m], tb[n], z4) * wcr[n]);
                    asm volatile("" ::: "memory");
                }
#pragma unroll
                for (int n = 0; n < 4; ++n) st4((bf16_t*)(S + SL_QM) + (16 * n + fr) * KTS + fq * 4, mfma16(g1, tb[n], up4(tk[n])) * wcr[n]);
                ((float*)(S + SL_WC))[lane] = (fq == 0) ? wcr[0] : (fq == 1) ? wcr[1] : (fq == 2) ? wcr[2] : wcr[3];
#pragma unroll
                for (int i = 0; i < 2; ++i) {
                    const unsigned q = i * 64 + lane, vrow = q & 15, sp = q >> 4;
                    *(unsigned*)((bf16_t*)(S + SL_VT) + vrow * SMS + 2 * sp) = vv[i][0] | (vv[i][1] << 16);
                }
            }
            LDS_WAIT();
            if (lane == 0) *(volatile LAS int*)(cnts + sl) = c + 1;
#pragma unroll
            for (int kk = 0; kk < 2; ++kk) { lwf[kk] = lwn[kk]; laf[kk] = lan[kk]; }
#pragma unroll
            for (int nt = 0; nt < 4; ++nt) { krw[nt] = krn[nt]; rrw[nt] = rrn[nt]; }
            tok_cur = tok_nxt;
        }
    }
    __syncthreads();
}

DI void phase_scan(const Params& p, char* smem) {
    for (int u = blockIdx.x; u < NBATCH * 16 * 2 * 4; u += gridDim.x) scan_unit_chunked(p, u, smem);
}

constexpr int NPHASE = 18;
constexpr int SMEM_BYTES = (SC2_SMEM > SC_SMEM ? SC2_SMEM : SC_SMEM) + 64;
static_assert(SMEM_BYTES >= GEMM_SMEM + 64 && SMEM_BYTES >= G8_SMEM + 64 && SMEM_BYTES + 16 <= 163840, "LDS");
template <int PH> DI void run_phase(const Params& p, char* smem) {
    if constexpr (PH == 0) phase_prologue(p, smem);
    else if constexpr (PH == 1) phase_norm0(p);
    else if constexpr (PH == 2) phase_qkv(p, smem);
    else if constexpr (PH == 3) phase_attn(p, smem);
    else if constexpr (PH == 4) phase_wout(p, smem);
    else if constexpr (PH == 5) phase_ffn_norm_route(p, 0, smem);
    else if constexpr (PH == 6) phase_moe1(p, 0, smem);
    else if constexpr (PH == 7) phase_moe2(p, 0, smem);
    else if constexpr (PH == 8) phase_combine_l0(p, smem);
    else if constexpr (PH == 9) phase_xx(p);
    else if constexpr (PH == 10) phase_rwkv_proj(p, smem);
    else if constexpr (PH == 11) phase_scan(p, smem);
    else if constexpr (PH == 12) phase_gate(p, smem);
    else if constexpr (PH == 13) phase_wo(p, smem);
    else if constexpr (PH == 14) phase_ffn_norm_route(p, 1, smem);
    else if constexpr (PH == 15) phase_moe1(p, 1, smem);
    else if constexpr (PH == 16) phase_moe2(p, 1, smem);
    else if constexpr (PH == 17) phase_final(p);
}
template <int PH, int END> struct PhaseSeq {
    static DI void run(const Params& p, char* smem, const XcdBarrier& bar) {
        run_phase<PH>(p, smem);
        if constexpr (PH + 1 < END) { xcd_barrier(bar); PhaseSeq<PH + 1, END>::run(p, smem, bar); }
    }
};
template <int BEG, int END>
__global__ void __launch_bounds__(NTH, 2) fwd_kernel(Params p) {
    extern __shared__ __attribute__((aligned(16))) char smem_raw[];
    char* smem = smem_raw + 16;
    if constexpr (END - BEG > 1) {
        if (tidx() == 0) *(uint4*)smem_raw = make_uint4(0u, 0u, 0u, 0u);
        __syncthreads();
        XcdBarrier bar = xcd_barrier_post((unsigned*)(p.ws + OFF_BAR), (volatile LAS unsigned*)smem_raw);
        PhaseSeq<BEG, END>::run(p, smem, bar);
    } else {
        run_phase<BEG>(p, smem);
    }
}

template <int BEG, int END> static void launch_range(const Params& p, int grid, hipStream_t stream) {
    (void)hipFuncSetAttribute((const void*)fwd_kernel<BEG, END>, hipFuncAttributeMaxDynamicSharedMemorySize, SMEM_BYTES + 16);
    hipLaunchKernelGGL((fwd_kernel<BEG, END>), dim3(grid), dim3(NTH), SMEM_BYTES + 16, stream, p);
}
#ifndef RUN_PHASES
#define RUN_PHASES NPHASE
#endif
#ifndef REPEAT_PHASE
#define REPEAT_PHASE -1
#endif
template <int PH> static void launch_each(const Params& p, int grid, hipStream_t stream) {
    launch_range<PH, PH + 1>(p, grid, stream);
    if (PH == REPEAT_PHASE) launch_range<PH, PH + 1>(p, grid, stream);
    if constexpr (PH + 1 < RUN_PHASES) launch_each<PH + 1>(p, grid, stream);
}

extern "C" void kernel_launch(void* const* d_in, const int* in_sizes, int n_in, void* d_out, int out_size, void* d_ws, size_t ws_size, hipStream_t stream) {
    Params p{};
    const float** f = (const float**)&p;
    for (int i = 0; i < 37; ++i) f[i] = (const float*)d_in[i];
    p.out = (float*)d_out;
    p.ws = (char*)d_ws;
    if (ws_size < WS_NEED || n_in < 37) return;
    static int grid = 0;
    if (!grid) {
        int dev = 0, cus = 0;
        (void)hipGetDevice(&dev);
        (void)hipDeviceGetAttribute(&cus, hipDeviceAttributeMultiprocessorCount, dev);
        grid = cus > 0 ? cus : 256;
    }
    (void)hipMemsetAsync(d_ws, 0, 32768, stream);
#if MEGA
    launch_range<0, NPHASE>(p, grid, stream);
#else
    launch_each<0>(p, grid, stream);
#endif
}
```

```cpp
#include <hip/hip_runtime.h>
#include <stdint.h>
#include <stdio.h>

#ifndef MEGA
#define MEGA 1
#endif

typedef unsigned short bf16_t;
typedef short bf16x8 __attribute__((ext_vector_type(8)));
typedef short s16x4 __attribute__((ext_vector_type(4)));
typedef float f32x2 __attribute__((ext_vector_type(2)));
typedef float f32x4 __attribute__((ext_vector_type(4)));
typedef float f32x16 __attribute__((ext_vector_type(16)));
typedef unsigned u32x2 __attribute__((ext_vector_type(2)));
typedef unsigned u32x4 __attribute__((ext_vector_type(4)));
typedef __bf16 bf16x2_t __attribute__((ext_vector_type(2)));
#define DI __device__ __forceinline__
__device__ __forceinline__ unsigned tidx() { unsigned t = threadIdx.x; asm volatile("" : "+v"(t)); return t; }

constexpr int DM = 1024, NBATCH = 2, SEQ = 16384, LCTX = 256, PTOT = SEQ + LCTX, TTOT = NBATCH * PTOT;
constexpr int NTH = 512, NWAVE = 8;
constexpr int QKV_N = 1536;
constexpr int NEXP = 16, CAP = TTOT * 2;
constexpr float RMS_EPS = 1e-6f, GN_EPS = 64e-5f;
constexpr float LOG2E = 1.4426950408889634f;

constexpr size_t MBy = 1u << 20;
constexpr size_t OFF_BAR   = 0;
constexpr size_t OFF_CNT   = 16384;
constexpr size_t OFF_MOD   = 32768;
constexpr size_t OFF_ROPE  = OFF_MOD + 2 * 3 * 6144 * 4;
constexpr size_t OFF_BONUS = 1 * MBy;
constexpr size_t OFF_BONUS2 = 6 * MBy;
constexpr size_t OFF_STOK  = 6 * MBy;
constexpr size_t OFF_SW    = 11 * MBy;
constexpr size_t OFF_XC    = 16 * MBy;
constexpr size_t OFF_WS    = 18 * MBy;
constexpr size_t OFF_MOEW  = 33 * MBy;
constexpr size_t OFF_H     = 129 * MBy;
constexpr size_t OFF_SCR   = 194 * MBy;
constexpr size_t SCR_SIZE  = 290 * MBy;
constexpr size_t WS_NEED   = OFF_SCR + SCR_SIZE;
constexpr size_t W_IN = 0, W_OUT = W_IN + 1536 * 1024, W_R = W_OUT + 1024 * 1024, W_K = W_R + 1024 * 1024, W_V = W_K + 1024 * 1024,
                 W_O = W_V + 1024 * 1024, W_W1 = W_O + 1024 * 1024, W_A1 = W_W1 + 128 * 1024, W_G1 = W_A1 + 128 * 1024,
                 W_W2 = W_G1 + 256 * 1024, W_A2 = W_W2 + 2 * 1024 * 64, W_G2 = W_A2 + 2 * 1024 * 64, W_END = W_G2 + 1024 * 192;
static_assert(W_END * 2 <= 15 * MBy, "small weights region");
constexpr size_t ROWB = (size_t)TTOT * 2048;
constexpr size_t S_Q = 0, S_K = S_Q + ROWB, S_VT = S_K + ROWB / 4, S_O = S_VT + ROWB / 4;
constexpr size_t S_HID = 0, S_Y = 140 * MBy;
constexpr size_t S_R = 0, S_KK = S_R + ROWB, S_V = S_KK + ROWB, S_LW = S_V + ROWB, S_LA = S_LW + ROWB / 8, S_LG = S_LA + ROWB / 8,
                 S_Y1 = 224 * MBy, S_XX = S_Y1, S_OR = S_R;
static_assert(S_O + ROWB <= SCR_SIZE, "scr");
static_assert(S_LG + (size_t)TTOT * 384 <= S_Y1, "scr2");
static_assert(S_Y1 + ROWB <= SCR_SIZE, "scr3");
static_assert(S_Y + 2 * ROWB <= SCR_SIZE, "scr4");
static_assert((size_t)(CAP / 256 + 16) * 256 * 2048 <= S_Y, "hid");
static_assert(OFF_H + ROWB <= OFF_SCR, "h");

struct Params {
    const float *x, *c, *ctx, *c_ctx, *ada_w, *ada_b, *norm_mix_g, *norm_ffn_g, *attn_w_in, *attn_w_out, *attn_sink, *attn_q_norm_g, *attn_k_norm_g,
        *rwkv_x_mix, *rwkv_w_r, *rwkv_w_k, *rwkv_w_v, *rwkv_w_o, *rwkv_decay_w0, *rwkv_decay_w1, *rwkv_decay_w2, *rwkv_iclr_a0, *rwkv_iclr_a1,
        *rwkv_iclr_a2, *rwkv_gate_g1, *rwkv_gate_g2, *rwkv_k_k, *rwkv_k_a, *rwkv_r_k, *rwkv_ln_g, *rwkv_ln_b, *router_w, *router_bias, *moe_w1,
        *moe_w3, *moe_w2, *final_norm_g;
    float* out;
    char* ws;
};

DI unsigned pk_bf16(float a, float b) { f32x2 v = {a, b}; bf16x2_t r = __builtin_convertvector(v, bf16x2_t); return __builtin_bit_cast(unsigned, r); }
DI float bf_lo(unsigned u) { return __uint_as_float(u << 16); }
DI float bf_hi(unsigned u) { return __uint_as_float(u & 0xffff0000u); }
DI float bf2f(bf16_t u) { return __uint_as_float(((unsigned)u) << 16); }
DI float wave_sum(float v) {
#pragma unroll
    for (int o = 32; o >= 1; o >>= 1) v += __shfl_xor(v, o);
    return v;
}
DI float sigmoidf_(float x) { return 1.0f / (1.0f + __expf(-x)); }
DI float siluf_(float x) { return x / (1.0f + __expf(-x)); }
DI float* xrow_ptr(const Params& p, int tok) {
    const int b = tok >= PTOT ? 1 : 0, pos = tok - b * PTOT;
    return pos < LCTX ? (float*)(p.ws + OFF_XC) + (size_t)(b * LCTX + pos) * DM : p.out + (size_t)(b * SEQ + pos - LCTX) * DM;
}
DI const float* xin_ptr(const Params& p, int tok) {
    const int b = tok >= PTOT ? 1 : 0, pos = tok - b * PTOT;
    return pos < LCTX ? p.ctx + (size_t)(b * LCTX + pos) * DM : p.x + (size_t)(b * SEQ + pos - LCTX) * DM;
}
DI const float* mod_ptr(const Params& p, int layer, int tok, int which) {
    const int b = tok >= PTOT ? 1 : 0, pos = tok - b * PTOT;
    const int w = pos < LCTX ? 2 : b;
    return (const float*)(p.ws + OFF_MOD) + (size_t)((layer * 3 + w) * 6 + which) * DM;
}

#define XB_TMO      128
#define XB_XCNT(j)  (256  + 64 * (j))
#define XB_XSUB(j)  (1280 + 64 * (j))
#define XB_XGEN(j)  (2304 + 64 * (j))
#define XB_TOP      3328
#define XB_TOPGEN   3392
#define XCD_BAR_WORDS 3456
#define XB_SPIN_CAP (1u << 18)
#define LAS __attribute__((address_space(3)))
DI unsigned xb_ld(unsigned* p)              { return __hip_atomic_load(p, __ATOMIC_RELAXED, __HIP_MEMORY_SCOPE_AGENT); }
DI unsigned xb_add(unsigned* p, unsigned v) { return __hip_atomic_fetch_add(p, v, __ATOMIC_RELAXED, __HIP_MEMORY_SCOPE_AGENT); }
DI unsigned xb_xcc_id() { return (unsigned)__builtin_amdgcn_s_getreg((3 << 11) | 20) & 0xFu; }
#define XB_SPIN(cond, bar) do { unsigned _sp = 0; while (cond) { __builtin_amdgcn_s_sleep(1); \
    if ((++_sp & 255u) == 0u) { if (xb_ld(&(bar)[XB_TMO])) break; if (_sp > XB_SPIN_CAP) { atomicAdd(&(bar)[XB_TMO], 1u); break; } } } } while (0)
struct XcdBarrier { unsigned* bar; unsigned x; volatile LAS unsigned* st; };
DI XcdBarrier xcd_barrier_post(unsigned* bar, volatile LAS unsigned* st) {
    XcdBarrier b; b.bar = bar; b.x = xb_xcc_id(); b.st = st;
    if (tidx() == 0) (void)xb_add(&bar[XB_XCNT(b.x)], 1u);
    return b;
}
DI void xcd_barrier_complete(unsigned* bar, unsigned x, unsigned& nloc, unsigned& nx) {
    const unsigned G = gridDim.x * gridDim.y * gridDim.z;
    unsigned sum, cnt, mine, sp = 0u;
    for (;;) {
        sum = 0u; cnt = 0u; mine = 0u;
#pragma unroll
        for (unsigned j = 0; j < 16; ++j) { const unsigned c = xb_ld(&bar[XB_XCNT(j)]); sum += c; cnt += (c > 0u) ? 1u : 0u; mine = (j == x) ? c : mine; }
        if (sum == G) break;
        __builtin_amdgcn_s_sleep(1);
        if ((++sp & 255u) == 0u) { if (xb_ld(&bar[XB_TMO])) break; if (sp > XB_SPIN_CAP) { atomicAdd(&bar[XB_TMO], 1u); break; } }
    }
    nloc = mine > 0u ? mine : 1u; nx = cnt > 0u ? cnt : 1u;
}
DI void xcd_barrier(const XcdBarrier& b) {
    asm volatile("s_waitcnt vmcnt(0)" ::: "memory");
    __syncthreads();
    if (tidx() == 0) {
        unsigned* bar = b.bar;
        __builtin_amdgcn_s_waitcnt(0);
        unsigned nloc = b.st[0], nx = b.st[1];
        if (nloc == 0u) { xcd_barrier_complete(bar, b.x, nloc, nx); b.st[0] = nloc; b.st[1] = nx; }
        const unsigned old = xb_add(&bar[XB_XSUB(b.x)], 1u);
        const unsigned gen = old / nloc;
        if (old + 1u == (gen + 1u) * nloc) {
            __builtin_amdgcn_fence(__ATOMIC_RELEASE, "agent");
            asm volatile("s_waitcnt vmcnt(0)" ::: "memory");
            const unsigned og = xb_add(&bar[XB_TOP], 1u);
            const unsigned tg = og / nx;
            if (og + 1u == (tg + 1u) * nx) xb_add(&bar[XB_TOPGEN], 1u);
            else XB_SPIN(xb_ld(&bar[XB_TOPGEN]) == tg, bar);
            __builtin_amdgcn_fence(__ATOMIC_ACQUIRE, "agent");
            xb_add(&bar[XB_XGEN(b.x)], 1u);
            asm volatile("s_waitcnt vmcnt(0)" ::: "memory");
        } else {
            XB_SPIN(xb_ld(&bar[XB_XGEN(b.x)]) == gen, bar);
            __builtin_amdgcn_fence(__ATOMIC_ACQUIRE, "agent");
            asm volatile("s_waitcnt vmcnt(0)" ::: "memory");
        }
    }
    __syncthreads();
}

DI void cvt_tile(const float* src, int ld, int kvalid, bool colvalid, bf16_t* dst, int dld, float* tile  ) {
    const int t = tidx();
    {
        const int k = t >> 3, c4 = (t & 7) * 4;
        f32x4 v = {0.f, 0.f, 0.f, 0.f};
        if (colvalid && k < kvalid) v = *(const f32x4*)(src + (size_t)k * ld + c4);
        tile[k * 33 + c4 + 0] = v[0]; tile[k * 33 + c4 + 1] = v[1]; tile[k * 33 + c4 + 2] = v[2]; tile[k * 33 + c4 + 3] = v[3];
    }
    __syncthreads();
    {
        const int n = t >> 4, kc = (t & 15) * 4;
        u32x2 w;
        w[0] = pk_bf16(tile[(kc + 0) * 33 + n], tile[(kc + 1) * 33 + n]);
        w[1] = pk_bf16(tile[(kc + 2) * 33 + n], tile[(kc + 3) * 33 + n]);
        *(u32x2*)(dst + (size_t)n * dld + kc) = w;
    }
    __syncthreads();
}
constexpr int CV_SMALL_UNITS = 768 + 512 * 5 + 64 + 64 + 128 + 64 + 64 + 96;
DI void cvt_small_unit(const Params& p, int u, float* tile) {
    bf16_t* wsm = (bf16_t*)(p.ws + OFF_WS);
    if (u < 768) { const int run = u >> 4, kt = u & 15; cvt_tile(p.attn_w_in + (size_t)kt * 64 * 1536 + run * 32, 1536, 64, true, wsm + W_IN + (size_t)run * 32 * 1024 + kt * 64, 1024, tile); return; }
    u -= 768;
    if (u < 512 * 5) {
        const int j = u >> 9, v = u & 511, run = v >> 4, kt = v & 15;
        const float* src = j == 0 ? p.attn_w_out : j == 1 ? p.rwkv_w_r : j == 2 ? p.rwkv_w_k : j == 3 ? p.rwkv_w_v : p.rwkv_w_o;
        const size_t dofs = j == 0 ? W_OUT : j == 1 ? W_R : j == 2 ? W_K : j == 3 ? W_V : W_O;
        cvt_tile(src + (size_t)kt * 64 * 1024 + run * 32, 1024, 64, true, wsm + dofs + (size_t)run * 32 * 1024 + kt * 64, 1024, tile); return;
    }
    u -= 512 * 5;
    if (u < 128) {
        const int j = u >> 6, v = u & 63, run = v >> 4, kt = v & 15, d = run >> 1, co = (run & 1) * 32;
        const float* src = (j == 0 ? p.rwkv_decay_w1 : p.rwkv_iclr_a1) + (size_t)d * 1024 * 64;
        cvt_tile(src + (size_t)kt * 64 * 64 + co, 64, 64, true, wsm + (j == 0 ? W_W1 : W_A1) + (size_t)run * 32 * 1024 + kt * 64, 1024, tile); return;
    }
    u -= 128;
    if (u < 128) {
        const int run = u >> 4, kt = u & 15;
        cvt_tile(p.rwkv_gate_g1 + (size_t)kt * 64 * 160 + run * 32, 160, 64, run < 5, wsm + W_G1 + (size_t)run * 32 * 1024 + kt * 64, 1024, tile); return;
    }
    u -= 128;
    if (u < 128) {
        const int j = u >> 6, v = u & 63, d = v >> 5, run = v & 31;
        const float* src = (j == 0 ? p.rwkv_decay_w2 : p.rwkv_iclr_a2) + (size_t)d * 64 * 1024;
        cvt_tile(src + run * 32, 1024, 64, true, wsm + (j == 0 ? W_W2 : W_A2) + (size_t)d * 1024 * 64 + (size_t)run * 32 * 64, 64, tile); return;
    }
    u -= 128;
    {
        const int run = u / 3, kt = u % 3;
        const int kvalid = 160 - kt * 64 > 64 ? 64 : (160 - kt * 64 < 0 ? 0 : 160 - kt * 64);
        cvt_tile(p.rwkv_gate_g2 + (size_t)kt * 64 * 1024 + run * 32, 1024, kvalid, true, wsm + W_G2 + (size_t)run * 32 * 192 + kt * 64, 192, tile);
    }
}
constexpr int CV_MOE_UNITS = 16 * (1024 + 512);
DI void cvt_moe_unit(const Params& p, int layer, int u, float* tile) {
    bf16_t* w13 = (bf16_t*)(p.ws + OFF_MOEW);
    bf16_t* w2t = w13 + (size_t)16 * 2048 * 1024;
    const int e = u / 1536, v = u % 1536;
    const size_t eo = (size_t)(layer * 16 + e) * 1024 * 1024;
    if (v < 1024) {
        const int run = v >> 4, kt = v & 15, g = run >> 1;
        const float* src = ((run & 1) ? p.moe_w3 : p.moe_w1) + eo;
        cvt_tile(src + (size_t)kt * 64 * 1024 + g * 32, 1024, 64, true, w13 + (size_t)e * 2048 * 1024 + (size_t)run * 32 * 1024 + kt * 64, 1024, tile);
    } else {
        const int w = v - 1024, run = w >> 4, kt = w & 15;
        cvt_tile(p.moe_w2 + eo + (size_t)kt * 64 * 1024 + run * 32, 1024, 64, true, w2t + (size_t)e * 1024 * 1024 + (size_t)run * 32 * 1024 + kt * 64, 1024, tile);
    }
}
DI void adaln_unit(const Params& p, int u, float* sm) {
    const int l = u / 96, n0 = (u % 96) * 64, t = tidx();
    float* sv = sm;
    float* red = sm + 3 * 1024;
    for (int i = t; i < 3 * 1024; i += NTH) { const int w = i >> 10, k = i & 1023; const float c = w < 2 ? p.c[w * 1024 + k] : p.c_ctx[k]; sv[i] = siluf_(c); }
    __syncthreads();
    const int kg = t >> 4, cl = t & 15;
    f32x4 a0 = {0, 0, 0, 0}, a1 = a0, a2 = a0;
    const float* W = p.ada_w + (size_t)l * 1024 * 6144 + n0 + cl * 4;
#pragma unroll 8
    for (int i = 0; i < 32; ++i) {
        const int k = kg + 32 * i;
        const f32x4 w = *(const f32x4*)(W + (size_t)k * 6144);
        a0 += w * sv[k]; a1 += w * sv[1024 + k]; a2 += w * sv[2048 + k];
    }
#pragma unroll
    for (int j = 0; j < 4; ++j) { red[kg * 192 + 0 * 64 + cl * 4 + j] = a0[j]; red[kg * 192 + 1 * 64 + cl * 4 + j] = a1[j]; red[kg * 192 + 2 * 64 + cl * 4 + j] = a2[j]; }
    __syncthreads();
    if (t < 192) {
        float s = 0.f;
        for (int g = 0; g < 32; ++g) s += red[g * 192 + t];
        const int w = t >> 6, n = n0 + (t & 63);
        ((float*)(p.ws + OFF_MOD))[(size_t)(l * 3 + w) * 6144 + n] = s + p.ada_b[l * 6144 + n];
    }
    __syncthreads();
}
DI void rope_unit(const Params& p, int u) {
    const int id = u * NTH + tidx();
    if (id < 320 * 16) {
        const int pi = id >> 4, f = id & 15;
        const float inv = exp2f(-(float)f * (13.287712379549449f / 16.0f));
        const float val = pi < 256 ? (float)pi : (float)(pi - 256);
        const float ang = val * inv;
        const double a = (double)ang;
        const double k = __builtin_rint(a * 0.15915494309189535);
        const float r = (float)(a - k * 6.283185307179586);
        f32x2 cs = {__cosf(r), __sinf(r)};
        ((f32x2*)(p.ws + OFF_ROPE))[id] = cs;
    }
}
DI void phase_prologue(const Params& p, char* smem) {
    float* sm = (float*)smem;
    const int nconv = CV_SMALL_UNITS + CV_MOE_UNITS;
    const int total = nconv + 192 + 10;
    for (int u = blockIdx.x; u < total; u += gridDim.x) {
        if (u < CV_SMALL_UNITS) cvt_small_unit(p, u, sm);
        else if (u < nconv) cvt_moe_unit(p, 0, u - CV_SMALL_UNITS, sm);
        else if (u < nconv + 192) adaln_unit(p, u - nconv, sm);
        else rope_unit(p, u - nconv - 192);
    }
}

DI void row_load(const float* src, f32x4 (&v)[4], int lane) {
#pragma unroll
    for (int i = 0; i < 4; ++i) v[i] = ((const f32x4*)src)[lane + 64 * i];
}
DI float row_rstd(const f32x4 (&v)[4]) {
    float ss = 0.f;
#pragma unroll
    for (int i = 0; i < 4; ++i) ss += v[i][0] * v[i][0] + v[i][1] * v[i][1] + v[i][2] * v[i][2] + v[i][3] * v[i][3];
    ss = wave_sum(ss);
    return rsqrtf(ss * (1.0f / DM) + RMS_EPS);
}
DI void row_norm_mod(const f32x4 (&v)[4], float rstd, const float* g, const float* shift, const float* scale, f32x4 (&h)[4], int lane) {
#pragma unroll
    for (int i = 0; i < 4; ++i) {
        const int c = (lane + 64 * i) * 4;
        const f32x4 g4 = *(const f32x4*)(g + c), sh = *(const f32x4*)(shift + c), sc = *(const f32x4*)(scale + c);
        h[i] = (v[i] * rstd * g4) * (1.0f + sc) + sh;
    }
}
DI void row_store_bf16(bf16_t* dst, const f32x4 (&h)[4], int lane) {
#pragma unroll
    for (int i = 0; i < 4; ++i) { u32x2 w; w[0] = pk_bf16(h[i][0], h[i][1]); w[1] = pk_bf16(h[i][2], h[i][3]); *(u32x2*)(dst + (lane + 64 * i) * 4) = w; }
}
DI void row_load_bf16(const bf16_t* src, f32x4 (&v)[4], int lane) {
#pragma unroll
    for (int i = 0; i < 4; ++i) { const u32x2 w = *(const u32x2*)(src + (lane + 64 * i) * 4); v[i][0] = bf_lo(w[0]); v[i][1] = bf_hi(w[0]); v[i][2] = bf_lo(w[1]); v[i][3] = bf_hi(w[1]); }
}

DI void phase_norm0(const Params& p) {
    const int lane = tidx() & 63, gw = blockIdx.x * NWAVE + (tidx() >> 6), nw = gridDim.x * NWAVE;
    bf16_t* H = (bf16_t*)(p.ws + OFF_H);
    for (int tok = gw; tok < TTOT; tok += nw) {
        f32x4 v[4], h[4];
        row_load(xin_ptr(p, tok), v, lane);
        const float rstd = row_rstd(v);
        row_norm_mod(v, rstd, p.norm_mix_g, mod_ptr(p, 0, tok, 0), mod_ptr(p, 0, tok, 1), h, lane);
        row_store_bf16(H + (size_t)tok * DM, h, lane);
    }
}

DI void route_row(const Params& p, const float (&lg)[16], int& e1, int& e2, float& g1, float& g2) {
    float mx = lg[0];
#pragma unroll
    for (int e = 1; e < 16; ++e) mx = fmaxf(mx, lg[e]);
    float pr[16], sum = 0.f;
#pragma unroll
    for (int e = 0; e < 16; ++e) { pr[e] = __expf(lg[e] - mx); sum += pr[e]; }
    const float inv = 1.0f / sum;
    float sel[16];
#pragma unroll
    for (int e = 0; e < 16; ++e) { pr[e] *= inv; sel[e] = pr[e] + p.router_bias[e]; }
    float best = -1e30f; int gi = 0;
#pragma unroll
    for (int g = 0; g < 4; ++g) {
        float m1 = -1e30f, m2 = -1e30f;
#pragma unroll
        for (int j = 0; j < 4; ++j) { const float s = sel[g * 4 + j]; if (s > m1) { m2 = m1; m1 = s; } else if (s > m2) m2 = s; }
        const float gs = m1 + m2;
        if (gs > best) { best = gs; gi = g; }
    }
    float s4[4], p4[4];
#pragma unroll
    for (int j = 0; j < 4; ++j) {
        s4[j] = gi == 0 ? sel[j] : gi == 1 ? sel[4 + j] : gi == 2 ? sel[8 + j] : sel[12 + j];
        p4[j] = gi == 0 ? pr[j] : gi == 1 ? pr[4 + j] : gi == 2 ? pr[8 + j] : pr[12 + j];
    }
    int i1 = 0; float b1 = s4[0];
#pragma unroll
    for (int j = 1; j < 4; ++j) if (s4[j] > b1) { b1 = s4[j]; i1 = j; }
    int i2 = i1 == 0 ? 1 : 0; float b2 = -3e38f;
#pragma unroll
    for (int j = 0; j < 4; ++j) if (j != i1 && s4[j] > b2) { b2 = s4[j]; i2 = j; }
    const float w1 = i1 == 0 ? p4[0] : i1 == 1 ? p4[1] : i1 == 2 ? p4[2] : p4[3];
    const float w2 = i2 == 0 ? p4[0] : i2 == 1 ? p4[1] : i2 == 2 ? p4[2] : p4[3];
    const float ws = 1.0f / (w1 + w2);
    e1 = gi * 4 + i1; e2 = gi * 4 + i2; g1 = w1 * ws; g2 = w2 * ws;
}
DI void phase_ffn_norm_route(const Params& p, int layer, char* smem) {
    const int lane = tidx() & 63, gw = blockIdx.x * NWAVE + (tidx() >> 6), nw = gridDim.x * NWAVE;
    float* rw = (float*)smem;
    for (int i = tidx(); i < 1024 * 16; i += NTH) rw[(i & 15) * 1024 + (i >> 4)] = p.router_w[i];
    __syncthreads();
    bf16_t* H = (bf16_t*)(p.ws + OFF_H);
    int* lcnt = (int*)(smem + 65536);
    if (tidx() < 32) lcnt[tidx()] = 0;
    int my_tok = -1, my_e1 = 0, my_e2 = 0, it = 0; float my_g1 = 0.f, my_g2 = 0.f;
    for (int tok = gw; tok < TTOT; tok += nw) {
        const int pos = tok >= PTOT ? tok - PTOT : tok;
        if (layer == 1 && pos < LCTX) continue;
        f32x4 v[4], h[4];
        row_load(xrow_ptr(p, tok), v, lane);
        const float rstd = row_rstd(v);
        row_norm_mod(v, rstd, p.norm_ffn_g + layer * DM, mod_ptr(p, layer, tok, 3), mod_ptr(p, layer, tok, 4), h, lane);
        row_store_bf16(H + (size_t)tok * DM, h, lane);
        float lg[16];
#pragma unroll
        for (int e = 0; e < 16; ++e) lg[e] = 0.f;
#pragma unroll
        for (int i = 0; i < 4; ++i)
#pragma unroll
            for (int e = 0; e < 16; ++e) {
                const f32x4 w = *(const f32x4*)(rw + e * 1024 + (lane + 64 * i) * 4);
                lg[e] += h[i][0] * w[0] + h[i][1] * w[1] + h[i][2] * w[2] + h[i][3] * w[3];
                if ((e & 3) == 3) asm volatile("" ::: "memory");
            }
#pragma unroll
        for (int e = 0; e < 16; ++e) lg[e] = wave_sum(lg[e]);
        int e1, e2; float g1, g2;
        route_row(p, lg, e1, e2, g1, g2);
        if (lane == it) { my_tok = tok; my_e1 = e1; my_e2 = e2; my_g1 = g1; my_g2 = g2; }
        ++it;
    }
    __syncthreads();
    int r1 = 0, r2 = 0;
    if (my_tok >= 0) { r1 = atomicAdd(&lcnt[my_e1], 1); r2 = atomicAdd(&lcnt[my_e2], 1); }
    __syncthreads();
    if (tidx() < 16) { const int n = lcnt[tidx()]; lcnt[16 + tidx()] = n ? atomicAdd((int*)(p.ws + OFF_CNT) + layer * 16 + tidx(), n) : 0; }
    __syncthreads();
    if (my_tok >= 0) {
        int* stok = (int*)(p.ws + OFF_STOK);
        float* sw = (float*)(p.ws + OFF_SW);
        const size_t s1 = (size_t)my_e1 * CAP + lcnt[16 + my_e1] + r1, s2 = (size_t)my_e2 * CAP + lcnt[16 + my_e2] + r2;
        stok[s1] = my_tok * 2 + 0; sw[s1] = my_g1;
        stok[s2] = my_tok * 2 + 1; sw[s2] = my_g2;
    }
    __syncthreads();
}

DI void combine_row(const Params& p, int layer, int tok, f32x4 (&v)[4], int lane) {
    const bf16_t* Y = (const bf16_t*)(p.ws + OFF_SCR + S_Y) + (size_t)tok * 2 * DM;
    const float* g5 = mod_ptr(p, layer, tok, 5);
    f32x4 y0[4], y1[4];
    row_load(xrow_ptr(p, tok), v, lane);
    row_load_bf16(Y, y0, lane); row_load_bf16(Y + DM, y1, lane);
#pragma unroll
    for (int i = 0; i < 4; ++i) { const f32x4 g = *(const f32x4*)(g5 + (lane + 64 * i) * 4); v[i] += g * (y0[i] + y1[i]); }
}
DI void phase_combine_l0(const Params& p, char* smem) {
    const int lane = tidx() & 63, gw = blockIdx.x * NWAVE + (tidx() >> 6), nw = gridDim.x * NWAVE;
    bf16_t* H = (bf16_t*)(p.ws + OFF_H);
    for (int tok = gw; tok < TTOT; tok += nw) {
        f32x4 v[4], h[4];
        combine_row(p, 0, tok, v, lane);
        float* X = xrow_ptr(p, tok);
#pragma unroll
        for (int i = 0; i < 4; ++i) ((f32x4*)X)[lane + 64 * i] = v[i];
        const float rstd = row_rstd(v);
        row_norm_mod(v, rstd, p.norm_mix_g + DM, mod_ptr(p, 1, tok, 0), mod_ptr(p, 1, tok, 1), h, lane);
        row_store_bf16(H + (size_t)tok * DM, h, lane);
    }
    __syncthreads();
    for (int u = blockIdx.x; u < CV_MOE_UNITS; u += gridDim.x) cvt_moe_unit(p, 1, u, (float*)smem);
}
DI void phase_xx(const Params& p) {
    const int lane = tidx() & 63, gw = blockIdx.x * NWAVE + (tidx() >> 6), nw = gridDim.x * NWAVE;
    const bf16_t* H = (const bf16_t*)(p.ws + OFF_H);
    bf16_t* XX = (bf16_t*)(p.ws + OFF_SCR + S_XX);
    for (int tok = gw; tok < TTOT; tok += nw) {
        const int pos = tok >= PTOT ? tok - PTOT : tok;
        const bool first = pos == 0 || pos == LCTX, last = pos == LCTX - 1 || pos == PTOT - 1;
        f32x4 hc[4], hp[4], hn[4], xx[4];
        row_load_bf16(H + (size_t)tok * DM, hc, lane);
        row_load_bf16(H + (size_t)(first ? tok : tok - 1) * DM, hp, lane);
        row_load_bf16(H + (size_t)(last ? tok : tok + 1) * DM, hn, lane);
#pragma unroll
        for (int i = 0; i < 4; ++i) {
            const f32x4 a = first ? (f32x4){0, 0, 0, 0} : hp[i], b = last ? (f32x4){0, 0, 0, 0} : hn[i];
            xx[i] = 0.5f * (a + b) - hc[i];
        }
        row_store_bf16(XX + (size_t)tok * DM, xx, lane);
    }
}
DI void phase_final(const Params& p) {
    const int lane = tidx() & 63, gw = blockIdx.x * NWAVE + (tidx() >> 6), nw = gridDim.x * NWAVE;
    for (int r = gw; r < NBATCH * SEQ; r += nw) {
        const int b = r / SEQ, tok = b * PTOT + LCTX + (r - b * SEQ);
        f32x4 v[4];
        combine_row(p, 1, tok, v, lane);
        const float rstd = row_rstd(v);
        float* O = p.out + (size_t)r * DM;
#pragma unroll
        for (int i = 0; i < 4; ++i) { const f32x4 g = *(const f32x4*)(p.final_norm_g + (lane + 64 * i) * 4); ((f32x4*)O)[lane + 64 * i] = v[i] * rstd * g; }
    }
}

constexpr int LDSROW = 72;
constexpr int GEMM_SMEM = 2 * (256 + 256) * LDSROW * 2;
template <int NH, class AL, class EPI>
DI void gemm_tile(AL& al, const bf16_t* __restrict__ Bt, int ldb, int nk, EPI& epi, char* smem) {
    const int t = tidx(), lane = t & 63, wid = t >> 6, wr = wid >> 1, wc = wid & 1, fr = lane & 15, fq = lane >> 4;
    constexpr int BR = 128 * NH;
    bf16_t* sA = (bf16_t*)smem;
    bf16_t* sB = sA + 2 * 256 * LDSROW;
    f32x4 acc[NH][4][4];
#pragma unroll
    for (int h = 0; h < NH; ++h)
#pragma unroll
        for (int m = 0; m < 4; ++m)
#pragma unroll
            for (int n = 0; n < 4; ++n) acc[h][m][n] = (f32x4){0.f, 0.f, 0.f, 0.f};
    const int lr = t >> 3, lc = (t & 7) * 8;
    typename AL::Raw ra[4]; u32x4 rb[2 * NH];
#pragma unroll
    for (int i = 0; i < 4; ++i) al.issue(ra[i], lr + 64 * i, lc, i);
#pragma unroll
    for (int i = 0; i < 2 * NH; ++i) rb[i] = *(const u32x4*)(Bt + (size_t)(lr + 64 * i) * ldb + lc);
#pragma unroll
    for (int i = 0; i < 4; ++i) *(u32x4*)(sA + (lr + 64 * i) * LDSROW + lc) = al.finish(ra[i], lc);
#pragma unroll
    for (int i = 0; i < 2 * NH; ++i) *(u32x4*)(sB + (lr + 64 * i) * LDSROW + lc) = rb[i];
    __syncthreads();
    for (int kt = 0; kt < nk; ++kt) {
        const int cur = kt & 1;
        const bool more = kt + 1 < nk;
        if (more) {
#pragma unroll
            for (int i = 0; i < 4; ++i) al.issue(ra[i], lr + 64 * i, (kt + 1) * 64 + lc, i);
#pragma unroll
            for (int i = 0; i < 2 * NH; ++i) rb[i] = *(const u32x4*)(Bt + (size_t)(lr + 64 * i) * ldb + (kt + 1) * 64 + lc);
        }
        __builtin_amdgcn_sched_barrier(0);
        const bf16_t* cA = sA + cur * 256 * LDSROW + (wr * 64 + fr) * LDSROW + fq * 8;
        const bf16_t* cB = sB + cur * BR * LDSROW + (wc * 64 + fr) * LDSROW + fq * 8;
#pragma unroll
        for (int kk = 0; kk < 2; ++kk) {
            bf16x8 af[4];
#pragma unroll
            for (int m = 0; m < 4; ++m) af[m] = *(const bf16x8*)(cA + m * 16 * LDSROW + kk * 32);
#pragma unroll
            for (int h = 0; h < NH; ++h) {
                bf16x8 bfr[4];
#pragma unroll
                for (int n = 0; n < 4; ++n) bfr[n] = *(const bf16x8*)(cB + (h * 128 + n * 16) * LDSROW + kk * 32);
#pragma unroll
                for (int m = 0; m < 4; ++m)
#pragma unroll
                    for (int n = 0; n < 4; ++n) acc[h][m][n] = __builtin_amdgcn_mfma_f32_16x16x32_bf16(bfr[n], af[m], acc[h][m][n], 0, 0, 0);
            }
            if (kk == AL::STORE_AT && more) {
                bf16_t* nA = sA + (cur ^ 1) * 256 * LDSROW;
                bf16_t* nB = sB + (cur ^ 1) * BR * LDSROW;
#pragma unroll
                for (int i = 0; i < 4; ++i) *(u32x4*)(nA + (lr + 64 * i) * LDSROW + lc) = al.finish(ra[i], (kt + 1) * 64 + lc);
#pragma unroll
                for (int i = 0; i < 2 * NH; ++i) *(u32x4*)(nB + (lr + 64 * i) * LDSROW + lc) = rb[i];
            }
        }
        __syncthreads();
    }
#pragma unroll
    for (int h = 0; h < NH; ++h) epi(acc[h], wr * 64, h * 128 + wc * 64, fr, fq);
}
constexpr int G8_HB = 128 * 64 * 2;
constexpr int G8_SMEM = 8 * G8_HB;
DI void g8_rc(int& R0, int& C0) {
    const int tz = tidx(), st = tz >> 6, sb = (tz & 63) * 16, swz = sb ^ (((sb >> 9) & 1) << 5);
    R0 = (st >> 1) * 16 + (swz >> 6); C0 = (st & 1) * 32 + ((swz & 63) >> 1);
}
DI int g8_bcol(int h, int rho) { return (rho >> 5) * 64 + h * 32 + (rho & 31); }
struct G8Rows {
    const bf16_t* base; unsigned o0, d1, d2;
    DI const bf16_t* ptr(int h, int i, int kt) const { return (base + (size_t)(h * d2 + i * d1 + kt * 64)) + o0; }
};
struct G8Gather {
    const bf16_t* base; unsigned o[4];
    DI const bf16_t* ptr(int h, int i, int kt) const { return (base + kt * 64) + o[h * 2 + i]; }
};
DI G8Rows g8_arows(const bf16_t* A, int lda) { int R0, C0; g8_rc(R0, C0); return G8Rows{A, (unsigned)(R0 * lda + C0), (unsigned)(64 * lda), (unsigned)(128 * lda)}; }
DI G8Rows g8_brows(const bf16_t* Bt, int ldb) { int R0, C0; g8_rc(R0, C0); return G8Rows{Bt, (unsigned)(g8_bcol(0, R0) * ldb + C0), (unsigned)(128 * ldb), (unsigned)(32 * ldb)}; }
template <class AS, class BS, class EPI>
DI void gemm8_tile(const AS& as, const BS& bs, int nt  , EPI& epi, char* smem) {
    int tz = tidx();
    int wid = tz >> 6, lane = tz & 63, wr = wid >> 2, wc = wid & 3, fr = lane & 15, fq = lane >> 4;
    int loff = ((fr * 64 + fq * 16) ^ ((fr >> 3) << 5));
#define G8_SA(b, h) (smem + ((b) * 2 + (h)) * G8_HB)
#define G8_SB(b, h) (smem + (4 + (b) * 2 + (h)) * G8_HB)
#define G8_STAGE(P, src, h, kt) do { \
        __builtin_amdgcn_global_load_lds((const unsigned*)(src).ptr(h, 0, kt), (LAS unsigned*)((P) + tz * 16), 16, 0, 0); \
        __builtin_amdgcn_global_load_lds((const unsigned*)(src).ptr(h, 1, kt), (LAS unsigned*)((P) + tz * 16 + 8192), 16, 0, 0); } while (0)
#define G8_STA(b, h, kt) G8_STAGE(G8_SA(b, h), as, h, kt)
#define G8_STB(b, h, kt) G8_STAGE(G8_SB(b, h), bs, h, kt)
#define G8_LDA(dst, b, h) _Pragma("unroll") for (int m = 0; m < 4; ++m) _Pragma("unroll") for (int k = 0; k < 2; ++k) \
        dst[m][k] = *(const bf16x8*)(G8_SA(b, h) + (wr * 8 + m * 2 + k) * 1024 + loff)
#define G8_LDB(dst, b, h) _Pragma("unroll") for (int n = 0; n < 2; ++n) _Pragma("unroll") for (int k = 0; k < 2; ++k) \
        dst[n][k] = *(const bf16x8*)(G8_SB(b, h) + (wc * 4 + n * 2 + k) * 1024 + loff)
#define G8_MMA(ai, bj, Bx) do { __builtin_amdgcn_s_setprio(1); \
        _Pragma("unroll") for (int m = 0; m < 4; ++m) _Pragma("unroll") for (int n = 0; n < 2; ++n) _Pragma("unroll") for (int k = 0; k < 2; ++k) \
            acc[ai][bj][m][n] = __builtin_amdgcn_mfma_f32_16x16x32_bf16(Bx[n][k], At[m][k], acc[ai][bj][m][n], 0, 0, 0); \
        __builtin_amdgcn_s_setprio(0); } while (0)
#define G8_WV(n) asm volatile("s_waitcnt vmcnt(" #n ")" ::: "memory")
#define G8_WL(n) asm volatile("s_waitcnt lgkmcnt(" #n ")" ::: "memory")
#define G8_BAR __builtin_amdgcn_s_barrier()
#define G8_SCHED __builtin_amdgcn_sched_barrier(0)
    f32x4 acc[2][2][4][2];
#pragma unroll
    for (int a = 0; a < 2; ++a)
#pragma unroll
        for (int b = 0; b < 2; ++b)
#pragma unroll
            for (int m = 0; m < 4; ++m)
#pragma unroll
                for (int n = 0; n < 2; ++n) acc[a][b][m][n] = (f32x4){0.f, 0.f, 0.f, 0.f};
    bf16x8 At[4][2], B0[2][2], B1[2][2];
    G8_STB(0, 0, 0); G8_STA(0, 0, 0); G8_STB(0, 1, 0); G8_STA(0, 1, 0);
    if (wr == 1) G8_BAR;
    G8_WV(4); G8_BAR;
    G8_STB(1, 0, 1); G8_STA(1, 0, 1); G8_STB(1, 1, 1);
    G8_WV(6); G8_BAR;
    for (int t = 0; t < nt - 2; t += 2) {
        G8_LDB(B0, 0, 0); G8_SCHED; G8_LDA(At, 0, 0); G8_STA(1, 1, t + 1);
        G8_WL(8); G8_BAR; G8_WL(0); G8_MMA(0, 0, B0); G8_BAR; G8_SCHED;
        G8_LDB(B1, 0, 1); G8_STB(0, 0, t + 2);
        G8_BAR; G8_WL(0); G8_MMA(0, 1, B1); G8_BAR;
        G8_LDA(At, 0, 1); G8_STA(0, 0, t + 2);
        G8_BAR; G8_WL(0); G8_MMA(1, 0, B0); G8_BAR; G8_SCHED;
        G8_STB(0, 1, t + 2);
        G8_WV(6); G8_BAR; G8_MMA(1, 1, B1); G8_BAR;
        G8_LDB(B0, 1, 0); G8_SCHED; G8_LDA(At, 1, 0); G8_STA(0, 1, t + 2);
        G8_WL(8); G8_BAR; G8_WL(0); G8_MMA(0, 0, B0); G8_BAR; G8_SCHED;
        G8_LDB(B1, 1, 1); G8_STB(1, 0, t + 3);
        G8_BAR; G8_WL(0); G8_MMA(0, 1, B1); G8_BAR;
        G8_LDA(At, 1, 1); G8_STA(1, 0, t + 3);
        G8_BAR; G8_WL(0); G8_MMA(1, 0, B0); G8_BAR; G8_SCHED;
        G8_STB(1, 1, t + 3);
        G8_WV(6); G8_BAR; G8_MMA(1, 1, B1); G8_BAR;
    }
    tz = tidx(); wid = tz >> 6; lane = tz & 63; wr = wid >> 2; wc = wid & 3; fr = lane & 15; fq = lane >> 4;
    loff = ((fr * 64 + fq * 16) ^ ((fr >> 3) << 5));
    {
        G8_LDB(B0, 0, 0); G8_WV(0); G8_LDA(At, 0, 0); G8_STA(1, 1, nt - 1);
        G8_BAR; G8_WL(0); G8_MMA(0, 0, B0); G8_BAR;
        G8_LDB(B1, 0, 1); G8_BAR; G8_WL(0); G8_MMA(0, 1, B1); G8_BAR;
        G8_LDA(At, 0, 1); G8_WV(4); G8_BAR; G8_WL(0); G8_MMA(1, 0, B0); G8_MMA(1, 1, B1); G8_BAR;
    }
    {
        G8_LDB(B0, 1, 0); G8_LDA(At, 1, 0); G8_WV(2); G8_BAR; G8_WL(0); G8_MMA(0, 0, B0); G8_BAR;
        G8_LDB(B1, 1, 1); G8_WV(0); G8_BAR; G8_WL(0); G8_MMA(0, 1, B1); G8_BAR;
        G8_LDA(At, 1, 1); G8_BAR; G8_WL(0); G8_MMA(1, 0, B0); G8_MMA(1, 1, B1); G8_BAR;
    }
    if (wr == 0) G8_BAR;
#pragma unroll
    for (int ai = 0; ai < 2; ++ai) {
        f32x4 a4[4][4];
#pragma unroll
        for (int m = 0; m < 4; ++m)
#pragma unroll
            for (int n = 0; n < 4; ++n) a4[m][n] = acc[ai][n >> 1][m][n & 1];
        epi(a4, ai * 128 + wr * 64, wc * 64, fr, fq);
    }
}
DI bool xcd_tile(int k, int nM, int NT, int& mt, int& nt) {
    const bool swz = (gridDim.x & 7) == 0;
    const int j = (swz ? (int)(blockIdx.x >> 3) : (int)blockIdx.x) + (swz ? (int)(gridDim.x >> 3) : (int)gridDim.x) * k, mi = j / NT;
    nt = j - mi * NT; mt = swz ? (int)(blockIdx.x & 7) + 8 * mi : mi;
    return mt < nM;
}
struct ALPlain {
    typedef u32x4 Raw; static constexpr int STORE_AT = 0;
    const bf16_t* A; int lda;
    DI void issue(Raw& r, int row, int k, int) const { r = *(const u32x4*)(A + (size_t)row * lda + k); }
    DI u32x4 finish(const Raw& r, int) const { return r; }
};
struct ALMix {
    struct Raw { u32x4 h, x; };
    static constexpr int STORE_AT = 1;
    const bf16_t* H; const bf16_t* XX; const LAS float* xm;
    DI void issue(Raw& r, int row, int k, int) const { r.h = *(const u32x4*)(H + (size_t)row * DM + k); r.x = *(const u32x4*)(XX + (size_t)row * DM + k); }
    DI void set_mix(const float* g) {
        const int t = tidx();
        LAS float* w = (LAS float*)xm;
        w[t] = g[t]; w[t + 512] = g[t + 512];
        __syncthreads();
    }
    DI u32x4 finish(const Raw& r, int k) const {
        const f32x4 m0 = *(const LAS f32x4*)(xm + k), m1 = *(const LAS f32x4*)(xm + k + 4);
        const u32x4 h = r.h, x = r.x;
        u32x4 o;
        o[0] = pk_bf16(bf_lo(h[0]) + bf_lo(x[0]) * m0[0], bf_hi(h[0]) + bf_hi(x[0]) * m0[1]);
        o[1] = pk_bf16(bf_lo(h[1]) + bf_lo(x[1]) * m0[2], bf_hi(h[1]) + bf_hi(x[1]) * m0[3]);
        o[2] = pk_bf16(bf_lo(h[2]) + bf_lo(x[2]) * m1[0], bf_hi(h[2]) + bf_hi(x[2]) * m1[1]);
        o[3] = pk_bf16(bf_lo(h[3]) + bf_lo(x[3]) * m1[2], bf_hi(h[3]) + bf_hi(x[3]) * m1[3]);
        return o;
    }
};

struct EpiQKV {
    const Params* p; int m0, n0;
    DI void operator()(const f32x4 (&acc)[4][4], int rb, int cb, int fr, int fq) const {
        const int hs = (n0 + cb) >> 6;
        const bool isq = hs < 8 || (hs >= 12 && hs < 20), isv = (hs >= 10 && hs < 12) || hs >= 22, normed = hs >= 12 && hs < 22;
        const float* gam = hs < 20 ? p->attn_q_norm_g : p->attn_k_norm_g;
        const f32x2* rope = (const f32x2*)(p->ws + OFF_ROPE);
        bf16_t* Q = (bf16_t*)(p->ws + OFF_SCR + S_Q);
        bf16_t* K = (bf16_t*)(p->ws + OFF_SCR + S_K);
        bf16_t* VT = (bf16_t*)(p->ws + OFF_SCR + S_VT);
#pragma unroll
        for (int m = 0; m < 4; ++m) {
            const int tok = m0 + rb + m * 16 + fr, b = tok >= PTOT ? 1 : 0, pos = tok - b * PTOT;
            f32x4 v[4];
#pragma unroll
            for (int n = 0; n < 4; ++n) v[n] = acc[m][n];
            if (normed) {
                float ss = 0.f;
#pragma unroll
                for (int n = 0; n < 4; ++n) ss += v[n][0] * v[n][0] + v[n][1] * v[n][1] + v[n][2] * v[n][2] + v[n][3] * v[n][3];
                ss += __shfl_xor(ss, 16); ss += __shfl_xor(ss, 32);
                const float rstd = rsqrtf(ss * (1.0f / 64.0f) + RMS_EPS);
#pragma unroll
                for (int n = 0; n < 4; ++n) { const f32x4 g = *(const f32x4*)(gam + n * 16 + fq * 4); v[n] = v[n] * rstd * g; }
            }
            if (!isv && pos >= LCTX) {
                const int t = pos - LCTX, prow = t >> 6, pcol = t & 63;
#pragma unroll
                for (int a = 0; a < 2; ++a) {
                    const f32x2* tb = rope + (a == 0 ? prow : 256 + pcol) * 16 + fq * 4;
#pragma unroll
                    for (int j = 0; j < 4; ++j) {
                        const f32x2 cs = tb[j];
                        const float x0 = v[2 * a][j], x1 = v[2 * a + 1][j];
                        v[2 * a][j] = x0 * cs[0] - x1 * cs[1];
                        v[2 * a + 1][j] = x1 * cs[0] + x0 * cs[1];
                    }
                }
            }
            if (isq) {
                const int hq = hs < 8 ? hs : hs - 4;
                bf16_t* dst = Q + ((size_t)(b * 16 + hq) * PTOT + pos) * 64 + fq * 4;
#pragma unroll
                for (int n = 0; n < 4; ++n) { const f32x4 w = v[n] * (0.125f * LOG2E); u32x2 o; o[0] = pk_bf16(w[0], w[1]); o[1] = pk_bf16(w[2], w[3]); *(u32x2*)(dst + n * 16) = o; }
            } else if (!isv) {
                const int kh = hs < 12 ? hs - 8 : hs - 18;
                bf16_t* dst = K + ((size_t)(b * 4 + kh) * PTOT + pos) * 64 + fq * 4;
#pragma unroll
                for (int n = 0; n < 4; ++n) { u32x2 o; o[0] = pk_bf16(v[n][0], v[n][1]); o[1] = pk_bf16(v[n][2], v[n][3]); *(u32x2*)(dst + n * 16) = o; }
            } else {
                const int vh = hs < 12 ? hs - 10 : hs - 20;
                bf16_t* dst = VT + (size_t)(b * 4 + vh) * 64 * PTOT + pos;
#pragma unroll
                for (int n = 0; n < 4; ++n)
#pragma unroll
                    for (int j = 0; j < 4; ++j) dst[(size_t)(n * 16 + fq * 4 + j) * PTOT] = (bf16_t)(pk_bf16(v[n][j], 0.f) & 0xffffu);
            }
        }
    }
};
DI void phase_qkv(const Params& p, char* smem) {
    const bf16_t* H = (const bf16_t*)(p.ws + OFF_H);
    const bf16_t* W = (const bf16_t*)(p.ws + OFF_WS) + W_IN;
    constexpr int NT = QKV_N / 256, MT = TTOT / 256;
    for (int k = 0;; ++k) {
        int mt, nt; if (!xcd_tile(k, MT, NT, mt, nt)) break;
        EpiQKV epi{&p, mt * 256, nt * 256};
        gemm8_tile(g8_arows(H + (size_t)mt * 256 * DM, DM), g8_brows(W + (size_t)nt * 256 * DM, DM), DM / 64, epi, smem);
    }
}

struct EpiResid {
    const Params* p; int m0, n0, layer; bool from_input;
    DI void operator()(const f32x4 (&acc)[4][4], int rb, int cb, int fr, int fq) const {
#pragma unroll
        for (int m = 0; m < 4; ++m) {
            const int tok = m0 + rb + m * 16 + fr;
            const float* xin = from_input ? xin_ptr(*p, tok) : xrow_ptr(*p, tok);
            float* xo = xrow_ptr(*p, tok);
            const float* gate = mod_ptr(*p, layer, tok, 2);
#pragma unroll
            for (int n = 0; n < 4; ++n) {
                const int c = n0 + cb + n * 16 + fq * 4;
                const f32x4 xi = *(const f32x4*)(xin + c), g = *(const f32x4*)(gate + c);
                *(f32x4*)(xo + c) = xi + g * acc[m][n];
            }
        }
    }
};
DI void phase_wout(const Params& p, char* smem) {
    const bf16_t* O = (const bf16_t*)(p.ws + OFF_SCR + S_O);
    const bf16_t* W = (const bf16_t*)(p.ws + OFF_WS) + W_OUT;
    constexpr int NT = 4, MT = TTOT / 256;
    for (int k = 0;; ++k) {
        int mt, nt; if (!xcd_tile(k, MT, NT, mt, nt)) break;
        EpiResid epi{&p, mt * 256, nt * 256, 0, true};
        gemm8_tile(g8_arows(O + (size_t)mt * 256 * DM, DM), g8_brows(W + (size_t)nt * 256 * DM, DM), DM / 64, epi, smem);
    }
}
DI void phase_wo(const Params& p, char* smem) {
    const bf16_t* O = (const bf16_t*)(p.ws + OFF_SCR + S_OR);
    const bf16_t* W = (const bf16_t*)(p.ws + OFF_WS) + W_O;
    constexpr int NT = 4, MTL = SEQ / 256;
    for (int k = 0;; ++k) {
        int mi, nt; if (!xcd_tile(k, NBATCH * MTL, NT, mi, nt)) break;
        const int b = mi / MTL, mt = b * (PTOT / 256) + 1 + (mi % MTL);
        EpiResid epi{&p, mt * 256, nt * 256, 1, false};
        gemm8_tile(g8_arows(O + (size_t)mt * 256 * DM, DM), g8_brows(W + (size_t)nt * 256 * DM, DM), DM / 64, epi, smem);
    }
}

struct MoeSched { int nt[16], base[17]; };
DI void moe_sched(const Params& p, int layer, MoeSched& s, int (&cnt)[16]) {
    const int* c = (const int*)(p.ws + OFF_CNT) + layer * 16;
    int acc = 0;
#pragma unroll
    for (int e = 0; e < 16; ++e) { cnt[e] = c[e]; s.nt[e] = (cnt[e] + 255) >> 8; s.base[e] = acc; acc += s.nt[e]; }
    s.base[16] = acc;
}
struct EpiMoe1 {
    bf16_t* hid;   int n0;
    DI void operator()(const f32x4 (&acc)[4][4], int rb, int cb, int fr, int fq) const {
        const int g = (n0 + cb) >> 6;
#pragma unroll
        for (int m = 0; m < 4; ++m) {
            bf16_t* dst = hid + (size_t)(rb + m * 16 + fr) * 1024 + g * 32 + fq * 4;
#pragma unroll
            for (int n = 0; n < 2; ++n) {
                const f32x4 a = acc[m][n], b = acc[m][n + 2];
                u32x2 o;
                o[0] = pk_bf16(siluf_(a[0]) * b[0], siluf_(a[1]) * b[1]);
                o[1] = pk_bf16(siluf_(a[2]) * b[2], siluf_(a[3]) * b[3]);
                *(u32x2*)(dst + n * 16) = o;
            }
        }
    }
};
DI void phase_moe1(const Params& p, int layer, char* smem) {
    MoeSched s; int cnt[16];
    moe_sched(p, layer, s, cnt);
    const bf16_t* H = (const bf16_t*)(p.ws + OFF_H);
    const bf16_t* W13 = (const bf16_t*)(p.ws + OFF_MOEW);
    const int* stok = (const int*)(p.ws + OFF_STOK);
    bf16_t* hid = (bf16_t*)(p.ws + OFF_SCR + S_HID);
    constexpr int NT = 8;
    const int total = s.base[16] * NT;
    for (int k = 0;; ++k) {
        int mg, nt; if (!xcd_tile(k, s.base[16], NT, mg, nt)) break;
        int e = 0;
#pragma unroll
        for (int i = 1; i < 16; ++i) if (mg >= s.base[i]) e = i;
        int ce = 0;
#pragma unroll
        for (int i = 0; i < 16; ++i) if (i == e) ce = cnt[i];
        int be = 0;
#pragma unroll
        for (int i = 0; i < 16; ++i) if (i == e) be = s.base[i];
        const int ml = mg - be;
        int R0, C0; g8_rc(R0, C0);
        G8Gather ag; ag.base = H;
#pragma unroll
        for (int q = 0; q < 4; ++q) {
            const int r = ml * 256 + R0 + 64 * (q & 1) + 128 * (q >> 1);
            const int tk = r < ce ? (stok[(size_t)e * CAP + r] >> 1) : 0;
            ag.o[q] = (unsigned)tk * 1024u + C0;
        }
        EpiMoe1 epi{hid + (size_t)mg * 256 * 1024, nt * 256};
        gemm8_tile(ag, g8_brows(W13 + (size_t)e * 2048 * 1024 + (size_t)nt * 256 * 1024, 1024), 16, epi, smem);
    }
}
struct EpiMoe2 {
    bf16_t* Y; const int* stok; const float* sw; int nvalid, n0;
    DI void operator()(const f32x4 (&acc)[4][4], int rb, int cb, int fr, int fq) const {
#pragma unroll
        for (int m = 0; m < 4; ++m) {
            const int r = rb + m * 16 + fr;
            if (r < nvalid) {
                const int tk = stok[r]; const float w = sw[r];
                bf16_t* dst = Y + (size_t)tk * 1024 + n0 + cb + fq * 4;
#pragma unroll
                for (int n = 0; n < 4; ++n) { const f32x4 a = acc[m][n] * w; u32x2 o; o[0] = pk_bf16(a[0], a[1]); o[1] = pk_bf16(a[2], a[3]); *(u32x2*)(dst + n * 16) = o; }
            }
        }
    }
};
DI void phase_moe2(const Params& p, int layer, char* smem) {
    MoeSched s; int cnt[16];
    moe_sched(p, layer, s, cnt);
    const bf16_t* hid = (const bf16_t*)(p.ws + OFF_SCR + S_HID);
    const bf16_t* W2 = (const bf16_t*)(p.ws + OFF_MOEW) + (size_t)16 * 2048 * 1024;
    const int* stok = (const int*)(p.ws + OFF_STOK);
    const float* sw = (const float*)(p.ws + OFF_SW);
    bf16_t* Y = (bf16_t*)(p.ws + OFF_SCR + S_Y);
    constexpr int NT = 4;
    const int total = s.base[16] * NT;
    for (int k = 0;; ++k) {
        int mg, nt; if (!xcd_tile(k, s.base[16], NT, mg, nt)) break;
        int e = 0;
#pragma unroll
        for (int i = 1; i < 16; ++i) if (mg >= s.base[i]) e = i;
        int ce = 0, be = 0;
#pragma unroll
        for (int i = 0; i < 16; ++i) if (i == e) { ce = cnt[i]; be = s.base[i]; }
        const int ml = mg - be;
        EpiMoe2 epi{Y, stok + (size_t)e * CAP + ml * 256, sw + (size_t)e * CAP + ml * 256, ce - ml * 256, nt * 256};
        gemm8_tile(g8_arows(hid + (size_t)mg * 256 * 1024, 1024), g8_brows(W2 + (size_t)e * 1024 * 1024 + (size_t)nt * 256 * 1024, 1024), 16, epi, smem);
    }
}

struct EpiRwkv {
    bf16_t* dst; int ld, m0, n0, act, nstore;
    DI void operator()(const f32x4 (&acc)[4][4], int rb, int cb, int fr, int fq) const {
#pragma unroll
        for (int m = 0; m < 4; ++m) {
            bf16_t* d = dst + (size_t)(m0 + rb + m * 16 + fr) * ld + n0 + cb + fq * 4;
#pragma unroll
            for (int n = 0; n < 4; ++n) {
                const int c = n0 + cb + n * 16 + fq * 4;
                if (c >= ld) continue;
                f32x4 a = acc[m][n];
                if (act == 1) {
#pragma unroll
                    for (int j = 0; j < 4; ++j) { const float e = __expf(2.0f * a[j]); a[j] = 1.0f - 2.0f / (e + 1.0f); }
                }
                if (act == 2) {
#pragma unroll
                    for (int j = 0; j < 4; ++j) a[j] = sigmoidf_(a[j]);
                }
                if (c >= nstore) a = (f32x4){0.f, 0.f, 0.f, 0.f};
                u32x2 o; o[0] = pk_bf16(a[0], a[1]); o[1] = pk_bf16(a[2], a[3]);
                *(u32x2*)(d + n * 16) = o;
            }
        }
    }
};
DI void phase_rwkv_proj(const Params& p, char* smem) {
    const bf16_t* H = (const bf16_t*)(p.ws + OFF_H);
    const bf16_t* XX = (const bf16_t*)(p.ws + OFF_SCR + S_XX);
    const bf16_t* wsm = (const bf16_t*)(p.ws + OFF_WS);
    constexpr int MT = TTOT / 256, NU = 14;
    for (int u = blockIdx.x; u < MT * NU; u += gridDim.x) {
        const int mt = u / NU, q = u % NU;
        ALMix al{H + (size_t)mt * 256 * DM, XX + (size_t)mt * 256 * DM, (const LAS float*)(smem + GEMM_SMEM)};
        if (q < 13) {
            const int job = q < 4 ? 0 : q < 8 ? 1 : q < 12 ? 2 : 5, nt = q < 12 ? (q & 3) : 0;
            const int mixj = job == 0 ? 0 : job == 1 ? 2 : job == 2 ? 3 : 5;
            const size_t wofs = job == 0 ? W_R : job == 1 ? W_K : job == 2 ? W_V : W_G1;
            const size_t dofs = job == 0 ? S_R : job == 1 ? S_KK : job == 2 ? S_V : S_LG;
            al.set_mix(p.rwkv_x_mix + mixj * DM);
            EpiRwkv epi{(bf16_t*)(p.ws + OFF_SCR + dofs), job == 5 ? 192 : 1024, mt * 256, nt * 256, job == 5 ? 2 : 0, job == 5 ? 160 : 4096};
            gemm_tile<2>(al, wsm + wofs + (size_t)nt * 256 * DM, DM, DM / 64, epi, smem);
        } else {
#pragma unroll 1
            for (int j = 0; j < 2; ++j) {
                al.set_mix(p.rwkv_x_mix + (j == 0 ? 1 : 4) * DM);
                EpiRwkv epi{(bf16_t*)(p.ws + OFF_SCR + (j == 0 ? S_LW : S_LA)), 128, mt * 256, 0, j == 0 ? 1 : 0, 4096};
                gemm_tile<1>(al, wsm + (j == 0 ? W_W1 : W_A1), DM, DM / 64, epi, smem);
            }
        }
    }
}

struct EpiGate {
    const Params* p; int m0, n0;
    DI void operator()(const f32x4 (&acc)[4][4], int rb, int cb, int fr, int fq) const {
        const bf16_t* Y0 = (const bf16_t*)(p->ws + OFF_H);
        const bf16_t* Y1 = (const bf16_t*)(p->ws + OFF_SCR + S_Y1);
        const bf16_t* V = (const bf16_t*)(p->ws + OFF_SCR + S_V);
        const float* bonus = (const float*)(p->ws + OFF_BONUS2);
        bf16_t* O = (bf16_t*)(p->ws + OFF_SCR + S_OR);
        const int c0 = n0 + cb, hd = c0 >> 6;
#pragma unroll
        for (int m = 0; m < 4; ++m) {
            const int tok = m0 + rb + m * 16 + fr;
            const size_t ro = (size_t)tok * DM + c0 + fq * 4;
            f32x4 y[4];
            float s = 0.f;
#pragma unroll
            for (int n = 0; n < 4; ++n) {
                const u32x2 a = *(const u32x2*)(Y0 + ro + n * 16), b = *(const u32x2*)(Y1 + ro + n * 16);
                y[n][0] = bf_lo(a[0]) + bf_lo(b[0]); y[n][1] = bf_hi(a[0]) + bf_hi(b[0]); y[n][2] = bf_lo(a[1]) + bf_lo(b[1]); y[n][3] = bf_hi(a[1]) + bf_hi(b[1]);
                s += y[n][0] + y[n][1] + y[n][2] + y[n][3];
            }
            s += __shfl_xor(s, 16); s += __shfl_xor(s, 32);
            const float mu = s * (1.0f / 64.0f);
            float q = 0.f;
#pragma unroll
            for (int n = 0; n < 4; ++n) { const f32x4 d = y[n] - mu; q += d[0] * d[0] + d[1] * d[1] + d[2] * d[2] + d[3] * d[3]; }
            q += __shfl_xor(q, 16); q += __shfl_xor(q, 32);
            const float rs = rsqrtf(q * (1.0f / 64.0f) + GN_EPS);
            const float bon = (bonus[(size_t)tok * 16 + hd] + bonus[(size_t)(TTOT + tok) * 16 + hd]) + (bonus[(size_t)(2 * TTOT + tok) * 16 + hd] + bonus[(size_t)(3 * TTOT + tok) * 16 + hd]);
#pragma unroll
            for (int n = 0; n < 4; ++n) {
                const int c = c0 + n * 16 + fq * 4;
                const f32x4 g = *(const f32x4*)(p->rwkv_ln_g + c), bb = *(const f32x4*)(p->rwkv_ln_b + c);
                const u32x2 vv = *(const u32x2*)(V + ro + n * 16);
                const f32x4 v4 = {bf_lo(vv[0]), bf_hi(vv[0]), bf_lo(vv[1]), bf_hi(vv[1])};
                const f32x4 o = ((y[n] - mu) * rs * g + bb + bon * v4) * acc[m][n];
                u32x2 w; w[0] = pk_bf16(o[0], o[1]); w[1] = pk_bf16(o[2], o[3]);
                *(u32x2*)(O + ro + n * 16) = w;
            }
        }
    }
};
DI void phase_gate(const Params& p, char* smem) {
    const bf16_t* LG = (const bf16_t*)(p.ws + OFF_SCR + S_LG);
    const bf16_t* W = (const bf16_t*)(p.ws + OFF_WS) + W_G2;
    constexpr int NT = 8, MT = TTOT / 256;
    for (int k = 0;; ++k) {
        int mt, nt; if (!xcd_tile(k, MT, NT, mt, nt)) break;
        ALPlain al{LG + (size_t)mt * 256 * 192, 192};
        EpiGate epi{&p, mt * 256, nt * 128};
        gemm_tile<1>(al, W + (size_t)nt * 128 * 192, 192, 3, epi, smem);
    }
}

constexpr int KROW = 72, VROW = 68;
constexpr int ATT_SMEM = 2 * 64 * KROW * 2 + 2 * 64 * VROW * 2;
DI int crow_(int i, int h) { return (i & 3) + 8 * (i >> 2) + 4 * h; }
#define MFMA32(a, b, c) __builtin_amdgcn_mfma_f32_32x32x16_bf16((a), (b), (c), 0, 0, 0)
template <int MODE>
DI void attn_unit(const Params& p, const bf16_t* Qg  , int nq_valid, const bf16_t* Kg  , const bf16_t* Vg  ,
                  int ta0, int ta1, int tb0, int tb1  , bool band, int q_lat0  ,
                  float init_m, float init_l0, bf16_t* Og  , char* smem) {
    const int t = tidx(), lane = t & 63, wid = t >> 6, r = lane & 31, h = lane >> 5;
    bf16_t* sK = (bf16_t*)smem;
    bf16_t* sV = sK + 2 * 64 * KROW;
    bf16x8 qf[2][4];
#pragma unroll
    for (int qs = 0; qs < 2; ++qs) {
        const int qi = wid * 64 + qs * 32 + r;
        const bf16_t* qp = Qg + (size_t)(qi < nq_valid ? qi : 0) * 64 + 8 * h;
#pragma unroll
        for (int ks = 0; ks < 4; ++ks) qf[qs][ks] = *(const bf16x8*)(qp + ks * 16);
    }
#pragma unroll
    for (int qs = 0; qs < 2; ++qs)
#pragma unroll
        for (int ks = 0; ks < 4; ++ks) asm volatile("" : "+v"(qf[qs][ks]));
    f32x16 o[2][2];
#pragma unroll
    for (int qs = 0; qs < 2; ++qs)
#pragma unroll
        for (int dt = 0; dt < 2; ++dt)
#pragma unroll
            for (int i = 0; i < 16; ++i) o[qs][dt][i] = 0.f;
    float mrun[2], lrun[2];
#pragma unroll
    for (int qs = 0; qs < 2; ++qs) { mrun[qs] = init_m; lrun[qs] = (MODE == 1 && h == 0) ? init_l0 : 0.f; }
    const int ntile = ((ta1 - ta0) + (tb1 - tb0)) >> 6;
    const int lrow = t >> 3, lch = (t & 7) * 8;
    u32x4 rk, rv;
    auto tile_pos = [&](int i) { const int a = (ta1 - ta0) >> 6; return i < a ? ta0 + i * 64 : tb0 + (i - a) * 64; };
    {
        const int kp = tile_pos(0);
        rk = *(const u32x4*)(Kg + (size_t)(kp + lrow) * 64 + lch);
        rv = *(const u32x4*)(Vg + (size_t)lrow * PTOT + kp + lch);
        *(u32x4*)(sK + lrow * KROW + lch) = rk;
        *(u32x2*)(sV + lrow * VROW + lch) = (u32x2){rv[0], rv[1]};
        *(u32x2*)(sV + lrow * VROW + lch + 4) = (u32x2){rv[2], rv[3]};
    }
    __syncthreads();
    for (int it = 0; it < ntile; ++it) {
        const int cur = it & 1;
        const bool more = it + 1 < ntile;
        const int kp = tile_pos(it);
        if (more) {
            const int kn = tile_pos(it + 1);
            rk = *(const u32x4*)(Kg + (size_t)(kn + lrow) * 64 + lch);
            rv = *(const u32x4*)(Vg + (size_t)lrow * PTOT + kn + lch);
        }
        __builtin_amdgcn_sched_barrier(0);
        const bf16_t* cK = sK + cur * 64 * KROW;
        const bf16_t* cV = sV + cur * 64 * VROW;
        bf16x8 kf[4];
#pragma unroll
        for (int ks = 0; ks < 4; ++ks) kf[ks] = *(const bf16x8*)(cK + r * KROW + ks * 16 + 8 * h);
#pragma unroll
        for (int ksub = 0; ksub < 2; ++ksub) {
            bf16x8 vf[2][2];
#pragma unroll
            for (int st = 0; st < 2; ++st)
#pragma unroll
                for (int dt = 0; dt < 2; ++dt) {
                    const int kb = ksub * 32 + 16 * st + 4 * h;
                    const s16x4 lo = *(const s16x4*)(cV + (dt * 32 + r) * VROW + kb), hi = *(const s16x4*)(cV + (dt * 32 + r) * VROW + kb + 8);
                    vf[st][dt] = __builtin_shufflevector(lo, hi, 0, 1, 2, 3, 4, 5, 6, 7);
                }
            __builtin_amdgcn_sched_barrier(0);
            f32x16 sc[2];
#pragma unroll
            for (int qs = 0; qs < 2; ++qs)
#pragma unroll
                for (int i = 0; i < 16; ++i) sc[qs][i] = MODE == 0 ? init_m : 0.f;
#pragma unroll
            for (int ks = 0; ks < 4; ++ks)
#pragma unroll
                for (int qs = 0; qs < 2; ++qs) sc[qs] = MFMA32(kf[ks], qf[qs][ks], sc[qs]);
            __builtin_amdgcn_sched_barrier(0);
            if (ksub == 0) {
#pragma unroll
                for (int ks = 0; ks < 4; ++ks) kf[ks] = *(const bf16x8*)(cK + (32 + r) * KROW + ks * 16 + 8 * h);
            }
            __builtin_amdgcn_sched_barrier(0);
#pragma unroll
            for (int qs = 0; qs < 2; ++qs) {
                if (MODE == 1) {
                    if (band && kp >= LCTX) {
                        const int qlat = q_lat0 + wid * 64 + qs * 32 + r, kl0 = kp - LCTX + ksub * 32;
#pragma unroll
                        for (int i = 0; i < 16; ++i) {
                            const int d0 = qlat - (kl0 + crow_(i, h));
                            if (d0 > 128 || d0 < -128) sc[qs][i] = -1e30f;
                        }
                    }
                    float mt = sc[qs][0];
#pragma unroll
                    for (int i = 1; i < 16; ++i) mt = fmaxf(mt, sc[qs][i]);
                    mt = fmaxf(mt, __shfl_xor(mt, 32));
                    const float mnew = fmaxf(mrun[qs], mt);
                    const float alpha = __builtin_amdgcn_exp2f(mrun[qs] - mnew);
                    mrun[qs] = mnew; lrun[qs] *= alpha;
#pragma unroll
                    for (int i = 0; i < 16; ++i) { o[qs][0][i] *= alpha; o[qs][1][i] *= alpha; }
#pragma unroll
                    for (int i = 0; i < 16; ++i) sc[qs][i] -= mnew;
                }
                float ls = 0.f;
#pragma unroll
                for (int i = 0; i < 16; ++i) { sc[qs][i] = __builtin_amdgcn_exp2f(sc[qs][i]); ls += sc[qs][i]; }
                lrun[qs] += ls;
            }
#pragma unroll
            for (int st = 0; st < 2; ++st) {
                bf16x8 pf[2];
#pragma unroll
                for (int qs = 0; qs < 2; ++qs) {
                    u32x4 pw;
#pragma unroll
                    for (int j = 0; j < 4; ++j) pw[j] = pk_bf16(sc[qs][8 * st + 2 * j], sc[qs][8 * st + 2 * j + 1]);
                    pf[qs] = __builtin_bit_cast(bf16x8, pw);
                }
#pragma unroll
                for (int dt = 0; dt < 2; ++dt)
#pragma unroll
                    for (int qs = 0; qs < 2; ++qs) o[qs][dt] = MFMA32(vf[st][dt], pf[qs], o[qs][dt]);
            }
        }
        if (more) {
            bf16_t* nK = sK + (cur ^ 1) * 64 * KROW;
            bf16_t* nV = sV + (cur ^ 1) * 64 * VROW;
            *(u32x4*)(nK + lrow * KROW + lch) = rk;
            *(u32x2*)(nV + lrow * VROW + lch) = (u32x2){rv[0], rv[1]};
            *(u32x2*)(nV + lrow * VROW + lch + 4) = (u32x2){rv[2], rv[3]};
        }
        __syncthreads();
    }
#pragma unroll
    for (int qs = 0; qs < 2; ++qs) {
        const int qi = wid * 64 + qs * 32 + r;
        const float lt = lrun[qs] + __shfl_xor(lrun[qs], 32);
        const float invl = 1.0f / lt;
        if (qi < nq_valid) {
            bf16_t* op = Og + (size_t)qi * DM;
#pragma unroll
            for (int g = 0; g < 4; ++g) {
                u32x2 w0, w1;
                w0[0] = pk_bf16(o[qs][0][4 * g] * invl, o[qs][0][4 * g + 1] * invl); w0[1] = pk_bf16(o[qs][0][4 * g + 2] * invl, o[qs][0][4 * g + 3] * invl);
                w1[0] = pk_bf16(o[qs][1][4 * g] * invl, o[qs][1][4 * g + 1] * invl); w1[1] = pk_bf16(o[qs][1][4 * g + 2] * invl, o[qs][1][4 * g + 3] * invl);
                *(u32x2*)(op + 8 * g + 4 * h) = w0;
                *(u32x2*)(op + 32 + 8 * g + 4 * h) = w1;
            }
        }
    }
}
DI void phase_attn(const Params& p, char* smem) {
    const bf16_t* Q = (const bf16_t*)(p.ws + OFF_SCR + S_Q);
    const bf16_t* K = (const bf16_t*)(p.ws + OFF_SCR + S_K);
    const bf16_t* VT = (const bf16_t*)(p.ws + OFF_SCR + S_VT);
    bf16_t* O = (bf16_t*)(p.ws + OFF_SCR + S_O);
    float gq = 0.f, gk = 0.f;
    for (int i = 0; i < 64; ++i) { gq = fmaxf(gq, fabsf(p.attn_q_norm_g[i])); gk = fmaxf(gk, fabsf(p.attn_k_norm_g[i])); }
    const float M2 = 8.25f * gq * gk * LOG2E;
    constexpr int QB = 512, NQB = SEQ / QB;
    const int G = gridDim.x;
    constexpr int NDENSE = NBATCH * 8 * NQB;
    for (int u = blockIdx.x; u < NDENSE; u += G) {
        int combo, within;
        if ((G & 7) == 0 && NDENSE % G == 0) {
            const int xcd = blockIdx.x & 7, idx = (blockIdx.x >> 3) + (G >> 3) * (u / G);
            combo = xcd & 3; within = (xcd >> 2) * (NDENSE / 8) + idx;
        } else { combo = u / (4 * NQB); within = u % (4 * NQB); }
        const int b = combo >> 1, kvh = combo & 1, hq = kvh * 4 + (within & 3), qb = within >> 2;
        const bf16_t* Qg = Q + ((size_t)(b * 16 + 8 + hq) * PTOT + LCTX + qb * QB) * 64;
        attn_unit<0>(p, Qg, QB, K + (size_t)(b * 4 + 2 + kvh) * PTOT * 64, VT + (size_t)(b * 4 + 2 + kvh) * 64 * PTOT, 0, PTOT, 0, 0, false, 0, -M2, 0.f,
                     O + (size_t)(b * PTOT + LCTX + qb * QB) * DM + (8 + hq) * 64, smem);
    }
    for (int u = blockIdx.x; u < NDENSE; u += G) {
        const int b = u / (8 * NQB), rem = u % (8 * NQB), qb = rem >> 3, hq = rem & 7, kvh = hq >> 2;
        const int i0 = qb * QB;
        const int lo = i0 - 128 < 0 ? 0 : i0 - 128, hi = i0 + QB + 128 > SEQ ? SEQ : i0 + QB + 128;
        const bf16_t* Qg = Q + ((size_t)(b * 16 + hq) * PTOT + LCTX + i0) * 64;
        attn_unit<1>(p, Qg, QB, K + (size_t)(b * 4 + kvh) * PTOT * 64, VT + (size_t)(b * 4 + kvh) * 64 * PTOT, 0, LCTX, LCTX + lo, LCTX + hi, true, i0,
                     p.attn_sink[hq] * LOG2E, 1.0f, O + (size_t)(b * PTOT + LCTX + i0) * DM + hq * 64, smem);
    }
    for (int u = blockIdx.x; u < NBATCH * 16; u += G) {
        const int b = u >> 4, hh = u & 15, isb = hh >> 3, hq = hh & 7, kvh = isb * 2 + (hq >> 2);
        const bf16_t* Qg = Q + ((size_t)(b * 16 + hh) * PTOT) * 64;
        attn_unit<1>(p, Qg, LCTX, K + (size_t)(b * 4 + kvh) * PTOT * 64, VT + (size_t)(b * 4 + kvh) * 64 * PTOT, 0, LCTX, 0, 0, false, 0,
                     isb ? -1e30f : p.attn_sink[hq] * LOG2E, isb ? 0.f : 1.0f, O + (size_t)(b * PTOT) * DM + hh * 64, smem);
    }
}

constexpr int TB = 32, NBUF = 3;
constexpr int SC_REC = 5 * 64;
constexpr int SC_OPS = TB * SC_REC * 4;
constexpr int SC_SMEM = NBUF * SC_OPS + NBUF * TB * 16 * 4 + NBUF * TB * 16 * 4 + 64;
DI int scan_pos(int n, int dir) {
    if (n < LCTX) return dir ? LCTX - 1 - n : n;
    const int m = n - LCTX;
    return LCTX + (dir ? SEQ - 1 - m : m);
}
template <int CTRL> DI float dpp_add(float v) { return v + __builtin_bit_cast(float, __builtin_amdgcn_update_dpp(0, __builtin_bit_cast(int, v), CTRL, 0xf, 0xf, false)); }
DI float row16_sum(float v) { v = dpp_add<0x128>(v); v = dpp_add<0x124>(v); v = dpp_add<0x122>(v); v = dpp_add<0x121>(v); return v; }
DI int lds_min4(int* c) { const volatile LAS int* q = (const volatile LAS int*)c; const int a = q[0], b = q[1], d = q[2], e = q[3]; return min(min(a, b), min(d, e)); }
DI void lds_publish(int* c, int v) { *(volatile LAS int*)c = v; }
DI void scan_unit(const Params& p, int u, char* smem) {
    const int t = tidx(), lane = t & 63, wid = __builtin_amdgcn_readfirstlane(t >> 6);
    const unsigned rg = u & 3, dir = (u >> 2) & 1, hd = (u >> 3) & 15, b = u >> 7;
    float* ops = (float*)smem;
    float* vbuf = (float*)(smem + NBUF * SC_OPS);
    float* ybuf = vbuf + NBUF * TB * 16;
    int* cnts = (int*)(ybuf + NBUF * TB * 16);
    const bf16_t* R = (const bf16_t*)(p.ws + OFF_SCR + S_R);
    const bf16_t* Kk = (const bf16_t*)(p.ws + OFF_SCR + S_KK);
    const bf16_t* V = (const bf16_t*)(p.ws + OFF_SCR + S_V);
    const bf16_t* LW = (const bf16_t*)(p.ws + OFF_SCR + S_LW);
    const bf16_t* LA = (const bf16_t*)(p.ws + OFF_SCR + S_LA);
    bf16_t* Yo = dir ? (bf16_t*)(p.ws + OFF_SCR + S_Y1) : (bf16_t*)(p.ws + OFF_H);
    float* bonus = (float*)(p.ws + OFF_BONUS2);
    const unsigned tokb = b * PTOT, hc = hd * 64;
    constexpr int NBLK = PTOT / TB;
    const unsigned fr = lane & 15, fq = lane >> 4;
    if (t < 8) cnts[t] = 0;
    __syncthreads();

    if (wid < 4) {
        __builtin_amdgcn_s_setprio(3);
        float s0 = 0.f, s1 = 0.f, s2 = 0.f, s3 = 0.f;
        const unsigned g = lane >> 4, c4 = (lane & 15) * 4, myrow = wid * 4 + g;
        for (int blk = 0; blk < NBLK; ++blk) {
            const unsigned buf = (unsigned)blk % NBUF;
            while (lds_min4(cnts) < blk + 1) __builtin_amdgcn_s_sleep(1);
            asm volatile("" ::: "memory");
            const float* rec = ops + buf * (TB * SC_REC) + c4;
            const float* vb = vbuf + buf * (TB * 16) + myrow;
            float* yb = ybuf + buf * (TB * 16) + myrow;
            f32x4 w0_ = *(const f32x4*)(rec), kd0_ = *(const f32x4*)(rec + 64), bb0_ = *(const f32x4*)(rec + 128), aa0_ = *(const f32x4*)(rec + 192), rr0_ = *(const f32x4*)(rec + 256);
            float vv0_ = vb[0];
#define SCAN_STEP(W, KD, BB, AA, RR, VV, ST) { \
                float sa = s0 * AA[0] + s1 * AA[1] + s2 * AA[2] + s3 * AA[3]; \
                sa = row16_sum(sa); \
                s0 = s0 * W[0] + sa * BB[0] + VV * KD[0]; \
                s1 = s1 * W[1] + sa * BB[1] + VV * KD[1]; \
                s2 = s2 * W[2] + sa * BB[2] + VV * KD[2]; \
                s3 = s3 * W[3] + sa * BB[3] + VV * KD[3]; \
                float y = s0 * RR[0] + s1 * RR[1] + s2 * RR[2] + s3 * RR[3]; \
                y = row16_sum(y); \
                if ((lane & 15) == 0) yb[(ST) * 16] = y; }
#pragma unroll 1
            for (int st = 0; st < TB; st += 2) {
                const float* r1 = rec + (st + 1) * SC_REC;
                const f32x4 w1_ = *(const f32x4*)(r1), kd1_ = *(const f32x4*)(r1 + 64), bb1_ = *(const f32x4*)(r1 + 128), aa1_ = *(const f32x4*)(r1 + 192), rr1_ = *(const f32x4*)(r1 + 256);
                const float vv1_ = vb[(st + 1) * 16];
                SCAN_STEP(w0_, kd0_, bb0_, aa0_, rr0_, vv0_, st)
                const int st2 = st + 2 < TB ? st + 2 : st;
                const float* r2 = rec + st2 * SC_REC;
                w0_ = *(const f32x4*)(r2); kd0_ = *(const f32x4*)(r2 + 64); bb0_ = *(const f32x4*)(r2 + 128); aa0_ = *(const f32x4*)(r2 + 192); rr0_ = *(const f32x4*)(r2 + 256);
                vv0_ = vb[st2 * 16];
                SCAN_STEP(w1_, kd1_, bb1_, aa1_, rr1_, vv1_, st + 1)
            }
#undef SCAN_STEP
            asm volatile("s_waitcnt lgkmcnt(0)" ::: "memory");
            if (lane == 0) lds_publish(cnts + 4 + wid, blk + 1);
        }
        __builtin_amdgcn_s_setprio(0);
    } else {
        const unsigned wt = wid & 1, chh = (wid >> 1) & 1;
        const bf16_t* wsm = (const bf16_t*)(p.ws + OFF_WS);
        const unsigned wo = W_W2 + dir * 65536u + (hc + fr) * 64u + fq * 8u;
        const unsigned ao = W_A2 + dir * 65536u + (hc + fr) * 64u + fq * 8u;
        const unsigned po = hc + fq * 4u;
        for (int blk = 0; blk < NBLK + NBUF; ++blk) {
            const unsigned buf = (unsigned)blk % NBUF;
            const int need = blk - NBUF + 1 < NBLK ? blk - NBUF + 1 : NBLK;
            while (lds_min4(cnts + 4) < need) __builtin_amdgcn_s_sleep(1);
            asm volatile("" ::: "memory");
            if (wid == 7 && blk >= NBUF) {
#pragma unroll
                for (int i = 0; i < TB * 16 / 64; ++i) {
                    const unsigned id = i * 64 + lane, st = id >> 4, rw = id & 15;
                    const unsigned tok = tokb + scan_pos((blk - NBUF) * TB + st, dir);
                    Yo[tok * 1024u + hc + rg * 16 + rw] = (bf16_t)(pk_bf16(ybuf[buf * (TB * 16) + id], 0.f) & 0xffffu);
                }
            }
            if (blk >= NBLK) continue;
            const unsigned st = wt * 16 + fr;
            const unsigned tok = tokb + scan_pos(blk * TB + st, dir);
            const unsigned lo = tok * 128u + dir * 64u + fq * 8u;
            const unsigned ro = tok * 1024u + hc + fq * 4u;
            bf16x8 lwf[2], laf[2];
#pragma unroll
            for (int kk = 0; kk < 2; ++kk) { lwf[kk] = *(const bf16x8*)(LW + lo + kk * 32); laf[kk] = *(const bf16x8*)(LA + lo + kk * 32); }
            float ssq = 0.f;
#pragma unroll
            for (int nt = 0; nt < 4; ++nt) {
                const f32x4 kkv = *(const f32x4*)(p.rwkv_k_k + po + nt * 16);
                const u32x2 c = *(const u32x2*)(Kk + ro + nt * 16);
                const float q0 = bf_lo(c[0]) * kkv[0], q1 = bf_hi(c[0]) * kkv[1], q2 = bf_lo(c[1]) * kkv[2], q3 = bf_hi(c[1]) * kkv[3];
                ssq += q0 * q0 + q1 * q1 + q2 * q2 + q3 * q3;
            }
            ssq += __shfl_xor(ssq, 16); ssq += __shfl_xor(ssq, 32);
            const float kn = __builtin_amdgcn_rsqf(fmaxf(ssq, 1e-24f));
            float* rec = ops + buf * (TB * SC_REC) + st * SC_REC + fq * 4;
            float bsum = 0.f;
#pragma unroll
            for (int n2 = 0; n2 < 2; ++n2) {
                const unsigned nt = chh * 2 + n2;
                f32x4 aw = {0.f, 0.f, 0.f, 0.f}, ai = aw;
#pragma unroll
                for (int kk = 0; kk < 2; ++kk) {
                    const bf16x8 w2f = *(const bf16x8*)(wsm + wo + nt * 1024 + kk * 32), a2f = *(const bf16x8*)(wsm + ao + nt * 1024 + kk * 32);
                    aw = __builtin_amdgcn_mfma_f32_16x16x32_bf16(w2f, lwf[kk], aw, 0, 0, 0);
                    ai = __builtin_amdgcn_mfma_f32_16x16x32_bf16(a2f, laf[kk], ai, 0, 0, 0);
                }
                const f32x4 w0v = *(const f32x4*)(p.rwkv_decay_w0 + dir * 1024u + po + nt * 16), a0v = *(const f32x4*)(p.rwkv_iclr_a0 + dir * 1024u + po + nt * 16);
                const f32x4 kkv = *(const f32x4*)(p.rwkv_k_k + po + nt * 16);
                const f32x4 kav = *(const f32x4*)(p.rwkv_k_a + po + nt * 16), rkv = *(const f32x4*)(p.rwkv_r_k + po + nt * 16);
                const u32x2 a = *(const u32x2*)(R + ro + nt * 16), c = *(const u32x2*)(Kk + ro + nt * 16);
                const f32x4 rr = {bf_lo(a[0]), bf_hi(a[0]), bf_lo(a[1]), bf_hi(a[1])};
                const f32x4 kr = {bf_lo(c[0]), bf_hi(c[0]), bf_lo(c[1]), bf_hi(c[1])};
                f32x4 wv, kd, bb, aa;
#pragma unroll
                for (int j = 0; j < 4; ++j) {
                    const float sg = __builtin_amdgcn_rcpf(1.0f + __builtin_amdgcn_exp2f(-(w0v[j] + aw[j]) * LOG2E));
                    wv[j] = __builtin_amdgcn_exp2f(sg * (-0.6065306597126334f * LOG2E));
                    const float ic = __builtin_amdgcn_rcpf(1.0f + __builtin_amdgcn_exp2f(-(a0v[j] + ai[j]) * LOG2E));
                    const float kkn = kr[j] * kkv[j] * kn;
                    kd[j] = kr[j] * (1.0f + (ic - 1.0f) * kav[j]);
                    bb[j] = kkn * ic;
                    aa[j] = -kkn;
                    bsum += rr[j] * kd[j] * rkv[j];
                }
                *(f32x4*)(rec + 0 * 64 + nt * 16) = wv;
                *(f32x4*)(rec + 1 * 64 + nt * 16) = kd;
                *(f32x4*)(rec + 2 * 64 + nt * 16) = bb;
                *(f32x4*)(rec + 3 * 64 + nt * 16) = aa;
                *(f32x4*)(rec + 4 * 64 + nt * 16) = rr;
            }
            bsum += __shfl_xor(bsum, 16); bsum += __shfl_xor(bsum, 32);
            if (rg == 0 && fq == 0) bonus[((chh * 2 + dir) * TTOT + tok) * 16u + hd] = bsum;
            if (wid == 6) {
                bf16_t vr[TB * 16 / 64];
#pragma unroll
                for (int i = 0; i < TB * 16 / 64; ++i) {
                    const unsigned id = i * 64 + lane, s2 = id >> 4, rw = id & 15;
                    const unsigned tk = tokb + scan_pos(blk * TB + s2, dir);
                    vr[i] = V[tk * 1024u + hc + rg * 16 + rw];
                }
#pragma unroll
                for (int i = 0; i < TB * 16 / 64; ++i) vbuf[buf * (TB * 16) + i * 64 + lane] = bf2f(vr[i]);
            }
            asm volatile("s_waitcnt lgkmcnt(0)" ::: "memory");
            if (lane == 0) lds_publish(cnts + (wid - 4), blk + 1);
        }
    }
    __syncthreads();
}

constexpr int CH = 16, NCHK = PTOT / CH;
constexpr int NPREP = 7, NSLOT = 2;
constexpr int TKS = 72, KTS = 20, SMS = 20;
constexpr int SL_PT = 0, SL_QM = SL_PT + 64 * TKS * 2, SL_RT = SL_QM + 64 * KTS * 2, SL_G2 = SL_RT + 16 * TKS * 2, SL_VT = SL_G2 + 16 * SMS * 2, SL_WC = SL_VT + 16 * SMS * 2,
              SLOT_BYTES = SL_WC + 64 * 4;
constexpr int XTK_B = 16 * TKS * 2, XKT_B = 64 * KTS * 2, SM_B = 16 * SMS * 2;
constexpr int PR_XA = 0, PR_XB = PR_XA + XTK_B, PR_XK = PR_XB + XTK_B, PR_XR = PR_XK + XTK_B, PR_TA = PR_XR + XTK_B, PR_TB = PR_TA + XKT_B, PR_TK = PR_TB + XKT_B,
              PR_SN = PR_TK + XKT_B, PREP_BYTES = PR_SN + 2 * SM_B;
static_assert(10 * SM_B <= 3 * XTK_B, "matrices fit in XA..XK");
constexpr int SC2_SMEM = NSLOT * SLOT_BYTES + NPREP * PREP_BYTES + 64 + 5 * 64 * 4;
typedef short s16x4v __attribute__((ext_vector_type(4)));
DI f32x4 mfma16(s16x4v a, s16x4v b, f32x4 c) { return __builtin_amdgcn_mfma_f32_16x16x16bf16_1k(a, b, c, 0, 0, 0); }
DI f32x4 mfma32(bf16x8 a, bf16x8 b, f32x4 c) { return __builtin_amdgcn_mfma_f32_16x16x32_bf16(a, b, c, 0, 0, 0); }
DI s16x4v ld4(const bf16_t* q) { return *(const s16x4v*)q; }
DI f32x4 up4(u32x2 w) { return (f32x4){bf_lo(w[0]), bf_hi(w[0]), bf_lo(w[1]), bf_hi(w[1])}; }
DI f32x4 ld4f(const bf16_t* q) { return up4(*(const u32x2*)q); }
DI void st4(bf16_t* q, f32x4 v) { u32x2 w; w[0] = pk_bf16(v[0], v[1]); w[1] = pk_bf16(v[2], v[3]); *(u32x2*)q = w; }
#define LDS_WAIT() asm volatile("s_waitcnt lgkmcnt(0)" ::: "memory")
template <int CTRL> DI float dpp_shr_add(float v) { return v + __builtin_bit_cast(float, __builtin_amdgcn_update_dpp(0, __builtin_bit_cast(int, v), CTRL, 0xf, 0xf, true)); }
DI float row16_prefix(float v) { v = dpp_shr_add<0x111>(v); v = dpp_shr_add<0x112>(v); v = dpp_shr_add<0x114>(v); v = dpp_shr_add<0x118>(v); return v; }
DI f32x4 mm16(const bf16_t* A, const bf16_t* Bt, int fr, int fq) {
    const s16x4v a = ld4(A + fr * SMS + fq * 4), b = ld4(Bt + fr * SMS + fq * 4);
    LDS_WAIT();
    return mfma16(a, b, (f32x4){0.f, 0.f, 0.f, 0.f});
}
DI f32x4 mm16p(const bf16_t* A, const bf16_t* Bt, const bf16_t* Add, int fr, int fq) {
    const s16x4v a = ld4(A + fr * SMS + fq * 4), b = ld4(Bt + fr * SMS + fq * 4);
    const u32x2 c = *(const u32x2*)(Add + fr * SMS + fq * 4);
    LDS_WAIT();
    return mfma16(a, b, up4(c));
}

DI void scan_unit_chunked(const Params& p, int u, char* smem) {
    const int t = tidx(), lane = t & 63, wid = __builtin_amdgcn_readfirstlane(t >> 6);
    const unsigned rg = u & 3, dir = (u >> 2) & 1, hd = (u >> 3) & 15, b = u >> 7;
    const unsigned tokb = b * PTOT, hc = hd * 64;
    const unsigned fr = lane & 15, fq = lane >> 4;
    char* slots = smem;
    char* prep0 = smem + NSLOT * SLOT_BYTES;
    int* cnts = (int*)(smem + NSLOT * SLOT_BYTES + NPREP * PREP_BYTES);
    const bf16_t* R = (const bf16_t*)(p.ws + OFF_SCR + S_R);
    const bf16_t* Kk = (const bf16_t*)(p.ws + OFF_SCR + S_KK);
    const bf16_t* V = (const bf16_t*)(p.ws + OFF_SCR + S_V);
    const bf16_t* LW = (const bf16_t*)(p.ws + OFF_SCR + S_LW);
    const bf16_t* LA = (const bf16_t*)(p.ws + OFF_SCR + S_LA);
    bf16_t* Yo = dir ? (bf16_t*)(p.ws + OFF_SCR + S_Y1) : (bf16_t*)(p.ws + OFF_H);
    float* bonus = (float*)(p.ws + OFF_BONUS2);
    float* prm = (float*)(cnts + 16);
    if (t < 16) cnts[t] = 0;
    if (t < 64) {
        prm[t] = p.rwkv_decay_w0[dir * 1024u + hc + t]; prm[64 + t] = p.rwkv_iclr_a0[dir * 1024u + hc + t];
        prm[128 + t] = p.rwkv_k_k[hc + t]; prm[192 + t] = p.rwkv_k_a[hc + t]; prm[256 + t] = p.rwkv_r_k[hc + t];
    }
    __syncthreads();

    if (wid == 0) {
        __builtin_amdgcn_s_setprio(3);
        f32x4 st[4];
#pragma unroll
        for (int m = 0; m < 4; ++m) st[m] = (f32x4){0.f, 0.f, 0.f, 0.f};
        for (int c = 0; c < NCHK; ++c) {
            const unsigned sl = (unsigned)c % NSLOT;
            const char* S = slots + sl * SLOT_BYTES;
            while (*(volatile LAS int*)(cnts + sl) < c + 1) __builtin_amdgcn_s_sleep(1);
            LDS_WAIT();
            const s16x4v vt = ld4((const bf16_t*)(S + SL_VT) + fr * SMS + fq * 4);
            const s16x4v g2 = ld4((const bf16_t*)(S + SL_G2) + fr * SMS + fq * 4);
            s16x4v rtl[2], rth[2], ptl[4][2], pth[4][2], qm[4];
            f32x4 wc[4];
#pragma unroll
            for (int i = 0; i < 2; ++i) { const bf16_t* q = (const bf16_t*)(S + SL_RT) + fr * TKS + 32 * i + fq * 4; rtl[i] = ld4(q); rth[i] = ld4(q + 16); }
#pragma unroll
            for (int m = 0; m < 4; ++m) {
                wc[m] = *(const f32x4*)((const float*)(S + SL_WC) + 16 * m + fq * 4);
                qm[m] = ld4((const bf16_t*)(S + SL_QM) + (16 * m + fr) * KTS + fq * 4);
#pragma unroll
                for (int i = 0; i < 2; ++i) { const bf16_t* q = (const bf16_t*)(S + SL_PT) + (16 * m + fr) * TKS + 32 * i + fq * 4; ptl[m][i] = ld4(q); pth[m][i] = ld4(q + 16); }
            }
            LDS_WAIT();
            if (lane == 0) *(volatile LAS int*)(cnts + 8) = c + 1;
            bf16x8 sb[2];
#pragma unroll
            for (int i = 0; i < 2; ++i) {
                u32x4 w; w[0] = pk_bf16(st[2 * i][0], st[2 * i][1]); w[1] = pk_bf16(st[2 * i][2], st[2 * i][3]); w[2] = pk_bf16(st[2 * i + 1][0], st[2 * i + 1][1]); w[3] = pk_bf16(st[2 * i + 1][2], st[2 * i + 1][3]);
                sb[i] = __builtin_bit_cast(bf16x8, w);
            }
            f32x4 y = {0.f, 0.f, 0.f, 0.f};
#pragma unroll
            for (int i = 0; i < 2; ++i) y = mfma32(__builtin_shufflevector(rtl[i], rth[i], 0, 1, 2, 3, 4, 5, 6, 7), sb[i], y);
            y = mfma16(g2, vt, y);
#pragma unroll
            for (int m = 0; m < 4; ++m) {
                f32x4 acc = st[m] * wc[m];
#pragma unroll
                for (int i = 0; i < 2; ++i) acc = mfma32(__builtin_shufflevector(ptl[m][i], pth[m][i], 0, 1, 2, 3, 4, 5, 6, 7), sb[i], acc);
                st[m] = mfma16(qm[m], vt, acc);
            }

#pragma unroll
            for (int j = 0; j < 4; ++j) {
                const unsigned tok = tokb + scan_pos(c * CH + fq * 4 + j, dir);
                Yo[tok * 1024u + hc + rg * 16 + fr] = (bf16_t)(pk_bf16(y[j], 0.f) & 0xffffu);
            }
        }
        __builtin_amdgcn_s_setprio(0);
    } else {
        const unsigned pid = wid - 1;
        char* PS = prep0 + pid * PREP_BYTES;
        bf16_t* XA = (bf16_t*)(PS + PR_XA); bf16_t* XB = (bf16_t*)(PS + PR_XB); bf16_t* XK = (bf16_t*)(PS + PR_XK); bf16_t* XR = (bf16_t*)(PS + PR_XR);
        bf16_t* TA = (bf16_t*)(PS + PR_TA); bf16_t* TB_ = (bf16_t*)(PS + PR_TB); bf16_t* TK = (bf16_t*)(PS + PR_TK); bf16_t* AT = TA;
        bf16_t* SN = (bf16_t*)(PS + PR_SN);
        bf16_t *M = SN, *NABR = SN + 1 * 16 * SMS;
        bf16_t *M2 = XA, *M2T = XA + 1 * 16 * SMS, *M4 = XA + 2 * 16 * SMS, *M4T = XA + 3 * 16 * SMS, *X1 = XA + 4 * 16 * SMS, *G1 = XA + 5 * 16 * SMS, *NAKR = XA + 6 * 16 * SMS,
                *NRBT = XA + 7 * 16 * SMS, *NRKT = XA + 8 * 16 * SMS, *IM = XA + 9 * 16 * SMS;
        bf16_t *M8T = M2, *X2 = M2T, *TT = M4;
        float* WCP = (float*)SN;
        const bf16_t* wsm = (const bf16_t*)(p.ws + OFF_WS);
        const unsigned wo = W_W2 + dir * 65536u + (hc + fr) * 64u + fq * 8u;
        const unsigned ao = W_A2 + dir * 65536u + (hc + fr) * 64u + fq * 8u;
        const unsigned po = hc + fq * 4u;
        const f32x4 z4 = {0.f, 0.f, 0.f, 0.f};
        bf16x8 lwf[2], laf[2];
        u32x2 krw[4], rrw[4];
        unsigned tok_cur = 0;
        auto issue = [&](int c, bf16x8 (&lw)[2], bf16x8 (&la)[2], u32x2 (&kw)[4], u32x2 (&rw)[4], unsigned& tk) {
            tk = tokb + scan_pos(c * CH + fr, dir);
            const unsigned lo = tk * 128u + dir * 64u + fq * 8u, ro = tk * 1024u + hc + fq * 4u;
#pragma unroll
            for (int kk = 0; kk < 2; ++kk) { lw[kk] = *(const bf16x8*)(LW + lo + kk * 32); la[kk] = *(const bf16x8*)(LA + lo + kk * 32); }
#pragma unroll
            for (int nt = 0; nt < 4; ++nt) { kw[nt] = *(const u32x2*)(Kk + ro + nt * 16); rw[nt] = *(const u32x2*)(R + ro + nt * 16); }
        };
        if ((int)pid < NCHK) issue(pid, lwf, laf, krw, rrw, tok_cur);
#pragma unroll
        for (int kk = 0; kk < 2; ++kk) asm volatile("" : "+v"(lwf[kk]), "+v"(laf[kk]));
#pragma unroll
        for (int nt = 0; nt < 4; ++nt) asm volatile("" : "+v"(krw[nt]), "+v"(rrw[nt]));
        auto ldw = [&](bf16x8 (&w)[2][2], int nt) {
#pragma unroll
            for (int kk = 0; kk < 2; ++kk) { w[0][kk] = *(const bf16x8*)(wsm + wo + nt * 1024 + kk * 32); w[1][kk] = *(const bf16x8*)(wsm + ao + nt * 1024 + kk * 32); }
        };
        for (int c = pid; c < NCHK; c += NPREP) {
            bf16x8 wq[2][2], wn[2][2];
            ldw(wq, 0);
            const unsigned tok = tok_cur;
            float ssq = 0.f;
#pragma unroll
            for (int nt = 0; nt < 4; ++nt) {
                const f32x4 kkv = *(const f32x4*)(prm + 128 + fq * 4 + nt * 16);
                const f32x4 q = up4(krw[nt]) * kkv;
                ssq += q[0] * q[0] + q[1] * q[1] + q[2] * q[2] + q[3] * q[3];
            }
            ssq += __shfl_xor(ssq, 16); ssq += __shfl_xor(ssq, 32);
            const float kn = __builtin_amdgcn_rsqf(fmaxf(ssq, 1e-24f));
            float bsum = 0.f;
#pragma unroll
            for (int nt = 0; nt < 4; ++nt) {
                f32x4 aw = z4, ai = z4;
                if (nt < 3) ldw(wn, nt + 1);
                __builtin_amdgcn_sched_barrier(0);
#pragma unroll
                for (int kk = 0; kk < 2; ++kk) {
                    aw = mfma32(wq[0][kk], lwf[kk], aw);
                    ai = mfma32(wq[1][kk], laf[kk], ai);
                }
                if (nt < 3) {
#pragma unroll
                    for (int kk = 0; kk < 2; ++kk) { wq[0][kk] = wn[0][kk]; wq[1][kk] = wn[1][kk]; }
                }
                const f32x4 w0v = *(const f32x4*)(prm + fq * 4 + nt * 16), a0v = *(const f32x4*)(prm + 64 + fq * 4 + nt * 16);
                const f32x4 kkv = *(const f32x4*)(prm + 128 + fq * 4 + nt * 16);
                const f32x4 kav = *(const f32x4*)(prm + 192 + fq * 4 + nt * 16), rkv = *(const f32x4*)(prm + 256 + fq * 4 + nt * 16);
                LDS_WAIT();
                const f32x4 rr = up4(rrw[nt]), krn4 = up4(krw[nt]);
                const f32x4 x1 = (w0v + aw) * (-LOG2E), x2 = (a0v + ai) * (-LOG2E);
                f32x4 ex1, ex2;
#pragma unroll
                for (int j = 0; j < 4; ++j) { ex1[j] = __builtin_amdgcn_exp2f(x1[j]); ex2[j] = __builtin_amdgcn_exp2f(x2[j]); }
                ex1 = ex1 + 1.0f; ex2 = ex2 + 1.0f;
                f32x4 sg, ic;
#pragma unroll
                for (int j = 0; j < 4; ++j) { sg[j] = __builtin_amdgcn_rcpf(ex1[j]); ic[j] = __builtin_amdgcn_rcpf(ex2[j]); }
                const f32x4 e2 = sg * (0.6065306597126334f * LOG2E);
                const f32x4 kkn = krn4 * kkv * kn;
                const f32x4 kd = krn4 * ((ic - 1.0f) * kav + 1.0f);
                { const f32x4 bq = rr * kd * rkv; bsum += (bq[0] + bq[1]) + (bq[2] + bq[3]); }
                f32x4 wt, wi, wp;
#pragma unroll
                for (int j = 0; j < 4; ++j) {
                    const float ec = row16_prefix(e2[j]);
                    wt[j] = __builtin_amdgcn_exp2f(-ec);
                    wi[j] = __builtin_amdgcn_exp2f(ec);
                    wp[j] = __builtin_amdgcn_exp2f(e2[j] - ec);
                }
                const f32x4 at = -(kkn * wp), rt = rr * wt, bt = kkn * ic * wi, kt = kd * wi;
                {
                    u32x2 wa, wb, wk;
                    wa[0] = pk_bf16(at[0], at[1]); wa[1] = pk_bf16(at[2], at[3]); wb[0] = pk_bf16(bt[0], bt[1]); wb[1] = pk_bf16(bt[2], bt[3]);
                    wk[0] = pk_bf16(kt[0], kt[1]); wk[1] = pk_bf16(kt[2], kt[3]);
                    *(u32x2*)(XA + fr * TKS + nt * 16 + fq * 4) = wa; *(u32x2*)(XB + fr * TKS + nt * 16 + fq * 4) = wb; *(u32x2*)(XK + fr * TKS + nt * 16 + fq * 4) = wk;
                    const unsigned o = (nt * 16 + fq * 4) * KTS + fr;
#pragma unroll
                    for (int j = 0; j < 4; ++j) {
                        TA[o + j * KTS] = (bf16_t)((j & 1) ? (wa[j >> 1] >> 16) : (wa[j >> 1] & 0xffffu));
                        TB_[o + j * KTS] = (bf16_t)((j & 1) ? (wb[j >> 1] >> 16) : (wb[j >> 1] & 0xffffu));
                        TK[o + j * KTS] = (bf16_t)((j & 1) ? (wk[j >> 1] >> 16) : (wk[j >> 1] & 0xffffu));
                    }
                }
                if (fr == 15) *(f32x4*)(WCP + nt * 16 + fq * 4) = wt;
                st4(XR + fr * TKS + nt * 16 + fq * 4, rt);
            }
            bsum += __shfl_xor(bsum, 16); bsum += __shfl_xor(bsum, 32);
            if (rg == 0 && fq == 0) { bonus[((0 * 2 + dir) * TTOT + tok) * 16u + hd] = bsum; bonus[((1 * 2 + dir) * TTOT + tok) * 16u + hd] = 0.f; }
            if (c + NPREP < NCHK) issue(c + NPREP, lwf, laf, krw, rrw, tok_cur);
            unsigned vv[2][2];
#pragma unroll
            for (int i = 0; i < 2; ++i) {
                const unsigned q = i * 64 + lane, vrow = q & 15, sp = q >> 4;
                const unsigned tk0 = tokb + scan_pos(c * CH + 2 * sp, dir), tk1 = tokb + scan_pos(c * CH + 2 * sp + 1, dir);
                vv[i][0] = V[tk0 * 1024u + hc + rg * 16 + vrow]; vv[i][1] = V[tk1 * 1024u + hc + rg * 16 + vrow];
            }
            LDS_WAIT();
            float wcr[4];
#pragma unroll
            for (int n = 0; n < 4; ++n) wcr[n] = WCP[16 * n + fr];
            bf16x8 fa[2], fb[2], fk[2], frr[2];
#pragma unroll
            for (int kk = 0; kk < 2; ++kk) {
                fa[kk] = *(const bf16x8*)(XA + fr * TKS + kk * 32 + fq * 8); fb[kk] = *(const bf16x8*)(XB + fr * TKS + kk * 32 + fq * 8);
                fk[kk] = *(const bf16x8*)(XK + fr * TKS + kk * 32 + fq * 8); frr[kk] = *(const bf16x8*)(XR + fr * TKS + kk * 32 + fq * 8);
            }
            LDS_WAIT();
            f32x4 d1 = z4, d2 = z4, d3 = z4, d4 = z4, d5 = z4;
#pragma unroll
            for (int kk = 0; kk < 2; ++kk) {
                d1 = mfma32(fb[kk], fa[kk], d1);
                d2 = mfma32(fa[kk], fb[kk], d2);
                d3 = mfma32(fa[kk], fk[kk], d3);
                d4 = mfma32(fb[kk], frr[kk], d4);
                d5 = mfma32(fk[kk], frr[kk], d5);
            }
            f32x4 im;
#pragma unroll
            for (int j = 0; j < 4; ++j) {
                const unsigned ij = fq * 4 + j;
                d1[j] = ij < fr ? d1[j] : 0.f;
                d2[j] = fr < ij ? d2[j] : 0.f;
                d3[j] = fr < ij ? d3[j] : 0.f;
                d4[j] = ij <= fr ? d4[j] : 0.f;
                d5[j] = ij <= fr ? d5[j] : 0.f;
                im[j] = d1[j] + (ij == fr ? 1.0f : 0.f);
            }
            st4(M + fr * SMS + fq * 4, d1);
            st4(IM + fr * SMS + fq * 4, im);
            st4(NABR + fr * SMS + fq * 4, d2);
            st4(NAKR + fr * SMS + fq * 4, d3);
            st4(NRBT + fr * SMS + fq * 4, d4);
            st4(NRKT + fr * SMS + fq * 4, d5);
            LDS_WAIT();
            const int so = fr * SMS + fq * 4;
            {
                const s16x4v m = ld4(M + so), mt = ld4(NABR + so);
                LDS_WAIT();
                st4(M2T + so, mfma16(m, mt, z4)); st4(M2 + so, mfma16(mt, m, z4));
                LDS_WAIT();
            }
            {
                const s16x4v m2 = ld4(M2 + so), m2t = ld4(M2T + so); const u32x2 imr = *(const u32x2*)(IM + so);
                LDS_WAIT();
                st4(M4T + so, mfma16(m2, m2t, z4)); st4(M4 + so, mfma16(m2t, m2, z4));
                st4(X1 + so, mfma16(m2t, __builtin_bit_cast(s16x4v, imr), up4(imr)));
                LDS_WAIT();
            }
            {
                const s16x4v m4 = ld4(M4 + so), m4t = ld4(M4T + so); const u32x2 x1r = *(const u32x2*)(X1 + so);
                LDS_WAIT();
                st4(M8T + so, mfma16(m4, m4t, z4));
                st4(X2 + so, mfma16(m4t, __builtin_bit_cast(s16x4v, x1r), up4(x1r)));
                LDS_WAIT();
            }
            {
                const s16x4v m8t = ld4(M8T + so); const u32x2 x2r = *(const u32x2*)(X2 + so);
                LDS_WAIT();
                st4(TT + so, mfma16(m8t, __builtin_bit_cast(s16x4v, x2r), up4(x2r)));
                LDS_WAIT();
            }
            {
                const s16x4v ta = ld4(TT + so), nk = ld4(NAKR + so);
                s16x4v xa[4];
#pragma unroll
                for (int n = 0; n < 4; ++n) xa[n] = ld4(TA + (16 * n + fr) * KTS + fq * 4);
                LDS_WAIT();
                st4(G1 + so, mfma16(ta, nk, z4));
#pragma unroll
                for (int n = 0; n < 4; ++n) st4(AT + (16 * n + fr) * KTS + fq * 4, mfma16(ta, xa[n], z4));
                LDS_WAIT();
            }
            const unsigned sl = (unsigned)c % NSLOT;
            char* S = slots + sl * SLOT_BYTES;
            {
                const s16x4v nrb = ld4(NRBT + so), g1 = ld4(G1 + so);
                const u32x2 nrk = *(const u32x2*)(NRKT + so);
                s16x4v atm[4], tb[4]; u32x2 xr[4], tk[4];
#pragma unroll
                for (int m = 0; m < 4; ++m) {
                    atm[m] = ld4(AT + (16 * m + fr) * KTS + fq * 4); tb[m] = ld4(TB_ + (16 * m + fr) * KTS + fq * 4);
                    xr[m] = *(const u32x2*)(XR + fr * TKS + 16 * m + fq * 4); tk[m] = *(const u32x2*)(TK + (16 * m + fr) * KTS + fq * 4);
                }
                LDS_WAIT();
                while (*(volatile LAS int*)(cnts + 8) < c - NSLOT + 1) __builtin_amdgcn_s_sleep(1);
                asm volatile("" ::: "memory");
                st4((bf16_t*)(S + SL_G2) + so, mfma16(g1, nrb, up4(nrk)));
#pragma unroll
                for (int m = 0; m < 4; ++m) {
                    st4((bf16_t*)(S + SL_RT) + fr * TKS + 16 * m + fq * 4, mfma16(atm[m], nrb, up4(xr[m])));
#pragma unroll
                    for (int n = 0; n < 4; ++n) st4((bf16_t*)(S + SL_PT) + (16 * n + fr) * TKS + 16 * m + fq * 4, mfma16(atm[m], tb[n], z4) * wcr[n]);
                    asm volatile("" ::: "memory");
                }
#pragma unroll
                for (int n = 0; n < 4; ++n) st4((bf16_t*)(S + SL_QM) + (16 * n + fr) * KTS + fq * 4, mfma16(g1, tb[n], up4(tk[n])) * wcr[n]);
                ((float*)(S + SL_WC))[lane] = (fq == 0) ? wcr[0] : (fq == 1) ? wcr[1] : (fq == 2) ? wcr[2] : wcr[3];
#pragma unroll
                for (int i = 0; i < 2; ++i) {
                    const unsigned q = i * 64 + lane, vrow = q & 15, sp = q >> 4;
                    *(unsigned*)((bf16_t*)(S + SL_VT) + vrow * SMS + 2 * sp) = vv[i][0] | (vv[i][1] << 16);
                }
            }
            LDS_WAIT();
            if (lane == 0) *(volatile LAS int*)(cnts + sl) = c + 1;
        }
    }
    __syncthreads();
}

DI void phase_scan(const Params& p, char* smem) {
    for (int u = blockIdx.x; u < NBATCH * 16 * 2 * 4; u += gridDim.x) scan_unit_chunked(p, u, smem);
}

constexpr int NPHASE = 18;
constexpr int SMEM_BYTES = (SC2_SMEM > SC_SMEM ? SC2_SMEM : SC_SMEM) + 64;
static_assert(SMEM_BYTES >= GEMM_SMEM + 4096 + 64 && SMEM_BYTES >= G8_SMEM + 64 && SMEM_BYTES + 16 <= 163840, "LDS");
template <int PH> DI void run_phase(const Params& p, char* smem) {
    if constexpr (PH == 0) phase_prologue(p, smem);
    else if constexpr (PH == 1) phase_norm0(p);
    else if constexpr (PH == 2) phase_qkv(p, smem);
    else if constexpr (PH == 3) phase_attn(p, smem);
    else if constexpr (PH == 4) phase_wout(p, smem);
    else if constexpr (PH == 5) phase_ffn_norm_route(p, 0, smem);
    else if constexpr (PH == 6) phase_moe1(p, 0, smem);
    else if constexpr (PH == 7) phase_moe2(p, 0, smem);
    else if constexpr (PH == 8) phase_combine_l0(p, smem);
    else if constexpr (PH == 9) phase_xx(p);
    else if constexpr (PH == 10) phase_rwkv_proj(p, smem);
    else if constexpr (PH == 11) phase_scan(p, smem);
    else if constexpr (PH == 12) phase_gate(p, smem);
    else if constexpr (PH == 13) phase_wo(p, smem);
    else if constexpr (PH == 14) phase_ffn_norm_route(p, 1, smem);
    else if constexpr (PH == 15) phase_moe1(p, 1, smem);
    else if constexpr (PH == 16) phase_moe2(p, 1, smem);
    else if constexpr (PH == 17) phase_final(p);
}
template <int PH, int END> struct PhaseSeq {
    static DI void run(const Params& p, char* smem, const XcdBarrier& bar) {
        run_phase<PH>(p, smem);
        if constexpr (PH + 1 < END) { xcd_barrier(bar); PhaseSeq<PH + 1, END>::run(p, smem, bar); }
    }
};
template <int BEG, int END>
__global__ void __launch_bounds__(NTH, 2) fwd_kernel(Params p) {
    extern __shared__ __attribute__((aligned(16))) char smem_raw[];
    char* smem = smem_raw + 16;
    if constexpr (END - BEG > 1) {
        if (tidx() == 0) *(uint4*)smem_raw = make_uint4(0u, 0u, 0u, 0u);
        __syncthreads();
        XcdBarrier bar = xcd_barrier_post((unsigned*)(p.ws + OFF_BAR), (volatile LAS unsigned*)smem_raw);
        PhaseSeq<BEG, END>::run(p, smem, bar);
    } else {
        run_phase<BEG>(p, smem);
    }
}

template <int BEG, int END> static void launch_range(const Params& p, int grid, hipStream_t stream) {
    (void)hipFuncSetAttribute((const void*)fwd_kernel<BEG, END>, hipFuncAttributeMaxDynamicSharedMemorySize, SMEM_BYTES + 16);
    hipLaunchKernelGGL((fwd_kernel<BEG, END>), dim3(grid), dim3(NTH), SMEM_BYTES + 16, stream, p);
}
#ifndef RUN_PHASES
#define RUN_PHASES NPHASE
#endif
#ifndef REPEAT_PHASE
#define REPEAT_PHASE -1
#endif
template <int PH> static void launch_each(const Params& p, int grid, hipStream_t stream) {
    launch_range<PH, PH + 1>(p, grid, stream);
    if (PH == REPEAT_PHASE) launch_range<PH, PH + 1>(p, grid, stream);
    if constexpr (PH + 1 < RUN_PHASES) launch_each<PH + 1>(p, grid, stream);
}

extern "C" void kernel_launch(void* const* d_in, const int* in_sizes, int n_in, void* d_out, int out_size, void* d_ws, size_t ws_size, hipStream_t stream) {
    Params p{};
    const float** f = (const float**)&p;
    for (int i = 0; i < 37; ++i) f[i] = (const float*)d_in[i];
    p.out = (float*)d_out;
    p.ws = (char*)d_ws;
    if (ws_size < WS_NEED || n_in < 37) return;
    static int grid = 0;
    if (!grid) {
        int dev = 0, cus = 0;
        (void)hipGetDevice(&dev);
        (void)hipDeviceGetAttribute(&cus, hipDeviceAttributeMultiprocessorCount, dev);
        grid = cus > 0 ? cus : 256;
    }
    (void)hipMemsetAsync(d_ws, 0, 32768, stream);
#if MEGA
    launch_range<0, NPHASE>(p, grid, stream);
#else
    launch_each<0>(p, grid, stream);
#endif
}
```

```cpp
#include <hip/hip_runtime.h>
#include <stdint.h>
#include <stdio.h>

#ifndef MEGA
#define MEGA 1
#endif

typedef unsigned short bf16_t;
typedef short bf16x8 __attribute__((ext_vector_type(8)));
typedef short s16x4 __attribute__((ext_vector_type(4)));
typedef float f32x2 __attribute__((ext_vector_type(2)));
typedef float f32x4 __attribute__((ext_vector_type(4)));
typedef float f32x16 __attribute__((ext_vector_type(16)));
typedef unsigned u32x2 __attribute__((ext_vector_type(2)));
typedef unsigned u32x4 __attribute__((ext_vector_type(4)));
typedef __bf16 bf16x2_t __attribute__((ext_vector_type(2)));
#define DI __device__ __forceinline__
__device__ __forceinline__ unsigned tidx() { unsigned t = threadIdx.x; asm volatile("" : "+v"(t)); return t; }

constexpr int DM = 1024, NBATCH = 2, SEQ = 16384, LCTX = 256, PTOT = SEQ + LCTX, TTOT = NBATCH * PTOT;
constexpr int NTH = 512, NWAVE = 8;
constexpr int QKV_N = 1536;
constexpr int NEXP = 16, CAP = TTOT * 2;
constexpr float RMS_EPS = 1e-6f, GN_EPS = 64e-5f;
constexpr float LOG2E = 1.4426950408889634f;

constexpr size_t MBy = 1u << 20;
constexpr size_t OFF_BAR   = 0;
constexpr size_t OFF_CNT   = 16384;
constexpr size_t OFF_MOD   = 32768;
constexpr size_t OFF_ROPE  = OFF_MOD + 2 * 3 * 6144 * 4;
constexpr size_t OFF_BONUS = 1 * MBy;
constexpr size_t OFF_BONUS2 = 6 * MBy;
constexpr size_t OFF_STOK  = 6 * MBy;
constexpr size_t OFF_SW    = 11 * MBy;
constexpr size_t OFF_XC    = 16 * MBy;
constexpr size_t OFF_WS    = 18 * MBy;
constexpr size_t OFF_MOEW  = 33 * MBy;
constexpr size_t OFF_H     = 129 * MBy;
constexpr size_t OFF_SCR   = 194 * MBy;
constexpr size_t SCR_SIZE  = 290 * MBy;
constexpr size_t WS_NEED   = OFF_SCR + SCR_SIZE;
constexpr size_t W_IN = 0, W_OUT = W_IN + 1536 * 1024, W_R = W_OUT + 1024 * 1024, W_K = W_R + 1024 * 1024, W_V = W_K + 1024 * 1024,
                 W_O = W_V + 1024 * 1024, W_W1 = W_O + 1024 * 1024, W_A1 = W_W1 + 128 * 1024, W_G1 = W_A1 + 128 * 1024,
                 W_W2 = W_G1 + 256 * 1024, W_A2 = W_W2 + 2 * 1024 * 64, W_G2 = W_A2 + 2 * 1024 * 64, W_END = W_G2 + 1024 * 192;
static_assert(W_END * 2 <= 15 * MBy, "small weights region");
constexpr size_t ROWB = (size_t)TTOT * 2048;
constexpr size_t S_Q = 0, S_K = S_Q + ROWB, S_VT = S_K + ROWB / 4, S_O = S_VT + ROWB / 4;
constexpr size_t S_HID = 0, S_Y = 140 * MBy;
constexpr size_t S_R = 0, S_KK = S_R + ROWB, S_V = S_KK + ROWB, S_LW = S_V + ROWB, S_LA = S_LW + ROWB / 8, S_LG = S_LA + ROWB / 8,
                 S_Y1 = 224 * MBy, S_XX = S_Y1, S_OR = S_R;
static_assert(S_O + ROWB <= SCR_SIZE, "scr");
static_assert(S_LG + (size_t)TTOT * 384 <= S_Y1, "scr2");
static_assert(S_Y1 + ROWB <= SCR_SIZE, "scr3");
static_assert(S_Y + 2 * ROWB <= SCR_SIZE, "scr4");
static_assert((size_t)(CAP / 256 + 16) * 256 * 2048 <= S_Y, "hid");
static_assert(OFF_H + ROWB <= OFF_SCR, "h");

struct Params {
    const float *x, *c, *ctx, *c_ctx, *ada_w, *ada_b, *norm_mix_g, *norm_ffn_g, *attn_w_in, *attn_w_out, *attn_sink, *attn_q_norm_g, *attn_k_norm_g,
        *rwkv_x_mix, *rwkv_w_r, *rwkv_w_k, *rwkv_w_v, *rwkv_w_o, *rwkv_decay_w0, *rwkv_decay_w1, *rwkv_decay_w2, *rwkv_iclr_a0, *rwkv_iclr_a1,
        *rwkv_iclr_a2, *rwkv_gate_g1, *rwkv_gate_g2, *rwkv_k_k, *rwkv_k_a, *rwkv_r_k, *rwkv_ln_g, *rwkv_ln_b, *router_w, *router_bias, *moe_w1,
        *moe_w3, *moe_w2, *final_norm_g;
    float* out;
    char* ws;
};

DI unsigned pk_bf16(float a, float b) { f32x2 v = {a, b}; bf16x2_t r = __builtin_convertvector(v, bf16x2_t); return __builtin_bit_cast(unsigned, r); }
DI float bf_lo(unsigned u) { return __uint_as_float(u << 16); }
DI float bf_hi(unsigned u) { return __uint_as_float(u & 0xffff0000u); }
DI float bf2f(bf16_t u) { return __uint_as_float(((unsigned)u) << 16); }
DI float wave_sum(float v) {
#pragma unroll
    for (int o = 32; o >= 1; o >>= 1) v += __shfl_xor(v, o);
    return v;
}
DI float sigmoidf_(float x) { return 1.0f / (1.0f + __expf(-x)); }
DI float siluf_(float x) { return x / (1.0f + __expf(-x)); }
DI float* xrow_ptr(const Params& p, int tok) {
    const int b = tok >= PTOT ? 1 : 0, pos = tok - b * PTOT;
    return pos < LCTX ? (float*)(p.ws + OFF_XC) + (size_t)(b * LCTX + pos) * DM : p.out + (size_t)(b * SEQ + pos - LCTX) * DM;
}
DI const float* xin_ptr(const Params& p, int tok) {
    const int b = tok >= PTOT ? 1 : 0, pos = tok - b * PTOT;
    return pos < LCTX ? p.ctx + (size_t)(b * LCTX + pos) * DM : p.x + (size_t)(b * SEQ + pos - LCTX) * DM;
}
DI const float* mod_ptr(const Params& p, int layer, int tok, int which) {
    const int b = tok >= PTOT ? 1 : 0, pos = tok - b * PTOT;
    const int w = pos < LCTX ? 2 : b;
    return (const float*)(p.ws + OFF_MOD) + (size_t)((layer * 3 + w) * 6 + which) * DM;
}

#define XB_TMO      128
#define XB_XCNT(j)  (256  + 64 * (j))
#define XB_XSUB(j)  (1280 + 64 * (j))
#define XB_XGEN(j)  (2304 + 64 * (j))
#define XB_TOP      3328
#define XB_TOPGEN   3392
#define XCD_BAR_WORDS 3456
#define XB_SPIN_CAP (1u << 18)
#define LAS __attribute__((address_space(3)))
DI unsigned xb_ld(unsigned* p)              { return __hip_atomic_load(p, __ATOMIC_RELAXED, __HIP_MEMORY_SCOPE_AGENT); }
DI unsigned xb_add(unsigned* p, unsigned v) { return __hip_atomic_fetch_add(p, v, __ATOMIC_RELAXED, __HIP_MEMORY_SCOPE_AGENT); }
DI unsigned xb_xcc_id() { return (unsigned)__builtin_amdgcn_s_getreg((3 << 11) | 20) & 0xFu; }
#define XB_SPIN(cond, bar) do { unsigned _sp = 0; while (cond) { __builtin_amdgcn_s_sleep(1); \
    if ((++_sp & 255u) == 0u) { if (xb_ld(&(bar)[XB_TMO])) break; if (_sp > XB_SPIN_CAP) { atomicAdd(&(bar)[XB_TMO], 1u); break; } } } } while (0)
struct XcdBarrier { unsigned* bar; unsigned x; volatile LAS unsigned* st; };
DI XcdBarrier xcd_barrier_post(unsigned* bar, volatile LAS unsigned* st) {
    XcdBarrier b; b.bar = bar; b.x = xb_xcc_id(); b.st = st;
    if (tidx() == 0) (void)xb_add(&bar[XB_XCNT(b.x)], 1u);
    return b;
}
DI void xcd_barrier_complete(unsigned* bar, unsigned x, unsigned& nloc, unsigned& nx) {
    const unsigned G = gridDim.x * gridDim.y * gridDim.z;
    unsigned sum, cnt, mine, sp = 0u;
    for (;;) {
        sum = 0u; cnt = 0u; mine = 0u;
#pragma unroll
        for (unsigned j = 0; j < 16; ++j) { const unsigned c = xb_ld(&bar[XB_XCNT(j)]); sum += c; cnt += (c > 0u) ? 1u : 0u; mine = (j == x) ? c : mine; }
        if (sum == G) break;
        __builtin_amdgcn_s_sleep(1);
        if ((++sp & 255u) == 0u) { if (xb_ld(&bar[XB_TMO])) break; if (sp > XB_SPIN_CAP) { atomicAdd(&bar[XB_TMO], 1u); break; } }
    }
    nloc = mine > 0u ? mine : 1u; nx = cnt > 0u ? cnt : 1u;
}
DI void xcd_barrier(const XcdBarrier& b) {
    asm volatile("s_waitcnt vmcnt(0)" ::: "memory");
    __syncthreads();
    if (tidx() == 0) {
        unsigned* bar = b.bar;
        __builtin_amdgcn_s_waitcnt(0);
        unsigned nloc = b.st[0], nx = b.st[1];
        if (nloc == 0u) { xcd_barrier_complete(bar, b.x, nloc, nx); b.st[0] = nloc; b.st[1] = nx; }
        const unsigned old = xb_add(&bar[XB_XSUB(b.x)], 1u);
        const unsigned gen = old / nloc;
        if (old + 1u == (gen + 1u) * nloc) {
            __builtin_amdgcn_fence(__ATOMIC_RELEASE, "agent");
            asm volatile("s_waitcnt vmcnt(0)" ::: "memory");
            const unsigned og = xb_add(&bar[XB_TOP], 1u);
            const unsigned tg = og / nx;
            if (og + 1u == (tg + 1u) * nx) xb_add(&bar[XB_TOPGEN], 1u);
            else XB_SPIN(xb_ld(&bar[XB_TOPGEN]) == tg, bar);
            __builtin_amdgcn_fence(__ATOMIC_ACQUIRE, "agent");
            xb_add(&bar[XB_XGEN(b.x)], 1u);
            asm volatile("s_waitcnt vmcnt(0)" ::: "memory");
        } else {
            XB_SPIN(xb_ld(&bar[XB_XGEN(b.x)]) == gen, bar);
            __builtin_amdgcn_fence(__ATOMIC_ACQUIRE, "agent");
            asm volatile("s_waitcnt vmcnt(0)" ::: "memory");
        }
    }
    __syncthreads();
}

struct CvtDesc { const float* src; bf16_t* dst; int ld, kvalid, dld; bool colvalid; };
DI CvtDesc cvt_tile(const float* src, int ld, int kvalid, bool colvalid, bf16_t* dst, int dld) { return CvtDesc{src, dst, ld, kvalid, dld, colvalid}; }
constexpr int CV_NB = 8;
template <class F>
DI void cvt_run(int nunits, F desc_of, float* tiles) {
    const int t = tidx();
    for (int i0 = 0;; i0 += CV_NB) {
        if ((int)blockIdx.x + (int)gridDim.x * i0 >= nunits) break;
        f32x4 v[CV_NB];
#pragma unroll
        for (int b = 0; b < CV_NB; ++b) {
            const int u = (int)blockIdx.x + (int)gridDim.x * (i0 + b);
            v[b] = (f32x4){0.f, 0.f, 0.f, 0.f};
            if (u < nunits) {
                const CvtDesc d = desc_of(u);
                const int k = t >> 3, c4 = (t & 7) * 4;
                if (d.colvalid && k < d.kvalid) v[b] = *(const f32x4*)(d.src + (size_t)k * d.ld + c4);
            }
        }
#pragma unroll
        for (int b = 0; b < CV_NB; ++b) {
            float* tile = tiles + b * 64 * 33;
            const int k = t >> 3, c4 = (t & 7) * 4;
            tile[k * 33 + c4 + 0] = v[b][0]; tile[k * 33 + c4 + 1] = v[b][1]; tile[k * 33 + c4 + 2] = v[b][2]; tile[k * 33 + c4 + 3] = v[b][3];
        }
        __syncthreads();
#pragma unroll
        for (int b = 0; b < CV_NB; ++b) {
            const int u = (int)blockIdx.x + (int)gridDim.x * (i0 + b);
            if (u < nunits) {
                const CvtDesc d = desc_of(u);
                const float* tile = tiles + b * 64 * 33;
                const int n = t >> 4, kc = (t & 15) * 4;
                u32x2 w;
                w[0] = pk_bf16(tile[(kc + 0) * 33 + n], tile[(kc + 1) * 33 + n]);
                w[1] = pk_bf16(tile[(kc + 2) * 33 + n], tile[(kc + 3) * 33 + n]);
                *(u32x2*)(d.dst + (size_t)n * d.dld + kc) = w;
            }
        }
        __syncthreads();
    }
}
constexpr int CV_SMALL_UNITS = 768 + 512 * 5 + 64 + 64 + 128 + 64 + 64 + 96;
DI CvtDesc cvt_small_unit(const Params& p, int u) {
    bf16_t* wsm = (bf16_t*)(p.ws + OFF_WS);
    if (u < 768) { const int run = u >> 4, kt = u & 15; return cvt_tile(p.attn_w_in + (size_t)kt * 64 * 1536 + run * 32, 1536, 64, true, wsm + W_IN + (size_t)run * 32 * 1024 + kt * 64, 1024); }
    u -= 768;
    if (u < 512 * 5) {
        const int j = u >> 9, v = u & 511, run = v >> 4, kt = v & 15;
        const float* src = j == 0 ? p.attn_w_out : j == 1 ? p.rwkv_w_r : j == 2 ? p.rwkv_w_k : j == 3 ? p.rwkv_w_v : p.rwkv_w_o;
        const size_t dofs = j == 0 ? W_OUT : j == 1 ? W_R : j == 2 ? W_K : j == 3 ? W_V : W_O;
        return cvt_tile(src + (size_t)kt * 64 * 1024 + run * 32, 1024, 64, true, wsm + dofs + (size_t)run * 32 * 1024 + kt * 64, 1024);
    }
    u -= 512 * 5;
    if (u < 128) {
        const int j = u >> 6, v = u & 63, run = v >> 4, kt = v & 15, d = run >> 1, co = (run & 1) * 32;
        const float* src = (j == 0 ? p.rwkv_decay_w1 : p.rwkv_iclr_a1) + (size_t)d * 1024 * 64;
        return cvt_tile(src + (size_t)kt * 64 * 64 + co, 64, 64, true, wsm + (j == 0 ? W_W1 : W_A1) + (size_t)run * 32 * 1024 + kt * 64, 1024);
    }
    u -= 128;
    if (u < 128) {
        const int run = u >> 4, kt = u & 15;
        return cvt_tile(p.rwkv_gate_g1 + (size_t)kt * 64 * 160 + run * 32, 160, 64, run < 5, wsm + W_G1 + (size_t)run * 32 * 1024 + kt * 64, 1024);
    }
    u -= 128;
    if (u < 128) {
        const int j = u >> 6, v = u & 63, d = v >> 5, run = v & 31;
        const float* src = (j == 0 ? p.rwkv_decay_w2 : p.rwkv_iclr_a2) + (size_t)d * 64 * 1024;
        return cvt_tile(src + run * 32, 1024, 64, true, wsm + (j == 0 ? W_W2 : W_A2) + (size_t)d * 1024 * 64 + (size_t)run * 32 * 64, 64);
    }
    u -= 128;
    {
        const int run = u / 3, kt = u % 3;
        const int kvalid = 160 - kt * 64 > 64 ? 64 : (160 - kt * 64 < 0 ? 0 : 160 - kt * 64);
        return cvt_tile(p.rwkv_gate_g2 + (size_t)kt * 64 * 1024 + run * 32, 1024, kvalid, true, wsm + W_G2 + (size_t)run * 32 * 192 + kt * 64, 192);
    }
}
constexpr int CV_MOE_UNITS = 16 * (1024 + 512);
DI CvtDesc cvt_moe_unit(const Params& p, int layer, int u) {
    bf16_t* w13 = (bf16_t*)(p.ws + OFF_MOEW);
    bf16_t* w2t = w13 + (size_t)16 * 2048 * 1024;
    const int e = u / 1536, v = u % 1536;
    const size_t eo = (size_t)(layer * 16 + e) * 1024 * 1024;
    if (v < 1024) {
        const int run = v >> 4, kt = v & 15, g = run >> 1;
        const float* src = ((run & 1) ? p.moe_w3 : p.moe_w1) + eo;
        return cvt_tile(src + (size_t)kt * 64 * 1024 + g * 32, 1024, 64, true, w13 + (size_t)e * 2048 * 1024 + (size_t)run * 32 * 1024 + kt * 64, 1024);
    } else {
        const int w = v - 1024, run = w >> 4, kt = w & 15;
        return cvt_tile(p.moe_w2 + eo + (size_t)kt * 64 * 1024 + run * 32, 1024, 64, true, w2t + (size_t)e * 1024 * 1024 + (size_t)run * 32 * 1024 + kt * 64, 1024);
    }
}
DI void adaln_unit(const Params& p, int u, float* sm) {
    const int l = u / 96, n0 = (u % 96) * 64, t = tidx();
    float* sv = sm;
    float* red = sm + 3 * 1024;
    for (int i = t; i < 3 * 1024; i += NTH) { const int w = i >> 10, k = i & 1023; const float c = w < 2 ? p.c[w * 1024 + k] : p.c_ctx[k]; sv[i] = siluf_(c); }
    __syncthreads();
    const int kg = t >> 4, cl = t & 15;
    f32x4 a0 = {0, 0, 0, 0}, a1 = a0, a2 = a0;
    const float* W = p.ada_w + (size_t)l * 1024 * 6144 + n0 + cl * 4;
#pragma unroll 8
    for (int i = 0; i < 32; ++i) {
        const int k = kg + 32 * i;
        const f32x4 w = *(const f32x4*)(W + (size_t)k * 6144);
        a0 += w * sv[k]; a1 += w * sv[1024 + k]; a2 += w * sv[2048 + k];
    }
#pragma unroll
    for (int j = 0; j < 4; ++j) { red[kg * 192 + 0 * 64 + cl * 4 + j] = a0[j]; red[kg * 192 + 1 * 64 + cl * 4 + j] = a1[j]; red[kg * 192 + 2 * 64 + cl * 4 + j] = a2[j]; }
    __syncthreads();
    if (t < 192) {
        float s = 0.f;
        for (int g = 0; g < 32; ++g) s += red[g * 192 + t];
        const int w = t >> 6, n = n0 + (t & 63);
        ((float*)(p.ws + OFF_MOD))[(size_t)(l * 3 + w) * 6144 + n] = s + p.ada_b[l * 6144 + n];
    }
    __syncthreads();
}
DI void rope_unit(const Params& p, int u) {
    const int id = u * NTH + tidx();
    if (id < 320 * 16) {
        const int pi = id >> 4, f = id & 15;
        const float inv = exp2f(-(float)f * (13.287712379549449f / 16.0f));
        const float val = pi < 256 ? (float)pi : (float)(pi - 256);
        const float ang = val * inv;
        const double a = (double)ang;
        const double k = __builtin_rint(a * 0.15915494309189535);
        const float r = (float)(a - k * 6.283185307179586);
        f32x2 cs = {__cosf(r), __sinf(r)};
        ((f32x2*)(p.ws + OFF_ROPE))[id] = cs;
    }
}
DI void phase_prologue(const Params& p, char* smem) {
    float* sm = (float*)smem;
    const int nconv = CV_SMALL_UNITS + CV_MOE_UNITS;
    const int total = nconv + 192 + 10;
    for (int u = nconv + blockIdx.x; u < total; u += gridDim.x) {
        if (u < nconv + 192) adaln_unit(p, u - nconv, sm);
        else rope_unit(p, u - nconv - 192);
    }
    __syncthreads();
    cvt_run(nconv, [&](int u) { return u < CV_SMALL_UNITS ? cvt_small_unit(p, u) : cvt_moe_unit(p, 0, u - CV_SMALL_UNITS); }, sm);
}

DI void row_load(const float* src, f32x4 (&v)[4], int lane) {
#pragma unroll
    for (int i = 0; i < 4; ++i) v[i] = ((const f32x4*)src)[lane + 64 * i];
}
DI float row_rstd(const f32x4 (&v)[4]) {
    float ss = 0.f;
#pragma unroll
    for (int i = 0; i < 4; ++i) ss += v[i][0] * v[i][0] + v[i][1] * v[i][1] + v[i][2] * v[i][2] + v[i][3] * v[i][3];
    ss = wave_sum(ss);
    return rsqrtf(ss * (1.0f / DM) + RMS_EPS);
}
DI void row_norm_mod(const f32x4 (&v)[4], float rstd, const float* g, const float* shift, const float* scale, f32x4 (&h)[4], int lane) {
#pragma unroll
    for (int i = 0; i < 4; ++i) {
        const int c = (lane + 64 * i) * 4;
        const f32x4 g4 = *(const f32x4*)(g + c), sh = *(const f32x4*)(shift + c), sc = *(const f32x4*)(scale + c);
        h[i] = (v[i] * rstd * g4) * (1.0f + sc) + sh;
    }
}
DI void row_store_bf16(bf16_t* dst, const f32x4 (&h)[4], int lane) {
#pragma unroll
    for (int i = 0; i < 4; ++i) { u32x2 w; w[0] = pk_bf16(h[i][0], h[i][1]); w[1] = pk_bf16(h[i][2], h[i][3]); *(u32x2*)(dst + (lane + 64 * i) * 4) = w; }
}
DI void row_load_bf16(const bf16_t* src, f32x4 (&v)[4], int lane) {
#pragma unroll
    for (int i = 0; i < 4; ++i) { const u32x2 w = *(const u32x2*)(src + (lane + 64 * i) * 4); v[i][0] = bf_lo(w[0]); v[i][1] = bf_hi(w[0]); v[i][2] = bf_lo(w[1]); v[i][3] = bf_hi(w[1]); }
}

DI void phase_norm0(const Params& p) {
    const int lane = tidx() & 63, gw = blockIdx.x * NWAVE + (tidx() >> 6), nw = gridDim.x * NWAVE;
    bf16_t* H = (bf16_t*)(p.ws + OFF_H);
    for (int tok = gw; tok < TTOT; tok += nw) {
        f32x4 v[4], h[4];
        row_load(xin_ptr(p, tok), v, lane);
        const float rstd = row_rstd(v);
        row_norm_mod(v, rstd, p.norm_mix_g, mod_ptr(p, 0, tok, 0), mod_ptr(p, 0, tok, 1), h, lane);
        row_store_bf16(H + (size_t)tok * DM, h, lane);
    }
}

DI void route_row(const Params& p, const float (&lg)[16], int& e1, int& e2, float& g1, float& g2) {
    float mx = lg[0];
#pragma unroll
    for (int e = 1; e < 16; ++e) mx = fmaxf(mx, lg[e]);
    float pr[16], sum = 0.f;
#pragma unroll
    for (int e = 0; e < 16; ++e) { pr[e] = __expf(lg[e] - mx); sum += pr[e]; }
    const float inv = 1.0f / sum;
    float sel[16];
#pragma unroll
    for (int e = 0; e < 16; ++e) { pr[e] *= inv; sel[e] = pr[e] + p.router_bias[e]; }
    float best = -1e30f; int gi = 0;
#pragma unroll
    for (int g = 0; g < 4; ++g) {
        float m1 = -1e30f, m2 = -1e30f;
#pragma unroll
        for (int j = 0; j < 4; ++j) { const float s = sel[g * 4 + j]; if (s > m1) { m2 = m1; m1 = s; } else if (s > m2) m2 = s; }
        const float gs = m1 + m2;
        if (gs > best) { best = gs; gi = g; }
    }
    float s4[4], p4[4];
#pragma unroll
    for (int j = 0; j < 4; ++j) {
        s4[j] = gi == 0 ? sel[j] : gi == 1 ? sel[4 + j] : gi == 2 ? sel[8 + j] : sel[12 + j];
        p4[j] = gi == 0 ? pr[j] : gi == 1 ? pr[4 + j] : gi == 2 ? pr[8 + j] : pr[12 + j];
    }
    int i1 = 0; float b1 = s4[0];
#pragma unroll
    for (int j = 1; j < 4; ++j) if (s4[j] > b1) { b1 = s4[j]; i1 = j; }
    int i2 = i1 == 0 ? 1 : 0; float b2 = -3e38f;
#pragma unroll
    for (int j = 0; j < 4; ++j) if (j != i1 && s4[j] > b2) { b2 = s4[j]; i2 = j; }
    const float w1 = i1 == 0 ? p4[0] : i1 == 1 ? p4[1] : i1 == 2 ? p4[2] : p4[3];
    const float w2 = i2 == 0 ? p4[0] : i2 == 1 ? p4[1] : i2 == 2 ? p4[2] : p4[3];
    const float ws = 1.0f / (w1 + w2);
    e1 = gi * 4 + i1; e2 = gi * 4 + i2; g1 = w1 * ws; g2 = w2 * ws;
}
DI void phase_ffn_norm_route(const Params& p, int layer, char* smem) {
    const int lane = tidx() & 63, gw = blockIdx.x * NWAVE + (tidx() >> 6), nw = gridDim.x * NWAVE;
    float* rw = (float*)smem;
    for (int i = tidx(); i < 1024 * 16; i += NTH) rw[(i & 15) * 1024 + (i >> 4)] = p.router_w[i];
    __syncthreads();
    bf16_t* H = (bf16_t*)(p.ws + OFF_H);
    int* lcnt = (int*)(smem + 65536);
    if (tidx() < 32) lcnt[tidx()] = 0;
    int my_tok = -1, my_e1 = 0, my_e2 = 0, it = 0; float my_g1 = 0.f, my_g2 = 0.f;
    for (int tok = gw; tok < TTOT; tok += nw) {
        const int pos = tok >= PTOT ? tok - PTOT : tok;
        if (layer == 1 && pos < LCTX) continue;
        f32x4 v[4], h[4];
        row_load(xrow_ptr(p, tok), v, lane);
        const float rstd = row_rstd(v);
        row_norm_mod(v, rstd, p.norm_ffn_g + layer * DM, mod_ptr(p, layer, tok, 3), mod_ptr(p, layer, tok, 4), h, lane);
        row_store_bf16(H + (size_t)tok * DM, h, lane);
        float lg[16];
#pragma unroll
        for (int e = 0; e < 16; ++e) lg[e] = 0.f;
#pragma unroll
        for (int i = 0; i < 4; ++i)
#pragma unroll
            for (int e = 0; e < 16; ++e) {
                const f32x4 w = *(const f32x4*)(rw + e * 1024 + (lane + 64 * i) * 4);
                lg[e] += h[i][0] * w[0] + h[i][1] * w[1] + h[i][2] * w[2] + h[i][3] * w[3];
                if ((e & 3) == 3) asm volatile("" ::: "memory");
            }
#pragma unroll
        for (int e = 0; e < 16; ++e) lg[e] = wave_sum(lg[e]);
        int e1, e2; float g1, g2;
        route_row(p, lg, e1, e2, g1, g2);
        if (lane == it) { my_tok = tok; my_e1 = e1; my_e2 = e2; my_g1 = g1; my_g2 = g2; }
        ++it;
    }
    __syncthreads();
    int r1 = 0, r2 = 0;
    if (my_tok >= 0) { r1 = atomicAdd(&lcnt[my_e1], 1); r2 = atomicAdd(&lcnt[my_e2], 1); }
    __syncthreads();
    if (tidx() < 16) { const int n = lcnt[tidx()]; lcnt[16 + tidx()] = n ? atomicAdd((int*)(p.ws + OFF_CNT) + layer * 16 + tidx(), n) : 0; }
    __syncthreads();
    if (my_tok >= 0) {
        int* stok = (int*)(p.ws + OFF_STOK);
        float* sw = (float*)(p.ws + OFF_SW);
        const size_t s1 = (size_t)my_e1 * CAP + lcnt[16 + my_e1] + r1, s2 = (size_t)my_e2 * CAP + lcnt[16 + my_e2] + r2;
        stok[s1] = my_tok * 2 + 0; sw[s1] = my_g1;
        stok[s2] = my_tok * 2 + 1; sw[s2] = my_g2;
    }
    __syncthreads();
}

DI void combine_row(const Params& p, int layer, int tok, f32x4 (&v)[4], int lane) {
    const bf16_t* Y = (const bf16_t*)(p.ws + OFF_SCR + S_Y) + (size_t)tok * 2 * DM;
    const float* g5 = mod_ptr(p, layer, tok, 5);
    f32x4 y0[4], y1[4];
    row_load(xrow_ptr(p, tok), v, lane);
    row_load_bf16(Y, y0, lane); row_load_bf16(Y + DM, y1, lane);
#pragma unroll
    for (int i = 0; i < 4; ++i) { const f32x4 g = *(const f32x4*)(g5 + (lane + 64 * i) * 4); v[i] += g * (y0[i] + y1[i]); }
}
DI void phase_combine_l0(const Params& p, char* smem) {
    const int lane = tidx() & 63, gw = blockIdx.x * NWAVE + (tidx() >> 6), nw = gridDim.x * NWAVE;
    bf16_t* H = (bf16_t*)(p.ws + OFF_H);
    for (int tok = gw; tok < TTOT; tok += nw) {
        f32x4 v[4], h[4];
        combine_row(p, 0, tok, v, lane);
        float* X = xrow_ptr(p, tok);
#pragma unroll
        for (int i = 0; i < 4; ++i) ((f32x4*)X)[lane + 64 * i] = v[i];
        const float rstd = row_rstd(v);
        row_norm_mod(v, rstd, p.norm_mix_g + DM, mod_ptr(p, 1, tok, 0), mod_ptr(p, 1, tok, 1), h, lane);
        row_store_bf16(H + (size_t)tok * DM, h, lane);
    }
    __syncthreads();
    cvt_run(CV_MOE_UNITS, [&](int u) { return cvt_moe_unit(p, 1, u); }, (float*)smem);
}
DI void phase_xx(const Params& p) {
    const int lane = tidx() & 63, gw = blockIdx.x * NWAVE + (tidx() >> 6), nw = gridDim.x * NWAVE;
    const bf16_t* H = (const bf16_t*)(p.ws + OFF_H);
    bf16_t* XX = (bf16_t*)(p.ws + OFF_SCR + S_XX);
    for (int tok = gw; tok < TTOT; tok += nw) {
        const int pos = tok >= PTOT ? tok - PTOT : tok;
        const bool first = pos == 0 || pos == LCTX, last = pos == LCTX - 1 || pos == PTOT - 1;
        f32x4 hc[4], hp[4], hn[4], xx[4];
        row_load_bf16(H + (size_t)tok * DM, hc, lane);
        row_load_bf16(H + (size_t)(first ? tok : tok - 1) * DM, hp, lane);
        row_load_bf16(H + (size_t)(last ? tok : tok + 1) * DM, hn, lane);
#pragma unroll
        for (int i = 0; i < 4; ++i) {
            const f32x4 a = first ? (f32x4){0, 0, 0, 0} : hp[i], b = last ? (f32x4){0, 0, 0, 0} : hn[i];
            xx[i] = 0.5f * (a + b) - hc[i];
        }
        row_store_bf16(XX + (size_t)tok * DM, xx, lane);
    }
}
DI void phase_final(const Params& p) {
    const int lane = tidx() & 63, gw = blockIdx.x * NWAVE + (tidx() >> 6), nw = gridDim.x * NWAVE;
    for (int r = gw; r < NBATCH * SEQ; r += nw) {
        const int b = r / SEQ, tok = b * PTOT + LCTX + (r - b * SEQ);
        f32x4 v[4];
        combine_row(p, 1, tok, v, lane);
        const float rstd = row_rstd(v);
        float* O = p.out + (size_t)r * DM;
#pragma unroll
        for (int i = 0; i < 4; ++i) { const f32x4 g = *(const f32x4*)(p.final_norm_g + (lane + 64 * i) * 4); ((f32x4*)O)[lane + 64 * i] = v[i] * rstd * g; }
    }
}

constexpr int LDSROW = 72;
constexpr int GEMM_SMEM = 2 * (256 + 256) * LDSROW * 2;
template <int NH, class AL, class EPI>
DI void gemm_tile(AL& al, const bf16_t* __restrict__ Bt, int ldb, int nk, EPI& epi, char* smem) {
    const int t = tidx(), lane = t & 63, wid = t >> 6, wr = wid >> 1, wc = wid & 1, fr = lane & 15, fq = lane >> 4;
    constexpr int BR = 128 * NH;
    bf16_t* sA = (bf16_t*)smem;
    bf16_t* sB = sA + 2 * 256 * LDSROW;
    f32x4 acc[NH][4][4];
#pragma unroll
    for (int h = 0; h < NH; ++h)
#pragma unroll
        for (int m = 0; m < 4; ++m)
#pragma unroll
            for (int n = 0; n < 4; ++n) acc[h][m][n] = (f32x4){0.f, 0.f, 0.f, 0.f};
    const int lr = t >> 3, lc = (t & 7) * 8;
    typename AL::Raw ra[4]; u32x4 rb[2 * NH];
#pragma unroll
    for (int i = 0; i < 4; ++i) al.issue(ra[i], lr + 64 * i, lc, i);
#pragma unroll
    for (int i = 0; i < 2 * NH; ++i) rb[i] = *(const u32x4*)(Bt + (size_t)(lr + 64 * i) * ldb + lc);
#pragma unroll
    for (int i = 0; i < 4; ++i) *(u32x4*)(sA + (lr + 64 * i) * LDSROW + lc) = al.finish(ra[i], lc);
#pragma unroll
    for (int i = 0; i < 2 * NH; ++i) *(u32x4*)(sB + (lr + 64 * i) * LDSROW + lc) = rb[i];
    __syncthreads();
    for (int kt = 0; kt < nk; ++kt) {
        const int cur = kt & 1;
        const bool more = kt + 1 < nk;
        if (more) {
#pragma unroll
            for (int i = 0; i < 4; ++i) al.issue(ra[i], lr + 64 * i, (kt + 1) * 64 + lc, i);
#pragma unroll
            for (int i = 0; i < 2 * NH; ++i) rb[i] = *(const u32x4*)(Bt + (size_t)(lr + 64 * i) * ldb + (kt + 1) * 64 + lc);
        }
        __builtin_amdgcn_sched_barrier(0);
        const bf16_t* cA = sA + cur * 256 * LDSROW + (wr * 64 + fr) * LDSROW + fq * 8;
        const bf16_t* cB = sB + cur * BR * LDSROW + (wc * 64 + fr) * LDSROW + fq * 8;
#pragma unroll
        for (int kk = 0; kk < 2; ++kk) {
            bf16x8 af[4];
#pragma unroll
            for (int m = 0; m < 4; ++m) af[m] = *(const bf16x8*)(cA + m * 16 * LDSROW + kk * 32);
#pragma unroll
            for (int h = 0; h < NH; ++h) {
                bf16x8 bfr[4];
#pragma unroll
                for (int n = 0; n < 4; ++n) bfr[n] = *(const bf16x8*)(cB + (h * 128 + n * 16) * LDSROW + kk * 32);
#pragma unroll
                for (int m = 0; m < 4; ++m)
#pragma unroll
                    for (int n = 0; n < 4; ++n) acc[h][m][n] = __builtin_amdgcn_mfma_f32_16x16x32_bf16(bfr[n], af[m], acc[h][m][n], 0, 0, 0);
            }
            if (kk == AL::STORE_AT && more) {
                bf16_t* nA = sA + (cur ^ 1) * 256 * LDSROW;
                bf16_t* nB = sB + (cur ^ 1) * BR * LDSROW;
#pragma unroll
                for (int i = 0; i < 4; ++i) *(u32x4*)(nA + (lr + 64 * i) * LDSROW + lc) = al.finish(ra[i], (kt + 1) * 64 + lc);
#pragma unroll
                for (int i = 0; i < 2 * NH; ++i) *(u32x4*)(nB + (lr + 64 * i) * LDSROW + lc) = rb[i];
            }
        }
        __syncthreads();
    }
#pragma unroll
    for (int h = 0; h < NH; ++h) epi(acc[h], wr * 64, h * 128 + wc * 64, fr, fq);
}
constexpr int G8_HB = 128 * 64 * 2;
constexpr int G8_SMEM = 8 * G8_HB;
DI void g8_rc(int& R0, int& C0) {
    const int tz = tidx(), st = tz >> 6, sb = (tz & 63) * 16, swz = sb ^ (((sb >> 9) & 1) << 5);
    R0 = (st >> 1) * 16 + (swz >> 6); C0 = (st & 1) * 32 + ((swz & 63) >> 1);
}
DI int g8_bcol(int h, int rho) { return (rho >> 5) * 64 + h * 32 + (rho & 31); }
struct G8Rows {
    const bf16_t* base; unsigned o0, d1, d2;
    DI const bf16_t* ptr(int h, int i, int kt) const { return (base + (size_t)(h * d2 + i * d1 + kt * 64)) + o0; }
};
struct G8Gather {
    const bf16_t* base; unsigned o[4];
    DI const bf16_t* ptr(int h, int i, int kt) const { return (base + kt * 64) + o[h * 2 + i]; }
};
DI G8Rows g8_arows(const bf16_t* A, int lda) { int R0, C0; g8_rc(R0, C0); return G8Rows{A, (unsigned)(R0 * lda + C0), (unsigned)(64 * lda), (unsigned)(128 * lda)}; }
DI G8Rows g8_brows(const bf16_t* Bt, int ldb) { int R0, C0; g8_rc(R0, C0); return G8Rows{Bt, (unsigned)(g8_bcol(0, R0) * ldb + C0), (unsigned)(128 * ldb), (unsigned)(32 * ldb)}; }
template <class AS, class BS, class EPI>
DI void gemm8_tile(const AS& as, const BS& bs, int nt  , EPI& epi, char* smem) {
    int tz = tidx();
    int wid = tz >> 6, lane = tz & 63, wr = wid >> 2, wc = wid & 3, fr = lane & 15, fq = lane >> 4;
    int loff = ((fr * 64 + fq * 16) ^ ((fr >> 3) << 5));
#define G8_SA(b, h) (smem + ((b) * 2 + (h)) * G8_HB)
#define G8_SB(b, h) (smem + (4 + (b) * 2 + (h)) * G8_HB)
#define G8_STAGE(P, src, h, kt) do { \
        __builtin_amdgcn_global_load_lds((const unsigned*)(src).ptr(h, 0, kt), (LAS unsigned*)((P) + tz * 16), 16, 0, 0); \
        __builtin_amdgcn_global_load_lds((const unsigned*)(src).ptr(h, 1, kt), (LAS unsigned*)((P) + tz * 16 + 8192), 16, 0, 0); } while (0)
#define G8_STA(b, h, kt) G8_STAGE(G8_SA(b, h), as, h, kt)
#define G8_STB(b, h, kt) G8_STAGE(G8_SB(b, h), bs, h, kt)
#define G8_LDA(dst, b, h) _Pragma("unroll") for (int m = 0; m < 4; ++m) _Pragma("unroll") for (int k = 0; k < 2; ++k) \
        dst[m][k] = *(const bf16x8*)(G8_SA(b, h) + (wr * 8 + m * 2 + k) * 1024 + loff)
#define G8_LDB(dst, b, h) _Pragma("unroll") for (int n = 0; n < 2; ++n) _Pragma("unroll") for (int k = 0; k < 2; ++k) \
        dst[n][k] = *(const bf16x8*)(G8_SB(b, h) + (wc * 4 + n * 2 + k) * 1024 + loff)
#define G8_MMA(ai, bj, Bx) do { __builtin_amdgcn_s_setprio(1); \
        _Pragma("unroll") for (int m = 0; m < 4; ++m) _Pragma("unroll") for (int n = 0; n < 2; ++n) _Pragma("unroll") for (int k = 0; k < 2; ++k) \
            acc[ai][bj][m][n] = __builtin_amdgcn_mfma_f32_16x16x32_bf16(Bx[n][k], At[m][k], acc[ai][bj][m][n], 0, 0, 0); \
        __builtin_amdgcn_s_setprio(0); } while (0)
#define G8_WV(n) asm volatile("s_waitcnt vmcnt(" #n ")" ::: "memory")
#define G8_WL(n) asm volatile("s_waitcnt lgkmcnt(" #n ")" ::: "memory")
#define G8_BAR __builtin_amdgcn_s_barrier()
#define G8_SCHED __builtin_amdgcn_sched_barrier(0)
    f32x4 acc[2][2][4][2];
#pragma unroll
    for (int a = 0; a < 2; ++a)
#pragma unroll
        for (int b = 0; b < 2; ++b)
#pragma unroll
            for (int m = 0; m < 4; ++m)
#pragma unroll
                for (int n = 0; n < 2; ++n) acc[a][b][m][n] = (f32x4){0.f, 0.f, 0.f, 0.f};
    bf16x8 At[4][2], B0[2][2], B1[2][2];
    G8_STB(0, 0, 0); G8_STA(0, 0, 0); G8_STB(0, 1, 0); G8_STA(0, 1, 0);
    if (wr == 1) G8_BAR;
    G8_WV(4); G8_BAR;
    G8_STB(1, 0, 1); G8_STA(1, 0, 1); G8_STB(1, 1, 1);
    G8_WV(6); G8_BAR;
    for (int t = 0; t < nt - 2; t += 2) {
        G8_LDB(B0, 0, 0); G8_SCHED; G8_LDA(At, 0, 0); G8_STA(1, 1, t + 1);
        G8_WL(8); G8_BAR; G8_WL(0); G8_MMA(0, 0, B0); G8_BAR; G8_SCHED;
        G8_LDB(B1, 0, 1); G8_STB(0, 0, t + 2);
        G8_BAR; G8_WL(0); G8_MMA(0, 1, B1); G8_BAR;
        G8_LDA(At, 0, 1); G8_STA(0, 0, t + 2);
        G8_BAR; G8_WL(0); G8_MMA(1, 0, B0); G8_BAR; G8_SCHED;
        G8_STB(0, 1, t + 2);
        G8_WV(6); G8_BAR; G8_MMA(1, 1, B1); G8_BAR;
        G8_LDB(B0, 1, 0); G8_SCHED; G8_LDA(At, 1, 0); G8_STA(0, 1, t + 2);
        G8_WL(8); G8_BAR; G8_WL(0); G8_MMA(0, 0, B0); G8_BAR; G8_SCHED;
        G8_LDB(B1, 1, 1); G8_STB(1, 0, t + 3);
        G8_BAR; G8_WL(0); G8_MMA(0, 1, B1); G8_BAR;
        G8_LDA(At, 1, 1); G8_STA(1, 0, t + 3);
        G8_BAR; G8_WL(0); G8_MMA(1, 0, B0); G8_BAR; G8_SCHED;
        G8_STB(1, 1, t + 3);
        G8_WV(6); G8_BAR; G8_MMA(1, 1, B1); G8_BAR;
    }
    tz = tidx(); wid = tz >> 6; lane = tz & 63; wr = wid >> 2; wc = wid & 3; fr = lane & 15; fq = lane >> 4;
    loff = ((fr * 64 + fq * 16) ^ ((fr >> 3) << 5));
    {
        G8_LDB(B0, 0, 0); G8_WV(0); G8_LDA(At, 0, 0); G8_STA(1, 1, nt - 1);
        G8_BAR; G8_WL(0); G8_MMA(0, 0, B0); G8_BAR;
        G8_LDB(B1, 0, 1); G8_BAR; G8_WL(0); G8_MMA(0, 1, B1); G8_BAR;
        G8_LDA(At, 0, 1); G8_WV(4); G8_BAR; G8_WL(0); G8_MMA(1, 0, B0); G8_MMA(1, 1, B1); G8_BAR;
    }
    {
        G8_LDB(B0, 1, 0); G8_LDA(At, 1, 0); G8_WV(2); G8_BAR; G8_WL(0); G8_MMA(0, 0, B0); G8_BAR;
        G8_LDB(B1, 1, 1); G8_WV(0); G8_BAR; G8_WL(0); G8_MMA(0, 1, B1); G8_BAR;
        G8_LDA(At, 1, 1); G8_BAR; G8_WL(0); G8_MMA(1, 0, B0); G8_MMA(1, 1, B1); G8_BAR;
    }
    if (wr == 0) G8_BAR;
#pragma unroll
    for (int ai = 0; ai < 2; ++ai) {
        f32x4 a4[4][4];
#pragma unroll
        for (int m = 0; m < 4; ++m)
#pragma unroll
            for (int n = 0; n < 4; ++n) a4[m][n] = acc[ai][n >> 1][m][n & 1];
        epi(a4, ai * 128 + wr * 64, wc * 64, fr, fq);
    }
}
DI bool xcd_tile(int k, int nM, int NT, int& mt, int& nt) {
    const bool swz = (gridDim.x & 7) == 0;
    const int j = (swz ? (int)(blockIdx.x >> 3) : (int)blockIdx.x) + (swz ? (int)(gridDim.x >> 3) : (int)gridDim.x) * k, mi = j / NT;
    nt = j - mi * NT; mt = swz ? (int)(blockIdx.x & 7) + 8 * mi : mi;
    return mt < nM;
}
struct ALPlain {
    typedef u32x4 Raw; static constexpr int STORE_AT = 0;
    const bf16_t* A; int lda;
    DI void issue(Raw& r, int row, int k, int) const { r = *(const u32x4*)(A + (size_t)row * lda + k); }
    DI u32x4 finish(const Raw& r, int) const { return r; }
};
struct ALMix {
    struct Raw { u32x4 h, x; };
    static constexpr int STORE_AT = 1;
    const bf16_t* H; const bf16_t* XX; const LAS float* xm;
    DI void issue(Raw& r, int row, int k, int) const { r.h = *(const u32x4*)(H + (size_t)row * DM + k); r.x = *(const u32x4*)(XX + (size_t)row * DM + k); }
    DI void set_mix(const float* g) {
        const int t = tidx();
        LAS float* w = (LAS float*)xm;
        w[t] = g[t]; w[t + 512] = g[t + 512];
        __syncthreads();
    }
    DI u32x4 finish(const Raw& r, int k) const {
        const f32x4 m0 = *(const LAS f32x4*)(xm + k), m1 = *(const LAS f32x4*)(xm + k + 4);
        const u32x4 h = r.h, x = r.x;
        u32x4 o;
        o[0] = pk_bf16(bf_lo(h[0]) + bf_lo(x[0]) * m0[0], bf_hi(h[0]) + bf_hi(x[0]) * m0[1]);
        o[1] = pk_bf16(bf_lo(h[1]) + bf_lo(x[1]) * m0[2], bf_hi(h[1]) + bf_hi(x[1]) * m0[3]);
        o[2] = pk_bf16(bf_lo(h[2]) + bf_lo(x[2]) * m1[0], bf_hi(h[2]) + bf_hi(x[2]) * m1[1]);
        o[3] = pk_bf16(bf_lo(h[3]) + bf_lo(x[3]) * m1[2], bf_hi(h[3]) + bf_hi(x[3]) * m1[3]);
        return o;
    }
};

struct EpiQKV {
    const Params* p; int m0, n0;
    DI void operator()(const f32x4 (&acc)[4][4], int rb, int cb, int fr, int fq) const {
        const int hs = (n0 + cb) >> 6;
        const bool isq = hs < 8 || (hs >= 12 && hs < 20), isv = (hs >= 10 && hs < 12) || hs >= 22, normed = hs >= 12 && hs < 22;
        const float* gam = hs < 20 ? p->attn_q_norm_g : p->attn_k_norm_g;
        const f32x2* rope = (const f32x2*)(p->ws + OFF_ROPE);
        bf16_t* Q = (bf16_t*)(p->ws + OFF_SCR + S_Q);
        bf16_t* K = (bf16_t*)(p->ws + OFF_SCR + S_K);
        bf16_t* VT = (bf16_t*)(p->ws + OFF_SCR + S_VT);
#pragma unroll
        for (int m = 0; m < 4; ++m) {
            const int tok = m0 + rb + m * 16 + fr, b = tok >= PTOT ? 1 : 0, pos = tok - b * PTOT;
            f32x4 v[4];
#pragma unroll
            for (int n = 0; n < 4; ++n) v[n] = acc[m][n];
            if (normed) {
                float ss = 0.f;
#pragma unroll
                for (int n = 0; n < 4; ++n) ss += v[n][0] * v[n][0] + v[n][1] * v[n][1] + v[n][2] * v[n][2] + v[n][3] * v[n][3];
                ss += __shfl_xor(ss, 16); ss += __shfl_xor(ss, 32);
                const float rstd = rsqrtf(ss * (1.0f / 64.0f) + RMS_EPS);
#pragma unroll
                for (int n = 0; n < 4; ++n) { const f32x4 g = *(const f32x4*)(gam + n * 16 + fq * 4); v[n] = v[n] * rstd * g; }
            }
            if (!isv && pos >= LCTX) {
                const int t = pos - LCTX, prow = t >> 6, pcol = t & 63;
#pragma unroll
                for (int a = 0; a < 2; ++a) {
                    const f32x2* tb = rope + (a == 0 ? prow : 256 + pcol) * 16 + fq * 4;
#pragma unroll
                    for (int j = 0; j < 4; ++j) {
                        const f32x2 cs = tb[j];
                        const float x0 = v[2 * a][j], x1 = v[2 * a + 1][j];
                        v[2 * a][j] = x0 * cs[0] - x1 * cs[1];
                        v[2 * a + 1][j] = x1 * cs[0] + x0 * cs[1];
                    }
                }
            }
            if (isq) {
                const int hq = hs < 8 ? hs : hs - 4;
                bf16_t* dst = Q + ((size_t)(b * 16 + hq) * PTOT + pos) * 64 + fq * 4;
#pragma unroll
                for (int n = 0; n < 4; ++n) { const f32x4 w = v[n] * (0.125f * LOG2E); u32x2 o; o[0] = pk_bf16(w[0], w[1]); o[1] = pk_bf16(w[2], w[3]); *(u32x2*)(dst + n * 16) = o; }
            } else if (!isv) {
                const int kh = hs < 12 ? hs - 8 : hs - 18;
                bf16_t* dst = K + ((size_t)(b * 4 + kh) * PTOT + pos) * 64 + fq * 4;
#pragma unroll
                for (int n = 0; n < 4; ++n) { u32x2 o; o[0] = pk_bf16(v[n][0], v[n][1]); o[1] = pk_bf16(v[n][2], v[n][3]); *(u32x2*)(dst + n * 16) = o; }
            } else {
                const int vh = hs < 12 ? hs - 10 : hs - 20;
                bf16_t* dst = VT + (size_t)(b * 4 + vh) * 64 * PTOT + pos;
#pragma unroll
                for (int n = 0; n < 4; ++n)
#pragma unroll
                    for (int j = 0; j < 4; ++j) dst[(size_t)(n * 16 + fq * 4 + j) * PTOT] = (bf16_t)(pk_bf16(v[n][j], 0.f) & 0xffffu);
            }
        }
    }
};
DI void phase_qkv(const Params& p, char* smem) {
    const bf16_t* H = (const bf16_t*)(p.ws + OFF_H);
    const bf16_t* W = (const bf16_t*)(p.ws + OFF_WS) + W_IN;
    constexpr int NT = QKV_N / 256, MT = TTOT / 256;
    for (int k = 0;; ++k) {
        int mt, nt; if (!xcd_tile(k, MT, NT, mt, nt)) break;
        EpiQKV epi{&p, mt * 256, nt * 256};
        gemm8_tile(g8_arows(H + (size_t)mt * 256 * DM, DM), g8_brows(W + (size_t)nt * 256 * DM, DM), DM / 64, epi, smem);
    }
}

struct EpiResid {
    const Params* p; int m0, n0, layer; bool from_input;
    DI void operator()(const f32x4 (&acc)[4][4], int rb, int cb, int fr, int fq) const {
        const int tok0 = m0 + rb, co = n0 + cb + fq * 4;
        const float* xin = (from_input ? xin_ptr(*p, tok0) : xrow_ptr(*p, tok0)) + (size_t)fr * DM + co;
        float* xo = xrow_ptr(*p, tok0) + (size_t)fr * DM + co;
        const float* gate = mod_ptr(*p, layer, tok0, 2) + co;
        f32x4 g[4], xi[2][4];
#pragma unroll
        for (int n = 0; n < 4; ++n) g[n] = *(const f32x4*)(gate + n * 16);
#pragma unroll
        for (int n = 0; n < 4; ++n) xi[0][n] = *(const f32x4*)(xin + n * 16);
#pragma unroll
        for (int m = 0; m < 4; ++m) {
            if (m < 3) {
#pragma unroll
                for (int n = 0; n < 4; ++n) xi[(m + 1) & 1][n] = *(const f32x4*)(xin + (size_t)(m + 1) * 16 * DM + n * 16);
            }
#pragma unroll
            for (int n = 0; n < 4; ++n) *(f32x4*)(xo + (size_t)m * 16 * DM + n * 16) = xi[m & 1][n] + g[n] * acc[m][n];
        }
    }
};
DI void phase_wout(const Params& p, char* smem) {
    const bf16_t* O = (const bf16_t*)(p.ws + OFF_SCR + S_O);
    const bf16_t* W = (const bf16_t*)(p.ws + OFF_WS) + W_OUT;
    constexpr int NT = 4, MT = TTOT / 256;
    for (int k = 0;; ++k) {
        int mt, nt; if (!xcd_tile(k, MT, NT, mt, nt)) break;
        EpiResid epi{&p, mt * 256, nt * 256, 0, true};
        gemm8_tile(g8_arows(O + (size_t)mt * 256 * DM, DM), g8_brows(W + (size_t)nt * 256 * DM, DM), DM / 64, epi, smem);
    }
}
DI void phase_wo(const Params& p, char* smem) {
    const bf16_t* O = (const bf16_t*)(p.ws + OFF_SCR + S_OR);
    const bf16_t* W = (const bf16_t*)(p.ws + OFF_WS) + W_O;
    constexpr int NT = 4, MTL = SEQ / 256;
    for (int k = 0;; ++k) {
        int mi, nt; if (!xcd_tile(k, NBATCH * MTL, NT, mi, nt)) break;
        const int b = mi / MTL, mt = b * (PTOT / 256) + 1 + (mi % MTL);
        EpiResid epi{&p, mt * 256, nt * 256, 1, false};
        gemm8_tile(g8_arows(O + (size_t)mt * 256 * DM, DM), g8_brows(W + (size_t)nt * 256 * DM, DM), DM / 64, epi, smem);
    }
}

struct MoeSched { int nt[16], base[17]; };
DI void moe_sched(const Params& p, int layer, MoeSched& s, int (&cnt)[16]) {
    const int* c = (const int*)(p.ws + OFF_CNT) + layer * 16;
    int acc = 0;
#pragma unroll
    for (int e = 0; e < 16; ++e) { cnt[e] = c[e]; s.nt[e] = (cnt[e] + 255) >> 8; s.base[e] = acc; acc += s.nt[e]; }
    s.base[16] = acc;
}
struct EpiMoe1 {
    bf16_t* hid;   int n0;
    DI void operator()(const f32x4 (&acc)[4][4], int rb, int cb, int fr, int fq) const {
        const int g = (n0 + cb) >> 6;
#pragma unroll
        for (int m = 0; m < 4; ++m) {
            bf16_t* dst = hid + (size_t)(rb + m * 16 + fr) * 1024 + g * 32 + fq * 4;
#pragma unroll
            for (int n = 0; n < 2; ++n) {
                const f32x4 a = acc[m][n], b = acc[m][n + 2];
                u32x2 o;
                o[0] = pk_bf16(siluf_(a[0]) * b[0], siluf_(a[1]) * b[1]);
                o[1] = pk_bf16(siluf_(a[2]) * b[2], siluf_(a[3]) * b[3]);
                *(u32x2*)(dst + n * 16) = o;
            }
        }
    }
};
DI void phase_moe1(const Params& p, int layer, char* smem) {
    MoeSched s; int cnt[16];
    moe_sched(p, layer, s, cnt);
    const bf16_t* H = (const bf16_t*)(p.ws + OFF_H);
    const bf16_t* W13 = (const bf16_t*)(p.ws + OFF_MOEW);
    const int* stok = (const int*)(p.ws + OFF_STOK);
    bf16_t* hid = (bf16_t*)(p.ws + OFF_SCR + S_HID);
    constexpr int NT = 8;
    const int total = s.base[16] * NT;
    for (int k = 0;; ++k) {
        int mg, nt; if (!xcd_tile(k, s.base[16], NT, mg, nt)) break;
        int e = 0;
#pragma unroll
        for (int i = 1; i < 16; ++i) if (mg >= s.base[i]) e = i;
        int ce = 0;
#pragma unroll
        for (int i = 0; i < 16; ++i) if (i == e) ce = cnt[i];
        int be = 0;
#pragma unroll
        for (int i = 0; i < 16; ++i) if (i == e) be = s.base[i];
        const int ml = mg - be;
        int R0, C0; g8_rc(R0, C0);
        G8Gather ag; ag.base = H;
#pragma unroll
        for (int q = 0; q < 4; ++q) {
            const int r = ml * 256 + R0 + 64 * (q & 1) + 128 * (q >> 1);
            const int tk = r < ce ? (stok[(size_t)e * CAP + r] >> 1) : 0;
            ag.o[q] = (unsigned)tk * 1024u + C0;
        }
        EpiMoe1 epi{hid + (size_t)mg * 256 * 1024, nt * 256};
        gemm8_tile(ag, g8_brows(W13 + (size_t)e * 2048 * 1024 + (size_t)nt * 256 * 1024, 1024), 16, epi, smem);
    }
}
struct EpiMoe2 {
    bf16_t* Y; const int* stok; const float* sw; int nvalid, n0;
    DI void operator()(const f32x4 (&acc)[4][4], int rb, int cb, int fr, int fq) const {
        int tkm[4]; float wm[4];
#pragma unroll
        for (int m = 0; m < 4; ++m) { tkm[m] = stok[rb + m * 16 + fr]; wm[m] = sw[rb + m * 16 + fr]; }
#pragma unroll
        for (int m = 0; m < 4; ++m) {
            const int r = rb + m * 16 + fr;
            if (r < nvalid) {
                const int tk = tkm[m]; const float w = wm[m];
                bf16_t* dst = Y + (size_t)tk * 1024 + n0 + cb + fq * 4;
#pragma unroll
                for (int n = 0; n < 4; ++n) { const f32x4 a = acc[m][n] * w; u32x2 o; o[0] = pk_bf16(a[0], a[1]); o[1] = pk_bf16(a[2], a[3]); *(u32x2*)(dst + n * 16) = o; }
            }
        }
    }
};
DI void phase_moe2(const Params& p, int layer, char* smem) {
    MoeSched s; int cnt[16];
    moe_sched(p, layer, s, cnt);
    const bf16_t* hid = (const bf16_t*)(p.ws + OFF_SCR + S_HID);
    const bf16_t* W2 = (const bf16_t*)(p.ws + OFF_MOEW) + (size_t)16 * 2048 * 1024;
    const int* stok = (const int*)(p.ws + OFF_STOK);
    const float* sw = (const float*)(p.ws + OFF_SW);
    bf16_t* Y = (bf16_t*)(p.ws + OFF_SCR + S_Y);
    constexpr int NT = 4;
    const int total = s.base[16] * NT;
    for (int k = 0;; ++k) {
        int mg, nt; if (!xcd_tile(k, s.base[16], NT, mg, nt)) break;
        int e = 0;
#pragma unroll
        for (int i = 1; i < 16; ++i) if (mg >= s.base[i]) e = i;
        int ce = 0, be = 0;
#pragma unroll
        for (int i = 0; i < 16; ++i) if (i == e) { ce = cnt[i]; be = s.base[i]; }
        const int ml = mg - be;
        EpiMoe2 epi{Y, stok + (size_t)e * CAP + ml * 256, sw + (size_t)e * CAP + ml * 256, ce - ml * 256, nt * 256};
        gemm8_tile(g8_arows(hid + (size_t)mg * 256 * 1024, 1024), g8_brows(W2 + (size_t)e * 1024 * 1024 + (size_t)nt * 256 * 1024, 1024), 16, epi, smem);
    }
}

struct EpiRwkv {
    bf16_t* dst; int ld, m0, n0, act, nstore;
    DI void operator()(const f32x4 (&acc)[4][4], int rb, int cb, int fr, int fq) const {
#pragma unroll
        for (int m = 0; m < 4; ++m) {
            bf16_t* d = dst + (size_t)(m0 + rb + m * 16 + fr) * ld + n0 + cb + fq * 4;
#pragma unroll
            for (int n = 0; n < 4; ++n) {
                const int c = n0 + cb + n * 16 + fq * 4;
                if (c >= ld) continue;
                f32x4 a = acc[m][n];
                if (act == 1) {
#pragma unroll
                    for (int j = 0; j < 4; ++j) { const float e = __expf(2.0f * a[j]); a[j] = 1.0f - 2.0f / (e + 1.0f); }
                }
                if (act == 2) {
#pragma unroll
                    for (int j = 0; j < 4; ++j) a[j] = sigmoidf_(a[j]);
                }
                if (c >= nstore) a = (f32x4){0.f, 0.f, 0.f, 0.f};
                u32x2 o; o[0] = pk_bf16(a[0], a[1]); o[1] = pk_bf16(a[2], a[3]);
                *(u32x2*)(d + n * 16) = o;
            }
        }
    }
};
DI void phase_rwkv_proj(const Params& p, char* smem) {
    const bf16_t* H = (const bf16_t*)(p.ws + OFF_H);
    const bf16_t* XX = (const bf16_t*)(p.ws + OFF_SCR + S_XX);
    const bf16_t* wsm = (const bf16_t*)(p.ws + OFF_WS);
    constexpr int MT = TTOT / 256, NU = 14;
    for (int u = blockIdx.x; u < MT * NU; u += gridDim.x) {
        const int mt = u / NU, q = u % NU;
        ALMix al{H + (size_t)mt * 256 * DM, XX + (size_t)mt * 256 * DM, (const LAS float*)(smem + GEMM_SMEM)};
        if (q < 13) {
            const int job = q < 4 ? 0 : q < 8 ? 1 : q < 12 ? 2 : 5, nt = q < 12 ? (q & 3) : 0;
            const int mixj = job == 0 ? 0 : job == 1 ? 2 : job == 2 ? 3 : 5;
            const size_t wofs = job == 0 ? W_R : job == 1 ? W_K : job == 2 ? W_V : W_G1;
            const size_t dofs = job == 0 ? S_R : job == 1 ? S_KK : job == 2 ? S_V : S_LG;
            al.set_mix(p.rwkv_x_mix + mixj * DM);
            EpiRwkv epi{(bf16_t*)(p.ws + OFF_SCR + dofs), job == 5 ? 192 : 1024, mt * 256, nt * 256, job == 5 ? 2 : 0, job == 5 ? 160 : 4096};
            gemm_tile<2>(al, wsm + wofs + (size_t)nt * 256 * DM, DM, DM / 64, epi, smem);
        } else {
#pragma unroll 1
            for (int j = 0; j < 2; ++j) {
                al.set_mix(p.rwkv_x_mix + (j == 0 ? 1 : 4) * DM);
                EpiRwkv epi{(bf16_t*)(p.ws + OFF_SCR + (j == 0 ? S_LW : S_LA)), 128, mt * 256, 0, j == 0 ? 1 : 0, 4096};
                gemm_tile<1>(al, wsm + (j == 0 ? W_W1 : W_A1), DM, DM / 64, epi, smem);
            }
        }
    }
}

struct EpiGate {
    const Params* p; int m0, n0;
    DI void operator()(const f32x4 (&acc)[4][4], int rb, int cb, int fr, int fq) const {
        const bf16_t* Y0 = (const bf16_t*)(p->ws + OFF_H);
        const bf16_t* Y1 = (const bf16_t*)(p->ws + OFF_SCR + S_Y1);
        const bf16_t* V = (const bf16_t*)(p->ws + OFF_SCR + S_V);
        const float* bonus = (const float*)(p->ws + OFF_BONUS2);
        bf16_t* O = (bf16_t*)(p->ws + OFF_SCR + S_OR);
        const int c0 = n0 + cb, hd = c0 >> 6;
#pragma unroll
        for (int m = 0; m < 4; ++m) {
            const int tok = m0 + rb + m * 16 + fr;
            const size_t ro = (size_t)tok * DM + c0 + fq * 4;
            f32x4 y[4];
            float s = 0.f;
#pragma unroll
            for (int n = 0; n < 4; ++n) {
                const u32x2 a = *(const u32x2*)(Y0 + ro + n * 16), b = *(const u32x2*)(Y1 + ro + n * 16);
                y[n][0] = bf_lo(a[0]) + bf_lo(b[0]); y[n][1] = bf_hi(a[0]) + bf_hi(b[0]); y[n][2] = bf_lo(a[1]) + bf_lo(b[1]); y[n][3] = bf_hi(a[1]) + bf_hi(b[1]);
                s += y[n][0] + y[n][1] + y[n][2] + y[n][3];
            }
            s += __shfl_xor(s, 16); s += __shfl_xor(s, 32);
            const float mu = s * (1.0f / 64.0f);
            float q = 0.f;
#pragma unroll
            for (int n = 0; n < 4; ++n) { const f32x4 d = y[n] - mu; q += d[0] * d[0] + d[1] * d[1] + d[2] * d[2] + d[3] * d[3]; }
            q += __shfl_xor(q, 16); q += __shfl_xor(q, 32);
            const float rs = rsqrtf(q * (1.0f / 64.0f) + GN_EPS);
            const float bon = (bonus[(size_t)tok * 16 + hd] + bonus[(size_t)(TTOT + tok) * 16 + hd]) + (bonus[(size_t)(2 * TTOT + tok) * 16 + hd] + bonus[(size_t)(3 * TTOT + tok) * 16 + hd]);
#pragma unroll
            for (int n = 0; n < 4; ++n) {
                const int c = c0 + n * 16 + fq * 4;
                const f32x4 g = *(const f32x4*)(p->rwkv_ln_g + c), bb = *(const f32x4*)(p->rwkv_ln_b + c);
                const u32x2 vv = *(const u32x2*)(V + ro + n * 16);
                const f32x4 v4 = {bf_lo(vv[0]), bf_hi(vv[0]), bf_lo(vv[1]), bf_hi(vv[1])};
                const f32x4 o = ((y[n] - mu) * rs * g + bb + bon * v4) * acc[m][n];
                u32x2 w; w[0] = pk_bf16(o[0], o[1]); w[1] = pk_bf16(o[2], o[3]);
                *(u32x2*)(O + ro + n * 16) = w;
            }
        }
    }
};
DI void phase_gate(const Params& p, char* smem) {
    const bf16_t* LG = (const bf16_t*)(p.ws + OFF_SCR + S_LG);
    const bf16_t* W = (const bf16_t*)(p.ws + OFF_WS) + W_G2;
    constexpr int NT = 8, MT = TTOT / 256;
    for (int k = 0;; ++k) {
        int mt, nt; if (!xcd_tile(k, MT, NT, mt, nt)) break;
        ALPlain al{LG + (size_t)mt * 256 * 192, 192};
        EpiGate epi{&p, mt * 256, nt * 128};
        gemm_tile<1>(al, W + (size_t)nt * 128 * 192, 192, 3, epi, smem);
    }
}

constexpr int KROW = 72, VROW = 68;
constexpr int ATT_SMEM = 2 * 64 * KROW * 2 + 2 * 64 * VROW * 2;
DI int crow_(int i, int h) { return (i & 3) + 8 * (i >> 2) + 4 * h; }
#define MFMA32(a, b, c) __builtin_amdgcn_mfma_f32_32x32x16_bf16((a), (b), (c), 0, 0, 0)
template <int MODE>
DI void attn_unit(const Params& p, const bf16_t* Qg  , int nq_valid, const bf16_t* Kg  , const bf16_t* Vg  ,
                  int ta0, int ta1, int tb0, int tb1  , bool band, int q_lat0  ,
                  float init_m, float init_l0, bf16_t* Og  , char* smem) {
    const int t = tidx(), lane = t & 63, wid = t >> 6, r = lane & 31, h = lane >> 5;
    bf16_t* sK = (bf16_t*)smem;
    bf16_t* sV = sK + 2 * 64 * KROW;
    bf16x8 qf[2][4];
#pragma unroll
    for (int qs = 0; qs < 2; ++qs) {
        const int qi = wid * 64 + qs * 32 + r;
        const bf16_t* qp = Qg + (size_t)(qi < nq_valid ? qi : 0) * 64 + 8 * h;
#pragma unroll
        for (int ks = 0; ks < 4; ++ks) qf[qs][ks] = *(const bf16x8*)(qp + ks * 16);
    }
#pragma unroll
    for (int qs = 0; qs < 2; ++qs)
#pragma unroll
        for (int ks = 0; ks < 4; ++ks) asm volatile("" : "+v"(qf[qs][ks]));
    f32x16 o[2][2];
#pragma unroll
    for (int qs = 0; qs < 2; ++qs)
#pragma unroll
        for (int dt = 0; dt < 2; ++dt)
#pragma unroll
            for (int i = 0; i < 16; ++i) o[qs][dt][i] = 0.f;
    float mrun[2], lrun[2];
#pragma unroll
    for (int qs = 0; qs < 2; ++qs) { mrun[qs] = init_m; lrun[qs] = (MODE == 1 && h == 0) ? init_l0 : 0.f; }
    const int ntile = ((ta1 - ta0) + (tb1 - tb0)) >> 6;
    const int lrow = t >> 3, lch = (t & 7) * 8;
    u32x4 rk, rv;
    auto tile_pos = [&](int i) { const int a = (ta1 - ta0) >> 6; return i < a ? ta0 + i * 64 : tb0 + (i - a) * 64; };
    {
        const int kp = tile_pos(0);
        rk = *(const u32x4*)(Kg + (size_t)(kp + lrow) * 64 + lch);
        rv = *(const u32x4*)(Vg + (size_t)lrow * PTOT + kp + lch);
        *(u32x4*)(sK + lrow * KROW + lch) = rk;
        *(u32x2*)(sV + lrow * VROW + lch) = (u32x2){rv[0], rv[1]};
        *(u32x2*)(sV + lrow * VROW + lch + 4) = (u32x2){rv[2], rv[3]};
    }
    __syncthreads();
    for (int it = 0; it < ntile; ++it) {
        const int cur = it & 1;
        const bool more = it + 1 < ntile;
        const int kp = tile_pos(it);
        if (more) {
            const int kn = tile_pos(it + 1);
            rk = *(const u32x4*)(Kg + (size_t)(kn + lrow) * 64 + lch);
            rv = *(const u32x4*)(Vg + (size_t)lrow * PTOT + kn + lch);
        }
        __builtin_amdgcn_sched_barrier(0);
        const bf16_t* cK = sK + cur * 64 * KROW;
        const bf16_t* cV = sV + cur * 64 * VROW;
        bf16x8 kf[4];
#pragma unroll
        for (int ks = 0; ks < 4; ++ks) kf[ks] = *(const bf16x8*)(cK + r * KROW + ks * 16 + 8 * h);
#pragma unroll
        for (int ksub = 0; ksub < 2; ++ksub) {
            bf16x8 vf[2][2];
#pragma unroll
            for (int st = 0; st < 2; ++st)
#pragma unroll
                for (int dt = 0; dt < 2; ++dt) {
                    const int kb = ksub * 32 + 16 * st + 4 * h;
                    const s16x4 lo = *(const s16x4*)(cV + (dt * 32 + r) * VROW + kb), hi = *(const s16x4*)(cV + (dt * 32 + r) * VROW + kb + 8);
                    vf[st][dt] = __builtin_shufflevector(lo, hi, 0, 1, 2, 3, 4, 5, 6, 7);
                }
            __builtin_amdgcn_sched_barrier(0);
            f32x16 sc[2];
#pragma unroll
            for (int qs = 0; qs < 2; ++qs)
#pragma unroll
                for (int i = 0; i < 16; ++i) sc[qs][i] = MODE == 0 ? init_m : 0.f;
#pragma unroll
            for (int ks = 0; ks < 4; ++ks)
#pragma unroll
                for (int qs = 0; qs < 2; ++qs) sc[qs] = MFMA32(kf[ks], qf[qs][ks], sc[qs]);
            __builtin_amdgcn_sched_barrier(0);
            if (ksub == 0) {
#pragma unroll
                for (int ks = 0; ks < 4; ++ks) kf[ks] = *(const bf16x8*)(cK + (32 + r) * KROW + ks * 16 + 8 * h);
            }
            __builtin_amdgcn_sched_barrier(0);
#pragma unroll
            for (int qs = 0; qs < 2; ++qs) {
                if (MODE == 1) {
                    if (band && kp >= LCTX) {
                        const int qlat = q_lat0 + wid * 64 + qs * 32 + r, kl0 = kp - LCTX + ksub * 32;
#pragma unroll
                        for (int i = 0; i < 16; ++i) {
                            const int d0 = qlat - (kl0 + crow_(i, h));
                            if (d0 > 128 || d0 < -128) sc[qs][i] = -1e30f;
                        }
                    }
                    float mt = sc[qs][0];
#pragma unroll
                    for (int i = 1; i < 16; ++i) mt = fmaxf(mt, sc[qs][i]);
                    mt = fmaxf(mt, __shfl_xor(mt, 32));
                    const float mnew = fmaxf(mrun[qs], mt);
                    const float alpha = __builtin_amdgcn_exp2f(mrun[qs] - mnew);
                    mrun[qs] = mnew; lrun[qs] *= alpha;
#pragma unroll
                    for (int i = 0; i < 16; ++i) { o[qs][0][i] *= alpha; o[qs][1][i] *= alpha; }
#pragma unroll
                    for (int i = 0; i < 16; ++i) sc[qs][i] -= mnew;
                }
                float ls = 0.f;
#pragma unroll
                for (int i = 0; i < 16; ++i) { sc[qs][i] = __builtin_amdgcn_exp2f(sc[qs][i]); ls += sc[qs][i]; }
                lrun[qs] += ls;
            }
#pragma unroll
            for (int st = 0; st < 2; ++st) {
                bf16x8 pf[2];
#pragma unroll
                for (int qs = 0; qs < 2; ++qs) {
                    u32x4 pw;
#pragma unroll
                    for (int j = 0; j < 4; ++j) pw[j] = pk_bf16(sc[qs][8 * st + 2 * j], sc[qs][8 * st + 2 * j + 1]);
                    pf[qs] = __builtin_bit_cast(bf16x8, pw);
                }
#pragma unroll
                for (int dt = 0; dt < 2; ++dt)
#pragma unroll
                    for (int qs = 0; qs < 2; ++qs) o[qs][dt] = MFMA32(vf[st][dt], pf[qs], o[qs][dt]);
            }
        }
        if (more) {
            bf16_t* nK = sK + (cur ^ 1) * 64 * KROW;
            bf16_t* nV = sV + (cur ^ 1) * 64 * VROW;
            *(u32x4*)(nK + lrow * KROW + lch) = rk;
            *(u32x2*)(nV + lrow * VROW + lch) = (u32x2){rv[0], rv[1]};
            *(u32x2*)(nV + lrow * VROW + lch + 4) = (u32x2){rv[2], rv[3]};
        }
        __syncthreads();
    }
#pragma unroll
    for (int qs = 0; qs < 2; ++qs) {
        const int qi = wid * 64 + qs * 32 + r;
        const float lt = lrun[qs] + __shfl_xor(lrun[qs], 32);
        const float invl = 1.0f / lt;
        if (qi < nq_valid) {
            bf16_t* op = Og + (size_t)qi * DM;
#pragma unroll
            for (int g = 0; g < 4; ++g) {
                u32x2 w0, w1;
                w0[0] = pk_bf16(o[qs][0][4 * g] * invl, o[qs][0][4 * g + 1] * invl); w0[1] = pk_bf16(o[qs][0][4 * g + 2] * invl, o[qs][0][4 * g + 3] * invl);
                w1[0] = pk_bf16(o[qs][1][4 * g] * invl, o[qs][1][4 * g + 1] * invl); w1[1] = pk_bf16(o[qs][1][4 * g + 2] * invl, o[qs][1][4 * g + 3] * invl);
                *(u32x2*)(op + 8 * g + 4 * h) = w0;
                *(u32x2*)(op + 32 + 8 * g + 4 * h) = w1;
            }
        }
    }
}
DI void phase_attn(const Params& p, char* smem) {
    const bf16_t* Q = (const bf16_t*)(p.ws + OFF_SCR + S_Q);
    const bf16_t* K = (const bf16_t*)(p.ws + OFF_SCR + S_K);
    const bf16_t* VT = (const bf16_t*)(p.ws + OFF_SCR + S_VT);
    bf16_t* O = (bf16_t*)(p.ws + OFF_SCR + S_O);
    float gq = 0.f, gk = 0.f;
    for (int i = 0; i < 64; ++i) { gq = fmaxf(gq, fabsf(p.attn_q_norm_g[i])); gk = fmaxf(gk, fabsf(p.attn_k_norm_g[i])); }
    const float M2 = 8.25f * gq * gk * LOG2E;
    constexpr int QB = 512, NQB = SEQ / QB;
    const int G = gridDim.x;
    constexpr int NDENSE = NBATCH * 8 * NQB;
    for (int u = blockIdx.x; u < NDENSE; u += G) {
        int combo, within;
        if ((G & 7) == 0 && NDENSE % G == 0) {
            const int xcd = blockIdx.x & 7, idx = (blockIdx.x >> 3) + (G >> 3) * (u / G);
            combo = xcd & 3; within = (xcd >> 2) * (NDENSE / 8) + idx;
        } else { combo = u / (4 * NQB); within = u % (4 * NQB); }
        const int b = combo >> 1, kvh = combo & 1, hq = kvh * 4 + (within & 3), qb = within >> 2;
        const bf16_t* Qg = Q + ((size_t)(b * 16 + 8 + hq) * PTOT + LCTX + qb * QB) * 64;
        attn_unit<0>(p, Qg, QB, K + (size_t)(b * 4 + 2 + kvh) * PTOT * 64, VT + (size_t)(b * 4 + 2 + kvh) * 64 * PTOT, 0, PTOT, 0, 0, false, 0, -M2, 0.f,
                     O + (size_t)(b * PTOT + LCTX + qb * QB) * DM + (8 + hq) * 64, smem);
    }
    for (int u = blockIdx.x; u < NDENSE; u += G) {
        const int b = u / (8 * NQB), rem = u % (8 * NQB), qb = rem >> 3, hq = rem & 7, kvh = hq >> 2;
        const int i0 = qb * QB;
        const int lo = i0 - 128 < 0 ? 0 : i0 - 128, hi = i0 + QB + 128 > SEQ ? SEQ : i0 + QB + 128;
        const bf16_t* Qg = Q + ((size_t)(b * 16 + hq) * PTOT + LCTX + i0) * 64;
        attn_unit<1>(p, Qg, QB, K + (size_t)(b * 4 + kvh) * PTOT * 64, VT + (size_t)(b * 4 + kvh) * 64 * PTOT, 0, LCTX, LCTX + lo, LCTX + hi, true, i0,
                     p.attn_sink[hq] * LOG2E, 1.0f, O + (size_t)(b * PTOT + LCTX + i0) * DM + hq * 64, smem);
    }
    for (int u = blockIdx.x; u < NBATCH * 16; u += G) {
        const int b = u >> 4, hh = u & 15, isb = hh >> 3, hq = hh & 7, kvh = isb * 2 + (hq >> 2);
        const bf16_t* Qg = Q + ((size_t)(b * 16 + hh) * PTOT) * 64;
        attn_unit<1>(p, Qg, LCTX, K + (size_t)(b * 4 + kvh) * PTOT * 64, VT + (size_t)(b * 4 + kvh) * 64 * PTOT, 0, LCTX, 0, 0, false, 0,
                     isb ? -1e30f : p.attn_sink[hq] * LOG2E, isb ? 0.f : 1.0f, O + (size_t)(b * PTOT) * DM + hh * 64, smem);
    }
}

constexpr int TB = 32, NBUF = 3;
constexpr int SC_REC = 5 * 64;
constexpr int SC_OPS = TB * SC_REC * 4;
constexpr int SC_SMEM = NBUF * SC_OPS + NBUF * TB * 16 * 4 + NBUF * TB * 16 * 4 + 64;
DI int scan_pos(int n, int dir) {
    if (n < LCTX) return dir ? LCTX - 1 - n : n;
    const int m = n - LCTX;
    return LCTX + (dir ? SEQ - 1 - m : m);
}
template <int CTRL> DI float dpp_add(float v) { return v + __builtin_bit_cast(float, __builtin_amdgcn_update_dpp(0, __builtin_bit_cast(int, v), CTRL, 0xf, 0xf, false)); }
DI float row16_sum(float v) { v = dpp_add<0x128>(v); v = dpp_add<0x124>(v); v = dpp_add<0x122>(v); v = dpp_add<0x121>(v); return v; }
DI int lds_min4(int* c) { const volatile LAS int* q = (const volatile LAS int*)c; const int a = q[0], b = q[1], d = q[2], e = q[3]; return min(min(a, b), min(d, e)); }
DI void lds_publish(int* c, int v) { *(volatile LAS int*)c = v; }
DI void scan_unit(const Params& p, int u, char* smem) {
    const int t = tidx(), lane = t & 63, wid = __builtin_amdgcn_readfirstlane(t >> 6);
    const unsigned rg = u & 3, dir = (u >> 2) & 1, hd = (u >> 3) & 15, b = u >> 7;
    float* ops = (float*)smem;
    float* vbuf = (float*)(smem + NBUF * SC_OPS);
    float* ybuf = vbuf + NBUF * TB * 16;
    int* cnts = (int*)(ybuf + NBUF * TB * 16);
    const bf16_t* R = (const bf16_t*)(p.ws + OFF_SCR + S_R);
    const bf16_t* Kk = (const bf16_t*)(p.ws + OFF_SCR + S_KK);
    const bf16_t* V = (const bf16_t*)(p.ws + OFF_SCR + S_V);
    const bf16_t* LW = (const bf16_t*)(p.ws + OFF_SCR + S_LW);
    const bf16_t* LA = (const bf16_t*)(p.ws + OFF_SCR + S_LA);
    bf16_t* Yo = dir ? (bf16_t*)(p.ws + OFF_SCR + S_Y1) : (bf16_t*)(p.ws + OFF_H);
    float* bonus = (float*)(p.ws + OFF_BONUS2);
    const unsigned tokb = b * PTOT, hc = hd * 64;
    constexpr int NBLK = PTOT / TB;
    const unsigned fr = lane & 15, fq = lane >> 4;
    if (t < 8) cnts[t] = 0;
    __syncthreads();

    if (wid < 4) {
        __builtin_amdgcn_s_setprio(3);
        float s0 = 0.f, s1 = 0.f, s2 = 0.f, s3 = 0.f;
        const unsigned g = lane >> 4, c4 = (lane & 15) * 4, myrow = wid * 4 + g;
        for (int blk = 0; blk < NBLK; ++blk) {
            const unsigned buf = (unsigned)blk % NBUF;
            while (lds_min4(cnts) < blk + 1) __builtin_amdgcn_s_sleep(1);
            asm volatile("" ::: "memory");
            const float* rec = ops + buf * (TB * SC_REC) + c4;
            const float* vb = vbuf + buf * (TB * 16) + myrow;
            float* yb = ybuf + buf * (TB * 16) + myrow;
            f32x4 w0_ = *(const f32x4*)(rec), kd0_ = *(const f32x4*)(rec + 64), bb0_ = *(const f32x4*)(rec + 128), aa0_ = *(const f32x4*)(rec + 192), rr0_ = *(const f32x4*)(rec + 256);
            float vv0_ = vb[0];
#define SCAN_STEP(W, KD, BB, AA, RR, VV, ST) { \
                float sa = s0 * AA[0] + s1 * AA[1] + s2 * AA[2] + s3 * AA[3]; \
                sa = row16_sum(sa); \
                s0 = s0 * W[0] + sa * BB[0] + VV * KD[0]; \
                s1 = s1 * W[1] + sa * BB[1] + VV * KD[1]; \
                s2 = s2 * W[2] + sa * BB[2] + VV * KD[2]; \
                s3 = s3 * W[3] + sa * BB[3] + VV * KD[3]; \
                float y = s0 * RR[0] + s1 * RR[1] + s2 * RR[2] + s3 * RR[3]; \
                y = row16_sum(y); \
                if ((lane & 15) == 0) yb[(ST) * 16] = y; }
#pragma unroll 1
            for (int st = 0; st < TB; st += 2) {
                const float* r1 = rec + (st + 1) * SC_REC;
                const f32x4 w1_ = *(const f32x4*)(r1), kd1_ = *(const f32x4*)(r1 + 64), bb1_ = *(const f32x4*)(r1 + 128), aa1_ = *(const f32x4*)(r1 + 192), rr1_ = *(const f32x4*)(r1 + 256);
                const float vv1_ = vb[(st + 1) * 16];
                SCAN_STEP(w0_, kd0_, bb0_, aa0_, rr0_, vv0_, st)
                const int st2 = st + 2 < TB ? st + 2 : st;
                const float* r2 = rec + st2 * SC_REC;
                w0_ = *(const f32x4*)(r2); kd0_ = *(const f32x4*)(r2 + 64); bb0_ = *(const f32x4*)(r2 + 128); aa0_ = *(const f32x4*)(r2 + 192); rr0_ = *(const f32x4*)(r2 + 256);
                vv0_ = vb[st2 * 16];
                SCAN_STEP(w1_, kd1_, bb1_, aa1_, rr1_, vv1_, st + 1)
            }
#undef SCAN_STEP
            asm volatile("s_waitcnt lgkmcnt(0)" ::: "memory");
            if (lane == 0) lds_publish(cnts + 4 + wid, blk + 1);
        }
        __builtin_amdgcn_s_setprio(0);
    } else {
        const unsigned wt = wid & 1, chh = (wid >> 1) & 1;
        const bf16_t* wsm = (const bf16_t*)(p.ws + OFF_WS);
        const unsigned wo = W_W2 + dir * 65536u + (hc + fr) * 64u + fq * 8u;
        const unsigned ao = W_A2 + dir * 65536u + (hc + fr) * 64u + fq * 8u;
        const unsigned po = hc + fq * 4u;
        for (int blk = 0; blk < NBLK + NBUF; ++blk) {
            const unsigned buf = (unsigned)blk % NBUF;
            const int need = blk - NBUF + 1 < NBLK ? blk - NBUF + 1 : NBLK;
            while (lds_min4(cnts + 4) < need) __builtin_amdgcn_s_sleep(1);
            asm volatile("" ::: "memory");
            if (wid == 7 && blk >= NBUF) {
#pragma unroll
                for (int i = 0; i < TB * 16 / 64; ++i) {
                    const unsigned id = i * 64 + lane, st = id >> 4, rw = id & 15;
                    const unsigned tok = tokb + scan_pos((blk - NBUF) * TB + st, dir);
                    Yo[tok * 1024u + hc + rg * 16 + rw] = (bf16_t)(pk_bf16(ybuf[buf * (TB * 16) + id], 0.f) & 0xffffu);
                }
            }
            if (blk >= NBLK) continue;
            const unsigned st = wt * 16 + fr;
            const unsigned tok = tokb + scan_pos(blk * TB + st, dir);
            const unsigned lo = tok * 128u + dir * 64u + fq * 8u;
            const unsigned ro = tok * 1024u + hc + fq * 4u;
            bf16x8 lwf[2], laf[2];
#pragma unroll
            for (int kk = 0; kk < 2; ++kk) { lwf[kk] = *(const bf16x8*)(LW + lo + kk * 32); laf[kk] = *(const bf16x8*)(LA + lo + kk * 32); }
            float ssq = 0.f;
#pragma unroll
            for (int nt = 0; nt < 4; ++nt) {
                const f32x4 kkv = *(const f32x4*)(p.rwkv_k_k + po + nt * 16);
                const u32x2 c = *(const u32x2*)(Kk + ro + nt * 16);
                const float q0 = bf_lo(c[0]) * kkv[0], q1 = bf_hi(c[0]) * kkv[1], q2 = bf_lo(c[1]) * kkv[2], q3 = bf_hi(c[1]) * kkv[3];
                ssq += q0 * q0 + q1 * q1 + q2 * q2 + q3 * q3;
            }
            ssq += __shfl_xor(ssq, 16); ssq += __shfl_xor(ssq, 32);
            const float kn = __builtin_amdgcn_rsqf(fmaxf(ssq, 1e-24f));
            float* rec = ops + buf * (TB * SC_REC) + st * SC_REC + fq * 4;
            float bsum = 0.f;
#pragma unroll
            for (int n2 = 0; n2 < 2; ++n2) {
                const unsigned nt = chh * 2 + n2;
                f32x4 aw = {0.f, 0.f, 0.f, 0.f}, ai = aw;
#pragma unroll
                for (int kk = 0; kk < 2; ++kk) {
                    const bf16x8 w2f = *(const bf16x8*)(wsm + wo + nt * 1024 + kk * 32), a2f = *(const bf16x8*)(wsm + ao + nt * 1024 + kk * 32);
                    aw = __builtin_amdgcn_mfma_f32_16x16x32_bf16(w2f, lwf[kk], aw, 0, 0, 0);
                    ai = __builtin_amdgcn_mfma_f32_16x16x32_bf16(a2f, laf[kk], ai, 0, 0, 0);
                }
                const f32x4 w0v = *(const f32x4*)(p.rwkv_decay_w0 + dir * 1024u + po + nt * 16), a0v = *(const f32x4*)(p.rwkv_iclr_a0 + dir * 1024u + po + nt * 16);
                const f32x4 kkv = *(const f32x4*)(p.rwkv_k_k + po + nt * 16);
                const f32x4 kav = *(const f32x4*)(p.rwkv_k_a + po + nt * 16), rkv = *(const f32x4*)(p.rwkv_r_k + po + nt * 16);
                const u32x2 a = *(const u32x2*)(R + ro + nt * 16), c = *(const u32x2*)(Kk + ro + nt * 16);
                const f32x4 rr = {bf_lo(a[0]), bf_hi(a[0]), bf_lo(a[1]), bf_hi(a[1])};
                const f32x4 kr = {bf_lo(c[0]), bf_hi(c[0]), bf_lo(c[1]), bf_hi(c[1])};
                f32x4 wv, kd, bb, aa;
#pragma unroll
                for (int j = 0; j < 4; ++j) {
                    const float sg = __builtin_amdgcn_rcpf(1.0f + __builtin_amdgcn_exp2f(-(w0v[j] + aw[j]) * LOG2E));
                    wv[j] = __builtin_amdgcn_exp2f(sg * (-0.6065306597126334f * LOG2E));
                    const float ic = __builtin_amdgcn_rcpf(1.0f + __builtin_amdgcn_exp2f(-(a0v[j] + ai[j]) * LOG2E));
                    const float kkn = kr[j] * kkv[j] * kn;
                    kd[j] = kr[j] * (1.0f + (ic - 1.0f) * kav[j]);
                    bb[j] = kkn * ic;
                    aa[j] = -kkn;
                    bsum += rr[j] * kd[j] * rkv[j];
                }
                *(f32x4*)(rec + 0 * 64 + nt * 16) = wv;
                *(f32x4*)(rec + 1 * 64 + nt * 16) = kd;
                *(f32x4*)(rec + 2 * 64 + nt * 16) = bb;
                *(f32x4*)(rec + 3 * 64 + nt * 16) = aa;
                *(f32x4*)(rec + 4 * 64 + nt * 16) = rr;
            }
            bsum += __shfl_xor(bsum, 16); bsum += __shfl_xor(bsum, 32);
            if (rg == 0 && fq == 0) bonus[((chh * 2 + dir) * TTOT + tok) * 16u + hd] = bsum;
            if (wid == 6) {
                bf16_t vr[TB * 16 / 64];
#pragma unroll
                for (int i = 0; i < TB * 16 / 64; ++i) {
                    const unsigned id = i * 64 + lane, s2 = id >> 4, rw = id & 15;
                    const unsigned tk = tokb + scan_pos(blk * TB + s2, dir);
                    vr[i] = V[tk * 1024u + hc + rg * 16 + rw];
                }
#pragma unroll
                for (int i = 0; i < TB * 16 / 64; ++i) vbuf[buf * (TB * 16) + i * 64 + lane] = bf2f(vr[i]);
            }
            asm volatile("s_waitcnt lgkmcnt(0)" ::: "memory");
            if (lane == 0) lds_publish(cnts + (wid - 4), blk + 1);
        }
    }
    __syncthreads();
}

constexpr int CH = 16, NCHK = PTOT / CH;
constexpr int NPREP = 7, NSLOT = 2;
constexpr int TKS = 72, KTS = 20, SMS = 20;
constexpr int SL_PT = 0, SL_QM = SL_PT + 64 * TKS * 2, SL_RT = SL_QM + 64 * KTS * 2, SL_G2 = SL_RT + 16 * TKS * 2, SL_VT = SL_G2 + 16 * SMS * 2, SL_WC = SL_VT + 16 * SMS * 2,
              SLOT_BYTES = SL_WC + 64 * 4;
constexpr int XTK_B = 16 * TKS * 2, XKT_B = 64 * KTS * 2, SM_B = 16 * SMS * 2;
constexpr int PR_XA = 0, PR_XB = PR_XA + XTK_B, PR_XK = PR_XB + XTK_B, PR_XR = PR_XK + XTK_B, PR_TA = PR_XR + XTK_B, PR_TB = PR_TA + XKT_B, PR_TK = PR_TB + XKT_B,
              PR_SN = PR_TK + XKT_B, PREP_BYTES = PR_SN + 2 * SM_B;
static_assert(10 * SM_B <= 3 * XTK_B, "matrices fit in XA..XK");
constexpr int SC2_SMEM = NSLOT * SLOT_BYTES + NPREP * PREP_BYTES + 64 + 5 * 64 * 4;
typedef short s16x4v __attribute__((ext_vector_type(4)));
DI f32x4 mfma16(s16x4v a, s16x4v b, f32x4 c) { return __builtin_amdgcn_mfma_f32_16x16x16bf16_1k(a, b, c, 0, 0, 0); }
DI f32x4 mfma32(bf16x8 a, bf16x8 b, f32x4 c) { return __builtin_amdgcn_mfma_f32_16x16x32_bf16(a, b, c, 0, 0, 0); }
DI s16x4v ld4(const bf16_t* q) { return *(const s16x4v*)q; }
DI f32x4 up4(u32x2 w) { return (f32x4){bf_lo(w[0]), bf_hi(w[0]), bf_lo(w[1]), bf_hi(w[1])}; }
DI f32x4 ld4f(const bf16_t* q) { return up4(*(const u32x2*)q); }
DI void st4(bf16_t* q, f32x4 v) { u32x2 w; w[0] = pk_bf16(v[0], v[1]); w[1] = pk_bf16(v[2], v[3]); *(u32x2*)q = w; }
#define LDS_WAIT() asm volatile("s_waitcnt lgkmcnt(0)" ::: "memory")
template <int CTRL> DI float dpp_shr_add(float v) { return v + __builtin_bit_cast(float, __builtin_amdgcn_update_dpp(0, __builtin_bit_cast(int, v), CTRL, 0xf, 0xf, true)); }
DI float row16_prefix(float v) { v = dpp_shr_add<0x111>(v); v = dpp_shr_add<0x112>(v); v = dpp_shr_add<0x114>(v); v = dpp_shr_add<0x118>(v); return v; }
DI f32x4 mm16(const bf16_t* A, const bf16_t* Bt, int fr, int fq) {
    const s16x4v a = ld4(A + fr * SMS + fq * 4), b = ld4(Bt + fr * SMS + fq * 4);
    LDS_WAIT();
    return mfma16(a, b, (f32x4){0.f, 0.f, 0.f, 0.f});
}
DI f32x4 mm16p(const bf16_t* A, const bf16_t* Bt, const bf16_t* Add, int fr, int fq) {
    const s16x4v a = ld4(A + fr * SMS + fq * 4), b = ld4(Bt + fr * SMS + fq * 4);
    const u32x2 c = *(const u32x2*)(Add + fr * SMS + fq * 4);
    LDS_WAIT();
    return mfma16(a, b, up4(c));
}

DI void scan_unit_chunked(const Params& p, int u, char* smem) {
    const int t = tidx(), lane = t & 63, wid = __builtin_amdgcn_readfirstlane(t >> 6);
    const unsigned rg = u & 3, dir = (u >> 2) & 1, hd = (u >> 3) & 15, b = u >> 7;
    const unsigned tokb = b * PTOT, hc = hd * 64;
    const unsigned fr = lane & 15, fq = lane >> 4;
    char* slots = smem;
    char* prep0 = smem + NSLOT * SLOT_BYTES;
    int* cnts = (int*)(smem + NSLOT * SLOT_BYTES + NPREP * PREP_BYTES);
    const bf16_t* R = (const bf16_t*)(p.ws + OFF_SCR + S_R);
    const bf16_t* Kk = (const bf16_t*)(p.ws + OFF_SCR + S_KK);
    const bf16_t* V = (const bf16_t*)(p.ws + OFF_SCR + S_V);
    const bf16_t* LW = (const bf16_t*)(p.ws + OFF_SCR + S_LW);
    const bf16_t* LA = (const bf16_t*)(p.ws + OFF_SCR + S_LA);
    bf16_t* Yo = dir ? (bf16_t*)(p.ws + OFF_SCR + S_Y1) : (bf16_t*)(p.ws + OFF_H);
    float* bonus = (float*)(p.ws + OFF_BONUS2);
    float* prm = (float*)(cnts + 16);
    if (t < 16) cnts[t] = 0;
    if (t < 64) {
        prm[t] = p.rwkv_decay_w0[dir * 1024u + hc + t]; prm[64 + t] = p.rwkv_iclr_a0[dir * 1024u + hc + t];
        prm[128 + t] = p.rwkv_k_k[hc + t]; prm[192 + t] = p.rwkv_k_a[hc + t]; prm[256 + t] = p.rwkv_r_k[hc + t];
    }
    __syncthreads();

    if (wid == 0) {
        __builtin_amdgcn_s_setprio(3);
        f32x4 st[4];
#pragma unroll
        for (int m = 0; m < 4; ++m) st[m] = (f32x4){0.f, 0.f, 0.f, 0.f};
        for (int c = 0; c < NCHK; ++c) {
            const unsigned sl = (unsigned)c % NSLOT;
            const char* S = slots + sl * SLOT_BYTES;
            while (*(volatile LAS int*)(cnts + sl) < c + 1) __builtin_amdgcn_s_sleep(1);
            LDS_WAIT();
            const s16x4v vt = ld4((const bf16_t*)(S + SL_VT) + fr * SMS + fq * 4);
            const s16x4v g2 = ld4((const bf16_t*)(S + SL_G2) + fr * SMS + fq * 4);
            s16x4v rtl[2], rth[2], ptl[4][2], pth[4][2], qm[4];
            f32x4 wc[4];
#pragma unroll
            for (int i = 0; i < 2; ++i) { const bf16_t* q = (const bf16_t*)(S + SL_RT) + fr * TKS + 32 * i + fq * 4; rtl[i] = ld4(q); rth[i] = ld4(q + 16); }
#pragma unroll
            for (int m = 0; m < 4; ++m) {
                wc[m] = *(const f32x4*)((const float*)(S + SL_WC) + 16 * m + fq * 4);
                qm[m] = ld4((const bf16_t*)(S + SL_QM) + (16 * m + fr) * KTS + fq * 4);
#pragma unroll
                for (int i = 0; i < 2; ++i) { const bf16_t* q = (const bf16_t*)(S + SL_PT) + (16 * m + fr) * TKS + 32 * i + fq * 4; ptl[m][i] = ld4(q); pth[m][i] = ld4(q + 16); }
            }
            LDS_WAIT();
            if (lane == 0) *(volatile LAS int*)(cnts + 8) = c + 1;
            bf16x8 sb[2];
#pragma unroll
            for (int i = 0; i < 2; ++i) {
                u32x4 w; w[0] = pk_bf16(st[2 * i][0], st[2 * i][1]); w[1] = pk_bf16(st[2 * i][2], st[2 * i][3]); w[2] = pk_bf16(st[2 * i + 1][0], st[2 * i + 1][1]); w[3] = pk_bf16(st[2 * i + 1][2], st[2 * i + 1][3]);
                sb[i] = __builtin_bit_cast(bf16x8, w);
            }
            f32x4 y = {0.f, 0.f, 0.f, 0.f};
#pragma unroll
            for (int i = 0; i < 2; ++i) y = mfma32(__builtin_shufflevector(rtl[i], rth[i], 0, 1, 2, 3, 4, 5, 6, 7), sb[i], y);
            y = mfma16(g2, vt, y);
#pragma unroll
            for (int m = 0; m < 4; ++m) {
                f32x4 acc = st[m] * wc[m];
#pragma unroll
                for (int i = 0; i < 2; ++i) acc = mfma32(__builtin_shufflevector(ptl[m][i], pth[m][i], 0, 1, 2, 3, 4, 5, 6, 7), sb[i], acc);
                st[m] = mfma16(qm[m], vt, acc);
            }

#pragma unroll
            for (int j = 0; j < 4; ++j) {
                const unsigned tok = tokb + scan_pos(c * CH + fq * 4 + j, dir);
                Yo[tok * 1024u + hc + rg * 16 + fr] = (bf16_t)(pk_bf16(y[j], 0.f) & 0xffffu);
            }
        }
        __builtin_amdgcn_s_setprio(0);
    } else {
        const unsigned pid = wid - 1;
        char* PS = prep0 + pid * PREP_BYTES;
        bf16_t* XA = (bf16_t*)(PS + PR_XA); bf16_t* XB = (bf16_t*)(PS + PR_XB); bf16_t* XK = (bf16_t*)(PS + PR_XK); bf16_t* XR = (bf16_t*)(PS + PR_XR);
        bf16_t* TA = (bf16_t*)(PS + PR_TA); bf16_t* TB_ = (bf16_t*)(PS + PR_TB); bf16_t* TK = (bf16_t*)(PS + PR_TK); bf16_t* AT = TA;
        bf16_t* SN = (bf16_t*)(PS + PR_SN);
        bf16_t *M = SN, *NABR = SN + 1 * 16 * SMS;
        bf16_t *M2 = XA, *M2T = XA + 1 * 16 * SMS, *M4 = XA + 2 * 16 * SMS, *M4T = XA + 3 * 16 * SMS, *X1 = XA + 4 * 16 * SMS, *G1 = XA + 5 * 16 * SMS, *NAKR = XA + 6 * 16 * SMS,
                *NRBT = XA + 7 * 16 * SMS, *NRKT = XA + 8 * 16 * SMS, *IM = XA + 9 * 16 * SMS;
        bf16_t *M8T = M2, *X2 = M2T, *TT = M4;
        float* WCP = (float*)SN;
        const bf16_t* wsm = (const bf16_t*)(p.ws + OFF_WS);
        const unsigned wo = W_W2 + dir * 65536u + (hc + fr) * 64u + fq * 8u;
        const unsigned ao = W_A2 + dir * 65536u + (hc + fr) * 64u + fq * 8u;
        const unsigned po = hc + fq * 4u;
        const f32x4 z4 = {0.f, 0.f, 0.f, 0.f};
        bf16x8 lwf[2], laf[2];
        u32x2 krw[4], rrw[4];
        unsigned tok_cur = 0;
        auto issue = [&](int c, bf16x8 (&lw)[2], bf16x8 (&la)[2], u32x2 (&kw)[4], u32x2 (&rw)[4], unsigned& tk) {
            tk = tokb + scan_pos(c * CH + fr, dir);
            const unsigned lo = tk * 128u + dir * 64u + fq * 8u, ro = tk * 1024u + hc + fq * 4u;
#pragma unroll
            for (int kk = 0; kk < 2; ++kk) { lw[kk] = *(const bf16x8*)(LW + lo + kk * 32); la[kk] = *(const bf16x8*)(LA + lo + kk * 32); }
#pragma unroll
            for (int nt = 0; nt < 4; ++nt) { kw[nt] = *(const u32x2*)(Kk + ro + nt * 16); rw[nt] = *(const u32x2*)(R + ro + nt * 16); }
        };
        if ((int)pid < NCHK) issue(pid, lwf, laf, krw, rrw, tok_cur);
#pragma unroll
        for (int kk = 0; kk < 2; ++kk) asm volatile("" : "+v"(lwf[kk]), "+v"(laf[kk]));
#pragma unroll
        for (int nt = 0; nt < 4; ++nt) asm volatile("" : "+v"(krw[nt]), "+v"(rrw[nt]));
        auto ldw = [&](bf16x8 (&w)[2][2], int nt) {
#pragma unroll
            for (int kk = 0; kk < 2; ++kk) { w[0][kk] = *(const bf16x8*)(wsm + wo + nt * 1024 + kk * 32); w[1][kk] = *(const bf16x8*)(wsm + ao + nt * 1024 + kk * 32); }
        };
        for (int c = pid; c < NCHK; c += NPREP) {
            bf16x8 wq[2][2], wn[2][2];
            ldw(wq, 0);
            const unsigned tok = tok_cur;
            float ssq = 0.f;
#pragma unroll
            for (int nt = 0; nt < 4; ++nt) {
                const f32x4 kkv = *(const f32x4*)(prm + 128 + fq * 4 + nt * 16);
                const f32x4 q = up4(krw[nt]) * kkv;
                ssq += q[0] * q[0] + q[1] * q[1] + q[2] * q[2] + q[3] * q[3];
            }
            ssq += __shfl_xor(ssq, 16); ssq += __shfl_xor(ssq, 32);
            const float kn = __builtin_amdgcn_rsqf(fmaxf(ssq, 1e-24f));
            float bsum = 0.f;
#pragma unroll
            for (int nt = 0; nt < 4; ++nt) {
                f32x4 aw = z4, ai = z4;
                if (nt < 3) ldw(wn, nt + 1);
                __builtin_amdgcn_sched_barrier(0);
#pragma unroll
                for (int kk = 0; kk < 2; ++kk) {
                    aw = mfma32(wq[0][kk], lwf[kk], aw);
                    ai = mfma32(wq[1][kk], laf[kk], ai);
                }
                if (nt < 3) {
#pragma unroll
                    for (int kk = 0; kk < 2; ++kk) { wq[0][kk] = wn[0][kk]; wq[1][kk] = wn[1][kk]; }
                }
                const f32x4 w0v = *(const f32x4*)(prm + fq * 4 + nt * 16), a0v = *(const f32x4*)(prm + 64 + fq * 4 + nt * 16);
                const f32x4 kkv = *(const f32x4*)(prm + 128 + fq * 4 + nt * 16);
                const f32x4 kav = *(const f32x4*)(prm + 192 + fq * 4 + nt * 16), rkv = *(const f32x4*)(prm + 256 + fq * 4 + nt * 16);
                LDS_WAIT();
                const f32x4 rr = up4(rrw[nt]), krn4 = up4(krw[nt]);
                const f32x4 x1 = (w0v + aw) * (-LOG2E), x2 = (a0v + ai) * (-LOG2E);
                f32x4 ex1, ex2;
#pragma unroll
                for (int j = 0; j < 4; ++j) { ex1[j] = __builtin_amdgcn_exp2f(x1[j]); ex2[j] = __builtin_amdgcn_exp2f(x2[j]); }
                ex1 = ex1 + 1.0f; ex2 = ex2 + 1.0f;
                f32x4 sg, ic;
#pragma unroll
                for (int j = 0; j < 4; ++j) { sg[j] = __builtin_amdgcn_rcpf(ex1[j]); ic[j] = __builtin_amdgcn_rcpf(ex2[j]); }
                const f32x4 e2 = sg * (0.6065306597126334f * LOG2E);
                const f32x4 kkn = krn4 * kkv * kn;
                const f32x4 kd = krn4 * ((ic - 1.0f) * kav + 1.0f);
                { const f32x4 bq = rr * kd * rkv; bsum += (bq[0] + bq[1]) + (bq[2] + bq[3]); }
                f32x4 wt, wi, wp;
#pragma unroll
                for (int j = 0; j < 4; ++j) {
                    const float ec = row16_prefix(e2[j]);
                    wt[j] = __builtin_amdgcn_exp2f(-ec);
                    wi[j] = __builtin_amdgcn_exp2f(ec);
                    wp[j] = __builtin_amdgcn_exp2f(e2[j] - ec);
                }
                const f32x4 at = -(kkn * wp), rt = rr * wt, bt = kkn * ic * wi, kt = kd * wi;
                {
                    u32x2 wa, wb, wk;
                    wa[0] = pk_bf16(at[0], at[1]); wa[1] = pk_bf16(at[2], at[3]); wb[0] = pk_bf16(bt[0], bt[1]); wb[1] = pk_bf16(bt[2], bt[3]);
                    wk[0] = pk_bf16(kt[0], kt[1]); wk[1] = pk_bf16(kt[2], kt[3]);
                    *(u32x2*)(XA + fr * TKS + nt * 16 + fq * 4) = wa; *(u32x2*)(XB + fr * TKS + nt * 16 + fq * 4) = wb; *(u32x2*)(XK + fr * TKS + nt * 16 + fq * 4) = wk;
                    const unsigned o = (nt * 16 + fq * 4) * KTS + fr;
#pragma unroll
                    for (int j = 0; j < 4; ++j) {
                        TA[o + j * KTS] = (bf16_t)((j & 1) ? (wa[j >> 1] >> 16) : (wa[j >> 1] & 0xffffu));
                        TB_[o + j * KTS] = (bf16_t)((j & 1) ? (wb[j >> 1] >> 16) : (wb[j >> 1] & 0xffffu));
                        TK[o + j * KTS] = (bf16_t)((j & 1) ? (wk[j >> 1] >> 16) : (wk[j >> 1] & 0xffffu));
                    }
                }
                if (fr == 15) *(f32x4*)(WCP + nt * 16 + fq * 4) = wt;
                st4(XR + fr * TKS + nt * 16 + fq * 4, rt);
            }
            bsum += __shfl_xor(bsum, 16); bsum += __shfl_xor(bsum, 32);
            if (rg == 0 && fq == 0) { bonus[((0 * 2 + dir) * TTOT + tok) * 16u + hd] = bsum; bonus[((1 * 2 + dir) * TTOT + tok) * 16u + hd] = 0.f; }
            if (c + NPREP < NCHK) issue(c + NPREP, lwf, laf, krw, rrw, tok_cur);
            unsigned vv[2][2];
#pragma unroll
            for (int i = 0; i < 2; ++i) {
                const unsigned q = i * 64 + lane, vrow = q & 15, sp = q >> 4;
                const unsigned tk0 = tokb + scan_pos(c * CH + 2 * sp, dir), tk1 = tokb + scan_pos(c * CH + 2 * sp + 1, dir);
                vv[i][0] = V[tk0 * 1024u + hc + rg * 16 + vrow]; vv[i][1] = V[tk1 * 1024u + hc + rg * 16 + vrow];
            }
            LDS_WAIT();
            float wcr[4];
#pragma unroll
            for (int n = 0; n < 4; ++n) wcr[n] = WCP[16 * n + fr];
            bf16x8 fa[2], fb[2], fk[2], frr[2];
#pragma unroll
            for (int kk = 0; kk < 2; ++kk) {
                fa[kk] = *(const bf16x8*)(XA + fr * TKS + kk * 32 + fq * 8); fb[kk] = *(const bf16x8*)(XB + fr * TKS + kk * 32 + fq * 8);
                fk[kk] = *(const bf16x8*)(XK + fr * TKS + kk * 32 + fq * 8); frr[kk] = *(const bf16x8*)(XR + fr * TKS + kk * 32 + fq * 8);
            }
            LDS_WAIT();
            f32x4 d1 = z4, d2 = z4, d3 = z4, d4 = z4, d5 = z4;
#pragma unroll
            for (int kk = 0; kk < 2; ++kk) {
                d1 = mfma32(fb[kk], fa[kk], d1);
                d2 = mfma32(fa[kk], fb[kk], d2);
                d3 = mfma32(fa[kk], fk[kk], d3);
                d4 = mfma32(fb[kk], frr[kk], d4);
                d5 = mfma32(fk[kk], frr[kk], d5);
            }
            f32x4 im;
#pragma unroll
            for (int j = 0; j < 4; ++j) {
                const unsigned ij = fq * 4 + j;
                d1[j] = ij < fr ? d1[j] : 0.f;
                d2[j] = fr < ij ? d2[j] : 0.f;
                d3[j] = fr < ij ? d3[j] : 0.f;
                d4[j] = ij <= fr ? d4[j] : 0.f;
                d5[j] = ij <= fr ? d5[j] : 0.f;
                im[j] = d1[j] + (ij == fr ? 1.0f : 0.f);
            }
            st4(M + fr * SMS + fq * 4, d1);
            st4(IM + fr * SMS + fq * 4, im);
            st4(NABR + fr * SMS + fq * 4, d2);
            st4(NAKR + fr * SMS + fq * 4, d3);
            st4(NRBT + fr * SMS + fq * 4, d4);
            st4(NRKT + fr * SMS + fq * 4, d5);
            LDS_WAIT();
            const int so = fr * SMS + fq * 4;
            {
                const s16x4v m = ld4(M + so), mt = ld4(NABR + so);
                LDS_WAIT();
                st4(M2T + so, mfma16(m, mt, z4)); st4(M2 + so, mfma16(mt, m, z4));
                LDS_WAIT();
            }
            {
                const s16x4v m2 = ld4(M2 + so), m2t = ld4(M2T + so); const u32x2 imr = *(const u32x2*)(IM + so);
                LDS_WAIT();
                st4(M4T + so, mfma16(m2, m2t, z4)); st4(M4 + so, mfma16(m2t, m2, z4));
                st4(X1 + so, mfma16(m2t, __builtin_bit_cast(s16x4v, imr), up4(imr)));
                LDS_WAIT();
            }
            {
                const s16x4v m4 = ld4(M4 + so), m4t = ld4(M4T + so); const u32x2 x1r = *(const u32x2*)(X1 + so);
                LDS_WAIT();
                st4(M8T + so, mfma16(m4, m4t, z4));
                st4(X2 + so, mfma16(m4t, __builtin_bit_cast(s16x4v, x1r), up4(x1r)));
                LDS_WAIT();
            }
            {
                const s16x4v m8t = ld4(M8T + so); const u32x2 x2r = *(const u32x2*)(X2 + so);
                LDS_WAIT();
                st4(TT + so, mfma16(m8t, __builtin_bit_cast(s16x4v, x2r), up4(x2r)));
                LDS_WAIT();
            }
            {
                const s16x4v ta = ld4(TT + so), nk = ld4(NAKR + so);
                s16x4v xa[4];
#pragma unroll
                for (int n = 0; n < 4; ++n) xa[n] = ld4(TA + (16 * n + fr) * KTS + fq * 4);
                LDS_WAIT();
                st4(G1 + so, mfma16(ta, nk, z4));
#pragma unroll
                for (int n = 0; n < 4; ++n) st4(AT + (16 * n + fr) * KTS + fq * 4, mfma16(ta, xa[n], z4));
                LDS_WAIT();
            }
            const unsigned sl = (unsigned)c % NSLOT;
            char* S = slots + sl * SLOT_BYTES;
            {
                const s16x4v nrb = ld4(NRBT + so), g1 = ld4(G1 + so);
                const u32x2 nrk = *(const u32x2*)(NRKT + so);
                s16x4v atm[4], tb[4]; u32x2 xr[4], tk[4];
#pragma unroll
                for (int m = 0; m < 4; ++m) {
                    atm[m] = ld4(AT + (16 * m + fr) * KTS + fq * 4); tb[m] = ld4(TB_ + (16 * m + fr) * KTS + fq * 4);
                    xr[m] = *(const u32x2*)(XR + fr * TKS + 16 * m + fq * 4); tk[m] = *(const u32x2*)(TK + (16 * m + fr) * KTS + fq * 4);
                }
                LDS_WAIT();
                while (*(volatile LAS int*)(cnts + 8) < c - NSLOT + 1) __builtin_amdgcn_s_sleep(1);
                asm volatile("" ::: "memory");
                st4((bf16_t*)(S + SL_G2) + so, mfma16(g1, nrb, up4(nrk)));
#pragma unroll
                for (int m = 0; m < 4; ++m) {
                    st4((bf16_t*)(S + SL_RT) + fr * TKS + 16 * m + fq * 4, mfma16(atm[m], nrb, up4(xr[m])));
#pragma unroll
                    for (int n = 0; n < 4; ++n) st4((bf16_t*)(S + SL_PT) + (16 * n + fr) * TKS + 16 * m + fq * 4, mfma16(atm[m], tb[n], z4) * wcr[n]);
                    asm volatile("" ::: "memory");
                }
#pragma unroll
                for (int n = 0; n < 4; ++n) st4((bf16_t*)(S + SL_QM) + (16 * n + fr) * KTS + fq * 4, mfma16(g1, tb[n], up4(tk[n])) * wcr[n]);
                ((float*)(S + SL_WC))[lane] = (fq == 0) ? wcr[0] : (fq == 1) ? wcr[1] : (fq == 2) ? wcr[2] : wcr[3];
#pragma unroll
                for (int i = 0; i < 2; ++i) {
                    const unsigned q = i * 64 + lane, vrow = q & 15, sp = q >> 4;
                    *(unsigned*)((bf16_t*)(S + SL_VT) + vrow * SMS + 2 * sp) = vv[i][0] | (vv[i][1] << 16);
                }
            }
            LDS_WAIT();
            if (lane == 0) *(volatile LAS int*)(cnts + sl) = c + 1;
        }
    }
    __syncthreads();
}

DI void phase_scan(const Params& p, char* smem) {
    for (int u = blockIdx.x; u < NBATCH * 16 * 2 * 4; u += gridDim.x) scan_unit_chunked(p, u, smem);
}

constexpr int NPHASE = 18;
constexpr int SMEM_BYTES = (SC2_SMEM > SC_SMEM ? SC2_SMEM : SC_SMEM) + 64;
static_assert(SMEM_BYTES >= GEMM_SMEM + 4096 + 64 && SMEM_BYTES >= G8_SMEM + 64 && SMEM_BYTES + 16 <= 163840, "LDS");
template <int PH> DI void run_phase(const Params& p, char* smem) {
    if constexpr (PH == 0) phase_prologue(p, smem);
    else if constexpr (PH == 1) phase_norm0(p);
    else if constexpr (PH == 2) phase_qkv(p, smem);
    else if constexpr (PH == 3) phase_attn(p, smem);
    else if constexpr (PH == 4) phase_wout(p, smem);
    else if constexpr (PH == 5) phase_ffn_norm_route(p, 0, smem);
    else if constexpr (PH == 6) phase_moe1(p, 0, smem);
    else if constexpr (PH == 7) phase_moe2(p, 0, smem);
    else if constexpr (PH == 8) phase_combine_l0(p, smem);
    else if constexpr (PH == 9) phase_xx(p);
    else if constexpr (PH == 10) phase_rwkv_proj(p, smem);
    else if constexpr (PH == 11) phase_scan(p, smem);
    else if constexpr (PH == 12) phase_gate(p, smem);
    else if constexpr (PH == 13) phase_wo(p, smem);
    else if constexpr (PH == 14) phase_ffn_norm_route(p, 1, smem);
    else if constexpr (PH == 15) phase_moe1(p, 1, smem);
    else if constexpr (PH == 16) phase_moe2(p, 1, smem);
    else if constexpr (PH == 17) phase_final(p);
}
template <int PH, int END> struct PhaseSeq {
    static DI void run(const Params& p, char* smem, const XcdBarrier& bar) {
        run_phase<PH>(p, smem);
        if constexpr (PH + 1 < END) { xcd_barrier(bar); PhaseSeq<PH + 1, END>::run(p, smem, bar); }
    }
};
template <int BEG, int END>
__global__ void __launch_bounds__(NTH, 2) fwd_kernel(Params p) {
    extern __shared__ __attribute__((aligned(16))) char smem_raw[];
    char* smem = smem_raw + 16;
    if constexpr (END - BEG > 1) {
        if (tidx() == 0) *(uint4*)smem_raw = make_uint4(0u, 0u, 0u, 0u);
        __syncthreads();
        XcdBarrier bar = xcd_barrier_post((unsigned*)(p.ws + OFF_BAR), (volatile LAS unsigned*)smem_raw);
        PhaseSeq<BEG, END>::run(p, smem, bar);
    } else {
        run_phase<BEG>(p, smem);
    }
}

template <int BEG, int END> static void launch_range(const Params& p, int grid, hipStream_t stream) {
    (void)hipFuncSetAttribute((const void*)fwd_kernel<BEG, END>, hipFuncAttributeMaxDynamicSharedMemorySize, SMEM_BYTES + 16);
    hipLaunchKernelGGL((fwd_kernel<BEG, END>), dim3(grid), dim3(NTH), SMEM_BYTES + 16, stream, p);
}
#ifndef RUN_PHASES
#define RUN_PHASES NPHASE
#endif
#ifndef REPEAT_PHASE
#define REPEAT_PHASE -1
#endif
template <int PH> static void launch_each(const Params& p, int grid, hipStream_t stream) {
    launch_range<PH, PH + 1>(p, grid, stream);
    if (PH == REPEAT_PHASE) launch_range<PH, PH + 1>(p, grid, stream);
    if constexpr (PH + 1 < RUN_PHASES) launch_each<PH + 1>(p, grid, stream);
}

extern "C" void kernel_launch(void* const* d_in, const int* in_sizes, int n_in, void* d_out, int out_size, void* d_ws, size_t ws_size, hipStream_t stream) {
    Params p{};
    const float** f = (const float**)&p;
    for (int i = 0; i < 37; ++i) f[i] = (const float*)d_in[i];
    p.out = (float*)d_out;
    p.ws = (char*)d_ws;
    if (ws_size < WS_NEED || n_in < 37) return;
    static int grid = 0;
    if (!grid) {
        int dev = 0, cus = 0;
        (void)hipGetDevice(&dev);
        (void)hipDeviceGetAttribute(&cus, hipDeviceAttributeMultiprocessorCount, dev);
        grid = cus > 0 ? cus : 256;
    }
    (void)hipMemsetAsync(d_ws, 0, 32768, stream);
#if MEGA
    launch_range<0, NPHASE>(p, grid, stream);
#else
    launch_each<0>(p, grid, stream);
#endif
}
```

```cpp
#include <hip/hip_runtime.h>
#include <stdint.h>
#include <stdio.h>

#ifndef MEGA
#define MEGA 1
#endif

typedef unsigned short bf16_t;
typedef short bf16x8 __attribute__((ext_vector_type(8)));
typedef short s16x4 __attribute__((ext_vector_type(4)));
typedef float f32x2 __attribute__((ext_vector_type(2)));
typedef float f32x4 __attribute__((ext_vector_type(4)));
typedef float f32x16 __attribute__((ext_vector_type(16)));
typedef unsigned u32x2 __attribute__((ext_vector_type(2)));
typedef unsigned u32x4 __attribute__((ext_vector_type(4)));
typedef __bf16 bf16x2_t __attribute__((ext_vector_type(2)));
#define DI __device__ __forceinline__
__device__ __forceinline__ unsigned tidx() { unsigned t = threadIdx.x; asm volatile("" : "+v"(t)); return t; }

constexpr int DM = 1024, NBATCH = 2, SEQ = 16384, LCTX = 256, PTOT = SEQ + LCTX, TTOT = NBATCH * PTOT;
constexpr int NTH = 512, NWAVE = 8;
constexpr int QKV_N = 1536;
constexpr int NEXP = 16, CAP = TTOT * 2;
constexpr float RMS_EPS = 1e-6f, GN_EPS = 64e-5f;
constexpr float LOG2E = 1.4426950408889634f;

constexpr size_t MBy = 1u << 20;
constexpr size_t OFF_BAR   = 0;
constexpr size_t OFF_CNT   = 16384;
constexpr size_t OFF_MOD   = 32768;
constexpr size_t OFF_ROPE  = OFF_MOD + 2 * 3 * 6144 * 4;
constexpr size_t OFF_BONUS = 1 * MBy;
constexpr size_t OFF_BONUS2 = 6 * MBy;
constexpr size_t OFF_STOK  = 6 * MBy;
constexpr size_t OFF_SW    = 11 * MBy;
constexpr size_t OFF_XC    = 16 * MBy;
constexpr size_t OFF_WS    = 18 * MBy;
constexpr size_t OFF_MOEW  = 33 * MBy;
constexpr size_t OFF_H     = 129 * MBy;
constexpr size_t OFF_SCR   = 194 * MBy;
constexpr size_t SCR_SIZE  = 290 * MBy;
constexpr size_t WS_NEED   = OFF_SCR + SCR_SIZE;
constexpr size_t W_IN = 0, W_OUT = W_IN + 1536 * 1024, W_R = W_OUT + 1024 * 1024, W_K = W_R + 1024 * 1024, W_V = W_K + 1024 * 1024,
                 W_O = W_V + 1024 * 1024, W_W1 = W_O + 1024 * 1024, W_A1 = W_W1 + 128 * 1024, W_G1 = W_A1 + 128 * 1024,
                 W_W2 = W_G1 + 256 * 1024, W_A2 = W_W2 + 2 * 1024 * 64, W_G2 = W_A2 + 2 * 1024 * 64, W_END = W_G2 + 1024 * 192;
static_assert(W_END * 2 <= 15 * MBy, "small weights region");
constexpr size_t ROWB = (size_t)TTOT * 2048;
constexpr size_t S_Q = 0, S_K = S_Q + ROWB, S_VT = S_K + ROWB / 4, S_O = S_VT + ROWB / 4;
constexpr size_t S_HID = 0, S_Y = 140 * MBy;
constexpr size_t S_R = 0, S_KK = S_R + ROWB, S_V = S_KK + ROWB, S_LW = S_V + ROWB, S_LA = S_LW + ROWB / 8, S_LG = S_LA + ROWB / 8,
                 S_Y1 = 224 * MBy, S_XX = S_Y1, S_OR = S_R;
static_assert(S_O + ROWB <= SCR_SIZE, "scr");
static_assert(S_LG + (size_t)TTOT * 384 <= S_Y1, "scr2");
static_assert(S_Y1 + ROWB <= SCR_SIZE, "scr3");
static_assert(S_Y + 2 * ROWB <= SCR_SIZE, "scr4");
static_assert((size_t)(CAP / 256 + 16) * 256 * 2048 <= S_Y, "hid");
static_assert(OFF_H + ROWB <= OFF_SCR, "h");

struct Params {
    const float *x, *c, *ctx, *c_ctx, *ada_w, *ada_b, *norm_mix_g, *norm_ffn_g, *attn_w_in, *attn_w_out, *attn_sink, *attn_q_norm_g, *attn_k_norm_g,
        *rwkv_x_mix, *rwkv_w_r, *rwkv_w_k, *rwkv_w_v, *rwkv_w_o, *rwkv_decay_w0, *rwkv_decay_w1, *rwkv_decay_w2, *rwkv_iclr_a0, *rwkv_iclr_a1,
        *rwkv_iclr_a2, *rwkv_gate_g1, *rwkv_gate_g2, *rwkv_k_k, *rwkv_k_a, *rwkv_r_k, *rwkv_ln_g, *rwkv_ln_b, *router_w, *router_bias, *moe_w1,
        *moe_w3, *moe_w2, *final_norm_g;
    float* out;
    char* ws;
};

DI unsigned pk_bf16(float a, float b) { f32x2 v = {a, b}; bf16x2_t r = __builtin_convertvector(v, bf16x2_t); return __builtin_bit_cast(unsigned, r); }
DI float bf_lo(unsigned u) { return __uint_as_float(u << 16); }
DI float bf_hi(unsigned u) { return __uint_as_float(u & 0xffff0000u); }
DI float bf2f(bf16_t u) { return __uint_as_float(((unsigned)u) << 16); }
DI float wave_sum(float v) {
#pragma unroll
    for (int o = 32; o >= 1; o >>= 1) v += __shfl_xor(v, o);
    return v;
}
DI float sigmoidf_(float x) { return __builtin_amdgcn_rcpf(1.0f + __builtin_amdgcn_exp2f(x * -LOG2E)); }
DI float siluf_(float x) { return x * __builtin_amdgcn_rcpf(1.0f + __builtin_amdgcn_exp2f(x * -LOG2E)); }
struct PLite { const float *x, *ctx, *qg, *kg; float* out; char* ws; };
DI PLite plite(const Params& p) { return PLite{p.x, p.ctx, p.attn_q_norm_g, p.attn_k_norm_g, p.out, p.ws}; }
template <class P> DI float* xrow_ptr(const P& p, int tok) {
    const int b = tok >= PTOT ? 1 : 0, pos = tok - b * PTOT;
    return pos < LCTX ? (float*)(p.ws + OFF_XC) + (size_t)(b * LCTX + pos) * DM : p.out + (size_t)(b * SEQ + pos - LCTX) * DM;
}
template <class P> DI const float* xin_ptr(const P& p, int tok) {
    const int b = tok >= PTOT ? 1 : 0, pos = tok - b * PTOT;
    return pos < LCTX ? p.ctx + (size_t)(b * LCTX + pos) * DM : p.x + (size_t)(b * SEQ + pos - LCTX) * DM;
}
template <class P> DI const float* mod_ptr(const P& p, int layer, int tok, int which) {
    const int b = tok >= PTOT ? 1 : 0, pos = tok - b * PTOT;
    const int w = pos < LCTX ? 2 : b;
    return (const float*)(p.ws + OFF_MOD) + (size_t)((layer * 3 + w) * 6 + which) * DM;
}

#define XB_TMO      128
#define XB_XCNT(j)  (256  + 64 * (j))
#define XB_XSUB(j)  (1280 + 64 * (j))
#define XB_XGEN(j)  (2304 + 64 * (j))
#define XB_TOP      3328
#define XB_TOPGEN   3392
#define XCD_BAR_WORDS 3456
#define XB_SPIN_CAP (1u << 18)
#define LAS __attribute__((address_space(3)))
DI unsigned xb_ld(unsigned* p)              { return __hip_atomic_load(p, __ATOMIC_RELAXED, __HIP_MEMORY_SCOPE_AGENT); }
DI unsigned xb_add(unsigned* p, unsigned v) { return __hip_atomic_fetch_add(p, v, __ATOMIC_RELAXED, __HIP_MEMORY_SCOPE_AGENT); }
DI unsigned xb_xcc_id() { return (unsigned)__builtin_amdgcn_s_getreg((3 << 11) | 20) & 0xFu; }
#define XB_SPIN(cond, bar) do { unsigned _sp = 0; while (cond) { __builtin_amdgcn_s_sleep(1); \
    if ((++_sp & 255u) == 0u) { if (xb_ld(&(bar)[XB_TMO])) break; if (_sp > XB_SPIN_CAP) { atomicAdd(&(bar)[XB_TMO], 1u); break; } } } } while (0)
struct XcdBarrier { unsigned* bar; unsigned x; volatile LAS unsigned* st; };
DI XcdBarrier xcd_barrier_post(unsigned* bar, volatile LAS unsigned* st) {
    XcdBarrier b; b.bar = bar; b.x = xb_xcc_id(); b.st = st;
    if (tidx() == 0) (void)xb_add(&bar[XB_XCNT(b.x)], 1u);
    return b;
}
DI void xcd_barrier_complete(unsigned* bar, unsigned x, unsigned& nloc, unsigned& nx) {
    const unsigned G = gridDim.x * gridDim.y * gridDim.z;
    unsigned sum, cnt, mine, sp = 0u;
    for (;;) {
        sum = 0u; cnt = 0u; mine = 0u;
#pragma unroll
        for (unsigned j = 0; j < 16; ++j) { const unsigned c = xb_ld(&bar[XB_XCNT(j)]); sum += c; cnt += (c > 0u) ? 1u : 0u; mine = (j == x) ? c : mine; }
        if (sum == G) break;
        __builtin_amdgcn_s_sleep(1);
        if ((++sp & 255u) == 0u) { if (xb_ld(&bar[XB_TMO])) break; if (sp > XB_SPIN_CAP) { atomicAdd(&bar[XB_TMO], 1u); break; } }
    }
    nloc = mine > 0u ? mine : 1u; nx = cnt > 0u ? cnt : 1u;
}
DI void xcd_barrier(const XcdBarrier& b) {
    asm volatile("s_waitcnt vmcnt(0)" ::: "memory");
    __syncthreads();
    if (tidx() == 0) {
        unsigned* bar = b.bar;
        __builtin_amdgcn_s_waitcnt(0);
        unsigned nloc = b.st[0], nx = b.st[1];
        if (nloc == 0u) { xcd_barrier_complete(bar, b.x, nloc, nx); b.st[0] = nloc; b.st[1] = nx; }
        const unsigned old = xb_add(&bar[XB_XSUB(b.x)], 1u);
        const unsigned gen = old / nloc;
        if (old + 1u == (gen + 1u) * nloc) {
            __builtin_amdgcn_fence(__ATOMIC_RELEASE, "agent");
            asm volatile("s_waitcnt vmcnt(0)" ::: "memory");
            const unsigned og = xb_add(&bar[XB_TOP], 1u);
            const unsigned tg = og / nx;
            if (og + 1u == (tg + 1u) * nx) xb_add(&bar[XB_TOPGEN], 1u);
            else XB_SPIN(xb_ld(&bar[XB_TOPGEN]) == tg, bar);
            __builtin_amdgcn_fence(__ATOMIC_ACQUIRE, "agent");
            xb_add(&bar[XB_XGEN(b.x)], 1u);
            asm volatile("s_waitcnt vmcnt(0)" ::: "memory");
        } else {
            XB_SPIN(xb_ld(&bar[XB_XGEN(b.x)]) == gen, bar);
            __builtin_amdgcn_fence(__ATOMIC_ACQUIRE, "agent");
            asm volatile("s_waitcnt vmcnt(0)" ::: "memory");
        }
    }
    __syncthreads();
}

struct CvtDesc { const float* src; bf16_t* dst; int ld, kvalid, dld; bool colvalid; };
DI CvtDesc cvt_tile(const float* src, int ld, int kvalid, bool colvalid, bf16_t* dst, int dld) { return CvtDesc{src, dst, ld, kvalid, dld, colvalid}; }
constexpr int CV_NB = 8;
template <class F>
DI void cvt_run(int nunits, F desc_of, float* tiles) {
    const int t = tidx();
    for (int i0 = 0;; i0 += CV_NB) {
        if ((int)blockIdx.x + (int)gridDim.x * i0 >= nunits) break;
        f32x4 v[CV_NB];
#pragma unroll
        for (int b = 0; b < CV_NB; ++b) {
            const int u = (int)blockIdx.x + (int)gridDim.x * (i0 + b);
            v[b] = (f32x4){0.f, 0.f, 0.f, 0.f};
            if (u < nunits) {
                const CvtDesc d = desc_of(u);
                const int k = t >> 3, c4 = (t & 7) * 4;
                if (d.colvalid && k < d.kvalid) v[b] = *(const f32x4*)(d.src + (size_t)k * d.ld + c4);
            }
        }
#pragma unroll
        for (int b = 0; b < CV_NB; ++b) {
            float* tile = tiles + b * 64 * 33;
            const int k = t >> 3, c4 = (t & 7) * 4;
            tile[k * 33 + c4 + 0] = v[b][0]; tile[k * 33 + c4 + 1] = v[b][1]; tile[k * 33 + c4 + 2] = v[b][2]; tile[k * 33 + c4 + 3] = v[b][3];
        }
        __syncthreads();
#pragma unroll
        for (int b = 0; b < CV_NB; ++b) {
            const int u = (int)blockIdx.x + (int)gridDim.x * (i0 + b);
            if (u < nunits) {
                const CvtDesc d = desc_of(u);
                const float* tile = tiles + b * 64 * 33;
                const int n = t >> 4, kc = (t & 15) * 4;
                u32x2 w;
                w[0] = pk_bf16(tile[(kc + 0) * 33 + n], tile[(kc + 1) * 33 + n]);
                w[1] = pk_bf16(tile[(kc + 2) * 33 + n], tile[(kc + 3) * 33 + n]);
                *(u32x2*)(d.dst + (size_t)n * d.dld + kc) = w;
            }
        }
        __syncthreads();
    }
}
constexpr int CV_SMALL_UNITS = 768 + 512 * 5 + 64 + 64 + 128 + 64 + 64 + 96;
DI CvtDesc cvt_small_unit(const Params& p, int u) {
    bf16_t* wsm = (bf16_t*)(p.ws + OFF_WS);
    if (u < 768) { const int run = u >> 4, kt = u & 15; return cvt_tile(p.attn_w_in + (size_t)kt * 64 * 1536 + run * 32, 1536, 64, true, wsm + W_IN + (size_t)run * 32 * 1024 + kt * 64, 1024); }
    u -= 768;
    if (u < 512 * 5) {
        const int j = u >> 9, v = u & 511, run = v >> 4, kt = v & 15;
        const float* src = j == 0 ? p.attn_w_out : j == 1 ? p.rwkv_w_r : j == 2 ? p.rwkv_w_k : j == 3 ? p.rwkv_w_v : p.rwkv_w_o;
        const size_t dofs = j == 0 ? W_OUT : j == 1 ? W_R : j == 2 ? W_K : j == 3 ? W_V : W_O;
        return cvt_tile(src + (size_t)kt * 64 * 1024 + run * 32, 1024, 64, true, wsm + dofs + (size_t)run * 32 * 1024 + kt * 64, 1024);
    }
    u -= 512 * 5;
    if (u < 128) {
        const int j = u >> 6, v = u & 63, run = v >> 4, kt = v & 15, d = run >> 1, co = (run & 1) * 32;
        const float* src = (j == 0 ? p.rwkv_decay_w1 : p.rwkv_iclr_a1) + (size_t)d * 1024 * 64;
        return cvt_tile(src + (size_t)kt * 64 * 64 + co, 64, 64, true, wsm + (j == 0 ? W_W1 : W_A1) + (size_t)run * 32 * 1024 + kt * 64, 1024);
    }
    u -= 128;
    if (u < 128) {
        const int run = u >> 4, kt = u & 15;
        return cvt_tile(p.rwkv_gate_g1 + (size_t)kt * 64 * 160 + run * 32, 160, 64, run < 5, wsm + W_G1 + (size_t)run * 32 * 1024 + kt * 64, 1024);
    }
    u -= 128;
    if (u < 128) {
        const int j = u >> 6, v = u & 63, d = v >> 5, run = v & 31;
        const float* src = (j == 0 ? p.rwkv_decay_w2 : p.rwkv_iclr_a2) + (size_t)d * 64 * 1024;
        return cvt_tile(src + run * 32, 1024, 64, true, wsm + (j == 0 ? W_W2 : W_A2) + (size_t)d * 1024 * 64 + (size_t)run * 32 * 64, 64);
    }
    u -= 128;
    {
        const int run = u / 3, kt = u % 3;
        const int kvalid = 160 - kt * 64 > 64 ? 64 : (160 - kt * 64 < 0 ? 0 : 160 - kt * 64);
        return cvt_tile(p.rwkv_gate_g2 + (size_t)kt * 64 * 1024 + run * 32, 1024, kvalid, true, wsm + W_G2 + (size_t)run * 32 * 192 + kt * 64, 192);
    }
}
constexpr int CV_MOE_UNITS = 16 * (1024 + 512);
DI CvtDesc cvt_moe_unit(const Params& p, int layer, int u) {
    bf16_t* w13 = (bf16_t*)(p.ws + OFF_MOEW);
    bf16_t* w2t = w13 + (size_t)16 * 2048 * 1024;
    const int e = u / 1536, v = u % 1536;
    const size_t eo = (size_t)(layer * 16 + e) * 1024 * 1024;
    if (v < 1024) {
        const int run = v >> 4, kt = v & 15, g = run >> 1;
        const float* src = ((run & 1) ? p.moe_w3 : p.moe_w1) + eo;
        return cvt_tile(src + (size_t)kt * 64 * 1024 + g * 32, 1024, 64, true, w13 + (size_t)e * 2048 * 1024 + (size_t)run * 32 * 1024 + kt * 64, 1024);
    } else {
        const int w = v - 1024, run = w >> 4, kt = w & 15;
        return cvt_tile(p.moe_w2 + eo + (size_t)kt * 64 * 1024 + run * 32, 1024, 64, true, w2t + (size_t)e * 1024 * 1024 + (size_t)run * 32 * 1024 + kt * 64, 1024);
    }
}
DI void adaln_unit(const Params& p, int u, float* sm) {
    const int l = u / 96, n0 = (u % 96) * 64, t = tidx();
    float* sv = sm;
    float* red = sm + 3 * 1024;
    for (int i = t; i < 3 * 1024; i += NTH) { const int w = i >> 10, k = i & 1023; const float c = w < 2 ? p.c[w * 1024 + k] : p.c_ctx[k]; sv[i] = siluf_(c); }
    __syncthreads();
    const int kg = t >> 4, cl = t & 15;
    f32x4 a0 = {0, 0, 0, 0}, a1 = a0, a2 = a0;
    const float* W = p.ada_w + (size_t)l * 1024 * 6144 + n0 + cl * 4;
#pragma unroll 8
    for (int i = 0; i < 32; ++i) {
        const int k = kg + 32 * i;
        const f32x4 w = *(const f32x4*)(W + (size_t)k * 6144);
        a0 += w * sv[k]; a1 += w * sv[1024 + k]; a2 += w * sv[2048 + k];
    }
#pragma unroll
    for (int j = 0; j < 4; ++j) { red[kg * 192 + 0 * 64 + cl * 4 + j] = a0[j]; red[kg * 192 + 1 * 64 + cl * 4 + j] = a1[j]; red[kg * 192 + 2 * 64 + cl * 4 + j] = a2[j]; }
    __syncthreads();
    if (t < 192) {
        float s = 0.f;
        for (int g = 0; g < 32; ++g) s += red[g * 192 + t];
        const int w = t >> 6, n = n0 + (t & 63);
        ((float*)(p.ws + OFF_MOD))[(size_t)(l * 3 + w) * 6144 + n] = s + p.ada_b[l * 6144 + n];
    }
    __syncthreads();
}
DI void rope_unit(const Params& p, int u) {
    const int id = u * NTH + tidx();
    if (id < 320 * 16) {
        const int pi = id >> 4, f = id & 15;
        const float inv = exp2f(-(float)f * (13.287712379549449f / 16.0f));
        const float val = pi < 256 ? (float)pi : (float)(pi - 256);
        const float ang = val * inv;
        const double a = (double)ang;
        const double k = __builtin_rint(a * 0.15915494309189535);
        const float r = (float)(a - k * 6.283185307179586);
        f32x2 cs = {__cosf(r), __sinf(r)};
        ((f32x2*)(p.ws + OFF_ROPE))[id] = cs;
    }
}
DI void phase_prologue(const Params& p, char* smem) {
    float* sm = (float*)smem;
    const int nconv = CV_SMALL_UNITS + CV_MOE_UNITS;
    const int total = nconv + 192 + 10;
    for (int u = nconv + blockIdx.x; u < total; u += gridDim.x) {
        if (u < nconv + 192) adaln_unit(p, u - nconv, sm);
        else rope_unit(p, u - nconv - 192);
    }
    __syncthreads();
    cvt_run(nconv, [&](int u) { return u < CV_SMALL_UNITS ? cvt_small_unit(p, u) : cvt_moe_unit(p, 0, u - CV_SMALL_UNITS); }, sm);
}

DI void row_load(const float* src, f32x4 (&v)[4], int lane) {
#pragma unroll
    for (int i = 0; i < 4; ++i) v[i] = ((const f32x4*)src)[lane + 64 * i];
}
DI float row_rstd(const f32x4 (&v)[4]) {
    float ss = 0.f;
#pragma unroll
    for (int i = 0; i < 4; ++i) ss += v[i][0] * v[i][0] + v[i][1] * v[i][1] + v[i][2] * v[i][2] + v[i][3] * v[i][3];
    ss = wave_sum(ss);
    return rsqrtf(ss * (1.0f / DM) + RMS_EPS);
}
DI void row_norm_mod(const f32x4 (&v)[4], float rstd, const float* g, const float* shift, const float* scale, f32x4 (&h)[4], int lane) {
#pragma unroll
    for (int i = 0; i < 4; ++i) {
        const int c = (lane + 64 * i) * 4;
        const f32x4 g4 = *(const f32x4*)(g + c), sh = *(const f32x4*)(shift + c), sc = *(const f32x4*)(scale + c);
        h[i] = (v[i] * rstd * g4) * (1.0f + sc) + sh;
    }
}
DI void row_store_bf16(bf16_t* dst, const f32x4 (&h)[4], int lane) {
#pragma unroll
    for (int i = 0; i < 4; ++i) { u32x2 w; w[0] = pk_bf16(h[i][0], h[i][1]); w[1] = pk_bf16(h[i][2], h[i][3]); *(u32x2*)(dst + (lane + 64 * i) * 4) = w; }
}
DI void row_load_bf16(const bf16_t* src, f32x4 (&v)[4], int lane) {
#pragma unroll
    for (int i = 0; i < 4; ++i) { const u32x2 w = *(const u32x2*)(src + (lane + 64 * i) * 4); v[i][0] = bf_lo(w[0]); v[i][1] = bf_hi(w[0]); v[i][2] = bf_lo(w[1]); v[i][3] = bf_hi(w[1]); }
}

DI void phase_norm0(const Params& p) {
    const int lane = tidx() & 63, gw = blockIdx.x * NWAVE + (tidx() >> 6), nw = gridDim.x * NWAVE;
    bf16_t* H = (bf16_t*)(p.ws + OFF_H);
    for (int tok = gw; tok < TTOT; tok += nw) {
        f32x4 v[4], h[4];
        row_load(xin_ptr(p, tok), v, lane);
        const float rstd = row_rstd(v);
        row_norm_mod(v, rstd, p.norm_mix_g, mod_ptr(p, 0, tok, 0), mod_ptr(p, 0, tok, 1), h, lane);
        row_store_bf16(H + (size_t)tok * DM, h, lane);
    }
}

DI void route_row(const Params& p, const float (&lg)[16], int& e1, int& e2, float& g1, float& g2) {
    float mx = lg[0];
#pragma unroll
    for (int e = 1; e < 16; ++e) mx = fmaxf(mx, lg[e]);
    float pr[16], sum = 0.f;
#pragma unroll
    for (int e = 0; e < 16; ++e) { pr[e] = __expf(lg[e] - mx); sum += pr[e]; }
    const float inv = 1.0f / sum;
    float sel[16];
#pragma unroll
    for (int e = 0; e < 16; ++e) { pr[e] *= inv; sel[e] = pr[e] + p.router_bias[e]; }
    float best = -1e30f; int gi = 0;
#pragma unroll
    for (int g = 0; g < 4; ++g) {
        float m1 = -1e30f, m2 = -1e30f;
#pragma unroll
        for (int j = 0; j < 4; ++j) { const float s = sel[g * 4 + j]; if (s > m1) { m2 = m1; m1 = s; } else if (s > m2) m2 = s; }
        const float gs = m1 + m2;
        if (gs > best) { best = gs; gi = g; }
    }
    float s4[4], p4[4];
#pragma unroll
    for (int j = 0; j < 4; ++j) {
        s4[j] = gi == 0 ? sel[j] : gi == 1 ? sel[4 + j] : gi == 2 ? sel[8 + j] : sel[12 + j];
        p4[j] = gi == 0 ? pr[j] : gi == 1 ? pr[4 + j] : gi == 2 ? pr[8 + j] : pr[12 + j];
    }
    int i1 = 0; float b1 = s4[0];
#pragma unroll
    for (int j = 1; j < 4; ++j) if (s4[j] > b1) { b1 = s4[j]; i1 = j; }
    int i2 = i1 == 0 ? 1 : 0; float b2 = -3e38f;
#pragma unroll
    for (int j = 0; j < 4; ++j) if (j != i1 && s4[j] > b2) { b2 = s4[j]; i2 = j; }
    const float w1 = i1 == 0 ? p4[0] : i1 == 1 ? p4[1] : i1 == 2 ? p4[2] : p4[3];
    const float w2 = i2 == 0 ? p4[0] : i2 == 1 ? p4[1] : i2 == 2 ? p4[2] : p4[3];
    const float ws = 1.0f / (w1 + w2);
    e1 = gi * 4 + i1; e2 = gi * 4 + i2; g1 = w1 * ws; g2 = w2 * ws;
}
DI void phase_ffn_norm_route(const Params& p, int layer, char* smem) {
    const int lane = tidx() & 63, gw = blockIdx.x * NWAVE + (tidx() >> 6), nw = gridDim.x * NWAVE;
    float* rw = (float*)smem;
    for (int i = tidx(); i < 1024 * 16; i += NTH) rw[(i & 15) * 1024 + (i >> 4)] = p.router_w[i];
    __syncthreads();
    bf16_t* H = (bf16_t*)(p.ws + OFF_H);
    int* lcnt = (int*)(smem + 65536);
    if (tidx() < 32) lcnt[tidx()] = 0;
    int my_tok = -1, my_e1 = 0, my_e2 = 0, it = 0; float my_g1 = 0.f, my_g2 = 0.f;
    for (int tok = gw; tok < TTOT; tok += nw) {
        const int pos = tok >= PTOT ? tok - PTOT : tok;
        if (layer == 1 && pos < LCTX) continue;
        f32x4 v[4], h[4];
        row_load(xrow_ptr(p, tok), v, lane);
        const float rstd = row_rstd(v);
        row_norm_mod(v, rstd, p.norm_ffn_g + layer * DM, mod_ptr(p, layer, tok, 3), mod_ptr(p, layer, tok, 4), h, lane);
        row_store_bf16(H + (size_t)tok * DM, h, lane);
        float lg[16];
#pragma unroll
        for (int e = 0; e < 16; ++e) lg[e] = 0.f;
#pragma unroll
        for (int i = 0; i < 4; ++i)
#pragma unroll
            for (int e = 0; e < 16; ++e) {
                const f32x4 w = *(const f32x4*)(rw + e * 1024 + (lane + 64 * i) * 4);
                lg[e] += h[i][0] * w[0] + h[i][1] * w[1] + h[i][2] * w[2] + h[i][3] * w[3];
                if ((e & 3) == 3) asm volatile("" ::: "memory");
            }
#pragma unroll
        for (int e = 0; e < 16; ++e) lg[e] = wave_sum(lg[e]);
        int e1, e2; float g1, g2;
        route_row(p, lg, e1, e2, g1, g2);
        if (lane == it) { my_tok = tok; my_e1 = e1; my_e2 = e2; my_g1 = g1; my_g2 = g2; }
        ++it;
    }
    __syncthreads();
    int r1 = 0, r2 = 0;
    if (my_tok >= 0) { r1 = atomicAdd(&lcnt[my_e1], 1); r2 = atomicAdd(&lcnt[my_e2], 1); }
    __syncthreads();
    if (tidx() < 16) { const int n = lcnt[tidx()]; lcnt[16 + tidx()] = n ? atomicAdd((int*)(p.ws + OFF_CNT) + layer * 16 + tidx(), n) : 0; }
    __syncthreads();
    if (my_tok >= 0) {
        int* stok = (int*)(p.ws + OFF_STOK);
        float* sw = (float*)(p.ws + OFF_SW);
        const size_t s1 = (size_t)my_e1 * CAP + lcnt[16 + my_e1] + r1, s2 = (size_t)my_e2 * CAP + lcnt[16 + my_e2] + r2;
        stok[s1] = my_tok * 2 + 0; sw[s1] = my_g1;
        stok[s2] = my_tok * 2 + 1; sw[s2] = my_g2;
    }
    __syncthreads();
}

DI void combine_row(const Params& p, int layer, int tok, f32x4 (&v)[4], int lane) {
    const bf16_t* Y = (const bf16_t*)(p.ws + OFF_SCR + S_Y) + (size_t)tok * 2 * DM;
    const float* g5 = mod_ptr(p, layer, tok, 5);
    f32x4 y0[4], y1[4];
    row_load(xrow_ptr(p, tok), v, lane);
    row_load_bf16(Y, y0, lane); row_load_bf16(Y + DM, y1, lane);
#pragma unroll
    for (int i = 0; i < 4; ++i) { const f32x4 g = *(const f32x4*)(g5 + (lane + 64 * i) * 4); v[i] += g * (y0[i] + y1[i]); }
}
DI void phase_combine_l0(const Params& p, char* smem) {
    const int lane = tidx() & 63, gw = blockIdx.x * NWAVE + (tidx() >> 6), nw = gridDim.x * NWAVE;
    bf16_t* H = (bf16_t*)(p.ws + OFF_H);
    for (int tok = gw; tok < TTOT; tok += nw) {
        f32x4 v[4], h[4];
        combine_row(p, 0, tok, v, lane);
        float* X = xrow_ptr(p, tok);
#pragma unroll
        for (int i = 0; i < 4; ++i) ((f32x4*)X)[lane + 64 * i] = v[i];
        const float rstd = row_rstd(v);
        row_norm_mod(v, rstd, p.norm_mix_g + DM, mod_ptr(p, 1, tok, 0), mod_ptr(p, 1, tok, 1), h, lane);
        row_store_bf16(H + (size_t)tok * DM, h, lane);
    }
    __syncthreads();
    cvt_run(CV_MOE_UNITS, [&](int u) { return cvt_moe_unit(p, 1, u); }, (float*)smem);
}
DI void phase_xx(const Params& p) {
    const int lane = tidx() & 63, gw = blockIdx.x * NWAVE + (tidx() >> 6), nw = gridDim.x * NWAVE;
    const bf16_t* H = (const bf16_t*)(p.ws + OFF_H);
    bf16_t* XX = (bf16_t*)(p.ws + OFF_SCR + S_XX);
    for (int tok = gw; tok < TTOT; tok += nw) {
        const int pos = tok >= PTOT ? tok - PTOT : tok;
        const bool first = pos == 0 || pos == LCTX, last = pos == LCTX - 1 || pos == PTOT - 1;
        f32x4 hc[4], hp[4], hn[4], xx[4];
        row_load_bf16(H + (size_t)tok * DM, hc, lane);
        row_load_bf16(H + (size_t)(first ? tok : tok - 1) * DM, hp, lane);
        row_load_bf16(H + (size_t)(last ? tok : tok + 1) * DM, hn, lane);
#pragma unroll
        for (int i = 0; i < 4; ++i) {
            const f32x4 a = first ? (f32x4){0, 0, 0, 0} : hp[i], b = last ? (f32x4){0, 0, 0, 0} : hn[i];
            xx[i] = 0.5f * (a + b) - hc[i];
        }
        row_store_bf16(XX + (size_t)tok * DM, xx, lane);
    }
}
DI void phase_final(const Params& p) {
    const int lane = tidx() & 63, gw = blockIdx.x * NWAVE + (tidx() >> 6), nw = gridDim.x * NWAVE;
    for (int r = gw; r < NBATCH * SEQ; r += nw) {
        const int b = r / SEQ, tok = b * PTOT + LCTX + (r - b * SEQ);
        f32x4 v[4];
        combine_row(p, 1, tok, v, lane);
        const float rstd = row_rstd(v);
        float* O = p.out + (size_t)r * DM;
#pragma unroll
        for (int i = 0; i < 4; ++i) { const f32x4 g = *(const f32x4*)(p.final_norm_g + (lane + 64 * i) * 4); ((f32x4*)O)[lane + 64 * i] = v[i] * rstd * g; }
    }
}

constexpr int LDSROW = 72;
constexpr int GEMM_SMEM = 2 * (256 + 256) * LDSROW * 2;
template <int NH, class AL, class EPI>
DI void gemm_tile(AL& al, const bf16_t* __restrict__ Bt, int ldb, int nk, EPI& epi, char* smem) {
    const int t = tidx(), lane = t & 63, wid = t >> 6, wr = wid >> 1, wc = wid & 1, fr = lane & 15, fq = lane >> 4;
    constexpr int BR = 128 * NH;
    bf16_t* sA = (bf16_t*)smem;
    bf16_t* sB = sA + 2 * 256 * LDSROW;
    f32x4 acc[NH][4][4];
#pragma unroll
    for (int h = 0; h < NH; ++h)
#pragma unroll
        for (int m = 0; m < 4; ++m)
#pragma unroll
            for (int n = 0; n < 4; ++n) acc[h][m][n] = (f32x4){0.f, 0.f, 0.f, 0.f};
    const int lr = t >> 3, lc = (t & 7) * 8;
    typename AL::Raw ra[4]; u32x4 rb[2 * NH];
#pragma unroll
    for (int i = 0; i < 4; ++i) al.issue(ra[i], lr + 64 * i, lc, i);
#pragma unroll
    for (int i = 0; i < 2 * NH; ++i) rb[i] = *(const u32x4*)(Bt + (size_t)(lr + 64 * i) * ldb + lc);
#pragma unroll
    for (int i = 0; i < 4; ++i) *(u32x4*)(sA + (lr + 64 * i) * LDSROW + lc) = al.finish(ra[i], lc);
#pragma unroll
    for (int i = 0; i < 2 * NH; ++i) *(u32x4*)(sB + (lr + 64 * i) * LDSROW + lc) = rb[i];
    __syncthreads();
    for (int kt = 0; kt < nk; ++kt) {
        const int cur = kt & 1;
        const bool more = kt + 1 < nk;
        if (more) {
#pragma unroll
            for (int i = 0; i < 4; ++i) al.issue(ra[i], lr + 64 * i, (kt + 1) * 64 + lc, i);
#pragma unroll
            for (int i = 0; i < 2 * NH; ++i) rb[i] = *(const u32x4*)(Bt + (size_t)(lr + 64 * i) * ldb + (kt + 1) * 64 + lc);
        }
        __builtin_amdgcn_sched_barrier(0);
        const bf16_t* cA = sA + cur * 256 * LDSROW + (wr * 64 + fr) * LDSROW + fq * 8;
        const bf16_t* cB = sB + cur * BR * LDSROW + (wc * 64 + fr) * LDSROW + fq * 8;
#pragma unroll
        for (int kk = 0; kk < 2; ++kk) {
            bf16x8 af[4];
#pragma unroll
            for (int m = 0; m < 4; ++m) af[m] = *(const bf16x8*)(cA + m * 16 * LDSROW + kk * 32);
#pragma unroll
            for (int h = 0; h < NH; ++h) {
                bf16x8 bfr[4];
#pragma unroll
                for (int n = 0; n < 4; ++n) bfr[n] = *(const bf16x8*)(cB + (h * 128 + n * 16) * LDSROW + kk * 32);
#pragma unroll
                for (int m = 0; m < 4; ++m)
#pragma unroll
                    for (int n = 0; n < 4; ++n) acc[h][m][n] = __builtin_amdgcn_mfma_f32_16x16x32_bf16(bfr[n], af[m], acc[h][m][n], 0, 0, 0);
            }
            if (kk == AL::STORE_AT && more) {
                bf16_t* nA = sA + (cur ^ 1) * 256 * LDSROW;
                bf16_t* nB = sB + (cur ^ 1) * BR * LDSROW;
#pragma unroll
                for (int i = 0; i < 4; ++i) *(u32x4*)(nA + (lr + 64 * i) * LDSROW + lc) = al.finish(ra[i], (kt + 1) * 64 + lc);
#pragma unroll
                for (int i = 0; i < 2 * NH; ++i) *(u32x4*)(nB + (lr + 64 * i) * LDSROW + lc) = rb[i];
            }
        }
        __syncthreads();
    }
#pragma unroll
    for (int h = 0; h < NH; ++h) epi(acc[h], wr * 64, h * 128 + wc * 64, fr, fq);
}
constexpr int G8_HB = 128 * 64 * 2;
constexpr int G8_SMEM = 8 * G8_HB;
DI void g8_rc(int& R0, int& C0) {
    const int tz = tidx(), st = tz >> 6, sb = (tz & 63) * 16, swz = sb ^ (((sb >> 9) & 1) << 5);
    R0 = (st >> 1) * 16 + (swz >> 6); C0 = (st & 1) * 32 + ((swz & 63) >> 1);
}
DI int g8_bcol(int h, int rho) { return (rho >> 5) * 64 + h * 32 + (rho & 31); }
struct G8Rows {
    const bf16_t* base; unsigned o0, d1, d2;
    DI const bf16_t* ptr(int h, int i, int kt) const { return (base + (size_t)(h * d2 + i * d1 + kt * 64)) + o0; }
};
struct G8Gather {
    const bf16_t* base; unsigned o[4];
    DI const bf16_t* ptr(int h, int i, int kt) const { return (base + kt * 64) + o[h * 2 + i]; }
};
DI G8Rows g8_arows(const bf16_t* A, int lda) { int R0, C0; g8_rc(R0, C0); return G8Rows{A, (unsigned)(R0 * lda + C0), (unsigned)(64 * lda), (unsigned)(128 * lda)}; }
DI G8Rows g8_brows(const bf16_t* Bt, int ldb) { int R0, C0; g8_rc(R0, C0); return G8Rows{Bt, (unsigned)(g8_bcol(0, R0) * ldb + C0), (unsigned)(128 * ldb), (unsigned)(32 * ldb)}; }
template <class AS, class BS, class EPI, class NF>
DI void gemm8_tile(const AS& as, const BS& bs, int nt  , EPI& epi, char* smem, bool prefetched, NF nextfn) {
    int tz = tidx();
    int wid = tz >> 6, lane = tz & 63, wr = wid >> 2, wc = wid & 3, fr = lane & 15, fq = lane >> 4;
    int loff = ((fr * 64 + fq * 16) ^ ((fr >> 3) << 5));
#define G8_SA(b, h) (smem + ((b) * 2 + (h)) * G8_HB)
#define G8_SB(b, h) (smem + (4 + (b) * 2 + (h)) * G8_HB)
#define G8_STAGE(P, src, h, kt) do { \
        __builtin_amdgcn_global_load_lds((const unsigned*)(src).ptr(h, 0, kt), (LAS unsigned*)((P) + tz * 16), 16, 0, 0); \
        __builtin_amdgcn_global_load_lds((const unsigned*)(src).ptr(h, 1, kt), (LAS unsigned*)((P) + tz * 16 + 8192), 16, 0, 0); } while (0)
#define G8_STA(b, h, kt) G8_STAGE(G8_SA(b, h), as, h, kt)
#define G8_STB(b, h, kt) G8_STAGE(G8_SB(b, h), bs, h, kt)
#define G8_LDA(dst, b, h) _Pragma("unroll") for (int m = 0; m < 4; ++m) _Pragma("unroll") for (int k = 0; k < 2; ++k) \
        dst[m][k] = *(const bf16x8*)(G8_SA(b, h) + (wr * 8 + m * 2 + k) * 1024 + loff)
#define G8_LDB(dst, b, h) _Pragma("unroll") for (int n = 0; n < 2; ++n) _Pragma("unroll") for (int k = 0; k < 2; ++k) \
        dst[n][k] = *(const bf16x8*)(G8_SB(b, h) + (wc * 4 + n * 2 + k) * 1024 + loff)
#define G8_MMA(ai, bj, Bx) do { __builtin_amdgcn_s_setprio(1); \
        _Pragma("unroll") for (int m = 0; m < 4; ++m) _Pragma("unroll") for (int n = 0; n < 2; ++n) _Pragma("unroll") for (int k = 0; k < 2; ++k) \
            acc[ai][bj][m][n] = __builtin_amdgcn_mfma_f32_16x16x32_bf16(Bx[n][k], At[m][k], acc[ai][bj][m][n], 0, 0, 0); \
        __builtin_amdgcn_s_setprio(0); } while (0)
#define G8_WV(n) asm volatile("s_waitcnt vmcnt(" #n ")" ::: "memory")
#define G8_WL(n) asm volatile("s_waitcnt lgkmcnt(" #n ")" ::: "memory")
#define G8_BAR __builtin_amdgcn_s_barrier()
#define G8_SCHED __builtin_amdgcn_sched_barrier(0)
    f32x4 acc[2][2][4][2];
#pragma unroll
    for (int a = 0; a < 2; ++a)
#pragma unroll
        for (int b = 0; b < 2; ++b)
#pragma unroll
            for (int m = 0; m < 4; ++m)
#pragma unroll
                for (int n = 0; n < 2; ++n) acc[a][b][m][n] = (f32x4){0.f, 0.f, 0.f, 0.f};
    bf16x8 At[4][2], B0[2][2], B1[2][2];
    if (!prefetched) { G8_STB(0, 0, 0); G8_STA(0, 0, 0); G8_STB(0, 1, 0); G8_STA(0, 1, 0); }
    if (wr == 1) G8_BAR;
    if (prefetched) G8_WV(0); else G8_WV(4);
    G8_BAR;
    G8_STB(1, 0, 1); G8_STA(1, 0, 1); G8_STB(1, 1, 1);
    G8_WV(6); G8_BAR;
    for (int t = 0; t < nt - 2; t += 2) {
        G8_LDB(B0, 0, 0); G8_SCHED; G8_LDA(At, 0, 0); G8_STA(1, 1, t + 1);
        G8_WL(8); G8_BAR; G8_WL(0); G8_MMA(0, 0, B0); G8_BAR; G8_SCHED;
        G8_LDB(B1, 0, 1); G8_STB(0, 0, t + 2);
        G8_BAR; G8_WL(0); G8_MMA(0, 1, B1); G8_BAR;
        G8_LDA(At, 0, 1); G8_STA(0, 0, t + 2);
        G8_BAR; G8_WL(0); G8_MMA(1, 0, B0); G8_BAR; G8_SCHED;
        G8_STB(0, 1, t + 2);
        G8_WV(6); G8_BAR; G8_MMA(1, 1, B1); G8_BAR;
        G8_LDB(B0, 1, 0); G8_SCHED; G8_LDA(At, 1, 0); G8_STA(0, 1, t + 2);
        G8_WL(8); G8_BAR; G8_WL(0); G8_MMA(0, 0, B0); G8_BAR; G8_SCHED;
        G8_LDB(B1, 1, 1); G8_STB(1, 0, t + 3);
        G8_BAR; G8_WL(0); G8_MMA(0, 1, B1); G8_BAR;
        G8_LDA(At, 1, 1); G8_STA(1, 0, t + 3);
        G8_BAR; G8_WL(0); G8_MMA(1, 0, B0); G8_BAR; G8_SCHED;
        G8_STB(1, 1, t + 3);
        G8_WV(6); G8_BAR; G8_MMA(1, 1, B1); G8_BAR;
    }
    tz = tidx(); wid = tz >> 6; lane = tz & 63; wr = wid >> 2; wc = wid & 3; fr = lane & 15; fq = lane >> 4;
    loff = ((fr * 64 + fq * 16) ^ ((fr >> 3) << 5));
    {
        G8_LDB(B0, 0, 0); G8_WV(0); G8_LDA(At, 0, 0); G8_STA(1, 1, nt - 1);
        G8_BAR; G8_WL(0); G8_MMA(0, 0, B0); G8_BAR;
        G8_LDB(B1, 0, 1); G8_BAR; G8_WL(0); G8_MMA(0, 1, B1); G8_BAR;
        G8_LDA(At, 0, 1); G8_WV(4); G8_BAR; G8_WL(0); G8_MMA(1, 0, B0); G8_MMA(1, 1, B1); G8_BAR;
    }
    {
        G8_LDB(B0, 1, 0); G8_LDA(At, 1, 0); G8_WV(2); G8_BAR; G8_WL(0); G8_MMA(0, 0, B0); G8_BAR;
        G8_LDB(B1, 1, 1); G8_WV(0); G8_BAR; G8_WL(0); G8_MMA(0, 1, B1); G8_BAR;
        G8_LDA(At, 1, 1); G8_BAR; G8_WL(0); G8_MMA(1, 0, B0); G8_MMA(1, 1, B1); G8_BAR;
    }
    if (wr == 0) G8_BAR;
    {
        AS a2; BS b2;
        if (!EPI::STAGED && nextfn(a2, b2)) {
            G8_STAGE(G8_SB(0, 0), b2, 0, 0); G8_STAGE(G8_SA(0, 0), a2, 0, 0); G8_STAGE(G8_SB(0, 1), b2, 1, 0); G8_STAGE(G8_SA(0, 1), a2, 1, 0);
        }
    }
#pragma unroll
    for (int ai = 0; ai < 2; ++ai) {
        f32x4 a4[4][4];
#pragma unroll
        for (int m = 0; m < 4; ++m)
#pragma unroll
            for (int n = 0; n < 4; ++n) a4[m][n] = acc[ai][n >> 1][m][n & 1];
        if constexpr (EPI::STAGED) epi.stage(a4, ai * 128 + wr * 64, wc * 64, fr, fq, smem);
        else epi(a4, ai * 128 + wr * 64, wc * 64, fr, fq);
    }
    if constexpr (EPI::STAGED) {
        __syncthreads();
        epi.flush(smem);
        __syncthreads();
    }
}
template <class TP>
DI void gemm8_run(TP& tp, int nt, char* smem) {
    typename TP::AS as; typename TP::BS bs; typename TP::EPI epi;
    bool pre = false;
    for (int k = 0; tp.get(k, as, bs, epi); ++k) {
        gemm8_tile(as, bs, nt, epi, smem, pre, [&](typename TP::AS& a2, typename TP::BS& b2) { typename TP::EPI e2; return tp.get(k + 1, a2, b2, e2); });
        pre = !TP::EPI::STAGED;
    }
}
DI bool xcd_tile(int k, int nM, int NT, int& mt, int& nt) {
    const bool swz = (gridDim.x & 7) == 0;
    const int j = (swz ? (int)(blockIdx.x >> 3) : (int)blockIdx.x) + (swz ? (int)(gridDim.x >> 3) : (int)gridDim.x) * k, mi = j / NT;
    nt = j - mi * NT; mt = swz ? (int)(blockIdx.x & 7) + 8 * mi : mi;
    return mt < nM;
}
struct ALPlain {
    typedef u32x4 Raw; static constexpr int STORE_AT = 0;
    const bf16_t* A; int lda;
    DI void issue(Raw& r, int row, int k, int) const { r = *(const u32x4*)(A + (size_t)row * lda + k); }
    DI u32x4 finish(const Raw& r, int) const { return r; }
};
struct ALMix {
    struct Raw { u32x4 h, x; };
    static constexpr int STORE_AT = 1;
    const bf16_t* H; const bf16_t* XX; const LAS float* xm;
    DI void issue(Raw& r, int row, int k, int) const { r.h = *(const u32x4*)(H + (size_t)row * DM + k); r.x = *(const u32x4*)(XX + (size_t)row * DM + k); }
    DI void set_mix(const float* g) {
        const int t = tidx();
        LAS float* w = (LAS float*)xm;
        w[t] = g[t]; w[t + 512] = g[t + 512];
        __syncthreads();
    }
    DI u32x4 finish(const Raw& r, int k) const {
        const f32x4 m0 = *(const LAS f32x4*)(xm + k), m1 = *(const LAS f32x4*)(xm + k + 4);
        const u32x4 h = r.h, x = r.x;
        u32x4 o;
        o[0] = pk_bf16(bf_lo(h[0]) + bf_lo(x[0]) * m0[0], bf_hi(h[0]) + bf_hi(x[0]) * m0[1]);
        o[1] = pk_bf16(bf_lo(h[1]) + bf_lo(x[1]) * m0[2], bf_hi(h[1]) + bf_hi(x[1]) * m0[3]);
        o[2] = pk_bf16(bf_lo(h[2]) + bf_lo(x[2]) * m1[0], bf_hi(h[2]) + bf_hi(x[2]) * m1[1]);
        o[3] = pk_bf16(bf_lo(h[3]) + bf_lo(x[3]) * m1[2], bf_hi(h[3]) + bf_hi(x[3]) * m1[3]);
        return o;
    }
};

struct EpiQKV {
    static constexpr bool STAGED = false;
    PLite p; int m0, n0;
    DI void operator()(const f32x4 (&acc)[4][4], int rb, int cb, int fr, int fq) const {
        const int hs = (n0 + cb) >> 6;
        const bool isq = hs < 8 || (hs >= 12 && hs < 20), isv = (hs >= 10 && hs < 12) || hs >= 22, normed = hs >= 12 && hs < 22;
        const float* gam = hs < 20 ? p.qg : p.kg;
        const f32x2* rope = (const f32x2*)(p.ws + OFF_ROPE);
        bf16_t* Q = (bf16_t*)(p.ws + OFF_SCR + S_Q);
        bf16_t* K = (bf16_t*)(p.ws + OFF_SCR + S_K);
        bf16_t* VT = (bf16_t*)(p.ws + OFF_SCR + S_VT);
#pragma unroll
        for (int m = 0; m < 4; ++m) {
            const int tok = m0 + rb + m * 16 + fr, b = tok >= PTOT ? 1 : 0, pos = tok - b * PTOT;
            f32x4 v[4];
#pragma unroll
            for (int n = 0; n < 4; ++n) v[n] = acc[m][n];
            if (normed) {
                float ss = 0.f;
#pragma unroll
                for (int n = 0; n < 4; ++n) ss += v[n][0] * v[n][0] + v[n][1] * v[n][1] + v[n][2] * v[n][2] + v[n][3] * v[n][3];
                ss += __shfl_xor(ss, 16); ss += __shfl_xor(ss, 32);
                const float rstd = rsqrtf(ss * (1.0f / 64.0f) + RMS_EPS);
#pragma unroll
                for (int n = 0; n < 4; ++n) { const f32x4 g = *(const f32x4*)(gam + n * 16 + fq * 4); v[n] = v[n] * rstd * g; }
            }
            if (!isv && pos >= LCTX) {
                const int t = pos - LCTX, prow = t >> 6, pcol = t & 63;
#pragma unroll
                for (int a = 0; a < 2; ++a) {
                    const f32x2* tb = rope + (a == 0 ? prow : 256 + pcol) * 16 + fq * 4;
#pragma unroll
                    for (int j = 0; j < 4; ++j) {
                        const f32x2 cs = tb[j];
                        const float x0 = v[2 * a][j], x1 = v[2 * a + 1][j];
                        v[2 * a][j] = x0 * cs[0] - x1 * cs[1];
                        v[2 * a + 1][j] = x1 * cs[0] + x0 * cs[1];
                    }
                }
            }
            if (isq) {
                const int hq = hs < 8 ? hs : hs - 4;
                bf16_t* dst = Q + ((size_t)(b * 16 + hq) * PTOT + pos) * 64 + fq * 4;
#pragma unroll
                for (int n = 0; n < 4; ++n) { const f32x4 w = v[n] * (0.125f * LOG2E); u32x2 o; o[0] = pk_bf16(w[0], w[1]); o[1] = pk_bf16(w[2], w[3]); *(u32x2*)(dst + n * 16) = o; }
            } else if (!isv) {
                const int kh = hs < 12 ? hs - 8 : hs - 18;
                bf16_t* dst = K + ((size_t)(b * 4 + kh) * PTOT + pos) * 64 + fq * 4;
#pragma unroll
                for (int n = 0; n < 4; ++n) { u32x2 o; o[0] = pk_bf16(v[n][0], v[n][1]); o[1] = pk_bf16(v[n][2], v[n][3]); *(u32x2*)(dst + n * 16) = o; }
            } else {
                const int vh = hs < 12 ? hs - 10 : hs - 20;
                bf16_t* dst = VT + (size_t)(b * 4 + vh) * 64 * PTOT + pos;
#pragma unroll
                for (int n = 0; n < 4; ++n)
#pragma unroll
                    for (int j = 0; j < 4; ++j) dst[(size_t)(n * 16 + fq * 4 + j) * PTOT] = (bf16_t)(pk_bf16(v[n][j], 0.f) & 0xffffu);
            }
        }
    }
};
struct TPQkv {
    typedef G8Rows AS; typedef G8Rows BS; typedef EpiQKV EPI;
    PLite p; const bf16_t* H; const bf16_t* W;
    DI bool get(int k, AS& as, BS& bs, EPI& epi) const {
        int mt, nt; if (!xcd_tile(k, TTOT / 256, QKV_N / 256, mt, nt)) return false;
        as = g8_arows(H + (size_t)mt * 256 * DM, DM); bs = g8_brows(W + (size_t)nt * 256 * DM, DM); epi = EpiQKV{p, mt * 256, nt * 256};
        return true;
    }
};
DI void phase_qkv(const Params& p, char* smem) {
    TPQkv tp{plite(p), (const bf16_t*)(p.ws + OFF_H), (const bf16_t*)(p.ws + OFF_WS) + W_IN};
    gemm8_run(tp, DM / 64, smem);
}

struct EpiResid {
    static constexpr bool STAGED = false;
    PLite p; int m0, n0, layer; bool from_input;
    DI void operator()(const f32x4 (&acc)[4][4], int rb, int cb, int fr, int fq) const {
        const int tok0 = m0 + rb, co = n0 + cb + fq * 4;
        const float* xin = (from_input ? xin_ptr(p, tok0) : xrow_ptr(p, tok0)) + (size_t)fr * DM + co;
        float* xo = xrow_ptr(p, tok0) + (size_t)fr * DM + co;
        const float* gate = mod_ptr(p, layer, tok0, 2) + co;
        f32x4 g[4], xi[2][4];
#pragma unroll
        for (int n = 0; n < 4; ++n) g[n] = *(const f32x4*)(gate + n * 16);
#pragma unroll
        for (int n = 0; n < 4; ++n) xi[0][n] = *(const f32x4*)(xin + n * 16);
#pragma unroll
        for (int m = 0; m < 4; ++m) {
            if (m < 3) {
#pragma unroll
                for (int n = 0; n < 4; ++n) xi[(m + 1) & 1][n] = *(const f32x4*)(xin + (size_t)(m + 1) * 16 * DM + n * 16);
            }
#pragma unroll
            for (int n = 0; n < 4; ++n) *(f32x4*)(xo + (size_t)m * 16 * DM + n * 16) = xi[m & 1][n] + g[n] * acc[m][n];
        }
    }
};
struct TPResid {
    typedef G8Rows AS; typedef G8Rows BS; typedef EpiResid EPI;
    PLite p; const bf16_t* O; const bf16_t* W; int layer;
    DI bool get(int k, AS& as, BS& bs, EPI& epi) const {
        constexpr int MTL = SEQ / 256;
        int mi, nt; if (!xcd_tile(k, layer == 0 ? TTOT / 256 : NBATCH * MTL, 4, mi, nt)) return false;
        const int mt = layer == 0 ? mi : (mi / MTL) * (PTOT / 256) + 1 + (mi % MTL);
        as = g8_arows(O + (size_t)mt * 256 * DM, DM); bs = g8_brows(W + (size_t)nt * 256 * DM, DM); epi = EpiResid{p, mt * 256, nt * 256, layer, layer == 0};
        return true;
    }
};
DI void phase_wout(const Params& p, char* smem) {
    TPResid tp{plite(p), (const bf16_t*)(p.ws + OFF_SCR + S_O), (const bf16_t*)(p.ws + OFF_WS) + W_OUT, 0};
    gemm8_run(tp, DM / 64, smem);
}
DI void phase_wo(const Params& p, char* smem) {
    TPResid tp{plite(p), (const bf16_t*)(p.ws + OFF_SCR + S_OR), (const bf16_t*)(p.ws + OFF_WS) + W_O, 1};
    gemm8_run(tp, DM / 64, smem);
}

struct MoeSched { int nt[16], base[17]; };
DI void moe_sched(const Params& p, int layer, MoeSched& s, int (&cnt)[16]) {
    const int* c = (const int*)(p.ws + OFF_CNT) + layer * 16;
    int acc = 0;
#pragma unroll
    for (int e = 0; e < 16; ++e) { cnt[e] = c[e]; s.nt[e] = (cnt[e] + 255) >> 8; s.base[e] = acc; acc += s.nt[e]; }
    s.base[16] = acc;
}
struct EpiMoe1 {
    static constexpr bool STAGED = true;
    static constexpr int SROW = 136;
    bf16_t* hid;   int n0;
    DI void stage(const f32x4 (&acc)[4][4], int rb, int cb, int fr, int fq, char* smem) const {
        bf16_t* st = (bf16_t*)smem;
        const int c0 = (cb >> 6) * 32 + fq * 4;
#pragma unroll
        for (int m = 0; m < 4; ++m) {
            bf16_t* dst = st + (rb + m * 16 + fr) * SROW + c0;
#pragma unroll
            for (int n = 0; n < 2; ++n) {
                const f32x4 a = acc[m][n], b = acc[m][n + 2];
                u32x2 o;
                o[0] = pk_bf16(siluf_(a[0]) * b[0], siluf_(a[1]) * b[1]);
                o[1] = pk_bf16(siluf_(a[2]) * b[2], siluf_(a[3]) * b[3]);
                *(u32x2*)(dst + n * 16) = o;
            }
        }
    }
    DI void flush(char* smem) const {
        const int t = tidx();
        const bf16_t* st = (const bf16_t*)smem;
        bf16_t* dst = hid + (n0 >> 1) + (t & 15) * 8;
#pragma unroll
        for (int ps = 0; ps < 8; ++ps) {
            const int row = ps * 32 + (t >> 4);
            *(u32x4*)(dst + (size_t)row * 1024) = *(const u32x4*)(st + row * SROW + (t & 15) * 8);
        }
    }
};
struct TPMoe1 {
    typedef G8Gather AS; typedef G8Rows BS; typedef EpiMoe1 EPI;
    MoeSched s; int cnt[16];
    const bf16_t* H; const bf16_t* W13; const int* stok; bf16_t* hid;
    DI bool get(int k, AS& as, BS& bs, EPI& epi) const {
        int mg, nt; if (!xcd_tile(k, s.base[16], 8, mg, nt)) return false;
        int e = 0;
#pragma unroll
        for (int i = 1; i < 16; ++i) if (mg >= s.base[i]) e = i;
        int ce = 0, be = 0;
#pragma unroll
        for (int i = 0; i < 16; ++i) if (i == e) { ce = cnt[i]; be = s.base[i]; }
        const int ml = mg - be;
        int R0, C0; g8_rc(R0, C0);
        as.base = H;
#pragma unroll
        for (int q = 0; q < 4; ++q) {
            const int r = ml * 256 + R0 + 64 * (q & 1) + 128 * (q >> 1);
            const int tk = r < ce ? (stok[(size_t)e * CAP + r] >> 1) : 0;
            as.o[q] = (unsigned)tk * 1024u + C0;
        }
        bs = g8_brows(W13 + (size_t)e * 2048 * 1024 + (size_t)nt * 256 * 1024, 1024);
        epi = EpiMoe1{hid + (size_t)mg * 256 * 1024, nt * 256};
        return true;
    }
};
DI void phase_moe1(const Params& p, int layer, char* smem) {
    TPMoe1 tp;
    moe_sched(p, layer, tp.s, tp.cnt);
    tp.H = (const bf16_t*)(p.ws + OFF_H); tp.W13 = (const bf16_t*)(p.ws + OFF_MOEW); tp.stok = (const int*)(p.ws + OFF_STOK); tp.hid = (bf16_t*)(p.ws + OFF_SCR + S_HID);
    gemm8_run(tp, 16, smem);
}
struct EpiMoe2 {
    static constexpr bool STAGED = false;
    bf16_t* Y; const int* stok; const float* sw; int nvalid, n0;
    DI void operator()(const f32x4 (&acc)[4][4], int rb, int cb, int fr, int fq) const {
        int tkm[4]; float wm[4];
#pragma unroll
        for (int m = 0; m < 4; ++m) { tkm[m] = stok[rb + m * 16 + fr]; wm[m] = sw[rb + m * 16 + fr]; }
#pragma unroll
        for (int m = 0; m < 4; ++m) {
            const int r = rb + m * 16 + fr;
            if (r < nvalid) {
                const int tk = tkm[m]; const float w = wm[m];
                bf16_t* dst = Y + (size_t)tk * 1024 + n0 + cb + fq * 4;
#pragma unroll
                for (int n = 0; n < 4; ++n) { const f32x4 a = acc[m][n] * w; u32x2 o; o[0] = pk_bf16(a[0], a[1]); o[1] = pk_bf16(a[2], a[3]); *(u32x2*)(dst + n * 16) = o; }
            }
        }
    }
};
struct TPMoe2 {
    typedef G8Rows AS; typedef G8Rows BS; typedef EpiMoe2 EPI;
    MoeSched s; int cnt[16];
    const bf16_t* hid; const bf16_t* W2; const int* stok; const float* sw; bf16_t* Y;
    DI bool get(int k, AS& as, BS& bs, EPI& epi) const {
        int mg, nt; if (!xcd_tile(k, s.base[16], 4, mg, nt)) return false;
        int e = 0;
#pragma unroll
        for (int i = 1; i < 16; ++i) if (mg >= s.base[i]) e = i;
        int ce = 0, be = 0;
#pragma unroll
        for (int i = 0; i < 16; ++i) if (i == e) { ce = cnt[i]; be = s.base[i]; }
        const int ml = mg - be;
        as = g8_arows(hid + (size_t)mg * 256 * 1024, 1024); bs = g8_brows(W2 + (size_t)e * 1024 * 1024 + (size_t)nt * 256 * 1024, 1024);
        epi = EpiMoe2{Y, stok + (size_t)e * CAP + ml * 256, sw + (size_t)e * CAP + ml * 256, ce - ml * 256, nt * 256};
        return true;
    }
};
DI void phase_moe2(const Params& p, int layer, char* smem) {
    TPMoe2 tp;
    moe_sched(p, layer, tp.s, tp.cnt);
    tp.hid = (const bf16_t*)(p.ws + OFF_SCR + S_HID); tp.W2 = (const bf16_t*)(p.ws + OFF_MOEW) + (size_t)16 * 2048 * 1024;
    tp.stok = (const int*)(p.ws + OFF_STOK); tp.sw = (const float*)(p.ws + OFF_SW); tp.Y = (bf16_t*)(p.ws + OFF_SCR + S_Y);
    gemm8_run(tp, 16, smem);
}

struct EpiRwkv {
    bf16_t* dst; int ld, m0, n0, act, nstore;
    DI void operator()(const f32x4 (&acc)[4][4], int rb, int cb, int fr, int fq) const {
#pragma unroll
        for (int m = 0; m < 4; ++m) {
            bf16_t* d = dst + (size_t)(m0 + rb + m * 16 + fr) * ld + n0 + cb + fq * 4;
#pragma unroll
            for (int n = 0; n < 4; ++n) {
                const int c = n0 + cb + n * 16 + fq * 4;
                if (c >= ld) continue;
                f32x4 a = acc[m][n];
                if (act == 1) {
#pragma unroll
                    for (int j = 0; j < 4; ++j) { const float e = __builtin_amdgcn_exp2f(a[j] * (2.0f * LOG2E)); a[j] = 1.0f - 2.0f * __builtin_amdgcn_rcpf(e + 1.0f); }
                }
                if (act == 2) {
#pragma unroll
                    for (int j = 0; j < 4; ++j) a[j] = sigmoidf_(a[j]);
                }
                if (c >= nstore) a = (f32x4){0.f, 0.f, 0.f, 0.f};
                u32x2 o; o[0] = pk_bf16(a[0], a[1]); o[1] = pk_bf16(a[2], a[3]);
                *(u32x2*)(d + n * 16) = o;
            }
        }
    }
};
DI void phase_rwkv_proj(const Params& p, char* smem) {
    const bf16_t* H = (const bf16_t*)(p.ws + OFF_H);
    const bf16_t* XX = (const bf16_t*)(p.ws + OFF_SCR + S_XX);
    const bf16_t* wsm = (const bf16_t*)(p.ws + OFF_WS);
    constexpr int MT = TTOT / 256, NU = 14;
    for (int u = blockIdx.x; u < MT * NU; u += gridDim.x) {
        const int mt = u / NU, q = u % NU;
        ALMix al{H + (size_t)mt * 256 * DM, XX + (size_t)mt * 256 * DM, (const LAS float*)(smem + GEMM_SMEM)};
        if (q < 13) {
            const int job = q < 4 ? 0 : q < 8 ? 1 : q < 12 ? 2 : 5, nt = q < 12 ? (q & 3) : 0;
            const int mixj = job == 0 ? 0 : job == 1 ? 2 : job == 2 ? 3 : 5;
            const size_t wofs = job == 0 ? W_R : job == 1 ? W_K : job == 2 ? W_V : W_G1;
            const size_t dofs = job == 0 ? S_R : job == 1 ? S_KK : job == 2 ? S_V : S_LG;
            al.set_mix(p.rwkv_x_mix + mixj * DM);
            EpiRwkv epi{(bf16_t*)(p.ws + OFF_SCR + dofs), job == 5 ? 192 : 1024, mt * 256, nt * 256, job == 5 ? 2 : 0, job == 5 ? 160 : 4096};
            gemm_tile<2>(al, wsm + wofs + (size_t)nt * 256 * DM, DM, DM / 64, epi, smem);
        } else {
#pragma unroll 1
            for (int j = 0; j < 2; ++j) {
                al.set_mix(p.rwkv_x_mix + (j == 0 ? 1 : 4) * DM);
                EpiRwkv epi{(bf16_t*)(p.ws + OFF_SCR + (j == 0 ? S_LW : S_LA)), 128, mt * 256, 0, j == 0 ? 1 : 0, 4096};
                gemm_tile<1>(al, wsm + (j == 0 ? W_W1 : W_A1), DM, DM / 64, epi, smem);
            }
        }
    }
}

struct EpiGate {
    const Params* p; int m0, n0;
    DI void operator()(const f32x4 (&acc)[4][4], int rb, int cb, int fr, int fq) const {
        const bf16_t* Y0 = (const bf16_t*)(p->ws + OFF_H);
        const bf16_t* Y1 = (const bf16_t*)(p->ws + OFF_SCR + S_Y1);
        const bf16_t* V = (const bf16_t*)(p->ws + OFF_SCR + S_V);
        const float* bonus = (const float*)(p->ws + OFF_BONUS2);
        bf16_t* O = (bf16_t*)(p->ws + OFF_SCR + S_OR);
        const int c0 = n0 + cb, hd = c0 >> 6;
#pragma unroll
        for (int m = 0; m < 4; ++m) {
            const int tok = m0 + rb + m * 16 + fr;
            const size_t ro = (size_t)tok * DM + c0 + fq * 4;
            f32x4 y[4];
            float s = 0.f;
#pragma unroll
            for (int n = 0; n < 4; ++n) {
                const u32x2 a = *(const u32x2*)(Y0 + ro + n * 16), b = *(const u32x2*)(Y1 + ro + n * 16);
                y[n][0] = bf_lo(a[0]) + bf_lo(b[0]); y[n][1] = bf_hi(a[0]) + bf_hi(b[0]); y[n][2] = bf_lo(a[1]) + bf_lo(b[1]); y[n][3] = bf_hi(a[1]) + bf_hi(b[1]);
                s += y[n][0] + y[n][1] + y[n][2] + y[n][3];
            }
            s += __shfl_xor(s, 16); s += __shfl_xor(s, 32);
            const float mu = s * (1.0f / 64.0f);
            float q = 0.f;
#pragma unroll
            for (int n = 0; n < 4; ++n) { const f32x4 d = y[n] - mu; q += d[0] * d[0] + d[1] * d[1] + d[2] * d[2] + d[3] * d[3]; }
            q += __shfl_xor(q, 16); q += __shfl_xor(q, 32);
            const float rs = rsqrtf(q * (1.0f / 64.0f) + GN_EPS);
            const float bon = (bonus[(size_t)tok * 16 + hd] + bonus[(size_t)(TTOT + tok) * 16 + hd]) + (bonus[(size_t)(2 * TTOT + tok) * 16 + hd] + bonus[(size_t)(3 * TTOT + tok) * 16 + hd]);
#pragma unroll
            for (int n = 0; n < 4; ++n) {
                const int c = c0 + n * 16 + fq * 4;
                const f32x4 g = *(const f32x4*)(p->rwkv_ln_g + c), bb = *(const f32x4*)(p->rwkv_ln_b + c);
                const u32x2 vv = *(const u32x2*)(V + ro + n * 16);
                const f32x4 v4 = {bf_lo(vv[0]), bf_hi(vv[0]), bf_lo(vv[1]), bf_hi(vv[1])};
                const f32x4 o = ((y[n] - mu) * rs * g + bb + bon * v4) * acc[m][n];
                u32x2 w; w[0] = pk_bf16(o[0], o[1]); w[1] = pk_bf16(o[2], o[3]);
                *(u32x2*)(O + ro + n * 16) = w;
            }
        }
    }
};
DI void phase_gate(const Params& p, char* smem) {
    const bf16_t* LG = (const bf16_t*)(p.ws + OFF_SCR + S_LG);
    const bf16_t* W = (const bf16_t*)(p.ws + OFF_WS) + W_G2;
    constexpr int NT = 8, MT = TTOT / 256;
    for (int k = 0;; ++k) {
        int mt, nt; if (!xcd_tile(k, MT, NT, mt, nt)) break;
        ALPlain al{LG + (size_t)mt * 256 * 192, 192};
        EpiGate epi{&p, mt * 256, nt * 128};
        gemm_tile<1>(al, W + (size_t)nt * 128 * 192, 192, 3, epi, smem);
    }
}

constexpr int KROW = 72, VROW = 68;
constexpr int ATT_SMEM = 2 * 64 * KROW * 2 + 2 * 64 * VROW * 2;
DI int crow_(int i, int h) { return (i & 3) + 8 * (i >> 2) + 4 * h; }
#define MFMA32(a, b, c) __builtin_amdgcn_mfma_f32_32x32x16_bf16((a), (b), (c), 0, 0, 0)
template <int MODE>
DI void attn_unit(const Params& p, const bf16_t* Qg  , int nq_valid, const bf16_t* Kg  , const bf16_t* Vg  ,
                  int ta0, int ta1, int tb0, int tb1  , bool band, int q_lat0  ,
                  float init_m, float init_l0, bf16_t* Og  , char* smem) {
    const int t = tidx(), lane = t & 63, wid = t >> 6, r = lane & 31, h = lane >> 5;
    bf16_t* sK = (bf16_t*)smem;
    bf16_t* sV = sK + 2 * 64 * KROW;
    bf16x8 qf[2][4];
#pragma unroll
    for (int qs = 0; qs < 2; ++qs) {
        const int qi = wid * 64 + qs * 32 + r;
        const bf16_t* qp = Qg + (size_t)(qi < nq_valid ? qi : 0) * 64 + 8 * h;
#pragma unroll
        for (int ks = 0; ks < 4; ++ks) qf[qs][ks] = *(const bf16x8*)(qp + ks * 16);
    }
#pragma unroll
    for (int qs = 0; qs < 2; ++qs)
#pragma unroll
        for (int ks = 0; ks < 4; ++ks) asm volatile("" : "+v"(qf[qs][ks]));
    f32x16 o[2][2];
#pragma unroll
    for (int qs = 0; qs < 2; ++qs)
#pragma unroll
        for (int dt = 0; dt < 2; ++dt)
#pragma unroll
            for (int i = 0; i < 16; ++i) o[qs][dt][i] = 0.f;
    float mrun[2], lrun[2];
#pragma unroll
    for (int qs = 0; qs < 2; ++qs) { mrun[qs] = init_m; lrun[qs] = (MODE == 1 && h == 0) ? init_l0 : 0.f; }
    const int ntile = ((ta1 - ta0) + (tb1 - tb0)) >> 6;
    const int lrow = t >> 3, lch = (t & 7) * 8;
    u32x4 rk, rv;
    auto tile_pos = [&](int i) { const int a = (ta1 - ta0) >> 6; return i < a ? ta0 + i * 64 : tb0 + (i - a) * 64; };
    {
        const int kp = tile_pos(0);
        rk = *(const u32x4*)(Kg + (size_t)(kp + lrow) * 64 + lch);
        rv = *(const u32x4*)(Vg + (size_t)lrow * PTOT + kp + lch);
        *(u32x4*)(sK + lrow * KROW + lch) = rk;
        *(u32x2*)(sV + lrow * VROW + lch) = (u32x2){rv[0], rv[1]};
        *(u32x2*)(sV + lrow * VROW + lch + 4) = (u32x2){rv[2], rv[3]};
    }
    __syncthreads();
    for (int it = 0; it < ntile; ++it) {
        const int cur = it & 1;
        const bool more = it + 1 < ntile;
        const int kp = tile_pos(it);
        if (more) {
            const int kn = tile_pos(it + 1);
            rk = *(const u32x4*)(Kg + (size_t)(kn + lrow) * 64 + lch);
            rv = *(const u32x4*)(Vg + (size_t)lrow * PTOT + kn + lch);
        }
        __builtin_amdgcn_sched_barrier(0);
        const bf16_t* cK = sK + cur * 64 * KROW;
        const bf16_t* cV = sV + cur * 64 * VROW;
        bf16x8 kf[4];
#pragma unroll
        for (int ks = 0; ks < 4; ++ks) kf[ks] = *(const bf16x8*)(cK + r * KROW + ks * 16 + 8 * h);
#pragma unroll
        for (int ksub = 0; ksub < 2; ++ksub) {
            bf16x8 vf[2][2];
#pragma unroll
            for (int st = 0; st < 2; ++st)
#pragma unroll
                for (int dt = 0; dt < 2; ++dt) {
                    const int kb = ksub * 32 + 16 * st + 4 * h;
                    const s16x4 lo = *(const s16x4*)(cV + (dt * 32 + r) * VROW + kb), hi = *(const s16x4*)(cV + (dt * 32 + r) * VROW + kb + 8);
                    vf[st][dt] = __builtin_shufflevector(lo, hi, 0, 1, 2, 3, 4, 5, 6, 7);
                }
            __builtin_amdgcn_sched_barrier(0);
            f32x16 sc[2];
#pragma unroll
            for (int qs = 0; qs < 2; ++qs)
#pragma unroll
                for (int i = 0; i < 16; ++i) sc[qs][i] = MODE == 0 ? init_m : 0.f;
#pragma unroll
            for (int ks = 0; ks < 4; ++ks)
#pragma unroll
                for (int qs = 0; qs < 2; ++qs) sc[qs] = MFMA32(kf[ks], qf[qs][ks], sc[qs]);
            __builtin_amdgcn_sched_barrier(0);
            if (ksub == 0) {
#pragma unroll
                for (int ks = 0; ks < 4; ++ks) kf[ks] = *(const bf16x8*)(cK + (32 + r) * KROW + ks * 16 + 8 * h);
            }
            __builtin_amdgcn_sched_barrier(0);
#pragma unroll
            for (int qs = 0; qs < 2; ++qs) {
                if (MODE == 1) {
                    if (band && kp >= LCTX) {
                        const int qlat = q_lat0 + wid * 64 + qs * 32 + r, kl0 = kp - LCTX + ksub * 32;
#pragma unroll
                        for (int i = 0; i < 16; ++i) {
                            const int d0 = qlat - (kl0 + crow_(i, h));
                            if (d0 > 128 || d0 < -128) sc[qs][i] = -1e30f;
                        }
                    }
                    float mt = sc[qs][0];
#pragma unroll
                    for (int i = 1; i < 16; ++i) mt = fmaxf(mt, sc[qs][i]);
                    mt = fmaxf(mt, __shfl_xor(mt, 32));
                    const float mnew = fmaxf(mrun[qs], mt);
                    const float alpha = __builtin_amdgcn_exp2f(mrun[qs] - mnew);
                    mrun[qs] = mnew; lrun[qs] *= alpha;
#pragma unroll
                    for (int i = 0; i < 16; ++i) { o[qs][0][i] *= alpha; o[qs][1][i] *= alpha; }
#pragma unroll
                    for (int i = 0; i < 16; ++i) sc[qs][i] -= mnew;
                }
                float ls = 0.f;
#pragma unroll
                for (int i = 0; i < 16; ++i) { sc[qs][i] = __builtin_amdgcn_exp2f(sc[qs][i]); ls += sc[qs][i]; }
                lrun[qs] += ls;
            }
#pragma unroll
            for (int st = 0; st < 2; ++st) {
                bf16x8 pf[2];
#pragma unroll
                for (int qs = 0; qs < 2; ++qs) {
                    u32x4 pw;
#pragma unroll
                    for (int j = 0; j < 4; ++j) pw[j] = pk_bf16(sc[qs][8 * st + 2 * j], sc[qs][8 * st + 2 * j + 1]);
                    pf[qs] = __builtin_bit_cast(bf16x8, pw);
                }
#pragma unroll
                for (int dt = 0; dt < 2; ++dt)
#pragma unroll
                    for (int qs = 0; qs < 2; ++qs) o[qs][dt] = MFMA32(vf[st][dt], pf[qs], o[qs][dt]);
            }
        }
        if (more) {
            bf16_t* nK = sK + (cur ^ 1) * 64 * KROW;
            bf16_t* nV = sV + (cur ^ 1) * 64 * VROW;
            *(u32x4*)(nK + lrow * KROW + lch) = rk;
            *(u32x2*)(nV + lrow * VROW + lch) = (u32x2){rv[0], rv[1]};
            *(u32x2*)(nV + lrow * VROW + lch + 4) = (u32x2){rv[2], rv[3]};
        }
        __syncthreads();
    }
#pragma unroll
    for (int qs = 0; qs < 2; ++qs) {
        const int qi = wid * 64 + qs * 32 + r;
        const float lt = lrun[qs] + __shfl_xor(lrun[qs], 32);
        const float invl = 1.0f / lt;
        if (qi < nq_valid) {
            bf16_t* op = Og + (size_t)qi * DM;
#pragma unroll
            for (int g = 0; g < 4; ++g) {
                u32x2 w0, w1;
                w0[0] = pk_bf16(o[qs][0][4 * g] * invl, o[qs][0][4 * g + 1] * invl); w0[1] = pk_bf16(o[qs][0][4 * g + 2] * invl, o[qs][0][4 * g + 3] * invl);
                w1[0] = pk_bf16(o[qs][1][4 * g] * invl, o[qs][1][4 * g + 1] * invl); w1[1] = pk_bf16(o[qs][1][4 * g + 2] * invl, o[qs][1][4 * g + 3] * invl);
                *(u32x2*)(op + 8 * g + 4 * h) = w0;
                *(u32x2*)(op + 32 + 8 * g + 4 * h) = w1;
            }
        }
    }
}
DI void phase_attn(const Params& p, char* smem) {
    const bf16_t* Q = (const bf16_t*)(p.ws + OFF_SCR + S_Q);
    const bf16_t* K = (const bf16_t*)(p.ws + OFF_SCR + S_K);
    const bf16_t* VT = (const bf16_t*)(p.ws + OFF_SCR + S_VT);
    bf16_t* O = (bf16_t*)(p.ws + OFF_SCR + S_O);
    float gq = 0.f, gk = 0.f;
    for (int i = 0; i < 64; ++i) { gq = fmaxf(gq, fabsf(p.attn_q_norm_g[i])); gk = fmaxf(gk, fabsf(p.attn_k_norm_g[i])); }
    const float M2 = 8.25f * gq * gk * LOG2E;
    constexpr int QB = 512, NQB = SEQ / QB;
    const int G = gridDim.x;
    constexpr int NDENSE = NBATCH * 8 * NQB;
    for (int u = blockIdx.x; u < NDENSE; u += G) {
        int combo, within;
        if ((G & 7) == 0 && NDENSE % G == 0) {
            const int xcd = blockIdx.x & 7, idx = (blockIdx.x >> 3) + (G >> 3) * (u / G);
            combo = xcd & 3; within = (xcd >> 2) * (NDENSE / 8) + idx;
        } else { combo = u / (4 * NQB); within = u % (4 * NQB); }
        const int b = combo >> 1, kvh = combo & 1, hq = kvh * 4 + (within & 3), qb = within >> 2;
        const bf16_t* Qg = Q + ((size_t)(b * 16 + 8 + hq) * PTOT + LCTX + qb * QB) * 64;
        attn_unit<0>(p, Qg, QB, K + (size_t)(b * 4 + 2 + kvh) * PTOT * 64, VT + (size_t)(b * 4 + 2 + kvh) * 64 * PTOT, 0, PTOT, 0, 0, false, 0, -M2, 0.f,
                     O + (size_t)(b * PTOT + LCTX + qb * QB) * DM + (8 + hq) * 64, smem);
    }
    for (int u = blockIdx.x; u < NDENSE; u += G) {
        const int b = u / (8 * NQB), rem = u % (8 * NQB), qb = rem >> 3, hq = rem & 7, kvh = hq >> 2;
        const int i0 = qb * QB;
        const int lo = i0 - 128 < 0 ? 0 : i0 - 128, hi = i0 + QB + 128 > SEQ ? SEQ : i0 + QB + 128;
        const bf16_t* Qg = Q + ((size_t)(b * 16 + hq) * PTOT + LCTX + i0) * 64;
        attn_unit<1>(p, Qg, QB, K + (size_t)(b * 4 + kvh) * PTOT * 64, VT + (size_t)(b * 4 + kvh) * 64 * PTOT, 0, LCTX, LCTX + lo, LCTX + hi, true, i0,
                     p.attn_sink[hq] * LOG2E, 1.0f, O + (size_t)(b * PTOT + LCTX + i0) * DM + hq * 64, smem);
    }
    for (int u = blockIdx.x; u < NBATCH * 16; u += G) {
        const int b = u >> 4, hh = u & 15, isb = hh >> 3, hq = hh & 7, kvh = isb * 2 + (hq >> 2);
        const bf16_t* Qg = Q + ((size_t)(b * 16 + hh) * PTOT) * 64;
        attn_unit<1>(p, Qg, LCTX, K + (size_t)(b * 4 + kvh) * PTOT * 64, VT + (size_t)(b * 4 + kvh) * 64 * PTOT, 0, LCTX, 0, 0, false, 0,
                     isb ? -1e30f : p.attn_sink[hq] * LOG2E, isb ? 0.f : 1.0f, O + (size_t)(b * PTOT) * DM + hh * 64, smem);
    }
}

constexpr int TB = 32, NBUF = 3;
constexpr int SC_REC = 5 * 64;
constexpr int SC_OPS = TB * SC_REC * 4;
constexpr int SC_SMEM = NBUF * SC_OPS + NBUF * TB * 16 * 4 + NBUF * TB * 16 * 4 + 64;
DI int scan_pos(int n, int dir) {
    if (n < LCTX) return dir ? LCTX - 1 - n : n;
    const int m = n - LCTX;
    return LCTX + (dir ? SEQ - 1 - m : m);
}
template <int CTRL> DI float dpp_add(float v) { return v + __builtin_bit_cast(float, __builtin_amdgcn_update_dpp(0, __builtin_bit_cast(int, v), CTRL, 0xf, 0xf, false)); }
DI float row16_sum(float v) { v = dpp_add<0x128>(v); v = dpp_add<0x124>(v); v = dpp_add<0x122>(v); v = dpp_add<0x121>(v); return v; }
DI int lds_min4(int* c) { const volatile LAS int* q = (const volatile LAS int*)c; const int a = q[0], b = q[1], d = q[2], e = q[3]; return min(min(a, b), min(d, e)); }
DI void lds_publish(int* c, int v) { *(volatile LAS int*)c = v; }
DI void scan_unit(const Params& p, int u, char* smem) {
    const int t = tidx(), lane = t & 63, wid = __builtin_amdgcn_readfirstlane(t >> 6);
    const unsigned rg = u & 3, dir = (u >> 2) & 1, hd = (u >> 3) & 15, b = u >> 7;
    float* ops = (float*)smem;
    float* vbuf = (float*)(smem + NBUF * SC_OPS);
    float* ybuf = vbuf + NBUF * TB * 16;
    int* cnts = (int*)(ybuf + NBUF * TB * 16);
    const bf16_t* R = (const bf16_t*)(p.ws + OFF_SCR + S_R);
    const bf16_t* Kk = (const bf16_t*)(p.ws + OFF_SCR + S_KK);
    const bf16_t* V = (const bf16_t*)(p.ws + OFF_SCR + S_V);
    const bf16_t* LW = (const bf16_t*)(p.ws + OFF_SCR + S_LW);
    const bf16_t* LA = (const bf16_t*)(p.ws + OFF_SCR + S_LA);
    bf16_t* Yo = dir ? (bf16_t*)(p.ws + OFF_SCR + S_Y1) : (bf16_t*)(p.ws + OFF_H);
    float* bonus = (float*)(p.ws + OFF_BONUS2);
    const unsigned tokb = b * PTOT, hc = hd * 64;
    constexpr int NBLK = PTOT / TB;
    const unsigned fr = lane & 15, fq = lane >> 4;
    if (t < 8) cnts[t] = 0;
    __syncthreads();

    if (wid < 4) {
        __builtin_amdgcn_s_setprio(3);
        float s0 = 0.f, s1 = 0.f, s2 = 0.f, s3 = 0.f;
        const unsigned g = lane >> 4, c4 = (lane & 15) * 4, myrow = wid * 4 + g;
        for (int blk = 0; blk < NBLK; ++blk) {
            const unsigned buf = (unsigned)blk % NBUF;
            while (lds_min4(cnts) < blk + 1) __builtin_amdgcn_s_sleep(1);
            asm volatile("" ::: "memory");
            const float* rec = ops + buf * (TB * SC_REC) + c4;
            const float* vb = vbuf + buf * (TB * 16) + myrow;
            float* yb = ybuf + buf * (TB * 16) + myrow;
            f32x4 w0_ = *(const f32x4*)(rec), kd0_ = *(const f32x4*)(rec + 64), bb0_ = *(const f32x4*)(rec + 128), aa0_ = *(const f32x4*)(rec + 192), rr0_ = *(const f32x4*)(rec + 256);
            float vv0_ = vb[0];
#define SCAN_STEP(W, KD, BB, AA, RR, VV, ST) { \
                float sa = s0 * AA[0] + s1 * AA[1] + s2 * AA[2] + s3 * AA[3]; \
                sa = row16_sum(sa); \
                s0 = s0 * W[0] + sa * BB[0] + VV * KD[0]; \
                s1 = s1 * W[1] + sa * BB[1] + VV * KD[1]; \
                s2 = s2 * W[2] + sa * BB[2] + VV * KD[2]; \
                s3 = s3 * W[3] + sa * BB[3] + VV * KD[3]; \
                float y = s0 * RR[0] + s1 * RR[1] + s2 * RR[2] + s3 * RR[3]; \
                y = row16_sum(y); \
                if ((lane & 15) == 0) yb[(ST) * 16] = y; }
#pragma unroll 1
            for (int st = 0; st < TB; st += 2) {
                const float* r1 = rec + (st + 1) * SC_REC;
                const f32x4 w1_ = *(const f32x4*)(r1), kd1_ = *(const f32x4*)(r1 + 64), bb1_ = *(const f32x4*)(r1 + 128), aa1_ = *(const f32x4*)(r1 + 192), rr1_ = *(const f32x4*)(r1 + 256);
                const float vv1_ = vb[(st + 1) * 16];
                SCAN_STEP(w0_, kd0_, bb0_, aa0_, rr0_, vv0_, st)
                const int st2 = st + 2 < TB ? st + 2 : st;
                const float* r2 = rec + st2 * SC_REC;
                w0_ = *(const f32x4*)(r2); kd0_ = *(const f32x4*)(r2 + 64); bb0_ = *(const f32x4*)(r2 + 128); aa0_ = *(const f32x4*)(r2 + 192); rr0_ = *(const f32x4*)(r2 + 256);
                vv0_ = vb[st2 * 16];
                SCAN_STEP(w1_, kd1_, bb1_, aa1_, rr1_, vv1_, st + 1)
            }
#undef SCAN_STEP
            asm volatile("s_waitcnt lgkmcnt(0)" ::: "memory");
            if (lane == 0) lds_publish(cnts + 4 + wid, blk + 1);
        }
        __builtin_amdgcn_s_setprio(0);
    } else {
        const unsigned wt = wid & 1, chh = (wid >> 1) & 1;
        const bf16_t* wsm = (const bf16_t*)(p.ws + OFF_WS);
        const unsigned wo = W_W2 + dir * 65536u + (hc + fr) * 64u + fq * 8u;
        const unsigned ao = W_A2 + dir * 65536u + (hc + fr) * 64u + fq * 8u;
        const unsigned po = hc + fq * 4u;
        for (int blk = 0; blk < NBLK + NBUF; ++blk) {
            const unsigned buf = (unsigned)blk % NBUF;
            const int need = blk - NBUF + 1 < NBLK ? blk - NBUF + 1 : NBLK;
            while (lds_min4(cnts + 4) < need) __builtin_amdgcn_s_sleep(1);
            asm volatile("" ::: "memory");
            if (wid == 7 && blk >= NBUF) {
#pragma unroll
                for (int i = 0; i < TB * 16 / 64; ++i) {
                    const unsigned id = i * 64 + lane, st = id >> 4, rw = id & 15;
                    const unsigned tok = tokb + scan_pos((blk - NBUF) * TB + st, dir);
                    Yo[tok * 1024u + hc + rg * 16 + rw] = (bf16_t)(pk_bf16(ybuf[buf * (TB * 16) + id], 0.f) & 0xffffu);
                }
            }
            if (blk >= NBLK) continue;
            const unsigned st = wt * 16 + fr;
            const unsigned tok = tokb + scan_pos(blk * TB + st, dir);
            const unsigned lo = tok * 128u + dir * 64u + fq * 8u;
            const unsigned ro = tok * 1024u + hc + fq * 4u;
            bf16x8 lwf[2], laf[2];
#pragma unroll
            for (int kk = 0; kk < 2; ++kk) { lwf[kk] = *(const bf16x8*)(LW + lo + kk * 32); laf[kk] = *(const bf16x8*)(LA + lo + kk * 32); }
            float ssq = 0.f;
#pragma unroll
            for (int nt = 0; nt < 4; ++nt) {
                const f32x4 kkv = *(const f32x4*)(p.rwkv_k_k + po + nt * 16);
                const u32x2 c = *(const u32x2*)(Kk + ro + nt * 16);
                const float q0 = bf_lo(c[0]) * kkv[0], q1 = bf_hi(c[0]) * kkv[1], q2 = bf_lo(c[1]) * kkv[2], q3 = bf_hi(c[1]) * kkv[3];
                ssq += q0 * q0 + q1 * q1 + q2 * q2 + q3 * q3;
            }
            ssq += __shfl_xor(ssq, 16); ssq += __shfl_xor(ssq, 32);
            const float kn = __builtin_amdgcn_rsqf(fmaxf(ssq, 1e-24f));
            float* rec = ops + buf * (TB * SC_REC) + st * SC_REC + fq * 4;
            float bsum = 0.f;
#pragma unroll
            for (int n2 = 0; n2 < 2; ++n2) {
                const unsigned nt = chh * 2 + n2;
                f32x4 aw = {0.f, 0.f, 0.f, 0.f}, ai = aw;
#pragma unroll
                for (int kk = 0; kk < 2; ++kk) {
                    const bf16x8 w2f = *(const bf16x8*)(wsm + wo + nt * 1024 + kk * 32), a2f = *(const bf16x8*)(wsm + ao + nt * 1024 + kk * 32);
                    aw = __builtin_amdgcn_mfma_f32_16x16x32_bf16(w2f, lwf[kk], aw, 0, 0, 0);
                    ai = __builtin_amdgcn_mfma_f32_16x16x32_bf16(a2f, laf[kk], ai, 0, 0, 0);
                }
                const f32x4 w0v = *(const f32x4*)(p.rwkv_decay_w0 + dir * 1024u + po + nt * 16), a0v = *(const f32x4*)(p.rwkv_iclr_a0 + dir * 1024u + po + nt * 16);
                const f32x4 kkv = *(const f32x4*)(p.rwkv_k_k + po + nt * 16);
                const f32x4 kav = *(const f32x4*)(p.rwkv_k_a + po + nt * 16), rkv = *(const f32x4*)(p.rwkv_r_k + po + nt * 16);
                const u32x2 a = *(const u32x2*)(R + ro + nt * 16), c = *(const u32x2*)(Kk + ro + nt * 16);
                const f32x4 rr = {bf_lo(a[0]), bf_hi(a[0]), bf_lo(a[1]), bf_hi(a[1])};
                const f32x4 kr = {bf_lo(c[0]), bf_hi(c[0]), bf_lo(c[1]), bf_hi(c[1])};
                f32x4 wv, kd, bb, aa;
#pragma unroll
                for (int j = 0; j < 4; ++j) {
                    const float sg = __builtin_amdgcn_rcpf(1.0f + __builtin_amdgcn_exp2f(-(w0v[j] + aw[j]) * LOG2E));
                    wv[j] = __builtin_amdgcn_exp2f(sg * (-0.6065306597126334f * LOG2E));
                    const float ic = __builtin_amdgcn_rcpf(1.0f + __builtin_amdgcn_exp2f(-(a0v[j] + ai[j]) * LOG2E));
                    const float kkn = kr[j] * kkv[j] * kn;
                    kd[j] = kr[j] * (1.0f + (ic - 1.0f) * kav[j]);
                    bb[j] = kkn * ic;
                    aa[j] = -kkn;
                    bsum += rr[j] * kd[j] * rkv[j];
                }
                *(f32x4*)(rec + 0 * 64 + nt * 16) = wv;
                *(f32x4*)(rec + 1 * 64 + nt * 16) = kd;
                *(f32x4*)(rec + 2 * 64 + nt * 16) = bb;
                *(f32x4*)(rec + 3 * 64 + nt * 16) = aa;
                *(f32x4*)(rec + 4 * 64 + nt * 16) = rr;
            }
            bsum += __shfl_xor(bsum, 16); bsum += __shfl_xor(bsum, 32);
            if (rg == 0 && fq == 0) bonus[((chh * 2 + dir) * TTOT + tok) * 16u + hd] = bsum;
            if (wid == 6) {
                bf16_t vr[TB * 16 / 64];
#pragma unroll
                for (int i = 0; i < TB * 16 / 64; ++i) {
                    const unsigned id = i * 64 + lane, s2 = id >> 4, rw = id & 15;
                    const unsigned tk = tokb + scan_pos(blk * TB + s2, dir);
                    vr[i] = V[tk * 1024u + hc + rg * 16 + rw];
                }
#pragma unroll
                for (int i = 0; i < TB * 16 / 64; ++i) vbuf[buf * (TB * 16) + i * 64 + lane] = bf2f(vr[i]);
            }
            asm volatile("s_waitcnt lgkmcnt(0)" ::: "memory");
            if (lane == 0) lds_publish(cnts + (wid - 4), blk + 1);
        }
    }
    __syncthreads();
}

constexpr int CH = 16, NCHK = PTOT / CH;
constexpr int NPREP = 7, NSLOT = 2;
constexpr int TKS = 72, KTS = 20, SMS = 20;
constexpr int SL_PT = 0, SL_QM = SL_PT + 64 * TKS * 2, SL_RT = SL_QM + 64 * KTS * 2, SL_G2 = SL_RT + 16 * TKS * 2, SL_VT = SL_G2 + 16 * SMS * 2, SL_WC = SL_VT + 16 * SMS * 2,
              SLOT_BYTES = SL_WC + 64 * 4;
constexpr int XTK_B = 16 * TKS * 2, XKT_B = 64 * KTS * 2, SM_B = 16 * SMS * 2;
constexpr int PR_XA = 0, PR_XB = PR_XA + XTK_B, PR_XK = PR_XB + XTK_B, PR_XR = PR_XK + XTK_B, PR_TA = PR_XR + XTK_B, PR_TB = PR_TA + XKT_B, PR_TK = PR_TB + XKT_B,
              PR_SN = PR_TK + XKT_B, PREP_BYTES = PR_SN + 2 * SM_B;
static_assert(10 * SM_B <= 3 * XTK_B, "matrices fit in XA..XK");
constexpr int SC2_SMEM = NSLOT * SLOT_BYTES + NPREP * PREP_BYTES + 64 + 5 * 64 * 4;
typedef short s16x4v __attribute__((ext_vector_type(4)));
DI f32x4 mfma16(s16x4v a, s16x4v b, f32x4 c) { return __builtin_amdgcn_mfma_f32_16x16x16bf16_1k(a, b, c, 0, 0, 0); }
DI f32x4 mfma32(bf16x8 a, bf16x8 b, f32x4 c) { return __builtin_amdgcn_mfma_f32_16x16x32_bf16(a, b, c, 0, 0, 0); }
DI s16x4v ld4(const bf16_t* q) { return *(const s16x4v*)q; }
DI f32x4 up4(u32x2 w) { return (f32x4){bf_lo(w[0]), bf_hi(w[0]), bf_lo(w[1]), bf_hi(w[1])}; }
DI f32x4 ld4f(const bf16_t* q) { return up4(*(const u32x2*)q); }
DI void st4(bf16_t* q, f32x4 v) { u32x2 w; w[0] = pk_bf16(v[0], v[1]); w[1] = pk_bf16(v[2], v[3]); *(u32x2*)q = w; }
#define LDS_WAIT() asm volatile("s_waitcnt lgkmcnt(0)" ::: "memory")
template <int CTRL> DI float dpp_shr_add(float v) { return v + __builtin_bit_cast(float, __builtin_amdgcn_update_dpp(0, __builtin_bit_cast(int, v), CTRL, 0xf, 0xf, true)); }
DI float row16_prefix(float v) { v = dpp_shr_add<0x111>(v); v = dpp_shr_add<0x112>(v); v = dpp_shr_add<0x114>(v); v = dpp_shr_add<0x118>(v); return v; }
DI f32x4 mm16(const bf16_t* A, const bf16_t* Bt, int fr, int fq) {
    const s16x4v a = ld4(A + fr * SMS + fq * 4), b = ld4(Bt + fr * SMS + fq * 4);
    LDS_WAIT();
    return mfma16(a, b, (f32x4){0.f, 0.f, 0.f, 0.f});
}
DI f32x4 mm16p(const bf16_t* A, const bf16_t* Bt, const bf16_t* Add, int fr, int fq) {
    const s16x4v a = ld4(A + fr * SMS + fq * 4), b = ld4(Bt + fr * SMS + fq * 4);
    const u32x2 c = *(const u32x2*)(Add + fr * SMS + fq * 4);
    LDS_WAIT();
    return mfma16(a, b, up4(c));
}

DI void scan_unit_chunked(const Params& p, int u, char* smem) {
    const int t = tidx(), lane = t & 63, wid = __builtin_amdgcn_readfirstlane(t >> 6);
    const unsigned rg = u & 3, dir = (u >> 2) & 1, hd = (u >> 3) & 15, b = u >> 7;
    const unsigned tokb = b * PTOT, hc = hd * 64;
    const unsigned fr = lane & 15, fq = lane >> 4;
    char* slots = smem;
    char* prep0 = smem + NSLOT * SLOT_BYTES;
    int* cnts = (int*)(smem + NSLOT * SLOT_BYTES + NPREP * PREP_BYTES);
    const bf16_t* R = (const bf16_t*)(p.ws + OFF_SCR + S_R);
    const bf16_t* Kk = (const bf16_t*)(p.ws + OFF_SCR + S_KK);
    const bf16_t* V = (const bf16_t*)(p.ws + OFF_SCR + S_V);
    const bf16_t* LW = (const bf16_t*)(p.ws + OFF_SCR + S_LW);
    const bf16_t* LA = (const bf16_t*)(p.ws + OFF_SCR + S_LA);
    bf16_t* Yo = dir ? (bf16_t*)(p.ws + OFF_SCR + S_Y1) : (bf16_t*)(p.ws + OFF_H);
    float* bonus = (float*)(p.ws + OFF_BONUS2);
    float* prm = (float*)(cnts + 16);
    if (t < 16) cnts[t] = 0;
    if (t < 64) {
        prm[t] = p.rwkv_decay_w0[dir * 1024u + hc + t]; prm[64 + t] = p.rwkv_iclr_a0[dir * 1024u + hc + t];
        prm[128 + t] = p.rwkv_k_k[hc + t]; prm[192 + t] = p.rwkv_k_a[hc + t]; prm[256 + t] = p.rwkv_r_k[hc + t];
    }
    __syncthreads();

    if (wid == 0) {
        __builtin_amdgcn_s_setprio(3);
        f32x4 st[4];
#pragma unroll
        for (int m = 0; m < 4; ++m) st[m] = (f32x4){0.f, 0.f, 0.f, 0.f};
        for (int c = 0; c < NCHK; ++c) {
            const unsigned sl = (unsigned)c % NSLOT;
            const char* S = slots + sl * SLOT_BYTES;
            while (*(volatile LAS int*)(cnts + sl) < c + 1) __builtin_amdgcn_s_sleep(1);
            LDS_WAIT();
            const s16x4v vt = ld4((const bf16_t*)(S + SL_VT) + fr * SMS + fq * 4);
            const s16x4v g2 = ld4((const bf16_t*)(S + SL_G2) + fr * SMS + fq * 4);
            s16x4v rtl[2], rth[2], ptl[4][2], pth[4][2], qm[4];
            f32x4 wc[4];
#pragma unroll
            for (int i = 0; i < 2; ++i) { const bf16_t* q = (const bf16_t*)(S + SL_RT) + fr * TKS + 32 * i + fq * 4; rtl[i] = ld4(q); rth[i] = ld4(q + 16); }
#pragma unroll
            for (int m = 0; m < 4; ++m) {
                wc[m] = *(const f32x4*)((const float*)(S + SL_WC) + 16 * m + fq * 4);
                qm[m] = ld4((const bf16_t*)(S + SL_QM) + (16 * m + fr) * KTS + fq * 4);
#pragma unroll
                for (int i = 0; i < 2; ++i) { const bf16_t* q = (const bf16_t*)(S + SL_PT) + (16 * m + fr) * TKS + 32 * i + fq * 4; ptl[m][i] = ld4(q); pth[m][i] = ld4(q + 16); }
            }
            LDS_WAIT();
            if (lane == 0) *(volatile LAS int*)(cnts + 8) = c + 1;
            bf16x8 sb[2];
#pragma unroll
            for (int i = 0; i < 2; ++i) {
                u32x4 w; w[0] = pk_bf16(st[2 * i][0], st[2 * i][1]); w[1] = pk_bf16(st[2 * i][2], st[2 * i][3]); w[2] = pk_bf16(st[2 * i + 1][0], st[2 * i + 1][1]); w[3] = pk_bf16(st[2 * i + 1][2], st[2 * i + 1][3]);
                sb[i] = __builtin_bit_cast(bf16x8, w);
            }
            f32x4 y = {0.f, 0.f, 0.f, 0.f};
#pragma unroll
            for (int i = 0; i < 2; ++i) y = mfma32(__builtin_shufflevector(rtl[i], rth[i], 0, 1, 2, 3, 4, 5, 6, 7), sb[i], y);
            y = mfma16(g2, vt, y);
#pragma unroll
            for (int m = 0; m < 4; ++m) {
                f32x4 acc = st[m] * wc[m];
#pragma unroll
                for (int i = 0; i < 2; ++i) acc = mfma32(__builtin_shufflevector(ptl[m][i], pth[m][i], 0, 1, 2, 3, 4, 5, 6, 7), sb[i], acc);
                st[m] = mfma16(qm[m], vt, acc);
            }

#pragma unroll
            for (int j = 0; j < 4; ++j) {
                const unsigned tok = tokb + scan_pos(c * CH + fq * 4 + j, dir);
                Yo[tok * 1024u + hc + rg * 16 + fr] = (bf16_t)(pk_bf16(y[j], 0.f) & 0xffffu);
            }
        }
        __builtin_amdgcn_s_setprio(0);
    } else {
        const unsigned pid = wid - 1;
        char* PS = prep0 + pid * PREP_BYTES;
        bf16_t* XA = (bf16_t*)(PS + PR_XA); bf16_t* XB = (bf16_t*)(PS + PR_XB); bf16_t* XK = (bf16_t*)(PS + PR_XK); bf16_t* XR = (bf16_t*)(PS + PR_XR);
        bf16_t* TA = (bf16_t*)(PS + PR_TA); bf16_t* TB_ = (bf16_t*)(PS + PR_TB); bf16_t* TK = (bf16_t*)(PS + PR_TK); bf16_t* AT = TA;
        bf16_t* SN = (bf16_t*)(PS + PR_SN);
        bf16_t *M = SN, *NABR = SN + 1 * 16 * SMS;
        bf16_t *M2 = XA, *M2T = XA + 1 * 16 * SMS, *M4 = XA + 2 * 16 * SMS, *M4T = XA + 3 * 16 * SMS, *X1 = XA + 4 * 16 * SMS, *G1 = XA + 5 * 16 * SMS, *NAKR = XA + 6 * 16 * SMS,
                *NRBT = XA + 7 * 16 * SMS, *NRKT = XA + 8 * 16 * SMS, *IM = XA + 9 * 16 * SMS;
        bf16_t *M8T = M2, *X2 = M2T, *TT = M4;
        float* WCP = (float*)SN;
        const bf16_t* wsm = (const bf16_t*)(p.ws + OFF_WS);
        const unsigned wo = W_W2 + dir * 65536u + (hc + fr) * 64u + fq * 8u;
        const unsigned ao = W_A2 + dir * 65536u + (hc + fr) * 64u + fq * 8u;
        const unsigned po = hc + fq * 4u;
        const f32x4 z4 = {0.f, 0.f, 0.f, 0.f};
        bf16x8 lwf[2], laf[2];
        u32x2 krw[4], rrw[4];
        unsigned tok_cur = 0;
        auto issue = [&](int c, bf16x8 (&lw)[2], bf16x8 (&la)[2], u32x2 (&kw)[4], u32x2 (&rw)[4], unsigned& tk) {
            tk = tokb + scan_pos(c * CH + fr, dir);
            const unsigned lo = tk * 128u + dir * 64u + fq * 8u, ro = tk * 1024u + hc + fq * 4u;
#pragma unroll
            for (int kk = 0; kk < 2; ++kk) { lw[kk] = *(const bf16x8*)(LW + lo + kk * 32); la[kk] = *(const bf16x8*)(LA + lo + kk * 32); }
#pragma unroll
            for (int nt = 0; nt < 4; ++nt) { kw[nt] = *(const u32x2*)(Kk + ro + nt * 16); rw[nt] = *(const u32x2*)(R + ro + nt * 16); }
        };
        if ((int)pid < NCHK) issue(pid, lwf, laf, krw, rrw, tok_cur);
#pragma unroll
        for (int kk = 0; kk < 2; ++kk) asm volatile("" : "+v"(lwf[kk]), "+v"(laf[kk]));
#pragma unroll
        for (int nt = 0; nt < 4; ++nt) asm volatile("" : "+v"(krw[nt]), "+v"(rrw[nt]));
        auto ldw = [&](bf16x8 (&w)[2][2], int nt) {
#pragma unroll
            for (int kk = 0; kk < 2; ++kk) { w[0][kk] = *(const bf16x8*)(wsm + wo + nt * 1024 + kk * 32); w[1][kk] = *(const bf16x8*)(wsm + ao + nt * 1024 + kk * 32); }
        };
        for (int c = pid; c < NCHK; c += NPREP) {
            bf16x8 wq[2][2], wn[2][2];
            ldw(wq, 0);
            const unsigned tok = tok_cur;
            float ssq = 0.f;
#pragma unroll
            for (int nt = 0; nt < 4; ++nt) {
                const f32x4 kkv = *(const f32x4*)(prm + 128 + fq * 4 + nt * 16);
                const f32x4 q = up4(krw[nt]) * kkv;
                ssq += q[0] * q[0] + q[1] * q[1] + q[2] * q[2] + q[3] * q[3];
            }
            ssq += __shfl_xor(ssq, 16); ssq += __shfl_xor(ssq, 32);
            const float kn = __builtin_amdgcn_rsqf(fmaxf(ssq, 1e-24f));
            float bsum = 0.f;
#pragma unroll
            for (int nt = 0; nt < 4; ++nt) {
                f32x4 aw = z4, ai = z4;
                if (nt < 3) ldw(wn, nt + 1);
                __builtin_amdgcn_sched_barrier(0);
#pragma unroll
                for (int kk = 0; kk < 2; ++kk) {
                    aw = mfma32(wq[0][kk], lwf[kk], aw);
                    ai = mfma32(wq[1][kk], laf[kk], ai);
                }
                if (nt < 3) {
#pragma unroll
                    for (int kk = 0; kk < 2; ++kk) { wq[0][kk] = wn[0][kk]; wq[1][kk] = wn[1][kk]; }
                }
                const f32x4 w0v = *(const f32x4*)(prm + fq * 4 + nt * 16), a0v = *(const f32x4*)(prm + 64 + fq * 4 + nt * 16);
                const f32x4 kkv = *(const f32x4*)(prm + 128 + fq * 4 + nt * 16);
                const f32x4 kav = *(const f32x4*)(prm + 192 + fq * 4 + nt * 16), rkv = *(const f32x4*)(prm + 256 + fq * 4 + nt * 16);
                LDS_WAIT();
                const f32x4 rr = up4(rrw[nt]), krn4 = up4(krw[nt]);
                const f32x4 x1 = (w0v + aw) * (-LOG2E), x2 = (a0v + ai) * (-LOG2E);
                f32x4 ex1, ex2;
#pragma unroll
                for (int j = 0; j < 4; ++j) { ex1[j] = __builtin_amdgcn_exp2f(x1[j]); ex2[j] = __builtin_amdgcn_exp2f(x2[j]); }
                ex1 = ex1 + 1.0f; ex2 = ex2 + 1.0f;
                f32x4 sg, ic;
#pragma unroll
                for (int j = 0; j < 4; ++j) { sg[j] = __builtin_amdgcn_rcpf(ex1[j]); ic[j] = __builtin_amdgcn_rcpf(ex2[j]); }
                const f32x4 e2 = sg * (0.6065306597126334f * LOG2E);
                const f32x4 kkn = krn4 * kkv * kn;
                const f32x4 kd = krn4 * ((ic - 1.0f) * kav + 1.0f);
                { const f32x4 bq = rr * kd * rkv; bsum += (bq[0] + bq[1]) + (bq[2] + bq[3]); }
                f32x4 wt, wi, wp;
#pragma unroll
                for (int j = 0; j < 4; ++j) {
                    const float ec = row16_prefix(e2[j]);
                    wt[j] = __builtin_amdgcn_exp2f(-ec);
                    wi[j] = __builtin_amdgcn_exp2f(ec);
                    wp[j] = __builtin_amdgcn_exp2f(e2[j] - ec);
                }
                const f32x4 at = -(kkn * wp), rt = rr * wt, bt = kkn * ic * wi, kt = kd * wi;
                {
                    u32x2 wa, wb, wk;
                    wa[0] = pk_bf16(at[0], at[1]); wa[1] = pk_bf16(at[2], at[3]); wb[0] = pk_bf16(bt[0], bt[1]); wb[1] = pk_bf16(bt[2], bt[3]);
                    wk[0] = pk_bf16(kt[0], kt[1]); wk[1] = pk_bf16(kt[2], kt[3]);
                    *(u32x2*)(XA + fr * TKS + nt * 16 + fq * 4) = wa; *(u32x2*)(XB + fr * TKS + nt * 16 + fq * 4) = wb; *(u32x2*)(XK + fr * TKS + nt * 16 + fq * 4) = wk;
                    const unsigned o = (nt * 16 + fq * 4) * KTS + fr;
#pragma unroll
                    for (int j = 0; j < 4; ++j) {
                        TA[o + j * KTS] = (bf16_t)((j & 1) ? (wa[j >> 1] >> 16) : (wa[j >> 1] & 0xffffu));
                        TB_[o + j * KTS] = (bf16_t)((j & 1) ? (wb[j >> 1] >> 16) : (wb[j >> 1] & 0xffffu));
                        TK[o + j * KTS] = (bf16_t)((j & 1) ? (wk[j >> 1] >> 16) : (wk[j >> 1] & 0xffffu));
                    }
                }
                if (fr == 15) *(f32x4*)(WCP + nt * 16 + fq * 4) = wt;
                st4(XR + fr * TKS + nt * 16 + fq * 4, rt);
            }
            bsum += __shfl_xor(bsum, 16); bsum += __shfl_xor(bsum, 32);
            if (rg == 0 && fq == 0) { bonus[((0 * 2 + dir) * TTOT + tok) * 16u + hd] = bsum; bonus[((1 * 2 + dir) * TTOT + tok) * 16u + hd] = 0.f; }
            if (c + NPREP < NCHK) issue(c + NPREP, lwf, laf, krw, rrw, tok_cur);
            unsigned vv[2][2];
#pragma unroll
            for (int i = 0; i < 2; ++i) {
                const unsigned q = i * 64 + lane, vrow = q & 15, sp = q >> 4;
                const unsigned tk0 = tokb + scan_pos(c * CH + 2 * sp, dir), tk1 = tokb + scan_pos(c * CH + 2 * sp + 1, dir);
                vv[i][0] = V[tk0 * 1024u + hc + rg * 16 + vrow]; vv[i][1] = V[tk1 * 1024u + hc + rg * 16 + vrow];
            }
            LDS_WAIT();
            float wcr[4];
#pragma unroll
            for (int n = 0; n < 4; ++n) wcr[n] = WCP[16 * n + fr];
            bf16x8 fa[2], fb[2], fk[2], frr[2];
#pragma unroll
            for (int kk = 0; kk < 2; ++kk) {
                fa[kk] = *(const bf16x8*)(XA + fr * TKS + kk * 32 + fq * 8); fb[kk] = *(const bf16x8*)(XB + fr * TKS + kk * 32 + fq * 8);
                fk[kk] = *(const bf16x8*)(XK + fr * TKS + kk * 32 + fq * 8); frr[kk] = *(const bf16x8*)(XR + fr * TKS + kk * 32 + fq * 8);
            }
            LDS_WAIT();
            f32x4 d1 = z4, d2 = z4, d3 = z4, d4 = z4, d5 = z4;
#pragma unroll
            for (int kk = 0; kk < 2; ++kk) {
                d1 = mfma32(fb[kk], fa[kk], d1);
                d2 = mfma32(fa[kk], fb[kk], d2);
                d3 = mfma32(fa[kk], fk[kk], d3);
                d4 = mfma32(fb[kk], frr[kk], d4);
                d5 = mfma32(fk[kk], frr[kk], d5);
            }
            f32x4 im;
#pragma unroll
            for (int j = 0; j < 4; ++j) {
                const unsigned ij = fq * 4 + j;
                d1[j] = ij < fr ? d1[j] : 0.f;
                d2[j] = fr < ij ? d2[j] : 0.f;
                d3[j] = fr < ij ? d3[j] : 0.f;
                d4[j] = ij <= fr ? d4[j] : 0.f;
                d5[j] = ij <= fr ? d5[j] : 0.f;
                im[j] = d1[j] + (ij == fr ? 1.0f : 0.f);
            }
            st4(M + fr * SMS + fq * 4, d1);
            st4(IM + fr * SMS + fq * 4, im);
            st4(NABR + fr * SMS + fq * 4, d2);
            st4(NAKR + fr * SMS + fq * 4, d3);
            st4(NRBT + fr * SMS + fq * 4, d4);
            st4(NRKT + fr * SMS + fq * 4, d5);
            LDS_WAIT();
            const int so = fr * SMS + fq * 4;
            {
                const s16x4v m = ld4(M + so), mt = ld4(NABR + so);
                LDS_WAIT();
                st4(M2T + so, mfma16(m, mt, z4)); st4(M2 + so, mfma16(mt, m, z4));
                LDS_WAIT();
            }
            {
                const s16x4v m2 = ld4(M2 + so), m2t = ld4(M2T + so); const u32x2 imr = *(const u32x2*)(IM + so);
                LDS_WAIT();
                st4(M4T + so, mfma16(m2, m2t, z4)); st4(M4 + so, mfma16(m2t, m2, z4));
                st4(X1 + so, mfma16(m2t, __builtin_bit_cast(s16x4v, imr), up4(imr)));
                LDS_WAIT();
            }
            {
                const s16x4v m4 = ld4(M4 + so), m4t = ld4(M4T + so); const u32x2 x1r = *(const u32x2*)(X1 + so);
                LDS_WAIT();
                st4(M8T + so, mfma16(m4, m4t, z4));
                st4(X2 + so, mfma16(m4t, __builtin_bit_cast(s16x4v, x1r), up4(x1r)));
                LDS_WAIT();
            }
            {
                const s16x4v m8t = ld4(M8T + so); const u32x2 x2r = *(const u32x2*)(X2 + so);
                LDS_WAIT();
                st4(TT + so, mfma16(m8t, __builtin_bit_cast(s16x4v, x2r), up4(x2r)));
                LDS_WAIT();
            }
            {
                const s16x4v ta = ld4(TT + so), nk = ld4(NAKR + so);
                s16x4v xa[4];
#pragma unroll
                for (int n = 0; n < 4; ++n) xa[n] = ld4(TA + (16 * n + fr) * KTS + fq * 4);
                LDS_WAIT();
                st4(G1 + so, mfma16(ta, nk, z4));
#pragma unroll
                for (int n = 0; n < 4; ++n) st4(AT + (16 * n + fr) * KTS + fq * 4, mfma16(ta, xa[n], z4));
                LDS_WAIT();
            }
            const unsigned sl = (unsigned)c % NSLOT;
            char* S = slots + sl * SLOT_BYTES;
            {
                const s16x4v nrb = ld4(NRBT + so), g1 = ld4(G1 + so);
                const u32x2 nrk = *(const u32x2*)(NRKT + so);
                s16x4v atm[4], tb[4]; u32x2 xr[4], tk[4];
#pragma unroll
                for (int m = 0; m < 4; ++m) {
                    atm[m] = ld4(AT + (16 * m + fr) * KTS + fq * 4); tb[m] = ld4(TB_ + (16 * m + fr) * KTS + fq * 4);
                    xr[m] = *(const u32x2*)(XR + fr * TKS + 16 * m + fq * 4); tk[m] = *(const u32x2*)(TK + (16 * m + fr) * KTS + fq * 4);
                }
                LDS_WAIT();
                while (*(volatile LAS int*)(cnts + 8) < c - NSLOT + 1) __builtin_amdgcn_s_sleep(1);
                asm volatile("" ::: "memory");
                st4((bf16_t*)(S + SL_G2) + so, mfma16(g1, nrb, up4(nrk)));
#pragma unroll
                for (int m = 0; m < 4; ++m) {
                    st4((bf16_t*)(S + SL_RT) + fr * TKS + 16 * m + fq * 4, mfma16(atm[m], nrb, up4(xr[m])));
#pragma unroll
                    for (int n = 0; n < 4; ++n) st4((bf16_t*)(S + SL_PT) + (16 * n + fr) * TKS + 16 * m + fq * 4, mfma16(atm[m], tb[n], z4) * wcr[n]);
                    asm volatile("" ::: "memory");
                }
#pragma unroll
                for (int n = 0; n < 4; ++n) st4((bf16_t*)(S + SL_QM) + (16 * n + fr) * KTS + fq * 4, mfma16(g1, tb[n], up4(tk[n])) * wcr[n]);
                ((float*)(S + SL_WC))[lane] = (fq == 0) ? wcr[0] : (fq == 1) ? wcr[1] : (fq == 2) ? wcr[2] : wcr[3];
#pragma unroll
                for (int i = 0; i < 2; ++i) {
                    const unsigned q = i * 64 + lane, vrow = q & 15, sp = q >> 4;
                    *(unsigned*)((bf16_t*)(S + SL_VT) + vrow * SMS + 2 * sp) = vv[i][0] | (vv[i][1] << 16);
                }
            }
            LDS_WAIT();
            if (lane == 0) *(volatile LAS int*)(cnts + sl) = c + 1;
        }
    }
    __syncthreads();
}

DI void phase_scan(const Params& p, char* smem) {
    for (int u = blockIdx.x; u < NBATCH * 16 * 2 * 4; u += gridDim.x) scan_unit_chunked(p, u, smem);
}

constexpr int NPHASE = 18;
constexpr int SMEM_BYTES = (SC2_SMEM > SC_SMEM ? SC2_SMEM : SC_SMEM) + 64;
static_assert(SMEM_BYTES >= GEMM_SMEM + 4096 + 64 && SMEM_BYTES >= G8_SMEM + 64 && SMEM_BYTES + 16 <= 163840, "LDS");
template <int PH> DI void run_phase(const Params& p, char* smem) {
    if constexpr (PH == 0) phase_prologue(p, smem);
    else if constexpr (PH == 1) phase_norm0(p);
    else if constexpr (PH == 2) phase_qkv(p, smem);
    else if constexpr (PH == 3) phase_attn(p, smem);
    else if constexpr (PH == 4) phase_wout(p, smem);
    else if constexpr (PH == 5) phase_ffn_norm_route(p, 0, smem);
    else if constexpr (PH == 6) phase_moe1(p, 0, smem);
    else if constexpr (PH == 7) phase_moe2(p, 0, smem);
    else if constexpr (PH == 8) phase_combine_l0(p, smem);
    else if constexpr (PH == 9) phase_xx(p);
    else if constexpr (PH == 10) phase_rwkv_proj(p, smem);
    else if constexpr (PH == 11) phase_scan(p, smem);
    else if constexpr (PH == 12) phase_gate(p, smem);
    else if constexpr (PH == 13) phase_wo(p, smem);
    else if constexpr (PH == 14) phase_ffn_norm_route(p, 1, smem);
    else if constexpr (PH == 15) phase_moe1(p, 1, smem);
    else if constexpr (PH == 16) phase_moe2(p, 1, smem);
    else if constexpr (PH == 17) phase_final(p);
}
template <int PH, int END> struct PhaseSeq {
    static DI void run(const Params& p, char* smem, const XcdBarrier& bar) {
        run_phase<PH>(p, smem);
        if constexpr (PH + 1 < END) { xcd_barrier(bar); PhaseSeq<PH + 1, END>::run(p, smem, bar); }
    }
};
template <int BEG, int END>
__global__ void __launch_bounds__(NTH, 2) fwd_kernel(Params p) {
    extern __shared__ __attribute__((aligned(16))) char smem_raw[];
    char* smem = smem_raw + 16;
    if constexpr (END - BEG > 1) {
        if (tidx() == 0) *(uint4*)smem_raw = make_uint4(0u, 0u, 0u, 0u);
        __syncthreads();
        XcdBarrier bar = xcd_barrier_post((unsigned*)(p.ws + OFF_BAR), (volatile LAS unsigned*)smem_raw);
        PhaseSeq<BEG, END>::run(p, smem, bar);
    } else {
        run_phase<BEG>(p, smem);
    }
}

template <int BEG, int END> static void launch_range(const Params& p, int grid, hipStream_t stream) {
    (void)hipFuncSetAttribute((const void*)fwd_kernel<BEG, END>, hipFuncAttributeMaxDynamicSharedMemorySize, SMEM_BYTES + 16);
    hipLaunchKernelGGL((fwd_kernel<BEG, END>), dim3(grid), dim3(NTH), SMEM_BYTES + 16, stream, p);
}
#ifndef RUN_PHASES
#define RUN_PHASES NPHASE
#endif
#ifndef REPEAT_PHASE
#define REPEAT_PHASE -1
#endif
template <int PH> static void launch_each(const Params& p, int grid, hipStream_t stream) {
    launch_range<PH, PH + 1>(p, grid, stream);
    if (PH == REPEAT_PHASE) launch_range<PH, PH + 1>(p, grid, stream);
    if constexpr (PH + 1 < RUN_PHASES) launch_each<PH + 1>(p, grid, stream);
}

extern "C" void kernel_launch(void* const* d_in, const int* in_sizes, int n_in, void* d_out, int out_size, void* d_ws, size_t ws_size, hipStream_t stream) {
    Params p{};
    const float** f = (const float**)&p;
    for (int i = 0; i < 37; ++i) f[i] = (const float*)d_in[i];
    p.out = (float*)d_out;
    p.ws = (char*)d_ws;
    if (ws_size < WS_NEED || n_in < 37) return;
    static int grid = 0;
    if (!grid) {
        int dev = 0, cus = 0;
        (void)hipGetDevice(&dev);
        (void)hipDeviceGetAttribute(&cus, hipDeviceAttributeMultiprocessorCount, dev);
        grid = cus > 0 ? cus : 256;
    }
    (void)hipMemsetAsync(d_ws, 0, 32768, stream);
#if MEGA
    launch_range<0, NPHASE>(p, grid, stream);
#else
    launch_each<0>(p, grid, stream);
#endif
}
```

```cpp
#include <hip/hip_runtime.h>
#include <stdint.h>
#include <stdio.h>

#ifndef MEGA
#define MEGA 1
#endif

typedef unsigned short bf16_t;
typedef short bf16x8 __attribute__((ext_vector_type(8)));
typedef short s16x4 __attribute__((ext_vector_type(4)));
typedef float f32x2 __attribute__((ext_vector_type(2)));
typedef float f32x4 __attribute__((ext_vector_type(4)));
typedef float f32x16 __attribute__((ext_vector_type(16)));
typedef unsigned u32x2 __attribute__((ext_vector_type(2)));
typedef unsigned u32x4 __attribute__((ext_vector_type(4)));
typedef __bf16 bf16x2_t __attribute__((ext_vector_type(2)));
#define DI __device__ __forceinline__
__device__ __forceinline__ unsigned tidx() { unsigned t = threadIdx.x; asm volatile("" : "+v"(t)); return t; }

constexpr int DM = 1024, NBATCH = 2, SEQ = 16384, LCTX = 256, PTOT = SEQ + LCTX, TTOT = NBATCH * PTOT;
constexpr int NTH = 512, NWAVE = 8;
constexpr int QKV_N = 1536;
constexpr int NEXP = 16, CAP = TTOT * 2;
constexpr float RMS_EPS = 1e-6f, GN_EPS = 64e-5f;
constexpr float LOG2E = 1.4426950408889634f;

constexpr size_t MBy = 1u << 20;
constexpr size_t OFF_BAR   = 0;
constexpr size_t OFF_CNT   = 16384;
constexpr size_t OFF_MOD   = 32768;
constexpr size_t OFF_ROPE  = OFF_MOD + 2 * 3 * 6144 * 4;
constexpr size_t OFF_BONUS = 1 * MBy;
constexpr size_t OFF_BONUS2 = 6 * MBy;
constexpr size_t OFF_STOK  = 6 * MBy;
constexpr size_t OFF_SW    = 11 * MBy;
constexpr size_t OFF_XC    = 16 * MBy;
constexpr size_t OFF_WS    = 18 * MBy;
constexpr size_t OFF_MOEW  = 33 * MBy;
constexpr size_t OFF_H     = 129 * MBy;
constexpr size_t OFF_SCR   = 194 * MBy;
constexpr size_t SCR_SIZE  = 290 * MBy;
constexpr size_t WS_NEED   = OFF_SCR + SCR_SIZE;
constexpr size_t W_IN = 0, W_OUT = W_IN + 1536 * 1024, W_R = W_OUT + 1024 * 1024, W_K = W_R + 1024 * 1024, W_V = W_K + 1024 * 1024,
                 W_O = W_V + 1024 * 1024, W_W1 = W_O + 1024 * 1024, W_A1 = W_W1 + 128 * 1024, W_G1 = W_A1 + 128 * 1024,
                 W_W2 = W_G1 + 256 * 1024, W_A2 = W_W2 + 2 * 1024 * 64, W_G2 = W_A2 + 2 * 1024 * 64, W_END = W_G2 + 1024 * 192;
static_assert(W_END * 2 <= 15 * MBy, "small weights region");
constexpr size_t ROWB = (size_t)TTOT * 2048;
constexpr size_t S_Q = 0, S_K = S_Q + ROWB, S_VT = S_K + ROWB / 4, S_O = S_VT + ROWB / 4;
constexpr size_t S_HID = 0, S_Y = 140 * MBy;
constexpr size_t S_R = 0, S_KK = S_R + ROWB, S_V = S_KK + ROWB, S_LW = S_V + ROWB, S_LA = S_LW + ROWB / 8, S_LG = S_LA + ROWB / 8,
                 S_Y1 = 224 * MBy, S_XX = S_Y1, S_OR = S_R;
static_assert(S_O + ROWB <= SCR_SIZE, "scr");
static_assert(S_LG + (size_t)TTOT * 384 <= S_Y1, "scr2");
static_assert(S_Y1 + ROWB <= SCR_SIZE, "scr3");
static_assert(S_Y + 2 * ROWB <= SCR_SIZE, "scr4");
static_assert((size_t)(CAP / 256 + 16) * 256 * 2048 <= S_Y, "hid");
static_assert(OFF_H + ROWB <= OFF_SCR, "h");

struct Params {
    const float *x, *c, *ctx, *c_ctx, *ada_w, *ada_b, *norm_mix_g, *norm_ffn_g, *attn_w_in, *attn_w_out, *attn_sink, *attn_q_norm_g, *attn_k_norm_g,
        *rwkv_x_mix, *rwkv_w_r, *rwkv_w_k, *rwkv_w_v, *rwkv_w_o, *rwkv_decay_w0, *rwkv_decay_w1, *rwkv_decay_w2, *rwkv_iclr_a0, *rwkv_iclr_a1,
        *rwkv_iclr_a2, *rwkv_gate_g1, *rwkv_gate_g2, *rwkv_k_k, *rwkv_k_a, *rwkv_r_k, *rwkv_ln_g, *rwkv_ln_b, *router_w, *router_bias, *moe_w1,
        *moe_w3, *moe_w2, *final_norm_g;
    float* out;
    char* ws;
};

DI unsigned pk_bf16(float a, float b) { f32x2 v = {a, b}; bf16x2_t r = __builtin_convertvector(v, bf16x2_t); return __builtin_bit_cast(unsigned, r); }
DI float bf_lo(unsigned u) { return __uint_as_float(u << 16); }
DI float bf_hi(unsigned u) { return __uint_as_float(u & 0xffff0000u); }
DI float bf2f(bf16_t u) { return __uint_as_float(((unsigned)u) << 16); }
DI float wave_sum(float v) {
#pragma unroll
    for (int o = 32; o >= 1; o >>= 1) v += __shfl_xor(v, o);
    return v;
}
DI float sigmoidf_(float x) { return __builtin_amdgcn_rcpf(1.0f + __builtin_amdgcn_exp2f(x * -LOG2E)); }
DI float siluf_(float x) { return x * __builtin_amdgcn_rcpf(1.0f + __builtin_amdgcn_exp2f(x * -LOG2E)); }
struct PLite { const float *x, *ctx, *qg, *kg; float* out; char* ws; };
DI PLite plite(const Params& p) { return PLite{p.x, p.ctx, p.attn_q_norm_g, p.attn_k_norm_g, p.out, p.ws}; }
template <class P> DI float* xrow_ptr(const P& p, int tok) {
    const int b = tok >= PTOT ? 1 : 0, pos = tok - b * PTOT;
    return pos < LCTX ? (float*)(p.ws + OFF_XC) + (size_t)(b * LCTX + pos) * DM : p.out + (size_t)(b * SEQ + pos - LCTX) * DM;
}
template <class P> DI const float* xin_ptr(const P& p, int tok) {
    const int b = tok >= PTOT ? 1 : 0, pos = tok - b * PTOT;
    return pos < LCTX ? p.ctx + (size_t)(b * LCTX + pos) * DM : p.x + (size_t)(b * SEQ + pos - LCTX) * DM;
}
template <class P> DI const float* mod_ptr(const P& p, int layer, int tok, int which) {
    const int b = tok >= PTOT ? 1 : 0, pos = tok - b * PTOT;
    const int w = pos < LCTX ? 2 : b;
    return (const float*)(p.ws + OFF_MOD) + (size_t)((layer * 3 + w) * 6 + which) * DM;
}

#define XB_TMO      128
#define XB_XCNT(j)  (256  + 64 * (j))
#define XB_XSUB(j)  (1280 + 64 * (j))
#define XB_XGEN(j)  (2304 + 64 * (j))
#define XB_TOP      3328
#define XB_TOPGEN   3392
#define XCD_BAR_WORDS 3456
#define XB_SPIN_CAP (1u << 18)
#define LAS __attribute__((address_space(3)))
DI unsigned xb_ld(unsigned* p)              { return __hip_atomic_load(p, __ATOMIC_RELAXED, __HIP_MEMORY_SCOPE_AGENT); }
DI unsigned xb_add(unsigned* p, unsigned v) { return __hip_atomic_fetch_add(p, v, __ATOMIC_RELAXED, __HIP_MEMORY_SCOPE_AGENT); }
DI unsigned xb_xcc_id() { return (unsigned)__builtin_amdgcn_s_getreg((3 << 11) | 20) & 0xFu; }
#define XB_SPIN(cond, bar) do { unsigned _sp = 0; while (cond) { __builtin_amdgcn_s_sleep(1); \
    if ((++_sp & 255u) == 0u) { if (xb_ld(&(bar)[XB_TMO])) break; if (_sp > XB_SPIN_CAP) { atomicAdd(&(bar)[XB_TMO], 1u); break; } } } } while (0)
struct XcdBarrier { unsigned* bar; unsigned x; volatile LAS unsigned* st; };
DI XcdBarrier xcd_barrier_post(unsigned* bar, volatile LAS unsigned* st) {
    XcdBarrier b; b.bar = bar; b.x = xb_xcc_id(); b.st = st;
    if (tidx() == 0) (void)xb_add(&bar[XB_XCNT(b.x)], 1u);
    return b;
}
DI void xcd_barrier_complete(unsigned* bar, unsigned x, unsigned& nloc, unsigned& nx) {
    const unsigned G = gridDim.x * gridDim.y * gridDim.z;
    unsigned sum, cnt, mine, sp = 0u;
    for (;;) {
        sum = 0u; cnt = 0u; mine = 0u;
#pragma unroll
        for (unsigned j = 0; j < 16; ++j) { const unsigned c = xb_ld(&bar[XB_XCNT(j)]); sum += c; cnt += (c > 0u) ? 1u : 0u; mine = (j == x) ? c : mine; }
        if (sum == G) break;
        __builtin_amdgcn_s_sleep(1);
        if ((++sp & 255u) == 0u) { if (xb_ld(&bar[XB_TMO])) break; if (sp > XB_SPIN_CAP) { atomicAdd(&bar[XB_TMO], 1u); break; } }
    }
    nloc = mine > 0u ? mine : 1u; nx = cnt > 0u ? cnt : 1u;
}
DI void xcd_barrier(const XcdBarrier& b) {
    asm volatile("s_waitcnt vmcnt(0)" ::: "memory");
    __syncthreads();
    if (tidx() == 0) {
        unsigned* bar = b.bar;
        __builtin_amdgcn_s_waitcnt(0);
        unsigned nloc = b.st[0], nx = b.st[1];
        if (nloc == 0u) { xcd_barrier_complete(bar, b.x, nloc, nx); b.st[0] = nloc; b.st[1] = nx; }
        const unsigned old = xb_add(&bar[XB_XSUB(b.x)], 1u);
        const unsigned gen = old / nloc;
        if (old + 1u == (gen + 1u) * nloc) {
            __builtin_amdgcn_fence(__ATOMIC_RELEASE, "agent");
            asm volatile("s_waitcnt vmcnt(0)" ::: "memory");
            const unsigned og = xb_add(&bar[XB_TOP], 1u);
            const unsigned tg = og / nx;
            if (og + 1u == (tg + 1u) * nx) xb_add(&bar[XB_TOPGEN], 1u);
            else XB_SPIN(xb_ld(&bar[XB_TOPGEN]) == tg, bar);
            __builtin_amdgcn_fence(__ATOMIC_ACQUIRE, "agent");
            xb_add(&bar[XB_XGEN(b.x)], 1u);
            asm volatile("s_waitcnt vmcnt(0)" ::: "memory");
        } else {
            XB_SPIN(xb_ld(&bar[XB_XGEN(b.x)]) == gen, bar);
            __builtin_amdgcn_fence(__ATOMIC_ACQUIRE, "agent");
            asm volatile("s_waitcnt vmcnt(0)" ::: "memory");
        }
    }
    __syncthreads();
}

struct CvtDesc { const float* src; bf16_t* dst; int ld, kvalid, dld; bool colvalid; };
DI CvtDesc cvt_tile(const float* src, int ld, int kvalid, bool colvalid, bf16_t* dst, int dld) { return CvtDesc{src, dst, ld, kvalid, dld, colvalid}; }
constexpr int CV_NB = 8;
template <class F>
DI void cvt_run(int nunits, F desc_of, float* tiles) {
    const int t = tidx();
    for (int i0 = 0;; i0 += CV_NB) {
        if ((int)blockIdx.x + (int)gridDim.x * i0 >= nunits) break;
        f32x4 v[CV_NB];
#pragma unroll
        for (int b = 0; b < CV_NB; ++b) {
            const int u = (int)blockIdx.x + (int)gridDim.x * (i0 + b);
            v[b] = (f32x4){0.f, 0.f, 0.f, 0.f};
            if (u < nunits) {
                const CvtDesc d = desc_of(u);
                const int k = t >> 3, c4 = (t & 7) * 4;
                if (d.colvalid && k < d.kvalid) v[b] = *(const f32x4*)(d.src + (size_t)k * d.ld + c4);
            }
        }
#pragma unroll
        for (int b = 0; b < CV_NB; ++b) {
            float* tile = tiles + b * 64 * 33;
            const int k = t >> 3, c4 = (t & 7) * 4;
            tile[k * 33 + c4 + 0] = v[b][0]; tile[k * 33 + c4 + 1] = v[b][1]; tile[k * 33 + c4 + 2] = v[b][2]; tile[k * 33 + c4 + 3] = v[b][3];
        }
        __syncthreads();
#pragma unroll
        for (int b = 0; b < CV_NB; ++b) {
            const int u = (int)blockIdx.x + (int)gridDim.x * (i0 + b);
            if (u < nunits) {
                const CvtDesc d = desc_of(u);
                const float* tile = tiles + b * 64 * 33;
                const int n = t >> 4, kc = (t & 15) * 4;
                u32x2 w;
                w[0] = pk_bf16(tile[(kc + 0) * 33 + n], tile[(kc + 1) * 33 + n]);
                w[1] = pk_bf16(tile[(kc + 2) * 33 + n], tile[(kc + 3) * 33 + n]);
                *(u32x2*)(d.dst + (size_t)n * d.dld + kc) = w;
            }
        }
        __syncthreads();
    }
}
constexpr int CV_SMALL_UNITS = 768 + 512 * 5 + 64 + 64 + 128 + 64 + 64 + 96;
DI CvtDesc cvt_small_unit(const Params& p, int u) {
    bf16_t* wsm = (bf16_t*)(p.ws + OFF_WS);
    if (u < 768) { const int run = u >> 4, kt = u & 15; return cvt_tile(p.attn_w_in + (size_t)kt * 64 * 1536 + run * 32, 1536, 64, true, wsm + W_IN + (size_t)run * 32 * 1024 + kt * 64, 1024); }
    u -= 768;
    if (u < 512 * 5) {
        const int j = u >> 9, v = u & 511, run = v >> 4, kt = v & 15;
        const float* src = j == 0 ? p.attn_w_out : j == 1 ? p.rwkv_w_r : j == 2 ? p.rwkv_w_k : j == 3 ? p.rwkv_w_v : p.rwkv_w_o;
        const size_t dofs = j == 0 ? W_OUT : j == 1 ? W_R : j == 2 ? W_K : j == 3 ? W_V : W_O;
        return cvt_tile(src + (size_t)kt * 64 * 1024 + run * 32, 1024, 64, true, wsm + dofs + (size_t)run * 32 * 1024 + kt * 64, 1024);
    }
    u -= 512 * 5;
    if (u < 128) {
        const int j = u >> 6, v = u & 63, run = v >> 4, kt = v & 15, d = run >> 1, co = (run & 1) * 32;
        const float* src = (j == 0 ? p.rwkv_decay_w1 : p.rwkv_iclr_a1) + (size_t)d * 1024 * 64;
        return cvt_tile(src + (size_t)kt * 64 * 64 + co, 64, 64, true, wsm + (j == 0 ? W_W1 : W_A1) + (size_t)run * 32 * 1024 + kt * 64, 1024);
    }
    u -= 128;
    if (u < 128) {
        const int run = u >> 4, kt = u & 15;
        return cvt_tile(p.rwkv_gate_g1 + (size_t)kt * 64 * 160 + run * 32, 160, 64, run < 5, wsm + W_G1 + (size_t)run * 32 * 1024 + kt * 64, 1024);
    }
    u -= 128;
    if (u < 128) {
        const int j = u >> 6, v = u & 63, d = v >> 5, run = v & 31;
        const float* src = (j == 0 ? p.rwkv_decay_w2 : p.rwkv_iclr_a2) + (size_t)d * 64 * 1024;
        return cvt_tile(src + run * 32, 1024, 64, true, wsm + (j == 0 ? W_W2 : W_A2) + (size_t)d * 1024 * 64 + (size_t)run * 32 * 64, 64);
    }
    u -= 128;
    {
        const int run = u / 3, kt = u % 3;
        const int kvalid = 160 - kt * 64 > 64 ? 64 : (160 - kt * 64 < 0 ? 0 : 160 - kt * 64);
        return cvt_tile(p.rwkv_gate_g2 + (size_t)kt * 64 * 1024 + run * 32, 1024, kvalid, true, wsm + W_G2 + (size_t)run * 32 * 192 + kt * 64, 192);
    }
}
constexpr int CV_MOE_UNITS = 16 * (1024 + 512);
DI CvtDesc cvt_moe_unit(const Params& p, int layer, int u) {
    bf16_t* w13 = (bf16_t*)(p.ws + OFF_MOEW);
    bf16_t* w2t = w13 + (size_t)16 * 2048 * 1024;
    const int e = u / 1536, v = u % 1536;
    const size_t eo = (size_t)(layer * 16 + e) * 1024 * 1024;
    if (v < 1024) {
        const int run = v >> 4, kt = v & 15, g = run >> 1;
        const float* src = ((run & 1) ? p.moe_w3 : p.moe_w1) + eo;
        return cvt_tile(src + (size_t)kt * 64 * 1024 + g * 32, 1024, 64, true, w13 + (size_t)e * 2048 * 1024 + (size_t)run * 32 * 1024 + kt * 64, 1024);
    } else {
        const int w = v - 1024, run = w >> 4, kt = w & 15;
        return cvt_tile(p.moe_w2 + eo + (size_t)kt * 64 * 1024 + run * 32, 1024, 64, true, w2t + (size_t)e * 1024 * 1024 + (size_t)run * 32 * 1024 + kt * 64, 1024);
    }
}
DI void adaln_unit(const Params& p, int u, float* sm) {
    const int l = u / 96, n0 = (u % 96) * 64, t = tidx();
    float* sv = sm;
    float* red = sm + 3 * 1024;
    for (int i = t; i < 3 * 1024; i += NTH) { const int w = i >> 10, k = i & 1023; const float c = w < 2 ? p.c[w * 1024 + k] : p.c_ctx[k]; sv[i] = siluf_(c); }
    __syncthreads();
    const int kg = t >> 4, cl = t & 15;
    f32x4 a0 = {0, 0, 0, 0}, a1 = a0, a2 = a0;
    const float* W = p.ada_w + (size_t)l * 1024 * 6144 + n0 + cl * 4;
#pragma unroll 8
    for (int i = 0; i < 32; ++i) {
        const int k = kg + 32 * i;
        const f32x4 w = *(const f32x4*)(W + (size_t)k * 6144);
        a0 += w * sv[k]; a1 += w * sv[1024 + k]; a2 += w * sv[2048 + k];
    }
#pragma unroll
    for (int j = 0; j < 4; ++j) { red[kg * 192 + 0 * 64 + cl * 4 + j] = a0[j]; red[kg * 192 + 1 * 64 + cl * 4 + j] = a1[j]; red[kg * 192 + 2 * 64 + cl * 4 + j] = a2[j]; }
    __syncthreads();
    if (t < 192) {
        float s = 0.f;
        for (int g = 0; g < 32; ++g) s += red[g * 192 + t];
        const int w = t >> 6, n = n0 + (t & 63);
        ((float*)(p.ws + OFF_MOD))[(size_t)(l * 3 + w) * 6144 + n] = s + p.ada_b[l * 6144 + n];
    }
    __syncthreads();
}
DI void rope_unit(const Params& p, int u) {
    const int id = u * NTH + tidx();
    if (id < 320 * 16) {
        const int pi = id >> 4, f = id & 15;
        const float inv = exp2f(-(float)f * (13.287712379549449f / 16.0f));
        const float val = pi < 256 ? (float)pi : (float)(pi - 256);
        const float ang = val * inv;
        const double a = (double)ang;
        const double k = __builtin_rint(a * 0.15915494309189535);
        const float r = (float)(a - k * 6.283185307179586);
        f32x2 cs = {__cosf(r), __sinf(r)};
        ((f32x2*)(p.ws + OFF_ROPE))[id] = cs;
    }
}
DI void phase_prologue(const Params& p, char* smem) {
    float* sm = (float*)smem;
    const int nconv = CV_SMALL_UNITS + CV_MOE_UNITS;
    const int total = nconv + 192 + 10;
    for (int u = nconv + blockIdx.x; u < total; u += gridDim.x) {
        if (u < nconv + 192) adaln_unit(p, u - nconv, sm);
        else rope_unit(p, u - nconv - 192);
    }
    __syncthreads();
    cvt_run(nconv, [&](int u) { return u < CV_SMALL_UNITS ? cvt_small_unit(p, u) : cvt_moe_unit(p, 0, u - CV_SMALL_UNITS); }, sm);
}

DI void row_load(const float* src, f32x4 (&v)[4], int lane) {
#pragma unroll
    for (int i = 0; i < 4; ++i) v[i] = ((const f32x4*)src)[lane + 64 * i];
}
DI float row_rstd(const f32x4 (&v)[4]) {
    float ss = 0.f;
#pragma unroll
    for (int i = 0; i < 4; ++i) ss += v[i][0] * v[i][0] + v[i][1] * v[i][1] + v[i][2] * v[i][2] + v[i][3] * v[i][3];
    ss = wave_sum(ss);
    return rsqrtf(ss * (1.0f / DM) + RMS_EPS);
}
DI void row_norm_mod(const f32x4 (&v)[4], float rstd, const float* g, const float* shift, const float* scale, f32x4 (&h)[4], int lane) {
#pragma unroll
    for (int i = 0; i < 4; ++i) {
        const int c = (lane + 64 * i) * 4;
        const f32x4 g4 = *(const f32x4*)(g + c), sh = *(const f32x4*)(shift + c), sc = *(const f32x4*)(scale + c);
        h[i] = (v[i] * rstd * g4) * (1.0f + sc) + sh;
    }
}
DI void row_store_bf16(bf16_t* dst, const f32x4 (&h)[4], int lane) {
#pragma unroll
    for (int i = 0; i < 4; ++i) { u32x2 w; w[0] = pk_bf16(h[i][0], h[i][1]); w[1] = pk_bf16(h[i][2], h[i][3]); *(u32x2*)(dst + (lane + 64 * i) * 4) = w; }
}
DI void row_load_bf16(const bf16_t* src, f32x4 (&v)[4], int lane) {
#pragma unroll
    for (int i = 0; i < 4; ++i) { const u32x2 w = *(const u32x2*)(src + (lane + 64 * i) * 4); v[i][0] = bf_lo(w[0]); v[i][1] = bf_hi(w[0]); v[i][2] = bf_lo(w[1]); v[i][3] = bf_hi(w[1]); }
}

DI void phase_norm0(const Params& p) {
    const int lane = tidx() & 63, gw = blockIdx.x * NWAVE + (tidx() >> 6), nw = gridDim.x * NWAVE;
    bf16_t* H = (bf16_t*)(p.ws + OFF_H);
    for (int tok = gw; tok < TTOT; tok += nw) {
        f32x4 v[4], h[4];
        row_load(xin_ptr(p, tok), v, lane);
        const float rstd = row_rstd(v);
        row_norm_mod(v, rstd, p.norm_mix_g, mod_ptr(p, 0, tok, 0), mod_ptr(p, 0, tok, 1), h, lane);
        row_store_bf16(H + (size_t)tok * DM, h, lane);
    }
}

DI void route_row(const Params& p, const float (&lg)[16], int& e1, int& e2, float& g1, float& g2) {
    float mx = lg[0];
#pragma unroll
    for (int e = 1; e < 16; ++e) mx = fmaxf(mx, lg[e]);
    float pr[16], sum = 0.f;
#pragma unroll
    for (int e = 0; e < 16; ++e) { pr[e] = __expf(lg[e] - mx); sum += pr[e]; }
    const float inv = 1.0f / sum;
    float sel[16];
#pragma unroll
    for (int e = 0; e < 16; ++e) { pr[e] *= inv; sel[e] = pr[e] + p.router_bias[e]; }
    float best = -1e30f; int gi = 0;
#pragma unroll
    for (int g = 0; g < 4; ++g) {
        float m1 = -1e30f, m2 = -1e30f;
#pragma unroll
        for (int j = 0; j < 4; ++j) { const float s = sel[g * 4 + j]; if (s > m1) { m2 = m1; m1 = s; } else if (s > m2) m2 = s; }
        const float gs = m1 + m2;
        if (gs > best) { best = gs; gi = g; }
    }
    float s4[4], p4[4];
#pragma unroll
    for (int j = 0; j < 4; ++j) {
        s4[j] = gi == 0 ? sel[j] : gi == 1 ? sel[4 + j] : gi == 2 ? sel[8 + j] : sel[12 + j];
        p4[j] = gi == 0 ? pr[j] : gi == 1 ? pr[4 + j] : gi == 2 ? pr[8 + j] : pr[12 + j];
    }
    int i1 = 0; float b1 = s4[0];
#pragma unroll
    for (int j = 1; j < 4; ++j) if (s4[j] > b1) { b1 = s4[j]; i1 = j; }
    int i2 = i1 == 0 ? 1 : 0; float b2 = -3e38f;
#pragma unroll
    for (int j = 0; j < 4; ++j) if (j != i1 && s4[j] > b2) { b2 = s4[j]; i2 = j; }
    const float w1 = i1 == 0 ? p4[0] : i1 == 1 ? p4[1] : i1 == 2 ? p4[2] : p4[3];
    const float w2 = i2 == 0 ? p4[0] : i2 == 1 ? p4[1] : i2 == 2 ? p4[2] : p4[3];
    const float ws = 1.0f / (w1 + w2);
    e1 = gi * 4 + i1; e2 = gi * 4 + i2; g1 = w1 * ws; g2 = w2 * ws;
}
DI void phase_ffn_norm_route(const Params& p, int layer, char* smem) {
    const int lane = tidx() & 63, gw = blockIdx.x * NWAVE + (tidx() >> 6), nw = gridDim.x * NWAVE;
    float* rw = (float*)smem;
    for (int i = tidx(); i < 1024 * 16; i += NTH) rw[(i & 15) * 1024 + (i >> 4)] = p.router_w[i];
    __syncthreads();
    bf16_t* H = (bf16_t*)(p.ws + OFF_H);
    int* lcnt = (int*)(smem + 65536);
    if (tidx() < 32) lcnt[tidx()] = 0;
    int my_tok = -1, my_e1 = 0, my_e2 = 0, it = 0; float my_g1 = 0.f, my_g2 = 0.f;
    for (int tok = gw; tok < TTOT; tok += nw) {
        const int pos = tok >= PTOT ? tok - PTOT : tok;
        if (layer == 1 && pos < LCTX) continue;
        f32x4 v[4], h[4];
        row_load(xrow_ptr(p, tok), v, lane);
        const float rstd = row_rstd(v);
        row_norm_mod(v, rstd, p.norm_ffn_g + layer * DM, mod_ptr(p, layer, tok, 3), mod_ptr(p, layer, tok, 4), h, lane);
        row_store_bf16(H + (size_t)tok * DM, h, lane);
        float lg[16];
#pragma unroll
        for (int e = 0; e < 16; ++e) lg[e] = 0.f;
#pragma unroll
        for (int i = 0; i < 4; ++i)
#pragma unroll
            for (int e = 0; e < 16; ++e) {
                const f32x4 w = *(const f32x4*)(rw + e * 1024 + (lane + 64 * i) * 4);
                lg[e] += h[i][0] * w[0] + h[i][1] * w[1] + h[i][2] * w[2] + h[i][3] * w[3];
                if ((e & 3) == 3) asm volatile("" ::: "memory");
            }
#pragma unroll
        for (int e = 0; e < 16; ++e) lg[e] = wave_sum(lg[e]);
        int e1, e2; float g1, g2;
        route_row(p, lg, e1, e2, g1, g2);
        if (lane == it) { my_tok = tok; my_e1 = e1; my_e2 = e2; my_g1 = g1; my_g2 = g2; }
        ++it;
    }
    __syncthreads();
    int r1 = 0, r2 = 0;
    if (my_tok >= 0) { r1 = atomicAdd(&lcnt[my_e1], 1); r2 = atomicAdd(&lcnt[my_e2], 1); }
    __syncthreads();
    if (tidx() < 16) { const int n = lcnt[tidx()]; lcnt[16 + tidx()] = n ? atomicAdd((int*)(p.ws + OFF_CNT) + layer * 16 + tidx(), n) : 0; }
    __syncthreads();
    if (my_tok >= 0) {
        int* stok = (int*)(p.ws + OFF_STOK);
        float* sw = (float*)(p.ws + OFF_SW);
        const size_t s1 = (size_t)my_e1 * CAP + lcnt[16 + my_e1] + r1, s2 = (size_t)my_e2 * CAP + lcnt[16 + my_e2] + r2;
        stok[s1] = my_tok * 2 + 0; sw[s1] = my_g1;
        stok[s2] = my_tok * 2 + 1; sw[s2] = my_g2;
    }
    __syncthreads();
}

DI void combine_row(const Params& p, int layer, int tok, f32x4 (&v)[4], int lane) {
    const bf16_t* Y = (const bf16_t*)(p.ws + OFF_SCR + S_Y) + (size_t)tok * 2 * DM;
    const float* g5 = mod_ptr(p, layer, tok, 5);
    f32x4 y0[4], y1[4];
    row_load(xrow_ptr(p, tok), v, lane);
    row_load_bf16(Y, y0, lane); row_load_bf16(Y + DM, y1, lane);
#pragma unroll
    for (int i = 0; i < 4; ++i) { const f32x4 g = *(const f32x4*)(g5 + (lane + 64 * i) * 4); v[i] += g * (y0[i] + y1[i]); }
}
DI void phase_combine_l0(const Params& p, char* smem) {
    const int lane = tidx() & 63, gw = blockIdx.x * NWAVE + (tidx() >> 6), nw = gridDim.x * NWAVE;
    bf16_t* H = (bf16_t*)(p.ws + OFF_H);
    for (int tok = gw; tok < TTOT; tok += nw) {
        f32x4 v[4], h[4];
        combine_row(p, 0, tok, v, lane);
        float* X = xrow_ptr(p, tok);
#pragma unroll
        for (int i = 0; i < 4; ++i) ((f32x4*)X)[lane + 64 * i] = v[i];
        const float rstd = row_rstd(v);
        row_norm_mod(v, rstd, p.norm_mix_g + DM, mod_ptr(p, 1, tok, 0), mod_ptr(p, 1, tok, 1), h, lane);
        row_store_bf16(H + (size_t)tok * DM, h, lane);
    }
    __syncthreads();
    cvt_run(CV_MOE_UNITS, [&](int u) { return cvt_moe_unit(p, 1, u); }, (float*)smem);
}
DI void phase_xx(const Params& p) {
    const int lane = tidx() & 63, gw = blockIdx.x * NWAVE + (tidx() >> 6), nw = gridDim.x * NWAVE;
    const bf16_t* H = (const bf16_t*)(p.ws + OFF_H);
    bf16_t* XX = (bf16_t*)(p.ws + OFF_SCR + S_XX);
    for (int tok = gw; tok < TTOT; tok += nw) {
        const int pos = tok >= PTOT ? tok - PTOT : tok;
        const bool first = pos == 0 || pos == LCTX, last = pos == LCTX - 1 || pos == PTOT - 1;
        f32x4 hc[4], hp[4], hn[4], xx[4];
        row_load_bf16(H + (size_t)tok * DM, hc, lane);
        row_load_bf16(H + (size_t)(first ? tok : tok - 1) * DM, hp, lane);
        row_load_bf16(H + (size_t)(last ? tok : tok + 1) * DM, hn, lane);
#pragma unroll
        for (int i = 0; i < 4; ++i) {
            const f32x4 a = first ? (f32x4){0, 0, 0, 0} : hp[i], b = last ? (f32x4){0, 0, 0, 0} : hn[i];
            xx[i] = 0.5f * (a + b) - hc[i];
        }
        row_store_bf16(XX + (size_t)tok * DM, xx, lane);
    }
}
DI void phase_final(const Params& p) {
    const int lane = tidx() & 63, gw = blockIdx.x * NWAVE + (tidx() >> 6), nw = gridDim.x * NWAVE;
    for (int r = gw; r < NBATCH * SEQ; r += nw) {
        const int b = r / SEQ, tok = b * PTOT + LCTX + (r - b * SEQ);
        f32x4 v[4];
        combine_row(p, 1, tok, v, lane);
        const float rstd = row_rstd(v);
        float* O = p.out + (size_t)r * DM;
#pragma unroll
        for (int i = 0; i < 4; ++i) { const f32x4 g = *(const f32x4*)(p.final_norm_g + (lane + 64 * i) * 4); ((f32x4*)O)[lane + 64 * i] = v[i] * rstd * g; }
    }
}

constexpr int LDSROW = 72;
constexpr int GEMM_SMEM = 2 * (256 + 256) * LDSROW * 2;
template <int NH, class AL, class EPI>
DI void gemm_tile(AL& al, const bf16_t* __restrict__ Bt, int ldb, int nk, EPI& epi, char* smem) {
    const int t = tidx(), lane = t & 63, wid = t >> 6, wr = wid >> 1, wc = wid & 1, fr = lane & 15, fq = lane >> 4;
    constexpr int BR = 128 * NH;
    bf16_t* sA = (bf16_t*)smem;
    bf16_t* sB = sA + 2 * 256 * LDSROW;
    f32x4 acc[NH][4][4];
#pragma unroll
    for (int h = 0; h < NH; ++h)
#pragma unroll
        for (int m = 0; m < 4; ++m)
#pragma unroll
            for (int n = 0; n < 4; ++n) acc[h][m][n] = (f32x4){0.f, 0.f, 0.f, 0.f};
    const int lr = t >> 3, lc = (t & 7) * 8;
    typename AL::Raw ra[4]; u32x4 rb[2 * NH];
#pragma unroll
    for (int i = 0; i < 4; ++i) al.issue(ra[i], lr + 64 * i, lc, i);
#pragma unroll
    for (int i = 0; i < 2 * NH; ++i) rb[i] = *(const u32x4*)(Bt + (size_t)(lr + 64 * i) * ldb + lc);
#pragma unroll
    for (int i = 0; i < 4; ++i) *(u32x4*)(sA + (lr + 64 * i) * LDSROW + lc) = al.finish(ra[i], lc);
#pragma unroll
    for (int i = 0; i < 2 * NH; ++i) *(u32x4*)(sB + (lr + 64 * i) * LDSROW + lc) = rb[i];
    __syncthreads();
    for (int kt = 0; kt < nk; ++kt) {
        const int cur = kt & 1;
        const bool more = kt + 1 < nk;
        if (more) {
#pragma unroll
            for (int i = 0; i < 4; ++i) al.issue(ra[i], lr + 64 * i, (kt + 1) * 64 + lc, i);
#pragma unroll
            for (int i = 0; i < 2 * NH; ++i) rb[i] = *(const u32x4*)(Bt + (size_t)(lr + 64 * i) * ldb + (kt + 1) * 64 + lc);
        }
        __builtin_amdgcn_sched_barrier(0);
        const bf16_t* cA = sA + cur * 256 * LDSROW + (wr * 64 + fr) * LDSROW + fq * 8;
        const bf16_t* cB = sB + cur * BR * LDSROW + (wc * 64 + fr) * LDSROW + fq * 8;
#pragma unroll
        for (int kk = 0; kk < 2; ++kk) {
            bf16x8 af[4];
#pragma unroll
            for (int m = 0; m < 4; ++m) af[m] = *(const bf16x8*)(cA + m * 16 * LDSROW + kk * 32);
#pragma unroll
            for (int h = 0; h < NH; ++h) {
                bf16x8 bfr[4];
#pragma unroll
                for (int n = 0; n < 4; ++n) bfr[n] = *(const bf16x8*)(cB + (h * 128 + n * 16) * LDSROW + kk * 32);
#pragma unroll
                for (int m = 0; m < 4; ++m)
#pragma unroll
                    for (int n = 0; n < 4; ++n) acc[h][m][n] = __builtin_amdgcn_mfma_f32_16x16x32_bf16(bfr[n], af[m], acc[h][m][n], 0, 0, 0);
            }
            if (kk == AL::STORE_AT && more) {
                bf16_t* nA = sA + (cur ^ 1) * 256 * LDSROW;
                bf16_t* nB = sB + (cur ^ 1) * BR * LDSROW;
#pragma unroll
                for (int i = 0; i < 4; ++i) *(u32x4*)(nA + (lr + 64 * i) * LDSROW + lc) = al.finish(ra[i], (kt + 1) * 64 + lc);
#pragma unroll
                for (int i = 0; i < 2 * NH; ++i) *(u32x4*)(nB + (lr + 64 * i) * LDSROW + lc) = rb[i];
            }
        }
        __syncthreads();
    }
#pragma unroll
    for (int h = 0; h < NH; ++h) epi(acc[h], wr * 64, h * 128 + wc * 64, fr, fq);
}
constexpr int G8_HB = 128 * 64 * 2;
constexpr int G8_SMEM = 8 * G8_HB;
DI void g8_rc(int& R0, int& C0) {
    const int tz = tidx(), st = tz >> 6, sb = (tz & 63) * 16, swz = sb ^ (((sb >> 9) & 1) << 5);
    R0 = (st >> 1) * 16 + (swz >> 6); C0 = (st & 1) * 32 + ((swz & 63) >> 1);
}
DI int g8_bcol(int h, int rho) { return (rho >> 5) * 64 + h * 32 + (rho & 31); }
struct G8Rows {
    const bf16_t* base; unsigned o0, d1, d2;
    DI const bf16_t* ptr(int h, int i, int kt) const { return (base + (size_t)(h * d2 + i * d1 + kt * 64)) + o0; }
};
struct G8Gather {
    const bf16_t* base; unsigned o[4];
    DI const bf16_t* ptr(int h, int i, int kt) const { return (base + kt * 64) + o[h * 2 + i]; }
};
DI G8Rows g8_arows(const bf16_t* A, int lda) { int R0, C0; g8_rc(R0, C0); return G8Rows{A, (unsigned)(R0 * lda + C0), (unsigned)(64 * lda), (unsigned)(128 * lda)}; }
DI G8Rows g8_brows(const bf16_t* Bt, int ldb) { int R0, C0; g8_rc(R0, C0); return G8Rows{Bt, (unsigned)(g8_bcol(0, R0) * ldb + C0), (unsigned)(128 * ldb), (unsigned)(32 * ldb)}; }
template <class AS, class BS, class EPI, class NF>
DI void gemm8_tile(const AS& as, const BS& bs, int nt  , EPI& epi, char* smem, bool prefetched, NF nextfn) {
    int tz = tidx();
    int wid = tz >> 6, lane = tz & 63, wr = wid >> 2, wc = wid & 3, fr = lane & 15, fq = lane >> 4;
    int loff = ((fr * 64 + fq * 16) ^ ((fr >> 3) << 5));
#define G8_SA(b, h) (smem + ((b) * 2 + (h)) * G8_HB)
#define G8_SB(b, h) (smem + (4 + (b) * 2 + (h)) * G8_HB)
#define G8_STAGE(P, src, h, kt) do { \
        __builtin_amdgcn_global_load_lds((const unsigned*)(src).ptr(h, 0, kt), (LAS unsigned*)((P) + tz * 16), 16, 0, 0); \
        __builtin_amdgcn_global_load_lds((const unsigned*)(src).ptr(h, 1, kt), (LAS unsigned*)((P) + tz * 16 + 8192), 16, 0, 0); } while (0)
#define G8_STA(b, h, kt) G8_STAGE(G8_SA(b, h), as, h, kt)
#define G8_STB(b, h, kt) G8_STAGE(G8_SB(b, h), bs, h, kt)
#define G8_LDA(dst, b, h) _Pragma("unroll") for (int m = 0; m < 4; ++m) _Pragma("unroll") for (int k = 0; k < 2; ++k) \
        dst[m][k] = *(const bf16x8*)(G8_SA(b, h) + (wr * 8 + m * 2 + k) * 1024 + loff)
#define G8_LDB(dst, b, h) _Pragma("unroll") for (int n = 0; n < 2; ++n) _Pragma("unroll") for (int k = 0; k < 2; ++k) \
        dst[n][k] = *(const bf16x8*)(G8_SB(b, h) + (wc * 4 + n * 2 + k) * 1024 + loff)
#define G8_MMA(ai, bj, Bx) do { __builtin_amdgcn_s_setprio(1); \
        _Pragma("unroll") for (int m = 0; m < 4; ++m) _Pragma("unroll") for (int n = 0; n < 2; ++n) _Pragma("unroll") for (int k = 0; k < 2; ++k) \
            acc[ai][bj][m][n] = __builtin_amdgcn_mfma_f32_16x16x32_bf16(Bx[n][k], At[m][k], acc[ai][bj][m][n], 0, 0, 0); \
        __builtin_amdgcn_s_setprio(0); } while (0)
#define G8_WV(n) asm volatile("s_waitcnt vmcnt(" #n ")" ::: "memory")
#define G8_WL(n) asm volatile("s_waitcnt lgkmcnt(" #n ")" ::: "memory")
#define G8_BAR __builtin_amdgcn_s_barrier()
#define G8_SCHED __builtin_amdgcn_sched_barrier(0)
    f32x4 acc[2][2][4][2];
#pragma unroll
    for (int a = 0; a < 2; ++a)
#pragma unroll
        for (int b = 0; b < 2; ++b)
#pragma unroll
            for (int m = 0; m < 4; ++m)
#pragma unroll
                for (int n = 0; n < 2; ++n) acc[a][b][m][n] = (f32x4){0.f, 0.f, 0.f, 0.f};
    bf16x8 At[4][2], B0[2][2], B1[2][2];
    if (!prefetched) { G8_STB(0, 0, 0); G8_STA(0, 0, 0); G8_STB(0, 1, 0); G8_STA(0, 1, 0); }
    if (wr == 1) G8_BAR;
    if (prefetched) G8_WV(0); else G8_WV(4);
    G8_BAR;
    G8_STB(1, 0, 1); G8_STA(1, 0, 1); G8_STB(1, 1, 1);
    G8_WV(6); G8_BAR;
    for (int t = 0; t < nt - 2; t += 2) {
        G8_LDB(B0, 0, 0); G8_SCHED; G8_LDA(At, 0, 0); G8_STA(1, 1, t + 1);
        G8_WL(8); G8_BAR; G8_WL(0); G8_MMA(0, 0, B0); G8_BAR; G8_SCHED;
        G8_LDB(B1, 0, 1); G8_STB(0, 0, t + 2);
        G8_BAR; G8_WL(0); G8_MMA(0, 1, B1); G8_BAR;
        G8_LDA(At, 0, 1); G8_STA(0, 0, t + 2);
        G8_BAR; G8_WL(0); G8_MMA(1, 0, B0); G8_BAR; G8_SCHED;
        G8_STB(0, 1, t + 2);
        G8_WV(6); G8_BAR; G8_MMA(1, 1, B1); G8_BAR;
        G8_LDB(B0, 1, 0); G8_SCHED; G8_LDA(At, 1, 0); G8_STA(0, 1, t + 2);
        G8_WL(8); G8_BAR; G8_WL(0); G8_MMA(0, 0, B0); G8_BAR; G8_SCHED;
        G8_LDB(B1, 1, 1); G8_STB(1, 0, t + 3);
        G8_BAR; G8_WL(0); G8_MMA(0, 1, B1); G8_BAR;
        G8_LDA(At, 1, 1); G8_STA(1, 0, t + 3);
        G8_BAR; G8_WL(0); G8_MMA(1, 0, B0); G8_BAR; G8_SCHED;
        G8_STB(1, 1, t + 3);
        G8_WV(6); G8_BAR; G8_MMA(1, 1, B1); G8_BAR;
    }
    tz = tidx(); wid = tz >> 6; lane = tz & 63; wr = wid >> 2; wc = wid & 3; fr = lane & 15; fq = lane >> 4;
    loff = ((fr * 64 + fq * 16) ^ ((fr >> 3) << 5));
    {
        G8_LDB(B0, 0, 0); G8_WV(0); G8_LDA(At, 0, 0); G8_STA(1, 1, nt - 1);
        G8_BAR; G8_WL(0); G8_MMA(0, 0, B0); G8_BAR;
        G8_LDB(B1, 0, 1); G8_BAR; G8_WL(0); G8_MMA(0, 1, B1); G8_BAR;
        G8_LDA(At, 0, 1); G8_WV(4); G8_BAR; G8_WL(0); G8_MMA(1, 0, B0); G8_MMA(1, 1, B1); G8_BAR;
    }
    {
        G8_LDB(B0, 1, 0); G8_LDA(At, 1, 0); G8_WV(2); G8_BAR; G8_WL(0); G8_MMA(0, 0, B0); G8_BAR;
        G8_LDB(B1, 1, 1); G8_WV(0); G8_BAR; G8_WL(0); G8_MMA(0, 1, B1); G8_BAR;
        G8_LDA(At, 1, 1); G8_BAR; G8_WL(0); G8_MMA(1, 0, B0); G8_MMA(1, 1, B1); G8_BAR;
    }
    if (wr == 0) G8_BAR;
    {
        AS a2; BS b2;
        if (!EPI::STAGED && nextfn(a2, b2)) {
            G8_STAGE(G8_SB(0, 0), b2, 0, 0); G8_STAGE(G8_SA(0, 0), a2, 0, 0); G8_STAGE(G8_SB(0, 1), b2, 1, 0); G8_STAGE(G8_SA(0, 1), a2, 1, 0);
        }
    }
#pragma unroll
    for (int ai = 0; ai < 2; ++ai) {
        f32x4 a4[4][4];
#pragma unroll
        for (int m = 0; m < 4; ++m)
#pragma unroll
            for (int n = 0; n < 4; ++n) a4[m][n] = acc[ai][n >> 1][m][n & 1];
        if constexpr (EPI::STAGED) epi.stage(a4, ai * 128 + wr * 64, wc * 64, fr, fq, smem);
        else epi(a4, ai * 128 + wr * 64, wc * 64, fr, fq);
    }
    if constexpr (EPI::STAGED) {
        __syncthreads();
        epi.flush(smem);
        __syncthreads();
    }
}
template <class TP>
DI void gemm8_run(TP& tp, int nt, char* smem) {
    typename TP::AS as; typename TP::BS bs; typename TP::EPI epi;
    bool pre = false;
    for (int k = 0; tp.get(k, as, bs, epi); ++k) {
        gemm8_tile(as, bs, nt, epi, smem, pre, [&](typename TP::AS& a2, typename TP::BS& b2) { typename TP::EPI e2; return tp.get(k + 1, a2, b2, e2); });
        pre = !TP::EPI::STAGED;
    }
}
DI bool xcd_tile(int k, int nM, int NT, int& mt, int& nt) {
    const bool swz = (gridDim.x & 7) == 0;
    const int j = (swz ? (int)(blockIdx.x >> 3) : (int)blockIdx.x) + (swz ? (int)(gridDim.x >> 3) : (int)gridDim.x) * k, mi = j / NT;
    nt = j - mi * NT; mt = swz ? (int)(blockIdx.x & 7) + 8 * mi : mi;
    return mt < nM;
}
struct ALPlain {
    typedef u32x4 Raw; static constexpr int STORE_AT = 0;
    const bf16_t* A; int lda;
    DI void issue(Raw& r, int row, int k, int) const { r = *(const u32x4*)(A + (size_t)row * lda + k); }
    DI u32x4 finish(const Raw& r, int) const { return r; }
};
struct ALMix {
    struct Raw { u32x4 h, x; };
    static constexpr int STORE_AT = 1;
    const bf16_t* H; const bf16_t* XX; const LAS float* xm;
    DI void issue(Raw& r, int row, int k, int) const { r.h = *(const u32x4*)(H + (size_t)row * DM + k); r.x = *(const u32x4*)(XX + (size_t)row * DM + k); }
    DI void set_mix(const float* g) {
        const int t = tidx();
        LAS float* w = (LAS float*)xm;
        w[t] = g[t]; w[t + 512] = g[t + 512];
        __syncthreads();
    }
    DI u32x4 finish(const Raw& r, int k) const {
        const f32x4 m0 = *(const LAS f32x4*)(xm + k), m1 = *(const LAS f32x4*)(xm + k + 4);
        const u32x4 h = r.h, x = r.x;
        u32x4 o;
        o[0] = pk_bf16(bf_lo(h[0]) + bf_lo(x[0]) * m0[0], bf_hi(h[0]) + bf_hi(x[0]) * m0[1]);
        o[1] = pk_bf16(bf_lo(h[1]) + bf_lo(x[1]) * m0[2], bf_hi(h[1]) + bf_hi(x[1]) * m0[3]);
        o[2] = pk_bf16(bf_lo(h[2]) + bf_lo(x[2]) * m1[0], bf_hi(h[2]) + bf_hi(x[2]) * m1[1]);
        o[3] = pk_bf16(bf_lo(h[3]) + bf_lo(x[3]) * m1[2], bf_hi(h[3]) + bf_hi(x[3]) * m1[3]);
        return o;
    }
};

struct EpiQKV {
    static constexpr bool STAGED = false;
    PLite p; int m0, n0;
    DI void operator()(const f32x4 (&acc)[4][4], int rb, int cb, int fr, int fq) const {
        const int hs = (n0 + cb) >> 6;
        const bool isq = hs < 8 || (hs >= 12 && hs < 20), isv = (hs >= 10 && hs < 12) || hs >= 22, normed = hs >= 12 && hs < 22;
        const float* gam = hs < 20 ? p.qg : p.kg;
        const f32x2* rope = (const f32x2*)(p.ws + OFF_ROPE);
        bf16_t* Q = (bf16_t*)(p.ws + OFF_SCR + S_Q);
        bf16_t* K = (bf16_t*)(p.ws + OFF_SCR + S_K);
        bf16_t* VT = (bf16_t*)(p.ws + OFF_SCR + S_VT);
#pragma unroll
        for (int m = 0; m < 4; ++m) {
            const int tok = m0 + rb + m * 16 + fr, b = tok >= PTOT ? 1 : 0, pos = tok - b * PTOT;
            f32x4 v[4];
#pragma unroll
            for (int n = 0; n < 4; ++n) v[n] = acc[m][n];
            if (normed) {
                float ss = 0.f;
#pragma unroll
                for (int n = 0; n < 4; ++n) ss += v[n][0] * v[n][0] + v[n][1] * v[n][1] + v[n][2] * v[n][2] + v[n][3] * v[n][3];
                ss += __shfl_xor(ss, 16); ss += __shfl_xor(ss, 32);
                const float rstd = rsqrtf(ss * (1.0f / 64.0f) + RMS_EPS);
#pragma unroll
                for (int n = 0; n < 4; ++n) { const f32x4 g = *(const f32x4*)(gam + n * 16 + fq * 4); v[n] = v[n] * rstd * g; }
            }
            if (!isv && pos >= LCTX) {
                const int t = pos - LCTX, prow = t >> 6, pcol = t & 63;
#pragma unroll
                for (int a = 0; a < 2; ++a) {
                    const f32x2* tb = rope + (a == 0 ? prow : 256 + pcol) * 16 + fq * 4;
#pragma unroll
                    for (int j = 0; j < 4; ++j) {
                        const f32x2 cs = tb[j];
                        const float x0 = v[2 * a][j], x1 = v[2 * a + 1][j];
                        v[2 * a][j] = x0 * cs[0] - x1 * cs[1];
                        v[2 * a + 1][j] = x1 * cs[0] + x0 * cs[1];
                    }
                }
            }
            if (isq) {
                const int hq = hs < 8 ? hs : hs - 4;
                bf16_t* dst = Q + ((size_t)(b * 16 + hq) * PTOT + pos) * 64 + fq * 4;
#pragma unroll
                for (int n = 0; n < 4; ++n) { const f32x4 w = v[n] * (0.125f * LOG2E); u32x2 o; o[0] = pk_bf16(w[0], w[1]); o[1] = pk_bf16(w[2], w[3]); *(u32x2*)(dst + n * 16) = o; }
            } else if (!isv) {
                const int kh = hs < 12 ? hs - 8 : hs - 18;
                bf16_t* dst = K + ((size_t)(b * 4 + kh) * PTOT + pos) * 64 + fq * 4;
#pragma unroll
                for (int n = 0; n < 4; ++n) { u32x2 o; o[0] = pk_bf16(v[n][0], v[n][1]); o[1] = pk_bf16(v[n][2], v[n][3]); *(u32x2*)(dst + n * 16) = o; }
            } else {
                const int vh = hs < 12 ? hs - 10 : hs - 20;
                bf16_t* dst = VT + (size_t)(b * 4 + vh) * 64 * PTOT + pos;
#pragma unroll
                for (int n = 0; n < 4; ++n)
#pragma unroll
                    for (int j = 0; j < 4; ++j) dst[(size_t)(n * 16 + fq * 4 + j) * PTOT] = (bf16_t)(pk_bf16(v[n][j], 0.f) & 0xffffu);
            }
        }
    }
};
struct TPQkv {
    typedef G8Rows AS; typedef G8Rows BS; typedef EpiQKV EPI;
    PLite p; const bf16_t* H; const bf16_t* W;
    DI bool get(int k, AS& as, BS& bs, EPI& epi) const {
        int mt, nt; if (!xcd_tile(k, TTOT / 256, QKV_N / 256, mt, nt)) return false;
        as = g8_arows(H + (size_t)mt * 256 * DM, DM); bs = g8_brows(W + (size_t)nt * 256 * DM, DM); epi = EpiQKV{p, mt * 256, nt * 256};
        return true;
    }
};
DI void phase_qkv(const Params& p, char* smem) {
    TPQkv tp{plite(p), (const bf16_t*)(p.ws + OFF_H), (const bf16_t*)(p.ws + OFF_WS) + W_IN};
    gemm8_run(tp, DM / 64, smem);
}

struct EpiResid {
    static constexpr bool STAGED = false;
    PLite p; int m0, n0, layer; bool from_input;
    DI void operator()(const f32x4 (&acc)[4][4], int rb, int cb, int fr, int fq) const {
        const int tok0 = m0 + rb, co = n0 + cb + fq * 4;
        const float* xin = (from_input ? xin_ptr(p, tok0) : xrow_ptr(p, tok0)) + (size_t)fr * DM + co;
        float* xo = xrow_ptr(p, tok0) + (size_t)fr * DM + co;
        const float* gate = mod_ptr(p, layer, tok0, 2) + co;
        f32x4 g[4], xi[2][4];
#pragma unroll
        for (int n = 0; n < 4; ++n) g[n] = *(const f32x4*)(gate + n * 16);
#pragma unroll
        for (int n = 0; n < 4; ++n) xi[0][n] = *(const f32x4*)(xin + n * 16);
#pragma unroll
        for (int m = 0; m < 4; ++m) {
            if (m < 3) {
#pragma unroll
                for (int n = 0; n < 4; ++n) xi[(m + 1) & 1][n] = *(const f32x4*)(xin + (size_t)(m + 1) * 16 * DM + n * 16);
            }
#pragma unroll
            for (int n = 0; n < 4; ++n) *(f32x4*)(xo + (size_t)m * 16 * DM + n * 16) = xi[m & 1][n] + g[n] * acc[m][n];
        }
    }
};
struct TPResid {
    typedef G8Rows AS; typedef G8Rows BS; typedef EpiResid EPI;
    PLite p; const bf16_t* O; const bf16_t* W; int layer;
    DI bool get(int k, AS& as, BS& bs, EPI& epi) const {
        constexpr int MTL = SEQ / 256;
        int mi, nt; if (!xcd_tile(k, layer == 0 ? TTOT / 256 : NBATCH * MTL, 4, mi, nt)) return false;
        const int mt = layer == 0 ? mi : (mi / MTL) * (PTOT / 256) + 1 + (mi % MTL);
        as = g8_arows(O + (size_t)mt * 256 * DM, DM); bs = g8_brows(W + (size_t)nt * 256 * DM, DM); epi = EpiResid{p, mt * 256, nt * 256, layer, layer == 0};
        return true;
    }
};
DI void phase_wout(const Params& p, char* smem) {
    TPResid tp{plite(p), (const bf16_t*)(p.ws + OFF_SCR + S_O), (const bf16_t*)(p.ws + OFF_WS) + W_OUT, 0};
    gemm8_run(tp, DM / 64, smem);
}
DI void phase_wo(const Params& p, char* smem) {
    TPResid tp{plite(p), (const bf16_t*)(p.ws + OFF_SCR + S_OR), (const bf16_t*)(p.ws + OFF_WS) + W_O, 1};
    gemm8_run(tp, DM / 64, smem);
}

struct MoeSched { int nt[16], base[17]; };
DI void moe_sched(const Params& p, int layer, MoeSched& s, int (&cnt)[16]) {
    const int* c = (const int*)(p.ws + OFF_CNT) + layer * 16;
    int acc = 0;
#pragma unroll
    for (int e = 0; e < 16; ++e) { cnt[e] = c[e]; s.nt[e] = (cnt[e] + 255) >> 8; s.base[e] = acc; acc += s.nt[e]; }
    s.base[16] = acc;
}
struct EpiMoe1 {
    static constexpr bool STAGED = true;
    static constexpr int SROW = 136;
    bf16_t* hid;   int n0;
    DI void stage(const f32x4 (&acc)[4][4], int rb, int cb, int fr, int fq, char* smem) const {
        bf16_t* st = (bf16_t*)smem;
        const int c0 = (cb >> 6) * 32 + fq * 4;
#pragma unroll
        for (int m = 0; m < 4; ++m) {
            bf16_t* dst = st + (rb + m * 16 + fr) * SROW + c0;
#pragma unroll
            for (int n = 0; n < 2; ++n) {
                const f32x4 a = acc[m][n], b = acc[m][n + 2];
                u32x2 o;
                o[0] = pk_bf16(siluf_(a[0]) * b[0], siluf_(a[1]) * b[1]);
                o[1] = pk_bf16(siluf_(a[2]) * b[2], siluf_(a[3]) * b[3]);
                *(u32x2*)(dst + n * 16) = o;
            }
        }
    }
    DI void flush(char* smem) const {
        const int t = tidx();
        const bf16_t* st = (const bf16_t*)smem;
        bf16_t* dst = hid + (n0 >> 1) + (t & 15) * 8;
#pragma unroll
        for (int ps = 0; ps < 8; ++ps) {
            const int row = ps * 32 + (t >> 4);
            *(u32x4*)(dst + (size_t)row * 1024) = *(const u32x4*)(st + row * SROW + (t & 15) * 8);
        }
    }
};
struct TPMoe1 {
    typedef G8Gather AS; typedef G8Rows BS; typedef EpiMoe1 EPI;
    MoeSched s; int cnt[16];
    const bf16_t* H; const bf16_t* W13; const int* stok; bf16_t* hid;
    DI bool get(int k, AS& as, BS& bs, EPI& epi) const {
        int mg, nt; if (!xcd_tile(k, s.base[16], 8, mg, nt)) return false;
        int e = 0;
#pragma unroll
        for (int i = 1; i < 16; ++i) if (mg >= s.base[i]) e = i;
        int ce = 0, be = 0;
#pragma unroll
        for (int i = 0; i < 16; ++i) if (i == e) { ce = cnt[i]; be = s.base[i]; }
        const int ml = mg - be;
        int R0, C0; g8_rc(R0, C0);
        as.base = H;
#pragma unroll
        for (int q = 0; q < 4; ++q) {
            const int r = ml * 256 + R0 + 64 * (q & 1) + 128 * (q >> 1);
            const int tk = r < ce ? (stok[(size_t)e * CAP + r] >> 1) : 0;
            as.o[q] = (unsigned)tk * 1024u + C0;
        }
        bs = g8_brows(W13 + (size_t)e * 2048 * 1024 + (size_t)nt * 256 * 1024, 1024);
        epi = EpiMoe1{hid + (size_t)mg * 256 * 1024, nt * 256};
        return true;
    }
};
DI void phase_moe1(const Params& p, int layer, char* smem) {
    TPMoe1 tp;
    moe_sched(p, layer, tp.s, tp.cnt);
    tp.H = (const bf16_t*)(p.ws + OFF_H); tp.W13 = (const bf16_t*)(p.ws + OFF_MOEW); tp.stok = (const int*)(p.ws + OFF_STOK); tp.hid = (bf16_t*)(p.ws + OFF_SCR + S_HID);
    gemm8_run(tp, 16, smem);
}
struct EpiMoe2 {
    static constexpr bool STAGED = false;
    bf16_t* Y; const int* stok; const float* sw; int nvalid, n0;
    DI void operator()(const f32x4 (&acc)[4][4], int rb, int cb, int fr, int fq) const {
        int tkm[4]; float wm[4];
#pragma unroll
        for (int m = 0; m < 4; ++m) { tkm[m] = stok[rb + m * 16 + fr]; wm[m] = sw[rb + m * 16 + fr]; }
#pragma unroll
        for (int m = 0; m < 4; ++m) {
            const int r = rb + m * 16 + fr;
            if (r < nvalid) {
                const int tk = tkm[m]; const float w = wm[m];
                bf16_t* dst = Y + (size_t)tk * 1024 + n0 + cb + fq * 4;
#pragma unroll
                for (int n = 0; n < 4; ++n) { const f32x4 a = acc[m][n] * w; u32x2 o; o[0] = pk_bf16(a[0], a[1]); o[1] = pk_bf16(a[2], a[3]); *(u32x2*)(dst + n * 16) = o; }
            }
        }
    }
};
struct TPMoe2 {
    typedef G8Rows AS; typedef G8Rows BS; typedef EpiMoe2 EPI;
    MoeSched s; int cnt[16];
    const bf16_t* hid; const bf16_t* W2; const int* stok; const float* sw; bf16_t* Y;
    DI bool get(int k, AS& as, BS& bs, EPI& epi) const {
        int mg, nt; if (!xcd_tile(k, s.base[16], 4, mg, nt)) return false;
        int e = 0;
#pragma unroll
        for (int i = 1; i < 16; ++i) if (mg >= s.base[i]) e = i;
        int ce = 0, be = 0;
#pragma unroll
        for (int i = 0; i < 16; ++i) if (i == e) { ce = cnt[i]; be = s.base[i]; }
        const int ml = mg - be;
        as = g8_arows(hid + (size_t)mg * 256 * 1024, 1024); bs = g8_brows(W2 + (size_t)e * 1024 * 1024 + (size_t)nt * 256 * 1024, 1024);
        epi = EpiMoe2{Y, stok + (size_t)e * CAP + ml * 256, sw + (size_t)e * CAP + ml * 256, ce - ml * 256, nt * 256};
        return true;
    }
};
DI void phase_moe2(const Params& p, int layer, char* smem) {
    TPMoe2 tp;
    moe_sched(p, layer, tp.s, tp.cnt);
    tp.hid = (const bf16_t*)(p.ws + OFF_SCR + S_HID); tp.W2 = (const bf16_t*)(p.ws + OFF_MOEW) + (size_t)16 * 2048 * 1024;
    tp.stok = (const int*)(p.ws + OFF_STOK); tp.sw = (const float*)(p.ws + OFF_SW); tp.Y = (bf16_t*)(p.ws + OFF_SCR + S_Y);
    gemm8_run(tp, 16, smem);
}

struct EpiRwkv {
    bf16_t* dst; int ld, m0, n0, act, nstore;
    DI void operator()(const f32x4 (&acc)[4][4], int rb, int cb, int fr, int fq) const {
#pragma unroll
        for (int m = 0; m < 4; ++m) {
            bf16_t* d = dst + (size_t)(m0 + rb + m * 16 + fr) * ld + n0 + cb + fq * 4;
#pragma unroll
            for (int n = 0; n < 4; ++n) {
                const int c = n0 + cb + n * 16 + fq * 4;
                if (c >= ld) continue;
                f32x4 a = acc[m][n];
                if (act == 1) {
#pragma unroll
                    for (int j = 0; j < 4; ++j) { const float e = __builtin_amdgcn_exp2f(a[j] * (2.0f * LOG2E)); a[j] = 1.0f - 2.0f * __builtin_amdgcn_rcpf(e + 1.0f); }
                }
                if (act == 2) {
#pragma unroll
                    for (int j = 0; j < 4; ++j) a[j] = sigmoidf_(a[j]);
                }
                if (c >= nstore) a = (f32x4){0.f, 0.f, 0.f, 0.f};
                u32x2 o; o[0] = pk_bf16(a[0], a[1]); o[1] = pk_bf16(a[2], a[3]);
                *(u32x2*)(d + n * 16) = o;
            }
        }
    }
};
DI void phase_rwkv_proj(const Params& p, char* smem) {
    const bf16_t* H = (const bf16_t*)(p.ws + OFF_H);
    const bf16_t* XX = (const bf16_t*)(p.ws + OFF_SCR + S_XX);
    const bf16_t* wsm = (const bf16_t*)(p.ws + OFF_WS);
    constexpr int MT = TTOT / 256, NU = 14;
    for (int u = blockIdx.x; u < MT * NU; u += gridDim.x) {
        const int mt = u / NU, q = u % NU;
        ALMix al{H + (size_t)mt * 256 * DM, XX + (size_t)mt * 256 * DM, (const LAS float*)(smem + GEMM_SMEM)};
        if (q < 13) {
            const int job = q < 4 ? 0 : q < 8 ? 1 : q < 12 ? 2 : 5, nt = q < 12 ? (q & 3) : 0;
            const int mixj = job == 0 ? 0 : job == 1 ? 2 : job == 2 ? 3 : 5;
            const size_t wofs = job == 0 ? W_R : job == 1 ? W_K : job == 2 ? W_V : W_G1;
            const size_t dofs = job == 0 ? S_R : job == 1 ? S_KK : job == 2 ? S_V : S_LG;
            al.set_mix(p.rwkv_x_mix + mixj * DM);
            EpiRwkv epi{(bf16_t*)(p.ws + OFF_SCR + dofs), job == 5 ? 192 : 1024, mt * 256, nt * 256, job == 5 ? 2 : 0, job == 5 ? 160 : 4096};
            gemm_tile<2>(al, wsm + wofs + (size_t)nt * 256 * DM, DM, DM / 64, epi, smem);
        } else {
#pragma unroll 1
            for (int j = 0; j < 2; ++j) {
                al.set_mix(p.rwkv_x_mix + (j == 0 ? 1 : 4) * DM);
                EpiRwkv epi{(bf16_t*)(p.ws + OFF_SCR + (j == 0 ? S_LW : S_LA)), 128, mt * 256, 0, j == 0 ? 1 : 0, 4096};
                gemm_tile<1>(al, wsm + (j == 0 ? W_W1 : W_A1), DM, DM / 64, epi, smem);
            }
        }
    }
}

struct EpiGate {
    const Params* p; int m0, n0;
    DI void operator()(const f32x4 (&acc)[4][4], int rb, int cb, int fr, int fq) const {
        const bf16_t* Y0 = (const bf16_t*)(p->ws + OFF_H);
        const bf16_t* Y1 = (const bf16_t*)(p->ws + OFF_SCR + S_Y1);
        const bf16_t* V = (const bf16_t*)(p->ws + OFF_SCR + S_V);
        const float* bonus = (const float*)(p->ws + OFF_BONUS2);
        bf16_t* O = (bf16_t*)(p->ws + OFF_SCR + S_OR);
        const int c0 = n0 + cb, hd = c0 >> 6;
#pragma unroll
        for (int m = 0; m < 4; ++m) {
            const int tok = m0 + rb + m * 16 + fr;
            const size_t ro = (size_t)tok * DM + c0 + fq * 4;
            f32x4 y[4];
            float s = 0.f;
#pragma unroll
            for (int n = 0; n < 4; ++n) {
                const u32x2 a = *(const u32x2*)(Y0 + ro + n * 16), b = *(const u32x2*)(Y1 + ro + n * 16);
                y[n][0] = bf_lo(a[0]) + bf_lo(b[0]); y[n][1] = bf_hi(a[0]) + bf_hi(b[0]); y[n][2] = bf_lo(a[1]) + bf_lo(b[1]); y[n][3] = bf_hi(a[1]) + bf_hi(b[1]);
                s += y[n][0] + y[n][1] + y[n][2] + y[n][3];
            }
            s += __shfl_xor(s, 16); s += __shfl_xor(s, 32);
            const float mu = s * (1.0f / 64.0f);
            float q = 0.f;
#pragma unroll
            for (int n = 0; n < 4; ++n) { const f32x4 d = y[n] - mu; q += d[0] * d[0] + d[1] * d[1] + d[2] * d[2] + d[3] * d[3]; }
            q += __shfl_xor(q, 16); q += __shfl_xor(q, 32);
            const float rs = rsqrtf(q * (1.0f / 64.0f) + GN_EPS);
            const float bon = (bonus[(size_t)tok * 16 + hd] + bonus[(size_t)(TTOT + tok) * 16 + hd]) + (bonus[(size_t)(2 * TTOT + tok) * 16 + hd] + bonus[(size_t)(3 * TTOT + tok) * 16 + hd]);
#pragma unroll
            for (int n = 0; n < 4; ++n) {
                const int c = c0 + n * 16 + fq * 4;
                const f32x4 g = *(const f32x4*)(p->rwkv_ln_g + c), bb = *(const f32x4*)(p->rwkv_ln_b + c);
                const u32x2 vv = *(const u32x2*)(V + ro + n * 16);
                const f32x4 v4 = {bf_lo(vv[0]), bf_hi(vv[0]), bf_lo(vv[1]), bf_hi(vv[1])};
                const f32x4 o = ((y[n] - mu) * rs * g + bb + bon * v4) * acc[m][n];
                u32x2 w; w[0] = pk_bf16(o[0], o[1]); w[1] = pk_bf16(o[2], o[3]);
                *(u32x2*)(O + ro + n * 16) = w;
            }
        }
    }
};
DI void phase_gate(const Params& p, char* smem) {
    const bf16_t* LG = (const bf16_t*)(p.ws + OFF_SCR + S_LG);
    const bf16_t* W = (const bf16_t*)(p.ws + OFF_WS) + W_G2;
    constexpr int NT = 8, MTL = SEQ / 256;
    for (int k = 0;; ++k) {
        int mi, nt; if (!xcd_tile(k, NBATCH * MTL, NT, mi, nt)) break;
        const int mt = (mi / MTL) * (PTOT / 256) + 1 + (mi % MTL);
        ALPlain al{LG + (size_t)mt * 256 * 192, 192};
        EpiGate epi{&p, mt * 256, nt * 128};
        gemm_tile<1>(al, W + (size_t)nt * 128 * 192, 192, 3, epi, smem);
    }
}

constexpr int KROW = 72, VROW = 68;
constexpr int ATT_SMEM = 2 * 64 * KROW * 2 + 2 * 64 * VROW * 2;
DI int crow_(int i, int h) { return (i & 3) + 8 * (i >> 2) + 4 * h; }
#define MFMA32(a, b, c) __builtin_amdgcn_mfma_f32_32x32x16_bf16((a), (b), (c), 0, 0, 0)
template <int MODE>
DI void attn_unit(const Params& p, const bf16_t* Qg  , int nq_valid, const bf16_t* Kg  , const bf16_t* Vg  ,
                  int ta0, int ta1, int tb0, int tb1  , bool band, int q_lat0  ,
                  float init_m, float init_l0, bf16_t* Og  , char* smem) {
    const int t = tidx(), lane = t & 63, wid = t >> 6, r = lane & 31, h = lane >> 5;
    bf16_t* sK = (bf16_t*)smem;
    bf16_t* sV = sK + 2 * 64 * KROW;
    bf16x8 qf[2][4];
#pragma unroll
    for (int qs = 0; qs < 2; ++qs) {
        const int qi = wid * 64 + qs * 32 + r;
        const bf16_t* qp = Qg + (size_t)(qi < nq_valid ? qi : 0) * 64 + 8 * h;
#pragma unroll
        for (int ks = 0; ks < 4; ++ks) qf[qs][ks] = *(const bf16x8*)(qp + ks * 16);
    }
#pragma unroll
    for (int qs = 0; qs < 2; ++qs)
#pragma unroll
        for (int ks = 0; ks < 4; ++ks) asm volatile("" : "+v"(qf[qs][ks]));
    f32x16 o[2][2];
#pragma unroll
    for (int qs = 0; qs < 2; ++qs)
#pragma unroll
        for (int dt = 0; dt < 2; ++dt)
#pragma unroll
            for (int i = 0; i < 16; ++i) o[qs][dt][i] = 0.f;
    float mrun[2], lrun[2];
#pragma unroll
    for (int qs = 0; qs < 2; ++qs) { mrun[qs] = init_m; lrun[qs] = (MODE == 1 && h == 0) ? init_l0 : 0.f; }
    const int ntile = ((ta1 - ta0) + (tb1 - tb0)) >> 6;
    const int lrow = t >> 3, lch = (t & 7) * 8;
    u32x4 rk, rv;
    auto tile_pos = [&](int i) { const int a = (ta1 - ta0) >> 6; return i < a ? ta0 + i * 64 : tb0 + (i - a) * 64; };
    {
        const int kp = tile_pos(0);
        rk = *(const u32x4*)(Kg + (size_t)(kp + lrow) * 64 + lch);
        rv = *(const u32x4*)(Vg + (size_t)lrow * PTOT + kp + lch);
        *(u32x4*)(sK + lrow * KROW + lch) = rk;
        *(u32x2*)(sV + lrow * VROW + lch) = (u32x2){rv[0], rv[1]};
        *(u32x2*)(sV + lrow * VROW + lch + 4) = (u32x2){rv[2], rv[3]};
    }
    __syncthreads();
    if (__builtin_amdgcn_readfirstlane(wid) >= 4) __builtin_amdgcn_s_setprio(1);
    for (int it = 0; it < ntile; ++it) {
        const int cur = it & 1;
        const bool more = it + 1 < ntile;
        const int kp = tile_pos(it);
        if (more) {
            const int kn = tile_pos(it + 1);
            rk = *(const u32x4*)(Kg + (size_t)(kn + lrow) * 64 + lch);
            rv = *(const u32x4*)(Vg + (size_t)lrow * PTOT + kn + lch);
        }
        __builtin_amdgcn_sched_barrier(0);
        const bf16_t* cK = sK + cur * 64 * KROW;
        const bf16_t* cV = sV + cur * 64 * VROW;
        bf16x8 kf[4];
#pragma unroll
        for (int ks = 0; ks < 4; ++ks) kf[ks] = *(const bf16x8*)(cK + r * KROW + ks * 16 + 8 * h);
#pragma unroll
        for (int ksub = 0; ksub < 2; ++ksub) {
            bf16x8 vf[2][2];
#pragma unroll
            for (int st = 0; st < 2; ++st)
#pragma unroll
                for (int dt = 0; dt < 2; ++dt) {
                    const int kb = ksub * 32 + 16 * st + 4 * h;
                    const s16x4 lo = *(const s16x4*)(cV + (dt * 32 + r) * VROW + kb), hi = *(const s16x4*)(cV + (dt * 32 + r) * VROW + kb + 8);
                    vf[st][dt] = __builtin_shufflevector(lo, hi, 0, 1, 2, 3, 4, 5, 6, 7);
                }
            __builtin_amdgcn_sched_barrier(0);
            f32x16 sc[2];
#pragma unroll
            for (int qs = 0; qs < 2; ++qs)
#pragma unroll
                for (int i = 0; i < 16; ++i) sc[qs][i] = MODE == 0 ? init_m : 0.f;
#pragma unroll
            for (int ks = 0; ks < 4; ++ks)
#pragma unroll
                for (int qs = 0; qs < 2; ++qs) sc[qs] = MFMA32(kf[ks], qf[qs][ks], sc[qs]);
            __builtin_amdgcn_sched_barrier(0);
            if (ksub == 0) {
#pragma unroll
                for (int ks = 0; ks < 4; ++ks) kf[ks] = *(const bf16x8*)(cK + (32 + r) * KROW + ks * 16 + 8 * h);
            }
            __builtin_amdgcn_sched_barrier(0);
#pragma unroll
            for (int qs = 0; qs < 2; ++qs) {
                if (MODE == 1) {
                    if (band && kp >= LCTX) {
                        const int qlat = q_lat0 + wid * 64 + qs * 32 + r, kl0 = kp - LCTX + ksub * 32;
#pragma unroll
                        for (int i = 0; i < 16; ++i) {
                            const int d0 = qlat - (kl0 + crow_(i, h));
                            if (d0 > 128 || d0 < -128) sc[qs][i] = -1e30f;
                        }
                    }
                    float mt = sc[qs][0];
#pragma unroll
                    for (int i = 1; i < 16; ++i) mt = fmaxf(mt, sc[qs][i]);
                    mt = fmaxf(mt, __shfl_xor(mt, 32));
                    const float mnew = fmaxf(mrun[qs], mt);
                    const float alpha = __builtin_amdgcn_exp2f(mrun[qs] - mnew);
                    mrun[qs] = mnew; lrun[qs] *= alpha;
#pragma unroll
                    for (int i = 0; i < 16; ++i) { o[qs][0][i] *= alpha; o[qs][1][i] *= alpha; }
#pragma unroll
                    for (int i = 0; i < 16; ++i) sc[qs][i] -= mnew;
                }
                float ls = 0.f;
#pragma unroll
                for (int i = 0; i < 16; ++i) { sc[qs][i] = __builtin_amdgcn_exp2f(sc[qs][i]); ls += sc[qs][i]; }
                lrun[qs] += ls;
            }
#pragma unroll
            for (int st = 0; st < 2; ++st) {
                bf16x8 pf[2];
#pragma unroll
                for (int qs = 0; qs < 2; ++qs) {
                    u32x4 pw;
#pragma unroll
                    for (int j = 0; j < 4; ++j) pw[j] = pk_bf16(sc[qs][8 * st + 2 * j], sc[qs][8 * st + 2 * j + 1]);
                    pf[qs] = __builtin_bit_cast(bf16x8, pw);
                }
#pragma unroll
                for (int dt = 0; dt < 2; ++dt)
#pragma unroll
                    for (int qs = 0; qs < 2; ++qs) o[qs][dt] = MFMA32(vf[st][dt], pf[qs], o[qs][dt]);
            }
        }
        if (more) {
            bf16_t* nK = sK + (cur ^ 1) * 64 * KROW;
            bf16_t* nV = sV + (cur ^ 1) * 64 * VROW;
            *(u32x4*)(nK + lrow * KROW + lch) = rk;
            *(u32x2*)(nV + lrow * VROW + lch) = (u32x2){rv[0], rv[1]};
            *(u32x2*)(nV + lrow * VROW + lch + 4) = (u32x2){rv[2], rv[3]};
        }
        __syncthreads();
    }
    __builtin_amdgcn_s_setprio(0);
#pragma unroll
    for (int qs = 0; qs < 2; ++qs) {
        const int qi = wid * 64 + qs * 32 + r;
        const float lt = lrun[qs] + __shfl_xor(lrun[qs], 32);
        const float invl = 1.0f / lt;
        if (qi < nq_valid) {
            bf16_t* op = Og + (size_t)qi * DM;
#pragma unroll
            for (int g = 0; g < 4; ++g) {
                u32x2 w0, w1;
                w0[0] = pk_bf16(o[qs][0][4 * g] * invl, o[qs][0][4 * g + 1] * invl); w0[1] = pk_bf16(o[qs][0][4 * g + 2] * invl, o[qs][0][4 * g + 3] * invl);
                w1[0] = pk_bf16(o[qs][1][4 * g] * invl, o[qs][1][4 * g + 1] * invl); w1[1] = pk_bf16(o[qs][1][4 * g + 2] * invl, o[qs][1][4 * g + 3] * invl);
                *(u32x2*)(op + 8 * g + 4 * h) = w0;
                *(u32x2*)(op + 32 + 8 * g + 4 * h) = w1;
            }
        }
    }
}
DI void phase_attn(const Params& p, char* smem) {
    const bf16_t* Q = (const bf16_t*)(p.ws + OFF_SCR + S_Q);
    const bf16_t* K = (const bf16_t*)(p.ws + OFF_SCR + S_K);
    const bf16_t* VT = (const bf16_t*)(p.ws + OFF_SCR + S_VT);
    bf16_t* O = (bf16_t*)(p.ws + OFF_SCR + S_O);
    float gq = 0.f, gk = 0.f;
    for (int i = 0; i < 64; ++i) { gq = fmaxf(gq, fabsf(p.attn_q_norm_g[i])); gk = fmaxf(gk, fabsf(p.attn_k_norm_g[i])); }
    const float M2 = 8.25f * gq * gk * LOG2E;
    constexpr int QB = 512, NQB = SEQ / QB;
    const int G = gridDim.x;
    constexpr int NDENSE = NBATCH * 8 * NQB;
    for (int u = blockIdx.x; u < NDENSE; u += G) {
        int combo, within;
        if ((G & 7) == 0 && NDENSE % G == 0) {
            const int xcd = blockIdx.x & 7, idx = (blockIdx.x >> 3) + (G >> 3) * (u / G);
            combo = xcd & 3; within = (xcd >> 2) * (NDENSE / 8) + idx;
        } else { combo = u / (4 * NQB); within = u % (4 * NQB); }
        const int b = combo >> 1, kvh = combo & 1, hq = kvh * 4 + (within & 3), qb = within >> 2;
        const bf16_t* Qg = Q + ((size_t)(b * 16 + 8 + hq) * PTOT + LCTX + qb * QB) * 64;
        attn_unit<0>(p, Qg, QB, K + (size_t)(b * 4 + 2 + kvh) * PTOT * 64, VT + (size_t)(b * 4 + 2 + kvh) * 64 * PTOT, 0, PTOT, 0, 0, false, 0, -M2, 0.f,
                     O + (size_t)(b * PTOT + LCTX + qb * QB) * DM + (8 + hq) * 64, smem);
    }
    for (int u = blockIdx.x; u < NDENSE; u += G) {
        const int b = u / (8 * NQB), rem = u % (8 * NQB), qb = rem >> 3, hq = rem & 7, kvh = hq >> 2;
        const int i0 = qb * QB;
        const int lo = i0 - 128 < 0 ? 0 : i0 - 128, hi = i0 + QB + 128 > SEQ ? SEQ : i0 + QB + 128;
        const bf16_t* Qg = Q + ((size_t)(b * 16 + hq) * PTOT + LCTX + i0) * 64;
        attn_unit<1>(p, Qg, QB, K + (size_t)(b * 4 + kvh) * PTOT * 64, VT + (size_t)(b * 4 + kvh) * 64 * PTOT, 0, LCTX, LCTX + lo, LCTX + hi, true, i0,
                     p.attn_sink[hq] * LOG2E, 1.0f, O + (size_t)(b * PTOT + LCTX + i0) * DM + hq * 64, smem);
    }
    for (int u = blockIdx.x; u < NBATCH * 16; u += G) {
        const int b = u >> 4, hh = u & 15, isb = hh >> 3, hq = hh & 7, kvh = isb * 2 + (hq >> 2);
        const bf16_t* Qg = Q + ((size_t)(b * 16 + hh) * PTOT) * 64;
        attn_unit<1>(p, Qg, LCTX, K + (size_t)(b * 4 + kvh) * PTOT * 64, VT + (size_t)(b * 4 + kvh) * 64 * PTOT, 0, LCTX, 0, 0, false, 0,
                     isb ? -1e30f : p.attn_sink[hq] * LOG2E, isb ? 0.f : 1.0f, O + (size_t)(b * PTOT) * DM + hh * 64, smem);
    }
}

constexpr int TB = 32, NBUF = 3;
constexpr int SC_REC = 5 * 64;
constexpr int SC_OPS = TB * SC_REC * 4;
constexpr int SC_SMEM = NBUF * SC_OPS + NBUF * TB * 16 * 4 + NBUF * TB * 16 * 4 + 64;
DI int scan_pos(int n, int dir) {
    if (n < LCTX) return dir ? LCTX - 1 - n : n;
    const int m = n - LCTX;
    return LCTX + (dir ? SEQ - 1 - m : m);
}
template <int CTRL> DI float dpp_add(float v) { return v + __builtin_bit_cast(float, __builtin_amdgcn_update_dpp(0, __builtin_bit_cast(int, v), CTRL, 0xf, 0xf, false)); }
DI float row16_sum(float v) { v = dpp_add<0x128>(v); v = dpp_add<0x124>(v); v = dpp_add<0x122>(v); v = dpp_add<0x121>(v); return v; }
DI int lds_min4(int* c) { const volatile LAS int* q = (const volatile LAS int*)c; const int a = q[0], b = q[1], d = q[2], e = q[3]; return min(min(a, b), min(d, e)); }
DI void lds_publish(int* c, int v) { *(volatile LAS int*)c = v; }
DI void scan_unit(const Params& p, int u, char* smem) {
    const int t = tidx(), lane = t & 63, wid = __builtin_amdgcn_readfirstlane(t >> 6);
    const unsigned rg = u & 3, dir = (u >> 2) & 1, hd = (u >> 3) & 15, b = u >> 7;
    float* ops = (float*)smem;
    float* vbuf = (float*)(smem + NBUF * SC_OPS);
    float* ybuf = vbuf + NBUF * TB * 16;
    int* cnts = (int*)(ybuf + NBUF * TB * 16);
    const bf16_t* R = (const bf16_t*)(p.ws + OFF_SCR + S_R);
    const bf16_t* Kk = (const bf16_t*)(p.ws + OFF_SCR + S_KK);
    const bf16_t* V = (const bf16_t*)(p.ws + OFF_SCR + S_V);
    const bf16_t* LW = (const bf16_t*)(p.ws + OFF_SCR + S_LW);
    const bf16_t* LA = (const bf16_t*)(p.ws + OFF_SCR + S_LA);
    bf16_t* Yo = dir ? (bf16_t*)(p.ws + OFF_SCR + S_Y1) : (bf16_t*)(p.ws + OFF_H);
    float* bonus = (float*)(p.ws + OFF_BONUS2);
    const unsigned tokb = b * PTOT, hc = hd * 64;
    constexpr int NBLK = PTOT / TB;
    const unsigned fr = lane & 15, fq = lane >> 4;
    if (t < 8) cnts[t] = 0;
    __syncthreads();

    if (wid < 4) {
        __builtin_amdgcn_s_setprio(3);
        float s0 = 0.f, s1 = 0.f, s2 = 0.f, s3 = 0.f;
        const unsigned g = lane >> 4, c4 = (lane & 15) * 4, myrow = wid * 4 + g;
        for (int blk = 0; blk < NBLK; ++blk) {
            const unsigned buf = (unsigned)blk % NBUF;
            while (lds_min4(cnts) < blk + 1) __builtin_amdgcn_s_sleep(1);
            asm volatile("" ::: "memory");
            const float* rec = ops + buf * (TB * SC_REC) + c4;
            const float* vb = vbuf + buf * (TB * 16) + myrow;
            float* yb = ybuf + buf * (TB * 16) + myrow;
            f32x4 w0_ = *(const f32x4*)(rec), kd0_ = *(const f32x4*)(rec + 64), bb0_ = *(const f32x4*)(rec + 128), aa0_ = *(const f32x4*)(rec + 192), rr0_ = *(const f32x4*)(rec + 256);
            float vv0_ = vb[0];
#define SCAN_STEP(W, KD, BB, AA, RR, VV, ST) { \
                float sa = s0 * AA[0] + s1 * AA[1] + s2 * AA[2] + s3 * AA[3]; \
                sa = row16_sum(sa); \
                s0 = s0 * W[0] + sa * BB[0] + VV * KD[0]; \
                s1 = s1 * W[1] + sa * BB[1] + VV * KD[1]; \
                s2 = s2 * W[2] + sa * BB[2] + VV * KD[2]; \
                s3 = s3 * W[3] + sa * BB[3] + VV * KD[3]; \
                float y = s0 * RR[0] + s1 * RR[1] + s2 * RR[2] + s3 * RR[3]; \
                y = row16_sum(y); \
                if ((lane & 15) == 0) yb[(ST) * 16] = y; }
#pragma unroll 1
            for (int st = 0; st < TB; st += 2) {
                const float* r1 = rec + (st + 1) * SC_REC;
                const f32x4 w1_ = *(const f32x4*)(r1), kd1_ = *(const f32x4*)(r1 + 64), bb1_ = *(const f32x4*)(r1 + 128), aa1_ = *(const f32x4*)(r1 + 192), rr1_ = *(const f32x4*)(r1 + 256);
                const float vv1_ = vb[(st + 1) * 16];
                SCAN_STEP(w0_, kd0_, bb0_, aa0_, rr0_, vv0_, st)
                const int st2 = st + 2 < TB ? st + 2 : st;
                const float* r2 = rec + st2 * SC_REC;
                w0_ = *(const f32x4*)(r2); kd0_ = *(const f32x4*)(r2 + 64); bb0_ = *(const f32x4*)(r2 + 128); aa0_ = *(const f32x4*)(r2 + 192); rr0_ = *(const f32x4*)(r2 + 256);
                vv0_ = vb[st2 * 16];
                SCAN_STEP(w1_, kd1_, bb1_, aa1_, rr1_, vv1_, st + 1)
            }
#undef SCAN_STEP
            asm volatile("s_waitcnt lgkmcnt(0)" ::: "memory");
            if (lane == 0) lds_publish(cnts + 4 + wid, blk + 1);
        }
        __builtin_amdgcn_s_setprio(0);
    } else {
        const unsigned wt = wid & 1, chh = (wid >> 1) & 1;
        const bf16_t* wsm = (const bf16_t*)(p.ws + OFF_WS);
        const unsigned wo = W_W2 + dir * 65536u + (hc + fr) * 64u + fq * 8u;
        const unsigned ao = W_A2 + dir * 65536u + (hc + fr) * 64u + fq * 8u;
        const unsigned po = hc + fq * 4u;
        for (int blk = 0; blk < NBLK + NBUF; ++blk) {
            const unsigned buf = (unsigned)blk % NBUF;
            const int need = blk - NBUF + 1 < NBLK ? blk - NBUF + 1 : NBLK;
            while (lds_min4(cnts + 4) < need) __builtin_amdgcn_s_sleep(1);
            asm volatile("" ::: "memory");
            if (wid == 7 && blk >= NBUF) {
#pragma unroll
                for (int i = 0; i < TB * 16 / 64; ++i) {
                    const unsigned id = i * 64 + lane, st = id >> 4, rw = id & 15;
                    const unsigned tok = tokb + scan_pos((blk - NBUF) * TB + st, dir);
                    Yo[tok * 1024u + hc + rg * 16 + rw] = (bf16_t)(pk_bf16(ybuf[buf * (TB * 16) + id], 0.f) & 0xffffu);
                }
            }
            if (blk >= NBLK) continue;
            const unsigned st = wt * 16 + fr;
            const unsigned tok = tokb + scan_pos(blk * TB + st, dir);
            const unsigned lo = tok * 128u + dir * 64u + fq * 8u;
            const unsigned ro = tok * 1024u + hc + fq * 4u;
            bf16x8 lwf[2], laf[2];
#pragma unroll
            for (int kk = 0; kk < 2; ++kk) { lwf[kk] = *(const bf16x8*)(LW + lo + kk * 32); laf[kk] = *(const bf16x8*)(LA + lo + kk * 32); }
            float ssq = 0.f;
#pragma unroll
            for (int nt = 0; nt < 4; ++nt) {
                const f32x4 kkv = *(const f32x4*)(p.rwkv_k_k + po + nt * 16);
                const u32x2 c = *(const u32x2*)(Kk + ro + nt * 16);
                const float q0 = bf_lo(c[0]) * kkv[0], q1 = bf_hi(c[0]) * kkv[1], q2 = bf_lo(c[1]) * kkv[2], q3 = bf_hi(c[1]) * kkv[3];
                ssq += q0 * q0 + q1 * q1 + q2 * q2 + q3 * q3;
            }
            ssq += __shfl_xor(ssq, 16); ssq += __shfl_xor(ssq, 32);
            const float kn = __builtin_amdgcn_rsqf(fmaxf(ssq, 1e-24f));
            float* rec = ops + buf * (TB * SC_REC) + st * SC_REC + fq * 4;
            float bsum = 0.f;
#pragma unroll
            for (int n2 = 0; n2 < 2; ++n2) {
                const unsigned nt = chh * 2 + n2;
                f32x4 aw = {0.f, 0.f, 0.f, 0.f}, ai = aw;
#pragma unroll
                for (int kk = 0; kk < 2; ++kk) {
                    const bf16x8 w2f = *(const bf16x8*)(wsm + wo + nt * 1024 + kk * 32), a2f = *(const bf16x8*)(wsm + ao + nt * 1024 + kk * 32);
                    aw = __builtin_amdgcn_mfma_f32_16x16x32_bf16(w2f, lwf[kk], aw, 0, 0, 0);
                    ai = __builtin_amdgcn_mfma_f32_16x16x32_bf16(a2f, laf[kk], ai, 0, 0, 0);
                }
                const f32x4 w0v = *(const f32x4*)(p.rwkv_decay_w0 + dir * 1024u + po + nt * 16), a0v = *(const f32x4*)(p.rwkv_iclr_a0 + dir * 1024u + po + nt * 16);
                const f32x4 kkv = *(const f32x4*)(p.rwkv_k_k + po + nt * 16);
                const f32x4 kav = *(const f32x4*)(p.rwkv_k_a + po + nt * 16), rkv = *(const f32x4*)(p.rwkv_r_k + po + nt * 16);
                const u32x2 a = *(const u32x2*)(R + ro + nt * 16), c = *(const u32x2*)(Kk + ro + nt * 16);
                const f32x4 rr = {bf_lo(a[0]), bf_hi(a[0]), bf_lo(a[1]), bf_hi(a[1])};
                const f32x4 kr = {bf_lo(c[0]), bf_hi(c[0]), bf_lo(c[1]), bf_hi(c[1])};
                f32x4 wv, kd, bb, aa;
#pragma unroll
                for (int j = 0; j < 4; ++j) {
                    const float sg = __builtin_amdgcn_rcpf(1.0f + __builtin_amdgcn_exp2f(-(w0v[j] + aw[j]) * LOG2E));
                    wv[j] = __builtin_amdgcn_exp2f(sg * (-0.6065306597126334f * LOG2E));
                    const float ic = __builtin_amdgcn_rcpf(1.0f + __builtin_amdgcn_exp2f(-(a0v[j] + ai[j]) * LOG2E));
                    const float kkn = kr[j] * kkv[j] * kn;
                    kd[j] = kr[j] * (1.0f + (ic - 1.0f) * kav[j]);
                    bb[j] = kkn * ic;
                    aa[j] = -kkn;
                    bsum += rr[j] * kd[j] * rkv[j];
                }
                *(f32x4*)(rec + 0 * 64 + nt * 16) = wv;
                *(f32x4*)(rec + 1 * 64 + nt * 16) = kd;
                *(f32x4*)(rec + 2 * 64 + nt * 16) = bb;
                *(f32x4*)(rec + 3 * 64 + nt * 16) = aa;
                *(f32x4*)(rec + 4 * 64 + nt * 16) = rr;
            }
            bsum += __shfl_xor(bsum, 16); bsum += __shfl_xor(bsum, 32);
            if (rg == 0 && fq == 0) bonus[((chh * 2 + dir) * TTOT + tok) * 16u + hd] = bsum;
            if (wid == 6) {
                bf16_t vr[TB * 16 / 64];
#pragma unroll
                for (int i = 0; i < TB * 16 / 64; ++i) {
                    const unsigned id = i * 64 + lane, s2 = id >> 4, rw = id & 15;
                    const unsigned tk = tokb + scan_pos(blk * TB + s2, dir);
                    vr[i] = V[tk * 1024u + hc + rg * 16 + rw];
                }
#pragma unroll
                for (int i = 0; i < TB * 16 / 64; ++i) vbuf[buf * (TB * 16) + i * 64 + lane] = bf2f(vr[i]);
            }
            asm volatile("s_waitcnt lgkmcnt(0)" ::: "memory");
            if (lane == 0) lds_publish(cnts + (wid - 4), blk + 1);
        }
    }
    __syncthreads();
}

constexpr int CH = 16, NCHK = PTOT / CH;
constexpr int NPREP = 7, NSLOT = 2;
constexpr int TKS = 72, KTS = 20, SMS = 20;
constexpr int SL_XA = 0, SL_XR = SL_XA + 16 * TKS * 2, SL_TB = SL_XR + 16 * TKS * 2, SL_TK = SL_TB + 64 * KTS * 2, SL_TT = SL_TK + 64 * KTS * 2, SL_NAK = SL_TT + 16 * SMS * 2,
              SL_NRB = SL_NAK + 16 * SMS * 2, SL_NRK = SL_NRB + 16 * SMS * 2, SL_VT = SL_NRK + 16 * SMS * 2, SL_WC = SL_VT + 16 * SMS * 2, SLOT_BYTES = SL_WC + 64 * 4;
constexpr int XTK_B = 16 * TKS * 2, XKT_B = 64 * KTS * 2, SM_B = 16 * SMS * 2;
constexpr int PR_XA = 0, PR_XB = PR_XA + XTK_B, PR_XK = PR_XB + XTK_B, PR_XR = PR_XK + XTK_B, PR_TB = PR_XR + XTK_B, PR_TK = PR_TB + XKT_B,
              PR_SN = PR_TK + XKT_B, PREP_BYTES = PR_SN + 2 * SM_B;
static_assert(10 * SM_B <= 3 * XTK_B, "matrices fit in XA..XK");
constexpr int SC2_SMEM = NSLOT * SLOT_BYTES + NPREP * PREP_BYTES + 64 + 5 * 64 * 4;
typedef short s16x4v __attribute__((ext_vector_type(4)));
DI f32x4 mfma16(s16x4v a, s16x4v b, f32x4 c) { return __builtin_amdgcn_mfma_f32_16x16x16bf16_1k(a, b, c, 0, 0, 0); }
DI f32x4 mfma32(bf16x8 a, bf16x8 b, f32x4 c) { return __builtin_amdgcn_mfma_f32_16x16x32_bf16(a, b, c, 0, 0, 0); }
DI s16x4v ld4(const bf16_t* q) { return *(const s16x4v*)q; }
DI f32x4 up4(u32x2 w) { return (f32x4){bf_lo(w[0]), bf_hi(w[0]), bf_lo(w[1]), bf_hi(w[1])}; }
DI f32x4 ld4f(const bf16_t* q) { return up4(*(const u32x2*)q); }
DI void st4(bf16_t* q, f32x4 v) { u32x2 w; w[0] = pk_bf16(v[0], v[1]); w[1] = pk_bf16(v[2], v[3]); *(u32x2*)q = w; }
#define LDS_WAIT() asm volatile("s_waitcnt lgkmcnt(0)" ::: "memory")
template <int CTRL> DI float dpp_shr_add(float v) { return v + __builtin_bit_cast(float, __builtin_amdgcn_update_dpp(0, __builtin_bit_cast(int, v), CTRL, 0xf, 0xf, true)); }
DI float row16_prefix(float v) { v = dpp_shr_add<0x111>(v); v = dpp_shr_add<0x112>(v); v = dpp_shr_add<0x114>(v); v = dpp_shr_add<0x118>(v); return v; }
DI f32x4 mm16(const bf16_t* A, const bf16_t* Bt, int fr, int fq) {
    const s16x4v a = ld4(A + fr * SMS + fq * 4), b = ld4(Bt + fr * SMS + fq * 4);
    LDS_WAIT();
    return mfma16(a, b, (f32x4){0.f, 0.f, 0.f, 0.f});
}
DI f32x4 mm16p(const bf16_t* A, const bf16_t* Bt, const bf16_t* Add, int fr, int fq) {
    const s16x4v a = ld4(A + fr * SMS + fq * 4), b = ld4(Bt + fr * SMS + fq * 4);
    const u32x2 c = *(const u32x2*)(Add + fr * SMS + fq * 4);
    LDS_WAIT();
    return mfma16(a, b, up4(c));
}

DI void scan_unit_chunked(const Params& p, int u, char* smem) {
    const int t = tidx(), lane = t & 63, wid = __builtin_amdgcn_readfirstlane(t >> 6);
    const unsigned rg = u & 3, dir = (u >> 2) & 1, hd = (u >> 3) & 15, b = u >> 7;
    const unsigned tokb = b * PTOT, hc = hd * 64;
    const unsigned fr = lane & 15, fq = lane >> 4;
    char* slots = smem;
    char* prep0 = smem + NSLOT * SLOT_BYTES;
    int* cnts = (int*)(smem + NSLOT * SLOT_BYTES + NPREP * PREP_BYTES);
    const bf16_t* R = (const bf16_t*)(p.ws + OFF_SCR + S_R);
    const bf16_t* Kk = (const bf16_t*)(p.ws + OFF_SCR + S_KK);
    const bf16_t* V = (const bf16_t*)(p.ws + OFF_SCR + S_V);
    const bf16_t* LW = (const bf16_t*)(p.ws + OFF_SCR + S_LW);
    const bf16_t* LA = (const bf16_t*)(p.ws + OFF_SCR + S_LA);
    bf16_t* Yo = dir ? (bf16_t*)(p.ws + OFF_SCR + S_Y1) : (bf16_t*)(p.ws + OFF_H);
    float* bonus = (float*)(p.ws + OFF_BONUS2);
    float* prm = (float*)(cnts + 16);
    if (t < 16) cnts[t] = 0;
    if (t < 64) {
        prm[t] = p.rwkv_decay_w0[dir * 1024u + hc + t]; prm[64 + t] = p.rwkv_iclr_a0[dir * 1024u + hc + t];
        prm[128 + t] = p.rwkv_k_k[hc + t]; prm[192 + t] = p.rwkv_k_a[hc + t]; prm[256 + t] = p.rwkv_r_k[hc + t];
    }
    __syncthreads();

    if (wid == 0) {
        __builtin_amdgcn_s_setprio(3);
        f32x4 st[4];
#pragma unroll
        for (int m = 0; m < 4; ++m) st[m] = (f32x4){0.f, 0.f, 0.f, 0.f};
        for (int c = 0; c < NCHK; ++c) {
            const unsigned sl = (unsigned)c % NSLOT;
            const char* S = slots + sl * SLOT_BYTES;
            while (*(volatile LAS int*)(cnts + sl) < c + 1) __builtin_amdgcn_s_sleep(1);
            LDS_WAIT();
            const int so = fr * SMS + fq * 4;
            const s16x4v vt = ld4((const bf16_t*)(S + SL_VT) + so);
            const s16x4v tt = ld4((const bf16_t*)(S + SL_TT) + so);
            const s16x4v nakt = ld4((const bf16_t*)(S + SL_NAK) + so);
            const s16x4v nrbt = ld4((const bf16_t*)(S + SL_NRB) + so);
            const s16x4v nrkt = ld4((const bf16_t*)(S + SL_NRK) + so);
            s16x4v xal[2], xah[2], xrl[2], xrh[2], tb[4], tk[4];
            f32x4 wc[4];
#pragma unroll
            for (int i = 0; i < 2; ++i) {
                const bf16_t* qa = (const bf16_t*)(S + SL_XA) + fr * TKS + 32 * i + fq * 4; xal[i] = ld4(qa); xah[i] = ld4(qa + 16);
                const bf16_t* qr = (const bf16_t*)(S + SL_XR) + fr * TKS + 32 * i + fq * 4; xrl[i] = ld4(qr); xrh[i] = ld4(qr + 16);
            }
#pragma unroll
            for (int m = 0; m < 4; ++m) {
                wc[m] = *(const f32x4*)((const float*)(S + SL_WC) + 16 * m + fq * 4);
                tb[m] = ld4((const bf16_t*)(S + SL_TB) + (16 * m + fr) * KTS + fq * 4);
                tk[m] = ld4((const bf16_t*)(S + SL_TK) + (16 * m + fr) * KTS + fq * 4);
            }
            LDS_WAIT();
            bf16x8 sb[2];
#pragma unroll
            for (int i = 0; i < 2; ++i) {
                u32x4 w; w[0] = pk_bf16(st[2 * i][0], st[2 * i][1]); w[1] = pk_bf16(st[2 * i][2], st[2 * i][3]); w[2] = pk_bf16(st[2 * i + 1][0], st[2 * i + 1][1]); w[3] = pk_bf16(st[2 * i + 1][2], st[2 * i + 1][3]);
                sb[i] = __builtin_bit_cast(bf16x8, w);
            }
            f32x4 z = {0.f, 0.f, 0.f, 0.f};
#pragma unroll
            for (int i = 0; i < 2; ++i) z = mfma32(__builtin_shufflevector(xal[i], xah[i], 0, 1, 2, 3, 4, 5, 6, 7), sb[i], z);
            z = mfma16(nakt, vt, z);
            u32x2 zw; zw[0] = pk_bf16(z[0], z[1]); zw[1] = pk_bf16(z[2], z[3]);
            const f32x4 uu = mfma16(tt, __builtin_bit_cast(s16x4v, zw), (f32x4){0.f, 0.f, 0.f, 0.f});
            u32x2 uw; uw[0] = pk_bf16(uu[0], uu[1]); uw[1] = pk_bf16(uu[2], uu[3]);
            const s16x4v ub = __builtin_bit_cast(s16x4v, uw);
            f32x4 y = {0.f, 0.f, 0.f, 0.f};
#pragma unroll
            for (int i = 0; i < 2; ++i) y = mfma32(__builtin_shufflevector(xrl[i], xrh[i], 0, 1, 2, 3, 4, 5, 6, 7), sb[i], y);
            y = mfma16(nrkt, vt, y);
            y = mfma16(nrbt, ub, y);
#pragma unroll
            for (int m = 0; m < 4; ++m) {
                f32x4 acc = mfma16(tk[m], vt, st[m]);
                acc = mfma16(tb[m], ub, acc);
                st[m] = acc * wc[m];
            }

#pragma unroll
            for (int j = 0; j < 4; ++j) {
                const unsigned tok = tokb + scan_pos(c * CH + fq * 4 + j, dir);
                Yo[tok * 1024u + hc + rg * 16 + fr] = (bf16_t)(pk_bf16(y[j], 0.f) & 0xffffu);
            }
            asm volatile("" ::: "memory");
            if (lane == 0) *(volatile LAS int*)(cnts + 8) = c + 1;
        }
        __builtin_amdgcn_s_setprio(0);
    } else {
        const unsigned pid = wid - 1;
        char* PS = prep0 + pid * PREP_BYTES;
        bf16_t* XA = (bf16_t*)(PS + PR_XA); bf16_t* XB = (bf16_t*)(PS + PR_XB); bf16_t* XK = (bf16_t*)(PS + PR_XK); bf16_t* XR = (bf16_t*)(PS + PR_XR);
        bf16_t* TB_ = (bf16_t*)(PS + PR_TB); bf16_t* TK = (bf16_t*)(PS + PR_TK);
        bf16_t* SN = (bf16_t*)(PS + PR_SN);
        bf16_t *M = SN, *NABR = SN + 1 * 16 * SMS;
        bf16_t *M2 = XA, *M2T = XA + 1 * 16 * SMS, *M4 = XA + 2 * 16 * SMS, *M4T = XA + 3 * 16 * SMS, *X1 = XA + 4 * 16 * SMS, *G1 = XA + 5 * 16 * SMS, *NAKR = XA + 6 * 16 * SMS,
                *NRBT = XA + 7 * 16 * SMS, *NRKT = XA + 8 * 16 * SMS, *IM = XA + 9 * 16 * SMS;
        bf16_t *M8T = M2, *X2 = M2T, *TT = M4;
        float* WCP = (float*)SN;
        const bf16_t* wsm = (const bf16_t*)(p.ws + OFF_WS);
        const unsigned wo = W_W2 + dir * 65536u + (hc + fr) * 64u + fq * 8u;
        const unsigned ao = W_A2 + dir * 65536u + (hc + fr) * 64u + fq * 8u;
        const unsigned po = hc + fq * 4u;
        const f32x4 z4 = {0.f, 0.f, 0.f, 0.f};
        bf16x8 lwf[2], laf[2];
        u32x2 krw[4], rrw[4];
        unsigned tok_cur = 0;
        auto issue = [&](int c, bf16x8 (&lw)[2], bf16x8 (&la)[2], u32x2 (&kw)[4], u32x2 (&rw)[4], unsigned& tk) {
            tk = tokb + scan_pos(c * CH + fr, dir);
            const unsigned lo = tk * 128u + dir * 64u + fq * 8u, ro = tk * 1024u + hc + fq * 4u;
#pragma unroll
            for (int kk = 0; kk < 2; ++kk) { lw[kk] = *(const bf16x8*)(LW + lo + kk * 32); la[kk] = *(const bf16x8*)(LA + lo + kk * 32); }
#pragma unroll
            for (int nt = 0; nt < 4; ++nt) { kw[nt] = *(const u32x2*)(Kk + ro + nt * 16); rw[nt] = *(const u32x2*)(R + ro + nt * 16); }
        };
        if ((int)pid < NCHK) issue(pid, lwf, laf, krw, rrw, tok_cur);
#pragma unroll
        for (int kk = 0; kk < 2; ++kk) asm volatile("" : "+v"(lwf[kk]), "+v"(laf[kk]));
#pragma unroll
        for (int nt = 0; nt < 4; ++nt) asm volatile("" : "+v"(krw[nt]), "+v"(rrw[nt]));
        auto ldw = [&](bf16x8 (&w)[2][2], int nt) {
#pragma unroll
            for (int kk = 0; kk < 2; ++kk) { w[0][kk] = *(const bf16x8*)(wsm + wo + nt * 1024 + kk * 32); w[1][kk] = *(const bf16x8*)(wsm + ao + nt * 1024 + kk * 32); }
        };
        for (int c = pid; c < NCHK; c += NPREP) {
            bf16x8 wq[2][2], wn[2][2];
            ldw(wq, 0);
            const unsigned tok = tok_cur;
            float ssq = 0.f;
#pragma unroll
            for (int nt = 0; nt < 4; ++nt) {
                const f32x4 kkv = *(const f32x4*)(prm + 128 + fq * 4 + nt * 16);
                const f32x4 q = up4(krw[nt]) * kkv;
                ssq += q[0] * q[0] + q[1] * q[1] + q[2] * q[2] + q[3] * q[3];
            }
            ssq += __shfl_xor(ssq, 16); ssq += __shfl_xor(ssq, 32);
            const float kn = __builtin_amdgcn_rsqf(fmaxf(ssq, 1e-24f));
            float bsum = 0.f;
#pragma unroll
            for (int nt = 0; nt < 4; ++nt) {
                f32x4 aw = z4, ai = z4;
                if (nt < 3) ldw(wn, nt + 1);
                __builtin_amdgcn_sched_barrier(0);
#pragma unroll
                for (int kk = 0; kk < 2; ++kk) {
                    aw = mfma32(wq[0][kk], lwf[kk], aw);
                    ai = mfma32(wq[1][kk], laf[kk], ai);
                }
                if (nt < 3) {
#pragma unroll
                    for (int kk = 0; kk < 2; ++kk) { wq[0][kk] = wn[0][kk]; wq[1][kk] = wn[1][kk]; }
                }
                const f32x4 w0v = *(const f32x4*)(prm + fq * 4 + nt * 16), a0v = *(const f32x4*)(prm + 64 + fq * 4 + nt * 16);
                const f32x4 kkv = *(const f32x4*)(prm + 128 + fq * 4 + nt * 16);
                const f32x4 kav = *(const f32x4*)(prm + 192 + fq * 4 + nt * 16), rkv = *(const f32x4*)(prm + 256 + fq * 4 + nt * 16);
                LDS_WAIT();
                const f32x4 rr = up4(rrw[nt]), krn4 = up4(krw[nt]);
                const f32x4 x1 = (w0v + aw) * (-LOG2E), x2 = (a0v + ai) * (-LOG2E);
                f32x4 ex1, ex2;
#pragma unroll
                for (int j = 0; j < 4; ++j) { ex1[j] = __builtin_amdgcn_exp2f(x1[j]); ex2[j] = __builtin_amdgcn_exp2f(x2[j]); }
                ex1 = ex1 + 1.0f; ex2 = ex2 + 1.0f;
                f32x4 sg, ic;
#pragma unroll
                for (int j = 0; j < 4; ++j) { sg[j] = __builtin_amdgcn_rcpf(ex1[j]); ic[j] = __builtin_amdgcn_rcpf(ex2[j]); }
                const f32x4 e2 = sg * (0.6065306597126334f * LOG2E);
                const f32x4 kkn = krn4 * kkv * kn;
                const f32x4 kd = krn4 * ((ic - 1.0f) * kav + 1.0f);
                { const f32x4 bq = rr * kd * rkv; bsum += (bq[0] + bq[1]) + (bq[2] + bq[3]); }
                f32x4 wt, wi, wp;
#pragma unroll
                for (int j = 0; j < 4; ++j) {
                    const float ec = row16_prefix(e2[j]);
                    wt[j] = __builtin_amdgcn_exp2f(-ec);
                    wi[j] = __builtin_amdgcn_exp2f(ec);
                    wp[j] = __builtin_amdgcn_exp2f(e2[j] - ec);
                }
                const f32x4 at = -(kkn * wp), rt = rr * wt, bt = kkn * ic * wi, kt = kd * wi;
                {
                    u32x2 wa, wb, wk;
                    wa[0] = pk_bf16(at[0], at[1]); wa[1] = pk_bf16(at[2], at[3]); wb[0] = pk_bf16(bt[0], bt[1]); wb[1] = pk_bf16(bt[2], bt[3]);
                    wk[0] = pk_bf16(kt[0], kt[1]); wk[1] = pk_bf16(kt[2], kt[3]);
                    *(u32x2*)(XA + fr * TKS + nt * 16 + fq * 4) = wa; *(u32x2*)(XB + fr * TKS + nt * 16 + fq * 4) = wb; *(u32x2*)(XK + fr * TKS + nt * 16 + fq * 4) = wk;
                    const unsigned o = (nt * 16 + fq * 4) * KTS + fr;
#pragma unroll
                    for (int j = 0; j < 4; ++j) {
                        TB_[o + j * KTS] = (bf16_t)((j & 1) ? (wb[j >> 1] >> 16) : (wb[j >> 1] & 0xffffu));
                        TK[o + j * KTS] = (bf16_t)((j & 1) ? (wk[j >> 1] >> 16) : (wk[j >> 1] & 0xffffu));
                    }
                }
                if (fr == 15) *(f32x4*)(WCP + nt * 16 + fq * 4) = wt;
                st4(XR + fr * TKS + nt * 16 + fq * 4, rt);
            }
            bsum += __shfl_xor(bsum, 16); bsum += __shfl_xor(bsum, 32);
            if (rg == 0 && fq == 0) { bonus[((0 * 2 + dir) * TTOT + tok) * 16u + hd] = bsum; bonus[((1 * 2 + dir) * TTOT + tok) * 16u + hd] = 0.f; }
            if (c + NPREP < NCHK) issue(c + NPREP, lwf, laf, krw, rrw, tok_cur);
            unsigned vv[2][2];
#pragma unroll
            for (int i = 0; i < 2; ++i) {
                const unsigned q = i * 64 + lane, vrow = q & 15, sp = q >> 4;
                const unsigned tk0 = tokb + scan_pos(c * CH + 2 * sp, dir), tk1 = tokb + scan_pos(c * CH + 2 * sp + 1, dir);
                vv[i][0] = V[tk0 * 1024u + hc + rg * 16 + vrow]; vv[i][1] = V[tk1 * 1024u + hc + rg * 16 + vrow];
            }
            LDS_WAIT();
            float wcr[4];
#pragma unroll
            for (int n = 0; n < 4; ++n) wcr[n] = WCP[16 * n + fr];
            bf16x8 fa[2], fb[2], fk[2], frr[2];
#pragma unroll
            for (int kk = 0; kk < 2; ++kk) {
                fa[kk] = *(const bf16x8*)(XA + fr * TKS + kk * 32 + fq * 8); fb[kk] = *(const bf16x8*)(XB + fr * TKS + kk * 32 + fq * 8);
                fk[kk] = *(const bf16x8*)(XK + fr * TKS + kk * 32 + fq * 8); frr[kk] = *(const bf16x8*)(XR + fr * TKS + kk * 32 + fq * 8);
            }
            LDS_WAIT();
            f32x4 d1 = z4, d2 = z4, d3 = z4, d4 = z4, d5 = z4;
#pragma unroll
            for (int kk = 0; kk < 2; ++kk) {
                d1 = mfma32(fb[kk], fa[kk], d1);
                d2 = mfma32(fa[kk], fb[kk], d2);
                d3 = mfma32(fk[kk], fa[kk], d3);
                d4 = mfma32(fb[kk], frr[kk], d4);
                d5 = mfma32(fk[kk], frr[kk], d5);
            }
            f32x4 im;
#pragma unroll
            for (int j = 0; j < 4; ++j) {
                const unsigned ij = fq * 4 + j;
                d1[j] = ij < fr ? d1[j] : 0.f;
                d2[j] = fr < ij ? d2[j] : 0.f;
                d3[j] = ij < fr ? d3[j] : 0.f;
                d4[j] = ij <= fr ? d4[j] : 0.f;
                d5[j] = ij <= fr ? d5[j] : 0.f;
                im[j] = d1[j] + (ij == fr ? 1.0f : 0.f);
            }
            st4(M + fr * SMS + fq * 4, d1);
            st4(IM + fr * SMS + fq * 4, im);
            st4(NABR + fr * SMS + fq * 4, d2);
            st4(NAKR + fr * SMS + fq * 4, d3);
            st4(NRBT + fr * SMS + fq * 4, d4);
            st4(NRKT + fr * SMS + fq * 4, d5);
            LDS_WAIT();
            const int so = fr * SMS + fq * 4;
            {
                const s16x4v m = ld4(M + so), mt = ld4(NABR + so);
                LDS_WAIT();
                st4(M2T + so, mfma16(m, mt, z4)); st4(M2 + so, mfma16(mt, m, z4));
                LDS_WAIT();
            }
            {
                const s16x4v m2 = ld4(M2 + so), m2t = ld4(M2T + so); const u32x2 imr = *(const u32x2*)(IM + so);
                LDS_WAIT();
                st4(M4T + so, mfma16(m2, m2t, z4)); st4(M4 + so, mfma16(m2t, m2, z4));
                st4(X1 + so, mfma16(m2t, __builtin_bit_cast(s16x4v, imr), up4(imr)));
                LDS_WAIT();
            }
            {
                const s16x4v m4 = ld4(M4 + so), m4t = ld4(M4T + so); const u32x2 x1r = *(const u32x2*)(X1 + so);
                LDS_WAIT();
                st4(M8T + so, mfma16(m4, m4t, z4));
                st4(X2 + so, mfma16(m4t, __builtin_bit_cast(s16x4v, x1r), up4(x1r)));
                LDS_WAIT();
            }
            {
                const s16x4v m8t = ld4(M8T + so); const u32x2 x2r = *(const u32x2*)(X2 + so);
                LDS_WAIT();
                st4(TT + so, mfma16(m8t, __builtin_bit_cast(s16x4v, x2r), up4(x2r)));
                LDS_WAIT();
            }
            const unsigned sl = (unsigned)c % NSLOT;
            char* S = slots + sl * SLOT_BYTES;
            {
                const s16x4v ta = ld4(TT + so), nak = ld4(NAKR + so), nrb = ld4(NRBT + so), nrk = ld4(NRKT + so);
                s16x4v tb[4], tk[4]; u32x2 xr[4];
#pragma unroll
                for (int m = 0; m < 4; ++m) {
                    tb[m] = ld4(TB_ + (16 * m + fr) * KTS + fq * 4); tk[m] = ld4(TK + (16 * m + fr) * KTS + fq * 4);
                    xr[m] = *(const u32x2*)(XR + fr * TKS + 16 * m + fq * 4);
                }
                LDS_WAIT();
                while (*(volatile LAS int*)(cnts + 8) < c - NSLOT + 1) __builtin_amdgcn_s_sleep(1);
                asm volatile("" ::: "memory");
                *(s16x4v*)((bf16_t*)(S + SL_TT) + so) = ta; *(s16x4v*)((bf16_t*)(S + SL_NAK) + so) = nak;
                *(s16x4v*)((bf16_t*)(S + SL_NRB) + so) = nrb; *(s16x4v*)((bf16_t*)(S + SL_NRK) + so) = nrk;
#pragma unroll
                for (int kk = 0; kk < 2; ++kk) *(bf16x8*)((bf16_t*)(S + SL_XA) + fr * TKS + kk * 32 + fq * 8) = fa[kk];
#pragma unroll
                for (int m = 0; m < 4; ++m) {
                    *(u32x2*)((bf16_t*)(S + SL_XR) + fr * TKS + 16 * m + fq * 4) = xr[m];
                    *(s16x4v*)((bf16_t*)(S + SL_TB) + (16 * m + fr) * KTS + fq * 4) = tb[m];
                    *(s16x4v*)((bf16_t*)(S + SL_TK) + (16 * m + fr) * KTS + fq * 4) = tk[m];
                }
                ((float*)(S + SL_WC))[lane] = (fq == 0) ? wcr[0] : (fq == 1) ? wcr[1] : (fq == 2) ? wcr[2] : wcr[3];
#pragma unroll
                for (int i = 0; i < 2; ++i) {
                    const unsigned q = i * 64 + lane, vrow = q & 15, sp = q >> 4;
                    *(unsigned*)((bf16_t*)(S + SL_VT) + vrow * SMS + 2 * sp) = vv[i][0] | (vv[i][1] << 16);
                }
            }
            LDS_WAIT();
            if (lane == 0) *(volatile LAS int*)(cnts + sl) = c + 1;
        }
    }
    __syncthreads();
}

DI void phase_scan(const Params& p, char* smem) {
    for (int u = blockIdx.x; u < NBATCH * 16 * 2 * 4; u += gridDim.x) scan_unit_chunked(p, u, smem);
}

constexpr int NPHASE = 18;
constexpr int cmax_(int a, int b) { return a > b ? a : b; }
constexpr int SMEM_BYTES = cmax_(cmax_(SC2_SMEM, SC_SMEM), cmax_(GEMM_SMEM + 4096, G8_SMEM)) + 64;
static_assert(SMEM_BYTES >= GEMM_SMEM + 4096 + 64 && SMEM_BYTES >= G8_SMEM + 64 && SMEM_BYTES + 16 <= 163840, "LDS");
template <int PH> DI void run_phase(const Params& p, char* smem) {
    if constexpr (PH == 0) phase_prologue(p, smem);
    else if constexpr (PH == 1) phase_norm0(p);
    else if constexpr (PH == 2) phase_qkv(p, smem);
    else if constexpr (PH == 3) phase_attn(p, smem);
    else if constexpr (PH == 4) phase_wout(p, smem);
    else if constexpr (PH == 5) phase_ffn_norm_route(p, 0, smem);
    else if constexpr (PH == 6) phase_moe1(p, 0, smem);
    else if constexpr (PH == 7) phase_moe2(p, 0, smem);
    else if constexpr (PH == 8) phase_combine_l0(p, smem);
    else if constexpr (PH == 9) phase_xx(p);
    else if constexpr (PH == 10) phase_rwkv_proj(p, smem);
    else if constexpr (PH == 11) phase_scan(p, smem);
    else if constexpr (PH == 12) phase_gate(p, smem);
    else if constexpr (PH == 13) phase_wo(p, smem);
    else if constexpr (PH == 14) phase_ffn_norm_route(p, 1, smem);
    else if constexpr (PH == 15) phase_moe1(p, 1, smem);
    else if constexpr (PH == 16) phase_moe2(p, 1, smem);
    else if constexpr (PH == 17) phase_final(p);
}
template <int PH, int END> struct PhaseSeq {
    static DI void run(const Params& p, char* smem, const XcdBarrier& bar) {
        run_phase<PH>(p, smem);
        if constexpr (PH + 1 < END) { xcd_barrier(bar); PhaseSeq<PH + 1, END>::run(p, smem, bar); }
    }
};
template <int BEG, int END>
__global__ void __launch_bounds__(NTH, 2) fwd_kernel(Params p) {
    extern __shared__ __attribute__((aligned(16))) char smem_raw[];
    char* smem = smem_raw + 16;
    if constexpr (END - BEG > 1) {
        if (tidx() == 0) *(uint4*)smem_raw = make_uint4(0u, 0u, 0u, 0u);
        __syncthreads();
        XcdBarrier bar = xcd_barrier_post((unsigned*)(p.ws + OFF_BAR), (volatile LAS unsigned*)smem_raw);
        PhaseSeq<BEG, END>::run(p, smem, bar);
    } else {
        run_phase<BEG>(p, smem);
    }
}

template <int BEG, int END> static void launch_range(const Params& p, int grid, hipStream_t stream) {
    (void)hipFuncSetAttribute((const void*)fwd_kernel<BEG, END>, hipFuncAttributeMaxDynamicSharedMemorySize, SMEM_BYTES + 16);
    hipLaunchKernelGGL((fwd_kernel<BEG, END>), dim3(grid), dim3(NTH), SMEM_BYTES + 16, stream, p);
}
#ifndef RUN_PHASES
#define RUN_PHASES NPHASE
#endif
#ifndef REPEAT_PHASE
#define REPEAT_PHASE -1
#endif
template <int PH> static void launch_each(const Params& p, int grid, hipStream_t stream) {
    launch_range<PH, PH + 1>(p, grid, stream);
    if (PH == REPEAT_PHASE) launch_range<PH, PH + 1>(p, grid, stream);
    if constexpr (PH + 1 < RUN_PHASES) launch_each<PH + 1>(p, grid, stream);
}

extern "C" void kernel_launch(void* const* d_in, const int* in_sizes, int n_in, void* d_out, int out_size, void* d_ws, size_t ws_size, hipStream_t stream) {
    Params p{};
    const float** f = (const float**)&p;
    for (int i = 0; i < 37; ++i) f[i] = (const float*)d_in[i];
    p.out = (float*)d_out;
    p.ws = (char*)d_ws;
    if (ws_size < WS_NEED || n_in < 37) return;
    static int grid = 0;
    if (!grid) {
        int dev = 0, cus = 0;
        (void)hipGetDevice(&dev);
        (void)hipDeviceGetAttribute(&cus, hipDeviceAttributeMultiprocessorCount, dev);
        grid = cus > 0 ? cus : 256;
    }
    (void)hipMemsetAsync(d_ws, 0, 32768, stream);
#if MEGA
    launch_range<0, NPHASE>(p, grid, stream);
#else
    launch_each<0>(p, grid, stream);
#endif
}
```

```cpp
#include <hip/hip_runtime.h>
#include <stdint.h>
#include <stdio.h>

#ifndef MEGA
#define MEGA 1
#endif

typedef unsigned short bf16_t;
typedef short bf16x8 __attribute__((ext_vector_type(8)));
typedef short s16x4 __attribute__((ext_vector_type(4)));
typedef float f32x2 __attribute__((ext_vector_type(2)));
typedef float f32x4 __attribute__((ext_vector_type(4)));
typedef float f32x16 __attribute__((ext_vector_type(16)));
typedef unsigned u32x2 __attribute__((ext_vector_type(2)));
typedef unsigned u32x4 __attribute__((ext_vector_type(4)));
typedef __bf16 bf16x2_t __attribute__((ext_vector_type(2)));
#define DI __device__ __forceinline__
__device__ __forceinline__ unsigned tidx() { unsigned t = threadIdx.x; asm volatile("" : "+v"(t)); return t; }

constexpr int DM = 1024, NBATCH = 2, SEQ = 16384, LCTX = 256, PTOT = SEQ + LCTX, TTOT = NBATCH * PTOT;
constexpr int NTH = 512, NWAVE = 8;
constexpr int QKV_N = 1536;
constexpr int NEXP = 16, CAP = TTOT * 2;
constexpr float RMS_EPS = 1e-6f, GN_EPS = 64e-5f;
constexpr float LOG2E = 1.4426950408889634f;

constexpr size_t MBy = 1u << 20;
constexpr size_t OFF_BAR   = 0;
constexpr size_t OFF_CNT   = 16384;
constexpr size_t OFF_MOD   = 32768;
constexpr size_t OFF_ROPE  = OFF_MOD + 2 * 3 * 6144 * 4;
constexpr size_t OFF_BONUS = 1 * MBy;
constexpr size_t OFF_BONUS2 = 6 * MBy;
constexpr size_t OFF_STOK  = 6 * MBy;
constexpr size_t OFF_SW    = 11 * MBy;
constexpr size_t OFF_XC    = 16 * MBy;
constexpr size_t OFF_WS    = 18 * MBy;
constexpr size_t OFF_MOEW  = 33 * MBy;
constexpr size_t OFF_H     = 129 * MBy;
constexpr size_t OFF_SCR   = 194 * MBy;
constexpr size_t SCR_SIZE  = 290 * MBy;
constexpr size_t WS_NEED   = OFF_SCR + SCR_SIZE;
constexpr size_t W_IN = 0, W_OUT = W_IN + 1536 * 1024, W_R = W_OUT + 1024 * 1024, W_K = W_R + 1024 * 1024, W_V = W_K + 1024 * 1024,
                 W_O = W_V + 1024 * 1024, W_W1 = W_O + 1024 * 1024, W_A1 = W_W1 + 128 * 1024, W_G1 = W_A1 + 128 * 1024,
                 W_W2 = W_G1 + 256 * 1024, W_A2 = W_W2 + 2 * 1024 * 64, W_G2 = W_A2 + 2 * 1024 * 64, W_END = W_G2 + 1024 * 192;
static_assert(W_END * 2 <= 15 * MBy, "small weights region");
constexpr size_t ROWB = (size_t)TTOT * 2048;
constexpr size_t S_Q = 0, S_K = S_Q + ROWB, S_VT = S_K + ROWB / 4, S_O = S_VT + ROWB / 4;
constexpr size_t S_HID = 0, S_Y = 140 * MBy;
constexpr size_t S_R = 0, S_KK = S_R + ROWB, S_V = S_KK + ROWB, S_LW = S_V + ROWB, S_LA = S_LW + ROWB / 8, S_LG = S_LA + ROWB / 8,
                 S_Y1 = 224 * MBy, S_XX = S_Y1, S_OR = S_R;
static_assert(S_O + ROWB <= SCR_SIZE, "scr");
static_assert(S_LG + (size_t)TTOT * 384 <= S_Y1, "scr2");
static_assert(S_Y1 + ROWB <= SCR_SIZE, "scr3");
static_assert(S_Y + 2 * ROWB <= SCR_SIZE, "scr4");
static_assert((size_t)(CAP / 256 + 16) * 256 * 2048 <= S_Y, "hid");
static_assert(OFF_H + ROWB <= OFF_SCR, "h");

struct Params {
    const float *x, *c, *ctx, *c_ctx, *ada_w, *ada_b, *norm_mix_g, *norm_ffn_g, *attn_w_in, *attn_w_out, *attn_sink, *attn_q_norm_g, *attn_k_norm_g,
        *rwkv_x_mix, *rwkv_w_r, *rwkv_w_k, *rwkv_w_v, *rwkv_w_o, *rwkv_decay_w0, *rwkv_decay_w1, *rwkv_decay_w2, *rwkv_iclr_a0, *rwkv_iclr_a1,
        *rwkv_iclr_a2, *rwkv_gate_g1, *rwkv_gate_g2, *rwkv_k_k, *rwkv_k_a, *rwkv_r_k, *rwkv_ln_g, *rwkv_ln_b, *router_w, *router_bias, *moe_w1,
        *moe_w3, *moe_w2, *final_norm_g;
    float* out;
    char* ws;
};

DI unsigned pk_bf16(float a, float b) { f32x2 v = {a, b}; bf16x2_t r = __builtin_convertvector(v, bf16x2_t); return __builtin_bit_cast(unsigned, r); }
DI float bf_lo(unsigned u) { return __uint_as_float(u << 16); }
DI float bf_hi(unsigned u) { return __uint_as_float(u & 0xffff0000u); }
DI float bf2f(bf16_t u) { return __uint_as_float(((unsigned)u) << 16); }
DI float wave_sum(float v) {
#pragma unroll
    for (int o = 32; o >= 1; o >>= 1) v += __shfl_xor(v, o);
    return v;
}
DI float sigmoidf_(float x) { return __builtin_amdgcn_rcpf(1.0f + __builtin_amdgcn_exp2f(x * -LOG2E)); }
DI float siluf_(float x) { return x * __builtin_amdgcn_rcpf(1.0f + __builtin_amdgcn_exp2f(x * -LOG2E)); }
struct PLite { const float *x, *ctx, *qg, *kg; float* out; char* ws; };
DI PLite plite(const Params& p) { return PLite{p.x, p.ctx, p.attn_q_norm_g, p.attn_k_norm_g, p.out, p.ws}; }
template <class P> DI float* xrow_ptr(const P& p, int tok) {
    const int b = tok >= PTOT ? 1 : 0, pos = tok - b * PTOT;
    return pos < LCTX ? (float*)(p.ws + OFF_XC) + (size_t)(b * LCTX + pos) * DM : p.out + (size_t)(b * SEQ + pos - LCTX) * DM;
}
template <class P> DI const float* xin_ptr(const P& p, int tok) {
    const int b = tok >= PTOT ? 1 : 0, pos = tok - b * PTOT;
    return pos < LCTX ? p.ctx + (size_t)(b * LCTX + pos) * DM : p.x + (size_t)(b * SEQ + pos - LCTX) * DM;
}
template <class P> DI const float* mod_ptr(const P& p, int layer, int tok, int which) {
    const int b = tok >= PTOT ? 1 : 0, pos = tok - b * PTOT;
    const int w = pos < LCTX ? 2 : b;
    return (const float*)(p.ws + OFF_MOD) + (size_t)((layer * 3 + w) * 6 + which) * DM;
}

#define XB_TMO      128
#define XB_XCNT(j)  (256  + 64 * (j))
#define XB_XSUB(j)  (1280 + 64 * (j))
#define XB_XGEN(j)  (2304 + 64 * (j))
#define XB_TOP      3328
#define XB_TOPGEN   3392
#define XCD_BAR_WORDS 3456
#define XB_SPIN_CAP (1u << 18)
#define LAS __attribute__((address_space(3)))
DI unsigned xb_ld(unsigned* p)              { return __hip_atomic_load(p, __ATOMIC_RELAXED, __HIP_MEMORY_SCOPE_AGENT); }
DI unsigned xb_add(unsigned* p, unsigned v) { return __hip_atomic_fetch_add(p, v, __ATOMIC_RELAXED, __HIP_MEMORY_SCOPE_AGENT); }
DI unsigned xb_xcc_id() { return (unsigned)__builtin_amdgcn_s_getreg((3 << 11) | 20) & 0xFu; }
#define XB_SPIN(cond, bar) do { unsigned _sp = 0; while (cond) { __builtin_amdgcn_s_sleep(1); \
    if ((++_sp & 255u) == 0u) { if (xb_ld(&(bar)[XB_TMO])) break; if (_sp > XB_SPIN_CAP) { atomicAdd(&(bar)[XB_TMO], 1u); break; } } } } while (0)
struct XcdBarrier { unsigned* bar; unsigned x; volatile LAS unsigned* st; };
DI XcdBarrier xcd_barrier_post(unsigned* bar, volatile LAS unsigned* st) {
    XcdBarrier b; b.bar = bar; b.x = xb_xcc_id(); b.st = st;
    if (tidx() == 0) (void)xb_add(&bar[XB_XCNT(b.x)], 1u);
    return b;
}
DI void xcd_barrier_complete(unsigned* bar, unsigned x, unsigned& nloc, unsigned& nx) {
    const unsigned G = gridDim.x * gridDim.y * gridDim.z;
    unsigned sum, cnt, mine, sp = 0u;
    for (;;) {
        sum = 0u; cnt = 0u; mine = 0u;
#pragma unroll
        for (unsigned j = 0; j < 16; ++j) { const unsigned c = xb_ld(&bar[XB_XCNT(j)]); sum += c; cnt += (c > 0u) ? 1u : 0u; mine = (j == x) ? c : mine; }
        if (sum == G) break;
        __builtin_amdgcn_s_sleep(1);
        if ((++sp & 255u) == 0u) { if (xb_ld(&bar[XB_TMO])) break; if (sp > XB_SPIN_CAP) { atomicAdd(&bar[XB_TMO], 1u); break; } }
    }
    nloc = mine > 0u ? mine : 1u; nx = cnt > 0u ? cnt : 1u;
}
DI void xcd_barrier(const XcdBarrier& b) {
    asm volatile("s_waitcnt vmcnt(0)" ::: "memory");
    __syncthreads();
    if (tidx() == 0) {
        unsigned* bar = b.bar;
        __builtin_amdgcn_s_waitcnt(0);
        unsigned nloc = b.st[0], nx = b.st[1];
        if (nloc == 0u) { xcd_barrier_complete(bar, b.x, nloc, nx); b.st[0] = nloc; b.st[1] = nx; }
        const unsigned old = xb_add(&bar[XB_XSUB(b.x)], 1u);
        const unsigned gen = old / nloc;
        if (old + 1u == (gen + 1u) * nloc) {
            __builtin_amdgcn_fence(__ATOMIC_RELEASE, "agent");
            asm volatile("s_waitcnt vmcnt(0)" ::: "memory");
            const unsigned og = xb_add(&bar[XB_TOP], 1u);
            const unsigned tg = og / nx;
            if (og + 1u == (tg + 1u) * nx) xb_add(&bar[XB_TOPGEN], 1u);
            else XB_SPIN(xb_ld(&bar[XB_TOPGEN]) == tg, bar);
            __builtin_amdgcn_fence(__ATOMIC_ACQUIRE, "agent");
            xb_add(&bar[XB_XGEN(b.x)], 1u);
            asm volatile("s_waitcnt vmcnt(0)" ::: "memory");
        } else {
            XB_SPIN(xb_ld(&bar[XB_XGEN(b.x)]) == gen, bar);
            __builtin_amdgcn_fence(__ATOMIC_ACQUIRE, "agent");
            asm volatile("s_waitcnt vmcnt(0)" ::: "memory");
        }
    }
    __syncthreads();
}

struct CvtDesc { const float* src; bf16_t* dst; int ld, kvalid, dld; bool colvalid; };
DI CvtDesc cvt_tile(const float* src, int ld, int kvalid, bool colvalid, bf16_t* dst, int dld) { return CvtDesc{src, dst, ld, kvalid, dld, colvalid}; }
constexpr int CV_NB = 8;
template <class F>
DI void cvt_run(int nunits, F desc_of, float* tiles) {
    const int t = tidx();
    for (int i0 = 0;; i0 += CV_NB) {
        if ((int)blockIdx.x + (int)gridDim.x * i0 >= nunits) break;
        f32x4 v[CV_NB];
#pragma unroll
        for (int b = 0; b < CV_NB; ++b) {
            const int u = (int)blockIdx.x + (int)gridDim.x * (i0 + b);
            v[b] = (f32x4){0.f, 0.f, 0.f, 0.f};
            if (u < nunits) {
                const CvtDesc d = desc_of(u);
                const int k = t >> 3, c4 = (t & 7) * 4;
                if (d.colvalid && k < d.kvalid) v[b] = *(const f32x4*)(d.src + (size_t)k * d.ld + c4);
            }
        }
#pragma unroll
        for (int b = 0; b < CV_NB; ++b) {
            float* tile = tiles + b * 64 * 33;
            const int k = t >> 3, c4 = (t & 7) * 4;
            tile[k * 33 + c4 + 0] = v[b][0]; tile[k * 33 + c4 + 1] = v[b][1]; tile[k * 33 + c4 + 2] = v[b][2]; tile[k * 33 + c4 + 3] = v[b][3];
        }
        __syncthreads();
#pragma unroll
        for (int b = 0; b < CV_NB; ++b) {
            const int u = (int)blockIdx.x + (int)gridDim.x * (i0 + b);
            if (u < nunits) {
                const CvtDesc d = desc_of(u);
                const float* tile = tiles + b * 64 * 33;
                const int n = t >> 4, kc = (t & 15) * 4;
                u32x2 w;
                w[0] = pk_bf16(tile[(kc + 0) * 33 + n], tile[(kc + 1) * 33 + n]);
                w[1] = pk_bf16(tile[(kc + 2) * 33 + n], tile[(kc + 3) * 33 + n]);
                *(u32x2*)(d.dst + (size_t)n * d.dld + kc) = w;
            }
        }
        __syncthreads();
    }
}
constexpr int CV_SMALL_UNITS = 768 + 512 * 5 + 64 + 64 + 128 + 64 + 64 + 96;
DI CvtDesc cvt_small_unit(const Params& p, int u) {
    bf16_t* wsm = (bf16_t*)(p.ws + OFF_WS);
    if (u < 768) { const int run = u >> 4, kt = u & 15; return cvt_tile(p.attn_w_in + (size_t)kt * 64 * 1536 + run * 32, 1536, 64, true, wsm + W_IN + (size_t)run * 32 * 1024 + kt * 64, 1024); }
    u -= 768;
    if (u < 512 * 5) {
        const int j = u >> 9, v = u & 511, run = v >> 4, kt = v & 15;
        const float* src = j == 0 ? p.attn_w_out : j == 1 ? p.rwkv_w_r : j == 2 ? p.rwkv_w_k : j == 3 ? p.rwkv_w_v : p.rwkv_w_o;
        const size_t dofs = j == 0 ? W_OUT : j == 1 ? W_R : j == 2 ? W_K : j == 3 ? W_V : W_O;
        return cvt_tile(src + (size_t)kt * 64 * 1024 + run * 32, 1024, 64, true, wsm + dofs + (size_t)run * 32 * 1024 + kt * 64, 1024);
    }
    u -= 512 * 5;
    if (u < 128) {
        const int j = u >> 6, v = u & 63, run = v >> 4, kt = v & 15, d = run >> 1, co = (run & 1) * 32;
        const float* src = (j == 0 ? p.rwkv_decay_w1 : p.rwkv_iclr_a1) + (size_t)d * 1024 * 64;
        return cvt_tile(src + (size_t)kt * 64 * 64 + co, 64, 64, true, wsm + (j == 0 ? W_W1 : W_A1) + (size_t)run * 32 * 1024 + kt * 64, 1024);
    }
    u -= 128;
    if (u < 128) {
        const int run = u >> 4, kt = u & 15;
        return cvt_tile(p.rwkv_gate_g1 + (size_t)kt * 64 * 160 + run * 32, 160, 64, run < 5, wsm + W_G1 + (size_t)run * 32 * 1024 + kt * 64, 1024);
    }
    u -= 128;
    if (u < 128) {
        const int j = u >> 6, v = u & 63, d = v >> 5, run = v & 31;
        const float* src = (j == 0 ? p.rwkv_decay_w2 : p.rwkv_iclr_a2) + (size_t)d * 64 * 1024;
        return cvt_tile(src + run * 32, 1024, 64, true, wsm + (j == 0 ? W_W2 : W_A2) + (size_t)d * 1024 * 64 + (size_t)run * 32 * 64, 64);
    }
    u -= 128;
    {
        const int run = u / 3, kt = u % 3;
        const int kvalid = 160 - kt * 64 > 64 ? 64 : (160 - kt * 64 < 0 ? 0 : 160 - kt * 64);
        return cvt_tile(p.rwkv_gate_g2 + (size_t)kt * 64 * 1024 + run * 32, 1024, kvalid, true, wsm + W_G2 + (size_t)run * 32 * 192 + kt * 64, 192);
    }
}
constexpr int CV_MOE_UNITS = 16 * (1024 + 512);
DI CvtDesc cvt_moe_unit(const Params& p, int layer, int u) {
    bf16_t* w13 = (bf16_t*)(p.ws + OFF_MOEW);
    bf16_t* w2t = w13 + (size_t)16 * 2048 * 1024;
    const int e = u / 1536, v = u % 1536;
    const size_t eo = (size_t)(layer * 16 + e) * 1024 * 1024;
    if (v < 1024) {
        const int run = v >> 4, kt = v & 15, g = run >> 1;
        const float* src = ((run & 1) ? p.moe_w3 : p.moe_w1) + eo;
        return cvt_tile(src + (size_t)kt * 64 * 1024 + g * 32, 1024, 64, true, w13 + (size_t)e * 2048 * 1024 + (size_t)run * 32 * 1024 + kt * 64, 1024);
    } else {
        const int w = v - 1024, run = w >> 4, kt = w & 15;
        return cvt_tile(p.moe_w2 + eo + (size_t)kt * 64 * 1024 + run * 32, 1024, 64, true, w2t + (size_t)e * 1024 * 1024 + (size_t)run * 32 * 1024 + kt * 64, 1024);
    }
}
DI void adaln_unit(const Params& p, int u, float* sm) {
    const int l = u / 96, n0 = (u % 96) * 64, t = tidx();
    float* sv = sm;
    float* red = sm + 3 * 1024;
    for (int i = t; i < 3 * 1024; i += NTH) { const int w = i >> 10, k = i & 1023; const float c = w < 2 ? p.c[w * 1024 + k] : p.c_ctx[k]; sv[i] = siluf_(c); }
    __syncthreads();
    const int kg = t >> 4, cl = t & 15;
    f32x4 a0 = {0, 0, 0, 0}, a1 = a0, a2 = a0;
    const float* W = p.ada_w + (size_t)l * 1024 * 6144 + n0 + cl * 4;
#pragma unroll 8
    for (int i = 0; i < 32; ++i) {
        const int k = kg + 32 * i;
        const f32x4 w = *(const f32x4*)(W + (size_t)k * 6144);
        a0 += w * sv[k]; a1 += w * sv[1024 + k]; a2 += w * sv[2048 + k];
    }
#pragma unroll
    for (int j = 0; j < 4; ++j) { red[kg * 192 + 0 * 64 + cl * 4 + j] = a0[j]; red[kg * 192 + 1 * 64 + cl * 4 + j] = a1[j]; red[kg * 192 + 2 * 64 + cl * 4 + j] = a2[j]; }
    __syncthreads();
    if (t < 192) {
        float s = 0.f;
        for (int g = 0; g < 32; ++g) s += red[g * 192 + t];
        const int w = t >> 6, n = n0 + (t & 63);
        ((float*)(p.ws + OFF_MOD))[(size_t)(l * 3 + w) * 6144 + n] = s + p.ada_b[l * 6144 + n];
    }
    __syncthreads();
}
DI void rope_unit(const Params& p, int u) {
    const int id = u * NTH + tidx();
    if (id < 320 * 16) {
        const int pi = id >> 4, f = id & 15;
        const float inv = exp2f(-(float)f * (13.287712379549449f / 16.0f));
        const float val = pi < 256 ? (float)pi : (float)(pi - 256);
        const float ang = val * inv;
        const double a = (double)ang;
        const double k = __builtin_rint(a * 0.15915494309189535);
        const float r = (float)(a - k * 6.283185307179586);
        f32x2 cs = {__cosf(r), __sinf(r)};
        ((f32x2*)(p.ws + OFF_ROPE))[id] = cs;
    }
}
DI void phase_prologue(const Params& p, char* smem) {
    float* sm = (float*)smem;
    const int nconv = CV_SMALL_UNITS + CV_MOE_UNITS;
    const int total = nconv + 192 + 10;
    for (int u = nconv + blockIdx.x; u < total; u += gridDim.x) {
        if (u < nconv + 192) adaln_unit(p, u - nconv, sm);
        else rope_unit(p, u - nconv - 192);
    }
    __syncthreads();
    cvt_run(nconv, [&](int u) { return u < CV_SMALL_UNITS ? cvt_small_unit(p, u) : cvt_moe_unit(p, 0, u - CV_SMALL_UNITS); }, sm);
}

DI void row_load(const float* src, f32x4 (&v)[4], int lane) {
#pragma unroll
    for (int i = 0; i < 4; ++i) v[i] = ((const f32x4*)src)[lane + 64 * i];
}
DI float row_rstd(const f32x4 (&v)[4]) {
    float ss = 0.f;
#pragma unroll
    for (int i = 0; i < 4; ++i) ss += v[i][0] * v[i][0] + v[i][1] * v[i][1] + v[i][2] * v[i][2] + v[i][3] * v[i][3];
    ss = wave_sum(ss);
    return rsqrtf(ss * (1.0f / DM) + RMS_EPS);
}
DI void row_norm_mod(const f32x4 (&v)[4], float rstd, const float* g, const float* shift, const float* scale, f32x4 (&h)[4], int lane) {
#pragma unroll
    for (int i = 0; i < 4; ++i) {
        const int c = (lane + 64 * i) * 4;
        const f32x4 g4 = *(const f32x4*)(g + c), sh = *(const f32x4*)(shift + c), sc = *(const f32x4*)(scale + c);
        h[i] = (v[i] * rstd * g4) * (1.0f + sc) + sh;
    }
}
DI void row_store_bf16(bf16_t* dst, const f32x4 (&h)[4], int lane) {
#pragma unroll
    for (int i = 0; i < 4; ++i) { u32x2 w; w[0] = pk_bf16(h[i][0], h[i][1]); w[1] = pk_bf16(h[i][2], h[i][3]); *(u32x2*)(dst + (lane + 64 * i) * 4) = w; }
}
DI void row_load_bf16(const bf16_t* src, f32x4 (&v)[4], int lane) {
#pragma unroll
    for (int i = 0; i < 4; ++i) { const u32x2 w = *(const u32x2*)(src + (lane + 64 * i) * 4); v[i][0] = bf_lo(w[0]); v[i][1] = bf_hi(w[0]); v[i][2] = bf_lo(w[1]); v[i][3] = bf_hi(w[1]); }
}

DI void phase_norm0(const Params& p) {
    const int lane = tidx() & 63, gw = blockIdx.x * NWAVE + (tidx() >> 6), nw = gridDim.x * NWAVE;
    bf16_t* H = (bf16_t*)(p.ws + OFF_H);
    for (int tok = gw; tok < TTOT; tok += nw) {
        f32x4 v[4], h[4];
        row_load(xin_ptr(p, tok), v, lane);
        const float rstd = row_rstd(v);
        row_norm_mod(v, rstd, p.norm_mix_g, mod_ptr(p, 0, tok, 0), mod_ptr(p, 0, tok, 1), h, lane);
        row_store_bf16(H + (size_t)tok * DM, h, lane);
    }
}

DI void route_row(const Params& p, const float (&lg)[16], int& e1, int& e2, float& g1, float& g2) {
    float mx = lg[0];
#pragma unroll
    for (int e = 1; e < 16; ++e) mx = fmaxf(mx, lg[e]);
    float pr[16], sum = 0.f;
#pragma unroll
    for (int e = 0; e < 16; ++e) { pr[e] = __expf(lg[e] - mx); sum += pr[e]; }
    const float inv = 1.0f / sum;
    float sel[16];
#pragma unroll
    for (int e = 0; e < 16; ++e) { pr[e] *= inv; sel[e] = pr[e] + p.router_bias[e]; }
    float best = -1e30f; int gi = 0;
#pragma unroll
    for (int g = 0; g < 4; ++g) {
        float m1 = -1e30f, m2 = -1e30f;
#pragma unroll
        for (int j = 0; j < 4; ++j) { const float s = sel[g * 4 + j]; if (s > m1) { m2 = m1; m1 = s; } else if (s > m2) m2 = s; }
        const float gs = m1 + m2;
        if (gs > best) { best = gs; gi = g; }
    }
    float s4[4], p4[4];
#pragma unroll
    for (int j = 0; j < 4; ++j) {
        s4[j] = gi == 0 ? sel[j] : gi == 1 ? sel[4 + j] : gi == 2 ? sel[8 + j] : sel[12 + j];
        p4[j] = gi == 0 ? pr[j] : gi == 1 ? pr[4 + j] : gi == 2 ? pr[8 + j] : pr[12 + j];
    }
    int i1 = 0; float b1 = s4[0];
#pragma unroll
    for (int j = 1; j < 4; ++j) if (s4[j] > b1) { b1 = s4[j]; i1 = j; }
    int i2 = i1 == 0 ? 1 : 0; float b2 = -3e38f;
#pragma unroll
    for (int j = 0; j < 4; ++j) if (j != i1 && s4[j] > b2) { b2 = s4[j]; i2 = j; }
    const float w1 = i1 == 0 ? p4[0] : i1 == 1 ? p4[1] : i1 == 2 ? p4[2] : p4[3];
    const float w2 = i2 == 0 ? p4[0] : i2 == 1 ? p4[1] : i2 == 2 ? p4[2] : p4[3];
    const float ws = 1.0f / (w1 + w2);
    e1 = gi * 4 + i1; e2 = gi * 4 + i2; g1 = w1 * ws; g2 = w2 * ws;
}
DI void phase_ffn_norm_route(const Params& p, int layer, char* smem) {
    const int lane = tidx() & 63, gw = blockIdx.x * NWAVE + (tidx() >> 6), nw = gridDim.x * NWAVE;
    float* rw = (float*)smem;
    for (int i = tidx(); i < 1024 * 16; i += NTH) rw[(i & 15) * 1024 + (i >> 4)] = p.router_w[i];
    __syncthreads();
    bf16_t* H = (bf16_t*)(p.ws + OFF_H);
    int* lcnt = (int*)(smem + 65536);
    if (tidx() < 32) lcnt[tidx()] = 0;
    int my_tok = -1, my_e1 = 0, my_e2 = 0, it = 0; float my_g1 = 0.f, my_g2 = 0.f;
    for (int tok = gw; tok < TTOT; tok += nw) {
        const int pos = tok >= PTOT ? tok - PTOT : tok;
        if (layer == 1 && pos < LCTX) continue;
        f32x4 v[4], h[4];
        row_load(xrow_ptr(p, tok), v, lane);
        const float rstd = row_rstd(v);
        row_norm_mod(v, rstd, p.norm_ffn_g + layer * DM, mod_ptr(p, layer, tok, 3), mod_ptr(p, layer, tok, 4), h, lane);
        row_store_bf16(H + (size_t)tok * DM, h, lane);
        float lg[16];
#pragma unroll
        for (int e = 0; e < 16; ++e) lg[e] = 0.f;
#pragma unroll
        for (int i = 0; i < 4; ++i)
#pragma unroll
            for (int e = 0; e < 16; ++e) {
                const f32x4 w = *(const f32x4*)(rw + e * 1024 + (lane + 64 * i) * 4);
                lg[e] += h[i][0] * w[0] + h[i][1] * w[1] + h[i][2] * w[2] + h[i][3] * w[3];
                if ((e & 3) == 3) asm volatile("" ::: "memory");
            }
#pragma unroll
        for (int e = 0; e < 16; ++e) lg[e] = wave_sum(lg[e]);
        int e1, e2; float g1, g2;
        route_row(p, lg, e1, e2, g1, g2);
        if (lane == it) { my_tok = tok; my_e1 = e1; my_e2 = e2; my_g1 = g1; my_g2 = g2; }
        ++it;
    }
    __syncthreads();
    int r1 = 0, r2 = 0;
    if (my_tok >= 0) { r1 = atomicAdd(&lcnt[my_e1], 1); r2 = atomicAdd(&lcnt[my_e2], 1); }
    __syncthreads();
    if (tidx() < 16) { const int n = lcnt[tidx()]; lcnt[16 + tidx()] = n ? atomicAdd((int*)(p.ws + OFF_CNT) + layer * 16 + tidx(), n) : 0; }
    __syncthreads();
    if (my_tok >= 0) {
        int* stok = (int*)(p.ws + OFF_STOK);
        float* sw = (float*)(p.ws + OFF_SW);
        const size_t s1 = (size_t)my_e1 * CAP + lcnt[16 + my_e1] + r1, s2 = (size_t)my_e2 * CAP + lcnt[16 + my_e2] + r2;
        stok[s1] = my_tok * 2 + 0; sw[s1] = my_g1;
        stok[s2] = my_tok * 2 + 1; sw[s2] = my_g2;
    }
    __syncthreads();
}

DI void combine_row(const Params& p, int layer, int tok, f32x4 (&v)[4], int lane) {
    const bf16_t* Y = (const bf16_t*)(p.ws + OFF_SCR + S_Y) + (size_t)tok * 2 * DM;
    const float* g5 = mod_ptr(p, layer, tok, 5);
    f32x4 y0[4], y1[4];
    row_load(xrow_ptr(p, tok), v, lane);
    row_load_bf16(Y, y0, lane); row_load_bf16(Y + DM, y1, lane);
#pragma unroll
    for (int i = 0; i < 4; ++i) { const f32x4 g = *(const f32x4*)(g5 + (lane + 64 * i) * 4); v[i] += g * (y0[i] + y1[i]); }
}
DI void phase_combine_l0(const Params& p, char* smem) {
    const int lane = tidx() & 63, gw = blockIdx.x * NWAVE + (tidx() >> 6), nw = gridDim.x * NWAVE;
    bf16_t* H = (bf16_t*)(p.ws + OFF_H);
    for (int tok = gw; tok < TTOT; tok += nw) {
        f32x4 v[4], h[4];
        combine_row(p, 0, tok, v, lane);
        float* X = xrow_ptr(p, tok);
#pragma unroll
        for (int i = 0; i < 4; ++i) ((f32x4*)X)[lane + 64 * i] = v[i];
        const float rstd = row_rstd(v);
        row_norm_mod(v, rstd, p.norm_mix_g + DM, mod_ptr(p, 1, tok, 0), mod_ptr(p, 1, tok, 1), h, lane);
        row_store_bf16(H + (size_t)tok * DM, h, lane);
    }
    __syncthreads();
    cvt_run(CV_MOE_UNITS, [&](int u) { return cvt_moe_unit(p, 1, u); }, (float*)smem);
}
DI void phase_xx(const Params& p) {
    const int lane = tidx() & 63, gw = blockIdx.x * NWAVE + (tidx() >> 6), nw = gridDim.x * NWAVE;
    const bf16_t* H = (const bf16_t*)(p.ws + OFF_H);
    bf16_t* XX = (bf16_t*)(p.ws + OFF_SCR + S_XX);
    for (int tok = gw; tok < TTOT; tok += nw) {
        const int pos = tok >= PTOT ? tok - PTOT : tok;
        const bool first = pos == 0 || pos == LCTX, last = pos == LCTX - 1 || pos == PTOT - 1;
        f32x4 hc[4], hp[4], hn[4], xx[4];
        row_load_bf16(H + (size_t)tok * DM, hc, lane);
        row_load_bf16(H + (size_t)(first ? tok : tok - 1) * DM, hp, lane);
        row_load_bf16(H + (size_t)(last ? tok : tok + 1) * DM, hn, lane);
#pragma unroll
        for (int i = 0; i < 4; ++i) {
            const f32x4 a = first ? (f32x4){0, 0, 0, 0} : hp[i], b = last ? (f32x4){0, 0, 0, 0} : hn[i];
            xx[i] = 0.5f * (a + b) - hc[i];
        }
        row_store_bf16(XX + (size_t)tok * DM, xx, lane);
    }
}
DI void phase_final(const Params& p) {
    const int lane = tidx() & 63, gw = blockIdx.x * NWAVE + (tidx() >> 6), nw = gridDim.x * NWAVE;
    for (int r = gw; r < NBATCH * SEQ; r += nw) {
        const int b = r / SEQ, tok = b * PTOT + LCTX + (r - b * SEQ);
        f32x4 v[4];
        combine_row(p, 1, tok, v, lane);
        const float rstd = row_rstd(v);
        float* O = p.out + (size_t)r * DM;
#pragma unroll
        for (int i = 0; i < 4; ++i) { const f32x4 g = *(const f32x4*)(p.final_norm_g + (lane + 64 * i) * 4); ((f32x4*)O)[lane + 64 * i] = v[i] * rstd * g; }
    }
}

constexpr int LDSROW = 72;
constexpr int GEMM_SMEM = 2 * (256 + 256) * LDSROW * 2;
template <int NH, class AL, class EPI>
DI void gemm_tile(AL& al, const bf16_t* __restrict__ Bt, int ldb, int nk, EPI& epi, char* smem) {
    const int t = tidx(), lane = t & 63, wid = t >> 6, wr = wid >> 1, wc = wid & 1, fr = lane & 15, fq = lane >> 4;
    constexpr int BR = 128 * NH;
    bf16_t* sA = (bf16_t*)smem;
    bf16_t* sB = sA + 2 * 256 * LDSROW;
    f32x4 acc[NH][4][4];
#pragma unroll
    for (int h = 0; h < NH; ++h)
#pragma unroll
        for (int m = 0; m < 4; ++m)
#pragma unroll
            for (int n = 0; n < 4; ++n) acc[h][m][n] = (f32x4){0.f, 0.f, 0.f, 0.f};
    const int lr = t >> 3, lc = (t & 7) * 8;
    typename AL::Raw ra[4]; u32x4 rb[2 * NH];
#pragma unroll
    for (int i = 0; i < 4; ++i) al.issue(ra[i], lr + 64 * i, lc, i);
#pragma unroll
    for (int i = 0; i < 2 * NH; ++i) rb[i] = *(const u32x4*)(Bt + (size_t)(lr + 64 * i) * ldb + lc);
#pragma unroll
    for (int i = 0; i < 4; ++i) *(u32x4*)(sA + (lr + 64 * i) * LDSROW + lc) = al.finish(ra[i], lc);
#pragma unroll
    for (int i = 0; i < 2 * NH; ++i) *(u32x4*)(sB + (lr + 64 * i) * LDSROW + lc) = rb[i];
    __syncthreads();
    for (int kt = 0; kt < nk; ++kt) {
        const int cur = kt & 1;
        const bool more = kt + 1 < nk;
        if (more) {
#pragma unroll
            for (int i = 0; i < 4; ++i) al.issue(ra[i], lr + 64 * i, (kt + 1) * 64 + lc, i);
#pragma unroll
            for (int i = 0; i < 2 * NH; ++i) rb[i] = *(const u32x4*)(Bt + (size_t)(lr + 64 * i) * ldb + (kt + 1) * 64 + lc);
        }
        __builtin_amdgcn_sched_barrier(0);
        const bf16_t* cA = sA + cur * 256 * LDSROW + (wr * 64 + fr) * LDSROW + fq * 8;
        const bf16_t* cB = sB + cur * BR * LDSROW + (wc * 64 + fr) * LDSROW + fq * 8;
#pragma unroll
        for (int kk = 0; kk < 2; ++kk) {
            bf16x8 af[4];
#pragma unroll
            for (int m = 0; m < 4; ++m) af[m] = *(const bf16x8*)(cA + m * 16 * LDSROW + kk * 32);
#pragma unroll
            for (int h = 0; h < NH; ++h) {
                bf16x8 bfr[4];
#pragma unroll
                for (int n = 0; n < 4; ++n) bfr[n] = *(const bf16x8*)(cB + (h * 128 + n * 16) * LDSROW + kk * 32);
#pragma unroll
                for (int m = 0; m < 4; ++m)
#pragma unroll
                    for (int n = 0; n < 4; ++n) acc[h][m][n] = __builtin_amdgcn_mfma_f32_16x16x32_bf16(bfr[n], af[m], acc[h][m][n], 0, 0, 0);
            }
            if (kk == AL::STORE_AT && more) {
                bf16_t* nA = sA + (cur ^ 1) * 256 * LDSROW;
                bf16_t* nB = sB + (cur ^ 1) * BR * LDSROW;
#pragma unroll
                for (int i = 0; i < 4; ++i) *(u32x4*)(nA + (lr + 64 * i) * LDSROW + lc) = al.finish(ra[i], (kt + 1) * 64 + lc);
#pragma unroll
                for (int i = 0; i < 2 * NH; ++i) *(u32x4*)(nB + (lr + 64 * i) * LDSROW + lc) = rb[i];
            }
        }
        __syncthreads();
    }
#pragma unroll
    for (int h = 0; h < NH; ++h) epi(acc[h], wr * 64, h * 128 + wc * 64, fr, fq);
}
constexpr int G8_HB = 128 * 64 * 2;
constexpr int G8_SMEM = 8 * G8_HB;
DI void g8_rc(int& R0, int& C0) {
    const int tz = tidx(), st = tz >> 6, sb = (tz & 63) * 16, swz = sb ^ (((sb >> 9) & 1) << 5);
    R0 = (st >> 1) * 16 + (swz >> 6); C0 = (st & 1) * 32 + ((swz & 63) >> 1);
}
DI int g8_bcol(int h, int rho) { return (rho >> 5) * 64 + h * 32 + (rho & 31); }
struct G8Rows {
    const bf16_t* base; unsigned o0, d1, d2;
    DI const bf16_t* ptr(int h, int i, int kt) const { return (base + (size_t)(h * d2 + i * d1 + kt * 64)) + o0; }
};
struct G8Gather {
    const bf16_t* base; unsigned o[4];
    DI const bf16_t* ptr(int h, int i, int kt) const { return (base + kt * 64) + o[h * 2 + i]; }
};
DI G8Rows g8_arows(const bf16_t* A, int lda) { int R0, C0; g8_rc(R0, C0); return G8Rows{A, (unsigned)(R0 * lda + C0), (unsigned)(64 * lda), (unsigned)(128 * lda)}; }
DI G8Rows g8_brows(const bf16_t* Bt, int ldb) { int R0, C0; g8_rc(R0, C0); return G8Rows{Bt, (unsigned)(g8_bcol(0, R0) * ldb + C0), (unsigned)(128 * ldb), (unsigned)(32 * ldb)}; }
template <class AS, class BS, class EPI, class NF>
DI void gemm8_tile(const AS& as, const BS& bs, int nt  , EPI& epi, char* smem, bool prefetched, NF nextfn) {
    int tz = tidx();
    int wid = tz >> 6, lane = tz & 63, wr = wid >> 2, wc = wid & 3, fr = lane & 15, fq = lane >> 4;
    int loff = ((fr * 64 + fq * 16) ^ ((fr >> 3) << 5));
#define G8_SA(b, h) (smem + ((b) * 2 + (h)) * G8_HB)
#define G8_SB(b, h) (smem + (4 + (b) * 2 + (h)) * G8_HB)
#define G8_STAGE(P, src, h, kt) do { \
        __builtin_amdgcn_global_load_lds((const unsigned*)(src).ptr(h, 0, kt), (LAS unsigned*)((P) + tz * 16), 16, 0, 0); \
        __builtin_amdgcn_global_load_lds((const unsigned*)(src).ptr(h, 1, kt), (LAS unsigned*)((P) + tz * 16 + 8192), 16, 0, 0); } while (0)
#define G8_STA(b, h, kt) G8_STAGE(G8_SA(b, h), as, h, kt)
#define G8_STB(b, h, kt) G8_STAGE(G8_SB(b, h), bs, h, kt)
#define G8_LDA(dst, b, h) _Pragma("unroll") for (int m = 0; m < 4; ++m) _Pragma("unroll") for (int k = 0; k < 2; ++k) \
        dst[m][k] = *(const bf16x8*)(G8_SA(b, h) + (wr * 8 + m * 2 + k) * 1024 + loff)
#define G8_LDB(dst, b, h) _Pragma("unroll") for (int n = 0; n < 2; ++n) _Pragma("unroll") for (int k = 0; k < 2; ++k) \
        dst[n][k] = *(const bf16x8*)(G8_SB(b, h) + (wc * 4 + n * 2 + k) * 1024 + loff)
#define G8_MMA(ai, bj, Bx) do { __builtin_amdgcn_s_setprio(1); \
        _Pragma("unroll") for (int m = 0; m < 4; ++m) _Pragma("unroll") for (int n = 0; n < 2; ++n) _Pragma("unroll") for (int k = 0; k < 2; ++k) \
            acc[ai][bj][m][n] = __builtin_amdgcn_mfma_f32_16x16x32_bf16(Bx[n][k], At[m][k], acc[ai][bj][m][n], 0, 0, 0); \
        __builtin_amdgcn_s_setprio(0); } while (0)
#define G8_WV(n) asm volatile("s_waitcnt vmcnt(" #n ")" ::: "memory")
#define G8_WL(n) asm volatile("s_waitcnt lgkmcnt(" #n ")" ::: "memory")
#define G8_BAR __builtin_amdgcn_s_barrier()
#define G8_SCHED __builtin_amdgcn_sched_barrier(0)
    f32x4 acc[2][2][4][2];
#pragma unroll
    for (int a = 0; a < 2; ++a)
#pragma unroll
        for (int b = 0; b < 2; ++b)
#pragma unroll
            for (int m = 0; m < 4; ++m)
#pragma unroll
                for (int n = 0; n < 2; ++n) acc[a][b][m][n] = (f32x4){0.f, 0.f, 0.f, 0.f};
    bf16x8 At[4][2], B0[2][2], B1[2][2];
    if (!prefetched) { G8_STB(0, 0, 0); G8_STA(0, 0, 0); G8_STB(0, 1, 0); G8_STA(0, 1, 0); }
    if (wr == 1) G8_BAR;
    if (prefetched) G8_WV(0); else G8_WV(4);
    G8_BAR;
    G8_STB(1, 0, 1); G8_STA(1, 0, 1); G8_STB(1, 1, 1);
    G8_WV(6); G8_BAR;
    for (int t = 0; t < nt - 2; t += 2) {
        G8_LDB(B0, 0, 0); G8_SCHED; G8_LDA(At, 0, 0); G8_STA(1, 1, t + 1);
        G8_WL(8); G8_BAR; G8_WL(0); G8_MMA(0, 0, B0); G8_BAR; G8_SCHED;
        G8_LDB(B1, 0, 1); G8_STB(0, 0, t + 2);
        G8_BAR; G8_WL(0); G8_MMA(0, 1, B1); G8_BAR;
        G8_LDA(At, 0, 1); G8_STA(0, 0, t + 2);
        G8_BAR; G8_WL(0); G8_MMA(1, 0, B0); G8_BAR; G8_SCHED;
        G8_STB(0, 1, t + 2);
        G8_WV(6); G8_BAR; G8_MMA(1, 1, B1); G8_BAR;
        G8_LDB(B0, 1, 0); G8_SCHED; G8_LDA(At, 1, 0); G8_STA(0, 1, t + 2);
        G8_WL(8); G8_BAR; G8_WL(0); G8_MMA(0, 0, B0); G8_BAR; G8_SCHED;
        G8_LDB(B1, 1, 1); G8_STB(1, 0, t + 3);
        G8_BAR; G8_WL(0); G8_MMA(0, 1, B1); G8_BAR;
        G8_LDA(At, 1, 1); G8_STA(1, 0, t + 3);
        G8_BAR; G8_WL(0); G8_MMA(1, 0, B0); G8_BAR; G8_SCHED;
        G8_STB(1, 1, t + 3);
        G8_WV(6); G8_BAR; G8_MMA(1, 1, B1); G8_BAR;
    }
    tz = tidx(); wid = tz >> 6; lane = tz & 63; wr = wid >> 2; wc = wid & 3; fr = lane & 15; fq = lane >> 4;
    loff = ((fr * 64 + fq * 16) ^ ((fr >> 3) << 5));
    {
        G8_LDB(B0, 0, 0); G8_WV(0); G8_LDA(At, 0, 0); G8_STA(1, 1, nt - 1);
        G8_BAR; G8_WL(0); G8_MMA(0, 0, B0); G8_BAR;
        G8_LDB(B1, 0, 1); G8_BAR; G8_WL(0); G8_MMA(0, 1, B1); G8_BAR;
        G8_LDA(At, 0, 1); G8_WV(4); G8_BAR; G8_WL(0); G8_MMA(1, 0, B0); G8_MMA(1, 1, B1); G8_BAR;
    }
    {
        G8_LDB(B0, 1, 0); G8_LDA(At, 1, 0); G8_WV(2); G8_BAR; G8_WL(0); G8_MMA(0, 0, B0); G8_BAR;
        G8_LDB(B1, 1, 1); G8_WV(0); G8_BAR; G8_WL(0); G8_MMA(0, 1, B1); G8_BAR;
        G8_LDA(At, 1, 1); G8_BAR; G8_WL(0); G8_MMA(1, 0, B0); G8_MMA(1, 1, B1); G8_BAR;
    }
    if (wr == 0) G8_BAR;
    {
        AS a2; BS b2;
        if (!EPI::STAGED && nextfn(a2, b2)) {
            G8_STAGE(G8_SB(0, 0), b2, 0, 0); G8_STAGE(G8_SA(0, 0), a2, 0, 0); G8_STAGE(G8_SB(0, 1), b2, 1, 0); G8_STAGE(G8_SA(0, 1), a2, 1, 0);
        }
    }
#pragma unroll
    for (int ai = 0; ai < 2; ++ai) {
        f32x4 a4[4][4];
#pragma unroll
        for (int m = 0; m < 4; ++m)
#pragma unroll
            for (int n = 0; n < 4; ++n) a4[m][n] = acc[ai][n >> 1][m][n & 1];
        if constexpr (EPI::STAGED) epi.stage(a4, ai * 128 + wr * 64, wc * 64, fr, fq, smem);
        else epi(a4, ai * 128 + wr * 64, wc * 64, fr, fq);
    }
    if constexpr (EPI::STAGED) {
        __syncthreads();
        epi.flush(smem);
        __syncthreads();
    }
}
template <class TP>
DI void gemm8_run(TP& tp, int nt, char* smem) {
    typename TP::AS as; typename TP::BS bs; typename TP::EPI epi;
    bool pre = false;
    for (int k = 0; tp.get(k, as, bs, epi); ++k) {
        gemm8_tile(as, bs, nt, epi, smem, pre, [&](typename TP::AS& a2, typename TP::BS& b2) { typename TP::EPI e2; return tp.get(k + 1, a2, b2, e2); });
        pre = !TP::EPI::STAGED;
    }
}
DI bool xcd_tile(int k, int nM, int NT, int& mt, int& nt) {
    const bool swz = (gridDim.x & 7) == 0;
    const int j = (swz ? (int)(blockIdx.x >> 3) : (int)blockIdx.x) + (swz ? (int)(gridDim.x >> 3) : (int)gridDim.x) * k, mi = j / NT;
    nt = j - mi * NT; mt = swz ? (int)(blockIdx.x & 7) + 8 * mi : mi;
    return mt < nM;
}
struct ALPlain {
    typedef u32x4 Raw; static constexpr int STORE_AT = 0;
    const bf16_t* A; int lda;
    DI void issue(Raw& r, int row, int k, int) const { r = *(const u32x4*)(A + (size_t)row * lda + k); }
    DI u32x4 finish(const Raw& r, int) const { return r; }
};
struct ALMix {
    struct Raw { u32x4 h, x; };
    static constexpr int STORE_AT = 1;
    const bf16_t* H; const bf16_t* XX; const LAS float* xm;
    DI void issue(Raw& r, int row, int k, int) const { r.h = *(const u32x4*)(H + (size_t)row * DM + k); r.x = *(const u32x4*)(XX + (size_t)row * DM + k); }
    DI void set_mix(const float* g) {
        const int t = tidx();
        LAS float* w = (LAS float*)xm;
        w[t] = g[t]; w[t + 512] = g[t + 512];
        __syncthreads();
    }
    DI u32x4 finish(const Raw& r, int k) const {
        const f32x4 m0 = *(const LAS f32x4*)(xm + k), m1 = *(const LAS f32x4*)(xm + k + 4);
        const u32x4 h = r.h, x = r.x;
        u32x4 o;
        o[0] = pk_bf16(bf_lo(h[0]) + bf_lo(x[0]) * m0[0], bf_hi(h[0]) + bf_hi(x[0]) * m0[1]);
        o[1] = pk_bf16(bf_lo(h[1]) + bf_lo(x[1]) * m0[2], bf_hi(h[1]) + bf_hi(x[1]) * m0[3]);
        o[2] = pk_bf16(bf_lo(h[2]) + bf_lo(x[2]) * m1[0], bf_hi(h[2]) + bf_hi(x[2]) * m1[1]);
        o[3] = pk_bf16(bf_lo(h[3]) + bf_lo(x[3]) * m1[2], bf_hi(h[3]) + bf_hi(x[3]) * m1[3]);
        return o;
    }
};

struct EpiQKV {
    static constexpr bool STAGED = false;
    PLite p; int m0, n0;
    DI void operator()(const f32x4 (&acc)[4][4], int rb, int cb, int fr, int fq) const {
        const int hs = (n0 + cb) >> 6;
        const bool isq = hs < 8 || (hs >= 12 && hs < 20), isv = (hs >= 10 && hs < 12) || hs >= 22, normed = hs >= 12 && hs < 22;
        const float* gam = hs < 20 ? p.qg : p.kg;
        const f32x2* rope = (const f32x2*)(p.ws + OFF_ROPE);
        bf16_t* Q = (bf16_t*)(p.ws + OFF_SCR + S_Q);
        bf16_t* K = (bf16_t*)(p.ws + OFF_SCR + S_K);
        bf16_t* VT = (bf16_t*)(p.ws + OFF_SCR + S_VT);
#pragma unroll
        for (int m = 0; m < 4; ++m) {
            const int tok = m0 + rb + m * 16 + fr, b = tok >= PTOT ? 1 : 0, pos = tok - b * PTOT;
            f32x4 v[4];
#pragma unroll
            for (int n = 0; n < 4; ++n) v[n] = acc[m][n];
            if (normed) {
                float ss = 0.f;
#pragma unroll
                for (int n = 0; n < 4; ++n) ss += v[n][0] * v[n][0] + v[n][1] * v[n][1] + v[n][2] * v[n][2] + v[n][3] * v[n][3];
                ss += __shfl_xor(ss, 16); ss += __shfl_xor(ss, 32);
                const float rstd = rsqrtf(ss * (1.0f / 64.0f) + RMS_EPS);
#pragma unroll
                for (int n = 0; n < 4; ++n) { const f32x4 g = *(const f32x4*)(gam + n * 16 + fq * 4); v[n] = v[n] * rstd * g; }
            }
            if (!isv && pos >= LCTX) {
                const int t = pos - LCTX, prow = t >> 6, pcol = t & 63;
#pragma unroll
                for (int a = 0; a < 2; ++a) {
                    const f32x2* tb = rope + (a == 0 ? prow : 256 + pcol) * 16 + fq * 4;
#pragma unroll
                    for (int j = 0; j < 4; ++j) {
                        const f32x2 cs = tb[j];
                        const float x0 = v[2 * a][j], x1 = v[2 * a + 1][j];
                        v[2 * a][j] = x0 * cs[0] - x1 * cs[1];
                        v[2 * a + 1][j] = x1 * cs[0] + x0 * cs[1];
                    }
                }
            }
            if (isq) {
                const int hq = hs < 8 ? hs : hs - 4;
                bf16_t* dst = Q + ((size_t)(b * 16 + hq) * PTOT + pos) * 64 + fq * 4;
#pragma unroll
                for (int n = 0; n < 4; ++n) { const f32x4 w = v[n] * (0.125f * LOG2E); u32x2 o; o[0] = pk_bf16(w[0], w[1]); o[1] = pk_bf16(w[2], w[3]); *(u32x2*)(dst + n * 16) = o; }
            } else if (!isv) {
                const int kh = hs < 12 ? hs - 8 : hs - 18;
                bf16_t* dst = K + ((size_t)(b * 4 + kh) * PTOT + pos) * 64 + fq * 4;
#pragma unroll
                for (int n = 0; n < 4; ++n) { u32x2 o; o[0] = pk_bf16(v[n][0], v[n][1]); o[1] = pk_bf16(v[n][2], v[n][3]); *(u32x2*)(dst + n * 16) = o; }
            } else {
                const int vh = hs < 12 ? hs - 10 : hs - 20;
                bf16_t* dst = VT + (size_t)(b * 4 + vh) * 64 * PTOT + pos;
#pragma unroll
                for (int n = 0; n < 4; ++n)
#pragma unroll
                    for (int j = 0; j < 4; ++j) dst[(size_t)(n * 16 + fq * 4 + j) * PTOT] = (bf16_t)(pk_bf16(v[n][j], 0.f) & 0xffffu);
            }
        }
    }
};
struct TPQkv {
    typedef G8Rows AS; typedef G8Rows BS; typedef EpiQKV EPI;
    PLite p; const bf16_t* H; const bf16_t* W;
    DI bool get(int k, AS& as, BS& bs, EPI& epi) const {
        int mt, nt; if (!xcd_tile(k, TTOT / 256, QKV_N / 256, mt, nt)) return false;
        as = g8_arows(H + (size_t)mt * 256 * DM, DM); bs = g8_brows(W + (size_t)nt * 256 * DM, DM); epi = EpiQKV{p, mt * 256, nt * 256};
        return true;
    }
};
DI void phase_qkv(const Params& p, char* smem) {
    TPQkv tp{plite(p), (const bf16_t*)(p.ws + OFF_H), (const bf16_t*)(p.ws + OFF_WS) + W_IN};
    gemm8_run(tp, DM / 64, smem);
}

struct EpiResid {
    static constexpr bool STAGED = false;
    PLite p; int m0, n0, layer; bool from_input;
    DI void operator()(const f32x4 (&acc)[4][4], int rb, int cb, int fr, int fq) const {
        const int tok0 = m0 + rb, co = n0 + cb + fq * 4;
        const float* xin = (from_input ? xin_ptr(p, tok0) : xrow_ptr(p, tok0)) + (size_t)fr * DM + co;
        float* xo = xrow_ptr(p, tok0) + (size_t)fr * DM + co;
        const float* gate = mod_ptr(p, layer, tok0, 2) + co;
        f32x4 g[4], xi[2][4];
#pragma unroll
        for (int n = 0; n < 4; ++n) g[n] = *(const f32x4*)(gate + n * 16);
#pragma unroll
        for (int n = 0; n < 4; ++n) xi[0][n] = *(const f32x4*)(xin + n * 16);
#pragma unroll
        for (int m = 0; m < 4; ++m) {
            if (m < 3) {
#pragma unroll
                for (int n = 0; n < 4; ++n) xi[(m + 1) & 1][n] = *(const f32x4*)(xin + (size_t)(m + 1) * 16 * DM + n * 16);
            }
#pragma unroll
            for (int n = 0; n < 4; ++n) *(f32x4*)(xo + (size_t)m * 16 * DM + n * 16) = xi[m & 1][n] + g[n] * acc[m][n];
        }
    }
};
struct TPResid {
    typedef G8Rows AS; typedef G8Rows BS; typedef EpiResid EPI;
    PLite p; const bf16_t* O; const bf16_t* W; int layer;
    DI bool get(int k, AS& as, BS& bs, EPI& epi) const {
        constexpr int MTL = SEQ / 256;
        int mi, nt; if (!xcd_tile(k, layer == 0 ? TTOT / 256 : NBATCH * MTL, 4, mi, nt)) return false;
        const int mt = layer == 0 ? mi : (mi / MTL) * (PTOT / 256) + 1 + (mi % MTL);
        as = g8_arows(O + (size_t)mt * 256 * DM, DM); bs = g8_brows(W + (size_t)nt * 256 * DM, DM); epi = EpiResid{p, mt * 256, nt * 256, layer, layer == 0};
        return true;
    }
};
DI void phase_wout(const Params& p, char* smem) {
    TPResid tp{plite(p), (const bf16_t*)(p.ws + OFF_SCR + S_O), (const bf16_t*)(p.ws + OFF_WS) + W_OUT, 0};
    gemm8_run(tp, DM / 64, smem);
}
DI void phase_wo(const Params& p, char* smem) {
    TPResid tp{plite(p), (const bf16_t*)(p.ws + OFF_SCR + S_OR), (const bf16_t*)(p.ws + OFF_WS) + W_O, 1};
    gemm8_run(tp, DM / 64, smem);
}

struct MoeSched { int nt[16], base[17]; };
DI void moe_sched(const Params& p, int layer, MoeSched& s, int (&cnt)[16]) {
    const int* c = (const int*)(p.ws + OFF_CNT) + layer * 16;
    int acc = 0;
#pragma unroll
    for (int e = 0; e < 16; ++e) { cnt[e] = c[e]; s.nt[e] = (cnt[e] + 255) >> 8; s.base[e] = acc; acc += s.nt[e]; }
    s.base[16] = acc;
}
struct EpiMoe1 {
    static constexpr bool STAGED = true;
    static constexpr int SROW = 136;
    bf16_t* hid;   int n0;
    DI void stage(const f32x4 (&acc)[4][4], int rb, int cb, int fr, int fq, char* smem) const {
        bf16_t* st = (bf16_t*)smem;
        const int c0 = (cb >> 6) * 32 + fq * 4;
#pragma unroll
        for (int m = 0; m < 4; ++m) {
            bf16_t* dst = st + (rb + m * 16 + fr) * SROW + c0;
#pragma unroll
            for (int n = 0; n < 2; ++n) {
                const f32x4 a = acc[m][n], b = acc[m][n + 2];
                u32x2 o;
                o[0] = pk_bf16(siluf_(a[0]) * b[0], siluf_(a[1]) * b[1]);
                o[1] = pk_bf16(siluf_(a[2]) * b[2], siluf_(a[3]) * b[3]);
                *(u32x2*)(dst + n * 16) = o;
            }
        }
    }
    DI void flush(char* smem) const {
        const int t = tidx();
        const bf16_t* st = (const bf16_t*)smem;
        bf16_t* dst = hid + (n0 >> 1) + (t & 15) * 8;
#pragma unroll
        for (int ps = 0; ps < 8; ++ps) {
            const int row = ps * 32 + (t >> 4);
            *(u32x4*)(dst + (size_t)row * 1024) = *(const u32x4*)(st + row * SROW + (t & 15) * 8);
        }
    }
};
struct TPMoe1 {
    typedef G8Gather AS; typedef G8Rows BS; typedef EpiMoe1 EPI;
    MoeSched s; int cnt[16];
    const bf16_t* H; const bf16_t* W13; const int* stok; bf16_t* hid;
    DI bool get(int k, AS& as, BS& bs, EPI& epi) const {
        int mg, nt; if (!xcd_tile(k, s.base[16], 8, mg, nt)) return false;
        int e = 0;
#pragma unroll
        for (int i = 1; i < 16; ++i) if (mg >= s.base[i]) e = i;
        int ce = 0, be = 0;
#pragma unroll
        for (int i = 0; i < 16; ++i) if (i == e) { ce = cnt[i]; be = s.base[i]; }
        const int ml = mg - be;
        int R0, C0; g8_rc(R0, C0);
        as.base = H;
#pragma unroll
        for (int q = 0; q < 4; ++q) {
            const int r = ml * 256 + R0 + 64 * (q & 1) + 128 * (q >> 1);
            const int tk = r < ce ? (stok[(size_t)e * CAP + r] >> 1) : 0;
            as.o[q] = (unsigned)tk * 1024u + C0;
        }
        bs = g8_brows(W13 + (size_t)e * 2048 * 1024 + (size_t)nt * 256 * 1024, 1024);
        epi = EpiMoe1{hid + (size_t)mg * 256 * 1024, nt * 256};
        return true;
    }
};
DI void phase_moe1(const Params& p, int layer, char* smem) {
    TPMoe1 tp;
    moe_sched(p, layer, tp.s, tp.cnt);
    tp.H = (const bf16_t*)(p.ws + OFF_H); tp.W13 = (const bf16_t*)(p.ws + OFF_MOEW); tp.stok = (const int*)(p.ws + OFF_STOK); tp.hid = (bf16_t*)(p.ws + OFF_SCR + S_HID);
    gemm8_run(tp, 16, smem);
}
struct EpiMoe2 {
    static constexpr bool STAGED = false;
    bf16_t* Y; const int* stok; const float* sw; int nvalid, n0;
    DI void operator()(const f32x4 (&acc)[4][4], int rb, int cb, int fr, int fq) const {
        int tkm[4]; float wm[4];
#pragma unroll
        for (int m = 0; m < 4; ++m) { tkm[m] = stok[rb + m * 16 + fr]; wm[m] = sw[rb + m * 16 + fr]; }
#pragma unroll
        for (int m = 0; m < 4; ++m) {
            const int r = rb + m * 16 + fr;
            if (r < nvalid) {
                const int tk = tkm[m]; const float w = wm[m];
                bf16_t* dst = Y + (size_t)tk * 1024 + n0 + cb + fq * 4;
#pragma unroll
                for (int n = 0; n < 4; ++n) { const f32x4 a = acc[m][n] * w; u32x2 o; o[0] = pk_bf16(a[0], a[1]); o[1] = pk_bf16(a[2], a[3]); *(u32x2*)(dst + n * 16) = o; }
            }
        }
    }
};
struct TPMoe2 {
    typedef G8Rows AS; typedef G8Rows BS; typedef EpiMoe2 EPI;
    MoeSched s; int cnt[16];
    const bf16_t* hid; const bf16_t* W2; const int* stok; const float* sw; bf16_t* Y;
    DI bool get(int k, AS& as, BS& bs, EPI& epi) const {
        int mg, nt; if (!xcd_tile(k, s.base[16], 4, mg, nt)) return false;
        int e = 0;
#pragma unroll
        for (int i = 1; i < 16; ++i) if (mg >= s.base[i]) e = i;
        int ce = 0, be = 0;
#pragma unroll
        for (int i = 0; i < 16; ++i) if (i == e) { ce = cnt[i]; be = s.base[i]; }
        const int ml = mg - be;
        as = g8_arows(hid + (size_t)mg * 256 * 1024, 1024); bs = g8_brows(W2 + (size_t)e * 1024 * 1024 + (size_t)nt * 256 * 1024, 1024);
        epi = EpiMoe2{Y, stok + (size_t)e * CAP + ml * 256, sw + (size_t)e * CAP + ml * 256, ce - ml * 256, nt * 256};
        return true;
    }
};
DI void phase_moe2(const Params& p, int layer, char* smem) {
    TPMoe2 tp;
    moe_sched(p, layer, tp.s, tp.cnt);
    tp.hid = (const bf16_t*)(p.ws + OFF_SCR + S_HID); tp.W2 = (const bf16_t*)(p.ws + OFF_MOEW) + (size_t)16 * 2048 * 1024;
    tp.stok = (const int*)(p.ws + OFF_STOK); tp.sw = (const float*)(p.ws + OFF_SW); tp.Y = (bf16_t*)(p.ws + OFF_SCR + S_Y);
    gemm8_run(tp, 16, smem);
}

struct EpiRwkv {
    bf16_t* dst; int ld, m0, n0, act, nstore;
    DI void operator()(const f32x4 (&acc)[4][4], int rb, int cb, int fr, int fq) const {
#pragma unroll
        for (int m = 0; m < 4; ++m) {
            bf16_t* d = dst + (size_t)(m0 + rb + m * 16 + fr) * ld + n0 + cb + fq * 4;
#pragma unroll
            for (int n = 0; n < 4; ++n) {
                const int c = n0 + cb + n * 16 + fq * 4;
                if (c >= ld) continue;
                f32x4 a = acc[m][n];
                if (act == 1) {
#pragma unroll
                    for (int j = 0; j < 4; ++j) { const float e = __builtin_amdgcn_exp2f(a[j] * (2.0f * LOG2E)); a[j] = 1.0f - 2.0f * __builtin_amdgcn_rcpf(e + 1.0f); }
                }
                if (act == 2) {
#pragma unroll
                    for (int j = 0; j < 4; ++j) a[j] = sigmoidf_(a[j]);
                }
                if (c >= nstore) a = (f32x4){0.f, 0.f, 0.f, 0.f};
                u32x2 o; o[0] = pk_bf16(a[0], a[1]); o[1] = pk_bf16(a[2], a[3]);
                *(u32x2*)(d + n * 16) = o;
            }
        }
    }
};
DI void phase_rwkv_proj(const Params& p, char* smem) {
    const bf16_t* H = (const bf16_t*)(p.ws + OFF_H);
    const bf16_t* XX = (const bf16_t*)(p.ws + OFF_SCR + S_XX);
    const bf16_t* wsm = (const bf16_t*)(p.ws + OFF_WS);
    constexpr int MT = TTOT / 256, NU = 14;
    for (int u = blockIdx.x; u < MT * NU; u += gridDim.x) {
        const int mt = u / NU, q = u % NU;
        ALMix al{H + (size_t)mt * 256 * DM, XX + (size_t)mt * 256 * DM, (const LAS float*)(smem + GEMM_SMEM)};
        if (q < 13) {
            const int job = q < 4 ? 0 : q < 8 ? 1 : q < 12 ? 2 : 5, nt = q < 12 ? (q & 3) : 0;
            const int mixj = job == 0 ? 0 : job == 1 ? 2 : job == 2 ? 3 : 5;
            const size_t wofs = job == 0 ? W_R : job == 1 ? W_K : job == 2 ? W_V : W_G1;
            const size_t dofs = job == 0 ? S_R : job == 1 ? S_KK : job == 2 ? S_V : S_LG;
            al.set_mix(p.rwkv_x_mix + mixj * DM);
            EpiRwkv epi{(bf16_t*)(p.ws + OFF_SCR + dofs), job == 5 ? 192 : 1024, mt * 256, nt * 256, job == 5 ? 2 : 0, job == 5 ? 160 : 4096};
            gemm_tile<2>(al, wsm + wofs + (size_t)nt * 256 * DM, DM, DM / 64, epi, smem);
        } else {
#pragma unroll 1
            for (int j = 0; j < 2; ++j) {
                al.set_mix(p.rwkv_x_mix + (j == 0 ? 1 : 4) * DM);
                EpiRwkv epi{(bf16_t*)(p.ws + OFF_SCR + (j == 0 ? S_LW : S_LA)), 128, mt * 256, 0, j == 0 ? 1 : 0, 4096};
                gemm_tile<1>(al, wsm + (j == 0 ? W_W1 : W_A1), DM, DM / 64, epi, smem);
            }
        }
    }
}

struct EpiGate {
    const Params* p; int m0, n0;
    DI void operator()(const f32x4 (&acc)[4][4], int rb, int cb, int fr, int fq) const {
        const bf16_t* Y0 = (const bf16_t*)(p->ws + OFF_H);
        const bf16_t* Y1 = (const bf16_t*)(p->ws + OFF_SCR + S_Y1);
        const bf16_t* V = (const bf16_t*)(p->ws + OFF_SCR + S_V);
        const float* bonus = (const float*)(p->ws + OFF_BONUS2);
        bf16_t* O = (bf16_t*)(p->ws + OFF_SCR + S_OR);
        const int c0 = n0 + cb, hd = c0 >> 6;
#pragma unroll
        for (int m = 0; m < 4; ++m) {
            const int tok = m0 + rb + m * 16 + fr;
            const size_t ro = (size_t)tok * DM + c0 + fq * 4;
            f32x4 y[4];
            float s = 0.f;
#pragma unroll
            for (int n = 0; n < 4; ++n) {
                const u32x2 a = *(const u32x2*)(Y0 + ro + n * 16), b = *(const u32x2*)(Y1 + ro + n * 16);
                y[n][0] = bf_lo(a[0]) + bf_lo(b[0]); y[n][1] = bf_hi(a[0]) + bf_hi(b[0]); y[n][2] = bf_lo(a[1]) + bf_lo(b[1]); y[n][3] = bf_hi(a[1]) + bf_hi(b[1]);
                s += y[n][0] + y[n][1] + y[n][2] + y[n][3];
            }
            s += __shfl_xor(s, 16); s += __shfl_xor(s, 32);
            const float mu = s * (1.0f / 64.0f);
            float q = 0.f;
#pragma unroll
            for (int n = 0; n < 4; ++n) { const f32x4 d = y[n] - mu; q += d[0] * d[0] + d[1] * d[1] + d[2] * d[2] + d[3] * d[3]; }
            q += __shfl_xor(q, 16); q += __shfl_xor(q, 32);
            const float rs = rsqrtf(q * (1.0f / 64.0f) + GN_EPS);
            const float bon = (bonus[(size_t)tok * 16 + hd] + bonus[(size_t)(TTOT + tok) * 16 + hd]) + (bonus[(size_t)(2 * TTOT + tok) * 16 + hd] + bonus[(size_t)(3 * TTOT + tok) * 16 + hd]);
#pragma unroll
            for (int n = 0; n < 4; ++n) {
                const int c = c0 + n * 16 + fq * 4;
                const f32x4 g = *(const f32x4*)(p->rwkv_ln_g + c), bb = *(const f32x4*)(p->rwkv_ln_b + c);
                const u32x2 vv = *(const u32x2*)(V + ro + n * 16);
                const f32x4 v4 = {bf_lo(vv[0]), bf_hi(vv[0]), bf_lo(vv[1]), bf_hi(vv[1])};
                const f32x4 o = ((y[n] - mu) * rs * g + bb + bon * v4) * acc[m][n];
                u32x2 w; w[0] = pk_bf16(o[0], o[1]); w[1] = pk_bf16(o[2], o[3]);
                *(u32x2*)(O + ro + n * 16) = w;
            }
        }
    }
};
DI void phase_gate(const Params& p, char* smem) {
    const bf16_t* LG = (const bf16_t*)(p.ws + OFF_SCR + S_LG);
    const bf16_t* W = (const bf16_t*)(p.ws + OFF_WS) + W_G2;
    constexpr int NT = 8, MTL = SEQ / 256;
    for (int k = 0;; ++k) {
        int mi, nt; if (!xcd_tile(k, NBATCH * MTL, NT, mi, nt)) break;
        const int mt = (mi / MTL) * (PTOT / 256) + 1 + (mi % MTL);
        ALPlain al{LG + (size_t)mt * 256 * 192, 192};
        EpiGate epi{&p, mt * 256, nt * 128};
        gemm_tile<1>(al, W + (size_t)nt * 128 * 192, 192, 3, epi, smem);
    }
}

constexpr int KROW = 72, VROW = 68;
constexpr int ATT_SMEM = 2 * 64 * KROW * 2 + 2 * 64 * VROW * 2;
DI int crow_(int i, int h) { return (i & 3) + 8 * (i >> 2) + 4 * h; }
#define MFMA32(a, b, c) __builtin_amdgcn_mfma_f32_32x32x16_bf16((a), (b), (c), 0, 0, 0)
template <int MODE>
DI void attn_unit(const Params& p, const bf16_t* Qg  , int nq_valid, const bf16_t* Kg  , const bf16_t* Vg  ,
                  int ta0, int ta1, int tb0, int tb1  , bool band, int q_lat0  ,
                  float init_m, float init_l0, bf16_t* Og  , char* smem) {
    const int t = tidx(), lane = t & 63, wid = t >> 6, r = lane & 31, h = lane >> 5;
    bf16_t* sK = (bf16_t*)smem;
    bf16_t* sV = sK + 2 * 64 * KROW;
    bf16x8 qf[2][4];
#pragma unroll
    for (int qs = 0; qs < 2; ++qs) {
        const int qi = wid * 64 + qs * 32 + r;
        const bf16_t* qp = Qg + (size_t)(qi < nq_valid ? qi : 0) * 64 + 8 * h;
#pragma unroll
        for (int ks = 0; ks < 4; ++ks) qf[qs][ks] = *(const bf16x8*)(qp + ks * 16);
    }
#pragma unroll
    for (int qs = 0; qs < 2; ++qs)
#pragma unroll
        for (int ks = 0; ks < 4; ++ks) asm volatile("" : "+v"(qf[qs][ks]));
    f32x16 o[2][2];
#pragma unroll
    for (int qs = 0; qs < 2; ++qs)
#pragma unroll
        for (int dt = 0; dt < 2; ++dt)
#pragma unroll
            for (int i = 0; i < 16; ++i) o[qs][dt][i] = 0.f;
    float mrun[2], lrun[2];
#pragma unroll
    for (int qs = 0; qs < 2; ++qs) { mrun[qs] = init_m; lrun[qs] = (MODE == 1 && h == 0) ? init_l0 : 0.f; }
    const int ntile = ((ta1 - ta0) + (tb1 - tb0)) >> 6;
    const int lrow = t >> 3, lch = (t & 7) * 8;
    u32x4 rk, rv;
    auto tile_pos = [&](int i) { const int a = (ta1 - ta0) >> 6; return i < a ? ta0 + i * 64 : tb0 + (i - a) * 64; };
    {
        const int kp = tile_pos(0);
        rk = *(const u32x4*)(Kg + (size_t)(kp + lrow) * 64 + lch);
        rv = *(const u32x4*)(Vg + (size_t)lrow * PTOT + kp + lch);
        *(u32x4*)(sK + lrow * KROW + lch) = rk;
        *(u32x2*)(sV + lrow * VROW + lch) = (u32x2){rv[0], rv[1]};
        *(u32x2*)(sV + lrow * VROW + lch + 4) = (u32x2){rv[2], rv[3]};
    }
    __syncthreads();
    if (__builtin_amdgcn_readfirstlane(wid) >= 4) __builtin_amdgcn_s_setprio(1);
    for (int it = 0; it < ntile; ++it) {
        const int cur = it & 1;
        const bool more = it + 1 < ntile;
        const int kp = tile_pos(it);
        if (more) {
            const int kn = tile_pos(it + 1);
            rk = *(const u32x4*)(Kg + (size_t)(kn + lrow) * 64 + lch);
            rv = *(const u32x4*)(Vg + (size_t)lrow * PTOT + kn + lch);
        }
        __builtin_amdgcn_sched_barrier(0);
        const bf16_t* cK = sK + cur * 64 * KROW;
        const bf16_t* cV = sV + cur * 64 * VROW;
        bool need = true;
        if (MODE == 1 && band && kp >= LCTX) {
            const int q0 = q_lat0 + __builtin_amdgcn_readfirstlane(wid) * 64, k0 = kp - LCTX;
            need = (k0 + 63 >= q0 - 128) && (k0 <= q0 + 63 + 128);
        }
        if (need) {
        bf16x8 kf[4];
#pragma unroll
        for (int ks = 0; ks < 4; ++ks) kf[ks] = *(const bf16x8*)(cK + r * KROW + ks * 16 + 8 * h);
#pragma unroll
        for (int ksub = 0; ksub < 2; ++ksub) {
            bf16x8 vf[2][2];
#pragma unroll
            for (int st = 0; st < 2; ++st)
#pragma unroll
                for (int dt = 0; dt < 2; ++dt) {
                    const int kb = ksub * 32 + 16 * st + 4 * h;
                    const s16x4 lo = *(const s16x4*)(cV + (dt * 32 + r) * VROW + kb), hi = *(const s16x4*)(cV + (dt * 32 + r) * VROW + kb + 8);
                    vf[st][dt] = __builtin_shufflevector(lo, hi, 0, 1, 2, 3, 4, 5, 6, 7);
                }
            __builtin_amdgcn_sched_barrier(0);
            f32x16 sc[2];
#pragma unroll
            for (int qs = 0; qs < 2; ++qs)
#pragma unroll
                for (int i = 0; i < 16; ++i) sc[qs][i] = MODE == 0 ? init_m : 0.f;
#pragma unroll
            for (int ks = 0; ks < 4; ++ks)
#pragma unroll
                for (int qs = 0; qs < 2; ++qs) sc[qs] = MFMA32(kf[ks], qf[qs][ks], sc[qs]);
            __builtin_amdgcn_sched_barrier(0);
            if (ksub == 0) {
#pragma unroll
                for (int ks = 0; ks < 4; ++ks) kf[ks] = *(const bf16x8*)(cK + (32 + r) * KROW + ks * 16 + 8 * h);
            }
            __builtin_amdgcn_sched_barrier(0);
#pragma unroll
            for (int qs = 0; qs < 2; ++qs) {
                if (MODE == 1) {
                    if (band && kp >= LCTX) {
                        const int qlat = q_lat0 + wid * 64 + qs * 32 + r, kl0 = kp - LCTX + ksub * 32;
#pragma unroll
                        for (int i = 0; i < 16; ++i) {
                            const int d0 = qlat - (kl0 + crow_(i, h));
                            if (d0 > 128 || d0 < -128) sc[qs][i] = -1e30f;
                        }
                    }
                    float mt = sc[qs][0];
#pragma unroll
                    for (int i = 1; i < 16; ++i) mt = fmaxf(mt, sc[qs][i]);
                    mt = fmaxf(mt, __shfl_xor(mt, 32));
                    const float mnew = fmaxf(mrun[qs], mt);
                    const float alpha = __builtin_amdgcn_exp2f(mrun[qs] - mnew);
                    mrun[qs] = mnew; lrun[qs] *= alpha;
#pragma unroll
                    for (int i = 0; i < 16; ++i) { o[qs][0][i] *= alpha; o[qs][1][i] *= alpha; }
#pragma unroll
                    for (int i = 0; i < 16; ++i) sc[qs][i] -= mnew;
                }
                float ls = 0.f;
#pragma unroll
                for (int i = 0; i < 16; ++i) { sc[qs][i] = __builtin_amdgcn_exp2f(sc[qs][i]); ls += sc[qs][i]; }
                lrun[qs] += ls;
            }
#pragma unroll
            for (int st = 0; st < 2; ++st) {
                bf16x8 pf[2];
#pragma unroll
                for (int qs = 0; qs < 2; ++qs) {
                    u32x4 pw;
#pragma unroll
                    for (int j = 0; j < 4; ++j) pw[j] = pk_bf16(sc[qs][8 * st + 2 * j], sc[qs][8 * st + 2 * j + 1]);
                    pf[qs] = __builtin_bit_cast(bf16x8, pw);
                }
#pragma unroll
                for (int dt = 0; dt < 2; ++dt)
#pragma unroll
                    for (int qs = 0; qs < 2; ++qs) o[qs][dt] = MFMA32(vf[st][dt], pf[qs], o[qs][dt]);
            }
        }
        }
        if (more) {
            bf16_t* nK = sK + (cur ^ 1) * 64 * KROW;
            bf16_t* nV = sV + (cur ^ 1) * 64 * VROW;
            *(u32x4*)(nK + lrow * KROW + lch) = rk;
            *(u32x2*)(nV + lrow * VROW + lch) = (u32x2){rv[0], rv[1]};
            *(u32x2*)(nV + lrow * VROW + lch + 4) = (u32x2){rv[2], rv[3]};
        }
        __syncthreads();
    }
    __builtin_amdgcn_s_setprio(0);
#pragma unroll
    for (int qs = 0; qs < 2; ++qs) {
        const int qi = wid * 64 + qs * 32 + r;
        const float lt = lrun[qs] + __shfl_xor(lrun[qs], 32);
        const float invl = 1.0f / lt;
        if (qi < nq_valid) {
            bf16_t* op = Og + (size_t)qi * DM;
#pragma unroll
            for (int g = 0; g < 4; ++g) {
                u32x2 w0, w1;
                w0[0] = pk_bf16(o[qs][0][4 * g] * invl, o[qs][0][4 * g + 1] * invl); w0[1] = pk_bf16(o[qs][0][4 * g + 2] * invl, o[qs][0][4 * g + 3] * invl);
                w1[0] = pk_bf16(o[qs][1][4 * g] * invl, o[qs][1][4 * g + 1] * invl); w1[1] = pk_bf16(o[qs][1][4 * g + 2] * invl, o[qs][1][4 * g + 3] * invl);
                *(u32x2*)(op + 8 * g + 4 * h) = w0;
                *(u32x2*)(op + 32 + 8 * g + 4 * h) = w1;
            }
        }
    }
}
DI void phase_attn(const Params& p, char* smem) {
    const bf16_t* Q = (const bf16_t*)(p.ws + OFF_SCR + S_Q);
    const bf16_t* K = (const bf16_t*)(p.ws + OFF_SCR + S_K);
    const bf16_t* VT = (const bf16_t*)(p.ws + OFF_SCR + S_VT);
    bf16_t* O = (bf16_t*)(p.ws + OFF_SCR + S_O);
    float gq = 0.f, gk = 0.f;
    for (int i = 0; i < 64; ++i) { gq = fmaxf(gq, fabsf(p.attn_q_norm_g[i])); gk = fmaxf(gk, fabsf(p.attn_k_norm_g[i])); }
    const float M2 = 8.25f * gq * gk * LOG2E;
    constexpr int QB = 512, NQB = SEQ / QB;
    const int G = gridDim.x;
    constexpr int NDENSE = NBATCH * 8 * NQB;
    for (int u = blockIdx.x; u < NDENSE; u += G) {
        int combo, within;
        if ((G & 7) == 0 && NDENSE % G == 0) {
            const int xcd = blockIdx.x & 7, idx = (blockIdx.x >> 3) + (G >> 3) * (u / G);
            combo = xcd & 3; within = (xcd >> 2) * (NDENSE / 8) + idx;
        } else { combo = u / (4 * NQB); within = u % (4 * NQB); }
        const int b = combo >> 1, kvh = combo & 1, hq = kvh * 4 + (within & 3), qb = within >> 2;
        const bf16_t* Qg = Q + ((size_t)(b * 16 + 8 + hq) * PTOT + LCTX + qb * QB) * 64;
        attn_unit<0>(p, Qg, QB, K + (size_t)(b * 4 + 2 + kvh) * PTOT * 64, VT + (size_t)(b * 4 + 2 + kvh) * 64 * PTOT, 0, PTOT, 0, 0, false, 0, -M2, 0.f,
                     O + (size_t)(b * PTOT + LCTX + qb * QB) * DM + (8 + hq) * 64, smem);
    }
    for (int u = blockIdx.x; u < NDENSE; u += G) {
        const int b = u / (8 * NQB), rem = u % (8 * NQB), qb = rem >> 3, hq = rem & 7, kvh = hq >> 2;
        const int i0 = qb * QB;
        const int lo = i0 - 128 < 0 ? 0 : i0 - 128, hi = i0 + QB + 128 > SEQ ? SEQ : i0 + QB + 128;
        const bf16_t* Qg = Q + ((size_t)(b * 16 + hq) * PTOT + LCTX + i0) * 64;
        attn_unit<1>(p, Qg, QB, K + (size_t)(b * 4 + kvh) * PTOT * 64, VT + (size_t)(b * 4 + kvh) * 64 * PTOT, 0, LCTX, LCTX + lo, LCTX + hi, true, i0,
                     p.attn_sink[hq] * LOG2E, 1.0f, O + (size_t)(b * PTOT + LCTX + i0) * DM + hq * 64, smem);
    }
    for (int u = blockIdx.x; u < NBATCH * 16; u += G) {
        const int b = u >> 4, hh = u & 15, isb = hh >> 3, hq = hh & 7, kvh = isb * 2 + (hq >> 2);
        const bf16_t* Qg = Q + ((size_t)(b * 16 + hh) * PTOT) * 64;
        attn_unit<1>(p, Qg, LCTX, K + (size_t)(b * 4 + kvh) * PTOT * 64, VT + (size_t)(b * 4 + kvh) * 64 * PTOT, 0, LCTX, 0, 0, false, 0,
                     isb ? -1e30f : p.attn_sink[hq] * LOG2E, isb ? 0.f : 1.0f, O + (size_t)(b * PTOT) * DM + hh * 64, smem);
    }
}

constexpr int TB = 32, NBUF = 3;
constexpr int SC_REC = 5 * 64;
constexpr int SC_OPS = TB * SC_REC * 4;
constexpr int SC_SMEM = NBUF * SC_OPS + NBUF * TB * 16 * 4 + NBUF * TB * 16 * 4 + 64;
DI int scan_pos(int n, int dir) {
    if (n < LCTX) return dir ? LCTX - 1 - n : n;
    const int m = n - LCTX;
    return LCTX + (dir ? SEQ - 1 - m : m);
}
template <int CTRL> DI float dpp_add(float v) { return v + __builtin_bit_cast(float, __builtin_amdgcn_update_dpp(0, __builtin_bit_cast(int, v), CTRL, 0xf, 0xf, false)); }
DI float row16_sum(float v) { v = dpp_add<0x128>(v); v = dpp_add<0x124>(v); v = dpp_add<0x122>(v); v = dpp_add<0x121>(v); return v; }
DI int lds_min4(int* c) { const volatile LAS int* q = (const volatile LAS int*)c; const int a = q[0], b = q[1], d = q[2], e = q[3]; return min(min(a, b), min(d, e)); }
DI void lds_publish(int* c, int v) { *(volatile LAS int*)c = v; }
DI void scan_unit(const Params& p, int u, char* smem) {
    const int t = tidx(), lane = t & 63, wid = __builtin_amdgcn_readfirstlane(t >> 6);
    const unsigned rg = u & 3, dir = (u >> 2) & 1, hd = (u >> 3) & 15, b = u >> 7;
    float* ops = (float*)smem;
    float* vbuf = (float*)(smem + NBUF * SC_OPS);
    float* ybuf = vbuf + NBUF * TB * 16;
    int* cnts = (int*)(ybuf + NBUF * TB * 16);
    const bf16_t* R = (const bf16_t*)(p.ws + OFF_SCR + S_R);
    const bf16_t* Kk = (const bf16_t*)(p.ws + OFF_SCR + S_KK);
    const bf16_t* V = (const bf16_t*)(p.ws + OFF_SCR + S_V);
    const bf16_t* LW = (const bf16_t*)(p.ws + OFF_SCR + S_LW);
    const bf16_t* LA = (const bf16_t*)(p.ws + OFF_SCR + S_LA);
    bf16_t* Yo = dir ? (bf16_t*)(p.ws + OFF_SCR + S_Y1) : (bf16_t*)(p.ws + OFF_H);
    float* bonus = (float*)(p.ws + OFF_BONUS2);
    const unsigned tokb = b * PTOT, hc = hd * 64;
    constexpr int NBLK = PTOT / TB;
    const unsigned fr = lane & 15, fq = lane >> 4;
    if (t < 8) cnts[t] = 0;
    __syncthreads();

    if (wid < 4) {
        __builtin_amdgcn_s_setprio(3);
        float s0 = 0.f, s1 = 0.f, s2 = 0.f, s3 = 0.f;
        const unsigned g = lane >> 4, c4 = (lane & 15) * 4, myrow = wid * 4 + g;
        for (int blk = 0; blk < NBLK; ++blk) {
            const unsigned buf = (unsigned)blk % NBUF;
            while (lds_min4(cnts) < blk + 1) __builtin_amdgcn_s_sleep(1);
            asm volatile("" ::: "memory");
            const float* rec = ops + buf * (TB * SC_REC) + c4;
            const float* vb = vbuf + buf * (TB * 16) + myrow;
            float* yb = ybuf + buf * (TB * 16) + myrow;
            f32x4 w0_ = *(const f32x4*)(rec), kd0_ = *(const f32x4*)(rec + 64), bb0_ = *(const f32x4*)(rec + 128), aa0_ = *(const f32x4*)(rec + 192), rr0_ = *(const f32x4*)(rec + 256);
            float vv0_ = vb[0];
#define SCAN_STEP(W, KD, BB, AA, RR, VV, ST) { \
                float sa = s0 * AA[0] + s1 * AA[1] + s2 * AA[2] + s3 * AA[3]; \
                sa = row16_sum(sa); \
                s0 = s0 * W[0] + sa * BB[0] + VV * KD[0]; \
                s1 = s1 * W[1] + sa * BB[1] + VV * KD[1]; \
                s2 = s2 * W[2] + sa * BB[2] + VV * KD[2]; \
                s3 = s3 * W[3] + sa * BB[3] + VV * KD[3]; \
                float y = s0 * RR[0] + s1 * RR[1] + s2 * RR[2] + s3 * RR[3]; \
                y = row16_sum(y); \
                if ((lane & 15) == 0) yb[(ST) * 16] = y; }
#pragma unroll 1
            for (int st = 0; st < TB; st += 2) {
                const float* r1 = rec + (st + 1) * SC_REC;
                const f32x4 w1_ = *(const f32x4*)(r1), kd1_ = *(const f32x4*)(r1 + 64), bb1_ = *(const f32x4*)(r1 + 128), aa1_ = *(const f32x4*)(r1 + 192), rr1_ = *(const f32x4*)(r1 + 256);
                const float vv1_ = vb[(st + 1) * 16];
                SCAN_STEP(w0_, kd0_, bb0_, aa0_, rr0_, vv0_, st)
                const int st2 = st + 2 < TB ? st + 2 : st;
                const float* r2 = rec + st2 * SC_REC;
                w0_ = *(const f32x4*)(r2); kd0_ = *(const f32x4*)(r2 + 64); bb0_ = *(const f32x4*)(r2 + 128); aa0_ = *(const f32x4*)(r2 + 192); rr0_ = *(const f32x4*)(r2 + 256);
                vv0_ = vb[st2 * 16];
                SCAN_STEP(w1_, kd1_, bb1_, aa1_, rr1_, vv1_, st + 1)
            }
#undef SCAN_STEP
            asm volatile("s_waitcnt lgkmcnt(0)" ::: "memory");
            if (lane == 0) lds_publish(cnts + 4 + wid, blk + 1);
        }
        __builtin_amdgcn_s_setprio(0);
    } else {
        const unsigned wt = wid & 1, chh = (wid >> 1) & 1;
        const bf16_t* wsm = (const bf16_t*)(p.ws + OFF_WS);
        const unsigned wo = W_W2 + dir * 65536u + (hc + fr) * 64u + fq * 8u;
        const unsigned ao = W_A2 + dir * 65536u + (hc + fr) * 64u + fq * 8u;
        const unsigned po = hc + fq * 4u;
        for (int blk = 0; blk < NBLK + NBUF; ++blk) {
            const unsigned buf = (unsigned)blk % NBUF;
            const int need = blk - NBUF + 1 < NBLK ? blk - NBUF + 1 : NBLK;
            while (lds_min4(cnts + 4) < need) __builtin_amdgcn_s_sleep(1);
            asm volatile("" ::: "memory");
            if (wid == 7 && blk >= NBUF) {
#pragma unroll
                for (int i = 0; i < TB * 16 / 64; ++i) {
                    const unsigned id = i * 64 + lane, st = id >> 4, rw = id & 15;
                    const unsigned tok = tokb + scan_pos((blk - NBUF) * TB + st, dir);
                    Yo[tok * 1024u + hc + rg * 16 + rw] = (bf16_t)(pk_bf16(ybuf[buf * (TB * 16) + id], 0.f) & 0xffffu);
                }
            }
            if (blk >= NBLK) continue;
            const unsigned st = wt * 16 + fr;
            const unsigned tok = tokb + scan_pos(blk * TB + st, dir);
            const unsigned lo = tok * 128u + dir * 64u + fq * 8u;
            const unsigned ro = tok * 1024u + hc + fq * 4u;
            bf16x8 lwf[2], laf[2];
#pragma unroll
            for (int kk = 0; kk < 2; ++kk) { lwf[kk] = *(const bf16x8*)(LW + lo + kk * 32); laf[kk] = *(const bf16x8*)(LA + lo + kk * 32); }
            float ssq = 0.f;
#pragma unroll
            for (int nt = 0; nt < 4; ++nt) {
                const f32x4 kkv = *(const f32x4*)(p.rwkv_k_k + po + nt * 16);
                const u32x2 c = *(const u32x2*)(Kk + ro + nt * 16);
                const float q0 = bf_lo(c[0]) * kkv[0], q1 = bf_hi(c[0]) * kkv[1], q2 = bf_lo(c[1]) * kkv[2], q3 = bf_hi(c[1]) * kkv[3];
                ssq += q0 * q0 + q1 * q1 + q2 * q2 + q3 * q3;
            }
            ssq += __shfl_xor(ssq, 16); ssq += __shfl_xor(ssq, 32);
            const float kn = __builtin_amdgcn_rsqf(fmaxf(ssq, 1e-24f));
            float* rec = ops + buf * (TB * SC_REC) + st * SC_REC + fq * 4;
            float bsum = 0.f;
#pragma unroll
            for (int n2 = 0; n2 < 2; ++n2) {
                const unsigned nt = chh * 2 + n2;
                f32x4 aw = {0.f, 0.f, 0.f, 0.f}, ai = aw;
#pragma unroll
                for (int kk = 0; kk < 2; ++kk) {
                    const bf16x8 w2f = *(const bf16x8*)(wsm + wo + nt * 1024 + kk * 32), a2f = *(const bf16x8*)(wsm + ao + nt * 1024 + kk * 32);
                    aw = __builtin_amdgcn_mfma_f32_16x16x32_bf16(w2f, lwf[kk], aw, 0, 0, 0);
                    ai = __builtin_amdgcn_mfma_f32_16x16x32_bf16(a2f, laf[kk], ai, 0, 0, 0);
                }
                const f32x4 w0v = *(const f32x4*)(p.rwkv_decay_w0 + dir * 1024u + po + nt * 16), a0v = *(const f32x4*)(p.rwkv_iclr_a0 + dir * 1024u + po + nt * 16);
                const f32x4 kkv = *(const f32x4*)(p.rwkv_k_k + po + nt * 16);
                const f32x4 kav = *(const f32x4*)(p.rwkv_k_a + po + nt * 16), rkv = *(const f32x4*)(p.rwkv_r_k + po + nt * 16);
                const u32x2 a = *(const u32x2*)(R + ro + nt * 16), c = *(const u32x2*)(Kk + ro + nt * 16);
                const f32x4 rr = {bf_lo(a[0]), bf_hi(a[0]), bf_lo(a[1]), bf_hi(a[1])};
                const f32x4 kr = {bf_lo(c[0]), bf_hi(c[0]), bf_lo(c[1]), bf_hi(c[1])};
                f32x4 wv, kd, bb, aa;
#pragma unroll
                for (int j = 0; j < 4; ++j) {
                    const float sg = __builtin_amdgcn_rcpf(1.0f + __builtin_amdgcn_exp2f(-(w0v[j] + aw[j]) * LOG2E));
                    wv[j] = __builtin_amdgcn_exp2f(sg * (-0.6065306597126334f * LOG2E));
                    const float ic = __builtin_amdgcn_rcpf(1.0f + __builtin_amdgcn_exp2f(-(a0v[j] + ai[j]) * LOG2E));
                    const float kkn = kr[j] * kkv[j] * kn;
                    kd[j] = kr[j] * (1.0f + (ic - 1.0f) * kav[j]);
                    bb[j] = kkn * ic;
                    aa[j] = -kkn;
                    bsum += rr[j] * kd[j] * rkv[j];
                }
                *(f32x4*)(rec + 0 * 64 + nt * 16) = wv;
                *(f32x4*)(rec + 1 * 64 + nt * 16) = kd;
                *(f32x4*)(rec + 2 * 64 + nt * 16) = bb;
                *(f32x4*)(rec + 3 * 64 + nt * 16) = aa;
                *(f32x4*)(rec + 4 * 64 + nt * 16) = rr;
            }
            bsum += __shfl_xor(bsum, 16); bsum += __shfl_xor(bsum, 32);
            if (rg == 0 && fq == 0) bonus[((chh * 2 + dir) * TTOT + tok) * 16u + hd] = bsum;
            if (wid == 6) {
                bf16_t vr[TB * 16 / 64];
#pragma unroll
                for (int i = 0; i < TB * 16 / 64; ++i) {
                    const unsigned id = i * 64 + lane, s2 = id >> 4, rw = id & 15;
                    const unsigned tk = tokb + scan_pos(blk * TB + s2, dir);
                    vr[i] = V[tk * 1024u + hc + rg * 16 + rw];
                }
#pragma unroll
                for (int i = 0; i < TB * 16 / 64; ++i) vbuf[buf * (TB * 16) + i * 64 + lane] = bf2f(vr[i]);
            }
            asm volatile("s_waitcnt lgkmcnt(0)" ::: "memory");
            if (lane == 0) lds_publish(cnts + (wid - 4), blk + 1);
        }
    }
    __syncthreads();
}

constexpr int CH = 16, NCHK = PTOT / CH;
constexpr int NPREP = 7, NSLOT = 2;
constexpr int TKS = 72, KTS = 20, SMS = 20;
constexpr int SL_XA = 0, SL_XR = SL_XA + 16 * TKS * 2, SL_TB = SL_XR + 16 * TKS * 2, SL_TK = SL_TB + 64 * KTS * 2, SL_TT = SL_TK + 64 * KTS * 2, SL_NAK = SL_TT + 16 * SMS * 2,
              SL_NRB = SL_NAK + 16 * SMS * 2, SL_NRK = SL_NRB + 16 * SMS * 2, SL_VT = SL_NRK + 16 * SMS * 2, SL_WC = SL_VT + 16 * SMS * 2, SLOT_BYTES = SL_WC + 64 * 4;
constexpr int XTK_B = 16 * TKS * 2, XKT_B = 64 * KTS * 2, SM_B = 16 * SMS * 2;
constexpr int PR_XA = 0, PR_XB = PR_XA + XTK_B, PR_XK = PR_XB + XTK_B, PR_XR = PR_XK + XTK_B, PR_TB = PR_XR + XTK_B, PR_TK = PR_TB + XKT_B,
              PR_SN = PR_TK + XKT_B, PREP_BYTES = PR_SN + 2 * SM_B;
static_assert(10 * SM_B <= 3 * XTK_B, "matrices fit in XA..XK");
constexpr int SC2_SMEM = NSLOT * SLOT_BYTES + NPREP * PREP_BYTES + 64 + 5 * 64 * 4;
typedef short s16x4v __attribute__((ext_vector_type(4)));
DI f32x4 mfma16(s16x4v a, s16x4v b, f32x4 c) { return __builtin_amdgcn_mfma_f32_16x16x16bf16_1k(a, b, c, 0, 0, 0); }
DI f32x4 mfma32(bf16x8 a, bf16x8 b, f32x4 c) { return __builtin_amdgcn_mfma_f32_16x16x32_bf16(a, b, c, 0, 0, 0); }
DI s16x4v ld4(const bf16_t* q) { return *(const s16x4v*)q; }
DI f32x4 up4(u32x2 w) { return (f32x4){bf_lo(w[0]), bf_hi(w[0]), bf_lo(w[1]), bf_hi(w[1])}; }
DI f32x4 ld4f(const bf16_t* q) { return up4(*(const u32x2*)q); }
DI void st4(bf16_t* q, f32x4 v) { u32x2 w; w[0] = pk_bf16(v[0], v[1]); w[1] = pk_bf16(v[2], v[3]); *(u32x2*)q = w; }
#define LDS_WAIT() asm volatile("s_waitcnt lgkmcnt(0)" ::: "memory")
template <int CTRL> DI float dpp_shr_add(float v) { return v + __builtin_bit_cast(float, __builtin_amdgcn_update_dpp(0, __builtin_bit_cast(int, v), CTRL, 0xf, 0xf, true)); }
DI float row16_prefix(float v) { v = dpp_shr_add<0x111>(v); v = dpp_shr_add<0x112>(v); v = dpp_shr_add<0x114>(v); v = dpp_shr_add<0x118>(v); return v; }
DI f32x4 mm16(const bf16_t* A, const bf16_t* Bt, int fr, int fq) {
    const s16x4v a = ld4(A + fr * SMS + fq * 4), b = ld4(Bt + fr * SMS + fq * 4);
    LDS_WAIT();
    return mfma16(a, b, (f32x4){0.f, 0.f, 0.f, 0.f});
}
DI f32x4 mm16p(const bf16_t* A, const bf16_t* Bt, const bf16_t* Add, int fr, int fq) {
    const s16x4v a = ld4(A + fr * SMS + fq * 4), b = ld4(Bt + fr * SMS + fq * 4);
    const u32x2 c = *(const u32x2*)(Add + fr * SMS + fq * 4);
    LDS_WAIT();
    return mfma16(a, b, up4(c));
}

DI void scan_unit_chunked(const Params& p, int u, char* smem) {
    const int t = tidx(), lane = t & 63, wid = __builtin_amdgcn_readfirstlane(t >> 6);
    const unsigned rg = u & 3, dir = (u >> 2) & 1, hd = (u >> 3) & 15, b = u >> 7;
    const unsigned tokb = b * PTOT, hc = hd * 64;
    const unsigned fr = lane & 15, fq = lane >> 4;
    char* slots = smem;
    char* prep0 = smem + NSLOT * SLOT_BYTES;
    int* cnts = (int*)(smem + NSLOT * SLOT_BYTES + NPREP * PREP_BYTES);
    const bf16_t* R = (const bf16_t*)(p.ws + OFF_SCR + S_R);
    const bf16_t* Kk = (const bf16_t*)(p.ws + OFF_SCR + S_KK);
    const bf16_t* V = (const bf16_t*)(p.ws + OFF_SCR + S_V);
    const bf16_t* LW = (const bf16_t*)(p.ws + OFF_SCR + S_LW);
    const bf16_t* LA = (const bf16_t*)(p.ws + OFF_SCR + S_LA);
    bf16_t* Yo = dir ? (bf16_t*)(p.ws + OFF_SCR + S_Y1) : (bf16_t*)(p.ws + OFF_H);
    float* bonus = (float*)(p.ws + OFF_BONUS2);
    float* prm = (float*)(cnts + 16);
    if (t < 16) cnts[t] = 0;
    if (t < 64) {
        prm[t] = p.rwkv_decay_w0[dir * 1024u + hc + t]; prm[64 + t] = p.rwkv_iclr_a0[dir * 1024u + hc + t];
        prm[128 + t] = p.rwkv_k_k[hc + t]; prm[192 + t] = p.rwkv_k_a[hc + t]; prm[256 + t] = p.rwkv_r_k[hc + t];
    }
    __syncthreads();

    if (wid == 0) {
        __builtin_amdgcn_s_setprio(3);
        f32x4 st[4];
#pragma unroll
        for (int m = 0; m < 4; ++m) st[m] = (f32x4){0.f, 0.f, 0.f, 0.f};
        for (int c = 0; c < NCHK; ++c) {
            const unsigned sl = (unsigned)c % NSLOT;
            const char* S = slots + sl * SLOT_BYTES;
            while (*(volatile LAS int*)(cnts + sl) < c + 1) __builtin_amdgcn_s_sleep(1);
            LDS_WAIT();
            const int so = fr * SMS + fq * 4;
            const s16x4v vt = ld4((const bf16_t*)(S + SL_VT) + so);
            const s16x4v tt = ld4((const bf16_t*)(S + SL_TT) + so);
            const s16x4v nakt = ld4((const bf16_t*)(S + SL_NAK) + so);
            const s16x4v nrbt = ld4((const bf16_t*)(S + SL_NRB) + so);
            const s16x4v nrkt = ld4((const bf16_t*)(S + SL_NRK) + so);
            s16x4v xal[2], xah[2], xrl[2], xrh[2], tb[4], tk[4];
            f32x4 wc[4];
#pragma unroll
            for (int i = 0; i < 2; ++i) {
                const bf16_t* qa = (const bf16_t*)(S + SL_XA) + fr * TKS + 32 * i + fq * 4; xal[i] = ld4(qa); xah[i] = ld4(qa + 16);
                const bf16_t* qr = (const bf16_t*)(S + SL_XR) + fr * TKS + 32 * i + fq * 4; xrl[i] = ld4(qr); xrh[i] = ld4(qr + 16);
            }
#pragma unroll
            for (int m = 0; m < 4; ++m) {
                wc[m] = *(const f32x4*)((const float*)(S + SL_WC) + 16 * m + fq * 4);
                tb[m] = ld4((const bf16_t*)(S + SL_TB) + (16 * m + fr) * KTS + fq * 4);
                tk[m] = ld4((const bf16_t*)(S + SL_TK) + (16 * m + fr) * KTS + fq * 4);
            }
            LDS_WAIT();
            bf16x8 sb[2];
#pragma unroll
            for (int i = 0; i < 2; ++i) {
                u32x4 w; w[0] = pk_bf16(st[2 * i][0], st[2 * i][1]); w[1] = pk_bf16(st[2 * i][2], st[2 * i][3]); w[2] = pk_bf16(st[2 * i + 1][0], st[2 * i + 1][1]); w[3] = pk_bf16(st[2 * i + 1][2], st[2 * i + 1][3]);
                sb[i] = __builtin_bit_cast(bf16x8, w);
            }
            f32x4 z = {0.f, 0.f, 0.f, 0.f};
#pragma unroll
            for (int i = 0; i < 2; ++i) z = mfma32(__builtin_shufflevector(xal[i], xah[i], 0, 1, 2, 3, 4, 5, 6, 7), sb[i], z);
            z = mfma16(nakt, vt, z);
            u32x2 zw; zw[0] = pk_bf16(z[0], z[1]); zw[1] = pk_bf16(z[2], z[3]);
            const f32x4 uu = mfma16(tt, __builtin_bit_cast(s16x4v, zw), (f32x4){0.f, 0.f, 0.f, 0.f});
            u32x2 uw; uw[0] = pk_bf16(uu[0], uu[1]); uw[1] = pk_bf16(uu[2], uu[3]);
            const s16x4v ub = __builtin_bit_cast(s16x4v, uw);
            f32x4 y = {0.f, 0.f, 0.f, 0.f};
#pragma unroll
            for (int i = 0; i < 2; ++i) y = mfma32(__builtin_shufflevector(xrl[i], xrh[i], 0, 1, 2, 3, 4, 5, 6, 7), sb[i], y);
            y = mfma16(nrkt, vt, y);
            y = mfma16(nrbt, ub, y);
#pragma unroll
            for (int m = 0; m < 4; ++m) {
                f32x4 acc = mfma16(tk[m], vt, st[m]);
                acc = mfma16(tb[m], ub, acc);
                st[m] = acc * wc[m];
            }

#pragma unroll
            for (int j = 0; j < 4; ++j) {
                const unsigned tok = tokb + scan_pos(c * CH + fq * 4 + j, dir);
                Yo[tok * 1024u + hc + rg * 16 + fr] = (bf16_t)(pk_bf16(y[j], 0.f) & 0xffffu);
            }
            asm volatile("" ::: "memory");
            if (lane == 0) *(volatile LAS int*)(cnts + 8) = c + 1;
        }
        __builtin_amdgcn_s_setprio(0);
    } else {
        const unsigned pid = wid - 1;
        char* PS = prep0 + pid * PREP_BYTES;
        bf16_t* XA = (bf16_t*)(PS + PR_XA); bf16_t* XB = (bf16_t*)(PS + PR_XB); bf16_t* XK = (bf16_t*)(PS + PR_XK); bf16_t* XR = (bf16_t*)(PS + PR_XR);
        bf16_t* TB_ = (bf16_t*)(PS + PR_TB); bf16_t* TK = (bf16_t*)(PS + PR_TK);
        bf16_t* SN = (bf16_t*)(PS + PR_SN);
        bf16_t *M = SN, *NABR = SN + 1 * 16 * SMS;
        bf16_t *M2 = XA, *M2T = XA + 1 * 16 * SMS, *M4 = XA + 2 * 16 * SMS, *M4T = XA + 3 * 16 * SMS, *X1 = XA + 4 * 16 * SMS, *G1 = XA + 5 * 16 * SMS, *NAKR = XA + 6 * 16 * SMS,
                *NRBT = XA + 7 * 16 * SMS, *NRKT = XA + 8 * 16 * SMS, *IM = XA + 9 * 16 * SMS;
        bf16_t *M8T = M2, *X2 = M2T, *TT = M4;
        float* WCP = (float*)SN;
        const bf16_t* wsm = (const bf16_t*)(p.ws + OFF_WS);
        const unsigned wo = W_W2 + dir * 65536u + (hc + fr) * 64u + fq * 8u;
        const unsigned ao = W_A2 + dir * 65536u + (hc + fr) * 64u + fq * 8u;
        const unsigned po = hc + fq * 4u;
        const f32x4 z4 = {0.f, 0.f, 0.f, 0.f};
        bf16x8 lwf[2], laf[2];
        u32x2 krw[4], rrw[4];
        unsigned tok_cur = 0;
        auto issue = [&](int c, bf16x8 (&lw)[2], bf16x8 (&la)[2], u32x2 (&kw)[4], u32x2 (&rw)[4], unsigned& tk) {
            tk = tokb + scan_pos(c * CH + fr, dir);
            const unsigned lo = tk * 128u + dir * 64u + fq * 8u, ro = tk * 1024u + hc + fq * 4u;
#pragma unroll
            for (int kk = 0; kk < 2; ++kk) { lw[kk] = *(const bf16x8*)(LW + lo + kk * 32); la[kk] = *(const bf16x8*)(LA + lo + kk * 32); }
#pragma unroll
            for (int nt = 0; nt < 4; ++nt) { kw[nt] = *(const u32x2*)(Kk + ro + nt * 16); rw[nt] = *(const u32x2*)(R + ro + nt * 16); }
        };
        if ((int)pid < NCHK) issue(pid, lwf, laf, krw, rrw, tok_cur);
#pragma unroll
        for (int kk = 0; kk < 2; ++kk) asm volatile("" : "+v"(lwf[kk]), "+v"(laf[kk]));
#pragma unroll
        for (int nt = 0; nt < 4; ++nt) asm volatile("" : "+v"(krw[nt]), "+v"(rrw[nt]));
        auto ldw = [&](bf16x8 (&w)[2][2], int nt) {
#pragma unroll
            for (int kk = 0; kk < 2; ++kk) { w[0][kk] = *(const bf16x8*)(wsm + wo + nt * 1024 + kk * 32); w[1][kk] = *(const bf16x8*)(wsm + ao + nt * 1024 + kk * 32); }
        };
        for (int c = pid; c < NCHK; c += NPREP) {
            bf16x8 wq[2][2], wn[2][2];
            ldw(wq, 0);
            const unsigned tok = tok_cur;
            float ssq = 0.f;
#pragma unroll
            for (int nt = 0; nt < 4; ++nt) {
                const f32x4 kkv = *(const f32x4*)(prm + 128 + fq * 4 + nt * 16);
                const f32x4 q = up4(krw[nt]) * kkv;
                ssq += q[0] * q[0] + q[1] * q[1] + q[2] * q[2] + q[3] * q[3];
            }
            ssq += __shfl_xor(ssq, 16); ssq += __shfl_xor(ssq, 32);
            const float kn = __builtin_amdgcn_rsqf(fmaxf(ssq, 1e-24f));
            float bsum = 0.f;
#pragma unroll
            for (int nt = 0; nt < 4; ++nt) {
                f32x4 aw = z4, ai = z4;
                if (nt < 3) ldw(wn, nt + 1);
                __builtin_amdgcn_sched_barrier(0);
#pragma unroll
                for (int kk = 0; kk < 2; ++kk) {
                    aw = mfma32(wq[0][kk], lwf[kk], aw);
                    ai = mfma32(wq[1][kk], laf[kk], ai);
                }
                if (nt < 3) {
#pragma unroll
                    for (int kk = 0; kk < 2; ++kk) { wq[0][kk] = wn[0][kk]; wq[1][kk] = wn[1][kk]; }
                }
                const f32x4 w0v = *(const f32x4*)(prm + fq * 4 + nt * 16), a0v = *(const f32x4*)(prm + 64 + fq * 4 + nt * 16);
                const f32x4 kkv = *(const f32x4*)(prm + 128 + fq * 4 + nt * 16);
                const f32x4 kav = *(const f32x4*)(prm + 192 + fq * 4 + nt * 16), rkv = *(const f32x4*)(prm + 256 + fq * 4 + nt * 16);
                LDS_WAIT();
                const f32x4 rr = up4(rrw[nt]), krn4 = up4(krw[nt]);
                const f32x4 x1 = (w0v + aw) * (-LOG2E), x2 = (a0v + ai) * (-LOG2E);
                f32x4 ex1, ex2;
#pragma unroll
                for (int j = 0; j < 4; ++j) { ex1[j] = __builtin_amdgcn_exp2f(x1[j]); ex2[j] = __builtin_amdgcn_exp2f(x2[j]); }
                ex1 = ex1 + 1.0f; ex2 = ex2 + 1.0f;
                f32x4 sg, ic;
#pragma unroll
                for (int j = 0; j < 4; ++j) { sg[j] = __builtin_amdgcn_rcpf(ex1[j]); ic[j] = __builtin_amdgcn_rcpf(ex2[j]); }
                const f32x4 e2 = sg * (0.6065306597126334f * LOG2E);
                const f32x4 kkn = krn4 * kkv * kn;
                const f32x4 kd = krn4 * ((ic - 1.0f) * kav + 1.0f);
                { const f32x4 bq = rr * kd * rkv; bsum += (bq[0] + bq[1]) + (bq[2] + bq[3]); }
                f32x4 wt, wi, wp;
#pragma unroll
                for (int j = 0; j < 4; ++j) {
                    const float ec = row16_prefix(e2[j]);
                    wt[j] = __builtin_amdgcn_exp2f(-ec);
                    wi[j] = __builtin_amdgcn_exp2f(ec);
                    wp[j] = __builtin_amdgcn_exp2f(e2[j] - ec);
                }
                const f32x4 at = -(kkn * wp), rt = rr * wt, bt = kkn * ic * wi, kt = kd * wi;
                {
                    u32x2 wa, wb, wk;
                    wa[0] = pk_bf16(at[0], at[1]); wa[1] = pk_bf16(at[2], at[3]); wb[0] = pk_bf16(bt[0], bt[1]); wb[1] = pk_bf16(bt[2], bt[3]);
                    wk[0] = pk_bf16(kt[0], kt[1]); wk[1] = pk_bf16(kt[2], kt[3]);
                    *(u32x2*)(XA + fr * TKS + nt * 16 + fq * 4) = wa; *(u32x2*)(XB + fr * TKS + nt * 16 + fq * 4) = wb; *(u32x2*)(XK + fr * TKS + nt * 16 + fq * 4) = wk;
                    const unsigned o = (nt * 16 + fq * 4) * KTS + fr;
#pragma unroll
                    for (int j = 0; j < 4; ++j) {
                        TB_[o + j * KTS] = (bf16_t)((j & 1) ? (wb[j >> 1] >> 16) : (wb[j >> 1] & 0xffffu));
                        TK[o + j * KTS] = (bf16_t)((j & 1) ? (wk[j >> 1] >> 16) : (wk[j >> 1] & 0xffffu));
                    }
                }
                if (fr == 15) *(f32x4*)(WCP + nt * 16 + fq * 4) = wt;
                st4(XR + fr * TKS + nt * 16 + fq * 4, rt);
            }
            bsum += __shfl_xor(bsum, 16); bsum += __shfl_xor(bsum, 32);
            if (rg == 0 && fq == 0) { bonus[((0 * 2 + dir) * TTOT + tok) * 16u + hd] = bsum; bonus[((1 * 2 + dir) * TTOT + tok) * 16u + hd] = 0.f; }
            if (c + NPREP < NCHK) issue(c + NPREP, lwf, laf, krw, rrw, tok_cur);
            unsigned vv[2][2];
#pragma unroll
            for (int i = 0; i < 2; ++i) {
                const unsigned q = i * 64 + lane, vrow = q & 15, sp = q >> 4;
                const unsigned tk0 = tokb + scan_pos(c * CH + 2 * sp, dir), tk1 = tokb + scan_pos(c * CH + 2 * sp + 1, dir);
                vv[i][0] = V[tk0 * 1024u + hc + rg * 16 + vrow]; vv[i][1] = V[tk1 * 1024u + hc + rg * 16 + vrow];
            }
            LDS_WAIT();
            float wcr[4];
#pragma unroll
            for (int n = 0; n < 4; ++n) wcr[n] = WCP[16 * n + fr];
            bf16x8 fa[2], fb[2], fk[2], frr[2];
#pragma unroll
            for (int kk = 0; kk < 2; ++kk) {
                fa[kk] = *(const bf16x8*)(XA + fr * TKS + kk * 32 + fq * 8); fb[kk] = *(const bf16x8*)(XB + fr * TKS + kk * 32 + fq * 8);
                fk[kk] = *(const bf16x8*)(XK + fr * TKS + kk * 32 + fq * 8); frr[kk] = *(const bf16x8*)(XR + fr * TKS + kk * 32 + fq * 8);
            }
            LDS_WAIT();
            f32x4 d1 = z4, d2 = z4, d3 = z4, d4 = z4, d5 = z4;
#pragma unroll
            for (int kk = 0; kk < 2; ++kk) {
                d1 = mfma32(fb[kk], fa[kk], d1);
                d2 = mfma32(fa[kk], fb[kk], d2);
                d3 = mfma32(fk[kk], fa[kk], d3);
                d4 = mfma32(fb[kk], frr[kk], d4);
                d5 = mfma32(fk[kk], frr[kk], d5);
            }
            f32x4 im;
#pragma unroll
            for (int j = 0; j < 4; ++j) {
                const unsigned ij = fq * 4 + j;
                d1[j] = ij < fr ? d1[j] : 0.f;
                d2[j] = fr < ij ? d2[j] : 0.f;
                d3[j] = ij < fr ? d3[j] : 0.f;
                d4[j] = ij <= fr ? d4[j] : 0.f;
                d5[j] = ij <= fr ? d5[j] : 0.f;
                im[j] = d1[j] + (ij == fr ? 1.0f : 0.f);
            }
            st4(M + fr * SMS + fq * 4, d1);
            st4(IM + fr * SMS + fq * 4, im);
            st4(NABR + fr * SMS + fq * 4, d2);
            st4(NAKR + fr * SMS + fq * 4, d3);
            st4(NRBT + fr * SMS + fq * 4, d4);
            st4(NRKT + fr * SMS + fq * 4, d5);
            LDS_WAIT();
            const int so = fr * SMS + fq * 4;
            {
                const s16x4v m = ld4(M + so), mt = ld4(NABR + so);
                LDS_WAIT();
                st4(M2T + so, mfma16(m, mt, z4)); st4(M2 + so, mfma16(mt, m, z4));
                LDS_WAIT();
            }
            {
                const s16x4v m2 = ld4(M2 + so), m2t = ld4(M2T + so); const u32x2 imr = *(const u32x2*)(IM + so);
                LDS_WAIT();
                st4(M4T + so, mfma16(m2, m2t, z4)); st4(M4 + so, mfma16(m2t, m2, z4));
                st4(X1 + so, mfma16(m2t, __builtin_bit_cast(s16x4v, imr), up4(imr)));
                LDS_WAIT();
            }
            {
                const s16x4v m4 = ld4(M4 + so), m4t = ld4(M4T + so); const u32x2 x1r = *(const u32x2*)(X1 + so);
                LDS_WAIT();
                st4(M8T + so, mfma16(m4, m4t, z4));
                st4(X2 + so, mfma16(m4t, __builtin_bit_cast(s16x4v, x1r), up4(x1r)));
                LDS_WAIT();
            }
            {
                const s16x4v m8t = ld4(M8T + so); const u32x2 x2r = *(const u32x2*)(X2 + so);
                LDS_WAIT();
                st4(TT + so, mfma16(m8t, __builtin_bit_cast(s16x4v, x2r), up4(x2r)));
                LDS_WAIT();
            }
            const unsigned sl = (unsigned)c % NSLOT;
            char* S = slots + sl * SLOT_BYTES;
            {
                const s16x4v ta = ld4(TT + so), nak = ld4(NAKR + so), nrb = ld4(NRBT + so), nrk = ld4(NRKT + so);
                s16x4v tb[4], tk[4]; u32x2 xr[4];
#pragma unroll
                for (int m = 0; m < 4; ++m) {
                    tb[m] = ld4(TB_ + (16 * m + fr) * KTS + fq * 4); tk[m] = ld4(TK + (16 * m + fr) * KTS + fq * 4);
                    xr[m] = *(const u32x2*)(XR + fr * TKS + 16 * m + fq * 4);
                }
                LDS_WAIT();
                while (*(volatile LAS int*)(cnts + 8) < c - NSLOT + 1) __builtin_amdgcn_s_sleep(1);
                asm volatile("" ::: "memory");
                *(s16x4v*)((bf16_t*)(S + SL_TT) + so) = ta; *(s16x4v*)((bf16_t*)(S + SL_NAK) + so) = nak;
                *(s16x4v*)((bf16_t*)(S + SL_NRB) + so) = nrb; *(s16x4v*)((bf16_t*)(S + SL_NRK) + so) = nrk;
#pragma unroll
                for (int kk = 0; kk < 2; ++kk) *(bf16x8*)((bf16_t*)(S + SL_XA) + fr * TKS + kk * 32 + fq * 8) = fa[kk];
#pragma unroll
                for (int m = 0; m < 4; ++m) {
                    *(u32x2*)((bf16_t*)(S + SL_XR) + fr * TKS + 16 * m + fq * 4) = xr[m];
                    *(s16x4v*)((bf16_t*)(S + SL_TB) + (16 * m + fr) * KTS + fq * 4) = tb[m];
                    *(s16x4v*)((bf16_t*)(S + SL_TK) + (16 * m + fr) * KTS + fq * 4) = tk[m];
                }
                ((float*)(S + SL_WC))[lane] = (fq == 0) ? wcr[0] : (fq == 1) ? wcr[1] : (fq == 2) ? wcr[2] : wcr[3];
#pragma unroll
                for (int i = 0; i < 2; ++i) {
                    const unsigned q = i * 64 + lane, vrow = q & 15, sp = q >> 4;
                    *(unsigned*)((bf16_t*)(S + SL_VT) + vrow * SMS + 2 * sp) = vv[i][0] | (vv[i][1] << 16);
                }
            }
            LDS_WAIT();
            if (lane == 0) *(volatile LAS int*)(cnts + sl) = c + 1;
        }
    }
    __syncthreads();
}

DI void phase_scan(const Params& p, char* smem) {
    for (int u = blockIdx.x; u < NBATCH * 16 * 2 * 4; u += gridDim.x) scan_unit_chunked(p, u, smem);
}

constexpr int NPHASE = 18;
constexpr int cmax_(int a, int b) { return a > b ? a : b; }
constexpr int SMEM_BYTES = cmax_(cmax_(SC2_SMEM, SC_SMEM), cmax_(GEMM_SMEM + 4096, G8_SMEM)) + 64;
static_assert(SMEM_BYTES >= GEMM_SMEM + 4096 + 64 && SMEM_BYTES >= G8_SMEM + 64 && SMEM_BYTES + 16 <= 163840, "LDS");
template <int PH> DI void run_phase(const Params& p, char* smem) {
    if constexpr (PH == 0) phase_prologue(p, smem);
    else if constexpr (PH == 1) phase_norm0(p);
    else if constexpr (PH == 2) phase_qkv(p, smem);
    else if constexpr (PH == 3) phase_attn(p, smem);
    else if constexpr (PH == 4) phase_wout(p, smem);
    else if constexpr (PH == 5) phase_ffn_norm_route(p, 0, smem);
    else if constexpr (PH == 6) phase_moe1(p, 0, smem);
    else if constexpr (PH == 7) phase_moe2(p, 0, smem);
    else if constexpr (PH == 8) phase_combine_l0(p, smem);
    else if constexpr (PH == 9) phase_xx(p);
    else if constexpr (PH == 10) phase_rwkv_proj(p, smem);
    else if constexpr (PH == 11) phase_scan(p, smem);
    else if constexpr (PH == 12) phase_gate(p, smem);
    else if constexpr (PH == 13) phase_wo(p, smem);
    else if constexpr (PH == 14) phase_ffn_norm_route(p, 1, smem);
    else if constexpr (PH == 15) phase_moe1(p, 1, smem);
    else if constexpr (PH == 16) phase_moe2(p, 1, smem);
    else if constexpr (PH == 17) phase_final(p);
}
template <int PH, int END> struct PhaseSeq {
    static DI void run(const Params& p, char* smem, const XcdBarrier& bar) {
        run_phase<PH>(p, smem);
        if constexpr (PH + 1 < END) { xcd_barrier(bar); PhaseSeq<PH + 1, END>::run(p, smem, bar); }
    }
};
template <int BEG, int END>
__global__ void __launch_bounds__(NTH, 2) fwd_kernel(Params p) {
    extern __shared__ __attribute__((aligned(16))) char smem_raw[];
    char* smem = smem_raw + 16;
    if constexpr (END - BEG > 1) {
        if (tidx() == 0) *(uint4*)smem_raw = make_uint4(0u, 0u, 0u, 0u);
        __syncthreads();
        XcdBarrier bar = xcd_barrier_post((unsigned*)(p.ws + OFF_BAR), (volatile LAS unsigned*)smem_raw);
        PhaseSeq<BEG, END>::run(p, smem, bar);
    } else {
        run_phase<BEG>(p, smem);
    }
}

template <int BEG, int END> static void launch_range(const Params& p, int grid, hipStream_t stream) {
    (void)hipFuncSetAttribute((const void*)fwd_kernel<BEG, END>, hipFuncAttributeMaxDynamicSharedMemorySize, SMEM_BYTES + 16);
    hipLaunchKernelGGL((fwd_kernel<BEG, END>), dim3(grid), dim3(NTH), SMEM_BYTES + 16, stream, p);
}
#ifndef RUN_PHASES
#define RUN_PHASES NPHASE
#endif
#ifndef REPEAT_PHASE
#define REPEAT_PHASE -1
#endif
template <int PH> static void launch_each(const Params& p, int grid, hipStream_t stream) {
    launch_range<PH, PH + 1>(p, grid, stream);
    if (PH == REPEAT_PHASE) launch_range<PH, PH + 1>(p, grid, stream);
    if constexpr (PH + 1 < RUN_PHASES) launch_each<PH + 1>(p, grid, stream);
}

extern "C" void kernel_launch(void* const* d_in, const int* in_sizes, int n_in, void* d_out, int out_size, void* d_ws, size_t ws_size, hipStream_t stream) {
    Params p{};
    const float** f = (const float**)&p;
    for (int i = 0; i < 37; ++i) f[i] = (const float*)d_in[i];
    p.out = (float*)d_out;
    p.ws = (char*)d_ws;
    if (ws_size < WS_NEED || n_in < 37) return;
    static int grid = 0;
    if (!grid) {
        int dev = 0, cus = 0;
        (void)hipGetDevice(&dev);
        (void)hipDeviceGetAttribute(&cus, hipDeviceAttributeMultiprocessorCount, dev);
        grid = cus > 0 ? cus : 256;
    }
    (void)hipMemsetAsync(d_ws, 0, 32768, stream);
#if MEGA
    launch_range<0, NPHASE>(p, grid, stream);
#else
    launch_each<0>(p, grid, stream);
#endif
}
```

```cpp
#include <hip/hip_runtime.h>
#include <stdint.h>
#include <stdio.h>

#ifndef MEGA
#define MEGA 1
#endif

typedef unsigned short bf16_t;
typedef short bf16x8 __attribute__((ext_vector_type(8)));
typedef short s16x4 __attribute__((ext_vector_type(4)));
typedef float f32x2 __attribute__((ext_vector_type(2)));
typedef float f32x4 __attribute__((ext_vector_type(4)));
typedef float f32x16 __attribute__((ext_vector_type(16)));
typedef unsigned u32x2 __attribute__((ext_vector_type(2)));
typedef unsigned u32x4 __attribute__((ext_vector_type(4)));
typedef __bf16 bf16x2_t __attribute__((ext_vector_type(2)));
#define DI __device__ __forceinline__
__device__ __forceinline__ unsigned tidx() { unsigned t = threadIdx.x; asm volatile("" : "+v"(t)); return t; }

constexpr int DM = 1024, NBATCH = 2, SEQ = 16384, LCTX = 256, PTOT = SEQ + LCTX, TTOT = NBATCH * PTOT;
constexpr int NTH = 512, NWAVE = 8;
constexpr int QKV_N = 1536;
constexpr int NEXP = 16, CAP = TTOT * 2;
constexpr float RMS_EPS = 1e-6f, GN_EPS = 64e-5f;
constexpr float LOG2E = 1.4426950408889634f;

constexpr size_t MBy = 1u << 20;
constexpr size_t OFF_BAR   = 0;
constexpr size_t OFF_CNT   = 16384;
constexpr size_t OFF_MOD   = 32768;
constexpr size_t OFF_ROPE  = OFF_MOD + 2 * 3 * 6144 * 4;
constexpr size_t OFF_BONUS = 1 * MBy;
constexpr size_t OFF_BONUS2 = 6 * MBy;
constexpr size_t OFF_STOK  = 6 * MBy;
constexpr size_t OFF_SW    = 11 * MBy;
constexpr size_t OFF_XC    = 16 * MBy;
constexpr size_t OFF_WS    = 18 * MBy;
constexpr size_t OFF_MOEW  = 33 * MBy;
constexpr size_t OFF_H     = 129 * MBy;
constexpr size_t OFF_SCR   = 194 * MBy;
constexpr size_t SCR_SIZE  = 290 * MBy;
constexpr size_t WS_NEED   = OFF_SCR + SCR_SIZE;
constexpr size_t W_IN = 0, W_OUT = W_IN + 1536 * 1024, W_R = W_OUT + 1024 * 1024, W_K = W_R + 1024 * 1024, W_V = W_K + 1024 * 1024,
                 W_O = W_V + 1024 * 1024, W_W1 = W_O + 1024 * 1024, W_A1 = W_W1 + 128 * 1024, W_G1 = W_A1 + 128 * 1024,
                 W_W2 = W_G1 + 256 * 1024, W_A2 = W_W2 + 2 * 1024 * 64, W_G2 = W_A2 + 2 * 1024 * 64, W_END = W_G2 + 1024 * 192;
static_assert(W_END * 2 <= 15 * MBy, "small weights region");
constexpr size_t ROWB = (size_t)TTOT * 2048;
constexpr size_t S_Q = 0, S_K = S_Q + ROWB, S_VT = S_K + ROWB / 4, S_O = S_VT + ROWB / 4;
constexpr size_t S_HID = 0, S_Y = 140 * MBy;
constexpr size_t S_R = 0, S_KK = S_R + ROWB, S_V = S_KK + ROWB, S_LW = S_V + ROWB, S_LA = S_LW + ROWB / 8, S_LG = S_LA + ROWB / 8,
                 S_Y1 = 224 * MBy, S_XX = S_Y1, S_OR = S_R;
static_assert(S_O + ROWB <= SCR_SIZE, "scr");
static_assert(S_LG + (size_t)TTOT * 384 <= S_Y1, "scr2");
static_assert(S_Y1 + ROWB <= SCR_SIZE, "scr3");
static_assert(S_Y + 2 * ROWB <= SCR_SIZE, "scr4");
static_assert((size_t)(CAP / 256 + 16) * 256 * 2048 <= S_Y, "hid");
static_assert(OFF_H + ROWB <= OFF_SCR, "h");

struct Params {
    const float *x, *c, *ctx, *c_ctx, *ada_w, *ada_b, *norm_mix_g, *norm_ffn_g, *attn_w_in, *attn_w_out, *attn_sink, *attn_q_norm_g, *attn_k_norm_g,
        *rwkv_x_mix, *rwkv_w_r, *rwkv_w_k, *rwkv_w_v, *rwkv_w_o, *rwkv_decay_w0, *rwkv_decay_w1, *rwkv_decay_w2, *rwkv_iclr_a0, *rwkv_iclr_a1,
        *rwkv_iclr_a2, *rwkv_gate_g1, *rwkv_gate_g2, *rwkv_k_k, *rwkv_k_a, *rwkv_r_k, *rwkv_ln_g, *rwkv_ln_b, *router_w, *router_bias, *moe_w1,
        *moe_w3, *moe_w2, *final_norm_g;
    float* out;
    char* ws;
};

DI unsigned pk_bf16(float a, float b) { f32x2 v = {a, b}; bf16x2_t r = __builtin_convertvector(v, bf16x2_t); return __builtin_bit_cast(unsigned, r); }
DI float bf_lo(unsigned u) { return __uint_as_float(u << 16); }
DI float bf_hi(unsigned u) { return __uint_as_float(u & 0xffff0000u); }
DI float bf2f(bf16_t u) { return __uint_as_float(((unsigned)u) << 16); }
DI float wave_sum(float v) {
#pragma unroll
    for (int o = 32; o >= 1; o >>= 1) v += __shfl_xor(v, o);
    return v;
}
DI float sigmoidf_(float x) { return __builtin_amdgcn_rcpf(1.0f + __builtin_amdgcn_exp2f(x * -LOG2E)); }
DI float siluf_(float x) { return x * __builtin_amdgcn_rcpf(1.0f + __builtin_amdgcn_exp2f(x * -LOG2E)); }
struct PLite { const float *x, *ctx, *qg, *kg; float* out; char* ws; };
DI PLite plite(const Params& p) { return PLite{p.x, p.ctx, p.attn_q_norm_g, p.attn_k_norm_g, p.out, p.ws}; }
template <class P> DI float* xrow_ptr(const P& p, int tok) {
    const int b = tok >= PTOT ? 1 : 0, pos = tok - b * PTOT;
    return pos < LCTX ? (float*)(p.ws + OFF_XC) + (size_t)(b * LCTX + pos) * DM : p.out + (size_t)(b * SEQ + pos - LCTX) * DM;
}
template <class P> DI const float* xin_ptr(const P& p, int tok) {
    const int b = tok >= PTOT ? 1 : 0, pos = tok - b * PTOT;
    return pos < LCTX ? p.ctx + (size_t)(b * LCTX + pos) * DM : p.x + (size_t)(b * SEQ + pos - LCTX) * DM;
}
template <class P> DI const float* mod_ptr(const P& p, int layer, int tok, int which) {
    const int b = tok >= PTOT ? 1 : 0, pos = tok - b * PTOT;
    const int w = pos < LCTX ? 2 : b;
    return (const float*)(p.ws + OFF_MOD) + (size_t)((layer * 3 + w) * 6 + which) * DM;
}

#define XB_TMO      128
#define XB_XCNT(j)  (256  + 64 * (j))
#define XB_XSUB(j)  (1280 + 64 * (j))
#define XB_XGEN(j)  (2304 + 64 * (j))
#define XB_TOP      3328
#define XB_TOPGEN   3392
#define XCD_BAR_WORDS 3456
#define XB_SPIN_CAP (1u << 18)
#define LAS __attribute__((address_space(3)))
DI unsigned xb_ld(unsigned* p)              { return __hip_atomic_load(p, __ATOMIC_RELAXED, __HIP_MEMORY_SCOPE_AGENT); }
DI unsigned xb_add(unsigned* p, unsigned v) { return __hip_atomic_fetch_add(p, v, __ATOMIC_RELAXED, __HIP_MEMORY_SCOPE_AGENT); }
DI unsigned xb_xcc_id() { return (unsigned)__builtin_amdgcn_s_getreg((3 << 11) | 20) & 0xFu; }
#define XB_SPIN(cond, bar) do { unsigned _sp = 0; while (cond) { __builtin_amdgcn_s_sleep(1); \
    if ((++_sp & 255u) == 0u) { if (xb_ld(&(bar)[XB_TMO])) break; if (_sp > XB_SPIN_CAP) { atomicAdd(&(bar)[XB_TMO], 1u); break; } } } } while (0)
struct XcdBarrier { unsigned* bar; unsigned x; volatile LAS unsigned* st; };
DI XcdBarrier xcd_barrier_post(unsigned* bar, volatile LAS unsigned* st) {
    XcdBarrier b; b.bar = bar; b.x = xb_xcc_id(); b.st = st;
    if (tidx() == 0) (void)xb_add(&bar[XB_XCNT(b.x)], 1u);
    return b;
}
DI void xcd_barrier_complete(unsigned* bar, unsigned x, unsigned& nloc, unsigned& nx) {
    const unsigned G = gridDim.x * gridDim.y * gridDim.z;
    unsigned sum, cnt, mine, sp = 0u;
    for (;;) {
        sum = 0u; cnt = 0u; mine = 0u;
#pragma unroll
        for (unsigned j = 0; j < 16; ++j) { const unsigned c = xb_ld(&bar[XB_XCNT(j)]); sum += c; cnt += (c > 0u) ? 1u : 0u; mine = (j == x) ? c : mine; }
        if (sum == G) break;
        __builtin_amdgcn_s_sleep(1);
        if ((++sp & 255u) == 0u) { if (xb_ld(&bar[XB_TMO])) break; if (sp > XB_SPIN_CAP) { atomicAdd(&bar[XB_TMO], 1u); break; } }
    }
    nloc = mine > 0u ? mine : 1u; nx = cnt > 0u ? cnt : 1u;
}
DI void xcd_barrier(const XcdBarrier& b) {
    asm volatile("s_waitcnt vmcnt(0)" ::: "memory");
    __syncthreads();
    if (tidx() == 0) {
        unsigned* bar = b.bar;
        __builtin_amdgcn_s_waitcnt(0);
        unsigned nloc = b.st[0], nx = b.st[1];
        if (nloc == 0u) { xcd_barrier_complete(bar, b.x, nloc, nx); b.st[0] = nloc; b.st[1] = nx; }
        const unsigned old = xb_add(&bar[XB_XSUB(b.x)], 1u);
        const unsigned gen = old / nloc;
        if (old + 1u == (gen + 1u) * nloc) {
            __builtin_amdgcn_fence(__ATOMIC_RELEASE, "agent");
            asm volatile("s_waitcnt vmcnt(0)" ::: "memory");
            const unsigned og = xb_add(&bar[XB_TOP], 1u);
            const unsigned tg = og / nx;
            if (og + 1u == (tg + 1u) * nx) xb_add(&bar[XB_TOPGEN], 1u);
            else XB_SPIN(xb_ld(&bar[XB_TOPGEN]) == tg, bar);
            __builtin_amdgcn_fence(__ATOMIC_ACQUIRE, "agent");
            xb_add(&bar[XB_XGEN(b.x)], 1u);
            asm volatile("s_waitcnt vmcnt(0)" ::: "memory");
        } else {
            XB_SPIN(xb_ld(&bar[XB_XGEN(b.x)]) == gen, bar);
            __builtin_amdgcn_fence(__ATOMIC_ACQUIRE, "agent");
            asm volatile("s_waitcnt vmcnt(0)" ::: "memory");
        }
    }
    __syncthreads();
}

struct CvtDesc { const float* src; bf16_t* dst; int ld, kvalid, dld; bool colvalid; };
DI CvtDesc cvt_tile(const float* src, int ld, int kvalid, bool colvalid, bf16_t* dst, int dld) { return CvtDesc{src, dst, ld, kvalid, dld, colvalid}; }
constexpr int CV_NB = 8;
template <class F>
DI void cvt_run(int nunits, F desc_of, float* tiles) {
    const int t = tidx();
    for (int i0 = 0;; i0 += CV_NB) {
        if ((int)blockIdx.x + (int)gridDim.x * i0 >= nunits) break;
        f32x4 v[CV_NB];
#pragma unroll
        for (int b = 0; b < CV_NB; ++b) {
            const int u = (int)blockIdx.x + (int)gridDim.x * (i0 + b);
            v[b] = (f32x4){0.f, 0.f, 0.f, 0.f};
            if (u < nunits) {
                const CvtDesc d = desc_of(u);
                const int k = t >> 3, c4 = (t & 7) * 4;
                if (d.colvalid && k < d.kvalid) v[b] = *(const f32x4*)(d.src + (size_t)k * d.ld + c4);
            }
        }
#pragma unroll
        for (int b = 0; b < CV_NB; ++b) {
            float* tile = tiles + b * 64 * 33;
            const int k = t >> 3, c4 = (t & 7) * 4;
            tile[k * 33 + c4 + 0] = v[b][0]; tile[k * 33 + c4 + 1] = v[b][1]; tile[k * 33 + c4 + 2] = v[b][2]; tile[k * 33 + c4 + 3] = v[b][3];
        }
        __syncthreads();
#pragma unroll
        for (int b = 0; b < CV_NB; ++b) {
            const int u = (int)blockIdx.x + (int)gridDim.x * (i0 + b);
            if (u < nunits) {
                const CvtDesc d = desc_of(u);
                const float* tile = tiles + b * 64 * 33;
                const int n = t >> 4, kc = (t & 15) * 4;
                u32x2 w;
                w[0] = pk_bf16(tile[(kc + 0) * 33 + n], tile[(kc + 1) * 33 + n]);
                w[1] = pk_bf16(tile[(kc + 2) * 33 + n], tile[(kc + 3) * 33 + n]);
                *(u32x2*)(d.dst + (size_t)n * d.dld + kc) = w;
            }
        }
        __syncthreads();
    }
}
constexpr int CV_SMALL_UNITS = 768 + 512 * 5 + 64 + 64 + 128 + 64 + 64 + 96;
DI CvtDesc cvt_small_unit(const Params& p, int u) {
    bf16_t* wsm = (bf16_t*)(p.ws + OFF_WS);
    if (u < 768) { const int run = u >> 4, kt = u & 15; return cvt_tile(p.attn_w_in + (size_t)kt * 64 * 1536 + run * 32, 1536, 64, true, wsm + W_IN + (size_t)run * 32 * 1024 + kt * 64, 1024); }
    u -= 768;
    if (u < 512 * 5) {
        const int j = u >> 9, v = u & 511, run = v >> 4, kt = v & 15;
        const float* src = j == 0 ? p.attn_w_out : j == 1 ? p.rwkv_w_r : j == 2 ? p.rwkv_w_k : j == 3 ? p.rwkv_w_v : p.rwkv_w_o;
        const size_t dofs = j == 0 ? W_OUT : j == 1 ? W_R : j == 2 ? W_K : j == 3 ? W_V : W_O;
        return cvt_tile(src + (size_t)kt * 64 * 1024 + run * 32, 1024, 64, true, wsm + dofs + (size_t)run * 32 * 1024 + kt * 64, 1024);
    }
    u -= 512 * 5;
    if (u < 128) {
        const int j = u >> 6, v = u & 63, run = v >> 4, kt = v & 15, d = run >> 1, co = (run & 1) * 32;
        const float* src = (j == 0 ? p.rwkv_decay_w1 : p.rwkv_iclr_a1) + (size_t)d * 1024 * 64;
        return cvt_tile(src + (size_t)kt * 64 * 64 + co, 64, 64, true, wsm + (j == 0 ? W_W1 : W_A1) + (size_t)run * 32 * 1024 + kt * 64, 1024);
    }
    u -= 128;
    if (u < 128) {
        const int run = u >> 4, kt = u & 15;
        return cvt_tile(p.rwkv_gate_g1 + (size_t)kt * 64 * 160 + run * 32, 160, 64, run < 5, wsm + W_G1 + (size_t)run * 32 * 1024 + kt * 64, 1024);
    }
    u -= 128;
    if (u < 128) {
        const int j = u >> 6, v = u & 63, d = v >> 5, run = v & 31;
        const float* src = (j == 0 ? p.rwkv_decay_w2 : p.rwkv_iclr_a2) + (size_t)d * 64 * 1024;
        return cvt_tile(src + run * 32, 1024, 64, true, wsm + (j == 0 ? W_W2 : W_A2) + (size_t)d * 1024 * 64 + (size_t)run * 32 * 64, 64);
    }
    u -= 128;
    {
        const int run = u / 3, kt = u % 3;
        const int kvalid = 160 - kt * 64 > 64 ? 64 : (160 - kt * 64 < 0 ? 0 : 160 - kt * 64);
        return cvt_tile(p.rwkv_gate_g2 + (size_t)kt * 64 * 1024 + run * 32, 1024, kvalid, true, wsm + W_G2 + (size_t)run * 32 * 192 + kt * 64, 192);
    }
}
constexpr int CV_MOE_UNITS = 16 * (1024 + 512);
DI CvtDesc cvt_moe_unit(const Params& p, int layer, int u) {
    bf16_t* w13 = (bf16_t*)(p.ws + OFF_MOEW);
    bf16_t* w2t = w13 + (size_t)16 * 2048 * 1024;
    const int e = u / 1536, v = u % 1536;
    const size_t eo = (size_t)(layer * 16 + e) * 1024 * 1024;
    if (v < 1024) {
        const int run = v >> 4, kt = v & 15, g = run >> 1;
        const float* src = ((run & 1) ? p.moe_w3 : p.moe_w1) + eo;
        return cvt_tile(src + (size_t)kt * 64 * 1024 + g * 32, 1024, 64, true, w13 + (size_t)e * 2048 * 1024 + (size_t)run * 32 * 1024 + kt * 64, 1024);
    } else {
        const int w = v - 1024, run = w >> 4, kt = w & 15;
        return cvt_tile(p.moe_w2 + eo + (size_t)kt * 64 * 1024 + run * 32, 1024, 64, true, w2t + (size_t)e * 1024 * 1024 + (size_t)run * 32 * 1024 + kt * 64, 1024);
    }
}
DI void adaln_unit(const Params& p, int u, float* sm) {
    const int l = u / 96, n0 = (u % 96) * 64, t = tidx();
    float* sv = sm;
    float* red = sm + 3 * 1024;
    for (int i = t; i < 3 * 1024; i += NTH) { const int w = i >> 10, k = i & 1023; const float c = w < 2 ? p.c[w * 1024 + k] : p.c_ctx[k]; sv[i] = siluf_(c); }
    __syncthreads();
    const int kg = t >> 4, cl = t & 15;
    f32x4 a0 = {0, 0, 0, 0}, a1 = a0, a2 = a0;
    const float* W = p.ada_w + (size_t)l * 1024 * 6144 + n0 + cl * 4;
#pragma unroll 8
    for (int i = 0; i < 32; ++i) {
        const int k = kg + 32 * i;
        const f32x4 w = *(const f32x4*)(W + (size_t)k * 6144);
        a0 += w * sv[k]; a1 += w * sv[1024 + k]; a2 += w * sv[2048 + k];
    }
#pragma unroll
    for (int j = 0; j < 4; ++j) { red[kg * 192 + 0 * 64 + cl * 4 + j] = a0[j]; red[kg * 192 + 1 * 64 + cl * 4 + j] = a1[j]; red[kg * 192 + 2 * 64 + cl * 4 + j] = a2[j]; }
    __syncthreads();
    if (t < 192) {
        float s = 0.f;
        for (int g = 0; g < 32; ++g) s += red[g * 192 + t];
        const int w = t >> 6, n = n0 + (t & 63);
        ((float*)(p.ws + OFF_MOD))[(size_t)(l * 3 + w) * 6144 + n] = s + p.ada_b[l * 6144 + n];
    }
    __syncthreads();
}
DI void rope_unit(const Params& p, int u) {
    const int id = u * NTH + tidx();
    if (id < 320 * 16) {
        const int pi = id >> 4, f = id & 15;
        const float inv = exp2f(-(float)f * (13.287712379549449f / 16.0f));
        const float val = pi < 256 ? (float)pi : (float)(pi - 256);
        const float ang = val * inv;
        const double a = (double)ang;
        const double k = __builtin_rint(a * 0.15915494309189535);
        const float r = (float)(a - k * 6.283185307179586);
        f32x2 cs = {__cosf(r), __sinf(r)};
        ((f32x2*)(p.ws + OFF_ROPE))[id] = cs;
    }
}
DI void phase_prologue(const Params& p, char* smem) {
    float* sm = (float*)smem;
    const int nconv = CV_SMALL_UNITS + CV_MOE_UNITS;
    const int total = nconv + 192 + 10;
    for (int u = nconv + blockIdx.x; u < total; u += gridDim.x) {
        if (u < nconv + 192) adaln_unit(p, u - nconv, sm);
        else rope_unit(p, u - nconv - 192);
    }
    __syncthreads();
    cvt_run(nconv, [&](int u) { return u < CV_SMALL_UNITS ? cvt_small_unit(p, u) : cvt_moe_unit(p, 0, u - CV_SMALL_UNITS); }, sm);
}

DI void row_load(const float* src, f32x4 (&v)[4], int lane) {
#pragma unroll
    for (int i = 0; i < 4; ++i) v[i] = ((const f32x4*)src)[lane + 64 * i];
}
DI float row_rstd(const f32x4 (&v)[4]) {
    float ss = 0.f;
#pragma unroll
    for (int i = 0; i < 4; ++i) ss += v[i][0] * v[i][0] + v[i][1] * v[i][1] + v[i][2] * v[i][2] + v[i][3] * v[i][3];
    ss = wave_sum(ss);
    return rsqrtf(ss * (1.0f / DM) + RMS_EPS);
}
DI void row_norm_mod(const f32x4 (&v)[4], float rstd, const float* g, const float* shift, const float* scale, f32x4 (&h)[4], int lane) {
#pragma unroll
    for (int i = 0; i < 4; ++i) {
        const int c = (lane + 64 * i) * 4;
        const f32x4 g4 = *(const f32x4*)(g + c), sh = *(const f32x4*)(shift + c), sc = *(const f32x4*)(scale + c);
        h[i] = (v[i] * rstd * g4) * (1.0f + sc) + sh;
    }
}
DI void row_store_bf16(bf16_t* dst, const f32x4 (&h)[4], int lane) {
#pragma unroll
    for (int i = 0; i < 4; ++i) { u32x2 w; w[0] = pk_bf16(h[i][0], h[i][1]); w[1] = pk_bf16(h[i][2], h[i][3]); *(u32x2*)(dst + (lane + 64 * i) * 4) = w; }
}
DI void row_load_bf16(const bf16_t* src, f32x4 (&v)[4], int lane) {
#pragma unroll
    for (int i = 0; i < 4; ++i) { const u32x2 w = *(const u32x2*)(src + (lane + 64 * i) * 4); v[i][0] = bf_lo(w[0]); v[i][1] = bf_hi(w[0]); v[i][2] = bf_lo(w[1]); v[i][3] = bf_hi(w[1]); }
}

DI void phase_norm0(const Params& p) {
    const int lane = tidx() & 63, gw = blockIdx.x * NWAVE + (tidx() >> 6), nw = gridDim.x * NWAVE;
    bf16_t* H = (bf16_t*)(p.ws + OFF_H);
    for (int tok = gw; tok < TTOT; tok += nw) {
        f32x4 v[4], h[4];
        row_load(xin_ptr(p, tok), v, lane);
        const float rstd = row_rstd(v);
        row_norm_mod(v, rstd, p.norm_mix_g, mod_ptr(p, 0, tok, 0), mod_ptr(p, 0, tok, 1), h, lane);
        row_store_bf16(H + (size_t)tok * DM, h, lane);
    }
}

DI void route_row(const Params& p, const float (&lg)[16], int& e1, int& e2, float& g1, float& g2) {
    float mx = lg[0];
#pragma unroll
    for (int e = 1; e < 16; ++e) mx = fmaxf(mx, lg[e]);
    float pr[16], sum = 0.f;
#pragma unroll
    for (int e = 0; e < 16; ++e) { pr[e] = __expf(lg[e] - mx); sum += pr[e]; }
    const float inv = 1.0f / sum;
    float sel[16];
#pragma unroll
    for (int e = 0; e < 16; ++e) { pr[e] *= inv; sel[e] = pr[e] + p.router_bias[e]; }
    float best = -1e30f; int gi = 0;
#pragma unroll
    for (int g = 0; g < 4; ++g) {
        float m1 = -1e30f, m2 = -1e30f;
#pragma unroll
        for (int j = 0; j < 4; ++j) { const float s = sel[g * 4 + j]; if (s > m1) { m2 = m1; m1 = s; } else if (s > m2) m2 = s; }
        const float gs = m1 + m2;
        if (gs > best) { best = gs; gi = g; }
    }
    float s4[4], p4[4];
#pragma unroll
    for (int j = 0; j < 4; ++j) {
        s4[j] = gi == 0 ? sel[j] : gi == 1 ? sel[4 + j] : gi == 2 ? sel[8 + j] : sel[12 + j];
        p4[j] = gi == 0 ? pr[j] : gi == 1 ? pr[4 + j] : gi == 2 ? pr[8 + j] : pr[12 + j];
    }
    int i1 = 0; float b1 = s4[0];
#pragma unroll
    for (int j = 1; j < 4; ++j) if (s4[j] > b1) { b1 = s4[j]; i1 = j; }
    int i2 = i1 == 0 ? 1 : 0; float b2 = -3e38f;
#pragma unroll
    for (int j = 0; j < 4; ++j) if (j != i1 && s4[j] > b2) { b2 = s4[j]; i2 = j; }
    const float w1 = i1 == 0 ? p4[0] : i1 == 1 ? p4[1] : i1 == 2 ? p4[2] : p4[3];
    const float w2 = i2 == 0 ? p4[0] : i2 == 1 ? p4[1] : i2 == 2 ? p4[2] : p4[3];
    const float ws = 1.0f / (w1 + w2);
    e1 = gi * 4 + i1; e2 = gi * 4 + i2; g1 = w1 * ws; g2 = w2 * ws;
}
DI void phase_ffn_norm_route(const Params& p, int layer, char* smem) {
    const int lane = tidx() & 63, gw = blockIdx.x * NWAVE + (tidx() >> 6), nw = gridDim.x * NWAVE;
    float* rw = (float*)smem;
    for (int i = tidx(); i < 1024 * 16; i += NTH) rw[(i & 15) * 1024 + (i >> 4)] = p.router_w[i];
    __syncthreads();
    bf16_t* H = (bf16_t*)(p.ws + OFF_H);
    int* lcnt = (int*)(smem + 65536);
    if (tidx() < 32) lcnt[tidx()] = 0;
    int my_tok = -1, my_e1 = 0, my_e2 = 0, it = 0; float my_g1 = 0.f, my_g2 = 0.f;
    for (int tok = gw; tok < TTOT; tok += nw) {
        const int pos = tok >= PTOT ? tok - PTOT : tok;
        if (layer == 1 && pos < LCTX) continue;
        f32x4 v[4], h[4];
        row_load(xrow_ptr(p, tok), v, lane);
        const float rstd = row_rstd(v);
        row_norm_mod(v, rstd, p.norm_ffn_g + layer * DM, mod_ptr(p, layer, tok, 3), mod_ptr(p, layer, tok, 4), h, lane);
        row_store_bf16(H + (size_t)tok * DM, h, lane);
        float lg[16];
#pragma unroll
        for (int e = 0; e < 16; ++e) lg[e] = 0.f;
#pragma unroll
        for (int i = 0; i < 4; ++i)
#pragma unroll
            for (int e = 0; e < 16; ++e) {
                const f32x4 w = *(const f32x4*)(rw + e * 1024 + (lane + 64 * i) * 4);
                lg[e] += h[i][0] * w[0] + h[i][1] * w[1] + h[i][2] * w[2] + h[i][3] * w[3];
                if ((e & 3) == 3) asm volatile("" ::: "memory");
            }
#pragma unroll
        for (int e = 0; e < 16; ++e) lg[e] = wave_sum(lg[e]);
        int e1, e2; float g1, g2;
        route_row(p, lg, e1, e2, g1, g2);
        if (lane == it) { my_tok = tok; my_e1 = e1; my_e2 = e2; my_g1 = g1; my_g2 = g2; }
        ++it;
    }
    __syncthreads();
    int r1 = 0, r2 = 0;
    if (my_tok >= 0) { r1 = atomicAdd(&lcnt[my_e1], 1); r2 = atomicAdd(&lcnt[my_e2], 1); }
    __syncthreads();
    if (tidx() < 16) { const int n = lcnt[tidx()]; lcnt[16 + tidx()] = n ? atomicAdd((int*)(p.ws + OFF_CNT) + layer * 16 + tidx(), n) : 0; }
    __syncthreads();
    if (my_tok >= 0) {
        int* stok = (int*)(p.ws + OFF_STOK);
        float* sw = (float*)(p.ws + OFF_SW);
        const size_t s1 = (size_t)my_e1 * CAP + lcnt[16 + my_e1] + r1, s2 = (size_t)my_e2 * CAP + lcnt[16 + my_e2] + r2;
        stok[s1] = my_tok * 2 + 0; sw[s1] = my_g1;
        stok[s2] = my_tok * 2 + 1; sw[s2] = my_g2;
    }
    __syncthreads();
}

DI void combine_row(const Params& p, int layer, int tok, f32x4 (&v)[4], int lane) {
    const bf16_t* Y = (const bf16_t*)(p.ws + OFF_SCR + S_Y) + (size_t)tok * 2 * DM;
    const float* g5 = mod_ptr(p, layer, tok, 5);
    f32x4 y0[4], y1[4];
    row_load(xrow_ptr(p, tok), v, lane);
    row_load_bf16(Y, y0, lane); row_load_bf16(Y + DM, y1, lane);
#pragma unroll
    for (int i = 0; i < 4; ++i) { const f32x4 g = *(const f32x4*)(g5 + (lane + 64 * i) * 4); v[i] += g * (y0[i] + y1[i]); }
}
DI void phase_combine_l0(const Params& p, char* smem) {
    const int lane = tidx() & 63, gw = blockIdx.x * NWAVE + (tidx() >> 6), nw = gridDim.x * NWAVE;
    bf16_t* H = (bf16_t*)(p.ws + OFF_H);
    for (int tok = gw; tok < TTOT; tok += nw) {
        f32x4 v[4], h[4];
        combine_row(p, 0, tok, v, lane);
        float* X = xrow_ptr(p, tok);
#pragma unroll
        for (int i = 0; i < 4; ++i) ((f32x4*)X)[lane + 64 * i] = v[i];
        const float rstd = row_rstd(v);
        row_norm_mod(v, rstd, p.norm_mix_g + DM, mod_ptr(p, 1, tok, 0), mod_ptr(p, 1, tok, 1), h, lane);
        row_store_bf16(H + (size_t)tok * DM, h, lane);
    }
    __syncthreads();
    cvt_run(CV_MOE_UNITS, [&](int u) { return cvt_moe_unit(p, 1, u); }, (float*)smem);
}
DI void phase_xx(const Params& p) {
    const int lane = tidx() & 63, gw = blockIdx.x * NWAVE + (tidx() >> 6), nw = gridDim.x * NWAVE;
    const bf16_t* H = (const bf16_t*)(p.ws + OFF_H);
    bf16_t* XX = (bf16_t*)(p.ws + OFF_SCR + S_XX);
    for (int tok = gw; tok < TTOT; tok += nw) {
        const int pos = tok >= PTOT ? tok - PTOT : tok;
        const bool first = pos == 0 || pos == LCTX, last = pos == LCTX - 1 || pos == PTOT - 1;
        f32x4 hc[4], hp[4], hn[4], xx[4];
        row_load_bf16(H + (size_t)tok * DM, hc, lane);
        row_load_bf16(H + (size_t)(first ? tok : tok - 1) * DM, hp, lane);
        row_load_bf16(H + (size_t)(last ? tok : tok + 1) * DM, hn, lane);
#pragma unroll
        for (int i = 0; i < 4; ++i) {
            const f32x4 a = first ? (f32x4){0, 0, 0, 0} : hp[i], b = last ? (f32x4){0, 0, 0, 0} : hn[i];
            xx[i] = 0.5f * (a + b) - hc[i];
        }
        row_store_bf16(XX + (size_t)tok * DM, xx, lane);
    }
}
DI void phase_final(const Params& p) {
    const int lane = tidx() & 63, gw = blockIdx.x * NWAVE + (tidx() >> 6), nw = gridDim.x * NWAVE;
    for (int r = gw; r < NBATCH * SEQ; r += nw) {
        const int b = r / SEQ, tok = b * PTOT + LCTX + (r - b * SEQ);
        f32x4 v[4];
        combine_row(p, 1, tok, v, lane);
        const float rstd = row_rstd(v);
        float* O = p.out + (size_t)r * DM;
#pragma unroll
        for (int i = 0; i < 4; ++i) { const f32x4 g = *(const f32x4*)(p.final_norm_g + (lane + 64 * i) * 4); ((f32x4*)O)[lane + 64 * i] = v[i] * rstd * g; }
    }
}

constexpr int LDSROW = 72;
constexpr int GEMM_SMEM = 2 * (256 + 256) * LDSROW * 2;
template <int NH, class AL, class EPI>
DI void gemm_tile(AL& al, const bf16_t* __restrict__ Bt, int ldb, int nk, EPI& epi, char* smem) {
    const int t = tidx(), lane = t & 63, wid = t >> 6, wr = wid >> 1, wc = wid & 1, fr = lane & 15, fq = lane >> 4;
    constexpr int BR = 128 * NH;
    bf16_t* sA = (bf16_t*)smem;
    bf16_t* sB = sA + 2 * 256 * LDSROW;
    f32x4 acc[NH][4][4];
#pragma unroll
    for (int h = 0; h < NH; ++h)
#pragma unroll
        for (int m = 0; m < 4; ++m)
#pragma unroll
            for (int n = 0; n < 4; ++n) acc[h][m][n] = (f32x4){0.f, 0.f, 0.f, 0.f};
    const int lr = t >> 3, lc = (t & 7) * 8;
    typename AL::Raw ra[4]; u32x4 rb[2 * NH];
#pragma unroll
    for (int i = 0; i < 4; ++i) al.issue(ra[i], lr + 64 * i, lc, i);
#pragma unroll
    for (int i = 0; i < 2 * NH; ++i) rb[i] = *(const u32x4*)(Bt + (size_t)(lr + 64 * i) * ldb + lc);
#pragma unroll
    for (int i = 0; i < 4; ++i) *(u32x4*)(sA + (lr + 64 * i) * LDSROW + lc) = al.finish(ra[i], lc);
#pragma unroll
    for (int i = 0; i < 2 * NH; ++i) *(u32x4*)(sB + (lr + 64 * i) * LDSROW + lc) = rb[i];
    __syncthreads();
    for (int kt = 0; kt < nk; ++kt) {
        const int cur = kt & 1;
        const bool more = kt + 1 < nk;
        if (more) {
#pragma unroll
            for (int i = 0; i < 4; ++i) al.issue(ra[i], lr + 64 * i, (kt + 1) * 64 + lc, i);
#pragma unroll
            for (int i = 0; i < 2 * NH; ++i) rb[i] = *(const u32x4*)(Bt + (size_t)(lr + 64 * i) * ldb + (kt + 1) * 64 + lc);
        }
        __builtin_amdgcn_sched_barrier(0);
        const bf16_t* cA = sA + cur * 256 * LDSROW + (wr * 64 + fr) * LDSROW + fq * 8;
        const bf16_t* cB = sB + cur * BR * LDSROW + (wc * 64 + fr) * LDSROW + fq * 8;
#pragma unroll
        for (int kk = 0; kk < 2; ++kk) {
            bf16x8 af[4];
#pragma unroll
            for (int m = 0; m < 4; ++m) af[m] = *(const bf16x8*)(cA + m * 16 * LDSROW + kk * 32);
#pragma unroll
            for (int h = 0; h < NH; ++h) {
                bf16x8 bfr[4];
#pragma unroll
                for (int n = 0; n < 4; ++n) bfr[n] = *(const bf16x8*)(cB + (h * 128 + n * 16) * LDSROW + kk * 32);
#pragma unroll
                for (int m = 0; m < 4; ++m)
#pragma unroll
                    for (int n = 0; n < 4; ++n) acc[h][m][n] = __builtin_amdgcn_mfma_f32_16x16x32_bf16(bfr[n], af[m], acc[h][m][n], 0, 0, 0);
            }
            if (kk == AL::STORE_AT && more) {
                bf16_t* nA = sA + (cur ^ 1) * 256 * LDSROW;
                bf16_t* nB = sB + (cur ^ 1) * BR * LDSROW;
#pragma unroll
                for (int i = 0; i < 4; ++i) *(u32x4*)(nA + (lr + 64 * i) * LDSROW + lc) = al.finish(ra[i], (kt + 1) * 64 + lc);
#pragma unroll
                for (int i = 0; i < 2 * NH; ++i) *(u32x4*)(nB + (lr + 64 * i) * LDSROW + lc) = rb[i];
            }
        }
        __syncthreads();
    }
#pragma unroll
    for (int h = 0; h < NH; ++h) epi(acc[h], wr * 64, h * 128 + wc * 64, fr, fq);
    if constexpr (EPI::LDS_FLUSH) {
        __syncthreads();
        epi.flush(smem);
        __syncthreads();
    }
}
constexpr int G8_HB = 128 * 64 * 2;
constexpr int G8_SMEM = 8 * G8_HB;
DI void g8_rc(int& R0, int& C0) {
    const int tz = tidx(), st = tz >> 6, sb = (tz & 63) * 16, swz = sb ^ (((sb >> 9) & 1) << 5);
    R0 = (st >> 1) * 16 + (swz >> 6); C0 = (st & 1) * 32 + ((swz & 63) >> 1);
}
DI int g8_bcol(int h, int rho) { return (rho >> 5) * 64 + h * 32 + (rho & 31); }
struct G8Rows {
    const bf16_t* base; unsigned o0, d1, d2;
    DI const bf16_t* ptr(int h, int i, int kt) const { return (base + (size_t)(h * d2 + i * d1 + kt * 64)) + o0; }
};
struct G8Gather {
    const bf16_t* base; unsigned o[4];
    DI const bf16_t* ptr(int h, int i, int kt) const { return (base + kt * 64) + o[h * 2 + i]; }
};
DI G8Rows g8_arows(const bf16_t* A, int lda) { int R0, C0; g8_rc(R0, C0); return G8Rows{A, (unsigned)(R0 * lda + C0), (unsigned)(64 * lda), (unsigned)(128 * lda)}; }
DI G8Rows g8_brows(const bf16_t* Bt, int ldb) { int R0, C0; g8_rc(R0, C0); return G8Rows{Bt, (unsigned)(g8_bcol(0, R0) * ldb + C0), (unsigned)(128 * ldb), (unsigned)(32 * ldb)}; }
template <class AS, class BS, class EPI, class NF>
DI void gemm8_tile(const AS& as, const BS& bs, int nt  , EPI& epi, char* smem, bool prefetched, NF nextfn) {
    int tz = tidx();
    int wid = tz >> 6, lane = tz & 63, wr = wid >> 2, wc = wid & 3, fr = lane & 15, fq = lane >> 4;
    int loff = ((fr * 64 + fq * 16) ^ ((fr >> 3) << 5));
#define G8_SA(b, h) (smem + ((b) * 2 + (h)) * G8_HB)
#define G8_SB(b, h) (smem + (4 + (b) * 2 + (h)) * G8_HB)
#define G8_STAGE(P, src, h, kt) do { \
        __builtin_amdgcn_global_load_lds((const unsigned*)(src).ptr(h, 0, kt), (LAS unsigned*)((P) + tz * 16), 16, 0, 0); \
        __builtin_amdgcn_global_load_lds((const unsigned*)(src).ptr(h, 1, kt), (LAS unsigned*)((P) + tz * 16 + 8192), 16, 0, 0); } while (0)
#define G8_STA(b, h, kt) G8_STAGE(G8_SA(b, h), as, h, kt)
#define G8_STB(b, h, kt) G8_STAGE(G8_SB(b, h), bs, h, kt)
#define G8_LDA(dst, b, h) _Pragma("unroll") for (int m = 0; m < 4; ++m) _Pragma("unroll") for (int k = 0; k < 2; ++k) \
        dst[m][k] = *(const bf16x8*)(G8_SA(b, h) + (wr * 8 + m * 2 + k) * 1024 + loff)
#define G8_LDB(dst, b, h) _Pragma("unroll") for (int n = 0; n < 2; ++n) _Pragma("unroll") for (int k = 0; k < 2; ++k) \
        dst[n][k] = *(const bf16x8*)(G8_SB(b, h) + (wc * 4 + n * 2 + k) * 1024 + loff)
#define G8_MMA(ai, bj, Bx) do { __builtin_amdgcn_s_setprio(1); \
        _Pragma("unroll") for (int m = 0; m < 4; ++m) _Pragma("unroll") for (int n = 0; n < 2; ++n) _Pragma("unroll") for (int k = 0; k < 2; ++k) \
            acc[ai][bj][m][n] = __builtin_amdgcn_mfma_f32_16x16x32_bf16(Bx[n][k], At[m][k], acc[ai][bj][m][n], 0, 0, 0); \
        __builtin_amdgcn_s_setprio(0); } while (0)
#define G8_WV(n) asm volatile("s_waitcnt vmcnt(" #n ")" ::: "memory")
#define G8_WL(n) asm volatile("s_waitcnt lgkmcnt(" #n ")" ::: "memory")
#define G8_BAR __builtin_amdgcn_s_barrier()
#define G8_SCHED __builtin_amdgcn_sched_barrier(0)
    f32x4 acc[2][2][4][2];
#pragma unroll
    for (int a = 0; a < 2; ++a)
#pragma unroll
        for (int b = 0; b < 2; ++b)
#pragma unroll
            for (int m = 0; m < 4; ++m)
#pragma unroll
                for (int n = 0; n < 2; ++n) acc[a][b][m][n] = (f32x4){0.f, 0.f, 0.f, 0.f};
    bf16x8 At[4][2], B0[2][2], B1[2][2];
    if (!prefetched) { G8_STB(0, 0, 0); G8_STA(0, 0, 0); G8_STB(0, 1, 0); G8_STA(0, 1, 0); }
    if (wr == 1) G8_BAR;
    if (prefetched) G8_WV(0); else G8_WV(4);
    G8_BAR;
    G8_STB(1, 0, 1); G8_STA(1, 0, 1); G8_STB(1, 1, 1);
    G8_WV(6); G8_BAR;
    for (int t = 0; t < nt - 2; t += 2) {
        G8_LDB(B0, 0, 0); G8_SCHED; G8_LDA(At, 0, 0); G8_STA(1, 1, t + 1);
        G8_WL(8); G8_BAR; G8_WL(0); G8_MMA(0, 0, B0); G8_BAR; G8_SCHED;
        G8_LDB(B1, 0, 1); G8_STB(0, 0, t + 2);
        G8_BAR; G8_WL(0); G8_MMA(0, 1, B1); G8_BAR;
        G8_LDA(At, 0, 1); G8_STA(0, 0, t + 2);
        G8_BAR; G8_WL(0); G8_MMA(1, 0, B0); G8_BAR; G8_SCHED;
        G8_STB(0, 1, t + 2);
        G8_WV(6); G8_BAR; G8_MMA(1, 1, B1); G8_BAR;
        G8_LDB(B0, 1, 0); G8_SCHED; G8_LDA(At, 1, 0); G8_STA(0, 1, t + 2);
        G8_WL(8); G8_BAR; G8_WL(0); G8_MMA(0, 0, B0); G8_BAR; G8_SCHED;
        G8_LDB(B1, 1, 1); G8_STB(1, 0, t + 3);
        G8_BAR; G8_WL(0); G8_MMA(0, 1, B1); G8_BAR;
        G8_LDA(At, 1, 1); G8_STA(1, 0, t + 3);
        G8_BAR; G8_WL(0); G8_MMA(1, 0, B0); G8_BAR; G8_SCHED;
        G8_STB(1, 1, t + 3);
        G8_WV(6); G8_BAR; G8_MMA(1, 1, B1); G8_BAR;
    }
    tz = tidx(); wid = tz >> 6; lane = tz & 63; wr = wid >> 2; wc = wid & 3; fr = lane & 15; fq = lane >> 4;
    loff = ((fr * 64 + fq * 16) ^ ((fr >> 3) << 5));
    {
        G8_LDB(B0, 0, 0); G8_WV(0); G8_LDA(At, 0, 0); G8_STA(1, 1, nt - 1);
        G8_BAR; G8_WL(0); G8_MMA(0, 0, B0); G8_BAR;
        G8_LDB(B1, 0, 1); G8_BAR; G8_WL(0); G8_MMA(0, 1, B1); G8_BAR;
        G8_LDA(At, 0, 1); G8_WV(4); G8_BAR; G8_WL(0); G8_MMA(1, 0, B0); G8_MMA(1, 1, B1); G8_BAR;
    }
    {
        G8_LDB(B0, 1, 0); G8_LDA(At, 1, 0); G8_WV(2); G8_BAR; G8_WL(0); G8_MMA(0, 0, B0); G8_BAR;
        G8_LDB(B1, 1, 1); G8_WV(0); G8_BAR; G8_WL(0); G8_MMA(0, 1, B1); G8_BAR;
        G8_LDA(At, 1, 1); G8_BAR; G8_WL(0); G8_MMA(1, 0, B0); G8_MMA(1, 1, B1); G8_BAR;
    }
    if (wr == 0) G8_BAR;
    {
        AS a2; BS b2;
        if (!EPI::STAGED && nextfn(a2, b2)) {
            G8_STAGE(G8_SB(0, 0), b2, 0, 0); G8_STAGE(G8_SA(0, 0), a2, 0, 0); G8_STAGE(G8_SB(0, 1), b2, 1, 0); G8_STAGE(G8_SA(0, 1), a2, 1, 0);
        }
    }
#pragma unroll
    for (int ai = 0; ai < 2; ++ai) {
        f32x4 a4[4][4];
#pragma unroll
        for (int m = 0; m < 4; ++m)
#pragma unroll
            for (int n = 0; n < 4; ++n) a4[m][n] = acc[ai][n >> 1][m][n & 1];
        if constexpr (EPI::STAGED) epi.stage(a4, ai * 128 + wr * 64, wc * 64, fr, fq, smem);
        else epi(a4, ai * 128 + wr * 64, wc * 64, fr, fq);
    }
    if constexpr (EPI::STAGED) {
        __syncthreads();
        epi.flush(smem);
        __syncthreads();
    }
}
template <class TP>
DI void gemm8_run(TP& tp, int nt, char* smem) {
    typename TP::AS as; typename TP::BS bs; typename TP::EPI epi;
    bool pre = false;
    for (int k = 0; tp.get(k, as, bs, epi); ++k) {
        gemm8_tile(as, bs, nt, epi, smem, pre, [&](typename TP::AS& a2, typename TP::BS& b2) { typename TP::EPI e2; return tp.get(k + 1, a2, b2, e2); });
        pre = !TP::EPI::STAGED;
    }
}
DI bool xcd_tile(int k, int nM, int NT, int& mt, int& nt) {
    const bool swz = (gridDim.x & 7) == 0;
    const int j = (swz ? (int)(blockIdx.x >> 3) : (int)blockIdx.x) + (swz ? (int)(gridDim.x >> 3) : (int)gridDim.x) * k, mi = j / NT;
    nt = j - mi * NT; mt = swz ? (int)(blockIdx.x & 7) + 8 * mi : mi;
    return mt < nM;
}
struct ALPlain {
    typedef u32x4 Raw; static constexpr int STORE_AT = 0;
    const bf16_t* A; int lda;
    DI void issue(Raw& r, int row, int k, int) const { r = *(const u32x4*)(A + (size_t)row * lda + k); }
    DI u32x4 finish(const Raw& r, int) const { return r; }
};
struct ALMix {
    struct Raw { u32x4 h, x; };
    static constexpr int STORE_AT = 1;
    const bf16_t* H; const bf16_t* XX; const LAS float* xm;
    DI void issue(Raw& r, int row, int k, int) const { r.h = *(const u32x4*)(H + (size_t)row * DM + k); r.x = *(const u32x4*)(XX + (size_t)row * DM + k); }
    DI void set_mix(const float* g) {
        const int t = tidx();
        LAS float* w = (LAS float*)xm;
        w[t] = g[t]; w[t + 512] = g[t + 512];
        __syncthreads();
    }
    DI u32x4 finish(const Raw& r, int k) const {
        const f32x4 m0 = *(const LAS f32x4*)(xm + k), m1 = *(const LAS f32x4*)(xm + k + 4);
        const u32x4 h = r.h, x = r.x;
        u32x4 o;
        o[0] = pk_bf16(bf_lo(h[0]) + bf_lo(x[0]) * m0[0], bf_hi(h[0]) + bf_hi(x[0]) * m0[1]);
        o[1] = pk_bf16(bf_lo(h[1]) + bf_lo(x[1]) * m0[2], bf_hi(h[1]) + bf_hi(x[1]) * m0[3]);
        o[2] = pk_bf16(bf_lo(h[2]) + bf_lo(x[2]) * m1[0], bf_hi(h[2]) + bf_hi(x[2]) * m1[1]);
        o[3] = pk_bf16(bf_lo(h[3]) + bf_lo(x[3]) * m1[2], bf_hi(h[3]) + bf_hi(x[3]) * m1[3]);
        return o;
    }
};

struct EpiQKV {
    static constexpr bool STAGED = false;
    PLite p; int m0, n0;
    DI void operator()(const f32x4 (&acc)[4][4], int rb, int cb, int fr, int fq) const {
        const int hs = (n0 + cb) >> 6;
        const bool isq = hs < 8 || (hs >= 12 && hs < 20), isv = (hs >= 10 && hs < 12) || hs >= 22, normed = hs >= 12 && hs < 22;
        const float* gam = hs < 20 ? p.qg : p.kg;
        const f32x2* rope = (const f32x2*)(p.ws + OFF_ROPE);
        bf16_t* Q = (bf16_t*)(p.ws + OFF_SCR + S_Q);
        bf16_t* K = (bf16_t*)(p.ws + OFF_SCR + S_K);
        bf16_t* VT = (bf16_t*)(p.ws + OFF_SCR + S_VT);
#pragma unroll
        for (int m = 0; m < 4; ++m) {
            const int tok = m0 + rb + m * 16 + fr, b = tok >= PTOT ? 1 : 0, pos = tok - b * PTOT;
            f32x4 v[4];
#pragma unroll
            for (int n = 0; n < 4; ++n) v[n] = acc[m][n];
            if (normed) {
                float ss = 0.f;
#pragma unroll
                for (int n = 0; n < 4; ++n) ss += v[n][0] * v[n][0] + v[n][1] * v[n][1] + v[n][2] * v[n][2] + v[n][3] * v[n][3];
                ss += __shfl_xor(ss, 16); ss += __shfl_xor(ss, 32);
                const float rstd = rsqrtf(ss * (1.0f / 64.0f) + RMS_EPS);
#pragma unroll
                for (int n = 0; n < 4; ++n) { const f32x4 g = *(const f32x4*)(gam + n * 16 + fq * 4); v[n] = v[n] * rstd * g; }
            }
            if (!isv && pos >= LCTX) {
                const int t = pos - LCTX, prow = t >> 6, pcol = t & 63;
#pragma unroll
                for (int a = 0; a < 2; ++a) {
                    const f32x2* tb = rope + (a == 0 ? prow : 256 + pcol) * 16 + fq * 4;
#pragma unroll
                    for (int j = 0; j < 4; ++j) {
                        const f32x2 cs = tb[j];
                        const float x0 = v[2 * a][j], x1 = v[2 * a + 1][j];
                        v[2 * a][j] = x0 * cs[0] - x1 * cs[1];
                        v[2 * a + 1][j] = x1 * cs[0] + x0 * cs[1];
                    }
                }
            }
            if (isq) {
                const int hq = hs < 8 ? hs : hs - 4;
                bf16_t* dst = Q + ((size_t)(b * 16 + hq) * PTOT + pos) * 64 + fq * 4;
#pragma unroll
                for (int n = 0; n < 4; ++n) { const f32x4 w = v[n] * (0.125f * LOG2E); u32x2 o; o[0] = pk_bf16(w[0], w[1]); o[1] = pk_bf16(w[2], w[3]); *(u32x2*)(dst + n * 16) = o; }
            } else if (!isv) {
                const int kh = hs < 12 ? hs - 8 : hs - 18;
                bf16_t* dst = K + ((size_t)(b * 4 + kh) * PTOT + pos) * 64 + fq * 4;
#pragma unroll
                for (int n = 0; n < 4; ++n) { u32x2 o; o[0] = pk_bf16(v[n][0], v[n][1]); o[1] = pk_bf16(v[n][2], v[n][3]); *(u32x2*)(dst + n * 16) = o; }
            } else {
                const int vh = hs < 12 ? hs - 10 : hs - 20;
                bf16_t* dst = VT + (size_t)(b * 4 + vh) * 64 * PTOT + pos;
#pragma unroll
                for (int n = 0; n < 4; ++n)
#pragma unroll
                    for (int j = 0; j < 4; ++j) dst[(size_t)(n * 16 + fq * 4 + j) * PTOT] = (bf16_t)(pk_bf16(v[n][j], 0.f) & 0xffffu);
            }
        }
    }
};
struct TPQkv {
    typedef G8Rows AS; typedef G8Rows BS; typedef EpiQKV EPI;
    PLite p; const bf16_t* H; const bf16_t* W;
    DI bool get(int k, AS& as, BS& bs, EPI& epi) const {
        int mt, nt; if (!xcd_tile(k, TTOT / 256, QKV_N / 256, mt, nt)) return false;
        as = g8_arows(H + (size_t)mt * 256 * DM, DM); bs = g8_brows(W + (size_t)nt * 256 * DM, DM); epi = EpiQKV{p, mt * 256, nt * 256};
        return true;
    }
};
DI void phase_qkv(const Params& p, char* smem) {
    TPQkv tp{plite(p), (const bf16_t*)(p.ws + OFF_H), (const bf16_t*)(p.ws + OFF_WS) + W_IN};
    gemm8_run(tp, DM / 64, smem);
}

struct EpiResid {
    static constexpr bool STAGED = false;
    PLite p; int m0, n0, layer; bool from_input;
    DI void operator()(const f32x4 (&acc)[4][4], int rb, int cb, int fr, int fq) const {
        const int tok0 = m0 + rb, co = n0 + cb + fq * 4;
        const float* xin = (from_input ? xin_ptr(p, tok0) : xrow_ptr(p, tok0)) + (size_t)fr * DM + co;
        float* xo = xrow_ptr(p, tok0) + (size_t)fr * DM + co;
        const float* gate = mod_ptr(p, layer, tok0, 2) + co;
        f32x4 g[4], xi[2][4];
#pragma unroll
        for (int n = 0; n < 4; ++n) g[n] = *(const f32x4*)(gate + n * 16);
#pragma unroll
        for (int n = 0; n < 4; ++n) xi[0][n] = *(const f32x4*)(xin + n * 16);
#pragma unroll
        for (int m = 0; m < 4; ++m) {
            if (m < 3) {
#pragma unroll
                for (int n = 0; n < 4; ++n) xi[(m + 1) & 1][n] = *(const f32x4*)(xin + (size_t)(m + 1) * 16 * DM + n * 16);
            }
#pragma unroll
            for (int n = 0; n < 4; ++n) *(f32x4*)(xo + (size_t)m * 16 * DM + n * 16) = xi[m & 1][n] + g[n] * acc[m][n];
        }
    }
};
struct TPResid {
    typedef G8Rows AS; typedef G8Rows BS; typedef EpiResid EPI;
    PLite p; const bf16_t* O; const bf16_t* W; int layer;
    DI bool get(int k, AS& as, BS& bs, EPI& epi) const {
        constexpr int MTL = SEQ / 256;
        int mi, nt; if (!xcd_tile(k, layer == 0 ? TTOT / 256 : NBATCH * MTL, 4, mi, nt)) return false;
        const int mt = layer == 0 ? mi : (mi / MTL) * (PTOT / 256) + 1 + (mi % MTL);
        as = g8_arows(O + (size_t)mt * 256 * DM, DM); bs = g8_brows(W + (size_t)nt * 256 * DM, DM); epi = EpiResid{p, mt * 256, nt * 256, layer, layer == 0};
        return true;
    }
};
DI void phase_wout(const Params& p, char* smem) {
    TPResid tp{plite(p), (const bf16_t*)(p.ws + OFF_SCR + S_O), (const bf16_t*)(p.ws + OFF_WS) + W_OUT, 0};
    gemm8_run(tp, DM / 64, smem);
}
DI void phase_wo(const Params& p, char* smem) {
    TPResid tp{plite(p), (const bf16_t*)(p.ws + OFF_SCR + S_OR), (const bf16_t*)(p.ws + OFF_WS) + W_O, 1};
    gemm8_run(tp, DM / 64, smem);
}

struct MoeSched { int nt[16], base[17]; };
DI void moe_sched(const Params& p, int layer, MoeSched& s, int (&cnt)[16]) {
    const int* c = (const int*)(p.ws + OFF_CNT) + layer * 16;
    int acc = 0;
#pragma unroll
    for (int e = 0; e < 16; ++e) { cnt[e] = c[e]; s.nt[e] = (cnt[e] + 255) >> 8; s.base[e] = acc; acc += s.nt[e]; }
    s.base[16] = acc;
}
struct EpiMoe1 {
    static constexpr bool STAGED = true;
    static constexpr int SROW = 136;
    bf16_t* hid;   int n0;
    DI void stage(const f32x4 (&acc)[4][4], int rb, int cb, int fr, int fq, char* smem) const {
        bf16_t* st = (bf16_t*)smem;
        const int c0 = (cb >> 6) * 32 + fq * 4;
#pragma unroll
        for (int m = 0; m < 4; ++m) {
            bf16_t* dst = st + (rb + m * 16 + fr) * SROW + c0;
#pragma unroll
            for (int n = 0; n < 2; ++n) {
                const f32x4 a = acc[m][n], b = acc[m][n + 2];
                u32x2 o;
                o[0] = pk_bf16(siluf_(a[0]) * b[0], siluf_(a[1]) * b[1]);
                o[1] = pk_bf16(siluf_(a[2]) * b[2], siluf_(a[3]) * b[3]);
                *(u32x2*)(dst + n * 16) = o;
            }
        }
    }
    DI void flush(char* smem) const {
        const int t = tidx();
        const bf16_t* st = (const bf16_t*)smem;
        bf16_t* dst = hid + (n0 >> 1) + (t & 15) * 8;
#pragma unroll
        for (int ps = 0; ps < 8; ++ps) {
            const int row = ps * 32 + (t >> 4);
            *(u32x4*)(dst + (size_t)row * 1024) = *(const u32x4*)(st + row * SROW + (t & 15) * 8);
        }
    }
};
struct TPMoe1 {
    typedef G8Gather AS; typedef G8Rows BS; typedef EpiMoe1 EPI;
    MoeSched s; int cnt[16];
    const bf16_t* H; const bf16_t* W13; const int* stok; bf16_t* hid;
    DI bool get(int k, AS& as, BS& bs, EPI& epi) const {
        int mg, nt; if (!xcd_tile(k, s.base[16], 8, mg, nt)) return false;
        int e = 0;
#pragma unroll
        for (int i = 1; i < 16; ++i) if (mg >= s.base[i]) e = i;
        int ce = 0, be = 0;
#pragma unroll
        for (int i = 0; i < 16; ++i) if (i == e) { ce = cnt[i]; be = s.base[i]; }
        const int ml = mg - be;
        int R0, C0; g8_rc(R0, C0);
        as.base = H;
#pragma unroll
        for (int q = 0; q < 4; ++q) {
            const int r = ml * 256 + R0 + 64 * (q & 1) + 128 * (q >> 1);
            const int tk = r < ce ? (stok[(size_t)e * CAP + r] >> 1) : 0;
            as.o[q] = (unsigned)tk * 1024u + C0;
        }
        bs = g8_brows(W13 + (size_t)e * 2048 * 1024 + (size_t)nt * 256 * 1024, 1024);
        epi = EpiMoe1{hid + (size_t)mg * 256 * 1024, nt * 256};
        return true;
    }
};
DI void phase_moe1(const Params& p, int layer, char* smem) {
    TPMoe1 tp;
    moe_sched(p, layer, tp.s, tp.cnt);
    tp.H = (const bf16_t*)(p.ws + OFF_H); tp.W13 = (const bf16_t*)(p.ws + OFF_MOEW); tp.stok = (const int*)(p.ws + OFF_STOK); tp.hid = (bf16_t*)(p.ws + OFF_SCR + S_HID);
    gemm8_run(tp, 16, smem);
}
struct EpiMoe2 {
    static constexpr bool STAGED = false;
    bf16_t* Y; const int* stok; const float* sw; int nvalid, n0;
    DI void operator()(const f32x4 (&acc)[4][4], int rb, int cb, int fr, int fq) const {
        int tkm[4]; float wm[4];
#pragma unroll
        for (int m = 0; m < 4; ++m) { tkm[m] = stok[rb + m * 16 + fr]; wm[m] = sw[rb + m * 16 + fr]; }
#pragma unroll
        for (int m = 0; m < 4; ++m) {
            const int r = rb + m * 16 + fr;
            if (r < nvalid) {
                const int tk = tkm[m]; const float w = wm[m];
                bf16_t* dst = Y + (size_t)tk * 1024 + n0 + cb + fq * 4;
#pragma unroll
                for (int n = 0; n < 4; ++n) { const f32x4 a = acc[m][n] * w; u32x2 o; o[0] = pk_bf16(a[0], a[1]); o[1] = pk_bf16(a[2], a[3]); *(u32x2*)(dst + n * 16) = o; }
            }
        }
    }
};
struct TPMoe2 {
    typedef G8Rows AS; typedef G8Rows BS; typedef EpiMoe2 EPI;
    MoeSched s; int cnt[16];
    const bf16_t* hid; const bf16_t* W2; const int* stok; const float* sw; bf16_t* Y;
    DI bool get(int k, AS& as, BS& bs, EPI& epi) const {
        int mg, nt; if (!xcd_tile(k, s.base[16], 4, mg, nt)) return false;
        int e = 0;
#pragma unroll
        for (int i = 1; i < 16; ++i) if (mg >= s.base[i]) e = i;
        int ce = 0, be = 0;
#pragma unroll
        for (int i = 0; i < 16; ++i) if (i == e) { ce = cnt[i]; be = s.base[i]; }
        const int ml = mg - be;
        as = g8_arows(hid + (size_t)mg * 256 * 1024, 1024); bs = g8_brows(W2 + (size_t)e * 1024 * 1024 + (size_t)nt * 256 * 1024, 1024);
        epi = EpiMoe2{Y, stok + (size_t)e * CAP + ml * 256, sw + (size_t)e * CAP + ml * 256, ce - ml * 256, nt * 256};
        return true;
    }
};
DI void phase_moe2(const Params& p, int layer, char* smem) {
    TPMoe2 tp;
    moe_sched(p, layer, tp.s, tp.cnt);
    tp.hid = (const bf16_t*)(p.ws + OFF_SCR + S_HID); tp.W2 = (const bf16_t*)(p.ws + OFF_MOEW) + (size_t)16 * 2048 * 1024;
    tp.stok = (const int*)(p.ws + OFF_STOK); tp.sw = (const float*)(p.ws + OFF_SW); tp.Y = (bf16_t*)(p.ws + OFF_SCR + S_Y);
    gemm8_run(tp, 16, smem);
}

struct EpiRwkv {
    static constexpr bool LDS_FLUSH = false;
    bf16_t* dst; int ld, m0, n0, act, nstore;
    DI void operator()(const f32x4 (&acc)[4][4], int rb, int cb, int fr, int fq) const {
#pragma unroll
        for (int m = 0; m < 4; ++m) {
            bf16_t* d = dst + (size_t)(m0 + rb + m * 16 + fr) * ld + n0 + cb + fq * 4;
#pragma unroll
            for (int n = 0; n < 4; ++n) {
                const int c = n0 + cb + n * 16 + fq * 4;
                if (c >= ld) continue;
                f32x4 a = acc[m][n];
                if (act == 1) {
#pragma unroll
                    for (int j = 0; j < 4; ++j) { const float e = __builtin_amdgcn_exp2f(a[j] * (2.0f * LOG2E)); a[j] = 1.0f - 2.0f * __builtin_amdgcn_rcpf(e + 1.0f); }
                }
                if (act == 2) {
#pragma unroll
                    for (int j = 0; j < 4; ++j) a[j] = sigmoidf_(a[j]);
                }
                if (c >= nstore) a = (f32x4){0.f, 0.f, 0.f, 0.f};
                u32x2 o; o[0] = pk_bf16(a[0], a[1]); o[1] = pk_bf16(a[2], a[3]);
                *(u32x2*)(d + n * 16) = o;
            }
        }
    }
};
DI void phase_rwkv_proj(const Params& p, char* smem) {
    const bf16_t* H = (const bf16_t*)(p.ws + OFF_H);
    const bf16_t* XX = (const bf16_t*)(p.ws + OFF_SCR + S_XX);
    const bf16_t* wsm = (const bf16_t*)(p.ws + OFF_WS);
    constexpr int MT = TTOT / 256, NU = 14;
    for (int u = blockIdx.x; u < MT * NU; u += gridDim.x) {
        const int mt = u / NU, q = u % NU;
        ALMix al{H + (size_t)mt * 256 * DM, XX + (size_t)mt * 256 * DM, (const LAS float*)(smem + GEMM_SMEM)};
        if (q < 13) {
            const int job = q < 4 ? 0 : q < 8 ? 1 : q < 12 ? 2 : 5, nt = q < 12 ? (q & 3) : 0;
            const int mixj = job == 0 ? 0 : job == 1 ? 2 : job == 2 ? 3 : 5;
            const size_t wofs = job == 0 ? W_R : job == 1 ? W_K : job == 2 ? W_V : W_G1;
            const size_t dofs = job == 0 ? S_R : job == 1 ? S_KK : job == 2 ? S_V : S_LG;
            al.set_mix(p.rwkv_x_mix + mixj * DM);
            EpiRwkv epi{(bf16_t*)(p.ws + OFF_SCR + dofs), job == 5 ? 192 : 1024, mt * 256, nt * 256, job == 5 ? 2 : 0, job == 5 ? 160 : 4096};
            gemm_tile<2>(al, wsm + wofs + (size_t)nt * 256 * DM, DM, DM / 64, epi, smem);
        } else {
#pragma unroll 1
            for (int j = 0; j < 2; ++j) {
                al.set_mix(p.rwkv_x_mix + (j == 0 ? 1 : 4) * DM);
                EpiRwkv epi{(bf16_t*)(p.ws + OFF_SCR + (j == 0 ? S_LW : S_LA)), 128, mt * 256, 0, j == 0 ? 1 : 0, 4096};
                gemm_tile<1>(al, wsm + (j == 0 ? W_W1 : W_A1), DM, DM / 64, epi, smem);
            }
        }
    }
}

struct EpiGate {
    static constexpr bool LDS_FLUSH = true;
    static constexpr int SROW = 132;
    const Params* p; int m0, n0; char* lds;
    DI void operator()(const f32x4 (&acc)[4][4], int rb, int cb, int fr, int fq) const {
        float* st = (float*)lds;
#pragma unroll
        for (int m = 0; m < 4; ++m)
#pragma unroll
            for (int n = 0; n < 4; ++n) *(f32x4*)(st + (rb + m * 16 + fr) * SROW + cb + n * 16 + fq * 4) = acc[m][n];
    }
    struct Rows { u32x4 a, b, v; float bon[4]; };
    DI void load(Rows& r, int tok, int c, int hd) const {
        const size_t ro = (size_t)tok * DM + c;
        r.a = *(const u32x4*)((const bf16_t*)(p->ws + OFF_H) + ro);
        r.b = *(const u32x4*)((const bf16_t*)(p->ws + OFF_SCR + S_Y1) + ro);
        r.v = *(const u32x4*)((const bf16_t*)(p->ws + OFF_SCR + S_V) + ro);
        const float* bonus = (const float*)(p->ws + OFF_BONUS2);
#pragma unroll
        for (int q = 0; q < 4; ++q) r.bon[q] = bonus[(size_t)(q * TTOT + tok) * 16 + hd];
    }
    DI void flush(char* smem) const {
        const int t = tidx(), ch = (t & 15) * 8, rr = t >> 4, c = n0 + ch, hd = c >> 6;
        const float* st = (const float*)smem;
        bf16_t* O = (bf16_t*)(p->ws + OFF_SCR + S_OR);
        const f32x4 g0 = *(const f32x4*)(p->rwkv_ln_g + c), g1 = *(const f32x4*)(p->rwkv_ln_g + c + 4), b0 = *(const f32x4*)(p->rwkv_ln_b + c), b1 = *(const f32x4*)(p->rwkv_ln_b + c + 4);
        Rows rw[2];
        load(rw[0], m0 + rr, c, hd);
#pragma unroll
        for (int ps = 0; ps < 8; ++ps) {
            const int row = ps * 32 + rr, tok = m0 + row;
            if (ps < 7) load(rw[(ps + 1) & 1], tok + 32, c, hd);
            const Rows& r = rw[ps & 1];
            f32x4 y0, y1;
            y0[0] = bf_lo(r.a[0]) + bf_lo(r.b[0]); y0[1] = bf_hi(r.a[0]) + bf_hi(r.b[0]); y0[2] = bf_lo(r.a[1]) + bf_lo(r.b[1]); y0[3] = bf_hi(r.a[1]) + bf_hi(r.b[1]);
            y1[0] = bf_lo(r.a[2]) + bf_lo(r.b[2]); y1[1] = bf_hi(r.a[2]) + bf_hi(r.b[2]); y1[2] = bf_lo(r.a[3]) + bf_lo(r.b[3]); y1[3] = bf_hi(r.a[3]) + bf_hi(r.b[3]);
            float s = (y0[0] + y0[1]) + (y0[2] + y0[3]) + (y1[0] + y1[1]) + (y1[2] + y1[3]);
            s += __shfl_xor(s, 1); s += __shfl_xor(s, 2); s += __shfl_xor(s, 4);
            const float mu = s * (1.0f / 64.0f);
            const f32x4 d0 = y0 - mu, d1 = y1 - mu;
            float q = (d0[0] * d0[0] + d0[1] * d0[1]) + (d0[2] * d0[2] + d0[3] * d0[3]) + (d1[0] * d1[0] + d1[1] * d1[1]) + (d1[2] * d1[2] + d1[3] * d1[3]);
            q += __shfl_xor(q, 1); q += __shfl_xor(q, 2); q += __shfl_xor(q, 4);
            const float rs = rsqrtf(q * (1.0f / 64.0f) + GN_EPS);
            const float bon = (r.bon[0] + r.bon[1]) + (r.bon[2] + r.bon[3]);
            const f32x4 v0 = {bf_lo(r.v[0]), bf_hi(r.v[0]), bf_lo(r.v[1]), bf_hi(r.v[1])}, v1 = {bf_lo(r.v[2]), bf_hi(r.v[2]), bf_lo(r.v[3]), bf_hi(r.v[3])};
            const f32x4 ga = *(const f32x4*)(st + row * SROW + ch), gb = *(const f32x4*)(st + row * SROW + ch + 4);
            const f32x4 o0 = (d0 * rs * g0 + b0 + bon * v0) * ga, o1 = (d1 * rs * g1 + b1 + bon * v1) * gb;
            u32x4 w; w[0] = pk_bf16(o0[0], o0[1]); w[1] = pk_bf16(o0[2], o0[3]); w[2] = pk_bf16(o1[0], o1[1]); w[3] = pk_bf16(o1[2], o1[3]);
            *(u32x4*)(O + (size_t)tok * DM + c) = w;
        }
    }
};
DI void phase_gate(const Params& p, char* smem) {
    const bf16_t* LG = (const bf16_t*)(p.ws + OFF_SCR + S_LG);
    const bf16_t* W = (const bf16_t*)(p.ws + OFF_WS) + W_G2;
    constexpr int NT = 8, MTL = SEQ / 256;
    for (int k = 0;; ++k) {
        int mi, nt; if (!xcd_tile(k, NBATCH * MTL, NT, mi, nt)) break;
        const int mt = (mi / MTL) * (PTOT / 256) + 1 + (mi % MTL);
        ALPlain al{LG + (size_t)mt * 256 * 192, 192};
        EpiGate epi{&p, mt * 256, nt * 128, smem};
        gemm_tile<1>(al, W + (size_t)nt * 128 * 192, 192, 3, epi, smem);
    }
}

constexpr int KROW = 72, VROW = 68;
constexpr int ATT_SMEM = 2 * 64 * KROW * 2 + 2 * 64 * VROW * 2;
DI int crow_(int i, int h) { return (i & 3) + 8 * (i >> 2) + 4 * h; }
#define MFMA32(a, b, c) __builtin_amdgcn_mfma_f32_32x32x16_bf16((a), (b), (c), 0, 0, 0)
template <int MODE>
DI void attn_unit(const Params& p, const bf16_t* Qg  , int nq_valid, const bf16_t* Kg  , const bf16_t* Vg  ,
                  int ta0, int ta1, int tb0, int tb1  , bool band, int q_lat0  ,
                  float init_m, float init_l0, bf16_t* Og  , char* smem) {
    const int t = tidx(), lane = t & 63, wid = t >> 6, r = lane & 31, h = lane >> 5;
    bf16_t* sK = (bf16_t*)smem;
    bf16_t* sV = sK + 2 * 64 * KROW;
    bf16x8 qf[2][4];
#pragma unroll
    for (int qs = 0; qs < 2; ++qs) {
        const int qi = wid * 64 + qs * 32 + r;
        const bf16_t* qp = Qg + (size_t)(qi < nq_valid ? qi : 0) * 64 + 8 * h;
#pragma unroll
        for (int ks = 0; ks < 4; ++ks) qf[qs][ks] = *(const bf16x8*)(qp + ks * 16);
    }
#pragma unroll
    for (int qs = 0; qs < 2; ++qs)
#pragma unroll
        for (int ks = 0; ks < 4; ++ks) asm volatile("" : "+v"(qf[qs][ks]));
    f32x16 o[2][2];
#pragma unroll
    for (int qs = 0; qs < 2; ++qs)
#pragma unroll
        for (int dt = 0; dt < 2; ++dt)
#pragma unroll
            for (int i = 0; i < 16; ++i) o[qs][dt][i] = 0.f;
    float mrun[2], lrun[2];
#pragma unroll
    for (int qs = 0; qs < 2; ++qs) { mrun[qs] = init_m; lrun[qs] = (MODE == 1 && h == 0) ? init_l0 : 0.f; }
    const int ntile = ((ta1 - ta0) + (tb1 - tb0)) >> 6;
    const int lrow = t >> 3, lch = (t & 7) * 8;
    u32x4 rk, rv;
    auto tile_pos = [&](int i) { const int a = (ta1 - ta0) >> 6; return i < a ? ta0 + i * 64 : tb0 + (i - a) * 64; };
    {
        const int kp = tile_pos(0);
        rk = *(const u32x4*)(Kg + (size_t)(kp + lrow) * 64 + lch);
        rv = *(const u32x4*)(Vg + (size_t)lrow * PTOT + kp + lch);
        *(u32x4*)(sK + lrow * KROW + lch) = rk;
        *(u32x2*)(sV + lrow * VROW + lch) = (u32x2){rv[0], rv[1]};
        *(u32x2*)(sV + lrow * VROW + lch + 4) = (u32x2){rv[2], rv[3]};
    }
    __syncthreads();
    if (__builtin_amdgcn_readfirstlane(wid) >= 4) __builtin_amdgcn_s_setprio(1);
    for (int it = 0; it < ntile; ++it) {
        const int cur = it & 1;
        const bool more = it + 1 < ntile;
        const int kp = tile_pos(it);
        if (more) {
            const int kn = tile_pos(it + 1);
            rk = *(const u32x4*)(Kg + (size_t)(kn + lrow) * 64 + lch);
            rv = *(const u32x4*)(Vg + (size_t)lrow * PTOT + kn + lch);
        }
        __builtin_amdgcn_sched_barrier(0);
        const bf16_t* cK = sK + cur * 64 * KROW;
        const bf16_t* cV = sV + cur * 64 * VROW;
        bool need = true;
        if (MODE == 1 && band && kp >= LCTX) {
            const int q0 = q_lat0 + __builtin_amdgcn_readfirstlane(wid) * 64, k0 = kp - LCTX;
            need = (k0 + 63 >= q0 - 128) && (k0 <= q0 + 63 + 128);
        }
        if (need) {
        bf16x8 kf[4];
#pragma unroll
        for (int ks = 0; ks < 4; ++ks) kf[ks] = *(const bf16x8*)(cK + r * KROW + ks * 16 + 8 * h);
#pragma unroll
        for (int ksub = 0; ksub < 2; ++ksub) {
            bf16x8 vf[2][2];
#pragma unroll
            for (int st = 0; st < 2; ++st)
#pragma unroll
                for (int dt = 0; dt < 2; ++dt) {
                    const int kb = ksub * 32 + 16 * st + 4 * h;
                    const s16x4 lo = *(const s16x4*)(cV + (dt * 32 + r) * VROW + kb), hi = *(const s16x4*)(cV + (dt * 32 + r) * VROW + kb + 8);
                    vf[st][dt] = __builtin_shufflevector(lo, hi, 0, 1, 2, 3, 4, 5, 6, 7);
                }
            __builtin_amdgcn_sched_barrier(0);
            f32x16 sc[2];
#pragma unroll
            for (int qs = 0; qs < 2; ++qs)
#pragma unroll
                for (int i = 0; i < 16; ++i) sc[qs][i] = MODE == 0 ? init_m : 0.f;
#pragma unroll
            for (int ks = 0; ks < 4; ++ks)
#pragma unroll
                for (int qs = 0; qs < 2; ++qs) sc[qs] = MFMA32(kf[ks], qf[qs][ks], sc[qs]);
            __builtin_amdgcn_sched_barrier(0);
            if (ksub == 0) {
#pragma unroll
                for (int ks = 0; ks < 4; ++ks) kf[ks] = *(const bf16x8*)(cK + (32 + r) * KROW + ks * 16 + 8 * h);
            }
            __builtin_amdgcn_sched_barrier(0);
#pragma unroll
            for (int qs = 0; qs < 2; ++qs) {
                if (MODE == 1) {
                    if (band && kp >= LCTX) {
                        const int qlat = q_lat0 + wid * 64 + qs * 32 + r, kl0 = kp - LCTX + ksub * 32;
#pragma unroll
                        for (int i = 0; i < 16; ++i) {
                            const int d0 = qlat - (kl0 + crow_(i, h));
                            if (d0 > 128 || d0 < -128) sc[qs][i] = -1e30f;
                        }
                    }
                    float mt = sc[qs][0];
#pragma unroll
                    for (int i = 1; i < 16; ++i) mt = fmaxf(mt, sc[qs][i]);
                    mt = fmaxf(mt, __shfl_xor(mt, 32));
                    const float mnew = fmaxf(mrun[qs], mt);
                    const float alpha = __builtin_amdgcn_exp2f(mrun[qs] - mnew);
                    mrun[qs] = mnew; lrun[qs] *= alpha;
#pragma unroll
                    for (int i = 0; i < 16; ++i) { o[qs][0][i] *= alpha; o[qs][1][i] *= alpha; }
#pragma unroll
                    for (int i = 0; i < 16; ++i) sc[qs][i] -= mnew;
                }
                float ls = 0.f;
#pragma unroll
                for (int i = 0; i < 16; ++i) { sc[qs][i] = __builtin_amdgcn_exp2f(sc[qs][i]); ls += sc[qs][i]; }
                lrun[qs] += ls;
            }
#pragma unroll
            for (int st = 0; st < 2; ++st) {
                bf16x8 pf[2];
#pragma unroll
                for (int qs = 0; qs < 2; ++qs) {
                    u32x4 pw;
#pragma unroll
                    for (int j = 0; j < 4; ++j) pw[j] = pk_bf16(sc[qs][8 * st + 2 * j], sc[qs][8 * st + 2 * j + 1]);
                    pf[qs] = __builtin_bit_cast(bf16x8, pw);
                }
#pragma unroll
                for (int dt = 0; dt < 2; ++dt)
#pragma unroll
                    for (int qs = 0; qs < 2; ++qs) o[qs][dt] = MFMA32(vf[st][dt], pf[qs], o[qs][dt]);
            }
        }
        }
        if (more) {
            bf16_t* nK = sK + (cur ^ 1) * 64 * KROW;
            bf16_t* nV = sV + (cur ^ 1) * 64 * VROW;
            *(u32x4*)(nK + lrow * KROW + lch) = rk;
            *(u32x2*)(nV + lrow * VROW + lch) = (u32x2){rv[0], rv[1]};
            *(u32x2*)(nV + lrow * VROW + lch + 4) = (u32x2){rv[2], rv[3]};
        }
        __syncthreads();
    }
    __builtin_amdgcn_s_setprio(0);
#pragma unroll
    for (int qs = 0; qs < 2; ++qs) {
        const int qi = wid * 64 + qs * 32 + r;
        const float lt = lrun[qs] + __shfl_xor(lrun[qs], 32);
        const float invl = 1.0f / lt;
        if (qi < nq_valid) {
            bf16_t* op = Og + (size_t)qi * DM;
#pragma unroll
            for (int g = 0; g < 4; ++g) {
                u32x2 w0, w1;
                w0[0] = pk_bf16(o[qs][0][4 * g] * invl, o[qs][0][4 * g + 1] * invl); w0[1] = pk_bf16(o[qs][0][4 * g + 2] * invl, o[qs][0][4 * g + 3] * invl);
                w1[0] = pk_bf16(o[qs][1][4 * g] * invl, o[qs][1][4 * g + 1] * invl); w1[1] = pk_bf16(o[qs][1][4 * g + 2] * invl, o[qs][1][4 * g + 3] * invl);
                *(u32x2*)(op + 8 * g + 4 * h) = w0;
                *(u32x2*)(op + 32 + 8 * g + 4 * h) = w1;
            }
        }
    }
}
DI void phase_attn(const Params& p, char* smem) {
    const bf16_t* Q = (const bf16_t*)(p.ws + OFF_SCR + S_Q);
    const bf16_t* K = (const bf16_t*)(p.ws + OFF_SCR + S_K);
    const bf16_t* VT = (const bf16_t*)(p.ws + OFF_SCR + S_VT);
    bf16_t* O = (bf16_t*)(p.ws + OFF_SCR + S_O);
    float gq = 0.f, gk = 0.f;
    for (int i = 0; i < 64; ++i) { gq = fmaxf(gq, fabsf(p.attn_q_norm_g[i])); gk = fmaxf(gk, fabsf(p.attn_k_norm_g[i])); }
    const float M2 = 8.25f * gq * gk * LOG2E;
    constexpr int QB = 512, NQB = SEQ / QB;
    const int G = gridDim.x;
    constexpr int NDENSE = NBATCH * 8 * NQB;
    for (int u = blockIdx.x; u < NDENSE; u += G) {
        int combo, within;
        if ((G & 7) == 0 && NDENSE % G == 0) {
            const int xcd = blockIdx.x & 7, idx = (blockIdx.x >> 3) + (G >> 3) * (u / G);
            combo = xcd & 3; within = (xcd >> 2) * (NDENSE / 8) + idx;
        } else { combo = u / (4 * NQB); within = u % (4 * NQB); }
        const int b = combo >> 1, kvh = combo & 1, hq = kvh * 4 + (within & 3), qb = within >> 2;
        const bf16_t* Qg = Q + ((size_t)(b * 16 + 8 + hq) * PTOT + LCTX + qb * QB) * 64;
        attn_unit<0>(p, Qg, QB, K + (size_t)(b * 4 + 2 + kvh) * PTOT * 64, VT + (size_t)(b * 4 + 2 + kvh) * 64 * PTOT, 0, PTOT, 0, 0, false, 0, -M2, 0.f,
                     O + (size_t)(b * PTOT + LCTX + qb * QB) * DM + (8 + hq) * 64, smem);
    }
    for (int u = blockIdx.x; u < NDENSE; u += G) {
        const int b = u / (8 * NQB), rem = u % (8 * NQB), qb = rem >> 3, hq = rem & 7, kvh = hq >> 2;
        const int i0 = qb * QB;
        const int lo = i0 - 128 < 0 ? 0 : i0 - 128, hi = i0 + QB + 128 > SEQ ? SEQ : i0 + QB + 128;
        const bf16_t* Qg = Q + ((size_t)(b * 16 + hq) * PTOT + LCTX + i0) * 64;
        attn_unit<1>(p, Qg, QB, K + (size_t)(b * 4 + kvh) * PTOT * 64, VT + (size_t)(b * 4 + kvh) * 64 * PTOT, 0, LCTX, LCTX + lo, LCTX + hi, true, i0,
                     p.attn_sink[hq] * LOG2E, 1.0f, O + (size_t)(b * PTOT + LCTX + i0) * DM + hq * 64, smem);
    }
    for (int u = blockIdx.x; u < NBATCH * 16; u += G) {
        const int b = u >> 4, hh = u & 15, isb = hh >> 3, hq = hh & 7, kvh = isb * 2 + (hq >> 2);
        const bf16_t* Qg = Q + ((size_t)(b * 16 + hh) * PTOT) * 64;
        attn_unit<1>(p, Qg, LCTX, K + (size_t)(b * 4 + kvh) * PTOT * 64, VT + (size_t)(b * 4 + kvh) * 64 * PTOT, 0, LCTX, 0, 0, false, 0,
                     isb ? -1e30f : p.attn_sink[hq] * LOG2E, isb ? 0.f : 1.0f, O + (size_t)(b * PTOT) * DM + hh * 64, smem);
    }
}

constexpr int TB = 32, NBUF = 3;
constexpr int SC_REC = 5 * 64;
constexpr int SC_OPS = TB * SC_REC * 4;
constexpr int SC_SMEM = NBUF * SC_OPS + NBUF * TB * 16 * 4 + NBUF * TB * 16 * 4 + 64;
DI int scan_pos(int n, int dir) {
    if (n < LCTX) return dir ? LCTX - 1 - n : n;
    const int m = n - LCTX;
    return LCTX + (dir ? SEQ - 1 - m : m);
}
template <int CTRL> DI float dpp_add(float v) { return v + __builtin_bit_cast(float, __builtin_amdgcn_update_dpp(0, __builtin_bit_cast(int, v), CTRL, 0xf, 0xf, false)); }
DI float row16_sum(float v) { v = dpp_add<0x128>(v); v = dpp_add<0x124>(v); v = dpp_add<0x122>(v); v = dpp_add<0x121>(v); return v; }
DI int lds_min4(int* c) { const volatile LAS int* q = (const volatile LAS int*)c; const int a = q[0], b = q[1], d = q[2], e = q[3]; return min(min(a, b), min(d, e)); }
DI void lds_publish(int* c, int v) { *(volatile LAS int*)c = v; }
DI void scan_unit(const Params& p, int u, char* smem) {
    const int t = tidx(), lane = t & 63, wid = __builtin_amdgcn_readfirstlane(t >> 6);
    const unsigned rg = u & 3, dir = (u >> 2) & 1, hd = (u >> 3) & 15, b = u >> 7;
    float* ops = (float*)smem;
    float* vbuf = (float*)(smem + NBUF * SC_OPS);
    float* ybuf = vbuf + NBUF * TB * 16;
    int* cnts = (int*)(ybuf + NBUF * TB * 16);
    const bf16_t* R = (const bf16_t*)(p.ws + OFF_SCR + S_R);
    const bf16_t* Kk = (const bf16_t*)(p.ws + OFF_SCR + S_KK);
    const bf16_t* V = (const bf16_t*)(p.ws + OFF_SCR + S_V);
    const bf16_t* LW = (const bf16_t*)(p.ws + OFF_SCR + S_LW);
    const bf16_t* LA = (const bf16_t*)(p.ws + OFF_SCR + S_LA);
    bf16_t* Yo = dir ? (bf16_t*)(p.ws + OFF_SCR + S_Y1) : (bf16_t*)(p.ws + OFF_H);
    float* bonus = (float*)(p.ws + OFF_BONUS2);
    const unsigned tokb = b * PTOT, hc = hd * 64;
    constexpr int NBLK = PTOT / TB;
    const unsigned fr = lane & 15, fq = lane >> 4;
    if (t < 8) cnts[t] = 0;
    __syncthreads();

    if (wid < 4) {
        __builtin_amdgcn_s_setprio(3);
        float s0 = 0.f, s1 = 0.f, s2 = 0.f, s3 = 0.f;
        const unsigned g = lane >> 4, c4 = (lane & 15) * 4, myrow = wid * 4 + g;
        for (int blk = 0; blk < NBLK; ++blk) {
            const unsigned buf = (unsigned)blk % NBUF;
            while (lds_min4(cnts) < blk + 1) __builtin_amdgcn_s_sleep(1);
            asm volatile("" ::: "memory");
            const float* rec = ops + buf * (TB * SC_REC) + c4;
            const float* vb = vbuf + buf * (TB * 16) + myrow;
            float* yb = ybuf + buf * (TB * 16) + myrow;
            f32x4 w0_ = *(const f32x4*)(rec), kd0_ = *(const f32x4*)(rec + 64), bb0_ = *(const f32x4*)(rec + 128), aa0_ = *(const f32x4*)(rec + 192), rr0_ = *(const f32x4*)(rec + 256);
            float vv0_ = vb[0];
#define SCAN_STEP(W, KD, BB, AA, RR, VV, ST) { \
                float sa = s0 * AA[0] + s1 * AA[1] + s2 * AA[2] + s3 * AA[3]; \
                sa = row16_sum(sa); \
                s0 = s0 * W[0] + sa * BB[0] + VV * KD[0]; \
                s1 = s1 * W[1] + sa * BB[1] + VV * KD[1]; \
                s2 = s2 * W[2] + sa * BB[2] + VV * KD[2]; \
                s3 = s3 * W[3] + sa * BB[3] + VV * KD[3]; \
                float y = s0 * RR[0] + s1 * RR[1] + s2 * RR[2] + s3 * RR[3]; \
                y = row16_sum(y); \
                if ((lane & 15) == 0) yb[(ST) * 16] = y; }
#pragma unroll 1
            for (int st = 0; st < TB; st += 2) {
                const float* r1 = rec + (st + 1) * SC_REC;
                const f32x4 w1_ = *(const f32x4*)(r1), kd1_ = *(const f32x4*)(r1 + 64), bb1_ = *(const f32x4*)(r1 + 128), aa1_ = *(const f32x4*)(r1 + 192), rr1_ = *(const f32x4*)(r1 + 256);
                const float vv1_ = vb[(st + 1) * 16];
                SCAN_STEP(w0_, kd0_, bb0_, aa0_, rr0_, vv0_, st)
                const int st2 = st + 2 < TB ? st + 2 : st;
                const float* r2 = rec + st2 * SC_REC;
                w0_ = *(const f32x4*)(r2); kd0_ = *(const f32x4*)(r2 + 64); bb0_ = *(const f32x4*)(r2 + 128); aa0_ = *(const f32x4*)(r2 + 192); rr0_ = *(const f32x4*)(r2 + 256);
                vv0_ = vb[st2 * 16];
                SCAN_STEP(w1_, kd1_, bb1_, aa1_, rr1_, vv1_, st + 1)
            }
#undef SCAN_STEP
            asm volatile("s_waitcnt lgkmcnt(0)" ::: "memory");
            if (lane == 0) lds_publish(cnts + 4 + wid, blk + 1);
        }
        __builtin_amdgcn_s_setprio(0);
    } else {
        const unsigned wt = wid & 1, chh = (wid >> 1) & 1;
        const bf16_t* wsm = (const bf16_t*)(p.ws + OFF_WS);
        const unsigned wo = W_W2 + dir * 65536u + (hc + fr) * 64u + fq * 8u;
        const unsigned ao = W_A2 + dir * 65536u + (hc + fr) * 64u + fq * 8u;
        const unsigned po = hc + fq * 4u;
        for (int blk = 0; blk < NBLK + NBUF; ++blk) {
            const unsigned buf = (unsigned)blk % NBUF;
            const int need = blk - NBUF + 1 < NBLK ? blk - NBUF + 1 : NBLK;
            while (lds_min4(cnts + 4) < need) __builtin_amdgcn_s_sleep(1);
            asm volatile("" ::: "memory");
            if (wid == 7 && blk >= NBUF) {
#pragma unroll
                for (int i = 0; i < TB * 16 / 64; ++i) {
                    const unsigned id = i * 64 + lane, st = id >> 4, rw = id & 15;
                    const unsigned tok = tokb + scan_pos((blk - NBUF) * TB + st, dir);
                    Yo[tok * 1024u + hc + rg * 16 + rw] = (bf16_t)(pk_bf16(ybuf[buf * (TB * 16) + id], 0.f) & 0xffffu);
                }
            }
            if (blk >= NBLK) continue;
            const unsigned st = wt * 16 + fr;
            const unsigned tok = tokb + scan_pos(blk * TB + st, dir);
            const unsigned lo = tok * 128u + dir * 64u + fq * 8u;
            const unsigned ro = tok * 1024u + hc + fq * 4u;
            bf16x8 lwf[2], laf[2];
#pragma unroll
            for (int kk = 0; kk < 2; ++kk) { lwf[kk] = *(const bf16x8*)(LW + lo + kk * 32); laf[kk] = *(const bf16x8*)(LA + lo + kk * 32); }
            float ssq = 0.f;
#pragma unroll
            for (int nt = 0; nt < 4; ++nt) {
                const f32x4 kkv = *(const f32x4*)(p.rwkv_k_k + po + nt * 16);
                const u32x2 c = *(const u32x2*)(Kk + ro + nt * 16);
                const float q0 = bf_lo(c[0]) * kkv[0], q1 = bf_hi(c[0]) * kkv[1], q2 = bf_lo(c[1]) * kkv[2], q3 = bf_hi(c[1]) * kkv[3];
                ssq += q0 * q0 + q1 * q1 + q2 * q2 + q3 * q3;
            }
            ssq += __shfl_xor(ssq, 16); ssq += __shfl_xor(ssq, 32);
            const float kn = __builtin_amdgcn_rsqf(fmaxf(ssq, 1e-24f));
            float* rec = ops + buf * (TB * SC_REC) + st * SC_REC + fq * 4;
            float bsum = 0.f;
#pragma unroll
            for (int n2 = 0; n2 < 2; ++n2) {
                const unsigned nt = chh * 2 + n2;
                f32x4 aw = {0.f, 0.f, 0.f, 0.f}, ai = aw;
#pragma unroll
                for (int kk = 0; kk < 2; ++kk) {
                    const bf16x8 w2f = *(const bf16x8*)(wsm + wo + nt * 1024 + kk * 32), a2f = *(const bf16x8*)(wsm + ao + nt * 1024 + kk * 32);
                    aw = __builtin_amdgcn_mfma_f32_16x16x32_bf16(w2f, lwf[kk], aw, 0, 0, 0);
                    ai = __builtin_amdgcn_mfma_f32_16x16x32_bf16(a2f, laf[kk], ai, 0, 0, 0);
                }
                const f32x4 w0v = *(const f32x4*)(p.rwkv_decay_w0 + dir * 1024u + po + nt * 16), a0v = *(const f32x4*)(p.rwkv_iclr_a0 + dir * 1024u + po + nt * 16);
                const f32x4 kkv = *(const f32x4*)(p.rwkv_k_k + po + nt * 16);
                const f32x4 kav = *(const f32x4*)(p.rwkv_k_a + po + nt * 16), rkv = *(const f32x4*)(p.rwkv_r_k + po + nt * 16);
                const u32x2 a = *(const u32x2*)(R + ro + nt * 16), c = *(const u32x2*)(Kk + ro + nt * 16);
                const f32x4 rr = {bf_lo(a[0]), bf_hi(a[0]), bf_lo(a[1]), bf_hi(a[1])};
                const f32x4 kr = {bf_lo(c[0]), bf_hi(c[0]), bf_lo(c[1]), bf_hi(c[1])};
                f32x4 wv, kd, bb, aa;
#pragma unroll
                for (int j = 0; j < 4; ++j) {
                    const float sg = __builtin_amdgcn_rcpf(1.0f + __builtin_amdgcn_exp2f(-(w0v[j] + aw[j]) * LOG2E));
                    wv[j] = __builtin_amdgcn_exp2f(sg * (-0.6065306597126334f * LOG2E));
                    const float ic = __builtin_amdgcn_rcpf(1.0f + __builtin_amdgcn_exp2f(-(a0v[j] + ai[j]) * LOG2E));
                    const float kkn = kr[j] * kkv[j] * kn;
                    kd[j] = kr[j] * (1.0f + (ic - 1.0f) * kav[j]);
                    bb[j] = kkn * ic;
                    aa[j] = -kkn;
                    bsum += rr[j] * kd[j] * rkv[j];
                }
                *(f32x4*)(rec + 0 * 64 + nt * 16) = wv;
                *(f32x4*)(rec + 1 * 64 + nt * 16) = kd;
                *(f32x4*)(rec + 2 * 64 + nt * 16) = bb;
                *(f32x4*)(rec + 3 * 64 + nt * 16) = aa;
                *(f32x4*)(rec + 4 * 64 + nt * 16) = rr;
            }
            bsum += __shfl_xor(bsum, 16); bsum += __shfl_xor(bsum, 32);
            if (rg == 0 && fq == 0) bonus[((chh * 2 + dir) * TTOT + tok) * 16u + hd] = bsum;
            if (wid == 6) {
                bf16_t vr[TB * 16 / 64];
#pragma unroll
                for (int i = 0; i < TB * 16 / 64; ++i) {
                    const unsigned id = i * 64 + lane, s2 = id >> 4, rw = id & 15;
                    const unsigned tk = tokb + scan_pos(blk * TB + s2, dir);
                    vr[i] = V[tk * 1024u + hc + rg * 16 + rw];
                }
#pragma unroll
                for (int i = 0; i < TB * 16 / 64; ++i) vbuf[buf * (TB * 16) + i * 64 + lane] = bf2f(vr[i]);
            }
            asm volatile("s_waitcnt lgkmcnt(0)" ::: "memory");
            if (lane == 0) lds_publish(cnts + (wid - 4), blk + 1);
        }
    }
    __syncthreads();
}

constexpr int CH = 16, NCHK = PTOT / CH;
constexpr int NPREP = 7, NSLOT = 2;
constexpr int TKS = 72, KTS = 20, SMS = 20;
constexpr int SL_XA = 0, SL_XR = SL_XA + 16 * TKS * 2, SL_TB = SL_XR + 16 * TKS * 2, SL_TK = SL_TB + 64 * KTS * 2, SL_TT = SL_TK + 64 * KTS * 2, SL_NAK = SL_TT + 16 * SMS * 2,
              SL_NRB = SL_NAK + 16 * SMS * 2, SL_NRK = SL_NRB + 16 * SMS * 2, SL_VT = SL_NRK + 16 * SMS * 2, SL_WC = SL_VT + 16 * SMS * 2, SLOT_BYTES = SL_WC + 64 * 4;
constexpr int XTK_B = 16 * TKS * 2, XKT_B = 64 * KTS * 2, SM_B = 16 * SMS * 2;
constexpr int PR_XA = 0, PR_XB = PR_XA + XTK_B, PR_XK = PR_XB + XTK_B, PR_XR = PR_XK + XTK_B, PR_TB = PR_XR + XTK_B, PR_TK = PR_TB + XKT_B,
              PR_SN = PR_TK + XKT_B, PREP_BYTES = PR_SN + 2 * SM_B;
static_assert(10 * SM_B <= 3 * XTK_B, "matrices fit in XA..XK");
constexpr int SC2_SMEM = NSLOT * SLOT_BYTES + NPREP * PREP_BYTES + 64 + 5 * 64 * 4;
typedef short s16x4v __attribute__((ext_vector_type(4)));
DI f32x4 mfma16(s16x4v a, s16x4v b, f32x4 c) { return __builtin_amdgcn_mfma_f32_16x16x16bf16_1k(a, b, c, 0, 0, 0); }
DI f32x4 mfma32(bf16x8 a, bf16x8 b, f32x4 c) { return __builtin_amdgcn_mfma_f32_16x16x32_bf16(a, b, c, 0, 0, 0); }
DI s16x4v ld4(const bf16_t* q) { return *(const s16x4v*)q; }
DI f32x4 up4(u32x2 w) { return (f32x4){bf_lo(w[0]), bf_hi(w[0]), bf_lo(w[1]), bf_hi(w[1])}; }
DI f32x4 ld4f(const bf16_t* q) { return up4(*(const u32x2*)q); }
DI void st4(bf16_t* q, f32x4 v) { u32x2 w; w[0] = pk_bf16(v[0], v[1]); w[1] = pk_bf16(v[2], v[3]); *(u32x2*)q = w; }
#define LDS_WAIT() asm volatile("s_waitcnt lgkmcnt(0)" ::: "memory")
template <int CTRL> DI float dpp_shr_add(float v) { return v + __builtin_bit_cast(float, __builtin_amdgcn_update_dpp(0, __builtin_bit_cast(int, v), CTRL, 0xf, 0xf, true)); }
DI float row16_prefix(float v) { v = dpp_shr_add<0x111>(v); v = dpp_shr_add<0x112>(v); v = dpp_shr_add<0x114>(v); v = dpp_shr_add<0x118>(v); return v; }
DI f32x4 mm16(const bf16_t* A, const bf16_t* Bt, int fr, int fq) {
    const s16x4v a = ld4(A + fr * SMS + fq * 4), b = ld4(Bt + fr * SMS + fq * 4);
    LDS_WAIT();
    return mfma16(a, b, (f32x4){0.f, 0.f, 0.f, 0.f});
}
DI f32x4 mm16p(const bf16_t* A, const bf16_t* Bt, const bf16_t* Add, int fr, int fq) {
    const s16x4v a = ld4(A + fr * SMS + fq * 4), b = ld4(Bt + fr * SMS + fq * 4);
    const u32x2 c = *(const u32x2*)(Add + fr * SMS + fq * 4);
    LDS_WAIT();
    return mfma16(a, b, up4(c));
}

DI void scan_unit_chunked(const Params& p, int u, char* smem) {
    const int t = tidx(), lane = t & 63, wid = __builtin_amdgcn_readfirstlane(t >> 6);
    const unsigned rg = u & 3, dir = (u >> 2) & 1, hd = (u >> 3) & 15, b = u >> 7;
    const unsigned tokb = b * PTOT, hc = hd * 64;
    const unsigned fr = lane & 15, fq = lane >> 4;
    char* slots = smem;
    char* prep0 = smem + NSLOT * SLOT_BYTES;
    int* cnts = (int*)(smem + NSLOT * SLOT_BYTES + NPREP * PREP_BYTES);
    const bf16_t* R = (const bf16_t*)(p.ws + OFF_SCR + S_R);
    const bf16_t* Kk = (const bf16_t*)(p.ws + OFF_SCR + S_KK);
    const bf16_t* V = (const bf16_t*)(p.ws + OFF_SCR + S_V);
    const bf16_t* LW = (const bf16_t*)(p.ws + OFF_SCR + S_LW);
    const bf16_t* LA = (const bf16_t*)(p.ws + OFF_SCR + S_LA);
    bf16_t* Yo = dir ? (bf16_t*)(p.ws + OFF_SCR + S_Y1) : (bf16_t*)(p.ws + OFF_H);
    float* bonus = (float*)(p.ws + OFF_BONUS2);
    float* prm = (float*)(cnts + 16);
    if (t < 16) cnts[t] = 0;
    if (t < 64) {
        prm[t] = p.rwkv_decay_w0[dir * 1024u + hc + t]; prm[64 + t] = p.rwkv_iclr_a0[dir * 1024u + hc + t];
        prm[128 + t] = p.rwkv_k_k[hc + t]; prm[192 + t] = p.rwkv_k_a[hc + t]; prm[256 + t] = p.rwkv_r_k[hc + t];
    }
    __syncthreads();

    if (wid == 0) {
        __builtin_amdgcn_s_setprio(3);
        f32x4 st[4];
#pragma unroll
        for (int m = 0; m < 4; ++m) st[m] = (f32x4){0.f, 0.f, 0.f, 0.f};
        for (int c = 0; c < NCHK; ++c) {
            const unsigned sl = (unsigned)c % NSLOT;
            const char* S = slots + sl * SLOT_BYTES;
            while (*(volatile LAS int*)(cnts + sl) < c + 1) __builtin_amdgcn_s_sleep(1);
            LDS_WAIT();
            const int so = fr * SMS + fq * 4;
            const s16x4v vt = ld4((const bf16_t*)(S + SL_VT) + so);
            const s16x4v tt = ld4((const bf16_t*)(S + SL_TT) + so);
            const s16x4v nakt = ld4((const bf16_t*)(S + SL_NAK) + so);
            const s16x4v nrbt = ld4((const bf16_t*)(S + SL_NRB) + so);
            const s16x4v nrkt = ld4((const bf16_t*)(S + SL_NRK) + so);
            s16x4v xal[2], xah[2], xrl[2], xrh[2], tb[4], tk[4];
            f32x4 wc[4];
#pragma unroll
            for (int i = 0; i < 2; ++i) {
                const bf16_t* qa = (const bf16_t*)(S + SL_XA) + fr * TKS + 32 * i + fq * 4; xal[i] = ld4(qa); xah[i] = ld4(qa + 16);
                const bf16_t* qr = (const bf16_t*)(S + SL_XR) + fr * TKS + 32 * i + fq * 4; xrl[i] = ld4(qr); xrh[i] = ld4(qr + 16);
            }
#pragma unroll
            for (int m = 0; m < 4; ++m) {
                wc[m] = *(const f32x4*)((const float*)(S + SL_WC) + 16 * m + fq * 4);
                tb[m] = ld4((const bf16_t*)(S + SL_TB) + (16 * m + fr) * KTS + fq * 4);
                tk[m] = ld4((const bf16_t*)(S + SL_TK) + (16 * m + fr) * KTS + fq * 4);
            }
            LDS_WAIT();
            bf16x8 sb[2];
#pragma unroll
            for (int i = 0; i < 2; ++i) {
                u32x4 w; w[0] = pk_bf16(st[2 * i][0], st[2 * i][1]); w[1] = pk_bf16(st[2 * i][2], st[2 * i][3]); w[2] = pk_bf16(st[2 * i + 1][0], st[2 * i + 1][1]); w[3] = pk_bf16(st[2 * i + 1][2], st[2 * i + 1][3]);
                sb[i] = __builtin_bit_cast(bf16x8, w);
            }
            f32x4 z = {0.f, 0.f, 0.f, 0.f};
#pragma unroll
            for (int i = 0; i < 2; ++i) z = mfma32(__builtin_shufflevector(xal[i], xah[i], 0, 1, 2, 3, 4, 5, 6, 7), sb[i], z);
            z = mfma16(nakt, vt, z);
            u32x2 zw; zw[0] = pk_bf16(z[0], z[1]); zw[1] = pk_bf16(z[2], z[3]);
            const f32x4 uu = mfma16(tt, __builtin_bit_cast(s16x4v, zw), (f32x4){0.f, 0.f, 0.f, 0.f});
            u32x2 uw; uw[0] = pk_bf16(uu[0], uu[1]); uw[1] = pk_bf16(uu[2], uu[3]);
            const s16x4v ub = __builtin_bit_cast(s16x4v, uw);
            f32x4 y = {0.f, 0.f, 0.f, 0.f};
#pragma unroll
            for (int i = 0; i < 2; ++i) y = mfma32(__builtin_shufflevector(xrl[i], xrh[i], 0, 1, 2, 3, 4, 5, 6, 7), sb[i], y);
            y = mfma16(nrkt, vt, y);
            y = mfma16(nrbt, ub, y);
#pragma unroll
            for (int m = 0; m < 4; ++m) {
                f32x4 acc = mfma16(tk[m], vt, st[m]);
                acc = mfma16(tb[m], ub, acc);
                st[m] = acc * wc[m];
            }

#pragma unroll
            for (int j = 0; j < 4; ++j) {
                const unsigned tok = tokb + scan_pos(c * CH + fq * 4 + j, dir);
                Yo[tok * 1024u + hc + rg * 16 + fr] = (bf16_t)(pk_bf16(y[j], 0.f) & 0xffffu);
            }
            asm volatile("" ::: "memory");
            if (lane == 0) *(volatile LAS int*)(cnts + 8) = c + 1;
        }
        __builtin_amdgcn_s_setprio(0);
    } else {
        const unsigned pid = wid - 1;
        char* PS = prep0 + pid * PREP_BYTES;
        bf16_t* XA = (bf16_t*)(PS + PR_XA); bf16_t* XB = (bf16_t*)(PS + PR_XB); bf16_t* XK = (bf16_t*)(PS + PR_XK); bf16_t* XR = (bf16_t*)(PS + PR_XR);
        bf16_t* TB_ = (bf16_t*)(PS + PR_TB); bf16_t* TK = (bf16_t*)(PS + PR_TK);
        bf16_t* SN = (bf16_t*)(PS + PR_SN);
        bf16_t *M = SN, *NABR = SN + 1 * 16 * SMS;
        bf16_t *M2 = XA, *M2T = XA + 1 * 16 * SMS, *M4 = XA + 2 * 16 * SMS, *M4T = XA + 3 * 16 * SMS, *X1 = XA + 4 * 16 * SMS, *G1 = XA + 5 * 16 * SMS, *NAKR = XA + 6 * 16 * SMS,
                *NRBT = XA + 7 * 16 * SMS, *NRKT = XA + 8 * 16 * SMS, *IM = XA + 9 * 16 * SMS;
        bf16_t *M8T = M2, *X2 = M2T, *TT = M4;
        float* WCP = (float*)SN;
        const bf16_t* wsm = (const bf16_t*)(p.ws + OFF_WS);
        const unsigned wo = W_W2 + dir * 65536u + (hc + fr) * 64u + fq * 8u;
        const unsigned ao = W_A2 + dir * 65536u + (hc + fr) * 64u + fq * 8u;
        const unsigned po = hc + fq * 4u;
        const f32x4 z4 = {0.f, 0.f, 0.f, 0.f};
        bf16x8 lwf[2], laf[2];
        u32x2 krw[4], rrw[4];
        unsigned tok_cur = 0;
        auto issue = [&](int c, bf16x8 (&lw)[2], bf16x8 (&la)[2], u32x2 (&kw)[4], u32x2 (&rw)[4], unsigned& tk) {
            tk = tokb + scan_pos(c * CH + fr, dir);
            const unsigned lo = tk * 128u + dir * 64u + fq * 8u, ro = tk * 1024u + hc + fq * 4u;
#pragma unroll
            for (int kk = 0; kk < 2; ++kk) { lw[kk] = *(const bf16x8*)(LW + lo + kk * 32); la[kk] = *(const bf16x8*)(LA + lo + kk * 32); }
#pragma unroll
            for (int nt = 0; nt < 4; ++nt) { kw[nt] = *(const u32x2*)(Kk + ro + nt * 16); rw[nt] = *(const u32x2*)(R + ro + nt * 16); }
        };
        if ((int)pid < NCHK) issue(pid, lwf, laf, krw, rrw, tok_cur);
#pragma unroll
        for (int kk = 0; kk < 2; ++kk) asm volatile("" : "+v"(lwf[kk]), "+v"(laf[kk]));
#pragma unroll
        for (int nt = 0; nt < 4; ++nt) asm volatile("" : "+v"(krw[nt]), "+v"(rrw[nt]));
        auto ldw = [&](bf16x8 (&w)[2][2], int nt) {
#pragma unroll
            for (int kk = 0; kk < 2; ++kk) { w[0][kk] = *(const bf16x8*)(wsm + wo + nt * 1024 + kk * 32); w[1][kk] = *(const bf16x8*)(wsm + ao + nt * 1024 + kk * 32); }
        };
        for (int c = pid; c < NCHK; c += NPREP) {
            bf16x8 wq[2][2], wn[2][2];
            ldw(wq, 0);
            const unsigned tok = tok_cur;
            float ssq = 0.f;
#pragma unroll
            for (int nt = 0; nt < 4; ++nt) {
                const f32x4 kkv = *(const f32x4*)(prm + 128 + fq * 4 + nt * 16);
                const f32x4 q = up4(krw[nt]) * kkv;
                ssq += q[0] * q[0] + q[1] * q[1] + q[2] * q[2] + q[3] * q[3];
            }
            ssq += __shfl_xor(ssq, 16); ssq += __shfl_xor(ssq, 32);
            const float kn = __builtin_amdgcn_rsqf(fmaxf(ssq, 1e-24f));
            float bsum = 0.f;
#pragma unroll
            for (int nt = 0; nt < 4; ++nt) {
                f32x4 aw = z4, ai = z4;
                if (nt < 3) ldw(wn, nt + 1);
                __builtin_amdgcn_sched_barrier(0);
#pragma unroll
                for (int kk = 0; kk < 2; ++kk) {
                    aw = mfma32(wq[0][kk], lwf[kk], aw);
                    ai = mfma32(wq[1][kk], laf[kk], ai);
                }
                if (nt < 3) {
#pragma unroll
                    for (int kk = 0; kk < 2; ++kk) { wq[0][kk] = wn[0][kk]; wq[1][kk] = wn[1][kk]; }
                }
                const f32x4 w0v = *(const f32x4*)(prm + fq * 4 + nt * 16), a0v = *(const f32x4*)(prm + 64 + fq * 4 + nt * 16);
                const f32x4 kkv = *(const f32x4*)(prm + 128 + fq * 4 + nt * 16);
                const f32x4 kav = *(const f32x4*)(prm + 192 + fq * 4 + nt * 16), rkv = *(const f32x4*)(prm + 256 + fq * 4 + nt * 16);
                LDS_WAIT();
                const f32x4 rr = up4(rrw[nt]), krn4 = up4(krw[nt]);
                const f32x4 x1 = (w0v + aw) * (-LOG2E), x2 = (a0v + ai) * (-LOG2E);
                f32x4 ex1, ex2;
#pragma unroll
                for (int j = 0; j < 4; ++j) { ex1[j] = __builtin_amdgcn_exp2f(x1[j]); ex2[j] = __builtin_amdgcn_exp2f(x2[j]); }
                ex1 = ex1 + 1.0f; ex2 = ex2 + 1.0f;
                f32x4 sg, ic;
#pragma unroll
                for (int j = 0; j < 4; ++j) { sg[j] = __builtin_amdgcn_rcpf(ex1[j]); ic[j] = __builtin_amdgcn_rcpf(ex2[j]); }
                const f32x4 e2 = sg * (0.6065306597126334f * LOG2E);
                const f32x4 kkn = krn4 * kkv * kn;
                const f32x4 kd = krn4 * ((ic - 1.0f) * kav + 1.0f);
                { const f32x4 bq = rr * kd * rkv; bsum += (bq[0] + bq[1]) + (bq[2] + bq[3]); }
                f32x4 wt, wi, wp;
#pragma unroll
                for (int j = 0; j < 4; ++j) {
                    const float ec = row16_prefix(e2[j]);
                    wt[j] = __builtin_amdgcn_exp2f(-ec);
                    wi[j] = __builtin_amdgcn_exp2f(ec);
                    wp[j] = __builtin_amdgcn_exp2f(e2[j] - ec);
                }
                const f32x4 at = -(kkn * wp), rt = rr * wt, bt = kkn * ic * wi, kt = kd * wi;
                {
                    u32x2 wa, wb, wk;
                    wa[0] = pk_bf16(at[0], at[1]); wa[1] = pk_bf16(at[2], at[3]); wb[0] = pk_bf16(bt[0], bt[1]); wb[1] = pk_bf16(bt[2], bt[3]);
                    wk[0] = pk_bf16(kt[0], kt[1]); wk[1] = pk_bf16(kt[2], kt[3]);
                    *(u32x2*)(XA + fr * TKS + nt * 16 + fq * 4) = wa; *(u32x2*)(XB + fr * TKS + nt * 16 + fq * 4) = wb; *(u32x2*)(XK + fr * TKS + nt * 16 + fq * 4) = wk;
                    const unsigned o = (nt * 16 + fq * 4) * KTS + fr;
#pragma unroll
                    for (int j = 0; j < 4; ++j) {
                        TB_[o + j * KTS] = (bf16_t)((j & 1) ? (wb[j >> 1] >> 16) : (wb[j >> 1] & 0xffffu));
                        TK[o + j * KTS] = (bf16_t)((j & 1) ? (wk[j >> 1] >> 16) : (wk[j >> 1] & 0xffffu));
                    }
                }
                if (fr == 15) *(f32x4*)(WCP + nt * 16 + fq * 4) = wt;
                st4(XR + fr * TKS + nt * 16 + fq * 4, rt);
            }
            bsum += __shfl_xor(bsum, 16); bsum += __shfl_xor(bsum, 32);
            if (rg == 0 && fq == 0) { bonus[((0 * 2 + dir) * TTOT + tok) * 16u + hd] = bsum; bonus[((1 * 2 + dir) * TTOT + tok) * 16u + hd] = 0.f; }
            if (c + NPREP < NCHK) issue(c + NPREP, lwf, laf, krw, rrw, tok_cur);
            unsigned vv[2][2];
#pragma unroll
            for (int i = 0; i < 2; ++i) {
                const unsigned q = i * 64 + lane, vrow = q & 15, sp = q >> 4;
                const unsigned tk0 = tokb + scan_pos(c * CH + 2 * sp, dir), tk1 = tokb + scan_pos(c * CH + 2 * sp + 1, dir);
                vv[i][0] = V[tk0 * 1024u + hc + rg * 16 + vrow]; vv[i][1] = V[tk1 * 1024u + hc + rg * 16 + vrow];
            }
            LDS_WAIT();
            float wcr[4];
#pragma unroll
            for (int n = 0; n < 4; ++n) wcr[n] = WCP[16 * n + fr];
            bf16x8 fa[2], fb[2], fk[2], frr[2];
#pragma unroll
            for (int kk = 0; kk < 2; ++kk) {
                fa[kk] = *(const bf16x8*)(XA + fr * TKS + kk * 32 + fq * 8); fb[kk] = *(const bf16x8*)(XB + fr * TKS + kk * 32 + fq * 8);
                fk[kk] = *(const bf16x8*)(XK + fr * TKS + kk * 32 + fq * 8); frr[kk] = *(const bf16x8*)(XR + fr * TKS + kk * 32 + fq * 8);
            }
            LDS_WAIT();
            f32x4 d1 = z4, d2 = z4, d3 = z4, d4 = z4, d5 = z4;
#pragma unroll
            for (int kk = 0; kk < 2; ++kk) {
                d1 = mfma32(fb[kk], fa[kk], d1);
                d2 = mfma32(fa[kk], fb[kk], d2);
                d3 = mfma32(fk[kk], fa[kk], d3);
                d4 = mfma32(fb[kk], frr[kk], d4);
                d5 = mfma32(fk[kk], frr[kk], d5);
            }
            f32x4 im;
#pragma unroll
            for (int j = 0; j < 4; ++j) {
                const unsigned ij = fq * 4 + j;
                d1[j] = ij < fr ? d1[j] : 0.f;
                d2[j] = fr < ij ? d2[j] : 0.f;
                d3[j] = ij < fr ? d3[j] : 0.f;
                d4[j] = ij <= fr ? d4[j] : 0.f;
                d5[j] = ij <= fr ? d5[j] : 0.f;
                im[j] = d1[j] + (ij == fr ? 1.0f : 0.f);
            }
            st4(M + fr * SMS + fq * 4, d1);
            st4(IM + fr * SMS + fq * 4, im);
            st4(NABR + fr * SMS + fq * 4, d2);
            st4(NAKR + fr * SMS + fq * 4, d3);
            st4(NRBT + fr * SMS + fq * 4, d4);
            st4(NRKT + fr * SMS + fq * 4, d5);
            LDS_WAIT();
            const int so = fr * SMS + fq * 4;
            {
                const s16x4v m = ld4(M + so), mt = ld4(NABR + so);
                LDS_WAIT();
                st4(M2T + so, mfma16(m, mt, z4)); st4(M2 + so, mfma16(mt, m, z4));
                LDS_WAIT();
            }
            {
                const s16x4v m2 = ld4(M2 + so), m2t = ld4(M2T + so); const u32x2 imr = *(const u32x2*)(IM + so);
                LDS_WAIT();
                st4(M4T + so, mfma16(m2, m2t, z4)); st4(M4 + so, mfma16(m2t, m2, z4));
                st4(X1 + so, mfma16(m2t, __builtin_bit_cast(s16x4v, imr), up4(imr)));
                LDS_WAIT();
            }
            {
                const s16x4v m4 = ld4(M4 + so), m4t = ld4(M4T + so); const u32x2 x1r = *(const u32x2*)(X1 + so);
                LDS_WAIT();
                st4(M8T + so, mfma16(m4, m4t, z4));
                st4(X2 + so, mfma16(m4t, __builtin_bit_cast(s16x4v, x1r), up4(x1r)));
                LDS_WAIT();
            }
            {
                const s16x4v m8t = ld4(M8T + so); const u32x2 x2r = *(const u32x2*)(X2 + so);
                LDS_WAIT();
                st4(TT + so, mfma16(m8t, __builtin_bit_cast(s16x4v, x2r), up4(x2r)));
                LDS_WAIT();
            }
            const unsigned sl = (unsigned)c % NSLOT;
            char* S = slots + sl * SLOT_BYTES;
            {
                const s16x4v ta = ld4(TT + so), nak = ld4(NAKR + so), nrb = ld4(NRBT + so), nrk = ld4(NRKT + so);
                s16x4v tb[4], tk[4]; u32x2 xr[4];
#pragma unroll
                for (int m = 0; m < 4; ++m) {
                    tb[m] = ld4(TB_ + (16 * m + fr) * KTS + fq * 4); tk[m] = ld4(TK + (16 * m + fr) * KTS + fq * 4);
                    xr[m] = *(const u32x2*)(XR + fr * TKS + 16 * m + fq * 4);
                }
                LDS_WAIT();
                while (*(volatile LAS int*)(cnts + 8) < c - NSLOT + 1) __builtin_amdgcn_s_sleep(1);
                asm volatile("" ::: "memory");
                *(s16x4v*)((bf16_t*)(S + SL_TT) + so) = ta; *(s16x4v*)((bf16_t*)(S + SL_NAK) + so) = nak;
                *(s16x4v*)((bf16_t*)(S + SL_NRB) + so) = nrb; *(s16x4v*)((bf16_t*)(S + SL_NRK) + so) = nrk;
#pragma unroll
                for (int kk = 0; kk < 2; ++kk) *(bf16x8*)((bf16_t*)(S + SL_XA) + fr * TKS + kk * 32 + fq * 8) = fa[kk];
#pragma unroll
                for (int m = 0; m < 4; ++m) {
                    *(u32x2*)((bf16_t*)(S + SL_XR) + fr * TKS + 16 * m + fq * 4) = xr[m];
                    *(s16x4v*)((bf16_t*)(S + SL_TB) + (16 * m + fr) * KTS + fq * 4) = tb[m];
                    *(s16x4v*)((bf16_t*)(S + SL_TK) + (16 * m + fr) * KTS + fq * 4) = tk[m];
                }
                ((float*)(S + SL_WC))[lane] = (fq == 0) ? wcr[0] : (fq == 1) ? wcr[1] : (fq == 2) ? wcr[2] : wcr[3];
#pragma unroll
                for (int i = 0; i < 2; ++i) {
                    const unsigned q = i * 64 + lane, vrow = q & 15, sp = q >> 4;
                    *(unsigned*)((bf16_t*)(S + SL_VT) + vrow * SMS + 2 * sp) = vv[i][0] | (vv[i][1] << 16);
                }
            }
            LDS_WAIT();
            if (lane == 0) *(volatile LAS int*)(cnts + sl) = c + 1;
        }
    }
    __syncthreads();
}

DI void phase_scan(const Params& p, char* smem) {
    for (int u = blockIdx.x; u < NBATCH * 16 * 2 * 4; u += gridDim.x) scan_unit_chunked(p, u, smem);
}

constexpr int NPHASE = 18;
constexpr int cmax_(int a, int b) { return a > b ? a : b; }
constexpr int SMEM_BYTES = cmax_(cmax_(SC2_SMEM, SC_SMEM), cmax_(GEMM_SMEM + 4096, G8_SMEM)) + 64;
static_assert(SMEM_BYTES >= GEMM_SMEM + 4096 + 64 && SMEM_BYTES >= G8_SMEM + 64 && SMEM_BYTES + 16 <= 163840, "LDS");
template <int PH> DI void run_phase(const Params& p, char* smem) {
    if constexpr (PH == 0) phase_prologue(p, smem);
    else if constexpr (PH == 1) phase_norm0(p);
    else if constexpr (PH == 2) phase_qkv(p, smem);
    else if constexpr (PH == 3) phase_attn(p, smem);
    else if constexpr (PH == 4) phase_wout(p, smem);
    else if constexpr (PH == 5) phase_ffn_norm_route(p, 0, smem);
    else if constexpr (PH == 6) phase_moe1(p, 0, smem);
    else if constexpr (PH == 7) phase_moe2(p, 0, smem);
    else if constexpr (PH == 8) phase_combine_l0(p, smem);
    else if constexpr (PH == 9) phase_xx(p);
    else if constexpr (PH == 10) phase_rwkv_proj(p, smem);
    else if constexpr (PH == 11) phase_scan(p, smem);
    else if constexpr (PH == 12) phase_gate(p, smem);
    else if constexpr (PH == 13) phase_wo(p, smem);
    else if constexpr (PH == 14) phase_ffn_norm_route(p, 1, smem);
    else if constexpr (PH == 15) phase_moe1(p, 1, smem);
    else if constexpr (PH == 16) phase_moe2(p, 1, smem);
    else if constexpr (PH == 17) phase_final(p);
}
template <int PH, int END> struct PhaseSeq {
    static DI void run(const Params& p, char* smem, const XcdBarrier& bar) {
        run_phase<PH>(p, smem);
        if constexpr (PH + 1 < END) { xcd_barrier(bar); PhaseSeq<PH + 1, END>::run(p, smem, bar); }
    }
};
template <int BEG, int END>
__global__ void __launch_bounds__(NTH, 2) fwd_kernel(Params p) {
    extern __shared__ __attribute__((aligned(16))) char smem_raw[];
    char* smem = smem_raw + 16;
    if constexpr (END - BEG > 1) {
        if (tidx() == 0) *(uint4*)smem_raw = make_uint4(0u, 0u, 0u, 0u);
        __syncthreads();
        XcdBarrier bar = xcd_barrier_post((unsigned*)(p.ws + OFF_BAR), (volatile LAS unsigned*)smem_raw);
        PhaseSeq<BEG, END>::run(p, smem, bar);
    } else {
        run_phase<BEG>(p, smem);
    }
}

template <int BEG, int END> static void launch_range(const Params& p, int grid, hipStream_t stream) {
    (void)hipFuncSetAttribute((const void*)fwd_kernel<BEG, END>, hipFuncAttributeMaxDynamicSharedMemorySize, SMEM_BYTES + 16);
    hipLaunchKernelGGL((fwd_kernel<BEG, END>), dim3(grid), dim3(NTH), SMEM_BYTES + 16, stream, p);
}
#ifndef RUN_PHASES
#define RUN_PHASES NPHASE
#endif
#ifndef REPEAT_PHASE
#define REPEAT_PHASE -1
#endif
template <int PH> static void launch_each(const Params& p, int grid, hipStream_t stream) {
    launch_range<PH, PH + 1>(p, grid, stream);
    if (PH == REPEAT_PHASE) launch_range<PH, PH + 1>(p, grid, stream);
    if constexpr (PH + 1 < RUN_PHASES) launch_each<PH + 1>(p, grid, stream);
}

extern "C" void kernel_launch(void* const* d_in, const int* in_sizes, int n_in, void* d_out, int out_size, void* d_ws, size_t ws_size, hipStream_t stream) {
    Params p{};
    const float** f = (const float**)&p;
    for (int i = 0; i < 37; ++i) f[i] = (const float*)d_in[i];
    p.out = (float*)d_out;
    p.ws = (char*)d_ws;
    if (ws_size < WS_NEED || n_in < 37) return;
    static int grid = 0;
    if (!grid) {
        int dev = 0, cus = 0;
        (void)hipGetDevice(&dev);
        (void)hipDeviceGetAttribute(&cus, hipDeviceAttributeMultiprocessorCount, dev);
        grid = cus > 0 ? cus : 256;
    }
    (void)hipMemsetAsync(d_ws, 0, 32768, stream);
#if MEGA
    launch_range<0, NPHASE>(p, grid, stream);
#else
    launch_each<0>(p, grid, stream);
#endif
}
```

```cpp
#include <hip/hip_runtime.h>
#include <stdint.h>
#include <stdio.h>

#ifndef MEGA
#define MEGA 1
#endif

typedef unsigned short bf16_t;
typedef short bf16x8 __attribute__((ext_vector_type(8)));
typedef short s16x4 __attribute__((ext_vector_type(4)));
typedef float f32x2 __attribute__((ext_vector_type(2)));
typedef float f32x4 __attribute__((ext_vector_type(4)));
typedef float f32x16 __attribute__((ext_vector_type(16)));
typedef unsigned u32x2 __attribute__((ext_vector_type(2)));
typedef unsigned u32x4 __attribute__((ext_vector_type(4)));
typedef __bf16 bf16x2_t __attribute__((ext_vector_type(2)));
#define DI __device__ __forceinline__
__device__ __forceinline__ unsigned tidx() { unsigned t = threadIdx.x; asm volatile("" : "+v"(t)); return t; }

constexpr int DM = 1024, NBATCH = 2, SEQ = 16384, LCTX = 256, PTOT = SEQ + LCTX, TTOT = NBATCH * PTOT;
constexpr int NTH = 512, NWAVE = 8;
constexpr int QKV_N = 1536;
constexpr int NEXP = 16, CAP = TTOT * 2;
constexpr float RMS_EPS = 1e-6f, GN_EPS = 64e-5f;
constexpr float LOG2E = 1.4426950408889634f;

constexpr size_t MBy = 1u << 20;
constexpr size_t OFF_BAR   = 0;
constexpr size_t OFF_CNT   = 16384;
constexpr size_t OFF_MOD   = 32768;
constexpr size_t OFF_ROPE  = OFF_MOD + 2 * 3 * 6144 * 4;
constexpr size_t OFF_BONUS = 1 * MBy;
constexpr size_t OFF_BONUS2 = 6 * MBy;
constexpr size_t OFF_STOK  = 6 * MBy;
constexpr size_t OFF_SW    = 11 * MBy;
constexpr size_t OFF_XC    = 16 * MBy;
constexpr size_t OFF_WS    = 18 * MBy;
constexpr size_t OFF_MOEW  = 33 * MBy;
constexpr size_t OFF_H     = 129 * MBy;
constexpr size_t OFF_SCR   = 194 * MBy;
constexpr size_t SCR_SIZE  = 290 * MBy;
constexpr size_t WS_NEED   = OFF_SCR + SCR_SIZE;
constexpr size_t W_IN = 0, W_OUT = W_IN + 1536 * 1024, W_R = W_OUT + 1024 * 1024, W_K = W_R + 1024 * 1024, W_V = W_K + 1024 * 1024,
                 W_O = W_V + 1024 * 1024, W_W1 = W_O + 1024 * 1024, W_A1 = W_W1 + 128 * 1024, W_G1 = W_A1 + 128 * 1024,
                 W_W2 = W_G1 + 256 * 1024, W_A2 = W_W2 + 2 * 1024 * 64, W_G2 = W_A2 + 2 * 1024 * 64, W_END = W_G2 + 1024 * 192;
static_assert(W_END * 2 <= 15 * MBy, "small weights region");
constexpr size_t ROWB = (size_t)TTOT * 2048;
constexpr size_t S_Q = 0, S_K = S_Q + ROWB, S_VT = S_K + ROWB / 4, S_O = S_VT + ROWB / 4;
constexpr size_t S_HID = 0, S_Y = 140 * MBy;
constexpr size_t S_R = 0, S_KK = S_R + ROWB, S_V = S_KK + ROWB, S_LW = S_V + ROWB, S_LA = S_LW + ROWB / 8, S_LG = S_LA + ROWB / 8,
                 S_Y1 = 224 * MBy, S_XX = S_Y1, S_OR = S_R;
constexpr size_t S_VT8 = S_O + ROWB;
constexpr size_t S_K8 = S_VT8 + (size_t)NBATCH * 2 * 64 * PTOT, S_Q8 = S_K8 + (size_t)NBATCH * 2 * PTOT * 64;
static_assert(S_Q8 + (size_t)NBATCH * 8 * PTOT * 64 <= SCR_SIZE, "scr");
static_assert(S_LG + (size_t)TTOT * 384 <= S_Y1, "scr2");
static_assert(S_Y1 + ROWB <= SCR_SIZE, "scr3");
static_assert(S_Y + 2 * ROWB <= SCR_SIZE, "scr4");
static_assert((size_t)(CAP / 256 + 16) * 256 * 2048 <= S_Y, "hid");
static_assert(OFF_H + ROWB <= OFF_SCR, "h");

struct Params {
    const float *x, *c, *ctx, *c_ctx, *ada_w, *ada_b, *norm_mix_g, *norm_ffn_g, *attn_w_in, *attn_w_out, *attn_sink, *attn_q_norm_g, *attn_k_norm_g,
        *rwkv_x_mix, *rwkv_w_r, *rwkv_w_k, *rwkv_w_v, *rwkv_w_o, *rwkv_decay_w0, *rwkv_decay_w1, *rwkv_decay_w2, *rwkv_iclr_a0, *rwkv_iclr_a1,
        *rwkv_iclr_a2, *rwkv_gate_g1, *rwkv_gate_g2, *rwkv_k_k, *rwkv_k_a, *rwkv_r_k, *rwkv_ln_g, *rwkv_ln_b, *router_w, *router_bias, *moe_w1,
        *moe_w3, *moe_w2, *final_norm_g;
    float* out;
    char* ws;
};

DI unsigned pk_bf16(float a, float b) { f32x2 v = {a, b}; bf16x2_t r = __builtin_convertvector(v, bf16x2_t); return __builtin_bit_cast(unsigned, r); }
typedef int v8i __attribute__((ext_vector_type(8)));
typedef int v4i __attribute__((ext_vector_type(4)));
constexpr float F8_SA = 8.0f, F8_SW = 64.0f, F8_SH = 16.0f, F8_SV = 8.0f, F8_SQ = 32.0f, F8_SK = 16.0f;
DI unsigned pk_fp8x4(float a, float b, float c, float d) {
    a = fminf(fmaxf(a, -448.f), 448.f); b = fminf(fmaxf(b, -448.f), 448.f); c = fminf(fmaxf(c, -448.f), 448.f); d = fminf(fmaxf(d, -448.f), 448.f);
    int w = __builtin_amdgcn_cvt_pk_fp8_f32(a, b, 0, false);
    w = __builtin_amdgcn_cvt_pk_fp8_f32(c, d, w, true);
    return (unsigned)w;
}
DI float bf_lo(unsigned u) { return __uint_as_float(u << 16); }
DI float bf_hi(unsigned u) { return __uint_as_float(u & 0xffff0000u); }
DI float bf2f(bf16_t u) { return __uint_as_float(((unsigned)u) << 16); }
DI float wave_sum(float v) {
#pragma unroll
    for (int o = 32; o >= 1; o >>= 1) v += __shfl_xor(v, o);
    return v;
}
DI float sigmoidf_(float x) { return __builtin_amdgcn_rcpf(1.0f + __builtin_amdgcn_exp2f(x * -LOG2E)); }
DI float siluf_(float x) { return x * __builtin_amdgcn_rcpf(1.0f + __builtin_amdgcn_exp2f(x * -LOG2E)); }
struct PLite { const float *x, *ctx, *qg, *kg; float* out; char* ws; };
DI PLite plite(const Params& p) { return PLite{p.x, p.ctx, p.attn_q_norm_g, p.attn_k_norm_g, p.out, p.ws}; }
template <class P> DI float* xrow_ptr(const P& p, int tok) {
    const int b = tok >= PTOT ? 1 : 0, pos = tok - b * PTOT;
    return pos < LCTX ? (float*)(p.ws + OFF_XC) + (size_t)(b * LCTX + pos) * DM : p.out + (size_t)(b * SEQ + pos - LCTX) * DM;
}
template <class P> DI const float* xin_ptr(const P& p, int tok) {
    const int b = tok >= PTOT ? 1 : 0, pos = tok - b * PTOT;
    return pos < LCTX ? p.ctx + (size_t)(b * LCTX + pos) * DM : p.x + (size_t)(b * SEQ + pos - LCTX) * DM;
}
template <class P> DI const float* mod_ptr(const P& p, int layer, int tok, int which) {
    const int b = tok >= PTOT ? 1 : 0, pos = tok - b * PTOT;
    const int w = pos < LCTX ? 2 : b;
    return (const float*)(p.ws + OFF_MOD) + (size_t)((layer * 3 + w) * 6 + which) * DM;
}

#define XB_TMO      128
#define XB_XCNT(j)  (256  + 64 * (j))
#define XB_XSUB(j)  (1280 + 64 * (j))
#define XB_XGEN(j)  (2304 + 64 * (j))
#define XB_TOP      3328
#define XB_TOPGEN   3392
#define XCD_BAR_WORDS 3456
#define XB_SPIN_CAP (1u << 18)
#define LAS __attribute__((address_space(3)))
DI unsigned xb_ld(unsigned* p)              { return __hip_atomic_load(p, __ATOMIC_RELAXED, __HIP_MEMORY_SCOPE_AGENT); }
DI unsigned xb_add(unsigned* p, unsigned v) { return __hip_atomic_fetch_add(p, v, __ATOMIC_RELAXED, __HIP_MEMORY_SCOPE_AGENT); }
DI unsigned xb_xcc_id() { return (unsigned)__builtin_amdgcn_s_getreg((3 << 11) | 20) & 0xFu; }
#define XB_SPIN(cond, bar) do { unsigned _sp = 0; while (cond) { __builtin_amdgcn_s_sleep(1); \
    if ((++_sp & 255u) == 0u) { if (xb_ld(&(bar)[XB_TMO])) break; if (_sp > XB_SPIN_CAP) { atomicAdd(&(bar)[XB_TMO], 1u); break; } } } } while (0)
struct XcdBarrier { unsigned* bar; unsigned x; volatile LAS unsigned* st; };
DI XcdBarrier xcd_barrier_post(unsigned* bar, volatile LAS unsigned* st) {
    XcdBarrier b; b.bar = bar; b.x = xb_xcc_id(); b.st = st;
    if (tidx() == 0) (void)xb_add(&bar[XB_XCNT(b.x)], 1u);
    return b;
}
DI void xcd_barrier_complete(unsigned* bar, unsigned x, unsigned& nloc, unsigned& nx) {
    const unsigned G = gridDim.x * gridDim.y * gridDim.z;
    unsigned sum, cnt, mine, sp = 0u;
    for (;;) {
        sum = 0u; cnt = 0u; mine = 0u;
#pragma unroll
        for (unsigned j = 0; j < 16; ++j) { const unsigned c = xb_ld(&bar[XB_XCNT(j)]); sum += c; cnt += (c > 0u) ? 1u : 0u; mine = (j == x) ? c : mine; }
        if (sum == G) break;
        __builtin_amdgcn_s_sleep(1);
        if ((++sp & 255u) == 0u) { if (xb_ld(&bar[XB_TMO])) break; if (sp > XB_SPIN_CAP) { atomicAdd(&bar[XB_TMO], 1u); break; } }
    }
    nloc = mine > 0u ? mine : 1u; nx = cnt > 0u ? cnt : 1u;
}
DI void xcd_barrier(const XcdBarrier& b) {
    asm volatile("s_waitcnt vmcnt(0)" ::: "memory");
    __syncthreads();
    if (tidx() == 0) {
        unsigned* bar = b.bar;
        __builtin_amdgcn_s_waitcnt(0);
        unsigned nloc = b.st[0], nx = b.st[1];
        if (nloc == 0u) { xcd_barrier_complete(bar, b.x, nloc, nx); b.st[0] = nloc; b.st[1] = nx; }
        const unsigned old = xb_add(&bar[XB_XSUB(b.x)], 1u);
        const unsigned gen = old / nloc;
        if (old + 1u == (gen + 1u) * nloc) {
            __builtin_amdgcn_fence(__ATOMIC_RELEASE, "agent");
            asm volatile("s_waitcnt vmcnt(0)" ::: "memory");
            const unsigned og = xb_add(&bar[XB_TOP], 1u);
            const unsigned tg = og / nx;
            if (og + 1u == (tg + 1u) * nx) xb_add(&bar[XB_TOPGEN], 1u);
            else XB_SPIN(xb_ld(&bar[XB_TOPGEN]) == tg, bar);
            __builtin_amdgcn_fence(__ATOMIC_ACQUIRE, "agent");
            xb_add(&bar[XB_XGEN(b.x)], 1u);
            asm volatile("s_waitcnt vmcnt(0)" ::: "memory");
        } else {
            XB_SPIN(xb_ld(&bar[XB_XGEN(b.x)]) == gen, bar);
            __builtin_amdgcn_fence(__ATOMIC_ACQUIRE, "agent");
            asm volatile("s_waitcnt vmcnt(0)" ::: "memory");
        }
    }
    __syncthreads();
}

struct CvtDesc { const float* src; bf16_t* dst; int ld, kvalid, dld; bool colvalid; bool f8; const float* ks; };
DI CvtDesc cvt_tile(const float* src, int ld, int kvalid, bool colvalid, bf16_t* dst, int dld, bool f8 = false, const float* ks = nullptr) { return CvtDesc{src, dst, ld, kvalid, dld, colvalid, f8, ks}; }
constexpr int CV_NB = 8;
template <class F>
DI void cvt_run(int nunits, F desc_of, float* tiles) {
    const int t = tidx();
    for (int i0 = 0;; i0 += CV_NB) {
        if ((int)blockIdx.x + (int)gridDim.x * i0 >= nunits) break;
        f32x4 v[CV_NB];
#pragma unroll
        for (int b = 0; b < CV_NB; ++b) {
            const int u = (int)blockIdx.x + (int)gridDim.x * (i0 + b);
            v[b] = (f32x4){0.f, 0.f, 0.f, 0.f};
            if (u < nunits) {
                const CvtDesc d = desc_of(u);
                const int k = t >> 3, c4 = (t & 7) * 4;
                if (d.colvalid && k < d.kvalid) { v[b] = *(const f32x4*)(d.src + (size_t)k * d.ld + c4); if (d.ks) v[b] = v[b] * d.ks[k]; }
            }
        }
#pragma unroll
        for (int b = 0; b < CV_NB; ++b) {
            float* tile = tiles + b * 64 * 33;
            const int k = t >> 3, c4 = (t & 7) * 4;
            tile[k * 33 + c4 + 0] = v[b][0]; tile[k * 33 + c4 + 1] = v[b][1]; tile[k * 33 + c4 + 2] = v[b][2]; tile[k * 33 + c4 + 3] = v[b][3];
        }
        __syncthreads();
#pragma unroll
        for (int b = 0; b < CV_NB; ++b) {
            const int u = (int)blockIdx.x + (int)gridDim.x * (i0 + b);
            if (u < nunits) {
                const CvtDesc d = desc_of(u);
                const float* tile = tiles + b * 64 * 33;
                const int n = t >> 4, kc = (t & 15) * 4;
                if (d.f8) {
                    *(unsigned*)((char*)d.dst + (size_t)n * d.dld + kc) = pk_fp8x4(tile[(kc + 0) * 33 + n] * F8_SW, tile[(kc + 1) * 33 + n] * F8_SW, tile[(kc + 2) * 33 + n] * F8_SW, tile[(kc + 3) * 33 + n] * F8_SW);
                } else {
                    u32x2 w;
                    w[0] = pk_bf16(tile[(kc + 0) * 33 + n], tile[(kc + 1) * 33 + n]);
                    w[1] = pk_bf16(tile[(kc + 2) * 33 + n], tile[(kc + 3) * 33 + n]);
                    *(u32x2*)(d.dst + (size_t)n * d.dld + kc) = w;
                }
            }
        }
        __syncthreads();
    }
}
constexpr int CV_SMALL_UNITS = 768 + 512 * 5 + 64 + 64 + 128 + 64 + 64 + 96;
DI CvtDesc cvt_small_unit(const Params& p, int u, int part = 0) {
    bf16_t* wsm = (bf16_t*)(p.ws + OFF_WS);
    if (u < 768) { const int run = u >> 4, kt = u & 15; return cvt_tile(p.attn_w_in + (size_t)kt * 64 * 1536 + run * 32, 1536, 64, true, wsm + W_IN + (size_t)run * 32 * 1024 + kt * 64, 1024); }
    u -= 768;
    if (u < 512 * 5) {
        const int j = u >> 9, v = u & 511, run = v >> 4, kt = v & 15;
        const float* src = j == 0 ? p.attn_w_out : j == 1 ? p.rwkv_w_r : j == 2 ? p.rwkv_w_k : j == 3 ? p.rwkv_w_v : p.rwkv_w_o;
        const size_t dofs = j == 0 ? W_OUT : j == 1 ? W_R : j == 2 ? W_K : j == 3 ? W_V : W_O;
        if (j >= 1 && j <= 3) {
            const float* ks = part ? p.rwkv_x_mix + (j == 1 ? 0 : j == 2 ? 2 : 3) * DM + kt * 64 : nullptr;
            return cvt_tile(src + (size_t)kt * 64 * 1024 + run * 32, 1024, 64, true, (bf16_t*)((char*)(wsm + dofs) + (size_t)run * 32 * 2048 + part * 1024 + kt * 64), 2048, true, ks);
        }
        return cvt_tile(src + (size_t)kt * 64 * 1024 + run * 32, 1024, 64, true, wsm + dofs + (size_t)run * 32 * 1024 + kt * 64, 1024);
    }
    u -= 512 * 5;
    if (u < 128) {
        const int j = u >> 6, v = u & 63, run = v >> 4, kt = v & 15, d = run >> 1, co = (run & 1) * 32;
        const float* src = (j == 0 ? p.rwkv_decay_w1 : p.rwkv_iclr_a1) + (size_t)d * 1024 * 64;
        const float* ks = part ? p.rwkv_x_mix + (j == 0 ? 1 : 4) * DM + kt * 64 : nullptr;
        return cvt_tile(src + (size_t)kt * 64 * 64 + co, 64, 64, true, (bf16_t*)((char*)(wsm + (j == 0 ? W_W1 : W_A1)) + (size_t)run * 32 * 2048 + part * 1024 + kt * 64), 2048, true, ks);
    }
    u -= 128;
    if (u < 128) {
        const int run = u >> 4, kt = u & 15;
        const float* ks = part ? p.rwkv_x_mix + 5 * DM + kt * 64 : nullptr;
        return cvt_tile(p.rwkv_gate_g1 + (size_t)kt * 64 * 160 + run * 32, 160, 64, run < 5, (bf16_t*)((char*)(wsm + W_G1) + (size_t)run * 32 * 2048 + part * 1024 + kt * 64), 2048, true, ks);
    }
    u -= 128;
    if (u < 128) {
        const int j = u >> 6, v = u & 63, d = v >> 5, run = v & 31;
        const float* src = (j == 0 ? p.rwkv_decay_w2 : p.rwkv_iclr_a2) + (size_t)d * 64 * 1024;
        return cvt_tile(src + run * 32, 1024, 64, true, wsm + (j == 0 ? W_W2 : W_A2) + (size_t)d * 1024 * 64 + (size_t)run * 32 * 64, 64);
    }
    u -= 128;
    {
        const int run = u / 3, kt = u % 3;
        const int kvalid = 160 - kt * 64 > 64 ? 64 : (160 - kt * 64 < 0 ? 0 : 160 - kt * 64);
        return cvt_tile(p.rwkv_gate_g2 + (size_t)kt * 64 * 1024 + run * 32, 1024, kvalid, true, wsm + W_G2 + (size_t)run * 32 * 192 + kt * 64, 192);
    }
}
constexpr int CV_MOE_UNITS = 16 * (1024 + 512);
DI CvtDesc cvt_moe_unit(const Params& p, int layer, int u) {
    bf16_t* w13 = (bf16_t*)(p.ws + OFF_MOEW);
    bf16_t* w2t = w13 + (size_t)16 * 2048 * 1024;
    const int e = u / 1536, v = u % 1536;
    const size_t eo = (size_t)(layer * 16 + e) * 1024 * 1024;
    if (v < 1024) {
        const int run = v >> 4, kt = v & 15, g = run >> 1;
        const float* src = ((run & 1) ? p.moe_w3 : p.moe_w1) + eo;
        return cvt_tile(src + (size_t)kt * 64 * 1024 + g * 32, 1024, 64, true, (bf16_t*)((char*)w13 + (size_t)e * 2048 * 1024 + (size_t)run * 32 * 1024 + kt * 64), 1024, true);
    } else {
        const int w = v - 1024, run = w >> 4, kt = w & 15;
        return cvt_tile(p.moe_w2 + eo + (size_t)kt * 64 * 1024 + run * 32, 1024, 64, true, (bf16_t*)((char*)w2t + (size_t)e * 1024 * 1024 + (size_t)run * 32 * 1024 + kt * 64), 1024, true);
    }
}
DI void adaln_unit(const Params& p, int u, float* sm) {
    const int l = u / 96, n0 = (u % 96) * 64, t = tidx();
    float* sv = sm;
    float* red = sm + 3 * 1024;
    for (int i = t; i < 3 * 1024; i += NTH) { const int w = i >> 10, k = i & 1023; const float c = w < 2 ? p.c[w * 1024 + k] : p.c_ctx[k]; sv[i] = siluf_(c); }
    __syncthreads();
    const int kg = t >> 4, cl = t & 15;
    f32x4 a0 = {0, 0, 0, 0}, a1 = a0, a2 = a0;
    const float* W = p.ada_w + (size_t)l * 1024 * 6144 + n0 + cl * 4;
#pragma unroll 8
    for (int i = 0; i < 32; ++i) {
        const int k = kg + 32 * i;
        const f32x4 w = *(const f32x4*)(W + (size_t)k * 6144);
        a0 += w * sv[k]; a1 += w * sv[1024 + k]; a2 += w * sv[2048 + k];
    }
#pragma unroll
    for (int j = 0; j < 4; ++j) { red[kg * 192 + 0 * 64 + cl * 4 + j] = a0[j]; red[kg * 192 + 1 * 64 + cl * 4 + j] = a1[j]; red[kg * 192 + 2 * 64 + cl * 4 + j] = a2[j]; }
    __syncthreads();
    if (t < 192) {
        float s = 0.f;
        for (int g = 0; g < 32; ++g) s += red[g * 192 + t];
        const int w = t >> 6, n = n0 + (t & 63);
        ((float*)(p.ws + OFF_MOD))[(size_t)(l * 3 + w) * 6144 + n] = s + p.ada_b[l * 6144 + n];
    }
    __syncthreads();
}
DI void rope_unit(const Params& p, int u) {
    const int id = u * NTH + tidx();
    if (id < 320 * 16) {
        const int pi = id >> 4, f = id & 15;
        const float inv = exp2f(-(float)f * (13.287712379549449f / 16.0f));
        const float val = pi < 256 ? (float)pi : (float)(pi - 256);
        const float ang = val * inv;
        const double a = (double)ang;
        const double k = __builtin_rint(a * 0.15915494309189535);
        const float r = (float)(a - k * 6.283185307179586);
        f32x2 cs = {__cosf(r), __sinf(r)};
        ((f32x2*)(p.ws + OFF_ROPE))[id] = cs;
    }
}
DI void phase_prologue(const Params& p, char* smem) {
    float* sm = (float*)smem;
    constexpr int NX = 1536 + 128 + 128;
    const int nconv = CV_SMALL_UNITS + NX + CV_MOE_UNITS;
    const int total = nconv + 192 + 10;
    for (int u = nconv + blockIdx.x; u < total; u += gridDim.x) {
        if (u < nconv + 192) adaln_unit(p, u - nconv, sm);
        else rope_unit(p, u - nconv - 192);
    }
    __syncthreads();
    cvt_run(nconv, [&](int u) {
        if (u < CV_SMALL_UNITS) return cvt_small_unit(p, u);
        if (u < CV_SMALL_UNITS + NX) { const int e = u - CV_SMALL_UNITS; return cvt_small_unit(p, e < 1536 ? 768 + 512 + e : 768 + 2560 + (e - 1536), 1); }
        return cvt_moe_unit(p, 0, u - CV_SMALL_UNITS - NX);
    }, sm);
}

DI void row_load(const float* src, f32x4 (&v)[4], int lane) {
#pragma unroll
    for (int i = 0; i < 4; ++i) v[i] = ((const f32x4*)src)[lane + 64 * i];
}
DI float row_rstd(const f32x4 (&v)[4]) {
    float ss = 0.f;
#pragma unroll
    for (int i = 0; i < 4; ++i) ss += v[i][0] * v[i][0] + v[i][1] * v[i][1] + v[i][2] * v[i][2] + v[i][3] * v[i][3];
    ss = wave_sum(ss);
    return rsqrtf(ss * (1.0f / DM) + RMS_EPS);
}
DI void row_norm_mod(const f32x4 (&v)[4], float rstd, const float* g, const float* shift, const float* scale, f32x4 (&h)[4], int lane) {
#pragma unroll
    for (int i = 0; i < 4; ++i) {
        const int c = (lane + 64 * i) * 4;
        const f32x4 g4 = *(const f32x4*)(g + c), sh = *(const f32x4*)(shift + c), sc = *(const f32x4*)(scale + c);
        h[i] = (v[i] * rstd * g4) * (1.0f + sc) + sh;
    }
}
DI void row_store_bf16(bf16_t* dst, const f32x4 (&h)[4], int lane) {
#pragma unroll
    for (int i = 0; i < 4; ++i) { u32x2 w; w[0] = pk_bf16(h[i][0], h[i][1]); w[1] = pk_bf16(h[i][2], h[i][3]); *(u32x2*)(dst + (lane + 64 * i) * 4) = w; }
}
DI void row_store_fp8(char* dst, const f32x4 (&h)[4], int lane) {
#pragma unroll
    for (int i = 0; i < 4; ++i) *(unsigned*)(dst + (lane + 64 * i) * 4) = pk_fp8x4(h[i][0] * F8_SA, h[i][1] * F8_SA, h[i][2] * F8_SA, h[i][3] * F8_SA);
}
DI void row_load_bf16(const bf16_t* src, f32x4 (&v)[4], int lane) {
#pragma unroll
    for (int i = 0; i < 4; ++i) { const u32x2 w = *(const u32x2*)(src + (lane + 64 * i) * 4); v[i][0] = bf_lo(w[0]); v[i][1] = bf_hi(w[0]); v[i][2] = bf_lo(w[1]); v[i][3] = bf_hi(w[1]); }
}

DI void phase_norm0(const Params& p) {
    const int lane = tidx() & 63, gw = blockIdx.x * NWAVE + (tidx() >> 6), nw = gridDim.x * NWAVE;
    bf16_t* H = (bf16_t*)(p.ws + OFF_H);
    for (int tok = gw; tok < TTOT; tok += nw) {
        f32x4 v[4], h[4];
        row_load(xin_ptr(p, tok), v, lane);
        const float rstd = row_rstd(v);
        row_norm_mod(v, rstd, p.norm_mix_g, mod_ptr(p, 0, tok, 0), mod_ptr(p, 0, tok, 1), h, lane);
        row_store_bf16(H + (size_t)tok * DM, h, lane);
    }
}

DI void route_row(const Params& p, const float (&lg)[16], int& e1, int& e2, float& g1, float& g2) {
    float mx = lg[0];
#pragma unroll
    for (int e = 1; e < 16; ++e) mx = fmaxf(mx, lg[e]);
    float pr[16], sum = 0.f;
#pragma unroll
    for (int e = 0; e < 16; ++e) { pr[e] = __expf(lg[e] - mx); sum += pr[e]; }
    const float inv = 1.0f / sum;
    float sel[16];
#pragma unroll
    for (int e = 0; e < 16; ++e) { pr[e] *= inv; sel[e] = pr[e] + p.router_bias[e]; }
    float best = -1e30f; int gi = 0;
#pragma unroll
    for (int g = 0; g < 4; ++g) {
        float m1 = -1e30f, m2 = -1e30f;
#pragma unroll
        for (int j = 0; j < 4; ++j) { const float s = sel[g * 4 + j]; if (s > m1) { m2 = m1; m1 = s; } else if (s > m2) m2 = s; }
        const float gs = m1 + m2;
        if (gs > best) { best = gs; gi = g; }
    }
    float s4[4], p4[4];
#pragma unroll
    for (int j = 0; j < 4; ++j) {
        s4[j] = gi == 0 ? sel[j] : gi == 1 ? sel[4 + j] : gi == 2 ? sel[8 + j] : sel[12 + j];
        p4[j] = gi == 0 ? pr[j] : gi == 1 ? pr[4 + j] : gi == 2 ? pr[8 + j] : pr[12 + j];
    }
    int i1 = 0; float b1 = s4[0];
#pragma unroll
    for (int j = 1; j < 4; ++j) if (s4[j] > b1) { b1 = s4[j]; i1 = j; }
    int i2 = i1 == 0 ? 1 : 0; float b2 = -3e38f;
#pragma unroll
    for (int j = 0; j < 4; ++j) if (j != i1 && s4[j] > b2) { b2 = s4[j]; i2 = j; }
    const float w1 = i1 == 0 ? p4[0] : i1 == 1 ? p4[1] : i1 == 2 ? p4[2] : p4[3];
    const float w2 = i2 == 0 ? p4[0] : i2 == 1 ? p4[1] : i2 == 2 ? p4[2] : p4[3];
    const float ws = 1.0f / (w1 + w2);
    e1 = gi * 4 + i1; e2 = gi * 4 + i2; g1 = w1 * ws; g2 = w2 * ws;
}
DI void phase_ffn_norm_route(const Params& p, int layer, char* smem) {
    const int lane = tidx() & 63, gw = blockIdx.x * NWAVE + (tidx() >> 6), nw = gridDim.x * NWAVE;
    float* rw = (float*)smem;
    for (int i = tidx(); i < 1024 * 16; i += NTH) rw[(i & 15) * 1024 + (i >> 4)] = p.router_w[i];
    __syncthreads();
    bf16_t* H = (bf16_t*)(p.ws + OFF_H);
    int* lcnt = (int*)(smem + 65536);
    if (tidx() < 32) lcnt[tidx()] = 0;
    int my_tok = -1, my_e1 = 0, my_e2 = 0, it = 0; float my_g1 = 0.f, my_g2 = 0.f;
    for (int tok = gw; tok < TTOT; tok += nw) {
        const int pos = tok >= PTOT ? tok - PTOT : tok;
        if (layer == 1 && pos < LCTX) continue;
        f32x4 v[4], h[4];
        row_load(xrow_ptr(p, tok), v, lane);
        const float rstd = row_rstd(v);
        row_norm_mod(v, rstd, p.norm_ffn_g + layer * DM, mod_ptr(p, layer, tok, 3), mod_ptr(p, layer, tok, 4), h, lane);
        row_store_fp8((char*)H + (size_t)tok * DM, h, lane);
        float lg[16];
#pragma unroll
        for (int e = 0; e < 16; ++e) lg[e] = 0.f;
#pragma unroll
        for (int i = 0; i < 4; ++i)
#pragma unroll
            for (int e = 0; e < 16; ++e) {
                const f32x4 w = *(const f32x4*)(rw + e * 1024 + (lane + 64 * i) * 4);
                lg[e] += h[i][0] * w[0] + h[i][1] * w[1] + h[i][2] * w[2] + h[i][3] * w[3];
                if ((e & 3) == 3) asm volatile("" ::: "memory");
            }
#pragma unroll
        for (int e = 0; e < 16; ++e) lg[e] = wave_sum(lg[e]);
        int e1, e2; float g1, g2;
        route_row(p, lg, e1, e2, g1, g2);
        if (lane == it) { my_tok = tok; my_e1 = e1; my_e2 = e2; my_g1 = g1; my_g2 = g2; }
        ++it;
    }
    __syncthreads();
    int r1 = 0, r2 = 0;
    if (my_tok >= 0) { r1 = atomicAdd(&lcnt[my_e1], 1); r2 = atomicAdd(&lcnt[my_e2], 1); }
    __syncthreads();
    if (tidx() < 16) { const int n = lcnt[tidx()]; lcnt[16 + tidx()] = n ? atomicAdd((int*)(p.ws + OFF_CNT) + layer * 16 + tidx(), n) : 0; }
    __syncthreads();
    if (my_tok >= 0) {
        int* stok = (int*)(p.ws + OFF_STOK);
        float* sw = (float*)(p.ws + OFF_SW);
        const size_t s1 = (size_t)my_e1 * CAP + lcnt[16 + my_e1] + r1, s2 = (size_t)my_e2 * CAP + lcnt[16 + my_e2] + r2;
        stok[s1] = my_tok * 2 + 0; sw[s1] = my_g1;
        stok[s2] = my_tok * 2 + 1; sw[s2] = my_g2;
    }
    __syncthreads();
}

DI void combine_row(const Params& p, int layer, int tok, f32x4 (&v)[4], int lane) {
    const bf16_t* Y = (const bf16_t*)(p.ws + OFF_SCR + S_Y) + (size_t)tok * 2 * DM;
    const float* g5 = mod_ptr(p, layer, tok, 5);
    f32x4 y0[4], y1[4];
    row_load(xrow_ptr(p, tok), v, lane);
    row_load_bf16(Y, y0, lane); row_load_bf16(Y + DM, y1, lane);
#pragma unroll
    for (int i = 0; i < 4; ++i) { const f32x4 g = *(const f32x4*)(g5 + (lane + 64 * i) * 4); v[i] += g * (y0[i] + y1[i]); }
}
DI void phase_combine_l0(const Params& p, char* smem) {
    const int lane = tidx() & 63, gw = blockIdx.x * NWAVE + (tidx() >> 6), nw = gridDim.x * NWAVE;
    bf16_t* H = (bf16_t*)(p.ws + OFF_H);
    for (int tok = gw; tok < TTOT; tok += nw) {
        f32x4 v[4], h[4];
        combine_row(p, 0, tok, v, lane);
        float* X = xrow_ptr(p, tok);
#pragma unroll
        for (int i = 0; i < 4; ++i) ((f32x4*)X)[lane + 64 * i] = v[i];
        const float rstd = row_rstd(v);
        row_norm_mod(v, rstd, p.norm_mix_g + DM, mod_ptr(p, 1, tok, 0), mod_ptr(p, 1, tok, 1), h, lane);
        row_store_bf16(H + (size_t)tok * DM, h, lane);
    }
    __syncthreads();
    cvt_run(CV_MOE_UNITS, [&](int u) { return cvt_moe_unit(p, 1, u); }, (float*)smem);
}
DI void phase_xx(const Params& p) {
    const int lane = tidx() & 63, gw = blockIdx.x * NWAVE + (tidx() >> 6), nw = gridDim.x * NWAVE;
    const bf16_t* H = (const bf16_t*)(p.ws + OFF_H);
    bf16_t* XX = (bf16_t*)(p.ws + OFF_SCR + S_XX);
    for (int tok = gw; tok < TTOT; tok += nw) {
        const int pos = tok >= PTOT ? tok - PTOT : tok;
        const bool first = pos == 0 || pos == LCTX, last = pos == LCTX - 1 || pos == PTOT - 1;
        f32x4 hc[4], hp[4], hn[4], xx[4];
        row_load_bf16(H + (size_t)tok * DM, hc, lane);
        row_load_bf16(H + (size_t)(first ? tok : tok - 1) * DM, hp, lane);
        row_load_bf16(H + (size_t)(last ? tok : tok + 1) * DM, hn, lane);
#pragma unroll
        for (int i = 0; i < 4; ++i) {
            const f32x4 a = first ? (f32x4){0, 0, 0, 0} : hp[i], b = last ? (f32x4){0, 0, 0, 0} : hn[i];
            xx[i] = 0.5f * (a + b) - hc[i];
        }
        row_store_fp8((char*)XX + (size_t)tok * 2048, hc, lane);
        row_store_fp8((char*)XX + (size_t)tok * 2048 + 1024, xx, lane);
    }
}
DI void phase_final(const Params& p) {
    const int lane = tidx() & 63, gw = blockIdx.x * NWAVE + (tidx() >> 6), nw = gridDim.x * NWAVE;
    for (int r = gw; r < NBATCH * SEQ; r += nw) {
        const int b = r / SEQ, tok = b * PTOT + LCTX + (r - b * SEQ);
        f32x4 v[4];
        combine_row(p, 1, tok, v, lane);
        const float rstd = row_rstd(v);
        float* O = p.out + (size_t)r * DM;
#pragma unroll
        for (int i = 0; i < 4; ++i) { const f32x4 g = *(const f32x4*)(p.final_norm_g + (lane + 64 * i) * 4); ((f32x4*)O)[lane + 64 * i] = v[i] * rstd * g; }
    }
}

constexpr int LDSROW = 72;
constexpr int GEMM_SMEM = 2 * (256 + 256) * LDSROW * 2;
template <int NH, class AL, class EPI>
DI void gemm_tile(AL& al, const bf16_t* __restrict__ Bt, int ldb, int nk, EPI& epi, char* smem) {
    const int t = tidx(), lane = t & 63, wid = t >> 6, wr = wid >> 1, wc = wid & 1, fr = lane & 15, fq = lane >> 4;
    constexpr int BR = 128 * NH;
    bf16_t* sA = (bf16_t*)smem;
    bf16_t* sB = sA + 2 * 256 * LDSROW;
    f32x4 acc[NH][4][4];
#pragma unroll
    for (int h = 0; h < NH; ++h)
#pragma unroll
        for (int m = 0; m < 4; ++m)
#pragma unroll
            for (int n = 0; n < 4; ++n) acc[h][m][n] = (f32x4){0.f, 0.f, 0.f, 0.f};
    const int lr = t >> 3, lc = (t & 7) * 8;
    typename AL::Raw ra[4]; u32x4 rb[2 * NH];
#pragma unroll
    for (int i = 0; i < 4; ++i) al.issue(ra[i], lr + 64 * i, lc, i);
#pragma unroll
    for (int i = 0; i < 2 * NH; ++i) rb[i] = *(const u32x4*)(Bt + (size_t)(lr + 64 * i) * ldb + lc);
#pragma unroll
    for (int i = 0; i < 4; ++i) *(u32x4*)(sA + (lr + 64 * i) * LDSROW + lc) = al.finish(ra[i], lc);
#pragma unroll
    for (int i = 0; i < 2 * NH; ++i) *(u32x4*)(sB + (lr + 64 * i) * LDSROW + lc) = rb[i];
    __syncthreads();
    for (int kt = 0; kt < nk; ++kt) {
        const int cur = kt & 1;
        const bool more = kt + 1 < nk;
        if (more) {
#pragma unroll
            for (int i = 0; i < 4; ++i) al.issue(ra[i], lr + 64 * i, (kt + 1) * 64 + lc, i);
#pragma unroll
            for (int i = 0; i < 2 * NH; ++i) rb[i] = *(const u32x4*)(Bt + (size_t)(lr + 64 * i) * ldb + (kt + 1) * 64 + lc);
        }
        __builtin_amdgcn_sched_barrier(0);
        const bf16_t* cA = sA + cur * 256 * LDSROW + (wr * 64 + fr) * LDSROW + fq * 8;
        const bf16_t* cB = sB + cur * BR * LDSROW + (wc * 64 + fr) * LDSROW + fq * 8;
#pragma unroll
        for (int kk = 0; kk < 2; ++kk) {
            bf16x8 af[4];
#pragma unroll
            for (int m = 0; m < 4; ++m) af[m] = *(const bf16x8*)(cA + m * 16 * LDSROW + kk * 32);
#pragma unroll
            for (int h = 0; h < NH; ++h) {
                bf16x8 bfr[4];
#pragma unroll
                for (int n = 0; n < 4; ++n) bfr[n] = *(const bf16x8*)(cB + (h * 128 + n * 16) * LDSROW + kk * 32);
#pragma unroll
                for (int m = 0; m < 4; ++m)
#pragma unroll
                    for (int n = 0; n < 4; ++n) acc[h][m][n] = __builtin_amdgcn_mfma_f32_16x16x32_bf16(bfr[n], af[m], acc[h][m][n], 0, 0, 0);
            }
            if (kk == AL::STORE_AT && more) {
                bf16_t* nA = sA + (cur ^ 1) * 256 * LDSROW;
                bf16_t* nB = sB + (cur ^ 1) * BR * LDSROW;
#pragma unroll
                for (int i = 0; i < 4; ++i) *(u32x4*)(nA + (lr + 64 * i) * LDSROW + lc) = al.finish(ra[i], (kt + 1) * 64 + lc);
#pragma unroll
                for (int i = 0; i < 2 * NH; ++i) *(u32x4*)(nB + (lr + 64 * i) * LDSROW + lc) = rb[i];
            }
        }
        __syncthreads();
    }
#pragma unroll
    for (int h = 0; h < NH; ++h) epi(acc[h], wr * 64, h * 128 + wc * 64, fr, fq);
    if constexpr (EPI::LDS_FLUSH) {
        __syncthreads();
        epi.flush(smem);
        __syncthreads();
    }
}
constexpr int G8_HB = 128 * 64 * 2;
constexpr int G8_SMEM = 8 * G8_HB;
DI void g8_rc(int& R0, int& C0) {
    const int tz = tidx(), st = tz >> 6, sb = (tz & 63) * 16, swz = sb ^ (((sb >> 9) & 1) << 5);
    R0 = (st >> 1) * 16 + (swz >> 6); C0 = (st & 1) * 32 + ((swz & 63) >> 1);
}
DI int g8_bcol(int h, int rho) { return (rho >> 5) * 64 + h * 32 + (rho & 31); }
struct G8Rows {
    const bf16_t* base; unsigned o0, d1, d2;
    DI const bf16_t* ptr(int h, int i, int kt) const { return (base + (size_t)(h * d2 + i * d1 + kt * 64)) + o0; }
};
struct G8Gather {
    const bf16_t* base; unsigned o[4];
    DI const bf16_t* ptr(int h, int i, int kt) const { return (base + kt * 64) + o[h * 2 + i]; }
};
DI G8Rows g8_arows(const bf16_t* A, int lda) { int R0, C0; g8_rc(R0, C0); return G8Rows{A, (unsigned)(R0 * lda + C0), (unsigned)(64 * lda), (unsigned)(128 * lda)}; }
DI G8Rows g8_brows(const bf16_t* Bt, int ldb) { int R0, C0; g8_rc(R0, C0); return G8Rows{Bt, (unsigned)(g8_bcol(0, R0) * ldb + C0), (unsigned)(128 * ldb), (unsigned)(32 * ldb)}; }
template <bool F8, class AS, class BS, class EPI, class NF>
DI void gemm8_tile(const AS& as, const BS& bs, int nt  , EPI& epi, char* smem, bool prefetched, NF nextfn) {
    int tz = tidx();
    int wid = tz >> 6, lane = tz & 63, wr = wid >> 2, wc = wid & 3, fr = lane & 15, fq = lane >> 4;
    int loff = ((fr * 64 + fq * 16) ^ ((fr >> 3) << 5));
#define G8_SA(b, h) (smem + ((b) * 2 + (h)) * G8_HB)
#define G8_SB(b, h) (smem + (4 + (b) * 2 + (h)) * G8_HB)
#define G8_STAGE(P, src, h, kt) do { \
        __builtin_amdgcn_global_load_lds((const unsigned*)(src).ptr(h, 0, kt), (LAS unsigned*)((P) + tz * 16), 16, 0, 0); \
        __builtin_amdgcn_global_load_lds((const unsigned*)(src).ptr(h, 1, kt), (LAS unsigned*)((P) + tz * 16 + 8192), 16, 0, 0); } while (0)
#define G8_STA(b, h, kt) G8_STAGE(G8_SA(b, h), as, h, kt)
#define G8_STB(b, h, kt) G8_STAGE(G8_SB(b, h), bs, h, kt)
#define G8_HALF(x, k) __builtin_bit_cast(bf16x8, __builtin_shufflevector(x, x, 4 * (k), 4 * (k) + 1, 4 * (k) + 2, 4 * (k) + 3))
#define G8_CAT(x0, x1) __builtin_shufflevector(__builtin_bit_cast(v4i, x0), __builtin_bit_cast(v4i, x1), 0, 1, 2, 3, 4, 5, 6, 7)
#define G8_LDA(dst, b, h) _Pragma("unroll") for (int m = 0; m < 4; ++m) \
        dst[m] = G8_CAT(*(const bf16x8*)(G8_SA(b, h) + (wr * 8 + m * 2 + 0) * 1024 + loff), *(const bf16x8*)(G8_SA(b, h) + (wr * 8 + m * 2 + 1) * 1024 + loff))
#define G8_LDB(dst, b, h) _Pragma("unroll") for (int n = 0; n < 2; ++n) \
        dst[n] = G8_CAT(*(const bf16x8*)(G8_SB(b, h) + (wc * 4 + n * 2 + 0) * 1024 + loff), *(const bf16x8*)(G8_SB(b, h) + (wc * 4 + n * 2 + 1) * 1024 + loff))
#define G8_MMA(ai, bj, Bx) do { __builtin_amdgcn_s_setprio(1); \
        _Pragma("unroll") for (int m = 0; m < 4; ++m) _Pragma("unroll") for (int n = 0; n < 2; ++n) { \
            if constexpr (F8) asm volatile("s_nop 1\n\tv_mfma_scale_f32_16x16x128_f8f6f4 %0, %1, %2, %0, %3, %3 op_sel_hi:[0,0,0]" : "+v"(acc[ai][bj][m][n]) : "v"(Bx[n]), "v"(At[m]), "v"(0x7f7f7f7f)); \
            else { acc[ai][bj][m][n] = __builtin_amdgcn_mfma_f32_16x16x32_bf16(G8_HALF(Bx[n], 0), G8_HALF(At[m], 0), acc[ai][bj][m][n], 0, 0, 0); \
                   acc[ai][bj][m][n] = __builtin_amdgcn_mfma_f32_16x16x32_bf16(G8_HALF(Bx[n], 1), G8_HALF(At[m], 1), acc[ai][bj][m][n], 0, 0, 0); } } \
        __builtin_amdgcn_s_setprio(0); } while (0)
#define G8_WV(n) asm volatile("s_waitcnt vmcnt(" #n ")" ::: "memory")
#define G8_WL(n) asm volatile("s_waitcnt lgkmcnt(" #n ")" ::: "memory")
#define G8_BAR __builtin_amdgcn_s_barrier()
#define G8_SCHED __builtin_amdgcn_sched_barrier(0)
    f32x4 acc[2][2][4][2];
#pragma unroll
    for (int a = 0; a < 2; ++a)
#pragma unroll
        for (int b = 0; b < 2; ++b)
#pragma unroll
            for (int m = 0; m < 4; ++m)
#pragma unroll
                for (int n = 0; n < 2; ++n) acc[a][b][m][n] = (f32x4){0.f, 0.f, 0.f, 0.f};
    v8i At[4], B0[2], B1[2];
    if (!prefetched) { G8_STB(0, 0, 0); G8_STA(0, 0, 0); G8_STB(0, 1, 0); G8_STA(0, 1, 0); }
    if (wr == 1) G8_BAR;
    if (prefetched) G8_WV(0); else G8_WV(4);
    G8_BAR;
    G8_STB(1, 0, 1); G8_STA(1, 0, 1); G8_STB(1, 1, 1);
    G8_WV(6); G8_BAR;
#pragma unroll 1
    for (int t = 0; t < nt - 2; t += 2) {
        G8_LDB(B0, 0, 0); G8_SCHED; G8_LDA(At, 0, 0); G8_STA(1, 1, t + 1);
        G8_WL(8); G8_BAR; G8_WL(0); G8_MMA(0, 0, B0); G8_BAR; G8_SCHED;
        G8_LDB(B1, 0, 1); G8_STB(0, 0, t + 2);
        G8_BAR; G8_WL(0); G8_MMA(0, 1, B1); G8_BAR;
        G8_LDA(At, 0, 1); G8_STA(0, 0, t + 2);
        G8_BAR; G8_WL(0); G8_MMA(1, 0, B0); G8_BAR; G8_SCHED;
        G8_STB(0, 1, t + 2);
        G8_WV(6); G8_BAR; G8_MMA(1, 1, B1); G8_BAR;
        G8_LDB(B0, 1, 0); G8_SCHED; G8_LDA(At, 1, 0); G8_STA(0, 1, t + 2);
        G8_WL(8); G8_BAR; G8_WL(0); G8_MMA(0, 0, B0); G8_BAR; G8_SCHED;
        G8_LDB(B1, 1, 1); G8_STB(1, 0, t + 3);
        G8_BAR; G8_WL(0); G8_MMA(0, 1, B1); G8_BAR;
        G8_LDA(At, 1, 1); G8_STA(1, 0, t + 3);
        G8_BAR; G8_WL(0); G8_MMA(1, 0, B0); G8_BAR; G8_SCHED;
        G8_STB(1, 1, t + 3);
        G8_WV(6); G8_BAR; G8_MMA(1, 1, B1); G8_BAR;
    }
    tz = tidx(); wid = tz >> 6; lane = tz & 63; wr = wid >> 2; wc = wid & 3; fr = lane & 15; fq = lane >> 4;
    loff = ((fr * 64 + fq * 16) ^ ((fr >> 3) << 5));
    {
        G8_LDB(B0, 0, 0); G8_WV(0); G8_LDA(At, 0, 0); G8_STA(1, 1, nt - 1);
        G8_BAR; G8_WL(0); G8_MMA(0, 0, B0); G8_BAR;
        G8_LDB(B1, 0, 1); G8_BAR; G8_WL(0); G8_MMA(0, 1, B1); G8_BAR;
        G8_LDA(At, 0, 1); G8_WV(4); G8_BAR; G8_WL(0); G8_MMA(1, 0, B0); G8_MMA(1, 1, B1); G8_BAR;
    }
    {
        G8_LDB(B0, 1, 0); G8_LDA(At, 1, 0); G8_WV(2); G8_BAR; G8_WL(0); G8_MMA(0, 0, B0); G8_BAR;
        G8_LDB(B1, 1, 1); G8_WV(0); G8_BAR; G8_WL(0); G8_MMA(0, 1, B1); G8_BAR;
        G8_LDA(At, 1, 1); G8_BAR; G8_WL(0); G8_MMA(1, 0, B0); G8_MMA(1, 1, B1); G8_BAR;
    }
    if constexpr (F8) asm volatile("s_nop 15\n\ts_nop 15" ::: "memory");
    if (wr == 0) G8_BAR;
    {
        AS a2; BS b2;
        if (!EPI::STAGED && nextfn(a2, b2)) {
            G8_STAGE(G8_SB(0, 0), b2, 0, 0); G8_STAGE(G8_SA(0, 0), a2, 0, 0); G8_STAGE(G8_SB(0, 1), b2, 1, 0); G8_STAGE(G8_SA(0, 1), a2, 1, 0);
        }
    }
#pragma unroll
    for (int ai = 0; ai < 2; ++ai) {
        f32x4 a4[4][4];
#pragma unroll
        for (int m = 0; m < 4; ++m)
#pragma unroll
            for (int n = 0; n < 4; ++n) a4[m][n] = acc[ai][n >> 1][m][n & 1];
        if constexpr (EPI::STAGED) epi.stage(a4, ai * 128 + wr * 64, wc * 64, fr, fq, smem);
        else epi(a4, ai * 128 + wr * 64, wc * 64, fr, fq);
    }
    if constexpr (EPI::STAGED) {
        __syncthreads();
        epi.flush(smem);
        __syncthreads();
    }
}
template <class TP>
DI void gemm8_run(TP& tp, int nt, char* smem) {
    typename TP::AS as; typename TP::BS bs; typename TP::EPI epi;
    bool pre = false;
    for (int k = 0; tp.get(k, as, bs, epi); ++k) {
        gemm8_tile<TP::F8>(as, bs, nt, epi, smem, pre, [&](typename TP::AS& a2, typename TP::BS& b2) { typename TP::EPI e2; return tp.get(k + 1, a2, b2, e2); });
        pre = !TP::EPI::STAGED;
    }
}
DI bool xcd_tile(int k, int nM, int NT, int& mt, int& nt) {
    const bool swz = (gridDim.x & 7) == 0;
    const int j = (swz ? (int)(blockIdx.x >> 3) : (int)blockIdx.x) + (swz ? (int)(gridDim.x >> 3) : (int)gridDim.x) * k, mi = j / NT;
    nt = j - mi * NT; mt = swz ? (int)(blockIdx.x & 7) + 8 * mi : mi;
    return mt < nM;
}
struct ALPlain {
    typedef u32x4 Raw; static constexpr int STORE_AT = 0;
    const bf16_t* A; int lda;
    DI void issue(Raw& r, int row, int k, int) const { r = *(const u32x4*)(A + (size_t)row * lda + k); }
    DI u32x4 finish(const Raw& r, int) const { return r; }
};
struct ALMix {
    struct Raw { u32x4 h, x; };
    static constexpr int STORE_AT = 1;
    const bf16_t* H; const bf16_t* XX; const LAS float* xm;
    DI void issue(Raw& r, int row, int k, int) const { r.h = *(const u32x4*)(H + (size_t)row * DM + k); r.x = *(const u32x4*)(XX + (size_t)row * DM + k); }
    DI void set_mix(const float* g) {
        const int t = tidx();
        LAS float* w = (LAS float*)xm;
        w[t] = g[t]; w[t + 512] = g[t + 512];
        __syncthreads();
    }
    DI u32x4 finish(const Raw& r, int k) const {
        const f32x4 m0 = *(const LAS f32x4*)(xm + k), m1 = *(const LAS f32x4*)(xm + k + 4);
        const u32x4 h = r.h, x = r.x;
        u32x4 o;
        o[0] = pk_bf16(bf_lo(h[0]) + bf_lo(x[0]) * m0[0], bf_hi(h[0]) + bf_hi(x[0]) * m0[1]);
        o[1] = pk_bf16(bf_lo(h[1]) + bf_lo(x[1]) * m0[2], bf_hi(h[1]) + bf_hi(x[1]) * m0[3]);
        o[2] = pk_bf16(bf_lo(h[2]) + bf_lo(x[2]) * m1[0], bf_hi(h[2]) + bf_hi(x[2]) * m1[1]);
        o[3] = pk_bf16(bf_lo(h[3]) + bf_lo(x[3]) * m1[2], bf_hi(h[3]) + bf_hi(x[3]) * m1[3]);
        return o;
    }
};

struct EpiQKV {
    static constexpr bool STAGED = false;
    PLite p; int m0, n0;
    DI void operator()(const f32x4 (&acc)[4][4], int rb, int cb, int fr, int fq) const {
        const int hs = (n0 + cb) >> 6;
        const bool isq = hs < 8 || (hs >= 12 && hs < 20), isv = (hs >= 10 && hs < 12) || hs >= 22, normed = hs >= 12 && hs < 22;
        const float* gam = hs < 20 ? p.qg : p.kg;
        const f32x2* rope = (const f32x2*)(p.ws + OFF_ROPE);
        bf16_t* Q = (bf16_t*)(p.ws + OFF_SCR + S_Q);
        bf16_t* K = (bf16_t*)(p.ws + OFF_SCR + S_K);
        bf16_t* VT = (bf16_t*)(p.ws + OFF_SCR + S_VT);
#pragma unroll
        for (int m = 0; m < 4; ++m) {
            const int tok = m0 + rb + m * 16 + fr, b = tok >= PTOT ? 1 : 0, pos = tok - b * PTOT;
            f32x4 v[4];
#pragma unroll
            for (int n = 0; n < 4; ++n) v[n] = acc[m][n];
            if (normed) {
                float ss = 0.f;
#pragma unroll
                for (int n = 0; n < 4; ++n) ss += v[n][0] * v[n][0] + v[n][1] * v[n][1] + v[n][2] * v[n][2] + v[n][3] * v[n][3];
                ss += __shfl_xor(ss, 16); ss += __shfl_xor(ss, 32);
                const float rstd = rsqrtf(ss * (1.0f / 64.0f) + RMS_EPS);
#pragma unroll
                for (int n = 0; n < 4; ++n) { const f32x4 g = *(const f32x4*)(gam + n * 16 + fq * 4); v[n] = v[n] * rstd * g; }
            }
            if (!isv && pos >= LCTX) {
                const int t = pos - LCTX, prow = t >> 6, pcol = t & 63;
#pragma unroll
                for (int a = 0; a < 2; ++a) {
                    const f32x2* tb = rope + (a == 0 ? prow : 256 + pcol) * 16 + fq * 4;
#pragma unroll
                    for (int j = 0; j < 4; ++j) {
                        const f32x2 cs = tb[j];
                        const float x0 = v[2 * a][j], x1 = v[2 * a + 1][j];
                        v[2 * a][j] = x0 * cs[0] - x1 * cs[1];
                        v[2 * a + 1][j] = x1 * cs[0] + x0 * cs[1];
                    }
                }
            }
            if (isq) {
                const int hq = hs < 8 ? hs : hs - 4;
                if (hs < 8 || pos < LCTX) {
                    bf16_t* dst = Q + ((size_t)(b * 16 + hq) * PTOT + pos) * 64 + fq * 4;
#pragma unroll
                    for (int n = 0; n < 4; ++n) { const f32x4 w = v[n] * (0.125f * LOG2E); u32x2 o; o[0] = pk_bf16(w[0], w[1]); o[1] = pk_bf16(w[2], w[3]); *(u32x2*)(dst + n * 16) = o; }
                } else {
                    char* d8 = p.ws + OFF_SCR + S_Q8 + ((size_t)(b * 8 + hq - 8) * PTOT + pos) * 64 + fq * 4;
#pragma unroll
                    for (int n = 0; n < 4; ++n) { const f32x4 w = v[n] * (0.125f * LOG2E * F8_SQ); *(unsigned*)(d8 + n * 16) = pk_fp8x4(w[0], w[1], w[2], w[3]); }
                }
            } else if (!isv) {
                const int kh = hs < 12 ? hs - 8 : hs - 18;
                if (hs < 12 || pos < LCTX) {
                    bf16_t* dst = K + ((size_t)(b * 4 + kh) * PTOT + pos) * 64 + fq * 4;
#pragma unroll
                    for (int n = 0; n < 4; ++n) { u32x2 o; o[0] = pk_bf16(v[n][0], v[n][1]); o[1] = pk_bf16(v[n][2], v[n][3]); *(u32x2*)(dst + n * 16) = o; }
                }
                if (hs >= 12) {
                    char* d8 = p.ws + OFF_SCR + S_K8 + ((size_t)(b * 2 + kh - 2) * PTOT + pos) * 64 + fq * 4;
#pragma unroll
                    for (int n = 0; n < 4; ++n) { const f32x4 w = v[n] * F8_SK; *(unsigned*)(d8 + n * 16) = pk_fp8x4(w[0], w[1], w[2], w[3]); }
                }
            } else {
                const int vh = hs < 12 ? hs - 10 : hs - 20;
                if (hs < 12 || pos < LCTX) {
                    bf16_t* dst = VT + (size_t)(b * 4 + vh) * 64 * PTOT + pos;
#pragma unroll
                    for (int n = 0; n < 4; ++n)
#pragma unroll
                        for (int j = 0; j < 4; ++j) dst[(size_t)(n * 16 + fq * 4 + j) * PTOT] = (bf16_t)(pk_bf16(v[n][j], 0.f) & 0xffffu);
                }
                if (hs >= 12) {
                    unsigned char* d8 = (unsigned char*)(p.ws + OFF_SCR + S_VT8) + (size_t)(b * 2 + vh - 2) * 64 * PTOT + pos;
#pragma unroll
                    for (int n = 0; n < 4; ++n)
#pragma unroll
                        for (int j = 0; j < 4; ++j) d8[(size_t)(n * 16 + fq * 4 + j) * PTOT] = (unsigned char)(pk_fp8x4(v[n][j] * F8_SV, 0.f, 0.f, 0.f) & 0xffu);
                }
            }
        }
    }
};
struct TPQkv {
    static constexpr bool F8 = false;
    typedef G8Rows AS; typedef G8Rows BS; typedef EpiQKV EPI;
    PLite p; const bf16_t* H; const bf16_t* W;
    DI bool get(int k, AS& as, BS& bs, EPI& epi) const {
        int mt, nt; if (!xcd_tile(k, TTOT / 256, QKV_N / 256, mt, nt)) return false;
        as = g8_arows(H + (size_t)mt * 256 * DM, DM); bs = g8_brows(W + (size_t)nt * 256 * DM, DM); epi = EpiQKV{p, mt * 256, nt * 256};
        return true;
    }
};
DI void phase_qkv(const Params& p, char* smem) {
    TPQkv tp{plite(p), (const bf16_t*)(p.ws + OFF_H), (const bf16_t*)(p.ws + OFF_WS) + W_IN};
    gemm8_run(tp, DM / 64, smem);
}

struct EpiResid {
    static constexpr bool STAGED = false;
    PLite p; int m0, n0, layer; bool from_input;
    DI void operator()(const f32x4 (&acc)[4][4], int rb, int cb, int fr, int fq) const {
        const int tok0 = m0 + rb, co = n0 + cb + fq * 4;
        const float* xin = (from_input ? xin_ptr(p, tok0) : xrow_ptr(p, tok0)) + (size_t)fr * DM + co;
        float* xo = xrow_ptr(p, tok0) + (size_t)fr * DM + co;
        const float* gate = mod_ptr(p, layer, tok0, 2) + co;
        f32x4 g[4], xi[2][4];
#pragma unroll
        for (int n = 0; n < 4; ++n) g[n] = *(const f32x4*)(gate + n * 16);
#pragma unroll
        for (int n = 0; n < 4; ++n) xi[0][n] = *(const f32x4*)(xin + n * 16);
#pragma unroll
        for (int m = 0; m < 4; ++m) {
            if (m < 3) {
#pragma unroll
                for (int n = 0; n < 4; ++n) xi[(m + 1) & 1][n] = *(const f32x4*)(xin + (size_t)(m + 1) * 16 * DM + n * 16);
            }
#pragma unroll
            for (int n = 0; n < 4; ++n) *(f32x4*)(xo + (size_t)m * 16 * DM + n * 16) = xi[m & 1][n] + g[n] * acc[m][n];
        }
    }
};
struct TPResid {
    static constexpr bool F8 = false;
    typedef G8Rows AS; typedef G8Rows BS; typedef EpiResid EPI;
    PLite p; const bf16_t* O; const bf16_t* W; int layer;
    DI bool get(int k, AS& as, BS& bs, EPI& epi) const {
        constexpr int MTL = SEQ / 256;
        int mi, nt; if (!xcd_tile(k, layer == 0 ? TTOT / 256 : NBATCH * MTL, 4, mi, nt)) return false;
        const int mt = layer == 0 ? mi : (mi / MTL) * (PTOT / 256) + 1 + (mi % MTL);
        as = g8_arows(O + (size_t)mt * 256 * DM, DM); bs = g8_brows(W + (size_t)nt * 256 * DM, DM); epi = EpiResid{p, mt * 256, nt * 256, layer, layer == 0};
        return true;
    }
};
DI void phase_wout(const Params& p, char* smem) {
    TPResid tp{plite(p), (const bf16_t*)(p.ws + OFF_SCR + S_O), (const bf16_t*)(p.ws + OFF_WS) + W_OUT, 0};
    gemm8_run(tp, DM / 64, smem);
}
DI void phase_wo(const Params& p, char* smem) {
    TPResid tp{plite(p), (const bf16_t*)(p.ws + OFF_SCR + S_OR), (const bf16_t*)(p.ws + OFF_WS) + W_O, 1};
    gemm8_run(tp, DM / 64, smem);
}

struct MoeSched { int nt[16], base[17]; };
DI void moe_sched(const Params& p, int layer, MoeSched& s, int (&cnt)[16]) {
    const int* c = (const int*)(p.ws + OFF_CNT) + layer * 16;
    int acc = 0;
#pragma unroll
    for (int e = 0; e < 16; ++e) { cnt[e] = c[e]; s.nt[e] = (cnt[e] + 255) >> 8; s.base[e] = acc; acc += s.nt[e]; }
    s.base[16] = acc;
}
struct EpiMoe1 {
    static constexpr bool STAGED = true;
    static constexpr int SROWB = 144;
    bf16_t* hid;   int n0;
    DI void stage(const f32x4 (&acc)[4][4], int rb, int cb, int fr, int fq, char* smem) const {
        char* st = smem;
        const int c0 = (cb >> 6) * 32 + fq * 4;
#pragma unroll
        for (int m = 0; m < 4; ++m) {
            char* dst = st + (rb + m * 16 + fr) * SROWB + c0;
#pragma unroll
            for (int n = 0; n < 2; ++n) {
                const f32x4 a = acc[m][n] * (1.0f / (F8_SA * F8_SW)), b = acc[m][n + 2] * (F8_SH / (F8_SA * F8_SW));
                *(unsigned*)(dst + n * 16) = pk_fp8x4(siluf_(a[0]) * b[0], siluf_(a[1]) * b[1], siluf_(a[2]) * b[2], siluf_(a[3]) * b[3]);
            }
        }
    }
    DI void flush(char* smem) const {
        const int t = tidx();
        const char* st = smem;
        char* dst = (char*)hid + (n0 >> 1) + (t & 7) * 16;
#pragma unroll
        for (int ps = 0; ps < 4; ++ps) {
            const int row = ps * 64 + (t >> 3);
            *(u32x4*)(dst + (size_t)row * 1024) = *(const u32x4*)(st + row * SROWB + (t & 7) * 16);
        }
    }
};
struct TPMoe1 {
    static constexpr bool F8 = true;
    typedef G8Gather AS; typedef G8Rows BS; typedef EpiMoe1 EPI;
    MoeSched s; int cnt[16];
    const bf16_t* H; const bf16_t* W13; const int* stok; bf16_t* hid;
    DI bool get(int k, AS& as, BS& bs, EPI& epi) const {
        int mg, nt; if (!xcd_tile(k, s.base[16], 8, mg, nt)) return false;
        int e = 0;
#pragma unroll
        for (int i = 1; i < 16; ++i) if (mg >= s.base[i]) e = i;
        int ce = 0, be = 0;
#pragma unroll
        for (int i = 0; i < 16; ++i) if (i == e) { ce = cnt[i]; be = s.base[i]; }
        const int ml = mg - be;
        int R0, C0; g8_rc(R0, C0);
        as.base = H;
#pragma unroll
        for (int q = 0; q < 4; ++q) {
            const int r = ml * 256 + R0 + 64 * (q & 1) + 128 * (q >> 1);
            const int tk = r < ce ? (stok[(size_t)e * CAP + r] >> 1) : 0;
            as.o[q] = (unsigned)tk * 512u + C0;
        }
        bs = g8_brows(W13 + (size_t)e * 2048 * 512 + (size_t)nt * 256 * 512, 512);
        epi = EpiMoe1{(bf16_t*)((char*)hid + (size_t)mg * 256 * 1024), nt * 256};
        return true;
    }
};
DI void phase_moe1(const Params& p, int layer, char* smem) {
    TPMoe1 tp;
    moe_sched(p, layer, tp.s, tp.cnt);
    tp.H = (const bf16_t*)(p.ws + OFF_H); tp.W13 = (const bf16_t*)(p.ws + OFF_MOEW); tp.stok = (const int*)(p.ws + OFF_STOK); tp.hid = (bf16_t*)(p.ws + OFF_SCR + S_HID);
    gemm8_run(tp, 8, smem);
}
struct EpiMoe2 {
    static constexpr bool STAGED = false;
    bf16_t* Y; const int* stok; const float* sw; int nvalid, n0;
    DI void operator()(const f32x4 (&acc)[4][4], int rb, int cb, int fr, int fq) const {
        int tkm[4]; float wm[4];
#pragma unroll
        for (int m = 0; m < 4; ++m) { tkm[m] = stok[rb + m * 16 + fr]; wm[m] = sw[rb + m * 16 + fr]; }
#pragma unroll
        for (int m = 0; m < 4; ++m) {
            const int r = rb + m * 16 + fr;
            if (r < nvalid) {
                const int tk = tkm[m]; const float w = wm[m];
                bf16_t* dst = Y + (size_t)tk * 1024 + n0 + cb + fq * 4;
#pragma unroll
                for (int n = 0; n < 4; ++n) { const f32x4 a = acc[m][n] * (w * (1.0f / (F8_SH * F8_SW))); u32x2 o; o[0] = pk_bf16(a[0], a[1]); o[1] = pk_bf16(a[2], a[3]); *(u32x2*)(dst + n * 16) = o; }
            }
        }
    }
};
struct TPMoe2 {
    static constexpr bool F8 = true;
    typedef G8Rows AS; typedef G8Rows BS; typedef EpiMoe2 EPI;
    MoeSched s; int cnt[16];
    const bf16_t* hid; const bf16_t* W2; const int* stok; const float* sw; bf16_t* Y;
    DI bool get(int k, AS& as, BS& bs, EPI& epi) const {
        int mg, nt; if (!xcd_tile(k, s.base[16], 4, mg, nt)) return false;
        int e = 0;
#pragma unroll
        for (int i = 1; i < 16; ++i) if (mg >= s.base[i]) e = i;
        int ce = 0, be = 0;
#pragma unroll
        for (int i = 0; i < 16; ++i) if (i == e) { ce = cnt[i]; be = s.base[i]; }
        const int ml = mg - be;
        as = g8_arows(hid + (size_t)mg * 256 * 512, 512); bs = g8_brows(W2 + (size_t)e * 1024 * 512 + (size_t)nt * 256 * 512, 512);
        epi = EpiMoe2{Y, stok + (size_t)e * CAP + ml * 256, sw + (size_t)e * CAP + ml * 256, ce - ml * 256, nt * 256};
        return true;
    }
};
DI void phase_moe2(const Params& p, int layer, char* smem) {
    TPMoe2 tp;
    moe_sched(p, layer, tp.s, tp.cnt);
    tp.hid = (const bf16_t*)(p.ws + OFF_SCR + S_HID); tp.W2 = (const bf16_t*)(p.ws + OFF_MOEW) + (size_t)16 * 2048 * 1024;
    tp.stok = (const int*)(p.ws + OFF_STOK); tp.sw = (const float*)(p.ws + OFF_SW); tp.Y = (bf16_t*)(p.ws + OFF_SCR + S_Y);
    gemm8_run(tp, 8, smem);
}

struct EpiRwkv {
    static constexpr bool STAGED = true;
    static constexpr int SROW = 264;
    bf16_t* dst; bf16_t* dst2; int ld, m0, n0, act, nstore, pair;
    DI void stage(const f32x4 (&acc)[4][4], int rb, int cb, int fr, int fq, char* smem) const {
        bf16_t* st = (bf16_t*)smem;
#pragma unroll
        for (int m = 0; m < 4; ++m) {
            bf16_t* d = st + (rb + m * 16 + fr) * SROW + cb + fq * 4;
#pragma unroll
            for (int n = 0; n < 4; ++n) {
                const int c = n0 + cb + n * 16 + fq * 4;
                f32x4 a = acc[m][n] * (1.0f / (F8_SA * F8_SW));
                const int ac = pair ? (cb < 128 ? 1 : 0) : act;
                if (ac == 1) {
#pragma unroll
                    for (int j = 0; j < 4; ++j) { const float e = __builtin_amdgcn_exp2f(a[j] * (2.0f * LOG2E)); a[j] = 1.0f - 2.0f * __builtin_amdgcn_rcpf(e + 1.0f); }
                }
                if (ac == 2) {
#pragma unroll
                    for (int j = 0; j < 4; ++j) a[j] = sigmoidf_(a[j]);
                }
                if (c >= nstore) a = (f32x4){0.f, 0.f, 0.f, 0.f};
                u32x2 o; o[0] = pk_bf16(a[0], a[1]); o[1] = pk_bf16(a[2], a[3]);
                *(u32x2*)(d + n * 16) = o;
            }
        }
    }
    DI void flush(char* smem) const {
        const int t = tidx(), ch = (t & 31) * 8, rr = t >> 5;
        const bf16_t* st = (const bf16_t*)smem;
        bf16_t* d = dst; int c = n0 + ch, l = ld;
        if (pair) { l = 128; if (ch >= 128) { d = dst2; c = ch - 128; } else c = ch; }
        if (c < l) {
#pragma unroll
            for (int ps = 0; ps < 16; ++ps) {
                const int row = ps * 16 + rr;
                *(u32x4*)(d + (size_t)(m0 + row) * l + c) = *(const u32x4*)(st + row * SROW + ch);
            }
        }
    }
};
struct TPRwkv {
    static constexpr bool F8 = true;
    typedef G8Rows AS; typedef G8Rows BS; typedef EpiRwkv EPI;
    const bf16_t* A8; const bf16_t* wsm; char* scr;
    DI bool get(int k, AS& as, BS& bs, EPI& epi) const {
        constexpr int MT = TTOT / 256, NU = 14;
        const int u = (int)blockIdx.x + (int)gridDim.x * k;
        if (u >= MT * NU) return false;
        const int mt = u / NU, q = u - mt * NU;
        as = g8_arows(A8 + (size_t)mt * 256 * 1024, 1024);
        if (q < 12) {
            const int job = q >> 2, nt = q & 3;
            const size_t wofs = job == 0 ? W_R : job == 1 ? W_K : W_V, dofs = job == 0 ? S_R : job == 1 ? S_KK : S_V;
            bs = g8_brows(wsm + wofs + (size_t)nt * 256 * 1024, 1024);
            epi = EpiRwkv{(bf16_t*)(scr + dofs), nullptr, 1024, mt * 256, nt * 256, 0, 4096, 0};
        } else if (q == 12) {
            bs = g8_brows(wsm + W_G1, 1024);
            epi = EpiRwkv{(bf16_t*)(scr + S_LG), nullptr, 192, mt * 256, 0, 2, 160, 0};
        } else {
            bs = g8_brows(wsm + W_W1, 1024);
            epi = EpiRwkv{(bf16_t*)(scr + S_LW), (bf16_t*)(scr + S_LA), 128, mt * 256, 0, 0, 4096, 1};
        }
        return true;
    }
};
DI void phase_rwkv_proj(const Params& p, char* smem) {
    TPRwkv tp{(const bf16_t*)(p.ws + OFF_SCR + S_XX), (const bf16_t*)(p.ws + OFF_WS), p.ws + OFF_SCR};
    gemm8_run(tp, 16, smem);
}

struct EpiGate {
    static constexpr bool LDS_FLUSH = true;
    static constexpr int SROW = 132;
    const Params* p; int m0, n0; char* lds;
    DI void operator()(const f32x4 (&acc)[4][4], int rb, int cb, int fr, int fq) const {
        float* st = (float*)lds;
#pragma unroll
        for (int m = 0; m < 4; ++m)
#pragma unroll
            for (int n = 0; n < 4; ++n) *(f32x4*)(st + (rb + m * 16 + fr) * SROW + cb + n * 16 + fq * 4) = acc[m][n];
    }
    struct Rows { u32x4 a, b, v; float bon[4]; };
    DI void load(Rows& r, int tok, int c, int hd) const {
        const size_t ro = (size_t)tok * DM + c;
        r.a = *(const u32x4*)((const bf16_t*)(p->ws + OFF_H) + ro);
        r.b = *(const u32x4*)((const bf16_t*)(p->ws + OFF_SCR + S_Y1) + ro);
        r.v = *(const u32x4*)((const bf16_t*)(p->ws + OFF_SCR + S_V) + ro);
        const float* bonus = (const float*)(p->ws + OFF_BONUS2);
#pragma unroll
        for (int q = 0; q < 4; ++q) r.bon[q] = bonus[(size_t)(q * TTOT + tok) * 16 + hd];
    }
    DI void flush(char* smem) const {
        const int t = tidx(), ch = (t & 15) * 8, rr = t >> 4, c = n0 + ch, hd = c >> 6;
        const float* st = (const float*)smem;
        bf16_t* O = (bf16_t*)(p->ws + OFF_SCR + S_OR);
        const f32x4 g0 = *(const f32x4*)(p->rwkv_ln_g + c), g1 = *(const f32x4*)(p->rwkv_ln_g + c + 4), b0 = *(const f32x4*)(p->rwkv_ln_b + c), b1 = *(const f32x4*)(p->rwkv_ln_b + c + 4);
        Rows rw[2];
        load(rw[0], m0 + rr, c, hd);
#pragma unroll
        for (int ps = 0; ps < 8; ++ps) {
            const int row = ps * 32 + rr, tok = m0 + row;
            if (ps < 7) load(rw[(ps + 1) & 1], tok + 32, c, hd);
            const Rows& r = rw[ps & 1];
            f32x4 y0, y1;
            y0[0] = bf_lo(r.a[0]) + bf_lo(r.b[0]); y0[1] = bf_hi(r.a[0]) + bf_hi(r.b[0]); y0[2] = bf_lo(r.a[1]) + bf_lo(r.b[1]); y0[3] = bf_hi(r.a[1]) + bf_hi(r.b[1]);
            y1[0] = bf_lo(r.a[2]) + bf_lo(r.b[2]); y1[1] = bf_hi(r.a[2]) + bf_hi(r.b[2]); y1[2] = bf_lo(r.a[3]) + bf_lo(r.b[3]); y1[3] = bf_hi(r.a[3]) + bf_hi(r.b[3]);
            float s = (y0[0] + y0[1]) + (y0[2] + y0[3]) + (y1[0] + y1[1]) + (y1[2] + y1[3]);
            s += __shfl_xor(s, 1); s += __shfl_xor(s, 2); s += __shfl_xor(s, 4);
            const float mu = s * (1.0f / 64.0f);
            const f32x4 d0 = y0 - mu, d1 = y1 - mu;
            float q = (d0[0] * d0[0] + d0[1] * d0[1]) + (d0[2] * d0[2] + d0[3] * d0[3]) + (d1[0] * d1[0] + d1[1] * d1[1]) + (d1[2] * d1[2] + d1[3] * d1[3]);
            q += __shfl_xor(q, 1); q += __shfl_xor(q, 2); q += __shfl_xor(q, 4);
            const float rs = rsqrtf(q * (1.0f / 64.0f) + GN_EPS);
            const float bon = (r.bon[0] + r.bon[1]) + (r.bon[2] + r.bon[3]);
            const f32x4 v0 = {bf_lo(r.v[0]), bf_hi(r.v[0]), bf_lo(r.v[1]), bf_hi(r.v[1])}, v1 = {bf_lo(r.v[2]), bf_hi(r.v[2]), bf_lo(r.v[3]), bf_hi(r.v[3])};
            const f32x4 ga = *(const f32x4*)(st + row * SROW + ch), gb = *(const f32x4*)(st + row * SROW + ch + 4);
            const f32x4 o0 = (d0 * rs * g0 + b0 + bon * v0) * ga, o1 = (d1 * rs * g1 + b1 + bon * v1) * gb;
            u32x4 w; w[0] = pk_bf16(o0[0], o0[1]); w[1] = pk_bf16(o0[2], o0[3]); w[2] = pk_bf16(o1[0], o1[1]); w[3] = pk_bf16(o1[2], o1[3]);
            *(u32x4*)(O + (size_t)tok * DM + c) = w;
        }
    }
};
DI void phase_gate(const Params& p, char* smem) {
    const bf16_t* LG = (const bf16_t*)(p.ws + OFF_SCR + S_LG);
    const bf16_t* W = (const bf16_t*)(p.ws + OFF_WS) + W_G2;
    constexpr int NT = 8, MTL = SEQ / 256;
    for (int k = 0;; ++k) {
        int mi, nt; if (!xcd_tile(k, NBATCH * MTL, NT, mi, nt)) break;
        const int mt = (mi / MTL) * (PTOT / 256) + 1 + (mi % MTL);
        ALPlain al{LG + (size_t)mt * 256 * 192, 192};
        EpiGate epi{&p, mt * 256, nt * 128, smem};
        gemm_tile<1>(al, W + (size_t)nt * 128 * 192, 192, 3, epi, smem);
    }
}

constexpr int KROW = 72, VROW = 68;
constexpr int ATT_SMEM = 2 * 64 * KROW * 2 + 2 * 64 * VROW * 2;
DI int crow_(int i, int h) { return (i & 3) + 8 * (i >> 2) + 4 * h; }
#define MFMA32(a, b, c) __builtin_amdgcn_mfma_f32_32x32x16_bf16((a), (b), (c), 0, 0, 0)
template <int MODE>
DI void attn_unit(const Params& p, const bf16_t* Qg  , int nq_valid, const bf16_t* Kg  , const bf16_t* Vg  ,
                  int ta0, int ta1, int tb0, int tb1  , bool band, int q_lat0  ,
                  float init_m, float init_l0, bf16_t* Og  , char* smem) {
    const int t = tidx(), lane = t & 63, wid = t >> 6, r = lane & 31, h = lane >> 5;
    bf16_t* sK = (bf16_t*)smem;
    bf16_t* sV = sK + 2 * 64 * KROW;
    bf16x8 qf[2][4];
#pragma unroll
    for (int qs = 0; qs < 2; ++qs) {
        const int qi = wid * 64 + qs * 32 + r;
        const bf16_t* qp = Qg + (size_t)(qi < nq_valid ? qi : 0) * 64 + 8 * h;
#pragma unroll
        for (int ks = 0; ks < 4; ++ks) qf[qs][ks] = *(const bf16x8*)(qp + ks * 16);
    }
#pragma unroll
    for (int qs = 0; qs < 2; ++qs)
#pragma unroll
        for (int ks = 0; ks < 4; ++ks) asm volatile("" : "+v"(qf[qs][ks]));
    f32x16 o[2][2];
#pragma unroll
    for (int qs = 0; qs < 2; ++qs)
#pragma unroll
        for (int dt = 0; dt < 2; ++dt)
#pragma unroll
            for (int i = 0; i < 16; ++i) o[qs][dt][i] = 0.f;
    float mrun[2], lrun[2];
#pragma unroll
    for (int qs = 0; qs < 2; ++qs) { mrun[qs] = init_m; lrun[qs] = (MODE == 1 && h == 0) ? init_l0 : 0.f; }
    const int ntile = ((ta1 - ta0) + (tb1 - tb0)) >> 6;
    const int lrow = t >> 3, lch = (t & 7) * 8;
    u32x4 rk, rv;
    auto tile_pos = [&](int i) { const int a = (ta1 - ta0) >> 6; return i < a ? ta0 + i * 64 : tb0 + (i - a) * 64; };
    {
        const int kp = tile_pos(0);
        rk = *(const u32x4*)(Kg + (size_t)(kp + lrow) * 64 + lch);
        rv = *(const u32x4*)(Vg + (size_t)lrow * PTOT + kp + lch);
        *(u32x4*)(sK + lrow * KROW + lch) = rk;
        *(u32x2*)(sV + lrow * VROW + lch) = (u32x2){rv[0], rv[1]};
        *(u32x2*)(sV + lrow * VROW + lch + 4) = (u32x2){rv[2], rv[3]};
    }
    __syncthreads();
    if (__builtin_amdgcn_readfirstlane(wid) >= 4) __builtin_amdgcn_s_setprio(1);
    for (int it = 0; it < ntile; ++it) {
        const int cur = it & 1;
        const bool more = it + 1 < ntile;
        const int kp = tile_pos(it);
        if (more) {
            const int kn = tile_pos(it + 1);
            rk = *(const u32x4*)(Kg + (size_t)(kn + lrow) * 64 + lch);
            rv = *(const u32x4*)(Vg + (size_t)lrow * PTOT + kn + lch);
        }
        __builtin_amdgcn_sched_barrier(0);
        const bf16_t* cK = sK + cur * 64 * KROW;
        const bf16_t* cV = sV + cur * 64 * VROW;
        bool need = true;
        if (MODE == 1 && band && kp >= LCTX) {
            const int q0 = q_lat0 + __builtin_amdgcn_readfirstlane(wid) * 64, k0 = kp - LCTX;
            need = (k0 + 63 >= q0 - 128) && (k0 <= q0 + 63 + 128);
        }
        if (need) {
        bf16x8 kf[4];
#pragma unroll
        for (int ks = 0; ks < 4; ++ks) kf[ks] = *(const bf16x8*)(cK + r * KROW + ks * 16 + 8 * h);
#pragma unroll
        for (int ksub = 0; ksub < 2; ++ksub) {
            bf16x8 vf[2][2];
#pragma unroll
            for (int st = 0; st < 2; ++st)
#pragma unroll
                for (int dt = 0; dt < 2; ++dt) {
                    const int kb = ksub * 32 + 16 * st + 4 * h;
                    const s16x4 lo = *(const s16x4*)(cV + (dt * 32 + r) * VROW + kb), hi = *(const s16x4*)(cV + (dt * 32 + r) * VROW + kb + 8);
                    vf[st][dt] = __builtin_shufflevector(lo, hi, 0, 1, 2, 3, 4, 5, 6, 7);
                }
            __builtin_amdgcn_sched_barrier(0);
            f32x16 sc[2];
#pragma unroll
            for (int qs = 0; qs < 2; ++qs)
#pragma unroll
                for (int i = 0; i < 16; ++i) sc[qs][i] = MODE == 0 ? init_m : 0.f;
#pragma unroll
            for (int ks = 0; ks < 4; ++ks)
#pragma unroll
                for (int qs = 0; qs < 2; ++qs) sc[qs] = MFMA32(kf[ks], qf[qs][ks], sc[qs]);
            __builtin_amdgcn_sched_barrier(0);
            if (ksub == 0) {
#pragma unroll
                for (int ks = 0; ks < 4; ++ks) kf[ks] = *(const bf16x8*)(cK + (32 + r) * KROW + ks * 16 + 8 * h);
            }
            __builtin_amdgcn_sched_barrier(0);
#pragma unroll
            for (int qs = 0; qs < 2; ++qs) {
                if (MODE == 1) {
                    if (band && kp >= LCTX) {
                        const int qlat = q_lat0 + wid * 64 + qs * 32 + r, kl0 = kp - LCTX + ksub * 32;
#pragma unroll
                        for (int i = 0; i < 16; ++i) {
                            const int d0 = qlat - (kl0 + crow_(i, h));
                            if (d0 > 128 || d0 < -128) sc[qs][i] = -1e30f;
                        }
                    }
                    float mt = sc[qs][0];
#pragma unroll
                    for (int i = 1; i < 16; ++i) mt = fmaxf(mt, sc[qs][i]);
                    mt = fmaxf(mt, __shfl_xor(mt, 32));
                    const float mnew = fmaxf(mrun[qs], mt);
                    const float alpha = __builtin_amdgcn_exp2f(mrun[qs] - mnew);
                    mrun[qs] = mnew; lrun[qs] *= alpha;
#pragma unroll
                    for (int i = 0; i < 16; ++i) { o[qs][0][i] *= alpha; o[qs][1][i] *= alpha; }
#pragma unroll
                    for (int i = 0; i < 16; ++i) sc[qs][i] -= mnew;
                }
                float ls = 0.f;
#pragma unroll
                for (int i = 0; i < 16; ++i) { sc[qs][i] = __builtin_amdgcn_exp2f(sc[qs][i]); ls += sc[qs][i]; }
                lrun[qs] += ls;
            }
#pragma unroll
            for (int st = 0; st < 2; ++st) {
                bf16x8 pf[2];
#pragma unroll
                for (int qs = 0; qs < 2; ++qs) {
                    u32x4 pw;
#pragma unroll
                    for (int j = 0; j < 4; ++j) pw[j] = pk_bf16(sc[qs][8 * st + 2 * j], sc[qs][8 * st + 2 * j + 1]);
                    pf[qs] = __builtin_bit_cast(bf16x8, pw);
                }
#pragma unroll
                for (int dt = 0; dt < 2; ++dt)
#pragma unroll
                    for (int qs = 0; qs < 2; ++qs) o[qs][dt] = MFMA32(vf[st][dt], pf[qs], o[qs][dt]);
            }
        }
        }
        if (more) {
            bf16_t* nK = sK + (cur ^ 1) * 64 * KROW;
            bf16_t* nV = sV + (cur ^ 1) * 64 * VROW;
            *(u32x4*)(nK + lrow * KROW + lch) = rk;
            *(u32x2*)(nV + lrow * VROW + lch) = (u32x2){rv[0], rv[1]};
            *(u32x2*)(nV + lrow * VROW + lch + 4) = (u32x2){rv[2], rv[3]};
        }
        __syncthreads();
    }
    __builtin_amdgcn_s_setprio(0);
#pragma unroll
    for (int qs = 0; qs < 2; ++qs) {
        const int qi = wid * 64 + qs * 32 + r;
        const float lt = lrun[qs] + __shfl_xor(lrun[qs], 32);
        const float invl = 1.0f / lt;
        if (qi < nq_valid) {
            bf16_t* op = Og + (size_t)qi * DM;
#pragma unroll
            for (int g = 0; g < 4; ++g) {
                u32x2 w0, w1;
                w0[0] = pk_bf16(o[qs][0][4 * g] * invl, o[qs][0][4 * g + 1] * invl); w0[1] = pk_bf16(o[qs][0][4 * g + 2] * invl, o[qs][0][4 * g + 3] * invl);
                w1[0] = pk_bf16(o[qs][1][4 * g] * invl, o[qs][1][4 * g + 1] * invl); w1[1] = pk_bf16(o[qs][1][4 * g + 2] * invl, o[qs][1][4 * g + 3] * invl);
                *(u32x2*)(op + 8 * g + 4 * h) = w0;
                *(u32x2*)(op + 32 + 8 * g + 4 * h) = w1;
            }
        }
    }
}
DI void attn_dense8(const Params& p, const unsigned char* Qg8  , int nq_valid, const unsigned char* Kg8  , const unsigned char* Vg8, int ntile, float init_m, bf16_t* Og, char* smem) {
    const int t = tidx(), lane = t & 63, wid = t >> 6, r = lane & 31, h = lane >> 5;
    constexpr int VR8 = 80;
    char* sK = smem;
    char* sV = sK + 2 * 64 * VR8;
    v8i qf8[2];
#pragma unroll
    for (int qs = 0; qs < 2; ++qs) {
        const int qi = wid * 64 + qs * 32 + r;
        const unsigned char* qp = Qg8 + (size_t)(qi < nq_valid ? qi : 0) * 64 + 32 * h;
        qf8[qs] = G8_CAT(*(const bf16x8*)qp, *(const bf16x8*)(qp + 16));
    }
#pragma unroll
    for (int qs = 0; qs < 2; ++qs) asm volatile("" : "+v"(qf8[qs]));
    f32x16 o[2][2];
#pragma unroll
    for (int qs = 0; qs < 2; ++qs)
#pragma unroll
        for (int dt = 0; dt < 2; ++dt)
#pragma unroll
            for (int i = 0; i < 16; ++i) o[qs][dt][i] = 0.f;
    f32x16 osum[2];
#pragma unroll
    for (int qs = 0; qs < 2; ++qs)
#pragma unroll
        for (int i = 0; i < 16; ++i) osum[qs][i] = 0.f;
    f32x16 cinit;
#pragma unroll
    for (int i = 0; i < 16; ++i) cinit[i] = init_m;
    asm volatile("" : "+v"(cinit));
    const int one4 = r == 0 ? 0x38383838 : 0;
    const v8i ones8 = {one4, one4, one4, one4, one4, one4, one4, one4};
    const int lrow = t >> 3, lch = (t & 7) * 8;
    u32x2 rk, rv;
    rk = *(const u32x2*)(Kg8 + (size_t)lrow * 64 + lch);
    rv = *(const u32x2*)(Vg8 + (size_t)lrow * PTOT + (t & 7) * 8);
    *(u32x2*)(sK + lrow * VR8 + lch) = rk;
    *(unsigned*)(sV + lrow * VR8 + (t & 7) * 4) = rv[0]; *(unsigned*)(sV + lrow * VR8 + 32 + (t & 7) * 4) = rv[1];
    __syncthreads();
    if (__builtin_amdgcn_readfirstlane(wid) >= 4) __builtin_amdgcn_s_setprio(1);
    for (int it = 0; it < ntile; ++it) {
        const int cur = it & 1;
        const bool more = it + 1 < ntile;
        if (more) {
            const int kn = (it + 1) * 64;
            rk = *(const u32x2*)(Kg8 + (size_t)(kn + lrow) * 64 + lch);
            rv = *(const u32x2*)(Vg8 + (size_t)lrow * PTOT + kn + (t & 7) * 8);
        }
        __builtin_amdgcn_sched_barrier(0);
        const char* cK = sK + cur * 64 * VR8;
        const char* cV = sV + cur * 64 * VR8;
        v8i kf8 = G8_CAT(*(const bf16x8*)(cK + r * VR8 + h * 32), *(const bf16x8*)(cK + r * VR8 + h * 32 + 16));
        v8i vf8[2];
#pragma unroll
        for (int dt = 0; dt < 2; ++dt) vf8[dt] = G8_CAT(*(const bf16x8*)(cV + (dt * 32 + r) * VR8 + h * 32), *(const bf16x8*)(cV + (dt * 32 + r) * VR8 + h * 32 + 16));
        v8i pf8[2];
#define A8_EXP(x, lo, hi) _Pragma("unroll") for (int i = lo; i < hi; ++i) x[i] = __builtin_amdgcn_exp2f(x[i])
#define A8_PACK(pw, x) _Pragma("unroll") for (int j = 0; j < 4; ++j) { int w; asm volatile("" : "=v"(w));   \
            w = __builtin_amdgcn_cvt_pk_fp8_f32(x[4 * j], x[4 * j + 1], w, false); pw[j] = __builtin_amdgcn_cvt_pk_fp8_f32(x[4 * j + 2], x[4 * j + 3], w, true); }
        {
            __builtin_amdgcn_sched_barrier(0);
            f32x16 sc0, sc1;
            asm volatile("s_nop 2\n\tv_mfma_scale_f32_32x32x64_f8f6f4 %0, %1, %2, %3, %4, %5 op_sel_hi:[0,0,0]" : "=&v"(sc0) : "v"(kf8), "v"(qf8[0]), "v"(cinit), "v"(0x7b7b7b7b), "v"(0x7a7a7a7a));
            asm volatile("s_nop 2\n\tv_mfma_scale_f32_32x32x64_f8f6f4 %0, %1, %2, %3, %4, %5 op_sel_hi:[0,0,0]" : "=&v"(sc1) : "v"(kf8), "v"(qf8[1]), "v"(cinit), "v"(0x7b7b7b7b), "v"(0x7a7a7a7a));
            const v8i kfb = G8_CAT(*(const bf16x8*)(cK + (32 + r) * VR8 + h * 32), *(const bf16x8*)(cK + (32 + r) * VR8 + h * 32 + 16));
            asm volatile("s_nop 15" : "+v"(sc0), "+v"(sc1));
            v4i pa0, pa1, pb;
            A8_EXP(sc0, 0, 16);
            A8_PACK(pa0, sc0);
            asm volatile("s_nop 2\n\tv_mfma_scale_f32_32x32x64_f8f6f4 %0, %2, %3, %4, %5, %6 op_sel_hi:[0,0,0]" : "=&v"(sc0), "+v"(pa0) : "v"(kfb), "v"(qf8[0]), "v"(cinit), "v"(0x7b7b7b7b), "v"(0x7a7a7a7a));
            asm volatile("s_nop 3" : "+v"(sc1));
            A8_EXP(sc1, 0, 16);
            A8_PACK(pa1, sc1);
            asm volatile("s_nop 2\n\tv_mfma_scale_f32_32x32x64_f8f6f4 %0, %2, %3, %4, %5, %6 op_sel_hi:[0,0,0]" : "=&v"(sc1), "+v"(pa1) : "v"(kfb), "v"(qf8[1]), "v"(cinit), "v"(0x7b7b7b7b), "v"(0x7a7a7a7a));
            asm volatile("s_nop 3" : "+v"(sc0), "+v"(sc1));
            A8_EXP(sc0, 0, 16);
            A8_PACK(pb, sc0);
            pf8[0] = __builtin_shufflevector(pa0, pb, 0, 1, 2, 3, 4, 5, 6, 7);
            __builtin_amdgcn_sched_barrier(0);
            asm volatile("s_nop 2\n\tv_mfma_scale_f32_32x32x64_f8f6f4 %0, %2, %3, %0, %4, %4 op_sel_hi:[0,0,0]" : "+v"(o[0][0]), "+v"(sc1) : "v"(vf8[0]), "v"(pf8[0]), "v"(0x7f7f7f7f));
            A8_EXP(sc1, 0, 8);
            __builtin_amdgcn_sched_barrier(0);
            asm volatile("s_nop 2\n\tv_mfma_scale_f32_32x32x64_f8f6f4 %0, %2, %3, %0, %4, %4 op_sel_hi:[0,0,0]" : "+v"(o[0][1]), "+v"(sc1) : "v"(vf8[1]), "v"(pf8[0]), "v"(0x7f7f7f7f));
            A8_EXP(sc1, 8, 16);
            __builtin_amdgcn_sched_barrier(0);
            asm volatile("s_nop 2\n\tv_mfma_scale_f32_32x32x64_f8f6f4 %0, %2, %3, %0, %4, %4 op_sel_hi:[0,0,0]" : "+v"(osum[0]), "+v"(sc1) : "v"(ones8), "v"(pf8[0]), "v"(0x7f7f7f7f));
            A8_PACK(pb, sc1);
            pf8[1] = __builtin_shufflevector(pa1, pb, 0, 1, 2, 3, 4, 5, 6, 7);
        }
#pragma unroll
        for (int dt = 0; dt < 2; ++dt)
            asm volatile("s_nop 2\n\tv_mfma_scale_f32_32x32x64_f8f6f4 %0, %1, %2, %0, %3, %3 op_sel_hi:[0,0,0]" : "+v"(o[1][dt]) : "v"(vf8[dt]), "v"(pf8[1]), "v"(0x7f7f7f7f));
        asm volatile("s_nop 2\n\tv_mfma_scale_f32_32x32x64_f8f6f4 %0, %1, %2, %0, %3, %3 op_sel_hi:[0,0,0]" : "+v"(osum[1]) : "v"(ones8), "v"(pf8[1]), "v"(0x7f7f7f7f));
        if (more) {
            char* nK = sK + (cur ^ 1) * 64 * VR8;
            char* nV = sV + (cur ^ 1) * 64 * VR8;
            *(u32x2*)(nK + lrow * VR8 + lch) = rk;
            *(unsigned*)(nV + lrow * VR8 + (t & 7) * 4) = rv[0]; *(unsigned*)(nV + lrow * VR8 + 32 + (t & 7) * 4) = rv[1];
        }
        __syncthreads();
    }
    __builtin_amdgcn_s_setprio(0);
    asm volatile("s_nop 15\n\ts_nop 15" ::: "memory");
#pragma unroll
    for (int qs = 0; qs < 2; ++qs) {
        const int qi = wid * 64 + qs * 32 + r;
        const float lt = __shfl(osum[qs][0], r);
        const float invl = (1.0f / F8_SV) / lt;
        if (qi < nq_valid) {
            bf16_t* op = Og + (size_t)qi * DM;
#pragma unroll
            for (int g = 0; g < 4; ++g) {
                u32x2 w0, w1;
                w0[0] = pk_bf16(o[qs][0][4 * g] * invl, o[qs][0][4 * g + 1] * invl); w0[1] = pk_bf16(o[qs][0][4 * g + 2] * invl, o[qs][0][4 * g + 3] * invl);
                w1[0] = pk_bf16(o[qs][1][4 * g] * invl, o[qs][1][4 * g + 1] * invl); w1[1] = pk_bf16(o[qs][1][4 * g + 2] * invl, o[qs][1][4 * g + 3] * invl);
                *(u32x2*)(op + 8 * g + 4 * h) = w0;
                *(u32x2*)(op + 32 + 8 * g + 4 * h) = w1;
            }
        }
    }
}
DI void phase_attn(const Params& p, char* smem) {
    const bf16_t* Q = (const bf16_t*)(p.ws + OFF_SCR + S_Q);
    const bf16_t* K = (const bf16_t*)(p.ws + OFF_SCR + S_K);
    const bf16_t* VT = (const bf16_t*)(p.ws + OFF_SCR + S_VT);
    bf16_t* O = (bf16_t*)(p.ws + OFF_SCR + S_O);
    float gq = 0.f, gk = 0.f;
    for (int i = 0; i < 64; ++i) { gq = fmaxf(gq, fabsf(p.attn_q_norm_g[i])); gk = fmaxf(gk, fabsf(p.attn_k_norm_g[i])); }
    const float M2 = 8.25f * gq * gk * LOG2E;
    constexpr int QB = 512, NQB = SEQ / QB;
    const int G = gridDim.x;
    constexpr int NDENSE = NBATCH * 8 * NQB;
    for (int u = blockIdx.x; u < NDENSE; u += G) {
        int combo, within;
        if ((G & 7) == 0 && NDENSE % G == 0) {
            const int xcd = blockIdx.x & 7, idx = (blockIdx.x >> 3) + (G >> 3) * (u / G);
            combo = xcd & 3; within = (xcd >> 2) * (NDENSE / 8) + idx;
        } else { combo = u / (4 * NQB); within = u % (4 * NQB); }
        const int b = combo >> 1, kvh = combo & 1, hq = kvh * 4 + (within & 3), qb = within >> 2;
        const unsigned char* Qg = (const unsigned char*)(p.ws + OFF_SCR + S_Q8) + ((size_t)(b * 8 + hq) * PTOT + LCTX + qb * QB) * 64;
        attn_dense8(p, Qg, QB, (const unsigned char*)(p.ws + OFF_SCR + S_K8) + (size_t)(b * 2 + kvh) * PTOT * 64, (const unsigned char*)(p.ws + OFF_SCR + S_VT8) + (size_t)(b * 2 + kvh) * 64 * PTOT, PTOT / 64, -M2 + 8.0f,
                    O + (size_t)(b * PTOT + LCTX + qb * QB) * DM + (8 + hq) * 64, smem);
    }
    for (int u = blockIdx.x; u < NDENSE; u += G) {
        const int b = u / (8 * NQB), rem = u % (8 * NQB), qb = rem >> 3, hq = rem & 7, kvh = hq >> 2;
        const int i0 = qb * QB;
        const int lo = i0 - 128 < 0 ? 0 : i0 - 128, hi = i0 + QB + 128 > SEQ ? SEQ : i0 + QB + 128;
        const bf16_t* Qg = Q + ((size_t)(b * 16 + hq) * PTOT + LCTX + i0) * 64;
        attn_unit<1>(p, Qg, QB, K + (size_t)(b * 4 + kvh) * PTOT * 64, VT + (size_t)(b * 4 + kvh) * 64 * PTOT, 0, LCTX, LCTX + lo, LCTX + hi, true, i0,
                     p.attn_sink[hq] * LOG2E, 1.0f, O + (size_t)(b * PTOT + LCTX + i0) * DM + hq * 64, smem);
    }
    for (int u = blockIdx.x; u < NBATCH * 16; u += G) {
        const int b = u >> 4, hh = u & 15, isb = hh >> 3, hq = hh & 7, kvh = isb * 2 + (hq >> 2);
        const bf16_t* Qg = Q + ((size_t)(b * 16 + hh) * PTOT) * 64;
        attn_unit<1>(p, Qg, LCTX, K + (size_t)(b * 4 + kvh) * PTOT * 64, VT + (size_t)(b * 4 + kvh) * 64 * PTOT, 0, LCTX, 0, 0, false, 0,
                     isb ? -1e30f : p.attn_sink[hq] * LOG2E, isb ? 0.f : 1.0f, O + (size_t)(b * PTOT) * DM + hh * 64, smem);
    }
}

constexpr int TB = 32, NBUF = 3;
constexpr int SC_REC = 5 * 64;
constexpr int SC_OPS = TB * SC_REC * 4;
constexpr int SC_SMEM = NBUF * SC_OPS + NBUF * TB * 16 * 4 + NBUF * TB * 16 * 4 + 64;
DI int scan_pos(int n, int dir) {
    if (n < LCTX) return dir ? LCTX - 1 - n : n;
    const int m = n - LCTX;
    return LCTX + (dir ? SEQ - 1 - m : m);
}
template <int CTRL> DI float dpp_add(float v) { return v + __builtin_bit_cast(float, __builtin_amdgcn_update_dpp(0, __builtin_bit_cast(int, v), CTRL, 0xf, 0xf, false)); }
DI float row16_sum(float v) { v = dpp_add<0x128>(v); v = dpp_add<0x124>(v); v = dpp_add<0x122>(v); v = dpp_add<0x121>(v); return v; }
DI int lds_min4(int* c) { const volatile LAS int* q = (const volatile LAS int*)c; const int a = q[0], b = q[1], d = q[2], e = q[3]; return min(min(a, b), min(d, e)); }
DI void lds_publish(int* c, int v) { *(volatile LAS int*)c = v; }
DI void scan_unit(const Params& p, int u, char* smem) {
    const int t = tidx(), lane = t & 63, wid = __builtin_amdgcn_readfirstlane(t >> 6);
    const unsigned rg = u & 3, dir = (u >> 2) & 1, hd = (u >> 3) & 15, b = u >> 7;
    float* ops = (float*)smem;
    float* vbuf = (float*)(smem + NBUF * SC_OPS);
    float* ybuf = vbuf + NBUF * TB * 16;
    int* cnts = (int*)(ybuf + NBUF * TB * 16);
    const bf16_t* R = (const bf16_t*)(p.ws + OFF_SCR + S_R);
    const bf16_t* Kk = (const bf16_t*)(p.ws + OFF_SCR + S_KK);
    const bf16_t* V = (const bf16_t*)(p.ws + OFF_SCR + S_V);
    const bf16_t* LW = (const bf16_t*)(p.ws + OFF_SCR + S_LW);
    const bf16_t* LA = (const bf16_t*)(p.ws + OFF_SCR + S_LA);
    bf16_t* Yo = dir ? (bf16_t*)(p.ws + OFF_SCR + S_Y1) : (bf16_t*)(p.ws + OFF_H);
    float* bonus = (float*)(p.ws + OFF_BONUS2);
    const unsigned tokb = b * PTOT, hc = hd * 64;
    constexpr int NBLK = PTOT / TB;
    const unsigned fr = lane & 15, fq = lane >> 4;
    if (t < 8) cnts[t] = 0;
    __syncthreads();

    if (wid < 4) {
        __builtin_amdgcn_s_setprio(3);
        float s0 = 0.f, s1 = 0.f, s2 = 0.f, s3 = 0.f;
        const unsigned g = lane >> 4, c4 = (lane & 15) * 4, myrow = wid * 4 + g;
        for (int blk = 0; blk < NBLK; ++blk) {
            const unsigned buf = (unsigned)blk % NBUF;
            while (lds_min4(cnts) < blk + 1) __builtin_amdgcn_s_sleep(1);
            asm volatile("" ::: "memory");
            const float* rec = ops + buf * (TB * SC_REC) + c4;
            const float* vb = vbuf + buf * (TB * 16) + myrow;
            float* yb = ybuf + buf * (TB * 16) + myrow;
            f32x4 w0_ = *(const f32x4*)(rec), kd0_ = *(const f32x4*)(rec + 64), bb0_ = *(const f32x4*)(rec + 128), aa0_ = *(const f32x4*)(rec + 192), rr0_ = *(const f32x4*)(rec + 256);
            float vv0_ = vb[0];
#define SCAN_STEP(W, KD, BB, AA, RR, VV, ST) { \
                float sa = s0 * AA[0] + s1 * AA[1] + s2 * AA[2] + s3 * AA[3]; \
                sa = row16_sum(sa); \
                s0 = s0 * W[0] + sa * BB[0] + VV * KD[0]; \
                s1 = s1 * W[1] + sa * BB[1] + VV * KD[1]; \
                s2 = s2 * W[2] + sa * BB[2] + VV * KD[2]; \
                s3 = s3 * W[3] + sa * BB[3] + VV * KD[3]; \
                float y = s0 * RR[0] + s1 * RR[1] + s2 * RR[2] + s3 * RR[3]; \
                y = row16_sum(y); \
                if ((lane & 15) == 0) yb[(ST) * 16] = y; }
#pragma unroll 1
            for (int st = 0; st < TB; st += 2) {
                const float* r1 = rec + (st + 1) * SC_REC;
                const f32x4 w1_ = *(const f32x4*)(r1), kd1_ = *(const f32x4*)(r1 + 64), bb1_ = *(const f32x4*)(r1 + 128), aa1_ = *(const f32x4*)(r1 + 192), rr1_ = *(const f32x4*)(r1 + 256);
                const float vv1_ = vb[(st + 1) * 16];
                SCAN_STEP(w0_, kd0_, bb0_, aa0_, rr0_, vv0_, st)
                const int st2 = st + 2 < TB ? st + 2 : st;
                const float* r2 = rec + st2 * SC_REC;
                w0_ = *(const f32x4*)(r2); kd0_ = *(const f32x4*)(r2 + 64); bb0_ = *(const f32x4*)(r2 + 128); aa0_ = *(const f32x4*)(r2 + 192); rr0_ = *(const f32x4*)(r2 + 256);
                vv0_ = vb[st2 * 16];
                SCAN_STEP(w1_, kd1_, bb1_, aa1_, rr1_, vv1_, st + 1)
            }
#undef SCAN_STEP
            asm volatile("s_waitcnt lgkmcnt(0)" ::: "memory");
            if (lane == 0) lds_publish(cnts + 4 + wid, blk + 1);
        }
        __builtin_amdgcn_s_setprio(0);
    } else {
        const unsigned wt = wid & 1, chh = (wid >> 1) & 1;
        const bf16_t* wsm = (const bf16_t*)(p.ws + OFF_WS);
        const unsigned wo = W_W2 + dir * 65536u + (hc + fr) * 64u + fq * 8u;
        const unsigned ao = W_A2 + dir * 65536u + (hc + fr) * 64u + fq * 8u;
        const unsigned po = hc + fq * 4u;
        for (int blk = 0; blk < NBLK + NBUF; ++blk) {
            const unsigned buf = (unsigned)blk % NBUF;
            const int need = blk - NBUF + 1 < NBLK ? blk - NBUF + 1 : NBLK;
            while (lds_min4(cnts + 4) < need) __builtin_amdgcn_s_sleep(1);
            asm volatile("" ::: "memory");
            if (wid == 7 && blk >= NBUF) {
#pragma unroll
                for (int i = 0; i < TB * 16 / 64; ++i) {
                    const unsigned id = i * 64 + lane, st = id >> 4, rw = id & 15;
                    const unsigned tok = tokb + scan_pos((blk - NBUF) * TB + st, dir);
                    Yo[tok * 1024u + hc + rg * 16 + rw] = (bf16_t)(pk_bf16(ybuf[buf * (TB * 16) + id], 0.f) & 0xffffu);
                }
            }
            if (blk >= NBLK) continue;
            const unsigned st = wt * 16 + fr;
            const unsigned tok = tokb + scan_pos(blk * TB + st, dir);
            const unsigned lo = tok * 128u + dir * 64u + fq * 8u;
            const unsigned ro = tok * 1024u + hc + fq * 4u;
            bf16x8 lwf[2], laf[2];
#pragma unroll
            for (int kk = 0; kk < 2; ++kk) { lwf[kk] = *(const bf16x8*)(LW + lo + kk * 32); laf[kk] = *(const bf16x8*)(LA + lo + kk * 32); }
            float ssq = 0.f;
#pragma unroll
            for (int nt = 0; nt < 4; ++nt) {
                const f32x4 kkv = *(const f32x4*)(p.rwkv_k_k + po + nt * 16);
                const u32x2 c = *(const u32x2*)(Kk + ro + nt * 16);
                const float q0 = bf_lo(c[0]) * kkv[0], q1 = bf_hi(c[0]) * kkv[1], q2 = bf_lo(c[1]) * kkv[2], q3 = bf_hi(c[1]) * kkv[3];
                ssq += q0 * q0 + q1 * q1 + q2 * q2 + q3 * q3;
            }
            ssq += __shfl_xor(ssq, 16); ssq += __shfl_xor(ssq, 32);
            const float kn = __builtin_amdgcn_rsqf(fmaxf(ssq, 1e-24f));
            float* rec = ops + buf * (TB * SC_REC) + st * SC_REC + fq * 4;
            float bsum = 0.f;
#pragma unroll
            for (int n2 = 0; n2 < 2; ++n2) {
                const unsigned nt = chh * 2 + n2;
                f32x4 aw = {0.f, 0.f, 0.f, 0.f}, ai = aw;
#pragma unroll
                for (int kk = 0; kk < 2; ++kk) {
                    const bf16x8 w2f = *(const bf16x8*)(wsm + wo + nt * 1024 + kk * 32), a2f = *(const bf16x8*)(wsm + ao + nt * 1024 + kk * 32);
                    aw = __builtin_amdgcn_mfma_f32_16x16x32_bf16(w2f, lwf[kk], aw, 0, 0, 0);
                    ai = __builtin_amdgcn_mfma_f32_16x16x32_bf16(a2f, laf[kk], ai, 0, 0, 0);
                }
                const f32x4 w0v = *(const f32x4*)(p.rwkv_decay_w0 + dir * 1024u + po + nt * 16), a0v = *(const f32x4*)(p.rwkv_iclr_a0 + dir * 1024u + po + nt * 16);
                const f32x4 kkv = *(const f32x4*)(p.rwkv_k_k + po + nt * 16);
                const f32x4 kav = *(const f32x4*)(p.rwkv_k_a + po + nt * 16), rkv = *(const f32x4*)(p.rwkv_r_k + po + nt * 16);
                const u32x2 a = *(const u32x2*)(R + ro + nt * 16), c = *(const u32x2*)(Kk + ro + nt * 16);
                const f32x4 rr = {bf_lo(a[0]), bf_hi(a[0]), bf_lo(a[1]), bf_hi(a[1])};
                const f32x4 kr = {bf_lo(c[0]), bf_hi(c[0]), bf_lo(c[1]), bf_hi(c[1])};
                f32x4 wv, kd, bb, aa;
#pragma unroll
                for (int j = 0; j < 4; ++j) {
                    const float sg = __builtin_amdgcn_rcpf(1.0f + __builtin_amdgcn_exp2f(-(w0v[j] + aw[j]) * LOG2E));
                    wv[j] = __builtin_amdgcn_exp2f(sg * (-0.6065306597126334f * LOG2E));
                    const float ic = __builtin_amdgcn_rcpf(1.0f + __builtin_amdgcn_exp2f(-(a0v[j] + ai[j]) * LOG2E));
                    const float kkn = kr[j] * kkv[j] * kn;
                    kd[j] = kr[j] * (1.0f + (ic - 1.0f) * kav[j]);
                    bb[j] = kkn * ic;
                    aa[j] = -kkn;
                    bsum += rr[j] * kd[j] * rkv[j];
                }
                *(f32x4*)(rec + 0 * 64 + nt * 16) = wv;
                *(f32x4*)(rec + 1 * 64 + nt * 16) = kd;
                *(f32x4*)(rec + 2 * 64 + nt * 16) = bb;
                *(f32x4*)(rec + 3 * 64 + nt * 16) = aa;
                *(f32x4*)(rec + 4 * 64 + nt * 16) = rr;
            }
            bsum += __shfl_xor(bsum, 16); bsum += __shfl_xor(bsum, 32);
            if (rg == 0 && fq == 0) bonus[((chh * 2 + dir) * TTOT + tok) * 16u + hd] = bsum;
            if (wid == 6) {
                bf16_t vr[TB * 16 / 64];
#pragma unroll
                for (int i = 0; i < TB * 16 / 64; ++i) {
                    const unsigned id = i * 64 + lane, s2 = id >> 4, rw = id & 15;
                    const unsigned tk = tokb + scan_pos(blk * TB + s2, dir);
                    vr[i] = V[tk * 1024u + hc + rg * 16 + rw];
                }
#pragma unroll
                for (int i = 0; i < TB * 16 / 64; ++i) vbuf[buf * (TB * 16) + i * 64 + lane] = bf2f(vr[i]);
            }
            asm volatile("s_waitcnt lgkmcnt(0)" ::: "memory");
            if (lane == 0) lds_publish(cnts + (wid - 4), blk + 1);
        }
    }
    __syncthreads();
}

constexpr int CH = 16, NCHK = PTOT / CH;
constexpr int NPREP = 7, NSLOT = 2;
constexpr int TKS = 72, KTS = 20, SMS = 20;
constexpr int SL_XA = 0, SL_XR = SL_XA + 16 * TKS * 2, SL_TB = SL_XR + 16 * TKS * 2, SL_TK = SL_TB + 64 * KTS * 2, SL_TT = SL_TK + 64 * KTS * 2, SL_NAK = SL_TT + 16 * SMS * 2,
              SL_NRB = SL_NAK + 16 * SMS * 2, SL_NRK = SL_NRB + 16 * SMS * 2, SL_VT = SL_NRK + 16 * SMS * 2, SL_WC = SL_VT + 16 * SMS * 2, SLOT_BYTES = SL_WC + 64 * 4;
constexpr int XTK_B = 16 * TKS * 2, XKT_B = 64 * KTS * 2, SM_B = 16 * SMS * 2;
constexpr int PR_XA = 0, PR_XB = PR_XA + XTK_B, PR_XK = PR_XB + XTK_B, PR_XR = PR_XK + XTK_B, PR_TB = PR_XR + XTK_B, PR_TK = PR_TB + XKT_B,
              PR_SN = PR_TK + XKT_B, PREP_BYTES = PR_SN + 2 * SM_B;
static_assert(10 * SM_B <= 3 * XTK_B, "matrices fit in XA..XK");
constexpr int SC2_SMEM = NSLOT * SLOT_BYTES + NPREP * PREP_BYTES + 64 + 5 * 64 * 4;
typedef short s16x4v __attribute__((ext_vector_type(4)));
DI f32x4 mfma16(s16x4v a, s16x4v b, f32x4 c) { return __builtin_amdgcn_mfma_f32_16x16x16bf16_1k(a, b, c, 0, 0, 0); }
DI f32x4 mfma32(bf16x8 a, bf16x8 b, f32x4 c) { return __builtin_amdgcn_mfma_f32_16x16x32_bf16(a, b, c, 0, 0, 0); }
DI s16x4v ld4(const bf16_t* q) { return *(const s16x4v*)q; }
DI f32x4 up4(u32x2 w) { return (f32x4){bf_lo(w[0]), bf_hi(w[0]), bf_lo(w[1]), bf_hi(w[1])}; }
DI f32x4 ld4f(const bf16_t* q) { return up4(*(const u32x2*)q); }
DI void st4(bf16_t* q, f32x4 v) { u32x2 w; w[0] = pk_bf16(v[0], v[1]); w[1] = pk_bf16(v[2], v[3]); *(u32x2*)q = w; }
#define LDS_WAIT() asm volatile("s_waitcnt lgkmcnt(0)" ::: "memory")
template <int CTRL> DI float dpp_shr_add(float v) { return v + __builtin_bit_cast(float, __builtin_amdgcn_update_dpp(0, __builtin_bit_cast(int, v), CTRL, 0xf, 0xf, true)); }
DI float row16_prefix(float v) { v = dpp_shr_add<0x111>(v); v = dpp_shr_add<0x112>(v); v = dpp_shr_add<0x114>(v); v = dpp_shr_add<0x118>(v); return v; }
DI f32x4 mm16(const bf16_t* A, const bf16_t* Bt, int fr, int fq) {
    const s16x4v a = ld4(A + fr * SMS + fq * 4), b = ld4(Bt + fr * SMS + fq * 4);
    LDS_WAIT();
    return mfma16(a, b, (f32x4){0.f, 0.f, 0.f, 0.f});
}
DI f32x4 mm16p(const bf16_t* A, const bf16_t* Bt, const bf16_t* Add, int fr, int fq) {
    const s16x4v a = ld4(A + fr * SMS + fq * 4), b = ld4(Bt + fr * SMS + fq * 4);
    const u32x2 c = *(const u32x2*)(Add + fr * SMS + fq * 4);
    LDS_WAIT();
    return mfma16(a, b, up4(c));
}

DI void scan_unit_chunked(const Params& p, int u, char* smem) {
    const int t = tidx(), lane = t & 63, wid = __builtin_amdgcn_readfirstlane(t >> 6);
    const unsigned rg = u & 3, dir = (u >> 2) & 1, hd = (u >> 3) & 15, b = u >> 7;
    const unsigned tokb = b * PTOT, hc = hd * 64;
    const unsigned fr = lane & 15, fq = lane >> 4;
    char* slots = smem;
    char* prep0 = smem + NSLOT * SLOT_BYTES;
    int* cnts = (int*)(smem + NSLOT * SLOT_BYTES + NPREP * PREP_BYTES);
    const bf16_t* R = (const bf16_t*)(p.ws + OFF_SCR + S_R);
    const bf16_t* Kk = (const bf16_t*)(p.ws + OFF_SCR + S_KK);
    const bf16_t* V = (const bf16_t*)(p.ws + OFF_SCR + S_V);
    const bf16_t* LW = (const bf16_t*)(p.ws + OFF_SCR + S_LW);
    const bf16_t* LA = (const bf16_t*)(p.ws + OFF_SCR + S_LA);
    bf16_t* Yo = dir ? (bf16_t*)(p.ws + OFF_SCR + S_Y1) : (bf16_t*)(p.ws + OFF_H);
    float* bonus = (float*)(p.ws + OFF_BONUS2);
    float* prm = (float*)(cnts + 16);
    if (t < 16) cnts[t] = 0;
    if (t < 64) {
        prm[t] = p.rwkv_decay_w0[dir * 1024u + hc + t]; prm[64 + t] = p.rwkv_iclr_a0[dir * 1024u + hc + t];
        prm[128 + t] = p.rwkv_k_k[hc + t]; prm[192 + t] = p.rwkv_k_a[hc + t]; prm[256 + t] = p.rwkv_r_k[hc + t];
    }
    __syncthreads();

    if (wid == 0) {
        __builtin_amdgcn_s_setprio(3);
        f32x4 st[4];
#pragma unroll
        for (int m = 0; m < 4; ++m) st[m] = (f32x4){0.f, 0.f, 0.f, 0.f};
        for (int c = 0; c < NCHK; ++c) {
            const unsigned sl = (unsigned)c % NSLOT;
            const char* S = slots + sl * SLOT_BYTES;
            while (*(volatile LAS int*)(cnts + sl) < c + 1) __builtin_amdgcn_s_sleep(1);
            LDS_WAIT();
            const int so = fr * SMS + fq * 4;
            const s16x4v vt = ld4((const bf16_t*)(S + SL_VT) + so);
            const s16x4v tt = ld4((const bf16_t*)(S + SL_TT) + so);
            const s16x4v nakt = ld4((const bf16_t*)(S + SL_NAK) + so);
            const s16x4v nrbt = ld4((const bf16_t*)(S + SL_NRB) + so);
            const s16x4v nrkt = ld4((const bf16_t*)(S + SL_NRK) + so);
            s16x4v xal[2], xah[2], xrl[2], xrh[2], tb[4], tk[4];
            f32x4 wc[4];
#pragma unroll
            for (int i = 0; i < 2; ++i) {
                const bf16_t* qa = (const bf16_t*)(S + SL_XA) + fr * TKS + 32 * i + fq * 4; xal[i] = ld4(qa); xah[i] = ld4(qa + 16);
                const bf16_t* qr = (const bf16_t*)(S + SL_XR) + fr * TKS + 32 * i + fq * 4; xrl[i] = ld4(qr); xrh[i] = ld4(qr + 16);
            }
#pragma unroll
            for (int m = 0; m < 4; ++m) {
                wc[m] = *(const f32x4*)((const float*)(S + SL_WC) + 16 * m + fq * 4);
                tb[m] = ld4((const bf16_t*)(S + SL_TB) + (16 * m + fr) * KTS + fq * 4);
                tk[m] = ld4((const bf16_t*)(S + SL_TK) + (16 * m + fr) * KTS + fq * 4);
            }
            LDS_WAIT();
            bf16x8 sb[2];
#pragma unroll
            for (int i = 0; i < 2; ++i) {
                u32x4 w; w[0] = pk_bf16(st[2 * i][0], st[2 * i][1]); w[1] = pk_bf16(st[2 * i][2], st[2 * i][3]); w[2] = pk_bf16(st[2 * i + 1][0], st[2 * i + 1][1]); w[3] = pk_bf16(st[2 * i + 1][2], st[2 * i + 1][3]);
                sb[i] = __builtin_bit_cast(bf16x8, w);
            }
            f32x4 z = {0.f, 0.f, 0.f, 0.f};
#pragma unroll
            for (int i = 0; i < 2; ++i) z = mfma32(__builtin_shufflevector(xal[i], xah[i], 0, 1, 2, 3, 4, 5, 6, 7), sb[i], z);
            z = mfma16(nakt, vt, z);
            u32x2 zw; zw[0] = pk_bf16(z[0], z[1]); zw[1] = pk_bf16(z[2], z[3]);
            const f32x4 uu = mfma16(tt, __builtin_bit_cast(s16x4v, zw), (f32x4){0.f, 0.f, 0.f, 0.f});
            u32x2 uw; uw[0] = pk_bf16(uu[0], uu[1]); uw[1] = pk_bf16(uu[2], uu[3]);
            const s16x4v ub = __builtin_bit_cast(s16x4v, uw);
            f32x4 y = {0.f, 0.f, 0.f, 0.f};
#pragma unroll
            for (int i = 0; i < 2; ++i) y = mfma32(__builtin_shufflevector(xrl[i], xrh[i], 0, 1, 2, 3, 4, 5, 6, 7), sb[i], y);
            y = mfma16(nrkt, vt, y);
            y = mfma16(nrbt, ub, y);
#pragma unroll
            for (int m = 0; m < 4; ++m) {
                f32x4 acc = mfma16(tk[m], vt, st[m]);
                acc = mfma16(tb[m], ub, acc);
                st[m] = acc * wc[m];
            }

#pragma unroll
            for (int j = 0; j < 4; ++j) {
                const unsigned tok = tokb + scan_pos(c * CH + fq * 4 + j, dir);
                Yo[tok * 1024u + hc + rg * 16 + fr] = (bf16_t)(pk_bf16(y[j], 0.f) & 0xffffu);
            }
            asm volatile("" ::: "memory");
            if (lane == 0) *(volatile LAS int*)(cnts + 8) = c + 1;
        }
        __builtin_amdgcn_s_setprio(0);
    } else {
        const unsigned pid = wid - 1;
        char* PS = prep0 + pid * PREP_BYTES;
        bf16_t* XA = (bf16_t*)(PS + PR_XA); bf16_t* XB = (bf16_t*)(PS + PR_XB); bf16_t* XK = (bf16_t*)(PS + PR_XK); bf16_t* XR = (bf16_t*)(PS + PR_XR);
        bf16_t* TB_ = (bf16_t*)(PS + PR_TB); bf16_t* TK = (bf16_t*)(PS + PR_TK);
        bf16_t* SN = (bf16_t*)(PS + PR_SN);
        bf16_t *M = SN, *NABR = SN + 1 * 16 * SMS;
        bf16_t *M2 = XA, *M2T = XA + 1 * 16 * SMS, *M4 = XA + 2 * 16 * SMS, *M4T = XA + 3 * 16 * SMS, *X1 = XA + 4 * 16 * SMS, *G1 = XA + 5 * 16 * SMS, *NAKR = XA + 6 * 16 * SMS,
                *NRBT = XA + 7 * 16 * SMS, *NRKT = XA + 8 * 16 * SMS, *IM = XA + 9 * 16 * SMS;
        bf16_t *M8T = M2, *X2 = M2T, *TT = M4;
        float* WCP = (float*)SN;
        const bf16_t* wsm = (const bf16_t*)(p.ws + OFF_WS);
        const unsigned wo = W_W2 + dir * 65536u + (hc + fr) * 64u + fq * 8u;
        const unsigned ao = W_A2 + dir * 65536u + (hc + fr) * 64u + fq * 8u;
        const unsigned po = hc + fq * 4u;
        const f32x4 z4 = {0.f, 0.f, 0.f, 0.f};
        bf16x8 lwf[2], laf[2];
        u32x2 krw[4], rrw[4];
        unsigned tok_cur = 0;
        auto issue = [&](int c, bf16x8 (&lw)[2], bf16x8 (&la)[2], u32x2 (&kw)[4], u32x2 (&rw)[4], unsigned& tk) {
            tk = tokb + scan_pos(c * CH + fr, dir);
            const unsigned lo = tk * 128u + dir * 64u + fq * 8u, ro = tk * 1024u + hc + fq * 4u;
#pragma unroll
            for (int kk = 0; kk < 2; ++kk) { lw[kk] = *(const bf16x8*)(LW + lo + kk * 32); la[kk] = *(const bf16x8*)(LA + lo + kk * 32); }
#pragma unroll
            for (int nt = 0; nt < 4; ++nt) { kw[nt] = *(const u32x2*)(Kk + ro + nt * 16); rw[nt] = *(const u32x2*)(R + ro + nt * 16); }
        };
        if ((int)pid < NCHK) issue(pid, lwf, laf, krw, rrw, tok_cur);
#pragma unroll
        for (int kk = 0; kk < 2; ++kk) asm volatile("" : "+v"(lwf[kk]), "+v"(laf[kk]));
#pragma unroll
        for (int nt = 0; nt < 4; ++nt) asm volatile("" : "+v"(krw[nt]), "+v"(rrw[nt]));
        auto ldw = [&](bf16x8 (&w)[2][2], int nt) {
#pragma unroll
            for (int kk = 0; kk < 2; ++kk) { w[0][kk] = *(const bf16x8*)(wsm + wo + nt * 1024 + kk * 32); w[1][kk] = *(const bf16x8*)(wsm + ao + nt * 1024 + kk * 32); }
        };
        for (int c = pid; c < NCHK; c += NPREP) {
            bf16x8 wq[2][2], wn[2][2];
            ldw(wq, 0);
            const unsigned tok = tok_cur;
            float ssq = 0.f;
#pragma unroll
            for (int nt = 0; nt < 4; ++nt) {
                const f32x4 kkv = *(const f32x4*)(prm + 128 + fq * 4 + nt * 16);
                const f32x4 q = up4(krw[nt]) * kkv;
                ssq += q[0] * q[0] + q[1] * q[1] + q[2] * q[2] + q[3] * q[3];
            }
            ssq += __shfl_xor(ssq, 16); ssq += __shfl_xor(ssq, 32);
            const float kn = __builtin_amdgcn_rsqf(fmaxf(ssq, 1e-24f));
            float bsum = 0.f;
#pragma unroll
            for (int nt = 0; nt < 4; ++nt) {
                f32x4 aw = z4, ai = z4;
                if (nt < 3) ldw(wn, nt + 1);
                __builtin_amdgcn_sched_barrier(0);
#pragma unroll
                for (int kk = 0; kk < 2; ++kk) {
                    aw = mfma32(wq[0][kk], lwf[kk], aw);
                    ai = mfma32(wq[1][kk], laf[kk], ai);
                }
                if (nt < 3) {
#pragma unroll
                    for (int kk = 0; kk < 2; ++kk) { wq[0][kk] = wn[0][kk]; wq[1][kk] = wn[1][kk]; }
                }
                const f32x4 w0v = *(const f32x4*)(prm + fq * 4 + nt * 16), a0v = *(const f32x4*)(prm + 64 + fq * 4 + nt * 16);
                const f32x4 kkv = *(const f32x4*)(prm + 128 + fq * 4 + nt * 16);
                const f32x4 kav = *(const f32x4*)(prm + 192 + fq * 4 + nt * 16), rkv = *(const f32x4*)(prm + 256 + fq * 4 + nt * 16);
                LDS_WAIT();
                const f32x4 rr = up4(rrw[nt]), krn4 = up4(krw[nt]);
                const f32x4 x1 = (w0v + aw) * (-LOG2E), x2 = (a0v + ai) * (-LOG2E);
                f32x4 ex1, ex2;
#pragma unroll
                for (int j = 0; j < 4; ++j) { ex1[j] = __builtin_amdgcn_exp2f(x1[j]); ex2[j] = __builtin_amdgcn_exp2f(x2[j]); }
                ex1 = ex1 + 1.0f; ex2 = ex2 + 1.0f;
                f32x4 sg, ic;
#pragma unroll
                for (int j = 0; j < 4; ++j) { sg[j] = __builtin_amdgcn_rcpf(ex1[j]); ic[j] = __builtin_amdgcn_rcpf(ex2[j]); }
                const f32x4 e2 = sg * (0.6065306597126334f * LOG2E);
                const f32x4 kkn = krn4 * kkv * kn;
                const f32x4 kd = krn4 * ((ic - 1.0f) * kav + 1.0f);
                { const f32x4 bq = rr * kd * rkv; bsum += (bq[0] + bq[1]) + (bq[2] + bq[3]); }
                f32x4 wt, wi, wp;
#pragma unroll
                for (int j = 0; j < 4; ++j) {
                    const float ec = row16_prefix(e2[j]);
                    wt[j] = __builtin_amdgcn_exp2f(-ec);
                    wi[j] = __builtin_amdgcn_exp2f(ec);
                    wp[j] = __builtin_amdgcn_exp2f(e2[j] - ec);
                }
                const f32x4 at = -(kkn * wp), rt = rr * wt, bt = kkn * ic * wi, kt = kd * wi;
                {
                    u32x2 wa, wb, wk;
                    wa[0] = pk_bf16(at[0], at[1]); wa[1] = pk_bf16(at[2], at[3]); wb[0] = pk_bf16(bt[0], bt[1]); wb[1] = pk_bf16(bt[2], bt[3]);
                    wk[0] = pk_bf16(kt[0], kt[1]); wk[1] = pk_bf16(kt[2], kt[3]);
                    *(u32x2*)(XA + fr * TKS + nt * 16 + fq * 4) = wa; *(u32x2*)(XB + fr * TKS + nt * 16 + fq * 4) = wb; *(u32x2*)(XK + fr * TKS + nt * 16 + fq * 4) = wk;
                    const unsigned o = (nt * 16 + fq * 4) * KTS + fr;
#pragma unroll
                    for (int j = 0; j < 4; ++j) {
                        TB_[o + j * KTS] = (bf16_t)((j & 1) ? (wb[j >> 1] >> 16) : (wb[j >> 1] & 0xffffu));
                        TK[o + j * KTS] = (bf16_t)((j & 1) ? (wk[j >> 1] >> 16) : (wk[j >> 1] & 0xffffu));
                    }
                }
                if (fr == 15) *(f32x4*)(WCP + nt * 16 + fq * 4) = wt;
                st4(XR + fr * TKS + nt * 16 + fq * 4, rt);
            }
            bsum += __shfl_xor(bsum, 16); bsum += __shfl_xor(bsum, 32);
            if (rg == 0 && fq == 0) { bonus[((0 * 2 + dir) * TTOT + tok) * 16u + hd] = bsum; bonus[((1 * 2 + dir) * TTOT + tok) * 16u + hd] = 0.f; }
            if (c + NPREP < NCHK) issue(c + NPREP, lwf, laf, krw, rrw, tok_cur);
            unsigned vv[2][2];
#pragma unroll
            for (int i = 0; i < 2; ++i) {
                const unsigned q = i * 64 + lane, vrow = q & 15, sp = q >> 4;
                const unsigned tk0 = tokb + scan_pos(c * CH + 2 * sp, dir), tk1 = tokb + scan_pos(c * CH + 2 * sp + 1, dir);
                vv[i][0] = V[tk0 * 1024u + hc + rg * 16 + vrow]; vv[i][1] = V[tk1 * 1024u + hc + rg * 16 + vrow];
            }
            LDS_WAIT();
            float wcr[4];
#pragma unroll
            for (int n = 0; n < 4; ++n) wcr[n] = WCP[16 * n + fr];
            bf16x8 fa[2], fb[2], fk[2], frr[2];
#pragma unroll
            for (int kk = 0; kk < 2; ++kk) {
                fa[kk] = *(const bf16x8*)(XA + fr * TKS + kk * 32 + fq * 8); fb[kk] = *(const bf16x8*)(XB + fr * TKS + kk * 32 + fq * 8);
                fk[kk] = *(const bf16x8*)(XK + fr * TKS + kk * 32 + fq * 8); frr[kk] = *(const bf16x8*)(XR + fr * TKS + kk * 32 + fq * 8);
            }
            LDS_WAIT();
            f32x4 d1 = z4, d2 = z4, d3 = z4, d4 = z4, d5 = z4;
#pragma unroll
            for (int kk = 0; kk < 2; ++kk) {
                d1 = mfma32(fb[kk], fa[kk], d1);
                d2 = mfma32(fa[kk], fb[kk], d2);
                d3 = mfma32(fk[kk], fa[kk], d3);
                d4 = mfma32(fb[kk], frr[kk], d4);
                d5 = mfma32(fk[kk], frr[kk], d5);
            }
            f32x4 im;
#pragma unroll
            for (int j = 0; j < 4; ++j) {
                const unsigned ij = fq * 4 + j;
                d1[j] = ij < fr ? d1[j] : 0.f;
                d2[j] = fr < ij ? d2[j] : 0.f;
                d3[j] = ij < fr ? d3[j] : 0.f;
                d4[j] = ij <= fr ? d4[j] : 0.f;
                d5[j] = ij <= fr ? d5[j] : 0.f;
                im[j] = d1[j] + (ij == fr ? 1.0f : 0.f);
            }
            st4(M + fr * SMS + fq * 4, d1);
            st4(IM + fr * SMS + fq * 4, im);
            st4(NABR + fr * SMS + fq * 4, d2);
            st4(NAKR + fr * SMS + fq * 4, d3);
            st4(NRBT + fr * SMS + fq * 4, d4);
            st4(NRKT + fr * SMS + fq * 4, d5);
            LDS_WAIT();
            const int so = fr * SMS + fq * 4;
            {
                const s16x4v m = ld4(M + so), mt = ld4(NABR + so);
                LDS_WAIT();
                st4(M2T + so, mfma16(m, mt, z4)); st4(M2 + so, mfma16(mt, m, z4));
                LDS_WAIT();
            }
            {
                const s16x4v m2 = ld4(M2 + so), m2t = ld4(M2T + so); const u32x2 imr = *(const u32x2*)(IM + so);
                LDS_WAIT();
                st4(M4T + so, mfma16(m2, m2t, z4)); st4(M4 + so, mfma16(m2t, m2, z4));
                st4(X1 + so, mfma16(m2t, __builtin_bit_cast(s16x4v, imr), up4(imr)));
                LDS_WAIT();
            }
            {
                const s16x4v m4 = ld4(M4 + so), m4t = ld4(M4T + so); const u32x2 x1r = *(const u32x2*)(X1 + so);
                LDS_WAIT();
                st4(M8T + so, mfma16(m4, m4t, z4));
                st4(X2 + so, mfma16(m4t, __builtin_bit_cast(s16x4v, x1r), up4(x1r)));
                LDS_WAIT();
            }
            {
                const s16x4v m8t = ld4(M8T + so); const u32x2 x2r = *(const u32x2*)(X2 + so);
                LDS_WAIT();
                st4(TT + so, mfma16(m8t, __builtin_bit_cast(s16x4v, x2r), up4(x2r)));
                LDS_WAIT();
            }
            const unsigned sl = (unsigned)c % NSLOT;
            char* S = slots + sl * SLOT_BYTES;
            {
                const s16x4v ta = ld4(TT + so), nak = ld4(NAKR + so), nrb = ld4(NRBT + so), nrk = ld4(NRKT + so);
                s16x4v tb[4], tk[4]; u32x2 xr[4];
#pragma unroll
                for (int m = 0; m < 4; ++m) {
                    tb[m] = ld4(TB_ + (16 * m + fr) * KTS + fq * 4); tk[m] = ld4(TK + (16 * m + fr) * KTS + fq * 4);
                    xr[m] = *(const u32x2*)(XR + fr * TKS + 16 * m + fq * 4);
                }
                LDS_WAIT();
                while (*(volatile LAS int*)(cnts + 8) < c - NSLOT + 1) __builtin_amdgcn_s_sleep(1);
                asm volatile("" ::: "memory");
                *(s16x4v*)((bf16_t*)(S + SL_TT) + so) = ta; *(s16x4v*)((bf16_t*)(S + SL_NAK) + so) = nak;
                *(s16x4v*)((bf16_t*)(S + SL_NRB) + so) = nrb; *(s16x4v*)((bf16_t*)(S + SL_NRK) + so) = nrk;
#pragma unroll
                for (int kk = 0; kk < 2; ++kk) *(bf16x8*)((bf16_t*)(S + SL_XA) + fr * TKS + kk * 32 + fq * 8) = fa[kk];
#pragma unroll
                for (int m = 0; m < 4; ++m) {
                    *(u32x2*)((bf16_t*)(S + SL_XR) + fr * TKS + 16 * m + fq * 4) = xr[m];
                    *(s16x4v*)((bf16_t*)(S + SL_TB) + (16 * m + fr) * KTS + fq * 4) = tb[m];
                    *(s16x4v*)((bf16_t*)(S + SL_TK) + (16 * m + fr) * KTS + fq * 4) = tk[m];
                }
                ((float*)(S + SL_WC))[lane] = (fq == 0) ? wcr[0] : (fq == 1) ? wcr[1] : (fq == 2) ? wcr[2] : wcr[3];
#pragma unroll
                for (int i = 0; i < 2; ++i) {
                    const unsigned q = i * 64 + lane, vrow = q & 15, sp = q >> 4;
                    *(unsigned*)((bf16_t*)(S + SL_VT) + vrow * SMS + 2 * sp) = vv[i][0] | (vv[i][1] << 16);
                }
            }
            LDS_WAIT();
            if (lane == 0) *(volatile LAS int*)(cnts + sl) = c + 1;
        }
    }
    __syncthreads();
}

DI void phase_scan(const Params& p, char* smem) {
    for (int u = blockIdx.x; u < NBATCH * 16 * 2 * 4; u += gridDim.x) scan_unit_chunked(p, u, smem);
}

constexpr int NPHASE = 18;
constexpr int cmax_(int a, int b) { return a > b ? a : b; }
constexpr int SMEM_BYTES = cmax_(cmax_(SC2_SMEM, SC_SMEM), cmax_(GEMM_SMEM + 4096, G8_SMEM)) + 64;
static_assert(SMEM_BYTES >= GEMM_SMEM + 4096 + 64 && SMEM_BYTES >= G8_SMEM + 64 && SMEM_BYTES + 16 <= 163840, "LDS");
template <int PH> DI void run_phase(const Params& p, char* smem) {
    if constexpr (PH == 0) phase_prologue(p, smem);
    else if constexpr (PH == 1) phase_norm0(p);
    else if constexpr (PH == 2) phase_qkv(p, smem);
    else if constexpr (PH == 3) phase_attn(p, smem);
    else if constexpr (PH == 4) phase_wout(p, smem);
    else if constexpr (PH == 5) phase_ffn_norm_route(p, 0, smem);
    else if constexpr (PH == 6) phase_moe1(p, 0, smem);
    else if constexpr (PH == 7) phase_moe2(p, 0, smem);
    else if constexpr (PH == 8) phase_combine_l0(p, smem);
    else if constexpr (PH == 9) phase_xx(p);
    else if constexpr (PH == 10) phase_rwkv_proj(p, smem);
    else if constexpr (PH == 11) phase_scan(p, smem);
    else if constexpr (PH == 12) phase_gate(p, smem);
    else if constexpr (PH == 13) phase_wo(p, smem);
    else if constexpr (PH == 14) phase_ffn_norm_route(p, 1, smem);
    else if constexpr (PH == 15) phase_moe1(p, 1, smem);
    else if constexpr (PH == 16) phase_moe2(p, 1, smem);
    else if constexpr (PH == 17) phase_final(p);
}
template <int PH, int END> struct PhaseSeq {
    static DI void run(const Params& p, char* smem, const XcdBarrier& bar) {
        run_phase<PH>(p, smem);
        if constexpr (PH + 1 < END) { xcd_barrier(bar); PhaseSeq<PH + 1, END>::run(p, smem, bar); }
    }
};
template <int BEG, int END>
__global__ void __launch_bounds__(NTH, 2) fwd_kernel(Params p) {
    extern __shared__ __attribute__((aligned(16))) char smem_raw[];
    char* smem = smem_raw + 16;
    if constexpr (END - BEG > 1) {
        if (tidx() == 0) *(uint4*)smem_raw = make_uint4(0u, 0u, 0u, 0u);
        __syncthreads();
        XcdBarrier bar = xcd_barrier_post((unsigned*)(p.ws + OFF_BAR), (volatile LAS unsigned*)smem_raw);
        PhaseSeq<BEG, END>::run(p, smem, bar);
    } else {
        run_phase<BEG>(p, smem);
    }
}

template <int BEG, int END> static void launch_range(const Params& p, int grid, hipStream_t stream) {
    (void)hipFuncSetAttribute((const void*)fwd_kernel<BEG, END>, hipFuncAttributeMaxDynamicSharedMemorySize, SMEM_BYTES + 16);
    hipLaunchKernelGGL((fwd_kernel<BEG, END>), dim3(grid), dim3(NTH), SMEM_BYTES + 16, stream, p);
}
#ifndef RUN_PHASES
#define RUN_PHASES NPHASE
#endif
#ifndef REPEAT_PHASE
#define REPEAT_PHASE -1
#endif
template <int PH> static void launch_each(const Params& p, int grid, hipStream_t stream) {
    launch_range<PH, PH + 1>(p, grid, stream);
    if (PH == REPEAT_PHASE) launch_range<PH, PH + 1>(p, grid, stream);
    if constexpr (PH + 1 < RUN_PHASES) launch_each<PH + 1>(p, grid, stream);
}

extern "C" void kernel_launch(void* const* d_in, const int* in_sizes, int n_in, void* d_out, int out_size, void* d_ws, size_t ws_size, hipStream_t stream) {
    Params p{};
    const float** f = (const float**)&p;
    for (int i = 0; i < 37; ++i) f[i] = (const float*)d_in[i];
    p.out = (float*)d_out;
    p.ws = (char*)d_ws;
    if (ws_size < WS_NEED || n_in < 37) return;
    static int grid = 0;
    if (!grid) {
        int dev = 0, cus = 0;
        (void)hipGetDevice(&dev);
        (void)hipDeviceGetAttribute(&cus, hipDeviceAttributeMultiprocessorCount, dev);
        grid = cus > 0 ? cus : 256;
    }
    (void)hipMemsetAsync(d_ws, 0, 32768, stream);
#if MEGA
    launch_range<0, NPHASE>(p, grid, stream);
#else
    launch_each<0>(p, grid, stream);
#endif
}
```
